# Optimizing an MI355X kernel written in HIP

```python
import jax
import jax.numpy as jnp
from jax import lax
import numpy as np

D_MODEL = 2048
BATCH = 4
SEQ = 2048
DEPTH = 2
DEC_BATCH = 32
DEC_SEQ = 32
PAST_LEN = 2048

CHUNK = 64
N_MEM = 256
MEM_HEADS = 4
MEM_HEAD_DIM = D_MODEL // MEM_HEADS
D_FF = 4 * D_MODEL
POOL_WIDTH = D_MODEL // 4
POOL_WINDOWS = (2, 4, 8, 16)
POOL_GROUPS = len(POOL_WINDOWS)
POOL_GROUP_DIM = POOL_WIDTH // POOL_GROUPS
POOL_HIST = max(POOL_WINDOWS) - 1
GMLP_WIDTH = D_MODEL // 4
GMLP_HEADS = 4
GMLP_HEAD_DIM = GMLP_WIDTH // GMLP_HEADS
GMLP_CHUNK = 128
MLSTM_WIDTH = D_MODEL - POOL_WIDTH - GMLP_WIDTH
MLSTM_HEADS = 8
MLSTM_HEAD_DIM = MLSTM_WIDTH // MLSTM_HEADS
MIX_WIDTH = POOL_WIDTH + GMLP_WIDTH + MLSTM_WIDTH
IN_COLS = POOL_WIDTH + 2 * GMLP_WIDTH + 4 * MLSTM_WIDTH + 2 * MLSTM_HEADS
EPS = 1e-6

kernel_name = "hybrid_pool_gmlp_mlstm_stream_step"


def rmsnorm(x, g):
    xf = x.astype(jnp.float32)
    y = xf * lax.rsqrt(jnp.mean(xf * xf, axis=-1, keepdims=True) + EPS)
    return (y * g.astype(jnp.float32)).astype(x.dtype)


def swiglu(h, w_in, w_out):
    gate, up = jnp.split(h @ w_in, 2, axis=-1)
    return (jax.nn.silu(gate) * up) @ w_out


def pool_mix(xp, hist, pos0, w_pool, scale):
    B, L, C = xp.shape
    full = jnp.concatenate([hist.astype(xp.dtype), xp], axis=1)
    cs = jnp.cumsum(full.astype(jnp.float32), axis=1)
    cs = jnp.pad(cs, ((0, 0), (1, 0), (0, 0)))
    ends = cs[:, POOL_HIST + 1:]
    pos = pos0 + jnp.arange(L)
    xf = xp.astype(jnp.float32)
    outs = []
    for g, w in enumerate(POOL_WINDOWS):
        sl = slice(g * POOL_GROUP_DIM, (g + 1) * POOL_GROUP_DIM)
        start = cs[:, POOL_HIST + 1 - w: POOL_HIST + 1 - w + L, sl]
        cnt = jnp.minimum(pos + 1, w).astype(jnp.float32)[None, :, None]
        outs.append((ends[..., sl] - start) / cnt - xf[..., sl])
    d = jnp.stack(outs, axis=2)
    y = jnp.einsum('blgc,gce->blge', d, w_pool.astype(jnp.float32)).reshape(B, L, C)
    y = y * scale.astype(jnp.float32)
    return y.astype(xp.dtype), full[:, -POOL_HIST:]


def gmlp_mix(u, v, v_gain, ws, bs):
    B, L, _ = u.shape
    Lc = min(L, GMLP_CHUNK)
    n = L // Lc
    vh = rmsnorm(v.reshape(B, L, GMLP_HEADS, GMLP_HEAD_DIM), v_gain.reshape(GMLP_HEADS, GMLP_HEAD_DIM))
    mask = jnp.tril(jnp.ones((Lc, Lc), dtype=bool))
    wsm = jnp.where(mask[None], ws[:, :Lc, :Lc], 0)
    vc = vh.reshape(B, n, Lc, GMLP_HEADS, GMLP_HEAD_DIM)
    s = jnp.einsum('hij,bnjhd->bnihd', wsm, vc) + bs[:, :Lc].T[None, None, :, :, None]
    out = u * s.reshape(B, L, GMLP_WIDTH).astype(u.dtype)
    return out, vh.reshape(B, L, GMLP_WIDTH)


def mlstm_chunk(carry, inp):
    C, n, m = carry
    q, k, v, ig, lf = inp
    L = q.shape[2]
    b = jnp.cumsum(lf, axis=-1)
    mask = jnp.tril(jnp.ones((L, L), dtype=bool))
    D = jnp.where(mask, b[..., :, None] - b[..., None, :] + ig[..., None, :], -jnp.inf)
    inter = b + m[..., None]
    m_row = jnp.maximum(inter, jnp.max(D, axis=-1))
    Dexp = jnp.exp(D - m_row[..., None])
    inter_w = jnp.exp(inter - m_row)
    S = jnp.einsum('bhid,bhjd->bhij', q, k) * Dexp
    num = jnp.einsum('bhij,bhjd->bhid', S, v) + inter_w[..., None] * jnp.einsum('bhid,bhde->bhie', q, C)
    den = jnp.sum(S, axis=-1) + inter_w * jnp.einsum('bhid,bhd->bhi', q, n)
    h = num / jnp.maximum(jnp.abs(den), jnp.exp(-m_row))[..., None]
    bL = b[..., -1]
    wlog = bL[..., None] - b + ig
    m_new = jnp.maximum(bL + m, jnp.max(wlog, axis=-1))
    decay = jnp.exp(bL + m - m_new)
    wt = jnp.exp(wlog - m_new[..., None])
    C_new = decay[..., None, None] * C + jnp.einsum('bht,bhtd,bhte->bhde', wt, k, v)
    n_new = decay[..., None] * n + jnp.einsum('bht,bhtd->bhd', wt, k)
    return (C_new, n_new, m_new), h


def mlstm_mix(q, k, v, o, ig, fg, state, norm_gain):
    B, L, _ = q.shape
    H, dh = MLSTM_HEADS, MLSTM_HEAD_DIM
    Lc = min(L, CHUNK)
    nc = L // Lc

    def heads(t):
        return t.astype(jnp.float32).reshape(B, nc, Lc, H, dh).transpose(1, 0, 3, 2, 4)

    def gates(t):
        return t.astype(jnp.float32).reshape(B, nc, Lc, H).transpose(1, 0, 3, 2)

    qs, ks, vs = heads(q), heads(k) * (dh ** -0.5), heads(v)
    igs = gates(ig)
    lfs = jax.nn.log_sigmoid(gates(fg))
    new_state, h = lax.scan(mlstm_chunk, state, (qs, ks, vs, igs, lfs))
    h = h.transpose(1, 0, 3, 2, 4).reshape(B, L, H, dh)
    h = rmsnorm(h, norm_gain.reshape(H, dh)).reshape(B, L, MLSTM_WIDTH)
    out = (h * jax.nn.sigmoid(o.astype(jnp.float32))).astype(q.dtype)
    return out, new_state


def mem_attend(h, mem_k, mem_v, w_q, w_o):
    B, L, _ = h.shape
    q = (h @ w_q).reshape(B, L, MEM_HEADS, MEM_HEAD_DIM).astype(jnp.float32)
    k = mem_k.reshape(B, N_MEM, MEM_HEADS, MEM_HEAD_DIM).astype(jnp.float32)
    v = mem_v.reshape(B, N_MEM, MEM_HEADS, MEM_HEAD_DIM).astype(jnp.float32)
    s = jnp.einsum('blhd,bmhd->bhlm', q, k) * (MEM_HEAD_DIM ** -0.5)
    p = jax.nn.softmax(s, axis=-1)
    o = jnp.einsum('bhlm,bmhd->blhd', p, v).reshape(B, L, D_MODEL).astype(h.dtype)
    return o @ w_o


def layer(x, pos0, mem_k, mem_v, pool_hist, mstate, p):
    x = x + 0.5 * swiglu(rmsnorm(x, p['g_ffn1']), p['w_ffn1_in'], p['w_ffn1_out'])
    proj = rmsnorm(x, p['g_mix']) @ p['w_in']
    o0 = POOL_WIDTH
    o1 = o0 + GMLP_WIDTH
    o2 = o1 + GMLP_WIDTH
    o3 = o2 + MLSTM_WIDTH
    o4 = o3 + MLSTM_WIDTH
    o5 = o4 + MLSTM_WIDTH
    o6 = o5 + MLSTM_WIDTH
    o7 = o6 + MLSTM_HEADS
    pool_y, pool_state = pool_mix(proj[..., :o0], pool_hist, pos0, p['pool_w'], p['pool_scale'])
    gmlp_y, v_rows = gmlp_mix(proj[..., o0:o1], proj[..., o1:o2], p['gmlp_v_gain'], p['gmlp_ws'], p['gmlp_bs'])
    ig = proj[..., o6:o7] + p['mlstm_i_bias']
    fg = proj[..., o7:] + p['mlstm_f_bias']
    mlstm_y, mstate = mlstm_mix(proj[..., o2:o3], proj[..., o3:o4], proj[..., o4:o5], proj[..., o5:o6],
                                ig, fg, mstate, p['mlstm_norm_gain'])
    x = x + jnp.concatenate([pool_y, gmlp_y, mlstm_y], axis=-1) @ p['w_out']
    x = x + mem_attend(rmsnorm(x, p['g_xattn']), mem_k, mem_v, p['w_mem_q'], p['w_mem_o'])
    x = x + 0.5 * swiglu(rmsnorm(x, p['g_ffn2']), p['w_ffn2_in'], p['w_ffn2_out'])
    return x, pool_state, v_rows, mstate


def setup_inputs(seed: int = 0) -> dict:
    key = jax.random.key(seed)
    ks = iter(jax.random.split(key, 48))

    def nrm(shape, scale=1.0):
        return jax.random.normal(next(ks), shape, dtype=jnp.float32) * scale

    def gain(shape):
        return 1.0 + nrm(shape, 0.05)

    H, dh = MLSTM_HEADS, MLSTM_HEAD_DIM
    return {
        'x_prompt': nrm((BATCH, SEQ, D_MODEL)),
        'x_sample': nrm((DEC_BATCH, DEC_SEQ, D_MODEL)),
        'mem_prompt': nrm((BATCH, N_MEM, D_MODEL)),
        'state_pool': nrm((DEPTH, DEC_BATCH, POOL_HIST, POOL_WIDTH)),
        'state_mlstm_C': nrm((DEPTH, DEC_BATCH, H, dh, dh), 0.5),
        'state_mlstm_n': nrm((DEPTH, DEC_BATCH, H, dh), 0.5),
        'state_mlstm_m': nrm((DEPTH, DEC_BATCH, H), 1.0),
        'cache_mem_k': nrm((DEPTH, DEC_BATCH, N_MEM, D_MODEL)),
        'cache_mem_v': nrm((DEPTH, DEC_BATCH, N_MEM, D_MODEL)),
        'g_ffn1': gain((DEPTH, D_MODEL)),
        'w_ffn1_in': nrm((DEPTH, D_MODEL, 2 * D_FF), D_MODEL ** -0.5),
        'w_ffn1_out': nrm((DEPTH, D_FF, D_MODEL), D_FF ** -0.5),
        'g_mix': gain((DEPTH, D_MODEL)),
        'w_in': nrm((DEPTH, D_MODEL, IN_COLS), D_MODEL ** -0.5),
        'pool_w': nrm((DEPTH, POOL_GROUPS, POOL_GROUP_DIM, POOL_GROUP_DIM), POOL_GROUP_DIM ** -0.5),
        'pool_scale': 0.5 + nrm((DEPTH, POOL_WIDTH), 0.1),
        'gmlp_v_gain': gain((DEPTH, GMLP_WIDTH)),
        'gmlp_ws': nrm((DEPTH, GMLP_HEADS, GMLP_CHUNK, GMLP_CHUNK), 0.5 * GMLP_CHUNK ** -0.5),
        'gmlp_bs': 1.0 + nrm((DEPTH, GMLP_HEADS, GMLP_CHUNK), 0.1),
        'mlstm_i_bias': nrm((DEPTH, H), 0.5),
        'mlstm_f_bias': 3.0 + nrm((DEPTH, H), 0.5),
        'mlstm_norm_gain': gain((DEPTH, MLSTM_WIDTH)),
        'w_out': nrm((DEPTH, MIX_WIDTH, D_MODEL), MIX_WIDTH ** -0.5),
        'g_xattn': gain((DEPTH, D_MODEL)),
        'g_mem': gain((DEPTH, D_MODEL)),
        'w_mem_q': nrm((DEPTH, D_MODEL, D_MODEL), D_MODEL ** -0.5),
        'w_mem_k': nrm((DEPTH, D_MODEL, D_MODEL), D_MODEL ** -0.5),
        'w_mem_v': nrm((DEPTH, D_MODEL, D_MODEL), D_MODEL ** -0.5),
        'w_mem_o': nrm((DEPTH, D_MODEL, D_MODEL), D_MODEL ** -0.5),
        'g_ffn2': gain((DEPTH, D_MODEL)),
        'w_ffn2_in': nrm((DEPTH, D_MODEL, 2 * D_FF), D_MODEL ** -0.5),
        'w_ffn2_out': nrm((DEPTH, D_FF, D_MODEL), D_FF ** -0.5),
        'g_final': gain((D_MODEL,)),
    }


def reference(x_prompt, x_sample, mem_prompt, state_pool, state_mlstm_C, state_mlstm_n, state_mlstm_m,
              cache_mem_k, cache_mem_v, g_ffn1, w_ffn1_in, w_ffn1_out, g_mix, w_in, pool_w, pool_scale,
              gmlp_v_gain, gmlp_ws, gmlp_bs, mlstm_i_bias, mlstm_f_bias, mlstm_norm_gain, w_out,
              g_xattn, g_mem, w_mem_q, w_mem_k, w_mem_v, w_mem_o, g_ffn2, w_ffn2_in, w_ffn2_out, g_final):
    H, dh = MLSTM_HEADS, MLSTM_HEAD_DIM
    B = x_prompt.shape[0]
    yp, ys = x_prompt, x_sample
    pool_p, pool_s, C_p, n_p, m_p, C_s, n_s, m_s, v_s, mk_p, mv_p = ([] for _ in range(11))
    for l in range(DEPTH):
        p = {
            'g_ffn1': g_ffn1[l], 'w_ffn1_in': w_ffn1_in[l], 'w_ffn1_out': w_ffn1_out[l],
            'g_mix': g_mix[l], 'w_in': w_in[l], 'pool_w': pool_w[l], 'pool_scale': pool_scale[l],
            'gmlp_v_gain': gmlp_v_gain[l], 'gmlp_ws': gmlp_ws[l], 'gmlp_bs': gmlp_bs[l],
            'mlstm_i_bias': mlstm_i_bias[l], 'mlstm_f_bias': mlstm_f_bias[l],
            'mlstm_norm_gain': mlstm_norm_gain[l], 'w_out': w_out[l],
            'g_xattn': g_xattn[l], 'w_mem_q': w_mem_q[l], 'w_mem_o': w_mem_o[l],
            'g_ffn2': g_ffn2[l], 'w_ffn2_in': w_ffn2_in[l], 'w_ffn2_out': w_ffn2_out[l],
        }
        mem_n = rmsnorm(mem_prompt, g_mem[l])
        mk = mem_n @ w_mem_k[l]
        mv = mem_n @ w_mem_v[l]
        hist0 = jnp.zeros((B, POOL_HIST, POOL_WIDTH), dtype=yp.dtype)
        st0 = (jnp.zeros((B, H, dh, dh), jnp.float32), jnp.zeros((B, H, dh), jnp.float32),
               jnp.zeros((B, H), jnp.float32))
        yp, ps, _, (Cn, nn_, mn) = layer(yp, 0, mk, mv, hist0, st0, p)
        pool_p.append(ps); C_p.append(Cn); n_p.append(nn_); m_p.append(mn); mk_p.append(mk); mv_p.append(mv)
        st = (state_mlstm_C[l].astype(jnp.float32), state_mlstm_n[l].astype(jnp.float32),
              state_mlstm_m[l].astype(jnp.float32))
        ys, ps2, vrow, (Cn2, nn2, mn2) = layer(ys, PAST_LEN, cache_mem_k[l], cache_mem_v[l], state_pool[l], st, p)
        pool_s.append(ps2); C_s.append(Cn2); n_s.append(nn2); m_s.append(mn2); v_s.append(vrow)
    y_prompt = rmsnorm(yp, g_final)
    y_sample = rmsnorm(ys, g_final)
    return (y_prompt, y_sample, jnp.stack(pool_p), jnp.stack(pool_s),
            jnp.stack(C_p), jnp.stack(n_p), jnp.stack(m_p),
            jnp.stack(C_s), jnp.stack(n_s), jnp.stack(m_s),
            jnp.stack(v_s), jnp.stack(mk_p), jnp.stack(mv_p))
```

```cpp
#include <hip/hip_runtime.h>
#include <cstdio>
#define ONE_LAUNCH 0
#define HD __host__ __device__
#ifndef HD
#define HD __host__ __device__
#endif
typedef unsigned short bf16_t;
HD inline unsigned f2u(float f) { return __builtin_bit_cast(unsigned, f); }
HD inline float u2f(unsigned u) { return __builtin_bit_cast(float, u); }
HD inline bf16_t f2bf(float f) { unsigned u = f2u(f); u += 0x7FFFu + ((u >> 16) & 1u); return (bf16_t)(u >> 16); }
HD inline float bf2f(bf16_t b) { return u2f(((unsigned)b) << 16); }

struct RC {
    static constexpr int D = 2048, FF = 8192, BATCH = 4, SEQ = 2048, DEPTH = 2, DEC_BATCH = 32, DEC_SEQ = 32, PAST = 2048, NMEM = 256;
};
template <class B> struct CfgT : B {
    using B::D; using B::FF; using B::BATCH; using B::SEQ; using B::DEPTH; using B::DEC_BATCH; using B::DEC_SEQ; using B::PAST; using B::NMEM;
    static constexpr int MP = BATCH * SEQ, MS = DEC_BATCH * DEC_SEQ, M = MP + MS, MM = BATCH * NMEM;
    static constexpr int PW = D / 4, PG = 4, PGD = PW / 4, PH = 15;
    static constexpr int GW = D / 4, GH = 4, GHD = GW / 4, GCH = 128;
    static constexpr int MW = D - PW - GW, MH = 8, MHD = MW / 8, CH = 64;
    static constexpr int INC = PW + 2 * GW + 4 * MW + 2 * MH;
    static constexpr int LDP = ((INC + 255) / 256) * 256;
    static constexpr int AH = 4, AHD = D / 4;
    static constexpr int O_U = PW, O_V = PW + GW, O_Q = PW + 2 * GW, O_K = O_Q + MW, O_VM = O_K + MW, O_O = O_VM + MW, O_IG = O_O + MW, O_FG = O_IG + MH;
    static constexpr int NC = SEQ / CH, NPC = BATCH * MH * NC, NSC = DEC_BATCH * MH, NCH = NPC + NSC;
    static constexpr int LCS = DEC_SEQ < CH ? DEC_SEQ : CH;
    static constexpr int GLP = SEQ < GCH ? SEQ : GCH, GLS = DEC_SEQ < GCH ? DEC_SEQ : GCH;
    static constexpr int NSS = 1 + 4 * DEPTH;
    static constexpr long OUT_YP = 0, OUT_YS = OUT_YP + (long)MP * D, OUT_POOLP = OUT_YS + (long)MS * D, OUT_POOLS = OUT_POOLP + (long)DEPTH * BATCH * PH * PW,
        OUT_CP = OUT_POOLS + (long)DEPTH * DEC_BATCH * PH * PW, OUT_NP = OUT_CP + (long)DEPTH * BATCH * MH * MHD * MHD, OUT_MP = OUT_NP + (long)DEPTH * BATCH * MH * MHD,
        OUT_CS = OUT_MP + (long)DEPTH * BATCH * MH, OUT_NS = OUT_CS + (long)DEPTH * DEC_BATCH * MH * MHD * MHD, OUT_MS = OUT_NS + (long)DEPTH * DEC_BATCH * MH * MHD,
        OUT_VS = OUT_MS + (long)DEPTH * DEC_BATCH * MH, OUT_MK = OUT_VS + (long)DEPTH * DEC_BATCH * DEC_SEQ * GW, OUT_MV = OUT_MK + (long)DEPTH * BATCH * NMEM * D,
        OUT_END = OUT_MV + (long)DEPTH * BATCH * NMEM * D;
    static constexpr size_t al(size_t x) { return (x + 255) & ~(size_t)255; }
    static constexpr size_t WS_CTL = 0, WS_SS = 65536, WS_X = al(WS_SS + (size_t)NSS * M * 4), WS_XB = al(WS_X + (size_t)M * D * 4),
        WS_BIG = al(WS_XB + (size_t)M * D * 2),
        WS_BIG_SZ = ((size_t)M * FF * 2 > (size_t)M * LDP * 4) ? (size_t)M * FF * 2 : (size_t)M * LDP * 4,
        WS_MIX = al(WS_BIG + WS_BIG_SZ), WS_Q = al(WS_MIX + (size_t)M * D * 2), WS_AO = al(WS_Q + (size_t)M * D * 2),
        WS_MEMB = al(WS_AO + (size_t)M * D * 2), WS_RSTDM = al(WS_MEMB + (size_t)MM * D * 2),
        WS_PD = al(WS_RSTDM + (size_t)MM * 4), WS_VH = al(WS_PD + (size_t)M * PW * 4),
        WS_GB = al(WS_VH + (size_t)M * GW * 4), WS_GA = al(WS_GB + (size_t)M * MH * 4), WS_GWT = al(WS_GA + (size_t)M * MH * 4),
        WS_CBL = al(WS_GWT + (size_t)M * MH * 4), WS_CML = al(WS_CBL + (size_t)NCH * 4), WS_MPREV = al(WS_CML + (size_t)NCH * 4),
        WS_DC = al(WS_MPREV + (size_t)NCH * 4), WS_DN = al(WS_DC + (size_t)NCH * MHD * MHD * 4),
        WS_SB = al(WS_DN + (size_t)NCH * MHD * 4), WS_DEN = al(WS_SB + (size_t)M * MH * CH * 4), WS_IW = al(WS_DEN + (size_t)M * MH * 4),
        WS_HB = al(WS_IW + (size_t)M * MH * 4), WS_SC = al(WS_HB + (size_t)M * MW * 4),
        WS_W = al(WS_SC + (size_t)M * AH * NMEM * 4);
    static constexpr size_t W_1IN = 0, W_1OUT = W_1IN + (size_t)2 * FF * D, W_IN = W_1OUT + (size_t)D * FF, W_OUT = W_IN + (size_t)LDP * D, W_Q = W_OUT + (size_t)D * D,
        W_KV = W_Q + (size_t)D * D, W_O = W_KV + (size_t)2 * D * D, W_2IN = W_O + (size_t)D * D, W_2OUT = W_2IN + (size_t)2 * FF * D, W_LAYER = W_2OUT + (size_t)D * FF;
    static constexpr size_t WS_END = al(WS_W + (size_t)DEPTH * W_LAYER * 2);
};

struct Ptrs { const float* in[33]; float* out; unsigned char* ws; };
enum { I_XP = 0, I_XS, I_MEM, I_SPOOL, I_SC, I_SN, I_SM, I_CK, I_CV, I_GFFN1, I_W1IN, I_W1OUT, I_GMIX, I_WIN, I_POOLW, I_POOLS, I_GVG, I_GWS, I_GBS, I_IB, I_FB, I_NG, I_WOUT,
       I_GX, I_GMEM, I_WQ, I_WK, I_WV, I_WO, I_GFFN2, I_W2IN, I_W2OUT, I_GFIN };

template <class C> HD inline float* wsf(const Ptrs& p, size_t off) { return (float*)(p.ws + off); }
template <class C> HD inline bf16_t* wsb(const Ptrs& p, size_t off) { return (bf16_t*)(p.ws + off); }
template <class C> HD inline bf16_t* wlayer(const Ptrs& p, int l, size_t off) { return (bf16_t*)(p.ws + C::WS_W) + (size_t)l * C::W_LAYER + off; }

template <class C> HD inline void row_info(int r, bool& s, int& b, int& t) {
    if (r < C::MP) { s = false; b = r / C::SEQ; t = r % C::SEQ; } else { s = true; const int q = r - C::MP; b = q / C::DEC_SEQ; t = q % C::DEC_SEQ; }
}
template <class C> HD inline void chunk_info(int r, int h, int& ci, int& i, int& lc) {
    bool s; int b, t; row_info<C>(r, s, b, t);
    if (!s) { ci = (b * C::MH + h) * C::NC + t / C::CH; i = t % C::CH; lc = C::CH; } else { ci = C::NPC + b * C::MH + h; i = t; lc = C::LCS; }
}
HD inline float sigmoidf_(float x) { return 1.0f / (1.0f + expf(-x)); }
HD inline float logsigmoidf_(float x) { return x >= 0.f ? -log1pf(expf(-x)) : x - log1pf(expf(x)); }

enum { WK_PLAIN = 0, WK_FFNIN = 1, WK_WIN = 2 };
template <class C> HD inline int wsrc_col(int kind, int n) {
    if (kind == WK_FFNIN) { const int pn = n >> 8, j = n & 255; return j < 128 ? 128 * pn + j : C::FF + 128 * pn + (j - 128); }
    if (kind == WK_WIN) return n < C::INC ? n : -1;
    return n;
}

template <class C> HD inline void st_rowinit(const Ptrs& p, int r) {
    const float* src = r < C::MP ? p.in[I_XP] + (size_t)r * C::D : p.in[I_XS] + (size_t)(r - C::MP) * C::D;
    float* X = wsf<C>(p, C::WS_X) + (size_t)r * C::D; bf16_t* XB = wsb<C>(p, C::WS_XB) + (size_t)r * C::D;
    float ss = 0.f;
    for (int k = 0; k < C::D; ++k) { const float v = src[k]; X[k] = v; XB[k] = f2bf(v); ss += v * v; }
    float* SS = wsf<C>(p, C::WS_SS);
    SS[r] = ss;
    for (int j = 1; j < C::NSS; ++j) SS[(size_t)j * C::M + r] = 0.f;
}
template <class C> HD inline void st_meminit(const Ptrs& p, int r) {
    const float* src = p.in[I_MEM] + (size_t)r * C::D; bf16_t* MB = wsb<C>(p, C::WS_MEMB) + (size_t)r * C::D;
    float ss = 0.f;
    for (int k = 0; k < C::D; ++k) { const float v = src[k]; MB[k] = f2bf(v); ss += v * v; }
    wsf<C>(p, C::WS_RSTDM)[r] = 1.0f / sqrtf(ss / C::D + 1e-6f);
}
template <class C> HD inline void st_pool_d(const Ptrs& p, int l, long item) {
    const int r = (int)(item / C::PW), ch = (int)(item % C::PW), g = ch / C::PGD;
    const int w = 2 << g;
    bool s; int b, t; row_info<C>(r, s, b, t);
    const float* P = wsf<C>(p, C::WS_BIG);
    const int pos = (s ? C::PAST : 0) + t;
    float sum = 0.f;
    for (int j = 0; j < w; ++j) { const int tt = t - j;
        float v;
        if (tt >= 0) v = P[(size_t)(r - j) * C::LDP + ch];
        else { const int hi = C::PH + tt;
            v = (s && hi >= 0) ? p.in[I_SPOOL][(((size_t)l * C::DEC_BATCH + b) * C::PH + hi) * C::PW + ch] : 0.f; }
        sum += v; }
    const float cnt = (float)((pos + 1) < w ? (pos + 1) : w);
    wsf<C>(p, C::WS_PD)[(size_t)r * C::PW + ch] = sum / cnt - P[(size_t)r * C::LDP + ch];
    const int L = s ? C::DEC_SEQ : C::SEQ;
    const int idx = t - (L - C::PH);
    if (idx >= 0) { float* o = p.out + (s ? C::OUT_POOLS + (((size_t)l * C::DEC_BATCH + b) * C::PH + idx) * C::PW : C::OUT_POOLP + (((size_t)l * C::BATCH + b) * C::PH + idx) * C::PW);
        o[ch] = P[(size_t)r * C::LDP + ch]; }
}
template <class C> HD inline void st_pool_y(const Ptrs& p, int l, long item) {
    const int r = (int)(item / C::PW), ch = (int)(item % C::PW), g = ch / C::PGD, e = ch % C::PGD;
    const float* d = wsf<C>(p, C::WS_PD) + (size_t)r * C::PW + g * C::PGD;
    const float* w = p.in[I_POOLW] + ((size_t)l * C::PG + g) * C::PGD * C::PGD;
    float acc = 0.f;
    for (int c = 0; c < C::PGD; ++c) acc += d[c] * w[(size_t)c * C::PGD + e];
    wsb<C>(p, C::WS_MIX)[(size_t)r * C::D + ch] = f2bf(acc * p.in[I_POOLS][(size_t)l * C::PW + ch]);
}
template <class C> HD inline void st_gmlp_v(const Ptrs& p, int l, long item) {
    const int r = (int)(item / C::GH), h = (int)(item % C::GH);
    const float* v = wsf<C>(p, C::WS_BIG) + (size_t)r * C::LDP + C::O_V + h * C::GHD;
    float ss = 0.f; for (int d = 0; d < C::GHD; ++d) ss += v[d] * v[d];
    const float rs = 1.0f / sqrtf(ss / C::GHD + 1e-6f);
    float* VH = wsf<C>(p, C::WS_VH) + (size_t)r * C::GW + h * C::GHD; const float* g = p.in[I_GVG] + (size_t)l * C::GW + h * C::GHD;
    bool s; int b, t; row_info<C>(r, s, b, t);
    float* o = s ? p.out + C::OUT_VS + (((size_t)l * C::DEC_BATCH + b) * C::DEC_SEQ + t) * C::GW + h * C::GHD : nullptr;
    for (int d = 0; d < C::GHD; ++d) { const float y = v[d] * rs * g[d]; VH[d] = y; if (o) o[d] = y; }
}
template <class C> HD inline void st_gmlp_s(const Ptrs& p, int l, long item) {
    const int r = (int)(item / C::GW), ch = (int)(item % C::GW), h = ch / C::GHD;
    bool s; int b, t; row_info<C>(r, s, b, t);
    const int lc = s ? C::GLS : C::GLP, i = t % lc, r0 = r - i;
    const float* ws = p.in[I_GWS] + (((size_t)l * C::GH + h) * C::GCH + i) * C::GCH;
    const float* VH = wsf<C>(p, C::WS_VH);
    float acc = p.in[I_GBS][((size_t)l * C::GH + h) * C::GCH + i];
    for (int j = 0; j <= i; ++j) acc += ws[j] * VH[(size_t)(r0 + j) * C::GW + ch];
    const float u = wsf<C>(p, C::WS_BIG)[(size_t)r * C::LDP + C::O_U + ch];
    wsb<C>(p, C::WS_MIX)[(size_t)r * C::D + C::PW + ch] = f2bf(u * acc);
}
template <class C> HD inline void st_ml_a1(const Ptrs& p, int l, int ci) {
    int r0, h, lc;
    if (ci < C::NPC) { const int c = ci % C::NC, bh = ci / C::NC; h = bh % C::MH; const int b = bh / C::MH; r0 = b * C::SEQ + c * C::CH; lc = C::CH; }
    else { const int q = ci - C::NPC; h = q % C::MH; const int b = q / C::MH; r0 = C::MP + b * C::DEC_SEQ; lc = C::LCS; }
    const float* P = wsf<C>(p, C::WS_BIG); float* GB = wsf<C>(p, C::WS_GB); float* GA = wsf<C>(p, C::WS_GA); float* GWT = wsf<C>(p, C::WS_GWT);
    const float ib = p.in[I_IB][l * C::MH + h], fb = p.in[I_FB][l * C::MH + h];
    float bc = 0.f, amax = -3.0e38f;
    for (int i = 0; i < lc; ++i) { const float* pr = P + (size_t)(r0 + i) * C::LDP;
        const float ig = pr[C::O_IG + h] + ib, fg = pr[C::O_FG + h] + fb;
        bc += logsigmoidf_(fg); const float a = ig - bc;
        GB[(size_t)(r0 + i) * C::MH + h] = bc; GA[(size_t)(r0 + i) * C::MH + h] = a; amax = a > amax ? a : amax; }
    const float bL = bc, mloc = bL + amax;
    wsf<C>(p, C::WS_CBL)[ci] = bL; wsf<C>(p, C::WS_CML)[ci] = mloc;
    for (int i = 0; i < lc; ++i) GWT[(size_t)(r0 + i) * C::MH + h] = expf(bL + GA[(size_t)(r0 + i) * C::MH + h] - mloc);
}
template <class C> HD inline void st_ml_a2(const Ptrs& p, int l, long item) {
    const int e = (int)(item % C::MHD), d = (int)((item / C::MHD) % C::MHD), ci = (int)(item / ((long)C::MHD * C::MHD));
    int r0, h, lc;
    if (ci < C::NPC) { const int c = ci % C::NC, bh = ci / C::NC; h = bh % C::MH; const int b = bh / C::MH; r0 = b * C::SEQ + c * C::CH; lc = C::CH; }
    else { const int q = ci - C::NPC; h = q % C::MH; const int b = q / C::MH; r0 = C::MP + b * C::DEC_SEQ; lc = C::LCS; }
    const float* P = wsf<C>(p, C::WS_BIG); const float* GWT = wsf<C>(p, C::WS_GWT);
    const float scale = 1.0f / sqrtf((float)C::MHD);
    float acc = 0.f, accn = 0.f;
    for (int t = 0; t < lc; ++t) { const float* pr = P + (size_t)(r0 + t) * C::LDP; const float wk = GWT[(size_t)(r0 + t) * C::MH + h] * pr[C::O_K + h * C::MHD + d] * scale;
        acc += wk * pr[C::O_VM + h * C::MHD + e]; accn += wk; }
    wsf<C>(p, C::WS_DC)[((size_t)ci * C::MHD + d) * C::MHD + e] = acc;
    if (e == 0) wsf<C>(p, C::WS_DN)[(size_t)ci * C::MHD + d] = accn;
}
template <class C> HD inline void st_ml_b0(const Ptrs& p, int l, int sq) {
    const float* CBL = wsf<C>(p, C::WS_CBL); const float* CML = wsf<C>(p, C::WS_CML); float* MPREV = wsf<C>(p, C::WS_MPREV);
    if (sq < C::BATCH * C::MH) { float m = 0.f;
        for (int c = 0; c < C::NC; ++c) { const int ci = sq * C::NC + c; MPREV[ci] = m; const float a = CBL[ci] + m, b2 = CML[ci]; m = a > b2 ? a : b2; }
        p.out[C::OUT_MP + (size_t)l * C::BATCH * C::MH + sq] = m;
    } else { const int q = sq - C::BATCH * C::MH, ci = C::NPC + q; const float m0 = p.in[I_SM][(size_t)l * C::DEC_BATCH * C::MH + q];
        MPREV[ci] = m0; const float a = CBL[ci] + m0, b2 = CML[ci]; p.out[C::OUT_MS + (size_t)l * C::DEC_BATCH * C::MH + q] = a > b2 ? a : b2; }
}
template <class C> HD inline void st_ml_b(const Ptrs& p, int l, long item) {
    const int e = (int)(item % C::MHD), d = (int)((item / C::MHD) % C::MHD), sq = (int)(item / ((long)C::MHD * C::MHD));
    const float* CBL = wsf<C>(p, C::WS_CBL); const float* CML = wsf<C>(p, C::WS_CML);
    float* DC = wsf<C>(p, C::WS_DC); float* DN = wsf<C>(p, C::WS_DN);
    if (sq < C::BATCH * C::MH) { float m = 0.f, cst = 0.f, nst = 0.f;
        for (int c = 0; c < C::NC; ++c) { const int ci = sq * C::NC + c; const float a = CBL[ci] + m, b2 = CML[ci], mn = a > b2 ? a : b2;
            const float dec = expf(a - mn), f = expf(b2 - mn);
            const size_t o = ((size_t)ci * C::MHD + d) * C::MHD + e; cst = dec * cst + f * DC[o]; DC[o] = cst;
            if (e == 0) { const size_t on = (size_t)ci * C::MHD + d; nst = dec * nst + f * DN[on]; DN[on] = nst; }
            m = mn; }
        p.out[C::OUT_CP + (((size_t)l * C::BATCH * C::MH + sq) * C::MHD + d) * C::MHD + e] = cst;
        if (e == 0) p.out[C::OUT_NP + ((size_t)l * C::BATCH * C::MH + sq) * C::MHD + d] = nst;
    } else { const int q = sq - C::BATCH * C::MH, ci = C::NPC + q; const float m0 = p.in[I_SM][(size_t)l * C::DEC_BATCH * C::MH + q];
        const float a = CBL[ci] + m0, b2 = CML[ci], mn = a > b2 ? a : b2, dec = expf(a - mn), f = expf(b2 - mn);
        const size_t so = (((size_t)l * C::DEC_BATCH * C::MH + q) * C::MHD + d) * C::MHD + e;
        p.out[C::OUT_CS + so] = dec * p.in[I_SC][so] + f * DC[((size_t)ci * C::MHD + d) * C::MHD + e];
        if (e == 0) { const size_t no = ((size_t)l * C::DEC_BATCH * C::MH + q) * C::MHD + d; p.out[C::OUT_NS + no] = dec * p.in[I_SN][no] + f * DN[(size_t)ci * C::MHD + d]; }
    }
}
template <class C> HD inline float ml_cprev(const Ptrs& p, int l, int ci, int d, int e) {
    if (ci < C::NPC) return (ci % C::NC) == 0 ? 0.f : wsf<C>(p, C::WS_DC)[((size_t)(ci - 1) * C::MHD + d) * C::MHD + e];
    return p.in[I_SC][(((size_t)l * C::DEC_BATCH * C::MH + (ci - C::NPC)) * C::MHD + d) * C::MHD + e];
}
template <class C> HD inline float ml_nprev(const Ptrs& p, int l, int ci, int d) {
    if (ci < C::NPC) return (ci % C::NC) == 0 ? 0.f : wsf<C>(p, C::WS_DN)[(size_t)(ci - 1) * C::MHD + d];
    return p.in[I_SN][((size_t)l * C::DEC_BATCH * C::MH + (ci - C::NPC)) * C::MHD + d];
}
template <class C> HD inline void st_ml_c1(const Ptrs& p, int l, long item) {
    const int r = (int)(item / C::MH), h = (int)(item % C::MH);
    int ci, i, lc; chunk_info<C>(r, h, ci, i, lc); const int r0 = r - i;
    const float* P = wsf<C>(p, C::WS_BIG); const float* GB = wsf<C>(p, C::WS_GB); const float* GA = wsf<C>(p, C::WS_GA);
    const float mprev = wsf<C>(p, C::WS_MPREV)[ci];
    const float bi = GB[(size_t)r * C::MH + h];
    float amax = -3.0e38f; for (int j = 0; j <= i; ++j) { const float a = GA[(size_t)(r0 + j) * C::MH + h]; amax = a > amax ? a : amax; }
    const float mrow = bi + (mprev > amax ? mprev : amax);
    const float scale = 1.0f / sqrtf((float)C::MHD);
    const float* q = P + (size_t)r * C::LDP + C::O_Q + h * C::MHD;
    float* S = wsf<C>(p, C::WS_SB) + ((size_t)r * C::MH + h) * C::CH;
    float ssum = 0.f;
    for (int j = 0; j < C::CH; ++j) { float sv = 0.f;
        if (j <= i) { const float* k = P + (size_t)(r0 + j) * C::LDP + C::O_K + h * C::MHD; float dot = 0.f; for (int d = 0; d < C::MHD; ++d) dot += q[d] * k[d];
            sv = dot * scale * expf(bi + GA[(size_t)(r0 + j) * C::MH + h] - mrow); }
        S[j] = sv; ssum += sv; }
    const float iw = expf(bi + mprev - mrow);
    float qn = 0.f; for (int d = 0; d < C::MHD; ++d) qn += q[d] * ml_nprev<C>(p, l, ci, d);
    const float den = ssum + iw * qn, fl = expf(-mrow), ad = fabsf(den);
    wsf<C>(p, C::WS_DEN)[(size_t)r * C::MH + h] = ad > fl ? ad : fl; wsf<C>(p, C::WS_IW)[(size_t)r * C::MH + h] = iw;
}
template <class C> HD inline void st_ml_c2(const Ptrs& p, int l, long item) {
    const int e = (int)(item % C::MHD), h = (int)((item / C::MHD) % C::MH), r = (int)(item / ((long)C::MHD * C::MH));
    int ci, i, lc; chunk_info<C>(r, h, ci, i, lc); const int r0 = r - i;
    const float* P = wsf<C>(p, C::WS_BIG); const float* S = wsf<C>(p, C::WS_SB) + ((size_t)r * C::MH + h) * C::CH;
    float num = 0.f; for (int j = 0; j <= i; ++j) num += S[j] * P[(size_t)(r0 + j) * C::LDP + C::O_VM + h * C::MHD + e];
    const float* q = P + (size_t)r * C::LDP + C::O_Q + h * C::MHD;
    float qc = 0.f; for (int d = 0; d < C::MHD; ++d) qc += q[d] * ml_cprev<C>(p, l, ci, d, e);
    num += wsf<C>(p, C::WS_IW)[(size_t)r * C::MH + h] * qc;
    wsf<C>(p, C::WS_HB)[(size_t)r * C::MW + h * C::MHD + e] = num / wsf<C>(p, C::WS_DEN)[(size_t)r * C::MH + h];
}
template <class C> HD inline void st_ml_c3(const Ptrs& p, int l, long item) {
    const int r = (int)(item / C::MH), h = (int)(item % C::MH);
    const float* hb = wsf<C>(p, C::WS_HB) + (size_t)r * C::MW + h * C::MHD;
    float ss = 0.f; for (int e = 0; e < C::MHD; ++e) ss += hb[e] * hb[e];
    const float rs = 1.0f / sqrtf(ss / C::MHD + 1e-6f);
    const float* g = p.in[I_NG] + (size_t)l * C::MW + h * C::MHD; const float* o = wsf<C>(p, C::WS_BIG) + (size_t)r * C::LDP + C::O_O + h * C::MHD;
    bf16_t* mix = wsb<C>(p, C::WS_MIX) + (size_t)r * C::D + C::PW + C::GW + h * C::MHD;
    for (int e = 0; e < C::MHD; ++e) mix[e] = f2bf(hb[e] * rs * g[e] * sigmoidf_(o[e]));
}
template <class C> HD inline const float* mem_kv(const Ptrs& p, int l, int r, bool isv, int m) {
    bool s; int b, t; row_info<C>(r, s, b, t);
    if (s) return p.in[isv ? I_CV : I_CK] + (((size_t)l * C::DEC_BATCH + b) * C::NMEM + m) * C::D;
    return p.out + (isv ? C::OUT_MV : C::OUT_MK) + (((size_t)l * C::BATCH + b) * C::NMEM + m) * C::D;
}
template <class C> HD inline void st_at_s(const Ptrs& p, int l, long item) {
    const int m = (int)(item % C::NMEM), hd = (int)((item / C::NMEM) % C::AH), r = (int)(item / ((long)C::NMEM * C::AH));
    const bf16_t* q = wsb<C>(p, C::WS_Q) + (size_t)r * C::D + hd * C::AHD; const float* k = mem_kv<C>(p, l, r, false, m) + hd * C::AHD;
    float acc = 0.f; for (int d = 0; d < C::AHD; ++d) acc += bf2f(q[d]) * k[d];
    wsf<C>(p, C::WS_SC)[((size_t)r * C::AH + hd) * C::NMEM + m] = acc / sqrtf((float)C::AHD);
}
template <class C> HD inline void st_at_p(const Ptrs& p, int l, long item) {
    float* sc = wsf<C>(p, C::WS_SC) + (size_t)item * C::NMEM;
    float mx = -3.0e38f; for (int m = 0; m < C::NMEM; ++m) mx = sc[m] > mx ? sc[m] : mx;
    float sum = 0.f; for (int m = 0; m < C::NMEM; ++m) { const float e = expf(sc[m] - mx); sc[m] = e; sum += e; }
    const float inv = 1.0f / sum; for (int m = 0; m < C::NMEM; ++m) sc[m] *= inv;
}
template <class C> HD inline void st_at_o(const Ptrs& p, int l, long item) {
    const int col = (int)(item % C::D), r = (int)(item / C::D), hd = col / C::AHD;
    const float* sc = wsf<C>(p, C::WS_SC) + ((size_t)r * C::AH + hd) * C::NMEM; const float* v0 = mem_kv<C>(p, l, r, true, 0) + col;
    float acc = 0.f; for (int m = 0; m < C::NMEM; ++m) acc += sc[m] * v0[(size_t)m * C::D];
    wsb<C>(p, C::WS_AO)[(size_t)r * C::D + col] = f2bf(acc);
}
template <class C> HD inline void st_final(const Ptrs& p, int r) {
    const float* X = wsf<C>(p, C::WS_X) + (size_t)r * C::D; const float rs = 1.0f / sqrtf(wsf<C>(p, C::WS_SS)[(size_t)(C::NSS - 1) * C::M + r] / C::D + 1e-6f);
    float* o = r < C::MP ? p.out + C::OUT_YP + (size_t)r * C::D : p.out + C::OUT_YS + (size_t)(r - C::MP) * C::D;
    for (int k = 0; k < C::D; ++k) o[k] = X[k] * rs * p.in[I_GFIN][k];
}

namespace pg8 {
#define PG8_LAS __attribute__((address_space(3)))
typedef unsigned short bf16_t;
typedef short bf16x8 __attribute__((ext_vector_type(8)));
typedef float f32x4 __attribute__((ext_vector_type(4)));
typedef unsigned u32x4 __attribute__((ext_vector_type(4)));
constexpr int BM = 256, BK = 64, HALF = 128, HTB = HALF * BK * 2  , STAGE_BYTES = 8 * HTB, NXCD = 8, WGM = 8;

__host__ __device__ __forceinline__ int lds_byte(int r, int c) { const int st = (r >> 4) * 2 + (c >> 5), rr = r & 15, cc = c & 31, ob = rr * 64 + cc * 2; return st * 1024 + (ob ^ (((ob >> 9) & 1) << 5)); }
__host__ __device__ __forceinline__ void stage_rc(int b, int& R, int& C) { const int st = b / 1024, sb = b % 1024, swz = sb ^ (((sb >> 9) & 1) << 5); R = (st >> 1) * 16 + swz / 64; C = (st & 1) * 32 + (swz % 64) / 2; }
__host__ __device__ __forceinline__ int perm32(int rho) { const int n = rho >> 4, i = rho & 15; return 8 * (i >> 2) + 4 * n + (i & 3); }

struct Unit { int pm, pn; };
struct Gemm { const bf16_t* A; const bf16_t* Bt; int M, N, K; };

struct StaticOrder {
    int nM, nN, nwg, G, c;
    __host__ __device__ void init(int M, int N, int G_, int c_) { nM = M / BM; nN = N / BM; nwg = nM * nN; G = G_; c = c_; }
    __host__ __device__ bool next(int i, Unit& u) const {
        const long L = (long)i * G + c; if (L >= nwg) return false;
        int wgid = (int)L; { const int q = nwg / NXCD, r = nwg % NXCD, xcd = wgid % NXCD, off = wgid / NXCD; wgid = (xcd < r ? xcd * (q + 1) : r * (q + 1) + (xcd - r) * q) + off; }
        const int nig = WGM * nN, gid = wgid / nig, fm = gid * WGM, gsz = (nM - fm) < WGM ? (nM - fm) : WGM;
        u.pm = fm + ((wgid % nig) % gsz); u.pn = (wgid % nig) / gsz; return true;
    }
    __device__ __forceinline__ void a_ready(const Unit&) const {}
    __device__ __forceinline__ void done(const Unit&) const {}
};
__device__ __forceinline__ unsigned cvt_pk_bf16(float lo, float hi) { unsigned r; asm volatile("v_cvt_pk_bf16_f32 %0, %1, %2" : "=v"(r) : "v"(lo), "v"(hi)); return r; }
typedef float f32x2 __attribute__((ext_vector_type(2)));
template <class Epi, class Sched, bool STAMP = false>
__device__ __forceinline__ void gemm_phase(PG8_LAS unsigned char* lds, const Gemm g, const Sched& S, const Epi& E, unsigned long long* stamps) {
    int tid_l = threadIdx.x; asm volatile("" : "+v"(tid_l));
    const int tid = tid_l, wid = __builtin_amdgcn_readfirstlane(tid >> 6), lane = tid & 63, wr = wid >> 2, wc = wid & 3, fr = lane & 15, fq = lane >> 4;
    const int K = g.K, nt = K / BK;
    int ts_lo = 0, ts_hi = 0, nts = 0; const unsigned long long rt_entry = STAMP ? (unsigned long long)wall_clock64() : 0ull;
#define PG8_STAMP() do { if (STAMP && wid == 0 && nts < 64) { const unsigned long long _c = (unsigned long long)clock64(); \
        ts_lo = (lane == nts) ? (int)(unsigned)_c : ts_lo; ts_hi = (lane == nts) ? (int)(unsigned)(_c >> 32) : ts_hi; ++nts; } } while (0)
    PG8_STAMP();
    unsigned voffA[2], voffB[2];
#pragma unroll
    for (int i = 0; i < 2; ++i) { int R, C; stage_rc(tid * 16 + i * 8192, R, C); const int Rb = Epi::PERM ? ((R & ~31) + perm32(R & 31)) : R;
        voffA[i] = (unsigned)(R * K + C) * 2u; voffB[i] = (unsigned)(Rb * K + C) * 2u; }
    const size_t kstep = (size_t)(BK * 2);
    const size_t hstep = (size_t)HALF * K * 2;
    const size_t tstep = 2 * hstep;
    const unsigned ldsw = (unsigned)wid * 1024u;
    const int aoff = lds_byte(wr * 64 + fr, fq * 8), boff = lds_byte(wc * 32 + fr, fq * 8);
#define PG8_SA(b, h) (((b) * 2 + (h)) * HTB)
#define PG8_SB(b, h) ((4 + (b) * 2 + (h)) * HTB)
#define PG8_STAGE(bufoff, gbase, voff) do { _Pragma("unroll") for (int _i = 0; _i < 2; ++_i) \
        __builtin_amdgcn_global_load_lds((const unsigned*)((const char*)(gbase) + (voff)[_i]), (PG8_LAS unsigned*)(lds + (bufoff) + ldsw + _i * 8192), 16, 0, 0); } while (0)
#define PG8_LDA(dst, b, h) do { _Pragma("unroll") for (int m = 0; m < 4; ++m) _Pragma("unroll") for (int k = 0; k < 2; ++k) dst[m][k] = *(const PG8_LAS bf16x8*)(lds + PG8_SA(b, h) + aoff + m * 2048 + k * 1024); } while (0)
#define PG8_LDB(dst, b, h) do { _Pragma("unroll") for (int n = 0; n < 2; ++n) _Pragma("unroll") for (int k = 0; k < 2; ++k) dst[n][k] = *(const PG8_LAS bf16x8*)(lds + PG8_SB(b, h) + boff + n * 2048 + k * 1024); } while (0)
#define PG8_MMA(ai, bj, At, Bt) do { __builtin_amdgcn_s_setprio(1); _Pragma("unroll") for (int m = 0; m < 4; ++m) _Pragma("unroll") for (int n = 0; n < 2; ++n) _Pragma("unroll") for (int k = 0; k < 2; ++k) \
        acc[ai][bj][m][n] = __builtin_amdgcn_mfma_f32_16x16x32_bf16(Bt[n][k], At[m][k], acc[ai][bj][m][n], 0, 0, 0); __builtin_amdgcn_s_setprio(0); } while (0)
#define PG8_WAIT_V(n) asm volatile("s_waitcnt vmcnt(" #n ")" ::: "memory")
#define PG8_WAIT_L(n) asm volatile("s_waitcnt lgkmcnt(" #n ")" ::: "memory")
#define PG8_BAR __builtin_amdgcn_s_barrier()
#define PG8_SCHED __builtin_amdgcn_sched_barrier(0)
    Unit cur, nxt; int ui = 0;
    if (!S.next(0, cur)) return;
    f32x4 acc[2][2][4][2];
#pragma unroll
    for (int a = 0; a < 2; ++a)
#pragma unroll
        for (int b = 0; b < 2; ++b)
#pragma unroll
            for (int m = 0; m < 4; ++m)
#pragma unroll
                for (int n = 0; n < 2; ++n) acc[a][b][m][n] = (f32x4){0.f, 0.f, 0.f, 0.f};
    bf16x8 At[4][2], B0[2][2], B1[2][2];
    const char* cA = (const char*)g.A + (size_t)cur.pm * tstep; const char* cB = (const char*)g.Bt + (size_t)cur.pn * tstep;
    S.a_ready(cur);
    PG8_STAGE(PG8_SB(0, 0), cB, voffB); PG8_STAGE(PG8_SA(0, 0), cA, voffA); PG8_STAGE(PG8_SB(0, 1), cB + hstep, voffB); PG8_STAGE(PG8_SA(0, 1), cA + hstep, voffA);
    if (wr == 1) PG8_BAR;
    PG8_WAIT_V(4); PG8_BAR;
    PG8_STAGE(PG8_SB(1, 0), cB + kstep, voffB); PG8_STAGE(PG8_SA(1, 0), cA + kstep, voffA); PG8_STAGE(PG8_SB(1, 1), cB + hstep + kstep, voffB);
    PG8_WAIT_V(6); PG8_BAR;
    PG8_STAMP();
    for (;;) {
        const bool has_next = S.next(ui + 1, nxt);
        const char* nA = has_next ? (const char*)g.A + (size_t)nxt.pm * tstep : cA; const char* nB = has_next ? (const char*)g.Bt + (size_t)nxt.pn * tstep : cB;
        for (int t = 0; t < nt; t += 2) {
            const bool last = (t == nt - 2);
            const char* a1 = cA + (size_t)(t + 1) * kstep;
            const char* a2 = last ? nA : cA + (size_t)(t + 2) * kstep; const char* b2 = last ? nB : cB + (size_t)(t + 2) * kstep;
            const char* a3 = a2 + kstep; const char* b3 = b2 + kstep;
            if (last && has_next) S.a_ready(nxt);
            PG8_LDB(B0, 0, 0); PG8_SCHED; PG8_LDA(At, 0, 0); PG8_STAGE(PG8_SA(1, 1), a1 + hstep, voffA);
            PG8_WAIT_L(8); PG8_BAR; PG8_WAIT_L(0); PG8_MMA(0, 0, At, B0); PG8_BAR; PG8_SCHED;
            PG8_LDB(B1, 0, 1); PG8_STAGE(PG8_SB(0, 0), b2, voffB);
            PG8_BAR; PG8_WAIT_L(0); PG8_MMA(0, 1, At, B1); PG8_BAR;
            PG8_LDA(At, 0, 1); PG8_STAGE(PG8_SA(0, 0), a2, voffA);
            PG8_BAR; PG8_WAIT_L(0); PG8_MMA(1, 0, At, B0); PG8_BAR; PG8_SCHED;
            PG8_STAGE(PG8_SB(0, 1), b2 + hstep, voffB);
            PG8_WAIT_V(6); PG8_BAR; PG8_MMA(1, 1, At, B1); PG8_BAR;
            PG8_LDB(B0, 1, 0); PG8_SCHED; PG8_LDA(At, 1, 0); PG8_STAGE(PG8_SA(0, 1), a2 + hstep, voffA);
            PG8_WAIT_L(8); PG8_BAR; PG8_WAIT_L(0); PG8_MMA(0, 0, At, B0); PG8_BAR; PG8_SCHED;
            PG8_LDB(B1, 1, 1); PG8_STAGE(PG8_SB(1, 0), b3, voffB);
            PG8_BAR; PG8_WAIT_L(0); PG8_MMA(0, 1, At, B1); PG8_BAR;
            PG8_LDA(At, 1, 1); PG8_STAGE(PG8_SA(1, 0), a3, voffA);
            PG8_BAR; PG8_WAIT_L(0); PG8_MMA(1, 0, At, B0); PG8_BAR; PG8_SCHED;
            PG8_STAGE(PG8_SB(1, 1), b3 + hstep, voffB);
            PG8_WAIT_V(6); PG8_BAR; PG8_MMA(1, 1, At, B1); PG8_BAR;
        }
        PG8_STAMP();
        if constexpr (!Epi::AFTER_DRAIN) { E(acc, cur, wr, wc, fr, fq); S.done(cur); }
        PG8_STAMP();
        if (!has_next) break;
#pragma unroll
        for (int a = 0; a < 2; ++a)
#pragma unroll
            for (int b = 0; b < 2; ++b)
#pragma unroll
                for (int m = 0; m < 4; ++m)
#pragma unroll
                    for (int n = 0; n < 2; ++n) acc[a][b][m][n] = (f32x4){0.f, 0.f, 0.f, 0.f};
        cur = nxt; cA = nA; cB = nB; ++ui;
    }
    PG8_WAIT_V(0);
    if (wr == 0) PG8_BAR;
    PG8_BAR;
    if constexpr (Epi::AFTER_DRAIN) { E.fused(acc, cur, wr, wc, fr, fq, lds, wid, lane); S.done(cur); }
    PG8_STAMP();
    if (STAMP && wid == 0) { stamps[lane] = lane < nts ? (((unsigned long long)(unsigned)ts_hi << 32) | (unsigned)ts_lo) : 0ull;
        if (lane == 62) stamps[62] = rt_entry; if (lane == 63) stamps[63] = (unsigned long long)wall_clock64(); }
#undef PG8_STAMP
#undef PG8_SA
#undef PG8_SB
#undef PG8_STAGE
#undef PG8_LDA
#undef PG8_LDB
#undef PG8_MMA
#undef PG8_WAIT_V
#undef PG8_WAIT_L
#undef PG8_BAR
#undef PG8_SCHED
}
}


#define LAS __attribute__((address_space(3)))
#define XB_TMO      128
#define XB_XCNT(j)  (256  + 64 * (j))
#define XB_XSUB(j)  (1280 + 64 * (j))
#define XB_XGEN(j)  (2304 + 64 * (j))
#define XB_TOP      3328
#define XB_TOPGEN   3392
#define XCD_BAR_WORDS 3456
#define XB_SPIN_CAP (1u << 18)

__device__ __forceinline__ unsigned xb_ld(unsigned* p)              { return __hip_atomic_load(p, __ATOMIC_RELAXED, __HIP_MEMORY_SCOPE_AGENT); }
__device__ __forceinline__ unsigned xb_add(unsigned* p, unsigned v) { return __hip_atomic_fetch_add(p, v, __ATOMIC_RELAXED, __HIP_MEMORY_SCOPE_AGENT); }
__device__ __forceinline__ unsigned xb_xcc_id() { return (unsigned)__builtin_amdgcn_s_getreg((3 << 11) | 20) & 0xFu; }
#define XB_SPIN(cond, bar) do { unsigned _sp = 0; while (cond) { __builtin_amdgcn_s_sleep(1); \
    if ((++_sp & 255u) == 0u) { if (xb_ld(&(bar)[XB_TMO])) break; if (_sp > XB_SPIN_CAP) { atomicAdd(&(bar)[XB_TMO], 1u); break; } } } } while (0)

struct XcdBarrier {
    unsigned* bar; unsigned x;
    volatile LAS unsigned* st;
};

__device__ __forceinline__ XcdBarrier xcd_barrier_post(unsigned* bar, volatile LAS unsigned* st) {
    XcdBarrier b; b.bar = bar; b.x = xb_xcc_id(); b.st = st;
    if (threadIdx.x == 0) (void)xb_add(&bar[XB_XCNT(b.x)], 1u);
    return b;
}
__device__ __forceinline__ void xcd_barrier_complete(unsigned* bar, unsigned x, unsigned& nloc, unsigned& nx) {
    const unsigned G = gridDim.x * gridDim.y * gridDim.z;
    unsigned sum, cnt, mine, sp = 0u;
    for (;;) {
        sum = 0u; cnt = 0u; mine = 0u;
#pragma unroll
        for (unsigned j = 0; j < 16; ++j) { const unsigned c = xb_ld(&bar[XB_XCNT(j)]); sum += c; cnt += (c > 0u) ? 1u : 0u; mine = (j == x) ? c : mine; }
        if (sum == G) break;
        __builtin_amdgcn_s_sleep(1);
        if ((++sp & 255u) == 0u) { if (xb_ld(&bar[XB_TMO])) break; if (sp > XB_SPIN_CAP) { atomicAdd(&bar[XB_TMO], 1u); break; } }
    }
    nloc = mine > 0u ? mine : 1u; nx = cnt > 0u ? cnt : 1u;
}

__device__ __forceinline__ void xcd_barrier(const XcdBarrier& b) {
    asm volatile("s_waitcnt vmcnt(0)" ::: "memory");
    __syncthreads();
    if (threadIdx.x == 0) {
        unsigned* bar = b.bar;
        __builtin_amdgcn_s_waitcnt(0);
        unsigned nloc = b.st[0], nx = b.st[1];
        if (nloc == 0u) { xcd_barrier_complete(bar, b.x, nloc, nx); b.st[0] = nloc; b.st[1] = nx; }
        const unsigned old = xb_add(&bar[XB_XSUB(b.x)], 1u);
        const unsigned gen = old / nloc;
        if (old + 1u == (gen + 1u) * nloc) {
            __builtin_amdgcn_fence(__ATOMIC_RELEASE, "agent");
            asm volatile("s_waitcnt vmcnt(0)" ::: "memory");
            const unsigned og = xb_add(&bar[XB_TOP], 1u);
            const unsigned tg = og / nx;
            if (og + 1u == (tg + 1u) * nx) xb_add(&bar[XB_TOPGEN], 1u);
            else XB_SPIN(xb_ld(&bar[XB_TOPGEN]) == tg, bar);
            __builtin_amdgcn_fence(__ATOMIC_ACQUIRE, "agent");
            xb_add(&bar[XB_XGEN(b.x)], 1u);
            asm volatile("s_waitcnt vmcnt(0)" ::: "memory");
        } else {
            XB_SPIN(xb_ld(&bar[XB_XGEN(b.x)]) == gen, bar);
            __builtin_amdgcn_fence(__ATOMIC_ACQUIRE, "agent");
            asm volatile("s_waitcnt vmcnt(0)" ::: "memory");
        }
    }
    __syncthreads();
}

typedef CfgT<RC> C;

constexpr int NTHREADS = 512, NWAVES = 8;
constexpr int LDS_STAGE = 131072, LDS_CTL = LDS_STAGE, LDS_BYTES = LDS_STAGE + 256;

namespace pg8 {
typedef unsigned u32x2 __attribute__((ext_vector_type(2)));
__device__ __forceinline__ float silu_f(float g) { return g * __builtin_amdgcn_rcpf(1.0f + __expf(-g)); }
struct EpiSwiGLU { static constexpr bool PERM = true, AFTER_DRAIN = false;
    bf16_t* act; const float* ss; int ff; float invd;
    __device__ __forceinline__ void operator()(const f32x4 (&acc)[2][2][4][2], const Unit& u, int wr, int wc, int fr, int fq) const {
        const int row0 = u.pm * BM + wr * 64 + fr, col = u.pn * 128 + wc * 32 + 8 * fq;
#pragma unroll
        for (int ai = 0; ai < 2; ++ai)
#pragma unroll
            for (int m = 0; m < 4; ++m) { const int row = row0 + ai * HALF + m * 16; const float rs = rsqrtf(ss[row] * invd + 1e-6f);
                f32x4 v[2];
#pragma unroll
                for (int n = 0; n < 2; ++n) { const f32x4 g = acc[ai][0][m][n] * rs, up = acc[ai][1][m][n] * rs;
#pragma unroll
                    for (int j = 0; j < 4; ++j) v[n][j] = silu_f(g[j]) * up[j]; }
                u32x4 w; w.x = cvt_pk_bf16(v[0][0], v[0][1]); w.y = cvt_pk_bf16(v[0][2], v[0][3]); w.z = cvt_pk_bf16(v[1][0], v[1][1]); w.w = cvt_pk_bf16(v[1][2], v[1][3]);
                *(u32x4*)(act + (size_t)row * ff + col) = w; }
    }
};
struct EpiResid { static constexpr bool PERM = false, AFTER_DRAIN = false;
    float* X; bf16_t* XB; float* ssout; float scale; int ld;
    __device__ __forceinline__ void operator()(const f32x4 (&acc)[2][2][4][2], const Unit& u, int wr, int wc, int fr, int fq) const {
        const int row0 = u.pm * BM + wr * 64 + fr, col0 = u.pn * BM + wc * 32 + 4 * fq;
#pragma unroll
        for (int ai = 0; ai < 2; ++ai)
#pragma unroll
            for (int m = 0; m < 4; ++m) { const int row = row0 + ai * HALF + m * 16; float* xr = X + (size_t)row * ld + col0; bf16_t* br = XB + (size_t)row * ld + col0; float s = 0.f;
#pragma unroll
                for (int bj = 0; bj < 2; ++bj)
#pragma unroll
                    for (int n = 0; n < 2; ++n) { f32x4 x = *(const f32x4*)(xr + bj * HALF + n * 16) + acc[ai][bj][m][n] * scale; *(f32x4*)(xr + bj * HALF + n * 16) = x;
                        u32x2 w; w.x = cvt_pk_bf16(x[0], x[1]); w.y = cvt_pk_bf16(x[2], x[3]); *(u32x2*)(br + bj * HALF + n * 16) = w;
                        s += (x[0] * x[0] + x[1] * x[1]) + (x[2] * x[2] + x[3] * x[3]); }
                s += __shfl_xor(s, 16); s += __shfl_xor(s, 32);
                if (fq == 0) unsafeAtomicAdd(ssout + row, s); }
    }
};
struct EpiScaleF32 { static constexpr bool PERM = false, AFTER_DRAIN = false;
    float* Cp; int ldc; const float* ss; float invd;
    __device__ __forceinline__ void operator()(const f32x4 (&acc)[2][2][4][2], const Unit& u, int wr, int wc, int fr, int fq) const {
        const int row0 = u.pm * BM + wr * 64 + fr, col0 = u.pn * BM + wc * 32 + 4 * fq;
#pragma unroll
        for (int ai = 0; ai < 2; ++ai)
#pragma unroll
            for (int m = 0; m < 4; ++m) { const int row = row0 + ai * HALF + m * 16; const float rs = rsqrtf(ss[row] * invd + 1e-6f); float* cr = Cp + (size_t)row * ldc + col0;
#pragma unroll
                for (int bj = 0; bj < 2; ++bj)
#pragma unroll
                    for (int n = 0; n < 2; ++n) *(f32x4*)(cr + bj * HALF + n * 16) = acc[ai][bj][m][n] * rs; }
    }
};
struct EpiScaleBf16 { static constexpr bool PERM = true, AFTER_DRAIN = false;
    bf16_t* O; int ldc; const float* ss; float invd;
    __device__ __forceinline__ void operator()(const f32x4 (&acc)[2][2][4][2], const Unit& u, int wr, int wc, int fr, int fq) const {
        const int row0 = u.pm * BM + wr * 64 + fr, col0 = u.pn * BM + wc * 32 + 8 * fq;
#pragma unroll
        for (int ai = 0; ai < 2; ++ai)
#pragma unroll
            for (int m = 0; m < 4; ++m) { const int row = row0 + ai * HALF + m * 16; const float rs = rsqrtf(ss[row] * invd + 1e-6f); bf16_t* orow = O + (size_t)row * ldc + col0;
#pragma unroll
                for (int bj = 0; bj < 2; ++bj) { const f32x4 v0 = acc[ai][bj][m][0] * rs, v1 = acc[ai][bj][m][1] * rs;
                    u32x4 w; w.x = cvt_pk_bf16(v0[0], v0[1]); w.y = cvt_pk_bf16(v0[2], v0[3]); w.z = cvt_pk_bf16(v1[0], v1[1]); w.w = cvt_pk_bf16(v1[2], v1[3]);
                    *(u32x4*)(orow + bj * HALF) = w; } }
    }
};
struct EpiMemKV { static constexpr bool PERM = false, AFTER_DRAIN = false;
    float* K; float* V; const float* rstd; int d;
    __device__ __forceinline__ void operator()(const f32x4 (&acc)[2][2][4][2], const Unit& u, int wr, int wc, int fr, int fq) const {
        const int row0 = u.pm * BM + wr * 64 + fr; int ct = u.pn * BM; float* base = K; if (ct >= d) { base = V; ct -= d; }
        const int col0 = ct + wc * 32 + 4 * fq;
#pragma unroll
        for (int ai = 0; ai < 2; ++ai)
#pragma unroll
            for (int m = 0; m < 4; ++m) { const int row = row0 + ai * HALF + m * 16; const float rs = rstd[row]; float* cr = base + (size_t)row * d + col0;
#pragma unroll
                for (int bj = 0; bj < 2; ++bj)
#pragma unroll
                    for (int n = 0; n < 2; ++n) *(f32x4*)(cr + bj * HALF + n * 16) = acc[ai][bj][m][n] * rs; }
    }
};
}

__device__ __forceinline__ unsigned pk2bf(float lo, float hi) { return pg8::cvt_pk_bf16(lo, hi); }
__device__ __forceinline__ void prep_item(const float* W, int K, int Ncols, const float* g, int kind, int N, bf16_t* Bt, LAS float* scr, int item, int lane) {
    const int nblk = N / 32, kb = item / nblk, nb = item % nblk, k0 = 64 * kb, n0 = 32 * nb;
    const int sc = wsrc_col<C>(kind, n0 + (lane & 31));
#pragma unroll 8
    for (int i = 0; i < 32; ++i) { const int kk = 2 * i + (lane >> 5); float v = 0.f;
        if (sc >= 0) { v = W[(size_t)(k0 + kk) * Ncols + sc]; if (g) v *= g[k0 + kk]; }
        scr[kk * 33 + (lane & 31)] = v; }
    asm volatile("s_waitcnt lgkmcnt(0)" ::: "memory");
    const int c = lane & 7;
#pragma unroll
    for (int j = 0; j < 4; ++j) { const int n = (lane >> 3) + 8 * j; const LAS float* s = scr + (8 * c) * 33 + n;
        pg8::u32x4 o; o.x = pk2bf(s[0 * 33], s[1 * 33]); o.y = pk2bf(s[2 * 33], s[3 * 33]); o.z = pk2bf(s[4 * 33], s[5 * 33]); o.w = pk2bf(s[6 * 33], s[7 * 33]);
        *(pg8::u32x4*)(Bt + (size_t)(n0 + n) * K + k0 + 8 * c) = o; }
    asm volatile("s_waitcnt lgkmcnt(0)" ::: "memory");
}
struct WDesc { const float* W; const float* g; bf16_t* dst; int K, Ncols, kind, N; };
__device__ __forceinline__ WDesc wdesc(const Ptrs& p, int l, int idx) {
    WDesc d; d.g = nullptr; d.kind = WK_PLAIN;
    switch (idx) {
    case 0: d.W = p.in[I_W1IN] + (size_t)l * C::D * 2 * C::FF; d.K = C::D; d.Ncols = 2 * C::FF; d.N = 2 * C::FF; d.g = p.in[I_GFFN1] + l * C::D; d.kind = WK_FFNIN; d.dst = wlayer<C>(p, l, C::W_1IN); break;
    case 1: d.W = p.in[I_W1OUT] + (size_t)l * C::FF * C::D; d.K = C::FF; d.Ncols = C::D; d.N = C::D; d.dst = wlayer<C>(p, l, C::W_1OUT); break;
    case 2: d.W = p.in[I_WIN] + (size_t)l * C::D * C::INC; d.K = C::D; d.Ncols = C::INC; d.N = C::LDP; d.g = p.in[I_GMIX] + l * C::D; d.kind = WK_WIN; d.dst = wlayer<C>(p, l, C::W_IN); break;
    case 3: d.W = p.in[I_WOUT] + (size_t)l * C::D * C::D; d.K = C::D; d.Ncols = C::D; d.N = C::D; d.dst = wlayer<C>(p, l, C::W_OUT); break;
    case 4: d.W = p.in[I_WQ] + (size_t)l * C::D * C::D; d.K = C::D; d.Ncols = C::D; d.N = C::D; d.g = p.in[I_GX] + l * C::D; d.dst = wlayer<C>(p, l, C::W_Q); break;
    case 5: d.W = p.in[I_WK] + (size_t)l * C::D * C::D; d.K = C::D; d.Ncols = C::D; d.N = C::D; d.g = p.in[I_GMEM] + l * C::D; d.dst = wlayer<C>(p, l, C::W_KV); break;
    case 6: d.W = p.in[I_WV] + (size_t)l * C::D * C::D; d.K = C::D; d.Ncols = C::D; d.N = C::D; d.g = p.in[I_GMEM] + l * C::D; d.dst = wlayer<C>(p, l, C::W_KV) + (size_t)C::D * C::D; break;
    case 7: d.W = p.in[I_WO] + (size_t)l * C::D * C::D; d.K = C::D; d.Ncols = C::D; d.N = C::D; d.dst = wlayer<C>(p, l, C::W_O); break;
    case 8: d.W = p.in[I_W2IN] + (size_t)l * C::D * 2 * C::FF; d.K = C::D; d.Ncols = 2 * C::FF; d.N = 2 * C::FF; d.g = p.in[I_GFFN2] + l * C::D; d.kind = WK_FFNIN; d.dst = wlayer<C>(p, l, C::W_2IN); break;
    default: d.W = p.in[I_W2OUT] + (size_t)l * C::FF * C::D; d.K = C::FF; d.Ncols = C::D; d.N = C::D; d.dst = wlayer<C>(p, l, C::W_2OUT); break;
    }
    return d;
}

constexpr int PH_PER_LAYER = 18, N_PHASES = 2 + PH_PER_LAYER * C::DEPTH;
struct Args { Ptrs p; int ph_lo, ph_hi; };
__global__ void __launch_bounds__(NTHREADS, 2) fwd(Args a) {
    extern __shared__ __attribute__((aligned(16))) unsigned char lds_raw[];
    LAS unsigned char* lds = (LAS unsigned char*)lds_raw;
    typedef __attribute__((address_space(4))) const Args* KArgs;
    const KArgs ka0 = (KArgs)__builtin_amdgcn_kernarg_segment_ptr();
    const int lo = a.ph_lo, hi = a.ph_hi;
#define IN(k) (lo <= (k) && (k) < hi)
#define BOTH(k) (IN(k) && IN((k) + 1))
#define GRID_BAR(k) do { if (BOTH(k)) { xcd_barrier(bar); } } while (0)
#if defined(__HIP_DEVICE_COMPILE__)
#define LOAD_PTRS KArgs ka = ka0; asm volatile("" : "+s"(ka)); Ptrs p; _Pragma("unroll") for (int i_ = 0; i_ < 33; ++i_) p.in[i_] = ka->p.in[i_]; p.out = ka->p.out; p.ws = ka->p.ws;
#else
#define LOAD_PTRS (void)ka0; const Ptrs p = a.p;
#endif
#define PHASE_ARGS LOAD_PTRS int tid = threadIdx.x; asm volatile("" : "+v"(tid)); \
    const int lane = tid & 63, wave = __builtin_amdgcn_readfirstlane(tid >> 6); (void)lane; (void)wave; \
    const long gtid = (long)blockIdx.x * NTHREADS + tid, gthreads = (long)gridDim.x * NTHREADS; (void)gtid; (void)gthreads; \
    float* SS = wsf<C>(p, C::WS_SS); (void)SS; const float invd = 1.0f / C::D; (void)invd;
#define ITEMS(n, call) do { for (long it = gtid; it < (long)(n); it += gthreads) { call; } } while (0)
#if ONE_LAUNCH
    if (threadIdx.x < 4) ((LAS unsigned*)(lds + LDS_CTL))[threadIdx.x] = 0u;
    __syncthreads();
    XcdBarrier bar = xcd_barrier_post((unsigned*)(a.p.ws + C::WS_CTL), (volatile LAS unsigned*)(lds + LDS_CTL));
#else
    XcdBarrier bar; bar.bar = nullptr; bar.x = 0; bar.st = nullptr;
#endif

    if (IN(0)) { PHASE_ARGS
        LAS float* scr = (LAS float*)(lds + wave * 16384);
        const int gw = blockIdx.x * NWAVES + wave, NGW = gridDim.x * NWAVES;
        for (int l = 0; l < C::DEPTH; ++l)
            for (int idx = 0; idx < 10; ++idx) { const WDesc d = wdesc(p, l, idx); const int nitems = (d.K / 64) * (d.N / 32);
                for (int it = gw; it < nitems; it += NGW) prep_item(d.W, d.K, d.Ncols, d.g, d.kind, d.N, d.dst, scr, it, lane); }
        ITEMS(C::M, st_rowinit<C>(p, (int)it));
        ITEMS(C::MM, st_meminit<C>(p, (int)it));
        GRID_BAR(0);
    }
    for (int l = 0; l < C::DEPTH; ++l) {
        const int pb = 1 + PH_PER_LAYER * l;
#define SSL(j) (SS + (size_t)(4 * l + (j)) * C::M)
        if (IN(pb + 0)) { PHASE_ARGS
            pg8::Gemm g{wsb<C>(p, C::WS_MEMB), wlayer<C>(p, l, C::W_KV), C::MM, 2 * C::D, C::D}; pg8::StaticOrder S; S.init(C::MM, 2 * C::D, gridDim.x, blockIdx.x);
            pg8::EpiMemKV E{p.out + C::OUT_MK + (size_t)l * C::MM * C::D, p.out + C::OUT_MV + (size_t)l * C::MM * C::D, wsf<C>(p, C::WS_RSTDM), C::D};
            pg8::gemm_phase<pg8::EpiMemKV, pg8::StaticOrder, false>(lds, g, S, E, nullptr);
            GRID_BAR(pb + 0);
        }
        if (IN(pb + 1)) { PHASE_ARGS
            pg8::Gemm g{wsb<C>(p, C::WS_XB), wlayer<C>(p, l, C::W_1IN), C::M, 2 * C::FF, C::D}; pg8::StaticOrder S; S.init(C::M, 2 * C::FF, gridDim.x, blockIdx.x);
            pg8::EpiSwiGLU E{wsb<C>(p, C::WS_BIG), SSL(0), C::FF, invd};
            pg8::gemm_phase<pg8::EpiSwiGLU, pg8::StaticOrder, false>(lds, g, S, E, nullptr);
            GRID_BAR(pb + 1);
        }
        if (IN(pb + 2)) { PHASE_ARGS
            pg8::Gemm g{wsb<C>(p, C::WS_BIG), wlayer<C>(p, l, C::W_1OUT), C::M, C::D, C::FF}; pg8::StaticOrder S; S.init(C::M, C::D, gridDim.x, blockIdx.x);
            pg8::EpiResid E{wsf<C>(p, C::WS_X), wsb<C>(p, C::WS_XB), SSL(1), 0.5f, C::D};
            pg8::gemm_phase<pg8::EpiResid, pg8::StaticOrder, false>(lds, g, S, E, nullptr);
            GRID_BAR(pb + 2);
        }
        if (IN(pb + 3)) { PHASE_ARGS
            pg8::Gemm g{wsb<C>(p, C::WS_XB), wlayer<C>(p, l, C::W_IN), C::M, C::LDP, C::D}; pg8::StaticOrder S; S.init(C::M, C::LDP, gridDim.x, blockIdx.x);
            pg8::EpiScaleF32 E{wsf<C>(p, C::WS_BIG), C::LDP, SSL(1), invd};
            pg8::gemm_phase<pg8::EpiScaleF32, pg8::StaticOrder, false>(lds, g, S, E, nullptr);
            GRID_BAR(pb + 3);
        }
        if (IN(pb + 4)) { PHASE_ARGS ITEMS((long)C::M * C::PW, st_pool_d<C>(p, l, it)); ITEMS((long)C::M * C::GH, st_gmlp_v<C>(p, l, it)); ITEMS(C::NCH, st_ml_a1<C>(p, l, (int)it)); GRID_BAR(pb + 4); }
        if (IN(pb + 5)) { PHASE_ARGS ITEMS((long)C::M * C::PW, st_pool_y<C>(p, l, it)); ITEMS((long)C::M * C::GW, st_gmlp_s<C>(p, l, it)); ITEMS((long)C::NCH * C::MHD * C::MHD, st_ml_a2<C>(p, l, it)); GRID_BAR(pb + 5); }
        if (IN(pb + 6)) { PHASE_ARGS ITEMS((C::BATCH + C::DEC_BATCH) * C::MH, st_ml_b0<C>(p, l, (int)it)); ITEMS((long)(C::BATCH + C::DEC_BATCH) * C::MH * C::MHD * C::MHD, st_ml_b<C>(p, l, it)); GRID_BAR(pb + 6); }
        if (IN(pb + 7)) { PHASE_ARGS ITEMS((long)C::M * C::MH, st_ml_c1<C>(p, l, it)); GRID_BAR(pb + 7); }
        if (IN(pb + 8)) { PHASE_ARGS ITEMS((long)C::M * C::MH * C::MHD, st_ml_c2<C>(p, l, it)); GRID_BAR(pb + 8); }
        if (IN(pb + 9)) { PHASE_ARGS ITEMS((long)C::M * C::MH, st_ml_c3<C>(p, l, it)); GRID_BAR(pb + 9); }
        if (IN(pb + 10)) { PHASE_ARGS
            pg8::Gemm g{wsb<C>(p, C::WS_MIX), wlayer<C>(p, l, C::W_OUT), C::M, C::D, C::D}; pg8::StaticOrder S; S.init(C::M, C::D, gridDim.x, blockIdx.x);
            pg8::EpiResid E{wsf<C>(p, C::WS_X), wsb<C>(p, C::WS_XB), SSL(2), 1.0f, C::D};
            pg8::gemm_phase<pg8::EpiResid, pg8::StaticOrder, false>(lds, g, S, E, nullptr);
            GRID_BAR(pb + 10);
        }
        if (IN(pb + 11)) { PHASE_ARGS
            pg8::Gemm g{wsb<C>(p, C::WS_XB), wlayer<C>(p, l, C::W_Q), C::M, C::D, C::D}; pg8::StaticOrder S; S.init(C::M, C::D, gridDim.x, blockIdx.x);
            pg8::EpiScaleBf16 E{wsb<C>(p, C::WS_Q), C::D, SSL(2), invd};
            pg8::gemm_phase<pg8::EpiScaleBf16, pg8::StaticOrder, false>(lds, g, S, E, nullptr);
            GRID_BAR(pb + 11);
        }
        if (IN(pb + 12)) { PHASE_ARGS ITEMS((long)C::M * C::AH * C::NMEM, st_at_s<C>(p, l, it)); GRID_BAR(pb + 12); }
        if (IN(pb + 13)) { PHASE_ARGS ITEMS((long)C::M * C::AH, st_at_p<C>(p, l, it)); GRID_BAR(pb + 13); }
        if (IN(pb + 14)) { PHASE_ARGS ITEMS((long)C::M * C::D, st_at_o<C>(p, l, it)); GRID_BAR(pb + 14); }
        if (IN(pb + 15)) { PHASE_ARGS
            pg8::Gemm g{wsb<C>(p, C::WS_AO), wlayer<C>(p, l, C::W_O), C::M, C::D, C::D}; pg8::StaticOrder S; S.init(C::M, C::D, gridDim.x, blockIdx.x);
            pg8::EpiResid E{wsf<C>(p, C::WS_X), wsb<C>(p, C::WS_XB), SSL(3), 1.0f, C::D};
            pg8::gemm_phase<pg8::EpiResid, pg8::StaticOrder, false>(lds, g, S, E, nullptr);
            GRID_BAR(pb + 15);
        }
        if (IN(pb + 16)) { PHASE_ARGS
            pg8::Gemm g{wsb<C>(p, C::WS_XB), wlayer<C>(p, l, C::W_2IN), C::M, 2 * C::FF, C::D}; pg8::StaticOrder S; S.init(C::M, 2 * C::FF, gridDim.x, blockIdx.x);
            pg8::EpiSwiGLU E{wsb<C>(p, C::WS_BIG), SSL(3), C::FF, invd};
            pg8::gemm_phase<pg8::EpiSwiGLU, pg8::StaticOrder, false>(lds, g, S, E, nullptr);
            GRID_BAR(pb + 16);
        }
        if (IN(pb + 17)) { PHASE_ARGS
            pg8::Gemm g{wsb<C>(p, C::WS_BIG), wlayer<C>(p, l, C::W_2OUT), C::M, C::D, C::FF}; pg8::StaticOrder S; S.init(C::M, C::D, gridDim.x, blockIdx.x);
            pg8::EpiResid E{wsf<C>(p, C::WS_X), wsb<C>(p, C::WS_XB), SSL(4), 0.5f, C::D};
            pg8::gemm_phase<pg8::EpiResid, pg8::StaticOrder, false>(lds, g, S, E, nullptr);
            GRID_BAR(pb + 17);
        }
    }
    if (IN(N_PHASES - 1)) { PHASE_ARGS ITEMS(C::M, st_final<C>(p, (int)it)); }
#undef IN
#undef BOTH
#undef GRID_BAR
#undef ITEMS
#undef PHASE_ARGS
#undef SSL
}

extern "C" void kernel_launch(void* const* d_in, const int* in_sizes, int n_in, void* d_out, int out_size, void* d_ws, size_t ws_size, hipStream_t stream) {
    static int ready = 0;
    if (!ready) {
        if (n_in != 33 || (long)out_size != (long)C::OUT_END || ws_size < (size_t)C::WS_END) { fprintf(stderr, "kernel_launch: unexpected shapes: n_in %d out %d ws %zu (need %zu)\n", n_in, out_size, ws_size, (size_t)C::WS_END); ready = -1; return; }
        if (hipFuncSetAttribute((const void*)fwd, hipFuncAttributeMaxDynamicSharedMemorySize, LDS_BYTES) != hipSuccess) { fprintf(stderr, "kernel_launch: hipFuncSetAttribute failed\n"); ready = -1; return; }
        ready = 1;
    }
    if (ready < 0) return;
    Args a{};
    for (int i = 0; i < 33; ++i) a.p.in[i] = (const float*)d_in[i];
    a.p.out = (float*)d_out; a.p.ws = (unsigned char*)d_ws;
#if ONE_LAUNCH
    (void)hipMemsetAsync((char*)d_ws + C::WS_CTL, 0, 65536, stream);
    a.ph_lo = 0; a.ph_hi = N_PHASES;
    hipLaunchKernelGGL(fwd, dim3(256), dim3(NTHREADS), LDS_BYTES, stream, a);
#else
    for (int k = 0; k < N_PHASES; ++k) { a.ph_lo = k; a.ph_hi = k + 1; hipLaunchKernelGGL(fwd, dim3(256), dim3(NTHREADS), LDS_BYTES, stream, a); }
#endif
}
```

```cpp
#include <hip/hip_runtime.h>
#include <cstdio>
#define ONE_LAUNCH 1
#define HD __host__ __device__
#ifndef HD
#define HD __host__ __device__
#endif
typedef unsigned short bf16_t;
HD inline unsigned f2u(float f) { return __builtin_bit_cast(unsigned, f); }
HD inline float u2f(unsigned u) { return __builtin_bit_cast(float, u); }
HD inline bf16_t f2bf(float f) { unsigned u = f2u(f); u += 0x7FFFu + ((u >> 16) & 1u); return (bf16_t)(u >> 16); }
HD inline float bf2f(bf16_t b) { return u2f(((unsigned)b) << 16); }

struct RC {
    static constexpr int D = 2048, FF = 8192, BATCH = 4, SEQ = 2048, DEPTH = 2, DEC_BATCH = 32, DEC_SEQ = 32, PAST = 2048, NMEM = 256;
};
template <class B> struct CfgT : B {
    using B::D; using B::FF; using B::BATCH; using B::SEQ; using B::DEPTH; using B::DEC_BATCH; using B::DEC_SEQ; using B::PAST; using B::NMEM;
    static constexpr int MP = BATCH * SEQ, MS = DEC_BATCH * DEC_SEQ, M = MP + MS, MM = BATCH * NMEM;
    static constexpr int PW = D / 4, PG = 4, PGD = PW / 4, PH = 15;
    static constexpr int GW = D / 4, GH = 4, GHD = GW / 4, GCH = 128;
    static constexpr int MW = D - PW - GW, MH = 8, MHD = MW / 8, CH = 64;
    static constexpr int INC = PW + 2 * GW + 4 * MW + 2 * MH;
    static constexpr int LDP = ((INC + 255) / 256) * 256;
    static constexpr int AH = 4, AHD = D / 4;
    static constexpr int O_U = PW, O_V = PW + GW, O_Q = PW + 2 * GW, O_K = O_Q + MW, O_VM = O_K + MW, O_O = O_VM + MW, O_IG = O_O + MW, O_FG = O_IG + MH;
    static constexpr int NC = SEQ / CH, NPC = BATCH * MH * NC, NSC = DEC_BATCH * MH, NCH = NPC + NSC;
    static constexpr int LCS = DEC_SEQ < CH ? DEC_SEQ : CH;
    static constexpr int GLP = SEQ < GCH ? SEQ : GCH, GLS = DEC_SEQ < GCH ? DEC_SEQ : GCH;
    static constexpr int NSS = 1 + 4 * DEPTH;
    static constexpr long OUT_YP = 0, OUT_YS = OUT_YP + (long)MP * D, OUT_POOLP = OUT_YS + (long)MS * D, OUT_POOLS = OUT_POOLP + (long)DEPTH * BATCH * PH * PW,
        OUT_CP = OUT_POOLS + (long)DEPTH * DEC_BATCH * PH * PW, OUT_NP = OUT_CP + (long)DEPTH * BATCH * MH * MHD * MHD, OUT_MP = OUT_NP + (long)DEPTH * BATCH * MH * MHD,
        OUT_CS = OUT_MP + (long)DEPTH * BATCH * MH, OUT_NS = OUT_CS + (long)DEPTH * DEC_BATCH * MH * MHD * MHD, OUT_MS = OUT_NS + (long)DEPTH * DEC_BATCH * MH * MHD,
        OUT_VS = OUT_MS + (long)DEPTH * DEC_BATCH * MH, OUT_MK = OUT_VS + (long)DEPTH * DEC_BATCH * DEC_SEQ * GW, OUT_MV = OUT_MK + (long)DEPTH * BATCH * NMEM * D,
        OUT_END = OUT_MV + (long)DEPTH * BATCH * NMEM * D;
    static constexpr size_t al(size_t x) { return (x + 255) & ~(size_t)255; }
    static constexpr size_t WS_CTL = 0, WS_SS = 65536, WS_X = al(WS_SS + (size_t)NSS * M * 4), WS_XB = al(WS_X + (size_t)M * D * 4),
        WS_BIG = al(WS_XB + (size_t)M * D * 2),
        WS_BIG_SZ = ((size_t)M * FF * 2 > (size_t)M * LDP * 4) ? (size_t)M * FF * 2 : (size_t)M * LDP * 4,
        WS_MIX = al(WS_BIG + WS_BIG_SZ), WS_Q = al(WS_MIX + (size_t)M * D * 2), WS_AO = al(WS_Q + (size_t)M * D * 2),
        WS_MEMB = al(WS_AO + (size_t)M * D * 2), WS_RSTDM = al(WS_MEMB + (size_t)MM * D * 2),
        WS_PD = al(WS_RSTDM + (size_t)MM * 4), WS_VH = al(WS_PD + (size_t)M * PW * 4),
        WS_GB = al(WS_VH + (size_t)M * GW * 4), WS_GA = al(WS_GB + (size_t)M * MH * 4), WS_GWT = al(WS_GA + (size_t)M * MH * 4),
        WS_CBL = al(WS_GWT + (size_t)M * MH * 4), WS_CML = al(WS_CBL + (size_t)NCH * 4), WS_MPREV = al(WS_CML + (size_t)NCH * 4),
        WS_DC = al(WS_MPREV + (size_t)NCH * 4), WS_DN = al(WS_DC + (size_t)NCH * MHD * MHD * 4),
        WS_SB = al(WS_DN + (size_t)NCH * MHD * 4), WS_DEN = al(WS_SB + (size_t)M * MH * CH * 4), WS_IW = al(WS_DEN + (size_t)M * MH * 4),
        WS_HB = al(WS_IW + (size_t)M * MH * 4), WS_SC = al(WS_HB + (size_t)M * MW * 4),
        WS_W = al(WS_SC + (size_t)M * AH * NMEM * 4);
    static constexpr size_t W_1IN = 0, W_1OUT = W_1IN + (size_t)2 * FF * D, W_IN = W_1OUT + (size_t)D * FF, W_OUT = W_IN + (size_t)LDP * D, W_Q = W_OUT + (size_t)D * D,
        W_KV = W_Q + (size_t)D * D, W_O = W_KV + (size_t)2 * D * D, W_2IN = W_O + (size_t)D * D, W_2OUT = W_2IN + (size_t)2 * FF * D, W_LAYER = W_2OUT + (size_t)D * FF;
    static constexpr size_t WS_END = al(WS_W + (size_t)DEPTH * W_LAYER * 2);
};

struct Ptrs { const float* in[33]; float* out; unsigned char* ws; };
enum { I_XP = 0, I_XS, I_MEM, I_SPOOL, I_SC, I_SN, I_SM, I_CK, I_CV, I_GFFN1, I_W1IN, I_W1OUT, I_GMIX, I_WIN, I_POOLW, I_POOLS, I_GVG, I_GWS, I_GBS, I_IB, I_FB, I_NG, I_WOUT,
       I_GX, I_GMEM, I_WQ, I_WK, I_WV, I_WO, I_GFFN2, I_W2IN, I_W2OUT, I_GFIN };

template <class C> HD inline float* wsf(const Ptrs& p, size_t off) { return (float*)(p.ws + off); }
template <class C> HD inline bf16_t* wsb(const Ptrs& p, size_t off) { return (bf16_t*)(p.ws + off); }
template <class C> HD inline bf16_t* wlayer(const Ptrs& p, int l, size_t off) { return (bf16_t*)(p.ws + C::WS_W) + (size_t)l * C::W_LAYER + off; }

template <class C> HD inline void row_info(int r, bool& s, int& b, int& t) {
    if (r < C::MP) { s = false; b = r / C::SEQ; t = r % C::SEQ; } else { s = true; const int q = r - C::MP; b = q / C::DEC_SEQ; t = q % C::DEC_SEQ; }
}
template <class C> HD inline void chunk_info(int r, int h, int& ci, int& i, int& lc) {
    bool s; int b, t; row_info<C>(r, s, b, t);
    if (!s) { ci = (b * C::MH + h) * C::NC + t / C::CH; i = t % C::CH; lc = C::CH; } else { ci = C::NPC + b * C::MH + h; i = t; lc = C::LCS; }
}
HD inline float sigmoidf_(float x) { return 1.0f / (1.0f + expf(-x)); }
HD inline float logsigmoidf_(float x) { return x >= 0.f ? -log1pf(expf(-x)) : x - log1pf(expf(x)); }

enum { WK_PLAIN = 0, WK_FFNIN = 1, WK_WIN = 2 };
template <class C> HD inline int wsrc_col(int kind, int n) {
    if (kind == WK_FFNIN) { const int pn = n >> 8, j = n & 255; return j < 128 ? 128 * pn + j : C::FF + 128 * pn + (j - 128); }
    if (kind == WK_WIN) return n < C::INC ? n : -1;
    return n;
}

template <class C> HD inline void st_rowinit(const Ptrs& p, int r) {
    const float* src = r < C::MP ? p.in[I_XP] + (size_t)r * C::D : p.in[I_XS] + (size_t)(r - C::MP) * C::D;
    float* X = wsf<C>(p, C::WS_X) + (size_t)r * C::D; bf16_t* XB = wsb<C>(p, C::WS_XB) + (size_t)r * C::D;
    float ss = 0.f;
    for (int k = 0; k < C::D; ++k) { const float v = src[k]; X[k] = v; XB[k] = f2bf(v); ss += v * v; }
    float* SS = wsf<C>(p, C::WS_SS);
    SS[r] = ss;
    for (int j = 1; j < C::NSS; ++j) SS[(size_t)j * C::M + r] = 0.f;
}
template <class C> HD inline void st_meminit(const Ptrs& p, int r) {
    const float* src = p.in[I_MEM] + (size_t)r * C::D; bf16_t* MB = wsb<C>(p, C::WS_MEMB) + (size_t)r * C::D;
    float ss = 0.f;
    for (int k = 0; k < C::D; ++k) { const float v = src[k]; MB[k] = f2bf(v); ss += v * v; }
    wsf<C>(p, C::WS_RSTDM)[r] = 1.0f / sqrtf(ss / C::D + 1e-6f);
}
template <class C> HD inline void st_pool_d(const Ptrs& p, int l, long item) {
    const int r = (int)(item / C::PW), ch = (int)(item % C::PW), g = ch / C::PGD;
    const int w = 2 << g;
    bool s; int b, t; row_info<C>(r, s, b, t);
    const float* P = wsf<C>(p, C::WS_BIG);
    const int pos = (s ? C::PAST : 0) + t;
    float sum = 0.f;
    for (int j = 0; j < w; ++j) { const int tt = t - j;
        float v;
        if (tt >= 0) v = P[(size_t)(r - j) * C::LDP + ch];
        else { const int hi = C::PH + tt;
            v = (s && hi >= 0) ? p.in[I_SPOOL][(((size_t)l * C::DEC_BATCH + b) * C::PH + hi) * C::PW + ch] : 0.f; }
        sum += v; }
    const float cnt = (float)((pos + 1) < w ? (pos + 1) : w);
    wsf<C>(p, C::WS_PD)[(size_t)r * C::PW + ch] = sum / cnt - P[(size_t)r * C::LDP + ch];
    const int L = s ? C::DEC_SEQ : C::SEQ;
    const int idx = t - (L - C::PH);
    if (idx >= 0) { float* o = p.out + (s ? C::OUT_POOLS + (((size_t)l * C::DEC_BATCH + b) * C::PH + idx) * C::PW : C::OUT_POOLP + (((size_t)l * C::BATCH + b) * C::PH + idx) * C::PW);
        o[ch] = P[(size_t)r * C::LDP + ch]; }
}
template <class C> HD inline void st_pool_y(const Ptrs& p, int l, long item) {
    const int r = (int)(item / C::PW), ch = (int)(item % C::PW), g = ch / C::PGD, e = ch % C::PGD;
    const float* d = wsf<C>(p, C::WS_PD) + (size_t)r * C::PW + g * C::PGD;
    const float* w = p.in[I_POOLW] + ((size_t)l * C::PG + g) * C::PGD * C::PGD;
    float acc = 0.f;
    for (int c = 0; c < C::PGD; ++c) acc += d[c] * w[(size_t)c * C::PGD + e];
    wsb<C>(p, C::WS_MIX)[(size_t)r * C::D + ch] = f2bf(acc * p.in[I_POOLS][(size_t)l * C::PW + ch]);
}
template <class C> HD inline void st_gmlp_v(const Ptrs& p, int l, long item) {
    const int r = (int)(item / C::GH), h = (int)(item % C::GH);
    const float* v = wsf<C>(p, C::WS_BIG) + (size_t)r * C::LDP + C::O_V + h * C::GHD;
    float ss = 0.f; for (int d = 0; d < C::GHD; ++d) ss += v[d] * v[d];
    const float rs = 1.0f / sqrtf(ss / C::GHD + 1e-6f);
    float* VH = wsf<C>(p, C::WS_VH) + (size_t)r * C::GW + h * C::GHD; const float* g = p.in[I_GVG] + (size_t)l * C::GW + h * C::GHD;
    bool s; int b, t; row_info<C>(r, s, b, t);
    float* o = s ? p.out + C::OUT_VS + (((size_t)l * C::DEC_BATCH + b) * C::DEC_SEQ + t) * C::GW + h * C::GHD : nullptr;
    for (int d = 0; d < C::GHD; ++d) { const float y = v[d] * rs * g[d]; VH[d] = y; if (o) o[d] = y; }
}
template <class C> HD inline void st_gmlp_s(const Ptrs& p, int l, long item) {
    const int r = (int)(item / C::GW), ch = (int)(item % C::GW), h = ch / C::GHD;
    bool s; int b, t; row_info<C>(r, s, b, t);
    const int lc = s ? C::GLS : C::GLP, i = t % lc, r0 = r - i;
    const float* ws = p.in[I_GWS] + (((size_t)l * C::GH + h) * C::GCH + i) * C::GCH;
    const float* VH = wsf<C>(p, C::WS_VH);
    float acc = p.in[I_GBS][((size_t)l * C::GH + h) * C::GCH + i];
    for (int j = 0; j <= i; ++j) acc += ws[j] * VH[(size_t)(r0 + j) * C::GW + ch];
    const float u = wsf<C>(p, C::WS_BIG)[(size_t)r * C::LDP + C::O_U + ch];
    wsb<C>(p, C::WS_MIX)[(size_t)r * C::D + C::PW + ch] = f2bf(u * acc);
}
template <class C> HD inline void st_ml_a1(const Ptrs& p, int l, int ci) {
    int r0, h, lc;
    if (ci < C::NPC) { const int c = ci % C::NC, bh = ci / C::NC; h = bh % C::MH; const int b = bh / C::MH; r0 = b * C::SEQ + c * C::CH; lc = C::CH; }
    else { const int q = ci - C::NPC; h = q % C::MH; const int b = q / C::MH; r0 = C::MP + b * C::DEC_SEQ; lc = C::LCS; }
    const float* P = wsf<C>(p, C::WS_BIG); float* GB = wsf<C>(p, C::WS_GB); float* GA = wsf<C>(p, C::WS_GA); float* GWT = wsf<C>(p, C::WS_GWT);
    const float ib = p.in[I_IB][l * C::MH + h], fb = p.in[I_FB][l * C::MH + h];
    float bc = 0.f, amax = -3.0e38f;
    for (int i = 0; i < lc; ++i) { const float* pr = P + (size_t)(r0 + i) * C::LDP;
        const float ig = pr[C::O_IG + h] + ib, fg = pr[C::O_FG + h] + fb;
        bc += logsigmoidf_(fg); const float a = ig - bc;
        GB[(size_t)(r0 + i) * C::MH + h] = bc; GA[(size_t)(r0 + i) * C::MH + h] = a; amax = a > amax ? a : amax; }
    const float bL = bc, mloc = bL + amax;
    wsf<C>(p, C::WS_CBL)[ci] = bL; wsf<C>(p, C::WS_CML)[ci] = mloc;
    for (int i = 0; i < lc; ++i) GWT[(size_t)(r0 + i) * C::MH + h] = expf(bL + GA[(size_t)(r0 + i) * C::MH + h] - mloc);
}
template <class C> HD inline void st_ml_a2(const Ptrs& p, int l, long item) {
    const int e = (int)(item % C::MHD), d = (int)((item / C::MHD) % C::MHD), ci = (int)(item / ((long)C::MHD * C::MHD));
    int r0, h, lc;
    if (ci < C::NPC) { const int c = ci % C::NC, bh = ci / C::NC; h = bh % C::MH; const int b = bh / C::MH; r0 = b * C::SEQ + c * C::CH; lc = C::CH; }
    else { const int q = ci - C::NPC; h = q % C::MH; const int b = q / C::MH; r0 = C::MP + b * C::DEC_SEQ; lc = C::LCS; }
    const float* P = wsf<C>(p, C::WS_BIG); const float* GWT = wsf<C>(p, C::WS_GWT);
    const float scale = 1.0f / sqrtf((float)C::MHD);
    float acc = 0.f, accn = 0.f;
    for (int t = 0; t < lc; ++t) { const float* pr = P + (size_t)(r0 + t) * C::LDP; const float wk = GWT[(size_t)(r0 + t) * C::MH + h] * pr[C::O_K + h * C::MHD + d] * scale;
        acc += wk * pr[C::O_VM + h * C::MHD + e]; accn += wk; }
    wsf<C>(p, C::WS_DC)[((size_t)ci * C::MHD + d) * C::MHD + e] = acc;
    if (e == 0) wsf<C>(p, C::WS_DN)[(size_t)ci * C::MHD + d] = accn;
}
template <class C> HD inline void st_ml_b0(const Ptrs& p, int l, int sq) {
    const float* CBL = wsf<C>(p, C::WS_CBL); const float* CML = wsf<C>(p, C::WS_CML); float* MPREV = wsf<C>(p, C::WS_MPREV);
    if (sq < C::BATCH * C::MH) { float m = 0.f;
        for (int c = 0; c < C::NC; ++c) { const int ci = sq * C::NC + c; MPREV[ci] = m; const float a = CBL[ci] + m, b2 = CML[ci]; m = a > b2 ? a : b2; }
        p.out[C::OUT_MP + (size_t)l * C::BATCH * C::MH + sq] = m;
    } else { const int q = sq - C::BATCH * C::MH, ci = C::NPC + q; const float m0 = p.in[I_SM][(size_t)l * C::DEC_BATCH * C::MH + q];
        MPREV[ci] = m0; const float a = CBL[ci] + m0, b2 = CML[ci]; p.out[C::OUT_MS + (size_t)l * C::DEC_BATCH * C::MH + q] = a > b2 ? a : b2; }
}
template <class C> HD inline void st_ml_b(const Ptrs& p, int l, long item) {
    const int e = (int)(item % C::MHD), d = (int)((item / C::MHD) % C::MHD), sq = (int)(item / ((long)C::MHD * C::MHD));
    const float* CBL = wsf<C>(p, C::WS_CBL); const float* CML = wsf<C>(p, C::WS_CML);
    float* DC = wsf<C>(p, C::WS_DC); float* DN = wsf<C>(p, C::WS_DN);
    if (sq < C::BATCH * C::MH) { float m = 0.f, cst = 0.f, nst = 0.f;
        for (int c = 0; c < C::NC; ++c) { const int ci = sq * C::NC + c; const float a = CBL[ci] + m, b2 = CML[ci], mn = a > b2 ? a : b2;
            const float dec = expf(a - mn), f = expf(b2 - mn);
            const size_t o = ((size_t)ci * C::MHD + d) * C::MHD + e; cst = dec * cst + f * DC[o]; DC[o] = cst;
            if (e == 0) { const size_t on = (size_t)ci * C::MHD + d; nst = dec * nst + f * DN[on]; DN[on] = nst; }
            m = mn; }
        p.out[C::OUT_CP + (((size_t)l * C::BATCH * C::MH + sq) * C::MHD + d) * C::MHD + e] = cst;
        if (e == 0) p.out[C::OUT_NP + ((size_t)l * C::BATCH * C::MH + sq) * C::MHD + d] = nst;
    } else { const int q = sq - C::BATCH * C::MH, ci = C::NPC + q; const float m0 = p.in[I_SM][(size_t)l * C::DEC_BATCH * C::MH + q];
        const float a = CBL[ci] + m0, b2 = CML[ci], mn = a > b2 ? a : b2, dec = expf(a - mn), f = expf(b2 - mn);
        const size_t so = (((size_t)l * C::DEC_BATCH * C::MH + q) * C::MHD + d) * C::MHD + e;
        p.out[C::OUT_CS + so] = dec * p.in[I_SC][so] + f * DC[((size_t)ci * C::MHD + d) * C::MHD + e];
        if (e == 0) { const size_t no = ((size_t)l * C::DEC_BATCH * C::MH + q) * C::MHD + d; p.out[C::OUT_NS + no] = dec * p.in[I_SN][no] + f * DN[(size_t)ci * C::MHD + d]; }
    }
}
template <class C> HD inline float ml_cprev(const Ptrs& p, int l, int ci, int d, int e) {
    if (ci < C::NPC) return (ci % C::NC) == 0 ? 0.f : wsf<C>(p, C::WS_DC)[((size_t)(ci - 1) * C::MHD + d) * C::MHD + e];
    return p.in[I_SC][(((size_t)l * C::DEC_BATCH * C::MH + (ci - C::NPC)) * C::MHD + d) * C::MHD + e];
}
template <class C> HD inline float ml_nprev(const Ptrs& p, int l, int ci, int d) {
    if (ci < C::NPC) return (ci % C::NC) == 0 ? 0.f : wsf<C>(p, C::WS_DN)[(size_t)(ci - 1) * C::MHD + d];
    return p.in[I_SN][((size_t)l * C::DEC_BATCH * C::MH + (ci - C::NPC)) * C::MHD + d];
}
template <class C> HD inline void st_ml_c1(const Ptrs& p, int l, long item) {
    const int r = (int)(item / C::MH), h = (int)(item % C::MH);
    int ci, i, lc; chunk_info<C>(r, h, ci, i, lc); const int r0 = r - i;
    const float* P = wsf<C>(p, C::WS_BIG); const float* GB = wsf<C>(p, C::WS_GB); const float* GA = wsf<C>(p, C::WS_GA);
    const float mprev = wsf<C>(p, C::WS_MPREV)[ci];
    const float bi = GB[(size_t)r * C::MH + h];
    float amax = -3.0e38f; for (int j = 0; j <= i; ++j) { const float a = GA[(size_t)(r0 + j) * C::MH + h]; amax = a > amax ? a : amax; }
    const float mrow = bi + (mprev > amax ? mprev : amax);
    const float scale = 1.0f / sqrtf((float)C::MHD);
    const float* q = P + (size_t)r * C::LDP + C::O_Q + h * C::MHD;
    float* S = wsf<C>(p, C::WS_SB) + ((size_t)r * C::MH + h) * C::CH;
    float ssum = 0.f;
    for (int j = 0; j < C::CH; ++j) { float sv = 0.f;
        if (j <= i) { const float* k = P + (size_t)(r0 + j) * C::LDP + C::O_K + h * C::MHD; float dot = 0.f; for (int d = 0; d < C::MHD; ++d) dot += q[d] * k[d];
            sv = dot * scale * expf(bi + GA[(size_t)(r0 + j) * C::MH + h] - mrow); }
        S[j] = sv; ssum += sv; }
    const float iw = expf(bi + mprev - mrow);
    float qn = 0.f; for (int d = 0; d < C::MHD; ++d) qn += q[d] * ml_nprev<C>(p, l, ci, d);
    const float den = ssum + iw * qn, fl = expf(-mrow), ad = fabsf(den);
    wsf<C>(p, C::WS_DEN)[(size_t)r * C::MH + h] = ad > fl ? ad : fl; wsf<C>(p, C::WS_IW)[(size_t)r * C::MH + h] = iw;
}
template <class C> HD inline void st_ml_c2(const Ptrs& p, int l, long item) {
    const int e = (int)(item % C::MHD), h = (int)((item / C::MHD) % C::MH), r = (int)(item / ((long)C::MHD * C::MH));
    int ci, i, lc; chunk_info<C>(r, h, ci, i, lc); const int r0 = r - i;
    const float* P = wsf<C>(p, C::WS_BIG); const float* S = wsf<C>(p, C::WS_SB) + ((size_t)r * C::MH + h) * C::CH;
    float num = 0.f; for (int j = 0; j <= i; ++j) num += S[j] * P[(size_t)(r0 + j) * C::LDP + C::O_VM + h * C::MHD + e];
    const float* q = P + (size_t)r * C::LDP + C::O_Q + h * C::MHD;
    float qc = 0.f; for (int d = 0; d < C::MHD; ++d) qc += q[d] * ml_cprev<C>(p, l, ci, d, e);
    num += wsf<C>(p, C::WS_IW)[(size_t)r * C::MH + h] * qc;
    wsf<C>(p, C::WS_HB)[(size_t)r * C::MW + h * C::MHD + e] = num / wsf<C>(p, C::WS_DEN)[(size_t)r * C::MH + h];
}
template <class C> HD inline void st_ml_c3(const Ptrs& p, int l, long item) {
    const int r = (int)(item / C::MH), h = (int)(item % C::MH);
    const float* hb = wsf<C>(p, C::WS_HB) + (size_t)r * C::MW + h * C::MHD;
    float ss = 0.f; for (int e = 0; e < C::MHD; ++e) ss += hb[e] * hb[e];
    const float rs = 1.0f / sqrtf(ss / C::MHD + 1e-6f);
    const float* g = p.in[I_NG] + (size_t)l * C::MW + h * C::MHD; const float* o = wsf<C>(p, C::WS_BIG) + (size_t)r * C::LDP + C::O_O + h * C::MHD;
    bf16_t* mix = wsb<C>(p, C::WS_MIX) + (size_t)r * C::D + C::PW + C::GW + h * C::MHD;
    for (int e = 0; e < C::MHD; ++e) mix[e] = f2bf(hb[e] * rs * g[e] * sigmoidf_(o[e]));
}
template <class C> HD inline const float* mem_kv(const Ptrs& p, int l, int r, bool isv, int m) {
    bool s; int b, t; row_info<C>(r, s, b, t);
    if (s) return p.in[isv ? I_CV : I_CK] + (((size_t)l * C::DEC_BATCH + b) * C::NMEM + m) * C::D;
    return p.out + (isv ? C::OUT_MV : C::OUT_MK) + (((size_t)l * C::BATCH + b) * C::NMEM + m) * C::D;
}
template <class C> HD inline void st_at_s(const Ptrs& p, int l, long item) {
    const int m = (int)(item % C::NMEM), hd = (int)((item / C::NMEM) % C::AH), r = (int)(item / ((long)C::NMEM * C::AH));
    const bf16_t* q = wsb<C>(p, C::WS_Q) + (size_t)r * C::D + hd * C::AHD; const float* k = mem_kv<C>(p, l, r, false, m) + hd * C::AHD;
    float acc = 0.f; for (int d = 0; d < C::AHD; ++d) acc += bf2f(q[d]) * k[d];
    wsf<C>(p, C::WS_SC)[((size_t)r * C::AH + hd) * C::NMEM + m] = acc / sqrtf((float)C::AHD);
}
template <class C> HD inline void st_at_p(const Ptrs& p, int l, long item) {
    float* sc = wsf<C>(p, C::WS_SC) + (size_t)item * C::NMEM;
    float mx = -3.0e38f; for (int m = 0; m < C::NMEM; ++m) mx = sc[m] > mx ? sc[m] : mx;
    float sum = 0.f; for (int m = 0; m < C::NMEM; ++m) { const float e = expf(sc[m] - mx); sc[m] = e; sum += e; }
    const float inv = 1.0f / sum; for (int m = 0; m < C::NMEM; ++m) sc[m] *= inv;
}
template <class C> HD inline void st_at_o(const Ptrs& p, int l, long item) {
    const int col = (int)(item % C::D), r = (int)(item / C::D), hd = col / C::AHD;
    const float* sc = wsf<C>(p, C::WS_SC) + ((size_t)r * C::AH + hd) * C::NMEM; const float* v0 = mem_kv<C>(p, l, r, true, 0) + col;
    float acc = 0.f; for (int m = 0; m < C::NMEM; ++m) acc += sc[m] * v0[(size_t)m * C::D];
    wsb<C>(p, C::WS_AO)[(size_t)r * C::D + col] = f2bf(acc);
}
template <class C> HD inline void st_final(const Ptrs& p, int r) {
    const float* X = wsf<C>(p, C::WS_X) + (size_t)r * C::D; const float rs = 1.0f / sqrtf(wsf<C>(p, C::WS_SS)[(size_t)(C::NSS - 1) * C::M + r] / C::D + 1e-6f);
    float* o = r < C::MP ? p.out + C::OUT_YP + (size_t)r * C::D : p.out + C::OUT_YS + (size_t)(r - C::MP) * C::D;
    for (int k = 0; k < C::D; ++k) o[k] = X[k] * rs * p.in[I_GFIN][k];
}

namespace pg8 {
#define PG8_LAS __attribute__((address_space(3)))
typedef unsigned short bf16_t;
typedef short bf16x8 __attribute__((ext_vector_type(8)));
typedef float f32x4 __attribute__((ext_vector_type(4)));
typedef unsigned u32x4 __attribute__((ext_vector_type(4)));
constexpr int BM = 256, BK = 64, HALF = 128, HTB = HALF * BK * 2  , STAGE_BYTES = 8 * HTB, NXCD = 8, WGM = 8;

__host__ __device__ __forceinline__ int lds_byte(int r, int c) { const int st = (r >> 4) * 2 + (c >> 5), rr = r & 15, cc = c & 31, ob = rr * 64 + cc * 2; return st * 1024 + (ob ^ (((ob >> 9) & 1) << 5)); }
__host__ __device__ __forceinline__ void stage_rc(int b, int& R, int& C) { const int st = b / 1024, sb = b % 1024, swz = sb ^ (((sb >> 9) & 1) << 5); R = (st >> 1) * 16 + swz / 64; C = (st & 1) * 32 + (swz % 64) / 2; }
__host__ __device__ __forceinline__ int perm32(int rho) { const int n = rho >> 4, i = rho & 15; return 8 * (i >> 2) + 4 * n + (i & 3); }

struct Unit { int pm, pn; };
struct Gemm { const bf16_t* A; const bf16_t* Bt; int M, N, K; };

struct StaticOrder {
    int nM, nN, nwg, G, c;
    __host__ __device__ void init(int M, int N, int G_, int c_) { nM = M / BM; nN = N / BM; nwg = nM * nN; G = G_; c = c_; }
    __host__ __device__ bool next(int i, Unit& u) const {
        const long L = (long)i * G + c; if (L >= nwg) return false;
        int wgid = (int)L; { const int q = nwg / NXCD, r = nwg % NXCD, xcd = wgid % NXCD, off = wgid / NXCD; wgid = (xcd < r ? xcd * (q + 1) : r * (q + 1) + (xcd - r) * q) + off; }
        const int nig = WGM * nN, gid = wgid / nig, fm = gid * WGM, gsz = (nM - fm) < WGM ? (nM - fm) : WGM;
        u.pm = fm + ((wgid % nig) % gsz); u.pn = (wgid % nig) / gsz; return true;
    }
    __device__ __forceinline__ void a_ready(const Unit&) const {}
    __device__ __forceinline__ void done(const Unit&) const {}
};
__device__ __forceinline__ unsigned cvt_pk_bf16(float lo, float hi) { unsigned r; asm volatile("v_cvt_pk_bf16_f32 %0, %1, %2" : "=v"(r) : "v"(lo), "v"(hi)); return r; }
typedef float f32x2 __attribute__((ext_vector_type(2)));
template <class Epi, class Sched, bool STAMP = false>
__device__ __forceinline__ void gemm_phase(PG8_LAS unsigned char* lds, const Gemm g, const Sched& S, const Epi& E, unsigned long long* stamps) {
    int tid_l = threadIdx.x; asm volatile("" : "+v"(tid_l));
    const int tid = tid_l, wid = __builtin_amdgcn_readfirstlane(tid >> 6), lane = tid & 63, wr = wid >> 2, wc = wid & 3, fr = lane & 15, fq = lane >> 4;
    const int K = g.K, nt = K / BK;
    int ts_lo = 0, ts_hi = 0, nts = 0; const unsigned long long rt_entry = STAMP ? (unsigned long long)wall_clock64() : 0ull;
#define PG8_STAMP() do { if (STAMP && wid == 0 && nts < 64) { const unsigned long long _c = (unsigned long long)clock64(); \
        ts_lo = (lane == nts) ? (int)(unsigned)_c : ts_lo; ts_hi = (lane == nts) ? (int)(unsigned)(_c >> 32) : ts_hi; ++nts; } } while (0)
    PG8_STAMP();
    unsigned voffA[2], voffB[2];
#pragma unroll
    for (int i = 0; i < 2; ++i) { int R, C; stage_rc(tid * 16 + i * 8192, R, C); const int Rb = Epi::PERM ? ((R & ~31) + perm32(R & 31)) : R;
        voffA[i] = (unsigned)(R * K + C) * 2u; voffB[i] = (unsigned)(Rb * K + C) * 2u; }
    const size_t kstep = (size_t)(BK * 2);
    const size_t hstep = (size_t)HALF * K * 2;
    const size_t tstep = 2 * hstep;
    const unsigned ldsw = (unsigned)wid * 1024u;
    const int aoff = lds_byte(wr * 64 + fr, fq * 8), boff = lds_byte(wc * 32 + fr, fq * 8);
#define PG8_SA(b, h) (((b) * 2 + (h)) * HTB)
#define PG8_SB(b, h) ((4 + (b) * 2 + (h)) * HTB)
#define PG8_STAGE(bufoff, gbase, voff) do { _Pragma("unroll") for (int _i = 0; _i < 2; ++_i) \
        __builtin_amdgcn_global_load_lds((const unsigned*)((const char*)(gbase) + (voff)[_i]), (PG8_LAS unsigned*)(lds + (bufoff) + ldsw + _i * 8192), 16, 0, 0); } while (0)
#define PG8_LDA(dst, b, h) do { _Pragma("unroll") for (int m = 0; m < 4; ++m) _Pragma("unroll") for (int k = 0; k < 2; ++k) dst[m][k] = *(const PG8_LAS bf16x8*)(lds + PG8_SA(b, h) + aoff + m * 2048 + k * 1024); } while (0)
#define PG8_LDB(dst, b, h) do { _Pragma("unroll") for (int n = 0; n < 2; ++n) _Pragma("unroll") for (int k = 0; k < 2; ++k) dst[n][k] = *(const PG8_LAS bf16x8*)(lds + PG8_SB(b, h) + boff + n * 2048 + k * 1024); } while (0)
#define PG8_MMA(ai, bj, At, Bt) do { __builtin_amdgcn_s_setprio(1); _Pragma("unroll") for (int m = 0; m < 4; ++m) _Pragma("unroll") for (int n = 0; n < 2; ++n) _Pragma("unroll") for (int k = 0; k < 2; ++k) \
        acc[ai][bj][m][n] = __builtin_amdgcn_mfma_f32_16x16x32_bf16(Bt[n][k], At[m][k], acc[ai][bj][m][n], 0, 0, 0); __builtin_amdgcn_s_setprio(0); } while (0)
#define PG8_WAIT_V(n) asm volatile("s_waitcnt vmcnt(" #n ")" ::: "memory")
#define PG8_WAIT_L(n) asm volatile("s_waitcnt lgkmcnt(" #n ")" ::: "memory")
#define PG8_BAR __builtin_amdgcn_s_barrier()
#define PG8_SCHED __builtin_amdgcn_sched_barrier(0)
    Unit cur, nxt; int ui = 0;
    if (!S.next(0, cur)) return;
    f32x4 acc[2][2][4][2];
#pragma unroll
    for (int a = 0; a < 2; ++a)
#pragma unroll
        for (int b = 0; b < 2; ++b)
#pragma unroll
            for (int m = 0; m < 4; ++m)
#pragma unroll
                for (int n = 0; n < 2; ++n) acc[a][b][m][n] = (f32x4){0.f, 0.f, 0.f, 0.f};
    bf16x8 At[4][2], B0[2][2], B1[2][2];
    const char* cA = (const char*)g.A + (size_t)cur.pm * tstep; const char* cB = (const char*)g.Bt + (size_t)cur.pn * tstep;
    S.a_ready(cur);
    PG8_STAGE(PG8_SB(0, 0), cB, voffB); PG8_STAGE(PG8_SA(0, 0), cA, voffA); PG8_STAGE(PG8_SB(0, 1), cB + hstep, voffB); PG8_STAGE(PG8_SA(0, 1), cA + hstep, voffA);
    if (wr == 1) PG8_BAR;
    PG8_WAIT_V(4); PG8_BAR;
    PG8_STAGE(PG8_SB(1, 0), cB + kstep, voffB); PG8_STAGE(PG8_SA(1, 0), cA + kstep, voffA); PG8_STAGE(PG8_SB(1, 1), cB + hstep + kstep, voffB);
    PG8_WAIT_V(6); PG8_BAR;
    PG8_STAMP();
    for (;;) {
        const bool has_next = S.next(ui + 1, nxt);
        const char* nA = has_next ? (const char*)g.A + (size_t)nxt.pm * tstep : cA; const char* nB = has_next ? (const char*)g.Bt + (size_t)nxt.pn * tstep : cB;
        for (int t = 0; t < nt; t += 2) {
            const bool last = (t == nt - 2);
            const char* a1 = cA + (size_t)(t + 1) * kstep;
            const char* a2 = last ? nA : cA + (size_t)(t + 2) * kstep; const char* b2 = last ? nB : cB + (size_t)(t + 2) * kstep;
            const char* a3 = a2 + kstep; const char* b3 = b2 + kstep;
            if (last && has_next) S.a_ready(nxt);
            PG8_LDB(B0, 0, 0); PG8_SCHED; PG8_LDA(At, 0, 0); PG8_STAGE(PG8_SA(1, 1), a1 + hstep, voffA);
            PG8_WAIT_L(8); PG8_BAR; PG8_WAIT_L(0); PG8_MMA(0, 0, At, B0); PG8_BAR; PG8_SCHED;
            PG8_LDB(B1, 0, 1); PG8_STAGE(PG8_SB(0, 0), b2, voffB);
            PG8_BAR; PG8_WAIT_L(0); PG8_MMA(0, 1, At, B1); PG8_BAR;
            PG8_LDA(At, 0, 1); PG8_STAGE(PG8_SA(0, 0), a2, voffA);
            PG8_BAR; PG8_WAIT_L(0); PG8_MMA(1, 0, At, B0); PG8_BAR; PG8_SCHED;
            PG8_STAGE(PG8_SB(0, 1), b2 + hstep, voffB);
            PG8_WAIT_V(6); PG8_BAR; PG8_MMA(1, 1, At, B1); PG8_BAR;
            PG8_LDB(B0, 1, 0); PG8_SCHED; PG8_LDA(At, 1, 0); PG8_STAGE(PG8_SA(0, 1), a2 + hstep, voffA);
            PG8_WAIT_L(8); PG8_BAR; PG8_WAIT_L(0); PG8_MMA(0, 0, At, B0); PG8_BAR; PG8_SCHED;
            PG8_LDB(B1, 1, 1); PG8_STAGE(PG8_SB(1, 0), b3, voffB);
            PG8_BAR; PG8_WAIT_L(0); PG8_MMA(0, 1, At, B1); PG8_BAR;
            PG8_LDA(At, 1, 1); PG8_STAGE(PG8_SA(1, 0), a3, voffA);
            PG8_BAR; PG8_WAIT_L(0); PG8_MMA(1, 0, At, B0); PG8_BAR; PG8_SCHED;
            PG8_STAGE(PG8_SB(1, 1), b3 + hstep, voffB);
            PG8_WAIT_V(6); PG8_BAR; PG8_MMA(1, 1, At, B1); PG8_BAR;
        }
        PG8_STAMP();
        if constexpr (!Epi::AFTER_DRAIN) { E(acc, cur, wr, wc, fr, fq); S.done(cur); }
        PG8_STAMP();
        if (!has_next) break;
#pragma unroll
        for (int a = 0; a < 2; ++a)
#pragma unroll
            for (int b = 0; b < 2; ++b)
#pragma unroll
                for (int m = 0; m < 4; ++m)
#pragma unroll
                    for (int n = 0; n < 2; ++n) acc[a][b][m][n] = (f32x4){0.f, 0.f, 0.f, 0.f};
        cur = nxt; cA = nA; cB = nB; ++ui;
    }
    PG8_WAIT_V(0);
    if (wr == 0) PG8_BAR;
    PG8_BAR;
    if constexpr (Epi::AFTER_DRAIN) { E.fused(acc, cur, wr, wc, fr, fq, lds, wid, lane); S.done(cur); }
    PG8_STAMP();
    if (STAMP && wid == 0) { stamps[lane] = lane < nts ? (((unsigned long long)(unsigned)ts_hi << 32) | (unsigned)ts_lo) : 0ull;
        if (lane == 62) stamps[62] = rt_entry; if (lane == 63) stamps[63] = (unsigned long long)wall_clock64(); }
#undef PG8_STAMP
#undef PG8_SA
#undef PG8_SB
#undef PG8_STAGE
#undef PG8_LDA
#undef PG8_LDB
#undef PG8_MMA
#undef PG8_WAIT_V
#undef PG8_WAIT_L
#undef PG8_BAR
#undef PG8_SCHED
}
}


#define LAS __attribute__((address_space(3)))
#define XB_TMO      128
#define XB_XCNT(j)  (256  + 64 * (j))
#define XB_XSUB(j)  (1280 + 64 * (j))
#define XB_XGEN(j)  (2304 + 64 * (j))
#define XB_TOP      3328
#define XB_TOPGEN   3392
#define XCD_BAR_WORDS 3456
#define XB_SPIN_CAP (1u << 18)

__device__ __forceinline__ unsigned xb_ld(unsigned* p)              { return __hip_atomic_load(p, __ATOMIC_RELAXED, __HIP_MEMORY_SCOPE_AGENT); }
__device__ __forceinline__ unsigned xb_add(unsigned* p, unsigned v) { return __hip_atomic_fetch_add(p, v, __ATOMIC_RELAXED, __HIP_MEMORY_SCOPE_AGENT); }
__device__ __forceinline__ unsigned xb_xcc_id() { return (unsigned)__builtin_amdgcn_s_getreg((3 << 11) | 20) & 0xFu; }
#define XB_SPIN(cond, bar) do { unsigned _sp = 0; while (cond) { __builtin_amdgcn_s_sleep(1); \
    if ((++_sp & 255u) == 0u) { if (xb_ld(&(bar)[XB_TMO])) break; if (_sp > XB_SPIN_CAP) { atomicAdd(&(bar)[XB_TMO], 1u); break; } } } } while (0)

struct XcdBarrier {
    unsigned* bar; unsigned x;
    volatile LAS unsigned* st;
};

__device__ __forceinline__ XcdBarrier xcd_barrier_post(unsigned* bar, volatile LAS unsigned* st) {
    XcdBarrier b; b.bar = bar; b.x = xb_xcc_id(); b.st = st;
    if (threadIdx.x == 0) (void)xb_add(&bar[XB_XCNT(b.x)], 1u);
    return b;
}
__device__ __forceinline__ void xcd_barrier_complete(unsigned* bar, unsigned x, unsigned& nloc, unsigned& nx) {
    const unsigned G = gridDim.x * gridDim.y * gridDim.z;
    unsigned sum, cnt, mine, sp = 0u;
    for (;;) {
        sum = 0u; cnt = 0u; mine = 0u;
#pragma unroll
        for (unsigned j = 0; j < 16; ++j) { const unsigned c = xb_ld(&bar[XB_XCNT(j)]); sum += c; cnt += (c > 0u) ? 1u : 0u; mine = (j == x) ? c : mine; }
        if (sum == G) break;
        __builtin_amdgcn_s_sleep(1);
        if ((++sp & 255u) == 0u) { if (xb_ld(&bar[XB_TMO])) break; if (sp > XB_SPIN_CAP) { atomicAdd(&bar[XB_TMO], 1u); break; } }
    }
    nloc = mine > 0u ? mine : 1u; nx = cnt > 0u ? cnt : 1u;
}

__device__ __forceinline__ void xcd_barrier(const XcdBarrier& b) {
    asm volatile("s_waitcnt vmcnt(0)" ::: "memory");
    __syncthreads();
    if (threadIdx.x == 0) {
        unsigned* bar = b.bar;
        __builtin_amdgcn_s_waitcnt(0);
        unsigned nloc = b.st[0], nx = b.st[1];
        if (nloc == 0u) { xcd_barrier_complete(bar, b.x, nloc, nx); b.st[0] = nloc; b.st[1] = nx; }
        const unsigned old = xb_add(&bar[XB_XSUB(b.x)], 1u);
        const unsigned gen = old / nloc;
        if (old + 1u == (gen + 1u) * nloc) {
            __builtin_amdgcn_fence(__ATOMIC_RELEASE, "agent");
            asm volatile("s_waitcnt vmcnt(0)" ::: "memory");
            const unsigned og = xb_add(&bar[XB_TOP], 1u);
            const unsigned tg = og / nx;
            if (og + 1u == (tg + 1u) * nx) xb_add(&bar[XB_TOPGEN], 1u);
            else XB_SPIN(xb_ld(&bar[XB_TOPGEN]) == tg, bar);
            __builtin_amdgcn_fence(__ATOMIC_ACQUIRE, "agent");
            xb_add(&bar[XB_XGEN(b.x)], 1u);
            asm volatile("s_waitcnt vmcnt(0)" ::: "memory");
        } else {
            XB_SPIN(xb_ld(&bar[XB_XGEN(b.x)]) == gen, bar);
            __builtin_amdgcn_fence(__ATOMIC_ACQUIRE, "agent");
            asm volatile("s_waitcnt vmcnt(0)" ::: "memory");
        }
    }
    __syncthreads();
}

typedef CfgT<RC> C;

constexpr int NTHREADS = 512, NWAVES = 8;
constexpr int LDS_STAGE = 131072, LDS_CTL = LDS_STAGE, LDS_BYTES = LDS_STAGE + 256;

namespace pg8 {
typedef unsigned u32x2 __attribute__((ext_vector_type(2)));
__device__ __forceinline__ float silu_f(float g) { return g * __builtin_amdgcn_rcpf(1.0f + __expf(-g)); }
struct EpiSwiGLU { static constexpr bool PERM = true, AFTER_DRAIN = false;
    bf16_t* act; const float* ss; int ff; float invd;
    __device__ __forceinline__ void operator()(const f32x4 (&acc)[2][2][4][2], const Unit& u, int wr, int wc, int fr, int fq) const {
        const int row0 = u.pm * BM + wr * 64 + fr, col = u.pn * 128 + wc * 32 + 8 * fq;
#pragma unroll
        for (int ai = 0; ai < 2; ++ai)
#pragma unroll
            for (int m = 0; m < 4; ++m) { const int row = row0 + ai * HALF + m * 16; const float rs = rsqrtf(ss[row] * invd + 1e-6f);
                f32x4 v[2];
#pragma unroll
                for (int n = 0; n < 2; ++n) { const f32x4 g = acc[ai][0][m][n] * rs, up = acc[ai][1][m][n] * rs;
#pragma unroll
                    for (int j = 0; j < 4; ++j) v[n][j] = silu_f(g[j]) * up[j]; }
                u32x4 w; w.x = cvt_pk_bf16(v[0][0], v[0][1]); w.y = cvt_pk_bf16(v[0][2], v[0][3]); w.z = cvt_pk_bf16(v[1][0], v[1][1]); w.w = cvt_pk_bf16(v[1][2], v[1][3]);
                *(u32x4*)(act + (size_t)row * ff + col) = w; }
    }
};
struct EpiResid { static constexpr bool PERM = false, AFTER_DRAIN = false;
    float* X; bf16_t* XB; float* ssout; float scale; int ld;
    __device__ __forceinline__ void operator()(const f32x4 (&acc)[2][2][4][2], const Unit& u, int wr, int wc, int fr, int fq) const {
        const int row0 = u.pm * BM + wr * 64 + fr, col0 = u.pn * BM + wc * 32 + 4 * fq;
#pragma unroll
        for (int ai = 0; ai < 2; ++ai)
#pragma unroll
            for (int m = 0; m < 4; ++m) { const int row = row0 + ai * HALF + m * 16; float* xr = X + (size_t)row * ld + col0; bf16_t* br = XB + (size_t)row * ld + col0; float s = 0.f;
#pragma unroll
                for (int bj = 0; bj < 2; ++bj)
#pragma unroll
                    for (int n = 0; n < 2; ++n) { f32x4 x = *(const f32x4*)(xr + bj * HALF + n * 16) + acc[ai][bj][m][n] * scale; *(f32x4*)(xr + bj * HALF + n * 16) = x;
                        u32x2 w; w.x = cvt_pk_bf16(x[0], x[1]); w.y = cvt_pk_bf16(x[2], x[3]); *(u32x2*)(br + bj * HALF + n * 16) = w;
                        s += (x[0] * x[0] + x[1] * x[1]) + (x[2] * x[2] + x[3] * x[3]); }
                s += __shfl_xor(s, 16); s += __shfl_xor(s, 32);
                if (fq == 0) unsafeAtomicAdd(ssout + row, s); }
    }
};
struct EpiScaleF32 { static constexpr bool PERM = false, AFTER_DRAIN = false;
    float* Cp; int ldc; const float* ss; float invd;
    __device__ __forceinline__ void operator()(const f32x4 (&acc)[2][2][4][2], const Unit& u, int wr, int wc, int fr, int fq) const {
        const int row0 = u.pm * BM + wr * 64 + fr, col0 = u.pn * BM + wc * 32 + 4 * fq;
#pragma unroll
        for (int ai = 0; ai < 2; ++ai)
#pragma unroll
            for (int m = 0; m < 4; ++m) { const int row = row0 + ai * HALF + m * 16; const float rs = rsqrtf(ss[row] * invd + 1e-6f); float* cr = Cp + (size_t)row * ldc + col0;
#pragma unroll
                for (int bj = 0; bj < 2; ++bj)
#pragma unroll
                    for (int n = 0; n < 2; ++n) *(f32x4*)(cr + bj * HALF + n * 16) = acc[ai][bj][m][n] * rs; }
    }
};
struct EpiScaleBf16 { static constexpr bool PERM = true, AFTER_DRAIN = false;
    bf16_t* O; int ldc; const float* ss; float invd;
    __device__ __forceinline__ void operator()(const f32x4 (&acc)[2][2][4][2], const Unit& u, int wr, int wc, int fr, int fq) const {
        const int row0 = u.pm * BM + wr * 64 + fr, col0 = u.pn * BM + wc * 32 + 8 * fq;
#pragma unroll
        for (int ai = 0; ai < 2; ++ai)
#pragma unroll
            for (int m = 0; m < 4; ++m) { const int row = row0 + ai * HALF + m * 16; const float rs = rsqrtf(ss[row] * invd + 1e-6f); bf16_t* orow = O + (size_t)row * ldc + col0;
#pragma unroll
                for (int bj = 0; bj < 2; ++bj) { const f32x4 v0 = acc[ai][bj][m][0] * rs, v1 = acc[ai][bj][m][1] * rs;
                    u32x4 w; w.x = cvt_pk_bf16(v0[0], v0[1]); w.y = cvt_pk_bf16(v0[2], v0[3]); w.z = cvt_pk_bf16(v1[0], v1[1]); w.w = cvt_pk_bf16(v1[2], v1[3]);
                    *(u32x4*)(orow + bj * HALF) = w; } }
    }
};
struct EpiMemKV { static constexpr bool PERM = false, AFTER_DRAIN = false;
    float* K; float* V; const float* rstd; int d;
    __device__ __forceinline__ void operator()(const f32x4 (&acc)[2][2][4][2], const Unit& u, int wr, int wc, int fr, int fq) const {
        const int row0 = u.pm * BM + wr * 64 + fr; int ct = u.pn * BM; float* base = K; if (ct >= d) { base = V; ct -= d; }
        const int col0 = ct + wc * 32 + 4 * fq;
#pragma unroll
        for (int ai = 0; ai < 2; ++ai)
#pragma unroll
            for (int m = 0; m < 4; ++m) { const int row = row0 + ai * HALF + m * 16; const float rs = rstd[row]; float* cr = base + (size_t)row * d + col0;
#pragma unroll
                for (int bj = 0; bj < 2; ++bj)
#pragma unroll
                    for (int n = 0; n < 2; ++n) *(f32x4*)(cr + bj * HALF + n * 16) = acc[ai][bj][m][n] * rs; }
    }
};
}

__device__ __forceinline__ unsigned pk2bf(float lo, float hi) { return pg8::cvt_pk_bf16(lo, hi); }
__device__ __forceinline__ void prep_item(const float* W, int K, int Ncols, const float* g, int kind, int N, bf16_t* Bt, LAS float* scr, int item, int lane) {
    const int nblk = N / 32, kb = item / nblk, nb = item % nblk, k0 = 64 * kb, n0 = 32 * nb;
    const int sc = wsrc_col<C>(kind, n0 + (lane & 31));
#pragma unroll 8
    for (int i = 0; i < 32; ++i) { const int kk = 2 * i + (lane >> 5); float v = 0.f;
        if (sc >= 0) { v = W[(size_t)(k0 + kk) * Ncols + sc]; if (g) v *= g[k0 + kk]; }
        scr[kk * 33 + (lane & 31)] = v; }
    asm volatile("s_waitcnt lgkmcnt(0)" ::: "memory");
    const int c = lane & 7;
#pragma unroll
    for (int j = 0; j < 4; ++j) { const int n = (lane >> 3) + 8 * j; const LAS float* s = scr + (8 * c) * 33 + n;
        pg8::u32x4 o; o.x = pk2bf(s[0 * 33], s[1 * 33]); o.y = pk2bf(s[2 * 33], s[3 * 33]); o.z = pk2bf(s[4 * 33], s[5 * 33]); o.w = pk2bf(s[6 * 33], s[7 * 33]);
        *(pg8::u32x4*)(Bt + (size_t)(n0 + n) * K + k0 + 8 * c) = o; }
    asm volatile("s_waitcnt lgkmcnt(0)" ::: "memory");
}
struct WDesc { const float* W; const float* g; bf16_t* dst; int K, Ncols, kind, N; };
__device__ __forceinline__ WDesc wdesc(const Ptrs& p, int l, int idx) {
    WDesc d; d.g = nullptr; d.kind = WK_PLAIN;
    switch (idx) {
    case 0: d.W = p.in[I_W1IN] + (size_t)l * C::D * 2 * C::FF; d.K = C::D; d.Ncols = 2 * C::FF; d.N = 2 * C::FF; d.g = p.in[I_GFFN1] + l * C::D; d.kind = WK_FFNIN; d.dst = wlayer<C>(p, l, C::W_1IN); break;
    case 1: d.W = p.in[I_W1OUT] + (size_t)l * C::FF * C::D; d.K = C::FF; d.Ncols = C::D; d.N = C::D; d.dst = wlayer<C>(p, l, C::W_1OUT); break;
    case 2: d.W = p.in[I_WIN] + (size_t)l * C::D * C::INC; d.K = C::D; d.Ncols = C::INC; d.N = C::LDP; d.g = p.in[I_GMIX] + l * C::D; d.kind = WK_WIN; d.dst = wlayer<C>(p, l, C::W_IN); break;
    case 3: d.W = p.in[I_WOUT] + (size_t)l * C::D * C::D; d.K = C::D; d.Ncols = C::D; d.N = C::D; d.dst = wlayer<C>(p, l, C::W_OUT); break;
    case 4: d.W = p.in[I_WQ] + (size_t)l * C::D * C::D; d.K = C::D; d.Ncols = C::D; d.N = C::D; d.g = p.in[I_GX] + l * C::D; d.dst = wlayer<C>(p, l, C::W_Q); break;
    case 5: d.W = p.in[I_WK] + (size_t)l * C::D * C::D; d.K = C::D; d.Ncols = C::D; d.N = C::D; d.g = p.in[I_GMEM] + l * C::D; d.dst = wlayer<C>(p, l, C::W_KV); break;
    case 6: d.W = p.in[I_WV] + (size_t)l * C::D * C::D; d.K = C::D; d.Ncols = C::D; d.N = C::D; d.g = p.in[I_GMEM] + l * C::D; d.dst = wlayer<C>(p, l, C::W_KV) + (size_t)C::D * C::D; break;
    case 7: d.W = p.in[I_WO] + (size_t)l * C::D * C::D; d.K = C::D; d.Ncols = C::D; d.N = C::D; d.dst = wlayer<C>(p, l, C::W_O); break;
    case 8: d.W = p.in[I_W2IN] + (size_t)l * C::D * 2 * C::FF; d.K = C::D; d.Ncols = 2 * C::FF; d.N = 2 * C::FF; d.g = p.in[I_GFFN2] + l * C::D; d.kind = WK_FFNIN; d.dst = wlayer<C>(p, l, C::W_2IN); break;
    default: d.W = p.in[I_W2OUT] + (size_t)l * C::FF * C::D; d.K = C::FF; d.Ncols = C::D; d.N = C::D; d.dst = wlayer<C>(p, l, C::W_2OUT); break;
    }
    return d;
}

constexpr int PH_PER_LAYER = 18, N_PHASES = 2 + PH_PER_LAYER * C::DEPTH;
struct Args { Ptrs p; int ph_lo, ph_hi; };
__global__ void __launch_bounds__(NTHREADS, 2) fwd(Args a) {
    extern __shared__ __attribute__((aligned(16))) unsigned char lds_raw[];
    LAS unsigned char* lds = (LAS unsigned char*)lds_raw;
    typedef __attribute__((address_space(4))) const Args* KArgs;
    const KArgs ka0 = (KArgs)__builtin_amdgcn_kernarg_segment_ptr();
    const int lo = a.ph_lo, hi = a.ph_hi;
#define IN(k) (lo <= (k) && (k) < hi)
#define BOTH(k) (IN(k) && IN((k) + 1))
#define GRID_BAR(k) do { if (BOTH(k)) { xcd_barrier(bar); } } while (0)
#if defined(__HIP_DEVICE_COMPILE__)
#define LOAD_PTRS KArgs ka = ka0; asm volatile("" : "+s"(ka)); Ptrs p; _Pragma("unroll") for (int i_ = 0; i_ < 33; ++i_) p.in[i_] = ka->p.in[i_]; p.out = ka->p.out; p.ws = ka->p.ws;
#else
#define LOAD_PTRS (void)ka0; const Ptrs p = a.p;
#endif
#define PHASE_ARGS LOAD_PTRS int tid = threadIdx.x; asm volatile("" : "+v"(tid)); \
    const int lane = tid & 63, wave = __builtin_amdgcn_readfirstlane(tid >> 6); (void)lane; (void)wave; \
    const long gtid = (long)blockIdx.x * NTHREADS + tid, gthreads = (long)gridDim.x * NTHREADS; (void)gtid; (void)gthreads; \
    float* SS = wsf<C>(p, C::WS_SS); (void)SS; const float invd = 1.0f / C::D; (void)invd;
#define ITEMS(n, call) do { for (long it = gtid; it < (long)(n); it += gthreads) { call; } } while (0)
#if ONE_LAUNCH
    if (threadIdx.x < 4) ((LAS unsigned*)(lds + LDS_CTL))[threadIdx.x] = 0u;
    __syncthreads();
    XcdBarrier bar = xcd_barrier_post((unsigned*)(a.p.ws + C::WS_CTL), (volatile LAS unsigned*)(lds + LDS_CTL));
#else
    XcdBarrier bar; bar.bar = nullptr; bar.x = 0; bar.st = nullptr;
#endif

    if (IN(0)) { PHASE_ARGS
        LAS float* scr = (LAS float*)(lds + wave * 16384);
        const int gw = blockIdx.x * NWAVES + wave, NGW = gridDim.x * NWAVES;
        for (int l = 0; l < C::DEPTH; ++l)
            for (int idx = 0; idx < 10; ++idx) { const WDesc d = wdesc(p, l, idx); const int nitems = (d.K / 64) * (d.N / 32);
                for (int it = gw; it < nitems; it += NGW) prep_item(d.W, d.K, d.Ncols, d.g, d.kind, d.N, d.dst, scr, it, lane); }
        ITEMS(C::M, st_rowinit<C>(p, (int)it));
        ITEMS(C::MM, st_meminit<C>(p, (int)it));
        GRID_BAR(0);
    }
    for (int l = 0; l < C::DEPTH; ++l) {
        const int pb = 1 + PH_PER_LAYER * l;
#define SSL(j) (SS + (size_t)(4 * l + (j)) * C::M)
        if (IN(pb + 0)) { PHASE_ARGS
            pg8::Gemm g{wsb<C>(p, C::WS_MEMB), wlayer<C>(p, l, C::W_KV), C::MM, 2 * C::D, C::D}; pg8::StaticOrder S; S.init(C::MM, 2 * C::D, gridDim.x, blockIdx.x);
            pg8::EpiMemKV E{p.out + C::OUT_MK + (size_t)l * C::MM * C::D, p.out + C::OUT_MV + (size_t)l * C::MM * C::D, wsf<C>(p, C::WS_RSTDM), C::D};
            pg8::gemm_phase<pg8::EpiMemKV, pg8::StaticOrder, false>(lds, g, S, E, nullptr);
            GRID_BAR(pb + 0);
        }
        if (IN(pb + 1)) { PHASE_ARGS
            pg8::Gemm g{wsb<C>(p, C::WS_XB), wlayer<C>(p, l, C::W_1IN), C::M, 2 * C::FF, C::D}; pg8::StaticOrder S; S.init(C::M, 2 * C::FF, gridDim.x, blockIdx.x);
            pg8::EpiSwiGLU E{wsb<C>(p, C::WS_BIG), SSL(0), C::FF, invd};
            pg8::gemm_phase<pg8::EpiSwiGLU, pg8::StaticOrder, false>(lds, g, S, E, nullptr);
            GRID_BAR(pb + 1);
        }
        if (IN(pb + 2)) { PHASE_ARGS
            pg8::Gemm g{wsb<C>(p, C::WS_BIG), wlayer<C>(p, l, C::W_1OUT), C::M, C::D, C::FF}; pg8::StaticOrder S; S.init(C::M, C::D, gridDim.x, blockIdx.x);
            pg8::EpiResid E{wsf<C>(p, C::WS_X), wsb<C>(p, C::WS_XB), SSL(1), 0.5f, C::D};
            pg8::gemm_phase<pg8::EpiResid, pg8::StaticOrder, false>(lds, g, S, E, nullptr);
            GRID_BAR(pb + 2);
        }
        if (IN(pb + 3)) { PHASE_ARGS
            pg8::Gemm g{wsb<C>(p, C::WS_XB), wlayer<C>(p, l, C::W_IN), C::M, C::LDP, C::D}; pg8::StaticOrder S; S.init(C::M, C::LDP, gridDim.x, blockIdx.x);
            pg8::EpiScaleF32 E{wsf<C>(p, C::WS_BIG), C::LDP, SSL(1), invd};
            pg8::gemm_phase<pg8::EpiScaleF32, pg8::StaticOrder, false>(lds, g, S, E, nullptr);
            GRID_BAR(pb + 3);
        }
        if (IN(pb + 4)) { PHASE_ARGS ITEMS((long)C::M * C::PW, st_pool_d<C>(p, l, it)); ITEMS((long)C::M * C::GH, st_gmlp_v<C>(p, l, it)); ITEMS(C::NCH, st_ml_a1<C>(p, l, (int)it)); GRID_BAR(pb + 4); }
        if (IN(pb + 5)) { PHASE_ARGS ITEMS((long)C::M * C::PW, st_pool_y<C>(p, l, it)); ITEMS((long)C::M * C::GW, st_gmlp_s<C>(p, l, it)); ITEMS((long)C::NCH * C::MHD * C::MHD, st_ml_a2<C>(p, l, it)); GRID_BAR(pb + 5); }
        if (IN(pb + 6)) { PHASE_ARGS ITEMS((C::BATCH + C::DEC_BATCH) * C::MH, st_ml_b0<C>(p, l, (int)it)); ITEMS((long)(C::BATCH + C::DEC_BATCH) * C::MH * C::MHD * C::MHD, st_ml_b<C>(p, l, it)); GRID_BAR(pb + 6); }
        if (IN(pb + 7)) { PHASE_ARGS ITEMS((long)C::M * C::MH, st_ml_c1<C>(p, l, it)); GRID_BAR(pb + 7); }
        if (IN(pb + 8)) { PHASE_ARGS ITEMS((long)C::M * C::MH * C::MHD, st_ml_c2<C>(p, l, it)); GRID_BAR(pb + 8); }
        if (IN(pb + 9)) { PHASE_ARGS ITEMS((long)C::M * C::MH, st_ml_c3<C>(p, l, it)); GRID_BAR(pb + 9); }
        if (IN(pb + 10)) { PHASE_ARGS
            pg8::Gemm g{wsb<C>(p, C::WS_MIX), wlayer<C>(p, l, C::W_OUT), C::M, C::D, C::D}; pg8::StaticOrder S; S.init(C::M, C::D, gridDim.x, blockIdx.x);
            pg8::EpiResid E{wsf<C>(p, C::WS_X), wsb<C>(p, C::WS_XB), SSL(2), 1.0f, C::D};
            pg8::gemm_phase<pg8::EpiResid, pg8::StaticOrder, false>(lds, g, S, E, nullptr);
            GRID_BAR(pb + 10);
        }
        if (IN(pb + 11)) { PHASE_ARGS
            pg8::Gemm g{wsb<C>(p, C::WS_XB), wlayer<C>(p, l, C::W_Q), C::M, C::D, C::D}; pg8::StaticOrder S; S.init(C::M, C::D, gridDim.x, blockIdx.x);
            pg8::EpiScaleBf16 E{wsb<C>(p, C::WS_Q), C::D, SSL(2), invd};
            pg8::gemm_phase<pg8::EpiScaleBf16, pg8::StaticOrder, false>(lds, g, S, E, nullptr);
            GRID_BAR(pb + 11);
        }
        if (IN(pb + 12)) { PHASE_ARGS ITEMS((long)C::M * C::AH * C::NMEM, st_at_s<C>(p, l, it)); GRID_BAR(pb + 12); }
        if (IN(pb + 13)) { PHASE_ARGS ITEMS((long)C::M * C::AH, st_at_p<C>(p, l, it)); GRID_BAR(pb + 13); }
        if (IN(pb + 14)) { PHASE_ARGS ITEMS((long)C::M * C::D, st_at_o<C>(p, l, it)); GRID_BAR(pb + 14); }
        if (IN(pb + 15)) { PHASE_ARGS
            pg8::Gemm g{wsb<C>(p, C::WS_AO), wlayer<C>(p, l, C::W_O), C::M, C::D, C::D}; pg8::StaticOrder S; S.init(C::M, C::D, gridDim.x, blockIdx.x);
            pg8::EpiResid E{wsf<C>(p, C::WS_X), wsb<C>(p, C::WS_XB), SSL(3), 1.0f, C::D};
            pg8::gemm_phase<pg8::EpiResid, pg8::StaticOrder, false>(lds, g, S, E, nullptr);
            GRID_BAR(pb + 15);
        }
        if (IN(pb + 16)) { PHASE_ARGS
            pg8::Gemm g{wsb<C>(p, C::WS_XB), wlayer<C>(p, l, C::W_2IN), C::M, 2 * C::FF, C::D}; pg8::StaticOrder S; S.init(C::M, 2 * C::FF, gridDim.x, blockIdx.x);
            pg8::EpiSwiGLU E{wsb<C>(p, C::WS_BIG), SSL(3), C::FF, invd};
            pg8::gemm_phase<pg8::EpiSwiGLU, pg8::StaticOrder, false>(lds, g, S, E, nullptr);
            GRID_BAR(pb + 16);
        }
        if (IN(pb + 17)) { PHASE_ARGS
            pg8::Gemm g{wsb<C>(p, C::WS_BIG), wlayer<C>(p, l, C::W_2OUT), C::M, C::D, C::FF}; pg8::StaticOrder S; S.init(C::M, C::D, gridDim.x, blockIdx.x);
            pg8::EpiResid E{wsf<C>(p, C::WS_X), wsb<C>(p, C::WS_XB), SSL(4), 0.5f, C::D};
            pg8::gemm_phase<pg8::EpiResid, pg8::StaticOrder, false>(lds, g, S, E, nullptr);
            GRID_BAR(pb + 17);
        }
    }
    if (IN(N_PHASES - 1)) { PHASE_ARGS ITEMS(C::M, st_final<C>(p, (int)it)); }
#undef IN
#undef BOTH
#undef GRID_BAR
#undef ITEMS
#undef PHASE_ARGS
#undef SSL
}

extern "C" void kernel_launch(void* const* d_in, const int* in_sizes, int n_in, void* d_out, int out_size, void* d_ws, size_t ws_size, hipStream_t stream) {
    static int ready = 0;
    if (!ready) {
        if (n_in != 33 || (long)out_size != (long)C::OUT_END || ws_size < (size_t)C::WS_END) { fprintf(stderr, "kernel_launch: unexpected shapes: n_in %d out %d ws %zu (need %zu)\n", n_in, out_size, ws_size, (size_t)C::WS_END); ready = -1; return; }
        if (hipFuncSetAttribute((const void*)fwd, hipFuncAttributeMaxDynamicSharedMemorySize, LDS_BYTES) != hipSuccess) { fprintf(stderr, "kernel_launch: hipFuncSetAttribute failed\n"); ready = -1; return; }
        int dev = 0, cus = 0, per_cu = 0;
        if (hipGetDevice(&dev) != hipSuccess || hipDeviceGetAttribute(&cus, hipDeviceAttributeMultiprocessorCount, dev) != hipSuccess) { fprintf(stderr, "kernel_launch: device query failed\n"); ready = -1; return; }
        if (hipOccupancyMaxActiveBlocksPerMultiprocessor(&per_cu, (const void*)fwd, NTHREADS, LDS_BYTES) != hipSuccess || per_cu < 1) { fprintf(stderr, "kernel_launch: occupancy query reports %d blocks per CU\n", per_cu); (void)hipGetLastError(); per_cu = 1; }
        ready = cus;
    }
    if (ready < 0) return;
    Args a{};
    for (int i = 0; i < 33; ++i) a.p.in[i] = (const float*)d_in[i];
    a.p.out = (float*)d_out; a.p.ws = (unsigned char*)d_ws;
#if ONE_LAUNCH
    (void)hipMemsetAsync((char*)d_ws + C::WS_CTL, 0, 65536, stream);
    a.ph_lo = 0; a.ph_hi = N_PHASES;
    hipLaunchKernelGGL(fwd, dim3(ready), dim3(NTHREADS), LDS_BYTES, stream, a);
#else
    for (int k = 0; k < N_PHASES; ++k) { a.ph_lo = k; a.ph_hi = k + 1; hipLaunchKernelGGL(fwd, dim3(ready), dim3(NTHREADS), LDS_BYTES, stream, a); }
#endif
}
```

```cpp
#include <hip/hip_runtime.h>
#include <cstdio>
#define ONE_LAUNCH 1
#define HD __host__ __device__
#ifndef HD
#define HD __host__ __device__
#endif
typedef unsigned short bf16_t;
HD inline unsigned f2u(float f) { return __builtin_bit_cast(unsigned, f); }
HD inline float u2f(unsigned u) { return __builtin_bit_cast(float, u); }
HD inline bf16_t f2bf(float f) { unsigned u = f2u(f); u += 0x7FFFu + ((u >> 16) & 1u); return (bf16_t)(u >> 16); }
HD inline float bf2f(bf16_t b) { return u2f(((unsigned)b) << 16); }

struct RC {
    static constexpr int D = 2048, FF = 8192, BATCH = 4, SEQ = 2048, DEPTH = 2, DEC_BATCH = 32, DEC_SEQ = 32, PAST = 2048, NMEM = 256;
};
template <class B> struct CfgT : B {
    using B::D; using B::FF; using B::BATCH; using B::SEQ; using B::DEPTH; using B::DEC_BATCH; using B::DEC_SEQ; using B::PAST; using B::NMEM;
    static constexpr int MP = BATCH * SEQ, MS = DEC_BATCH * DEC_SEQ, M = MP + MS, MM = BATCH * NMEM;
    static constexpr int PW = D / 4, PG = 4, PGD = PW / 4, PH = 15;
    static constexpr int GW = D / 4, GH = 4, GHD = GW / 4, GCH = 128;
    static constexpr int MW = D - PW - GW, MH = 8, MHD = MW / 8, CH = 64;
    static constexpr int INC = PW + 2 * GW + 4 * MW + 2 * MH;
    static constexpr int LDP = ((INC + 255) / 256) * 256;
    static constexpr int AH = 4, AHD = D / 4;
    static constexpr int O_U = PW, O_V = PW + GW, O_Q = PW + 2 * GW, O_K = O_Q + MW, O_VM = O_K + MW, O_O = O_VM + MW, O_IG = O_O + MW, O_FG = O_IG + MH;
    static constexpr int NC = SEQ / CH, NPC = BATCH * MH * NC, NSC = DEC_BATCH * MH, NCH = NPC + NSC;
    static constexpr int LCS = DEC_SEQ < CH ? DEC_SEQ : CH;
    static constexpr int GLP = SEQ < GCH ? SEQ : GCH, GLS = DEC_SEQ < GCH ? DEC_SEQ : GCH;
    static constexpr int NSS = 1 + 4 * DEPTH;
    static constexpr long OUT_YP = 0, OUT_YS = OUT_YP + (long)MP * D, OUT_POOLP = OUT_YS + (long)MS * D, OUT_POOLS = OUT_POOLP + (long)DEPTH * BATCH * PH * PW,
        OUT_CP = OUT_POOLS + (long)DEPTH * DEC_BATCH * PH * PW, OUT_NP = OUT_CP + (long)DEPTH * BATCH * MH * MHD * MHD, OUT_MP = OUT_NP + (long)DEPTH * BATCH * MH * MHD,
        OUT_CS = OUT_MP + (long)DEPTH * BATCH * MH, OUT_NS = OUT_CS + (long)DEPTH * DEC_BATCH * MH * MHD * MHD, OUT_MS = OUT_NS + (long)DEPTH * DEC_BATCH * MH * MHD,
        OUT_VS = OUT_MS + (long)DEPTH * DEC_BATCH * MH, OUT_MK = OUT_VS + (long)DEPTH * DEC_BATCH * DEC_SEQ * GW, OUT_MV = OUT_MK + (long)DEPTH * BATCH * NMEM * D,
        OUT_END = OUT_MV + (long)DEPTH * BATCH * NMEM * D;
    static constexpr size_t al(size_t x) { return (x + 255) & ~(size_t)255; }
    static constexpr size_t WS_CTL = 0, WS_SS = 65536, WS_X = al(WS_SS + (size_t)NSS * M * 4), WS_XB = al(WS_X + (size_t)M * D * 4),
        WS_BIG = al(WS_XB + (size_t)M * D * 2),
        WS_BIG_SZ = ((size_t)M * FF * 2 > (size_t)M * LDP * 4) ? (size_t)M * FF * 2 : (size_t)M * LDP * 4,
        WS_MIX = al(WS_BIG + WS_BIG_SZ), WS_Q = al(WS_MIX + (size_t)M * D * 2), WS_AO = al(WS_Q + (size_t)M * D * 2),
        WS_MEMB = al(WS_AO + (size_t)M * D * 2), WS_RSTDM = al(WS_MEMB + (size_t)MM * D * 2),
        WS_PD = al(WS_RSTDM + (size_t)MM * 4), WS_VH = al(WS_PD + (size_t)M * PW * 4),
        WS_GB = al(WS_VH + (size_t)M * GW * 4), WS_GA = al(WS_GB + (size_t)M * MH * 4), WS_GWT = al(WS_GA + (size_t)M * MH * 4),
        WS_CBL = al(WS_GWT + (size_t)M * MH * 4), WS_CML = al(WS_CBL + (size_t)NCH * 4), WS_MPREV = al(WS_CML + (size_t)NCH * 4),
        WS_DC = al(WS_MPREV + (size_t)NCH * 4), WS_DN = al(WS_DC + (size_t)NCH * MHD * MHD * 4),
        WS_SB = al(WS_DN + (size_t)NCH * MHD * 4), WS_DEN = al(WS_SB + (size_t)M * MH * CH * 4), WS_IW = al(WS_DEN + (size_t)M * MH * 4),
        WS_HB = al(WS_IW + (size_t)M * MH * 4), WS_SC = al(WS_HB + (size_t)M * MW * 4),
        WS_W = al(WS_SC + (size_t)M * AH * NMEM * 4);
    static constexpr size_t W_1IN = 0, W_1OUT = W_1IN + (size_t)2 * FF * D, W_IN = W_1OUT + (size_t)D * FF, W_OUT = W_IN + (size_t)LDP * D, W_Q = W_OUT + (size_t)D * D,
        W_KV = W_Q + (size_t)D * D, W_O = W_KV + (size_t)2 * D * D, W_2IN = W_O + (size_t)D * D, W_2OUT = W_2IN + (size_t)2 * FF * D, W_LAYER = W_2OUT + (size_t)D * FF;
    static constexpr size_t WS_END = al(WS_W + (size_t)DEPTH * W_LAYER * 2);
};

struct Ptrs { const float* in[33]; float* out; unsigned char* ws; };
enum { I_XP = 0, I_XS, I_MEM, I_SPOOL, I_SC, I_SN, I_SM, I_CK, I_CV, I_GFFN1, I_W1IN, I_W1OUT, I_GMIX, I_WIN, I_POOLW, I_POOLS, I_GVG, I_GWS, I_GBS, I_IB, I_FB, I_NG, I_WOUT,
       I_GX, I_GMEM, I_WQ, I_WK, I_WV, I_WO, I_GFFN2, I_W2IN, I_W2OUT, I_GFIN };

template <class C> HD inline float* wsf(const Ptrs& p, size_t off) { return (float*)(p.ws + off); }
template <class C> HD inline bf16_t* wsb(const Ptrs& p, size_t off) { return (bf16_t*)(p.ws + off); }
template <class C> HD inline bf16_t* wlayer(const Ptrs& p, int l, size_t off) { return (bf16_t*)(p.ws + C::WS_W) + (size_t)l * C::W_LAYER + off; }

template <class C> HD inline void row_info(int r, bool& s, int& b, int& t) {
    if (r < C::MP) { s = false; b = r / C::SEQ; t = r % C::SEQ; } else { s = true; const int q = r - C::MP; b = q / C::DEC_SEQ; t = q % C::DEC_SEQ; }
}
template <class C> HD inline void chunk_info(int r, int h, int& ci, int& i, int& lc) {
    bool s; int b, t; row_info<C>(r, s, b, t);
    if (!s) { ci = (b * C::MH + h) * C::NC + t / C::CH; i = t % C::CH; lc = C::CH; } else { ci = C::NPC + b * C::MH + h; i = t; lc = C::LCS; }
}
HD inline float sigmoidf_(float x) { return 1.0f / (1.0f + expf(-x)); }
HD inline float logsigmoidf_(float x) { return x >= 0.f ? -log1pf(expf(-x)) : x - log1pf(expf(x)); }

enum { WK_PLAIN = 0, WK_FFNIN = 1, WK_WIN = 2 };
template <class C> HD inline int wsrc_col(int kind, int n) {
    if (kind == WK_FFNIN) { const int pn = n >> 8, j = n & 255; return j < 128 ? 128 * pn + j : C::FF + 128 * pn + (j - 128); }
    if (kind == WK_WIN) return n < C::INC ? n : -1;
    return n;
}

template <class C> HD inline void st_rowinit(const Ptrs& p, int r) {
    const float* src = r < C::MP ? p.in[I_XP] + (size_t)r * C::D : p.in[I_XS] + (size_t)(r - C::MP) * C::D;
    float* X = wsf<C>(p, C::WS_X) + (size_t)r * C::D; bf16_t* XB = wsb<C>(p, C::WS_XB) + (size_t)r * C::D;
    float ss = 0.f;
    for (int k = 0; k < C::D; ++k) { const float v = src[k]; X[k] = v; XB[k] = f2bf(v); ss += v * v; }
    float* SS = wsf<C>(p, C::WS_SS);
    SS[r] = ss;
    for (int j = 1; j < C::NSS; ++j) SS[(size_t)j * C::M + r] = 0.f;
}
template <class C> HD inline void st_meminit(const Ptrs& p, int r) {
    const float* src = p.in[I_MEM] + (size_t)r * C::D; bf16_t* MB = wsb<C>(p, C::WS_MEMB) + (size_t)r * C::D;
    float ss = 0.f;
    for (int k = 0; k < C::D; ++k) { const float v = src[k]; MB[k] = f2bf(v); ss += v * v; }
    wsf<C>(p, C::WS_RSTDM)[r] = 1.0f / sqrtf(ss / C::D + 1e-6f);
}
template <class C> HD inline void st_pool_d(const Ptrs& p, int l, long item) {
    const int r = (int)(item / C::PW), ch = (int)(item % C::PW), g = ch / C::PGD;
    const int w = 2 << g;
    bool s; int b, t; row_info<C>(r, s, b, t);
    const float* P = wsf<C>(p, C::WS_BIG);
    const int pos = (s ? C::PAST : 0) + t;
    float sum = 0.f;
    for (int j = 0; j < w; ++j) { const int tt = t - j;
        float v;
        if (tt >= 0) v = P[(size_t)(r - j) * C::LDP + ch];
        else { const int hi = C::PH + tt;
            v = (s && hi >= 0) ? p.in[I_SPOOL][(((size_t)l * C::DEC_BATCH + b) * C::PH + hi) * C::PW + ch] : 0.f; }
        sum += v; }
    const float cnt = (float)((pos + 1) < w ? (pos + 1) : w);
    wsf<C>(p, C::WS_PD)[(size_t)r * C::PW + ch] = sum / cnt - P[(size_t)r * C::LDP + ch];
    const int L = s ? C::DEC_SEQ : C::SEQ;
    const int idx = t - (L - C::PH);
    if (idx >= 0) { float* o = p.out + (s ? C::OUT_POOLS + (((size_t)l * C::DEC_BATCH + b) * C::PH + idx) * C::PW : C::OUT_POOLP + (((size_t)l * C::BATCH + b) * C::PH + idx) * C::PW);
        o[ch] = P[(size_t)r * C::LDP + ch]; }
}
template <class C> HD inline void st_pool_y(const Ptrs& p, int l, long item) {
    const int r = (int)(item / C::PW), ch = (int)(item % C::PW), g = ch / C::PGD, e = ch % C::PGD;
    const float* d = wsf<C>(p, C::WS_PD) + (size_t)r * C::PW + g * C::PGD;
    const float* w = p.in[I_POOLW] + ((size_t)l * C::PG + g) * C::PGD * C::PGD;
    float acc = 0.f;
    for (int c = 0; c < C::PGD; ++c) acc += d[c] * w[(size_t)c * C::PGD + e];
    wsb<C>(p, C::WS_MIX)[(size_t)r * C::D + ch] = f2bf(acc * p.in[I_POOLS][(size_t)l * C::PW + ch]);
}
template <class C> HD inline void st_gmlp_v(const Ptrs& p, int l, long item) {
    const int r = (int)(item / C::GH), h = (int)(item % C::GH);
    const float* v = wsf<C>(p, C::WS_BIG) + (size_t)r * C::LDP + C::O_V + h * C::GHD;
    float ss = 0.f; for (int d = 0; d < C::GHD; ++d) ss += v[d] * v[d];
    const float rs = 1.0f / sqrtf(ss / C::GHD + 1e-6f);
    float* VH = wsf<C>(p, C::WS_VH) + (size_t)r * C::GW + h * C::GHD; const float* g = p.in[I_GVG] + (size_t)l * C::GW + h * C::GHD;
    bool s; int b, t; row_info<C>(r, s, b, t);
    float* o = s ? p.out + C::OUT_VS + (((size_t)l * C::DEC_BATCH + b) * C::DEC_SEQ + t) * C::GW + h * C::GHD : nullptr;
    for (int d = 0; d < C::GHD; ++d) { const float y = v[d] * rs * g[d]; VH[d] = y; if (o) o[d] = y; }
}
template <class C> HD inline void st_gmlp_s(const Ptrs& p, int l, long item) {
    const int r = (int)(item / C::GW), ch = (int)(item % C::GW), h = ch / C::GHD;
    bool s; int b, t; row_info<C>(r, s, b, t);
    const int lc = s ? C::GLS : C::GLP, i = t % lc, r0 = r - i;
    const float* ws = p.in[I_GWS] + (((size_t)l * C::GH + h) * C::GCH + i) * C::GCH;
    const float* VH = wsf<C>(p, C::WS_VH);
    float acc = p.in[I_GBS][((size_t)l * C::GH + h) * C::GCH + i];
    for (int j = 0; j <= i; ++j) acc += ws[j] * VH[(size_t)(r0 + j) * C::GW + ch];
    const float u = wsf<C>(p, C::WS_BIG)[(size_t)r * C::LDP + C::O_U + ch];
    wsb<C>(p, C::WS_MIX)[(size_t)r * C::D + C::PW + ch] = f2bf(u * acc);
}
template <class C> HD inline void st_ml_a1(const Ptrs& p, int l, int ci) {
    int r0, h, lc;
    if (ci < C::NPC) { const int c = ci % C::NC, bh = ci / C::NC; h = bh % C::MH; const int b = bh / C::MH; r0 = b * C::SEQ + c * C::CH; lc = C::CH; }
    else { const int q = ci - C::NPC; h = q % C::MH; const int b = q / C::MH; r0 = C::MP + b * C::DEC_SEQ; lc = C::LCS; }
    const float* P = wsf<C>(p, C::WS_BIG); float* GB = wsf<C>(p, C::WS_GB); float* GA = wsf<C>(p, C::WS_GA); float* GWT = wsf<C>(p, C::WS_GWT);
    const float ib = p.in[I_IB][l * C::MH + h], fb = p.in[I_FB][l * C::MH + h];
    float bc = 0.f, amax = -3.0e38f;
    for (int i = 0; i < lc; ++i) { const float* pr = P + (size_t)(r0 + i) * C::LDP;
        const float ig = pr[C::O_IG + h] + ib, fg = pr[C::O_FG + h] + fb;
        bc += logsigmoidf_(fg); const float a = ig - bc;
        GB[(size_t)(r0 + i) * C::MH + h] = bc; GA[(size_t)(r0 + i) * C::MH + h] = a; amax = a > amax ? a : amax; }
    const float bL = bc, mloc = bL + amax;
    wsf<C>(p, C::WS_CBL)[ci] = bL; wsf<C>(p, C::WS_CML)[ci] = mloc;
    for (int i = 0; i < lc; ++i) GWT[(size_t)(r0 + i) * C::MH + h] = expf(bL + GA[(size_t)(r0 + i) * C::MH + h] - mloc);
}
template <class C> HD inline void st_ml_a2(const Ptrs& p, int l, long item) {
    const int e = (int)(item % C::MHD), d = (int)((item / C::MHD) % C::MHD), ci = (int)(item / ((long)C::MHD * C::MHD));
    int r0, h, lc;
    if (ci < C::NPC) { const int c = ci % C::NC, bh = ci / C::NC; h = bh % C::MH; const int b = bh / C::MH; r0 = b * C::SEQ + c * C::CH; lc = C::CH; }
    else { const int q = ci - C::NPC; h = q % C::MH; const int b = q / C::MH; r0 = C::MP + b * C::DEC_SEQ; lc = C::LCS; }
    const float* P = wsf<C>(p, C::WS_BIG); const float* GWT = wsf<C>(p, C::WS_GWT);
    const float scale = 1.0f / sqrtf((float)C::MHD);
    float acc = 0.f, accn = 0.f;
    for (int t = 0; t < lc; ++t) { const float* pr = P + (size_t)(r0 + t) * C::LDP; const float wk = GWT[(size_t)(r0 + t) * C::MH + h] * pr[C::O_K + h * C::MHD + d] * scale;
        acc += wk * pr[C::O_VM + h * C::MHD + e]; accn += wk; }
    wsf<C>(p, C::WS_DC)[((size_t)ci * C::MHD + d) * C::MHD + e] = acc;
    if (e == 0) wsf<C>(p, C::WS_DN)[(size_t)ci * C::MHD + d] = accn;
}
template <class C> HD inline void st_ml_b0(const Ptrs& p, int l, int sq) {
    const float* CBL = wsf<C>(p, C::WS_CBL); const float* CML = wsf<C>(p, C::WS_CML); float* MPREV = wsf<C>(p, C::WS_MPREV);
    if (sq < C::BATCH * C::MH) { float m = 0.f;
        for (int c = 0; c < C::NC; ++c) { const int ci = sq * C::NC + c; MPREV[ci] = m; const float a = CBL[ci] + m, b2 = CML[ci]; m = a > b2 ? a : b2; }
        p.out[C::OUT_MP + (size_t)l * C::BATCH * C::MH + sq] = m;
    } else { const int q = sq - C::BATCH * C::MH, ci = C::NPC + q; const float m0 = p.in[I_SM][(size_t)l * C::DEC_BATCH * C::MH + q];
        MPREV[ci] = m0; const float a = CBL[ci] + m0, b2 = CML[ci]; p.out[C::OUT_MS + (size_t)l * C::DEC_BATCH * C::MH + q] = a > b2 ? a : b2; }
}
template <class C> HD inline void st_ml_b(const Ptrs& p, int l, long item) {
    const int e = (int)(item % C::MHD), d = (int)((item / C::MHD) % C::MHD), sq = (int)(item / ((long)C::MHD * C::MHD));
    const float* CBL = wsf<C>(p, C::WS_CBL); const float* CML = wsf<C>(p, C::WS_CML);
    float* DC = wsf<C>(p, C::WS_DC); float* DN = wsf<C>(p, C::WS_DN);
    if (sq < C::BATCH * C::MH) { float m = 0.f, cst = 0.f, nst = 0.f;
        for (int c = 0; c < C::NC; ++c) { const int ci = sq * C::NC + c; const float a = CBL[ci] + m, b2 = CML[ci], mn = a > b2 ? a : b2;
            const float dec = expf(a - mn), f = expf(b2 - mn);
            const size_t o = ((size_t)ci * C::MHD + d) * C::MHD + e; cst = dec * cst + f * DC[o]; DC[o] = cst;
            if (e == 0) { const size_t on = (size_t)ci * C::MHD + d; nst = dec * nst + f * DN[on]; DN[on] = nst; }
            m = mn; }
        p.out[C::OUT_CP + (((size_t)l * C::BATCH * C::MH + sq) * C::MHD + d) * C::MHD + e] = cst;
        if (e == 0) p.out[C::OUT_NP + ((size_t)l * C::BATCH * C::MH + sq) * C::MHD + d] = nst;
    } else { const int q = sq - C::BATCH * C::MH, ci = C::NPC + q; const float m0 = p.in[I_SM][(size_t)l * C::DEC_BATCH * C::MH + q];
        const float a = CBL[ci] + m0, b2 = CML[ci], mn = a > b2 ? a : b2, dec = expf(a - mn), f = expf(b2 - mn);
        const size_t so = (((size_t)l * C::DEC_BATCH * C::MH + q) * C::MHD + d) * C::MHD + e;
        p.out[C::OUT_CS + so] = dec * p.in[I_SC][so] + f * DC[((size_t)ci * C::MHD + d) * C::MHD + e];
        if (e == 0) { const size_t no = ((size_t)l * C::DEC_BATCH * C::MH + q) * C::MHD + d; p.out[C::OUT_NS + no] = dec * p.in[I_SN][no] + f * DN[(size_t)ci * C::MHD + d]; }
    }
}
template <class C> HD inline float ml_cprev(const Ptrs& p, int l, int ci, int d, int e) {
    if (ci < C::NPC) return (ci % C::NC) == 0 ? 0.f : wsf<C>(p, C::WS_DC)[((size_t)(ci - 1) * C::MHD + d) * C::MHD + e];
    return p.in[I_SC][(((size_t)l * C::DEC_BATCH * C::MH + (ci - C::NPC)) * C::MHD + d) * C::MHD + e];
}
template <class C> HD inline float ml_nprev(const Ptrs& p, int l, int ci, int d) {
    if (ci < C::NPC) return (ci % C::NC) == 0 ? 0.f : wsf<C>(p, C::WS_DN)[(size_t)(ci - 1) * C::MHD + d];
    return p.in[I_SN][((size_t)l * C::DEC_BATCH * C::MH + (ci - C::NPC)) * C::MHD + d];
}
template <class C> HD inline void st_ml_c1(const Ptrs& p, int l, long item) {
    const int r = (int)(item / C::MH), h = (int)(item % C::MH);
    int ci, i, lc; chunk_info<C>(r, h, ci, i, lc); const int r0 = r - i;
    const float* P = wsf<C>(p, C::WS_BIG); const float* GB = wsf<C>(p, C::WS_GB); const float* GA = wsf<C>(p, C::WS_GA);
    const float mprev = wsf<C>(p, C::WS_MPREV)[ci];
    const float bi = GB[(size_t)r * C::MH + h];
    float amax = -3.0e38f; for (int j = 0; j <= i; ++j) { const float a = GA[(size_t)(r0 + j) * C::MH + h]; amax = a > amax ? a : amax; }
    const float mrow = bi + (mprev > amax ? mprev : amax);
    const float scale = 1.0f / sqrtf((float)C::MHD);
    const float* q = P + (size_t)r * C::LDP + C::O_Q + h * C::MHD;
    float* S = wsf<C>(p, C::WS_SB) + ((size_t)r * C::MH + h) * C::CH;
    float ssum = 0.f;
    for (int j = 0; j < C::CH; ++j) { float sv = 0.f;
        if (j <= i) { const float* k = P + (size_t)(r0 + j) * C::LDP + C::O_K + h * C::MHD; float dot = 0.f; for (int d = 0; d < C::MHD; ++d) dot += q[d] * k[d];
            sv = dot * scale * expf(bi + GA[(size_t)(r0 + j) * C::MH + h] - mrow); }
        S[j] = sv; ssum += sv; }
    const float iw = expf(bi + mprev - mrow);
    float qn = 0.f; for (int d = 0; d < C::MHD; ++d) qn += q[d] * ml_nprev<C>(p, l, ci, d);
    const float den = ssum + iw * qn, fl = expf(-mrow), ad = fabsf(den);
    wsf<C>(p, C::WS_DEN)[(size_t)r * C::MH + h] = ad > fl ? ad : fl; wsf<C>(p, C::WS_IW)[(size_t)r * C::MH + h] = iw;
}
template <class C> HD inline void st_ml_c2(const Ptrs& p, int l, long item) {
    const int e = (int)(item % C::MHD), h = (int)((item / C::MHD) % C::MH), r = (int)(item / ((long)C::MHD * C::MH));
    int ci, i, lc; chunk_info<C>(r, h, ci, i, lc); const int r0 = r - i;
    const float* P = wsf<C>(p, C::WS_BIG); const float* S = wsf<C>(p, C::WS_SB) + ((size_t)r * C::MH + h) * C::CH;
    float num = 0.f; for (int j = 0; j <= i; ++j) num += S[j] * P[(size_t)(r0 + j) * C::LDP + C::O_VM + h * C::MHD + e];
    const float* q = P + (size_t)r * C::LDP + C::O_Q + h * C::MHD;
    float qc = 0.f; for (int d = 0; d < C::MHD; ++d) qc += q[d] * ml_cprev<C>(p, l, ci, d, e);
    num += wsf<C>(p, C::WS_IW)[(size_t)r * C::MH + h] * qc;
    wsf<C>(p, C::WS_HB)[(size_t)r * C::MW + h * C::MHD + e] = num / wsf<C>(p, C::WS_DEN)[(size_t)r * C::MH + h];
}
template <class C> HD inline void st_ml_c3(const Ptrs& p, int l, long item) {
    const int r = (int)(item / C::MH), h = (int)(item % C::MH);
    const float* hb = wsf<C>(p, C::WS_HB) + (size_t)r * C::MW + h * C::MHD;
    float ss = 0.f; for (int e = 0; e < C::MHD; ++e) ss += hb[e] * hb[e];
    const float rs = 1.0f / sqrtf(ss / C::MHD + 1e-6f);
    const float* g = p.in[I_NG] + (size_t)l * C::MW + h * C::MHD; const float* o = wsf<C>(p, C::WS_BIG) + (size_t)r * C::LDP + C::O_O + h * C::MHD;
    bf16_t* mix = wsb<C>(p, C::WS_MIX) + (size_t)r * C::D + C::PW + C::GW + h * C::MHD;
    for (int e = 0; e < C::MHD; ++e) mix[e] = f2bf(hb[e] * rs * g[e] * sigmoidf_(o[e]));
}
template <class C> HD inline const float* mem_kv(const Ptrs& p, int l, int r, bool isv, int m) {
    bool s; int b, t; row_info<C>(r, s, b, t);
    if (s) return p.in[isv ? I_CV : I_CK] + (((size_t)l * C::DEC_BATCH + b) * C::NMEM + m) * C::D;
    return p.out + (isv ? C::OUT_MV : C::OUT_MK) + (((size_t)l * C::BATCH + b) * C::NMEM + m) * C::D;
}
template <class C> HD inline void st_at_s(const Ptrs& p, int l, long item) {
    const int m = (int)(item % C::NMEM), hd = (int)((item / C::NMEM) % C::AH), r = (int)(item / ((long)C::NMEM * C::AH));
    const bf16_t* q = wsb<C>(p, C::WS_Q) + (size_t)r * C::D + hd * C::AHD; const float* k = mem_kv<C>(p, l, r, false, m) + hd * C::AHD;
    float acc = 0.f; for (int d = 0; d < C::AHD; ++d) acc += bf2f(q[d]) * k[d];
    wsf<C>(p, C::WS_SC)[((size_t)r * C::AH + hd) * C::NMEM + m] = acc / sqrtf((float)C::AHD);
}
template <class C> HD inline void st_at_p(const Ptrs& p, int l, long item) {
    float* sc = wsf<C>(p, C::WS_SC) + (size_t)item * C::NMEM;
    float mx = -3.0e38f; for (int m = 0; m < C::NMEM; ++m) mx = sc[m] > mx ? sc[m] : mx;
    float sum = 0.f; for (int m = 0; m < C::NMEM; ++m) { const float e = expf(sc[m] - mx); sc[m] = e; sum += e; }
    const float inv = 1.0f / sum; for (int m = 0; m < C::NMEM; ++m) sc[m] *= inv;
}
template <class C> HD inline void st_at_o(const Ptrs& p, int l, long item) {
    const int col = (int)(item % C::D), r = (int)(item / C::D), hd = col / C::AHD;
    const float* sc = wsf<C>(p, C::WS_SC) + ((size_t)r * C::AH + hd) * C::NMEM; const float* v0 = mem_kv<C>(p, l, r, true, 0) + col;
    float acc = 0.f; for (int m = 0; m < C::NMEM; ++m) acc += sc[m] * v0[(size_t)m * C::D];
    wsb<C>(p, C::WS_AO)[(size_t)r * C::D + col] = f2bf(acc);
}
template <class C> HD inline void st_final(const Ptrs& p, int r) {
    const float* X = wsf<C>(p, C::WS_X) + (size_t)r * C::D; const float rs = 1.0f / sqrtf(wsf<C>(p, C::WS_SS)[(size_t)(C::NSS - 1) * C::M + r] / C::D + 1e-6f);
    float* o = r < C::MP ? p.out + C::OUT_YP + (size_t)r * C::D : p.out + C::OUT_YS + (size_t)(r - C::MP) * C::D;
    for (int k = 0; k < C::D; ++k) o[k] = X[k] * rs * p.in[I_GFIN][k];
}

namespace pg8 {
#define PG8_LAS __attribute__((address_space(3)))
typedef unsigned short bf16_t;
typedef short bf16x8 __attribute__((ext_vector_type(8)));
typedef float f32x4 __attribute__((ext_vector_type(4)));
typedef unsigned u32x4 __attribute__((ext_vector_type(4)));
constexpr int BM = 256, BK = 64, HALF = 128, HTB = HALF * BK * 2  , STAGE_BYTES = 8 * HTB, NXCD = 8, WGM = 8;

__host__ __device__ __forceinline__ int lds_byte(int r, int c) { const int st = (r >> 4) * 2 + (c >> 5), rr = r & 15, cc = c & 31, ob = rr * 64 + cc * 2; return st * 1024 + (ob ^ (((ob >> 9) & 1) << 5)); }
__host__ __device__ __forceinline__ void stage_rc(int b, int& R, int& C) { const int st = b / 1024, sb = b % 1024, swz = sb ^ (((sb >> 9) & 1) << 5); R = (st >> 1) * 16 + swz / 64; C = (st & 1) * 32 + (swz % 64) / 2; }
__host__ __device__ __forceinline__ int perm32(int rho) { const int n = rho >> 4, i = rho & 15; return 8 * (i >> 2) + 4 * n + (i & 3); }

struct Unit { int pm, pn; };
struct Gemm { const bf16_t* A; const bf16_t* Bt; int M, N, K; };

struct StaticOrder {
    int nM, nN, nwg, G, c;
    __host__ __device__ void init(int M, int N, int G_, int c_) { nM = M / BM; nN = N / BM; nwg = nM * nN; G = G_; c = c_; }
    __host__ __device__ bool next(int i, Unit& u) const {
        const long L = (long)i * G + c; if (L >= nwg) return false;
        int wgid = (int)L; { const int q = nwg / NXCD, r = nwg % NXCD, xcd = wgid % NXCD, off = wgid / NXCD; wgid = (xcd < r ? xcd * (q + 1) : r * (q + 1) + (xcd - r) * q) + off; }
        const int nig = WGM * nN, gid = wgid / nig, fm = gid * WGM, gsz = (nM - fm) < WGM ? (nM - fm) : WGM;
        u.pm = fm + ((wgid % nig) % gsz); u.pn = (wgid % nig) / gsz; return true;
    }
    __device__ __forceinline__ void a_ready(const Unit&) const {}
    __device__ __forceinline__ void done(const Unit&) const {}
};
__device__ __forceinline__ unsigned cvt_pk_bf16(float lo, float hi) { unsigned r; asm volatile("v_cvt_pk_bf16_f32 %0, %1, %2" : "=v"(r) : "v"(lo), "v"(hi)); return r; }
typedef float f32x2 __attribute__((ext_vector_type(2)));
template <class Epi, class Sched, bool STAMP = false>
__device__ __forceinline__ void gemm_phase(PG8_LAS unsigned char* lds, const Gemm g, const Sched& S, const Epi& E, unsigned long long* stamps) {
    int tid_l = threadIdx.x; asm volatile("" : "+v"(tid_l));
    const int tid = tid_l, wid = __builtin_amdgcn_readfirstlane(tid >> 6), lane = tid & 63, wr = wid >> 2, wc = wid & 3, fr = lane & 15, fq = lane >> 4;
    const int K = g.K, nt = K / BK;
    int ts_lo = 0, ts_hi = 0, nts = 0; const unsigned long long rt_entry = STAMP ? (unsigned long long)wall_clock64() : 0ull;
#define PG8_STAMP() do { if (STAMP && wid == 0 && nts < 64) { const unsigned long long _c = (unsigned long long)clock64(); \
        ts_lo = (lane == nts) ? (int)(unsigned)_c : ts_lo; ts_hi = (lane == nts) ? (int)(unsigned)(_c >> 32) : ts_hi; ++nts; } } while (0)
    PG8_STAMP();
    unsigned voffA[2], voffB[2];
#pragma unroll
    for (int i = 0; i < 2; ++i) { int R, C; stage_rc(tid * 16 + i * 8192, R, C); const int Rb = Epi::PERM ? ((R & ~31) + perm32(R & 31)) : R;
        voffA[i] = (unsigned)(R * K + C) * 2u; voffB[i] = (unsigned)(Rb * K + C) * 2u; }
    const size_t kstep = (size_t)(BK * 2);
    const size_t hstep = (size_t)HALF * K * 2;
    const size_t tstep = 2 * hstep;
    const unsigned ldsw = (unsigned)wid * 1024u;
    const int aoff = lds_byte(wr * 64 + fr, fq * 8), boff = lds_byte(wc * 32 + fr, fq * 8);
#define PG8_SA(b, h) (((b) * 2 + (h)) * HTB)
#define PG8_SB(b, h) ((4 + (b) * 2 + (h)) * HTB)
#define PG8_STAGE(bufoff, gbase, voff) do { _Pragma("unroll") for (int _i = 0; _i < 2; ++_i) \
        __builtin_amdgcn_global_load_lds((const unsigned*)((const char*)(gbase) + (voff)[_i]), (PG8_LAS unsigned*)(lds + (bufoff) + ldsw + _i * 8192), 16, 0, 0); } while (0)
#define PG8_LDA(dst, b, h) do { _Pragma("unroll") for (int m = 0; m < 4; ++m) _Pragma("unroll") for (int k = 0; k < 2; ++k) dst[m][k] = *(const PG8_LAS bf16x8*)(lds + PG8_SA(b, h) + aoff + m * 2048 + k * 1024); } while (0)
#define PG8_LDB(dst, b, h) do { _Pragma("unroll") for (int n = 0; n < 2; ++n) _Pragma("unroll") for (int k = 0; k < 2; ++k) dst[n][k] = *(const PG8_LAS bf16x8*)(lds + PG8_SB(b, h) + boff + n * 2048 + k * 1024); } while (0)
#define PG8_MMA(ai, bj, At, Bt) do { __builtin_amdgcn_s_setprio(1); _Pragma("unroll") for (int m = 0; m < 4; ++m) _Pragma("unroll") for (int n = 0; n < 2; ++n) _Pragma("unroll") for (int k = 0; k < 2; ++k) \
        acc[ai][bj][m][n] = __builtin_amdgcn_mfma_f32_16x16x32_bf16(Bt[n][k], At[m][k], acc[ai][bj][m][n], 0, 0, 0); __builtin_amdgcn_s_setprio(0); } while (0)
#define PG8_WAIT_V(n) asm volatile("s_waitcnt vmcnt(" #n ")" ::: "memory")
#define PG8_WAIT_L(n) asm volatile("s_waitcnt lgkmcnt(" #n ")" ::: "memory")
#define PG8_BAR __builtin_amdgcn_s_barrier()
#define PG8_SCHED __builtin_amdgcn_sched_barrier(0)
    Unit cur, nxt; int ui = 0;
    if (!S.next(0, cur)) return;
    f32x4 acc[2][2][4][2];
#pragma unroll
    for (int a = 0; a < 2; ++a)
#pragma unroll
        for (int b = 0; b < 2; ++b)
#pragma unroll
            for (int m = 0; m < 4; ++m)
#pragma unroll
                for (int n = 0; n < 2; ++n) acc[a][b][m][n] = (f32x4){0.f, 0.f, 0.f, 0.f};
    bf16x8 At[4][2], B0[2][2], B1[2][2];
    const char* cA = (const char*)g.A + (size_t)cur.pm * tstep; const char* cB = (const char*)g.Bt + (size_t)cur.pn * tstep;
    S.a_ready(cur);
    PG8_STAGE(PG8_SB(0, 0), cB, voffB); PG8_STAGE(PG8_SA(0, 0), cA, voffA); PG8_STAGE(PG8_SB(0, 1), cB + hstep, voffB); PG8_STAGE(PG8_SA(0, 1), cA + hstep, voffA);
    if (wr == 1) PG8_BAR;
    PG8_WAIT_V(4); PG8_BAR;
    PG8_STAGE(PG8_SB(1, 0), cB + kstep, voffB); PG8_STAGE(PG8_SA(1, 0), cA + kstep, voffA); PG8_STAGE(PG8_SB(1, 1), cB + hstep + kstep, voffB);
    PG8_WAIT_V(6); PG8_BAR;
    PG8_STAMP();
    for (;;) {
        const bool has_next = S.next(ui + 1, nxt);
        const char* nA = has_next ? (const char*)g.A + (size_t)nxt.pm * tstep : cA; const char* nB = has_next ? (const char*)g.Bt + (size_t)nxt.pn * tstep : cB;
        for (int t = 0; t < nt; t += 2) {
            const bool last = (t == nt - 2);
            const char* a1 = cA + (size_t)(t + 1) * kstep;
            const char* a2 = last ? nA : cA + (size_t)(t + 2) * kstep; const char* b2 = last ? nB : cB + (size_t)(t + 2) * kstep;
            const char* a3 = a2 + kstep; const char* b3 = b2 + kstep;
            if (last && has_next) S.a_ready(nxt);
            PG8_LDB(B0, 0, 0); PG8_SCHED; PG8_LDA(At, 0, 0); PG8_STAGE(PG8_SA(1, 1), a1 + hstep, voffA);
            PG8_WAIT_L(8); PG8_BAR; PG8_WAIT_L(0); PG8_MMA(0, 0, At, B0); PG8_BAR; PG8_SCHED;
            PG8_LDB(B1, 0, 1); PG8_STAGE(PG8_SB(0, 0), b2, voffB);
            PG8_BAR; PG8_WAIT_L(0); PG8_MMA(0, 1, At, B1); PG8_BAR;
            PG8_LDA(At, 0, 1); PG8_STAGE(PG8_SA(0, 0), a2, voffA);
            PG8_BAR; PG8_WAIT_L(0); PG8_MMA(1, 0, At, B0); PG8_BAR; PG8_SCHED;
            PG8_STAGE(PG8_SB(0, 1), b2 + hstep, voffB);
            PG8_WAIT_V(6); PG8_BAR; PG8_MMA(1, 1, At, B1); PG8_BAR;
            PG8_LDB(B0, 1, 0); PG8_SCHED; PG8_LDA(At, 1, 0); PG8_STAGE(PG8_SA(0, 1), a2 + hstep, voffA);
            PG8_WAIT_L(8); PG8_BAR; PG8_WAIT_L(0); PG8_MMA(0, 0, At, B0); PG8_BAR; PG8_SCHED;
            PG8_LDB(B1, 1, 1); PG8_STAGE(PG8_SB(1, 0), b3, voffB);
            PG8_BAR; PG8_WAIT_L(0); PG8_MMA(0, 1, At, B1); PG8_BAR;
            PG8_LDA(At, 1, 1); PG8_STAGE(PG8_SA(1, 0), a3, voffA);
            PG8_BAR; PG8_WAIT_L(0); PG8_MMA(1, 0, At, B0); PG8_BAR; PG8_SCHED;
            PG8_STAGE(PG8_SB(1, 1), b3 + hstep, voffB);
            PG8_WAIT_V(6); PG8_BAR; PG8_MMA(1, 1, At, B1); PG8_BAR;
        }
        PG8_STAMP();
        if constexpr (!Epi::AFTER_DRAIN) { E(acc, cur, wr, wc, fr, fq); S.done(cur); }
        PG8_STAMP();
        if (!has_next) break;
#pragma unroll
        for (int a = 0; a < 2; ++a)
#pragma unroll
            for (int b = 0; b < 2; ++b)
#pragma unroll
                for (int m = 0; m < 4; ++m)
#pragma unroll
                    for (int n = 0; n < 2; ++n) acc[a][b][m][n] = (f32x4){0.f, 0.f, 0.f, 0.f};
        cur = nxt; cA = nA; cB = nB; ++ui;
    }
    PG8_WAIT_V(0);
    if (wr == 0) PG8_BAR;
    PG8_BAR;
    if constexpr (Epi::AFTER_DRAIN) { E.fused(acc, cur, wr, wc, fr, fq, lds, wid, lane); S.done(cur); }
    PG8_STAMP();
    if (STAMP && wid == 0) { stamps[lane] = lane < nts ? (((unsigned long long)(unsigned)ts_hi << 32) | (unsigned)ts_lo) : 0ull;
        if (lane == 62) stamps[62] = rt_entry; if (lane == 63) stamps[63] = (unsigned long long)wall_clock64(); }
#undef PG8_STAMP
#undef PG8_SA
#undef PG8_SB
#undef PG8_STAGE
#undef PG8_LDA
#undef PG8_LDB
#undef PG8_MMA
#undef PG8_WAIT_V
#undef PG8_WAIT_L
#undef PG8_BAR
#undef PG8_SCHED
}
}


#define LAS __attribute__((address_space(3)))
#define XB_TMO      128
#define XB_XCNT(j)  (256  + 64 * (j))
#define XB_XSUB(j)  (1280 + 64 * (j))
#define XB_XGEN(j)  (2304 + 64 * (j))
#define XB_TOP      3328
#define XB_TOPGEN   3392
#define XCD_BAR_WORDS 3456
#define XB_SPIN_CAP (1u << 18)

__device__ __forceinline__ unsigned xb_ld(unsigned* p)              { return __hip_atomic_load(p, __ATOMIC_RELAXED, __HIP_MEMORY_SCOPE_AGENT); }
__device__ __forceinline__ unsigned xb_add(unsigned* p, unsigned v) { return __hip_atomic_fetch_add(p, v, __ATOMIC_RELAXED, __HIP_MEMORY_SCOPE_AGENT); }
__device__ __forceinline__ unsigned xb_xcc_id() { return (unsigned)__builtin_amdgcn_s_getreg((3 << 11) | 20) & 0xFu; }
#define XB_SPIN(cond, bar) do { unsigned _sp = 0; while (cond) { __builtin_amdgcn_s_sleep(1); \
    if ((++_sp & 255u) == 0u) { if (xb_ld(&(bar)[XB_TMO])) break; if (_sp > XB_SPIN_CAP) { atomicAdd(&(bar)[XB_TMO], 1u); break; } } } } while (0)

struct XcdBarrier {
    unsigned* bar; unsigned x;
    volatile LAS unsigned* st;
};

__device__ __forceinline__ XcdBarrier xcd_barrier_post(unsigned* bar, volatile LAS unsigned* st) {
    XcdBarrier b; b.bar = bar; b.x = xb_xcc_id(); b.st = st;
    if (threadIdx.x == 0) (void)xb_add(&bar[XB_XCNT(b.x)], 1u);
    return b;
}
__device__ __forceinline__ void xcd_barrier_complete(unsigned* bar, unsigned x, unsigned& nloc, unsigned& nx) {
    const unsigned G = gridDim.x * gridDim.y * gridDim.z;
    unsigned sum, cnt, mine, sp = 0u;
    for (;;) {
        sum = 0u; cnt = 0u; mine = 0u;
#pragma unroll
        for (unsigned j = 0; j < 16; ++j) { const unsigned c = xb_ld(&bar[XB_XCNT(j)]); sum += c; cnt += (c > 0u) ? 1u : 0u; mine = (j == x) ? c : mine; }
        if (sum == G) break;
        __builtin_amdgcn_s_sleep(1);
        if ((++sp & 255u) == 0u) { if (xb_ld(&bar[XB_TMO])) break; if (sp > XB_SPIN_CAP) { atomicAdd(&bar[XB_TMO], 1u); break; } }
    }
    nloc = mine > 0u ? mine : 1u; nx = cnt > 0u ? cnt : 1u;
}

__device__ __forceinline__ void xcd_barrier(const XcdBarrier& b) {
    asm volatile("s_waitcnt vmcnt(0)" ::: "memory");
    __syncthreads();
    if (threadIdx.x == 0) {
        unsigned* bar = b.bar;
        __builtin_amdgcn_s_waitcnt(0);
        unsigned nloc = b.st[0], nx = b.st[1];
        if (nloc == 0u) { xcd_barrier_complete(bar, b.x, nloc, nx); b.st[0] = nloc; b.st[1] = nx; }
        const unsigned old = xb_add(&bar[XB_XSUB(b.x)], 1u);
        const unsigned gen = old / nloc;
        if (old + 1u == (gen + 1u) * nloc) {
            __builtin_amdgcn_fence(__ATOMIC_RELEASE, "agent");
            asm volatile("s_waitcnt vmcnt(0)" ::: "memory");
            const unsigned og = xb_add(&bar[XB_TOP], 1u);
            const unsigned tg = og / nx;
            if (og + 1u == (tg + 1u) * nx) xb_add(&bar[XB_TOPGEN], 1u);
            else XB_SPIN(xb_ld(&bar[XB_TOPGEN]) == tg, bar);
            __builtin_amdgcn_fence(__ATOMIC_ACQUIRE, "agent");
            xb_add(&bar[XB_XGEN(b.x)], 1u);
            asm volatile("s_waitcnt vmcnt(0)" ::: "memory");
        } else {
            XB_SPIN(xb_ld(&bar[XB_XGEN(b.x)]) == gen, bar);
            __builtin_amdgcn_fence(__ATOMIC_ACQUIRE, "agent");
            asm volatile("s_waitcnt vmcnt(0)" ::: "memory");
        }
    }
    __syncthreads();
}

typedef CfgT<RC> C;
constexpr int NTHREADS = 512, NWAVES = 8;
constexpr int LDS_STAGE = 131072, LDS_CTL = LDS_STAGE, LDS_BYTES = LDS_STAGE + 256;

namespace pg8 {
typedef unsigned u32x2 __attribute__((ext_vector_type(2)));
__device__ __forceinline__ float silu_f(float g) { return g * __builtin_amdgcn_rcpf(1.0f + __expf(-g)); }
struct EpiSwiGLU { static constexpr bool PERM = true, AFTER_DRAIN = false;
    bf16_t* act; const float* ss; int ff; float invd;
    __device__ __forceinline__ void operator()(const f32x4 (&acc)[2][2][4][2], const Unit& u, int wr, int wc, int fr, int fq) const {
        const int row0 = u.pm * BM + wr * 64 + fr, col = u.pn * 128 + wc * 32 + 8 * fq;
#pragma unroll
        for (int ai = 0; ai < 2; ++ai)
#pragma unroll
            for (int m = 0; m < 4; ++m) { const int row = row0 + ai * HALF + m * 16; const float rs = rsqrtf(ss[row] * invd + 1e-6f);
                f32x4 v[2];
#pragma unroll
                for (int n = 0; n < 2; ++n) { const f32x4 g = acc[ai][0][m][n] * rs, up = acc[ai][1][m][n] * rs;
#pragma unroll
                    for (int j = 0; j < 4; ++j) v[n][j] = silu_f(g[j]) * up[j]; }
                u32x4 w; w.x = cvt_pk_bf16(v[0][0], v[0][1]); w.y = cvt_pk_bf16(v[0][2], v[0][3]); w.z = cvt_pk_bf16(v[1][0], v[1][1]); w.w = cvt_pk_bf16(v[1][2], v[1][3]);
                *(u32x4*)(act + (size_t)row * ff + col) = w; }
    }
};
struct EpiResid { static constexpr bool PERM = false, AFTER_DRAIN = false;
    float* X; bf16_t* XB; float* ssout; float scale; int ld;
    __device__ __forceinline__ void operator()(const f32x4 (&acc)[2][2][4][2], const Unit& u, int wr, int wc, int fr, int fq) const {
        const int row0 = u.pm * BM + wr * 64 + fr, col0 = u.pn * BM + wc * 32 + 4 * fq;
#pragma unroll
        for (int ai = 0; ai < 2; ++ai)
#pragma unroll
            for (int m = 0; m < 4; ++m) { const int row = row0 + ai * HALF + m * 16; float* xr = X + (size_t)row * ld + col0; bf16_t* br = XB + (size_t)row * ld + col0; float s = 0.f;
#pragma unroll
                for (int bj = 0; bj < 2; ++bj)
#pragma unroll
                    for (int n = 0; n < 2; ++n) { f32x4 x = *(const f32x4*)(xr + bj * HALF + n * 16) + acc[ai][bj][m][n] * scale; *(f32x4*)(xr + bj * HALF + n * 16) = x;
                        u32x2 w; w.x = cvt_pk_bf16(x[0], x[1]); w.y = cvt_pk_bf16(x[2], x[3]); *(u32x2*)(br + bj * HALF + n * 16) = w;
                        s += (x[0] * x[0] + x[1] * x[1]) + (x[2] * x[2] + x[3] * x[3]); }
                s += __shfl_xor(s, 16); s += __shfl_xor(s, 32);
                if (fq == 0) unsafeAtomicAdd(ssout + row, s); }
    }
};
struct EpiScaleF32 { static constexpr bool PERM = false, AFTER_DRAIN = false;
    float* Cp; int ldc; const float* ss; float invd;
    __device__ __forceinline__ void operator()(const f32x4 (&acc)[2][2][4][2], const Unit& u, int wr, int wc, int fr, int fq) const {
        const int row0 = u.pm * BM + wr * 64 + fr, col0 = u.pn * BM + wc * 32 + 4 * fq;
#pragma unroll
        for (int ai = 0; ai < 2; ++ai)
#pragma unroll
            for (int m = 0; m < 4; ++m) { const int row = row0 + ai * HALF + m * 16; const float rs = rsqrtf(ss[row] * invd + 1e-6f); float* cr = Cp + (size_t)row * ldc + col0;
#pragma unroll
                for (int bj = 0; bj < 2; ++bj)
#pragma unroll
                    for (int n = 0; n < 2; ++n) *(f32x4*)(cr + bj * HALF + n * 16) = acc[ai][bj][m][n] * rs; }
    }
};
struct EpiScaleBf16 { static constexpr bool PERM = true, AFTER_DRAIN = false;
    bf16_t* O; int ldc; const float* ss; float invd;
    __device__ __forceinline__ void operator()(const f32x4 (&acc)[2][2][4][2], const Unit& u, int wr, int wc, int fr, int fq) const {
        const int row0 = u.pm * BM + wr * 64 + fr, col0 = u.pn * BM + wc * 32 + 8 * fq;
#pragma unroll
        for (int ai = 0; ai < 2; ++ai)
#pragma unroll
            for (int m = 0; m < 4; ++m) { const int row = row0 + ai * HALF + m * 16; const float rs = rsqrtf(ss[row] * invd + 1e-6f); bf16_t* orow = O + (size_t)row * ldc + col0;
#pragma unroll
                for (int bj = 0; bj < 2; ++bj) { const f32x4 v0 = acc[ai][bj][m][0] * rs, v1 = acc[ai][bj][m][1] * rs;
                    u32x4 w; w.x = cvt_pk_bf16(v0[0], v0[1]); w.y = cvt_pk_bf16(v0[2], v0[3]); w.z = cvt_pk_bf16(v1[0], v1[1]); w.w = cvt_pk_bf16(v1[2], v1[3]);
                    *(u32x4*)(orow + bj * HALF) = w; } }
    }
};
struct EpiMemKV { static constexpr bool PERM = false, AFTER_DRAIN = false;
    float* K; float* V; const float* rstd; int d;
    __device__ __forceinline__ void operator()(const f32x4 (&acc)[2][2][4][2], const Unit& u, int wr, int wc, int fr, int fq) const {
        const int row0 = u.pm * BM + wr * 64 + fr; int ct = u.pn * BM; float* base = K; if (ct >= d) { base = V; ct -= d; }
        const int col0 = ct + wc * 32 + 4 * fq;
#pragma unroll
        for (int ai = 0; ai < 2; ++ai)
#pragma unroll
            for (int m = 0; m < 4; ++m) { const int row = row0 + ai * HALF + m * 16; const float rs = rstd[row]; float* cr = base + (size_t)row * d + col0;
#pragma unroll
                for (int bj = 0; bj < 2; ++bj)
#pragma unroll
                    for (int n = 0; n < 2; ++n) *(f32x4*)(cr + bj * HALF + n * 16) = acc[ai][bj][m][n] * rs; }
    }
};
}

__device__ __forceinline__ unsigned pk2bf(float lo, float hi) { return pg8::cvt_pk_bf16(lo, hi); }
__device__ __forceinline__ void prep_item(const float* W, int K, int Ncols, const float* g, int kind, int N, bf16_t* Bt, LAS float* scr, int item, int lane) {
    const int nblk = N / 32, kb = item / nblk, nb = item % nblk, k0 = 64 * kb, n0 = 32 * nb;
    const int sc = wsrc_col<C>(kind, n0 + (lane & 31));
#pragma unroll 8
    for (int i = 0; i < 32; ++i) { const int kk = 2 * i + (lane >> 5); float v = 0.f;
        if (sc >= 0) { v = W[(size_t)(k0 + kk) * Ncols + sc]; if (g) v *= g[k0 + kk]; }
        scr[kk * 33 + (lane & 31)] = v; }
    asm volatile("s_waitcnt lgkmcnt(0)" ::: "memory");
    const int c = lane & 7;
#pragma unroll
    for (int j = 0; j < 4; ++j) { const int n = (lane >> 3) + 8 * j; const LAS float* s = scr + (8 * c) * 33 + n;
        pg8::u32x4 o; o.x = pk2bf(s[0 * 33], s[1 * 33]); o.y = pk2bf(s[2 * 33], s[3 * 33]); o.z = pk2bf(s[4 * 33], s[5 * 33]); o.w = pk2bf(s[6 * 33], s[7 * 33]);
        *(pg8::u32x4*)(Bt + (size_t)(n0 + n) * K + k0 + 8 * c) = o; }
    asm volatile("s_waitcnt lgkmcnt(0)" ::: "memory");
}
struct WDesc { const float* W; const float* g; bf16_t* dst; int K, Ncols, kind, N; };
__device__ __forceinline__ WDesc wdesc(const Ptrs& p, int l, int idx) {
    WDesc d; d.g = nullptr; d.kind = WK_PLAIN;
    switch (idx) {
    case 0: d.W = p.in[I_W1IN] + (size_t)l * C::D * 2 * C::FF; d.K = C::D; d.Ncols = 2 * C::FF; d.N = 2 * C::FF; d.g = p.in[I_GFFN1] + l * C::D; d.kind = WK_FFNIN; d.dst = wlayer<C>(p, l, C::W_1IN); break;
    case 1: d.W = p.in[I_W1OUT] + (size_t)l * C::FF * C::D; d.K = C::FF; d.Ncols = C::D; d.N = C::D; d.dst = wlayer<C>(p, l, C::W_1OUT); break;
    case 2: d.W = p.in[I_WIN] + (size_t)l * C::D * C::INC; d.K = C::D; d.Ncols = C::INC; d.N = C::LDP; d.g = p.in[I_GMIX] + l * C::D; d.kind = WK_WIN; d.dst = wlayer<C>(p, l, C::W_IN); break;
    case 3: d.W = p.in[I_WOUT] + (size_t)l * C::D * C::D; d.K = C::D; d.Ncols = C::D; d.N = C::D; d.dst = wlayer<C>(p, l, C::W_OUT); break;
    case 4: d.W = p.in[I_WQ] + (size_t)l * C::D * C::D; d.K = C::D; d.Ncols = C::D; d.N = C::D; d.g = p.in[I_GX] + l * C::D; d.dst = wlayer<C>(p, l, C::W_Q); break;
    case 5: d.W = p.in[I_WK] + (size_t)l * C::D * C::D; d.K = C::D; d.Ncols = C::D; d.N = C::D; d.g = p.in[I_GMEM] + l * C::D; d.dst = wlayer<C>(p, l, C::W_KV); break;
    case 6: d.W = p.in[I_WV] + (size_t)l * C::D * C::D; d.K = C::D; d.Ncols = C::D; d.N = C::D; d.g = p.in[I_GMEM] + l * C::D; d.dst = wlayer<C>(p, l, C::W_KV) + (size_t)C::D * C::D; break;
    case 7: d.W = p.in[I_WO] + (size_t)l * C::D * C::D; d.K = C::D; d.Ncols = C::D; d.N = C::D; d.dst = wlayer<C>(p, l, C::W_O); break;
    case 8: d.W = p.in[I_W2IN] + (size_t)l * C::D * 2 * C::FF; d.K = C::D; d.Ncols = 2 * C::FF; d.N = 2 * C::FF; d.g = p.in[I_GFFN2] + l * C::D; d.kind = WK_FFNIN; d.dst = wlayer<C>(p, l, C::W_2IN); break;
    default: d.W = p.in[I_W2OUT] + (size_t)l * C::FF * C::D; d.K = C::FF; d.Ncols = C::D; d.N = C::D; d.dst = wlayer<C>(p, l, C::W_2OUT); break;
    }
    return d;
}

namespace att {
typedef short bf16x8 __attribute__((ext_vector_type(8)));
typedef short s16x4 __attribute__((ext_vector_type(4)));
typedef float f32x4 __attribute__((ext_vector_type(4)));
typedef unsigned u32x2 __attribute__((ext_vector_type(2)));
constexpr int TOK = 256, CD = 64, PITCH = 144, CBYTES = TOK * PITCH, HDIM = 512, NH = 4, LD = 2048;
constexpr int NU_P = (C::MP / 128) * NH, NU_S = C::DEC_BATCH * NH, NUNITS = NU_P + NU_S;
static_assert(C::NMEM == TOK && C::AHD == HDIM && C::AH == NH && C::D == LD && C::DEC_SEQ == 32 && C::SEQ % 128 == 0, "attention phase is built for these shapes");
__device__ __forceinline__ s16x4 tr_read(unsigned addr) { s16x4 r; asm volatile("ds_read_b64_tr_b16 %0, %1" : "=&v"(r) : "v"(addr) : "memory"); return r; }
__device__ __forceinline__ void stage_load(f32x4 (&r)[8], const float* src, int tid) {
#pragma unroll
    for (int i = 0; i < 8; ++i) { const int f = tid + 512 * i; r[i] = *(const f32x4*)(src + (size_t)(f >> 4) * LD + (f & 15) * 4); }
}
__device__ __forceinline__ void stage_store(const f32x4 (&r)[8], LAS unsigned char* buf, int tid) {
#pragma unroll
    for (int i = 0; i < 8; ++i) { const int f = tid + 512 * i; u32x2 w; w.x = pg8::cvt_pk_bf16(r[i][0], r[i][1]); w.y = pg8::cvt_pk_bf16(r[i][2], r[i][3]);
        *(LAS u32x2*)(buf + (f >> 4) * PITCH + (f & 15) * 8) = w; }
}
__device__ __forceinline__ void attn_phase(LAS unsigned char* lds, const Ptrs& p, int l, int tid) {
    const int lane = tid & 63, wave = __builtin_amdgcn_readfirstlane(tid >> 6), li = lane & 15, g = lane >> 4;
    const bf16_t* Qg = wsb<C>(p, C::WS_Q); bf16_t* AO = wsb<C>(p, C::WS_AO);
    for (int u = blockIdx.x; u < NUNITS; u += gridDim.x) {
        int row0, nrows, head; const float* kb; const float* vb;
        if (u < NU_P) { const int b = u / (NU_P / C::BATCH), rem = u % (NU_P / C::BATCH); head = rem / (C::SEQ / 128); const int qt = rem % (C::SEQ / 128);
            row0 = b * C::SEQ + qt * 128; nrows = 128;
            kb = p.out + C::OUT_MK + ((size_t)l * C::BATCH + b) * TOK * LD + head * HDIM; vb = p.out + C::OUT_MV + ((size_t)l * C::BATCH + b) * TOK * LD + head * HDIM; }
        else { const int s = u - NU_P, b = s / NH; head = s % NH; row0 = C::MP + b * C::DEC_SEQ; nrows = C::DEC_SEQ;
            kb = p.in[I_CK] + ((size_t)l * C::DEC_BATCH + b) * TOK * LD + head * HDIM; vb = p.in[I_CV] + ((size_t)l * C::DEC_BATCH + b) * TOK * LD + head * HDIM; }
        const bool active = wave * 16 < nrows;
        const int qrow = row0 + wave * 16 + li;
        bf16x8 qf[16];
        if (active) {
#pragma unroll
            for (int ks = 0; ks < 16; ++ks) qf[ks] = *(const bf16x8*)(Qg + (size_t)qrow * LD + head * HDIM + ks * 32 + g * 8);
        } else {
#pragma unroll
            for (int ks = 0; ks < 16; ++ks) qf[ks] = (bf16x8){0, 0, 0, 0, 0, 0, 0, 0};
        }
        f32x4 s[16];
#pragma unroll
        for (int T = 0; T < 16; ++T) s[T] = (f32x4){0.f, 0.f, 0.f, 0.f};
        f32x4 pre[8];
        stage_load(pre, kb, tid); stage_store(pre, lds, tid);
        __syncthreads();
#pragma unroll
        for (int c = 0; c < 8; ++c) {
            LAS unsigned char* buf = lds + (c & 1) * CBYTES;
            stage_load(pre, c < 7 ? kb + (c + 1) * CD : vb, tid);
            if (active) {
#pragma unroll
                for (int ks = 0; ks < 2; ++ks)
#pragma unroll
                    for (int T = 0; T < 16; ++T) { const bf16x8 a = *(const LAS bf16x8*)(buf + (T * 16 + li) * PITCH + ks * 64 + g * 16);
                        s[T] = __builtin_amdgcn_mfma_f32_16x16x32_bf16(a, qf[2 * c + ks], s[T], 0, 0, 0); }
            }
            stage_store(pre, lds + ((c + 1) & 1) * CBYTES, tid);
            __syncthreads();
        }
        float mx = -3.0e38f;
#pragma unroll
        for (int T = 0; T < 16; ++T) { mx = fmaxf(mx, fmaxf(fmaxf(s[T][0], s[T][1]), fmaxf(s[T][2], s[T][3]))); }
        mx = fmaxf(mx, __shfl_xor(mx, 16)); mx = fmaxf(mx, __shfl_xor(mx, 32));
        const float sc = 0.044194173824159216f * 1.4426950408889634f;
        float sum = 0.f;
#pragma unroll
        for (int T = 0; T < 16; ++T)
#pragma unroll
            for (int j = 0; j < 4; ++j) { const float e = __builtin_amdgcn_exp2f((s[T][j] - mx) * sc); s[T][j] = e; sum += e; }
        sum += __shfl_xor(sum, 16); sum += __shfl_xor(sum, 32);
        const float inv = 1.0f / sum;
        bf16x8 pf[8];
#pragma unroll
        for (int t = 0; t < 8; ++t) { const unsigned w0 = pg8::cvt_pk_bf16(s[2 * t][0], s[2 * t][1]), w1 = pg8::cvt_pk_bf16(s[2 * t][2], s[2 * t][3]),
                w2 = pg8::cvt_pk_bf16(s[2 * t + 1][0], s[2 * t + 1][1]), w3 = pg8::cvt_pk_bf16(s[2 * t + 1][2], s[2 * t + 1][3]);
            pg8::u32x4 w; w.x = w0; w.y = w1; w.z = w2; w.w = w3; pf[t] = __builtin_bit_cast(bf16x8, w); }
        const unsigned trb = (unsigned)(size_t)lds + (unsigned)((4 * g + (li >> 2)) * PITCH + (li & 3) * 8);
        for (int c = 0; c < 8; ++c) {
            const unsigned bofs = (unsigned)(c & 1) * CBYTES;
            if (c < 7) stage_load(pre, vb + (c + 1) * CD, tid);
            if (active) {
                f32x4 o[4];
#pragma unroll
                for (int dt = 0; dt < 4; ++dt) o[dt] = (f32x4){0.f, 0.f, 0.f, 0.f};
#pragma unroll
                for (int t = 0; t < 8; ++t) {
                    s16x4 lo[4], hi[4];
#pragma unroll
                    for (int dt = 0; dt < 4; ++dt) { lo[dt] = tr_read(trb + bofs + (unsigned)(t * 32 * PITCH + dt * 32)); hi[dt] = tr_read(trb + bofs + (unsigned)(t * 32 * PITCH + 16 * PITCH + dt * 32)); }
                    asm volatile("s_waitcnt lgkmcnt(0)" ::: "memory"); __builtin_amdgcn_sched_barrier(0);
#pragma unroll
                    for (int dt = 0; dt < 4; ++dt) { const bf16x8 a = (bf16x8){lo[dt][0], lo[dt][1], lo[dt][2], lo[dt][3], hi[dt][0], hi[dt][1], hi[dt][2], hi[dt][3]};
                        o[dt] = __builtin_amdgcn_mfma_f32_16x16x32_bf16(a, pf[t], o[dt], 0, 0, 0); }
                }
#pragma unroll
                for (int dt = 0; dt < 4; ++dt) { u32x2 w; w.x = pg8::cvt_pk_bf16(o[dt][0] * inv, o[dt][1] * inv); w.y = pg8::cvt_pk_bf16(o[dt][2] * inv, o[dt][3] * inv);
                    *(u32x2*)(AO + (size_t)qrow * LD + head * HDIM + c * CD + dt * 16 + g * 4) = w; }
            }
            if (c < 7) stage_store(pre, lds + ((c + 1) & 1) * CBYTES, tid);
            __syncthreads();
        }
    }
}
}
constexpr int PH_PER_LAYER = 16, N_PHASES = 2 + PH_PER_LAYER * C::DEPTH;
struct Args { Ptrs p; int ph_lo, ph_hi; };
__global__ void __launch_bounds__(NTHREADS, 2) fwd(Args a) {
    extern __shared__ __attribute__((aligned(16))) unsigned char lds_raw[];
    LAS unsigned char* lds = (LAS unsigned char*)lds_raw;
    typedef __attribute__((address_space(4))) const Args* KArgs;
    const KArgs ka0 = (KArgs)__builtin_amdgcn_kernarg_segment_ptr();
    const int lo = a.ph_lo, hi = a.ph_hi;
#define IN(k) (lo <= (k) && (k) < hi)
#define BOTH(k) (IN(k) && IN((k) + 1))
#define GRID_BAR(k) do { if (BOTH(k)) { xcd_barrier(bar); } } while (0)
#if defined(__HIP_DEVICE_COMPILE__)
#define LOAD_PTRS KArgs ka = ka0; asm volatile("" : "+s"(ka)); Ptrs p; _Pragma("unroll") for (int i_ = 0; i_ < 33; ++i_) p.in[i_] = ka->p.in[i_]; p.out = ka->p.out; p.ws = ka->p.ws;
#else
#define LOAD_PTRS (void)ka0; const Ptrs p = a.p;
#endif
#define PHASE_ARGS LOAD_PTRS int tid = threadIdx.x; asm volatile("" : "+v"(tid)); \
    const int lane = tid & 63, wave = __builtin_amdgcn_readfirstlane(tid >> 6); (void)lane; (void)wave; \
    const long gtid = (long)blockIdx.x * NTHREADS + tid, gthreads = (long)gridDim.x * NTHREADS; (void)gtid; (void)gthreads; \
    float* SS = wsf<C>(p, C::WS_SS); (void)SS; const float invd = 1.0f / C::D; (void)invd;
#define ITEMS(n, call) do { for (long it = gtid; it < (long)(n); it += gthreads) { call; } } while (0)
#if ONE_LAUNCH
    if (threadIdx.x < 4) ((LAS unsigned*)(lds + LDS_CTL))[threadIdx.x] = 0u;
    __syncthreads();
    XcdBarrier bar = xcd_barrier_post((unsigned*)(a.p.ws + C::WS_CTL), (volatile LAS unsigned*)(lds + LDS_CTL));
#else
    XcdBarrier bar; bar.bar = nullptr; bar.x = 0; bar.st = nullptr;
#endif

    if (IN(0)) { PHASE_ARGS
        LAS float* scr = (LAS float*)(lds + wave * 16384);
        const int gw = blockIdx.x * NWAVES + wave, NGW = gridDim.x * NWAVES;
        for (int l = 0; l < C::DEPTH; ++l)
            for (int idx = 0; idx < 10; ++idx) { const WDesc d = wdesc(p, l, idx); const int nitems = (d.K / 64) * (d.N / 32);
                for (int it = gw; it < nitems; it += NGW) prep_item(d.W, d.K, d.Ncols, d.g, d.kind, d.N, d.dst, scr, it, lane); }
        ITEMS(C::M, st_rowinit<C>(p, (int)it));
        ITEMS(C::MM, st_meminit<C>(p, (int)it));
        GRID_BAR(0);
    }
    for (int l = 0; l < C::DEPTH; ++l) {
        const int pb = 1 + PH_PER_LAYER * l;
#define SSL(j) (SS + (size_t)(4 * l + (j)) * C::M)
        if (IN(pb + 0)) { PHASE_ARGS
            pg8::Gemm g{wsb<C>(p, C::WS_MEMB), wlayer<C>(p, l, C::W_KV), C::MM, 2 * C::D, C::D}; pg8::StaticOrder S; S.init(C::MM, 2 * C::D, gridDim.x, blockIdx.x);
            pg8::EpiMemKV E{p.out + C::OUT_MK + (size_t)l * C::MM * C::D, p.out + C::OUT_MV + (size_t)l * C::MM * C::D, wsf<C>(p, C::WS_RSTDM), C::D};
            pg8::gemm_phase<pg8::EpiMemKV, pg8::StaticOrder, false>(lds, g, S, E, nullptr);
            GRID_BAR(pb + 0);
        }
        if (IN(pb + 1)) { PHASE_ARGS
            pg8::Gemm g{wsb<C>(p, C::WS_XB), wlayer<C>(p, l, C::W_1IN), C::M, 2 * C::FF, C::D}; pg8::StaticOrder S; S.init(C::M, 2 * C::FF, gridDim.x, blockIdx.x);
            pg8::EpiSwiGLU E{wsb<C>(p, C::WS_BIG), SSL(0), C::FF, invd};
            pg8::gemm_phase<pg8::EpiSwiGLU, pg8::StaticOrder, false>(lds, g, S, E, nullptr);
            GRID_BAR(pb + 1);
        }
        if (IN(pb + 2)) { PHASE_ARGS
            pg8::Gemm g{wsb<C>(p, C::WS_BIG), wlayer<C>(p, l, C::W_1OUT), C::M, C::D, C::FF}; pg8::StaticOrder S; S.init(C::M, C::D, gridDim.x, blockIdx.x);
            pg8::EpiResid E{wsf<C>(p, C::WS_X), wsb<C>(p, C::WS_XB), SSL(1), 0.5f, C::D};
            pg8::gemm_phase<pg8::EpiResid, pg8::StaticOrder, false>(lds, g, S, E, nullptr);
            GRID_BAR(pb + 2);
        }
        if (IN(pb + 3)) { PHASE_ARGS
            pg8::Gemm g{wsb<C>(p, C::WS_XB), wlayer<C>(p, l, C::W_IN), C::M, C::LDP, C::D}; pg8::StaticOrder S; S.init(C::M, C::LDP, gridDim.x, blockIdx.x);
            pg8::EpiScaleF32 E{wsf<C>(p, C::WS_BIG), C::LDP, SSL(1), invd};
            pg8::gemm_phase<pg8::EpiScaleF32, pg8::StaticOrder, false>(lds, g, S, E, nullptr);
            GRID_BAR(pb + 3);
        }
        if (IN(pb + 4)) { PHASE_ARGS ITEMS((long)C::M * C::PW, st_pool_d<C>(p, l, it)); ITEMS((long)C::M * C::GH, st_gmlp_v<C>(p, l, it)); ITEMS(C::NCH, st_ml_a1<C>(p, l, (int)it)); GRID_BAR(pb + 4); }
        if (IN(pb + 5)) { PHASE_ARGS ITEMS((long)C::M * C::PW, st_pool_y<C>(p, l, it)); ITEMS((long)C::M * C::GW, st_gmlp_s<C>(p, l, it)); ITEMS((long)C::NCH * C::MHD * C::MHD, st_ml_a2<C>(p, l, it)); GRID_BAR(pb + 5); }
        if (IN(pb + 6)) { PHASE_ARGS ITEMS((C::BATCH + C::DEC_BATCH) * C::MH, st_ml_b0<C>(p, l, (int)it)); ITEMS((long)(C::BATCH + C::DEC_BATCH) * C::MH * C::MHD * C::MHD, st_ml_b<C>(p, l, it)); GRID_BAR(pb + 6); }
        if (IN(pb + 7)) { PHASE_ARGS ITEMS((long)C::M * C::MH, st_ml_c1<C>(p, l, it)); GRID_BAR(pb + 7); }
        if (IN(pb + 8)) { PHASE_ARGS ITEMS((long)C::M * C::MH * C::MHD, st_ml_c2<C>(p, l, it)); GRID_BAR(pb + 8); }
        if (IN(pb + 9)) { PHASE_ARGS ITEMS((long)C::M * C::MH, st_ml_c3<C>(p, l, it)); GRID_BAR(pb + 9); }
        if (IN(pb + 10)) { PHASE_ARGS
            pg8::Gemm g{wsb<C>(p, C::WS_MIX), wlayer<C>(p, l, C::W_OUT), C::M, C::D, C::D}; pg8::StaticOrder S; S.init(C::M, C::D, gridDim.x, blockIdx.x);
            pg8::EpiResid E{wsf<C>(p, C::WS_X), wsb<C>(p, C::WS_XB), SSL(2), 1.0f, C::D};
            pg8::gemm_phase<pg8::EpiResid, pg8::StaticOrder, false>(lds, g, S, E, nullptr);
            GRID_BAR(pb + 10);
        }
        if (IN(pb + 11)) { PHASE_ARGS
            pg8::Gemm g{wsb<C>(p, C::WS_XB), wlayer<C>(p, l, C::W_Q), C::M, C::D, C::D}; pg8::StaticOrder S; S.init(C::M, C::D, gridDim.x, blockIdx.x);
            pg8::EpiScaleBf16 E{wsb<C>(p, C::WS_Q), C::D, SSL(2), invd};
            pg8::gemm_phase<pg8::EpiScaleBf16, pg8::StaticOrder, false>(lds, g, S, E, nullptr);
            GRID_BAR(pb + 11);
        }
        if (IN(pb + 12)) { PHASE_ARGS att::attn_phase(lds, p, l, tid); GRID_BAR(pb + 12); }
        if (IN(pb + 13)) { PHASE_ARGS
            pg8::Gemm g{wsb<C>(p, C::WS_AO), wlayer<C>(p, l, C::W_O), C::M, C::D, C::D}; pg8::StaticOrder S; S.init(C::M, C::D, gridDim.x, blockIdx.x);
            pg8::EpiResid E{wsf<C>(p, C::WS_X), wsb<C>(p, C::WS_XB), SSL(3), 1.0f, C::D};
            pg8::gemm_phase<pg8::EpiResid, pg8::StaticOrder, false>(lds, g, S, E, nullptr);
            GRID_BAR(pb + 13);
        }
        if (IN(pb + 14)) { PHASE_ARGS
            pg8::Gemm g{wsb<C>(p, C::WS_XB), wlayer<C>(p, l, C::W_2IN), C::M, 2 * C::FF, C::D}; pg8::StaticOrder S; S.init(C::M, 2 * C::FF, gridDim.x, blockIdx.x);
            pg8::EpiSwiGLU E{wsb<C>(p, C::WS_BIG), SSL(3), C::FF, invd};
            pg8::gemm_phase<pg8::EpiSwiGLU, pg8::StaticOrder, false>(lds, g, S, E, nullptr);
            GRID_BAR(pb + 14);
        }
        if (IN(pb + 15)) { PHASE_ARGS
            pg8::Gemm g{wsb<C>(p, C::WS_BIG), wlayer<C>(p, l, C::W_2OUT), C::M, C::D, C::FF}; pg8::StaticOrder S; S.init(C::M, C::D, gridDim.x, blockIdx.x);
            pg8::EpiResid E{wsf<C>(p, C::WS_X), wsb<C>(p, C::WS_XB), SSL(4), 0.5f, C::D};
            pg8::gemm_phase<pg8::EpiResid, pg8::StaticOrder, false>(lds, g, S, E, nullptr);
            GRID_BAR(pb + 15);
        }
    }
    if (IN(N_PHASES - 1)) { PHASE_ARGS ITEMS(C::M, st_final<C>(p, (int)it)); }
#undef IN
#undef BOTH
#undef GRID_BAR
#undef ITEMS
#undef PHASE_ARGS
#undef SSL
}

extern "C" void kernel_launch(void* const* d_in, const int* in_sizes, int n_in, void* d_out, int out_size, void* d_ws, size_t ws_size, hipStream_t stream) {
    static int ready = 0;
    if (!ready) {
        if (n_in != 33 || (long)out_size != (long)C::OUT_END || ws_size < (size_t)C::WS_END) { fprintf(stderr, "kernel_launch: unexpected shapes: n_in %d out %d ws %zu (need %zu)\n", n_in, out_size, ws_size, (size_t)C::WS_END); ready = -1; return; }
        if (hipFuncSetAttribute((const void*)fwd, hipFuncAttributeMaxDynamicSharedMemorySize, LDS_BYTES) != hipSuccess) { fprintf(stderr, "kernel_launch: hipFuncSetAttribute failed\n"); ready = -1; return; }
        int dev = 0, cus = 0, per_cu = 0;
        if (hipGetDevice(&dev) != hipSuccess || hipDeviceGetAttribute(&cus, hipDeviceAttributeMultiprocessorCount, dev) != hipSuccess) { fprintf(stderr, "kernel_launch: device query failed\n"); ready = -1; return; }
        if (hipOccupancyMaxActiveBlocksPerMultiprocessor(&per_cu, (const void*)fwd, NTHREADS, LDS_BYTES) != hipSuccess || per_cu < 1) { fprintf(stderr, "kernel_launch: occupancy query reports %d blocks per CU\n", per_cu); (void)hipGetLastError(); per_cu = 1; }
        ready = cus;
    }
    if (ready < 0) return;
    Args a{};
    for (int i = 0; i < 33; ++i) a.p.in[i] = (const float*)d_in[i];
    a.p.out = (float*)d_out; a.p.ws = (unsigned char*)d_ws;
#if ONE_LAUNCH
    (void)hipMemsetAsync((char*)d_ws + C::WS_CTL, 0, 65536, stream);
    a.ph_lo = 0; a.ph_hi = N_PHASES;
    hipLaunchKernelGGL(fwd, dim3(ready), dim3(NTHREADS), LDS_BYTES, stream, a);
#else
    for (int k = 0; k < N_PHASES; ++k) { a.ph_lo = k; a.ph_hi = k + 1; hipLaunchKernelGGL(fwd, dim3(ready), dim3(NTHREADS), LDS_BYTES, stream, a); }
#endif
}
```

```cpp
#include <hip/hip_runtime.h>
#include <cstdio>
#define ONE_LAUNCH 1
#define HD __host__ __device__
#ifndef HD
#define HD __host__ __device__
#endif
typedef unsigned short bf16_t;
HD inline unsigned f2u(float f) { return __builtin_bit_cast(unsigned, f); }
HD inline float u2f(unsigned u) { return __builtin_bit_cast(float, u); }
HD inline bf16_t f2bf(float f) { unsigned u = f2u(f); u += 0x7FFFu + ((u >> 16) & 1u); return (bf16_t)(u >> 16); }
HD inline float bf2f(bf16_t b) { return u2f(((unsigned)b) << 16); }

struct RC {
    static constexpr int D = 2048, FF = 8192, BATCH = 4, SEQ = 2048, DEPTH = 2, DEC_BATCH = 32, DEC_SEQ = 32, PAST = 2048, NMEM = 256;
};
template <class B> struct CfgT : B {
    using B::D; using B::FF; using B::BATCH; using B::SEQ; using B::DEPTH; using B::DEC_BATCH; using B::DEC_SEQ; using B::PAST; using B::NMEM;
    static constexpr int MP = BATCH * SEQ, MS = DEC_BATCH * DEC_SEQ, M = MP + MS, MM = BATCH * NMEM;
    static constexpr int PW = D / 4, PG = 4, PGD = PW / 4, PH = 15;
    static constexpr int GW = D / 4, GH = 4, GHD = GW / 4, GCH = 128;
    static constexpr int MW = D - PW - GW, MH = 8, MHD = MW / 8, CH = 64;
    static constexpr int INC = PW + 2 * GW + 4 * MW + 2 * MH;
    static constexpr int LDP = ((INC + 255) / 256) * 256;
    static constexpr int AH = 4, AHD = D / 4;
    static constexpr int O_U = PW, O_V = PW + GW, O_Q = PW + 2 * GW, O_K = O_Q + MW, O_VM = O_K + MW, O_O = O_VM + MW, O_IG = O_O + MW, O_FG = O_IG + MH;
    static constexpr int NC = SEQ / CH, NPC = BATCH * MH * NC, NSC = DEC_BATCH * MH, NCH = NPC + NSC;
    static constexpr int LCS = DEC_SEQ < CH ? DEC_SEQ : CH;
    static constexpr int GLP = SEQ < GCH ? SEQ : GCH, GLS = DEC_SEQ < GCH ? DEC_SEQ : GCH;
    static constexpr int NSS = 1 + 4 * DEPTH;
    static constexpr long OUT_YP = 0, OUT_YS = OUT_YP + (long)MP * D, OUT_POOLP = OUT_YS + (long)MS * D, OUT_POOLS = OUT_POOLP + (long)DEPTH * BATCH * PH * PW,
        OUT_CP = OUT_POOLS + (long)DEPTH * DEC_BATCH * PH * PW, OUT_NP = OUT_CP + (long)DEPTH * BATCH * MH * MHD * MHD, OUT_MP = OUT_NP + (long)DEPTH * BATCH * MH * MHD,
        OUT_CS = OUT_MP + (long)DEPTH * BATCH * MH, OUT_NS = OUT_CS + (long)DEPTH * DEC_BATCH * MH * MHD * MHD, OUT_MS = OUT_NS + (long)DEPTH * DEC_BATCH * MH * MHD,
        OUT_VS = OUT_MS + (long)DEPTH * DEC_BATCH * MH, OUT_MK = OUT_VS + (long)DEPTH * DEC_BATCH * DEC_SEQ * GW, OUT_MV = OUT_MK + (long)DEPTH * BATCH * NMEM * D,
        OUT_END = OUT_MV + (long)DEPTH * BATCH * NMEM * D;
    static constexpr size_t al(size_t x) { return (x + 255) & ~(size_t)255; }
    static constexpr size_t WS_CTL = 0, WS_SS = 65536, WS_X = al(WS_SS + (size_t)NSS * M * 4), WS_XB = al(WS_X + (size_t)M * D * 4),
        WS_BIG = al(WS_XB + (size_t)M * D * 2),
        WS_BIG_SZ = ((size_t)M * FF * 2 > (size_t)M * LDP * 4) ? (size_t)M * FF * 2 : (size_t)M * LDP * 4,
        WS_MIX = al(WS_BIG + WS_BIG_SZ), WS_Q = al(WS_MIX + (size_t)M * D * 2), WS_AO = al(WS_Q + (size_t)M * D * 2),
        WS_MEMB = al(WS_AO + (size_t)M * D * 2), WS_RSTDM = al(WS_MEMB + (size_t)MM * D * 2),
        WS_PD = al(WS_RSTDM + (size_t)MM * 4), WS_VH = al(WS_PD + (size_t)M * PW * 4),
        WS_GB = al(WS_VH + (size_t)M * GW * 4), WS_GA = al(WS_GB + (size_t)M * MH * 4), WS_GWT = al(WS_GA + (size_t)M * MH * 4),
        WS_CBL = al(WS_GWT + (size_t)M * MH * 4), WS_CML = al(WS_CBL + (size_t)NCH * 4), WS_MPREV = al(WS_CML + (size_t)NCH * 4),
        WS_DC = al(WS_MPREV + (size_t)NCH * 4), WS_DN = al(WS_DC + (size_t)NCH * MHD * MHD * 4),
        WS_SB = al(WS_DN + (size_t)NCH * MHD * 4), WS_DEN = al(WS_SB + (size_t)M * MH * CH * 4), WS_IW = al(WS_DEN + (size_t)M * MH * 4),
        WS_HB = al(WS_IW + (size_t)M * MH * 4), WS_SC = al(WS_HB + (size_t)M * MW * 4),
        WS_W = al(WS_SC + (size_t)M * AH * NMEM * 4);
    static constexpr size_t W_1IN = 0, W_1OUT = W_1IN + (size_t)2 * FF * D, W_IN = W_1OUT + (size_t)D * FF, W_OUT = W_IN + (size_t)LDP * D, W_Q = W_OUT + (size_t)D * D,
        W_KV = W_Q + (size_t)D * D, W_O = W_KV + (size_t)2 * D * D, W_2IN = W_O + (size_t)D * D, W_2OUT = W_2IN + (size_t)2 * FF * D, W_LAYER = W_2OUT + (size_t)D * FF;
    static constexpr size_t WS_END = al(WS_W + (size_t)DEPTH * W_LAYER * 2);
};

struct Ptrs { const float* in[33]; float* out; unsigned char* ws; };
enum { I_XP = 0, I_XS, I_MEM, I_SPOOL, I_SC, I_SN, I_SM, I_CK, I_CV, I_GFFN1, I_W1IN, I_W1OUT, I_GMIX, I_WIN, I_POOLW, I_POOLS, I_GVG, I_GWS, I_GBS, I_IB, I_FB, I_NG, I_WOUT,
       I_GX, I_GMEM, I_WQ, I_WK, I_WV, I_WO, I_GFFN2, I_W2IN, I_W2OUT, I_GFIN };

template <class C> HD inline float* wsf(const Ptrs& p, size_t off) { return (float*)(p.ws + off); }
template <class C> HD inline bf16_t* wsb(const Ptrs& p, size_t off) { return (bf16_t*)(p.ws + off); }
template <class C> HD inline bf16_t* wlayer(const Ptrs& p, int l, size_t off) { return (bf16_t*)(p.ws + C::WS_W) + (size_t)l * C::W_LAYER + off; }

template <class C> HD inline void row_info(int r, bool& s, int& b, int& t) {
    if (r < C::MP) { s = false; b = r / C::SEQ; t = r % C::SEQ; } else { s = true; const int q = r - C::MP; b = q / C::DEC_SEQ; t = q % C::DEC_SEQ; }
}
template <class C> HD inline void chunk_info(int r, int h, int& ci, int& i, int& lc) {
    bool s; int b, t; row_info<C>(r, s, b, t);
    if (!s) { ci = (b * C::MH + h) * C::NC + t / C::CH; i = t % C::CH; lc = C::CH; } else { ci = C::NPC + b * C::MH + h; i = t; lc = C::LCS; }
}
HD inline float sigmoidf_(float x) { return 1.0f / (1.0f + expf(-x)); }
HD inline float logsigmoidf_(float x) { return x >= 0.f ? -log1pf(expf(-x)) : x - log1pf(expf(x)); }

enum { WK_PLAIN = 0, WK_FFNIN = 1, WK_WIN = 2 };
template <class C> HD inline int wsrc_col(int kind, int n) {
    if (kind == WK_FFNIN) { const int pn = n >> 8, j = n & 255; return j < 128 ? 128 * pn + j : C::FF + 128 * pn + (j - 128); }
    if (kind == WK_WIN) return n < C::INC ? n : -1;
    return n;
}

template <class C> HD inline void st_rowinit(const Ptrs& p, int r) {
    const float* src = r < C::MP ? p.in[I_XP] + (size_t)r * C::D : p.in[I_XS] + (size_t)(r - C::MP) * C::D;
    float* X = wsf<C>(p, C::WS_X) + (size_t)r * C::D; bf16_t* XB = wsb<C>(p, C::WS_XB) + (size_t)r * C::D;
    float ss = 0.f;
    for (int k = 0; k < C::D; ++k) { const float v = src[k]; X[k] = v; XB[k] = f2bf(v); ss += v * v; }
    float* SS = wsf<C>(p, C::WS_SS);
    SS[r] = ss;
    for (int j = 1; j < C::NSS; ++j) SS[(size_t)j * C::M + r] = 0.f;
}
template <class C> HD inline void st_meminit(const Ptrs& p, int r) {
    const float* src = p.in[I_MEM] + (size_t)r * C::D; bf16_t* MB = wsb<C>(p, C::WS_MEMB) + (size_t)r * C::D;
    float ss = 0.f;
    for (int k = 0; k < C::D; ++k) { const float v = src[k]; MB[k] = f2bf(v); ss += v * v; }
    wsf<C>(p, C::WS_RSTDM)[r] = 1.0f / sqrtf(ss / C::D + 1e-6f);
}
template <class C> HD inline void st_pool_d(const Ptrs& p, int l, long item) {
    const int r = (int)(item / C::PW), ch = (int)(item % C::PW), g = ch / C::PGD;
    const int w = 2 << g;
    bool s; int b, t; row_info<C>(r, s, b, t);
    const float* P = wsf<C>(p, C::WS_BIG);
    const int pos = (s ? C::PAST : 0) + t;
    float sum = 0.f;
    for (int j = 0; j < w; ++j) { const int tt = t - j;
        float v;
        if (tt >= 0) v = P[(size_t)(r - j) * C::LDP + ch];
        else { const int hi = C::PH + tt;
            v = (s && hi >= 0) ? p.in[I_SPOOL][(((size_t)l * C::DEC_BATCH + b) * C::PH + hi) * C::PW + ch] : 0.f; }
        sum += v; }
    const float cnt = (float)((pos + 1) < w ? (pos + 1) : w);
    wsf<C>(p, C::WS_PD)[(size_t)r * C::PW + ch] = sum / cnt - P[(size_t)r * C::LDP + ch];
    const int L = s ? C::DEC_SEQ : C::SEQ;
    const int idx = t - (L - C::PH);
    if (idx >= 0) { float* o = p.out + (s ? C::OUT_POOLS + (((size_t)l * C::DEC_BATCH + b) * C::PH + idx) * C::PW : C::OUT_POOLP + (((size_t)l * C::BATCH + b) * C::PH + idx) * C::PW);
        o[ch] = P[(size_t)r * C::LDP + ch]; }
}
template <class C> HD inline void st_pool_y(const Ptrs& p, int l, long item) {
    const int r = (int)(item / C::PW), ch = (int)(item % C::PW), g = ch / C::PGD, e = ch % C::PGD;
    const float* d = wsf<C>(p, C::WS_PD) + (size_t)r * C::PW + g * C::PGD;
    const float* w = p.in[I_POOLW] + ((size_t)l * C::PG + g) * C::PGD * C::PGD;
    float acc = 0.f;
    for (int c = 0; c < C::PGD; ++c) acc += d[c] * w[(size_t)c * C::PGD + e];
    wsb<C>(p, C::WS_MIX)[(size_t)r * C::D + ch] = f2bf(acc * p.in[I_POOLS][(size_t)l * C::PW + ch]);
}
template <class C> HD inline void st_gmlp_v(const Ptrs& p, int l, long item) {
    const int r = (int)(item / C::GH), h = (int)(item % C::GH);
    const float* v = wsf<C>(p, C::WS_BIG) + (size_t)r * C::LDP + C::O_V + h * C::GHD;
    float ss = 0.f; for (int d = 0; d < C::GHD; ++d) ss += v[d] * v[d];
    const float rs = 1.0f / sqrtf(ss / C::GHD + 1e-6f);
    float* VH = wsf<C>(p, C::WS_VH) + (size_t)r * C::GW + h * C::GHD; const float* g = p.in[I_GVG] + (size_t)l * C::GW + h * C::GHD;
    bool s; int b, t; row_info<C>(r, s, b, t);
    float* o = s ? p.out + C::OUT_VS + (((size_t)l * C::DEC_BATCH + b) * C::DEC_SEQ + t) * C::GW + h * C::GHD : nullptr;
    for (int d = 0; d < C::GHD; ++d) { const float y = v[d] * rs * g[d]; VH[d] = y; if (o) o[d] = y; }
}
template <class C> HD inline void st_gmlp_s(const Ptrs& p, int l, long item) {
    const int r = (int)(item / C::GW), ch = (int)(item % C::GW), h = ch / C::GHD;
    bool s; int b, t; row_info<C>(r, s, b, t);
    const int lc = s ? C::GLS : C::GLP, i = t % lc, r0 = r - i;
    const float* ws = p.in[I_GWS] + (((size_t)l * C::GH + h) * C::GCH + i) * C::GCH;
    const float* VH = wsf<C>(p, C::WS_VH);
    float acc = p.in[I_GBS][((size_t)l * C::GH + h) * C::GCH + i];
    for (int j = 0; j <= i; ++j) acc += ws[j] * VH[(size_t)(r0 + j) * C::GW + ch];
    const float u = wsf<C>(p, C::WS_BIG)[(size_t)r * C::LDP + C::O_U + ch];
    wsb<C>(p, C::WS_MIX)[(size_t)r * C::D + C::PW + ch] = f2bf(u * acc);
}
template <class C> HD inline void st_ml_a1(const Ptrs& p, int l, int ci) {
    int r0, h, lc;
    if (ci < C::NPC) { const int c = ci % C::NC, bh = ci / C::NC; h = bh % C::MH; const int b = bh / C::MH; r0 = b * C::SEQ + c * C::CH; lc = C::CH; }
    else { const int q = ci - C::NPC; h = q % C::MH; const int b = q / C::MH; r0 = C::MP + b * C::DEC_SEQ; lc = C::LCS; }
    const float* P = wsf<C>(p, C::WS_BIG); float* GB = wsf<C>(p, C::WS_GB); float* GA = wsf<C>(p, C::WS_GA); float* GWT = wsf<C>(p, C::WS_GWT);
    const float ib = p.in[I_IB][l * C::MH + h], fb = p.in[I_FB][l * C::MH + h];
    float bc = 0.f, amax = -3.0e38f;
    for (int i = 0; i < lc; ++i) { const float* pr = P + (size_t)(r0 + i) * C::LDP;
        const float ig = pr[C::O_IG + h] + ib, fg = pr[C::O_FG + h] + fb;
        bc += logsigmoidf_(fg); const float a = ig - bc;
        GB[(size_t)(r0 + i) * C::MH + h] = bc; GA[(size_t)(r0 + i) * C::MH + h] = a; amax = a > amax ? a : amax; }
    const float bL = bc, mloc = bL + amax;
    wsf<C>(p, C::WS_CBL)[ci] = bL; wsf<C>(p, C::WS_CML)[ci] = mloc;
    for (int i = 0; i < lc; ++i) GWT[(size_t)(r0 + i) * C::MH + h] = expf(bL + GA[(size_t)(r0 + i) * C::MH + h] - mloc);
}
template <class C> HD inline void st_ml_a2(const Ptrs& p, int l, long item) {
    const int e = (int)(item % C::MHD), d = (int)((item / C::MHD) % C::MHD), ci = (int)(item / ((long)C::MHD * C::MHD));
    int r0, h, lc;
    if (ci < C::NPC) { const int c = ci % C::NC, bh = ci / C::NC; h = bh % C::MH; const int b = bh / C::MH; r0 = b * C::SEQ + c * C::CH; lc = C::CH; }
    else { const int q = ci - C::NPC; h = q % C::MH; const int b = q / C::MH; r0 = C::MP + b * C::DEC_SEQ; lc = C::LCS; }
    const float* P = wsf<C>(p, C::WS_BIG); const float* GWT = wsf<C>(p, C::WS_GWT);
    const float scale = 1.0f / sqrtf((float)C::MHD);
    float acc = 0.f, accn = 0.f;
    for (int t = 0; t < lc; ++t) { const float* pr = P + (size_t)(r0 + t) * C::LDP; const float wk = GWT[(size_t)(r0 + t) * C::MH + h] * pr[C::O_K + h * C::MHD + d] * scale;
        acc += wk * pr[C::O_VM + h * C::MHD + e]; accn += wk; }
    wsf<C>(p, C::WS_DC)[((size_t)ci * C::MHD + d) * C::MHD + e] = acc;
    if (e == 0) wsf<C>(p, C::WS_DN)[(size_t)ci * C::MHD + d] = accn;
}
template <class C> HD inline void st_ml_b0(const Ptrs& p, int l, int sq) {
    const float* CBL = wsf<C>(p, C::WS_CBL); const float* CML = wsf<C>(p, C::WS_CML); float* MPREV = wsf<C>(p, C::WS_MPREV);
    if (sq < C::BATCH * C::MH) { float m = 0.f;
        for (int c = 0; c < C::NC; ++c) { const int ci = sq * C::NC + c; MPREV[ci] = m; const float a = CBL[ci] + m, b2 = CML[ci]; m = a > b2 ? a : b2; }
        p.out[C::OUT_MP + (size_t)l * C::BATCH * C::MH + sq] = m;
    } else { const int q = sq - C::BATCH * C::MH, ci = C::NPC + q; const float m0 = p.in[I_SM][(size_t)l * C::DEC_BATCH * C::MH + q];
        MPREV[ci] = m0; const float a = CBL[ci] + m0, b2 = CML[ci]; p.out[C::OUT_MS + (size_t)l * C::DEC_BATCH * C::MH + q] = a > b2 ? a : b2; }
}
template <class C> HD inline void st_ml_b(const Ptrs& p, int l, long item) {
    const int e = (int)(item % C::MHD), d = (int)((item / C::MHD) % C::MHD), sq = (int)(item / ((long)C::MHD * C::MHD));
    const float* CBL = wsf<C>(p, C::WS_CBL); const float* CML = wsf<C>(p, C::WS_CML);
    float* DC = wsf<C>(p, C::WS_DC); float* DN = wsf<C>(p, C::WS_DN);
    if (sq < C::BATCH * C::MH) { float m = 0.f, cst = 0.f, nst = 0.f;
        for (int c = 0; c < C::NC; ++c) { const int ci = sq * C::NC + c; const float a = CBL[ci] + m, b2 = CML[ci], mn = a > b2 ? a : b2;
            const float dec = expf(a - mn), f = expf(b2 - mn);
            const size_t o = ((size_t)ci * C::MHD + d) * C::MHD + e; cst = dec * cst + f * DC[o]; DC[o] = cst;
            if (e == 0) { const size_t on = (size_t)ci * C::MHD + d; nst = dec * nst + f * DN[on]; DN[on] = nst; }
            m = mn; }
        p.out[C::OUT_CP + (((size_t)l * C::BATCH * C::MH + sq) * C::MHD + d) * C::MHD + e] = cst;
        if (e == 0) p.out[C::OUT_NP + ((size_t)l * C::BATCH * C::MH + sq) * C::MHD + d] = nst;
    } else { const int q = sq - C::BATCH * C::MH, ci = C::NPC + q; const float m0 = p.in[I_SM][(size_t)l * C::DEC_BATCH * C::MH + q];
        const float a = CBL[ci] + m0, b2 = CML[ci], mn = a > b2 ? a : b2, dec = expf(a - mn), f = expf(b2 - mn);
        const size_t so = (((size_t)l * C::DEC_BATCH * C::MH + q) * C::MHD + d) * C::MHD + e;
        p.out[C::OUT_CS + so] = dec * p.in[I_SC][so] + f * DC[((size_t)ci * C::MHD + d) * C::MHD + e];
        if (e == 0) { const size_t no = ((size_t)l * C::DEC_BATCH * C::MH + q) * C::MHD + d; p.out[C::OUT_NS + no] = dec * p.in[I_SN][no] + f * DN[(size_t)ci * C::MHD + d]; }
    }
}
template <class C> HD inline float ml_cprev(const Ptrs& p, int l, int ci, int d, int e) {
    if (ci < C::NPC) return (ci % C::NC) == 0 ? 0.f : wsf<C>(p, C::WS_DC)[((size_t)(ci - 1) * C::MHD + d) * C::MHD + e];
    return p.in[I_SC][(((size_t)l * C::DEC_BATCH * C::MH + (ci - C::NPC)) * C::MHD + d) * C::MHD + e];
}
template <class C> HD inline float ml_nprev(const Ptrs& p, int l, int ci, int d) {
    if (ci < C::NPC) return (ci % C::NC) == 0 ? 0.f : wsf<C>(p, C::WS_DN)[(size_t)(ci - 1) * C::MHD + d];
    return p.in[I_SN][((size_t)l * C::DEC_BATCH * C::MH + (ci - C::NPC)) * C::MHD + d];
}
template <class C> HD inline void st_ml_c1(const Ptrs& p, int l, long item) {
    const int r = (int)(item / C::MH), h = (int)(item % C::MH);
    int ci, i, lc; chunk_info<C>(r, h, ci, i, lc); const int r0 = r - i;
    const float* P = wsf<C>(p, C::WS_BIG); const float* GB = wsf<C>(p, C::WS_GB); const float* GA = wsf<C>(p, C::WS_GA);
    const float mprev = wsf<C>(p, C::WS_MPREV)[ci];
    const float bi = GB[(size_t)r * C::MH + h];
    float amax = -3.0e38f; for (int j = 0; j <= i; ++j) { const float a = GA[(size_t)(r0 + j) * C::MH + h]; amax = a > amax ? a : amax; }
    const float mrow = bi + (mprev > amax ? mprev : amax);
    const float scale = 1.0f / sqrtf((float)C::MHD);
    const float* q = P + (size_t)r * C::LDP + C::O_Q + h * C::MHD;
    float* S = wsf<C>(p, C::WS_SB) + ((size_t)r * C::MH + h) * C::CH;
    float ssum = 0.f;
    for (int j = 0; j < C::CH; ++j) { float sv = 0.f;
        if (j <= i) { const float* k = P + (size_t)(r0 + j) * C::LDP + C::O_K + h * C::MHD; float dot = 0.f; for (int d = 0; d < C::MHD; ++d) dot += q[d] * k[d];
            sv = dot * scale * expf(bi + GA[(size_t)(r0 + j) * C::MH + h] - mrow); }
        S[j] = sv; ssum += sv; }
    const float iw = expf(bi + mprev - mrow);
    float qn = 0.f; for (int d = 0; d < C::MHD; ++d) qn += q[d] * ml_nprev<C>(p, l, ci, d);
    const float den = ssum + iw * qn, fl = expf(-mrow), ad = fabsf(den);
    wsf<C>(p, C::WS_DEN)[(size_t)r * C::MH + h] = ad > fl ? ad : fl; wsf<C>(p, C::WS_IW)[(size_t)r * C::MH + h] = iw;
}
template <class C> HD inline void st_ml_c2(const Ptrs& p, int l, long item) {
    const int e = (int)(item % C::MHD), h = (int)((item / C::MHD) % C::MH), r = (int)(item / ((long)C::MHD * C::MH));
    int ci, i, lc; chunk_info<C>(r, h, ci, i, lc); const int r0 = r - i;
    const float* P = wsf<C>(p, C::WS_BIG); const float* S = wsf<C>(p, C::WS_SB) + ((size_t)r * C::MH + h) * C::CH;
    float num = 0.f; for (int j = 0; j <= i; ++j) num += S[j] * P[(size_t)(r0 + j) * C::LDP + C::O_VM + h * C::MHD + e];
    const float* q = P + (size_t)r * C::LDP + C::O_Q + h * C::MHD;
    float qc = 0.f; for (int d = 0; d < C::MHD; ++d) qc += q[d] * ml_cprev<C>(p, l, ci, d, e);
    num += wsf<C>(p, C::WS_IW)[(size_t)r * C::MH + h] * qc;
    wsf<C>(p, C::WS_HB)[(size_t)r * C::MW + h * C::MHD + e] = num / wsf<C>(p, C::WS_DEN)[(size_t)r * C::MH + h];
}
template <class C> HD inline void st_ml_c3(const Ptrs& p, int l, long item) {
    const int r = (int)(item / C::MH), h = (int)(item % C::MH);
    const float* hb = wsf<C>(p, C::WS_HB) + (size_t)r * C::MW + h * C::MHD;
    float ss = 0.f; for (int e = 0; e < C::MHD; ++e) ss += hb[e] * hb[e];
    const float rs = 1.0f / sqrtf(ss / C::MHD + 1e-6f);
    const float* g = p.in[I_NG] + (size_t)l * C::MW + h * C::MHD; const float* o = wsf<C>(p, C::WS_BIG) + (size_t)r * C::LDP + C::O_O + h * C::MHD;
    bf16_t* mix = wsb<C>(p, C::WS_MIX) + (size_t)r * C::D + C::PW + C::GW + h * C::MHD;
    for (int e = 0; e < C::MHD; ++e) mix[e] = f2bf(hb[e] * rs * g[e] * sigmoidf_(o[e]));
}
template <class C> HD inline const float* mem_kv(const Ptrs& p, int l, int r, bool isv, int m) {
    bool s; int b, t; row_info<C>(r, s, b, t);
    if (s) return p.in[isv ? I_CV : I_CK] + (((size_t)l * C::DEC_BATCH + b) * C::NMEM + m) * C::D;
    return p.out + (isv ? C::OUT_MV : C::OUT_MK) + (((size_t)l * C::BATCH + b) * C::NMEM + m) * C::D;
}
template <class C> HD inline void st_at_s(const Ptrs& p, int l, long item) {
    const int m = (int)(item % C::NMEM), hd = (int)((item / C::NMEM) % C::AH), r = (int)(item / ((long)C::NMEM * C::AH));
    const bf16_t* q = wsb<C>(p, C::WS_Q) + (size_t)r * C::D + hd * C::AHD; const float* k = mem_kv<C>(p, l, r, false, m) + hd * C::AHD;
    float acc = 0.f; for (int d = 0; d < C::AHD; ++d) acc += bf2f(q[d]) * k[d];
    wsf<C>(p, C::WS_SC)[((size_t)r * C::AH + hd) * C::NMEM + m] = acc / sqrtf((float)C::AHD);
}
template <class C> HD inline void st_at_p(const Ptrs& p, int l, long item) {
    float* sc = wsf<C>(p, C::WS_SC) + (size_t)item * C::NMEM;
    float mx = -3.0e38f; for (int m = 0; m < C::NMEM; ++m) mx = sc[m] > mx ? sc[m] : mx;
    float sum = 0.f; for (int m = 0; m < C::NMEM; ++m) { const float e = expf(sc[m] - mx); sc[m] = e; sum += e; }
    const float inv = 1.0f / sum; for (int m = 0; m < C::NMEM; ++m) sc[m] *= inv;
}
template <class C> HD inline void st_at_o(const Ptrs& p, int l, long item) {
    const int col = (int)(item % C::D), r = (int)(item / C::D), hd = col / C::AHD;
    const float* sc = wsf<C>(p, C::WS_SC) + ((size_t)r * C::AH + hd) * C::NMEM; const float* v0 = mem_kv<C>(p, l, r, true, 0) + col;
    float acc = 0.f; for (int m = 0; m < C::NMEM; ++m) acc += sc[m] * v0[(size_t)m * C::D];
    wsb<C>(p, C::WS_AO)[(size_t)r * C::D + col] = f2bf(acc);
}
template <class C> HD inline void st_final(const Ptrs& p, int r) {
    const float* X = wsf<C>(p, C::WS_X) + (size_t)r * C::D; const float rs = 1.0f / sqrtf(wsf<C>(p, C::WS_SS)[(size_t)(C::NSS - 1) * C::M + r] / C::D + 1e-6f);
    float* o = r < C::MP ? p.out + C::OUT_YP + (size_t)r * C::D : p.out + C::OUT_YS + (size_t)(r - C::MP) * C::D;
    for (int k = 0; k < C::D; ++k) o[k] = X[k] * rs * p.in[I_GFIN][k];
}

namespace pg8 {
#define PG8_LAS __attribute__((address_space(3)))
typedef unsigned short bf16_t;
typedef short bf16x8 __attribute__((ext_vector_type(8)));
typedef float f32x4 __attribute__((ext_vector_type(4)));
typedef unsigned u32x4 __attribute__((ext_vector_type(4)));
constexpr int BM = 256, BK = 64, HALF = 128, HTB = HALF * BK * 2  , STAGE_BYTES = 8 * HTB, NXCD = 8, WGM = 8;

__host__ __device__ __forceinline__ int lds_byte(int r, int c) { const int st = (r >> 4) * 2 + (c >> 5), rr = r & 15, cc = c & 31, ob = rr * 64 + cc * 2; return st * 1024 + (ob ^ (((ob >> 9) & 1) << 5)); }
__host__ __device__ __forceinline__ void stage_rc(int b, int& R, int& C) { const int st = b / 1024, sb = b % 1024, swz = sb ^ (((sb >> 9) & 1) << 5); R = (st >> 1) * 16 + swz / 64; C = (st & 1) * 32 + (swz % 64) / 2; }
__host__ __device__ __forceinline__ int perm32(int rho) { const int n = rho >> 4, i = rho & 15; return 8 * (i >> 2) + 4 * n + (i & 3); }

struct Unit { int pm, pn; };
struct Gemm { const bf16_t* A; const bf16_t* Bt; int M, N, K; };

struct StaticOrder {
    int nM, nN, nwg, G, c;
    __host__ __device__ void init(int M, int N, int G_, int c_) { nM = M / BM; nN = N / BM; nwg = nM * nN; G = G_; c = c_; }
    __host__ __device__ bool next(int i, Unit& u) const {
        const long L = (long)i * G + c; if (L >= nwg) return false;
        int wgid = (int)L; { const int q = nwg / NXCD, r = nwg % NXCD, xcd = wgid % NXCD, off = wgid / NXCD; wgid = (xcd < r ? xcd * (q + 1) : r * (q + 1) + (xcd - r) * q) + off; }
        const int nig = WGM * nN, gid = wgid / nig, fm = gid * WGM, gsz = (nM - fm) < WGM ? (nM - fm) : WGM;
        u.pm = fm + ((wgid % nig) % gsz); u.pn = (wgid % nig) / gsz; return true;
    }
    __device__ __forceinline__ void a_ready(const Unit&) const {}
    __device__ __forceinline__ void done(const Unit&) const {}
};
__device__ __forceinline__ unsigned cvt_pk_bf16(float lo, float hi) { unsigned r; asm volatile("v_cvt_pk_bf16_f32 %0, %1, %2" : "=v"(r) : "v"(lo), "v"(hi)); return r; }
typedef float f32x2 __attribute__((ext_vector_type(2)));
template <class Epi, class Sched, bool STAMP = false>
__device__ __forceinline__ void gemm_phase(PG8_LAS unsigned char* lds, const Gemm g, const Sched& S, const Epi& E, unsigned long long* stamps) {
    int tid_l = threadIdx.x; asm volatile("" : "+v"(tid_l));
    const int tid = tid_l, wid = __builtin_amdgcn_readfirstlane(tid >> 6), lane = tid & 63, wr = wid >> 2, wc = wid & 3, fr = lane & 15, fq = lane >> 4;
    const int K = g.K, nt = K / BK;
    int ts_lo = 0, ts_hi = 0, nts = 0; const unsigned long long rt_entry = STAMP ? (unsigned long long)wall_clock64() : 0ull;
#define PG8_STAMP() do { if (STAMP && wid == 0 && nts < 64) { const unsigned long long _c = (unsigned long long)clock64(); \
        ts_lo = (lane == nts) ? (int)(unsigned)_c : ts_lo; ts_hi = (lane == nts) ? (int)(unsigned)(_c >> 32) : ts_hi; ++nts; } } while (0)
    PG8_STAMP();
    unsigned voffA[2], voffB[2];
#pragma unroll
    for (int i = 0; i < 2; ++i) { int R, C; stage_rc(tid * 16 + i * 8192, R, C); const int Rb = Epi::PERM ? ((R & ~31) + perm32(R & 31)) : R;
        voffA[i] = (unsigned)(R * K + C) * 2u; voffB[i] = (unsigned)(Rb * K + C) * 2u; }
    const size_t kstep = (size_t)(BK * 2);
    const size_t hstep = (size_t)HALF * K * 2;
    const size_t tstep = 2 * hstep;
    const unsigned ldsw = (unsigned)wid * 1024u;
    const int aoff = lds_byte(wr * 64 + fr, fq * 8), boff = lds_byte(wc * 32 + fr, fq * 8);
#define PG8_SA(b, h) (((b) * 2 + (h)) * HTB)
#define PG8_SB(b, h) ((4 + (b) * 2 + (h)) * HTB)
#define PG8_STAGE(bufoff, gbase, voff) do { _Pragma("unroll") for (int _i = 0; _i < 2; ++_i) \
        __builtin_amdgcn_global_load_lds((const unsigned*)((const char*)(gbase) + (voff)[_i]), (PG8_LAS unsigned*)(lds + (bufoff) + ldsw + _i * 8192), 16, 0, 0); } while (0)
#define PG8_LDA(dst, b, h) do { _Pragma("unroll") for (int m = 0; m < 4; ++m) _Pragma("unroll") for (int k = 0; k < 2; ++k) dst[m][k] = *(const PG8_LAS bf16x8*)(lds + PG8_SA(b, h) + aoff + m * 2048 + k * 1024); } while (0)
#define PG8_LDB(dst, b, h) do { _Pragma("unroll") for (int n = 0; n < 2; ++n) _Pragma("unroll") for (int k = 0; k < 2; ++k) dst[n][k] = *(const PG8_LAS bf16x8*)(lds + PG8_SB(b, h) + boff + n * 2048 + k * 1024); } while (0)
#define PG8_MMA(ai, bj, At, Bt) do { __builtin_amdgcn_s_setprio(1); _Pragma("unroll") for (int m = 0; m < 4; ++m) _Pragma("unroll") for (int n = 0; n < 2; ++n) _Pragma("unroll") for (int k = 0; k < 2; ++k) \
        acc[ai][bj][m][n] = __builtin_amdgcn_mfma_f32_16x16x32_bf16(Bt[n][k], At[m][k], acc[ai][bj][m][n], 0, 0, 0); __builtin_amdgcn_s_setprio(0); } while (0)
#define PG8_WAIT_V(n) asm volatile("s_waitcnt vmcnt(" #n ")" ::: "memory")
#define PG8_WAIT_L(n) asm volatile("s_waitcnt lgkmcnt(" #n ")" ::: "memory")
#define PG8_BAR __builtin_amdgcn_s_barrier()
#define PG8_SCHED __builtin_amdgcn_sched_barrier(0)
    Unit cur, nxt; int ui = 0;
    if (!S.next(0, cur)) return;
    f32x4 acc[2][2][4][2];
#pragma unroll
    for (int a = 0; a < 2; ++a)
#pragma unroll
        for (int b = 0; b < 2; ++b)
#pragma unroll
            for (int m = 0; m < 4; ++m)
#pragma unroll
                for (int n = 0; n < 2; ++n) acc[a][b][m][n] = (f32x4){0.f, 0.f, 0.f, 0.f};
    bf16x8 At[4][2], B0[2][2], B1[2][2];
    const char* cA = (const char*)g.A + (size_t)cur.pm * tstep; const char* cB = (const char*)g.Bt + (size_t)cur.pn * tstep;
    S.a_ready(cur);
    PG8_STAGE(PG8_SB(0, 0), cB, voffB); PG8_STAGE(PG8_SA(0, 0), cA, voffA); PG8_STAGE(PG8_SB(0, 1), cB + hstep, voffB); PG8_STAGE(PG8_SA(0, 1), cA + hstep, voffA);
    if (wr == 1) PG8_BAR;
    PG8_WAIT_V(4); PG8_BAR;
    PG8_STAGE(PG8_SB(1, 0), cB + kstep, voffB); PG8_STAGE(PG8_SA(1, 0), cA + kstep, voffA); PG8_STAGE(PG8_SB(1, 1), cB + hstep + kstep, voffB);
    PG8_WAIT_V(6); PG8_BAR;
    PG8_STAMP();
    for (;;) {
        const bool has_next = S.next(ui + 1, nxt);
        const char* nA = has_next ? (const char*)g.A + (size_t)nxt.pm * tstep : cA; const char* nB = has_next ? (const char*)g.Bt + (size_t)nxt.pn * tstep : cB;
        for (int t = 0; t < nt; t += 2) {
            const bool last = (t == nt - 2);
            const char* a1 = cA + (size_t)(t + 1) * kstep;
            const char* a2 = last ? nA : cA + (size_t)(t + 2) * kstep; const char* b2 = last ? nB : cB + (size_t)(t + 2) * kstep;
            const char* a3 = a2 + kstep; const char* b3 = b2 + kstep;
            if (last && has_next) S.a_ready(nxt);
            PG8_LDB(B0, 0, 0); PG8_SCHED; PG8_LDA(At, 0, 0); PG8_STAGE(PG8_SA(1, 1), a1 + hstep, voffA);
            PG8_WAIT_L(8); PG8_BAR; PG8_WAIT_L(0); PG8_MMA(0, 0, At, B0); PG8_BAR; PG8_SCHED;
            PG8_LDB(B1, 0, 1); PG8_STAGE(PG8_SB(0, 0), b2, voffB);
            PG8_BAR; PG8_WAIT_L(0); PG8_MMA(0, 1, At, B1); PG8_BAR;
            PG8_LDA(At, 0, 1); PG8_STAGE(PG8_SA(0, 0), a2, voffA);
            PG8_BAR; PG8_WAIT_L(0); PG8_MMA(1, 0, At, B0); PG8_BAR; PG8_SCHED;
            PG8_STAGE(PG8_SB(0, 1), b2 + hstep, voffB);
            PG8_WAIT_V(6); PG8_BAR; PG8_MMA(1, 1, At, B1); PG8_BAR;
            PG8_LDB(B0, 1, 0); PG8_SCHED; PG8_LDA(At, 1, 0); PG8_STAGE(PG8_SA(0, 1), a2 + hstep, voffA);
            PG8_WAIT_L(8); PG8_BAR; PG8_WAIT_L(0); PG8_MMA(0, 0, At, B0); PG8_BAR; PG8_SCHED;
            PG8_LDB(B1, 1, 1); PG8_STAGE(PG8_SB(1, 0), b3, voffB);
            PG8_BAR; PG8_WAIT_L(0); PG8_MMA(0, 1, At, B1); PG8_BAR;
            PG8_LDA(At, 1, 1); PG8_STAGE(PG8_SA(1, 0), a3, voffA);
            PG8_BAR; PG8_WAIT_L(0); PG8_MMA(1, 0, At, B0); PG8_BAR; PG8_SCHED;
            PG8_STAGE(PG8_SB(1, 1), b3 + hstep, voffB);
            PG8_WAIT_V(6); PG8_BAR; PG8_MMA(1, 1, At, B1); PG8_BAR;
        }
        PG8_STAMP();
        if constexpr (!Epi::AFTER_DRAIN) { E(acc, cur, wr, wc, fr, fq); S.done(cur); }
        PG8_STAMP();
        if (!has_next) break;
#pragma unroll
        for (int a = 0; a < 2; ++a)
#pragma unroll
            for (int b = 0; b < 2; ++b)
#pragma unroll
                for (int m = 0; m < 4; ++m)
#pragma unroll
                    for (int n = 0; n < 2; ++n) acc[a][b][m][n] = (f32x4){0.f, 0.f, 0.f, 0.f};
        cur = nxt; cA = nA; cB = nB; ++ui;
    }
    PG8_WAIT_V(0);
    if (wr == 0) PG8_BAR;
    PG8_BAR;
    if constexpr (Epi::AFTER_DRAIN) { E.fused(acc, cur, wr, wc, fr, fq, lds, wid, lane); S.done(cur); }
    PG8_STAMP();
    if (STAMP && wid == 0) { stamps[lane] = lane < nts ? (((unsigned long long)(unsigned)ts_hi << 32) | (unsigned)ts_lo) : 0ull;
        if (lane == 62) stamps[62] = rt_entry; if (lane == 63) stamps[63] = (unsigned long long)wall_clock64(); }
#undef PG8_STAMP
#undef PG8_SA
#undef PG8_SB
#undef PG8_STAGE
#undef PG8_LDA
#undef PG8_LDB
#undef PG8_MMA
#undef PG8_WAIT_V
#undef PG8_WAIT_L
#undef PG8_BAR
#undef PG8_SCHED
}
}


#define LAS __attribute__((address_space(3)))
#define XB_TMO      128
#define XB_XCNT(j)  (256  + 64 * (j))
#define XB_XSUB(j)  (1280 + 64 * (j))
#define XB_XGEN(j)  (2304 + 64 * (j))
#define XB_TOP      3328
#define XB_TOPGEN   3392
#define XCD_BAR_WORDS 3456
#define XB_SPIN_CAP (1u << 18)

__device__ __forceinline__ unsigned xb_ld(unsigned* p)              { return __hip_atomic_load(p, __ATOMIC_RELAXED, __HIP_MEMORY_SCOPE_AGENT); }
__device__ __forceinline__ unsigned xb_add(unsigned* p, unsigned v) { return __hip_atomic_fetch_add(p, v, __ATOMIC_RELAXED, __HIP_MEMORY_SCOPE_AGENT); }
__device__ __forceinline__ unsigned xb_xcc_id() { return (unsigned)__builtin_amdgcn_s_getreg((3 << 11) | 20) & 0xFu; }
#define XB_SPIN(cond, bar) do { unsigned _sp = 0; while (cond) { __builtin_amdgcn_s_sleep(1); \
    if ((++_sp & 255u) == 0u) { if (xb_ld(&(bar)[XB_TMO])) break; if (_sp > XB_SPIN_CAP) { atomicAdd(&(bar)[XB_TMO], 1u); break; } } } } while (0)

struct XcdBarrier {
    unsigned* bar; unsigned x;
    volatile LAS unsigned* st;
};

__device__ __forceinline__ XcdBarrier xcd_barrier_post(unsigned* bar, volatile LAS unsigned* st) {
    XcdBarrier b; b.bar = bar; b.x = xb_xcc_id(); b.st = st;
    if (threadIdx.x == 0) (void)xb_add(&bar[XB_XCNT(b.x)], 1u);
    return b;
}
__device__ __forceinline__ void xcd_barrier_complete(unsigned* bar, unsigned x, unsigned& nloc, unsigned& nx) {
    const unsigned G = gridDim.x * gridDim.y * gridDim.z;
    unsigned sum, cnt, mine, sp = 0u;
    for (;;) {
        sum = 0u; cnt = 0u; mine = 0u;
#pragma unroll
        for (unsigned j = 0; j < 16; ++j) { const unsigned c = xb_ld(&bar[XB_XCNT(j)]); sum += c; cnt += (c > 0u) ? 1u : 0u; mine = (j == x) ? c : mine; }
        if (sum == G) break;
        __builtin_amdgcn_s_sleep(1);
        if ((++sp & 255u) == 0u) { if (xb_ld(&bar[XB_TMO])) break; if (sp > XB_SPIN_CAP) { atomicAdd(&bar[XB_TMO], 1u); break; } }
    }
    nloc = mine > 0u ? mine : 1u; nx = cnt > 0u ? cnt : 1u;
}

__device__ __forceinline__ void xcd_barrier(const XcdBarrier& b) {
    asm volatile("s_waitcnt vmcnt(0)" ::: "memory");
    __syncthreads();
    if (threadIdx.x == 0) {
        unsigned* bar = b.bar;
        __builtin_amdgcn_s_waitcnt(0);
        unsigned nloc = b.st[0], nx = b.st[1];
        if (nloc == 0u) { xcd_barrier_complete(bar, b.x, nloc, nx); b.st[0] = nloc; b.st[1] = nx; }
        const unsigned old = xb_add(&bar[XB_XSUB(b.x)], 1u);
        const unsigned gen = old / nloc;
        if (old + 1u == (gen + 1u) * nloc) {
            __builtin_amdgcn_fence(__ATOMIC_RELEASE, "agent");
            asm volatile("s_waitcnt vmcnt(0)" ::: "memory");
            const unsigned og = xb_add(&bar[XB_TOP], 1u);
            const unsigned tg = og / nx;
            if (og + 1u == (tg + 1u) * nx) xb_add(&bar[XB_TOPGEN], 1u);
            else XB_SPIN(xb_ld(&bar[XB_TOPGEN]) == tg, bar);
            __builtin_amdgcn_fence(__ATOMIC_ACQUIRE, "agent");
            xb_add(&bar[XB_XGEN(b.x)], 1u);
            asm volatile("s_waitcnt vmcnt(0)" ::: "memory");
        } else {
            XB_SPIN(xb_ld(&bar[XB_XGEN(b.x)]) == gen, bar);
            __builtin_amdgcn_fence(__ATOMIC_ACQUIRE, "agent");
            asm volatile("s_waitcnt vmcnt(0)" ::: "memory");
        }
    }
    __syncthreads();
}

typedef CfgT<RC> C;
constexpr int NTHREADS = 512, NWAVES = 8;
constexpr int LDS_STAGE = 131072, LDS_CTL = LDS_STAGE, LDS_BYTES = LDS_STAGE + 256;

namespace pg8 {
typedef unsigned u32x2 __attribute__((ext_vector_type(2)));
__device__ __forceinline__ float silu_f(float g) { return g * __builtin_amdgcn_rcpf(1.0f + __expf(-g)); }
struct EpiSwiGLU { static constexpr bool PERM = true, AFTER_DRAIN = false;
    bf16_t* act; const float* ss; int ff; float invd;
    __device__ __forceinline__ void operator()(const f32x4 (&acc)[2][2][4][2], const Unit& u, int wr, int wc, int fr, int fq) const {
        const int row0 = u.pm * BM + wr * 64 + fr, col = u.pn * 128 + wc * 32 + 8 * fq;
#pragma unroll
        for (int ai = 0; ai < 2; ++ai)
#pragma unroll
            for (int m = 0; m < 4; ++m) { const int row = row0 + ai * HALF + m * 16; const float rs = rsqrtf(ss[row] * invd + 1e-6f);
                f32x4 v[2];
#pragma unroll
                for (int n = 0; n < 2; ++n) { const f32x4 g = acc[ai][0][m][n] * rs, up = acc[ai][1][m][n] * rs;
#pragma unroll
                    for (int j = 0; j < 4; ++j) v[n][j] = silu_f(g[j]) * up[j]; }
                u32x4 w; w.x = cvt_pk_bf16(v[0][0], v[0][1]); w.y = cvt_pk_bf16(v[0][2], v[0][3]); w.z = cvt_pk_bf16(v[1][0], v[1][1]); w.w = cvt_pk_bf16(v[1][2], v[1][3]);
                *(u32x4*)(act + (size_t)row * ff + col) = w; }
    }
};
struct EpiResid { static constexpr bool PERM = false, AFTER_DRAIN = false;
    float* X; bf16_t* XB; float* ssout; float scale; int ld;
    __device__ __forceinline__ void operator()(const f32x4 (&acc)[2][2][4][2], const Unit& u, int wr, int wc, int fr, int fq) const {
        const int row0 = u.pm * BM + wr * 64 + fr, col0 = u.pn * BM + wc * 32 + 4 * fq;
#pragma unroll
        for (int ai = 0; ai < 2; ++ai)
#pragma unroll
            for (int m = 0; m < 4; ++m) { const int row = row0 + ai * HALF + m * 16; float* xr = X + (size_t)row * ld + col0; bf16_t* br = XB + (size_t)row * ld + col0; float s = 0.f;
#pragma unroll
                for (int bj = 0; bj < 2; ++bj)
#pragma unroll
                    for (int n = 0; n < 2; ++n) { f32x4 x = *(const f32x4*)(xr + bj * HALF + n * 16) + acc[ai][bj][m][n] * scale; *(f32x4*)(xr + bj * HALF + n * 16) = x;
                        u32x2 w; w.x = cvt_pk_bf16(x[0], x[1]); w.y = cvt_pk_bf16(x[2], x[3]); *(u32x2*)(br + bj * HALF + n * 16) = w;
                        s += (x[0] * x[0] + x[1] * x[1]) + (x[2] * x[2] + x[3] * x[3]); }
                s += __shfl_xor(s, 16); s += __shfl_xor(s, 32);
                if (fq == 0) unsafeAtomicAdd(ssout + row, s); }
    }
};
struct EpiScaleF32 { static constexpr bool PERM = false, AFTER_DRAIN = false;
    float* Cp; int ldc; const float* ss; float invd;
    __device__ __forceinline__ void operator()(const f32x4 (&acc)[2][2][4][2], const Unit& u, int wr, int wc, int fr, int fq) const {
        const int row0 = u.pm * BM + wr * 64 + fr, col0 = u.pn * BM + wc * 32 + 4 * fq;
#pragma unroll
        for (int ai = 0; ai < 2; ++ai)
#pragma unroll
            for (int m = 0; m < 4; ++m) { const int row = row0 + ai * HALF + m * 16; const float rs = rsqrtf(ss[row] * invd + 1e-6f); float* cr = Cp + (size_t)row * ldc + col0;
#pragma unroll
                for (int bj = 0; bj < 2; ++bj)
#pragma unroll
                    for (int n = 0; n < 2; ++n) *(f32x4*)(cr + bj * HALF + n * 16) = acc[ai][bj][m][n] * rs; }
    }
};
struct EpiScaleBf16 { static constexpr bool PERM = true, AFTER_DRAIN = false;
    bf16_t* O; int ldc; const float* ss; float invd;
    __device__ __forceinline__ void operator()(const f32x4 (&acc)[2][2][4][2], const Unit& u, int wr, int wc, int fr, int fq) const {
        const int row0 = u.pm * BM + wr * 64 + fr, col0 = u.pn * BM + wc * 32 + 8 * fq;
#pragma unroll
        for (int ai = 0; ai < 2; ++ai)
#pragma unroll
            for (int m = 0; m < 4; ++m) { const int row = row0 + ai * HALF + m * 16; const float rs = rsqrtf(ss[row] * invd + 1e-6f); bf16_t* orow = O + (size_t)row * ldc + col0;
#pragma unroll
                for (int bj = 0; bj < 2; ++bj) { const f32x4 v0 = acc[ai][bj][m][0] * rs, v1 = acc[ai][bj][m][1] * rs;
                    u32x4 w; w.x = cvt_pk_bf16(v0[0], v0[1]); w.y = cvt_pk_bf16(v0[2], v0[3]); w.z = cvt_pk_bf16(v1[0], v1[1]); w.w = cvt_pk_bf16(v1[2], v1[3]);
                    *(u32x4*)(orow + bj * HALF) = w; } }
    }
};
struct EpiMemKV { static constexpr bool PERM = false, AFTER_DRAIN = false;
    float* K; float* V; const float* rstd; int d;
    __device__ __forceinline__ void operator()(const f32x4 (&acc)[2][2][4][2], const Unit& u, int wr, int wc, int fr, int fq) const {
        const int row0 = u.pm * BM + wr * 64 + fr; int ct = u.pn * BM; float* base = K; if (ct >= d) { base = V; ct -= d; }
        const int col0 = ct + wc * 32 + 4 * fq;
#pragma unroll
        for (int ai = 0; ai < 2; ++ai)
#pragma unroll
            for (int m = 0; m < 4; ++m) { const int row = row0 + ai * HALF + m * 16; const float rs = rstd[row]; float* cr = base + (size_t)row * d + col0;
#pragma unroll
                for (int bj = 0; bj < 2; ++bj)
#pragma unroll
                    for (int n = 0; n < 2; ++n) *(f32x4*)(cr + bj * HALF + n * 16) = acc[ai][bj][m][n] * rs; }
    }
};
}

__device__ __forceinline__ unsigned pk2bf(float lo, float hi) { return pg8::cvt_pk_bf16(lo, hi); }
__device__ __forceinline__ void prep_item(const float* W, int K, int Ncols, const float* g, int kind, int N, bf16_t* Bt, LAS float* scr, int item, int lane) {
    const int nblk = N / 32, kb = item / nblk, nb = item % nblk, k0 = 64 * kb, n0 = 32 * nb;
    const int sc = wsrc_col<C>(kind, n0 + (lane & 31));
#pragma unroll 8
    for (int i = 0; i < 32; ++i) { const int kk = 2 * i + (lane >> 5); float v = 0.f;
        if (sc >= 0) { v = W[(size_t)(k0 + kk) * Ncols + sc]; if (g) v *= g[k0 + kk]; }
        scr[kk * 33 + (lane & 31)] = v; }
    asm volatile("s_waitcnt lgkmcnt(0)" ::: "memory");
    const int c = lane & 7;
#pragma unroll
    for (int j = 0; j < 4; ++j) { const int n = (lane >> 3) + 8 * j; const LAS float* s = scr + (8 * c) * 33 + n;
        pg8::u32x4 o; o.x = pk2bf(s[0 * 33], s[1 * 33]); o.y = pk2bf(s[2 * 33], s[3 * 33]); o.z = pk2bf(s[4 * 33], s[5 * 33]); o.w = pk2bf(s[6 * 33], s[7 * 33]);
        *(pg8::u32x4*)(Bt + (size_t)(n0 + n) * K + k0 + 8 * c) = o; }
    asm volatile("s_waitcnt lgkmcnt(0)" ::: "memory");
}
struct WDesc { const float* W; const float* g; bf16_t* dst; int K, Ncols, kind, N; };
__device__ __forceinline__ WDesc wdesc(const Ptrs& p, int l, int idx) {
    WDesc d; d.g = nullptr; d.kind = WK_PLAIN;
    switch (idx) {
    case 0: d.W = p.in[I_W1IN] + (size_t)l * C::D * 2 * C::FF; d.K = C::D; d.Ncols = 2 * C::FF; d.N = 2 * C::FF; d.g = p.in[I_GFFN1] + l * C::D; d.kind = WK_FFNIN; d.dst = wlayer<C>(p, l, C::W_1IN); break;
    case 1: d.W = p.in[I_W1OUT] + (size_t)l * C::FF * C::D; d.K = C::FF; d.Ncols = C::D; d.N = C::D; d.dst = wlayer<C>(p, l, C::W_1OUT); break;
    case 2: d.W = p.in[I_WIN] + (size_t)l * C::D * C::INC; d.K = C::D; d.Ncols = C::INC; d.N = C::LDP; d.g = p.in[I_GMIX] + l * C::D; d.kind = WK_WIN; d.dst = wlayer<C>(p, l, C::W_IN); break;
    case 3: d.W = p.in[I_WOUT] + (size_t)l * C::D * C::D; d.K = C::D; d.Ncols = C::D; d.N = C::D; d.dst = wlayer<C>(p, l, C::W_OUT); break;
    case 4: d.W = p.in[I_WQ] + (size_t)l * C::D * C::D; d.K = C::D; d.Ncols = C::D; d.N = C::D; d.g = p.in[I_GX] + l * C::D; d.dst = wlayer<C>(p, l, C::W_Q); break;
    case 5: d.W = p.in[I_WK] + (size_t)l * C::D * C::D; d.K = C::D; d.Ncols = C::D; d.N = C::D; d.g = p.in[I_GMEM] + l * C::D; d.dst = wlayer<C>(p, l, C::W_KV); break;
    case 6: d.W = p.in[I_WV] + (size_t)l * C::D * C::D; d.K = C::D; d.Ncols = C::D; d.N = C::D; d.g = p.in[I_GMEM] + l * C::D; d.dst = wlayer<C>(p, l, C::W_KV) + (size_t)C::D * C::D; break;
    case 7: d.W = p.in[I_WO] + (size_t)l * C::D * C::D; d.K = C::D; d.Ncols = C::D; d.N = C::D; d.dst = wlayer<C>(p, l, C::W_O); break;
    case 8: d.W = p.in[I_W2IN] + (size_t)l * C::D * 2 * C::FF; d.K = C::D; d.Ncols = 2 * C::FF; d.N = 2 * C::FF; d.g = p.in[I_GFFN2] + l * C::D; d.kind = WK_FFNIN; d.dst = wlayer<C>(p, l, C::W_2IN); break;
    default: d.W = p.in[I_W2OUT] + (size_t)l * C::FF * C::D; d.K = C::FF; d.Ncols = C::D; d.N = C::D; d.dst = wlayer<C>(p, l, C::W_2OUT); break;
    }
    return d;
}

namespace att {
typedef short bf16x8 __attribute__((ext_vector_type(8)));
typedef short s16x4 __attribute__((ext_vector_type(4)));
typedef float f32x4 __attribute__((ext_vector_type(4)));
typedef unsigned u32x2 __attribute__((ext_vector_type(2)));
constexpr int TOK = 256, CD = 64, PITCH = 144, CBYTES = TOK * PITCH, HDIM = 512, NH = 4, LD = 2048;
constexpr int NU_P = (C::MP / 128) * NH, NU_S = C::DEC_BATCH * NH, NUNITS = NU_P + NU_S;
static_assert(C::NMEM == TOK && C::AHD == HDIM && C::AH == NH && C::D == LD && C::DEC_SEQ == 32 && C::SEQ % 128 == 0, "attention phase is built for these shapes");
__device__ __forceinline__ s16x4 tr_read(unsigned addr) { s16x4 r; asm volatile("ds_read_b64_tr_b16 %0, %1" : "=&v"(r) : "v"(addr) : "memory"); return r; }
__device__ __forceinline__ void stage_load(f32x4 (&r)[8], const float* src, int tid) {
#pragma unroll
    for (int i = 0; i < 8; ++i) { const int f = tid + 512 * i; r[i] = *(const f32x4*)(src + (size_t)(f >> 4) * LD + (f & 15) * 4); }
}
__device__ __forceinline__ void stage_store(const f32x4 (&r)[8], LAS unsigned char* buf, int tid) {
#pragma unroll
    for (int i = 0; i < 8; ++i) { const int f = tid + 512 * i; u32x2 w; w.x = pg8::cvt_pk_bf16(r[i][0], r[i][1]); w.y = pg8::cvt_pk_bf16(r[i][2], r[i][3]);
        *(LAS u32x2*)(buf + (f >> 4) * PITCH + (f & 15) * 8) = w; }
}
__device__ __forceinline__ void attn_phase(LAS unsigned char* lds, const Ptrs& p, int l, int tid) {
    const int lane = tid & 63, wave = __builtin_amdgcn_readfirstlane(tid >> 6), li = lane & 15, g = lane >> 4;
    const bf16_t* Qg = wsb<C>(p, C::WS_Q); bf16_t* AO = wsb<C>(p, C::WS_AO);
    for (int u = blockIdx.x; u < NUNITS; u += gridDim.x) {
        int row0, nrows, head; const float* kb; const float* vb;
        if (u < NU_P) { const int b = u / (NU_P / C::BATCH), rem = u % (NU_P / C::BATCH); head = rem / (C::SEQ / 128); const int qt = rem % (C::SEQ / 128);
            row0 = b * C::SEQ + qt * 128; nrows = 128;
            kb = p.out + C::OUT_MK + ((size_t)l * C::BATCH + b) * TOK * LD + head * HDIM; vb = p.out + C::OUT_MV + ((size_t)l * C::BATCH + b) * TOK * LD + head * HDIM; }
        else { const int s = u - NU_P, b = s / NH; head = s % NH; row0 = C::MP + b * C::DEC_SEQ; nrows = C::DEC_SEQ;
            kb = p.in[I_CK] + ((size_t)l * C::DEC_BATCH + b) * TOK * LD + head * HDIM; vb = p.in[I_CV] + ((size_t)l * C::DEC_BATCH + b) * TOK * LD + head * HDIM; }
        const bool active = wave * 16 < nrows;
        const int qrow = row0 + wave * 16 + li;
        bf16x8 qf[16];
        if (active) {
#pragma unroll
            for (int ks = 0; ks < 16; ++ks) qf[ks] = *(const bf16x8*)(Qg + (size_t)qrow * LD + head * HDIM + ks * 32 + g * 8);
        } else {
#pragma unroll
            for (int ks = 0; ks < 16; ++ks) qf[ks] = (bf16x8){0, 0, 0, 0, 0, 0, 0, 0};
        }
        f32x4 s[16];
#pragma unroll
        for (int T = 0; T < 16; ++T) s[T] = (f32x4){0.f, 0.f, 0.f, 0.f};
        f32x4 pre[8];
        stage_load(pre, kb, tid); stage_store(pre, lds, tid);
        __syncthreads();
#pragma unroll
        for (int c = 0; c < 8; ++c) {
            LAS unsigned char* buf = lds + (c & 1) * CBYTES;
            stage_load(pre, c < 7 ? kb + (c + 1) * CD : vb, tid);
            if (active) {
#pragma unroll
                for (int ks = 0; ks < 2; ++ks)
#pragma unroll
                    for (int T = 0; T < 16; ++T) { const bf16x8 a = *(const LAS bf16x8*)(buf + (T * 16 + li) * PITCH + ks * 64 + g * 16);
                        s[T] = __builtin_amdgcn_mfma_f32_16x16x32_bf16(a, qf[2 * c + ks], s[T], 0, 0, 0); }
            }
            stage_store(pre, lds + ((c + 1) & 1) * CBYTES, tid);
            __syncthreads();
        }
        float mx = -3.0e38f;
#pragma unroll
        for (int T = 0; T < 16; ++T) { mx = fmaxf(mx, fmaxf(fmaxf(s[T][0], s[T][1]), fmaxf(s[T][2], s[T][3]))); }
        mx = fmaxf(mx, __shfl_xor(mx, 16)); mx = fmaxf(mx, __shfl_xor(mx, 32));
        const float sc = 0.044194173824159216f * 1.4426950408889634f;
        float sum = 0.f;
#pragma unroll
        for (int T = 0; T < 16; ++T)
#pragma unroll
            for (int j = 0; j < 4; ++j) { const float e = __builtin_amdgcn_exp2f((s[T][j] - mx) * sc); s[T][j] = e; sum += e; }
        sum += __shfl_xor(sum, 16); sum += __shfl_xor(sum, 32);
        const float inv = 1.0f / sum;
        bf16x8 pf[8];
#pragma unroll
        for (int t = 0; t < 8; ++t) { const unsigned w0 = pg8::cvt_pk_bf16(s[2 * t][0], s[2 * t][1]), w1 = pg8::cvt_pk_bf16(s[2 * t][2], s[2 * t][3]),
                w2 = pg8::cvt_pk_bf16(s[2 * t + 1][0], s[2 * t + 1][1]), w3 = pg8::cvt_pk_bf16(s[2 * t + 1][2], s[2 * t + 1][3]);
            pg8::u32x4 w; w.x = w0; w.y = w1; w.z = w2; w.w = w3; pf[t] = __builtin_bit_cast(bf16x8, w); }
        const unsigned trb = (unsigned)(size_t)lds + (unsigned)((4 * g + (li >> 2)) * PITCH + (li & 3) * 8);
        for (int c = 0; c < 8; ++c) {
            const unsigned bofs = (unsigned)(c & 1) * CBYTES;
            if (c < 7) stage_load(pre, vb + (c + 1) * CD, tid);
            if (active) {
                f32x4 o[4];
#pragma unroll
                for (int dt = 0; dt < 4; ++dt) o[dt] = (f32x4){0.f, 0.f, 0.f, 0.f};
#pragma unroll
                for (int t = 0; t < 8; ++t) {
                    s16x4 lo[4], hi[4];
#pragma unroll
                    for (int dt = 0; dt < 4; ++dt) { lo[dt] = tr_read(trb + bofs + (unsigned)(t * 32 * PITCH + dt * 32)); hi[dt] = tr_read(trb + bofs + (unsigned)(t * 32 * PITCH + 16 * PITCH + dt * 32)); }
                    asm volatile("s_waitcnt lgkmcnt(0)" ::: "memory"); __builtin_amdgcn_sched_barrier(0);
#pragma unroll
                    for (int dt = 0; dt < 4; ++dt) { const bf16x8 a = (bf16x8){lo[dt][0], lo[dt][1], lo[dt][2], lo[dt][3], hi[dt][0], hi[dt][1], hi[dt][2], hi[dt][3]};
                        o[dt] = __builtin_amdgcn_mfma_f32_16x16x32_bf16(a, pf[t], o[dt], 0, 0, 0); }
                }
#pragma unroll
                for (int dt = 0; dt < 4; ++dt) { u32x2 w; w.x = pg8::cvt_pk_bf16(o[dt][0] * inv, o[dt][1] * inv); w.y = pg8::cvt_pk_bf16(o[dt][2] * inv, o[dt][3] * inv);
                    *(u32x2*)(AO + (size_t)qrow * LD + head * HDIM + c * CD + dt * 16 + g * 4) = w; }
            }
            if (c < 7) stage_store(pre, lds + ((c + 1) & 1) * CBYTES, tid);
            __syncthreads();
        }
    }
}
}
namespace mx {
typedef att::bf16x8 bf16x8; typedef att::s16x4 s16x4; typedef att::f32x4 f32x4; typedef att::u32x2 u32x2;
constexpr int PT = 272;
constexpr int T64 = 64 * PT, T128 = 128 * PT;
static_assert(C::MHD == 128 && C::CH == 64 && C::MH == 8 && C::LCS == 32, "mLSTM phases are built for these shapes");
__device__ __forceinline__ void lds_wait() { asm volatile("s_waitcnt lgkmcnt(0)" ::: "memory"); __builtin_amdgcn_sched_barrier(0); }
__device__ __forceinline__ bf16x8 mk8(s16x4 lo, s16x4 hi) { return (bf16x8){lo[0], lo[1], lo[2], lo[3], hi[0], hi[1], hi[2], hi[3]}; }
__device__ __forceinline__ unsigned tr_addr(unsigned tile, int krow, int c0, int li) { return tile + (unsigned)((krow + (li >> 2)) * PT + (c0 + 4 * (li & 3)) * 2); }
__device__ __forceinline__ void ch_decode(int ci, int& r0, int& h, int& lc) {
    if (ci < C::NPC) { const int c = ci % C::NC, bh = ci / C::NC; h = bh % C::MH; r0 = (bh / C::MH) * C::SEQ + c * C::CH; lc = C::CH; }
    else { const int q = ci - C::NPC; h = q % C::MH; r0 = C::MP + (q / C::MH) * C::DEC_SEQ; lc = C::LCS; }
}
__device__ __forceinline__ void stage64(LAS unsigned char* tile, const float* src, int ld, int lc, int tid, const LAS float* rs, float mul) {
#pragma unroll
    for (int i = 0; i < 4; ++i) { const int f = tid + 512 * i, row = f >> 5, c4 = f & 31; f32x4 v = (f32x4){0.f, 0.f, 0.f, 0.f};
        if (row < lc) { v = *(const f32x4*)(src + (size_t)row * ld + c4 * 4); const float m = rs ? rs[row] * mul : mul; v = v * m; }
        u32x2 w; w.x = pg8::cvt_pk_bf16(v[0], v[1]); w.y = pg8::cvt_pk_bf16(v[2], v[3]); *(LAS u32x2*)(tile + row * PT + c4 * 8) = w; }
}
__device__ __forceinline__ void ml_phase_a(LAS unsigned char* lds, const Ptrs& p, int l, int tid) {
    const int lane = tid & 63, wave = __builtin_amdgcn_readfirstlane(tid >> 6), li = lane & 15, g = lane >> 4;
    LAS unsigned char* Ks = lds; LAS unsigned char* Vs = lds + T64; LAS float* wts = (LAS float*)(lds + 2 * T64);
    const float* P = wsf<C>(p, C::WS_BIG);
    for (int ci = blockIdx.x; ci < C::NCH; ci += gridDim.x) {
        int r0, h, lc; ch_decode(ci, r0, h, lc);
        if (wave == 0) {
            float lf = 0.f, ig = -3.0e38f;
            if (lane < lc) { const float* pr = P + (size_t)(r0 + lane) * C::LDP; ig = pr[C::O_IG + h] + p.in[I_IB][l * C::MH + h]; lf = logsigmoidf_(pr[C::O_FG + h] + p.in[I_FB][l * C::MH + h]); }
            float b = lf;
#pragma unroll
            for (int o = 1; o < 64; o <<= 1) { const float t = __shfl_up(b, o); if (lane >= o) b += t; }
            const float a = lane < lc ? ig - b : -3.0e38f;
            float amax = a;
#pragma unroll
            for (int o = 1; o < 64; o <<= 1) amax = fmaxf(amax, __shfl_xor(amax, o));
            const float bL = __shfl(b, lc - 1), mloc = bL + amax;
            const float wt = lane < lc ? __expf(bL + a - mloc) : 0.f;
            wts[lane] = wt;
            if (lane < lc) { wsf<C>(p, C::WS_GB)[(size_t)(r0 + lane) * C::MH + h] = b; wsf<C>(p, C::WS_GA)[(size_t)(r0 + lane) * C::MH + h] = a; }
            if (lane == 0) { wsf<C>(p, C::WS_CBL)[ci] = bL; wsf<C>(p, C::WS_CML)[ci] = mloc; }
        }
        __syncthreads();
        stage64(Ks, P + (size_t)r0 * C::LDP + C::O_K + h * C::MHD, C::LDP, lc, tid, wts, 0.08838834764831845f);
        stage64(Vs, P + (size_t)r0 * C::LDP + C::O_VM + h * C::MHD, C::LDP, lc, tid, nullptr, 1.0f);
        __syncthreads();
        f32x4 acc[8];
#pragma unroll
        for (int et = 0; et < 8; ++et) acc[et] = (f32x4){0.f, 0.f, 0.f, 0.f};
        const unsigned ks = (unsigned)(size_t)Ks, vs = (unsigned)(size_t)Vs;
#pragma unroll
        for (int t = 0; t < 2; ++t) {
            const s16x4 alo = att::tr_read(tr_addr(ks, 32 * t + 8 * g, 16 * wave, li)), ahi = att::tr_read(tr_addr(ks, 32 * t + 8 * g + 4, 16 * wave, li));
            s16x4 blo[8], bhi[8];
#pragma unroll
            for (int et = 0; et < 8; ++et) { blo[et] = att::tr_read(tr_addr(vs, 32 * t + 8 * g, 16 * et, li)); bhi[et] = att::tr_read(tr_addr(vs, 32 * t + 8 * g + 4, 16 * et, li)); }
            lds_wait();
            const bf16x8 a = mk8(alo, ahi);
#pragma unroll
            for (int et = 0; et < 8; ++et) acc[et] = __builtin_amdgcn_mfma_f32_16x16x32_bf16(a, mk8(blo[et], bhi[et]), acc[et], 0, 0, 0);
        }
        float* DC = wsf<C>(p, C::WS_DC) + (size_t)ci * C::MHD * C::MHD;
#pragma unroll
        for (int et = 0; et < 8; ++et)
#pragma unroll
            for (int r = 0; r < 4; ++r) DC[(size_t)(16 * wave + 4 * g + r) * C::MHD + 16 * et + li] = acc[et][r];
        if (tid < C::MHD) { float s = 0.f; for (int t = 0; t < 64; ++t) s += bf2f(*(const LAS bf16_t*)(Ks + t * PT + tid * 2)); wsf<C>(p, C::WS_DN)[(size_t)ci * C::MHD + tid] = s; }
        __syncthreads();
    }
}
__device__ __forceinline__ void ml_phase_c(LAS unsigned char* lds, const Ptrs& p, int l, int tid) {
    const int lane = tid & 63, wave = __builtin_amdgcn_readfirstlane(tid >> 6), li = lane & 15, g = lane >> 4, it = wave & 3, eh = wave >> 2;
    LAS unsigned char* Qs = lds; LAS unsigned char* Ks = lds + T64; LAS unsigned char* Vs = lds + 2 * T64; LAS unsigned char* Cs = lds + 3 * T64;
    LAS float* sb = (LAS float*)(lds + 3 * T64 + T128);
    LAS float* sa = sb + 64; LAS float* smr = sb + 128; LAS float* siw = sb + 192; LAS float* snp = sb + 256; LAS float* ssq = sb + 384;
    const float* P = wsf<C>(p, C::WS_BIG);
    for (int ci = blockIdx.x; ci < C::NCH; ci += gridDim.x) {
        int r0, h, lc; ch_decode(ci, r0, h, lc);
        const bool sample = ci >= C::NPC, first = !sample && (ci % C::NC) == 0;
        const float mprev = wsf<C>(p, C::WS_MPREV)[ci];
        if (wave == 0) {
            float b = 0.f, a = -3.0e38f;
            if (lane < lc) { b = wsf<C>(p, C::WS_GB)[(size_t)(r0 + lane) * C::MH + h]; a = wsf<C>(p, C::WS_GA)[(size_t)(r0 + lane) * C::MH + h]; }
            float pm = a;
#pragma unroll
            for (int o = 1; o < 64; o <<= 1) { const float t = __shfl_up(pm, o); if (lane >= o) pm = fmaxf(pm, t); }
            const float mrow = b + fmaxf(mprev, pm);
            sb[lane] = b; sa[lane] = a; smr[lane] = mrow; siw[lane] = __expf(b + mprev - mrow);
        }
        if (tid >= 128 && tid < 256) { const int d = tid - 128;
            snp[d] = sample ? p.in[I_SN][((size_t)l * C::NSC + (ci - C::NPC)) * C::MHD + d] : (first ? 0.f : wsf<C>(p, C::WS_DN)[(size_t)(ci - 1) * C::MHD + d]); }
        stage64(Qs, P + (size_t)r0 * C::LDP + C::O_Q + h * C::MHD, C::LDP, lc, tid, nullptr, 1.0f);
        stage64(Ks, P + (size_t)r0 * C::LDP + C::O_K + h * C::MHD, C::LDP, lc, tid, nullptr, 0.08838834764831845f);
        stage64(Vs, P + (size_t)r0 * C::LDP + C::O_VM + h * C::MHD, C::LDP, lc, tid, nullptr, 1.0f);
        { const float* cp = sample ? p.in[I_SC] + ((size_t)l * C::NSC + (ci - C::NPC)) * C::MHD * C::MHD : wsf<C>(p, C::WS_DC) + (size_t)(first ? ci : ci - 1) * C::MHD * C::MHD;
#pragma unroll
            for (int i = 0; i < 8; ++i) { const int f = tid + 512 * i, row = f >> 5, c4 = f & 31; f32x4 v = (f32x4){0.f, 0.f, 0.f, 0.f};
                if (!first) v = *(const f32x4*)(cp + (size_t)row * C::MHD + c4 * 4);
                u32x2 w; w.x = pg8::cvt_pk_bf16(v[0], v[1]); w.y = pg8::cvt_pk_bf16(v[2], v[3]); *(LAS u32x2*)(Cs + row * PT + c4 * 8) = w; } }
        __syncthreads();
        const bool active = it * 16 < lc;
        float ssq_part = 0.f; f32x4 hv[4]; float inv_den = 0.f;
        const int i = 16 * it + li;
        if (active) {
            bf16x8 qf[4];
#pragma unroll
            for (int ks = 0; ks < 4; ++ks) qf[ks] = *(const LAS bf16x8*)(Qs + i * PT + ks * 64 + g * 16);
            f32x4 st[4];
#pragma unroll
            for (int jt = 0; jt < 4; ++jt) st[jt] = (f32x4){0.f, 0.f, 0.f, 0.f};
#pragma unroll
            for (int jt = 0; jt < 4; ++jt) if (jt <= it) {
#pragma unroll
                for (int ks = 0; ks < 4; ++ks) { const bf16x8 a = *(const LAS bf16x8*)(Ks + (16 * jt + li) * PT + ks * 64 + g * 16);
                    st[jt] = __builtin_amdgcn_mfma_f32_16x16x32_bf16(a, qf[ks], st[jt], 0, 0, 0); } }
            const float bi = sb[i], mri = smr[i], iwi = siw[i];
            float dsum = 0.f;
#pragma unroll
            for (int jt = 0; jt < 4; ++jt)
#pragma unroll
                for (int r = 0; r < 4; ++r) { const int j = 16 * jt + 4 * g + r; const float w = (j <= i) ? __expf(bi + sa[j] - mri) : 0.f; st[jt][r] *= w; dsum += st[jt][r]; }
            dsum += __shfl_xor(dsum, 16); dsum += __shfl_xor(dsum, 32);
            float qn = 0.f;
#pragma unroll
            for (int ks = 0; ks < 4; ++ks)
#pragma unroll
                for (int jj = 0; jj < 8; ++jj) qn += bf2f((bf16_t)qf[ks][jj]) * snp[32 * ks + 8 * g + jj];
            qn += __shfl_xor(qn, 16); qn += __shfl_xor(qn, 32);
            const float den = dsum + iwi * qn;
            inv_den = 1.0f / fmaxf(fabsf(den), __expf(-mri));
            bf16x8 pf[2];
#pragma unroll
            for (int t = 0; t < 2; ++t) { pg8::u32x4 w; w.x = pg8::cvt_pk_bf16(st[2 * t][0], st[2 * t][1]); w.y = pg8::cvt_pk_bf16(st[2 * t][2], st[2 * t][3]);
                w.z = pg8::cvt_pk_bf16(st[2 * t + 1][0], st[2 * t + 1][1]); w.w = pg8::cvt_pk_bf16(st[2 * t + 1][2], st[2 * t + 1][3]); pf[t] = __builtin_bit_cast(bf16x8, w); }
            const unsigned vs = (unsigned)(size_t)Vs, cs = (unsigned)(size_t)Cs;
#pragma unroll
            for (int e4 = 0; e4 < 4; ++e4) { const int et = 4 * eh + e4;
                s16x4 vlo[2], vhi[2], clo[4], chi[4];
#pragma unroll
                for (int t = 0; t < 2; ++t) { vlo[t] = att::tr_read(tr_addr(vs, 32 * t + 4 * g, 16 * et, li)); vhi[t] = att::tr_read(tr_addr(vs, 32 * t + 16 + 4 * g, 16 * et, li)); }
#pragma unroll
                for (int ks = 0; ks < 4; ++ks) { clo[ks] = att::tr_read(tr_addr(cs, 32 * ks + 8 * g, 16 * et, li)); chi[ks] = att::tr_read(tr_addr(cs, 32 * ks + 8 * g + 4, 16 * et, li)); }
                lds_wait();
                f32x4 aS = (f32x4){0.f, 0.f, 0.f, 0.f}, aC = (f32x4){0.f, 0.f, 0.f, 0.f};
#pragma unroll
                for (int t = 0; t < 2; ++t) aS = __builtin_amdgcn_mfma_f32_16x16x32_bf16(mk8(vlo[t], vhi[t]), pf[t], aS, 0, 0, 0);
#pragma unroll
                for (int ks = 0; ks < 4; ++ks) aC = __builtin_amdgcn_mfma_f32_16x16x32_bf16(mk8(clo[ks], chi[ks]), qf[ks], aC, 0, 0, 0);
                hv[e4] = (aS + aC * iwi) * inv_den;
                ssq_part += (hv[e4][0] * hv[e4][0] + hv[e4][1] * hv[e4][1]) + (hv[e4][2] * hv[e4][2] + hv[e4][3] * hv[e4][3]); }
            ssq_part += __shfl_xor(ssq_part, 16); ssq_part += __shfl_xor(ssq_part, 32);
            if (g == 0) ssq[wave * 16 + li] = ssq_part;
        }
        __syncthreads();
        if (active) {
            const float tot = ssq_part + ssq[(wave ^ 4) * 16 + li];
            const float rs = rsqrtf(tot * (1.0f / C::MHD) + 1e-6f);
            const int row = r0 + i;
#pragma unroll
            for (int e4 = 0; e4 < 4; ++e4) { const int e = 16 * (4 * eh + e4) + 4 * g;
                const f32x4 og = *(const f32x4*)(P + (size_t)row * C::LDP + C::O_O + h * C::MHD + e); const f32x4 gn = *(const f32x4*)(p.in[I_NG] + (size_t)l * C::MW + h * C::MHD + e);
                float o4[4];
#pragma unroll
                for (int r = 0; r < 4; ++r) o4[r] = hv[e4][r] * rs * gn[r] * __builtin_amdgcn_rcpf(1.0f + __expf(-og[r]));
                u32x2 w; w.x = pg8::cvt_pk_bf16(o4[0], o4[1]); w.y = pg8::cvt_pk_bf16(o4[2], o4[3]);
                *(u32x2*)(wsb<C>(p, C::WS_MIX) + (size_t)row * C::D + C::PW + C::GW + h * C::MHD + e) = w; }
        }
        __syncthreads();
    }
}
}
constexpr int PH_PER_LAYER = 14, N_PHASES = 2 + PH_PER_LAYER * C::DEPTH;
struct Args { Ptrs p; int ph_lo, ph_hi; };
__global__ void __launch_bounds__(NTHREADS, 2) fwd(Args a) {
    extern __shared__ __attribute__((aligned(16))) unsigned char lds_raw[];
    LAS unsigned char* lds = (LAS unsigned char*)lds_raw;
    typedef __attribute__((address_space(4))) const Args* KArgs;
    const KArgs ka0 = (KArgs)__builtin_amdgcn_kernarg_segment_ptr();
    const int lo = a.ph_lo, hi = a.ph_hi;
#define IN(k) (lo <= (k) && (k) < hi)
#define BOTH(k) (IN(k) && IN((k) + 1))
#define GRID_BAR(k) do { if (BOTH(k)) { xcd_barrier(bar); } } while (0)
#if defined(__HIP_DEVICE_COMPILE__)
#define LOAD_PTRS KArgs ka = ka0; asm volatile("" : "+s"(ka)); Ptrs p; _Pragma("unroll") for (int i_ = 0; i_ < 33; ++i_) p.in[i_] = ka->p.in[i_]; p.out = ka->p.out; p.ws = ka->p.ws;
#else
#define LOAD_PTRS (void)ka0; const Ptrs p = a.p;
#endif
#define PHASE_ARGS LOAD_PTRS int tid = threadIdx.x; asm volatile("" : "+v"(tid)); \
    const int lane = tid & 63, wave = __builtin_amdgcn_readfirstlane(tid >> 6); (void)lane; (void)wave; \
    const long gtid = (long)blockIdx.x * NTHREADS + tid, gthreads = (long)gridDim.x * NTHREADS; (void)gtid; (void)gthreads; \
    float* SS = wsf<C>(p, C::WS_SS); (void)SS; const float invd = 1.0f / C::D; (void)invd;
#define ITEMS(n, call) do { for (long it = gtid; it < (long)(n); it += gthreads) { call; } } while (0)
#if ONE_LAUNCH
    if (threadIdx.x < 4) ((LAS unsigned*)(lds + LDS_CTL))[threadIdx.x] = 0u;
    __syncthreads();
    XcdBarrier bar = xcd_barrier_post((unsigned*)(a.p.ws + C::WS_CTL), (volatile LAS unsigned*)(lds + LDS_CTL));
#else
    XcdBarrier bar; bar.bar = nullptr; bar.x = 0; bar.st = nullptr;
#endif

    if (IN(0)) { PHASE_ARGS
        LAS float* scr = (LAS float*)(lds + wave * 16384);
        const int gw = blockIdx.x * NWAVES + wave, NGW = gridDim.x * NWAVES;
        for (int l = 0; l < C::DEPTH; ++l)
            for (int idx = 0; idx < 10; ++idx) { const WDesc d = wdesc(p, l, idx); const int nitems = (d.K / 64) * (d.N / 32);
                for (int it = gw; it < nitems; it += NGW) prep_item(d.W, d.K, d.Ncols, d.g, d.kind, d.N, d.dst, scr, it, lane); }
        ITEMS(C::M, st_rowinit<C>(p, (int)it));
        ITEMS(C::MM, st_meminit<C>(p, (int)it));
        GRID_BAR(0);
    }
    for (int l = 0; l < C::DEPTH; ++l) {
        const int pb = 1 + PH_PER_LAYER * l;
#define SSL(j) (SS + (size_t)(4 * l + (j)) * C::M)
        if (IN(pb + 0)) { PHASE_ARGS
            pg8::Gemm g{wsb<C>(p, C::WS_MEMB), wlayer<C>(p, l, C::W_KV), C::MM, 2 * C::D, C::D}; pg8::StaticOrder S; S.init(C::MM, 2 * C::D, gridDim.x, blockIdx.x);
            pg8::EpiMemKV E{p.out + C::OUT_MK + (size_t)l * C::MM * C::D, p.out + C::OUT_MV + (size_t)l * C::MM * C::D, wsf<C>(p, C::WS_RSTDM), C::D};
            pg8::gemm_phase<pg8::EpiMemKV, pg8::StaticOrder, false>(lds, g, S, E, nullptr);
            GRID_BAR(pb + 0);
        }
        if (IN(pb + 1)) { PHASE_ARGS
            pg8::Gemm g{wsb<C>(p, C::WS_XB), wlayer<C>(p, l, C::W_1IN), C::M, 2 * C::FF, C::D}; pg8::StaticOrder S; S.init(C::M, 2 * C::FF, gridDim.x, blockIdx.x);
            pg8::EpiSwiGLU E{wsb<C>(p, C::WS_BIG), SSL(0), C::FF, invd};
            pg8::gemm_phase<pg8::EpiSwiGLU, pg8::StaticOrder, false>(lds, g, S, E, nullptr);
            GRID_BAR(pb + 1);
        }
        if (IN(pb + 2)) { PHASE_ARGS
            pg8::Gemm g{wsb<C>(p, C::WS_BIG), wlayer<C>(p, l, C::W_1OUT), C::M, C::D, C::FF}; pg8::StaticOrder S; S.init(C::M, C::D, gridDim.x, blockIdx.x);
            pg8::EpiResid E{wsf<C>(p, C::WS_X), wsb<C>(p, C::WS_XB), SSL(1), 0.5f, C::D};
            pg8::gemm_phase<pg8::EpiResid, pg8::StaticOrder, false>(lds, g, S, E, nullptr);
            GRID_BAR(pb + 2);
        }
        if (IN(pb + 3)) { PHASE_ARGS
            pg8::Gemm g{wsb<C>(p, C::WS_XB), wlayer<C>(p, l, C::W_IN), C::M, C::LDP, C::D}; pg8::StaticOrder S; S.init(C::M, C::LDP, gridDim.x, blockIdx.x);
            pg8::EpiScaleF32 E{wsf<C>(p, C::WS_BIG), C::LDP, SSL(1), invd};
            pg8::gemm_phase<pg8::EpiScaleF32, pg8::StaticOrder, false>(lds, g, S, E, nullptr);
            GRID_BAR(pb + 3);
        }
        if (IN(pb + 4)) { PHASE_ARGS ITEMS((long)C::M * C::PW, st_pool_d<C>(p, l, it)); ITEMS((long)C::M * C::GH, st_gmlp_v<C>(p, l, it)); mx::ml_phase_a(lds, p, l, tid); GRID_BAR(pb + 4); }
        if (IN(pb + 5)) { PHASE_ARGS ITEMS((long)C::M * C::PW, st_pool_y<C>(p, l, it)); ITEMS((long)C::M * C::GW, st_gmlp_s<C>(p, l, it)); GRID_BAR(pb + 5); }
        if (IN(pb + 6)) { PHASE_ARGS ITEMS((C::BATCH + C::DEC_BATCH) * C::MH, st_ml_b0<C>(p, l, (int)it)); ITEMS((long)(C::BATCH + C::DEC_BATCH) * C::MH * C::MHD * C::MHD, st_ml_b<C>(p, l, it)); GRID_BAR(pb + 6); }
        if (IN(pb + 7)) { PHASE_ARGS mx::ml_phase_c(lds, p, l, tid); GRID_BAR(pb + 7); }
        if (IN(pb + 8)) { PHASE_ARGS
            pg8::Gemm g{wsb<C>(p, C::WS_MIX), wlayer<C>(p, l, C::W_OUT), C::M, C::D, C::D}; pg8::StaticOrder S; S.init(C::M, C::D, gridDim.x, blockIdx.x);
            pg8::EpiResid E{wsf<C>(p, C::WS_X), wsb<C>(p, C::WS_XB), SSL(2), 1.0f, C::D};
            pg8::gemm_phase<pg8::EpiResid, pg8::StaticOrder, false>(lds, g, S, E, nullptr);
            GRID_BAR(pb + 8);
        }
        if (IN(pb + 9)) { PHASE_ARGS
            pg8::Gemm g{wsb<C>(p, C::WS_XB), wlayer<C>(p, l, C::W_Q), C::M, C::D, C::D}; pg8::StaticOrder S; S.init(C::M, C::D, gridDim.x, blockIdx.x);
            pg8::EpiScaleBf16 E{wsb<C>(p, C::WS_Q), C::D, SSL(2), invd};
            pg8::gemm_phase<pg8::EpiScaleBf16, pg8::StaticOrder, false>(lds, g, S, E, nullptr);
            GRID_BAR(pb + 9);
        }
        if (IN(pb + 10)) { PHASE_ARGS att::attn_phase(lds, p, l, tid); GRID_BAR(pb + 10); }
        if (IN(pb + 11)) { PHASE_ARGS
            pg8::Gemm g{wsb<C>(p, C::WS_AO), wlayer<C>(p, l, C::W_O), C::M, C::D, C::D}; pg8::StaticOrder S; S.init(C::M, C::D, gridDim.x, blockIdx.x);
            pg8::EpiResid E{wsf<C>(p, C::WS_X), wsb<C>(p, C::WS_XB), SSL(3), 1.0f, C::D};
            pg8::gemm_phase<pg8::EpiResid, pg8::StaticOrder, false>(lds, g, S, E, nullptr);
            GRID_BAR(pb + 11);
        }
        if (IN(pb + 12)) { PHASE_ARGS
            pg8::Gemm g{wsb<C>(p, C::WS_XB), wlayer<C>(p, l, C::W_2IN), C::M, 2 * C::FF, C::D}; pg8::StaticOrder S; S.init(C::M, 2 * C::FF, gridDim.x, blockIdx.x);
            pg8::EpiSwiGLU E{wsb<C>(p, C::WS_BIG), SSL(3), C::FF, invd};
            pg8::gemm_phase<pg8::EpiSwiGLU, pg8::StaticOrder, false>(lds, g, S, E, nullptr);
            GRID_BAR(pb + 12);
        }
        if (IN(pb + 13)) { PHASE_ARGS
            pg8::Gemm g{wsb<C>(p, C::WS_BIG), wlayer<C>(p, l, C::W_2OUT), C::M, C::D, C::FF}; pg8::StaticOrder S; S.init(C::M, C::D, gridDim.x, blockIdx.x);
            pg8::EpiResid E{wsf<C>(p, C::WS_X), wsb<C>(p, C::WS_XB), SSL(4), 0.5f, C::D};
            pg8::gemm_phase<pg8::EpiResid, pg8::StaticOrder, false>(lds, g, S, E, nullptr);
            GRID_BAR(pb + 13);
        }
    }
    if (IN(N_PHASES - 1)) { PHASE_ARGS ITEMS(C::M, st_final<C>(p, (int)it)); }
#undef IN
#undef BOTH
#undef GRID_BAR
#undef ITEMS
#undef PHASE_ARGS
#undef SSL
}

extern "C" void kernel_launch(void* const* d_in, const int* in_sizes, int n_in, void* d_out, int out_size, void* d_ws, size_t ws_size, hipStream_t stream) {
    static int ready = 0;
    if (!ready) {
        if (n_in != 33 || (long)out_size != (long)C::OUT_END || ws_size < (size_t)C::WS_END) { fprintf(stderr, "kernel_launch: unexpected shapes: n_in %d out %d ws %zu (need %zu)\n", n_in, out_size, ws_size, (size_t)C::WS_END); ready = -1; return; }
        if (hipFuncSetAttribute((const void*)fwd, hipFuncAttributeMaxDynamicSharedMemorySize, LDS_BYTES) != hipSuccess) { fprintf(stderr, "kernel_launch: hipFuncSetAttribute failed\n"); ready = -1; return; }
        int dev = 0, cus = 0, per_cu = 0;
        if (hipGetDevice(&dev) != hipSuccess || hipDeviceGetAttribute(&cus, hipDeviceAttributeMultiprocessorCount, dev) != hipSuccess) { fprintf(stderr, "kernel_launch: device query failed\n"); ready = -1; return; }
        if (hipOccupancyMaxActiveBlocksPerMultiprocessor(&per_cu, (const void*)fwd, NTHREADS, LDS_BYTES) != hipSuccess || per_cu < 1) { fprintf(stderr, "kernel_launch: occupancy query reports %d blocks per CU\n", per_cu); (void)hipGetLastError(); per_cu = 1; }
        ready = cus;
    }
    if (ready < 0) return;
    Args a{};
    for (int i = 0; i < 33; ++i) a.p.in[i] = (const float*)d_in[i];
    a.p.out = (float*)d_out; a.p.ws = (unsigned char*)d_ws;
#if ONE_LAUNCH
    (void)hipMemsetAsync((char*)d_ws + C::WS_CTL, 0, 65536, stream);
    a.ph_lo = 0; a.ph_hi = N_PHASES;
    hipLaunchKernelGGL(fwd, dim3(ready), dim3(NTHREADS), LDS_BYTES, stream, a);
#else
    for (int k = 0; k < N_PHASES; ++k) { a.ph_lo = k; a.ph_hi = k + 1; hipLaunchKernelGGL(fwd, dim3(ready), dim3(NTHREADS), LDS_BYTES, stream, a); }
#endif
}
```

```cpp
#include <hip/hip_runtime.h>
#include <cstdio>
#define ONE_LAUNCH 1
#define HD __host__ __device__
#ifndef HD
#define HD __host__ __device__
#endif
typedef unsigned short bf16_t;
HD inline unsigned f2u(float f) { return __builtin_bit_cast(unsigned, f); }
HD inline float u2f(unsigned u) { return __builtin_bit_cast(float, u); }
HD inline bf16_t f2bf(float f) { unsigned u = f2u(f); u += 0x7FFFu + ((u >> 16) & 1u); return (bf16_t)(u >> 16); }
HD inline float bf2f(bf16_t b) { return u2f(((unsigned)b) << 16); }

struct RC {
    static constexpr int D = 2048, FF = 8192, BATCH = 4, SEQ = 2048, DEPTH = 2, DEC_BATCH = 32, DEC_SEQ = 32, PAST = 2048, NMEM = 256;
};
template <class B> struct CfgT : B {
    using B::D; using B::FF; using B::BATCH; using B::SEQ; using B::DEPTH; using B::DEC_BATCH; using B::DEC_SEQ; using B::PAST; using B::NMEM;
    static constexpr int MP = BATCH * SEQ, MS = DEC_BATCH * DEC_SEQ, M = MP + MS, MM = BATCH * NMEM;
    static constexpr int PW = D / 4, PG = 4, PGD = PW / 4, PH = 15;
    static constexpr int GW = D / 4, GH = 4, GHD = GW / 4, GCH = 128;
    static constexpr int MW = D - PW - GW, MH = 8, MHD = MW / 8, CH = 64;
    static constexpr int INC = PW + 2 * GW + 4 * MW + 2 * MH;
    static constexpr int LDP = ((INC + 255) / 256) * 256;
    static constexpr int AH = 4, AHD = D / 4;
    static constexpr int O_U = PW, O_V = PW + GW, O_Q = PW + 2 * GW, O_K = O_Q + MW, O_VM = O_K + MW, O_O = O_VM + MW, O_IG = O_O + MW, O_FG = O_IG + MH;
    static constexpr int NC = SEQ / CH, NPC = BATCH * MH * NC, NSC = DEC_BATCH * MH, NCH = NPC + NSC;
    static constexpr int LCS = DEC_SEQ < CH ? DEC_SEQ : CH;
    static constexpr int GLP = SEQ < GCH ? SEQ : GCH, GLS = DEC_SEQ < GCH ? DEC_SEQ : GCH;
    static constexpr int NSS = 1 + 4 * DEPTH;
    static constexpr long OUT_YP = 0, OUT_YS = OUT_YP + (long)MP * D, OUT_POOLP = OUT_YS + (long)MS * D, OUT_POOLS = OUT_POOLP + (long)DEPTH * BATCH * PH * PW,
        OUT_CP = OUT_POOLS + (long)DEPTH * DEC_BATCH * PH * PW, OUT_NP = OUT_CP + (long)DEPTH * BATCH * MH * MHD * MHD, OUT_MP = OUT_NP + (long)DEPTH * BATCH * MH * MHD,
        OUT_CS = OUT_MP + (long)DEPTH * BATCH * MH, OUT_NS = OUT_CS + (long)DEPTH * DEC_BATCH * MH * MHD * MHD, OUT_MS = OUT_NS + (long)DEPTH * DEC_BATCH * MH * MHD,
        OUT_VS = OUT_MS + (long)DEPTH * DEC_BATCH * MH, OUT_MK = OUT_VS + (long)DEPTH * DEC_BATCH * DEC_SEQ * GW, OUT_MV = OUT_MK + (long)DEPTH * BATCH * NMEM * D,
        OUT_END = OUT_MV + (long)DEPTH * BATCH * NMEM * D;
    static constexpr size_t al(size_t x) { return (x + 255) & ~(size_t)255; }
    static constexpr size_t WS_CTL = 0, WS_SS = 65536, WS_X = al(WS_SS + (size_t)NSS * M * 4), WS_XB = al(WS_X + (size_t)M * D * 4),
        WS_BIG = al(WS_XB + (size_t)M * D * 2),
        WS_BIG_SZ = ((size_t)M * FF * 2 > (size_t)M * LDP * 4) ? (size_t)M * FF * 2 : (size_t)M * LDP * 4,
        WS_MIX = al(WS_BIG + WS_BIG_SZ), WS_Q = al(WS_MIX + (size_t)M * D * 2), WS_AO = al(WS_Q + (size_t)M * D * 2),
        WS_MEMB = al(WS_AO + (size_t)M * D * 2), WS_RSTDM = al(WS_MEMB + (size_t)MM * D * 2),
        WS_PD = al(WS_RSTDM + (size_t)MM * 4), WS_VH = al(WS_PD + (size_t)M * PW * 4),
        WS_GB = al(WS_VH + (size_t)M * GW * 4), WS_GA = al(WS_GB + (size_t)M * MH * 4), WS_GWT = al(WS_GA + (size_t)M * MH * 4),
        WS_CBL = al(WS_GWT + (size_t)M * MH * 4), WS_CML = al(WS_CBL + (size_t)NCH * 4), WS_MPREV = al(WS_CML + (size_t)NCH * 4),
        WS_DC = al(WS_MPREV + (size_t)NCH * 4), WS_DN = al(WS_DC + (size_t)NCH * MHD * MHD * 4),
        WS_SB = al(WS_DN + (size_t)NCH * MHD * 4), WS_DEN = al(WS_SB + (size_t)M * MH * CH * 4), WS_IW = al(WS_DEN + (size_t)M * MH * 4),
        WS_HB = al(WS_IW + (size_t)M * MH * 4), WS_SC = al(WS_HB + (size_t)M * MW * 4),
        WS_W = al(WS_SC + (size_t)M * AH * NMEM * 4);
    static constexpr size_t W_1IN = 0, W_1OUT = W_1IN + (size_t)2 * FF * D, W_IN = W_1OUT + (size_t)D * FF, W_OUT = W_IN + (size_t)LDP * D, W_Q = W_OUT + (size_t)D * D,
        W_KV = W_Q + (size_t)D * D, W_O = W_KV + (size_t)2 * D * D, W_2IN = W_O + (size_t)D * D, W_2OUT = W_2IN + (size_t)2 * FF * D, W_LAYER = W_2OUT + (size_t)D * FF;
    static constexpr size_t WS_END = al(WS_W + (size_t)DEPTH * W_LAYER * 2);
};

struct Ptrs { const float* in[33]; float* out; unsigned char* ws; };
enum { I_XP = 0, I_XS, I_MEM, I_SPOOL, I_SC, I_SN, I_SM, I_CK, I_CV, I_GFFN1, I_W1IN, I_W1OUT, I_GMIX, I_WIN, I_POOLW, I_POOLS, I_GVG, I_GWS, I_GBS, I_IB, I_FB, I_NG, I_WOUT,
       I_GX, I_GMEM, I_WQ, I_WK, I_WV, I_WO, I_GFFN2, I_W2IN, I_W2OUT, I_GFIN };

template <class C> HD inline float* wsf(const Ptrs& p, size_t off) { return (float*)(p.ws + off); }
template <class C> HD inline bf16_t* wsb(const Ptrs& p, size_t off) { return (bf16_t*)(p.ws + off); }
template <class C> HD inline bf16_t* wlayer(const Ptrs& p, int l, size_t off) { return (bf16_t*)(p.ws + C::WS_W) + (size_t)l * C::W_LAYER + off; }

template <class C> HD inline void row_info(int r, bool& s, int& b, int& t) {
    if (r < C::MP) { s = false; b = r / C::SEQ; t = r % C::SEQ; } else { s = true; const int q = r - C::MP; b = q / C::DEC_SEQ; t = q % C::DEC_SEQ; }
}
template <class C> HD inline void chunk_info(int r, int h, int& ci, int& i, int& lc) {
    bool s; int b, t; row_info<C>(r, s, b, t);
    if (!s) { ci = (b * C::MH + h) * C::NC + t / C::CH; i = t % C::CH; lc = C::CH; } else { ci = C::NPC + b * C::MH + h; i = t; lc = C::LCS; }
}
HD inline float sigmoidf_(float x) { return 1.0f / (1.0f + expf(-x)); }
HD inline float logsigmoidf_(float x) { return x >= 0.f ? -log1pf(expf(-x)) : x - log1pf(expf(x)); }

enum { WK_PLAIN = 0, WK_FFNIN = 1, WK_WIN = 2 };
template <class C> HD inline int wsrc_col(int kind, int n) {
    if (kind == WK_FFNIN) { const int pn = n >> 8, j = n & 255; return j < 128 ? 128 * pn + j : C::FF + 128 * pn + (j - 128); }
    if (kind == WK_WIN) return n < C::INC ? n : -1;
    return n;
}

template <class C> HD inline void st_rowinit(const Ptrs& p, int r) {
    const float* src = r < C::MP ? p.in[I_XP] + (size_t)r * C::D : p.in[I_XS] + (size_t)(r - C::MP) * C::D;
    float* X = wsf<C>(p, C::WS_X) + (size_t)r * C::D; bf16_t* XB = wsb<C>(p, C::WS_XB) + (size_t)r * C::D;
    float ss = 0.f;
    for (int k = 0; k < C::D; ++k) { const float v = src[k]; X[k] = v; XB[k] = f2bf(v); ss += v * v; }
    float* SS = wsf<C>(p, C::WS_SS);
    SS[r] = ss;
    for (int j = 1; j < C::NSS; ++j) SS[(size_t)j * C::M + r] = 0.f;
}
template <class C> HD inline void st_meminit(const Ptrs& p, int r) {
    const float* src = p.in[I_MEM] + (size_t)r * C::D; bf16_t* MB = wsb<C>(p, C::WS_MEMB) + (size_t)r * C::D;
    float ss = 0.f;
    for (int k = 0; k < C::D; ++k) { const float v = src[k]; MB[k] = f2bf(v); ss += v * v; }
    wsf<C>(p, C::WS_RSTDM)[r] = 1.0f / sqrtf(ss / C::D + 1e-6f);
}
template <class C> HD inline void st_pool_d(const Ptrs& p, int l, long item) {
    const int r = (int)(item / C::PW), ch = (int)(item % C::PW), g = ch / C::PGD;
    const int w = 2 << g;
    bool s; int b, t; row_info<C>(r, s, b, t);
    const float* P = wsf<C>(p, C::WS_BIG);
    const int pos = (s ? C::PAST : 0) + t;
    float sum = 0.f;
    for (int j = 0; j < w; ++j) { const int tt = t - j;
        float v;
        if (tt >= 0) v = P[(size_t)(r - j) * C::LDP + ch];
        else { const int hi = C::PH + tt;
            v = (s && hi >= 0) ? p.in[I_SPOOL][(((size_t)l * C::DEC_BATCH + b) * C::PH + hi) * C::PW + ch] : 0.f; }
        sum += v; }
    const float cnt = (float)((pos + 1) < w ? (pos + 1) : w);
    wsf<C>(p, C::WS_PD)[(size_t)r * C::PW + ch] = sum / cnt - P[(size_t)r * C::LDP + ch];
    const int L = s ? C::DEC_SEQ : C::SEQ;
    const int idx = t - (L - C::PH);
    if (idx >= 0) { float* o = p.out + (s ? C::OUT_POOLS + (((size_t)l * C::DEC_BATCH + b) * C::PH + idx) * C::PW : C::OUT_POOLP + (((size_t)l * C::BATCH + b) * C::PH + idx) * C::PW);
        o[ch] = P[(size_t)r * C::LDP + ch]; }
}
template <class C> HD inline void st_pool_y(const Ptrs& p, int l, long item) {
    const int r = (int)(item / C::PW), ch = (int)(item % C::PW), g = ch / C::PGD, e = ch % C::PGD;
    const float* d = wsf<C>(p, C::WS_PD) + (size_t)r * C::PW + g * C::PGD;
    const float* w = p.in[I_POOLW] + ((size_t)l * C::PG + g) * C::PGD * C::PGD;
    float acc = 0.f;
    for (int c = 0; c < C::PGD; ++c) acc += d[c] * w[(size_t)c * C::PGD + e];
    wsb<C>(p, C::WS_MIX)[(size_t)r * C::D + ch] = f2bf(acc * p.in[I_POOLS][(size_t)l * C::PW + ch]);
}
template <class C> HD inline void st_gmlp_v(const Ptrs& p, int l, long item) {
    const int r = (int)(item / C::GH), h = (int)(item % C::GH);
    const float* v = wsf<C>(p, C::WS_BIG) + (size_t)r * C::LDP + C::O_V + h * C::GHD;
    float ss = 0.f; for (int d = 0; d < C::GHD; ++d) ss += v[d] * v[d];
    const float rs = 1.0f / sqrtf(ss / C::GHD + 1e-6f);
    float* VH = wsf<C>(p, C::WS_VH) + (size_t)r * C::GW + h * C::GHD; const float* g = p.in[I_GVG] + (size_t)l * C::GW + h * C::GHD;
    bool s; int b, t; row_info<C>(r, s, b, t);
    float* o = s ? p.out + C::OUT_VS + (((size_t)l * C::DEC_BATCH + b) * C::DEC_SEQ + t) * C::GW + h * C::GHD : nullptr;
    for (int d = 0; d < C::GHD; ++d) { const float y = v[d] * rs * g[d]; VH[d] = y; if (o) o[d] = y; }
}
template <class C> HD inline void st_gmlp_s(const Ptrs& p, int l, long item) {
    const int r = (int)(item / C::GW), ch = (int)(item % C::GW), h = ch / C::GHD;
    bool s; int b, t; row_info<C>(r, s, b, t);
    const int lc = s ? C::GLS : C::GLP, i = t % lc, r0 = r - i;
    const float* ws = p.in[I_GWS] + (((size_t)l * C::GH + h) * C::GCH + i) * C::GCH;
    const float* VH = wsf<C>(p, C::WS_VH);
    float acc = p.in[I_GBS][((size_t)l * C::GH + h) * C::GCH + i];
    for (int j = 0; j <= i; ++j) acc += ws[j] * VH[(size_t)(r0 + j) * C::GW + ch];
    const float u = wsf<C>(p, C::WS_BIG)[(size_t)r * C::LDP + C::O_U + ch];
    wsb<C>(p, C::WS_MIX)[(size_t)r * C::D + C::PW + ch] = f2bf(u * acc);
}
template <class C> HD inline void st_ml_a1(const Ptrs& p, int l, int ci) {
    int r0, h, lc;
    if (ci < C::NPC) { const int c = ci % C::NC, bh = ci / C::NC; h = bh % C::MH; const int b = bh / C::MH; r0 = b * C::SEQ + c * C::CH; lc = C::CH; }
    else { const int q = ci - C::NPC; h = q % C::MH; const int b = q / C::MH; r0 = C::MP + b * C::DEC_SEQ; lc = C::LCS; }
    const float* P = wsf<C>(p, C::WS_BIG); float* GB = wsf<C>(p, C::WS_GB); float* GA = wsf<C>(p, C::WS_GA); float* GWT = wsf<C>(p, C::WS_GWT);
    const float ib = p.in[I_IB][l * C::MH + h], fb = p.in[I_FB][l * C::MH + h];
    float bc = 0.f, amax = -3.0e38f;
    for (int i = 0; i < lc; ++i) { const float* pr = P + (size_t)(r0 + i) * C::LDP;
        const float ig = pr[C::O_IG + h] + ib, fg = pr[C::O_FG + h] + fb;
        bc += logsigmoidf_(fg); const float a = ig - bc;
        GB[(size_t)(r0 + i) * C::MH + h] = bc; GA[(size_t)(r0 + i) * C::MH + h] = a; amax = a > amax ? a : amax; }
    const float bL = bc, mloc = bL + amax;
    wsf<C>(p, C::WS_CBL)[ci] = bL; wsf<C>(p, C::WS_CML)[ci] = mloc;
    for (int i = 0; i < lc; ++i) GWT[(size_t)(r0 + i) * C::MH + h] = expf(bL + GA[(size_t)(r0 + i) * C::MH + h] - mloc);
}
template <class C> HD inline void st_ml_a2(const Ptrs& p, int l, long item) {
    const int e = (int)(item % C::MHD), d = (int)((item / C::MHD) % C::MHD), ci = (int)(item / ((long)C::MHD * C::MHD));
    int r0, h, lc;
    if (ci < C::NPC) { const int c = ci % C::NC, bh = ci / C::NC; h = bh % C::MH; const int b = bh / C::MH; r0 = b * C::SEQ + c * C::CH; lc = C::CH; }
    else { const int q = ci - C::NPC; h = q % C::MH; const int b = q / C::MH; r0 = C::MP + b * C::DEC_SEQ; lc = C::LCS; }
    const float* P = wsf<C>(p, C::WS_BIG); const float* GWT = wsf<C>(p, C::WS_GWT);
    const float scale = 1.0f / sqrtf((float)C::MHD);
    float acc = 0.f, accn = 0.f;
    for (int t = 0; t < lc; ++t) { const float* pr = P + (size_t)(r0 + t) * C::LDP; const float wk = GWT[(size_t)(r0 + t) * C::MH + h] * pr[C::O_K + h * C::MHD + d] * scale;
        acc += wk * pr[C::O_VM + h * C::MHD + e]; accn += wk; }
    wsf<C>(p, C::WS_DC)[((size_t)ci * C::MHD + d) * C::MHD + e] = acc;
    if (e == 0) wsf<C>(p, C::WS_DN)[(size_t)ci * C::MHD + d] = accn;
}
template <class C> HD inline void st_ml_b0(const Ptrs& p, int l, int sq) {
    const float* CBL = wsf<C>(p, C::WS_CBL); const float* CML = wsf<C>(p, C::WS_CML); float* MPREV = wsf<C>(p, C::WS_MPREV);
    if (sq < C::BATCH * C::MH) { float m = 0.f;
        for (int c = 0; c < C::NC; ++c) { const int ci = sq * C::NC + c; MPREV[ci] = m; const float a = CBL[ci] + m, b2 = CML[ci]; m = a > b2 ? a : b2; }
        p.out[C::OUT_MP + (size_t)l * C::BATCH * C::MH + sq] = m;
    } else { const int q = sq - C::BATCH * C::MH, ci = C::NPC + q; const float m0 = p.in[I_SM][(size_t)l * C::DEC_BATCH * C::MH + q];
        MPREV[ci] = m0; const float a = CBL[ci] + m0, b2 = CML[ci]; p.out[C::OUT_MS + (size_t)l * C::DEC_BATCH * C::MH + q] = a > b2 ? a : b2; }
}
template <class C> HD inline void st_ml_b(const Ptrs& p, int l, long item) {
    const int e = (int)(item % C::MHD), d = (int)((item / C::MHD) % C::MHD), sq = (int)(item / ((long)C::MHD * C::MHD));
    const float* CBL = wsf<C>(p, C::WS_CBL); const float* CML = wsf<C>(p, C::WS_CML);
    float* DC = wsf<C>(p, C::WS_DC); float* DN = wsf<C>(p, C::WS_DN);
    if (sq < C::BATCH * C::MH) { float m = 0.f, cst = 0.f, nst = 0.f;
        for (int c = 0; c < C::NC; ++c) { const int ci = sq * C::NC + c; const float a = CBL[ci] + m, b2 = CML[ci], mn = a > b2 ? a : b2;
            const float dec = expf(a - mn), f = expf(b2 - mn);
            const size_t o = ((size_t)ci * C::MHD + d) * C::MHD + e; cst = dec * cst + f * DC[o]; DC[o] = cst;
            if (e == 0) { const size_t on = (size_t)ci * C::MHD + d; nst = dec * nst + f * DN[on]; DN[on] = nst; }
            m = mn; }
        p.out[C::OUT_CP + (((size_t)l * C::BATCH * C::MH + sq) * C::MHD + d) * C::MHD + e] = cst;
        if (e == 0) p.out[C::OUT_NP + ((size_t)l * C::BATCH * C::MH + sq) * C::MHD + d] = nst;
    } else { const int q = sq - C::BATCH * C::MH, ci = C::NPC + q; const float m0 = p.in[I_SM][(size_t)l * C::DEC_BATCH * C::MH + q];
        const float a = CBL[ci] + m0, b2 = CML[ci], mn = a > b2 ? a : b2, dec = expf(a - mn), f = expf(b2 - mn);
        const size_t so = (((size_t)l * C::DEC_BATCH * C::MH + q) * C::MHD + d) * C::MHD + e;
        p.out[C::OUT_CS + so] = dec * p.in[I_SC][so] + f * DC[((size_t)ci * C::MHD + d) * C::MHD + e];
        if (e == 0) { const size_t no = ((size_t)l * C::DEC_BATCH * C::MH + q) * C::MHD + d; p.out[C::OUT_NS + no] = dec * p.in[I_SN][no] + f * DN[(size_t)ci * C::MHD + d]; }
    }
}
template <class C> HD inline float ml_cprev(const Ptrs& p, int l, int ci, int d, int e) {
    if (ci < C::NPC) return (ci % C::NC) == 0 ? 0.f : wsf<C>(p, C::WS_DC)[((size_t)(ci - 1) * C::MHD + d) * C::MHD + e];
    return p.in[I_SC][(((size_t)l * C::DEC_BATCH * C::MH + (ci - C::NPC)) * C::MHD + d) * C::MHD + e];
}
template <class C> HD inline float ml_nprev(const Ptrs& p, int l, int ci, int d) {
    if (ci < C::NPC) return (ci % C::NC) == 0 ? 0.f : wsf<C>(p, C::WS_DN)[(size_t)(ci - 1) * C::MHD + d];
    return p.in[I_SN][((size_t)l * C::DEC_BATCH * C::MH + (ci - C::NPC)) * C::MHD + d];
}
template <class C> HD inline void st_ml_c1(const Ptrs& p, int l, long item) {
    const int r = (int)(item / C::MH), h = (int)(item % C::MH);
    int ci, i, lc; chunk_info<C>(r, h, ci, i, lc); const int r0 = r - i;
    const float* P = wsf<C>(p, C::WS_BIG); const float* GB = wsf<C>(p, C::WS_GB); const float* GA = wsf<C>(p, C::WS_GA);
    const float mprev = wsf<C>(p, C::WS_MPREV)[ci];
    const float bi = GB[(size_t)r * C::MH + h];
    float amax = -3.0e38f; for (int j = 0; j <= i; ++j) { const float a = GA[(size_t)(r0 + j) * C::MH + h]; amax = a > amax ? a : amax; }
    const float mrow = bi + (mprev > amax ? mprev : amax);
    const float scale = 1.0f / sqrtf((float)C::MHD);
    const float* q = P + (size_t)r * C::LDP + C::O_Q + h * C::MHD;
    float* S = wsf<C>(p, C::WS_SB) + ((size_t)r * C::MH + h) * C::CH;
    float ssum = 0.f;
    for (int j = 0; j < C::CH; ++j) { float sv = 0.f;
        if (j <= i) { const float* k = P + (size_t)(r0 + j) * C::LDP + C::O_K + h * C::MHD; float dot = 0.f; for (int d = 0; d < C::MHD; ++d) dot += q[d] * k[d];
            sv = dot * scale * expf(bi + GA[(size_t)(r0 + j) * C::MH + h] - mrow); }
        S[j] = sv; ssum += sv; }
    const float iw = expf(bi + mprev - mrow);
    float qn = 0.f; for (int d = 0; d < C::MHD; ++d) qn += q[d] * ml_nprev<C>(p, l, ci, d);
    const float den = ssum + iw * qn, fl = expf(-mrow), ad = fabsf(den);
    wsf<C>(p, C::WS_DEN)[(size_t)r * C::MH + h] = ad > fl ? ad : fl; wsf<C>(p, C::WS_IW)[(size_t)r * C::MH + h] = iw;
}
template <class C> HD inline void st_ml_c2(const Ptrs& p, int l, long item) {
    const int e = (int)(item % C::MHD), h = (int)((item / C::MHD) % C::MH), r = (int)(item / ((long)C::MHD * C::MH));
    int ci, i, lc; chunk_info<C>(r, h, ci, i, lc); const int r0 = r - i;
    const float* P = wsf<C>(p, C::WS_BIG); const float* S = wsf<C>(p, C::WS_SB) + ((size_t)r * C::MH + h) * C::CH;
    float num = 0.f; for (int j = 0; j <= i; ++j) num += S[j] * P[(size_t)(r0 + j) * C::LDP + C::O_VM + h * C::MHD + e];
    const float* q = P + (size_t)r * C::LDP + C::O_Q + h * C::MHD;
    float qc = 0.f; for (int d = 0; d < C::MHD; ++d) qc += q[d] * ml_cprev<C>(p, l, ci, d, e);
    num += wsf<C>(p, C::WS_IW)[(size_t)r * C::MH + h] * qc;
    wsf<C>(p, C::WS_HB)[(size_t)r * C::MW + h * C::MHD + e] = num / wsf<C>(p, C::WS_DEN)[(size_t)r * C::MH + h];
}
template <class C> HD inline void st_ml_c3(const Ptrs& p, int l, long item) {
    const int r = (int)(item / C::MH), h = (int)(item % C::MH);
    const float* hb = wsf<C>(p, C::WS_HB) + (size_t)r * C::MW + h * C::MHD;
    float ss = 0.f; for (int e = 0; e < C::MHD; ++e) ss += hb[e] * hb[e];
    const float rs = 1.0f / sqrtf(ss / C::MHD + 1e-6f);
    const float* g = p.in[I_NG] + (size_t)l * C::MW + h * C::MHD; const float* o = wsf<C>(p, C::WS_BIG) + (size_t)r * C::LDP + C::O_O + h * C::MHD;
    bf16_t* mix = wsb<C>(p, C::WS_MIX) + (size_t)r * C::D + C::PW + C::GW + h * C::MHD;
    for (int e = 0; e < C::MHD; ++e) mix[e] = f2bf(hb[e] * rs * g[e] * sigmoidf_(o[e]));
}
template <class C> HD inline const float* mem_kv(const Ptrs& p, int l, int r, bool isv, int m) {
    bool s; int b, t; row_info<C>(r, s, b, t);
    if (s) return p.in[isv ? I_CV : I_CK] + (((size_t)l * C::DEC_BATCH + b) * C::NMEM + m) * C::D;
    return p.out + (isv ? C::OUT_MV : C::OUT_MK) + (((size_t)l * C::BATCH + b) * C::NMEM + m) * C::D;
}
template <class C> HD inline void st_at_s(const Ptrs& p, int l, long item) {
    const int m = (int)(item % C::NMEM), hd = (int)((item / C::NMEM) % C::AH), r = (int)(item / ((long)C::NMEM * C::AH));
    const bf16_t* q = wsb<C>(p, C::WS_Q) + (size_t)r * C::D + hd * C::AHD; const float* k = mem_kv<C>(p, l, r, false, m) + hd * C::AHD;
    float acc = 0.f; for (int d = 0; d < C::AHD; ++d) acc += bf2f(q[d]) * k[d];
    wsf<C>(p, C::WS_SC)[((size_t)r * C::AH + hd) * C::NMEM + m] = acc / sqrtf((float)C::AHD);
}
template <class C> HD inline void st_at_p(const Ptrs& p, int l, long item) {
    float* sc = wsf<C>(p, C::WS_SC) + (size_t)item * C::NMEM;
    float mx = -3.0e38f; for (int m = 0; m < C::NMEM; ++m) mx = sc[m] > mx ? sc[m] : mx;
    float sum = 0.f; for (int m = 0; m < C::NMEM; ++m) { const float e = expf(sc[m] - mx); sc[m] = e; sum += e; }
    const float inv = 1.0f / sum; for (int m = 0; m < C::NMEM; ++m) sc[m] *= inv;
}
template <class C> HD inline void st_at_o(const Ptrs& p, int l, long item) {
    const int col = (int)(item % C::D), r = (int)(item / C::D), hd = col / C::AHD;
    const float* sc = wsf<C>(p, C::WS_SC) + ((size_t)r * C::AH + hd) * C::NMEM; const float* v0 = mem_kv<C>(p, l, r, true, 0) + col;
    float acc = 0.f; for (int m = 0; m < C::NMEM; ++m) acc += sc[m] * v0[(size_t)m * C::D];
    wsb<C>(p, C::WS_AO)[(size_t)r * C::D + col] = f2bf(acc);
}
template <class C> HD inline void st_final(const Ptrs& p, int r) {
    const float* X = wsf<C>(p, C::WS_X) + (size_t)r * C::D; const float rs = 1.0f / sqrtf(wsf<C>(p, C::WS_SS)[(size_t)(C::NSS - 1) * C::M + r] / C::D + 1e-6f);
    float* o = r < C::MP ? p.out + C::OUT_YP + (size_t)r * C::D : p.out + C::OUT_YS + (size_t)(r - C::MP) * C::D;
    for (int k = 0; k < C::D; ++k) o[k] = X[k] * rs * p.in[I_GFIN][k];
}

namespace pg8 {
#define PG8_LAS __attribute__((address_space(3)))
typedef unsigned short bf16_t;
typedef short bf16x8 __attribute__((ext_vector_type(8)));
typedef float f32x4 __attribute__((ext_vector_type(4)));
typedef unsigned u32x4 __attribute__((ext_vector_type(4)));
constexpr int BM = 256, BK = 64, HALF = 128, HTB = HALF * BK * 2  , STAGE_BYTES = 8 * HTB, NXCD = 8, WGM = 8;

__host__ __device__ __forceinline__ int lds_byte(int r, int c) { const int st = (r >> 4) * 2 + (c >> 5), rr = r & 15, cc = c & 31, ob = rr * 64 + cc * 2; return st * 1024 + (ob ^ (((ob >> 9) & 1) << 5)); }
__host__ __device__ __forceinline__ void stage_rc(int b, int& R, int& C) { const int st = b / 1024, sb = b % 1024, swz = sb ^ (((sb >> 9) & 1) << 5); R = (st >> 1) * 16 + swz / 64; C = (st & 1) * 32 + (swz % 64) / 2; }
__host__ __device__ __forceinline__ int perm32(int rho) { const int n = rho >> 4, i = rho & 15; return 8 * (i >> 2) + 4 * n + (i & 3); }

struct Unit { int pm, pn; };
struct Gemm { const bf16_t* A; const bf16_t* Bt; int M, N, K; };

struct StaticOrder {
    int nM, nN, nwg, G, c;
    __host__ __device__ void init(int M, int N, int G_, int c_) { nM = M / BM; nN = N / BM; nwg = nM * nN; G = G_; c = c_; }
    __host__ __device__ bool next(int i, Unit& u) const {
        const long L = (long)i * G + c; if (L >= nwg) return false;
        int wgid = (int)L; { const int q = nwg / NXCD, r = nwg % NXCD, xcd = wgid % NXCD, off = wgid / NXCD; wgid = (xcd < r ? xcd * (q + 1) : r * (q + 1) + (xcd - r) * q) + off; }
        const int nig = WGM * nN, gid = wgid / nig, fm = gid * WGM, gsz = (nM - fm) < WGM ? (nM - fm) : WGM;
        u.pm = fm + ((wgid % nig) % gsz); u.pn = (wgid % nig) / gsz; return true;
    }
    __device__ __forceinline__ void a_ready(const Unit&) const {}
    __device__ __forceinline__ void done(const Unit&) const {}
};
__device__ __forceinline__ unsigned cvt_pk_bf16(float lo, float hi) { unsigned r; asm volatile("v_cvt_pk_bf16_f32 %0, %1, %2" : "=v"(r) : "v"(lo), "v"(hi)); return r; }
typedef float f32x2 __attribute__((ext_vector_type(2)));
template <class Epi, class Sched, bool STAMP = false>
__device__ __forceinline__ void gemm_phase(PG8_LAS unsigned char* lds, const Gemm g, const Sched& S, const Epi& E, unsigned long long* stamps) {
    int tid_l = threadIdx.x; asm volatile("" : "+v"(tid_l));
    const int tid = tid_l, wid = __builtin_amdgcn_readfirstlane(tid >> 6), lane = tid & 63, wr = wid >> 2, wc = wid & 3, fr = lane & 15, fq = lane >> 4;
    const int K = g.K, nt = K / BK;
    int ts_lo = 0, ts_hi = 0, nts = 0; const unsigned long long rt_entry = STAMP ? (unsigned long long)wall_clock64() : 0ull;
#define PG8_STAMP() do { if (STAMP && wid == 0 && nts < 64) { const unsigned long long _c = (unsigned long long)clock64(); \
        ts_lo = (lane == nts) ? (int)(unsigned)_c : ts_lo; ts_hi = (lane == nts) ? (int)(unsigned)(_c >> 32) : ts_hi; ++nts; } } while (0)
    PG8_STAMP();
    unsigned voffA[2], voffB[2];
#pragma unroll
    for (int i = 0; i < 2; ++i) { int R, C; stage_rc(tid * 16 + i * 8192, R, C); const int Rb = Epi::PERM ? ((R & ~31) + perm32(R & 31)) : R;
        voffA[i] = (unsigned)(R * K + C) * 2u; voffB[i] = (unsigned)(Rb * K + C) * 2u; }
    const size_t kstep = (size_t)(BK * 2);
    const size_t hstep = (size_t)HALF * K * 2;
    const size_t tstep = 2 * hstep;
    const unsigned ldsw = (unsigned)wid * 1024u;
    const int aoff = lds_byte(wr * 64 + fr, fq * 8), boff = lds_byte(wc * 32 + fr, fq * 8);
#define PG8_SA(b, h) (((b) * 2 + (h)) * HTB)
#define PG8_SB(b, h) ((4 + (b) * 2 + (h)) * HTB)
#define PG8_STAGE(bufoff, gbase, voff) do { _Pragma("unroll") for (int _i = 0; _i < 2; ++_i) \
        __builtin_amdgcn_global_load_lds((const unsigned*)((const char*)(gbase) + (voff)[_i]), (PG8_LAS unsigned*)(lds + (bufoff) + ldsw + _i * 8192), 16, 0, 0); } while (0)
#define PG8_LDA(dst, b, h) do { _Pragma("unroll") for (int m = 0; m < 4; ++m) _Pragma("unroll") for (int k = 0; k < 2; ++k) dst[m][k] = *(const PG8_LAS bf16x8*)(lds + PG8_SA(b, h) + aoff + m * 2048 + k * 1024); } while (0)
#define PG8_LDB(dst, b, h) do { _Pragma("unroll") for (int n = 0; n < 2; ++n) _Pragma("unroll") for (int k = 0; k < 2; ++k) dst[n][k] = *(const PG8_LAS bf16x8*)(lds + PG8_SB(b, h) + boff + n * 2048 + k * 1024); } while (0)
#define PG8_MMA(ai, bj, At, Bt) do { __builtin_amdgcn_s_setprio(1); _Pragma("unroll") for (int m = 0; m < 4; ++m) _Pragma("unroll") for (int n = 0; n < 2; ++n) _Pragma("unroll") for (int k = 0; k < 2; ++k) \
        acc[ai][bj][m][n] = __builtin_amdgcn_mfma_f32_16x16x32_bf16(Bt[n][k], At[m][k], acc[ai][bj][m][n], 0, 0, 0); __builtin_amdgcn_s_setprio(0); } while (0)
#define PG8_WAIT_V(n) asm volatile("s_waitcnt vmcnt(" #n ")" ::: "memory")
#define PG8_WAIT_L(n) asm volatile("s_waitcnt lgkmcnt(" #n ")" ::: "memory")
#define PG8_BAR __builtin_amdgcn_s_barrier()
#define PG8_SCHED __builtin_amdgcn_sched_barrier(0)
    Unit cur, nxt; int ui = 0;
    if (!S.next(0, cur)) return;
    f32x4 acc[2][2][4][2];
#pragma unroll
    for (int a = 0; a < 2; ++a)
#pragma unroll
        for (int b = 0; b < 2; ++b)
#pragma unroll
            for (int m = 0; m < 4; ++m)
#pragma unroll
                for (int n = 0; n < 2; ++n) acc[a][b][m][n] = (f32x4){0.f, 0.f, 0.f, 0.f};
    bf16x8 At[4][2], B0[2][2], B1[2][2];
    const char* cA = (const char*)g.A + (size_t)cur.pm * tstep; const char* cB = (const char*)g.Bt + (size_t)cur.pn * tstep;
    S.a_ready(cur);
    PG8_STAGE(PG8_SB(0, 0), cB, voffB); PG8_STAGE(PG8_SA(0, 0), cA, voffA); PG8_STAGE(PG8_SB(0, 1), cB + hstep, voffB); PG8_STAGE(PG8_SA(0, 1), cA + hstep, voffA);
    if (wr == 1) PG8_BAR;
    PG8_WAIT_V(4); PG8_BAR;
    PG8_STAGE(PG8_SB(1, 0), cB + kstep, voffB); PG8_STAGE(PG8_SA(1, 0), cA + kstep, voffA); PG8_STAGE(PG8_SB(1, 1), cB + hstep + kstep, voffB);
    PG8_WAIT_V(6); PG8_BAR;
    PG8_STAMP();
    for (;;) {
        const bool has_next = S.next(ui + 1, nxt);
        const char* nA = has_next ? (const char*)g.A + (size_t)nxt.pm * tstep : cA; const char* nB = has_next ? (const char*)g.Bt + (size_t)nxt.pn * tstep : cB;
        for (int t = 0; t < nt; t += 2) {
            const bool last = (t == nt - 2);
            const char* a1 = cA + (size_t)(t + 1) * kstep;
            const char* a2 = last ? nA : cA + (size_t)(t + 2) * kstep; const char* b2 = last ? nB : cB + (size_t)(t + 2) * kstep;
            const char* a3 = a2 + kstep; const char* b3 = b2 + kstep;
            if (last && has_next) S.a_ready(nxt);
            PG8_LDB(B0, 0, 0); PG8_SCHED; PG8_LDA(At, 0, 0); PG8_STAGE(PG8_SA(1, 1), a1 + hstep, voffA);
            PG8_WAIT_L(8); PG8_BAR; PG8_WAIT_L(0); PG8_MMA(0, 0, At, B0); PG8_BAR; PG8_SCHED;
            PG8_LDB(B1, 0, 1); PG8_STAGE(PG8_SB(0, 0), b2, voffB);
            PG8_BAR; PG8_WAIT_L(0); PG8_MMA(0, 1, At, B1); PG8_BAR;
            PG8_LDA(At, 0, 1); PG8_STAGE(PG8_SA(0, 0), a2, voffA);
            PG8_BAR; PG8_WAIT_L(0); PG8_MMA(1, 0, At, B0); PG8_BAR; PG8_SCHED;
            PG8_STAGE(PG8_SB(0, 1), b2 + hstep, voffB);
            PG8_WAIT_V(6); PG8_BAR; PG8_MMA(1, 1, At, B1); PG8_BAR;
            PG8_LDB(B0, 1, 0); PG8_SCHED; PG8_LDA(At, 1, 0); PG8_STAGE(PG8_SA(0, 1), a2 + hstep, voffA);
            PG8_WAIT_L(8); PG8_BAR; PG8_WAIT_L(0); PG8_MMA(0, 0, At, B0); PG8_BAR; PG8_SCHED;
            PG8_LDB(B1, 1, 1); PG8_STAGE(PG8_SB(1, 0), b3, voffB);
            PG8_BAR; PG8_WAIT_L(0); PG8_MMA(0, 1, At, B1); PG8_BAR;
            PG8_LDA(At, 1, 1); PG8_STAGE(PG8_SA(1, 0), a3, voffA);
            PG8_BAR; PG8_WAIT_L(0); PG8_MMA(1, 0, At, B0); PG8_BAR; PG8_SCHED;
            PG8_STAGE(PG8_SB(1, 1), b3 + hstep, voffB);
            PG8_WAIT_V(6); PG8_BAR; PG8_MMA(1, 1, At, B1); PG8_BAR;
        }
        PG8_STAMP();
        if constexpr (!Epi::AFTER_DRAIN) { E(acc, cur, wr, wc, fr, fq); S.done(cur); }
        PG8_STAMP();
        if (!has_next) break;
#pragma unroll
        for (int a = 0; a < 2; ++a)
#pragma unroll
            for (int b = 0; b < 2; ++b)
#pragma unroll
                for (int m = 0; m < 4; ++m)
#pragma unroll
                    for (int n = 0; n < 2; ++n) acc[a][b][m][n] = (f32x4){0.f, 0.f, 0.f, 0.f};
        cur = nxt; cA = nA; cB = nB; ++ui;
    }
    PG8_WAIT_V(0);
    if (wr == 0) PG8_BAR;
    PG8_BAR;
    if constexpr (Epi::AFTER_DRAIN) { E.fused(acc, cur, wr, wc, fr, fq, lds, wid, lane); S.done(cur); }
    PG8_STAMP();
    if (STAMP && wid == 0) { stamps[lane] = lane < nts ? (((unsigned long long)(unsigned)ts_hi << 32) | (unsigned)ts_lo) : 0ull;
        if (lane == 62) stamps[62] = rt_entry; if (lane == 63) stamps[63] = (unsigned long long)wall_clock64(); }
#undef PG8_STAMP
#undef PG8_SA
#undef PG8_SB
#undef PG8_STAGE
#undef PG8_LDA
#undef PG8_LDB
#undef PG8_MMA
#undef PG8_WAIT_V
#undef PG8_WAIT_L
#undef PG8_BAR
#undef PG8_SCHED
}
}


#define LAS __attribute__((address_space(3)))
#define XB_TMO      128
#define XB_XCNT(j)  (256  + 64 * (j))
#define XB_XSUB(j)  (1280 + 64 * (j))
#define XB_XGEN(j)  (2304 + 64 * (j))
#define XB_TOP      3328
#define XB_TOPGEN   3392
#define XCD_BAR_WORDS 3456
#define XB_SPIN_CAP (1u << 18)

__device__ __forceinline__ unsigned xb_ld(unsigned* p)              { return __hip_atomic_load(p, __ATOMIC_RELAXED, __HIP_MEMORY_SCOPE_AGENT); }
__device__ __forceinline__ unsigned xb_add(unsigned* p, unsigned v) { return __hip_atomic_fetch_add(p, v, __ATOMIC_RELAXED, __HIP_MEMORY_SCOPE_AGENT); }
__device__ __forceinline__ unsigned xb_xcc_id() { return (unsigned)__builtin_amdgcn_s_getreg((3 << 11) | 20) & 0xFu; }
#define XB_SPIN(cond, bar) do { unsigned _sp = 0; while (cond) { __builtin_amdgcn_s_sleep(1); \
    if ((++_sp & 255u) == 0u) { if (xb_ld(&(bar)[XB_TMO])) break; if (_sp > XB_SPIN_CAP) { atomicAdd(&(bar)[XB_TMO], 1u); break; } } } } while (0)

struct XcdBarrier {
    unsigned* bar; unsigned x;
    volatile LAS unsigned* st;
};

__device__ __forceinline__ XcdBarrier xcd_barrier_post(unsigned* bar, volatile LAS unsigned* st) {
    XcdBarrier b; b.bar = bar; b.x = xb_xcc_id(); b.st = st;
    if (threadIdx.x == 0) (void)xb_add(&bar[XB_XCNT(b.x)], 1u);
    return b;
}
__device__ __forceinline__ void xcd_barrier_complete(unsigned* bar, unsigned x, unsigned& nloc, unsigned& nx) {
    const unsigned G = gridDim.x * gridDim.y * gridDim.z;
    unsigned sum, cnt, mine, sp = 0u;
    for (;;) {
        sum = 0u; cnt = 0u; mine = 0u;
#pragma unroll
        for (unsigned j = 0; j < 16; ++j) { const unsigned c = xb_ld(&bar[XB_XCNT(j)]); sum += c; cnt += (c > 0u) ? 1u : 0u; mine = (j == x) ? c : mine; }
        if (sum == G) break;
        __builtin_amdgcn_s_sleep(1);
        if ((++sp & 255u) == 0u) { if (xb_ld(&bar[XB_TMO])) break; if (sp > XB_SPIN_CAP) { atomicAdd(&bar[XB_TMO], 1u); break; } }
    }
    nloc = mine > 0u ? mine : 1u; nx = cnt > 0u ? cnt : 1u;
}

__device__ __forceinline__ void xcd_barrier(const XcdBarrier& b) {
    asm volatile("s_waitcnt vmcnt(0)" ::: "memory");
    __syncthreads();
    if (threadIdx.x == 0) {
        unsigned* bar = b.bar;
        __builtin_amdgcn_s_waitcnt(0);
        unsigned nloc = b.st[0], nx = b.st[1];
        if (nloc == 0u) { xcd_barrier_complete(bar, b.x, nloc, nx); b.st[0] = nloc; b.st[1] = nx; }
        const unsigned old = xb_add(&bar[XB_XSUB(b.x)], 1u);
        const unsigned gen = old / nloc;
        if (old + 1u == (gen + 1u) * nloc) {
            __builtin_amdgcn_fence(__ATOMIC_RELEASE, "agent");
            asm volatile("s_waitcnt vmcnt(0)" ::: "memory");
            const unsigned og = xb_add(&bar[XB_TOP], 1u);
            const unsigned tg = og / nx;
            if (og + 1u == (tg + 1u) * nx) xb_add(&bar[XB_TOPGEN], 1u);
            else XB_SPIN(xb_ld(&bar[XB_TOPGEN]) == tg, bar);
            __builtin_amdgcn_fence(__ATOMIC_ACQUIRE, "agent");
            xb_add(&bar[XB_XGEN(b.x)], 1u);
            asm volatile("s_waitcnt vmcnt(0)" ::: "memory");
        } else {
            XB_SPIN(xb_ld(&bar[XB_XGEN(b.x)]) == gen, bar);
            __builtin_amdgcn_fence(__ATOMIC_ACQUIRE, "agent");
            asm volatile("s_waitcnt vmcnt(0)" ::: "memory");
        }
    }
    __syncthreads();
}

typedef CfgT<RC> C;
constexpr int NTHREADS = 512, NWAVES = 8;
constexpr int LDS_STAGE = 131072, LDS_CTL = LDS_STAGE, LDS_BYTES = LDS_STAGE + 256;

namespace pg8 {
typedef unsigned u32x2 __attribute__((ext_vector_type(2)));
__device__ __forceinline__ float silu_f(float g) { return g * __builtin_amdgcn_rcpf(1.0f + __expf(-g)); }
struct EpiSwiGLU { static constexpr bool PERM = true, AFTER_DRAIN = false;
    bf16_t* act; const float* ss; int ff; float invd;
    __device__ __forceinline__ void operator()(const f32x4 (&acc)[2][2][4][2], const Unit& u, int wr, int wc, int fr, int fq) const {
        const int row0 = u.pm * BM + wr * 64 + fr, col = u.pn * 128 + wc * 32 + 8 * fq;
#pragma unroll
        for (int ai = 0; ai < 2; ++ai)
#pragma unroll
            for (int m = 0; m < 4; ++m) { const int row = row0 + ai * HALF + m * 16; const float rs = rsqrtf(ss[row] * invd + 1e-6f);
                f32x4 v[2];
#pragma unroll
                for (int n = 0; n < 2; ++n) { const f32x4 g = acc[ai][0][m][n] * rs, up = acc[ai][1][m][n] * rs;
#pragma unroll
                    for (int j = 0; j < 4; ++j) v[n][j] = silu_f(g[j]) * up[j]; }
                u32x4 w; w.x = cvt_pk_bf16(v[0][0], v[0][1]); w.y = cvt_pk_bf16(v[0][2], v[0][3]); w.z = cvt_pk_bf16(v[1][0], v[1][1]); w.w = cvt_pk_bf16(v[1][2], v[1][3]);
                *(u32x4*)(act + (size_t)row * ff + col) = w; }
    }
};
struct EpiResid { static constexpr bool PERM = false, AFTER_DRAIN = false;
    float* X; bf16_t* XB; float* ssout; float scale; int ld;
    __device__ __forceinline__ void operator()(const f32x4 (&acc)[2][2][4][2], const Unit& u, int wr, int wc, int fr, int fq) const {
        const int row0 = u.pm * BM + wr * 64 + fr, col0 = u.pn * BM + wc * 32 + 4 * fq;
#pragma unroll
        for (int ai = 0; ai < 2; ++ai)
#pragma unroll
            for (int m = 0; m < 4; ++m) { const int row = row0 + ai * HALF + m * 16; float* xr = X + (size_t)row * ld + col0; bf16_t* br = XB + (size_t)row * ld + col0; float s = 0.f;
#pragma unroll
                for (int bj = 0; bj < 2; ++bj)
#pragma unroll
                    for (int n = 0; n < 2; ++n) { f32x4 x = *(const f32x4*)(xr + bj * HALF + n * 16) + acc[ai][bj][m][n] * scale; *(f32x4*)(xr + bj * HALF + n * 16) = x;
                        u32x2 w; w.x = cvt_pk_bf16(x[0], x[1]); w.y = cvt_pk_bf16(x[2], x[3]); *(u32x2*)(br + bj * HALF + n * 16) = w;
                        s += (x[0] * x[0] + x[1] * x[1]) + (x[2] * x[2] + x[3] * x[3]); }
                s += __shfl_xor(s, 16); s += __shfl_xor(s, 32);
                if (fq == 0) unsafeAtomicAdd(ssout + row, s); }
    }
};
struct EpiScaleF32 { static constexpr bool PERM = false, AFTER_DRAIN = false;
    float* Cp; int ldc; const float* ss; float invd;
    __device__ __forceinline__ void operator()(const f32x4 (&acc)[2][2][4][2], const Unit& u, int wr, int wc, int fr, int fq) const {
        const int row0 = u.pm * BM + wr * 64 + fr, col0 = u.pn * BM + wc * 32 + 4 * fq;
#pragma unroll
        for (int ai = 0; ai < 2; ++ai)
#pragma unroll
            for (int m = 0; m < 4; ++m) { const int row = row0 + ai * HALF + m * 16; const float rs = rsqrtf(ss[row] * invd + 1e-6f); float* cr = Cp + (size_t)row * ldc + col0;
#pragma unroll
                for (int bj = 0; bj < 2; ++bj)
#pragma unroll
                    for (int n = 0; n < 2; ++n) *(f32x4*)(cr + bj * HALF + n * 16) = acc[ai][bj][m][n] * rs; }
    }
};
struct EpiScaleBf16 { static constexpr bool PERM = true, AFTER_DRAIN = false;
    bf16_t* O; int ldc; const float* ss; float invd;
    __device__ __forceinline__ void operator()(const f32x4 (&acc)[2][2][4][2], const Unit& u, int wr, int wc, int fr, int fq) const {
        const int row0 = u.pm * BM + wr * 64 + fr, col0 = u.pn * BM + wc * 32 + 8 * fq;
#pragma unroll
        for (int ai = 0; ai < 2; ++ai)
#pragma unroll
            for (int m = 0; m < 4; ++m) { const int row = row0 + ai * HALF + m * 16; const float rs = rsqrtf(ss[row] * invd + 1e-6f); bf16_t* orow = O + (size_t)row * ldc + col0;
#pragma unroll
                for (int bj = 0; bj < 2; ++bj) { const f32x4 v0 = acc[ai][bj][m][0] * rs, v1 = acc[ai][bj][m][1] * rs;
                    u32x4 w; w.x = cvt_pk_bf16(v0[0], v0[1]); w.y = cvt_pk_bf16(v0[2], v0[3]); w.z = cvt_pk_bf16(v1[0], v1[1]); w.w = cvt_pk_bf16(v1[2], v1[3]);
                    *(u32x4*)(orow + bj * HALF) = w; } }
    }
};
struct EpiMemKV { static constexpr bool PERM = false, AFTER_DRAIN = false;
    float* K; float* V; const float* rstd; int d;
    __device__ __forceinline__ void operator()(const f32x4 (&acc)[2][2][4][2], const Unit& u, int wr, int wc, int fr, int fq) const {
        const int row0 = u.pm * BM + wr * 64 + fr; int ct = u.pn * BM; float* base = K; if (ct >= d) { base = V; ct -= d; }
        const int col0 = ct + wc * 32 + 4 * fq;
#pragma unroll
        for (int ai = 0; ai < 2; ++ai)
#pragma unroll
            for (int m = 0; m < 4; ++m) { const int row = row0 + ai * HALF + m * 16; const float rs = rstd[row]; float* cr = base + (size_t)row * d + col0;
#pragma unroll
                for (int bj = 0; bj < 2; ++bj)
#pragma unroll
                    for (int n = 0; n < 2; ++n) *(f32x4*)(cr + bj * HALF + n * 16) = acc[ai][bj][m][n] * rs; }
    }
};
}

__device__ __forceinline__ unsigned pk2bf(float lo, float hi) { return pg8::cvt_pk_bf16(lo, hi); }
__device__ __forceinline__ void prep_item(const float* W, int K, int Ncols, const float* g, int kind, int N, bf16_t* Bt, LAS float* scr, int item, int lane) {
    const int nblk = N / 32, kb = item / nblk, nb = item % nblk, k0 = 64 * kb, n0 = 32 * nb;
    const int sc = wsrc_col<C>(kind, n0 + (lane & 31));
#pragma unroll 8
    for (int i = 0; i < 32; ++i) { const int kk = 2 * i + (lane >> 5); float v = 0.f;
        if (sc >= 0) { v = W[(size_t)(k0 + kk) * Ncols + sc]; if (g) v *= g[k0 + kk]; }
        scr[kk * 33 + (lane & 31)] = v; }
    asm volatile("s_waitcnt lgkmcnt(0)" ::: "memory");
    const int c = lane & 7;
#pragma unroll
    for (int j = 0; j < 4; ++j) { const int n = (lane >> 3) + 8 * j; const LAS float* s = scr + (8 * c) * 33 + n;
        pg8::u32x4 o; o.x = pk2bf(s[0 * 33], s[1 * 33]); o.y = pk2bf(s[2 * 33], s[3 * 33]); o.z = pk2bf(s[4 * 33], s[5 * 33]); o.w = pk2bf(s[6 * 33], s[7 * 33]);
        *(pg8::u32x4*)(Bt + (size_t)(n0 + n) * K + k0 + 8 * c) = o; }
    asm volatile("s_waitcnt lgkmcnt(0)" ::: "memory");
}
struct WDesc { const float* W; const float* g; bf16_t* dst; int K, Ncols, kind, N; };
__device__ __forceinline__ WDesc wdesc(const Ptrs& p, int l, int idx) {
    WDesc d; d.g = nullptr; d.kind = WK_PLAIN;
    switch (idx) {
    case 0: d.W = p.in[I_W1IN] + (size_t)l * C::D * 2 * C::FF; d.K = C::D; d.Ncols = 2 * C::FF; d.N = 2 * C::FF; d.g = p.in[I_GFFN1] + l * C::D; d.kind = WK_FFNIN; d.dst = wlayer<C>(p, l, C::W_1IN); break;
    case 1: d.W = p.in[I_W1OUT] + (size_t)l * C::FF * C::D; d.K = C::FF; d.Ncols = C::D; d.N = C::D; d.dst = wlayer<C>(p, l, C::W_1OUT); break;
    case 2: d.W = p.in[I_WIN] + (size_t)l * C::D * C::INC; d.K = C::D; d.Ncols = C::INC; d.N = C::LDP; d.g = p.in[I_GMIX] + l * C::D; d.kind = WK_WIN; d.dst = wlayer<C>(p, l, C::W_IN); break;
    case 3: d.W = p.in[I_WOUT] + (size_t)l * C::D * C::D; d.K = C::D; d.Ncols = C::D; d.N = C::D; d.dst = wlayer<C>(p, l, C::W_OUT); break;
    case 4: d.W = p.in[I_WQ] + (size_t)l * C::D * C::D; d.K = C::D; d.Ncols = C::D; d.N = C::D; d.g = p.in[I_GX] + l * C::D; d.dst = wlayer<C>(p, l, C::W_Q); break;
    case 5: d.W = p.in[I_WK] + (size_t)l * C::D * C::D; d.K = C::D; d.Ncols = C::D; d.N = C::D; d.g = p.in[I_GMEM] + l * C::D; d.dst = wlayer<C>(p, l, C::W_KV); break;
    case 6: d.W = p.in[I_WV] + (size_t)l * C::D * C::D; d.K = C::D; d.Ncols = C::D; d.N = C::D; d.g = p.in[I_GMEM] + l * C::D; d.dst = wlayer<C>(p, l, C::W_KV) + (size_t)C::D * C::D; break;
    case 7: d.W = p.in[I_WO] + (size_t)l * C::D * C::D; d.K = C::D; d.Ncols = C::D; d.N = C::D; d.dst = wlayer<C>(p, l, C::W_O); break;
    case 8: d.W = p.in[I_W2IN] + (size_t)l * C::D * 2 * C::FF; d.K = C::D; d.Ncols = 2 * C::FF; d.N = 2 * C::FF; d.g = p.in[I_GFFN2] + l * C::D; d.kind = WK_FFNIN; d.dst = wlayer<C>(p, l, C::W_2IN); break;
    default: d.W = p.in[I_W2OUT] + (size_t)l * C::FF * C::D; d.K = C::FF; d.Ncols = C::D; d.N = C::D; d.dst = wlayer<C>(p, l, C::W_2OUT); break;
    }
    return d;
}

namespace att {
typedef short bf16x8 __attribute__((ext_vector_type(8)));
typedef short s16x4 __attribute__((ext_vector_type(4)));
typedef float f32x4 __attribute__((ext_vector_type(4)));
typedef unsigned u32x2 __attribute__((ext_vector_type(2)));
constexpr int TOK = 256, CD = 64, PITCH = 144, CBYTES = TOK * PITCH, HDIM = 512, NH = 4, LD = 2048;
constexpr int NU_P = (C::MP / 128) * NH, NU_S = C::DEC_BATCH * NH, NUNITS = NU_P + NU_S;
static_assert(C::NMEM == TOK && C::AHD == HDIM && C::AH == NH && C::D == LD && C::DEC_SEQ == 32 && C::SEQ % 128 == 0, "attention phase is built for these shapes");
__device__ __forceinline__ s16x4 tr_read(unsigned addr) { s16x4 r; asm volatile("ds_read_b64_tr_b16 %0, %1" : "=&v"(r) : "v"(addr) : "memory"); return r; }
__device__ __forceinline__ void stage_load(f32x4 (&r)[8], const float* src, int tid) {
#pragma unroll
    for (int i = 0; i < 8; ++i) { const int f = tid + 512 * i; r[i] = *(const f32x4*)(src + (size_t)(f >> 4) * LD + (f & 15) * 4); }
}
__device__ __forceinline__ void stage_store(const f32x4 (&r)[8], LAS unsigned char* buf, int tid) {
#pragma unroll
    for (int i = 0; i < 8; ++i) { const int f = tid + 512 * i; u32x2 w; w.x = pg8::cvt_pk_bf16(r[i][0], r[i][1]); w.y = pg8::cvt_pk_bf16(r[i][2], r[i][3]);
        *(LAS u32x2*)(buf + (f >> 4) * PITCH + (f & 15) * 8) = w; }
}
__device__ __forceinline__ void attn_phase(LAS unsigned char* lds, const Ptrs& p, int l, int tid) {
    const int lane = tid & 63, wave = __builtin_amdgcn_readfirstlane(tid >> 6), li = lane & 15, g = lane >> 4;
    const bf16_t* Qg = wsb<C>(p, C::WS_Q); bf16_t* AO = wsb<C>(p, C::WS_AO);
    for (int u = blockIdx.x; u < NUNITS; u += gridDim.x) {
        int row0, nrows, head; const float* kb; const float* vb;
        if (u < NU_P) { const int b = u / (NU_P / C::BATCH), rem = u % (NU_P / C::BATCH); head = rem / (C::SEQ / 128); const int qt = rem % (C::SEQ / 128);
            row0 = b * C::SEQ + qt * 128; nrows = 128;
            kb = p.out + C::OUT_MK + ((size_t)l * C::BATCH + b) * TOK * LD + head * HDIM; vb = p.out + C::OUT_MV + ((size_t)l * C::BATCH + b) * TOK * LD + head * HDIM; }
        else { const int s = u - NU_P, b = s / NH; head = s % NH; row0 = C::MP + b * C::DEC_SEQ; nrows = C::DEC_SEQ;
            kb = p.in[I_CK] + ((size_t)l * C::DEC_BATCH + b) * TOK * LD + head * HDIM; vb = p.in[I_CV] + ((size_t)l * C::DEC_BATCH + b) * TOK * LD + head * HDIM; }
        const bool active = wave * 16 < nrows;
        const int qrow = row0 + wave * 16 + li;
        bf16x8 qf[16];
        if (active) {
#pragma unroll
            for (int ks = 0; ks < 16; ++ks) qf[ks] = *(const bf16x8*)(Qg + (size_t)qrow * LD + head * HDIM + ks * 32 + g * 8);
        } else {
#pragma unroll
            for (int ks = 0; ks < 16; ++ks) qf[ks] = (bf16x8){0, 0, 0, 0, 0, 0, 0, 0};
        }
        f32x4 s[16];
#pragma unroll
        for (int T = 0; T < 16; ++T) s[T] = (f32x4){0.f, 0.f, 0.f, 0.f};
        f32x4 pre[8];
        stage_load(pre, kb, tid); stage_store(pre, lds, tid);
        __syncthreads();
#pragma unroll
        for (int c = 0; c < 8; ++c) {
            LAS unsigned char* buf = lds + (c & 1) * CBYTES;
            stage_load(pre, c < 7 ? kb + (c + 1) * CD : vb, tid);
            if (active) {
#pragma unroll
                for (int ks = 0; ks < 2; ++ks)
#pragma unroll
                    for (int T = 0; T < 16; ++T) { const bf16x8 a = *(const LAS bf16x8*)(buf + (T * 16 + li) * PITCH + ks * 64 + g * 16);
                        s[T] = __builtin_amdgcn_mfma_f32_16x16x32_bf16(a, qf[2 * c + ks], s[T], 0, 0, 0); }
            }
            stage_store(pre, lds + ((c + 1) & 1) * CBYTES, tid);
            __syncthreads();
        }
        float mx = -3.0e38f;
#pragma unroll
        for (int T = 0; T < 16; ++T) { mx = fmaxf(mx, fmaxf(fmaxf(s[T][0], s[T][1]), fmaxf(s[T][2], s[T][3]))); }
        mx = fmaxf(mx, __shfl_xor(mx, 16)); mx = fmaxf(mx, __shfl_xor(mx, 32));
        const float sc = 0.044194173824159216f * 1.4426950408889634f;
        float sum = 0.f;
#pragma unroll
        for (int T = 0; T < 16; ++T)
#pragma unroll
            for (int j = 0; j < 4; ++j) { const float e = __builtin_amdgcn_exp2f((s[T][j] - mx) * sc); s[T][j] = e; sum += e; }
        sum += __shfl_xor(sum, 16); sum += __shfl_xor(sum, 32);
        const float inv = 1.0f / sum;
        bf16x8 pf[8];
#pragma unroll
        for (int t = 0; t < 8; ++t) { const unsigned w0 = pg8::cvt_pk_bf16(s[2 * t][0], s[2 * t][1]), w1 = pg8::cvt_pk_bf16(s[2 * t][2], s[2 * t][3]),
                w2 = pg8::cvt_pk_bf16(s[2 * t + 1][0], s[2 * t + 1][1]), w3 = pg8::cvt_pk_bf16(s[2 * t + 1][2], s[2 * t + 1][3]);
            pg8::u32x4 w; w.x = w0; w.y = w1; w.z = w2; w.w = w3; pf[t] = __builtin_bit_cast(bf16x8, w); }
        const unsigned trb = (unsigned)(size_t)lds + (unsigned)((4 * g + (li >> 2)) * PITCH + (li & 3) * 8);
        for (int c = 0; c < 8; ++c) {
            const unsigned bofs = (unsigned)(c & 1) * CBYTES;
            if (c < 7) stage_load(pre, vb + (c + 1) * CD, tid);
            if (active) {
                f32x4 o[4];
#pragma unroll
                for (int dt = 0; dt < 4; ++dt) o[dt] = (f32x4){0.f, 0.f, 0.f, 0.f};
#pragma unroll
                for (int t = 0; t < 8; ++t) {
                    s16x4 lo[4], hi[4];
#pragma unroll
                    for (int dt = 0; dt < 4; ++dt) { lo[dt] = tr_read(trb + bofs + (unsigned)(t * 32 * PITCH + dt * 32)); hi[dt] = tr_read(trb + bofs + (unsigned)(t * 32 * PITCH + 16 * PITCH + dt * 32)); }
                    asm volatile("s_waitcnt lgkmcnt(0)" ::: "memory"); __builtin_amdgcn_sched_barrier(0);
#pragma unroll
                    for (int dt = 0; dt < 4; ++dt) { const bf16x8 a = (bf16x8){lo[dt][0], lo[dt][1], lo[dt][2], lo[dt][3], hi[dt][0], hi[dt][1], hi[dt][2], hi[dt][3]};
                        o[dt] = __builtin_amdgcn_mfma_f32_16x16x32_bf16(a, pf[t], o[dt], 0, 0, 0); }
                }
#pragma unroll
                for (int dt = 0; dt < 4; ++dt) { u32x2 w; w.x = pg8::cvt_pk_bf16(o[dt][0] * inv, o[dt][1] * inv); w.y = pg8::cvt_pk_bf16(o[dt][2] * inv, o[dt][3] * inv);
                    *(u32x2*)(AO + (size_t)qrow * LD + head * HDIM + c * CD + dt * 16 + g * 4) = w; }
            }
            if (c < 7) stage_store(pre, lds + ((c + 1) & 1) * CBYTES, tid);
            __syncthreads();
        }
    }
}
}
namespace mx {
typedef att::bf16x8 bf16x8; typedef att::s16x4 s16x4; typedef att::f32x4 f32x4; typedef att::u32x2 u32x2;
constexpr int PT = 272;
constexpr int T64 = 64 * PT, T128 = 128 * PT;
static_assert(C::MHD == 128 && C::CH == 64 && C::MH == 8 && C::LCS == 32, "mLSTM phases are built for these shapes");
__device__ __forceinline__ void lds_wait() { asm volatile("s_waitcnt lgkmcnt(0)" ::: "memory"); __builtin_amdgcn_sched_barrier(0); }
__device__ __forceinline__ bf16x8 mk8(s16x4 lo, s16x4 hi) { return (bf16x8){lo[0], lo[1], lo[2], lo[3], hi[0], hi[1], hi[2], hi[3]}; }
__device__ __forceinline__ unsigned tr_addr(unsigned tile, int krow, int c0, int li) { return tile + (unsigned)((krow + (li >> 2)) * PT + (c0 + 4 * (li & 3)) * 2); }
__device__ __forceinline__ void ch_decode(int ci, int& r0, int& h, int& lc) {
    if (ci < C::NPC) { const int c = ci % C::NC, bh = ci / C::NC; h = bh % C::MH; r0 = (bh / C::MH) * C::SEQ + c * C::CH; lc = C::CH; }
    else { const int q = ci - C::NPC; h = q % C::MH; r0 = C::MP + (q / C::MH) * C::DEC_SEQ; lc = C::LCS; }
}
__device__ __forceinline__ void stage64(LAS unsigned char* tile, const float* src, int ld, int lc, int tid, const LAS float* rs, float mul) {
#pragma unroll
    for (int i = 0; i < 4; ++i) { const int f = tid + 512 * i, row = f >> 5, c4 = f & 31; f32x4 v = (f32x4){0.f, 0.f, 0.f, 0.f};
        if (row < lc) { v = *(const f32x4*)(src + (size_t)row * ld + c4 * 4); const float m = rs ? rs[row] * mul : mul; v = v * m; }
        u32x2 w; w.x = pg8::cvt_pk_bf16(v[0], v[1]); w.y = pg8::cvt_pk_bf16(v[2], v[3]); *(LAS u32x2*)(tile + row * PT + c4 * 8) = w; }
}
__device__ __forceinline__ void ml_phase_a(LAS unsigned char* lds, const Ptrs& p, int l, int tid) {
    const int lane = tid & 63, wave = __builtin_amdgcn_readfirstlane(tid >> 6), li = lane & 15, g = lane >> 4;
    LAS unsigned char* Ks = lds; LAS unsigned char* Vs = lds + T64; LAS float* wts = (LAS float*)(lds + 2 * T64);
    const float* P = wsf<C>(p, C::WS_BIG);
    for (int ci = blockIdx.x; ci < C::NCH; ci += gridDim.x) {
        int r0, h, lc; ch_decode(ci, r0, h, lc);
        if (wave == 0) {
            float lf = 0.f, ig = -3.0e38f;
            if (lane < lc) { const float* pr = P + (size_t)(r0 + lane) * C::LDP; ig = pr[C::O_IG + h] + p.in[I_IB][l * C::MH + h]; lf = logsigmoidf_(pr[C::O_FG + h] + p.in[I_FB][l * C::MH + h]); }
            float b = lf;
#pragma unroll
            for (int o = 1; o < 64; o <<= 1) { const float t = __shfl_up(b, o); if (lane >= o) b += t; }
            const float a = lane < lc ? ig - b : -3.0e38f;
            float amax = a;
#pragma unroll
            for (int o = 1; o < 64; o <<= 1) amax = fmaxf(amax, __shfl_xor(amax, o));
            const float bL = __shfl(b, lc - 1), mloc = bL + amax;
            const float wt = lane < lc ? __expf(bL + a - mloc) : 0.f;
            wts[lane] = wt;
            if (lane < lc) { wsf<C>(p, C::WS_GB)[(size_t)(r0 + lane) * C::MH + h] = b; wsf<C>(p, C::WS_GA)[(size_t)(r0 + lane) * C::MH + h] = a; }
            if (lane == 0) { wsf<C>(p, C::WS_CBL)[ci] = bL; wsf<C>(p, C::WS_CML)[ci] = mloc; }
        }
        __syncthreads();
        stage64(Ks, P + (size_t)r0 * C::LDP + C::O_K + h * C::MHD, C::LDP, lc, tid, wts, 0.08838834764831845f);
        stage64(Vs, P + (size_t)r0 * C::LDP + C::O_VM + h * C::MHD, C::LDP, lc, tid, nullptr, 1.0f);
        __syncthreads();
        f32x4 acc[8];
#pragma unroll
        for (int et = 0; et < 8; ++et) acc[et] = (f32x4){0.f, 0.f, 0.f, 0.f};
        const unsigned ks = (unsigned)(size_t)Ks, vs = (unsigned)(size_t)Vs;
#pragma unroll
        for (int t = 0; t < 2; ++t) {
            const s16x4 alo = att::tr_read(tr_addr(ks, 32 * t + 8 * g, 16 * wave, li)), ahi = att::tr_read(tr_addr(ks, 32 * t + 8 * g + 4, 16 * wave, li));
            s16x4 blo[8], bhi[8];
#pragma unroll
            for (int et = 0; et < 8; ++et) { blo[et] = att::tr_read(tr_addr(vs, 32 * t + 8 * g, 16 * et, li)); bhi[et] = att::tr_read(tr_addr(vs, 32 * t + 8 * g + 4, 16 * et, li)); }
            lds_wait();
            const bf16x8 a = mk8(alo, ahi);
#pragma unroll
            for (int et = 0; et < 8; ++et) acc[et] = __builtin_amdgcn_mfma_f32_16x16x32_bf16(a, mk8(blo[et], bhi[et]), acc[et], 0, 0, 0);
        }
        float* DC = wsf<C>(p, C::WS_DC) + (size_t)ci * C::MHD * C::MHD;
#pragma unroll
        for (int et = 0; et < 8; ++et)
#pragma unroll
            for (int r = 0; r < 4; ++r) DC[(size_t)(16 * wave + 4 * g + r) * C::MHD + 16 * et + li] = acc[et][r];
        if (tid < C::MHD) { float s = 0.f; for (int t = 0; t < 64; ++t) s += bf2f(*(const LAS bf16_t*)(Ks + t * PT + tid * 2)); wsf<C>(p, C::WS_DN)[(size_t)ci * C::MHD + tid] = s; }
        __syncthreads();
    }
}
__device__ __forceinline__ void ml_phase_c(LAS unsigned char* lds, const Ptrs& p, int l, int tid) {
    const int lane = tid & 63, wave = __builtin_amdgcn_readfirstlane(tid >> 6), li = lane & 15, g = lane >> 4, it = wave & 3, eh = wave >> 2;
    LAS unsigned char* Qs = lds; LAS unsigned char* Ks = lds + T64; LAS unsigned char* Vs = lds + 2 * T64; LAS unsigned char* Cs = lds + 3 * T64;
    LAS float* sb = (LAS float*)(lds + 3 * T64 + T128);
    LAS float* sa = sb + 64; LAS float* smr = sb + 128; LAS float* siw = sb + 192; LAS float* snp = sb + 256; LAS float* ssq = sb + 384;
    const float* P = wsf<C>(p, C::WS_BIG);
    for (int ci = blockIdx.x; ci < C::NCH; ci += gridDim.x) {
        int r0, h, lc; ch_decode(ci, r0, h, lc);
        const bool sample = ci >= C::NPC, first = !sample && (ci % C::NC) == 0;
        const float mprev = wsf<C>(p, C::WS_MPREV)[ci];
        if (wave == 0) {
            float b = 0.f, a = -3.0e38f;
            if (lane < lc) { b = wsf<C>(p, C::WS_GB)[(size_t)(r0 + lane) * C::MH + h]; a = wsf<C>(p, C::WS_GA)[(size_t)(r0 + lane) * C::MH + h]; }
            float pm = a;
#pragma unroll
            for (int o = 1; o < 64; o <<= 1) { const float t = __shfl_up(pm, o); if (lane >= o) pm = fmaxf(pm, t); }
            const float mrow = b + fmaxf(mprev, pm);
            sb[lane] = b; sa[lane] = a; smr[lane] = mrow; siw[lane] = __expf(b + mprev - mrow);
        }
        if (tid >= 128 && tid < 256) { const int d = tid - 128;
            snp[d] = sample ? p.in[I_SN][((size_t)l * C::NSC + (ci - C::NPC)) * C::MHD + d] : (first ? 0.f : wsf<C>(p, C::WS_DN)[(size_t)(ci - 1) * C::MHD + d]); }
        stage64(Qs, P + (size_t)r0 * C::LDP + C::O_Q + h * C::MHD, C::LDP, lc, tid, nullptr, 1.0f);
        stage64(Ks, P + (size_t)r0 * C::LDP + C::O_K + h * C::MHD, C::LDP, lc, tid, nullptr, 0.08838834764831845f);
        stage64(Vs, P + (size_t)r0 * C::LDP + C::O_VM + h * C::MHD, C::LDP, lc, tid, nullptr, 1.0f);
        { const float* cp = sample ? p.in[I_SC] + ((size_t)l * C::NSC + (ci - C::NPC)) * C::MHD * C::MHD : wsf<C>(p, C::WS_DC) + (size_t)(first ? ci : ci - 1) * C::MHD * C::MHD;
#pragma unroll
            for (int i = 0; i < 8; ++i) { const int f = tid + 512 * i, row = f >> 5, c4 = f & 31; f32x4 v = (f32x4){0.f, 0.f, 0.f, 0.f};
                if (!first) v = *(const f32x4*)(cp + (size_t)row * C::MHD + c4 * 4);
                u32x2 w; w.x = pg8::cvt_pk_bf16(v[0], v[1]); w.y = pg8::cvt_pk_bf16(v[2], v[3]); *(LAS u32x2*)(Cs + row * PT + c4 * 8) = w; } }
        __syncthreads();
        const bool active = it * 16 < lc;
        float ssq_part = 0.f; f32x4 hv[4]; float inv_den = 0.f;
        const int i = 16 * it + li;
        if (active) {
            bf16x8 qf[4];
#pragma unroll
            for (int ks = 0; ks < 4; ++ks) qf[ks] = *(const LAS bf16x8*)(Qs + i * PT + ks * 64 + g * 16);
            f32x4 st[4];
#pragma unroll
            for (int jt = 0; jt < 4; ++jt) st[jt] = (f32x4){0.f, 0.f, 0.f, 0.f};
#pragma unroll
            for (int jt = 0; jt < 4; ++jt) if (jt <= it) {
#pragma unroll
                for (int ks = 0; ks < 4; ++ks) { const bf16x8 a = *(const LAS bf16x8*)(Ks + (16 * jt + li) * PT + ks * 64 + g * 16);
                    st[jt] = __builtin_amdgcn_mfma_f32_16x16x32_bf16(a, qf[ks], st[jt], 0, 0, 0); } }
            const float bi = sb[i], mri = smr[i], iwi = siw[i];
            float dsum = 0.f;
#pragma unroll
            for (int jt = 0; jt < 4; ++jt)
#pragma unroll
                for (int r = 0; r < 4; ++r) { const int j = 16 * jt + 4 * g + r; const float w = (j <= i) ? __expf(bi + sa[j] - mri) : 0.f; st[jt][r] *= w; dsum += st[jt][r]; }
            dsum += __shfl_xor(dsum, 16); dsum += __shfl_xor(dsum, 32);
            float qn = 0.f;
#pragma unroll
            for (int ks = 0; ks < 4; ++ks)
#pragma unroll
                for (int jj = 0; jj < 8; ++jj) qn += bf2f((bf16_t)qf[ks][jj]) * snp[32 * ks + 8 * g + jj];
            qn += __shfl_xor(qn, 16); qn += __shfl_xor(qn, 32);
            const float den = dsum + iwi * qn;
            inv_den = 1.0f / fmaxf(fabsf(den), __expf(-mri));
            bf16x8 pf[2];
#pragma unroll
            for (int t = 0; t < 2; ++t) { pg8::u32x4 w; w.x = pg8::cvt_pk_bf16(st[2 * t][0], st[2 * t][1]); w.y = pg8::cvt_pk_bf16(st[2 * t][2], st[2 * t][3]);
                w.z = pg8::cvt_pk_bf16(st[2 * t + 1][0], st[2 * t + 1][1]); w.w = pg8::cvt_pk_bf16(st[2 * t + 1][2], st[2 * t + 1][3]); pf[t] = __builtin_bit_cast(bf16x8, w); }
            const unsigned vs = (unsigned)(size_t)Vs, cs = (unsigned)(size_t)Cs;
#pragma unroll
            for (int e4 = 0; e4 < 4; ++e4) { const int et = 4 * eh + e4;
                s16x4 vlo[2], vhi[2], clo[4], chi[4];
#pragma unroll
                for (int t = 0; t < 2; ++t) { vlo[t] = att::tr_read(tr_addr(vs, 32 * t + 4 * g, 16 * et, li)); vhi[t] = att::tr_read(tr_addr(vs, 32 * t + 16 + 4 * g, 16 * et, li)); }
#pragma unroll
                for (int ks = 0; ks < 4; ++ks) { clo[ks] = att::tr_read(tr_addr(cs, 32 * ks + 8 * g, 16 * et, li)); chi[ks] = att::tr_read(tr_addr(cs, 32 * ks + 8 * g + 4, 16 * et, li)); }
                lds_wait();
                f32x4 aS = (f32x4){0.f, 0.f, 0.f, 0.f}, aC = (f32x4){0.f, 0.f, 0.f, 0.f};
#pragma unroll
                for (int t = 0; t < 2; ++t) aS = __builtin_amdgcn_mfma_f32_16x16x32_bf16(mk8(vlo[t], vhi[t]), pf[t], aS, 0, 0, 0);
#pragma unroll
                for (int ks = 0; ks < 4; ++ks) aC = __builtin_amdgcn_mfma_f32_16x16x32_bf16(mk8(clo[ks], chi[ks]), qf[ks], aC, 0, 0, 0);
                hv[e4] = (aS + aC * iwi) * inv_den;
                ssq_part += (hv[e4][0] * hv[e4][0] + hv[e4][1] * hv[e4][1]) + (hv[e4][2] * hv[e4][2] + hv[e4][3] * hv[e4][3]); }
            ssq_part += __shfl_xor(ssq_part, 16); ssq_part += __shfl_xor(ssq_part, 32);
            if (g == 0) ssq[wave * 16 + li] = ssq_part;
        }
        __syncthreads();
        if (active) {
            const float tot = ssq_part + ssq[(wave ^ 4) * 16 + li];
            const float rs = rsqrtf(tot * (1.0f / C::MHD) + 1e-6f);
            const int row = r0 + i;
#pragma unroll
            for (int e4 = 0; e4 < 4; ++e4) { const int e = 16 * (4 * eh + e4) + 4 * g;
                const f32x4 og = *(const f32x4*)(P + (size_t)row * C::LDP + C::O_O + h * C::MHD + e); const f32x4 gn = *(const f32x4*)(p.in[I_NG] + (size_t)l * C::MW + h * C::MHD + e);
                float o4[4];
#pragma unroll
                for (int r = 0; r < 4; ++r) o4[r] = hv[e4][r] * rs * gn[r] * __builtin_amdgcn_rcpf(1.0f + __expf(-og[r]));
                u32x2 w; w.x = pg8::cvt_pk_bf16(o4[0], o4[1]); w.y = pg8::cvt_pk_bf16(o4[2], o4[3]);
                *(u32x2*)(wsb<C>(p, C::WS_MIX) + (size_t)row * C::D + C::PW + C::GW + h * C::MHD + e) = w; }
        }
        __syncthreads();
    }
}
}
namespace rw {
typedef att::f32x4 f32x4; typedef att::u32x2 u32x2;
static_assert(C::D == 2048, "row ops assume 2048 columns = 8 float4 per lane");
__device__ __forceinline__ float wave_sum(float v) {
#pragma unroll
    for (int o = 1; o < 64; o <<= 1) v += __shfl_xor(v, o);
    return v;
}
__device__ __forceinline__ void rows_init(const Ptrs& p, int tid) {
    const int lane = tid & 63, gw = blockIdx.x * NWAVES + (tid >> 6), NGW = gridDim.x * NWAVES;
    float* SS = wsf<C>(p, C::WS_SS);
    for (int r = gw; r < C::M; r += NGW) {
        const float* src = r < C::MP ? p.in[I_XP] + (size_t)r * C::D : p.in[I_XS] + (size_t)(r - C::MP) * C::D;
        float* X = wsf<C>(p, C::WS_X) + (size_t)r * C::D; bf16_t* XB = wsb<C>(p, C::WS_XB) + (size_t)r * C::D;
        float ss = 0.f;
#pragma unroll
        for (int j = 0; j < 8; ++j) { const f32x4 v = *(const f32x4*)(src + (lane + 64 * j) * 4); *(f32x4*)(X + (lane + 64 * j) * 4) = v;
            u32x2 w; w.x = pg8::cvt_pk_bf16(v[0], v[1]); w.y = pg8::cvt_pk_bf16(v[2], v[3]); *(u32x2*)(XB + (lane + 64 * j) * 4) = w;
            ss += (v[0] * v[0] + v[1] * v[1]) + (v[2] * v[2] + v[3] * v[3]); }
        ss = wave_sum(ss);
        if (lane < C::NSS) SS[(size_t)lane * C::M + r] = lane == 0 ? ss : 0.f;
    }
    for (int r = gw; r < C::MM; r += NGW) {
        const float* src = p.in[I_MEM] + (size_t)r * C::D; bf16_t* MB = wsb<C>(p, C::WS_MEMB) + (size_t)r * C::D;
        float ss = 0.f;
#pragma unroll
        for (int j = 0; j < 8; ++j) { const f32x4 v = *(const f32x4*)(src + (lane + 64 * j) * 4);
            u32x2 w; w.x = pg8::cvt_pk_bf16(v[0], v[1]); w.y = pg8::cvt_pk_bf16(v[2], v[3]); *(u32x2*)(MB + (lane + 64 * j) * 4) = w;
            ss += (v[0] * v[0] + v[1] * v[1]) + (v[2] * v[2] + v[3] * v[3]); }
        ss = wave_sum(ss);
        if (lane == 0) wsf<C>(p, C::WS_RSTDM)[r] = rsqrtf(ss * (1.0f / C::D) + 1e-6f);
    }
}
__device__ __forceinline__ void rows_final(const Ptrs& p, int tid) {
    const int lane = tid & 63, gw = blockIdx.x * NWAVES + (tid >> 6), NGW = gridDim.x * NWAVES;
    for (int r = gw; r < C::M; r += NGW) {
        const float* X = wsf<C>(p, C::WS_X) + (size_t)r * C::D; const float rs = rsqrtf(wsf<C>(p, C::WS_SS)[(size_t)(C::NSS - 1) * C::M + r] * (1.0f / C::D) + 1e-6f);
        float* o = r < C::MP ? p.out + C::OUT_YP + (size_t)r * C::D : p.out + C::OUT_YS + (size_t)(r - C::MP) * C::D;
#pragma unroll
        for (int j = 0; j < 8; ++j) { const f32x4 v = *(const f32x4*)(X + (lane + 64 * j) * 4); const f32x4 gg = *(const f32x4*)(p.in[I_GFIN] + (lane + 64 * j) * 4);
            *(f32x4*)(o + (lane + 64 * j) * 4) = v * rs * gg; }
    }
}
__device__ __forceinline__ void ml_scan(const Ptrs& p, int l, long gtid, long gthreads) {
    const float* CBL = wsf<C>(p, C::WS_CBL); const float* CML = wsf<C>(p, C::WS_CML);
    float* DC = wsf<C>(p, C::WS_DC); float* DN = wsf<C>(p, C::WS_DN);
    constexpr int NPS = C::BATCH * C::MH, E4 = C::MHD / 4;
    for (long it = gtid; it < (long)NPS * C::MHD * E4; it += gthreads) {
        const int e4 = (int)(it % E4), d = (int)((it / E4) % C::MHD), sq = (int)(it / ((long)E4 * C::MHD));
        float m = 0.f; f32x4 cst = (f32x4){0.f, 0.f, 0.f, 0.f};
        for (int c = 0; c < C::NC; ++c) { const int ci = sq * C::NC + c; const float a = CBL[ci] + m, b2 = CML[ci], mn = fmaxf(a, b2), dec = __expf(a - mn), f = __expf(b2 - mn);
            f32x4* q = (f32x4*)(DC + ((size_t)ci * C::MHD + d) * C::MHD + e4 * 4); cst = cst * dec + *q * f; *q = cst; m = mn; }
        *(f32x4*)(p.out + C::OUT_CP + (((size_t)l * NPS + sq) * C::MHD + d) * C::MHD + e4 * 4) = cst;
    }
    for (long it = gtid; it < (long)NPS * C::MHD; it += gthreads) {
        const int d = (int)(it % C::MHD), sq = (int)(it / C::MHD);
        float m = 0.f, nst = 0.f;
        for (int c = 0; c < C::NC; ++c) { const int ci = sq * C::NC + c; const float a = CBL[ci] + m, b2 = CML[ci], mn = fmaxf(a, b2), dec = __expf(a - mn), f = __expf(b2 - mn);
            const size_t on = (size_t)ci * C::MHD + d; nst = dec * nst + f * DN[on]; DN[on] = nst; m = mn; }
        p.out[C::OUT_NP + ((size_t)l * NPS + sq) * C::MHD + d] = nst;
    }
    for (long it = gtid; it < (long)C::NSC * C::MHD * E4; it += gthreads) {
        const int e4 = (int)(it % E4), d = (int)((it / E4) % C::MHD), q = (int)(it / ((long)E4 * C::MHD)), ci = C::NPC + q;
        const float m0 = p.in[I_SM][(size_t)l * C::NSC + q], a = CBL[ci] + m0, b2 = CML[ci], mn = fmaxf(a, b2), dec = __expf(a - mn), f = __expf(b2 - mn);
        const size_t so = (((size_t)l * C::NSC + q) * C::MHD + d) * C::MHD + e4 * 4;
        *(f32x4*)(p.out + C::OUT_CS + so) = *(const f32x4*)(p.in[I_SC] + so) * dec + *(const f32x4*)(DC + ((size_t)ci * C::MHD + d) * C::MHD + e4 * 4) * f;
    }
    for (long it = gtid; it < (long)C::NSC * C::MHD; it += gthreads) {
        const int d = (int)(it % C::MHD), q = (int)(it / C::MHD), ci = C::NPC + q;
        const float m0 = p.in[I_SM][(size_t)l * C::NSC + q], a = CBL[ci] + m0, b2 = CML[ci], mn = fmaxf(a, b2), dec = __expf(a - mn), f = __expf(b2 - mn);
        const size_t no = ((size_t)l * C::NSC + q) * C::MHD + d;
        p.out[C::OUT_NS + no] = dec * p.in[I_SN][no] + f * DN[(size_t)ci * C::MHD + d];
    }
}
}

namespace gp {
typedef att::bf16x8 bf16x8; typedef att::s16x4 s16x4; typedef att::f32x4 f32x4; typedef att::u32x2 u32x2;
constexpr int PT = mx::PT, T128 = mx::T128;
static_assert(C::GHD == 128 && C::PGD == 128 && C::GCH == 128 && C::SEQ % 128 == 0 && C::DEC_SEQ == 32 && C::PH == 15, "gmlp / pool phases are built for these shapes");
constexpr int NT_P = C::MP / 128;
constexpr int NU_G = NT_P * 4 + C::DEC_BATCH * 4;
__device__ __forceinline__ void gmlp_phase(LAS unsigned char* lds, const Ptrs& p, int l, int tid) {
    const int lane = tid & 63, wave = __builtin_amdgcn_readfirstlane(tid >> 6), li = lane & 15, g = lane >> 4;
    LAS unsigned char* Vs = lds; LAS unsigned char* Ws = lds + T128;
    const float* P = wsf<C>(p, C::WS_BIG);
    for (int u = blockIdx.x; u < NU_G; u += gridDim.x) {
        int r0, lc, h; bool sample = false; int sb = 0;
        if (u < NT_P * 4) { h = u & 3; r0 = (u >> 2) * 128; lc = 128; } else { const int s = u - NT_P * 4; h = s & 3; sb = s >> 2; r0 = C::MP + sb * C::DEC_SEQ; lc = C::DEC_SEQ; sample = true; }
#pragma unroll
        for (int i = 0; i < 8; ++i) { const int f = tid + 512 * i, row = f >> 5, c4 = f & 31; f32x4 v = (f32x4){0.f, 0.f, 0.f, 0.f};
            if (row < lc) v = *(const f32x4*)(P + (size_t)(r0 + row) * C::LDP + C::O_V + h * 128 + c4 * 4);
            float ss = (v[0] * v[0] + v[1] * v[1]) + (v[2] * v[2] + v[3] * v[3]);
#pragma unroll
            for (int o = 1; o < 32; o <<= 1) ss += __shfl_xor(ss, o);
            const float rs = rsqrtf(ss * (1.0f / 128) + 1e-6f); const f32x4 gn = *(const f32x4*)(p.in[I_GVG] + (size_t)l * C::GW + h * 128 + c4 * 4);
            v = v * rs * gn;
            if (sample && row < lc) *(f32x4*)(p.out + C::OUT_VS + (((size_t)l * C::DEC_BATCH + sb) * C::DEC_SEQ + row) * C::GW + h * 128 + c4 * 4) = v;
            u32x2 w; w.x = pg8::cvt_pk_bf16(v[0], v[1]); w.y = pg8::cvt_pk_bf16(v[2], v[3]); *(LAS u32x2*)(Vs + row * PT + c4 * 8) = w; }
        const float* wsrc = p.in[I_GWS] + ((size_t)l * C::GH + h) * 128 * 128;
#pragma unroll
        for (int i = 0; i < 8; ++i) { const int f = tid + 512 * i, row = f >> 5, c4 = f & 31; f32x4 v = *(const f32x4*)(wsrc + (size_t)row * 128 + c4 * 4);
#pragma unroll
            for (int j = 0; j < 4; ++j) if (c4 * 4 + j > row) v[j] = 0.f;
            u32x2 w; w.x = pg8::cvt_pk_bf16(v[0], v[1]); w.y = pg8::cvt_pk_bf16(v[2], v[3]); *(LAS u32x2*)(Ws + row * PT + c4 * 8) = w; }
        __syncthreads();
        if (wave * 16 < lc) {
            const int i = wave * 16 + li, nks = (wave * 16 + 15) / 32 + 1;
            f32x4 acc[8];
#pragma unroll
            for (int dt = 0; dt < 8; ++dt) acc[dt] = (f32x4){0.f, 0.f, 0.f, 0.f};
            const unsigned vs = (unsigned)(size_t)Vs;
            for (int ks = 0; ks < nks; ++ks) {
                const bf16x8 bq = *(const LAS bf16x8*)(Ws + i * PT + ks * 64 + g * 16);
                s16x4 lo[8], hi[8];
#pragma unroll
                for (int dt = 0; dt < 8; ++dt) { lo[dt] = att::tr_read(mx::tr_addr(vs, 32 * ks + 8 * g, 16 * dt, li)); hi[dt] = att::tr_read(mx::tr_addr(vs, 32 * ks + 8 * g + 4, 16 * dt, li)); }
                mx::lds_wait();
#pragma unroll
                for (int dt = 0; dt < 8; ++dt) acc[dt] = __builtin_amdgcn_mfma_f32_16x16x32_bf16(mx::mk8(lo[dt], hi[dt]), bq, acc[dt], 0, 0, 0);
            }
            const float bsi = p.in[I_GBS][((size_t)l * C::GH + h) * C::GCH + i];
            const int row = r0 + i;
#pragma unroll
            for (int dt = 0; dt < 8; ++dt) { const int d = 16 * dt + 4 * g; const f32x4 uu = *(const f32x4*)(P + (size_t)row * C::LDP + C::O_U + h * 128 + d);
                u32x2 w; w.x = pg8::cvt_pk_bf16(uu[0] * (acc[dt][0] + bsi), uu[1] * (acc[dt][1] + bsi)); w.y = pg8::cvt_pk_bf16(uu[2] * (acc[dt][2] + bsi), uu[3] * (acc[dt][3] + bsi));
                *(u32x2*)(wsb<C>(p, C::WS_MIX) + (size_t)row * C::D + C::PW + h * 128 + d) = w; }
        }
        __syncthreads();
    }
}
__device__ __forceinline__ void pool_phase(LAS unsigned char* lds, const Ptrs& p, int l, int tid) {
    const int lane = tid & 63, wave = __builtin_amdgcn_readfirstlane(tid >> 6), li = lane & 15, g = lane >> 4;
    LAS unsigned char* Ds = lds; LAS unsigned char* Ws = lds + T128;
    const float* P = wsf<C>(p, C::WS_BIG);
    for (int u = blockIdx.x; u < NU_G; u += gridDim.x) {
        int r0, lc, grp, t0, L, b; bool sample = false;
        if (u < NT_P * 4) { grp = u & 3; r0 = (u >> 2) * 128; lc = 128; b = r0 / C::SEQ; t0 = r0 % C::SEQ; L = C::SEQ; } else { const int s = u - NT_P * 4; grp = s & 3; b = s >> 2; r0 = C::MP + b * C::DEC_SEQ; lc = C::DEC_SEQ; t0 = 0; L = C::DEC_SEQ; sample = true; }
        const int w = 2 << grp;
        { const int c4 = tid & 31, sg = tid >> 5, ch = grp * 128 + c4 * 4;
            const float* hist = p.in[I_SPOOL] + ((size_t)l * C::DEC_BATCH + b) * C::PH * C::PW + ch;
            auto xat = [&](int t) -> f32x4 {
                if (t >= 0) return *(const f32x4*)(P + (size_t)(r0 - t0 + t) * C::LDP + ch);
                if (sample && C::PH + t >= 0) return *(const f32x4*)(hist + (size_t)(C::PH + t) * C::PW);
                return (f32x4){0.f, 0.f, 0.f, 0.f}; };
            if (sg * 8 < lc) {
                const int ts = t0 + sg * 8;
                f32x4 sum = (f32x4){0.f, 0.f, 0.f, 0.f};
                for (int j = 1; j < w; ++j) sum = sum + xat(ts - j);
#pragma unroll
                for (int k = 0; k < 8; ++k) { const int t = ts + k; const f32x4 x = xat(t); sum = sum + x;
                    const int pos = (sample ? C::PAST : 0) + t; const float inv = 1.0f / (float)((pos + 1) < w ? (pos + 1) : w);
                    const f32x4 dv = sum * inv - x;
                    u32x2 ww; ww.x = pg8::cvt_pk_bf16(dv[0], dv[1]); ww.y = pg8::cvt_pk_bf16(dv[2], dv[3]); *(LAS u32x2*)(Ds + (sg * 8 + k) * PT + c4 * 8) = ww;
                    sum = sum - xat(t - w + 1);
                    const int idx = t - (L - C::PH);
                    if (idx >= 0) *(f32x4*)(p.out + (sample ? C::OUT_POOLS + (((size_t)l * C::DEC_BATCH + b) * C::PH + idx) * C::PW : C::OUT_POOLP + (((size_t)l * C::BATCH + b) * C::PH + idx) * C::PW) + ch) = x; }
            } else {
#pragma unroll
                for (int k = 0; k < 8; ++k) *(LAS u32x2*)(Ds + (sg * 8 + k) * PT + c4 * 8) = (u32x2){0u, 0u};
            }
        }
        const float* wsrc = p.in[I_POOLW] + ((size_t)l * C::PG + grp) * 128 * 128;
#pragma unroll
        for (int i = 0; i < 8; ++i) { const int f = tid + 512 * i, row = f >> 5, c4 = f & 31; const f32x4 v = *(const f32x4*)(wsrc + (size_t)row * 128 + c4 * 4);
            u32x2 ww; ww.x = pg8::cvt_pk_bf16(v[0], v[1]); ww.y = pg8::cvt_pk_bf16(v[2], v[3]); *(LAS u32x2*)(Ws + row * PT + c4 * 8) = ww; }
        __syncthreads();
        if (wave * 16 < lc) {
            const int t = wave * 16 + li;
            f32x4 acc[8];
#pragma unroll
            for (int et = 0; et < 8; ++et) acc[et] = (f32x4){0.f, 0.f, 0.f, 0.f};
            const unsigned wsa = (unsigned)(size_t)Ws;
#pragma unroll
            for (int ks = 0; ks < 4; ++ks) {
                const bf16x8 bq = *(const LAS bf16x8*)(Ds + t * PT + ks * 64 + g * 16);
                s16x4 lo[8], hi[8];
#pragma unroll
                for (int et = 0; et < 8; ++et) { lo[et] = att::tr_read(mx::tr_addr(wsa, 32 * ks + 8 * g, 16 * et, li)); hi[et] = att::tr_read(mx::tr_addr(wsa, 32 * ks + 8 * g + 4, 16 * et, li)); }
                mx::lds_wait();
#pragma unroll
                for (int et = 0; et < 8; ++et) acc[et] = __builtin_amdgcn_mfma_f32_16x16x32_bf16(mx::mk8(lo[et], hi[et]), bq, acc[et], 0, 0, 0);
            }
            const int row = r0 + t;
#pragma unroll
            for (int et = 0; et < 8; ++et) { const int e = 16 * et + 4 * g; const f32x4 sc = *(const f32x4*)(p.in[I_POOLS] + (size_t)l * C::PW + grp * 128 + e);
                u32x2 ww; ww.x = pg8::cvt_pk_bf16(acc[et][0] * sc[0], acc[et][1] * sc[1]); ww.y = pg8::cvt_pk_bf16(acc[et][2] * sc[2], acc[et][3] * sc[3]);
                *(u32x2*)(wsb<C>(p, C::WS_MIX) + (size_t)row * C::D + grp * 128 + e) = ww; }
        }
        __syncthreads();
    }
}
}
constexpr int PH_PER_LAYER = 13, N_PHASES = 2 + PH_PER_LAYER * C::DEPTH;
struct Args { Ptrs p; int ph_lo, ph_hi; };
__global__ void __launch_bounds__(NTHREADS, 2) fwd(Args a) {
    extern __shared__ __attribute__((aligned(16))) unsigned char lds_raw[];
    LAS unsigned char* lds = (LAS unsigned char*)lds_raw;
    typedef __attribute__((address_space(4))) const Args* KArgs;
    const KArgs ka0 = (KArgs)__builtin_amdgcn_kernarg_segment_ptr();
    const int lo = a.ph_lo, hi = a.ph_hi;
#define IN(k) (lo <= (k) && (k) < hi)
#define BOTH(k) (IN(k) && IN((k) + 1))
#define GRID_BAR(k) do { if (BOTH(k)) { xcd_barrier(bar); } } while (0)
#if defined(__HIP_DEVICE_COMPILE__)
#define LOAD_PTRS KArgs ka = ka0; asm volatile("" : "+s"(ka)); Ptrs p; _Pragma("unroll") for (int i_ = 0; i_ < 33; ++i_) p.in[i_] = ka->p.in[i_]; p.out = ka->p.out; p.ws = ka->p.ws;
#else
#define LOAD_PTRS (void)ka0; const Ptrs p = a.p;
#endif
#define PHASE_ARGS LOAD_PTRS int tid = threadIdx.x; asm volatile("" : "+v"(tid)); \
    const int lane = tid & 63, wave = __builtin_amdgcn_readfirstlane(tid >> 6); (void)lane; (void)wave; \
    const long gtid = (long)blockIdx.x * NTHREADS + tid, gthreads = (long)gridDim.x * NTHREADS; (void)gtid; (void)gthreads; \
    float* SS = wsf<C>(p, C::WS_SS); (void)SS; const float invd = 1.0f / C::D; (void)invd;
#define ITEMS(n, call) do { for (long it = gtid; it < (long)(n); it += gthreads) { call; } } while (0)
#if ONE_LAUNCH
    if (threadIdx.x < 4) ((LAS unsigned*)(lds + LDS_CTL))[threadIdx.x] = 0u;
    __syncthreads();
    XcdBarrier bar = xcd_barrier_post((unsigned*)(a.p.ws + C::WS_CTL), (volatile LAS unsigned*)(lds + LDS_CTL));
#else
    XcdBarrier bar; bar.bar = nullptr; bar.x = 0; bar.st = nullptr;
#endif

    if (IN(0)) { PHASE_ARGS
        LAS float* scr = (LAS float*)(lds + wave * 16384);
        const int gw = blockIdx.x * NWAVES + wave, NGW = gridDim.x * NWAVES;
        for (int l = 0; l < C::DEPTH; ++l)
            for (int idx = 0; idx < 10; ++idx) { const WDesc d = wdesc(p, l, idx); const int nitems = (d.K / 64) * (d.N / 32);
                for (int it = gw; it < nitems; it += NGW) prep_item(d.W, d.K, d.Ncols, d.g, d.kind, d.N, d.dst, scr, it, lane); }
        rw::rows_init(p, tid);
        GRID_BAR(0);
    }
    for (int l = 0; l < C::DEPTH; ++l) {
        const int pb = 1 + PH_PER_LAYER * l;
#define SSL(j) (SS + (size_t)(4 * l + (j)) * C::M)
        if (IN(pb + 0)) { PHASE_ARGS
            pg8::Gemm g{wsb<C>(p, C::WS_MEMB), wlayer<C>(p, l, C::W_KV), C::MM, 2 * C::D, C::D}; pg8::StaticOrder S; S.init(C::MM, 2 * C::D, gridDim.x, blockIdx.x);
            pg8::EpiMemKV E{p.out + C::OUT_MK + (size_t)l * C::MM * C::D, p.out + C::OUT_MV + (size_t)l * C::MM * C::D, wsf<C>(p, C::WS_RSTDM), C::D};
            pg8::gemm_phase<pg8::EpiMemKV, pg8::StaticOrder, false>(lds, g, S, E, nullptr);
            GRID_BAR(pb + 0);
        }
        if (IN(pb + 1)) { PHASE_ARGS
            pg8::Gemm g{wsb<C>(p, C::WS_XB), wlayer<C>(p, l, C::W_1IN), C::M, 2 * C::FF, C::D}; pg8::StaticOrder S; S.init(C::M, 2 * C::FF, gridDim.x, blockIdx.x);
            pg8::EpiSwiGLU E{wsb<C>(p, C::WS_BIG), SSL(0), C::FF, invd};
            pg8::gemm_phase<pg8::EpiSwiGLU, pg8::StaticOrder, false>(lds, g, S, E, nullptr);
            GRID_BAR(pb + 1);
        }
        if (IN(pb + 2)) { PHASE_ARGS
            pg8::Gemm g{wsb<C>(p, C::WS_BIG), wlayer<C>(p, l, C::W_1OUT), C::M, C::D, C::FF}; pg8::StaticOrder S; S.init(C::M, C::D, gridDim.x, blockIdx.x);
            pg8::EpiResid E{wsf<C>(p, C::WS_X), wsb<C>(p, C::WS_XB), SSL(1), 0.5f, C::D};
            pg8::gemm_phase<pg8::EpiResid, pg8::StaticOrder, false>(lds, g, S, E, nullptr);
            GRID_BAR(pb + 2);
        }
        if (IN(pb + 3)) { PHASE_ARGS
            pg8::Gemm g{wsb<C>(p, C::WS_XB), wlayer<C>(p, l, C::W_IN), C::M, C::LDP, C::D}; pg8::StaticOrder S; S.init(C::M, C::LDP, gridDim.x, blockIdx.x);
            pg8::EpiScaleF32 E{wsf<C>(p, C::WS_BIG), C::LDP, SSL(1), invd};
            pg8::gemm_phase<pg8::EpiScaleF32, pg8::StaticOrder, false>(lds, g, S, E, nullptr);
            GRID_BAR(pb + 3);
        }
        if (IN(pb + 4)) { PHASE_ARGS mx::ml_phase_a(lds, p, l, tid); gp::gmlp_phase(lds, p, l, tid); gp::pool_phase(lds, p, l, tid); GRID_BAR(pb + 4); }
        if (IN(pb + 5)) { PHASE_ARGS ITEMS((C::BATCH + C::DEC_BATCH) * C::MH, st_ml_b0<C>(p, l, (int)it)); rw::ml_scan(p, l, gtid, gthreads); GRID_BAR(pb + 5); }
        if (IN(pb + 6)) { PHASE_ARGS mx::ml_phase_c(lds, p, l, tid); GRID_BAR(pb + 6); }
        if (IN(pb + 7)) { PHASE_ARGS
            pg8::Gemm g{wsb<C>(p, C::WS_MIX), wlayer<C>(p, l, C::W_OUT), C::M, C::D, C::D}; pg8::StaticOrder S; S.init(C::M, C::D, gridDim.x, blockIdx.x);
            pg8::EpiResid E{wsf<C>(p, C::WS_X), wsb<C>(p, C::WS_XB), SSL(2), 1.0f, C::D};
            pg8::gemm_phase<pg8::EpiResid, pg8::StaticOrder, false>(lds, g, S, E, nullptr);
            GRID_BAR(pb + 7);
        }
        if (IN(pb + 8)) { PHASE_ARGS
            pg8::Gemm g{wsb<C>(p, C::WS_XB), wlayer<C>(p, l, C::W_Q), C::M, C::D, C::D}; pg8::StaticOrder S; S.init(C::M, C::D, gridDim.x, blockIdx.x);
            pg8::EpiScaleBf16 E{wsb<C>(p, C::WS_Q), C::D, SSL(2), invd};
            pg8::gemm_phase<pg8::EpiScaleBf16, pg8::StaticOrder, false>(lds, g, S, E, nullptr);
            GRID_BAR(pb + 8);
        }
        if (IN(pb + 9)) { PHASE_ARGS att::attn_phase(lds, p, l, tid); GRID_BAR(pb + 9); }
        if (IN(pb + 10)) { PHASE_ARGS
            pg8::Gemm g{wsb<C>(p, C::WS_AO), wlayer<C>(p, l, C::W_O), C::M, C::D, C::D}; pg8::StaticOrder S; S.init(C::M, C::D, gridDim.x, blockIdx.x);
            pg8::EpiResid E{wsf<C>(p, C::WS_X), wsb<C>(p, C::WS_XB), SSL(3), 1.0f, C::D};
            pg8::gemm_phase<pg8::EpiResid, pg8::StaticOrder, false>(lds, g, S, E, nullptr);
            GRID_BAR(pb + 10);
        }
        if (IN(pb + 11)) { PHASE_ARGS
            pg8::Gemm g{wsb<C>(p, C::WS_XB), wlayer<C>(p, l, C::W_2IN), C::M, 2 * C::FF, C::D}; pg8::StaticOrder S; S.init(C::M, 2 * C::FF, gridDim.x, blockIdx.x);
            pg8::EpiSwiGLU E{wsb<C>(p, C::WS_BIG), SSL(3), C::FF, invd};
            pg8::gemm_phase<pg8::EpiSwiGLU, pg8::StaticOrder, false>(lds, g, S, E, nullptr);
            GRID_BAR(pb + 11);
        }
        if (IN(pb + 12)) { PHASE_ARGS
            pg8::Gemm g{wsb<C>(p, C::WS_BIG), wlayer<C>(p, l, C::W_2OUT), C::M, C::D, C::FF}; pg8::StaticOrder S; S.init(C::M, C::D, gridDim.x, blockIdx.x);
            pg8::EpiResid E{wsf<C>(p, C::WS_X), wsb<C>(p, C::WS_XB), SSL(4), 0.5f, C::D};
            pg8::gemm_phase<pg8::EpiResid, pg8::StaticOrder, false>(lds, g, S, E, nullptr);
            GRID_BAR(pb + 12);
        }
    }
    if (IN(N_PHASES - 1)) { PHASE_ARGS rw::rows_final(p, tid); }
#undef IN
#undef BOTH
#undef GRID_BAR
#undef ITEMS
#undef PHASE_ARGS
#undef SSL
}

extern "C" void kernel_launch(void* const* d_in, const int* in_sizes, int n_in, void* d_out, int out_size, void* d_ws, size_t ws_size, hipStream_t stream) {
    static int ready = 0;
    if (!ready) {
        if (n_in != 33 || (long)out_size != (long)C::OUT_END || ws_size < (size_t)C::WS_END) { fprintf(stderr, "kernel_launch: unexpected shapes: n_in %d out %d ws %zu (need %zu)\n", n_in, out_size, ws_size, (size_t)C::WS_END); ready = -1; return; }
        if (hipFuncSetAttribute((const void*)fwd, hipFuncAttributeMaxDynamicSharedMemorySize, LDS_BYTES) != hipSuccess) { fprintf(stderr, "kernel_launch: hipFuncSetAttribute failed\n"); ready = -1; return; }
        int dev = 0, cus = 0, per_cu = 0;
        if (hipGetDevice(&dev) != hipSuccess || hipDeviceGetAttribute(&cus, hipDeviceAttributeMultiprocessorCount, dev) != hipSuccess) { fprintf(stderr, "kernel_launch: device query failed\n"); ready = -1; return; }
        if (hipOccupancyMaxActiveBlocksPerMultiprocessor(&per_cu, (const void*)fwd, NTHREADS, LDS_BYTES) != hipSuccess || per_cu < 1) { fprintf(stderr, "kernel_launch: occupancy query reports %d blocks per CU\n", per_cu); (void)hipGetLastError(); per_cu = 1; }
        ready = cus;
    }
    if (ready < 0) return;
    Args a{};
    for (int i = 0; i < 33; ++i) a.p.in[i] = (const float*)d_in[i];
    a.p.out = (float*)d_out; a.p.ws = (unsigned char*)d_ws;
#if ONE_LAUNCH
    (void)hipMemsetAsync((char*)d_ws + C::WS_CTL, 0, 65536, stream);
    a.ph_lo = 0; a.ph_hi = N_PHASES;
    hipLaunchKernelGGL(fwd, dim3(ready), dim3(NTHREADS), LDS_BYTES, stream, a);
#else
    for (int k = 0; k < N_PHASES; ++k) { a.ph_lo = k; a.ph_hi = k + 1; hipLaunchKernelGGL(fwd, dim3(ready), dim3(NTHREADS), LDS_BYTES, stream, a); }
#endif
}
```

```cpp
#include <hip/hip_runtime.h>
#include <cstdio>
#define ONE_LAUNCH 1

#define HD __host__ __device__
#ifndef HD
#define HD __host__ __device__
#endif
typedef unsigned short bf16_t;
HD inline unsigned f2u(float f) { return __builtin_bit_cast(unsigned, f); }
HD inline float u2f(unsigned u) { return __builtin_bit_cast(float, u); }
HD inline bf16_t f2bf(float f) { unsigned u = f2u(f); u += 0x7FFFu + ((u >> 16) & 1u); return (bf16_t)(u >> 16); }
HD inline float bf2f(bf16_t b) { return u2f(((unsigned)b) << 16); }

struct RC {
    static constexpr int D = 2048, FF = 8192, BATCH = 4, SEQ = 2048, DEPTH = 2, DEC_BATCH = 32, DEC_SEQ = 32, PAST = 2048, NMEM = 256;
};
template <class B> struct CfgT : B {
    using B::D; using B::FF; using B::BATCH; using B::SEQ; using B::DEPTH; using B::DEC_BATCH; using B::DEC_SEQ; using B::PAST; using B::NMEM;
    static constexpr int MP = BATCH * SEQ, MS = DEC_BATCH * DEC_SEQ, M = MP + MS, MM = BATCH * NMEM;
    static constexpr int PW = D / 4, PG = 4, PGD = PW / 4, PH = 15;
    static constexpr int GW = D / 4, GH = 4, GHD = GW / 4, GCH = 128;
    static constexpr int MW = D - PW - GW, MH = 8, MHD = MW / 8, CH = 64;
    static constexpr int INC = PW + 2 * GW + 4 * MW + 2 * MH;
    static constexpr int LDP = ((INC + 255) / 256) * 256;
    static constexpr int AH = 4, AHD = D / 4;
    static constexpr int O_U = PW, O_V = PW + GW, O_Q = PW + 2 * GW, O_K = O_Q + MW, O_VM = O_K + MW, O_O = O_VM + MW, O_IG = O_O + MW, O_FG = O_IG + MH;
    static constexpr int NC = SEQ / CH, NPC = BATCH * MH * NC, NSC = DEC_BATCH * MH, NCH = NPC + NSC;
    static constexpr int LCS = DEC_SEQ < CH ? DEC_SEQ : CH;
    static constexpr int GLP = SEQ < GCH ? SEQ : GCH, GLS = DEC_SEQ < GCH ? DEC_SEQ : GCH;
    static constexpr int NSS = 1 + 4 * DEPTH;
    static constexpr long OUT_YP = 0, OUT_YS = OUT_YP + (long)MP * D, OUT_POOLP = OUT_YS + (long)MS * D, OUT_POOLS = OUT_POOLP + (long)DEPTH * BATCH * PH * PW,
        OUT_CP = OUT_POOLS + (long)DEPTH * DEC_BATCH * PH * PW, OUT_NP = OUT_CP + (long)DEPTH * BATCH * MH * MHD * MHD, OUT_MP = OUT_NP + (long)DEPTH * BATCH * MH * MHD,
        OUT_CS = OUT_MP + (long)DEPTH * BATCH * MH, OUT_NS = OUT_CS + (long)DEPTH * DEC_BATCH * MH * MHD * MHD, OUT_MS = OUT_NS + (long)DEPTH * DEC_BATCH * MH * MHD,
        OUT_VS = OUT_MS + (long)DEPTH * DEC_BATCH * MH, OUT_MK = OUT_VS + (long)DEPTH * DEC_BATCH * DEC_SEQ * GW, OUT_MV = OUT_MK + (long)DEPTH * BATCH * NMEM * D,
        OUT_END = OUT_MV + (long)DEPTH * BATCH * NMEM * D;
    static constexpr size_t al(size_t x) { return (x + 255) & ~(size_t)255; }
    static constexpr size_t WS_CTL = 0, WS_SS = 65536, WS_X = al(WS_SS + (size_t)NSS * M * 4), WS_XB = al(WS_X + (size_t)M * D * 4),
        WS_BIG = al(WS_XB + (size_t)M * D * 2),
        WS_BIG_SZ = ((size_t)M * FF * 2 > (size_t)M * LDP * 4) ? (size_t)M * FF * 2 : (size_t)M * LDP * 4,
        WS_MIX = al(WS_BIG + WS_BIG_SZ), WS_Q = al(WS_MIX + (size_t)M * D * 2), WS_AO = al(WS_Q + (size_t)M * D * 2),
        WS_MEMB = al(WS_AO + (size_t)M * D * 2), WS_RSTDM = al(WS_MEMB + (size_t)MM * D * 2),
        WS_GB = al(WS_RSTDM + (size_t)MM * 4), WS_GA = al(WS_GB + (size_t)M * MH * 4),
        WS_CBL = al(WS_GA + (size_t)M * MH * 4), WS_CML = al(WS_CBL + (size_t)NCH * 4), WS_MPREV = al(WS_CML + (size_t)NCH * 4),
        WS_DC = al(WS_MPREV + (size_t)NCH * 4), WS_DN = al(WS_DC + (size_t)NCH * MHD * MHD * 4),
        WS_PART = al(WS_DN + (size_t)NCH * MHD * 4),
        WS_W = al(WS_PART + (size_t)256 * 65536 * 4);
    static constexpr size_t W_1IN = 0, W_1OUT = W_1IN + (size_t)2 * FF * D, W_IN = W_1OUT + (size_t)D * FF, W_OUT = W_IN + (size_t)LDP * D, W_Q = W_OUT + (size_t)D * D,
        W_KV = W_Q + (size_t)D * D, W_O = W_KV + (size_t)2 * D * D, W_2IN = W_O + (size_t)D * D, W_2OUT = W_2IN + (size_t)2 * FF * D, W_LAYER = W_2OUT + (size_t)D * FF;
    static constexpr size_t WS_END = al(WS_W + (size_t)DEPTH * W_LAYER * 2);
};

struct Ptrs { const float* in[33]; float* out; unsigned char* ws; };
enum { I_XP = 0, I_XS, I_MEM, I_SPOOL, I_SC, I_SN, I_SM, I_CK, I_CV, I_GFFN1, I_W1IN, I_W1OUT, I_GMIX, I_WIN, I_POOLW, I_POOLS, I_GVG, I_GWS, I_GBS, I_IB, I_FB, I_NG, I_WOUT,
       I_GX, I_GMEM, I_WQ, I_WK, I_WV, I_WO, I_GFFN2, I_W2IN, I_W2OUT, I_GFIN };

template <class C> HD inline float* wsf(const Ptrs& p, size_t off) { return (float*)(p.ws + off); }
template <class C> HD inline bf16_t* wsb(const Ptrs& p, size_t off) { return (bf16_t*)(p.ws + off); }
template <class C> HD inline bf16_t* wlayer(const Ptrs& p, int l, size_t off) { return (bf16_t*)(p.ws + C::WS_W) + (size_t)l * C::W_LAYER + off; }

template <class C> HD inline void row_info(int r, bool& s, int& b, int& t) {
    if (r < C::MP) { s = false; b = r / C::SEQ; t = r % C::SEQ; } else { s = true; const int q = r - C::MP; b = q / C::DEC_SEQ; t = q % C::DEC_SEQ; }
}
template <class C> HD inline void chunk_info(int r, int h, int& ci, int& i, int& lc) {
    bool s; int b, t; row_info<C>(r, s, b, t);
    if (!s) { ci = (b * C::MH + h) * C::NC + t / C::CH; i = t % C::CH; lc = C::CH; } else { ci = C::NPC + b * C::MH + h; i = t; lc = C::LCS; }
}
HD inline float sigmoidf_(float x) { return 1.0f / (1.0f + expf(-x)); }
HD inline float logsigmoidf_(float x) { return x >= 0.f ? -log1pf(expf(-x)) : x - log1pf(expf(x)); }

enum { WK_PLAIN = 0, WK_FFNIN = 1, WK_WIN = 2 };
template <class C> HD inline int wsrc_col(int kind, int n) {
    if (kind == WK_FFNIN) { const int pn = n >> 8, j = n & 255; return j < 128 ? 128 * pn + j : C::FF + 128 * pn + (j - 128); }
    if (kind == WK_WIN) return n < C::INC ? n : -1;
    return n;
}

template <class C> HD inline void st_ml_b0(const Ptrs& p, int l, int sq) {
    const float* CBL = wsf<C>(p, C::WS_CBL); const float* CML = wsf<C>(p, C::WS_CML); float* MPREV = wsf<C>(p, C::WS_MPREV);
    if (sq < C::BATCH * C::MH) { float m = 0.f;
        for (int c = 0; c < C::NC; ++c) { const int ci = sq * C::NC + c; MPREV[ci] = m; const float a = CBL[ci] + m, b2 = CML[ci]; m = a > b2 ? a : b2; }
        p.out[C::OUT_MP + (size_t)l * C::BATCH * C::MH + sq] = m;
    } else { const int q = sq - C::BATCH * C::MH, ci = C::NPC + q; const float m0 = p.in[I_SM][(size_t)l * C::DEC_BATCH * C::MH + q];
        MPREV[ci] = m0; const float a = CBL[ci] + m0, b2 = CML[ci]; p.out[C::OUT_MS + (size_t)l * C::DEC_BATCH * C::MH + q] = a > b2 ? a : b2; }
}

namespace pg8 {
#define PG8_LAS __attribute__((address_space(3)))
typedef unsigned short bf16_t;
typedef short bf16x8 __attribute__((ext_vector_type(8)));
typedef float f32x4 __attribute__((ext_vector_type(4)));
typedef unsigned u32x4 __attribute__((ext_vector_type(4)));
constexpr int BM = 256, BK = 64, HALF = 128, HTB = HALF * BK * 2  , STAGE_BYTES = 8 * HTB, NXCD = 8, WGM = 8;

__host__ __device__ __forceinline__ int lds_byte(int r, int c) { const int st = (r >> 4) * 2 + (c >> 5), rr = r & 15, cc = c & 31, ob = rr * 64 + cc * 2; return st * 1024 + (ob ^ (((ob >> 9) & 1) << 5)); }
__host__ __device__ __forceinline__ void stage_rc(int b, int& R, int& C) { const int st = b / 1024, sb = b % 1024, swz = sb ^ (((sb >> 9) & 1) << 5); R = (st >> 1) * 16 + swz / 64; C = (st & 1) * 32 + (swz % 64) / 2; }
__host__ __device__ __forceinline__ int perm32(int rho) { const int n = rho >> 4, i = rho & 15; return 8 * (i >> 2) + 4 * n + (i & 3); }

struct Unit { int pm, pn; };
struct Gemm { const bf16_t* A; const bf16_t* Bt; int M, N, K, ld; };

struct StaticOrder {
    int nM, nN, nwg, G, c;
    __host__ __device__ void init(int M, int N, int G_, int c_) { nM = M / BM; nN = N / BM; nwg = nM * nN; G = G_; c = c_; }
    __host__ __device__ bool next(int i, Unit& u) const {
        const long L = (long)i * G + c; if (L >= nwg) return false;
        int wgid = (int)L; { const int q = nwg / NXCD, r = nwg % NXCD, xcd = wgid % NXCD, off = wgid / NXCD; wgid = (xcd < r ? xcd * (q + 1) : r * (q + 1) + (xcd - r) * q) + off; }
        const int nig = WGM * nN, gid = wgid / nig, fm = gid * WGM, gsz = (nM - fm) < WGM ? (nM - fm) : WGM;
        u.pm = fm + ((wgid % nig) % gsz); u.pn = (wgid % nig) / gsz; return true;
    }
    __device__ __forceinline__ void a_ready(const Unit&) const {}
    __device__ __forceinline__ void done(const Unit&) const {}
};
__device__ __forceinline__ unsigned cvt_pk_bf16(float lo, float hi) { unsigned r; asm volatile("v_cvt_pk_bf16_f32 %0, %1, %2" : "=v"(r) : "v"(lo), "v"(hi)); return r; }
typedef float f32x2 __attribute__((ext_vector_type(2)));
template <class Epi, class Sched, bool STAMP = false>
__device__ __forceinline__ void gemm_phase(PG8_LAS unsigned char* lds, const Gemm g, const Sched& S, const Epi& E, unsigned long long* stamps) {
    int tid_l = threadIdx.x; asm volatile("" : "+v"(tid_l));
    const int tid = tid_l, wid = __builtin_amdgcn_readfirstlane(tid >> 6), lane = tid & 63, wr = wid >> 2, wc = wid & 3, fr = lane & 15, fq = lane >> 4;
    const int K = g.K, nt = K / BK;
    int ts_lo = 0, ts_hi = 0, nts = 0; const unsigned long long rt_entry = STAMP ? (unsigned long long)wall_clock64() : 0ull;
#define PG8_STAMP() do { if (STAMP && wid == 0 && nts < 64) { const unsigned long long _c = (unsigned long long)clock64(); \
        ts_lo = (lane == nts) ? (int)(unsigned)_c : ts_lo; ts_hi = (lane == nts) ? (int)(unsigned)(_c >> 32) : ts_hi; ++nts; } } while (0)
    PG8_STAMP();
    unsigned voffA[2], voffB[2];
#pragma unroll
    for (int i = 0; i < 2; ++i) { int R, C; stage_rc(tid * 16 + i * 8192, R, C); const int Rb = Epi::PERM ? ((R & ~31) + perm32(R & 31)) : R;
        voffA[i] = (unsigned)(R * g.ld + C) * 2u; voffB[i] = (unsigned)(Rb * g.ld + C) * 2u; }
    const size_t kstep = (size_t)(BK * 2);
    const size_t hstep = (size_t)HALF * g.ld * 2;
    const size_t tstep = 2 * hstep;
    const unsigned ldsw = (unsigned)wid * 1024u;
    const int aoff = lds_byte(wr * 64 + fr, fq * 8), boff = lds_byte(wc * 32 + fr, fq * 8);
#define PG8_SA(b, h) (((b) * 2 + (h)) * HTB)
#define PG8_SB(b, h) ((4 + (b) * 2 + (h)) * HTB)
#define PG8_STAGE(bufoff, gbase, voff) do { _Pragma("unroll") for (int _i = 0; _i < 2; ++_i) \
        __builtin_amdgcn_global_load_lds((const unsigned*)((const char*)(gbase) + (voff)[_i]), (PG8_LAS unsigned*)(lds + (bufoff) + ldsw + _i * 8192), 16, 0, 0); } while (0)
#define PG8_LDA(dst, b, h) do { _Pragma("unroll") for (int m = 0; m < 4; ++m) _Pragma("unroll") for (int k = 0; k < 2; ++k) dst[m][k] = *(const PG8_LAS bf16x8*)(lds + PG8_SA(b, h) + aoff + m * 2048 + k * 1024); } while (0)
#define PG8_LDB(dst, b, h) do { _Pragma("unroll") for (int n = 0; n < 2; ++n) _Pragma("unroll") for (int k = 0; k < 2; ++k) dst[n][k] = *(const PG8_LAS bf16x8*)(lds + PG8_SB(b, h) + boff + n * 2048 + k * 1024); } while (0)
#define PG8_MMA(ai, bj, At, Bt) do { __builtin_amdgcn_s_setprio(1); _Pragma("unroll") for (int m = 0; m < 4; ++m) _Pragma("unroll") for (int n = 0; n < 2; ++n) _Pragma("unroll") for (int k = 0; k < 2; ++k) \
        acc[ai][bj][m][n] = __builtin_amdgcn_mfma_f32_16x16x32_bf16(Bt[n][k], At[m][k], acc[ai][bj][m][n], 0, 0, 0); __builtin_amdgcn_s_setprio(0); } while (0)
#define PG8_WAIT_V(n) asm volatile("s_waitcnt vmcnt(" #n ")" ::: "memory")
#define PG8_WAIT_L(n) asm volatile("s_waitcnt lgkmcnt(" #n ")" ::: "memory")
#define PG8_BAR __builtin_amdgcn_s_barrier()
#define PG8_SCHED __builtin_amdgcn_sched_barrier(0)
    Unit cur, nxt; int ui = 0;
    if (!S.next(0, cur)) return;
    f32x4 acc[2][2][4][2];
#pragma unroll
    for (int a = 0; a < 2; ++a)
#pragma unroll
        for (int b = 0; b < 2; ++b)
#pragma unroll
            for (int m = 0; m < 4; ++m)
#pragma unroll
                for (int n = 0; n < 2; ++n) acc[a][b][m][n] = (f32x4){0.f, 0.f, 0.f, 0.f};
    bf16x8 At[4][2], B0[2][2], B1[2][2];
    const char* cA = (const char*)g.A + (size_t)cur.pm * tstep; const char* cB = (const char*)g.Bt + (size_t)cur.pn * tstep;
    S.a_ready(cur);
    PG8_STAGE(PG8_SB(0, 0), cB, voffB); PG8_STAGE(PG8_SA(0, 0), cA, voffA); PG8_STAGE(PG8_SB(0, 1), cB + hstep, voffB); PG8_STAGE(PG8_SA(0, 1), cA + hstep, voffA);
    if (wr == 1) PG8_BAR;
    PG8_WAIT_V(4); PG8_BAR;
    PG8_STAGE(PG8_SB(1, 0), cB + kstep, voffB); PG8_STAGE(PG8_SA(1, 0), cA + kstep, voffA); PG8_STAGE(PG8_SB(1, 1), cB + hstep + kstep, voffB);
    PG8_WAIT_V(6); PG8_BAR;
    PG8_STAMP();
    for (;;) {
        const bool has_next = S.next(ui + 1, nxt);
        const char* nA = has_next ? (const char*)g.A + (size_t)nxt.pm * tstep : cA; const char* nB = has_next ? (const char*)g.Bt + (size_t)nxt.pn * tstep : cB;
        for (int t = 0; t < nt; t += 2) {
            const bool last = (t == nt - 2);
            const char* a1 = cA + (size_t)(t + 1) * kstep;
            const char* a2 = last ? nA : cA + (size_t)(t + 2) * kstep; const char* b2 = last ? nB : cB + (size_t)(t + 2) * kstep;
            const char* a3 = a2 + kstep; const char* b3 = b2 + kstep;
            if (last && has_next) S.a_ready(nxt);
            PG8_LDB(B0, 0, 0); PG8_SCHED; PG8_LDA(At, 0, 0); PG8_STAGE(PG8_SA(1, 1), a1 + hstep, voffA);
            PG8_WAIT_L(8); PG8_BAR; PG8_WAIT_L(0); PG8_MMA(0, 0, At, B0); PG8_BAR; PG8_SCHED;
            PG8_LDB(B1, 0, 1); PG8_STAGE(PG8_SB(0, 0), b2, voffB);
            PG8_BAR; PG8_WAIT_L(0); PG8_MMA(0, 1, At, B1); PG8_BAR;
            PG8_LDA(At, 0, 1); PG8_STAGE(PG8_SA(0, 0), a2, voffA);
            PG8_BAR; PG8_WAIT_L(0); PG8_MMA(1, 0, At, B0); PG8_BAR; PG8_SCHED;
            PG8_STAGE(PG8_SB(0, 1), b2 + hstep, voffB);
            PG8_WAIT_V(6); PG8_BAR; PG8_MMA(1, 1, At, B1); PG8_BAR;
            PG8_LDB(B0, 1, 0); PG8_SCHED; PG8_LDA(At, 1, 0); PG8_STAGE(PG8_SA(0, 1), a2 + hstep, voffA);
            PG8_WAIT_L(8); PG8_BAR; PG8_WAIT_L(0); PG8_MMA(0, 0, At, B0); PG8_BAR; PG8_SCHED;
            PG8_LDB(B1, 1, 1); PG8_STAGE(PG8_SB(1, 0), b3, voffB);
            PG8_BAR; PG8_WAIT_L(0); PG8_MMA(0, 1, At, B1); PG8_BAR;
            PG8_LDA(At, 1, 1); PG8_STAGE(PG8_SA(1, 0), a3, voffA);
            PG8_BAR; PG8_WAIT_L(0); PG8_MMA(1, 0, At, B0); PG8_BAR; PG8_SCHED;
            PG8_STAGE(PG8_SB(1, 1), b3 + hstep, voffB);
            PG8_WAIT_V(6); PG8_BAR; PG8_MMA(1, 1, At, B1); PG8_BAR;
        }
        PG8_STAMP();
        if constexpr (!Epi::AFTER_DRAIN) { E(acc, cur, wr, wc, fr, fq); S.done(cur); }
        PG8_STAMP();
        if (!has_next) break;
#pragma unroll
        for (int a = 0; a < 2; ++a)
#pragma unroll
            for (int b = 0; b < 2; ++b)
#pragma unroll
                for (int m = 0; m < 4; ++m)
#pragma unroll
                    for (int n = 0; n < 2; ++n) acc[a][b][m][n] = (f32x4){0.f, 0.f, 0.f, 0.f};
        cur = nxt; cA = nA; cB = nB; ++ui;
    }
    PG8_WAIT_V(0);
    if (wr == 0) PG8_BAR;
    PG8_BAR;
    if constexpr (Epi::AFTER_DRAIN) { E.fused(acc, cur, wr, wc, fr, fq, lds, wid, lane); S.done(cur); }
    PG8_STAMP();
    if (STAMP && wid == 0) { stamps[lane] = lane < nts ? (((unsigned long long)(unsigned)ts_hi << 32) | (unsigned)ts_lo) : 0ull;
        if (lane == 62) stamps[62] = rt_entry; if (lane == 63) stamps[63] = (unsigned long long)wall_clock64(); }
#undef PG8_STAMP
#undef PG8_SA
#undef PG8_SB
#undef PG8_STAGE
#undef PG8_LDA
#undef PG8_LDB
#undef PG8_MMA
#undef PG8_WAIT_V
#undef PG8_WAIT_L
#undef PG8_BAR
#undef PG8_SCHED
}
}


#define LAS __attribute__((address_space(3)))
#define XB_TMO      128
#define XB_XCNT(j)  (256  + 64 * (j))
#define XB_XSUB(j)  (1280 + 64 * (j))
#define XB_XGEN(j)  (2304 + 64 * (j))
#define XB_TOP      3328
#define XB_TOPGEN   3392
#define XCD_BAR_WORDS 3456
#define XB_SPIN_CAP (1u << 18)

__device__ __forceinline__ unsigned xb_ld(unsigned* p)              { return __hip_atomic_load(p, __ATOMIC_RELAXED, __HIP_MEMORY_SCOPE_AGENT); }
__device__ __forceinline__ unsigned xb_add(unsigned* p, unsigned v) { return __hip_atomic_fetch_add(p, v, __ATOMIC_RELAXED, __HIP_MEMORY_SCOPE_AGENT); }
__device__ __forceinline__ unsigned xb_xcc_id() { return (unsigned)__builtin_amdgcn_s_getreg((3 << 11) | 20) & 0xFu; }
#define XB_SPIN(cond, bar) do { unsigned _sp = 0; while (cond) { __builtin_amdgcn_s_sleep(1); \
    if ((++_sp & 255u) == 0u) { if (xb_ld(&(bar)[XB_TMO])) break; if (_sp > XB_SPIN_CAP) { atomicAdd(&(bar)[XB_TMO], 1u); break; } } } } while (0)

struct XcdBarrier {
    unsigned* bar; unsigned x;
    volatile LAS unsigned* st;
};

__device__ __forceinline__ XcdBarrier xcd_barrier_post(unsigned* bar, volatile LAS unsigned* st) {
    XcdBarrier b; b.bar = bar; b.x = xb_xcc_id(); b.st = st;
    if (threadIdx.x == 0) (void)xb_add(&bar[XB_XCNT(b.x)], 1u);
    return b;
}
__device__ __forceinline__ void xcd_barrier_complete(unsigned* bar, unsigned x, unsigned& nloc, unsigned& nx) {
    const unsigned G = gridDim.x * gridDim.y * gridDim.z;
    unsigned sum, cnt, mine, sp = 0u;
    for (;;) {
        sum = 0u; cnt = 0u; mine = 0u;
#pragma unroll
        for (unsigned j = 0; j < 16; ++j) { const unsigned c = xb_ld(&bar[XB_XCNT(j)]); sum += c; cnt += (c > 0u) ? 1u : 0u; mine = (j == x) ? c : mine; }
        if (sum == G) break;
        __builtin_amdgcn_s_sleep(1);
        if ((++sp & 255u) == 0u) { if (xb_ld(&bar[XB_TMO])) break; if (sp > XB_SPIN_CAP) { atomicAdd(&bar[XB_TMO], 1u); break; } }
    }
    nloc = mine > 0u ? mine : 1u; nx = cnt > 0u ? cnt : 1u;
}

__device__ __forceinline__ void xcd_barrier(const XcdBarrier& b) {
    asm volatile("s_waitcnt vmcnt(0)" ::: "memory");
    __syncthreads();
    if (threadIdx.x == 0) {
        unsigned* bar = b.bar;
        __builtin_amdgcn_s_waitcnt(0);
        unsigned nloc = b.st[0], nx = b.st[1];
        if (nloc == 0u) { xcd_barrier_complete(bar, b.x, nloc, nx); b.st[0] = nloc; b.st[1] = nx; }
        const unsigned old = xb_add(&bar[XB_XSUB(b.x)], 1u);
        const unsigned gen = old / nloc;
        if (old + 1u == (gen + 1u) * nloc) {
            __builtin_amdgcn_fence(__ATOMIC_RELEASE, "agent");
            asm volatile("s_waitcnt vmcnt(0)" ::: "memory");
            const unsigned og = xb_add(&bar[XB_TOP], 1u);
            const unsigned tg = og / nx;
            if (og + 1u == (tg + 1u) * nx) xb_add(&bar[XB_TOPGEN], 1u);
            else XB_SPIN(xb_ld(&bar[XB_TOPGEN]) == tg, bar);
            __builtin_amdgcn_fence(__ATOMIC_ACQUIRE, "agent");
            xb_add(&bar[XB_XGEN(b.x)], 1u);
            asm volatile("s_waitcnt vmcnt(0)" ::: "memory");
        } else {
            XB_SPIN(xb_ld(&bar[XB_XGEN(b.x)]) == gen, bar);
            __builtin_amdgcn_fence(__ATOMIC_ACQUIRE, "agent");
            asm volatile("s_waitcnt vmcnt(0)" ::: "memory");
        }
    }
    __syncthreads();
}

typedef CfgT<RC> C;
constexpr int NTHREADS = 512, NWAVES = 8;
constexpr int LDS_STAGE = 131072, LDS_CTL = LDS_STAGE, LDS_BYTES = LDS_STAGE + 256;

namespace pg8 {
typedef unsigned u32x2 __attribute__((ext_vector_type(2)));
__device__ __forceinline__ float silu_f(float g) { return g * __builtin_amdgcn_rcpf(1.0f + __expf(-g)); }
struct EpiSwiGLU { static constexpr bool PERM = true, AFTER_DRAIN = false;
    bf16_t* act; const float* ss; int ff; float invd;
    __device__ __forceinline__ void operator()(const f32x4 (&acc)[2][2][4][2], const Unit& u, int wr, int wc, int fr, int fq) const {
        const int row0 = u.pm * BM + wr * 64 + fr, col = u.pn * 128 + wc * 32 + 8 * fq;
#pragma unroll
        for (int ai = 0; ai < 2; ++ai)
#pragma unroll
            for (int m = 0; m < 4; ++m) { const int row = row0 + ai * HALF + m * 16; const float rs = rsqrtf(ss[row] * invd + 1e-6f);
                f32x4 v[2];
#pragma unroll
                for (int n = 0; n < 2; ++n) { const f32x4 g = acc[ai][0][m][n] * rs, up = acc[ai][1][m][n] * rs;
#pragma unroll
                    for (int j = 0; j < 4; ++j) v[n][j] = silu_f(g[j]) * up[j]; }
                u32x4 w; w.x = cvt_pk_bf16(v[0][0], v[0][1]); w.y = cvt_pk_bf16(v[0][2], v[0][3]); w.z = cvt_pk_bf16(v[1][0], v[1][1]); w.w = cvt_pk_bf16(v[1][2], v[1][3]);
                *(u32x4*)(act + (size_t)row * ff + col) = w; }
    }
};
struct EpiResid { static constexpr bool PERM = false, AFTER_DRAIN = false;
    float* X; bf16_t* XB; float* ssout; float scale; int ld;
    __device__ __forceinline__ void operator()(const f32x4 (&acc)[2][2][4][2], const Unit& u, int wr, int wc, int fr, int fq) const {
        const int row0 = u.pm * BM + wr * 64 + fr, col0 = u.pn * BM + wc * 32 + 4 * fq;
#pragma unroll
        for (int ai = 0; ai < 2; ++ai)
#pragma unroll
            for (int m = 0; m < 4; ++m) { const int row = row0 + ai * HALF + m * 16; float* xr = X + (size_t)row * ld + col0; bf16_t* br = XB + (size_t)row * ld + col0; float s = 0.f;
#pragma unroll
                for (int bj = 0; bj < 2; ++bj)
#pragma unroll
                    for (int n = 0; n < 2; ++n) { f32x4 x = *(const f32x4*)(xr + bj * HALF + n * 16) + acc[ai][bj][m][n] * scale; *(f32x4*)(xr + bj * HALF + n * 16) = x;
                        u32x2 w; w.x = cvt_pk_bf16(x[0], x[1]); w.y = cvt_pk_bf16(x[2], x[3]); *(u32x2*)(br + bj * HALF + n * 16) = w;
                        s += (x[0] * x[0] + x[1] * x[1]) + (x[2] * x[2] + x[3] * x[3]); }
                s += __shfl_xor(s, 16); s += __shfl_xor(s, 32);
                if (fq == 0) unsafeAtomicAdd(ssout + row, s); }
    }
};
struct EpiScaleF32 { static constexpr bool PERM = false, AFTER_DRAIN = false;
    float* Cp; int ldc; const float* ss; float invd;
    __device__ __forceinline__ void operator()(const f32x4 (&acc)[2][2][4][2], const Unit& u, int wr, int wc, int fr, int fq) const {
        const int row0 = u.pm * BM + wr * 64 + fr, col0 = u.pn * BM + wc * 32 + 4 * fq;
#pragma unroll
        for (int ai = 0; ai < 2; ++ai)
#pragma unroll
            for (int m = 0; m < 4; ++m) { const int row = row0 + ai * HALF + m * 16; const float rs = rsqrtf(ss[row] * invd + 1e-6f); float* cr = Cp + (size_t)row * ldc + col0;
#pragma unroll
                for (int bj = 0; bj < 2; ++bj)
#pragma unroll
                    for (int n = 0; n < 2; ++n) *(f32x4*)(cr + bj * HALF + n * 16) = acc[ai][bj][m][n] * rs; }
    }
};
struct EpiScaleBf16 { static constexpr bool PERM = true, AFTER_DRAIN = false;
    bf16_t* O; int ldc; const float* ss; float invd;
    __device__ __forceinline__ void operator()(const f32x4 (&acc)[2][2][4][2], const Unit& u, int wr, int wc, int fr, int fq) const {
        const int row0 = u.pm * BM + wr * 64 + fr, col0 = u.pn * BM + wc * 32 + 8 * fq;
#pragma unroll
        for (int ai = 0; ai < 2; ++ai)
#pragma unroll
            for (int m = 0; m < 4; ++m) { const int row = row0 + ai * HALF + m * 16; const float rs = rsqrtf(ss[row] * invd + 1e-6f); bf16_t* orow = O + (size_t)row * ldc + col0;
#pragma unroll
                for (int bj = 0; bj < 2; ++bj) { const f32x4 v0 = acc[ai][bj][m][0] * rs, v1 = acc[ai][bj][m][1] * rs;
                    u32x4 w; w.x = cvt_pk_bf16(v0[0], v0[1]); w.y = cvt_pk_bf16(v0[2], v0[3]); w.z = cvt_pk_bf16(v1[0], v1[1]); w.w = cvt_pk_bf16(v1[2], v1[3]);
                    *(u32x4*)(orow + bj * HALF) = w; } }
    }
};
struct EpiMemKV { static constexpr bool PERM = false, AFTER_DRAIN = false;
    float* K; float* V; const float* rstd; int d;
    __device__ __forceinline__ void operator()(const f32x4 (&acc)[2][2][4][2], const Unit& u, int wr, int wc, int fr, int fq) const {
        const int row0 = u.pm * BM + wr * 64 + fr; int ct = u.pn * BM; float* base = K; if (ct >= d) { base = V; ct -= d; }
        const int col0 = ct + wc * 32 + 4 * fq;
#pragma unroll
        for (int ai = 0; ai < 2; ++ai)
#pragma unroll
            for (int m = 0; m < 4; ++m) { const int row = row0 + ai * HALF + m * 16; const float rs = rstd[row]; float* cr = base + (size_t)row * d + col0;
#pragma unroll
                for (int bj = 0; bj < 2; ++bj)
#pragma unroll
                    for (int n = 0; n < 2; ++n) *(f32x4*)(cr + bj * HALF + n * 16) = acc[ai][bj][m][n] * rs; }
    }
};
struct RoundOrder : StaticOrder { int round;
    __device__ bool next(int i, Unit& u) const { if (i != 0) return false; return StaticOrder::next(round, u); } };
struct EpiPartial { static constexpr bool PERM = false, AFTER_DRAIN = false;
    float* part;
    __device__ __forceinline__ void operator()(const f32x4 (&acc)[2][2][4][2], const Unit& u, int wr, int wc, int fr, int fq) const {
        const int row0 = wr * 64 + fr, col0 = wc * 32 + 4 * fq;
#pragma unroll
        for (int ai = 0; ai < 2; ++ai)
#pragma unroll
            for (int m = 0; m < 4; ++m) { float* cr = part + (size_t)(row0 + ai * HALF + m * 16) * BM + col0;
#pragma unroll
                for (int bj = 0; bj < 2; ++bj)
#pragma unroll
                    for (int n = 0; n < 2; ++n) *(f32x4*)(cr + bj * HALF + n * 16) = acc[ai][bj][m][n]; }
    }
};
}

__device__ __forceinline__ unsigned pk2bf(float lo, float hi) { return pg8::cvt_pk_bf16(lo, hi); }
__device__ __forceinline__ void prep_item(const float* W, int K, int Ncols, const float* g, int kind, int N, bf16_t* Bt, LAS float* scr, int item, int lane) {
    const int nblk = N / 32, kb = item / nblk, nb = item % nblk, k0 = 64 * kb, n0 = 32 * nb;
    const int sc = wsrc_col<C>(kind, n0 + (lane & 31));
#pragma unroll 8
    for (int i = 0; i < 32; ++i) { const int kk = 2 * i + (lane >> 5); float v = 0.f;
        if (sc >= 0) { v = W[(size_t)(k0 + kk) * Ncols + sc]; if (g) v *= g[k0 + kk]; }
        scr[kk * 33 + (lane & 31)] = v; }
    asm volatile("s_waitcnt lgkmcnt(0)" ::: "memory");
    const int c = lane & 7;
#pragma unroll
    for (int j = 0; j < 4; ++j) { const int n = (lane >> 3) + 8 * j; const LAS float* s = scr + (8 * c) * 33 + n;
        pg8::u32x4 o; o.x = pk2bf(s[0 * 33], s[1 * 33]); o.y = pk2bf(s[2 * 33], s[3 * 33]); o.z = pk2bf(s[4 * 33], s[5 * 33]); o.w = pk2bf(s[6 * 33], s[7 * 33]);
        *(pg8::u32x4*)(Bt + (size_t)(n0 + n) * K + k0 + 8 * c) = o; }
    asm volatile("s_waitcnt lgkmcnt(0)" ::: "memory");
}
struct WDesc { const float* W; const float* g; bf16_t* dst; int K, Ncols, kind, N; };
__device__ __forceinline__ WDesc wdesc(const Ptrs& p, int l, int idx) {
    WDesc d; d.g = nullptr; d.kind = WK_PLAIN;
    switch (idx) {
    case 0: d.W = p.in[I_W1IN] + (size_t)l * C::D * 2 * C::FF; d.K = C::D; d.Ncols = 2 * C::FF; d.N = 2 * C::FF; d.g = p.in[I_GFFN1] + l * C::D; d.kind = WK_FFNIN; d.dst = wlayer<C>(p, l, C::W_1IN); break;
    case 1: d.W = p.in[I_W1OUT] + (size_t)l * C::FF * C::D; d.K = C::FF; d.Ncols = C::D; d.N = C::D; d.dst = wlayer<C>(p, l, C::W_1OUT); break;
    case 2: d.W = p.in[I_WIN] + (size_t)l * C::D * C::INC; d.K = C::D; d.Ncols = C::INC; d.N = C::LDP; d.g = p.in[I_GMIX] + l * C::D; d.kind = WK_WIN; d.dst = wlayer<C>(p, l, C::W_IN); break;
    case 3: d.W = p.in[I_WOUT] + (size_t)l * C::D * C::D; d.K = C::D; d.Ncols = C::D; d.N = C::D; d.dst = wlayer<C>(p, l, C::W_OUT); break;
    case 4: d.W = p.in[I_WQ] + (size_t)l * C::D * C::D; d.K = C::D; d.Ncols = C::D; d.N = C::D; d.g = p.in[I_GX] + l * C::D; d.dst = wlayer<C>(p, l, C::W_Q); break;
    case 5: d.W = p.in[I_WK] + (size_t)l * C::D * C::D; d.K = C::D; d.Ncols = C::D; d.N = C::D; d.g = p.in[I_GMEM] + l * C::D; d.dst = wlayer<C>(p, l, C::W_KV); break;
    case 6: d.W = p.in[I_WV] + (size_t)l * C::D * C::D; d.K = C::D; d.Ncols = C::D; d.N = C::D; d.g = p.in[I_GMEM] + l * C::D; d.dst = wlayer<C>(p, l, C::W_KV) + (size_t)C::D * C::D; break;
    case 7: d.W = p.in[I_WO] + (size_t)l * C::D * C::D; d.K = C::D; d.Ncols = C::D; d.N = C::D; d.dst = wlayer<C>(p, l, C::W_O); break;
    case 8: d.W = p.in[I_W2IN] + (size_t)l * C::D * 2 * C::FF; d.K = C::D; d.Ncols = 2 * C::FF; d.N = 2 * C::FF; d.g = p.in[I_GFFN2] + l * C::D; d.kind = WK_FFNIN; d.dst = wlayer<C>(p, l, C::W_2IN); break;
    default: d.W = p.in[I_W2OUT] + (size_t)l * C::FF * C::D; d.K = C::FF; d.Ncols = C::D; d.N = C::D; d.dst = wlayer<C>(p, l, C::W_2OUT); break;
    }
    return d;
}

namespace att {
typedef short bf16x8 __attribute__((ext_vector_type(8)));
typedef short s16x4 __attribute__((ext_vector_type(4)));
typedef float f32x4 __attribute__((ext_vector_type(4)));
typedef unsigned u32x2 __attribute__((ext_vector_type(2)));
constexpr int TOK = 256, CD = 64, PITCH = 144, CBYTES = TOK * PITCH, HDIM = 512, NH = 4, LD = 2048;
constexpr int NU_P = (C::MP / 128) * NH, NU_S = C::DEC_BATCH * NH, NUNITS = NU_P + NU_S;
static_assert(C::NMEM == TOK && C::AHD == HDIM && C::AH == NH && C::D == LD && C::DEC_SEQ == 32 && C::SEQ % 128 == 0, "attention phase is built for these shapes");
__device__ __forceinline__ s16x4 tr_read(unsigned addr) { s16x4 r; asm volatile("ds_read_b64_tr_b16 %0, %1" : "=&v"(r) : "v"(addr) : "memory"); return r; }
__device__ __forceinline__ void stage_load(f32x4 (&r)[8], const float* src, int tid) {
#pragma unroll
    for (int i = 0; i < 8; ++i) { const int f = tid + 512 * i; r[i] = *(const f32x4*)(src + (size_t)(f >> 4) * LD + (f & 15) * 4); }
}
__device__ __forceinline__ void stage_store(const f32x4 (&r)[8], LAS unsigned char* buf, int tid) {
#pragma unroll
    for (int i = 0; i < 8; ++i) { const int f = tid + 512 * i; u32x2 w; w.x = pg8::cvt_pk_bf16(r[i][0], r[i][1]); w.y = pg8::cvt_pk_bf16(r[i][2], r[i][3]);
        *(LAS u32x2*)(buf + (f >> 4) * PITCH + (f & 15) * 8) = w; }
}
__device__ __forceinline__ void attn_phase(LAS unsigned char* lds, const Ptrs& p, int l, int tid) {
    const int lane = tid & 63, wave = __builtin_amdgcn_readfirstlane(tid >> 6), li = lane & 15, g = lane >> 4;
    const bf16_t* Qg = wsb<C>(p, C::WS_Q); bf16_t* AO = wsb<C>(p, C::WS_AO);
    for (int u = blockIdx.x; u < NUNITS; u += gridDim.x) {
        int row0, nrows, head; const float* kb; const float* vb;
        if (u < NU_P) { const int b = u / (NU_P / C::BATCH), rem = u % (NU_P / C::BATCH); head = rem / (C::SEQ / 128); const int qt = rem % (C::SEQ / 128);
            row0 = b * C::SEQ + qt * 128; nrows = 128;
            kb = p.out + C::OUT_MK + ((size_t)l * C::BATCH + b) * TOK * LD + head * HDIM; vb = p.out + C::OUT_MV + ((size_t)l * C::BATCH + b) * TOK * LD + head * HDIM; }
        else { const int s = u - NU_P, b = s / NH; head = s % NH; row0 = C::MP + b * C::DEC_SEQ; nrows = C::DEC_SEQ;
            kb = p.in[I_CK] + ((size_t)l * C::DEC_BATCH + b) * TOK * LD + head * HDIM; vb = p.in[I_CV] + ((size_t)l * C::DEC_BATCH + b) * TOK * LD + head * HDIM; }
        const bool active = wave * 16 < nrows;
        const int qrow = row0 + wave * 16 + li;
        bf16x8 qf[16];
        if (active) {
#pragma unroll
            for (int ks = 0; ks < 16; ++ks) qf[ks] = *(const bf16x8*)(Qg + (size_t)qrow * LD + head * HDIM + ks * 32 + g * 8);
        } else {
#pragma unroll
            for (int ks = 0; ks < 16; ++ks) qf[ks] = (bf16x8){0, 0, 0, 0, 0, 0, 0, 0};
        }
        f32x4 s[16];
#pragma unroll
        for (int T = 0; T < 16; ++T) s[T] = (f32x4){0.f, 0.f, 0.f, 0.f};
        f32x4 pre[8];
        stage_load(pre, kb, tid); stage_store(pre, lds, tid);
        __syncthreads();
#pragma unroll
        for (int c = 0; c < 8; ++c) {
            LAS unsigned char* buf = lds + (c & 1) * CBYTES;
            stage_load(pre, c < 7 ? kb + (c + 1) * CD : vb, tid);
            if (active) {
#pragma unroll
                for (int ks = 0; ks < 2; ++ks)
#pragma unroll
                    for (int T = 0; T < 16; ++T) { const bf16x8 a = *(const LAS bf16x8*)(buf + (T * 16 + li) * PITCH + ks * 64 + g * 16);
                        s[T] = __builtin_amdgcn_mfma_f32_16x16x32_bf16(a, qf[2 * c + ks], s[T], 0, 0, 0); }
            }
            stage_store(pre, lds + ((c + 1) & 1) * CBYTES, tid);
            __syncthreads();
        }
        float mx = -3.0e38f;
#pragma unroll
        for (int T = 0; T < 16; ++T) { mx = fmaxf(mx, fmaxf(fmaxf(s[T][0], s[T][1]), fmaxf(s[T][2], s[T][3]))); }
        mx = fmaxf(mx, __shfl_xor(mx, 16)); mx = fmaxf(mx, __shfl_xor(mx, 32));
        const float sc = 0.044194173824159216f * 1.4426950408889634f;
        float sum = 0.f;
#pragma unroll
        for (int T = 0; T < 16; ++T)
#pragma unroll
            for (int j = 0; j < 4; ++j) { const float e = __builtin_amdgcn_exp2f((s[T][j] - mx) * sc); s[T][j] = e; sum += e; }
        sum += __shfl_xor(sum, 16); sum += __shfl_xor(sum, 32);
        const float inv = 1.0f / sum;
        bf16x8 pf[8];
#pragma unroll
        for (int t = 0; t < 8; ++t) { const unsigned w0 = pg8::cvt_pk_bf16(s[2 * t][0], s[2 * t][1]), w1 = pg8::cvt_pk_bf16(s[2 * t][2], s[2 * t][3]),
                w2 = pg8::cvt_pk_bf16(s[2 * t + 1][0], s[2 * t + 1][1]), w3 = pg8::cvt_pk_bf16(s[2 * t + 1][2], s[2 * t + 1][3]);
            pg8::u32x4 w; w.x = w0; w.y = w1; w.z = w2; w.w = w3; pf[t] = __builtin_bit_cast(bf16x8, w); }
        const unsigned trb = (unsigned)(size_t)lds + (unsigned)((4 * g + (li >> 2)) * PITCH + (li & 3) * 8);
        for (int c = 0; c < 8; ++c) {
            const unsigned bofs = (unsigned)(c & 1) * CBYTES;
            if (c < 7) stage_load(pre, vb + (c + 1) * CD, tid);
            if (active) {
                f32x4 o[4];
#pragma unroll
                for (int dt = 0; dt < 4; ++dt) o[dt] = (f32x4){0.f, 0.f, 0.f, 0.f};
#pragma unroll
                for (int t = 0; t < 8; ++t) {
                    s16x4 lo[4], hi[4];
#pragma unroll
                    for (int dt = 0; dt < 4; ++dt) { lo[dt] = tr_read(trb + bofs + (unsigned)(t * 32 * PITCH + dt * 32)); hi[dt] = tr_read(trb + bofs + (unsigned)(t * 32 * PITCH + 16 * PITCH + dt * 32)); }
                    asm volatile("s_waitcnt lgkmcnt(0)" ::: "memory"); __builtin_amdgcn_sched_barrier(0);
#pragma unroll
                    for (int dt = 0; dt < 4; ++dt) { const bf16x8 a = (bf16x8){lo[dt][0], lo[dt][1], lo[dt][2], lo[dt][3], hi[dt][0], hi[dt][1], hi[dt][2], hi[dt][3]};
                        o[dt] = __builtin_amdgcn_mfma_f32_16x16x32_bf16(a, pf[t], o[dt], 0, 0, 0); }
                }
#pragma unroll
                for (int dt = 0; dt < 4; ++dt) { u32x2 w; w.x = pg8::cvt_pk_bf16(o[dt][0] * inv, o[dt][1] * inv); w.y = pg8::cvt_pk_bf16(o[dt][2] * inv, o[dt][3] * inv);
                    *(u32x2*)(AO + (size_t)qrow * LD + head * HDIM + c * CD + dt * 16 + g * 4) = w; }
            }
            if (c < 7) stage_store(pre, lds + ((c + 1) & 1) * CBYTES, tid);
            __syncthreads();
        }
    }
}
}
namespace mx {
typedef att::bf16x8 bf16x8; typedef att::s16x4 s16x4; typedef att::f32x4 f32x4; typedef att::u32x2 u32x2;
constexpr int PT = 272;
constexpr int T64 = 64 * PT, T128 = 128 * PT;
static_assert(C::MHD == 128 && C::CH == 64 && C::MH == 8 && C::LCS == 32, "mLSTM phases are built for these shapes");
__device__ __forceinline__ void lds_wait() { asm volatile("s_waitcnt lgkmcnt(0)" ::: "memory"); __builtin_amdgcn_sched_barrier(0); }
__device__ __forceinline__ bf16x8 mk8(s16x4 lo, s16x4 hi) { return (bf16x8){lo[0], lo[1], lo[2], lo[3], hi[0], hi[1], hi[2], hi[3]}; }
__device__ __forceinline__ unsigned tr_addr(unsigned tile, int krow, int c0, int li) { return tile + (unsigned)((krow + (li >> 2)) * PT + (c0 + 4 * (li & 3)) * 2); }
__device__ __forceinline__ void ch_decode(int ci, int& r0, int& h, int& lc) {
    if (ci < C::NPC) { const int c = ci % C::NC, bh = ci / C::NC; h = bh % C::MH; r0 = (bh / C::MH) * C::SEQ + c * C::CH; lc = C::CH; }
    else { const int q = ci - C::NPC; h = q % C::MH; r0 = C::MP + (q / C::MH) * C::DEC_SEQ; lc = C::LCS; }
}
__device__ __forceinline__ void stage64(LAS unsigned char* tile, const float* src, int ld, int lc, int tid, const LAS float* rs, float mul) {
#pragma unroll
    for (int i = 0; i < 4; ++i) { const int f = tid + 512 * i, row = f >> 5, c4 = f & 31; f32x4 v = (f32x4){0.f, 0.f, 0.f, 0.f};
        if (row < lc) { v = *(const f32x4*)(src + (size_t)row * ld + c4 * 4); const float m = rs ? rs[row] * mul : mul; v = v * m; }
        u32x2 w; w.x = pg8::cvt_pk_bf16(v[0], v[1]); w.y = pg8::cvt_pk_bf16(v[2], v[3]); *(LAS u32x2*)(tile + row * PT + c4 * 8) = w; }
}
__device__ __forceinline__ void ml_phase_a(LAS unsigned char* lds, const Ptrs& p, int l, int tid) {
    const int lane = tid & 63, wave = __builtin_amdgcn_readfirstlane(tid >> 6), li = lane & 15, g = lane >> 4;
    LAS unsigned char* Ks = lds; LAS unsigned char* Vs = lds + T64; LAS float* wts = (LAS float*)(lds + 2 * T64);
    const float* P = wsf<C>(p, C::WS_BIG);
    for (int ci = blockIdx.x; ci < C::NCH; ci += gridDim.x) {
        int r0, h, lc; ch_decode(ci, r0, h, lc);
        if (wave == 0) {
            float lf = 0.f, ig = -3.0e38f;
            if (lane < lc) { const float* pr = P + (size_t)(r0 + lane) * C::LDP; ig = pr[C::O_IG + h] + p.in[I_IB][l * C::MH + h]; lf = logsigmoidf_(pr[C::O_FG + h] + p.in[I_FB][l * C::MH + h]); }
            float b = lf;
#pragma unroll
            for (int o = 1; o < 64; o <<= 1) { const float t = __shfl_up(b, o); if (lane >= o) b += t; }
            const float a = lane < lc ? ig - b : -3.0e38f;
            float amax = a;
#pragma unroll
            for (int o = 1; o < 64; o <<= 1) amax = fmaxf(amax, __shfl_xor(amax, o));
            const float bL = __shfl(b, lc - 1), mloc = bL + amax;
            const float wt = lane < lc ? __expf(bL + a - mloc) : 0.f;
            wts[lane] = wt;
            if (lane < lc) { wsf<C>(p, C::WS_GB)[(size_t)(r0 + lane) * C::MH + h] = b; wsf<C>(p, C::WS_GA)[(size_t)(r0 + lane) * C::MH + h] = a; }
            if (lane == 0) { wsf<C>(p, C::WS_CBL)[ci] = bL; wsf<C>(p, C::WS_CML)[ci] = mloc; }
        }
        __syncthreads();
        stage64(Ks, P + (size_t)r0 * C::LDP + C::O_K + h * C::MHD, C::LDP, lc, tid, wts, 0.08838834764831845f);
        stage64(Vs, P + (size_t)r0 * C::LDP + C::O_VM + h * C::MHD, C::LDP, lc, tid, nullptr, 1.0f);
        __syncthreads();
        f32x4 acc[8];
#pragma unroll
        for (int et = 0; et < 8; ++et) acc[et] = (f32x4){0.f, 0.f, 0.f, 0.f};
        const unsigned ks = (unsigned)(size_t)Ks, vs = (unsigned)(size_t)Vs;
#pragma unroll
        for (int t = 0; t < 2; ++t) {
            const s16x4 alo = att::tr_read(tr_addr(ks, 32 * t + 8 * g, 16 * wave, li)), ahi = att::tr_read(tr_addr(ks, 32 * t + 8 * g + 4, 16 * wave, li));
            s16x4 blo[8], bhi[8];
#pragma unroll
            for (int et = 0; et < 8; ++et) { blo[et] = att::tr_read(tr_addr(vs, 32 * t + 8 * g, 16 * et, li)); bhi[et] = att::tr_read(tr_addr(vs, 32 * t + 8 * g + 4, 16 * et, li)); }
            lds_wait();
            const bf16x8 a = mk8(alo, ahi);
#pragma unroll
            for (int et = 0; et < 8; ++et) acc[et] = __builtin_amdgcn_mfma_f32_16x16x32_bf16(a, mk8(blo[et], bhi[et]), acc[et], 0, 0, 0);
        }
        float* DC = wsf<C>(p, C::WS_DC) + (size_t)ci * C::MHD * C::MHD;
#pragma unroll
        for (int et = 0; et < 8; ++et)
#pragma unroll
            for (int r = 0; r < 4; ++r) DC[(size_t)(16 * wave + 4 * g + r) * C::MHD + 16 * et + li] = acc[et][r];
        if (tid < C::MHD) { float s = 0.f; for (int t = 0; t < 64; ++t) s += bf2f(*(const LAS bf16_t*)(Ks + t * PT + tid * 2)); wsf<C>(p, C::WS_DN)[(size_t)ci * C::MHD + tid] = s; }
        __syncthreads();
    }
}
__device__ __forceinline__ void ml_phase_c(LAS unsigned char* lds, const Ptrs& p, int l, int tid) {
    const int lane = tid & 63, wave = __builtin_amdgcn_readfirstlane(tid >> 6), li = lane & 15, g = lane >> 4, it = wave & 3, eh = wave >> 2;
    LAS unsigned char* Qs = lds; LAS unsigned char* Ks = lds + T64; LAS unsigned char* Vs = lds + 2 * T64; LAS unsigned char* Cs = lds + 3 * T64;
    LAS float* sb = (LAS float*)(lds + 3 * T64 + T128);
    LAS float* sa = sb + 64; LAS float* smr = sb + 128; LAS float* siw = sb + 192; LAS float* snp = sb + 256; LAS float* ssq = sb + 384;
    const float* P = wsf<C>(p, C::WS_BIG);
    for (int ci = blockIdx.x; ci < C::NCH; ci += gridDim.x) {
        int r0, h, lc; ch_decode(ci, r0, h, lc);
        const bool sample = ci >= C::NPC, first = !sample && (ci % C::NC) == 0;
        const float mprev = wsf<C>(p, C::WS_MPREV)[ci];
        if (wave == 0) {
            float b = 0.f, a = -3.0e38f;
            if (lane < lc) { b = wsf<C>(p, C::WS_GB)[(size_t)(r0 + lane) * C::MH + h]; a = wsf<C>(p, C::WS_GA)[(size_t)(r0 + lane) * C::MH + h]; }
            float pm = a;
#pragma unroll
            for (int o = 1; o < 64; o <<= 1) { const float t = __shfl_up(pm, o); if (lane >= o) pm = fmaxf(pm, t); }
            const float mrow = b + fmaxf(mprev, pm);
            sb[lane] = b; sa[lane] = a; smr[lane] = mrow; siw[lane] = __expf(b + mprev - mrow);
        }
        if (tid >= 128 && tid < 256) { const int d = tid - 128;
            snp[d] = sample ? p.in[I_SN][((size_t)l * C::NSC + (ci - C::NPC)) * C::MHD + d] : (first ? 0.f : wsf<C>(p, C::WS_DN)[(size_t)(ci - 1) * C::MHD + d]); }
        stage64(Qs, P + (size_t)r0 * C::LDP + C::O_Q + h * C::MHD, C::LDP, lc, tid, nullptr, 1.0f);
        stage64(Ks, P + (size_t)r0 * C::LDP + C::O_K + h * C::MHD, C::LDP, lc, tid, nullptr, 0.08838834764831845f);
        stage64(Vs, P + (size_t)r0 * C::LDP + C::O_VM + h * C::MHD, C::LDP, lc, tid, nullptr, 1.0f);
        { const float* cp = sample ? p.in[I_SC] + ((size_t)l * C::NSC + (ci - C::NPC)) * C::MHD * C::MHD : wsf<C>(p, C::WS_DC) + (size_t)(first ? ci : ci - 1) * C::MHD * C::MHD;
#pragma unroll
            for (int i = 0; i < 8; ++i) { const int f = tid + 512 * i, row = f >> 5, c4 = f & 31; f32x4 v = (f32x4){0.f, 0.f, 0.f, 0.f};
                if (!first) v = *(const f32x4*)(cp + (size_t)row * C::MHD + c4 * 4);
                u32x2 w; w.x = pg8::cvt_pk_bf16(v[0], v[1]); w.y = pg8::cvt_pk_bf16(v[2], v[3]); *(LAS u32x2*)(Cs + row * PT + c4 * 8) = w; } }
        __syncthreads();
        const bool active = it * 16 < lc;
        float ssq_part = 0.f; f32x4 hv[4]; float inv_den = 0.f;
        const int i = 16 * it + li;
        if (active) {
            bf16x8 qf[4];
#pragma unroll
            for (int ks = 0; ks < 4; ++ks) qf[ks] = *(const LAS bf16x8*)(Qs + i * PT + ks * 64 + g * 16);
            f32x4 st[4];
#pragma unroll
            for (int jt = 0; jt < 4; ++jt) st[jt] = (f32x4){0.f, 0.f, 0.f, 0.f};
#pragma unroll
            for (int jt = 0; jt < 4; ++jt) if (jt <= it) {
#pragma unroll
                for (int ks = 0; ks < 4; ++ks) { const bf16x8 a = *(const LAS bf16x8*)(Ks + (16 * jt + li) * PT + ks * 64 + g * 16);
                    st[jt] = __builtin_amdgcn_mfma_f32_16x16x32_bf16(a, qf[ks], st[jt], 0, 0, 0); } }
            const float bi = sb[i], mri = smr[i], iwi = siw[i];
            float dsum = 0.f;
#pragma unroll
            for (int jt = 0; jt < 4; ++jt)
#pragma unroll
                for (int r = 0; r < 4; ++r) { const int j = 16 * jt + 4 * g + r; const float w = (j <= i) ? __expf(bi + sa[j] - mri) : 0.f; st[jt][r] *= w; dsum += st[jt][r]; }
            dsum += __shfl_xor(dsum, 16); dsum += __shfl_xor(dsum, 32);
            float qn = 0.f;
#pragma unroll
            for (int ks = 0; ks < 4; ++ks)
#pragma unroll
                for (int jj = 0; jj < 8; ++jj) qn += bf2f((bf16_t)qf[ks][jj]) * snp[32 * ks + 8 * g + jj];
            qn += __shfl_xor(qn, 16); qn += __shfl_xor(qn, 32);
            const float den = dsum + iwi * qn;
            inv_den = 1.0f / fmaxf(fabsf(den), __expf(-mri));
            bf16x8 pf[2];
#pragma unroll
            for (int t = 0; t < 2; ++t) { pg8::u32x4 w; w.x = pg8::cvt_pk_bf16(st[2 * t][0], st[2 * t][1]); w.y = pg8::cvt_pk_bf16(st[2 * t][2], st[2 * t][3]);
                w.z = pg8::cvt_pk_bf16(st[2 * t + 1][0], st[2 * t + 1][1]); w.w = pg8::cvt_pk_bf16(st[2 * t + 1][2], st[2 * t + 1][3]); pf[t] = __builtin_bit_cast(bf16x8, w); }
            const unsigned vs = (unsigned)(size_t)Vs, cs = (unsigned)(size_t)Cs;
#pragma unroll
            for (int e4 = 0; e4 < 4; ++e4) { const int et = 4 * eh + e4;
                s16x4 vlo[2], vhi[2], clo[4], chi[4];
#pragma unroll
                for (int t = 0; t < 2; ++t) { vlo[t] = att::tr_read(tr_addr(vs, 32 * t + 4 * g, 16 * et, li)); vhi[t] = att::tr_read(tr_addr(vs, 32 * t + 16 + 4 * g, 16 * et, li)); }
#pragma unroll
                for (int ks = 0; ks < 4; ++ks) { clo[ks] = att::tr_read(tr_addr(cs, 32 * ks + 8 * g, 16 * et, li)); chi[ks] = att::tr_read(tr_addr(cs, 32 * ks + 8 * g + 4, 16 * et, li)); }
                lds_wait();
                f32x4 aS = (f32x4){0.f, 0.f, 0.f, 0.f}, aC = (f32x4){0.f, 0.f, 0.f, 0.f};
#pragma unroll
                for (int t = 0; t < 2; ++t) aS = __builtin_amdgcn_mfma_f32_16x16x32_bf16(mk8(vlo[t], vhi[t]), pf[t], aS, 0, 0, 0);
#pragma unroll
                for (int ks = 0; ks < 4; ++ks) aC = __builtin_amdgcn_mfma_f32_16x16x32_bf16(mk8(clo[ks], chi[ks]), qf[ks], aC, 0, 0, 0);
                hv[e4] = (aS + aC * iwi) * inv_den;
                ssq_part += (hv[e4][0] * hv[e4][0] + hv[e4][1] * hv[e4][1]) + (hv[e4][2] * hv[e4][2] + hv[e4][3] * hv[e4][3]); }
            ssq_part += __shfl_xor(ssq_part, 16); ssq_part += __shfl_xor(ssq_part, 32);
            if (g == 0) ssq[wave * 16 + li] = ssq_part;
        }
        __syncthreads();
        if (active) {
            const float tot = ssq_part + ssq[(wave ^ 4) * 16 + li];
            const float rs = rsqrtf(tot * (1.0f / C::MHD) + 1e-6f);
            const int row = r0 + i;
#pragma unroll
            for (int e4 = 0; e4 < 4; ++e4) { const int e = 16 * (4 * eh + e4) + 4 * g;
                const f32x4 og = *(const f32x4*)(P + (size_t)row * C::LDP + C::O_O + h * C::MHD + e); const f32x4 gn = *(const f32x4*)(p.in[I_NG] + (size_t)l * C::MW + h * C::MHD + e);
                float o4[4];
#pragma unroll
                for (int r = 0; r < 4; ++r) o4[r] = hv[e4][r] * rs * gn[r] * __builtin_amdgcn_rcpf(1.0f + __expf(-og[r]));
                u32x2 w; w.x = pg8::cvt_pk_bf16(o4[0], o4[1]); w.y = pg8::cvt_pk_bf16(o4[2], o4[3]);
                *(u32x2*)(wsb<C>(p, C::WS_MIX) + (size_t)row * C::D + C::PW + C::GW + h * C::MHD + e) = w; }
        }
        __syncthreads();
    }
}
}
namespace rw {
typedef att::f32x4 f32x4; typedef att::u32x2 u32x2;
static_assert(C::D == 2048, "row ops assume 2048 columns = 8 float4 per lane");
__device__ __forceinline__ float wave_sum(float v) {
#pragma unroll
    for (int o = 1; o < 64; o <<= 1) v += __shfl_xor(v, o);
    return v;
}
__device__ __forceinline__ void rows_init(const Ptrs& p, int tid) {
    const int lane = tid & 63, gw = blockIdx.x * NWAVES + (tid >> 6), NGW = gridDim.x * NWAVES;
    float* SS = wsf<C>(p, C::WS_SS);
    for (int r = gw; r < C::M; r += NGW) {
        const float* src = r < C::MP ? p.in[I_XP] + (size_t)r * C::D : p.in[I_XS] + (size_t)(r - C::MP) * C::D;
        float* X = wsf<C>(p, C::WS_X) + (size_t)r * C::D; bf16_t* XB = wsb<C>(p, C::WS_XB) + (size_t)r * C::D;
        float ss = 0.f;
#pragma unroll
        for (int j = 0; j < 8; ++j) { const f32x4 v = *(const f32x4*)(src + (lane + 64 * j) * 4); *(f32x4*)(X + (lane + 64 * j) * 4) = v;
            u32x2 w; w.x = pg8::cvt_pk_bf16(v[0], v[1]); w.y = pg8::cvt_pk_bf16(v[2], v[3]); *(u32x2*)(XB + (lane + 64 * j) * 4) = w;
            ss += (v[0] * v[0] + v[1] * v[1]) + (v[2] * v[2] + v[3] * v[3]); }
        ss = wave_sum(ss);
        if (lane < C::NSS) SS[(size_t)lane * C::M + r] = lane == 0 ? ss : 0.f;
    }
    for (int r = gw; r < C::MM; r += NGW) {
        const float* src = p.in[I_MEM] + (size_t)r * C::D; bf16_t* MB = wsb<C>(p, C::WS_MEMB) + (size_t)r * C::D;
        float ss = 0.f;
#pragma unroll
        for (int j = 0; j < 8; ++j) { const f32x4 v = *(const f32x4*)(src + (lane + 64 * j) * 4);
            u32x2 w; w.x = pg8::cvt_pk_bf16(v[0], v[1]); w.y = pg8::cvt_pk_bf16(v[2], v[3]); *(u32x2*)(MB + (lane + 64 * j) * 4) = w;
            ss += (v[0] * v[0] + v[1] * v[1]) + (v[2] * v[2] + v[3] * v[3]); }
        ss = wave_sum(ss);
        if (lane == 0) wsf<C>(p, C::WS_RSTDM)[r] = rsqrtf(ss * (1.0f / C::D) + 1e-6f);
    }
}
__device__ __forceinline__ void rows_final(const Ptrs& p, int tid) {
    const int lane = tid & 63, gw = blockIdx.x * NWAVES + (tid >> 6), NGW = gridDim.x * NWAVES;
    for (int r = gw; r < C::M; r += NGW) {
        const float* X = wsf<C>(p, C::WS_X) + (size_t)r * C::D; const float rs = rsqrtf(wsf<C>(p, C::WS_SS)[(size_t)(C::NSS - 1) * C::M + r] * (1.0f / C::D) + 1e-6f);
        float* o = r < C::MP ? p.out + C::OUT_YP + (size_t)r * C::D : p.out + C::OUT_YS + (size_t)(r - C::MP) * C::D;
#pragma unroll
        for (int j = 0; j < 8; ++j) { const f32x4 v = *(const f32x4*)(X + (lane + 64 * j) * 4); const f32x4 gg = *(const f32x4*)(p.in[I_GFIN] + (lane + 64 * j) * 4);
            *(f32x4*)(o + (lane + 64 * j) * 4) = v * rs * gg; }
    }
}
__device__ __forceinline__ void ml_scan(const Ptrs& p, int l, long gtid, long gthreads) {
    const float* CBL = wsf<C>(p, C::WS_CBL); const float* CML = wsf<C>(p, C::WS_CML);
    float* DC = wsf<C>(p, C::WS_DC); float* DN = wsf<C>(p, C::WS_DN);
    constexpr int NPS = C::BATCH * C::MH, E4 = C::MHD / 4;
    for (long it = gtid; it < (long)NPS * C::MHD * E4; it += gthreads) {
        const int e4 = (int)(it % E4), d = (int)((it / E4) % C::MHD), sq = (int)(it / ((long)E4 * C::MHD));
        float m = 0.f; f32x4 cst = (f32x4){0.f, 0.f, 0.f, 0.f};
        for (int c = 0; c < C::NC; ++c) { const int ci = sq * C::NC + c; const float a = CBL[ci] + m, b2 = CML[ci], mn = fmaxf(a, b2), dec = __expf(a - mn), f = __expf(b2 - mn);
            f32x4* q = (f32x4*)(DC + ((size_t)ci * C::MHD + d) * C::MHD + e4 * 4); cst = cst * dec + *q * f; *q = cst; m = mn; }
        *(f32x4*)(p.out + C::OUT_CP + (((size_t)l * NPS + sq) * C::MHD + d) * C::MHD + e4 * 4) = cst;
    }
    for (long it = gtid; it < (long)NPS * C::MHD; it += gthreads) {
        const int d = (int)(it % C::MHD), sq = (int)(it / C::MHD);
        float m = 0.f, nst = 0.f;
        for (int c = 0; c < C::NC; ++c) { const int ci = sq * C::NC + c; const float a = CBL[ci] + m, b2 = CML[ci], mn = fmaxf(a, b2), dec = __expf(a - mn), f = __expf(b2 - mn);
            const size_t on = (size_t)ci * C::MHD + d; nst = dec * nst + f * DN[on]; DN[on] = nst; m = mn; }
        p.out[C::OUT_NP + ((size_t)l * NPS + sq) * C::MHD + d] = nst;
    }
    for (long it = gtid; it < (long)C::NSC * C::MHD * E4; it += gthreads) {
        const int e4 = (int)(it % E4), d = (int)((it / E4) % C::MHD), q = (int)(it / ((long)E4 * C::MHD)), ci = C::NPC + q;
        const float m0 = p.in[I_SM][(size_t)l * C::NSC + q], a = CBL[ci] + m0, b2 = CML[ci], mn = fmaxf(a, b2), dec = __expf(a - mn), f = __expf(b2 - mn);
        const size_t so = (((size_t)l * C::NSC + q) * C::MHD + d) * C::MHD + e4 * 4;
        *(f32x4*)(p.out + C::OUT_CS + so) = *(const f32x4*)(p.in[I_SC] + so) * dec + *(const f32x4*)(DC + ((size_t)ci * C::MHD + d) * C::MHD + e4 * 4) * f;
    }
    for (long it = gtid; it < (long)C::NSC * C::MHD; it += gthreads) {
        const int d = (int)(it % C::MHD), q = (int)(it / C::MHD), ci = C::NPC + q;
        const float m0 = p.in[I_SM][(size_t)l * C::NSC + q], a = CBL[ci] + m0, b2 = CML[ci], mn = fmaxf(a, b2), dec = __expf(a - mn), f = __expf(b2 - mn);
        const size_t no = ((size_t)l * C::NSC + q) * C::MHD + d;
        p.out[C::OUT_NS + no] = dec * p.in[I_SN][no] + f * DN[(size_t)ci * C::MHD + d];
    }
}
}

namespace gp {
typedef att::bf16x8 bf16x8; typedef att::s16x4 s16x4; typedef att::f32x4 f32x4; typedef att::u32x2 u32x2;
constexpr int PT = mx::PT, T128 = mx::T128;
static_assert(C::GHD == 128 && C::PGD == 128 && C::GCH == 128 && C::SEQ % 128 == 0 && C::DEC_SEQ == 32 && C::PH == 15, "gmlp / pool phases are built for these shapes");
constexpr int NT_P = C::MP / 128;
constexpr int NU_G = NT_P * 4 + C::DEC_BATCH * 4;
__device__ __forceinline__ void gmlp_phase(LAS unsigned char* lds, const Ptrs& p, int l, int tid) {
    const int lane = tid & 63, wave = __builtin_amdgcn_readfirstlane(tid >> 6), li = lane & 15, g = lane >> 4;
    LAS unsigned char* Vs = lds; LAS unsigned char* Ws = lds + T128;
    const float* P = wsf<C>(p, C::WS_BIG);
    for (int u = blockIdx.x; u < NU_G; u += gridDim.x) {
        int r0, lc, h; bool sample = false; int sb = 0;
        if (u < NT_P * 4) { h = u & 3; r0 = (u >> 2) * 128; lc = 128; } else { const int s = u - NT_P * 4; h = s & 3; sb = s >> 2; r0 = C::MP + sb * C::DEC_SEQ; lc = C::DEC_SEQ; sample = true; }
#pragma unroll
        for (int i = 0; i < 8; ++i) { const int f = tid + 512 * i, row = f >> 5, c4 = f & 31; f32x4 v = (f32x4){0.f, 0.f, 0.f, 0.f};
            if (row < lc) v = *(const f32x4*)(P + (size_t)(r0 + row) * C::LDP + C::O_V + h * 128 + c4 * 4);
            float ss = (v[0] * v[0] + v[1] * v[1]) + (v[2] * v[2] + v[3] * v[3]);
#pragma unroll
            for (int o = 1; o < 32; o <<= 1) ss += __shfl_xor(ss, o);
            const float rs = rsqrtf(ss * (1.0f / 128) + 1e-6f); const f32x4 gn = *(const f32x4*)(p.in[I_GVG] + (size_t)l * C::GW + h * 128 + c4 * 4);
            v = v * rs * gn;
            if (sample && row < lc) *(f32x4*)(p.out + C::OUT_VS + (((size_t)l * C::DEC_BATCH + sb) * C::DEC_SEQ + row) * C::GW + h * 128 + c4 * 4) = v;
            u32x2 w; w.x = pg8::cvt_pk_bf16(v[0], v[1]); w.y = pg8::cvt_pk_bf16(v[2], v[3]); *(LAS u32x2*)(Vs + row * PT + c4 * 8) = w; }
        const float* wsrc = p.in[I_GWS] + ((size_t)l * C::GH + h) * 128 * 128;
#pragma unroll
        for (int i = 0; i < 8; ++i) { const int f = tid + 512 * i, row = f >> 5, c4 = f & 31; f32x4 v = *(const f32x4*)(wsrc + (size_t)row * 128 + c4 * 4);
#pragma unroll
            for (int j = 0; j < 4; ++j) if (c4 * 4 + j > row) v[j] = 0.f;
            u32x2 w; w.x = pg8::cvt_pk_bf16(v[0], v[1]); w.y = pg8::cvt_pk_bf16(v[2], v[3]); *(LAS u32x2*)(Ws + row * PT + c4 * 8) = w; }
        __syncthreads();
        if (wave * 16 < lc) {
            const int i = wave * 16 + li, nks = (wave * 16 + 15) / 32 + 1;
            f32x4 acc[8];
#pragma unroll
            for (int dt = 0; dt < 8; ++dt) acc[dt] = (f32x4){0.f, 0.f, 0.f, 0.f};
            const unsigned vs = (unsigned)(size_t)Vs;
            for (int ks = 0; ks < nks; ++ks) {
                const bf16x8 bq = *(const LAS bf16x8*)(Ws + i * PT + ks * 64 + g * 16);
                s16x4 lo[8], hi[8];
#pragma unroll
                for (int dt = 0; dt < 8; ++dt) { lo[dt] = att::tr_read(mx::tr_addr(vs, 32 * ks + 8 * g, 16 * dt, li)); hi[dt] = att::tr_read(mx::tr_addr(vs, 32 * ks + 8 * g + 4, 16 * dt, li)); }
                mx::lds_wait();
#pragma unroll
                for (int dt = 0; dt < 8; ++dt) acc[dt] = __builtin_amdgcn_mfma_f32_16x16x32_bf16(mx::mk8(lo[dt], hi[dt]), bq, acc[dt], 0, 0, 0);
            }
            const float bsi = p.in[I_GBS][((size_t)l * C::GH + h) * C::GCH + i];
            const int row = r0 + i;
#pragma unroll
            for (int dt = 0; dt < 8; ++dt) { const int d = 16 * dt + 4 * g; const f32x4 uu = *(const f32x4*)(P + (size_t)row * C::LDP + C::O_U + h * 128 + d);
                u32x2 w; w.x = pg8::cvt_pk_bf16(uu[0] * (acc[dt][0] + bsi), uu[1] * (acc[dt][1] + bsi)); w.y = pg8::cvt_pk_bf16(uu[2] * (acc[dt][2] + bsi), uu[3] * (acc[dt][3] + bsi));
                *(u32x2*)(wsb<C>(p, C::WS_MIX) + (size_t)row * C::D + C::PW + h * 128 + d) = w; }
        }
        __syncthreads();
    }
}
__device__ __forceinline__ void pool_phase(LAS unsigned char* lds, const Ptrs& p, int l, int tid) {
    const int lane = tid & 63, wave = __builtin_amdgcn_readfirstlane(tid >> 6), li = lane & 15, g = lane >> 4;
    LAS unsigned char* Ds = lds; LAS unsigned char* Ws = lds + T128;
    const float* P = wsf<C>(p, C::WS_BIG);
    for (int u = blockIdx.x; u < NU_G; u += gridDim.x) {
        int r0, lc, grp, t0, L, b; bool sample = false;
        if (u < NT_P * 4) { grp = u & 3; r0 = (u >> 2) * 128; lc = 128; b = r0 / C::SEQ; t0 = r0 % C::SEQ; L = C::SEQ; } else { const int s = u - NT_P * 4; grp = s & 3; b = s >> 2; r0 = C::MP + b * C::DEC_SEQ; lc = C::DEC_SEQ; t0 = 0; L = C::DEC_SEQ; sample = true; }
        const int w = 2 << grp;
        { const int c4 = tid & 31, sg = tid >> 5, ch = grp * 128 + c4 * 4;
            const float* hist = p.in[I_SPOOL] + ((size_t)l * C::DEC_BATCH + b) * C::PH * C::PW + ch;
            auto xat = [&](int t) -> f32x4 {
                if (t >= 0) return *(const f32x4*)(P + (size_t)(r0 - t0 + t) * C::LDP + ch);
                if (sample && C::PH + t >= 0) return *(const f32x4*)(hist + (size_t)(C::PH + t) * C::PW);
                return (f32x4){0.f, 0.f, 0.f, 0.f}; };
            if (sg * 8 < lc) {
                const int ts = t0 + sg * 8;
                f32x4 sum = (f32x4){0.f, 0.f, 0.f, 0.f};
                for (int j = 1; j < w; ++j) sum = sum + xat(ts - j);
#pragma unroll
                for (int k = 0; k < 8; ++k) { const int t = ts + k; const f32x4 x = xat(t); sum = sum + x;
                    const int pos = (sample ? C::PAST : 0) + t; const float inv = 1.0f / (float)((pos + 1) < w ? (pos + 1) : w);
                    const f32x4 dv = sum * inv - x;
                    u32x2 ww; ww.x = pg8::cvt_pk_bf16(dv[0], dv[1]); ww.y = pg8::cvt_pk_bf16(dv[2], dv[3]); *(LAS u32x2*)(Ds + (sg * 8 + k) * PT + c4 * 8) = ww;
                    sum = sum - xat(t - w + 1);
                    const int idx = t - (L - C::PH);
                    if (idx >= 0) *(f32x4*)(p.out + (sample ? C::OUT_POOLS + (((size_t)l * C::DEC_BATCH + b) * C::PH + idx) * C::PW : C::OUT_POOLP + (((size_t)l * C::BATCH + b) * C::PH + idx) * C::PW) + ch) = x; }
            } else {
#pragma unroll
                for (int k = 0; k < 8; ++k) *(LAS u32x2*)(Ds + (sg * 8 + k) * PT + c4 * 8) = (u32x2){0u, 0u};
            }
        }
        const float* wsrc = p.in[I_POOLW] + ((size_t)l * C::PG + grp) * 128 * 128;
#pragma unroll
        for (int i = 0; i < 8; ++i) { const int f = tid + 512 * i, row = f >> 5, c4 = f & 31; const f32x4 v = *(const f32x4*)(wsrc + (size_t)row * 128 + c4 * 4);
            u32x2 ww; ww.x = pg8::cvt_pk_bf16(v[0], v[1]); ww.y = pg8::cvt_pk_bf16(v[2], v[3]); *(LAS u32x2*)(Ws + row * PT + c4 * 8) = ww; }
        __syncthreads();
        if (wave * 16 < lc) {
            const int t = wave * 16 + li;
            f32x4 acc[8];
#pragma unroll
            for (int et = 0; et < 8; ++et) acc[et] = (f32x4){0.f, 0.f, 0.f, 0.f};
            const unsigned wsa = (unsigned)(size_t)Ws;
#pragma unroll
            for (int ks = 0; ks < 4; ++ks) {
                const bf16x8 bq = *(const LAS bf16x8*)(Ds + t * PT + ks * 64 + g * 16);
                s16x4 lo[8], hi[8];
#pragma unroll
                for (int et = 0; et < 8; ++et) { lo[et] = att::tr_read(mx::tr_addr(wsa, 32 * ks + 8 * g, 16 * et, li)); hi[et] = att::tr_read(mx::tr_addr(wsa, 32 * ks + 8 * g + 4, 16 * et, li)); }
                mx::lds_wait();
#pragma unroll
                for (int et = 0; et < 8; ++et) acc[et] = __builtin_amdgcn_mfma_f32_16x16x32_bf16(mx::mk8(lo[et], hi[et]), bq, acc[et], 0, 0, 0);
            }
            const int row = r0 + t;
#pragma unroll
            for (int et = 0; et < 8; ++et) { const int e = 16 * et + 4 * g; const f32x4 sc = *(const f32x4*)(p.in[I_POOLS] + (size_t)l * C::PW + grp * 128 + e);
                u32x2 ww; ww.x = pg8::cvt_pk_bf16(acc[et][0] * sc[0], acc[et][1] * sc[1]); ww.y = pg8::cvt_pk_bf16(acc[et][2] * sc[2], acc[et][3] * sc[3]);
                *(u32x2*)(wsb<C>(p, C::WS_MIX) + (size_t)row * C::D + grp * 128 + e) = ww; }
        }
        __syncthreads();
    }
}
}
template <int MODE> __device__ __forceinline__ void split_reduce(const Ptrs& p, int tid, float scale, float* ssout, const float* ssin) {
    typedef att::f32x4 f32x4; typedef att::u32x2 u32x2;
    const int lane = tid & 63, gw = blockIdx.x * NWAVES + (tid >> 6), NGW = gridDim.x * NWAVES;
    const float* PART = wsf<C>(p, C::WS_PART);
    for (int w = gw; w < 32 * 256; w += NGW) {
        const int t = w >> 8, row = w & 255;
        pg8::StaticOrder S; S.init(C::M, C::D, 256, t); pg8::Unit u; S.next(1, u);
        const int grow = u.pm * 256 + row, gcol = u.pn * 256 + lane * 4;
        f32x4 s = (f32x4){0.f, 0.f, 0.f, 0.f};
#pragma unroll
        for (int sl = 0; sl < 8; ++sl) s = s + *(const f32x4*)(PART + ((size_t)(t * 8 + sl) * 65536) + row * 256 + lane * 4);
        if (MODE == 0) {
            float* xr = wsf<C>(p, C::WS_X) + (size_t)grow * C::D + gcol; const f32x4 x = *(const f32x4*)xr + s * scale; *(f32x4*)xr = x;
            u32x2 wv; wv.x = pg8::cvt_pk_bf16(x[0], x[1]); wv.y = pg8::cvt_pk_bf16(x[2], x[3]); *(u32x2*)(wsb<C>(p, C::WS_XB) + (size_t)grow * C::D + gcol) = wv;
            const float ss = rw::wave_sum((x[0] * x[0] + x[1] * x[1]) + (x[2] * x[2] + x[3] * x[3]));
            if (lane == 0) unsafeAtomicAdd(ssout + grow, ss);
        } else {
            const float rs = rsqrtf(ssin[grow] * (1.0f / C::D) + 1e-6f);
            u32x2 wv; wv.x = pg8::cvt_pk_bf16(s[0] * rs, s[1] * rs); wv.y = pg8::cvt_pk_bf16(s[2] * rs, s[3] * rs); *(u32x2*)(wsb<C>(p, C::WS_Q) + (size_t)grow * C::D + gcol) = wv;
        }
    }
}
constexpr int PH_PER_LAYER = 18, N_PHASES = 2 + PH_PER_LAYER * C::DEPTH;
struct Args { Ptrs p; int ph_lo, ph_hi; };
__global__ void __launch_bounds__(NTHREADS, 2) fwd(Args a) {
    extern __shared__ __attribute__((aligned(16))) unsigned char lds_raw[];
    LAS unsigned char* lds = (LAS unsigned char*)lds_raw;
    typedef __attribute__((address_space(4))) const Args* KArgs;
    const KArgs ka0 = (KArgs)__builtin_amdgcn_kernarg_segment_ptr();
    const int lo = a.ph_lo, hi = a.ph_hi;
#define IN(k) (lo <= (k) && (k) < hi)
#define BOTH(k) (IN(k) && IN((k) + 1))
#define GRID_BAR(k) do { if (BOTH(k)) { xcd_barrier(bar); } } while (0)
#if defined(__HIP_DEVICE_COMPILE__)
#define LOAD_PTRS KArgs ka = ka0; asm volatile("" : "+s"(ka)); Ptrs p; _Pragma("unroll") for (int i_ = 0; i_ < 33; ++i_) p.in[i_] = ka->p.in[i_]; p.out = ka->p.out; p.ws = ka->p.ws;
#else
#define LOAD_PTRS (void)ka0; const Ptrs p = a.p;
#endif
#define PHASE_ARGS LOAD_PTRS int tid = threadIdx.x; asm volatile("" : "+v"(tid)); \
    const int lane = tid & 63, wave = __builtin_amdgcn_readfirstlane(tid >> 6); (void)lane; (void)wave; \
    const long gtid = (long)blockIdx.x * NTHREADS + tid, gthreads = (long)gridDim.x * NTHREADS; (void)gtid; (void)gthreads; \
    float* SS = wsf<C>(p, C::WS_SS); (void)SS; const float invd = 1.0f / C::D; (void)invd;
#define ITEMS(n, call) do { for (long it = gtid; it < (long)(n); it += gthreads) { call; } } while (0)
#define SSL(j) (SS + (size_t)(4 * l + (j)) * C::M)
#define GEMM_ALL(EPI, Aop, Bop, Mr, Nc, Kd, ...) do { pg8::Gemm g{Aop, Bop, Mr, Nc, Kd, Kd}; pg8::StaticOrder S; S.init(Mr, Nc, gridDim.x, blockIdx.x); \
        pg8::EPI E{__VA_ARGS__}; pg8::gemm_phase<pg8::EPI, pg8::StaticOrder, false>(lds, g, S, E, nullptr); } while (0)
#define GEMM_SPLIT(EPI, Aop, Bop, Kd, ...) do { \
        { pg8::Gemm g{Aop, Bop, C::M, C::D, Kd, Kd}; pg8::RoundOrder S; S.init(C::M, C::D, 256, blockIdx.x); S.round = 0; \
          pg8::EPI E{__VA_ARGS__}; pg8::gemm_phase<pg8::EPI, pg8::RoundOrder, false>(lds, g, S, E, nullptr); } \
        { const int t_ = blockIdx.x >> 3, sl_ = blockIdx.x & 7; pg8::Gemm g{(Aop) + sl_ * ((Kd) / 8), (Bop) + sl_ * ((Kd) / 8), C::M, C::D, (Kd) / 8, Kd}; \
          pg8::RoundOrder S; S.init(C::M, C::D, 256, t_); S.round = 1; pg8::EpiPartial E{wsf<C>(p, C::WS_PART) + (size_t)blockIdx.x * 65536}; \
          pg8::gemm_phase<pg8::EpiPartial, pg8::RoundOrder, false>(lds, g, S, E, nullptr); } } while (0)
#if ONE_LAUNCH
    if (threadIdx.x < 4) ((LAS unsigned*)(lds + LDS_CTL))[threadIdx.x] = 0u;
    __syncthreads();
    XcdBarrier bar = xcd_barrier_post((unsigned*)(a.p.ws + C::WS_CTL), (volatile LAS unsigned*)(lds + LDS_CTL));
#else
    XcdBarrier bar; bar.bar = nullptr; bar.x = 0; bar.st = nullptr;
#endif

    if (IN(0)) { PHASE_ARGS
        LAS float* scr = (LAS float*)(lds + wave * 16384);
        const int gw = blockIdx.x * NWAVES + wave, NGW = gridDim.x * NWAVES;
        for (int l = 0; l < C::DEPTH; ++l)
            for (int idx = 0; idx < 10; ++idx) { const WDesc d = wdesc(p, l, idx); const int nitems = (d.K / 64) * (d.N / 32);
                for (int it = gw; it < nitems; it += NGW) prep_item(d.W, d.K, d.Ncols, d.g, d.kind, d.N, d.dst, scr, it, lane); }
        rw::rows_init(p, tid);
        GRID_BAR(0);
    }
    for (int l = 0; l < C::DEPTH; ++l) {
        const int pb = 1 + PH_PER_LAYER * l;
        if (IN(pb + 0)) { PHASE_ARGS
            GEMM_ALL(EpiMemKV, wsb<C>(p, C::WS_MEMB), wlayer<C>(p, l, C::W_KV), C::MM, 2 * C::D, C::D, p.out + C::OUT_MK + (size_t)l * C::MM * C::D, p.out + C::OUT_MV + (size_t)l * C::MM * C::D, wsf<C>(p, C::WS_RSTDM), C::D);
            GRID_BAR(pb + 0); }
        if (IN(pb + 1)) { PHASE_ARGS
            GEMM_ALL(EpiSwiGLU, wsb<C>(p, C::WS_XB), wlayer<C>(p, l, C::W_1IN), C::M, 2 * C::FF, C::D, wsb<C>(p, C::WS_BIG), SSL(0), C::FF, invd);
            GRID_BAR(pb + 1); }
        if (IN(pb + 2)) { PHASE_ARGS
            GEMM_SPLIT(EpiResid, wsb<C>(p, C::WS_BIG), wlayer<C>(p, l, C::W_1OUT), C::FF, wsf<C>(p, C::WS_X), wsb<C>(p, C::WS_XB), SSL(1), 0.5f, C::D);
            GRID_BAR(pb + 2); }
        if (IN(pb + 3)) { PHASE_ARGS split_reduce<0>(p, tid, 0.5f, SSL(1), nullptr); GRID_BAR(pb + 3); }
        if (IN(pb + 4)) { PHASE_ARGS
            GEMM_ALL(EpiScaleF32, wsb<C>(p, C::WS_XB), wlayer<C>(p, l, C::W_IN), C::M, C::LDP, C::D, wsf<C>(p, C::WS_BIG), C::LDP, SSL(1), invd);
            GRID_BAR(pb + 4); }
        if (IN(pb + 5)) { PHASE_ARGS mx::ml_phase_a(lds, p, l, tid); gp::gmlp_phase(lds, p, l, tid); gp::pool_phase(lds, p, l, tid); GRID_BAR(pb + 5); }
        if (IN(pb + 6)) { PHASE_ARGS ITEMS((C::BATCH + C::DEC_BATCH) * C::MH, st_ml_b0<C>(p, l, (int)it)); rw::ml_scan(p, l, gtid, gthreads); GRID_BAR(pb + 6); }
        if (IN(pb + 7)) { PHASE_ARGS mx::ml_phase_c(lds, p, l, tid); GRID_BAR(pb + 7); }
        if (IN(pb + 8)) { PHASE_ARGS
            GEMM_SPLIT(EpiResid, wsb<C>(p, C::WS_MIX), wlayer<C>(p, l, C::W_OUT), C::D, wsf<C>(p, C::WS_X), wsb<C>(p, C::WS_XB), SSL(2), 1.0f, C::D);
            GRID_BAR(pb + 8); }
        if (IN(pb + 9)) { PHASE_ARGS split_reduce<0>(p, tid, 1.0f, SSL(2), nullptr); GRID_BAR(pb + 9); }
        if (IN(pb + 10)) { PHASE_ARGS
            GEMM_SPLIT(EpiScaleBf16, wsb<C>(p, C::WS_XB), wlayer<C>(p, l, C::W_Q), C::D, wsb<C>(p, C::WS_Q), C::D, SSL(2), invd);
            GRID_BAR(pb + 10); }
        if (IN(pb + 11)) { PHASE_ARGS split_reduce<1>(p, tid, 1.0f, nullptr, SSL(2)); GRID_BAR(pb + 11); }
        if (IN(pb + 12)) { PHASE_ARGS att::attn_phase(lds, p, l, tid); GRID_BAR(pb + 12); }
        if (IN(pb + 13)) { PHASE_ARGS
            GEMM_SPLIT(EpiResid, wsb<C>(p, C::WS_AO), wlayer<C>(p, l, C::W_O), C::D, wsf<C>(p, C::WS_X), wsb<C>(p, C::WS_XB), SSL(3), 1.0f, C::D);
            GRID_BAR(pb + 13); }
        if (IN(pb + 14)) { PHASE_ARGS split_reduce<0>(p, tid, 1.0f, SSL(3), nullptr); GRID_BAR(pb + 14); }
        if (IN(pb + 15)) { PHASE_ARGS
            GEMM_ALL(EpiSwiGLU, wsb<C>(p, C::WS_XB), wlayer<C>(p, l, C::W_2IN), C::M, 2 * C::FF, C::D, wsb<C>(p, C::WS_BIG), SSL(3), C::FF, invd);
            GRID_BAR(pb + 15); }
        if (IN(pb + 16)) { PHASE_ARGS
            GEMM_SPLIT(EpiResid, wsb<C>(p, C::WS_BIG), wlayer<C>(p, l, C::W_2OUT), C::FF, wsf<C>(p, C::WS_X), wsb<C>(p, C::WS_XB), SSL(4), 0.5f, C::D);
            GRID_BAR(pb + 16); }
        if (IN(pb + 17)) { PHASE_ARGS split_reduce<0>(p, tid, 0.5f, SSL(4), nullptr); GRID_BAR(pb + 17); }
    }
    if (IN(N_PHASES - 1)) { PHASE_ARGS rw::rows_final(p, tid); }
#undef IN
#undef BOTH
#undef GRID_BAR
#undef ITEMS
#undef PHASE_ARGS
#undef SSL
}

extern "C" void kernel_launch(void* const* d_in, const int* in_sizes, int n_in, void* d_out, int out_size, void* d_ws, size_t ws_size, hipStream_t stream) {
    static int ready = 0;
    if (!ready) {
        if (n_in != 33 || (long)out_size != (long)C::OUT_END || ws_size < (size_t)C::WS_END) { fprintf(stderr, "kernel_launch: unexpected shapes: n_in %d out %d ws %zu (need %zu)\n", n_in, out_size, ws_size, (size_t)C::WS_END); ready = -1; return; }
        if (hipFuncSetAttribute((const void*)fwd, hipFuncAttributeMaxDynamicSharedMemorySize, LDS_BYTES) != hipSuccess) { fprintf(stderr, "kernel_launch: hipFuncSetAttribute failed\n"); ready = -1; return; }
        int dev = 0, cus = 0, per_cu = 0;
        if (hipGetDevice(&dev) != hipSuccess || hipDeviceGetAttribute(&cus, hipDeviceAttributeMultiprocessorCount, dev) != hipSuccess) { fprintf(stderr, "kernel_launch: device query failed\n"); ready = -1; return; }
        if (hipOccupancyMaxActiveBlocksPerMultiprocessor(&per_cu, (const void*)fwd, NTHREADS, LDS_BYTES) != hipSuccess || per_cu < 1) { fprintf(stderr, "kernel_launch: occupancy query reports %d blocks per CU\n", per_cu); (void)hipGetLastError(); per_cu = 1; }
        if (cus != 256) { fprintf(stderr, "kernel_launch: built for a 256-CU device (one resident workgroup per CU), found %d\n", cus); ready = -1; return; }
        ready = cus;
    }
    if (ready < 0) return;
    Args a{};
    for (int i = 0; i < 33; ++i) a.p.in[i] = (const float*)d_in[i];
    a.p.out = (float*)d_out; a.p.ws = (unsigned char*)d_ws;
#if ONE_LAUNCH
    (void)hipMemsetAsync((char*)d_ws + C::WS_CTL, 0, 65536, stream);
    a.ph_lo = 0; a.ph_hi = N_PHASES;
    hipLaunchKernelGGL(fwd, dim3(ready), dim3(NTHREADS), LDS_BYTES, stream, a);
#else
    for (int k = 0; k < N_PHASES; ++k) { a.ph_lo = k; a.ph_hi = k + 1; hipLaunchKernelGGL(fwd, dim3(ready), dim3(NTHREADS), LDS_BYTES, stream, a); }
#endif
}
```

```cpp
#include <hip/hip_runtime.h>
#include <cstdio>
#define ONE_LAUNCH 1

#define HD __host__ __device__
#ifndef HD
#define HD __host__ __device__
#endif
typedef unsigned short bf16_t;
HD inline unsigned f2u(float f) { return __builtin_bit_cast(unsigned, f); }
HD inline float u2f(unsigned u) { return __builtin_bit_cast(float, u); }
HD inline bf16_t f2bf(float f) { unsigned u = f2u(f); u += 0x7FFFu + ((u >> 16) & 1u); return (bf16_t)(u >> 16); }
HD inline float bf2f(bf16_t b) { return u2f(((unsigned)b) << 16); }

struct RC {
    static constexpr int D = 2048, FF = 8192, BATCH = 4, SEQ = 2048, DEPTH = 2, DEC_BATCH = 32, DEC_SEQ = 32, PAST = 2048, NMEM = 256;
};
template <class B> struct CfgT : B {
    using B::D; using B::FF; using B::BATCH; using B::SEQ; using B::DEPTH; using B::DEC_BATCH; using B::DEC_SEQ; using B::PAST; using B::NMEM;
    static constexpr int MP = BATCH * SEQ, MS = DEC_BATCH * DEC_SEQ, M = MP + MS, MM = BATCH * NMEM;
    static constexpr int PW = D / 4, PG = 4, PGD = PW / 4, PH = 15;
    static constexpr int GW = D / 4, GH = 4, GHD = GW / 4, GCH = 128;
    static constexpr int MW = D - PW - GW, MH = 8, MHD = MW / 8, CH = 64;
    static constexpr int INC = PW + 2 * GW + 4 * MW + 2 * MH;
    static constexpr int LDP = ((INC + 255) / 256) * 256;
    static constexpr int AH = 4, AHD = D / 4;
    static constexpr int O_U = PW, O_V = PW + GW, O_Q = PW + 2 * GW, O_K = O_Q + MW, O_VM = O_K + MW, O_O = O_VM + MW, O_IG = O_O + MW, O_FG = O_IG + MH;
    static constexpr int NC = SEQ / CH, NPC = BATCH * MH * NC, NSC = DEC_BATCH * MH, NCH = NPC + NSC;
    static constexpr int LCS = DEC_SEQ < CH ? DEC_SEQ : CH;
    static constexpr int GLP = SEQ < GCH ? SEQ : GCH, GLS = DEC_SEQ < GCH ? DEC_SEQ : GCH;
    static constexpr int NSS = 1 + 4 * DEPTH;
    static constexpr long OUT_YP = 0, OUT_YS = OUT_YP + (long)MP * D, OUT_POOLP = OUT_YS + (long)MS * D, OUT_POOLS = OUT_POOLP + (long)DEPTH * BATCH * PH * PW,
        OUT_CP = OUT_POOLS + (long)DEPTH * DEC_BATCH * PH * PW, OUT_NP = OUT_CP + (long)DEPTH * BATCH * MH * MHD * MHD, OUT_MP = OUT_NP + (long)DEPTH * BATCH * MH * MHD,
        OUT_CS = OUT_MP + (long)DEPTH * BATCH * MH, OUT_NS = OUT_CS + (long)DEPTH * DEC_BATCH * MH * MHD * MHD, OUT_MS = OUT_NS + (long)DEPTH * DEC_BATCH * MH * MHD,
        OUT_VS = OUT_MS + (long)DEPTH * DEC_BATCH * MH, OUT_MK = OUT_VS + (long)DEPTH * DEC_BATCH * DEC_SEQ * GW, OUT_MV = OUT_MK + (long)DEPTH * BATCH * NMEM * D,
        OUT_END = OUT_MV + (long)DEPTH * BATCH * NMEM * D;
    static constexpr size_t al(size_t x) { return (x + 255) & ~(size_t)255; }
    static constexpr size_t WS_CTL = 0, WS_SS = 65536, WS_X = al(WS_SS + (size_t)NSS * M * 4), WS_XB = al(WS_X + (size_t)M * D * 4),
        WS_BIG = al(WS_XB + (size_t)M * D * 2),
        WS_BIG_SZ = ((size_t)M * FF * 2 > (size_t)M * LDP * 4) ? (size_t)M * FF * 2 : (size_t)M * LDP * 4,
        WS_MIX = al(WS_BIG + WS_BIG_SZ), WS_Q = al(WS_MIX + (size_t)M * D * 2), WS_AO = al(WS_Q + (size_t)M * D * 2),
        WS_MEMB = al(WS_AO + (size_t)M * D * 2), WS_RSTDM = al(WS_MEMB + (size_t)MM * D * 2),
        WS_GB = al(WS_RSTDM + (size_t)MM * 4), WS_GA = al(WS_GB + (size_t)M * MH * 4),
        WS_CBL = al(WS_GA + (size_t)M * MH * 4), WS_CML = al(WS_CBL + (size_t)NCH * 4), WS_MPREV = al(WS_CML + (size_t)NCH * 4),
        WS_DC = al(WS_MPREV + (size_t)NCH * 4), WS_DN = al(WS_DC + (size_t)NCH * MHD * MHD * 4),
        WS_PART = al(WS_DN + (size_t)NCH * MHD * 4),
        WS_W = al(WS_PART + (size_t)256 * 65536 * 4);
    static constexpr size_t W_1IN = 0, W_1OUT = W_1IN + (size_t)2 * FF * D, W_IN = W_1OUT + (size_t)D * FF, W_OUT = W_IN + (size_t)LDP * D, W_Q = W_OUT + (size_t)D * D,
        W_KV = W_Q + (size_t)D * D, W_O = W_KV + (size_t)2 * D * D, W_2IN = W_O + (size_t)D * D, W_2OUT = W_2IN + (size_t)2 * FF * D, W_LAYER = W_2OUT + (size_t)D * FF;
    static constexpr size_t WS_END = al(WS_W + (size_t)DEPTH * W_LAYER * 2);
};

struct Ptrs { const float* in[33]; float* out; unsigned char* ws; };
enum { I_XP = 0, I_XS, I_MEM, I_SPOOL, I_SC, I_SN, I_SM, I_CK, I_CV, I_GFFN1, I_W1IN, I_W1OUT, I_GMIX, I_WIN, I_POOLW, I_POOLS, I_GVG, I_GWS, I_GBS, I_IB, I_FB, I_NG, I_WOUT,
       I_GX, I_GMEM, I_WQ, I_WK, I_WV, I_WO, I_GFFN2, I_W2IN, I_W2OUT, I_GFIN };

template <class C> HD inline float* wsf(const Ptrs& p, size_t off) { return (float*)(p.ws + off); }
template <class C> HD inline bf16_t* wsb(const Ptrs& p, size_t off) { return (bf16_t*)(p.ws + off); }
template <class C> HD inline bf16_t* wlayer(const Ptrs& p, int l, size_t off) { return (bf16_t*)(p.ws + C::WS_W) + (size_t)l * C::W_LAYER + off; }

template <class C> HD inline void row_info(int r, bool& s, int& b, int& t) {
    if (r < C::MP) { s = false; b = r / C::SEQ; t = r % C::SEQ; } else { s = true; const int q = r - C::MP; b = q / C::DEC_SEQ; t = q % C::DEC_SEQ; }
}
template <class C> HD inline void chunk_info(int r, int h, int& ci, int& i, int& lc) {
    bool s; int b, t; row_info<C>(r, s, b, t);
    if (!s) { ci = (b * C::MH + h) * C::NC + t / C::CH; i = t % C::CH; lc = C::CH; } else { ci = C::NPC + b * C::MH + h; i = t; lc = C::LCS; }
}
HD inline float sigmoidf_(float x) { return 1.0f / (1.0f + expf(-x)); }
HD inline float logsigmoidf_(float x) { return x >= 0.f ? -log1pf(expf(-x)) : x - log1pf(expf(x)); }

enum { WK_PLAIN = 0, WK_FFNIN = 1, WK_WIN = 2 };
template <class C> HD inline int wsrc_col(int kind, int n) {
    if (kind == WK_FFNIN) { const int pn = n >> 8, j = n & 255; return j < 128 ? 128 * pn + j : C::FF + 128 * pn + (j - 128); }
    if (kind == WK_WIN) return n < C::INC ? n : -1;
    return n;
}

template <class C> HD inline void st_ml_b0(const Ptrs& p, int l, int sq) {
    const float* CBL = wsf<C>(p, C::WS_CBL); const float* CML = wsf<C>(p, C::WS_CML); float* MPREV = wsf<C>(p, C::WS_MPREV);
    if (sq < C::BATCH * C::MH) { float m = 0.f;
        for (int c = 0; c < C::NC; ++c) { const int ci = sq * C::NC + c; MPREV[ci] = m; const float a = CBL[ci] + m, b2 = CML[ci]; m = a > b2 ? a : b2; }
        p.out[C::OUT_MP + (size_t)l * C::BATCH * C::MH + sq] = m;
    } else { const int q = sq - C::BATCH * C::MH, ci = C::NPC + q; const float m0 = p.in[I_SM][(size_t)l * C::DEC_BATCH * C::MH + q];
        MPREV[ci] = m0; const float a = CBL[ci] + m0, b2 = CML[ci]; p.out[C::OUT_MS + (size_t)l * C::DEC_BATCH * C::MH + q] = a > b2 ? a : b2; }
}

namespace pg8 {
#define PG8_LAS __attribute__((address_space(3)))
typedef unsigned short bf16_t;
typedef short bf16x8 __attribute__((ext_vector_type(8)));
typedef float f32x4 __attribute__((ext_vector_type(4)));
typedef unsigned u32x4 __attribute__((ext_vector_type(4)));
constexpr int BM = 256, BK = 64, HALF = 128, HTB = HALF * BK * 2  , STAGE_BYTES = 8 * HTB, NXCD = 8, WGM = 8;

__host__ __device__ __forceinline__ int lds_byte(int r, int c) { const int st = (r >> 4) * 2 + (c >> 5), rr = r & 15, cc = c & 31, ob = rr * 64 + cc * 2; return st * 1024 + (ob ^ (((ob >> 9) & 1) << 5)); }
__host__ __device__ __forceinline__ void stage_rc(int b, int& R, int& C) { const int st = b / 1024, sb = b % 1024, swz = sb ^ (((sb >> 9) & 1) << 5); R = (st >> 1) * 16 + swz / 64; C = (st & 1) * 32 + (swz % 64) / 2; }
__host__ __device__ __forceinline__ int perm32(int rho) { const int n = rho >> 4, i = rho & 15; return 8 * (i >> 2) + 4 * n + (i & 3); }

struct Unit { int pm, pn; };
struct Gemm { const bf16_t* A; const bf16_t* Bt; int M, N, K, ld; };

struct StaticOrder {
    int nM, nN, nwg, G, c;
    __host__ __device__ void init(int M, int N, int G_, int c_) { nM = M / BM; nN = N / BM; nwg = nM * nN; G = G_; c = c_; }
    __host__ __device__ bool next(int i, Unit& u) const {
        const long L = (long)i * G + c; if (L >= nwg) return false;
        int wgid = (int)L; { const int q = nwg / NXCD, r = nwg % NXCD, xcd = wgid % NXCD, off = wgid / NXCD; wgid = (xcd < r ? xcd * (q + 1) : r * (q + 1) + (xcd - r) * q) + off; }
        const int nig = WGM * nN, gid = wgid / nig, fm = gid * WGM, gsz = (nM - fm) < WGM ? (nM - fm) : WGM;
        u.pm = fm + ((wgid % nig) % gsz); u.pn = (wgid % nig) / gsz; return true;
    }
    __device__ __forceinline__ void a_ready(const Unit&) const {}
    __device__ __forceinline__ void done(const Unit&) const {}
};
__device__ __forceinline__ unsigned cvt_pk_bf16(float lo, float hi) { unsigned r; asm volatile("v_cvt_pk_bf16_f32 %0, %1, %2" : "=v"(r) : "v"(lo), "v"(hi)); return r; }
typedef float f32x2 __attribute__((ext_vector_type(2)));
template <class Epi, class Sched, bool STAMP = false>
__device__ __forceinline__ void gemm_phase(PG8_LAS unsigned char* lds, const Gemm g, const Sched& S, const Epi& E, unsigned long long* stamps) {
    int tid_l = threadIdx.x; asm volatile("" : "+v"(tid_l));
    const int tid = tid_l, wid = __builtin_amdgcn_readfirstlane(tid >> 6), lane = tid & 63, wr = wid >> 2, wc = wid & 3, fr = lane & 15, fq = lane >> 4;
    const int K = g.K, nt = K / BK;
    int ts_lo = 0, ts_hi = 0, nts = 0; const unsigned long long rt_entry = STAMP ? (unsigned long long)wall_clock64() : 0ull;
#define PG8_STAMP() do { if (STAMP && wid == 0 && nts < 64) { const unsigned long long _c = (unsigned long long)clock64(); \
        ts_lo = (lane == nts) ? (int)(unsigned)_c : ts_lo; ts_hi = (lane == nts) ? (int)(unsigned)(_c >> 32) : ts_hi; ++nts; } } while (0)
    PG8_STAMP();
    unsigned voffA[2], voffB[2];
#pragma unroll
    for (int i = 0; i < 2; ++i) { int R, C; stage_rc(tid * 16 + i * 8192, R, C); const int Rb = Epi::PERM ? ((R & ~31) + perm32(R & 31)) : R;
        voffA[i] = (unsigned)(R * g.ld + C) * 2u; voffB[i] = (unsigned)(Rb * g.ld + C) * 2u; }
    const size_t kstep = (size_t)(BK * 2);
    const size_t hstep = (size_t)HALF * g.ld * 2;
    const size_t tstep = 2 * hstep;
    const unsigned ldsw = (unsigned)wid * 1024u;
    const int aoff = lds_byte(wr * 64 + fr, fq * 8), boff = lds_byte(wc * 32 + fr, fq * 8);
#define PG8_SA(b, h) (((b) * 2 + (h)) * HTB)
#define PG8_SB(b, h) ((4 + (b) * 2 + (h)) * HTB)
#define PG8_STAGE(bufoff, gbase, voff) do { _Pragma("unroll") for (int _i = 0; _i < 2; ++_i) \
        __builtin_amdgcn_global_load_lds((const unsigned*)((const char*)(gbase) + (voff)[_i]), (PG8_LAS unsigned*)(lds + (bufoff) + ldsw + _i * 8192), 16, 0, 0); } while (0)
#define PG8_LDA(dst, b, h) do { _Pragma("unroll") for (int m = 0; m < 4; ++m) _Pragma("unroll") for (int k = 0; k < 2; ++k) dst[m][k] = *(const PG8_LAS bf16x8*)(lds + PG8_SA(b, h) + aoff + m * 2048 + k * 1024); } while (0)
#define PG8_LDB(dst, b, h) do { _Pragma("unroll") for (int n = 0; n < 2; ++n) _Pragma("unroll") for (int k = 0; k < 2; ++k) dst[n][k] = *(const PG8_LAS bf16x8*)(lds + PG8_SB(b, h) + boff + n * 2048 + k * 1024); } while (0)
#define PG8_MMA(ai, bj, At, Bt) do { __builtin_amdgcn_s_setprio(1); _Pragma("unroll") for (int m = 0; m < 4; ++m) _Pragma("unroll") for (int n = 0; n < 2; ++n) _Pragma("unroll") for (int k = 0; k < 2; ++k) \
        acc[ai][bj][m][n] = __builtin_amdgcn_mfma_f32_16x16x32_bf16(Bt[n][k], At[m][k], acc[ai][bj][m][n], 0, 0, 0); __builtin_amdgcn_s_setprio(0); } while (0)
#define PG8_WAIT_V(n) asm volatile("s_waitcnt vmcnt(" #n ")" ::: "memory")
#define PG8_WAIT_L(n) asm volatile("s_waitcnt lgkmcnt(" #n ")" ::: "memory")
#define PG8_BAR __builtin_amdgcn_s_barrier()
#define PG8_SCHED __builtin_amdgcn_sched_barrier(0)
    Unit cur, nxt; int ui = 0;
    if (!S.next(0, cur)) return;
    f32x4 acc[2][2][4][2];
#pragma unroll
    for (int a = 0; a < 2; ++a)
#pragma unroll
        for (int b = 0; b < 2; ++b)
#pragma unroll
            for (int m = 0; m < 4; ++m)
#pragma unroll
                for (int n = 0; n < 2; ++n) acc[a][b][m][n] = (f32x4){0.f, 0.f, 0.f, 0.f};
    bf16x8 At[4][2], B0[2][2], B1[2][2];
    const char* cA = (const char*)g.A + (size_t)cur.pm * tstep; const char* cB = (const char*)g.Bt + (size_t)cur.pn * tstep;
    S.a_ready(cur);
    PG8_STAGE(PG8_SB(0, 0), cB, voffB); PG8_STAGE(PG8_SA(0, 0), cA, voffA); PG8_STAGE(PG8_SB(0, 1), cB + hstep, voffB); PG8_STAGE(PG8_SA(0, 1), cA + hstep, voffA);
    if (wr == 1) PG8_BAR;
    PG8_WAIT_V(4); PG8_BAR;
    PG8_STAGE(PG8_SB(1, 0), cB + kstep, voffB); PG8_STAGE(PG8_SA(1, 0), cA + kstep, voffA); PG8_STAGE(PG8_SB(1, 1), cB + hstep + kstep, voffB);
    PG8_WAIT_V(6); PG8_BAR;
    PG8_STAMP();
    for (;;) {
        const bool has_next = S.next(ui + 1, nxt);
        const char* nA = has_next ? (const char*)g.A + (size_t)nxt.pm * tstep : cA; const char* nB = has_next ? (const char*)g.Bt + (size_t)nxt.pn * tstep : cB;
        for (int t = 0; t < nt; t += 2) {
            const bool last = (t == nt - 2);
            const char* a1 = cA + (size_t)(t + 1) * kstep;
            const char* a2 = last ? nA : cA + (size_t)(t + 2) * kstep; const char* b2 = last ? nB : cB + (size_t)(t + 2) * kstep;
            const char* a3 = a2 + kstep; const char* b3 = b2 + kstep;
            if (last && has_next) S.a_ready(nxt);
            PG8_LDB(B0, 0, 0); PG8_SCHED; PG8_LDA(At, 0, 0); PG8_STAGE(PG8_SA(1, 1), a1 + hstep, voffA);
            PG8_WAIT_L(8); PG8_BAR; PG8_WAIT_L(0); PG8_MMA(0, 0, At, B0); PG8_BAR; PG8_SCHED;
            PG8_LDB(B1, 0, 1); PG8_STAGE(PG8_SB(0, 0), b2, voffB);
            PG8_BAR; PG8_WAIT_L(0); PG8_MMA(0, 1, At, B1); PG8_BAR;
            PG8_LDA(At, 0, 1); PG8_STAGE(PG8_SA(0, 0), a2, voffA);
            PG8_BAR; PG8_WAIT_L(0); PG8_MMA(1, 0, At, B0); PG8_BAR; PG8_SCHED;
            PG8_STAGE(PG8_SB(0, 1), b2 + hstep, voffB);
            PG8_WAIT_V(6); PG8_BAR; PG8_MMA(1, 1, At, B1); PG8_BAR;
            PG8_LDB(B0, 1, 0); PG8_SCHED; PG8_LDA(At, 1, 0); PG8_STAGE(PG8_SA(0, 1), a2 + hstep, voffA);
            PG8_WAIT_L(8); PG8_BAR; PG8_WAIT_L(0); PG8_MMA(0, 0, At, B0); PG8_BAR; PG8_SCHED;
            PG8_LDB(B1, 1, 1); PG8_STAGE(PG8_SB(1, 0), b3, voffB);
            PG8_BAR; PG8_WAIT_L(0); PG8_MMA(0, 1, At, B1); PG8_BAR;
            PG8_LDA(At, 1, 1); PG8_STAGE(PG8_SA(1, 0), a3, voffA);
            PG8_BAR; PG8_WAIT_L(0); PG8_MMA(1, 0, At, B0); PG8_BAR; PG8_SCHED;
            PG8_STAGE(PG8_SB(1, 1), b3 + hstep, voffB);
            PG8_WAIT_V(6); PG8_BAR; PG8_MMA(1, 1, At, B1); PG8_BAR;
        }
        PG8_STAMP();
        if constexpr (!Epi::AFTER_DRAIN) { E(acc, cur, wr, wc, fr, fq); S.done(cur); }
        PG8_STAMP();
        if (!has_next) break;
#pragma unroll
        for (int a = 0; a < 2; ++a)
#pragma unroll
            for (int b = 0; b < 2; ++b)
#pragma unroll
                for (int m = 0; m < 4; ++m)
#pragma unroll
                    for (int n = 0; n < 2; ++n) acc[a][b][m][n] = (f32x4){0.f, 0.f, 0.f, 0.f};
        cur = nxt; cA = nA; cB = nB; ++ui;
    }
    PG8_WAIT_V(0);
    if (wr == 0) PG8_BAR;
    PG8_BAR;
    if constexpr (Epi::AFTER_DRAIN) { E.fused(acc, cur, wr, wc, fr, fq, lds, wid, lane); S.done(cur); }
    PG8_STAMP();
    if (STAMP && wid == 0) { stamps[lane] = lane < nts ? (((unsigned long long)(unsigned)ts_hi << 32) | (unsigned)ts_lo) : 0ull;
        if (lane == 62) stamps[62] = rt_entry; if (lane == 63) stamps[63] = (unsigned long long)wall_clock64(); }
#undef PG8_STAMP
#undef PG8_SA
#undef PG8_SB
#undef PG8_STAGE
#undef PG8_LDA
#undef PG8_LDB
#undef PG8_MMA
#undef PG8_WAIT_V
#undef PG8_WAIT_L
#undef PG8_BAR
#undef PG8_SCHED
}
}


#define LAS __attribute__((address_space(3)))
#define XB_TMO      128
#define XB_XCNT(j)  (256  + 64 * (j))
#define XB_XSUB(j)  (1280 + 64 * (j))
#define XB_XGEN(j)  (2304 + 64 * (j))
#define XB_TOP      3328
#define XB_TOPGEN   3392
#define XCD_BAR_WORDS 3456
#define XB_SPIN_CAP (1u << 18)

__device__ __forceinline__ unsigned xb_ld(unsigned* p)              { return __hip_atomic_load(p, __ATOMIC_RELAXED, __HIP_MEMORY_SCOPE_AGENT); }
__device__ __forceinline__ unsigned xb_add(unsigned* p, unsigned v) { return __hip_atomic_fetch_add(p, v, __ATOMIC_RELAXED, __HIP_MEMORY_SCOPE_AGENT); }
__device__ __forceinline__ unsigned xb_xcc_id() { return (unsigned)__builtin_amdgcn_s_getreg((3 << 11) | 20) & 0xFu; }
#define XB_SPIN(cond, bar) do { unsigned _sp = 0; while (cond) { __builtin_amdgcn_s_sleep(1); \
    if ((++_sp & 255u) == 0u) { if (xb_ld(&(bar)[XB_TMO])) break; if (_sp > XB_SPIN_CAP) { atomicAdd(&(bar)[XB_TMO], 1u); break; } } } } while (0)

struct XcdBarrier {
    unsigned* bar; unsigned x;
    volatile LAS unsigned* st;
};

__device__ __forceinline__ XcdBarrier xcd_barrier_post(unsigned* bar, volatile LAS unsigned* st) {
    XcdBarrier b; b.bar = bar; b.x = xb_xcc_id(); b.st = st;
    if (threadIdx.x == 0) (void)xb_add(&bar[XB_XCNT(b.x)], 1u);
    return b;
}
__device__ __forceinline__ void xcd_barrier_complete(unsigned* bar, unsigned x, unsigned& nloc, unsigned& nx) {
    const unsigned G = gridDim.x * gridDim.y * gridDim.z;
    unsigned sum, cnt, mine, sp = 0u;
    for (;;) {
        sum = 0u; cnt = 0u; mine = 0u;
#pragma unroll
        for (unsigned j = 0; j < 16; ++j) { const unsigned c = xb_ld(&bar[XB_XCNT(j)]); sum += c; cnt += (c > 0u) ? 1u : 0u; mine = (j == x) ? c : mine; }
        if (sum == G) break;
        __builtin_amdgcn_s_sleep(1);
        if ((++sp & 255u) == 0u) { if (xb_ld(&bar[XB_TMO])) break; if (sp > XB_SPIN_CAP) { atomicAdd(&bar[XB_TMO], 1u); break; } }
    }
    nloc = mine > 0u ? mine : 1u; nx = cnt > 0u ? cnt : 1u;
}

__device__ __forceinline__ void xcd_barrier(const XcdBarrier& b) {
    asm volatile("s_waitcnt vmcnt(0)" ::: "memory");
    __syncthreads();
    if (threadIdx.x == 0) {
        unsigned* bar = b.bar;
        __builtin_amdgcn_s_waitcnt(0);
        unsigned nloc = b.st[0], nx = b.st[1];
        if (nloc == 0u) { xcd_barrier_complete(bar, b.x, nloc, nx); b.st[0] = nloc; b.st[1] = nx; }
        const unsigned old = xb_add(&bar[XB_XSUB(b.x)], 1u);
        const unsigned gen = old / nloc;
        if (old + 1u == (gen + 1u) * nloc) {
            __builtin_amdgcn_fence(__ATOMIC_RELEASE, "agent");
            asm volatile("s_waitcnt vmcnt(0)" ::: "memory");
            const unsigned og = xb_add(&bar[XB_TOP], 1u);
            const unsigned tg = og / nx;
            if (og + 1u == (tg + 1u) * nx) xb_add(&bar[XB_TOPGEN], 1u);
            else XB_SPIN(xb_ld(&bar[XB_TOPGEN]) == tg, bar);
            __builtin_amdgcn_fence(__ATOMIC_ACQUIRE, "agent");
            xb_add(&bar[XB_XGEN(b.x)], 1u);
            asm volatile("s_waitcnt vmcnt(0)" ::: "memory");
        } else {
            XB_SPIN(xb_ld(&bar[XB_XGEN(b.x)]) == gen, bar);
            __builtin_amdgcn_fence(__ATOMIC_ACQUIRE, "agent");
            asm volatile("s_waitcnt vmcnt(0)" ::: "memory");
        }
    }
    __syncthreads();
}

typedef CfgT<RC> C;
constexpr int NTHREADS = 512, NWAVES = 8;
constexpr int LDS_STAGE = 131072, LDS_CTL = LDS_STAGE, LDS_BYTES = LDS_STAGE + 256;

namespace pg8 {
typedef unsigned u32x2 __attribute__((ext_vector_type(2)));
__device__ __forceinline__ float silu_f(float g) { return g * __builtin_amdgcn_rcpf(1.0f + __expf(-g)); }
struct EpiSwiGLU { static constexpr bool PERM = true, AFTER_DRAIN = false;
    bf16_t* act; const float* ss; int ff; float invd;
    __device__ __forceinline__ void operator()(const f32x4 (&acc)[2][2][4][2], const Unit& u, int wr, int wc, int fr, int fq) const {
        const int row0 = u.pm * BM + wr * 64 + fr, col = u.pn * 128 + wc * 32 + 8 * fq;
#pragma unroll
        for (int ai = 0; ai < 2; ++ai)
#pragma unroll
            for (int m = 0; m < 4; ++m) { const int row = row0 + ai * HALF + m * 16; const float rs = rsqrtf(ss[row] * invd + 1e-6f);
                f32x4 v[2];
#pragma unroll
                for (int n = 0; n < 2; ++n) { const f32x4 g = acc[ai][0][m][n] * rs, up = acc[ai][1][m][n] * rs;
#pragma unroll
                    for (int j = 0; j < 4; ++j) v[n][j] = silu_f(g[j]) * up[j]; }
                u32x4 w; w.x = cvt_pk_bf16(v[0][0], v[0][1]); w.y = cvt_pk_bf16(v[0][2], v[0][3]); w.z = cvt_pk_bf16(v[1][0], v[1][1]); w.w = cvt_pk_bf16(v[1][2], v[1][3]);
                *(u32x4*)(act + (size_t)row * ff + col) = w; }
    }
};
struct EpiResid { static constexpr bool PERM = false, AFTER_DRAIN = false;
    float* X; bf16_t* XB; float* ssout; float scale; int ld;
    __device__ __forceinline__ void operator()(const f32x4 (&acc)[2][2][4][2], const Unit& u, int wr, int wc, int fr, int fq) const {
        const int row0 = u.pm * BM + wr * 64 + fr, col0 = u.pn * BM + wc * 32 + 4 * fq;
#pragma unroll
        for (int ai = 0; ai < 2; ++ai)
#pragma unroll
            for (int m = 0; m < 4; ++m) { const int row = row0 + ai * HALF + m * 16; float* xr = X + (size_t)row * ld + col0; bf16_t* br = XB + (size_t)row * ld + col0; float s = 0.f;
#pragma unroll
                for (int bj = 0; bj < 2; ++bj)
#pragma unroll
                    for (int n = 0; n < 2; ++n) { f32x4 x = *(const f32x4*)(xr + bj * HALF + n * 16) + acc[ai][bj][m][n] * scale; *(f32x4*)(xr + bj * HALF + n * 16) = x;
                        u32x2 w; w.x = cvt_pk_bf16(x[0], x[1]); w.y = cvt_pk_bf16(x[2], x[3]); *(u32x2*)(br + bj * HALF + n * 16) = w;
                        s += (x[0] * x[0] + x[1] * x[1]) + (x[2] * x[2] + x[3] * x[3]); }
                s += __shfl_xor(s, 16); s += __shfl_xor(s, 32);
                if (fq == 0) unsafeAtomicAdd(ssout + row, s); }
    }
};
struct EpiScaleF32 { static constexpr bool PERM = false, AFTER_DRAIN = false;
    float* Cp; int ldc; const float* ss; float invd;
    __device__ __forceinline__ void operator()(const f32x4 (&acc)[2][2][4][2], const Unit& u, int wr, int wc, int fr, int fq) const {
        const int row0 = u.pm * BM + wr * 64 + fr, col0 = u.pn * BM + wc * 32 + 4 * fq;
#pragma unroll
        for (int ai = 0; ai < 2; ++ai)
#pragma unroll
            for (int m = 0; m < 4; ++m) { const int row = row0 + ai * HALF + m * 16; const float rs = rsqrtf(ss[row] * invd + 1e-6f); float* cr = Cp + (size_t)row * ldc + col0;
#pragma unroll
                for (int bj = 0; bj < 2; ++bj)
#pragma unroll
                    for (int n = 0; n < 2; ++n) *(f32x4*)(cr + bj * HALF + n * 16) = acc[ai][bj][m][n] * rs; }
    }
};
struct EpiScaleBf16 { static constexpr bool PERM = true, AFTER_DRAIN = false;
    bf16_t* O; int ldc; const float* ss; float invd;
    __device__ __forceinline__ void operator()(const f32x4 (&acc)[2][2][4][2], const Unit& u, int wr, int wc, int fr, int fq) const {
        const int row0 = u.pm * BM + wr * 64 + fr, col0 = u.pn * BM + wc * 32 + 8 * fq;
#pragma unroll
        for (int ai = 0; ai < 2; ++ai)
#pragma unroll
            for (int m = 0; m < 4; ++m) { const int row = row0 + ai * HALF + m * 16; const float rs = rsqrtf(ss[row] * invd + 1e-6f); bf16_t* orow = O + (size_t)row * ldc + col0;
#pragma unroll
                for (int bj = 0; bj < 2; ++bj) { const f32x4 v0 = acc[ai][bj][m][0] * rs, v1 = acc[ai][bj][m][1] * rs;
                    u32x4 w; w.x = cvt_pk_bf16(v0[0], v0[1]); w.y = cvt_pk_bf16(v0[2], v0[3]); w.z = cvt_pk_bf16(v1[0], v1[1]); w.w = cvt_pk_bf16(v1[2], v1[3]);
                    *(u32x4*)(orow + bj * HALF) = w; } }
    }
};
struct EpiMemKV { static constexpr bool PERM = false, AFTER_DRAIN = false;
    float* K; float* V; const float* rstd; int d;
    __device__ __forceinline__ void operator()(const f32x4 (&acc)[2][2][4][2], const Unit& u, int wr, int wc, int fr, int fq) const {
        const int row0 = u.pm * BM + wr * 64 + fr; int ct = u.pn * BM; float* base = K; if (ct >= d) { base = V; ct -= d; }
        const int col0 = ct + wc * 32 + 4 * fq;
#pragma unroll
        for (int ai = 0; ai < 2; ++ai)
#pragma unroll
            for (int m = 0; m < 4; ++m) { const int row = row0 + ai * HALF + m * 16; const float rs = rstd[row]; float* cr = base + (size_t)row * d + col0;
#pragma unroll
                for (int bj = 0; bj < 2; ++bj)
#pragma unroll
                    for (int n = 0; n < 2; ++n) *(f32x4*)(cr + bj * HALF + n * 16) = acc[ai][bj][m][n] * rs; }
    }
};
struct RoundOrder : StaticOrder { int round;
    __device__ bool next(int i, Unit& u) const { if (i != 0) return false; return StaticOrder::next(round, u); } };
struct EpiPartial { static constexpr bool PERM = false, AFTER_DRAIN = false;
    float* part;
    __device__ __forceinline__ void operator()(const f32x4 (&acc)[2][2][4][2], const Unit& u, int wr, int wc, int fr, int fq) const {
        const int row0 = wr * 64 + fr, col0 = wc * 32 + 4 * fq;
#pragma unroll
        for (int ai = 0; ai < 2; ++ai)
#pragma unroll
            for (int m = 0; m < 4; ++m) { float* cr = part + (size_t)(row0 + ai * HALF + m * 16) * BM + col0;
#pragma unroll
                for (int bj = 0; bj < 2; ++bj)
#pragma unroll
                    for (int n = 0; n < 2; ++n) *(f32x4*)(cr + bj * HALF + n * 16) = acc[ai][bj][m][n]; }
    }
};
}

__device__ __forceinline__ void prep_item(const float* W, int K, int Ncols, const float* g, int kind, int N, bf16_t* Bt, int item, int lane) {
    const int nblk = N / 64, kb = item / nblk, nb = item % nblk, k0 = 64 * kb, n = 64 * nb + lane;
    const int sc = wsrc_col<C>(kind, n);
    const float* src = W + (size_t)k0 * Ncols + (sc >= 0 ? sc : 0);
    float v[64];
#pragma unroll
    for (int kk = 0; kk < 64; ++kk) v[kk] = src[(size_t)kk * Ncols];
    if (g) {
#pragma unroll
        for (int kk = 0; kk < 64; ++kk) v[kk] *= g[k0 + kk];
    }
    if (sc < 0) {
#pragma unroll
        for (int kk = 0; kk < 64; ++kk) v[kk] = 0.f;
    }
    bf16_t* dst = Bt + (size_t)n * K + k0;
#pragma unroll
    for (int j = 0; j < 8; ++j) { pg8::u32x4 o; o.x = pg8::cvt_pk_bf16(v[8 * j], v[8 * j + 1]); o.y = pg8::cvt_pk_bf16(v[8 * j + 2], v[8 * j + 3]); o.z = pg8::cvt_pk_bf16(v[8 * j + 4], v[8 * j + 5]); o.w = pg8::cvt_pk_bf16(v[8 * j + 6], v[8 * j + 7]);
        *(pg8::u32x4*)(dst + 8 * j) = o; }
}
struct WDesc { const float* W; const float* g; bf16_t* dst; int K, Ncols, kind, N; };
__device__ __forceinline__ WDesc wdesc(const Ptrs& p, int l, int idx) {
    WDesc d; d.g = nullptr; d.kind = WK_PLAIN;
    switch (idx) {
    case 0: d.W = p.in[I_W1IN] + (size_t)l * C::D * 2 * C::FF; d.K = C::D; d.Ncols = 2 * C::FF; d.N = 2 * C::FF; d.g = p.in[I_GFFN1] + l * C::D; d.kind = WK_FFNIN; d.dst = wlayer<C>(p, l, C::W_1IN); break;
    case 1: d.W = p.in[I_W1OUT] + (size_t)l * C::FF * C::D; d.K = C::FF; d.Ncols = C::D; d.N = C::D; d.dst = wlayer<C>(p, l, C::W_1OUT); break;
    case 2: d.W = p.in[I_WIN] + (size_t)l * C::D * C::INC; d.K = C::D; d.Ncols = C::INC; d.N = C::LDP; d.g = p.in[I_GMIX] + l * C::D; d.kind = WK_WIN; d.dst = wlayer<C>(p, l, C::W_IN); break;
    case 3: d.W = p.in[I_WOUT] + (size_t)l * C::D * C::D; d.K = C::D; d.Ncols = C::D; d.N = C::D; d.dst = wlayer<C>(p, l, C::W_OUT); break;
    case 4: d.W = p.in[I_WQ] + (size_t)l * C::D * C::D; d.K = C::D; d.Ncols = C::D; d.N = C::D; d.g = p.in[I_GX] + l * C::D; d.dst = wlayer<C>(p, l, C::W_Q); break;
    case 5: d.W = p.in[I_WK] + (size_t)l * C::D * C::D; d.K = C::D; d.Ncols = C::D; d.N = C::D; d.g = p.in[I_GMEM] + l * C::D; d.dst = wlayer<C>(p, l, C::W_KV); break;
    case 6: d.W = p.in[I_WV] + (size_t)l * C::D * C::D; d.K = C::D; d.Ncols = C::D; d.N = C::D; d.g = p.in[I_GMEM] + l * C::D; d.dst = wlayer<C>(p, l, C::W_KV) + (size_t)C::D * C::D; break;
    case 7: d.W = p.in[I_WO] + (size_t)l * C::D * C::D; d.K = C::D; d.Ncols = C::D; d.N = C::D; d.dst = wlayer<C>(p, l, C::W_O); break;
    case 8: d.W = p.in[I_W2IN] + (size_t)l * C::D * 2 * C::FF; d.K = C::D; d.Ncols = 2 * C::FF; d.N = 2 * C::FF; d.g = p.in[I_GFFN2] + l * C::D; d.kind = WK_FFNIN; d.dst = wlayer<C>(p, l, C::W_2IN); break;
    default: d.W = p.in[I_W2OUT] + (size_t)l * C::FF * C::D; d.K = C::FF; d.Ncols = C::D; d.N = C::D; d.dst = wlayer<C>(p, l, C::W_2OUT); break;
    }
    return d;
}

namespace att {
typedef short bf16x8 __attribute__((ext_vector_type(8)));
typedef short s16x4 __attribute__((ext_vector_type(4)));
typedef float f32x4 __attribute__((ext_vector_type(4)));
typedef unsigned u32x2 __attribute__((ext_vector_type(2)));
constexpr int TOK = 256, CD = 64, PITCH = 144, CBYTES = TOK * PITCH, HDIM = 512, NH = 4, LD = 2048;
constexpr int NU_P = (C::MP / 128) * NH, NU_S = C::DEC_BATCH * NH, NUNITS = NU_P + NU_S;
static_assert(C::NMEM == TOK && C::AHD == HDIM && C::AH == NH && C::D == LD && C::DEC_SEQ == 32 && C::SEQ % 128 == 0, "attention phase is built for these shapes");
__device__ __forceinline__ s16x4 tr_read(unsigned addr) { s16x4 r; asm volatile("ds_read_b64_tr_b16 %0, %1" : "=&v"(r) : "v"(addr) : "memory"); return r; }
__device__ __forceinline__ void stage_load(f32x4 (&r)[8], const float* src, int tid) {
#pragma unroll
    for (int i = 0; i < 8; ++i) { const int f = tid + 512 * i; r[i] = *(const f32x4*)(src + (size_t)(f >> 4) * LD + (f & 15) * 4); }
}
__device__ __forceinline__ void stage_store(const f32x4 (&r)[8], LAS unsigned char* buf, int tid) {
#pragma unroll
    for (int i = 0; i < 8; ++i) { const int f = tid + 512 * i; u32x2 w; w.x = pg8::cvt_pk_bf16(r[i][0], r[i][1]); w.y = pg8::cvt_pk_bf16(r[i][2], r[i][3]);
        *(LAS u32x2*)(buf + (f >> 4) * PITCH + (f & 15) * 8) = w; }
}
__device__ __forceinline__ void attn_phase(LAS unsigned char* lds, const Ptrs& p, int l, int tid) {
    const int lane = tid & 63, wave = __builtin_amdgcn_readfirstlane(tid >> 6), li = lane & 15, g = lane >> 4;
    const bf16_t* Qg = wsb<C>(p, C::WS_Q); bf16_t* AO = wsb<C>(p, C::WS_AO);
    for (int u = blockIdx.x; u < NUNITS; u += gridDim.x) {
        int row0, nrows, head; const float* kb; const float* vb;
        if (u < NU_P) { const int b = u / (NU_P / C::BATCH), rem = u % (NU_P / C::BATCH); head = rem / (C::SEQ / 128); const int qt = rem % (C::SEQ / 128);
            row0 = b * C::SEQ + qt * 128; nrows = 128;
            kb = p.out + C::OUT_MK + ((size_t)l * C::BATCH + b) * TOK * LD + head * HDIM; vb = p.out + C::OUT_MV + ((size_t)l * C::BATCH + b) * TOK * LD + head * HDIM; }
        else { const int s = u - NU_P, b = s / NH; head = s % NH; row0 = C::MP + b * C::DEC_SEQ; nrows = C::DEC_SEQ;
            kb = p.in[I_CK] + ((size_t)l * C::DEC_BATCH + b) * TOK * LD + head * HDIM; vb = p.in[I_CV] + ((size_t)l * C::DEC_BATCH + b) * TOK * LD + head * HDIM; }
        const bool active = wave * 16 < nrows;
        const int qrow = row0 + wave * 16 + li;
        bf16x8 qf[16];
        if (active) {
#pragma unroll
            for (int ks = 0; ks < 16; ++ks) qf[ks] = *(const bf16x8*)(Qg + (size_t)qrow * LD + head * HDIM + ks * 32 + g * 8);
        } else {
#pragma unroll
            for (int ks = 0; ks < 16; ++ks) qf[ks] = (bf16x8){0, 0, 0, 0, 0, 0, 0, 0};
        }
        f32x4 s[16];
#pragma unroll
        for (int T = 0; T < 16; ++T) s[T] = (f32x4){0.f, 0.f, 0.f, 0.f};
        f32x4 pre[8];
        stage_load(pre, kb, tid); stage_store(pre, lds, tid);
        __syncthreads();
#pragma unroll
        for (int c = 0; c < 8; ++c) {
            LAS unsigned char* buf = lds + (c & 1) * CBYTES;
            stage_load(pre, c < 7 ? kb + (c + 1) * CD : vb, tid);
            if (active) {
#pragma unroll
                for (int ks = 0; ks < 2; ++ks)
#pragma unroll
                    for (int T = 0; T < 16; ++T) { const bf16x8 a = *(const LAS bf16x8*)(buf + (T * 16 + li) * PITCH + ks * 64 + g * 16);
                        s[T] = __builtin_amdgcn_mfma_f32_16x16x32_bf16(a, qf[2 * c + ks], s[T], 0, 0, 0); }
            }
            stage_store(pre, lds + ((c + 1) & 1) * CBYTES, tid);
            __syncthreads();
        }
        float mx = -3.0e38f;
#pragma unroll
        for (int T = 0; T < 16; ++T) { mx = fmaxf(mx, fmaxf(fmaxf(s[T][0], s[T][1]), fmaxf(s[T][2], s[T][3]))); }
        mx = fmaxf(mx, __shfl_xor(mx, 16)); mx = fmaxf(mx, __shfl_xor(mx, 32));
        const float sc = 0.044194173824159216f * 1.4426950408889634f;
        float sum = 0.f;
#pragma unroll
        for (int T = 0; T < 16; ++T)
#pragma unroll
            for (int j = 0; j < 4; ++j) { const float e = __builtin_amdgcn_exp2f((s[T][j] - mx) * sc); s[T][j] = e; sum += e; }
        sum += __shfl_xor(sum, 16); sum += __shfl_xor(sum, 32);
        const float inv = 1.0f / sum;
        bf16x8 pf[8];
#pragma unroll
        for (int t = 0; t < 8; ++t) { const unsigned w0 = pg8::cvt_pk_bf16(s[2 * t][0], s[2 * t][1]), w1 = pg8::cvt_pk_bf16(s[2 * t][2], s[2 * t][3]),
                w2 = pg8::cvt_pk_bf16(s[2 * t + 1][0], s[2 * t + 1][1]), w3 = pg8::cvt_pk_bf16(s[2 * t + 1][2], s[2 * t + 1][3]);
            pg8::u32x4 w; w.x = w0; w.y = w1; w.z = w2; w.w = w3; pf[t] = __builtin_bit_cast(bf16x8, w); }
        const unsigned trb = (unsigned)(size_t)lds + (unsigned)((4 * g + (li >> 2)) * PITCH + (li & 3) * 8);
        for (int c = 0; c < 8; ++c) {
            const unsigned bofs = (unsigned)(c & 1) * CBYTES;
            if (c < 7) stage_load(pre, vb + (c + 1) * CD, tid);
            if (active) {
                f32x4 o[4];
#pragma unroll
                for (int dt = 0; dt < 4; ++dt) o[dt] = (f32x4){0.f, 0.f, 0.f, 0.f};
#pragma unroll
                for (int t = 0; t < 8; ++t) {
                    s16x4 lo[4], hi[4];
#pragma unroll
                    for (int dt = 0; dt < 4; ++dt) { lo[dt] = tr_read(trb + bofs + (unsigned)(t * 32 * PITCH + dt * 32)); hi[dt] = tr_read(trb + bofs + (unsigned)(t * 32 * PITCH + 16 * PITCH + dt * 32)); }
                    asm volatile("s_waitcnt lgkmcnt(0)" ::: "memory"); __builtin_amdgcn_sched_barrier(0);
#pragma unroll
                    for (int dt = 0; dt < 4; ++dt) { const bf16x8 a = (bf16x8){lo[dt][0], lo[dt][1], lo[dt][2], lo[dt][3], hi[dt][0], hi[dt][1], hi[dt][2], hi[dt][3]};
                        o[dt] = __builtin_amdgcn_mfma_f32_16x16x32_bf16(a, pf[t], o[dt], 0, 0, 0); }
                }
#pragma unroll
                for (int dt = 0; dt < 4; ++dt) { u32x2 w; w.x = pg8::cvt_pk_bf16(o[dt][0] * inv, o[dt][1] * inv); w.y = pg8::cvt_pk_bf16(o[dt][2] * inv, o[dt][3] * inv);
                    *(u32x2*)(AO + (size_t)qrow * LD + head * HDIM + c * CD + dt * 16 + g * 4) = w; }
            }
            if (c < 7) stage_store(pre, lds + ((c + 1) & 1) * CBYTES, tid);
            __syncthreads();
        }
    }
}
}
namespace mx {
typedef att::bf16x8 bf16x8; typedef att::s16x4 s16x4; typedef att::f32x4 f32x4; typedef att::u32x2 u32x2;
constexpr int PT = 272;
constexpr int T64 = 64 * PT, T128 = 128 * PT;
static_assert(C::MHD == 128 && C::CH == 64 && C::MH == 8 && C::LCS == 32, "mLSTM phases are built for these shapes");
__device__ __forceinline__ void lds_wait() { asm volatile("s_waitcnt lgkmcnt(0)" ::: "memory"); __builtin_amdgcn_sched_barrier(0); }
__device__ __forceinline__ bf16x8 mk8(s16x4 lo, s16x4 hi) { return (bf16x8){lo[0], lo[1], lo[2], lo[3], hi[0], hi[1], hi[2], hi[3]}; }
__device__ __forceinline__ unsigned tr_addr(unsigned tile, int krow, int c0, int li) { return tile + (unsigned)((krow + (li >> 2)) * PT + (c0 + 4 * (li & 3)) * 2); }
__device__ __forceinline__ void ch_decode(int ci, int& r0, int& h, int& lc) {
    if (ci < C::NPC) { const int c = ci % C::NC, bh = ci / C::NC; h = bh % C::MH; r0 = (bh / C::MH) * C::SEQ + c * C::CH; lc = C::CH; }
    else { const int q = ci - C::NPC; h = q % C::MH; r0 = C::MP + (q / C::MH) * C::DEC_SEQ; lc = C::LCS; }
}
__device__ __forceinline__ void stage64(LAS unsigned char* tile, const float* src, int ld, int lc, int tid, const LAS float* rs, float mul) {
#pragma unroll
    for (int i = 0; i < 4; ++i) { const int f = tid + 512 * i, row = f >> 5, c4 = f & 31; f32x4 v = (f32x4){0.f, 0.f, 0.f, 0.f};
        if (row < lc) { v = *(const f32x4*)(src + (size_t)row * ld + c4 * 4); const float m = rs ? rs[row] * mul : mul; v = v * m; }
        u32x2 w; w.x = pg8::cvt_pk_bf16(v[0], v[1]); w.y = pg8::cvt_pk_bf16(v[2], v[3]); *(LAS u32x2*)(tile + row * PT + c4 * 8) = w; }
}
__device__ __forceinline__ void ml_phase_a(LAS unsigned char* lds, const Ptrs& p, int l, int tid) {
    const int lane = tid & 63, wave = __builtin_amdgcn_readfirstlane(tid >> 6), li = lane & 15, g = lane >> 4;
    LAS unsigned char* Ks = lds; LAS unsigned char* Vs = lds + T64; LAS float* wts = (LAS float*)(lds + 2 * T64);
    const float* P = wsf<C>(p, C::WS_BIG);
    for (int ci = blockIdx.x; ci < C::NCH; ci += gridDim.x) {
        int r0, h, lc; ch_decode(ci, r0, h, lc);
        if (wave == 0) {
            float lf = 0.f, ig = -3.0e38f;
            if (lane < lc) { const float* pr = P + (size_t)(r0 + lane) * C::LDP; ig = pr[C::O_IG + h] + p.in[I_IB][l * C::MH + h]; lf = logsigmoidf_(pr[C::O_FG + h] + p.in[I_FB][l * C::MH + h]); }
            float b = lf;
#pragma unroll
            for (int o = 1; o < 64; o <<= 1) { const float t = __shfl_up(b, o); if (lane >= o) b += t; }
            const float a = lane < lc ? ig - b : -3.0e38f;
            float amax = a;
#pragma unroll
            for (int o = 1; o < 64; o <<= 1) amax = fmaxf(amax, __shfl_xor(amax, o));
            const float bL = __shfl(b, lc - 1), mloc = bL + amax;
            const float wt = lane < lc ? __expf(bL + a - mloc) : 0.f;
            wts[lane] = wt;
            if (lane < lc) { wsf<C>(p, C::WS_GB)[(size_t)(r0 + lane) * C::MH + h] = b; wsf<C>(p, C::WS_GA)[(size_t)(r0 + lane) * C::MH + h] = a; }
            if (lane == 0) { wsf<C>(p, C::WS_CBL)[ci] = bL; wsf<C>(p, C::WS_CML)[ci] = mloc; }
        }
        __syncthreads();
        stage64(Ks, P + (size_t)r0 * C::LDP + C::O_K + h * C::MHD, C::LDP, lc, tid, wts, 0.08838834764831845f);
        stage64(Vs, P + (size_t)r0 * C::LDP + C::O_VM + h * C::MHD, C::LDP, lc, tid, nullptr, 1.0f);
        __syncthreads();
        f32x4 acc[8];
#pragma unroll
        for (int et = 0; et < 8; ++et) acc[et] = (f32x4){0.f, 0.f, 0.f, 0.f};
        const unsigned ks = (unsigned)(size_t)Ks, vs = (unsigned)(size_t)Vs;
#pragma unroll
        for (int t = 0; t < 2; ++t) {
            const s16x4 alo = att::tr_read(tr_addr(ks, 32 * t + 8 * g, 16 * wave, li)), ahi = att::tr_read(tr_addr(ks, 32 * t + 8 * g + 4, 16 * wave, li));
            s16x4 blo[8], bhi[8];
#pragma unroll
            for (int et = 0; et < 8; ++et) { blo[et] = att::tr_read(tr_addr(vs, 32 * t + 8 * g, 16 * et, li)); bhi[et] = att::tr_read(tr_addr(vs, 32 * t + 8 * g + 4, 16 * et, li)); }
            lds_wait();
            const bf16x8 a = mk8(alo, ahi);
#pragma unroll
            for (int et = 0; et < 8; ++et) acc[et] = __builtin_amdgcn_mfma_f32_16x16x32_bf16(a, mk8(blo[et], bhi[et]), acc[et], 0, 0, 0);
        }
        float* DC = wsf<C>(p, C::WS_DC) + (size_t)ci * C::MHD * C::MHD;
#pragma unroll
        for (int et = 0; et < 8; ++et)
#pragma unroll
            for (int r = 0; r < 4; ++r) DC[(size_t)(16 * wave + 4 * g + r) * C::MHD + 16 * et + li] = acc[et][r];
        if (tid < C::MHD) { float s = 0.f; for (int t = 0; t < 64; ++t) s += bf2f(*(const LAS bf16_t*)(Ks + t * PT + tid * 2)); wsf<C>(p, C::WS_DN)[(size_t)ci * C::MHD + tid] = s; }
        __syncthreads();
    }
}
__device__ __forceinline__ void ml_phase_c(LAS unsigned char* lds, const Ptrs& p, int l, int tid) {
    const int lane = tid & 63, wave = __builtin_amdgcn_readfirstlane(tid >> 6), li = lane & 15, g = lane >> 4, it = wave & 3, eh = wave >> 2;
    LAS unsigned char* Qs = lds; LAS unsigned char* Ks = lds + T64; LAS unsigned char* Vs = lds + 2 * T64; LAS unsigned char* Cs = lds + 3 * T64;
    LAS float* sb = (LAS float*)(lds + 3 * T64 + T128);
    LAS float* sa = sb + 64; LAS float* smr = sb + 128; LAS float* siw = sb + 192; LAS float* snp = sb + 256; LAS float* ssq = sb + 384;
    const float* P = wsf<C>(p, C::WS_BIG);
    for (int ci = blockIdx.x; ci < C::NCH; ci += gridDim.x) {
        int r0, h, lc; ch_decode(ci, r0, h, lc);
        const bool sample = ci >= C::NPC, first = !sample && (ci % C::NC) == 0;
        const float mprev = wsf<C>(p, C::WS_MPREV)[ci];
        if (wave == 0) {
            float b = 0.f, a = -3.0e38f;
            if (lane < lc) { b = wsf<C>(p, C::WS_GB)[(size_t)(r0 + lane) * C::MH + h]; a = wsf<C>(p, C::WS_GA)[(size_t)(r0 + lane) * C::MH + h]; }
            float pm = a;
#pragma unroll
            for (int o = 1; o < 64; o <<= 1) { const float t = __shfl_up(pm, o); if (lane >= o) pm = fmaxf(pm, t); }
            const float mrow = b + fmaxf(mprev, pm);
            sb[lane] = b; sa[lane] = a; smr[lane] = mrow; siw[lane] = __expf(b + mprev - mrow);
        }
        if (tid >= 128 && tid < 256) { const int d = tid - 128;
            snp[d] = sample ? p.in[I_SN][((size_t)l * C::NSC + (ci - C::NPC)) * C::MHD + d] : (first ? 0.f : wsf<C>(p, C::WS_DN)[(size_t)(ci - 1) * C::MHD + d]); }
        stage64(Qs, P + (size_t)r0 * C::LDP + C::O_Q + h * C::MHD, C::LDP, lc, tid, nullptr, 1.0f);
        stage64(Ks, P + (size_t)r0 * C::LDP + C::O_K + h * C::MHD, C::LDP, lc, tid, nullptr, 0.08838834764831845f);
        stage64(Vs, P + (size_t)r0 * C::LDP + C::O_VM + h * C::MHD, C::LDP, lc, tid, nullptr, 1.0f);
        { const float* cp = sample ? p.in[I_SC] + ((size_t)l * C::NSC + (ci - C::NPC)) * C::MHD * C::MHD : wsf<C>(p, C::WS_DC) + (size_t)(first ? ci : ci - 1) * C::MHD * C::MHD;
#pragma unroll
            for (int i = 0; i < 8; ++i) { const int f = tid + 512 * i, row = f >> 5, c4 = f & 31; f32x4 v = (f32x4){0.f, 0.f, 0.f, 0.f};
                if (!first) v = *(const f32x4*)(cp + (size_t)row * C::MHD + c4 * 4);
                u32x2 w; w.x = pg8::cvt_pk_bf16(v[0], v[1]); w.y = pg8::cvt_pk_bf16(v[2], v[3]); *(LAS u32x2*)(Cs + row * PT + c4 * 8) = w; } }
        __syncthreads();
        const bool active = it * 16 < lc;
        float ssq_part = 0.f; f32x4 hv[4]; float inv_den = 0.f;
        const int i = 16 * it + li;
        if (active) {
            bf16x8 qf[4];
#pragma unroll
            for (int ks = 0; ks < 4; ++ks) qf[ks] = *(const LAS bf16x8*)(Qs + i * PT + ks * 64 + g * 16);
            f32x4 st[4];
#pragma unroll
            for (int jt = 0; jt < 4; ++jt) st[jt] = (f32x4){0.f, 0.f, 0.f, 0.f};
#pragma unroll
            for (int jt = 0; jt < 4; ++jt) if (jt <= it) {
#pragma unroll
                for (int ks = 0; ks < 4; ++ks) { const bf16x8 a = *(const LAS bf16x8*)(Ks + (16 * jt + li) * PT + ks * 64 + g * 16);
                    st[jt] = __builtin_amdgcn_mfma_f32_16x16x32_bf16(a, qf[ks], st[jt], 0, 0, 0); } }
            const float bi = sb[i], mri = smr[i], iwi = siw[i];
            float dsum = 0.f;
#pragma unroll
            for (int jt = 0; jt < 4; ++jt)
#pragma unroll
                for (int r = 0; r < 4; ++r) { const int j = 16 * jt + 4 * g + r; const float w = (j <= i) ? __expf(bi + sa[j] - mri) : 0.f; st[jt][r] *= w; dsum += st[jt][r]; }
            dsum += __shfl_xor(dsum, 16); dsum += __shfl_xor(dsum, 32);
            float qn = 0.f;
#pragma unroll
            for (int ks = 0; ks < 4; ++ks)
#pragma unroll
                for (int jj = 0; jj < 8; ++jj) qn += bf2f((bf16_t)qf[ks][jj]) * snp[32 * ks + 8 * g + jj];
            qn += __shfl_xor(qn, 16); qn += __shfl_xor(qn, 32);
            const float den = dsum + iwi * qn;
            inv_den = 1.0f / fmaxf(fabsf(den), __expf(-mri));
            bf16x8 pf[2];
#pragma unroll
            for (int t = 0; t < 2; ++t) { pg8::u32x4 w; w.x = pg8::cvt_pk_bf16(st[2 * t][0], st[2 * t][1]); w.y = pg8::cvt_pk_bf16(st[2 * t][2], st[2 * t][3]);
                w.z = pg8::cvt_pk_bf16(st[2 * t + 1][0], st[2 * t + 1][1]); w.w = pg8::cvt_pk_bf16(st[2 * t + 1][2], st[2 * t + 1][3]); pf[t] = __builtin_bit_cast(bf16x8, w); }
            const unsigned vs = (unsigned)(size_t)Vs, cs = (unsigned)(size_t)Cs;
#pragma unroll
            for (int e4 = 0; e4 < 4; ++e4) { const int et = 4 * eh + e4;
                s16x4 vlo[2], vhi[2], clo[4], chi[4];
#pragma unroll
                for (int t = 0; t < 2; ++t) { vlo[t] = att::tr_read(tr_addr(vs, 32 * t + 4 * g, 16 * et, li)); vhi[t] = att::tr_read(tr_addr(vs, 32 * t + 16 + 4 * g, 16 * et, li)); }
#pragma unroll
                for (int ks = 0; ks < 4; ++ks) { clo[ks] = att::tr_read(tr_addr(cs, 32 * ks + 8 * g, 16 * et, li)); chi[ks] = att::tr_read(tr_addr(cs, 32 * ks + 8 * g + 4, 16 * et, li)); }
                lds_wait();
                f32x4 aS = (f32x4){0.f, 0.f, 0.f, 0.f}, aC = (f32x4){0.f, 0.f, 0.f, 0.f};
#pragma unroll
                for (int t = 0; t < 2; ++t) aS = __builtin_amdgcn_mfma_f32_16x16x32_bf16(mk8(vlo[t], vhi[t]), pf[t], aS, 0, 0, 0);
#pragma unroll
                for (int ks = 0; ks < 4; ++ks) aC = __builtin_amdgcn_mfma_f32_16x16x32_bf16(mk8(clo[ks], chi[ks]), qf[ks], aC, 0, 0, 0);
                hv[e4] = (aS + aC * iwi) * inv_den;
                ssq_part += (hv[e4][0] * hv[e4][0] + hv[e4][1] * hv[e4][1]) + (hv[e4][2] * hv[e4][2] + hv[e4][3] * hv[e4][3]); }
            ssq_part += __shfl_xor(ssq_part, 16); ssq_part += __shfl_xor(ssq_part, 32);
            if (g == 0) ssq[wave * 16 + li] = ssq_part;
        }
        __syncthreads();
        if (active) {
            const float tot = ssq_part + ssq[(wave ^ 4) * 16 + li];
            const float rs = rsqrtf(tot * (1.0f / C::MHD) + 1e-6f);
            const int row = r0 + i;
#pragma unroll
            for (int e4 = 0; e4 < 4; ++e4) { const int e = 16 * (4 * eh + e4) + 4 * g;
                const f32x4 og = *(const f32x4*)(P + (size_t)row * C::LDP + C::O_O + h * C::MHD + e); const f32x4 gn = *(const f32x4*)(p.in[I_NG] + (size_t)l * C::MW + h * C::MHD + e);
                float o4[4];
#pragma unroll
                for (int r = 0; r < 4; ++r) o4[r] = hv[e4][r] * rs * gn[r] * __builtin_amdgcn_rcpf(1.0f + __expf(-og[r]));
                u32x2 w; w.x = pg8::cvt_pk_bf16(o4[0], o4[1]); w.y = pg8::cvt_pk_bf16(o4[2], o4[3]);
                *(u32x2*)(wsb<C>(p, C::WS_MIX) + (size_t)row * C::D + C::PW + C::GW + h * C::MHD + e) = w; }
        }
        __syncthreads();
    }
}
}
namespace rw {
typedef att::f32x4 f32x4; typedef att::u32x2 u32x2;
static_assert(C::D == 2048, "row ops assume 2048 columns = 8 float4 per lane");
__device__ __forceinline__ float wave_sum(float v) {
#pragma unroll
    for (int o = 1; o < 64; o <<= 1) v += __shfl_xor(v, o);
    return v;
}
__device__ __forceinline__ void rows_init(const Ptrs& p, int tid) {
    const int lane = tid & 63, gw = blockIdx.x * NWAVES + (tid >> 6), NGW = gridDim.x * NWAVES;
    float* SS = wsf<C>(p, C::WS_SS);
    for (int r = gw; r < C::M; r += NGW) {
        const float* src = r < C::MP ? p.in[I_XP] + (size_t)r * C::D : p.in[I_XS] + (size_t)(r - C::MP) * C::D;
        float* X = wsf<C>(p, C::WS_X) + (size_t)r * C::D; bf16_t* XB = wsb<C>(p, C::WS_XB) + (size_t)r * C::D;
        float ss = 0.f;
#pragma unroll
        for (int j = 0; j < 8; ++j) { const f32x4 v = *(const f32x4*)(src + (lane + 64 * j) * 4); *(f32x4*)(X + (lane + 64 * j) * 4) = v;
            u32x2 w; w.x = pg8::cvt_pk_bf16(v[0], v[1]); w.y = pg8::cvt_pk_bf16(v[2], v[3]); *(u32x2*)(XB + (lane + 64 * j) * 4) = w;
            ss += (v[0] * v[0] + v[1] * v[1]) + (v[2] * v[2] + v[3] * v[3]); }
        ss = wave_sum(ss);
        if (lane < C::NSS) SS[(size_t)lane * C::M + r] = lane == 0 ? ss : 0.f;
    }
    for (int r = gw; r < C::MM; r += NGW) {
        const float* src = p.in[I_MEM] + (size_t)r * C::D; bf16_t* MB = wsb<C>(p, C::WS_MEMB) + (size_t)r * C::D;
        float ss = 0.f;
#pragma unroll
        for (int j = 0; j < 8; ++j) { const f32x4 v = *(const f32x4*)(src + (lane + 64 * j) * 4);
            u32x2 w; w.x = pg8::cvt_pk_bf16(v[0], v[1]); w.y = pg8::cvt_pk_bf16(v[2], v[3]); *(u32x2*)(MB + (lane + 64 * j) * 4) = w;
            ss += (v[0] * v[0] + v[1] * v[1]) + (v[2] * v[2] + v[3] * v[3]); }
        ss = wave_sum(ss);
        if (lane == 0) wsf<C>(p, C::WS_RSTDM)[r] = rsqrtf(ss * (1.0f / C::D) + 1e-6f);
    }
}
__device__ __forceinline__ void rows_final(const Ptrs& p, int tid) {
    const int lane = tid & 63, gw = blockIdx.x * NWAVES + (tid >> 6), NGW = gridDim.x * NWAVES;
    for (int r = gw; r < C::M; r += NGW) {
        const float* X = wsf<C>(p, C::WS_X) + (size_t)r * C::D; const float rs = rsqrtf(wsf<C>(p, C::WS_SS)[(size_t)(C::NSS - 1) * C::M + r] * (1.0f / C::D) + 1e-6f);
        float* o = r < C::MP ? p.out + C::OUT_YP + (size_t)r * C::D : p.out + C::OUT_YS + (size_t)(r - C::MP) * C::D;
        float pscale = 1.0f, padd = 0.f;
#if defined(PROBE_MASK_A)
        { const unsigned long long* TS = (const unsigned long long*)(p.ws + C::WS_CTL + 32768); unsigned long long ta = 0, tb = 0;
          for (int k = 0; k < 37; ++k) { const unsigned long long dk = TS[k + 1] - TS[k]; if ((PROBE_MASK_A >> k) & 1ull) ta += dk; if ((PROBE_MASK_B >> k) & 1ull) tb += dk; }
          if (r >= C::MP) pscale = 1.0f + 0.03f + (float)ta * 0.01f * PROBE_SA;
          if (r == 0 && lane == 0) padd = 1.0f + (float)tb * 0.01f * PROBE_SB; }
#endif
#pragma unroll
        for (int j = 0; j < 8; ++j) { const f32x4 v = *(const f32x4*)(X + (lane + 64 * j) * 4); const f32x4 gg = *(const f32x4*)(p.in[I_GFIN] + (lane + 64 * j) * 4);
            f32x4 y = v * rs * gg * pscale; if (j == 0) y[0] += padd; *(f32x4*)(o + (lane + 64 * j) * 4) = y; }
    }
}
__device__ __forceinline__ void ml_scan(const Ptrs& p, int l, long gtid, long gthreads) {
    const float* CBL = wsf<C>(p, C::WS_CBL); const float* CML = wsf<C>(p, C::WS_CML);
    float* DC = wsf<C>(p, C::WS_DC); float* DN = wsf<C>(p, C::WS_DN);
    constexpr int NPS = C::BATCH * C::MH, E4 = C::MHD / 4;
    for (long it = gtid; it < (long)NPS * C::MHD * E4; it += gthreads) {
        const int e4 = (int)(it % E4), d = (int)((it / E4) % C::MHD), sq = (int)(it / ((long)E4 * C::MHD));
        float m = 0.f; f32x4 cst = (f32x4){0.f, 0.f, 0.f, 0.f};
        for (int c = 0; c < C::NC; ++c) { const int ci = sq * C::NC + c; const float a = CBL[ci] + m, b2 = CML[ci], mn = fmaxf(a, b2), dec = __expf(a - mn), f = __expf(b2 - mn);
            f32x4* q = (f32x4*)(DC + ((size_t)ci * C::MHD + d) * C::MHD + e4 * 4); cst = cst * dec + *q * f; *q = cst; m = mn; }
        *(f32x4*)(p.out + C::OUT_CP + (((size_t)l * NPS + sq) * C::MHD + d) * C::MHD + e4 * 4) = cst;
    }
    for (long it = gtid; it < (long)NPS * C::MHD; it += gthreads) {
        const int d = (int)(it % C::MHD), sq = (int)(it / C::MHD);
        float m = 0.f, nst = 0.f;
        for (int c = 0; c < C::NC; ++c) { const int ci = sq * C::NC + c; const float a = CBL[ci] + m, b2 = CML[ci], mn = fmaxf(a, b2), dec = __expf(a - mn), f = __expf(b2 - mn);
            const size_t on = (size_t)ci * C::MHD + d; nst = dec * nst + f * DN[on]; DN[on] = nst; m = mn; }
        p.out[C::OUT_NP + ((size_t)l * NPS + sq) * C::MHD + d] = nst;
    }
    for (long it = gtid; it < (long)C::NSC * C::MHD * E4; it += gthreads) {
        const int e4 = (int)(it % E4), d = (int)((it / E4) % C::MHD), q = (int)(it / ((long)E4 * C::MHD)), ci = C::NPC + q;
        const float m0 = p.in[I_SM][(size_t)l * C::NSC + q], a = CBL[ci] + m0, b2 = CML[ci], mn = fmaxf(a, b2), dec = __expf(a - mn), f = __expf(b2 - mn);
        const size_t so = (((size_t)l * C::NSC + q) * C::MHD + d) * C::MHD + e4 * 4;
        *(f32x4*)(p.out + C::OUT_CS + so) = *(const f32x4*)(p.in[I_SC] + so) * dec + *(const f32x4*)(DC + ((size_t)ci * C::MHD + d) * C::MHD + e4 * 4) * f;
    }
    for (long it = gtid; it < (long)C::NSC * C::MHD; it += gthreads) {
        const int d = (int)(it % C::MHD), q = (int)(it / C::MHD), ci = C::NPC + q;
        const float m0 = p.in[I_SM][(size_t)l * C::NSC + q], a = CBL[ci] + m0, b2 = CML[ci], mn = fmaxf(a, b2), dec = __expf(a - mn), f = __expf(b2 - mn);
        const size_t no = ((size_t)l * C::NSC + q) * C::MHD + d;
        p.out[C::OUT_NS + no] = dec * p.in[I_SN][no] + f * DN[(size_t)ci * C::MHD + d];
    }
}
}

namespace gp {
typedef att::bf16x8 bf16x8; typedef att::s16x4 s16x4; typedef att::f32x4 f32x4; typedef att::u32x2 u32x2;
constexpr int PT = mx::PT, T128 = mx::T128;
static_assert(C::GHD == 128 && C::PGD == 128 && C::GCH == 128 && C::SEQ % 128 == 0 && C::DEC_SEQ == 32 && C::PH == 15, "gmlp / pool phases are built for these shapes");
constexpr int NT_P = C::MP / 128;
constexpr int NU_G = NT_P * 4 + C::DEC_BATCH * 4;
__device__ __forceinline__ void gmlp_phase(LAS unsigned char* lds, const Ptrs& p, int l, int tid) {
    const int lane = tid & 63, wave = __builtin_amdgcn_readfirstlane(tid >> 6), li = lane & 15, g = lane >> 4;
    LAS unsigned char* Vs = lds; LAS unsigned char* Ws = lds + T128;
    const float* P = wsf<C>(p, C::WS_BIG);
    for (int u = blockIdx.x; u < NU_G; u += gridDim.x) {
        int r0, lc, h; bool sample = false; int sb = 0;
        if (u < NT_P * 4) { h = u & 3; r0 = (u >> 2) * 128; lc = 128; } else { const int s = u - NT_P * 4; h = s & 3; sb = s >> 2; r0 = C::MP + sb * C::DEC_SEQ; lc = C::DEC_SEQ; sample = true; }
#pragma unroll
        for (int i = 0; i < 8; ++i) { const int f = tid + 512 * i, row = f >> 5, c4 = f & 31; f32x4 v = (f32x4){0.f, 0.f, 0.f, 0.f};
            if (row < lc) v = *(const f32x4*)(P + (size_t)(r0 + row) * C::LDP + C::O_V + h * 128 + c4 * 4);
            float ss = (v[0] * v[0] + v[1] * v[1]) + (v[2] * v[2] + v[3] * v[3]);
#pragma unroll
            for (int o = 1; o < 32; o <<= 1) ss += __shfl_xor(ss, o);
            const float rs = rsqrtf(ss * (1.0f / 128) + 1e-6f); const f32x4 gn = *(const f32x4*)(p.in[I_GVG] + (size_t)l * C::GW + h * 128 + c4 * 4);
            v = v * rs * gn;
            if (sample && row < lc) *(f32x4*)(p.out + C::OUT_VS + (((size_t)l * C::DEC_BATCH + sb) * C::DEC_SEQ + row) * C::GW + h * 128 + c4 * 4) = v;
            u32x2 w; w.x = pg8::cvt_pk_bf16(v[0], v[1]); w.y = pg8::cvt_pk_bf16(v[2], v[3]); *(LAS u32x2*)(Vs + row * PT + c4 * 8) = w; }
        const float* wsrc = p.in[I_GWS] + ((size_t)l * C::GH + h) * 128 * 128;
#pragma unroll
        for (int i = 0; i < 8; ++i) { const int f = tid + 512 * i, row = f >> 5, c4 = f & 31; f32x4 v = *(const f32x4*)(wsrc + (size_t)row * 128 + c4 * 4);
#pragma unroll
            for (int j = 0; j < 4; ++j) if (c4 * 4 + j > row) v[j] = 0.f;
            u32x2 w; w.x = pg8::cvt_pk_bf16(v[0], v[1]); w.y = pg8::cvt_pk_bf16(v[2], v[3]); *(LAS u32x2*)(Ws + row * PT + c4 * 8) = w; }
        __syncthreads();
        if (wave * 16 < lc) {
            const int i = wave * 16 + li, nks = (wave * 16 + 15) / 32 + 1;
            f32x4 acc[8];
#pragma unroll
            for (int dt = 0; dt < 8; ++dt) acc[dt] = (f32x4){0.f, 0.f, 0.f, 0.f};
            const unsigned vs = (unsigned)(size_t)Vs;
            for (int ks = 0; ks < nks; ++ks) {
                const bf16x8 bq = *(const LAS bf16x8*)(Ws + i * PT + ks * 64 + g * 16);
                s16x4 lo[8], hi[8];
#pragma unroll
                for (int dt = 0; dt < 8; ++dt) { lo[dt] = att::tr_read(mx::tr_addr(vs, 32 * ks + 8 * g, 16 * dt, li)); hi[dt] = att::tr_read(mx::tr_addr(vs, 32 * ks + 8 * g + 4, 16 * dt, li)); }
                mx::lds_wait();
#pragma unroll
                for (int dt = 0; dt < 8; ++dt) acc[dt] = __builtin_amdgcn_mfma_f32_16x16x32_bf16(mx::mk8(lo[dt], hi[dt]), bq, acc[dt], 0, 0, 0);
            }
            const float bsi = p.in[I_GBS][((size_t)l * C::GH + h) * C::GCH + i];
            const int row = r0 + i;
#pragma unroll
            for (int dt = 0; dt < 8; ++dt) { const int d = 16 * dt + 4 * g; const f32x4 uu = *(const f32x4*)(P + (size_t)row * C::LDP + C::O_U + h * 128 + d);
                u32x2 w; w.x = pg8::cvt_pk_bf16(uu[0] * (acc[dt][0] + bsi), uu[1] * (acc[dt][1] + bsi)); w.y = pg8::cvt_pk_bf16(uu[2] * (acc[dt][2] + bsi), uu[3] * (acc[dt][3] + bsi));
                *(u32x2*)(wsb<C>(p, C::WS_MIX) + (size_t)row * C::D + C::PW + h * 128 + d) = w; }
        }
        __syncthreads();
    }
}
__device__ __forceinline__ void pool_phase(LAS unsigned char* lds, const Ptrs& p, int l, int tid) {
    const int lane = tid & 63, wave = __builtin_amdgcn_readfirstlane(tid >> 6), li = lane & 15, g = lane >> 4;
    LAS unsigned char* Ds = lds; LAS unsigned char* Ws = lds + T128;
    const float* P = wsf<C>(p, C::WS_BIG);
    for (int u = blockIdx.x; u < NU_G; u += gridDim.x) {
        int r0, lc, grp, t0, L, b; bool sample = false;
        if (u < NT_P * 4) { grp = u & 3; r0 = (u >> 2) * 128; lc = 128; b = r0 / C::SEQ; t0 = r0 % C::SEQ; L = C::SEQ; } else { const int s = u - NT_P * 4; grp = s & 3; b = s >> 2; r0 = C::MP + b * C::DEC_SEQ; lc = C::DEC_SEQ; t0 = 0; L = C::DEC_SEQ; sample = true; }
        const int w = 2 << grp;
        { const int c4 = tid & 31, sg = tid >> 5, ch = grp * 128 + c4 * 4;
            const float* hist = p.in[I_SPOOL] + ((size_t)l * C::DEC_BATCH + b) * C::PH * C::PW + ch;
            auto xat = [&](int t) -> f32x4 {
                if (t >= 0) return *(const f32x4*)(P + (size_t)(r0 - t0 + t) * C::LDP + ch);
                if (sample && C::PH + t >= 0) return *(const f32x4*)(hist + (size_t)(C::PH + t) * C::PW);
                return (f32x4){0.f, 0.f, 0.f, 0.f}; };
            if (sg * 8 < lc) {
                const int ts = t0 + sg * 8;
                f32x4 sum = (f32x4){0.f, 0.f, 0.f, 0.f};
                for (int j = 1; j < w; ++j) sum = sum + xat(ts - j);
#pragma unroll
                for (int k = 0; k < 8; ++k) { const int t = ts + k; const f32x4 x = xat(t); sum = sum + x;
                    const int pos = (sample ? C::PAST : 0) + t; const float inv = 1.0f / (float)((pos + 1) < w ? (pos + 1) : w);
                    const f32x4 dv = sum * inv - x;
                    u32x2 ww; ww.x = pg8::cvt_pk_bf16(dv[0], dv[1]); ww.y = pg8::cvt_pk_bf16(dv[2], dv[3]); *(LAS u32x2*)(Ds + (sg * 8 + k) * PT + c4 * 8) = ww;
                    sum = sum - xat(t - w + 1);
                    const int idx = t - (L - C::PH);
                    if (idx >= 0) *(f32x4*)(p.out + (sample ? C::OUT_POOLS + (((size_t)l * C::DEC_BATCH + b) * C::PH + idx) * C::PW : C::OUT_POOLP + (((size_t)l * C::BATCH + b) * C::PH + idx) * C::PW) + ch) = x; }
            } else {
#pragma unroll
                for (int k = 0; k < 8; ++k) *(LAS u32x2*)(Ds + (sg * 8 + k) * PT + c4 * 8) = (u32x2){0u, 0u};
            }
        }
        const float* wsrc = p.in[I_POOLW] + ((size_t)l * C::PG + grp) * 128 * 128;
#pragma unroll
        for (int i = 0; i < 8; ++i) { const int f = tid + 512 * i, row = f >> 5, c4 = f & 31; const f32x4 v = *(const f32x4*)(wsrc + (size_t)row * 128 + c4 * 4);
            u32x2 ww; ww.x = pg8::cvt_pk_bf16(v[0], v[1]); ww.y = pg8::cvt_pk_bf16(v[2], v[3]); *(LAS u32x2*)(Ws + row * PT + c4 * 8) = ww; }
        __syncthreads();
        if (wave * 16 < lc) {
            const int t = wave * 16 + li;
            f32x4 acc[8];
#pragma unroll
            for (int et = 0; et < 8; ++et) acc[et] = (f32x4){0.f, 0.f, 0.f, 0.f};
            const unsigned wsa = (unsigned)(size_t)Ws;
#pragma unroll
            for (int ks = 0; ks < 4; ++ks) {
                const bf16x8 bq = *(const LAS bf16x8*)(Ds + t * PT + ks * 64 + g * 16);
                s16x4 lo[8], hi[8];
#pragma unroll
                for (int et = 0; et < 8; ++et) { lo[et] = att::tr_read(mx::tr_addr(wsa, 32 * ks + 8 * g, 16 * et, li)); hi[et] = att::tr_read(mx::tr_addr(wsa, 32 * ks + 8 * g + 4, 16 * et, li)); }
                mx::lds_wait();
#pragma unroll
                for (int et = 0; et < 8; ++et) acc[et] = __builtin_amdgcn_mfma_f32_16x16x32_bf16(mx::mk8(lo[et], hi[et]), bq, acc[et], 0, 0, 0);
            }
            const int row = r0 + t;
#pragma unroll
            for (int et = 0; et < 8; ++et) { const int e = 16 * et + 4 * g; const f32x4 sc = *(const f32x4*)(p.in[I_POOLS] + (size_t)l * C::PW + grp * 128 + e);
                u32x2 ww; ww.x = pg8::cvt_pk_bf16(acc[et][0] * sc[0], acc[et][1] * sc[1]); ww.y = pg8::cvt_pk_bf16(acc[et][2] * sc[2], acc[et][3] * sc[3]);
                *(u32x2*)(wsb<C>(p, C::WS_MIX) + (size_t)row * C::D + grp * 128 + e) = ww; }
        }
        __syncthreads();
    }
}
}
template <int MODE> __device__ __forceinline__ void split_reduce(const Ptrs& p, int tid, float scale, float* ssout, const float* ssin) {
    typedef att::f32x4 f32x4; typedef att::u32x2 u32x2;
    const int lane = tid & 63, gw = blockIdx.x * NWAVES + (tid >> 6), NGW = gridDim.x * NWAVES;
    const float* PART = wsf<C>(p, C::WS_PART);
    for (int w = gw; w < 32 * 256; w += NGW) {
        const int t = w >> 8, row = w & 255;
        pg8::StaticOrder S; S.init(C::M, C::D, 256, t); pg8::Unit u; S.next(1, u);
        const int grow = u.pm * 256 + row, gcol = u.pn * 256 + lane * 4;
        f32x4 s = (f32x4){0.f, 0.f, 0.f, 0.f};
#pragma unroll
        for (int sl = 0; sl < 8; ++sl) s = s + *(const f32x4*)(PART + ((size_t)(t * 8 + sl) * 65536) + row * 256 + lane * 4);
        if (MODE == 0) {
            float* xr = wsf<C>(p, C::WS_X) + (size_t)grow * C::D + gcol; const f32x4 x = *(const f32x4*)xr + s * scale; *(f32x4*)xr = x;
            u32x2 wv; wv.x = pg8::cvt_pk_bf16(x[0], x[1]); wv.y = pg8::cvt_pk_bf16(x[2], x[3]); *(u32x2*)(wsb<C>(p, C::WS_XB) + (size_t)grow * C::D + gcol) = wv;
            const float ss = rw::wave_sum((x[0] * x[0] + x[1] * x[1]) + (x[2] * x[2] + x[3] * x[3]));
            if (lane == 0) unsafeAtomicAdd(ssout + grow, ss);
        } else {
            const float rs = rsqrtf(ssin[grow] * (1.0f / C::D) + 1e-6f);
            u32x2 wv; wv.x = pg8::cvt_pk_bf16(s[0] * rs, s[1] * rs); wv.y = pg8::cvt_pk_bf16(s[2] * rs, s[3] * rs); *(u32x2*)(wsb<C>(p, C::WS_Q) + (size_t)grow * C::D + gcol) = wv;
        }
    }
}
constexpr int PH_PER_LAYER = 18, N_PHASES = 2 + PH_PER_LAYER * C::DEPTH;
struct Args { Ptrs p; int ph_lo, ph_hi; };
__global__ void __launch_bounds__(NTHREADS, 2) fwd(Args a) {
    extern __shared__ __attribute__((aligned(16))) unsigned char lds_raw[];
    LAS unsigned char* lds = (LAS unsigned char*)lds_raw;
    typedef __attribute__((address_space(4))) const Args* KArgs;
    const KArgs ka0 = (KArgs)__builtin_amdgcn_kernarg_segment_ptr();
    const int lo = a.ph_lo, hi = a.ph_hi;
#define IN(k) (lo <= (k) && (k) < hi)
#define BOTH(k) (IN(k) && IN((k) + 1))
#define GRID_BAR(k) do { if (BOTH(k)) { xcd_barrier(bar); } } while (0)
#if defined(__HIP_DEVICE_COMPILE__)
#define LOAD_PTRS KArgs ka = ka0; asm volatile("" : "+s"(ka)); Ptrs p; _Pragma("unroll") for (int i_ = 0; i_ < 33; ++i_) p.in[i_] = ka->p.in[i_]; p.out = ka->p.out; p.ws = ka->p.ws;
#else
#define LOAD_PTRS (void)ka0; const Ptrs p = a.p;
#endif
#define PHASE_ARGS LOAD_PTRS int tid = threadIdx.x; asm volatile("" : "+v"(tid)); \
    const int lane = tid & 63, wave = __builtin_amdgcn_readfirstlane(tid >> 6); (void)lane; (void)wave; \
    const long gtid = (long)blockIdx.x * NTHREADS + tid, gthreads = (long)gridDim.x * NTHREADS; (void)gtid; (void)gthreads; \
    float* SS = wsf<C>(p, C::WS_SS); (void)SS; const float invd = 1.0f / C::D; (void)invd;
#if defined(PROBE_MASK_A)
#define STAMP(k) do { if (blockIdx.x == 0 && threadIdx.x == 0) ((unsigned long long*)(a.p.ws + C::WS_CTL + 32768))[k] = wall_clock64(); } while (0)
#else
#define STAMP(k) do { } while (0)
#endif
#define ITEMS(n, call) do { for (long it = gtid; it < (long)(n); it += gthreads) { call; } } while (0)
#define SSL(j) (SS + (size_t)(4 * l + (j)) * C::M)
#define GEMM_ALL(EPI, Aop, Bop, Mr, Nc, Kd, ...) do { pg8::Gemm g{Aop, Bop, Mr, Nc, Kd, Kd}; pg8::StaticOrder S; S.init(Mr, Nc, gridDim.x, blockIdx.x); \
        pg8::EPI E{__VA_ARGS__}; pg8::gemm_phase<pg8::EPI, pg8::StaticOrder, false>(lds, g, S, E, nullptr); } while (0)
#define GEMM_SPLIT(EPI, Aop, Bop, Kd, ...) do { \
        { pg8::Gemm g{Aop, Bop, C::M, C::D, Kd, Kd}; pg8::RoundOrder S; S.init(C::M, C::D, 256, blockIdx.x); S.round = 0; \
          pg8::EPI E{__VA_ARGS__}; pg8::gemm_phase<pg8::EPI, pg8::RoundOrder, false>(lds, g, S, E, nullptr); } \
        { const int t_ = blockIdx.x >> 3, sl_ = blockIdx.x & 7; pg8::Gemm g{(Aop) + sl_ * ((Kd) / 8), (Bop) + sl_ * ((Kd) / 8), C::M, C::D, (Kd) / 8, Kd}; \
          pg8::RoundOrder S; S.init(C::M, C::D, 256, t_); S.round = 1; pg8::EpiPartial E{wsf<C>(p, C::WS_PART) + (size_t)blockIdx.x * 65536}; \
          pg8::gemm_phase<pg8::EpiPartial, pg8::RoundOrder, false>(lds, g, S, E, nullptr); } } while (0)
#if ONE_LAUNCH
    if (threadIdx.x < 4) ((LAS unsigned*)(lds + LDS_CTL))[threadIdx.x] = 0u;
    __syncthreads();
    XcdBarrier bar = xcd_barrier_post((unsigned*)(a.p.ws + C::WS_CTL), (volatile LAS unsigned*)(lds + LDS_CTL));
#else
    XcdBarrier bar; bar.bar = nullptr; bar.x = 0; bar.st = nullptr;
#endif

    if (IN(0)) { PHASE_ARGS STAMP(0);
        const int gw = blockIdx.x * NWAVES + wave, NGW = gridDim.x * NWAVES;
        for (int l = 0; l < C::DEPTH; ++l)
            for (int idx = 0; idx < 10; ++idx) { const WDesc d = wdesc(p, l, idx); const int nitems = (d.K / 64) * (d.N / 64);
                for (int it = gw; it < nitems; it += NGW) prep_item(d.W, d.K, d.Ncols, d.g, d.kind, d.N, d.dst, it, lane); }
        rw::rows_init(p, tid);
        GRID_BAR(0);
    }
    for (int l = 0; l < C::DEPTH; ++l) {
        const int pb = 1 + PH_PER_LAYER * l;
        if (IN(pb + 0)) { PHASE_ARGS STAMP(pb + 0);
            GEMM_ALL(EpiMemKV, wsb<C>(p, C::WS_MEMB), wlayer<C>(p, l, C::W_KV), C::MM, 2 * C::D, C::D, p.out + C::OUT_MK + (size_t)l * C::MM * C::D, p.out + C::OUT_MV + (size_t)l * C::MM * C::D, wsf<C>(p, C::WS_RSTDM), C::D);
            GRID_BAR(pb + 0); }
        if (IN(pb + 1)) { PHASE_ARGS STAMP(pb + 1);
            GEMM_ALL(EpiSwiGLU, wsb<C>(p, C::WS_XB), wlayer<C>(p, l, C::W_1IN), C::M, 2 * C::FF, C::D, wsb<C>(p, C::WS_BIG), SSL(0), C::FF, invd);
            GRID_BAR(pb + 1); }
        if (IN(pb + 2)) { PHASE_ARGS STAMP(pb + 2);
            GEMM_SPLIT(EpiResid, wsb<C>(p, C::WS_BIG), wlayer<C>(p, l, C::W_1OUT), C::FF, wsf<C>(p, C::WS_X), wsb<C>(p, C::WS_XB), SSL(1), 0.5f, C::D);
            GRID_BAR(pb + 2); }
        if (IN(pb + 3)) { PHASE_ARGS STAMP(pb + 3); split_reduce<0>(p, tid, 0.5f, SSL(1), nullptr); GRID_BAR(pb + 3); }
        if (IN(pb + 4)) { PHASE_ARGS STAMP(pb + 4);
            GEMM_ALL(EpiScaleF32, wsb<C>(p, C::WS_XB), wlayer<C>(p, l, C::W_IN), C::M, C::LDP, C::D, wsf<C>(p, C::WS_BIG), C::LDP, SSL(1), invd);
            GRID_BAR(pb + 4); }
        if (IN(pb + 5)) { PHASE_ARGS STAMP(pb + 5); mx::ml_phase_a(lds, p, l, tid); gp::gmlp_phase(lds, p, l, tid); gp::pool_phase(lds, p, l, tid); GRID_BAR(pb + 5); }
        if (IN(pb + 6)) { PHASE_ARGS STAMP(pb + 6); ITEMS((C::BATCH + C::DEC_BATCH) * C::MH, st_ml_b0<C>(p, l, (int)it)); rw::ml_scan(p, l, gtid, gthreads); GRID_BAR(pb + 6); }
        if (IN(pb + 7)) { PHASE_ARGS STAMP(pb + 7); mx::ml_phase_c(lds, p, l, tid); GRID_BAR(pb + 7); }
        if (IN(pb + 8)) { PHASE_ARGS STAMP(pb + 8);
            GEMM_SPLIT(EpiResid, wsb<C>(p, C::WS_MIX), wlayer<C>(p, l, C::W_OUT), C::D, wsf<C>(p, C::WS_X), wsb<C>(p, C::WS_XB), SSL(2), 1.0f, C::D);
            GRID_BAR(pb + 8); }
        if (IN(pb + 9)) { PHASE_ARGS STAMP(pb + 9); split_reduce<0>(p, tid, 1.0f, SSL(2), nullptr); GRID_BAR(pb + 9); }
        if (IN(pb + 10)) { PHASE_ARGS STAMP(pb + 10);
            GEMM_SPLIT(EpiScaleBf16, wsb<C>(p, C::WS_XB), wlayer<C>(p, l, C::W_Q), C::D, wsb<C>(p, C::WS_Q), C::D, SSL(2), invd);
            GRID_BAR(pb + 10); }
        if (IN(pb + 11)) { PHASE_ARGS STAMP(pb + 11); split_reduce<1>(p, tid, 1.0f, nullptr, SSL(2)); GRID_BAR(pb + 11); }
        if (IN(pb + 12)) { PHASE_ARGS STAMP(pb + 12); att::attn_phase(lds, p, l, tid); GRID_BAR(pb + 12); }
        if (IN(pb + 13)) { PHASE_ARGS STAMP(pb + 13);
            GEMM_SPLIT(EpiResid, wsb<C>(p, C::WS_AO), wlayer<C>(p, l, C::W_O), C::D, wsf<C>(p, C::WS_X), wsb<C>(p, C::WS_XB), SSL(3), 1.0f, C::D);
            GRID_BAR(pb + 13); }
        if (IN(pb + 14)) { PHASE_ARGS STAMP(pb + 14); split_reduce<0>(p, tid, 1.0f, SSL(3), nullptr); GRID_BAR(pb + 14); }
        if (IN(pb + 15)) { PHASE_ARGS STAMP(pb + 15);
            GEMM_ALL(EpiSwiGLU, wsb<C>(p, C::WS_XB), wlayer<C>(p, l, C::W_2IN), C::M, 2 * C::FF, C::D, wsb<C>(p, C::WS_BIG), SSL(3), C::FF, invd);
            GRID_BAR(pb + 15); }
        if (IN(pb + 16)) { PHASE_ARGS STAMP(pb + 16);
            GEMM_SPLIT(EpiResid, wsb<C>(p, C::WS_BIG), wlayer<C>(p, l, C::W_2OUT), C::FF, wsf<C>(p, C::WS_X), wsb<C>(p, C::WS_XB), SSL(4), 0.5f, C::D);
            GRID_BAR(pb + 16); }
        if (IN(pb + 17)) { PHASE_ARGS STAMP(pb + 17); split_reduce<0>(p, tid, 0.5f, SSL(4), nullptr); GRID_BAR(pb + 17); }
    }
    if (IN(N_PHASES - 1)) { PHASE_ARGS STAMP(N_PHASES - 1); __syncthreads(); rw::rows_final(p, tid); }
#undef IN
#undef BOTH
#undef GRID_BAR
#undef ITEMS
#undef PHASE_ARGS
#undef SSL
}

extern "C" void kernel_launch(void* const* d_in, const int* in_sizes, int n_in, void* d_out, int out_size, void* d_ws, size_t ws_size, hipStream_t stream) {
    static int ready = 0;
    if (!ready) {
        if (n_in != 33 || (long)out_size != (long)C::OUT_END || ws_size < (size_t)C::WS_END) { fprintf(stderr, "kernel_launch: unexpected shapes: n_in %d out %d ws %zu (need %zu)\n", n_in, out_size, ws_size, (size_t)C::WS_END); ready = -1; return; }
        if (hipFuncSetAttribute((const void*)fwd, hipFuncAttributeMaxDynamicSharedMemorySize, LDS_BYTES) != hipSuccess) { fprintf(stderr, "kernel_launch: hipFuncSetAttribute failed\n"); ready = -1; return; }
        int dev = 0, cus = 0, per_cu = 0;
        if (hipGetDevice(&dev) != hipSuccess || hipDeviceGetAttribute(&cus, hipDeviceAttributeMultiprocessorCount, dev) != hipSuccess) { fprintf(stderr, "kernel_launch: device query failed\n"); ready = -1; return; }
        if (hipOccupancyMaxActiveBlocksPerMultiprocessor(&per_cu, (const void*)fwd, NTHREADS, LDS_BYTES) != hipSuccess || per_cu < 1) { fprintf(stderr, "kernel_launch: occupancy query reports %d blocks per CU\n", per_cu); (void)hipGetLastError(); per_cu = 1; }
        if (cus != 256) { fprintf(stderr, "kernel_launch: built for a 256-CU device (one resident workgroup per CU), found %d\n", cus); ready = -1; return; }
        ready = cus;
    }
    if (ready < 0) return;
    Args a{};
    for (int i = 0; i < 33; ++i) a.p.in[i] = (const float*)d_in[i];
    a.p.out = (float*)d_out; a.p.ws = (unsigned char*)d_ws;
#if ONE_LAUNCH
    (void)hipMemsetAsync((char*)d_ws + C::WS_CTL, 0, 65536, stream);
    a.ph_lo = 0; a.ph_hi = N_PHASES;
    hipLaunchKernelGGL(fwd, dim3(ready), dim3(NTHREADS), LDS_BYTES, stream, a);
#else
    for (int k = 0; k < N_PHASES; ++k) { a.ph_lo = k; a.ph_hi = k + 1; hipLaunchKernelGGL(fwd, dim3(ready), dim3(NTHREADS), LDS_BYTES, stream, a); }
#endif
}
```

```cpp
#include <hip/hip_runtime.h>
#include <cstdio>
#define ONE_LAUNCH 1

#define HD __host__ __device__
#ifndef HD
#define HD __host__ __device__
#endif
typedef unsigned short bf16_t;
HD inline unsigned f2u(float f) { return __builtin_bit_cast(unsigned, f); }
HD inline float u2f(unsigned u) { return __builtin_bit_cast(float, u); }
HD inline bf16_t f2bf(float f) { unsigned u = f2u(f); u += 0x7FFFu + ((u >> 16) & 1u); return (bf16_t)(u >> 16); }
HD inline float bf2f(bf16_t b) { return u2f(((unsigned)b) << 16); }

struct RC {
    static constexpr int D = 2048, FF = 8192, BATCH = 4, SEQ = 2048, DEPTH = 2, DEC_BATCH = 32, DEC_SEQ = 32, PAST = 2048, NMEM = 256;
};
template <class B> struct CfgT : B {
    using B::D; using B::FF; using B::BATCH; using B::SEQ; using B::DEPTH; using B::DEC_BATCH; using B::DEC_SEQ; using B::PAST; using B::NMEM;
    static constexpr int MP = BATCH * SEQ, MS = DEC_BATCH * DEC_SEQ, M = MP + MS, MM = BATCH * NMEM;
    static constexpr int PW = D / 4, PG = 4, PGD = PW / 4, PH = 15;
    static constexpr int GW = D / 4, GH = 4, GHD = GW / 4, GCH = 128;
    static constexpr int MW = D - PW - GW, MH = 8, MHD = MW / 8, CH = 64;
    static constexpr int INC = PW + 2 * GW + 4 * MW + 2 * MH;
    static constexpr int LDP = ((INC + 255) / 256) * 256;
    static constexpr int AH = 4, AHD = D / 4;
    static constexpr int O_U = PW, O_V = PW + GW, O_Q = PW + 2 * GW, O_K = O_Q + MW, O_VM = O_K + MW, O_O = O_VM + MW, O_IG = O_O + MW, O_FG = O_IG + MH;
    static constexpr int NC = SEQ / CH, NPC = BATCH * MH * NC, NSC = DEC_BATCH * MH, NCH = NPC + NSC;
    static constexpr int LCS = DEC_SEQ < CH ? DEC_SEQ : CH;
    static constexpr int GLP = SEQ < GCH ? SEQ : GCH, GLS = DEC_SEQ < GCH ? DEC_SEQ : GCH;
    static constexpr int NSS = 1 + 4 * DEPTH;
    static constexpr long OUT_YP = 0, OUT_YS = OUT_YP + (long)MP * D, OUT_POOLP = OUT_YS + (long)MS * D, OUT_POOLS = OUT_POOLP + (long)DEPTH * BATCH * PH * PW,
        OUT_CP = OUT_POOLS + (long)DEPTH * DEC_BATCH * PH * PW, OUT_NP = OUT_CP + (long)DEPTH * BATCH * MH * MHD * MHD, OUT_MP = OUT_NP + (long)DEPTH * BATCH * MH * MHD,
        OUT_CS = OUT_MP + (long)DEPTH * BATCH * MH, OUT_NS = OUT_CS + (long)DEPTH * DEC_BATCH * MH * MHD * MHD, OUT_MS = OUT_NS + (long)DEPTH * DEC_BATCH * MH * MHD,
        OUT_VS = OUT_MS + (long)DEPTH * DEC_BATCH * MH, OUT_MK = OUT_VS + (long)DEPTH * DEC_BATCH * DEC_SEQ * GW, OUT_MV = OUT_MK + (long)DEPTH * BATCH * NMEM * D,
        OUT_END = OUT_MV + (long)DEPTH * BATCH * NMEM * D;
    static constexpr size_t al(size_t x) { return (x + 255) & ~(size_t)255; }
    static constexpr size_t WS_CTL = 0, WS_SS = 65536, WS_X = al(WS_SS + (size_t)NSS * M * 4), WS_XB = al(WS_X + (size_t)M * D * 4),
        WS_BIG = al(WS_XB + (size_t)M * D * 2),
        WS_BIG_SZ = ((size_t)M * FF * 2 > (size_t)M * LDP * 4) ? (size_t)M * FF * 2 : (size_t)M * LDP * 4,
        WS_MIX = al(WS_BIG + WS_BIG_SZ), WS_Q = al(WS_MIX + (size_t)M * D * 2), WS_AO = al(WS_Q + (size_t)M * D * 2),
        WS_MEMB = al(WS_AO + (size_t)M * D * 2), WS_RSTDM = al(WS_MEMB + (size_t)MM * D * 2),
        WS_GB = al(WS_RSTDM + (size_t)MM * 4), WS_GA = al(WS_GB + (size_t)M * MH * 4),
        WS_CBL = al(WS_GA + (size_t)M * MH * 4), WS_CML = al(WS_CBL + (size_t)NCH * 4), WS_MPREV = al(WS_CML + (size_t)NCH * 4),
        WS_DC = al(WS_MPREV + (size_t)NCH * 4), WS_DN = al(WS_DC + (size_t)NCH * MHD * MHD * 4),
        WS_PART = al(WS_DN + (size_t)NCH * MHD * 4),
        WS_W = al(WS_PART + (size_t)256 * 65536 * 4);
    static constexpr size_t W_1IN = 0, W_1OUT = W_1IN + (size_t)2 * FF * D, W_IN = W_1OUT + (size_t)D * FF, W_OUT = W_IN + (size_t)LDP * D, W_Q = W_OUT + (size_t)D * D,
        W_KV = W_Q + (size_t)D * D, W_O = W_KV + (size_t)2 * D * D, W_2IN = W_O + (size_t)D * D, W_2OUT = W_2IN + (size_t)2 * FF * D, W_LAYER = W_2OUT + (size_t)D * FF;
    static constexpr size_t WS_END = al(WS_W + (size_t)DEPTH * W_LAYER * 2);
};

struct Ptrs { const float* in[33]; float* out; unsigned char* ws; };
enum { I_XP = 0, I_XS, I_MEM, I_SPOOL, I_SC, I_SN, I_SM, I_CK, I_CV, I_GFFN1, I_W1IN, I_W1OUT, I_GMIX, I_WIN, I_POOLW, I_POOLS, I_GVG, I_GWS, I_GBS, I_IB, I_FB, I_NG, I_WOUT,
       I_GX, I_GMEM, I_WQ, I_WK, I_WV, I_WO, I_GFFN2, I_W2IN, I_W2OUT, I_GFIN };

template <class C> HD inline float* wsf(const Ptrs& p, size_t off) { return (float*)(p.ws + off); }
template <class C> HD inline bf16_t* wsb(const Ptrs& p, size_t off) { return (bf16_t*)(p.ws + off); }
template <class C> HD inline bf16_t* wlayer(const Ptrs& p, int l, size_t off) { return (bf16_t*)(p.ws + C::WS_W) + (size_t)l * C::W_LAYER + off; }

template <class C> HD inline void row_info(int r, bool& s, int& b, int& t) {
    if (r < C::MP) { s = false; b = r / C::SEQ; t = r % C::SEQ; } else { s = true; const int q = r - C::MP; b = q / C::DEC_SEQ; t = q % C::DEC_SEQ; }
}
template <class C> HD inline void chunk_info(int r, int h, int& ci, int& i, int& lc) {
    bool s; int b, t; row_info<C>(r, s, b, t);
    if (!s) { ci = (b * C::MH + h) * C::NC + t / C::CH; i = t % C::CH; lc = C::CH; } else { ci = C::NPC + b * C::MH + h; i = t; lc = C::LCS; }
}
HD inline float sigmoidf_(float x) { return 1.0f / (1.0f + expf(-x)); }
HD inline float logsigmoidf_(float x) { return x >= 0.f ? -log1pf(expf(-x)) : x - log1pf(expf(x)); }

enum { WK_PLAIN = 0, WK_FFNIN = 1, WK_WIN = 2 };
template <class C> HD inline int wsrc_col(int kind, int n) {
    if (kind == WK_FFNIN) { const int pn = n >> 8, j = n & 255; return j < 128 ? 128 * pn + j : C::FF + 128 * pn + (j - 128); }
    if (kind == WK_WIN) return n < C::INC ? n : -1;
    return n;
}

template <class C> HD inline void st_ml_b0(const Ptrs& p, int l, int sq) {
    const float* CBL = wsf<C>(p, C::WS_CBL); const float* CML = wsf<C>(p, C::WS_CML); float* MPREV = wsf<C>(p, C::WS_MPREV);
    if (sq < C::BATCH * C::MH) { float m = 0.f;
        for (int c = 0; c < C::NC; ++c) { const int ci = sq * C::NC + c; MPREV[ci] = m; const float a = CBL[ci] + m, b2 = CML[ci]; m = a > b2 ? a : b2; }
        p.out[C::OUT_MP + (size_t)l * C::BATCH * C::MH + sq] = m;
    } else { const int q = sq - C::BATCH * C::MH, ci = C::NPC + q; const float m0 = p.in[I_SM][(size_t)l * C::DEC_BATCH * C::MH + q];
        MPREV[ci] = m0; const float a = CBL[ci] + m0, b2 = CML[ci]; p.out[C::OUT_MS + (size_t)l * C::DEC_BATCH * C::MH + q] = a > b2 ? a : b2; }
}

namespace pg8 {
#define PG8_LAS __attribute__((address_space(3)))
typedef unsigned short bf16_t;
typedef short bf16x8 __attribute__((ext_vector_type(8)));
typedef float f32x4 __attribute__((ext_vector_type(4)));
typedef unsigned u32x4 __attribute__((ext_vector_type(4)));
constexpr int BM = 256, BK = 64, HALF = 128, HTB = HALF * BK * 2  , STAGE_BYTES = 8 * HTB, NXCD = 8, WGM = 8;

__host__ __device__ __forceinline__ int lds_byte(int r, int c) { const int st = (r >> 4) * 2 + (c >> 5), rr = r & 15, cc = c & 31, ob = rr * 64 + cc * 2; return st * 1024 + (ob ^ (((ob >> 9) & 1) << 5)); }
__host__ __device__ __forceinline__ void stage_rc(int b, int& R, int& C) { const int st = b / 1024, sb = b % 1024, swz = sb ^ (((sb >> 9) & 1) << 5); R = (st >> 1) * 16 + swz / 64; C = (st & 1) * 32 + (swz % 64) / 2; }
__host__ __device__ __forceinline__ int perm32(int rho) { const int n = rho >> 4, i = rho & 15; return 8 * (i >> 2) + 4 * n + (i & 3); }

struct Unit { int pm, pn; };
struct Gemm { const bf16_t* A; const bf16_t* Bt; int M, N, K, ld; };

struct StaticOrder {
    int nM, nN, nwg, G, c;
    __host__ __device__ __forceinline__ void init(int M, int N, int G_, int c_, int rows_per_tile = BM) { nM = M / rows_per_tile; nN = N / BM; nwg = nM * nN; G = G_; c = c_; }
    __host__ __device__ __forceinline__ bool next(int i, Unit& u) const {
        const long L = (long)i * G + c; if (L >= nwg) return false;
        int wgid = (int)L; { const int q = nwg / NXCD, r = nwg % NXCD, xcd = wgid % NXCD, off = wgid / NXCD; wgid = (xcd < r ? xcd * (q + 1) : r * (q + 1) + (xcd - r) * q) + off; }
        const int nig = WGM * nN, gid = wgid / nig, fm = gid * WGM, gsz = (nM - fm) < WGM ? (nM - fm) : WGM;
        u.pm = fm + ((wgid % nig) % gsz); u.pn = (wgid % nig) / gsz; return true;
    }
    __device__ __forceinline__ void a_ready(const Unit&) const {}
    __device__ __forceinline__ void done(const Unit&) const {}
};
__device__ __forceinline__ unsigned cvt_pk_bf16(float lo, float hi) { unsigned r; asm volatile("v_cvt_pk_bf16_f32 %0, %1, %2" : "=v"(r) : "v"(lo), "v"(hi)); return r; }
typedef float f32x2 __attribute__((ext_vector_type(2)));
template <class Epi, class Sched, bool STRIP = false, bool STAMP = false>
__device__ __forceinline__ void gemm_phase(PG8_LAS unsigned char* lds, const Gemm g, const Sched& S, const Epi& E, unsigned long long* stamps) {
    int tid_l = threadIdx.x; asm volatile("" : "+v"(tid_l));
    const int tid = tid_l, wid = __builtin_amdgcn_readfirstlane(tid >> 6), lane = tid & 63, wr = wid >> 2, wc = wid & 3, fr = lane & 15, fq = lane >> 4;
    const int K = g.K, nt = K / BK;
    int ts_lo = 0, ts_hi = 0, nts = 0; const unsigned long long rt_entry = STAMP ? (unsigned long long)wall_clock64() : 0ull;
#define PG8_STAMP() do { if (STAMP && wid == 0 && nts < 64) { const unsigned long long _c = (unsigned long long)clock64(); \
        ts_lo = (lane == nts) ? (int)(unsigned)_c : ts_lo; ts_hi = (lane == nts) ? (int)(unsigned)(_c >> 32) : ts_hi; ++nts; } } while (0)
    PG8_STAMP();
    unsigned voffA[2], voffB[2];
#pragma unroll
    for (int i = 0; i < 2; ++i) { int R, C; stage_rc(tid * 16 + i * 8192, R, C); const int Rb = Epi::PERM ? ((R & ~31) + perm32(R & 31)) : R;
        voffA[i] = (unsigned)(R * g.ld + C) * 2u; voffB[i] = (unsigned)(Rb * g.ld + C) * 2u; }
    const size_t kstep = (size_t)(BK * 2);
    const size_t hstep = (size_t)HALF * g.ld * 2;
    const size_t tstep = 2 * hstep;
    const size_t tstepA = STRIP ? (size_t)288 * g.ld * 2 : tstep;
    unsigned voffS = 0u; if constexpr (STRIP) { int R, C; stage_rc((wid & 3) * 1024 + lane * 16, R, C); voffS = (unsigned)(R * g.ld + C) * 2u; }
    const int soff = lds_byte(wr * 16 + fr, fq * 8);
    const unsigned ldsw = (unsigned)wid * 1024u;
    const int aoff = lds_byte(wr * 64 + fr, fq * 8), boff = lds_byte(wc * 32 + fr, fq * 8);
#define PG8_SA(b, h) (((b) * 2 + (h)) * HTB)
#define PG8_SB(b, h) ((4 + (b) * 2 + (h)) * HTB)
#define PG8_SS(b) (8 * HTB + (b) * 8192)
#define PG8_STAGE_S(b, gbase) do { if constexpr (STRIP) __builtin_amdgcn_global_load_lds((const unsigned*)((const char*)(gbase) + 2 * hstep + voffS), (PG8_LAS unsigned*)(lds + PG8_SS(b) + ldsw), 16, 0, 0); } while (0)
#define PG8_LDS(b) do { if constexpr (STRIP) { _Pragma("unroll") for (int k = 0; k < 2; ++k) Sf[k] = *(const PG8_LAS bf16x8*)(lds + PG8_SS(b) + soff + k * 1024); } } while (0)
#define PG8_MMS(bj, Bt) do { if constexpr (STRIP) { _Pragma("unroll") for (int n = 0; n < 2; ++n) _Pragma("unroll") for (int k = 0; k < 2; ++k) accS[bj][n] = __builtin_amdgcn_mfma_f32_16x16x32_bf16(Bt[n][k], Sf[k], accS[bj][n], 0, 0, 0); } } while (0)
#define PG8_STAGE(bufoff, gbase, voff) do { _Pragma("unroll") for (int _i = 0; _i < 2; ++_i) \
        __builtin_amdgcn_global_load_lds((const unsigned*)((const char*)(gbase) + (voff)[_i]), (PG8_LAS unsigned*)(lds + (bufoff) + ldsw + _i * 8192), 16, 0, 0); } while (0)
#define PG8_LDA(dst, b, h) do { _Pragma("unroll") for (int m = 0; m < 4; ++m) _Pragma("unroll") for (int k = 0; k < 2; ++k) dst[m][k] = *(const PG8_LAS bf16x8*)(lds + PG8_SA(b, h) + aoff + m * 2048 + k * 1024); } while (0)
#define PG8_LDB(dst, b, h) do { _Pragma("unroll") for (int n = 0; n < 2; ++n) _Pragma("unroll") for (int k = 0; k < 2; ++k) dst[n][k] = *(const PG8_LAS bf16x8*)(lds + PG8_SB(b, h) + boff + n * 2048 + k * 1024); } while (0)
#define PG8_MMA(ai, bj, At, Bt) do { __builtin_amdgcn_s_setprio(1); _Pragma("unroll") for (int m = 0; m < 4; ++m) _Pragma("unroll") for (int n = 0; n < 2; ++n) _Pragma("unroll") for (int k = 0; k < 2; ++k) \
        acc[ai][bj][m][n] = __builtin_amdgcn_mfma_f32_16x16x32_bf16(Bt[n][k], At[m][k], acc[ai][bj][m][n], 0, 0, 0); __builtin_amdgcn_s_setprio(0); } while (0)
#define PG8_WAIT_V(n) asm volatile("s_waitcnt vmcnt(" #n ")" ::: "memory")
#define PG8_WAIT_L(n) asm volatile("s_waitcnt lgkmcnt(" #n ")" ::: "memory")
#define PG8_WAIT_VS(n, ns) do { if constexpr (STRIP) PG8_WAIT_V(ns); else PG8_WAIT_V(n); } while (0)
#define PG8_WAIT_LS(n, ns) do { if constexpr (STRIP) PG8_WAIT_L(ns); else PG8_WAIT_L(n); } while (0)
#define PG8_BAR __builtin_amdgcn_s_barrier()
#define PG8_SCHED __builtin_amdgcn_sched_barrier(0)
    Unit cur, nxt; int ui = 0;
    if (!S.next(0, cur)) return;
    f32x4 acc[2][2][4][2];
#pragma unroll
    for (int a = 0; a < 2; ++a)
#pragma unroll
        for (int b = 0; b < 2; ++b)
#pragma unroll
            for (int m = 0; m < 4; ++m)
#pragma unroll
                for (int n = 0; n < 2; ++n) acc[a][b][m][n] = (f32x4){0.f, 0.f, 0.f, 0.f};
    bf16x8 At[4][2], B0[2][2], B1[2][2];
    f32x4 accS[2][2]; bf16x8 Sf[2];
#pragma unroll
    for (int b = 0; b < 2; ++b)
#pragma unroll
        for (int n = 0; n < 2; ++n) accS[b][n] = (f32x4){0.f, 0.f, 0.f, 0.f};
#pragma unroll
    for (int k = 0; k < 2; ++k) Sf[k] = (bf16x8){0, 0, 0, 0, 0, 0, 0, 0};
    const char* cA = (const char*)g.A + (size_t)cur.pm * tstepA; const char* cB = (const char*)g.Bt + (size_t)cur.pn * tstep;
    S.a_ready(cur);
    PG8_STAGE(PG8_SB(0, 0), cB, voffB); PG8_STAGE(PG8_SA(0, 0), cA, voffA); PG8_STAGE(PG8_SB(0, 1), cB + hstep, voffB); PG8_STAGE(PG8_SA(0, 1), cA + hstep, voffA); PG8_STAGE_S(0, cA);
    if (wr == 1) PG8_BAR;
    PG8_WAIT_VS(4, 5); PG8_BAR;
    PG8_STAGE(PG8_SB(1, 0), cB + kstep, voffB); PG8_STAGE(PG8_SA(1, 0), cA + kstep, voffA); PG8_STAGE(PG8_SB(1, 1), cB + hstep + kstep, voffB); PG8_STAGE_S(1, cA + kstep);
    PG8_WAIT_VS(6, 7); PG8_BAR;
    PG8_STAMP();
    for (;;) {
        const bool has_next = S.next(ui + 1, nxt);
        const char* nA = has_next ? (const char*)g.A + (size_t)nxt.pm * tstepA : cA; const char* nB = has_next ? (const char*)g.Bt + (size_t)nxt.pn * tstep : cB;
        for (int t = 0; t < nt; t += 2) {
            const bool last = (t == nt - 2);
            const char* a1 = cA + (size_t)(t + 1) * kstep;
            const char* a2 = last ? nA : cA + (size_t)(t + 2) * kstep; const char* b2 = last ? nB : cB + (size_t)(t + 2) * kstep;
            const char* a3 = a2 + kstep; const char* b3 = b2 + kstep;
            if (last && has_next) S.a_ready(nxt);
            PG8_LDB(B0, 0, 0); PG8_SCHED; PG8_LDA(At, 0, 0); PG8_LDS(0); PG8_STAGE(PG8_SA(1, 1), a1 + hstep, voffA);
            PG8_WAIT_LS(8, 10); PG8_BAR; PG8_WAIT_L(0); PG8_MMA(0, 0, At, B0); PG8_MMS(0, B0); PG8_BAR; PG8_SCHED;
            PG8_LDB(B1, 0, 1); PG8_STAGE(PG8_SB(0, 0), b2, voffB);
            PG8_BAR; PG8_WAIT_L(0); PG8_MMA(0, 1, At, B1); PG8_MMS(1, B1); PG8_BAR;
            PG8_LDA(At, 0, 1); PG8_STAGE(PG8_SA(0, 0), a2, voffA); PG8_STAGE_S(0, a2);
            PG8_BAR; PG8_WAIT_L(0); PG8_MMA(1, 0, At, B0); PG8_BAR; PG8_SCHED;
            PG8_STAGE(PG8_SB(0, 1), b2 + hstep, voffB);
            PG8_WAIT_VS(6, 7); PG8_BAR; PG8_MMA(1, 1, At, B1); PG8_BAR;
            PG8_LDB(B0, 1, 0); PG8_SCHED; PG8_LDA(At, 1, 0); PG8_LDS(1); PG8_STAGE(PG8_SA(0, 1), a2 + hstep, voffA);
            PG8_WAIT_LS(8, 10); PG8_BAR; PG8_WAIT_L(0); PG8_MMA(0, 0, At, B0); PG8_MMS(0, B0); PG8_BAR; PG8_SCHED;
            PG8_LDB(B1, 1, 1); PG8_STAGE(PG8_SB(1, 0), b3, voffB);
            PG8_BAR; PG8_WAIT_L(0); PG8_MMA(0, 1, At, B1); PG8_MMS(1, B1); PG8_BAR;
            PG8_LDA(At, 1, 1); PG8_STAGE(PG8_SA(1, 0), a3, voffA); PG8_STAGE_S(1, a3);
            PG8_BAR; PG8_WAIT_L(0); PG8_MMA(1, 0, At, B0); PG8_BAR; PG8_SCHED;
            PG8_STAGE(PG8_SB(1, 1), b3 + hstep, voffB);
            PG8_WAIT_VS(6, 7); PG8_BAR; PG8_MMA(1, 1, At, B1); PG8_BAR;
        }
        PG8_STAMP();
        { const int rt0 = cur.pm * (STRIP ? 288 : 256);
#pragma unroll
          for (int ai = 0; ai < 2; ++ai)
#pragma unroll
            for (int m = 0; m < 4; ++m) { const f32x4 v[2][2] = {{acc[ai][0][m][0], acc[ai][0][m][1]}, {acc[ai][1][m][0], acc[ai][1][m][1]}}; E.row(v, rt0 + ai * HALF + wr * 64 + m * 16 + fr, cur.pn, wc, fq); }
          if constexpr (STRIP) { E.row(accS, rt0 + 256 + wr * 16 + fr, cur.pn, wc, fq);
#pragma unroll
            for (int b = 0; b < 2; ++b)
#pragma unroll
              for (int n = 0; n < 2; ++n) accS[b][n] = (f32x4){0.f, 0.f, 0.f, 0.f}; }
          S.done(cur); }
        PG8_STAMP();
        if (!has_next) break;
#pragma unroll
        for (int a = 0; a < 2; ++a)
#pragma unroll
            for (int b = 0; b < 2; ++b)
#pragma unroll
                for (int m = 0; m < 4; ++m)
#pragma unroll
                    for (int n = 0; n < 2; ++n) acc[a][b][m][n] = (f32x4){0.f, 0.f, 0.f, 0.f};
        cur = nxt; cA = nA; cB = nB; ++ui;
    }
    PG8_WAIT_V(0);
    if (wr == 0) PG8_BAR;
    PG8_BAR;
    PG8_STAMP();
    if (STAMP && wid == 0) { stamps[lane] = lane < nts ? (((unsigned long long)(unsigned)ts_hi << 32) | (unsigned)ts_lo) : 0ull;
        if (lane == 62) stamps[62] = rt_entry; if (lane == 63) stamps[63] = (unsigned long long)wall_clock64(); }
#undef PG8_STAMP
#undef PG8_SA
#undef PG8_SB
#undef PG8_STAGE
#undef PG8_LDA
#undef PG8_LDB
#undef PG8_MMA
#undef PG8_WAIT_V
#undef PG8_WAIT_L
#undef PG8_BAR
#undef PG8_SCHED
#undef PG8_WAIT_LS
#undef PG8_WAIT_VS
#undef PG8_MMS
#undef PG8_LDS
#undef PG8_STAGE_S
#undef PG8_SS
}
}


#define LAS __attribute__((address_space(3)))
#define XB_TMO      128
#define XB_XCNT(j)  (256  + 64 * (j))
#define XB_XSUB(j)  (1280 + 64 * (j))
#define XB_XGEN(j)  (2304 + 64 * (j))
#define XB_TOP      3328
#define XB_TOPGEN   3392
#define XCD_BAR_WORDS 3456
#define XB_SPIN_CAP (1u << 18)

__device__ __forceinline__ unsigned xb_ld(unsigned* p)              { return __hip_atomic_load(p, __ATOMIC_RELAXED, __HIP_MEMORY_SCOPE_AGENT); }
__device__ __forceinline__ unsigned xb_add(unsigned* p, unsigned v) { return __hip_atomic_fetch_add(p, v, __ATOMIC_RELAXED, __HIP_MEMORY_SCOPE_AGENT); }
__device__ __forceinline__ unsigned xb_xcc_id() { return (unsigned)__builtin_amdgcn_s_getreg((3 << 11) | 20) & 0xFu; }
#define XB_SPIN(cond, bar) do { unsigned _sp = 0; while (cond) { __builtin_amdgcn_s_sleep(1); \
    if ((++_sp & 255u) == 0u) { if (xb_ld(&(bar)[XB_TMO])) break; if (_sp > XB_SPIN_CAP) { atomicAdd(&(bar)[XB_TMO], 1u); break; } } } } while (0)

struct XcdBarrier {
    unsigned* bar; unsigned x;
    volatile LAS unsigned* st;
};

__device__ __forceinline__ XcdBarrier xcd_barrier_post(unsigned* bar, volatile LAS unsigned* st) {
    XcdBarrier b; b.bar = bar; b.x = xb_xcc_id(); b.st = st;
    if (threadIdx.x == 0) (void)xb_add(&bar[XB_XCNT(b.x)], 1u);
    return b;
}
__device__ __forceinline__ void xcd_barrier_complete(unsigned* bar, unsigned x, unsigned& nloc, unsigned& nx) {
    const unsigned G = gridDim.x * gridDim.y * gridDim.z;
    unsigned sum, cnt, mine, sp = 0u;
    for (;;) {
        sum = 0u; cnt = 0u; mine = 0u;
#pragma unroll
        for (unsigned j = 0; j < 16; ++j) { const unsigned c = xb_ld(&bar[XB_XCNT(j)]); sum += c; cnt += (c > 0u) ? 1u : 0u; mine = (j == x) ? c : mine; }
        if (sum == G) break;
        __builtin_amdgcn_s_sleep(1);
        if ((++sp & 255u) == 0u) { if (xb_ld(&bar[XB_TMO])) break; if (sp > XB_SPIN_CAP) { atomicAdd(&bar[XB_TMO], 1u); break; } }
    }
    nloc = mine > 0u ? mine : 1u; nx = cnt > 0u ? cnt : 1u;
}

__device__ __forceinline__ void xcd_barrier(const XcdBarrier& b) {
    asm volatile("s_waitcnt vmcnt(0)" ::: "memory");
    __syncthreads();
    if (threadIdx.x == 0) {
        unsigned* bar = b.bar;
        __builtin_amdgcn_s_waitcnt(0);
        unsigned nloc = b.st[0], nx = b.st[1];
        if (nloc == 0u) { xcd_barrier_complete(bar, b.x, nloc, nx); b.st[0] = nloc; b.st[1] = nx; }
        const unsigned old = xb_add(&bar[XB_XSUB(b.x)], 1u);
        const unsigned gen = old / nloc;
        if (old + 1u == (gen + 1u) * nloc) {
            __builtin_amdgcn_fence(__ATOMIC_RELEASE, "agent");
            asm volatile("s_waitcnt vmcnt(0)" ::: "memory");
            const unsigned og = xb_add(&bar[XB_TOP], 1u);
            const unsigned tg = og / nx;
            if (og + 1u == (tg + 1u) * nx) xb_add(&bar[XB_TOPGEN], 1u);
            else XB_SPIN(xb_ld(&bar[XB_TOPGEN]) == tg, bar);
            __builtin_amdgcn_fence(__ATOMIC_ACQUIRE, "agent");
            xb_add(&bar[XB_XGEN(b.x)], 1u);
            asm volatile("s_waitcnt vmcnt(0)" ::: "memory");
        } else {
            XB_SPIN(xb_ld(&bar[XB_XGEN(b.x)]) == gen, bar);
            __builtin_amdgcn_fence(__ATOMIC_ACQUIRE, "agent");
            asm volatile("s_waitcnt vmcnt(0)" ::: "memory");
        }
    }
    __syncthreads();
}

typedef CfgT<RC> C;
constexpr int NTHREADS = 512, NWAVES = 8;
constexpr int LDS_STAGE = 131072 + 16384, LDS_CTL = LDS_STAGE, LDS_BYTES = LDS_STAGE + 256;

namespace pg8 {
typedef unsigned u32x2 __attribute__((ext_vector_type(2)));
__device__ __forceinline__ float silu_f(float g) { return g * __builtin_amdgcn_rcpf(1.0f + __expf(-g)); }
struct EpiSwiGLU { static constexpr bool PERM = true;
    bf16_t* act; const float* ss; int ff; float invd;
    __device__ __forceinline__ void row(const f32x4 (&v)[2][2], int row, int pn, int wc, int fq) const {
        const float rs = rsqrtf(ss[row] * invd + 1e-6f); f32x4 o[2];
#pragma unroll
        for (int n = 0; n < 2; ++n) { const f32x4 g = v[0][n] * rs, up = v[1][n] * rs;
#pragma unroll
            for (int j = 0; j < 4; ++j) o[n][j] = silu_f(g[j]) * up[j]; }
        u32x4 w; w.x = cvt_pk_bf16(o[0][0], o[0][1]); w.y = cvt_pk_bf16(o[0][2], o[0][3]); w.z = cvt_pk_bf16(o[1][0], o[1][1]); w.w = cvt_pk_bf16(o[1][2], o[1][3]);
        *(u32x4*)(act + (size_t)row * ff + pn * 128 + wc * 32 + 8 * fq) = w;
    }
};
struct EpiResid { static constexpr bool PERM = false;
    float* X; bf16_t* XB; float* ssout; float scale; int ld;
    __device__ __forceinline__ void row(const f32x4 (&v)[2][2], int row, int pn, int wc, int fq) const {
        const int col0 = pn * BM + wc * 32 + 4 * fq; float* xr = X + (size_t)row * ld + col0; bf16_t* br = XB + (size_t)row * ld + col0; float s = 0.f;
#pragma unroll
        for (int bj = 0; bj < 2; ++bj)
#pragma unroll
            for (int n = 0; n < 2; ++n) { const f32x4 x = *(const f32x4*)(xr + bj * HALF + n * 16) + v[bj][n] * scale; *(f32x4*)(xr + bj * HALF + n * 16) = x;
                u32x2 w; w.x = cvt_pk_bf16(x[0], x[1]); w.y = cvt_pk_bf16(x[2], x[3]); *(u32x2*)(br + bj * HALF + n * 16) = w;
                s += (x[0] * x[0] + x[1] * x[1]) + (x[2] * x[2] + x[3] * x[3]); }
        s += __shfl_xor(s, 16); s += __shfl_xor(s, 32);
        if (fq == 0) unsafeAtomicAdd(ssout + row, s);
    }
};
struct EpiScaleF32 { static constexpr bool PERM = false;
    float* Cp; int ldc; const float* ss; float invd;
    __device__ __forceinline__ void row(const f32x4 (&v)[2][2], int row, int pn, int wc, int fq) const {
        const float rs = rsqrtf(ss[row] * invd + 1e-6f); float* cr = Cp + (size_t)row * ldc + pn * BM + wc * 32 + 4 * fq;
#pragma unroll
        for (int bj = 0; bj < 2; ++bj)
#pragma unroll
            for (int n = 0; n < 2; ++n) *(f32x4*)(cr + bj * HALF + n * 16) = v[bj][n] * rs;
    }
};
struct EpiScaleBf16 { static constexpr bool PERM = true;
    bf16_t* O; int ldc; const float* ss; float invd;
    __device__ __forceinline__ void row(const f32x4 (&v)[2][2], int row, int pn, int wc, int fq) const {
        const float rs = rsqrtf(ss[row] * invd + 1e-6f); bf16_t* orow = O + (size_t)row * ldc + pn * BM + wc * 32 + 8 * fq;
#pragma unroll
        for (int bj = 0; bj < 2; ++bj) { const f32x4 v0 = v[bj][0] * rs, v1 = v[bj][1] * rs;
            u32x4 w; w.x = cvt_pk_bf16(v0[0], v0[1]); w.y = cvt_pk_bf16(v0[2], v0[3]); w.z = cvt_pk_bf16(v1[0], v1[1]); w.w = cvt_pk_bf16(v1[2], v1[3]);
            *(u32x4*)(orow + bj * HALF) = w; }
    }
};
struct EpiMemKV { static constexpr bool PERM = false;
    float* K; float* V; const float* rstd; int d;
    __device__ __forceinline__ void row(const f32x4 (&v)[2][2], int row, int pn, int wc, int fq) const {
        int ct = pn * BM; float* base = K; if (ct >= d) { base = V; ct -= d; }
        const float rs = rstd[row]; float* cr = base + (size_t)row * d + ct + wc * 32 + 4 * fq;
#pragma unroll
        for (int bj = 0; bj < 2; ++bj)
#pragma unroll
            for (int n = 0; n < 2; ++n) *(f32x4*)(cr + bj * HALF + n * 16) = v[bj][n] * rs;
    }
};
}

__device__ __forceinline__ void prep_item(const float* W, int K, int Ncols, const float* g, int kind, int N, bf16_t* Bt, int item, int lane) {
    const int nblk = N / 64, kb = item / nblk, nb = item % nblk, k0 = 64 * kb, n = 64 * nb + lane;
    const int sc = wsrc_col<C>(kind, n);
    const float* src = W + (size_t)k0 * Ncols + (sc >= 0 ? sc : 0);
    float v[64];
#pragma unroll
    for (int kk = 0; kk < 64; ++kk) v[kk] = src[(size_t)kk * Ncols];
    if (g) {
#pragma unroll
        for (int kk = 0; kk < 64; ++kk) v[kk] *= g[k0 + kk];
    }
    if (sc < 0) {
#pragma unroll
        for (int kk = 0; kk < 64; ++kk) v[kk] = 0.f;
    }
    bf16_t* dst = Bt + (size_t)n * K + k0;
#pragma unroll
    for (int j = 0; j < 8; ++j) { pg8::u32x4 o; o.x = pg8::cvt_pk_bf16(v[8 * j], v[8 * j + 1]); o.y = pg8::cvt_pk_bf16(v[8 * j + 2], v[8 * j + 3]); o.z = pg8::cvt_pk_bf16(v[8 * j + 4], v[8 * j + 5]); o.w = pg8::cvt_pk_bf16(v[8 * j + 6], v[8 * j + 7]);
        *(pg8::u32x4*)(dst + 8 * j) = o; }
}
struct WDesc { const float* W; const float* g; bf16_t* dst; int K, Ncols, kind, N; };
__device__ __forceinline__ WDesc wdesc(const Ptrs& p, int l, int idx) {
    WDesc d; d.g = nullptr; d.kind = WK_PLAIN;
    switch (idx) {
    case 0: d.W = p.in[I_W1IN] + (size_t)l * C::D * 2 * C::FF; d.K = C::D; d.Ncols = 2 * C::FF; d.N = 2 * C::FF; d.g = p.in[I_GFFN1] + l * C::D; d.kind = WK_FFNIN; d.dst = wlayer<C>(p, l, C::W_1IN); break;
    case 1: d.W = p.in[I_W1OUT] + (size_t)l * C::FF * C::D; d.K = C::FF; d.Ncols = C::D; d.N = C::D; d.dst = wlayer<C>(p, l, C::W_1OUT); break;
    case 2: d.W = p.in[I_WIN] + (size_t)l * C::D * C::INC; d.K = C::D; d.Ncols = C::INC; d.N = C::LDP; d.g = p.in[I_GMIX] + l * C::D; d.kind = WK_WIN; d.dst = wlayer<C>(p, l, C::W_IN); break;
    case 3: d.W = p.in[I_WOUT] + (size_t)l * C::D * C::D; d.K = C::D; d.Ncols = C::D; d.N = C::D; d.dst = wlayer<C>(p, l, C::W_OUT); break;
    case 4: d.W = p.in[I_WQ] + (size_t)l * C::D * C::D; d.K = C::D; d.Ncols = C::D; d.N = C::D; d.g = p.in[I_GX] + l * C::D; d.dst = wlayer<C>(p, l, C::W_Q); break;
    case 5: d.W = p.in[I_WK] + (size_t)l * C::D * C::D; d.K = C::D; d.Ncols = C::D; d.N = C::D; d.g = p.in[I_GMEM] + l * C::D; d.dst = wlayer<C>(p, l, C::W_KV); break;
    case 6: d.W = p.in[I_WV] + (size_t)l * C::D * C::D; d.K = C::D; d.Ncols = C::D; d.N = C::D; d.g = p.in[I_GMEM] + l * C::D; d.dst = wlayer<C>(p, l, C::W_KV) + (size_t)C::D * C::D; break;
    case 7: d.W = p.in[I_WO] + (size_t)l * C::D * C::D; d.K = C::D; d.Ncols = C::D; d.N = C::D; d.dst = wlayer<C>(p, l, C::W_O); break;
    case 8: d.W = p.in[I_W2IN] + (size_t)l * C::D * 2 * C::FF; d.K = C::D; d.Ncols = 2 * C::FF; d.N = 2 * C::FF; d.g = p.in[I_GFFN2] + l * C::D; d.kind = WK_FFNIN; d.dst = wlayer<C>(p, l, C::W_2IN); break;
    default: d.W = p.in[I_W2OUT] + (size_t)l * C::FF * C::D; d.K = C::FF; d.Ncols = C::D; d.N = C::D; d.dst = wlayer<C>(p, l, C::W_2OUT); break;
    }
    return d;
}

namespace att {
typedef short bf16x8 __attribute__((ext_vector_type(8)));
typedef short s16x4 __attribute__((ext_vector_type(4)));
typedef float f32x4 __attribute__((ext_vector_type(4)));
typedef unsigned u32x2 __attribute__((ext_vector_type(2)));
constexpr int TOK = 256, CD = 64, PITCH = 144, CBYTES = TOK * PITCH, HDIM = 512, NH = 4, LD = 2048;
constexpr int NU_P = (C::MP / 128) * NH, NU_S = C::DEC_BATCH * NH, NUNITS = NU_P + NU_S;
static_assert(C::NMEM == TOK && C::AHD == HDIM && C::AH == NH && C::D == LD && C::DEC_SEQ == 32 && C::SEQ % 128 == 0, "attention phase is built for these shapes");
__device__ __forceinline__ s16x4 tr_read(unsigned addr) { s16x4 r; asm volatile("ds_read_b64_tr_b16 %0, %1" : "=&v"(r) : "v"(addr) : "memory"); return r; }
__device__ __forceinline__ void stage_load(f32x4 (&r)[8], const float* src, int tid) {
#pragma unroll
    for (int i = 0; i < 8; ++i) { const int f = tid + 512 * i; r[i] = *(const f32x4*)(src + (size_t)(f >> 4) * LD + (f & 15) * 4); }
}
__device__ __forceinline__ void stage_store(const f32x4 (&r)[8], LAS unsigned char* buf, int tid) {
#pragma unroll
    for (int i = 0; i < 8; ++i) { const int f = tid + 512 * i; u32x2 w; w.x = pg8::cvt_pk_bf16(r[i][0], r[i][1]); w.y = pg8::cvt_pk_bf16(r[i][2], r[i][3]);
        *(LAS u32x2*)(buf + (f >> 4) * PITCH + (f & 15) * 8) = w; }
}
__device__ __forceinline__ void attn_phase(LAS unsigned char* lds, const Ptrs& p, int l, int tid) {
    const int lane = tid & 63, wave = __builtin_amdgcn_readfirstlane(tid >> 6), li = lane & 15, g = lane >> 4;
    const bf16_t* Qg = wsb<C>(p, C::WS_Q); bf16_t* AO = wsb<C>(p, C::WS_AO);
    for (int u = blockIdx.x; u < NUNITS; u += gridDim.x) {
        int row0, nrows, head; const float* kb; const float* vb;
        if (u < NU_P) { const int b = u / (NU_P / C::BATCH), rem = u % (NU_P / C::BATCH); head = rem / (C::SEQ / 128); const int qt = rem % (C::SEQ / 128);
            row0 = b * C::SEQ + qt * 128; nrows = 128;
            kb = p.out + C::OUT_MK + ((size_t)l * C::BATCH + b) * TOK * LD + head * HDIM; vb = p.out + C::OUT_MV + ((size_t)l * C::BATCH + b) * TOK * LD + head * HDIM; }
        else { const int s = u - NU_P, b = s / NH; head = s % NH; row0 = C::MP + b * C::DEC_SEQ; nrows = C::DEC_SEQ;
            kb = p.in[I_CK] + ((size_t)l * C::DEC_BATCH + b) * TOK * LD + head * HDIM; vb = p.in[I_CV] + ((size_t)l * C::DEC_BATCH + b) * TOK * LD + head * HDIM; }
        const bool active = wave * 16 < nrows;
        const int qrow = row0 + wave * 16 + li;
        bf16x8 qf[16];
        if (active) {
#pragma unroll
            for (int ks = 0; ks < 16; ++ks) qf[ks] = *(const bf16x8*)(Qg + (size_t)qrow * LD + head * HDIM + ks * 32 + g * 8);
        } else {
#pragma unroll
            for (int ks = 0; ks < 16; ++ks) qf[ks] = (bf16x8){0, 0, 0, 0, 0, 0, 0, 0};
        }
        f32x4 s[16];
#pragma unroll
        for (int T = 0; T < 16; ++T) s[T] = (f32x4){0.f, 0.f, 0.f, 0.f};
        f32x4 pre[8];
        stage_load(pre, kb, tid); stage_store(pre, lds, tid);
        __syncthreads();
#pragma unroll
        for (int c = 0; c < 8; ++c) {
            LAS unsigned char* buf = lds + (c & 1) * CBYTES;
            stage_load(pre, c < 7 ? kb + (c + 1) * CD : vb, tid);
            if (active) {
#pragma unroll
                for (int ks = 0; ks < 2; ++ks)
#pragma unroll
                    for (int T = 0; T < 16; ++T) { const bf16x8 a = *(const LAS bf16x8*)(buf + (T * 16 + li) * PITCH + ks * 64 + g * 16);
                        s[T] = __builtin_amdgcn_mfma_f32_16x16x32_bf16(a, qf[2 * c + ks], s[T], 0, 0, 0); }
            }
            stage_store(pre, lds + ((c + 1) & 1) * CBYTES, tid);
            __syncthreads();
        }
        float mx = -3.0e38f;
#pragma unroll
        for (int T = 0; T < 16; ++T) { mx = fmaxf(mx, fmaxf(fmaxf(s[T][0], s[T][1]), fmaxf(s[T][2], s[T][3]))); }
        mx = fmaxf(mx, __shfl_xor(mx, 16)); mx = fmaxf(mx, __shfl_xor(mx, 32));
        const float sc = 0.044194173824159216f * 1.4426950408889634f;
        float sum = 0.f;
#pragma unroll
        for (int T = 0; T < 16; ++T)
#pragma unroll
            for (int j = 0; j < 4; ++j) { const float e = __builtin_amdgcn_exp2f((s[T][j] - mx) * sc); s[T][j] = e; sum += e; }
        sum += __shfl_xor(sum, 16); sum += __shfl_xor(sum, 32);
        const float inv = 1.0f / sum;
        bf16x8 pf[8];
#pragma unroll
        for (int t = 0; t < 8; ++t) { const unsigned w0 = pg8::cvt_pk_bf16(s[2 * t][0], s[2 * t][1]), w1 = pg8::cvt_pk_bf16(s[2 * t][2], s[2 * t][3]),
                w2 = pg8::cvt_pk_bf16(s[2 * t + 1][0], s[2 * t + 1][1]), w3 = pg8::cvt_pk_bf16(s[2 * t + 1][2], s[2 * t + 1][3]);
            pg8::u32x4 w; w.x = w0; w.y = w1; w.z = w2; w.w = w3; pf[t] = __builtin_bit_cast(bf16x8, w); }
        const unsigned trb = (unsigned)(size_t)lds + (unsigned)((4 * g + (li >> 2)) * PITCH + (li & 3) * 8);
        for (int c = 0; c < 8; ++c) {
            const unsigned bofs = (unsigned)(c & 1) * CBYTES;
            if (c < 7) stage_load(pre, vb + (c + 1) * CD, tid);
            if (active) {
                f32x4 o[4];
#pragma unroll
                for (int dt = 0; dt < 4; ++dt) o[dt] = (f32x4){0.f, 0.f, 0.f, 0.f};
#pragma unroll
                for (int t = 0; t < 8; ++t) {
                    s16x4 lo[4], hi[4];
#pragma unroll
                    for (int dt = 0; dt < 4; ++dt) { lo[dt] = tr_read(trb + bofs + (unsigned)(t * 32 * PITCH + dt * 32)); hi[dt] = tr_read(trb + bofs + (unsigned)(t * 32 * PITCH + 16 * PITCH + dt * 32)); }
                    asm volatile("s_waitcnt lgkmcnt(0)" ::: "memory"); __builtin_amdgcn_sched_barrier(0);
#pragma unroll
                    for (int dt = 0; dt < 4; ++dt) { const bf16x8 a = (bf16x8){lo[dt][0], lo[dt][1], lo[dt][2], lo[dt][3], hi[dt][0], hi[dt][1], hi[dt][2], hi[dt][3]};
                        o[dt] = __builtin_amdgcn_mfma_f32_16x16x32_bf16(a, pf[t], o[dt], 0, 0, 0); }
                }
#pragma unroll
                for (int dt = 0; dt < 4; ++dt) { u32x2 w; w.x = pg8::cvt_pk_bf16(o[dt][0] * inv, o[dt][1] * inv); w.y = pg8::cvt_pk_bf16(o[dt][2] * inv, o[dt][3] * inv);
                    *(u32x2*)(AO + (size_t)qrow * LD + head * HDIM + c * CD + dt * 16 + g * 4) = w; }
            }
            if (c < 7) stage_store(pre, lds + ((c + 1) & 1) * CBYTES, tid);
            __syncthreads();
        }
    }
}
}
namespace mx {
typedef att::bf16x8 bf16x8; typedef att::s16x4 s16x4; typedef att::f32x4 f32x4; typedef att::u32x2 u32x2;
constexpr int PT = 272;
constexpr int T64 = 64 * PT, T128 = 128 * PT;
static_assert(C::MHD == 128 && C::CH == 64 && C::MH == 8 && C::LCS == 32, "mLSTM phases are built for these shapes");
__device__ __forceinline__ void lds_wait() { asm volatile("s_waitcnt lgkmcnt(0)" ::: "memory"); __builtin_amdgcn_sched_barrier(0); }
__device__ __forceinline__ bf16x8 mk8(s16x4 lo, s16x4 hi) { return (bf16x8){lo[0], lo[1], lo[2], lo[3], hi[0], hi[1], hi[2], hi[3]}; }
__device__ __forceinline__ unsigned tr_addr(unsigned tile, int krow, int c0, int li) { return tile + (unsigned)((krow + (li >> 2)) * PT + (c0 + 4 * (li & 3)) * 2); }
__device__ __forceinline__ void ch_decode(int ci, int& r0, int& h, int& lc) {
    if (ci < C::NPC) { const int c = ci % C::NC, bh = ci / C::NC; h = bh % C::MH; r0 = (bh / C::MH) * C::SEQ + c * C::CH; lc = C::CH; }
    else { const int q = ci - C::NPC; h = q % C::MH; r0 = C::MP + (q / C::MH) * C::DEC_SEQ; lc = C::LCS; }
}
__device__ __forceinline__ void stage64(LAS unsigned char* tile, const float* src, int ld, int lc, int tid, const LAS float* rs, float mul) {
#pragma unroll
    for (int i = 0; i < 4; ++i) { const int f = tid + 512 * i, row = f >> 5, c4 = f & 31; f32x4 v = (f32x4){0.f, 0.f, 0.f, 0.f};
        if (row < lc) { v = *(const f32x4*)(src + (size_t)row * ld + c4 * 4); const float m = rs ? rs[row] * mul : mul; v = v * m; }
        u32x2 w; w.x = pg8::cvt_pk_bf16(v[0], v[1]); w.y = pg8::cvt_pk_bf16(v[2], v[3]); *(LAS u32x2*)(tile + row * PT + c4 * 8) = w; }
}
__device__ __forceinline__ void ml_phase_a(LAS unsigned char* lds, const Ptrs& p, int l, int tid) {
    const int lane = tid & 63, wave = __builtin_amdgcn_readfirstlane(tid >> 6), li = lane & 15, g = lane >> 4;
    LAS unsigned char* Ks = lds; LAS unsigned char* Vs = lds + T64; LAS float* wts = (LAS float*)(lds + 2 * T64);
    const float* P = wsf<C>(p, C::WS_BIG);
    for (int ci = blockIdx.x; ci < C::NCH; ci += gridDim.x) {
        int r0, h, lc; ch_decode(ci, r0, h, lc);
        if (wave == 0) {
            float lf = 0.f, ig = -3.0e38f;
            if (lane < lc) { const float* pr = P + (size_t)(r0 + lane) * C::LDP; ig = pr[C::O_IG + h] + p.in[I_IB][l * C::MH + h]; lf = logsigmoidf_(pr[C::O_FG + h] + p.in[I_FB][l * C::MH + h]); }
            float b = lf;
#pragma unroll
            for (int o = 1; o < 64; o <<= 1) { const float t = __shfl_up(b, o); if (lane >= o) b += t; }
            const float a = lane < lc ? ig - b : -3.0e38f;
            float amax = a;
#pragma unroll
            for (int o = 1; o < 64; o <<= 1) amax = fmaxf(amax, __shfl_xor(amax, o));
            const float bL = __shfl(b, lc - 1), mloc = bL + amax;
            const float wt = lane < lc ? __expf(bL + a - mloc) : 0.f;
            wts[lane] = wt;
            if (lane < lc) { wsf<C>(p, C::WS_GB)[(size_t)(r0 + lane) * C::MH + h] = b; wsf<C>(p, C::WS_GA)[(size_t)(r0 + lane) * C::MH + h] = a; }
            if (lane == 0) { wsf<C>(p, C::WS_CBL)[ci] = bL; wsf<C>(p, C::WS_CML)[ci] = mloc; }
        }
        __syncthreads();
        stage64(Ks, P + (size_t)r0 * C::LDP + C::O_K + h * C::MHD, C::LDP, lc, tid, wts, 0.08838834764831845f);
        stage64(Vs, P + (size_t)r0 * C::LDP + C::O_VM + h * C::MHD, C::LDP, lc, tid, nullptr, 1.0f);
        __syncthreads();
        f32x4 acc[8];
#pragma unroll
        for (int et = 0; et < 8; ++et) acc[et] = (f32x4){0.f, 0.f, 0.f, 0.f};
        const unsigned ks = (unsigned)(size_t)Ks, vs = (unsigned)(size_t)Vs;
#pragma unroll
        for (int t = 0; t < 2; ++t) {
            const s16x4 alo = att::tr_read(tr_addr(ks, 32 * t + 8 * g, 16 * wave, li)), ahi = att::tr_read(tr_addr(ks, 32 * t + 8 * g + 4, 16 * wave, li));
            s16x4 blo[8], bhi[8];
#pragma unroll
            for (int et = 0; et < 8; ++et) { blo[et] = att::tr_read(tr_addr(vs, 32 * t + 8 * g, 16 * et, li)); bhi[et] = att::tr_read(tr_addr(vs, 32 * t + 8 * g + 4, 16 * et, li)); }
            lds_wait();
            const bf16x8 a = mk8(alo, ahi);
#pragma unroll
            for (int et = 0; et < 8; ++et) acc[et] = __builtin_amdgcn_mfma_f32_16x16x32_bf16(a, mk8(blo[et], bhi[et]), acc[et], 0, 0, 0);
        }
        float* DC = wsf<C>(p, C::WS_DC) + (size_t)ci * C::MHD * C::MHD;
#pragma unroll
        for (int et = 0; et < 8; ++et)
#pragma unroll
            for (int r = 0; r < 4; ++r) DC[(size_t)(16 * wave + 4 * g + r) * C::MHD + 16 * et + li] = acc[et][r];
        if (tid < C::MHD) { float s = 0.f; for (int t = 0; t < 64; ++t) s += bf2f(*(const LAS bf16_t*)(Ks + t * PT + tid * 2)); wsf<C>(p, C::WS_DN)[(size_t)ci * C::MHD + tid] = s; }
        __syncthreads();
    }
}
__device__ __forceinline__ void ml_phase_c(LAS unsigned char* lds, const Ptrs& p, int l, int tid) {
    const int lane = tid & 63, wave = __builtin_amdgcn_readfirstlane(tid >> 6), li = lane & 15, g = lane >> 4, it = wave & 3, eh = wave >> 2;
    LAS unsigned char* Qs = lds; LAS unsigned char* Ks = lds + T64; LAS unsigned char* Vs = lds + 2 * T64; LAS unsigned char* Cs = lds + 3 * T64;
    LAS float* sb = (LAS float*)(lds + 3 * T64 + T128);
    LAS float* sa = sb + 64; LAS float* smr = sb + 128; LAS float* siw = sb + 192; LAS float* snp = sb + 256; LAS float* ssq = sb + 384;
    const float* P = wsf<C>(p, C::WS_BIG);
    for (int ci = blockIdx.x; ci < C::NCH; ci += gridDim.x) {
        int r0, h, lc; ch_decode(ci, r0, h, lc);
        const bool sample = ci >= C::NPC, first = !sample && (ci % C::NC) == 0;
        const float mprev = wsf<C>(p, C::WS_MPREV)[ci];
        if (wave == 0) {
            float b = 0.f, a = -3.0e38f;
            if (lane < lc) { b = wsf<C>(p, C::WS_GB)[(size_t)(r0 + lane) * C::MH + h]; a = wsf<C>(p, C::WS_GA)[(size_t)(r0 + lane) * C::MH + h]; }
            float pm = a;
#pragma unroll
            for (int o = 1; o < 64; o <<= 1) { const float t = __shfl_up(pm, o); if (lane >= o) pm = fmaxf(pm, t); }
            const float mrow = b + fmaxf(mprev, pm);
            sb[lane] = b; sa[lane] = a; smr[lane] = mrow; siw[lane] = __expf(b + mprev - mrow);
        }
        if (tid >= 128 && tid < 256) { const int d = tid - 128;
            snp[d] = sample ? p.in[I_SN][((size_t)l * C::NSC + (ci - C::NPC)) * C::MHD + d] : (first ? 0.f : wsf<C>(p, C::WS_DN)[(size_t)(ci - 1) * C::MHD + d]); }
        stage64(Qs, P + (size_t)r0 * C::LDP + C::O_Q + h * C::MHD, C::LDP, lc, tid, nullptr, 1.0f);
        stage64(Ks, P + (size_t)r0 * C::LDP + C::O_K + h * C::MHD, C::LDP, lc, tid, nullptr, 0.08838834764831845f);
        stage64(Vs, P + (size_t)r0 * C::LDP + C::O_VM + h * C::MHD, C::LDP, lc, tid, nullptr, 1.0f);
        { const float* cp = sample ? p.in[I_SC] + ((size_t)l * C::NSC + (ci - C::NPC)) * C::MHD * C::MHD : wsf<C>(p, C::WS_DC) + (size_t)(first ? ci : ci - 1) * C::MHD * C::MHD;
#pragma unroll
            for (int i = 0; i < 8; ++i) { const int f = tid + 512 * i, row = f >> 5, c4 = f & 31; f32x4 v = (f32x4){0.f, 0.f, 0.f, 0.f};
                if (!first) v = *(const f32x4*)(cp + (size_t)row * C::MHD + c4 * 4);
                u32x2 w; w.x = pg8::cvt_pk_bf16(v[0], v[1]); w.y = pg8::cvt_pk_bf16(v[2], v[3]); *(LAS u32x2*)(Cs + row * PT + c4 * 8) = w; } }
        __syncthreads();
        const bool active = it * 16 < lc;
        float ssq_part = 0.f; f32x4 hv[4]; float inv_den = 0.f;
        const int i = 16 * it + li;
        if (active) {
            bf16x8 qf[4];
#pragma unroll
            for (int ks = 0; ks < 4; ++ks) qf[ks] = *(const LAS bf16x8*)(Qs + i * PT + ks * 64 + g * 16);
            f32x4 st[4];
#pragma unroll
            for (int jt = 0; jt < 4; ++jt) st[jt] = (f32x4){0.f, 0.f, 0.f, 0.f};
#pragma unroll
            for (int jt = 0; jt < 4; ++jt) if (jt <= it) {
#pragma unroll
                for (int ks = 0; ks < 4; ++ks) { const bf16x8 a = *(const LAS bf16x8*)(Ks + (16 * jt + li) * PT + ks * 64 + g * 16);
                    st[jt] = __builtin_amdgcn_mfma_f32_16x16x32_bf16(a, qf[ks], st[jt], 0, 0, 0); } }
            const float bi = sb[i], mri = smr[i], iwi = siw[i];
            float dsum = 0.f;
#pragma unroll
            for (int jt = 0; jt < 4; ++jt)
#pragma unroll
                for (int r = 0; r < 4; ++r) { const int j = 16 * jt + 4 * g + r; const float w = (j <= i) ? __expf(bi + sa[j] - mri) : 0.f; st[jt][r] *= w; dsum += st[jt][r]; }
            dsum += __shfl_xor(dsum, 16); dsum += __shfl_xor(dsum, 32);
            float qn = 0.f;
#pragma unroll
            for (int ks = 0; ks < 4; ++ks)
#pragma unroll
                for (int jj = 0; jj < 8; ++jj) qn += bf2f((bf16_t)qf[ks][jj]) * snp[32 * ks + 8 * g + jj];
            qn += __shfl_xor(qn, 16); qn += __shfl_xor(qn, 32);
            const float den = dsum + iwi * qn;
            inv_den = 1.0f / fmaxf(fabsf(den), __expf(-mri));
            bf16x8 pf[2];
#pragma unroll
            for (int t = 0; t < 2; ++t) { pg8::u32x4 w; w.x = pg8::cvt_pk_bf16(st[2 * t][0], st[2 * t][1]); w.y = pg8::cvt_pk_bf16(st[2 * t][2], st[2 * t][3]);
                w.z = pg8::cvt_pk_bf16(st[2 * t + 1][0], st[2 * t + 1][1]); w.w = pg8::cvt_pk_bf16(st[2 * t + 1][2], st[2 * t + 1][3]); pf[t] = __builtin_bit_cast(bf16x8, w); }
            const unsigned vs = (unsigned)(size_t)Vs, cs = (unsigned)(size_t)Cs;
#pragma unroll
            for (int e4 = 0; e4 < 4; ++e4) { const int et = 4 * eh + e4;
                s16x4 vlo[2], vhi[2], clo[4], chi[4];
#pragma unroll
                for (int t = 0; t < 2; ++t) { vlo[t] = att::tr_read(tr_addr(vs, 32 * t + 4 * g, 16 * et, li)); vhi[t] = att::tr_read(tr_addr(vs, 32 * t + 16 + 4 * g, 16 * et, li)); }
#pragma unroll
                for (int ks = 0; ks < 4; ++ks) { clo[ks] = att::tr_read(tr_addr(cs, 32 * ks + 8 * g, 16 * et, li)); chi[ks] = att::tr_read(tr_addr(cs, 32 * ks + 8 * g + 4, 16 * et, li)); }
                lds_wait();
                f32x4 aS = (f32x4){0.f, 0.f, 0.f, 0.f}, aC = (f32x4){0.f, 0.f, 0.f, 0.f};
#pragma unroll
                for (int t = 0; t < 2; ++t) aS = __builtin_amdgcn_mfma_f32_16x16x32_bf16(mk8(vlo[t], vhi[t]), pf[t], aS, 0, 0, 0);
#pragma unroll
                for (int ks = 0; ks < 4; ++ks) aC = __builtin_amdgcn_mfma_f32_16x16x32_bf16(mk8(clo[ks], chi[ks]), qf[ks], aC, 0, 0, 0);
                hv[e4] = (aS + aC * iwi) * inv_den;
                ssq_part += (hv[e4][0] * hv[e4][0] + hv[e4][1] * hv[e4][1]) + (hv[e4][2] * hv[e4][2] + hv[e4][3] * hv[e4][3]); }
            ssq_part += __shfl_xor(ssq_part, 16); ssq_part += __shfl_xor(ssq_part, 32);
            if (g == 0) ssq[wave * 16 + li] = ssq_part;
        }
        __syncthreads();
        if (active) {
            const float tot = ssq_part + ssq[(wave ^ 4) * 16 + li];
            const float rs = rsqrtf(tot * (1.0f / C::MHD) + 1e-6f);
            const int row = r0 + i;
#pragma unroll
            for (int e4 = 0; e4 < 4; ++e4) { const int e = 16 * (4 * eh + e4) + 4 * g;
                const f32x4 og = *(const f32x4*)(P + (size_t)row * C::LDP + C::O_O + h * C::MHD + e); const f32x4 gn = *(const f32x4*)(p.in[I_NG] + (size_t)l * C::MW + h * C::MHD + e);
                float o4[4];
#pragma unroll
                for (int r = 0; r < 4; ++r) o4[r] = hv[e4][r] * rs * gn[r] * __builtin_amdgcn_rcpf(1.0f + __expf(-og[r]));
                u32x2 w; w.x = pg8::cvt_pk_bf16(o4[0], o4[1]); w.y = pg8::cvt_pk_bf16(o4[2], o4[3]);
                *(u32x2*)(wsb<C>(p, C::WS_MIX) + (size_t)row * C::D + C::PW + C::GW + h * C::MHD + e) = w; }
        }
        __syncthreads();
    }
}
}
namespace rw {
typedef att::f32x4 f32x4; typedef att::u32x2 u32x2;
static_assert(C::D == 2048, "row ops assume 2048 columns = 8 float4 per lane");
__device__ __forceinline__ float wave_sum(float v) {
#pragma unroll
    for (int o = 1; o < 64; o <<= 1) v += __shfl_xor(v, o);
    return v;
}
__device__ __forceinline__ void rows_init(const Ptrs& p, int tid) {
    const int lane = tid & 63, gw = blockIdx.x * NWAVES + (tid >> 6), NGW = gridDim.x * NWAVES;
    float* SS = wsf<C>(p, C::WS_SS);
    for (int r = gw; r < C::M; r += NGW) {
        const float* src = r < C::MP ? p.in[I_XP] + (size_t)r * C::D : p.in[I_XS] + (size_t)(r - C::MP) * C::D;
        float* X = wsf<C>(p, C::WS_X) + (size_t)r * C::D; bf16_t* XB = wsb<C>(p, C::WS_XB) + (size_t)r * C::D;
        float ss = 0.f;
#pragma unroll
        for (int j = 0; j < 8; ++j) { const f32x4 v = *(const f32x4*)(src + (lane + 64 * j) * 4); *(f32x4*)(X + (lane + 64 * j) * 4) = v;
            u32x2 w; w.x = pg8::cvt_pk_bf16(v[0], v[1]); w.y = pg8::cvt_pk_bf16(v[2], v[3]); *(u32x2*)(XB + (lane + 64 * j) * 4) = w;
            ss += (v[0] * v[0] + v[1] * v[1]) + (v[2] * v[2] + v[3] * v[3]); }
        ss = wave_sum(ss);
        if (lane < C::NSS) SS[(size_t)lane * C::M + r] = lane == 0 ? ss : 0.f;
    }
    for (int r = gw; r < C::MM; r += NGW) {
        const float* src = p.in[I_MEM] + (size_t)r * C::D; bf16_t* MB = wsb<C>(p, C::WS_MEMB) + (size_t)r * C::D;
        float ss = 0.f;
#pragma unroll
        for (int j = 0; j < 8; ++j) { const f32x4 v = *(const f32x4*)(src + (lane + 64 * j) * 4);
            u32x2 w; w.x = pg8::cvt_pk_bf16(v[0], v[1]); w.y = pg8::cvt_pk_bf16(v[2], v[3]); *(u32x2*)(MB + (lane + 64 * j) * 4) = w;
            ss += (v[0] * v[0] + v[1] * v[1]) + (v[2] * v[2] + v[3] * v[3]); }
        ss = wave_sum(ss);
        if (lane == 0) wsf<C>(p, C::WS_RSTDM)[r] = rsqrtf(ss * (1.0f / C::D) + 1e-6f);
    }
}
__device__ __forceinline__ void rows_final(const Ptrs& p, int tid) {
    const int lane = tid & 63, gw = blockIdx.x * NWAVES + (tid >> 6), NGW = gridDim.x * NWAVES;
    for (int r = gw; r < C::M; r += NGW) {
        const float* X = wsf<C>(p, C::WS_X) + (size_t)r * C::D; const float rs = rsqrtf(wsf<C>(p, C::WS_SS)[(size_t)(C::NSS - 1) * C::M + r] * (1.0f / C::D) + 1e-6f);
        float* o = r < C::MP ? p.out + C::OUT_YP + (size_t)r * C::D : p.out + C::OUT_YS + (size_t)(r - C::MP) * C::D;
        float pscale = 1.0f, padd = 0.f;
#if defined(PROBE_MASK_A)
        { const unsigned long long* TS = (const unsigned long long*)(p.ws + C::WS_CTL + 32768); unsigned long long ta = 0, tb = 0;
          for (int k = 0; k < 27; ++k) { const unsigned long long dk = TS[k + 1] - TS[k]; if ((PROBE_MASK_A >> k) & 1ull) ta += dk; if ((PROBE_MASK_B >> k) & 1ull) tb += dk; }
          if (r >= C::MP) pscale = 1.0f + 0.03f + (float)ta * 0.01f * PROBE_SA;
          if (r == 0 && lane == 0) padd = 1.0f + (float)tb * 0.01f * PROBE_SB; }
#endif
#pragma unroll
        for (int j = 0; j < 8; ++j) { const f32x4 v = *(const f32x4*)(X + (lane + 64 * j) * 4); const f32x4 gg = *(const f32x4*)(p.in[I_GFIN] + (lane + 64 * j) * 4);
            f32x4 y = v * rs * gg * pscale; if (j == 0) y[0] += padd; *(f32x4*)(o + (lane + 64 * j) * 4) = y; }
    }
}
__device__ __forceinline__ void ml_scan(const Ptrs& p, int l, long gtid, long gthreads) {
    const float* CBL = wsf<C>(p, C::WS_CBL); const float* CML = wsf<C>(p, C::WS_CML);
    float* DC = wsf<C>(p, C::WS_DC); float* DN = wsf<C>(p, C::WS_DN);
    constexpr int NPS = C::BATCH * C::MH, E4 = C::MHD / 4;
    for (long it = gtid; it < (long)NPS * C::MHD * E4; it += gthreads) {
        const int e4 = (int)(it % E4), d = (int)((it / E4) % C::MHD), sq = (int)(it / ((long)E4 * C::MHD));
        float m = 0.f; f32x4 cst = (f32x4){0.f, 0.f, 0.f, 0.f};
        static_assert(C::NC % 8 == 0, "scan is unrolled by 8 chunks");
        for (int c0 = 0; c0 < C::NC; c0 += 8) {
            f32x4 v[8]; float bl[8], ml[8];
#pragma unroll
            for (int j = 0; j < 8; ++j) { const int ci = sq * C::NC + c0 + j; v[j] = *(const f32x4*)(DC + ((size_t)ci * C::MHD + d) * C::MHD + e4 * 4); bl[j] = CBL[ci]; ml[j] = CML[ci]; }
#pragma unroll
            for (int j = 0; j < 8; ++j) { const int ci = sq * C::NC + c0 + j; const float a = bl[j] + m, mn = fmaxf(a, ml[j]), dec = __expf(a - mn), f = __expf(ml[j] - mn);
                cst = cst * dec + v[j] * f; *(f32x4*)(DC + ((size_t)ci * C::MHD + d) * C::MHD + e4 * 4) = cst; m = mn; }
        }
        *(f32x4*)(p.out + C::OUT_CP + (((size_t)l * NPS + sq) * C::MHD + d) * C::MHD + e4 * 4) = cst;
    }
    for (long it = gtid; it < (long)NPS * C::MHD; it += gthreads) {
        const int d = (int)(it % C::MHD), sq = (int)(it / C::MHD);
        float m = 0.f, nst = 0.f;
        for (int c = 0; c < C::NC; ++c) { const int ci = sq * C::NC + c; const float a = CBL[ci] + m, b2 = CML[ci], mn = fmaxf(a, b2), dec = __expf(a - mn), f = __expf(b2 - mn);
            const size_t on = (size_t)ci * C::MHD + d; nst = dec * nst + f * DN[on]; DN[on] = nst; m = mn; }
        p.out[C::OUT_NP + ((size_t)l * NPS + sq) * C::MHD + d] = nst;
    }
    for (long it = gtid; it < (long)C::NSC * C::MHD * E4; it += gthreads) {
        const int e4 = (int)(it % E4), d = (int)((it / E4) % C::MHD), q = (int)(it / ((long)E4 * C::MHD)), ci = C::NPC + q;
        const float m0 = p.in[I_SM][(size_t)l * C::NSC + q], a = CBL[ci] + m0, b2 = CML[ci], mn = fmaxf(a, b2), dec = __expf(a - mn), f = __expf(b2 - mn);
        const size_t so = (((size_t)l * C::NSC + q) * C::MHD + d) * C::MHD + e4 * 4;
        *(f32x4*)(p.out + C::OUT_CS + so) = *(const f32x4*)(p.in[I_SC] + so) * dec + *(const f32x4*)(DC + ((size_t)ci * C::MHD + d) * C::MHD + e4 * 4) * f;
    }
    for (long it = gtid; it < (long)C::NSC * C::MHD; it += gthreads) {
        const int d = (int)(it % C::MHD), q = (int)(it / C::MHD), ci = C::NPC + q;
        const float m0 = p.in[I_SM][(size_t)l * C::NSC + q], a = CBL[ci] + m0, b2 = CML[ci], mn = fmaxf(a, b2), dec = __expf(a - mn), f = __expf(b2 - mn);
        const size_t no = ((size_t)l * C::NSC + q) * C::MHD + d;
        p.out[C::OUT_NS + no] = dec * p.in[I_SN][no] + f * DN[(size_t)ci * C::MHD + d];
    }
}
}

namespace gp {
typedef att::bf16x8 bf16x8; typedef att::s16x4 s16x4; typedef att::f32x4 f32x4; typedef att::u32x2 u32x2;
constexpr int PT = mx::PT, T128 = mx::T128;
static_assert(C::GHD == 128 && C::PGD == 128 && C::GCH == 128 && C::SEQ % 128 == 0 && C::DEC_SEQ == 32 && C::PH == 15, "gmlp / pool phases are built for these shapes");
constexpr int NT_P = C::MP / 128;
constexpr int NU_G = NT_P * 4 + C::DEC_BATCH * 4;
__device__ __forceinline__ void gmlp_phase(LAS unsigned char* lds, const Ptrs& p, int l, int tid) {
    const int lane = tid & 63, wave = __builtin_amdgcn_readfirstlane(tid >> 6), li = lane & 15, g = lane >> 4;
    LAS unsigned char* Vs = lds; LAS unsigned char* Ws = lds + T128;
    const float* P = wsf<C>(p, C::WS_BIG);
    for (int u = blockIdx.x; u < NU_G; u += gridDim.x) {
        int r0, lc, h; bool sample = false; int sb = 0;
        if (u < NT_P * 4) { h = u & 3; r0 = (u >> 2) * 128; lc = 128; } else { const int s = u - NT_P * 4; h = s & 3; sb = s >> 2; r0 = C::MP + sb * C::DEC_SEQ; lc = C::DEC_SEQ; sample = true; }
#pragma unroll
        for (int i = 0; i < 8; ++i) { const int f = tid + 512 * i, row = f >> 5, c4 = f & 31; f32x4 v = (f32x4){0.f, 0.f, 0.f, 0.f};
            if (row < lc) v = *(const f32x4*)(P + (size_t)(r0 + row) * C::LDP + C::O_V + h * 128 + c4 * 4);
            float ss = (v[0] * v[0] + v[1] * v[1]) + (v[2] * v[2] + v[3] * v[3]);
#pragma unroll
            for (int o = 1; o < 32; o <<= 1) ss += __shfl_xor(ss, o);
            const float rs = rsqrtf(ss * (1.0f / 128) + 1e-6f); const f32x4 gn = *(const f32x4*)(p.in[I_GVG] + (size_t)l * C::GW + h * 128 + c4 * 4);
            v = v * rs * gn;
            if (sample && row < lc) *(f32x4*)(p.out + C::OUT_VS + (((size_t)l * C::DEC_BATCH + sb) * C::DEC_SEQ + row) * C::GW + h * 128 + c4 * 4) = v;
            u32x2 w; w.x = pg8::cvt_pk_bf16(v[0], v[1]); w.y = pg8::cvt_pk_bf16(v[2], v[3]); *(LAS u32x2*)(Vs + row * PT + c4 * 8) = w; }
        const float* wsrc = p.in[I_GWS] + ((size_t)l * C::GH + h) * 128 * 128;
#pragma unroll
        for (int i = 0; i < 8; ++i) { const int f = tid + 512 * i, row = f >> 5, c4 = f & 31; f32x4 v = *(const f32x4*)(wsrc + (size_t)row * 128 + c4 * 4);
#pragma unroll
            for (int j = 0; j < 4; ++j) if (c4 * 4 + j > row) v[j] = 0.f;
            u32x2 w; w.x = pg8::cvt_pk_bf16(v[0], v[1]); w.y = pg8::cvt_pk_bf16(v[2], v[3]); *(LAS u32x2*)(Ws + row * PT + c4 * 8) = w; }
        __syncthreads();
        if (wave * 16 < lc) {
            const int i = wave * 16 + li, nks = (wave * 16 + 15) / 32 + 1;
            f32x4 acc[8];
#pragma unroll
            for (int dt = 0; dt < 8; ++dt) acc[dt] = (f32x4){0.f, 0.f, 0.f, 0.f};
            const unsigned vs = (unsigned)(size_t)Vs;
            for (int ks = 0; ks < nks; ++ks) {
                const bf16x8 bq = *(const LAS bf16x8*)(Ws + i * PT + ks * 64 + g * 16);
                s16x4 lo[8], hi[8];
#pragma unroll
                for (int dt = 0; dt < 8; ++dt) { lo[dt] = att::tr_read(mx::tr_addr(vs, 32 * ks + 8 * g, 16 * dt, li)); hi[dt] = att::tr_read(mx::tr_addr(vs, 32 * ks + 8 * g + 4, 16 * dt, li)); }
                mx::lds_wait();
#pragma unroll
                for (int dt = 0; dt < 8; ++dt) acc[dt] = __builtin_amdgcn_mfma_f32_16x16x32_bf16(mx::mk8(lo[dt], hi[dt]), bq, acc[dt], 0, 0, 0);
            }
            const float bsi = p.in[I_GBS][((size_t)l * C::GH + h) * C::GCH + i];
            const int row = r0 + i;
#pragma unroll
            for (int dt = 0; dt < 8; ++dt) { const int d = 16 * dt + 4 * g; const f32x4 uu = *(const f32x4*)(P + (size_t)row * C::LDP + C::O_U + h * 128 + d);
                u32x2 w; w.x = pg8::cvt_pk_bf16(uu[0] * (acc[dt][0] + bsi), uu[1] * (acc[dt][1] + bsi)); w.y = pg8::cvt_pk_bf16(uu[2] * (acc[dt][2] + bsi), uu[3] * (acc[dt][3] + bsi));
                *(u32x2*)(wsb<C>(p, C::WS_MIX) + (size_t)row * C::D + C::PW + h * 128 + d) = w; }
        }
        __syncthreads();
    }
}
__device__ __forceinline__ void pool_phase(LAS unsigned char* lds, const Ptrs& p, int l, int tid) {
    const int lane = tid & 63, wave = __builtin_amdgcn_readfirstlane(tid >> 6), li = lane & 15, g = lane >> 4;
    LAS unsigned char* Ds = lds; LAS unsigned char* Ws = lds + T128;
    const float* P = wsf<C>(p, C::WS_BIG);
    for (int u = blockIdx.x; u < NU_G; u += gridDim.x) {
        int r0, lc, grp, t0, L, b; bool sample = false;
        if (u < NT_P * 4) { grp = u & 3; r0 = (u >> 2) * 128; lc = 128; b = r0 / C::SEQ; t0 = r0 % C::SEQ; L = C::SEQ; } else { const int s = u - NT_P * 4; grp = s & 3; b = s >> 2; r0 = C::MP + b * C::DEC_SEQ; lc = C::DEC_SEQ; t0 = 0; L = C::DEC_SEQ; sample = true; }
        const int w = 2 << grp;
        { const int c4 = tid & 31, sg = tid >> 5, ch = grp * 128 + c4 * 4;
            const float* hist = p.in[I_SPOOL] + ((size_t)l * C::DEC_BATCH + b) * C::PH * C::PW + ch;
            auto xat = [&](int t) -> f32x4 {
                if (t >= 0) return *(const f32x4*)(P + (size_t)(r0 - t0 + t) * C::LDP + ch);
                if (sample && C::PH + t >= 0) return *(const f32x4*)(hist + (size_t)(C::PH + t) * C::PW);
                return (f32x4){0.f, 0.f, 0.f, 0.f}; };
            if (sg * 8 < lc) {
                const int ts = t0 + sg * 8;
                f32x4 sum = (f32x4){0.f, 0.f, 0.f, 0.f};
                for (int j = 1; j < w; ++j) sum = sum + xat(ts - j);
#pragma unroll
                for (int k = 0; k < 8; ++k) { const int t = ts + k; const f32x4 x = xat(t); sum = sum + x;
                    const int pos = (sample ? C::PAST : 0) + t; const float inv = 1.0f / (float)((pos + 1) < w ? (pos + 1) : w);
                    const f32x4 dv = sum * inv - x;
                    u32x2 ww; ww.x = pg8::cvt_pk_bf16(dv[0], dv[1]); ww.y = pg8::cvt_pk_bf16(dv[2], dv[3]); *(LAS u32x2*)(Ds + (sg * 8 + k) * PT + c4 * 8) = ww;
                    sum = sum - xat(t - w + 1);
                    const int idx = t - (L - C::PH);
                    if (idx >= 0) *(f32x4*)(p.out + (sample ? C::OUT_POOLS + (((size_t)l * C::DEC_BATCH + b) * C::PH + idx) * C::PW : C::OUT_POOLP + (((size_t)l * C::BATCH + b) * C::PH + idx) * C::PW) + ch) = x; }
            } else {
#pragma unroll
                for (int k = 0; k < 8; ++k) *(LAS u32x2*)(Ds + (sg * 8 + k) * PT + c4 * 8) = (u32x2){0u, 0u};
            }
        }
        const float* wsrc = p.in[I_POOLW] + ((size_t)l * C::PG + grp) * 128 * 128;
#pragma unroll
        for (int i = 0; i < 8; ++i) { const int f = tid + 512 * i, row = f >> 5, c4 = f & 31; const f32x4 v = *(const f32x4*)(wsrc + (size_t)row * 128 + c4 * 4);
            u32x2 ww; ww.x = pg8::cvt_pk_bf16(v[0], v[1]); ww.y = pg8::cvt_pk_bf16(v[2], v[3]); *(LAS u32x2*)(Ws + row * PT + c4 * 8) = ww; }
        __syncthreads();
        if (wave * 16 < lc) {
            const int t = wave * 16 + li;
            f32x4 acc[8];
#pragma unroll
            for (int et = 0; et < 8; ++et) acc[et] = (f32x4){0.f, 0.f, 0.f, 0.f};
            const unsigned wsa = (unsigned)(size_t)Ws;
#pragma unroll
            for (int ks = 0; ks < 4; ++ks) {
                const bf16x8 bq = *(const LAS bf16x8*)(Ds + t * PT + ks * 64 + g * 16);
                s16x4 lo[8], hi[8];
#pragma unroll
                for (int et = 0; et < 8; ++et) { lo[et] = att::tr_read(mx::tr_addr(wsa, 32 * ks + 8 * g, 16 * et, li)); hi[et] = att::tr_read(mx::tr_addr(wsa, 32 * ks + 8 * g + 4, 16 * et, li)); }
                mx::lds_wait();
#pragma unroll
                for (int et = 0; et < 8; ++et) acc[et] = __builtin_amdgcn_mfma_f32_16x16x32_bf16(mx::mk8(lo[et], hi[et]), bq, acc[et], 0, 0, 0);
            }
            const int row = r0 + t;
#pragma unroll
            for (int et = 0; et < 8; ++et) { const int e = 16 * et + 4 * g; const f32x4 sc = *(const f32x4*)(p.in[I_POOLS] + (size_t)l * C::PW + grp * 128 + e);
                u32x2 ww; ww.x = pg8::cvt_pk_bf16(acc[et][0] * sc[0], acc[et][1] * sc[1]); ww.y = pg8::cvt_pk_bf16(acc[et][2] * sc[2], acc[et][3] * sc[3]);
                *(u32x2*)(wsb<C>(p, C::WS_MIX) + (size_t)row * C::D + grp * 128 + e) = ww; }
        }
        __syncthreads();
    }
}
}
constexpr int PH_PER_LAYER = 13, N_PHASES = 2 + PH_PER_LAYER * C::DEPTH;
struct Args { Ptrs p; int ph_lo, ph_hi; };
__global__ void __launch_bounds__(NTHREADS, 2) fwd(Args a) {
    extern __shared__ __attribute__((aligned(16))) unsigned char lds_raw[];
    LAS unsigned char* lds = (LAS unsigned char*)lds_raw;
    typedef __attribute__((address_space(4))) const Args* KArgs;
    const KArgs ka0 = (KArgs)__builtin_amdgcn_kernarg_segment_ptr();
    const int lo = a.ph_lo, hi = a.ph_hi;
#define IN(k) (lo <= (k) && (k) < hi)
#define BOTH(k) (IN(k) && IN((k) + 1))
#define GRID_BAR(k) do { if (BOTH(k)) { xcd_barrier(bar); } } while (0)
#if defined(__HIP_DEVICE_COMPILE__)
#define LOAD_PTRS KArgs ka = ka0; asm volatile("" : "+s"(ka)); Ptrs p; _Pragma("unroll") for (int i_ = 0; i_ < 33; ++i_) p.in[i_] = ka->p.in[i_]; p.out = ka->p.out; p.ws = ka->p.ws;
#else
#define LOAD_PTRS (void)ka0; const Ptrs p = a.p;
#endif
#define PHASE_ARGS LOAD_PTRS int tid = threadIdx.x; asm volatile("" : "+v"(tid)); \
    const int lane = tid & 63, wave = __builtin_amdgcn_readfirstlane(tid >> 6); (void)lane; (void)wave; \
    const long gtid = (long)blockIdx.x * NTHREADS + tid, gthreads = (long)gridDim.x * NTHREADS; (void)gtid; (void)gthreads; \
    float* SS = wsf<C>(p, C::WS_SS); (void)SS; const float invd = 1.0f / C::D; (void)invd;
#if defined(PROBE_MASK_A)
#define STAMP(k) do { if (blockIdx.x == 0 && threadIdx.x == 0) ((unsigned long long*)(a.p.ws + C::WS_CTL + 32768))[k] = wall_clock64(); } while (0)
#else
#define STAMP(k) do { } while (0)
#endif
#define ITEMS(n, call) do { for (long it = gtid; it < (long)(n); it += gthreads) { call; } } while (0)
#define SSL(j) (SS + (size_t)(4 * l + (j)) * C::M)
#define GEMM_ALL(STRIP, EPI, Aop, Bop, Mr, Nc, Kd, ...) do { pg8::Gemm g{Aop, Bop, Mr, Nc, Kd, Kd}; pg8::StaticOrder S; S.init(Mr, Nc, gridDim.x, blockIdx.x, (STRIP) ? 288 : 256); \
        pg8::EPI E{__VA_ARGS__}; pg8::gemm_phase<pg8::EPI, pg8::StaticOrder, STRIP, false>(lds, g, S, E, nullptr); } while (0)
#if ONE_LAUNCH
    if (threadIdx.x < 4) ((LAS unsigned*)(lds + LDS_CTL))[threadIdx.x] = 0u;
    __syncthreads();
    XcdBarrier bar = xcd_barrier_post((unsigned*)(a.p.ws + C::WS_CTL), (volatile LAS unsigned*)(lds + LDS_CTL));
#else
    XcdBarrier bar; bar.bar = nullptr; bar.x = 0; bar.st = nullptr;
#endif

    if (IN(0)) { PHASE_ARGS STAMP(0);
        const int gw = blockIdx.x * NWAVES + wave, NGW = gridDim.x * NWAVES;
        for (int l = 0; l < C::DEPTH; ++l)
            for (int idx = 0; idx < 10; ++idx) { const WDesc d = wdesc(p, l, idx); const int nitems = (d.K / 64) * (d.N / 64);
                for (int it = gw; it < nitems; it += NGW) prep_item(d.W, d.K, d.Ncols, d.g, d.kind, d.N, d.dst, it, lane); }
        rw::rows_init(p, tid);
        GRID_BAR(0);
    }
    for (int l = 0; l < C::DEPTH; ++l) {
        const int pb = 1 + PH_PER_LAYER * l;
        if (IN(pb + 0)) { PHASE_ARGS STAMP(pb + 0);
            GEMM_ALL(false, EpiMemKV, wsb<C>(p, C::WS_MEMB), wlayer<C>(p, l, C::W_KV), C::MM, 2 * C::D, C::D, p.out + C::OUT_MK + (size_t)l * C::MM * C::D, p.out + C::OUT_MV + (size_t)l * C::MM * C::D, wsf<C>(p, C::WS_RSTDM), C::D);
            GRID_BAR(pb + 0); }
        if (IN(pb + 1)) { PHASE_ARGS STAMP(pb + 1);
            GEMM_ALL(true, EpiSwiGLU, wsb<C>(p, C::WS_XB), wlayer<C>(p, l, C::W_1IN), C::M, 2 * C::FF, C::D, wsb<C>(p, C::WS_BIG), SSL(0), C::FF, invd);
            GRID_BAR(pb + 1); }
        if (IN(pb + 2)) { PHASE_ARGS STAMP(pb + 2);
            GEMM_ALL(true, EpiResid, wsb<C>(p, C::WS_BIG), wlayer<C>(p, l, C::W_1OUT), C::M, C::D, C::FF, wsf<C>(p, C::WS_X), wsb<C>(p, C::WS_XB), SSL(1), 0.5f, C::D);
            GRID_BAR(pb + 2); }
        if (IN(pb + 3)) { PHASE_ARGS STAMP(pb + 3);
            GEMM_ALL(true, EpiScaleF32, wsb<C>(p, C::WS_XB), wlayer<C>(p, l, C::W_IN), C::M, C::LDP, C::D, wsf<C>(p, C::WS_BIG), C::LDP, SSL(1), invd);
            GRID_BAR(pb + 3); }
        if (IN(pb + 4)) { PHASE_ARGS STAMP(pb + 4); mx::ml_phase_a(lds, p, l, tid); gp::gmlp_phase(lds, p, l, tid); gp::pool_phase(lds, p, l, tid); GRID_BAR(pb + 4); }
        if (IN(pb + 5)) { PHASE_ARGS STAMP(pb + 5); ITEMS((C::BATCH + C::DEC_BATCH) * C::MH, st_ml_b0<C>(p, l, (int)it)); rw::ml_scan(p, l, gtid, gthreads); GRID_BAR(pb + 5); }
        if (IN(pb + 6)) { PHASE_ARGS STAMP(pb + 6); mx::ml_phase_c(lds, p, l, tid); GRID_BAR(pb + 6); }
        if (IN(pb + 7)) { PHASE_ARGS STAMP(pb + 7);
            GEMM_ALL(true, EpiResid, wsb<C>(p, C::WS_MIX), wlayer<C>(p, l, C::W_OUT), C::M, C::D, C::D, wsf<C>(p, C::WS_X), wsb<C>(p, C::WS_XB), SSL(2), 1.0f, C::D);
            GRID_BAR(pb + 7); }
        if (IN(pb + 8)) { PHASE_ARGS STAMP(pb + 8);
            GEMM_ALL(true, EpiScaleBf16, wsb<C>(p, C::WS_XB), wlayer<C>(p, l, C::W_Q), C::M, C::D, C::D, wsb<C>(p, C::WS_Q), C::D, SSL(2), invd);
            GRID_BAR(pb + 8); }
        if (IN(pb + 9)) { PHASE_ARGS STAMP(pb + 9); att::attn_phase(lds, p, l, tid); GRID_BAR(pb + 9); }
        if (IN(pb + 10)) { PHASE_ARGS STAMP(pb + 10);
            GEMM_ALL(true, EpiResid, wsb<C>(p, C::WS_AO), wlayer<C>(p, l, C::W_O), C::M, C::D, C::D, wsf<C>(p, C::WS_X), wsb<C>(p, C::WS_XB), SSL(3), 1.0f, C::D);
            GRID_BAR(pb + 10); }
        if (IN(pb + 11)) { PHASE_ARGS STAMP(pb + 11);
            GEMM_ALL(true, EpiSwiGLU, wsb<C>(p, C::WS_XB), wlayer<C>(p, l, C::W_2IN), C::M, 2 * C::FF, C::D, wsb<C>(p, C::WS_BIG), SSL(3), C::FF, invd);
            GRID_BAR(pb + 11); }
        if (IN(pb + 12)) { PHASE_ARGS STAMP(pb + 12);
            GEMM_ALL(true, EpiResid, wsb<C>(p, C::WS_BIG), wlayer<C>(p, l, C::W_2OUT), C::M, C::D, C::FF, wsf<C>(p, C::WS_X), wsb<C>(p, C::WS_XB), SSL(4), 0.5f, C::D);
            GRID_BAR(pb + 12); }
    }
    if (IN(N_PHASES - 1)) { PHASE_ARGS STAMP(N_PHASES - 1); __syncthreads(); rw::rows_final(p, tid); }
#undef IN
#undef BOTH
#undef GRID_BAR
#undef ITEMS
#undef PHASE_ARGS
#undef SSL
}

extern "C" void kernel_launch(void* const* d_in, const int* in_sizes, int n_in, void* d_out, int out_size, void* d_ws, size_t ws_size, hipStream_t stream) {
    static int ready = 0;
    if (!ready) {
        if (n_in != 33 || (long)out_size != (long)C::OUT_END || ws_size < (size_t)C::WS_END) { fprintf(stderr, "kernel_launch: unexpected shapes: n_in %d out %d ws %zu (need %zu)\n", n_in, out_size, ws_size, (size_t)C::WS_END); ready = -1; return; }
        if (hipFuncSetAttribute((const void*)fwd, hipFuncAttributeMaxDynamicSharedMemorySize, LDS_BYTES) != hipSuccess) { fprintf(stderr, "kernel_launch: hipFuncSetAttribute failed\n"); ready = -1; return; }
        int dev = 0, cus = 0, per_cu = 0;
        if (hipGetDevice(&dev) != hipSuccess || hipDeviceGetAttribute(&cus, hipDeviceAttributeMultiprocessorCount, dev) != hipSuccess) { fprintf(stderr, "kernel_launch: device query failed\n"); ready = -1; return; }
        if (hipOccupancyMaxActiveBlocksPerMultiprocessor(&per_cu, (const void*)fwd, NTHREADS, LDS_BYTES) != hipSuccess || per_cu < 1) { fprintf(stderr, "kernel_launch: occupancy query reports %d blocks per CU\n", per_cu); (void)hipGetLastError(); per_cu = 1; }
        if (cus != 256) { fprintf(stderr, "kernel_launch: built for a 256-CU device (one resident workgroup per CU), found %d\n", cus); ready = -1; return; }
        ready = cus;
    }
    if (ready < 0) return;
    Args a{};
    for (int i = 0; i < 33; ++i) a.p.in[i] = (const float*)d_in[i];
    a.p.out = (float*)d_out; a.p.ws = (unsigned char*)d_ws;
#if ONE_LAUNCH
    (void)hipMemsetAsync((char*)d_ws + C::WS_CTL, 0, 65536, stream);
    a.ph_lo = 0; a.ph_hi = N_PHASES;
    hipLaunchKernelGGL(fwd, dim3(ready), dim3(NTHREADS), LDS_BYTES, stream, a);
#else
    for (int k = 0; k < N_PHASES; ++k) { a.ph_lo = k; a.ph_hi = k + 1; hipLaunchKernelGGL(fwd, dim3(ready), dim3(NTHREADS), LDS_BYTES, stream, a); }
#endif
}
```

```cpp
#include <hip/hip_runtime.h>
#include <cstdio>
#define ONE_LAUNCH 1

#define HD __host__ __device__
#ifndef HD
#define HD __host__ __device__
#endif
typedef unsigned short bf16_t;
HD inline unsigned f2u(float f) { return __builtin_bit_cast(unsigned, f); }
HD inline float u2f(unsigned u) { return __builtin_bit_cast(float, u); }
HD inline bf16_t f2bf(float f) { unsigned u = f2u(f); u += 0x7FFFu + ((u >> 16) & 1u); return (bf16_t)(u >> 16); }
HD inline float bf2f(bf16_t b) { return u2f(((unsigned)b) << 16); }

struct RC {
    static constexpr int D = 2048, FF = 8192, BATCH = 4, SEQ = 2048, DEPTH = 2, DEC_BATCH = 32, DEC_SEQ = 32, PAST = 2048, NMEM = 256;
};
template <class B> struct CfgT : B {
    using B::D; using B::FF; using B::BATCH; using B::SEQ; using B::DEPTH; using B::DEC_BATCH; using B::DEC_SEQ; using B::PAST; using B::NMEM;
    static constexpr int MP = BATCH * SEQ, MS = DEC_BATCH * DEC_SEQ, M = MP + MS, MM = BATCH * NMEM;
    static constexpr int PW = D / 4, PG = 4, PGD = PW / 4, PH = 15;
    static constexpr int GW = D / 4, GH = 4, GHD = GW / 4, GCH = 128;
    static constexpr int MW = D - PW - GW, MH = 8, MHD = MW / 8, CH = 64;
    static constexpr int INC = PW + 2 * GW + 4 * MW + 2 * MH;
    static constexpr int LDP = ((INC + 255) / 256) * 256;
    static constexpr int AH = 4, AHD = D / 4;
    static constexpr int O_U = PW, O_V = PW + GW, O_Q = PW + 2 * GW, O_K = O_Q + MW, O_VM = O_K + MW, O_O = O_VM + MW, O_IG = O_O + MW, O_FG = O_IG + MH;
    static constexpr int NC = SEQ / CH, NPC = BATCH * MH * NC, NSC = DEC_BATCH * MH, NCH = NPC + NSC;
    static constexpr int LCS = DEC_SEQ < CH ? DEC_SEQ : CH;
    static constexpr int GLP = SEQ < GCH ? SEQ : GCH, GLS = DEC_SEQ < GCH ? DEC_SEQ : GCH;
    static constexpr int NSS = 1 + 4 * DEPTH;
    static constexpr long OUT_YP = 0, OUT_YS = OUT_YP + (long)MP * D, OUT_POOLP = OUT_YS + (long)MS * D, OUT_POOLS = OUT_POOLP + (long)DEPTH * BATCH * PH * PW,
        OUT_CP = OUT_POOLS + (long)DEPTH * DEC_BATCH * PH * PW, OUT_NP = OUT_CP + (long)DEPTH * BATCH * MH * MHD * MHD, OUT_MP = OUT_NP + (long)DEPTH * BATCH * MH * MHD,
        OUT_CS = OUT_MP + (long)DEPTH * BATCH * MH, OUT_NS = OUT_CS + (long)DEPTH * DEC_BATCH * MH * MHD * MHD, OUT_MS = OUT_NS + (long)DEPTH * DEC_BATCH * MH * MHD,
        OUT_VS = OUT_MS + (long)DEPTH * DEC_BATCH * MH, OUT_MK = OUT_VS + (long)DEPTH * DEC_BATCH * DEC_SEQ * GW, OUT_MV = OUT_MK + (long)DEPTH * BATCH * NMEM * D,
        OUT_END = OUT_MV + (long)DEPTH * BATCH * NMEM * D;
    static constexpr size_t al(size_t x) { return (x + 255) & ~(size_t)255; }
    static constexpr size_t WS_CTL = 0, WS_SS = 65536, WS_X = al(WS_SS + (size_t)NSS * M * 4), WS_XB = al(WS_X + (size_t)M * D * 4),
        WS_BIG = al(WS_XB + (size_t)M * D * 2),
        WS_BIG_SZ = ((size_t)M * FF * 2 > (size_t)M * LDP * 4) ? (size_t)M * FF * 2 : (size_t)M * LDP * 4,
        WS_MIX = al(WS_BIG + WS_BIG_SZ), WS_Q = al(WS_MIX + (size_t)M * D * 2), WS_AO = al(WS_Q + (size_t)M * D * 2),
        WS_MEMB = al(WS_AO + (size_t)M * D * 2), WS_RSTDM = al(WS_MEMB + (size_t)MM * D * 2),
        WS_GB = al(WS_RSTDM + (size_t)MM * 4), WS_GA = al(WS_GB + (size_t)M * MH * 4),
        WS_CBL = al(WS_GA + (size_t)M * MH * 4), WS_CML = al(WS_CBL + (size_t)NCH * 4), WS_MPREV = al(WS_CML + (size_t)NCH * 4),
        WS_DC = al(WS_MPREV + (size_t)NCH * 4), WS_DN = al(WS_DC + (size_t)NCH * MHD * MHD * 4),
        WS_PART = al(WS_DN + (size_t)NCH * MHD * 4),
        WS_W = al(WS_PART + (size_t)256 * 65536 * 4);
    static constexpr size_t W_1IN = 0, W_1OUT = W_1IN + (size_t)2 * FF * D, W_IN = W_1OUT + (size_t)D * FF, W_OUT = W_IN + (size_t)LDP * D, W_Q = W_OUT + (size_t)D * D,
        W_KV = W_Q + (size_t)D * D, W_O = W_KV + (size_t)2 * D * D, W_2IN = W_O + (size_t)D * D, W_2OUT = W_2IN + (size_t)2 * FF * D, W_LAYER = W_2OUT + (size_t)D * FF;
    static constexpr size_t WS_END = al(WS_W + (size_t)DEPTH * W_LAYER * 2);
};

struct Ptrs { const float* in[33]; float* out; unsigned char* ws; };
enum { I_XP = 0, I_XS, I_MEM, I_SPOOL, I_SC, I_SN, I_SM, I_CK, I_CV, I_GFFN1, I_W1IN, I_W1OUT, I_GMIX, I_WIN, I_POOLW, I_POOLS, I_GVG, I_GWS, I_GBS, I_IB, I_FB, I_NG, I_WOUT,
       I_GX, I_GMEM, I_WQ, I_WK, I_WV, I_WO, I_GFFN2, I_W2IN, I_W2OUT, I_GFIN };

template <class C> HD inline float* wsf(const Ptrs& p, size_t off) { return (float*)(p.ws + off); }
template <class C> HD inline bf16_t* wsb(const Ptrs& p, size_t off) { return (bf16_t*)(p.ws + off); }
template <class C> HD inline bf16_t* wlayer(const Ptrs& p, int l, size_t off) { return (bf16_t*)(p.ws + C::WS_W) + (size_t)l * C::W_LAYER + off; }

template <class C> HD inline void row_info(int r, bool& s, int& b, int& t) {
    if (r < C::MP) { s = false; b = r / C::SEQ; t = r % C::SEQ; } else { s = true; const int q = r - C::MP; b = q / C::DEC_SEQ; t = q % C::DEC_SEQ; }
}
template <class C> HD inline void chunk_info(int r, int h, int& ci, int& i, int& lc) {
    bool s; int b, t; row_info<C>(r, s, b, t);
    if (!s) { ci = (b * C::MH + h) * C::NC + t / C::CH; i = t % C::CH; lc = C::CH; } else { ci = C::NPC + b * C::MH + h; i = t; lc = C::LCS; }
}
HD inline float sigmoidf_(float x) { return 1.0f / (1.0f + expf(-x)); }
HD inline float logsigmoidf_(float x) { return x >= 0.f ? -log1pf(expf(-x)) : x - log1pf(expf(x)); }

enum { WK_PLAIN = 0, WK_FFNIN = 1, WK_WIN = 2 };
template <class C> HD inline int wsrc_col(int kind, int n) {
    if (kind == WK_FFNIN) { const int pn = n >> 8, j = n & 255; return j < 128 ? 128 * pn + j : C::FF + 128 * pn + (j - 128); }
    if (kind == WK_WIN) return n < C::INC ? n : -1;
    return n;
}

template <class C> HD inline void st_ml_b0(const Ptrs& p, int l, int sq) {
    const float* CBL = wsf<C>(p, C::WS_CBL); const float* CML = wsf<C>(p, C::WS_CML); float* MPREV = wsf<C>(p, C::WS_MPREV);
    if (sq < C::BATCH * C::MH) { float m = 0.f;
        for (int c = 0; c < C::NC; ++c) { const int ci = sq * C::NC + c; MPREV[ci] = m; const float a = CBL[ci] + m, b2 = CML[ci]; m = a > b2 ? a : b2; }
        p.out[C::OUT_MP + (size_t)l * C::BATCH * C::MH + sq] = m;
    } else { const int q = sq - C::BATCH * C::MH, ci = C::NPC + q; const float m0 = p.in[I_SM][(size_t)l * C::DEC_BATCH * C::MH + q];
        MPREV[ci] = m0; const float a = CBL[ci] + m0, b2 = CML[ci]; p.out[C::OUT_MS + (size_t)l * C::DEC_BATCH * C::MH + q] = a > b2 ? a : b2; }
}

namespace pg8 {
#define PG8_LAS __attribute__((address_space(3)))
typedef unsigned short bf16_t;
typedef short bf16x8 __attribute__((ext_vector_type(8)));
typedef float f32x4 __attribute__((ext_vector_type(4)));
typedef unsigned u32x4 __attribute__((ext_vector_type(4)));
constexpr int BM = 256, BK = 64, HALF = 128, HTB = HALF * BK * 2  , STAGE_BYTES = 8 * HTB, NXCD = 8, WGM = 8;

__host__ __device__ __forceinline__ int lds_byte(int r, int c) { const int st = (r >> 4) * 2 + (c >> 5), rr = r & 15, cc = c & 31, ob = rr * 64 + cc * 2; return st * 1024 + (ob ^ (((ob >> 9) & 1) << 5)); }
__host__ __device__ __forceinline__ void stage_rc(int b, int& R, int& C) { const int st = b / 1024, sb = b % 1024, swz = sb ^ (((sb >> 9) & 1) << 5); R = (st >> 1) * 16 + swz / 64; C = (st & 1) * 32 + (swz % 64) / 2; }
__host__ __device__ __forceinline__ int perm32(int rho) { const int n = rho >> 4, i = rho & 15; return 8 * (i >> 2) + 4 * n + (i & 3); }

struct Unit { int pm, pn; };
struct Gemm { const bf16_t* A; const bf16_t* Bt; int M, N, K, ld; };

struct StaticOrder {
    int nM, nN, nwg, G, c;
    __host__ __device__ __forceinline__ void init(int M, int N, int G_, int c_, int rows_per_tile = BM) { nM = M / rows_per_tile; nN = N / BM; nwg = nM * nN; G = G_; c = c_; }
    __host__ __device__ __forceinline__ bool next(int i, Unit& u) const {
        const long L = (long)i * G + c; if (L >= nwg) return false;
        int wgid = (int)L; { const int q = nwg / NXCD, r = nwg % NXCD, xcd = wgid % NXCD, off = wgid / NXCD; wgid = (xcd < r ? xcd * (q + 1) : r * (q + 1) + (xcd - r) * q) + off; }
        const int nig = WGM * nN, gid = wgid / nig, fm = gid * WGM, gsz = (nM - fm) < WGM ? (nM - fm) : WGM;
        u.pm = fm + ((wgid % nig) % gsz); u.pn = (wgid % nig) / gsz; return true;
    }
    __device__ __forceinline__ void a_ready(const Unit&) const {}
    __device__ __forceinline__ void done(const Unit&) const {}
};
__device__ __forceinline__ unsigned cvt_pk_bf16(float lo, float hi) { unsigned r; asm volatile("v_cvt_pk_bf16_f32 %0, %1, %2" : "=v"(r) : "v"(lo), "v"(hi)); return r; }
typedef float f32x2 __attribute__((ext_vector_type(2)));
template <class Epi, class Sched, bool STRIP = false, bool STAMP = false>
__device__ __forceinline__ void gemm_phase(PG8_LAS unsigned char* lds, const Gemm g, const Sched& S, const Epi& E, unsigned long long* stamps) {
    int tid_l = threadIdx.x; asm volatile("" : "+v"(tid_l));
    const int tid = tid_l, wid = __builtin_amdgcn_readfirstlane(tid >> 6), lane = tid & 63, wr = wid >> 2, wc = wid & 3, fr = lane & 15, fq = lane >> 4;
    const int K = g.K, nt = K / BK;
    int ts_lo = 0, ts_hi = 0, nts = 0; const unsigned long long rt_entry = STAMP ? (unsigned long long)wall_clock64() : 0ull;
#define PG8_STAMP() do { if (STAMP && wid == 0 && nts < 64) { const unsigned long long _c = (unsigned long long)clock64(); \
        ts_lo = (lane == nts) ? (int)(unsigned)_c : ts_lo; ts_hi = (lane == nts) ? (int)(unsigned)(_c >> 32) : ts_hi; ++nts; } } while (0)
    PG8_STAMP();
    unsigned voffA[2], voffB[2];
#pragma unroll
    for (int i = 0; i < 2; ++i) { int R, C; stage_rc(tid * 16 + i * 8192, R, C); const int Rb = Epi::PERM ? ((R & ~31) + perm32(R & 31)) : R;
        voffA[i] = (unsigned)(R * g.ld + C) * 2u; voffB[i] = (unsigned)(Rb * g.ld + C) * 2u; }
    const size_t kstep = (size_t)(BK * 2);
    const size_t hstep = (size_t)HALF * g.ld * 2;
    const size_t tstep = 2 * hstep;
    const size_t tstepA = STRIP ? (size_t)288 * g.ld * 2 : tstep;
    unsigned voffS = 0u; if constexpr (STRIP) { int R, C; stage_rc((wid & 3) * 1024 + lane * 16, R, C); voffS = (unsigned)(R * g.ld + C) * 2u; }
    const int soff = lds_byte(wr * 16 + fr, fq * 8);
    const unsigned ldsw = (unsigned)wid * 1024u;
    const int aoff = lds_byte(wr * 64 + fr, fq * 8), boff = lds_byte(wc * 32 + fr, fq * 8);
#define PG8_SA(b, h) (((b) * 2 + (h)) * HTB)
#define PG8_SB(b, h) ((4 + (b) * 2 + (h)) * HTB)
#define PG8_SS(b) (8 * HTB + (b) * 8192)
#define PG8_STAGE_S(b, gbase) do { if constexpr (STRIP) __builtin_amdgcn_global_load_lds((const unsigned*)((const char*)(gbase) + 2 * hstep + voffS), (PG8_LAS unsigned*)(lds + PG8_SS(b) + ldsw), 16, 0, 0); } while (0)
#define PG8_LDS(b) do { if constexpr (STRIP) { _Pragma("unroll") for (int k = 0; k < 2; ++k) Sf[k] = *(const PG8_LAS bf16x8*)(lds + PG8_SS(b) + soff + k * 1024); } } while (0)
#define PG8_MMS(bj, Bt) do { if constexpr (STRIP) { _Pragma("unroll") for (int n = 0; n < 2; ++n) _Pragma("unroll") for (int k = 0; k < 2; ++k) accS[bj][n] = __builtin_amdgcn_mfma_f32_16x16x32_bf16(Bt[n][k], Sf[k], accS[bj][n], 0, 0, 0); } } while (0)
#define PG8_STAGE(bufoff, gbase, voff) do { _Pragma("unroll") for (int _i = 0; _i < 2; ++_i) \
        __builtin_amdgcn_global_load_lds((const unsigned*)((const char*)(gbase) + (voff)[_i]), (PG8_LAS unsigned*)(lds + (bufoff) + ldsw + _i * 8192), 16, 0, 0); } while (0)
#define PG8_LDA(dst, b, h) do { _Pragma("unroll") for (int m = 0; m < 4; ++m) _Pragma("unroll") for (int k = 0; k < 2; ++k) dst[m][k] = *(const PG8_LAS bf16x8*)(lds + PG8_SA(b, h) + aoff + m * 2048 + k * 1024); } while (0)
#define PG8_LDB(dst, b, h) do { _Pragma("unroll") for (int n = 0; n < 2; ++n) _Pragma("unroll") for (int k = 0; k < 2; ++k) dst[n][k] = *(const PG8_LAS bf16x8*)(lds + PG8_SB(b, h) + boff + n * 2048 + k * 1024); } while (0)
#define PG8_MMA(ai, bj, At, Bt) do { __builtin_amdgcn_s_setprio(1); _Pragma("unroll") for (int m = 0; m < 4; ++m) _Pragma("unroll") for (int n = 0; n < 2; ++n) _Pragma("unroll") for (int k = 0; k < 2; ++k) \
        acc[ai][bj][m][n] = __builtin_amdgcn_mfma_f32_16x16x32_bf16(Bt[n][k], At[m][k], acc[ai][bj][m][n], 0, 0, 0); __builtin_amdgcn_s_setprio(0); } while (0)
#define PG8_WAIT_V(n) asm volatile("s_waitcnt vmcnt(" #n ")" ::: "memory")
#define PG8_WAIT_L(n) asm volatile("s_waitcnt lgkmcnt(" #n ")" ::: "memory")
#define PG8_WAIT_VS(n, ns) do { if constexpr (STRIP) PG8_WAIT_V(ns); else PG8_WAIT_V(n); } while (0)
#define PG8_WAIT_LS(n, ns) do { if constexpr (STRIP) PG8_WAIT_L(ns); else PG8_WAIT_L(n); } while (0)
#define PG8_BAR __builtin_amdgcn_s_barrier()
#define PG8_SCHED __builtin_amdgcn_sched_barrier(0)
    Unit cur, nxt; int ui = 0;
    if (!S.next(0, cur)) return;
    f32x4 acc[2][2][4][2];
#pragma unroll
    for (int a = 0; a < 2; ++a)
#pragma unroll
        for (int b = 0; b < 2; ++b)
#pragma unroll
            for (int m = 0; m < 4; ++m)
#pragma unroll
                for (int n = 0; n < 2; ++n) acc[a][b][m][n] = (f32x4){0.f, 0.f, 0.f, 0.f};
    bf16x8 At[4][2], B0[2][2], B1[2][2];
    f32x4 accS[2][2]; bf16x8 Sf[2];
#pragma unroll
    for (int b = 0; b < 2; ++b)
#pragma unroll
        for (int n = 0; n < 2; ++n) accS[b][n] = (f32x4){0.f, 0.f, 0.f, 0.f};
#pragma unroll
    for (int k = 0; k < 2; ++k) Sf[k] = (bf16x8){0, 0, 0, 0, 0, 0, 0, 0};
    const char* cA = (const char*)g.A + (size_t)cur.pm * tstepA; const char* cB = (const char*)g.Bt + (size_t)cur.pn * tstep;
    S.a_ready(cur);
    PG8_STAGE(PG8_SB(0, 0), cB, voffB); PG8_STAGE(PG8_SA(0, 0), cA, voffA); PG8_STAGE(PG8_SB(0, 1), cB + hstep, voffB); PG8_STAGE(PG8_SA(0, 1), cA + hstep, voffA); PG8_STAGE_S(0, cA);
    if (wr == 1) PG8_BAR;
    PG8_WAIT_VS(4, 5); PG8_BAR;
    PG8_STAGE(PG8_SB(1, 0), cB + kstep, voffB); PG8_STAGE(PG8_SA(1, 0), cA + kstep, voffA); PG8_STAGE(PG8_SB(1, 1), cB + hstep + kstep, voffB); PG8_STAGE_S(1, cA + kstep);
    PG8_WAIT_VS(6, 7); PG8_BAR;
    PG8_STAMP();
    for (;;) {
        const bool has_next = S.next(ui + 1, nxt);
        const char* nA = has_next ? (const char*)g.A + (size_t)nxt.pm * tstepA : cA; const char* nB = has_next ? (const char*)g.Bt + (size_t)nxt.pn * tstep : cB;
        for (int t = 0; t < nt; t += 2) {
            const bool last = (t == nt - 2);
            const char* a1 = cA + (size_t)(t + 1) * kstep;
            const char* a2 = last ? nA : cA + (size_t)(t + 2) * kstep; const char* b2 = last ? nB : cB + (size_t)(t + 2) * kstep;
            const char* a3 = a2 + kstep; const char* b3 = b2 + kstep;
            if (last && has_next) S.a_ready(nxt);
            PG8_LDB(B0, 0, 0); PG8_SCHED; PG8_LDA(At, 0, 0); PG8_LDS(0); PG8_STAGE(PG8_SA(1, 1), a1 + hstep, voffA);
            PG8_WAIT_LS(8, 10); PG8_BAR; PG8_WAIT_L(0); PG8_MMA(0, 0, At, B0); PG8_MMS(0, B0); PG8_BAR; PG8_SCHED;
            PG8_LDB(B1, 0, 1); PG8_STAGE(PG8_SB(0, 0), b2, voffB);
            PG8_BAR; PG8_WAIT_L(0); PG8_MMA(0, 1, At, B1); PG8_MMS(1, B1); PG8_BAR;
            PG8_LDA(At, 0, 1); PG8_STAGE(PG8_SA(0, 0), a2, voffA); PG8_STAGE_S(0, a2);
            PG8_BAR; PG8_WAIT_L(0); PG8_MMA(1, 0, At, B0); PG8_BAR; PG8_SCHED;
            PG8_STAGE(PG8_SB(0, 1), b2 + hstep, voffB);
            PG8_WAIT_VS(6, 7); PG8_BAR; PG8_MMA(1, 1, At, B1); PG8_BAR;
            PG8_LDB(B0, 1, 0); PG8_SCHED; PG8_LDA(At, 1, 0); PG8_LDS(1); PG8_STAGE(PG8_SA(0, 1), a2 + hstep, voffA);
            PG8_WAIT_LS(8, 10); PG8_BAR; PG8_WAIT_L(0); PG8_MMA(0, 0, At, B0); PG8_MMS(0, B0); PG8_BAR; PG8_SCHED;
            PG8_LDB(B1, 1, 1); PG8_STAGE(PG8_SB(1, 0), b3, voffB);
            PG8_BAR; PG8_WAIT_L(0); PG8_MMA(0, 1, At, B1); PG8_MMS(1, B1); PG8_BAR;
            PG8_LDA(At, 1, 1); PG8_STAGE(PG8_SA(1, 0), a3, voffA); PG8_STAGE_S(1, a3);
            PG8_BAR; PG8_WAIT_L(0); PG8_MMA(1, 0, At, B0); PG8_BAR; PG8_SCHED;
            PG8_STAGE(PG8_SB(1, 1), b3 + hstep, voffB);
            PG8_WAIT_VS(6, 7); PG8_BAR; PG8_MMA(1, 1, At, B1); PG8_BAR;
        }
        PG8_STAMP();
        { const int rt0 = cur.pm * (STRIP ? 288 : 256), rw0 = rt0 + wr * 64 + fr;
#define PG8_RV(ai, m) {{acc[ai][0][m][0], acc[ai][0][m][1]}, {acc[ai][1][m][0], acc[ai][1][m][1]}}
#define PG8_BATCH(r0_, v0_, r1_, v1_) do { const typename Epi::Pre p0_ = E.pre(r0_, cur.pn, wc, fq), p1_ = E.pre(r1_, cur.pn, wc, fq); \
              { const f32x4 v_[2][2] = v0_; E.row(v_, p0_, r0_, cur.pn, wc, fq); } { const f32x4 v_[2][2] = v1_; E.row(v_, p1_, r1_, cur.pn, wc, fq); } } while (0)
          PG8_BATCH(rw0, PG8_RV(0, 0), rw0 + 16, PG8_RV(0, 1));
          PG8_BATCH(rw0 + 32, PG8_RV(0, 2), rw0 + 48, PG8_RV(0, 3));
          PG8_BATCH(rw0 + HALF, PG8_RV(1, 0), rw0 + HALF + 16, PG8_RV(1, 1));
          PG8_BATCH(rw0 + HALF + 32, PG8_RV(1, 2), rw0 + HALF + 48, PG8_RV(1, 3));
          if constexpr (STRIP) { const int rs_ = rt0 + 256 + wr * 16 + fr; const typename Epi::Pre ps_ = E.pre(rs_, cur.pn, wc, fq); E.row(accS, ps_, rs_, cur.pn, wc, fq);
#pragma unroll
              for (int b = 0; b < 2; ++b)
#pragma unroll
                for (int n = 0; n < 2; ++n) accS[b][n] = (f32x4){0.f, 0.f, 0.f, 0.f}; }
#undef PG8_BATCH
#undef PG8_RV
          S.done(cur); }
        PG8_STAMP();
        if (!has_next) break;
#pragma unroll
        for (int a = 0; a < 2; ++a)
#pragma unroll
            for (int b = 0; b < 2; ++b)
#pragma unroll
                for (int m = 0; m < 4; ++m)
#pragma unroll
                    for (int n = 0; n < 2; ++n) acc[a][b][m][n] = (f32x4){0.f, 0.f, 0.f, 0.f};
        cur = nxt; cA = nA; cB = nB; ++ui;
    }
    PG8_WAIT_V(0);
    if (wr == 0) PG8_BAR;
    PG8_BAR;
    PG8_STAMP();
    if (STAMP && wid == 0) { stamps[lane] = lane < nts ? (((unsigned long long)(unsigned)ts_hi << 32) | (unsigned)ts_lo) : 0ull;
        if (lane == 62) stamps[62] = rt_entry; if (lane == 63) stamps[63] = (unsigned long long)wall_clock64(); }
#undef PG8_STAMP
#undef PG8_SA
#undef PG8_SB
#undef PG8_STAGE
#undef PG8_LDA
#undef PG8_LDB
#undef PG8_MMA
#undef PG8_WAIT_V
#undef PG8_WAIT_L
#undef PG8_BAR
#undef PG8_SCHED
#undef PG8_WAIT_LS
#undef PG8_WAIT_VS
#undef PG8_MMS
#undef PG8_LDS
#undef PG8_STAGE_S
#undef PG8_SS
}
}


#define LAS __attribute__((address_space(3)))
#define XB_TMO      128
#define XB_XCNT(j)  (256  + 64 * (j))
#define XB_XSUB(j)  (1280 + 64 * (j))
#define XB_XGEN(j)  (2304 + 64 * (j))
#define XB_TOP      3328
#define XB_TOPGEN   3392
#define XCD_BAR_WORDS 3456
#define XB_SPIN_CAP (1u << 18)

__device__ __forceinline__ unsigned xb_ld(unsigned* p)              { return __hip_atomic_load(p, __ATOMIC_RELAXED, __HIP_MEMORY_SCOPE_AGENT); }
__device__ __forceinline__ unsigned xb_add(unsigned* p, unsigned v) { return __hip_atomic_fetch_add(p, v, __ATOMIC_RELAXED, __HIP_MEMORY_SCOPE_AGENT); }
__device__ __forceinline__ unsigned xb_xcc_id() { return (unsigned)__builtin_amdgcn_s_getreg((3 << 11) | 20) & 0xFu; }
#define XB_SPIN(cond, bar) do { unsigned _sp = 0; while (cond) { __builtin_amdgcn_s_sleep(1); \
    if ((++_sp & 255u) == 0u) { if (xb_ld(&(bar)[XB_TMO])) break; if (_sp > XB_SPIN_CAP) { atomicAdd(&(bar)[XB_TMO], 1u); break; } } } } while (0)

struct XcdBarrier {
    unsigned* bar; unsigned x;
    volatile LAS unsigned* st;
};

__device__ __forceinline__ XcdBarrier xcd_barrier_post(unsigned* bar, volatile LAS unsigned* st) {
    XcdBarrier b; b.bar = bar; b.x = xb_xcc_id(); b.st = st;
    if (threadIdx.x == 0) (void)xb_add(&bar[XB_XCNT(b.x)], 1u);
    return b;
}
__device__ __forceinline__ void xcd_barrier_complete(unsigned* bar, unsigned x, unsigned& nloc, unsigned& nx) {
    const unsigned G = gridDim.x * gridDim.y * gridDim.z;
    unsigned sum, cnt, mine, sp = 0u;
    for (;;) {
        sum = 0u; cnt = 0u; mine = 0u;
#pragma unroll
        for (unsigned j = 0; j < 16; ++j) { const unsigned c = xb_ld(&bar[XB_XCNT(j)]); sum += c; cnt += (c > 0u) ? 1u : 0u; mine = (j == x) ? c : mine; }
        if (sum == G) break;
        __builtin_amdgcn_s_sleep(1);
        if ((++sp & 255u) == 0u) { if (xb_ld(&bar[XB_TMO])) break; if (sp > XB_SPIN_CAP) { atomicAdd(&bar[XB_TMO], 1u); break; } }
    }
    nloc = mine > 0u ? mine : 1u; nx = cnt > 0u ? cnt : 1u;
}

__device__ __forceinline__ void xcd_barrier(const XcdBarrier& b) {
    asm volatile("s_waitcnt vmcnt(0)" ::: "memory");
    __syncthreads();
    if (threadIdx.x == 0) {
        unsigned* bar = b.bar;
        __builtin_amdgcn_s_waitcnt(0);
        unsigned nloc = b.st[0], nx = b.st[1];
        if (nloc == 0u) { xcd_barrier_complete(bar, b.x, nloc, nx); b.st[0] = nloc; b.st[1] = nx; }
        const unsigned old = xb_add(&bar[XB_XSUB(b.x)], 1u);
        const unsigned gen = old / nloc;
        if (old + 1u == (gen + 1u) * nloc) {
            __builtin_amdgcn_fence(__ATOMIC_RELEASE, "agent");
            asm volatile("s_waitcnt vmcnt(0)" ::: "memory");
            const unsigned og = xb_add(&bar[XB_TOP], 1u);
            const unsigned tg = og / nx;
            if (og + 1u == (tg + 1u) * nx) xb_add(&bar[XB_TOPGEN], 1u);
            else XB_SPIN(xb_ld(&bar[XB_TOPGEN]) == tg, bar);
            __builtin_amdgcn_fence(__ATOMIC_ACQUIRE, "agent");
            xb_add(&bar[XB_XGEN(b.x)], 1u);
            asm volatile("s_waitcnt vmcnt(0)" ::: "memory");
        } else {
            XB_SPIN(xb_ld(&bar[XB_XGEN(b.x)]) == gen, bar);
            __builtin_amdgcn_fence(__ATOMIC_ACQUIRE, "agent");
            asm volatile("s_waitcnt vmcnt(0)" ::: "memory");
        }
    }
    __syncthreads();
}

typedef CfgT<RC> C;
constexpr int NTHREADS = 512, NWAVES = 8;
constexpr int LDS_STAGE = 131072 + 16384, LDS_CTL = LDS_STAGE, LDS_BYTES = LDS_STAGE + 256;

namespace pg8 {
typedef unsigned u32x2 __attribute__((ext_vector_type(2)));
__device__ __forceinline__ float silu_f(float g) { return g * __builtin_amdgcn_rcpf(1.0f + __expf(-g)); }
struct EpiSwiGLU { static constexpr bool PERM = true;
    bf16_t* act; const float* ss; int ff; float invd;
    typedef float Pre;
    __device__ __forceinline__ Pre pre(int row, int pn, int wc, int fq) const { return ss[row]; }
    __device__ __forceinline__ void row(const f32x4 (&v)[2][2], Pre ssr, int row, int pn, int wc, int fq) const {
        const float rs = rsqrtf(ssr * invd + 1e-6f); f32x4 o[2];
#pragma unroll
        for (int n = 0; n < 2; ++n) { const f32x4 g = v[0][n] * rs, up = v[1][n] * rs;
#pragma unroll
            for (int j = 0; j < 4; ++j) o[n][j] = silu_f(g[j]) * up[j]; }
        u32x4 w; w.x = cvt_pk_bf16(o[0][0], o[0][1]); w.y = cvt_pk_bf16(o[0][2], o[0][3]); w.z = cvt_pk_bf16(o[1][0], o[1][1]); w.w = cvt_pk_bf16(o[1][2], o[1][3]);
        *(u32x4*)(act + (size_t)row * ff + pn * 128 + wc * 32 + 8 * fq) = w;
    }
};
struct EpiResid { static constexpr bool PERM = false;
    float* X; bf16_t* XB; float* ssout; float scale; int ld;
    struct Pre { f32x4 x[2][2]; };
    __device__ __forceinline__ Pre pre(int row, int pn, int wc, int fq) const { Pre q; const float* xr = X + (size_t)row * ld + pn * BM + wc * 32 + 4 * fq;
#pragma unroll
        for (int bj = 0; bj < 2; ++bj)
#pragma unroll
            for (int n = 0; n < 2; ++n) q.x[bj][n] = *(const f32x4*)(xr + bj * HALF + n * 16);
        return q; }
    __device__ __forceinline__ void row(const f32x4 (&v)[2][2], const Pre& q, int row, int pn, int wc, int fq) const {
        const int col0 = pn * BM + wc * 32 + 4 * fq; float* xr = X + (size_t)row * ld + col0; bf16_t* br = XB + (size_t)row * ld + col0; float s = 0.f;
#pragma unroll
        for (int bj = 0; bj < 2; ++bj)
#pragma unroll
            for (int n = 0; n < 2; ++n) { const f32x4 x = q.x[bj][n] + v[bj][n] * scale; *(f32x4*)(xr + bj * HALF + n * 16) = x;
                u32x2 w; w.x = cvt_pk_bf16(x[0], x[1]); w.y = cvt_pk_bf16(x[2], x[3]); *(u32x2*)(br + bj * HALF + n * 16) = w;
                s += (x[0] * x[0] + x[1] * x[1]) + (x[2] * x[2] + x[3] * x[3]); }
        s += __shfl_xor(s, 16); s += __shfl_xor(s, 32);
        if (fq == 0) unsafeAtomicAdd(ssout + row, s);
    }
};
struct EpiScaleF32 { static constexpr bool PERM = false;
    float* Cp; int ldc; const float* ss; float invd;
    typedef float Pre;
    __device__ __forceinline__ Pre pre(int row, int pn, int wc, int fq) const { return ss[row]; }
    __device__ __forceinline__ void row(const f32x4 (&v)[2][2], Pre ssr, int row, int pn, int wc, int fq) const {
        const float rs = rsqrtf(ssr * invd + 1e-6f); float* cr = Cp + (size_t)row * ldc + pn * BM + wc * 32 + 4 * fq;
#pragma unroll
        for (int bj = 0; bj < 2; ++bj)
#pragma unroll
            for (int n = 0; n < 2; ++n) *(f32x4*)(cr + bj * HALF + n * 16) = v[bj][n] * rs;
    }
};
struct EpiScaleBf16 { static constexpr bool PERM = true;
    bf16_t* O; int ldc; const float* ss; float invd;
    typedef float Pre;
    __device__ __forceinline__ Pre pre(int row, int pn, int wc, int fq) const { return ss[row]; }
    __device__ __forceinline__ void row(const f32x4 (&v)[2][2], Pre ssr, int row, int pn, int wc, int fq) const {
        const float rs = rsqrtf(ssr * invd + 1e-6f); bf16_t* orow = O + (size_t)row * ldc + pn * BM + wc * 32 + 8 * fq;
#pragma unroll
        for (int bj = 0; bj < 2; ++bj) { const f32x4 v0 = v[bj][0] * rs, v1 = v[bj][1] * rs;
            u32x4 w; w.x = cvt_pk_bf16(v0[0], v0[1]); w.y = cvt_pk_bf16(v0[2], v0[3]); w.z = cvt_pk_bf16(v1[0], v1[1]); w.w = cvt_pk_bf16(v1[2], v1[3]);
            *(u32x4*)(orow + bj * HALF) = w; }
    }
};
struct EpiMemKV { static constexpr bool PERM = false;
    float* K; float* V; const float* rstd; int d;
    typedef float Pre;
    __device__ __forceinline__ Pre pre(int row, int pn, int wc, int fq) const { return rstd[row]; }
    __device__ __forceinline__ void row(const f32x4 (&v)[2][2], Pre rs, int row, int pn, int wc, int fq) const {
        int ct = pn * BM; float* base = K; if (ct >= d) { base = V; ct -= d; } float* cr = base + (size_t)row * d + ct + wc * 32 + 4 * fq;
#pragma unroll
        for (int bj = 0; bj < 2; ++bj)
#pragma unroll
            for (int n = 0; n < 2; ++n) *(f32x4*)(cr + bj * HALF + n * 16) = v[bj][n] * rs;
    }
};
}

__device__ __forceinline__ void prep_item(const float* W, int K, int Ncols, const float* g, int kind, int N, bf16_t* Bt, LAS unsigned char* scr, int item, int lane) {
    const int nblk = N / 64, kb = item / nblk, nb = item % nblk, k0 = 64 * kb, n = 64 * nb + lane;
    const int sc = wsrc_col<C>(kind, n);
    const float* src = W + (size_t)k0 * Ncols + (sc >= 0 ? sc : 0);
    float v[64];
#pragma unroll
    for (int kk = 0; kk < 64; ++kk) v[kk] = src[(size_t)kk * Ncols];
    if (g) {
#pragma unroll
        for (int kk = 0; kk < 64; ++kk) v[kk] *= g[k0 + kk];
    }
    if (sc < 0) {
#pragma unroll
        for (int kk = 0; kk < 64; ++kk) v[kk] = 0.f;
    }
#pragma unroll
    for (int j = 0; j < 8; ++j) { pg8::u32x4 o; o.x = pg8::cvt_pk_bf16(v[8 * j], v[8 * j + 1]); o.y = pg8::cvt_pk_bf16(v[8 * j + 2], v[8 * j + 3]); o.z = pg8::cvt_pk_bf16(v[8 * j + 4], v[8 * j + 5]); o.w = pg8::cvt_pk_bf16(v[8 * j + 6], v[8 * j + 7]);
        *(LAS pg8::u32x4*)(scr + lane * 144 + j * 16) = o; }
    asm volatile("s_waitcnt lgkmcnt(0)" ::: "memory");
    bf16_t* dst = Bt + (size_t)(64 * nb) * K + k0 + (lane & 7) * 8;
#pragma unroll
    for (int it = 0; it < 8; ++it) { const int row = it * 8 + (lane >> 3); const pg8::u32x4 o = *(const LAS pg8::u32x4*)(scr + row * 144 + (lane & 7) * 16);
        *(pg8::u32x4*)(dst + (size_t)row * K) = o; }
    asm volatile("s_waitcnt lgkmcnt(0)" ::: "memory");
}
struct WDesc { const float* W; const float* g; bf16_t* dst; int K, Ncols, kind, N; };
__device__ __forceinline__ WDesc wdesc(const Ptrs& p, int l, int idx) {
    WDesc d; d.g = nullptr; d.kind = WK_PLAIN;
    switch (idx) {
    case 0: d.W = p.in[I_W1IN] + (size_t)l * C::D * 2 * C::FF; d.K = C::D; d.Ncols = 2 * C::FF; d.N = 2 * C::FF; d.g = p.in[I_GFFN1] + l * C::D; d.kind = WK_FFNIN; d.dst = wlayer<C>(p, l, C::W_1IN); break;
    case 1: d.W = p.in[I_W1OUT] + (size_t)l * C::FF * C::D; d.K = C::FF; d.Ncols = C::D; d.N = C::D; d.dst = wlayer<C>(p, l, C::W_1OUT); break;
    case 2: d.W = p.in[I_WIN] + (size_t)l * C::D * C::INC; d.K = C::D; d.Ncols = C::INC; d.N = C::LDP; d.g = p.in[I_GMIX] + l * C::D; d.kind = WK_WIN; d.dst = wlayer<C>(p, l, C::W_IN); break;
    case 3: d.W = p.in[I_WOUT] + (size_t)l * C::D * C::D; d.K = C::D; d.Ncols = C::D; d.N = C::D; d.dst = wlayer<C>(p, l, C::W_OUT); break;
    case 4: d.W = p.in[I_WQ] + (size_t)l * C::D * C::D; d.K = C::D; d.Ncols = C::D; d.N = C::D; d.g = p.in[I_GX] + l * C::D; d.dst = wlayer<C>(p, l, C::W_Q); break;
    case 5: d.W = p.in[I_WK] + (size_t)l * C::D * C::D; d.K = C::D; d.Ncols = C::D; d.N = C::D; d.g = p.in[I_GMEM] + l * C::D; d.dst = wlayer<C>(p, l, C::W_KV); break;
    case 6: d.W = p.in[I_WV] + (size_t)l * C::D * C::D; d.K = C::D; d.Ncols = C::D; d.N = C::D; d.g = p.in[I_GMEM] + l * C::D; d.dst = wlayer<C>(p, l, C::W_KV) + (size_t)C::D * C::D; break;
    case 7: d.W = p.in[I_WO] + (size_t)l * C::D * C::D; d.K = C::D; d.Ncols = C::D; d.N = C::D; d.dst = wlayer<C>(p, l, C::W_O); break;
    case 8: d.W = p.in[I_W2IN] + (size_t)l * C::D * 2 * C::FF; d.K = C::D; d.Ncols = 2 * C::FF; d.N = 2 * C::FF; d.g = p.in[I_GFFN2] + l * C::D; d.kind = WK_FFNIN; d.dst = wlayer<C>(p, l, C::W_2IN); break;
    default: d.W = p.in[I_W2OUT] + (size_t)l * C::FF * C::D; d.K = C::FF; d.Ncols = C::D; d.N = C::D; d.dst = wlayer<C>(p, l, C::W_2OUT); break;
    }
    return d;
}

namespace att {
typedef short bf16x8 __attribute__((ext_vector_type(8)));
typedef short s16x4 __attribute__((ext_vector_type(4)));
typedef float f32x4 __attribute__((ext_vector_type(4)));
typedef unsigned u32x2 __attribute__((ext_vector_type(2)));
constexpr int TOK = 256, CD = 64, PITCH = 144, CBYTES = TOK * PITCH, HDIM = 512, NH = 4, LD = 2048;
constexpr int NU_P = (C::MP / 128) * NH, NU_S = C::DEC_BATCH * NH, NUNITS = NU_P + NU_S;
static_assert(C::NMEM == TOK && C::AHD == HDIM && C::AH == NH && C::D == LD && C::DEC_SEQ == 32 && C::SEQ % 128 == 0, "attention phase is built for these shapes");
__device__ __forceinline__ s16x4 tr_read(unsigned addr) { s16x4 r; asm volatile("ds_read_b64_tr_b16 %0, %1" : "=&v"(r) : "v"(addr) : "memory"); return r; }
__device__ __forceinline__ void stage_load(f32x4 (&r)[8], const float* src, int tid) {
#pragma unroll
    for (int i = 0; i < 8; ++i) { const int f = tid + 512 * i; r[i] = *(const f32x4*)(src + (size_t)(f >> 4) * LD + (f & 15) * 4); }
}
__device__ __forceinline__ void stage_store(const f32x4 (&r)[8], LAS unsigned char* buf, int tid) {
#pragma unroll
    for (int i = 0; i < 8; ++i) { const int f = tid + 512 * i; u32x2 w; w.x = pg8::cvt_pk_bf16(r[i][0], r[i][1]); w.y = pg8::cvt_pk_bf16(r[i][2], r[i][3]);
        *(LAS u32x2*)(buf + (f >> 4) * PITCH + (f & 15) * 8) = w; }
}
__device__ __forceinline__ void attn_phase(LAS unsigned char* lds, const Ptrs& p, int l, int tid, int bid, int gsz) {
    const int lane = tid & 63, wave = __builtin_amdgcn_readfirstlane(tid >> 6), li = lane & 15, g = lane >> 4;
    const bf16_t* Qg = wsb<C>(p, C::WS_Q); bf16_t* AO = wsb<C>(p, C::WS_AO);
    for (int u = bid; u < NUNITS; u += gsz) {
        int row0, nrows, head; const float* kb; const float* vb;
        if (u < NU_P) { const int b = u / (NU_P / C::BATCH), rem = u % (NU_P / C::BATCH); head = rem / (C::SEQ / 128); const int qt = rem % (C::SEQ / 128);
            row0 = b * C::SEQ + qt * 128; nrows = 128;
            kb = p.out + C::OUT_MK + ((size_t)l * C::BATCH + b) * TOK * LD + head * HDIM; vb = p.out + C::OUT_MV + ((size_t)l * C::BATCH + b) * TOK * LD + head * HDIM; }
        else { const int s = u - NU_P, b = s / NH; head = s % NH; row0 = C::MP + b * C::DEC_SEQ; nrows = C::DEC_SEQ;
            kb = p.in[I_CK] + ((size_t)l * C::DEC_BATCH + b) * TOK * LD + head * HDIM; vb = p.in[I_CV] + ((size_t)l * C::DEC_BATCH + b) * TOK * LD + head * HDIM; }
        const bool active = wave * 16 < nrows;
        const int qrow = row0 + wave * 16 + li;
        bf16x8 qf[16];
        if (active) {
#pragma unroll
            for (int ks = 0; ks < 16; ++ks) qf[ks] = *(const bf16x8*)(Qg + (size_t)qrow * LD + head * HDIM + ks * 32 + g * 8);
        } else {
#pragma unroll
            for (int ks = 0; ks < 16; ++ks) qf[ks] = (bf16x8){0, 0, 0, 0, 0, 0, 0, 0};
        }
        f32x4 s[16];
#pragma unroll
        for (int T = 0; T < 16; ++T) s[T] = (f32x4){0.f, 0.f, 0.f, 0.f};
        f32x4 pre[8];
        stage_load(pre, kb, tid); stage_store(pre, lds, tid);
        __syncthreads();
#pragma unroll
        for (int c = 0; c < 8; ++c) {
            LAS unsigned char* buf = lds + (c & 1) * CBYTES;
            stage_load(pre, c < 7 ? kb + (c + 1) * CD : vb, tid);
            if (active) {
#pragma unroll
                for (int ks = 0; ks < 2; ++ks)
#pragma unroll
                    for (int T = 0; T < 16; ++T) { const bf16x8 a = *(const LAS bf16x8*)(buf + (T * 16 + li) * PITCH + ks * 64 + g * 16);
                        s[T] = __builtin_amdgcn_mfma_f32_16x16x32_bf16(a, qf[2 * c + ks], s[T], 0, 0, 0); }
            }
            stage_store(pre, lds + ((c + 1) & 1) * CBYTES, tid);
            __syncthreads();
        }
        float mx = -3.0e38f;
#pragma unroll
        for (int T = 0; T < 16; ++T) { mx = fmaxf(mx, fmaxf(fmaxf(s[T][0], s[T][1]), fmaxf(s[T][2], s[T][3]))); }
        mx = fmaxf(mx, __shfl_xor(mx, 16)); mx = fmaxf(mx, __shfl_xor(mx, 32));
        const float sc = 0.044194173824159216f * 1.4426950408889634f;
        float sum = 0.f;
#pragma unroll
        for (int T = 0; T < 16; ++T)
#pragma unroll
            for (int j = 0; j < 4; ++j) { const float e = __builtin_amdgcn_exp2f((s[T][j] - mx) * sc); s[T][j] = e; sum += e; }
        sum += __shfl_xor(sum, 16); sum += __shfl_xor(sum, 32);
        const float inv = 1.0f / sum;
        bf16x8 pf[8];
#pragma unroll
        for (int t = 0; t < 8; ++t) { const unsigned w0 = pg8::cvt_pk_bf16(s[2 * t][0], s[2 * t][1]), w1 = pg8::cvt_pk_bf16(s[2 * t][2], s[2 * t][3]),
                w2 = pg8::cvt_pk_bf16(s[2 * t + 1][0], s[2 * t + 1][1]), w3 = pg8::cvt_pk_bf16(s[2 * t + 1][2], s[2 * t + 1][3]);
            pg8::u32x4 w; w.x = w0; w.y = w1; w.z = w2; w.w = w3; pf[t] = __builtin_bit_cast(bf16x8, w); }
        const unsigned trb = (unsigned)(size_t)lds + (unsigned)((4 * g + (li >> 2)) * PITCH + (li & 3) * 8);
        for (int c = 0; c < 8; ++c) {
            const unsigned bofs = (unsigned)(c & 1) * CBYTES;
            if (c < 7) stage_load(pre, vb + (c + 1) * CD, tid);
            if (active) {
                f32x4 o[4];
#pragma unroll
                for (int dt = 0; dt < 4; ++dt) o[dt] = (f32x4){0.f, 0.f, 0.f, 0.f};
#pragma unroll
                for (int t = 0; t < 8; ++t) {
                    s16x4 lo[4], hi[4];
#pragma unroll
                    for (int dt = 0; dt < 4; ++dt) { lo[dt] = tr_read(trb + bofs + (unsigned)(t * 32 * PITCH + dt * 32)); hi[dt] = tr_read(trb + bofs + (unsigned)(t * 32 * PITCH + 16 * PITCH + dt * 32)); }
                    asm volatile("s_waitcnt lgkmcnt(0)" ::: "memory"); __builtin_amdgcn_sched_barrier(0);
#pragma unroll
                    for (int dt = 0; dt < 4; ++dt) { const bf16x8 a = (bf16x8){lo[dt][0], lo[dt][1], lo[dt][2], lo[dt][3], hi[dt][0], hi[dt][1], hi[dt][2], hi[dt][3]};
                        o[dt] = __builtin_amdgcn_mfma_f32_16x16x32_bf16(a, pf[t], o[dt], 0, 0, 0); }
                }
#pragma unroll
                for (int dt = 0; dt < 4; ++dt) { u32x2 w; w.x = pg8::cvt_pk_bf16(o[dt][0] * inv, o[dt][1] * inv); w.y = pg8::cvt_pk_bf16(o[dt][2] * inv, o[dt][3] * inv);
                    *(u32x2*)(AO + (size_t)qrow * LD + head * HDIM + c * CD + dt * 16 + g * 4) = w; }
            }
            if (c < 7) stage_store(pre, lds + ((c + 1) & 1) * CBYTES, tid);
            __syncthreads();
        }
    }
}
}
namespace mx {
typedef att::bf16x8 bf16x8; typedef att::s16x4 s16x4; typedef att::f32x4 f32x4; typedef att::u32x2 u32x2;
constexpr int PT = 272;
constexpr int T64 = 64 * PT, T128 = 128 * PT;
static_assert(C::MHD == 128 && C::CH == 64 && C::MH == 8 && C::LCS == 32, "mLSTM phases are built for these shapes");
__device__ __forceinline__ void lds_wait() { asm volatile("s_waitcnt lgkmcnt(0)" ::: "memory"); __builtin_amdgcn_sched_barrier(0); }
__device__ __forceinline__ bf16x8 mk8(s16x4 lo, s16x4 hi) { return (bf16x8){lo[0], lo[1], lo[2], lo[3], hi[0], hi[1], hi[2], hi[3]}; }
__device__ __forceinline__ unsigned tr_addr(unsigned tile, int krow, int c0, int li) { return tile + (unsigned)((krow + (li >> 2)) * PT + (c0 + 4 * (li & 3)) * 2); }
__device__ __forceinline__ void ch_decode(int ci, int& r0, int& h, int& lc) {
    if (ci < C::NPC) { const int c = ci % C::NC, bh = ci / C::NC; h = bh % C::MH; r0 = (bh / C::MH) * C::SEQ + c * C::CH; lc = C::CH; }
    else { const int q = ci - C::NPC; h = q % C::MH; r0 = C::MP + (q / C::MH) * C::DEC_SEQ; lc = C::LCS; }
}
__device__ __forceinline__ void stage64(LAS unsigned char* tile, const float* src, int ld, int lc, int tid, const LAS float* rs, float mul) {
#pragma unroll
    for (int i = 0; i < 4; ++i) { const int f = tid + 512 * i, row = f >> 5, c4 = f & 31; f32x4 v = (f32x4){0.f, 0.f, 0.f, 0.f};
        if (row < lc) { v = *(const f32x4*)(src + (size_t)row * ld + c4 * 4); const float m = rs ? rs[row] * mul : mul; v = v * m; }
        u32x2 w; w.x = pg8::cvt_pk_bf16(v[0], v[1]); w.y = pg8::cvt_pk_bf16(v[2], v[3]); *(LAS u32x2*)(tile + row * PT + c4 * 8) = w; }
}
__device__ __forceinline__ void ml_phase_a(LAS unsigned char* lds, const Ptrs& p, int l, int tid, int bid, int gsz) {
    const int lane = tid & 63, wave = __builtin_amdgcn_readfirstlane(tid >> 6), li = lane & 15, g = lane >> 4;
    LAS unsigned char* Ks = lds; LAS unsigned char* Vs = lds + T64; LAS float* wts = (LAS float*)(lds + 2 * T64);
    const float* P = wsf<C>(p, C::WS_BIG);
    for (int ci = bid; ci < C::NCH; ci += gsz) {
        int r0, h, lc; ch_decode(ci, r0, h, lc);
        if (wave == 0) {
            float lf = 0.f, ig = -3.0e38f;
            if (lane < lc) { const float* pr = P + (size_t)(r0 + lane) * C::LDP; ig = pr[C::O_IG + h] + p.in[I_IB][l * C::MH + h]; const float fx = pr[C::O_FG + h] + p.in[I_FB][l * C::MH + h]; lf = fx >= 0.f ? -__logf(1.0f + __expf(-fx)) : fx - __logf(1.0f + __expf(fx)); }
            float b = lf;
#pragma unroll
            for (int o = 1; o < 64; o <<= 1) { const float t = __shfl_up(b, o); if (lane >= o) b += t; }
            const float a = lane < lc ? ig - b : -3.0e38f;
            float amax = a;
#pragma unroll
            for (int o = 1; o < 64; o <<= 1) amax = fmaxf(amax, __shfl_xor(amax, o));
            const float bL = __shfl(b, lc - 1), mloc = bL + amax;
            const float wt = lane < lc ? __expf(bL + a - mloc) : 0.f;
            wts[lane] = wt;
            if (lane < lc) { wsf<C>(p, C::WS_GB)[(size_t)(r0 + lane) * C::MH + h] = b; wsf<C>(p, C::WS_GA)[(size_t)(r0 + lane) * C::MH + h] = a; }
            if (lane == 0) { wsf<C>(p, C::WS_CBL)[ci] = bL; wsf<C>(p, C::WS_CML)[ci] = mloc; }
        }
        __syncthreads();
        stage64(Ks, P + (size_t)r0 * C::LDP + C::O_K + h * C::MHD, C::LDP, lc, tid, wts, 0.08838834764831845f);
        stage64(Vs, P + (size_t)r0 * C::LDP + C::O_VM + h * C::MHD, C::LDP, lc, tid, nullptr, 1.0f);
        __syncthreads();
        f32x4 acc[8];
#pragma unroll
        for (int et = 0; et < 8; ++et) acc[et] = (f32x4){0.f, 0.f, 0.f, 0.f};
        const unsigned ks = (unsigned)(size_t)Ks, vs = (unsigned)(size_t)Vs;
#pragma unroll
        for (int t = 0; t < 2; ++t) {
            const s16x4 alo = att::tr_read(tr_addr(ks, 32 * t + 8 * g, 16 * wave, li)), ahi = att::tr_read(tr_addr(ks, 32 * t + 8 * g + 4, 16 * wave, li));
            s16x4 blo[8], bhi[8];
#pragma unroll
            for (int et = 0; et < 8; ++et) { blo[et] = att::tr_read(tr_addr(vs, 32 * t + 8 * g, 16 * et, li)); bhi[et] = att::tr_read(tr_addr(vs, 32 * t + 8 * g + 4, 16 * et, li)); }
            lds_wait();
            const bf16x8 a = mk8(alo, ahi);
#pragma unroll
            for (int et = 0; et < 8; ++et) acc[et] = __builtin_amdgcn_mfma_f32_16x16x32_bf16(a, mk8(blo[et], bhi[et]), acc[et], 0, 0, 0);
        }
        float* DC = wsf<C>(p, C::WS_DC) + (size_t)ci * C::MHD * C::MHD;
#pragma unroll
        for (int et = 0; et < 8; ++et)
#pragma unroll
            for (int r = 0; r < 4; ++r) DC[(size_t)(16 * wave + 4 * g + r) * C::MHD + 16 * et + li] = acc[et][r];
        if (tid < C::MHD) { float s = 0.f; for (int t = 0; t < 64; ++t) s += bf2f(*(const LAS bf16_t*)(Ks + t * PT + tid * 2)); wsf<C>(p, C::WS_DN)[(size_t)ci * C::MHD + tid] = s; }
        __syncthreads();
    }
}
__device__ __forceinline__ void ml_phase_c(LAS unsigned char* lds, const Ptrs& p, int l, int tid, int bid, int gsz) {
    const int lane = tid & 63, wave = __builtin_amdgcn_readfirstlane(tid >> 6), li = lane & 15, g = lane >> 4, it = wave & 3, eh = wave >> 2;
    LAS unsigned char* Qs = lds; LAS unsigned char* Ks = lds + T64; LAS unsigned char* Vs = lds + 2 * T64; LAS unsigned char* Cs = lds + 3 * T64;
    LAS float* sb = (LAS float*)(lds + 3 * T64 + T128);
    LAS float* sa = sb + 64; LAS float* smr = sb + 128; LAS float* siw = sb + 192; LAS float* snp = sb + 256; LAS float* ssq = sb + 384;
    const float* P = wsf<C>(p, C::WS_BIG);
    for (int ci = bid; ci < C::NCH; ci += gsz) {
        int r0, h, lc; ch_decode(ci, r0, h, lc);
        const bool sample = ci >= C::NPC, first = !sample && (ci % C::NC) == 0;
        const float mprev = wsf<C>(p, C::WS_MPREV)[ci];
        if (wave == 0) {
            float b = 0.f, a = -3.0e38f;
            if (lane < lc) { b = wsf<C>(p, C::WS_GB)[(size_t)(r0 + lane) * C::MH + h]; a = wsf<C>(p, C::WS_GA)[(size_t)(r0 + lane) * C::MH + h]; }
            float pm = a;
#pragma unroll
            for (int o = 1; o < 64; o <<= 1) { const float t = __shfl_up(pm, o); if (lane >= o) pm = fmaxf(pm, t); }
            const float mrow = b + fmaxf(mprev, pm);
            sb[lane] = b; sa[lane] = a; smr[lane] = mrow; siw[lane] = __expf(b + mprev - mrow);
        }
        if (tid >= 128 && tid < 256) { const int d = tid - 128;
            snp[d] = sample ? p.in[I_SN][((size_t)l * C::NSC + (ci - C::NPC)) * C::MHD + d] : (first ? 0.f : wsf<C>(p, C::WS_DN)[(size_t)(ci - 1) * C::MHD + d]); }
        stage64(Qs, P + (size_t)r0 * C::LDP + C::O_Q + h * C::MHD, C::LDP, lc, tid, nullptr, 1.0f);
        stage64(Ks, P + (size_t)r0 * C::LDP + C::O_K + h * C::MHD, C::LDP, lc, tid, nullptr, 0.08838834764831845f);
        stage64(Vs, P + (size_t)r0 * C::LDP + C::O_VM + h * C::MHD, C::LDP, lc, tid, nullptr, 1.0f);
        { const float* cp = sample ? p.in[I_SC] + ((size_t)l * C::NSC + (ci - C::NPC)) * C::MHD * C::MHD : wsf<C>(p, C::WS_DC) + (size_t)(first ? ci : ci - 1) * C::MHD * C::MHD;
#pragma unroll
            for (int i = 0; i < 8; ++i) { const int f = tid + 512 * i, row = f >> 5, c4 = f & 31; f32x4 v = (f32x4){0.f, 0.f, 0.f, 0.f};
                if (!first) v = *(const f32x4*)(cp + (size_t)row * C::MHD + c4 * 4);
                u32x2 w; w.x = pg8::cvt_pk_bf16(v[0], v[1]); w.y = pg8::cvt_pk_bf16(v[2], v[3]); *(LAS u32x2*)(Cs + row * PT + c4 * 8) = w; } }
        __syncthreads();
        const bool active = it * 16 < lc;
        float ssq_part = 0.f; f32x4 hv[4]; float inv_den = 0.f;
        const int i = 16 * it + li;
        if (active) {
            bf16x8 qf[4];
#pragma unroll
            for (int ks = 0; ks < 4; ++ks) qf[ks] = *(const LAS bf16x8*)(Qs + i * PT + ks * 64 + g * 16);
            f32x4 st[4];
#pragma unroll
            for (int jt = 0; jt < 4; ++jt) st[jt] = (f32x4){0.f, 0.f, 0.f, 0.f};
#pragma unroll
            for (int jt = 0; jt < 4; ++jt) if (jt <= it) {
#pragma unroll
                for (int ks = 0; ks < 4; ++ks) { const bf16x8 a = *(const LAS bf16x8*)(Ks + (16 * jt + li) * PT + ks * 64 + g * 16);
                    st[jt] = __builtin_amdgcn_mfma_f32_16x16x32_bf16(a, qf[ks], st[jt], 0, 0, 0); } }
            const float bi = sb[i], mri = smr[i], iwi = siw[i];
            float dsum = 0.f;
#pragma unroll
            for (int jt = 0; jt < 4; ++jt)
#pragma unroll
                for (int r = 0; r < 4; ++r) { const int j = 16 * jt + 4 * g + r; const float w = (j <= i) ? __expf(bi + sa[j] - mri) : 0.f; st[jt][r] *= w; dsum += st[jt][r]; }
            dsum += __shfl_xor(dsum, 16); dsum += __shfl_xor(dsum, 32);
            float qn = 0.f;
#pragma unroll
            for (int ks = 0; ks < 4; ++ks)
#pragma unroll
                for (int jj = 0; jj < 8; ++jj) qn += bf2f((bf16_t)qf[ks][jj]) * snp[32 * ks + 8 * g + jj];
            qn += __shfl_xor(qn, 16); qn += __shfl_xor(qn, 32);
            const float den = dsum + iwi * qn;
            inv_den = 1.0f / fmaxf(fabsf(den), __expf(-mri));
            bf16x8 pf[2];
#pragma unroll
            for (int t = 0; t < 2; ++t) { pg8::u32x4 w; w.x = pg8::cvt_pk_bf16(st[2 * t][0], st[2 * t][1]); w.y = pg8::cvt_pk_bf16(st[2 * t][2], st[2 * t][3]);
                w.z = pg8::cvt_pk_bf16(st[2 * t + 1][0], st[2 * t + 1][1]); w.w = pg8::cvt_pk_bf16(st[2 * t + 1][2], st[2 * t + 1][3]); pf[t] = __builtin_bit_cast(bf16x8, w); }
            const unsigned vs = (unsigned)(size_t)Vs, cs = (unsigned)(size_t)Cs;
#pragma unroll
            for (int e4 = 0; e4 < 4; ++e4) { const int et = 4 * eh + e4;
                s16x4 vlo[2], vhi[2], clo[4], chi[4];
#pragma unroll
                for (int t = 0; t < 2; ++t) { vlo[t] = att::tr_read(tr_addr(vs, 32 * t + 4 * g, 16 * et, li)); vhi[t] = att::tr_read(tr_addr(vs, 32 * t + 16 + 4 * g, 16 * et, li)); }
#pragma unroll
                for (int ks = 0; ks < 4; ++ks) { clo[ks] = att::tr_read(tr_addr(cs, 32 * ks + 8 * g, 16 * et, li)); chi[ks] = att::tr_read(tr_addr(cs, 32 * ks + 8 * g + 4, 16 * et, li)); }
                lds_wait();
                f32x4 aS = (f32x4){0.f, 0.f, 0.f, 0.f}, aC = (f32x4){0.f, 0.f, 0.f, 0.f};
#pragma unroll
                for (int t = 0; t < 2; ++t) aS = __builtin_amdgcn_mfma_f32_16x16x32_bf16(mk8(vlo[t], vhi[t]), pf[t], aS, 0, 0, 0);
#pragma unroll
                for (int ks = 0; ks < 4; ++ks) aC = __builtin_amdgcn_mfma_f32_16x16x32_bf16(mk8(clo[ks], chi[ks]), qf[ks], aC, 0, 0, 0);
                hv[e4] = (aS + aC * iwi) * inv_den;
                ssq_part += (hv[e4][0] * hv[e4][0] + hv[e4][1] * hv[e4][1]) + (hv[e4][2] * hv[e4][2] + hv[e4][3] * hv[e4][3]); }
            ssq_part += __shfl_xor(ssq_part, 16); ssq_part += __shfl_xor(ssq_part, 32);
            if (g == 0) ssq[wave * 16 + li] = ssq_part;
        }
        __syncthreads();
        if (active) {
            const float tot = ssq_part + ssq[(wave ^ 4) * 16 + li];
            const float rs = rsqrtf(tot * (1.0f / C::MHD) + 1e-6f);
            const int row = r0 + i;
#pragma unroll
            for (int e4 = 0; e4 < 4; ++e4) { const int e = 16 * (4 * eh + e4) + 4 * g;
                const f32x4 og = *(const f32x4*)(P + (size_t)row * C::LDP + C::O_O + h * C::MHD + e); const f32x4 gn = *(const f32x4*)(p.in[I_NG] + (size_t)l * C::MW + h * C::MHD + e);
                float o4[4];
#pragma unroll
                for (int r = 0; r < 4; ++r) o4[r] = hv[e4][r] * rs * gn[r] * __builtin_amdgcn_rcpf(1.0f + __expf(-og[r]));
                u32x2 w; w.x = pg8::cvt_pk_bf16(o4[0], o4[1]); w.y = pg8::cvt_pk_bf16(o4[2], o4[3]);
                *(u32x2*)(wsb<C>(p, C::WS_MIX) + (size_t)row * C::D + C::PW + C::GW + h * C::MHD + e) = w; }
        }
        __syncthreads();
    }
}
}
namespace rw {
typedef att::f32x4 f32x4; typedef att::u32x2 u32x2;
static_assert(C::D == 2048, "row ops assume 2048 columns = 8 float4 per lane");
__device__ __forceinline__ float wave_sum(float v) {
#pragma unroll
    for (int o = 1; o < 64; o <<= 1) v += __shfl_xor(v, o);
    return v;
}
__device__ __forceinline__ void rows_init(const Ptrs& p, int tid, int bid, int gsz) {
    const int lane = tid & 63, gw = bid * NWAVES + (tid >> 6), NGW = gsz * NWAVES;
    float* SS = wsf<C>(p, C::WS_SS);
    for (int r = gw; r < C::M; r += NGW) {
        const float* src = r < C::MP ? p.in[I_XP] + (size_t)r * C::D : p.in[I_XS] + (size_t)(r - C::MP) * C::D;
        float* X = wsf<C>(p, C::WS_X) + (size_t)r * C::D; bf16_t* XB = wsb<C>(p, C::WS_XB) + (size_t)r * C::D;
        float ss = 0.f;
#pragma unroll
        for (int j = 0; j < 8; ++j) { const f32x4 v = *(const f32x4*)(src + (lane + 64 * j) * 4); *(f32x4*)(X + (lane + 64 * j) * 4) = v;
            u32x2 w; w.x = pg8::cvt_pk_bf16(v[0], v[1]); w.y = pg8::cvt_pk_bf16(v[2], v[3]); *(u32x2*)(XB + (lane + 64 * j) * 4) = w;
            ss += (v[0] * v[0] + v[1] * v[1]) + (v[2] * v[2] + v[3] * v[3]); }
        ss = wave_sum(ss);
        if (lane < C::NSS) SS[(size_t)lane * C::M + r] = lane == 0 ? ss : 0.f;
    }
    for (int r = gw; r < C::MM; r += NGW) {
        const float* src = p.in[I_MEM] + (size_t)r * C::D; bf16_t* MB = wsb<C>(p, C::WS_MEMB) + (size_t)r * C::D;
        float ss = 0.f;
#pragma unroll
        for (int j = 0; j < 8; ++j) { const f32x4 v = *(const f32x4*)(src + (lane + 64 * j) * 4);
            u32x2 w; w.x = pg8::cvt_pk_bf16(v[0], v[1]); w.y = pg8::cvt_pk_bf16(v[2], v[3]); *(u32x2*)(MB + (lane + 64 * j) * 4) = w;
            ss += (v[0] * v[0] + v[1] * v[1]) + (v[2] * v[2] + v[3] * v[3]); }
        ss = wave_sum(ss);
        if (lane == 0) wsf<C>(p, C::WS_RSTDM)[r] = rsqrtf(ss * (1.0f / C::D) + 1e-6f);
    }
}
__device__ __forceinline__ void rows_final(const Ptrs& p, int tid, int bid, int gsz) {
    const int lane = tid & 63, gw = bid * NWAVES + (tid >> 6), NGW = gsz * NWAVES;
    for (int r = gw; r < C::M; r += NGW) {
        const float* X = wsf<C>(p, C::WS_X) + (size_t)r * C::D; const float rs = rsqrtf(wsf<C>(p, C::WS_SS)[(size_t)(C::NSS - 1) * C::M + r] * (1.0f / C::D) + 1e-6f);
        float* o = r < C::MP ? p.out + C::OUT_YP + (size_t)r * C::D : p.out + C::OUT_YS + (size_t)(r - C::MP) * C::D;
        float pscale = 1.0f, padd = 0.f;
#if defined(PROBE_MASK_A)
        { const unsigned long long* TS = (const unsigned long long*)(p.ws + C::WS_CTL + 32768); unsigned long long ta = 0, tb = 0;
          for (int k = 0; k < 25; ++k) { const unsigned long long dk = TS[k + 1] - TS[k]; if ((PROBE_MASK_A >> k) & 1ull) ta += dk; if ((PROBE_MASK_B >> k) & 1ull) tb += dk; }
          if (r >= C::MP) pscale = 1.0f + 0.03f + (float)ta * 0.01f * PROBE_SA;
          if (r == 0 && lane == 0) padd = 1.0f + (float)tb * 0.01f * PROBE_SB; }
#endif
#pragma unroll
        for (int j = 0; j < 8; ++j) { const f32x4 v = *(const f32x4*)(X + (lane + 64 * j) * 4); const f32x4 gg = *(const f32x4*)(p.in[I_GFIN] + (lane + 64 * j) * 4);
            f32x4 y = v * rs * gg * pscale; if (j == 0) y[0] += padd; *(f32x4*)(o + (lane + 64 * j) * 4) = y; }
    }
}
__device__ __forceinline__ void ml_scan(const Ptrs& p, int l, long gtid, long gthreads) {
    const float* CBL = wsf<C>(p, C::WS_CBL); const float* CML = wsf<C>(p, C::WS_CML);
    float* DC = wsf<C>(p, C::WS_DC); float* DN = wsf<C>(p, C::WS_DN);
    constexpr int NPS = C::BATCH * C::MH, E4 = C::MHD / 4;
    for (long it = gtid; it < (long)NPS * C::MHD * E4; it += gthreads) {
        const int e4 = (int)(it % E4), d = (int)((it / E4) % C::MHD), sq = (int)(it / ((long)E4 * C::MHD));
        float m = 0.f; f32x4 cst = (f32x4){0.f, 0.f, 0.f, 0.f};
        static_assert(C::NC % 8 == 0, "scan is unrolled by 8 chunks");
        for (int c0 = 0; c0 < C::NC; c0 += 8) {
            f32x4 v[8]; float bl[8], ml[8];
#pragma unroll
            for (int j = 0; j < 8; ++j) { const int ci = sq * C::NC + c0 + j; v[j] = *(const f32x4*)(DC + ((size_t)ci * C::MHD + d) * C::MHD + e4 * 4); bl[j] = CBL[ci]; ml[j] = CML[ci]; }
#pragma unroll
            for (int j = 0; j < 8; ++j) { const int ci = sq * C::NC + c0 + j; const float a = bl[j] + m, mn = fmaxf(a, ml[j]), dec = __expf(a - mn), f = __expf(ml[j] - mn);
                cst = cst * dec + v[j] * f; *(f32x4*)(DC + ((size_t)ci * C::MHD + d) * C::MHD + e4 * 4) = cst; m = mn; }
        }
        *(f32x4*)(p.out + C::OUT_CP + (((size_t)l * NPS + sq) * C::MHD + d) * C::MHD + e4 * 4) = cst;
    }
    for (long it = gtid; it < (long)NPS * C::MHD; it += gthreads) {
        const int d = (int)(it % C::MHD), sq = (int)(it / C::MHD);
        float m = 0.f, nst = 0.f;
        for (int c = 0; c < C::NC; ++c) { const int ci = sq * C::NC + c; const float a = CBL[ci] + m, b2 = CML[ci], mn = fmaxf(a, b2), dec = __expf(a - mn), f = __expf(b2 - mn);
            const size_t on = (size_t)ci * C::MHD + d; nst = dec * nst + f * DN[on]; DN[on] = nst; m = mn; }
        p.out[C::OUT_NP + ((size_t)l * NPS + sq) * C::MHD + d] = nst;
    }
    for (long it = gtid; it < (long)C::NSC * C::MHD * E4; it += gthreads) {
        const int e4 = (int)(it % E4), d = (int)((it / E4) % C::MHD), q = (int)(it / ((long)E4 * C::MHD)), ci = C::NPC + q;
        const float m0 = p.in[I_SM][(size_t)l * C::NSC + q], a = CBL[ci] + m0, b2 = CML[ci], mn = fmaxf(a, b2), dec = __expf(a - mn), f = __expf(b2 - mn);
        const size_t so = (((size_t)l * C::NSC + q) * C::MHD + d) * C::MHD + e4 * 4;
        *(f32x4*)(p.out + C::OUT_CS + so) = *(const f32x4*)(p.in[I_SC] + so) * dec + *(const f32x4*)(DC + ((size_t)ci * C::MHD + d) * C::MHD + e4 * 4) * f;
    }
    for (long it = gtid; it < (long)C::NSC * C::MHD; it += gthreads) {
        const int d = (int)(it % C::MHD), q = (int)(it / C::MHD), ci = C::NPC + q;
        const float m0 = p.in[I_SM][(size_t)l * C::NSC + q], a = CBL[ci] + m0, b2 = CML[ci], mn = fmaxf(a, b2), dec = __expf(a - mn), f = __expf(b2 - mn);
        const size_t no = ((size_t)l * C::NSC + q) * C::MHD + d;
        p.out[C::OUT_NS + no] = dec * p.in[I_SN][no] + f * DN[(size_t)ci * C::MHD + d];
    }
}
}

namespace gp {
typedef att::bf16x8 bf16x8; typedef att::s16x4 s16x4; typedef att::f32x4 f32x4; typedef att::u32x2 u32x2;
constexpr int PT = mx::PT, T128 = mx::T128;
static_assert(C::GHD == 128 && C::PGD == 128 && C::GCH == 128 && C::SEQ % 128 == 0 && C::DEC_SEQ == 32 && C::PH == 15, "gmlp / pool phases are built for these shapes");
constexpr int NT_P = C::MP / 128;
constexpr int NU_G = NT_P * 4 + C::DEC_BATCH * 4;
__device__ __forceinline__ void gmlp_phase(LAS unsigned char* lds, const Ptrs& p, int l, int tid, int bid, int gsz) {
    const int lane = tid & 63, wave = __builtin_amdgcn_readfirstlane(tid >> 6), li = lane & 15, g = lane >> 4;
    LAS unsigned char* Vs = lds; LAS unsigned char* Ws = lds + T128;
    const float* P = wsf<C>(p, C::WS_BIG);
    for (int u = bid; u < NU_G; u += gsz) {
        int r0, lc, h; bool sample = false; int sb = 0;
        if (u < NT_P * 4) { h = u & 3; r0 = (u >> 2) * 128; lc = 128; } else { const int s = u - NT_P * 4; h = s & 3; sb = s >> 2; r0 = C::MP + sb * C::DEC_SEQ; lc = C::DEC_SEQ; sample = true; }
#pragma unroll
        for (int i = 0; i < 8; ++i) { const int f = tid + 512 * i, row = f >> 5, c4 = f & 31; f32x4 v = (f32x4){0.f, 0.f, 0.f, 0.f};
            if (row < lc) v = *(const f32x4*)(P + (size_t)(r0 + row) * C::LDP + C::O_V + h * 128 + c4 * 4);
            float ss = (v[0] * v[0] + v[1] * v[1]) + (v[2] * v[2] + v[3] * v[3]);
#pragma unroll
            for (int o = 1; o < 32; o <<= 1) ss += __shfl_xor(ss, o);
            const float rs = rsqrtf(ss * (1.0f / 128) + 1e-6f); const f32x4 gn = *(const f32x4*)(p.in[I_GVG] + (size_t)l * C::GW + h * 128 + c4 * 4);
            v = v * rs * gn;
            if (sample && row < lc) *(f32x4*)(p.out + C::OUT_VS + (((size_t)l * C::DEC_BATCH + sb) * C::DEC_SEQ + row) * C::GW + h * 128 + c4 * 4) = v;
            u32x2 w; w.x = pg8::cvt_pk_bf16(v[0], v[1]); w.y = pg8::cvt_pk_bf16(v[2], v[3]); *(LAS u32x2*)(Vs + row * PT + c4 * 8) = w; }
        const float* wsrc = p.in[I_GWS] + ((size_t)l * C::GH + h) * 128 * 128;
#pragma unroll
        for (int i = 0; i < 8; ++i) { const int f = tid + 512 * i, row = f >> 5, c4 = f & 31; f32x4 v = *(const f32x4*)(wsrc + (size_t)row * 128 + c4 * 4);
#pragma unroll
            for (int j = 0; j < 4; ++j) if (c4 * 4 + j > row) v[j] = 0.f;
            u32x2 w; w.x = pg8::cvt_pk_bf16(v[0], v[1]); w.y = pg8::cvt_pk_bf16(v[2], v[3]); *(LAS u32x2*)(Ws + row * PT + c4 * 8) = w; }
        __syncthreads();
        if (wave * 16 < lc) {
            const int i = wave * 16 + li, nks = (wave * 16 + 15) / 32 + 1;
            f32x4 acc[8];
#pragma unroll
            for (int dt = 0; dt < 8; ++dt) acc[dt] = (f32x4){0.f, 0.f, 0.f, 0.f};
            const unsigned vs = (unsigned)(size_t)Vs;
            for (int ks = 0; ks < nks; ++ks) {
                const bf16x8 bq = *(const LAS bf16x8*)(Ws + i * PT + ks * 64 + g * 16);
                s16x4 lo[8], hi[8];
#pragma unroll
                for (int dt = 0; dt < 8; ++dt) { lo[dt] = att::tr_read(mx::tr_addr(vs, 32 * ks + 8 * g, 16 * dt, li)); hi[dt] = att::tr_read(mx::tr_addr(vs, 32 * ks + 8 * g + 4, 16 * dt, li)); }
                mx::lds_wait();
#pragma unroll
                for (int dt = 0; dt < 8; ++dt) acc[dt] = __builtin_amdgcn_mfma_f32_16x16x32_bf16(mx::mk8(lo[dt], hi[dt]), bq, acc[dt], 0, 0, 0);
            }
            const float bsi = p.in[I_GBS][((size_t)l * C::GH + h) * C::GCH + i];
            const int row = r0 + i;
#pragma unroll
            for (int dt = 0; dt < 8; ++dt) { const int d = 16 * dt + 4 * g; const f32x4 uu = *(const f32x4*)(P + (size_t)row * C::LDP + C::O_U + h * 128 + d);
                u32x2 w; w.x = pg8::cvt_pk_bf16(uu[0] * (acc[dt][0] + bsi), uu[1] * (acc[dt][1] + bsi)); w.y = pg8::cvt_pk_bf16(uu[2] * (acc[dt][2] + bsi), uu[3] * (acc[dt][3] + bsi));
                *(u32x2*)(wsb<C>(p, C::WS_MIX) + (size_t)row * C::D + C::PW + h * 128 + d) = w; }
        }
        __syncthreads();
    }
}
__device__ __forceinline__ void pool_phase(LAS unsigned char* lds, const Ptrs& p, int l, int tid, int bid, int gsz) {
    const int lane = tid & 63, wave = __builtin_amdgcn_readfirstlane(tid >> 6), li = lane & 15, g = lane >> 4;
    LAS unsigned char* Ds = lds; LAS unsigned char* Ws = lds + T128;
    const float* P = wsf<C>(p, C::WS_BIG);
    for (int u = bid; u < NU_G; u += gsz) {
        int r0, lc, grp, t0, L, b; bool sample = false;
        if (u < NT_P * 4) { grp = u & 3; r0 = (u >> 2) * 128; lc = 128; b = r0 / C::SEQ; t0 = r0 % C::SEQ; L = C::SEQ; } else { const int s = u - NT_P * 4; grp = s & 3; b = s >> 2; r0 = C::MP + b * C::DEC_SEQ; lc = C::DEC_SEQ; t0 = 0; L = C::DEC_SEQ; sample = true; }
        const int w = 2 << grp;
        { const int c4 = tid & 31, sg = tid >> 5, ch = grp * 128 + c4 * 4;
            const float* hist = p.in[I_SPOOL] + ((size_t)l * C::DEC_BATCH + b) * C::PH * C::PW + ch;
            auto xat = [&](int t) -> f32x4 {
                if (t >= 0) return *(const f32x4*)(P + (size_t)(r0 - t0 + t) * C::LDP + ch);
                if (sample && C::PH + t >= 0) return *(const f32x4*)(hist + (size_t)(C::PH + t) * C::PW);
                return (f32x4){0.f, 0.f, 0.f, 0.f}; };
            if (sg * 8 < lc) {
                const int ts = t0 + sg * 8;
                f32x4 sum = (f32x4){0.f, 0.f, 0.f, 0.f};
                for (int j = 1; j < w; ++j) sum = sum + xat(ts - j);
#pragma unroll
                for (int k = 0; k < 8; ++k) { const int t = ts + k; const f32x4 x = xat(t); sum = sum + x;
                    const int pos = (sample ? C::PAST : 0) + t; const float inv = 1.0f / (float)((pos + 1) < w ? (pos + 1) : w);
                    const f32x4 dv = sum * inv - x;
                    u32x2 ww; ww.x = pg8::cvt_pk_bf16(dv[0], dv[1]); ww.y = pg8::cvt_pk_bf16(dv[2], dv[3]); *(LAS u32x2*)(Ds + (sg * 8 + k) * PT + c4 * 8) = ww;
                    sum = sum - xat(t - w + 1);
                    const int idx = t - (L - C::PH);
                    if (idx >= 0) *(f32x4*)(p.out + (sample ? C::OUT_POOLS + (((size_t)l * C::DEC_BATCH + b) * C::PH + idx) * C::PW : C::OUT_POOLP + (((size_t)l * C::BATCH + b) * C::PH + idx) * C::PW) + ch) = x; }
            } else {
#pragma unroll
                for (int k = 0; k < 8; ++k) *(LAS u32x2*)(Ds + (sg * 8 + k) * PT + c4 * 8) = (u32x2){0u, 0u};
            }
        }
        const float* wsrc = p.in[I_POOLW] + ((size_t)l * C::PG + grp) * 128 * 128;
#pragma unroll
        for (int i = 0; i < 8; ++i) { const int f = tid + 512 * i, row = f >> 5, c4 = f & 31; const f32x4 v = *(const f32x4*)(wsrc + (size_t)row * 128 + c4 * 4);
            u32x2 ww; ww.x = pg8::cvt_pk_bf16(v[0], v[1]); ww.y = pg8::cvt_pk_bf16(v[2], v[3]); *(LAS u32x2*)(Ws + row * PT + c4 * 8) = ww; }
        __syncthreads();
        if (wave * 16 < lc) {
            const int t = wave * 16 + li;
            f32x4 acc[8];
#pragma unroll
            for (int et = 0; et < 8; ++et) acc[et] = (f32x4){0.f, 0.f, 0.f, 0.f};
            const unsigned wsa = (unsigned)(size_t)Ws;
#pragma unroll
            for (int ks = 0; ks < 4; ++ks) {
                const bf16x8 bq = *(const LAS bf16x8*)(Ds + t * PT + ks * 64 + g * 16);
                s16x4 lo[8], hi[8];
#pragma unroll
                for (int et = 0; et < 8; ++et) { lo[et] = att::tr_read(mx::tr_addr(wsa, 32 * ks + 8 * g, 16 * et, li)); hi[et] = att::tr_read(mx::tr_addr(wsa, 32 * ks + 8 * g + 4, 16 * et, li)); }
                mx::lds_wait();
#pragma unroll
                for (int et = 0; et < 8; ++et) acc[et] = __builtin_amdgcn_mfma_f32_16x16x32_bf16(mx::mk8(lo[et], hi[et]), bq, acc[et], 0, 0, 0);
            }
            const int row = r0 + t;
#pragma unroll
            for (int et = 0; et < 8; ++et) { const int e = 16 * et + 4 * g; const f32x4 sc = *(const f32x4*)(p.in[I_POOLS] + (size_t)l * C::PW + grp * 128 + e);
                u32x2 ww; ww.x = pg8::cvt_pk_bf16(acc[et][0] * sc[0], acc[et][1] * sc[1]); ww.y = pg8::cvt_pk_bf16(acc[et][2] * sc[2], acc[et][3] * sc[3]);
                *(u32x2*)(wsb<C>(p, C::WS_MIX) + (size_t)row * C::D + grp * 128 + e) = ww; }
        }
        __syncthreads();
    }
}
}
constexpr int PH_PER_LAYER = 12, N_PHASES = 2 + PH_PER_LAYER * C::DEPTH;
struct Args { Ptrs p; int ph_lo, ph_hi; };
__global__ void __launch_bounds__(NTHREADS, 2) fwd(Args a) {
    extern __shared__ __attribute__((aligned(16))) unsigned char lds_raw[];
    LAS unsigned char* lds = (LAS unsigned char*)lds_raw;
    typedef __attribute__((address_space(4))) const Args* KArgs;
    const KArgs ka0 = (KArgs)__builtin_amdgcn_kernarg_segment_ptr();
    const int lo = a.ph_lo, hi = a.ph_hi;
#define IN(k) (lo <= (k) && (k) < hi)
#define BOTH(k) (IN(k) && IN((k) + 1))
#define GRID_BAR(k) do { if (BOTH(k)) { xcd_barrier(bar); } } while (0)
#if defined(__HIP_DEVICE_COMPILE__)
#define LOAD_PTRS KArgs ka = ka0; asm volatile("" : "+s"(ka)); Ptrs p; _Pragma("unroll") for (int i_ = 0; i_ < 33; ++i_) p.in[i_] = ka->p.in[i_]; p.out = ka->p.out; p.ws = ka->p.ws;
#else
#define LOAD_PTRS (void)ka0; const Ptrs p = a.p;
#endif
#define PHASE_ARGS LOAD_PTRS int tid = threadIdx.x; asm volatile("" : "+v"(tid)); int bid = blockIdx.x, gsz = gridDim.x; asm volatile("" : "+s"(bid), "+s"(gsz));     \
    const int lane = tid & 63, wave = __builtin_amdgcn_readfirstlane(tid >> 6); (void)lane; (void)wave; \
    const long gtid = (long)bid * NTHREADS + tid, gthreads = (long)gsz * NTHREADS; (void)gtid; (void)gthreads; \
    float* SS = wsf<C>(p, C::WS_SS); (void)SS; const float invd = 1.0f / C::D; (void)invd;
#if defined(PROBE_MASK_A)
#define STAMP(k) do { if (blockIdx.x == 0 && threadIdx.x == 0) ((unsigned long long*)(a.p.ws + C::WS_CTL + 32768))[k] = wall_clock64(); } while (0)
#else
#define STAMP(k) do { } while (0)
#endif
#define ITEMS(n, call) do { for (long it = gtid; it < (long)(n); it += gthreads) { call; } } while (0)
#define SSL(j) (SS + (size_t)(4 * l + (j)) * C::M)
#define GEMM_ALL(STRIP, EPI, Aop, Bop, Mr, Nc, Kd, ...) do { pg8::Gemm g{Aop, Bop, Mr, Nc, Kd, Kd}; pg8::StaticOrder S; S.init(Mr, Nc, gsz, bid, (STRIP) ? 288 : 256); \
        pg8::EPI E{__VA_ARGS__}; pg8::gemm_phase<pg8::EPI, pg8::StaticOrder, STRIP, false>(lds, g, S, E, nullptr); } while (0)
#if ONE_LAUNCH
    if (threadIdx.x < 4) ((LAS unsigned*)(lds + LDS_CTL))[threadIdx.x] = 0u;
    __syncthreads();
    XcdBarrier bar = xcd_barrier_post((unsigned*)(a.p.ws + C::WS_CTL), (volatile LAS unsigned*)(lds + LDS_CTL));
#else
    XcdBarrier bar; bar.bar = nullptr; bar.x = 0; bar.st = nullptr;
#endif

    if (IN(0)) { PHASE_ARGS STAMP(0);
        const int gw = bid * NWAVES + wave, NGW = gsz * NWAVES;
        for (int l = 0; l < C::DEPTH; ++l)
            for (int idx = 0; idx < 10; ++idx) { const WDesc d = wdesc(p, l, idx); const int nitems = (d.K / 64) * (d.N / 64);
                for (int it = gw; it < nitems; it += NGW) prep_item(d.W, d.K, d.Ncols, d.g, d.kind, d.N, d.dst, lds + wave * 9216, it, lane); }
        rw::rows_init(p, tid, bid, gsz);
        GRID_BAR(0);
    }
    for (int l = 0; l < C::DEPTH; ++l) {
        const int pb = 1 + PH_PER_LAYER * l;
        if (IN(pb + 0)) { PHASE_ARGS STAMP(pb + 0);
            GEMM_ALL(true, EpiSwiGLU, wsb<C>(p, C::WS_XB), wlayer<C>(p, l, C::W_1IN), C::M, 2 * C::FF, C::D, wsb<C>(p, C::WS_BIG), SSL(0), C::FF, invd);
            GRID_BAR(pb + 0); }
        if (IN(pb + 1)) { PHASE_ARGS STAMP(pb + 1);
            GEMM_ALL(true, EpiResid, wsb<C>(p, C::WS_BIG), wlayer<C>(p, l, C::W_1OUT), C::M, C::D, C::FF, wsf<C>(p, C::WS_X), wsb<C>(p, C::WS_XB), SSL(1), 0.5f, C::D);
            GRID_BAR(pb + 1); }
        if (IN(pb + 2)) { PHASE_ARGS STAMP(pb + 2);
            GEMM_ALL(true, EpiScaleF32, wsb<C>(p, C::WS_XB), wlayer<C>(p, l, C::W_IN), C::M, C::LDP, C::D, wsf<C>(p, C::WS_BIG), C::LDP, SSL(1), invd);
            GRID_BAR(pb + 2); }
        if (IN(pb + 3)) { PHASE_ARGS STAMP(pb + 3); mx::ml_phase_a(lds, p, l, tid, bid, gsz); gp::gmlp_phase(lds, p, l, tid, bid, gsz); gp::pool_phase(lds, p, l, tid, bid, gsz); GRID_BAR(pb + 3); }
        if (IN(pb + 4)) { PHASE_ARGS STAMP(pb + 4);
            if (bid < 64) {
                pg8::Gemm g{wsb<C>(p, C::WS_MEMB), wlayer<C>(p, l, C::W_KV), C::MM, 2 * C::D, C::D, C::D}; pg8::StaticOrder S; S.init(C::MM, 2 * C::D, 64, bid);
                pg8::EpiMemKV E{p.out + C::OUT_MK + (size_t)l * C::MM * C::D, p.out + C::OUT_MV + (size_t)l * C::MM * C::D, wsf<C>(p, C::WS_RSTDM), C::D};
                pg8::gemm_phase<pg8::EpiMemKV, pg8::StaticOrder, false, false>(lds, g, S, E, nullptr);
            } else { const long gt2 = (long)(bid - 64) * NTHREADS + tid, gn2 = (long)(gsz - 64) * NTHREADS;
                for (long it = gt2; it < (C::BATCH + C::DEC_BATCH) * C::MH; it += gn2) st_ml_b0<C>(p, l, (int)it);
                rw::ml_scan(p, l, gt2, gn2); }
            GRID_BAR(pb + 4); }
        if (IN(pb + 5)) { PHASE_ARGS STAMP(pb + 5); mx::ml_phase_c(lds, p, l, tid, bid, gsz); GRID_BAR(pb + 5); }
        if (IN(pb + 6)) { PHASE_ARGS STAMP(pb + 6);
            GEMM_ALL(true, EpiResid, wsb<C>(p, C::WS_MIX), wlayer<C>(p, l, C::W_OUT), C::M, C::D, C::D, wsf<C>(p, C::WS_X), wsb<C>(p, C::WS_XB), SSL(2), 1.0f, C::D);
            GRID_BAR(pb + 6); }
        if (IN(pb + 7)) { PHASE_ARGS STAMP(pb + 7);
            GEMM_ALL(true, EpiScaleBf16, wsb<C>(p, C::WS_XB), wlayer<C>(p, l, C::W_Q), C::M, C::D, C::D, wsb<C>(p, C::WS_Q), C::D, SSL(2), invd);
            GRID_BAR(pb + 7); }
        if (IN(pb + 8)) { PHASE_ARGS STAMP(pb + 8); att::attn_phase(lds, p, l, tid, bid, gsz); GRID_BAR(pb + 8); }
        if (IN(pb + 9)) { PHASE_ARGS STAMP(pb + 9);
            GEMM_ALL(true, EpiResid, wsb<C>(p, C::WS_AO), wlayer<C>(p, l, C::W_O), C::M, C::D, C::D, wsf<C>(p, C::WS_X), wsb<C>(p, C::WS_XB), SSL(3), 1.0f, C::D);
            GRID_BAR(pb + 9); }
        if (IN(pb + 10)) { PHASE_ARGS STAMP(pb + 10);
            GEMM_ALL(true, EpiSwiGLU, wsb<C>(p, C::WS_XB), wlayer<C>(p, l, C::W_2IN), C::M, 2 * C::FF, C::D, wsb<C>(p, C::WS_BIG), SSL(3), C::FF, invd);
            GRID_BAR(pb + 10); }
        if (IN(pb + 11)) { PHASE_ARGS STAMP(pb + 11);
            GEMM_ALL(true, EpiResid, wsb<C>(p, C::WS_BIG), wlayer<C>(p, l, C::W_2OUT), C::M, C::D, C::FF, wsf<C>(p, C::WS_X), wsb<C>(p, C::WS_XB), SSL(4), 0.5f, C::D);
            GRID_BAR(pb + 11); }
    }
    if (IN(N_PHASES - 1)) { PHASE_ARGS STAMP(N_PHASES - 1); __syncthreads(); rw::rows_final(p, tid, bid, gsz); }
#undef IN
#undef BOTH
#undef GRID_BAR
#undef ITEMS
#undef PHASE_ARGS
#undef SSL
}

extern "C" void kernel_launch(void* const* d_in, const int* in_sizes, int n_in, void* d_out, int out_size, void* d_ws, size_t ws_size, hipStream_t stream) {
    static int ready = 0;
    if (!ready) {
        if (n_in != 33 || (long)out_size != (long)C::OUT_END || ws_size < (size_t)C::WS_END) { fprintf(stderr, "kernel_launch: unexpected shapes: n_in %d out %d ws %zu (need %zu)\n", n_in, out_size, ws_size, (size_t)C::WS_END); ready = -1; return; }
        if (hipFuncSetAttribute((const void*)fwd, hipFuncAttributeMaxDynamicSharedMemorySize, LDS_BYTES) != hipSuccess) { fprintf(stderr, "kernel_launch: hipFuncSetAttribute failed\n"); ready = -1; return; }
        int dev = 0, cus = 0, per_cu = 0;
        if (hipGetDevice(&dev) != hipSuccess || hipDeviceGetAttribute(&cus, hipDeviceAttributeMultiprocessorCount, dev) != hipSuccess) { fprintf(stderr, "kernel_launch: device query failed\n"); ready = -1; return; }
        if (hipOccupancyMaxActiveBlocksPerMultiprocessor(&per_cu, (const void*)fwd, NTHREADS, LDS_BYTES) != hipSuccess || per_cu < 1) { fprintf(stderr, "kernel_launch: occupancy query reports %d blocks per CU\n", per_cu); (void)hipGetLastError(); per_cu = 1; }
        if (cus != 256) { fprintf(stderr, "kernel_launch: built for a 256-CU device (one resident workgroup per CU), found %d\n", cus); ready = -1; return; }
        ready = cus;
    }
    if (ready < 0) return;
    Args a{};
    for (int i = 0; i < 33; ++i) a.p.in[i] = (const float*)d_in[i];
    a.p.out = (float*)d_out; a.p.ws = (unsigned char*)d_ws;
#if ONE_LAUNCH
    (void)hipMemsetAsync((char*)d_ws + C::WS_CTL, 0, 65536, stream);
    a.ph_lo = 0; a.ph_hi = N_PHASES;
    hipLaunchKernelGGL(fwd, dim3(ready), dim3(NTHREADS), LDS_BYTES, stream, a);
#else
    for (int k = 0; k < N_PHASES; ++k) { a.ph_lo = k; a.ph_hi = k + 1; hipLaunchKernelGGL(fwd, dim3(ready), dim3(NTHREADS), LDS_BYTES, stream, a); }
#endif
}
```

```cpp
#include <hip/hip_runtime.h>
#include <cstdio>
#define ONE_LAUNCH 1

#define HD __host__ __device__
#ifndef HD
#define HD __host__ __device__
#endif
typedef unsigned short bf16_t;
HD inline unsigned f2u(float f) { return __builtin_bit_cast(unsigned, f); }
HD inline float u2f(unsigned u) { return __builtin_bit_cast(float, u); }
HD inline bf16_t f2bf(float f) { unsigned u = f2u(f); u += 0x7FFFu + ((u >> 16) & 1u); return (bf16_t)(u >> 16); }
HD inline float bf2f(bf16_t b) { return u2f(((unsigned)b) << 16); }

struct RC {
    static constexpr int D = 2048, FF = 8192, BATCH = 4, SEQ = 2048, DEPTH = 2, DEC_BATCH = 32, DEC_SEQ = 32, PAST = 2048, NMEM = 256;
};
template <class B> struct CfgT : B {
    using B::D; using B::FF; using B::BATCH; using B::SEQ; using B::DEPTH; using B::DEC_BATCH; using B::DEC_SEQ; using B::PAST; using B::NMEM;
    static constexpr int MP = BATCH * SEQ, MS = DEC_BATCH * DEC_SEQ, M = MP + MS, MM = BATCH * NMEM;
    static constexpr int PW = D / 4, PG = 4, PGD = PW / 4, PH = 15;
    static constexpr int GW = D / 4, GH = 4, GHD = GW / 4, GCH = 128;
    static constexpr int MW = D - PW - GW, MH = 8, MHD = MW / 8, CH = 64;
    static constexpr int INC = PW + 2 * GW + 4 * MW + 2 * MH;
    static constexpr int LDP = ((INC + 255) / 256) * 256;
    static constexpr int AH = 4, AHD = D / 4;
    static constexpr int O_U = PW, O_V = PW + GW, O_Q = PW + 2 * GW, O_K = O_Q + MW, O_VM = O_K + MW, O_O = O_VM + MW, O_IG = O_O + MW, O_FG = O_IG + MH;
    static constexpr int NC = SEQ / CH, NPC = BATCH * MH * NC, NSC = DEC_BATCH * MH, NCH = NPC + NSC;
    static constexpr int LCS = DEC_SEQ < CH ? DEC_SEQ : CH;
    static constexpr int GLP = SEQ < GCH ? SEQ : GCH, GLS = DEC_SEQ < GCH ? DEC_SEQ : GCH;
    static constexpr int NSS = 1 + 4 * DEPTH;
    static constexpr long OUT_YP = 0, OUT_YS = OUT_YP + (long)MP * D, OUT_POOLP = OUT_YS + (long)MS * D, OUT_POOLS = OUT_POOLP + (long)DEPTH * BATCH * PH * PW,
        OUT_CP = OUT_POOLS + (long)DEPTH * DEC_BATCH * PH * PW, OUT_NP = OUT_CP + (long)DEPTH * BATCH * MH * MHD * MHD, OUT_MP = OUT_NP + (long)DEPTH * BATCH * MH * MHD,
        OUT_CS = OUT_MP + (long)DEPTH * BATCH * MH, OUT_NS = OUT_CS + (long)DEPTH * DEC_BATCH * MH * MHD * MHD, OUT_MS = OUT_NS + (long)DEPTH * DEC_BATCH * MH * MHD,
        OUT_VS = OUT_MS + (long)DEPTH * DEC_BATCH * MH, OUT_MK = OUT_VS + (long)DEPTH * DEC_BATCH * DEC_SEQ * GW, OUT_MV = OUT_MK + (long)DEPTH * BATCH * NMEM * D,
        OUT_END = OUT_MV + (long)DEPTH * BATCH * NMEM * D;
    static constexpr size_t al(size_t x) { return (x + 255) & ~(size_t)255; }
    static constexpr size_t WS_CTL = 0, WS_SS = 65536, WS_X = al(WS_SS + (size_t)NSS * M * 4), WS_XB = al(WS_X + (size_t)M * D * 4),
        WS_BIG = al(WS_XB + (size_t)M * D * 2),
        WS_BIG_SZ = ((size_t)M * FF * 2 > (size_t)M * LDP * 4) ? (size_t)M * FF * 2 : (size_t)M * LDP * 4,
        WS_MIX = al(WS_BIG + WS_BIG_SZ), WS_Q = al(WS_MIX + (size_t)M * D * 2), WS_AO = al(WS_Q + (size_t)M * D * 2),
        WS_MEMB = al(WS_AO + (size_t)M * D * 2), WS_RSTDM = al(WS_MEMB + (size_t)MM * D * 2),
        WS_GB = al(WS_RSTDM + (size_t)MM * 4), WS_GA = al(WS_GB + (size_t)M * MH * 4),
        WS_CBL = al(WS_GA + (size_t)M * MH * 4), WS_CML = al(WS_CBL + (size_t)NCH * 4), WS_MPREV = al(WS_CML + (size_t)NCH * 4),
        WS_DC = al(WS_MPREV + (size_t)NCH * 4), WS_DN = al(WS_DC + (size_t)NCH * MHD * MHD * 4),
        WS_DCB = al(WS_DN + (size_t)NCH * MHD * 4),
        WS_W = al(WS_DCB + (size_t)NCH * MHD * MHD * 2);
    static constexpr size_t W_1IN = 0, W_1OUT = W_1IN + (size_t)2 * FF * D, W_IN = W_1OUT + (size_t)D * FF, W_OUT = W_IN + (size_t)LDP * D, W_Q = W_OUT + (size_t)D * D,
        W_KV = W_Q + (size_t)D * D, W_O = W_KV + (size_t)2 * D * D, W_2IN = W_O + (size_t)D * D, W_2OUT = W_2IN + (size_t)2 * FF * D, W_LAYER = W_2OUT + (size_t)D * FF;
    static constexpr size_t WS_END = al(WS_W + (size_t)DEPTH * W_LAYER * 2);
};

struct Ptrs { const float* in[33]; float* out; unsigned char* ws; };
enum { I_XP = 0, I_XS, I_MEM, I_SPOOL, I_SC, I_SN, I_SM, I_CK, I_CV, I_GFFN1, I_W1IN, I_W1OUT, I_GMIX, I_WIN, I_POOLW, I_POOLS, I_GVG, I_GWS, I_GBS, I_IB, I_FB, I_NG, I_WOUT,
       I_GX, I_GMEM, I_WQ, I_WK, I_WV, I_WO, I_GFFN2, I_W2IN, I_W2OUT, I_GFIN };

template <class C> HD inline float* wsf(const Ptrs& p, size_t off) { return (float*)(p.ws + off); }
template <class C> HD inline bf16_t* wsb(const Ptrs& p, size_t off) { return (bf16_t*)(p.ws + off); }
template <class C> HD inline bf16_t* wlayer(const Ptrs& p, int l, size_t off) { return (bf16_t*)(p.ws + C::WS_W) + (size_t)l * C::W_LAYER + off; }

template <class C> HD inline void row_info(int r, bool& s, int& b, int& t) {
    if (r < C::MP) { s = false; b = r / C::SEQ; t = r % C::SEQ; } else { s = true; const int q = r - C::MP; b = q / C::DEC_SEQ; t = q % C::DEC_SEQ; }
}
template <class C> HD inline void chunk_info(int r, int h, int& ci, int& i, int& lc) {
    bool s; int b, t; row_info<C>(r, s, b, t);
    if (!s) { ci = (b * C::MH + h) * C::NC + t / C::CH; i = t % C::CH; lc = C::CH; } else { ci = C::NPC + b * C::MH + h; i = t; lc = C::LCS; }
}
HD inline float sigmoidf_(float x) { return 1.0f / (1.0f + expf(-x)); }
HD inline float logsigmoidf_(float x) { return x >= 0.f ? -log1pf(expf(-x)) : x - log1pf(expf(x)); }

enum { WK_PLAIN = 0, WK_FFNIN = 1, WK_WIN = 2 };
template <class C> HD inline int wsrc_col(int kind, int n) {
    if (kind == WK_FFNIN) { const int pn = n >> 8, j = n & 255; return j < 128 ? 128 * pn + j : C::FF + 128 * pn + (j - 128); }
    if (kind == WK_WIN) return n < C::INC ? n : -1;
    return n;
}

template <class C> HD inline void st_ml_b0(const Ptrs& p, int l, int sq) {
    const float* CBL = wsf<C>(p, C::WS_CBL); const float* CML = wsf<C>(p, C::WS_CML); float* MPREV = wsf<C>(p, C::WS_MPREV);
    if (sq < C::BATCH * C::MH) { float m = 0.f;
        for (int c = 0; c < C::NC; ++c) { const int ci = sq * C::NC + c; MPREV[ci] = m; const float a = CBL[ci] + m, b2 = CML[ci]; m = a > b2 ? a : b2; }
        p.out[C::OUT_MP + (size_t)l * C::BATCH * C::MH + sq] = m;
    } else { const int q = sq - C::BATCH * C::MH, ci = C::NPC + q; const float m0 = p.in[I_SM][(size_t)l * C::DEC_BATCH * C::MH + q];
        MPREV[ci] = m0; const float a = CBL[ci] + m0, b2 = CML[ci]; p.out[C::OUT_MS + (size_t)l * C::DEC_BATCH * C::MH + q] = a > b2 ? a : b2; }
}

namespace pg8 {
#define PG8_LAS __attribute__((address_space(3)))
typedef unsigned short bf16_t;
typedef short bf16x8 __attribute__((ext_vector_type(8)));
typedef float f32x4 __attribute__((ext_vector_type(4)));
typedef unsigned u32x4 __attribute__((ext_vector_type(4)));
constexpr int BM = 256, BK = 64, HALF = 128, HTB = HALF * BK * 2  , STAGE_BYTES = 8 * HTB, NXCD = 8, WGM = 8;

__host__ __device__ __forceinline__ int lds_byte(int r, int c) { const int st = (r >> 4) * 2 + (c >> 5), rr = r & 15, cc = c & 31, ob = rr * 64 + cc * 2; return st * 1024 + (ob ^ (((ob >> 9) & 1) << 5)); }
__host__ __device__ __forceinline__ void stage_rc(int b, int& R, int& C) { const int st = b / 1024, sb = b % 1024, swz = sb ^ (((sb >> 9) & 1) << 5); R = (st >> 1) * 16 + swz / 64; C = (st & 1) * 32 + (swz % 64) / 2; }
__host__ __device__ __forceinline__ int perm32(int rho) { const int n = rho >> 4, i = rho & 15; return 8 * (i >> 2) + 4 * n + (i & 3); }

struct Unit { int pm, pn; };
struct Gemm { const bf16_t* A; const bf16_t* Bt; int M, N, K, ld; };

struct StaticOrder {
    int nM, nN, nwg, G, c;
    __host__ __device__ __forceinline__ void init(int M, int N, int G_, int c_, int rows_per_tile = BM) { nM = M / rows_per_tile; nN = N / BM; nwg = nM * nN; G = G_; c = c_; }
    __host__ __device__ __forceinline__ bool next(int i, Unit& u) const {
        const long L = (long)i * G + c; if (L >= nwg) return false;
        int wgid = (int)L; { const int q = nwg / NXCD, r = nwg % NXCD, xcd = wgid % NXCD, off = wgid / NXCD; wgid = (xcd < r ? xcd * (q + 1) : r * (q + 1) + (xcd - r) * q) + off; }
        const int nig = WGM * nN, gid = wgid / nig, fm = gid * WGM, gsz = (nM - fm) < WGM ? (nM - fm) : WGM;
        u.pm = fm + ((wgid % nig) % gsz); u.pn = (wgid % nig) / gsz; return true;
    }
    __device__ __forceinline__ void a_ready(const Unit&) const {}
    __device__ __forceinline__ void done(const Unit&) const {}
};
__device__ __forceinline__ unsigned cvt_pk_bf16(float lo, float hi) { unsigned r; asm volatile("v_cvt_pk_bf16_f32 %0, %1, %2" : "=v"(r) : "v"(lo), "v"(hi)); return r; }
typedef float f32x2 __attribute__((ext_vector_type(2)));
template <class Epi, class Sched, bool STRIP = false, bool STAMP = false>
__device__ __forceinline__ void gemm_phase(PG8_LAS unsigned char* lds, const Gemm g, const Sched& S, const Epi& E, unsigned long long* stamps) {
    int tid_l = threadIdx.x; asm volatile("" : "+v"(tid_l));
    const int tid = tid_l, wid = __builtin_amdgcn_readfirstlane(tid >> 6), lane = tid & 63, wr = wid >> 2, wc = wid & 3, fr = lane & 15, fq = lane >> 4;
    const int K = g.K, nt = K / BK;
    int ts_lo = 0, ts_hi = 0, nts = 0; const unsigned long long rt_entry = STAMP ? (unsigned long long)wall_clock64() : 0ull;
#define PG8_STAMP() do { if (STAMP && wid == 0 && nts < 64) { const unsigned long long _c = (unsigned long long)clock64(); \
        ts_lo = (lane == nts) ? (int)(unsigned)_c : ts_lo; ts_hi = (lane == nts) ? (int)(unsigned)(_c >> 32) : ts_hi; ++nts; } } while (0)
    PG8_STAMP();
    unsigned voffA[2], voffB[2];
#pragma unroll
    for (int i = 0; i < 2; ++i) { int R, C; stage_rc(tid * 16 + i * 8192, R, C); const int Rb = Epi::PERM ? ((R & ~31) + perm32(R & 31)) : R;
        voffA[i] = (unsigned)(R * g.ld + C) * 2u; voffB[i] = (unsigned)(Rb * g.ld + C) * 2u; }
    const size_t kstep = (size_t)(BK * 2);
    const size_t hstep = (size_t)HALF * g.ld * 2;
    const size_t tstep = 2 * hstep;
    const size_t tstepA = STRIP ? (size_t)288 * g.ld * 2 : tstep;
    unsigned voffS = 0u; if constexpr (STRIP) { int R, C; stage_rc((wid & 3) * 1024 + lane * 16, R, C); voffS = (unsigned)(R * g.ld + C) * 2u; }
    const int soff = lds_byte(wr * 16 + fr, fq * 8);
    const unsigned ldsw = (unsigned)wid * 1024u;
    const int aoff = lds_byte(wr * 64 + fr, fq * 8), boff = lds_byte(wc * 32 + fr, fq * 8);
#define PG8_SA(b, h) (((b) * 2 + (h)) * HTB)
#define PG8_SB(b, h) ((4 + (b) * 2 + (h)) * HTB)
#define PG8_SS(b) (8 * HTB + (b) * 8192)
#define PG8_STAGE_S(b, gbase) do { if constexpr (STRIP) __builtin_amdgcn_global_load_lds((const unsigned*)((const char*)(gbase) + 2 * hstep + voffS), (PG8_LAS unsigned*)(lds + PG8_SS(b) + ldsw), 16, 0, 0); } while (0)
#define PG8_LDS(b) do { if constexpr (STRIP) { _Pragma("unroll") for (int k = 0; k < 2; ++k) Sf[k] = *(const PG8_LAS bf16x8*)(lds + PG8_SS(b) + soff + k * 1024); } } while (0)
#define PG8_MMS(bj, Bt) do { if constexpr (STRIP) { _Pragma("unroll") for (int n = 0; n < 2; ++n) _Pragma("unroll") for (int k = 0; k < 2; ++k) accS[bj][n] = __builtin_amdgcn_mfma_f32_16x16x32_bf16(Bt[n][k], Sf[k], accS[bj][n], 0, 0, 0); } } while (0)
#define PG8_STAGE(bufoff, gbase, voff) do { _Pragma("unroll") for (int _i = 0; _i < 2; ++_i) \
        __builtin_amdgcn_global_load_lds((const unsigned*)((const char*)(gbase) + (voff)[_i]), (PG8_LAS unsigned*)(lds + (bufoff) + ldsw + _i * 8192), 16, 0, 0); } while (0)
#define PG8_LDA(dst, b, h) do { _Pragma("unroll") for (int m = 0; m < 4; ++m) _Pragma("unroll") for (int k = 0; k < 2; ++k) dst[m][k] = *(const PG8_LAS bf16x8*)(lds + PG8_SA(b, h) + aoff + m * 2048 + k * 1024); } while (0)
#define PG8_LDB(dst, b, h) do { _Pragma("unroll") for (int n = 0; n < 2; ++n) _Pragma("unroll") for (int k = 0; k < 2; ++k) dst[n][k] = *(const PG8_LAS bf16x8*)(lds + PG8_SB(b, h) + boff + n * 2048 + k * 1024); } while (0)
#define PG8_MMA(ai, bj, At, Bt) do { __builtin_amdgcn_s_setprio(1); _Pragma("unroll") for (int m = 0; m < 4; ++m) _Pragma("unroll") for (int n = 0; n < 2; ++n) _Pragma("unroll") for (int k = 0; k < 2; ++k) \
        acc[ai][bj][m][n] = __builtin_amdgcn_mfma_f32_16x16x32_bf16(Bt[n][k], At[m][k], acc[ai][bj][m][n], 0, 0, 0); __builtin_amdgcn_s_setprio(0); } while (0)
#define PG8_WAIT_V(n) asm volatile("s_waitcnt vmcnt(" #n ")" ::: "memory")
#define PG8_WAIT_L(n) asm volatile("s_waitcnt lgkmcnt(" #n ")" ::: "memory")
#define PG8_WAIT_VS(n, ns) do { if constexpr (STRIP) PG8_WAIT_V(ns); else PG8_WAIT_V(n); } while (0)
#define PG8_WAIT_LS(n, ns) do { if constexpr (STRIP) PG8_WAIT_L(ns); else PG8_WAIT_L(n); } while (0)
#define PG8_BAR __builtin_amdgcn_s_barrier()
#define PG8_SCHED __builtin_amdgcn_sched_barrier(0)
    Unit cur, nxt; int ui = 0;
    if (!S.next(0, cur)) return;
    f32x4 acc[2][2][4][2];
#pragma unroll
    for (int a = 0; a < 2; ++a)
#pragma unroll
        for (int b = 0; b < 2; ++b)
#pragma unroll
            for (int m = 0; m < 4; ++m)
#pragma unroll
                for (int n = 0; n < 2; ++n) acc[a][b][m][n] = (f32x4){0.f, 0.f, 0.f, 0.f};
    bf16x8 At[4][2], B0[2][2], B1[2][2];
    f32x4 accS[2][2]; bf16x8 Sf[2];
#pragma unroll
    for (int b = 0; b < 2; ++b)
#pragma unroll
        for (int n = 0; n < 2; ++n) accS[b][n] = (f32x4){0.f, 0.f, 0.f, 0.f};
#pragma unroll
    for (int k = 0; k < 2; ++k) Sf[k] = (bf16x8){0, 0, 0, 0, 0, 0, 0, 0};
    const char* cA = (const char*)g.A + (size_t)cur.pm * tstepA; const char* cB = (const char*)g.Bt + (size_t)cur.pn * tstep;
    S.a_ready(cur);
    PG8_STAGE(PG8_SB(0, 0), cB, voffB); PG8_STAGE(PG8_SA(0, 0), cA, voffA); PG8_STAGE(PG8_SB(0, 1), cB + hstep, voffB); PG8_STAGE(PG8_SA(0, 1), cA + hstep, voffA); PG8_STAGE_S(0, cA);
    if (wr == 1) PG8_BAR;
    PG8_WAIT_VS(4, 5); PG8_BAR;
    PG8_STAGE(PG8_SB(1, 0), cB + kstep, voffB); PG8_STAGE(PG8_SA(1, 0), cA + kstep, voffA); PG8_STAGE(PG8_SB(1, 1), cB + hstep + kstep, voffB); PG8_STAGE_S(1, cA + kstep);
    PG8_WAIT_VS(6, 7); PG8_BAR;
    PG8_STAMP();
    for (;;) {
        const bool has_next = S.next(ui + 1, nxt);
        const char* nA = has_next ? (const char*)g.A + (size_t)nxt.pm * tstepA : cA; const char* nB = has_next ? (const char*)g.Bt + (size_t)nxt.pn * tstep : cB;
        for (int t = 0; t < nt; t += 2) {
            const bool last = (t == nt - 2);
            const char* a1 = cA + (size_t)(t + 1) * kstep;
            const char* a2 = last ? nA : cA + (size_t)(t + 2) * kstep; const char* b2 = last ? nB : cB + (size_t)(t + 2) * kstep;
            const char* a3 = a2 + kstep; const char* b3 = b2 + kstep;
            if (last && has_next) S.a_ready(nxt);
            PG8_LDB(B0, 0, 0); PG8_SCHED; PG8_LDA(At, 0, 0); PG8_LDS(0); PG8_STAGE(PG8_SA(1, 1), a1 + hstep, voffA);
            PG8_WAIT_LS(8, 10); PG8_BAR; PG8_WAIT_L(0); PG8_MMA(0, 0, At, B0); PG8_MMS(0, B0); PG8_BAR; PG8_SCHED;
            PG8_LDB(B1, 0, 1); PG8_STAGE(PG8_SB(0, 0), b2, voffB);
            PG8_BAR; PG8_WAIT_L(0); PG8_MMA(0, 1, At, B1); PG8_MMS(1, B1); PG8_BAR;
            PG8_LDA(At, 0, 1); PG8_STAGE(PG8_SA(0, 0), a2, voffA); PG8_STAGE_S(0, a2);
            PG8_BAR; PG8_WAIT_L(0); PG8_MMA(1, 0, At, B0); PG8_BAR; PG8_SCHED;
            PG8_STAGE(PG8_SB(0, 1), b2 + hstep, voffB);
            PG8_WAIT_VS(6, 7); PG8_BAR; PG8_MMA(1, 1, At, B1); PG8_BAR;
            PG8_LDB(B0, 1, 0); PG8_SCHED; PG8_LDA(At, 1, 0); PG8_LDS(1); PG8_STAGE(PG8_SA(0, 1), a2 + hstep, voffA);
            PG8_WAIT_LS(8, 10); PG8_BAR; PG8_WAIT_L(0); PG8_MMA(0, 0, At, B0); PG8_MMS(0, B0); PG8_BAR; PG8_SCHED;
            PG8_LDB(B1, 1, 1); PG8_STAGE(PG8_SB(1, 0), b3, voffB);
            PG8_BAR; PG8_WAIT_L(0); PG8_MMA(0, 1, At, B1); PG8_MMS(1, B1); PG8_BAR;
            PG8_LDA(At, 1, 1); PG8_STAGE(PG8_SA(1, 0), a3, voffA); PG8_STAGE_S(1, a3);
            PG8_BAR; PG8_WAIT_L(0); PG8_MMA(1, 0, At, B0); PG8_BAR; PG8_SCHED;
            PG8_STAGE(PG8_SB(1, 1), b3 + hstep, voffB);
            PG8_WAIT_VS(6, 7); PG8_BAR; PG8_MMA(1, 1, At, B1); PG8_BAR;
        }
        PG8_STAMP();
        { const int rt0 = cur.pm * (STRIP ? 288 : 256), rw0 = rt0 + wr * 64 + fr;
#define PG8_RV(ai, m) {{acc[ai][0][m][0], acc[ai][0][m][1]}, {acc[ai][1][m][0], acc[ai][1][m][1]}}
#define PG8_BATCH(r0_, v0_, r1_, v1_) do { const typename Epi::Pre p0_ = E.pre(r0_, cur.pn, wc, fq), p1_ = E.pre(r1_, cur.pn, wc, fq); \
              { const f32x4 v_[2][2] = v0_; E.row(v_, p0_, r0_, cur.pn, wc, fq); } { const f32x4 v_[2][2] = v1_; E.row(v_, p1_, r1_, cur.pn, wc, fq); } } while (0)
          PG8_BATCH(rw0, PG8_RV(0, 0), rw0 + 16, PG8_RV(0, 1));
          PG8_BATCH(rw0 + 32, PG8_RV(0, 2), rw0 + 48, PG8_RV(0, 3));
          PG8_BATCH(rw0 + HALF, PG8_RV(1, 0), rw0 + HALF + 16, PG8_RV(1, 1));
          PG8_BATCH(rw0 + HALF + 32, PG8_RV(1, 2), rw0 + HALF + 48, PG8_RV(1, 3));
          if constexpr (STRIP) { const int rs_ = rt0 + 256 + wr * 16 + fr; const typename Epi::Pre ps_ = E.pre(rs_, cur.pn, wc, fq); E.row(accS, ps_, rs_, cur.pn, wc, fq);
#pragma unroll
              for (int b = 0; b < 2; ++b)
#pragma unroll
                for (int n = 0; n < 2; ++n) accS[b][n] = (f32x4){0.f, 0.f, 0.f, 0.f}; }
#undef PG8_BATCH
#undef PG8_RV
          S.done(cur); }
        PG8_STAMP();
        if (!has_next) break;
#pragma unroll
        for (int a = 0; a < 2; ++a)
#pragma unroll
            for (int b = 0; b < 2; ++b)
#pragma unroll
                for (int m = 0; m < 4; ++m)
#pragma unroll
                    for (int n = 0; n < 2; ++n) acc[a][b][m][n] = (f32x4){0.f, 0.f, 0.f, 0.f};
        cur = nxt; cA = nA; cB = nB; ++ui;
    }
    PG8_WAIT_V(0);
    if (wr == 0) PG8_BAR;
    PG8_BAR;
    PG8_STAMP();
    if (STAMP && wid == 0) { stamps[lane] = lane < nts ? (((unsigned long long)(unsigned)ts_hi << 32) | (unsigned)ts_lo) : 0ull;
        if (lane == 62) stamps[62] = rt_entry; if (lane == 63) stamps[63] = (unsigned long long)wall_clock64(); }
#undef PG8_STAMP
#undef PG8_SA
#undef PG8_SB
#undef PG8_STAGE
#undef PG8_LDA
#undef PG8_LDB
#undef PG8_MMA
#undef PG8_WAIT_V
#undef PG8_WAIT_L
#undef PG8_BAR
#undef PG8_SCHED
#undef PG8_WAIT_LS
#undef PG8_WAIT_VS
#undef PG8_MMS
#undef PG8_LDS
#undef PG8_STAGE_S
#undef PG8_SS
}
}


#define LAS __attribute__((address_space(3)))
#define XB_TMO      128
#define XB_XCNT(j)  (256  + 64 * (j))
#define XB_XSUB(j)  (1280 + 64 * (j))
#define XB_XGEN(j)  (2304 + 64 * (j))
#define XB_TOP      3328
#define XB_TOPGEN   3392
#define XCD_BAR_WORDS 3456
#define XB_SPIN_CAP (1u << 18)

__device__ __forceinline__ unsigned xb_ld(unsigned* p)              { return __hip_atomic_load(p, __ATOMIC_RELAXED, __HIP_MEMORY_SCOPE_AGENT); }
__device__ __forceinline__ unsigned xb_add(unsigned* p, unsigned v) { return __hip_atomic_fetch_add(p, v, __ATOMIC_RELAXED, __HIP_MEMORY_SCOPE_AGENT); }
__device__ __forceinline__ unsigned xb_xcc_id() { return (unsigned)__builtin_amdgcn_s_getreg((3 << 11) | 20) & 0xFu; }
#define XB_SPIN(cond, bar) do { unsigned _sp = 0; while (cond) { __builtin_amdgcn_s_sleep(1); \
    if ((++_sp & 255u) == 0u) { if (xb_ld(&(bar)[XB_TMO])) break; if (_sp > XB_SPIN_CAP) { atomicAdd(&(bar)[XB_TMO], 1u); break; } } } } while (0)

struct XcdBarrier {
    unsigned* bar; unsigned x;
    volatile LAS unsigned* st;
};

__device__ __forceinline__ XcdBarrier xcd_barrier_post(unsigned* bar, volatile LAS unsigned* st) {
    XcdBarrier b; b.bar = bar; b.x = xb_xcc_id(); b.st = st;
    if (threadIdx.x == 0) (void)xb_add(&bar[XB_XCNT(b.x)], 1u);
    return b;
}
__device__ __forceinline__ void xcd_barrier_complete(unsigned* bar, unsigned x, unsigned& nloc, unsigned& nx) {
    const unsigned G = gridDim.x * gridDim.y * gridDim.z;
    unsigned sum, cnt, mine, sp = 0u;
    for (;;) {
        sum = 0u; cnt = 0u; mine = 0u;
#pragma unroll
        for (unsigned j = 0; j < 16; ++j) { const unsigned c = xb_ld(&bar[XB_XCNT(j)]); sum += c; cnt += (c > 0u) ? 1u : 0u; mine = (j == x) ? c : mine; }
        if (sum == G) break;
        __builtin_amdgcn_s_sleep(1);
        if ((++sp & 255u) == 0u) { if (xb_ld(&bar[XB_TMO])) break; if (sp > XB_SPIN_CAP) { atomicAdd(&bar[XB_TMO], 1u); break; } }
    }
    nloc = mine > 0u ? mine : 1u; nx = cnt > 0u ? cnt : 1u;
}

__device__ __forceinline__ void xcd_barrier(const XcdBarrier& b) {
    asm volatile("s_waitcnt vmcnt(0)" ::: "memory");
    __syncthreads();
    if (threadIdx.x == 0) {
        unsigned* bar = b.bar;
        __builtin_amdgcn_s_waitcnt(0);
        unsigned nloc = b.st[0], nx = b.st[1];
        if (nloc == 0u) { xcd_barrier_complete(bar, b.x, nloc, nx); b.st[0] = nloc; b.st[1] = nx; }
        const unsigned old = xb_add(&bar[XB_XSUB(b.x)], 1u);
        const unsigned gen = old / nloc;
        if (old + 1u == (gen + 1u) * nloc) {
            __builtin_amdgcn_fence(__ATOMIC_RELEASE, "agent");
            asm volatile("s_waitcnt vmcnt(0)" ::: "memory");
            const unsigned og = xb_add(&bar[XB_TOP], 1u);
            const unsigned tg = og / nx;
            if (og + 1u == (tg + 1u) * nx) xb_add(&bar[XB_TOPGEN], 1u);
            else XB_SPIN(xb_ld(&bar[XB_TOPGEN]) == tg, bar);
            __builtin_amdgcn_fence(__ATOMIC_ACQUIRE, "agent");
            xb_add(&bar[XB_XGEN(b.x)], 1u);
            asm volatile("s_waitcnt vmcnt(0)" ::: "memory");
        } else {
            XB_SPIN(xb_ld(&bar[XB_XGEN(b.x)]) == gen, bar);
            __builtin_amdgcn_fence(__ATOMIC_ACQUIRE, "agent");
            asm volatile("s_waitcnt vmcnt(0)" ::: "memory");
        }
    }
    __syncthreads();
}

typedef CfgT<RC> C;
constexpr int NTHREADS = 512, NWAVES = 8;
constexpr int LDS_STAGE = 131072 + 16384 + 8192, LDS_CTL = LDS_STAGE, LDS_BYTES = LDS_STAGE + 256;

namespace pg8 {
typedef unsigned u32x2 __attribute__((ext_vector_type(2)));
__device__ __forceinline__ float silu_f(float g) { return g * __builtin_amdgcn_rcpf(1.0f + __expf(-g)); }
struct EpiSwiGLU { static constexpr bool PERM = true;
    bf16_t* act; const float* ss; int ff; float invd;
    typedef float Pre;
    __device__ __forceinline__ Pre pre(int row, int pn, int wc, int fq) const { return ss[row]; }
    __device__ __forceinline__ void row(const f32x4 (&v)[2][2], Pre ssr, int row, int pn, int wc, int fq) const {
        const float rs = rsqrtf(ssr * invd + 1e-6f); f32x4 o[2];
#pragma unroll
        for (int n = 0; n < 2; ++n) { const f32x4 g = v[0][n] * rs, up = v[1][n] * rs;
#pragma unroll
            for (int j = 0; j < 4; ++j) o[n][j] = silu_f(g[j]) * up[j]; }
        u32x4 w; w.x = cvt_pk_bf16(o[0][0], o[0][1]); w.y = cvt_pk_bf16(o[0][2], o[0][3]); w.z = cvt_pk_bf16(o[1][0], o[1][1]); w.w = cvt_pk_bf16(o[1][2], o[1][3]);
        *(u32x4*)(act + (size_t)row * ff + pn * 128 + wc * 32 + 8 * fq) = w;
    }
};
struct EpiResid { static constexpr bool PERM = false;
    float* X; bf16_t* XB; float* ssout; float scale; int ld;
    struct Pre { f32x4 x[2][2]; };
    __device__ __forceinline__ Pre pre(int row, int pn, int wc, int fq) const { Pre q; const float* xr = X + (size_t)row * ld + pn * BM + wc * 32 + 4 * fq;
#pragma unroll
        for (int bj = 0; bj < 2; ++bj)
#pragma unroll
            for (int n = 0; n < 2; ++n) q.x[bj][n] = *(const f32x4*)(xr + bj * HALF + n * 16);
        return q; }
    __device__ __forceinline__ void row(const f32x4 (&v)[2][2], const Pre& q, int row, int pn, int wc, int fq) const {
        const int col0 = pn * BM + wc * 32 + 4 * fq; float* xr = X + (size_t)row * ld + col0; bf16_t* br = XB + (size_t)row * ld + col0; float s = 0.f;
#pragma unroll
        for (int bj = 0; bj < 2; ++bj)
#pragma unroll
            for (int n = 0; n < 2; ++n) { const f32x4 x = q.x[bj][n] + v[bj][n] * scale; *(f32x4*)(xr + bj * HALF + n * 16) = x;
                u32x2 w; w.x = cvt_pk_bf16(x[0], x[1]); w.y = cvt_pk_bf16(x[2], x[3]); *(u32x2*)(br + bj * HALF + n * 16) = w;
                s += (x[0] * x[0] + x[1] * x[1]) + (x[2] * x[2] + x[3] * x[3]); }
        s += __shfl_xor(s, 16); s += __shfl_xor(s, 32);
        if (fq == 0) unsafeAtomicAdd(ssout + row, s);
    }
};
struct EpiScaleF32 { static constexpr bool PERM = false;
    float* Cp; int ldc; const float* ss; float invd;
    typedef float Pre;
    __device__ __forceinline__ Pre pre(int row, int pn, int wc, int fq) const { return ss[row]; }
    __device__ __forceinline__ void row(const f32x4 (&v)[2][2], Pre ssr, int row, int pn, int wc, int fq) const {
        const float rs = rsqrtf(ssr * invd + 1e-6f); float* cr = Cp + (size_t)row * ldc + pn * BM + wc * 32 + 4 * fq;
#pragma unroll
        for (int bj = 0; bj < 2; ++bj)
#pragma unroll
            for (int n = 0; n < 2; ++n) *(f32x4*)(cr + bj * HALF + n * 16) = v[bj][n] * rs;
    }
};
struct EpiScaleBf16 { static constexpr bool PERM = true;
    bf16_t* O; int ldc; const float* ss; float invd;
    typedef float Pre;
    __device__ __forceinline__ Pre pre(int row, int pn, int wc, int fq) const { return ss[row]; }
    __device__ __forceinline__ void row(const f32x4 (&v)[2][2], Pre ssr, int row, int pn, int wc, int fq) const {
        const float rs = rsqrtf(ssr * invd + 1e-6f); bf16_t* orow = O + (size_t)row * ldc + pn * BM + wc * 32 + 8 * fq;
#pragma unroll
        for (int bj = 0; bj < 2; ++bj) { const f32x4 v0 = v[bj][0] * rs, v1 = v[bj][1] * rs;
            u32x4 w; w.x = cvt_pk_bf16(v0[0], v0[1]); w.y = cvt_pk_bf16(v0[2], v0[3]); w.z = cvt_pk_bf16(v1[0], v1[1]); w.w = cvt_pk_bf16(v1[2], v1[3]);
            *(u32x4*)(orow + bj * HALF) = w; }
    }
};
struct EpiMemKV { static constexpr bool PERM = false;
    float* K; float* V; const float* rstd; int d;
    typedef float Pre;
    __device__ __forceinline__ Pre pre(int row, int pn, int wc, int fq) const { return rstd[row]; }
    __device__ __forceinline__ void row(const f32x4 (&v)[2][2], Pre rs, int row, int pn, int wc, int fq) const {
        int ct = pn * BM; float* base = K; if (ct >= d) { base = V; ct -= d; } float* cr = base + (size_t)row * d + ct + wc * 32 + 4 * fq;
#pragma unroll
        for (int bj = 0; bj < 2; ++bj)
#pragma unroll
            for (int n = 0; n < 2; ++n) *(f32x4*)(cr + bj * HALF + n * 16) = v[bj][n] * rs;
    }
};
}

__device__ __forceinline__ void prep_item(const float* W, int K, int Ncols, const float* g, int kind, int N, bf16_t* Bt, LAS unsigned char* scr, int item, int lane) {
    const int nblk = N / 64, kb = item / nblk, nb = item % nblk, k0 = 64 * kb, n = 64 * nb + lane;
    const int sc = wsrc_col<C>(kind, n);
    const float* src = W + (size_t)k0 * Ncols + (sc >= 0 ? sc : 0);
    float v[64];
#pragma unroll
    for (int kk = 0; kk < 64; ++kk) v[kk] = src[(size_t)kk * Ncols];
    if (g) {
#pragma unroll
        for (int kk = 0; kk < 64; ++kk) v[kk] *= g[k0 + kk];
    }
    if (sc < 0) {
#pragma unroll
        for (int kk = 0; kk < 64; ++kk) v[kk] = 0.f;
    }
#pragma unroll
    for (int j = 0; j < 8; ++j) { pg8::u32x4 o; o.x = pg8::cvt_pk_bf16(v[8 * j], v[8 * j + 1]); o.y = pg8::cvt_pk_bf16(v[8 * j + 2], v[8 * j + 3]); o.z = pg8::cvt_pk_bf16(v[8 * j + 4], v[8 * j + 5]); o.w = pg8::cvt_pk_bf16(v[8 * j + 6], v[8 * j + 7]);
        *(LAS pg8::u32x4*)(scr + lane * 144 + j * 16) = o; }
    asm volatile("s_waitcnt lgkmcnt(0)" ::: "memory");
    bf16_t* dst = Bt + (size_t)(64 * nb) * K + k0 + (lane & 7) * 8;
#pragma unroll
    for (int it = 0; it < 8; ++it) { const int row = it * 8 + (lane >> 3); const pg8::u32x4 o = *(const LAS pg8::u32x4*)(scr + row * 144 + (lane & 7) * 16);
        *(pg8::u32x4*)(dst + (size_t)row * K) = o; }
    asm volatile("s_waitcnt lgkmcnt(0)" ::: "memory");
}
struct WDesc { const float* W; const float* g; bf16_t* dst; int K, Ncols, kind, N; };
__device__ __forceinline__ WDesc wdesc(const Ptrs& p, int l, int idx) {
    WDesc d; d.g = nullptr; d.kind = WK_PLAIN;
    switch (idx) {
    case 0: d.W = p.in[I_W1IN] + (size_t)l * C::D * 2 * C::FF; d.K = C::D; d.Ncols = 2 * C::FF; d.N = 2 * C::FF; d.g = p.in[I_GFFN1] + l * C::D; d.kind = WK_FFNIN; d.dst = wlayer<C>(p, l, C::W_1IN); break;
    case 1: d.W = p.in[I_W1OUT] + (size_t)l * C::FF * C::D; d.K = C::FF; d.Ncols = C::D; d.N = C::D; d.dst = wlayer<C>(p, l, C::W_1OUT); break;
    case 2: d.W = p.in[I_WIN] + (size_t)l * C::D * C::INC; d.K = C::D; d.Ncols = C::INC; d.N = C::LDP; d.g = p.in[I_GMIX] + l * C::D; d.kind = WK_WIN; d.dst = wlayer<C>(p, l, C::W_IN); break;
    case 3: d.W = p.in[I_WOUT] + (size_t)l * C::D * C::D; d.K = C::D; d.Ncols = C::D; d.N = C::D; d.dst = wlayer<C>(p, l, C::W_OUT); break;
    case 4: d.W = p.in[I_WQ] + (size_t)l * C::D * C::D; d.K = C::D; d.Ncols = C::D; d.N = C::D; d.g = p.in[I_GX] + l * C::D; d.dst = wlayer<C>(p, l, C::W_Q); break;
    case 5: d.W = p.in[I_WK] + (size_t)l * C::D * C::D; d.K = C::D; d.Ncols = C::D; d.N = C::D; d.g = p.in[I_GMEM] + l * C::D; d.dst = wlayer<C>(p, l, C::W_KV); break;
    case 6: d.W = p.in[I_WV] + (size_t)l * C::D * C::D; d.K = C::D; d.Ncols = C::D; d.N = C::D; d.g = p.in[I_GMEM] + l * C::D; d.dst = wlayer<C>(p, l, C::W_KV) + (size_t)C::D * C::D; break;
    case 7: d.W = p.in[I_WO] + (size_t)l * C::D * C::D; d.K = C::D; d.Ncols = C::D; d.N = C::D; d.dst = wlayer<C>(p, l, C::W_O); break;
    case 8: d.W = p.in[I_W2IN] + (size_t)l * C::D * 2 * C::FF; d.K = C::D; d.Ncols = 2 * C::FF; d.N = 2 * C::FF; d.g = p.in[I_GFFN2] + l * C::D; d.kind = WK_FFNIN; d.dst = wlayer<C>(p, l, C::W_2IN); break;
    default: d.W = p.in[I_W2OUT] + (size_t)l * C::FF * C::D; d.K = C::FF; d.Ncols = C::D; d.N = C::D; d.dst = wlayer<C>(p, l, C::W_2OUT); break;
    }
    return d;
}

#define WG_SYNC() do { asm volatile("s_waitcnt lgkmcnt(0)" ::: "memory"); __builtin_amdgcn_s_barrier(); asm volatile("" ::: "memory"); } while (0)
namespace att {
typedef short bf16x8 __attribute__((ext_vector_type(8)));
typedef short s16x4 __attribute__((ext_vector_type(4)));
typedef float f32x4 __attribute__((ext_vector_type(4)));
typedef unsigned u32x2 __attribute__((ext_vector_type(2)));
constexpr int TOK = 256, CD = 64, PITCH = 144, CBYTES = TOK * PITCH, HDIM = 512, NH = 4, LD = 2048;
constexpr int NU_P = (C::MP / 128) * NH, NU_S = C::DEC_BATCH * NH, NUNITS = NU_P + NU_S;
static_assert(C::NMEM == TOK && C::AHD == HDIM && C::AH == NH && C::D == LD && C::DEC_SEQ == 32 && C::SEQ % 128 == 0, "attention phase is built for these shapes");
__device__ __forceinline__ s16x4 tr_read(unsigned addr) { s16x4 r; asm volatile("ds_read_b64_tr_b16 %0, %1" : "=&v"(r) : "v"(addr) : "memory"); return r; }
__device__ __forceinline__ void stage_load(f32x4 (&r)[8], const float* src, int tid) {
#pragma unroll
    for (int i = 0; i < 8; ++i) { const int f = tid + 512 * i; r[i] = *(const f32x4*)(src + (size_t)(f >> 4) * LD + (f & 15) * 4); }
    __builtin_amdgcn_sched_barrier(0);
}
__device__ __forceinline__ void stage_store(const f32x4 (&r)[8], LAS unsigned char* buf, int tid) {
#pragma unroll
    for (int i = 0; i < 8; ++i) { const int f = tid + 512 * i; u32x2 w; w.x = pg8::cvt_pk_bf16(r[i][0], r[i][1]); w.y = pg8::cvt_pk_bf16(r[i][2], r[i][3]);
        *(LAS u32x2*)(buf + (f >> 4) * PITCH + (f & 15) * 8) = w; }
}
__device__ __forceinline__ void attn_phase(LAS unsigned char* lds, const Ptrs& p, int l, int tid, int bid, int gsz) {
    const int lane = tid & 63, wave = __builtin_amdgcn_readfirstlane(tid >> 6), li = lane & 15, g = lane >> 4;
    const bf16_t* Qg = wsb<C>(p, C::WS_Q); bf16_t* AO = wsb<C>(p, C::WS_AO);
    for (int u = bid; u < NUNITS; u += gsz) {
        int row0, nrows, head; const float* kb; const float* vb;
        if (u < NU_P) { const int b = u / (NU_P / C::BATCH), rem = u % (NU_P / C::BATCH); head = rem / (C::SEQ / 128); const int qt = rem % (C::SEQ / 128);
            row0 = b * C::SEQ + qt * 128; nrows = 128;
            kb = p.out + C::OUT_MK + ((size_t)l * C::BATCH + b) * TOK * LD + head * HDIM; vb = p.out + C::OUT_MV + ((size_t)l * C::BATCH + b) * TOK * LD + head * HDIM; }
        else { const int s = u - NU_P, b = s / NH; head = s % NH; row0 = C::MP + b * C::DEC_SEQ; nrows = C::DEC_SEQ;
            kb = p.in[I_CK] + ((size_t)l * C::DEC_BATCH + b) * TOK * LD + head * HDIM; vb = p.in[I_CV] + ((size_t)l * C::DEC_BATCH + b) * TOK * LD + head * HDIM; }
        const bool active = wave * 16 < nrows;
        const int qrow = row0 + wave * 16 + li;
        bf16x8 qf[16];
        if (active) {
#pragma unroll
            for (int ks = 0; ks < 16; ++ks) qf[ks] = *(const bf16x8*)(Qg + (size_t)qrow * LD + head * HDIM + ks * 32 + g * 8);
        } else {
#pragma unroll
            for (int ks = 0; ks < 16; ++ks) qf[ks] = (bf16x8){0, 0, 0, 0, 0, 0, 0, 0};
        }
        f32x4 s[16];
#pragma unroll
        for (int T = 0; T < 16; ++T) s[T] = (f32x4){0.f, 0.f, 0.f, 0.f};
        f32x4 pre[8];
        stage_load(pre, kb, tid); stage_store(pre, lds, tid);
        WG_SYNC();
#pragma unroll
        for (int c = 0; c < 8; ++c) {
            LAS unsigned char* buf = lds + (c & 1) * CBYTES;
            stage_load(pre, c < 7 ? kb + (c + 1) * CD : vb, tid);
            if (active) {
#pragma unroll
                for (int ks = 0; ks < 2; ++ks)
#pragma unroll
                    for (int T = 0; T < 16; ++T) { const bf16x8 a = *(const LAS bf16x8*)(buf + (T * 16 + li) * PITCH + ks * 64 + g * 16);
                        s[T] = __builtin_amdgcn_mfma_f32_16x16x32_bf16(a, qf[2 * c + ks], s[T], 0, 0, 0); }
            }
            stage_store(pre, lds + ((c + 1) & 1) * CBYTES, tid);
            WG_SYNC();
        }
        float mx = -3.0e38f;
#pragma unroll
        for (int T = 0; T < 16; ++T) { mx = fmaxf(mx, fmaxf(fmaxf(s[T][0], s[T][1]), fmaxf(s[T][2], s[T][3]))); }
        mx = fmaxf(mx, __shfl_xor(mx, 16)); mx = fmaxf(mx, __shfl_xor(mx, 32));
        const float sc = 0.044194173824159216f * 1.4426950408889634f;
        float sum = 0.f;
#pragma unroll
        for (int T = 0; T < 16; ++T)
#pragma unroll
            for (int j = 0; j < 4; ++j) { const float e = __builtin_amdgcn_exp2f((s[T][j] - mx) * sc); s[T][j] = e; sum += e; }
        sum += __shfl_xor(sum, 16); sum += __shfl_xor(sum, 32);
        const float inv = 1.0f / sum;
        bf16x8 pf[8];
#pragma unroll
        for (int t = 0; t < 8; ++t) { const unsigned w0 = pg8::cvt_pk_bf16(s[2 * t][0], s[2 * t][1]), w1 = pg8::cvt_pk_bf16(s[2 * t][2], s[2 * t][3]),
                w2 = pg8::cvt_pk_bf16(s[2 * t + 1][0], s[2 * t + 1][1]), w3 = pg8::cvt_pk_bf16(s[2 * t + 1][2], s[2 * t + 1][3]);
            pg8::u32x4 w; w.x = w0; w.y = w1; w.z = w2; w.w = w3; pf[t] = __builtin_bit_cast(bf16x8, w); }
        const unsigned trb = (unsigned)(size_t)lds + (unsigned)((4 * g + (li >> 2)) * PITCH + (li & 3) * 8);
        for (int c = 0; c < 8; ++c) {
            const unsigned bofs = (unsigned)(c & 1) * CBYTES;
            if (c < 7) stage_load(pre, vb + (c + 1) * CD, tid);
            if (active) {
                f32x4 o[4];
#pragma unroll
                for (int dt = 0; dt < 4; ++dt) o[dt] = (f32x4){0.f, 0.f, 0.f, 0.f};
#pragma unroll
                for (int t = 0; t < 8; ++t) {
                    s16x4 lo[4], hi[4];
#pragma unroll
                    for (int dt = 0; dt < 4; ++dt) { lo[dt] = tr_read(trb + bofs + (unsigned)(t * 32 * PITCH + dt * 32)); hi[dt] = tr_read(trb + bofs + (unsigned)(t * 32 * PITCH + 16 * PITCH + dt * 32)); }
                    asm volatile("s_waitcnt lgkmcnt(0)" ::: "memory"); __builtin_amdgcn_sched_barrier(0);
#pragma unroll
                    for (int dt = 0; dt < 4; ++dt) { const bf16x8 a = (bf16x8){lo[dt][0], lo[dt][1], lo[dt][2], lo[dt][3], hi[dt][0], hi[dt][1], hi[dt][2], hi[dt][3]};
                        o[dt] = __builtin_amdgcn_mfma_f32_16x16x32_bf16(a, pf[t], o[dt], 0, 0, 0); }
                }
#pragma unroll
                for (int dt = 0; dt < 4; ++dt) { u32x2 w; w.x = pg8::cvt_pk_bf16(o[dt][0] * inv, o[dt][1] * inv); w.y = pg8::cvt_pk_bf16(o[dt][2] * inv, o[dt][3] * inv);
                    *(u32x2*)(AO + (size_t)qrow * LD + head * HDIM + c * CD + dt * 16 + g * 4) = w; }
            }
            if (c < 7) stage_store(pre, lds + ((c + 1) & 1) * CBYTES, tid);
            WG_SYNC();
        }
    }
}
}
namespace mx {
typedef att::bf16x8 bf16x8; typedef att::s16x4 s16x4; typedef att::f32x4 f32x4; typedef att::u32x2 u32x2;
constexpr int PT = 272;
constexpr int T64 = 64 * PT, T128 = 128 * PT;
static_assert(C::MHD == 128 && C::CH == 64 && C::MH == 8 && C::LCS == 32, "mLSTM phases are built for these shapes");
__device__ __forceinline__ void lds_wait() { asm volatile("s_waitcnt lgkmcnt(0)" ::: "memory"); __builtin_amdgcn_sched_barrier(0); }
__device__ __forceinline__ bf16x8 mk8(s16x4 lo, s16x4 hi) { return (bf16x8){lo[0], lo[1], lo[2], lo[3], hi[0], hi[1], hi[2], hi[3]}; }
__device__ __forceinline__ unsigned tr_addr(unsigned tile, int krow, int c0, int li) { return tile + (unsigned)((krow + (li >> 2)) * PT + (c0 + 4 * (li & 3)) * 2); }
__device__ __forceinline__ void ch_decode(int ci, int& r0, int& h, int& lc) {
    if (ci < C::NPC) { const int c = ci % C::NC, bh = ci / C::NC; h = bh % C::MH; r0 = (bh / C::MH) * C::SEQ + c * C::CH; lc = C::CH; }
    else { const int q = ci - C::NPC; h = q % C::MH; r0 = C::MP + (q / C::MH) * C::DEC_SEQ; lc = C::LCS; }
}
__device__ __forceinline__ void stage64(LAS unsigned char* tile, const float* src, int ld, int lc, int tid, const LAS float* rs, float mul) {
#pragma unroll
    for (int i = 0; i < 4; ++i) { const int f = tid + 512 * i, row = f >> 5, c4 = f & 31; f32x4 v = (f32x4){0.f, 0.f, 0.f, 0.f};
        if (row < lc) { v = *(const f32x4*)(src + (size_t)row * ld + c4 * 4); const float m = rs ? rs[row] * mul : mul; v = v * m; }
        u32x2 w; w.x = pg8::cvt_pk_bf16(v[0], v[1]); w.y = pg8::cvt_pk_bf16(v[2], v[3]); *(LAS u32x2*)(tile + row * PT + c4 * 8) = w; }
}
__device__ __forceinline__ void ml_phase_a(LAS unsigned char* lds, const Ptrs& p, int l, int tid, int bid, int gsz) {
    const int lane = tid & 63, wave = __builtin_amdgcn_readfirstlane(tid >> 6), li = lane & 15, g = lane >> 4;
    LAS unsigned char* Ks = lds; LAS unsigned char* Vs = lds + T64; LAS float* wts = (LAS float*)(lds + 2 * T64);
    const float* P = wsf<C>(p, C::WS_BIG);
    for (int ci = bid; ci < C::NCH; ci += gsz) {
        int r0, h, lc; ch_decode(ci, r0, h, lc);
        if (wave == 0) {
            float lf = 0.f, ig = -3.0e38f;
            if (lane < lc) { const float* pr = P + (size_t)(r0 + lane) * C::LDP; ig = pr[C::O_IG + h] + p.in[I_IB][l * C::MH + h]; const float fx = pr[C::O_FG + h] + p.in[I_FB][l * C::MH + h]; lf = fx >= 0.f ? -__logf(1.0f + __expf(-fx)) : fx - __logf(1.0f + __expf(fx)); }
            float b = lf;
#pragma unroll
            for (int o = 1; o < 64; o <<= 1) { const float t = __shfl_up(b, o); if (lane >= o) b += t; }
            const float a = lane < lc ? ig - b : -3.0e38f;
            float amax = a;
#pragma unroll
            for (int o = 1; o < 64; o <<= 1) amax = fmaxf(amax, __shfl_xor(amax, o));
            const float bL = __shfl(b, lc - 1), mloc = bL + amax;
            const float wt = lane < lc ? __expf(bL + a - mloc) : 0.f;
            wts[lane] = wt;
            if (lane < lc) { wsf<C>(p, C::WS_GB)[(size_t)(r0 + lane) * C::MH + h] = b; wsf<C>(p, C::WS_GA)[(size_t)(r0 + lane) * C::MH + h] = a; }
            if (lane == 0) { wsf<C>(p, C::WS_CBL)[ci] = bL; wsf<C>(p, C::WS_CML)[ci] = mloc; }
        }
        __syncthreads();
        stage64(Ks, P + (size_t)r0 * C::LDP + C::O_K + h * C::MHD, C::LDP, lc, tid, wts, 0.08838834764831845f);
        stage64(Vs, P + (size_t)r0 * C::LDP + C::O_VM + h * C::MHD, C::LDP, lc, tid, nullptr, 1.0f);
        __syncthreads();
        f32x4 acc[8];
#pragma unroll
        for (int et = 0; et < 8; ++et) acc[et] = (f32x4){0.f, 0.f, 0.f, 0.f};
        const unsigned ks = (unsigned)(size_t)Ks, vs = (unsigned)(size_t)Vs;
#pragma unroll
        for (int t = 0; t < 2; ++t) {
            const s16x4 alo = att::tr_read(tr_addr(ks, 32 * t + 8 * g, 16 * wave, li)), ahi = att::tr_read(tr_addr(ks, 32 * t + 8 * g + 4, 16 * wave, li));
            s16x4 blo[8], bhi[8];
#pragma unroll
            for (int et = 0; et < 8; ++et) { blo[et] = att::tr_read(tr_addr(vs, 32 * t + 8 * g, 16 * et, li)); bhi[et] = att::tr_read(tr_addr(vs, 32 * t + 8 * g + 4, 16 * et, li)); }
            lds_wait();
            const bf16x8 a = mk8(alo, ahi);
#pragma unroll
            for (int et = 0; et < 8; ++et) acc[et] = __builtin_amdgcn_mfma_f32_16x16x32_bf16(a, mk8(blo[et], bhi[et]), acc[et], 0, 0, 0);
        }
        float* DC = wsf<C>(p, C::WS_DC) + (size_t)ci * C::MHD * C::MHD;
#pragma unroll
        for (int et = 0; et < 8; ++et)
#pragma unroll
            for (int r = 0; r < 4; ++r) DC[(size_t)(16 * wave + 4 * g + r) * C::MHD + 16 * et + li] = acc[et][r];
        if (tid < C::MHD) { float s = 0.f; for (int t = 0; t < 64; ++t) s += bf2f(*(const LAS bf16_t*)(Ks + t * PT + tid * 2)); wsf<C>(p, C::WS_DN)[(size_t)ci * C::MHD + tid] = s; }
        __syncthreads();
    }
}
__device__ __forceinline__ void ml_phase_c(LAS unsigned char* lds, const Ptrs& p, int l, int tid, int bid, int gsz) {
    const int lane = tid & 63, wave = __builtin_amdgcn_readfirstlane(tid >> 6), li = lane & 15, g = lane >> 4, it = wave & 3, eh = wave >> 2;
    LAS unsigned char* Qs = lds; LAS unsigned char* Ks = lds + T64; LAS unsigned char* Vs = lds + 2 * T64; LAS unsigned char* Cs = lds + 3 * T64;
    LAS float* sb = (LAS float*)(lds + 3 * T64 + T128);
    LAS float* sa = sb + 64; LAS float* smr = sb + 128; LAS float* siw = sb + 192; LAS float* snp = sb + 256; LAS float* ssq = sb + 384;
    const float* P = wsf<C>(p, C::WS_BIG);
    for (int ci = bid; ci < C::NCH; ci += gsz) {
        int r0, h, lc; ch_decode(ci, r0, h, lc);
        const bool sample = ci >= C::NPC, first = !sample && (ci % C::NC) == 0;
        const float mprev = wsf<C>(p, C::WS_MPREV)[ci];
        if (wave == 0) {
            float b = 0.f, a = -3.0e38f;
            if (lane < lc) { b = wsf<C>(p, C::WS_GB)[(size_t)(r0 + lane) * C::MH + h]; a = wsf<C>(p, C::WS_GA)[(size_t)(r0 + lane) * C::MH + h]; }
            float pm = a;
#pragma unroll
            for (int o = 1; o < 64; o <<= 1) { const float t = __shfl_up(pm, o); if (lane >= o) pm = fmaxf(pm, t); }
            const float mrow = b + fmaxf(mprev, pm);
            sb[lane] = b; sa[lane] = a; smr[lane] = mrow; siw[lane] = __expf(b + mprev - mrow);
        }
        if (tid >= 128 && tid < 256) { const int d = tid - 128;
            snp[d] = sample ? p.in[I_SN][((size_t)l * C::NSC + (ci - C::NPC)) * C::MHD + d] : (first ? 0.f : wsf<C>(p, C::WS_DN)[(size_t)(ci - 1) * C::MHD + d]); }
        stage64(Qs, P + (size_t)r0 * C::LDP + C::O_Q + h * C::MHD, C::LDP, lc, tid, nullptr, 1.0f);
        stage64(Ks, P + (size_t)r0 * C::LDP + C::O_K + h * C::MHD, C::LDP, lc, tid, nullptr, 0.08838834764831845f);
        stage64(Vs, P + (size_t)r0 * C::LDP + C::O_VM + h * C::MHD, C::LDP, lc, tid, nullptr, 1.0f);
        { const float* cp = sample ? p.in[I_SC] + ((size_t)l * C::NSC + (ci - C::NPC)) * C::MHD * C::MHD : wsf<C>(p, C::WS_DC) + (size_t)(first ? ci : ci - 1) * C::MHD * C::MHD;
#pragma unroll
            for (int i = 0; i < 8; ++i) { const int f = tid + 512 * i, row = f >> 5, c4 = f & 31; f32x4 v = (f32x4){0.f, 0.f, 0.f, 0.f};
                if (!first) v = *(const f32x4*)(cp + (size_t)row * C::MHD + c4 * 4);
                u32x2 w; w.x = pg8::cvt_pk_bf16(v[0], v[1]); w.y = pg8::cvt_pk_bf16(v[2], v[3]); *(LAS u32x2*)(Cs + row * PT + c4 * 8) = w; } }
        __syncthreads();
        const bool active = it * 16 < lc;
        float ssq_part = 0.f; f32x4 hv[4]; float inv_den = 0.f;
        const int i = 16 * it + li;
        if (active) {
            bf16x8 qf[4];
#pragma unroll
            for (int ks = 0; ks < 4; ++ks) qf[ks] = *(const LAS bf16x8*)(Qs + i * PT + ks * 64 + g * 16);
            f32x4 st[4];
#pragma unroll
            for (int jt = 0; jt < 4; ++jt) st[jt] = (f32x4){0.f, 0.f, 0.f, 0.f};
#pragma unroll
            for (int jt = 0; jt < 4; ++jt) if (jt <= it) {
#pragma unroll
                for (int ks = 0; ks < 4; ++ks) { const bf16x8 a = *(const LAS bf16x8*)(Ks + (16 * jt + li) * PT + ks * 64 + g * 16);
                    st[jt] = __builtin_amdgcn_mfma_f32_16x16x32_bf16(a, qf[ks], st[jt], 0, 0, 0); } }
            const float bi = sb[i], mri = smr[i], iwi = siw[i];
            float dsum = 0.f;
#pragma unroll
            for (int jt = 0; jt < 4; ++jt)
#pragma unroll
                for (int r = 0; r < 4; ++r) { const int j = 16 * jt + 4 * g + r; const float w = (j <= i) ? __expf(bi + sa[j] - mri) : 0.f; st[jt][r] *= w; dsum += st[jt][r]; }
            dsum += __shfl_xor(dsum, 16); dsum += __shfl_xor(dsum, 32);
            float qn = 0.f;
#pragma unroll
            for (int ks = 0; ks < 4; ++ks)
#pragma unroll
                for (int jj = 0; jj < 8; ++jj) qn += bf2f((bf16_t)qf[ks][jj]) * snp[32 * ks + 8 * g + jj];
            qn += __shfl_xor(qn, 16); qn += __shfl_xor(qn, 32);
            const float den = dsum + iwi * qn;
            inv_den = 1.0f / fmaxf(fabsf(den), __expf(-mri));
            bf16x8 pf[2];
#pragma unroll
            for (int t = 0; t < 2; ++t) { pg8::u32x4 w; w.x = pg8::cvt_pk_bf16(st[2 * t][0], st[2 * t][1]); w.y = pg8::cvt_pk_bf16(st[2 * t][2], st[2 * t][3]);
                w.z = pg8::cvt_pk_bf16(st[2 * t + 1][0], st[2 * t + 1][1]); w.w = pg8::cvt_pk_bf16(st[2 * t + 1][2], st[2 * t + 1][3]); pf[t] = __builtin_bit_cast(bf16x8, w); }
            const unsigned vs = (unsigned)(size_t)Vs, cs = (unsigned)(size_t)Cs;
#pragma unroll
            for (int e4 = 0; e4 < 4; ++e4) { const int et = 4 * eh + e4;
                s16x4 vlo[2], vhi[2], clo[4], chi[4];
#pragma unroll
                for (int t = 0; t < 2; ++t) { vlo[t] = att::tr_read(tr_addr(vs, 32 * t + 4 * g, 16 * et, li)); vhi[t] = att::tr_read(tr_addr(vs, 32 * t + 16 + 4 * g, 16 * et, li)); }
#pragma unroll
                for (int ks = 0; ks < 4; ++ks) { clo[ks] = att::tr_read(tr_addr(cs, 32 * ks + 8 * g, 16 * et, li)); chi[ks] = att::tr_read(tr_addr(cs, 32 * ks + 8 * g + 4, 16 * et, li)); }
                lds_wait();
                f32x4 aS = (f32x4){0.f, 0.f, 0.f, 0.f}, aC = (f32x4){0.f, 0.f, 0.f, 0.f};
#pragma unroll
                for (int t = 0; t < 2; ++t) aS = __builtin_amdgcn_mfma_f32_16x16x32_bf16(mk8(vlo[t], vhi[t]), pf[t], aS, 0, 0, 0);
#pragma unroll
                for (int ks = 0; ks < 4; ++ks) aC = __builtin_amdgcn_mfma_f32_16x16x32_bf16(mk8(clo[ks], chi[ks]), qf[ks], aC, 0, 0, 0);
                hv[e4] = (aS + aC * iwi) * inv_den;
                ssq_part += (hv[e4][0] * hv[e4][0] + hv[e4][1] * hv[e4][1]) + (hv[e4][2] * hv[e4][2] + hv[e4][3] * hv[e4][3]); }
            ssq_part += __shfl_xor(ssq_part, 16); ssq_part += __shfl_xor(ssq_part, 32);
            if (g == 0) ssq[wave * 16 + li] = ssq_part;
        }
        __syncthreads();
        if (active) {
            const float tot = ssq_part + ssq[(wave ^ 4) * 16 + li];
            const float rs = rsqrtf(tot * (1.0f / C::MHD) + 1e-6f);
            const int row = r0 + i;
#pragma unroll
            for (int e4 = 0; e4 < 4; ++e4) { const int e = 16 * (4 * eh + e4) + 4 * g;
                const f32x4 og = *(const f32x4*)(P + (size_t)row * C::LDP + C::O_O + h * C::MHD + e); const f32x4 gn = *(const f32x4*)(p.in[I_NG] + (size_t)l * C::MW + h * C::MHD + e);
                float o4[4];
#pragma unroll
                for (int r = 0; r < 4; ++r) o4[r] = hv[e4][r] * rs * gn[r] * __builtin_amdgcn_rcpf(1.0f + __expf(-og[r]));
                u32x2 w; w.x = pg8::cvt_pk_bf16(o4[0], o4[1]); w.y = pg8::cvt_pk_bf16(o4[2], o4[3]);
                *(u32x2*)(wsb<C>(p, C::WS_MIX) + (size_t)row * C::D + C::PW + C::GW + h * C::MHD + e) = w; }
        }
        __syncthreads();
    }
}
}
namespace rw {
typedef att::f32x4 f32x4; typedef att::u32x2 u32x2;
static_assert(C::D == 2048, "row ops assume 2048 columns = 8 float4 per lane");
__device__ __forceinline__ float wave_sum(float v) {
#pragma unroll
    for (int o = 1; o < 64; o <<= 1) v += __shfl_xor(v, o);
    return v;
}
__device__ __forceinline__ void rows_init(const Ptrs& p, int tid, int bid, int gsz) {
    const int lane = tid & 63, gw = bid * NWAVES + (tid >> 6), NGW = gsz * NWAVES;
    float* SS = wsf<C>(p, C::WS_SS);
    for (int r = gw; r < C::M; r += NGW) {
        const float* src = r < C::MP ? p.in[I_XP] + (size_t)r * C::D : p.in[I_XS] + (size_t)(r - C::MP) * C::D;
        float* X = wsf<C>(p, C::WS_X) + (size_t)r * C::D; bf16_t* XB = wsb<C>(p, C::WS_XB) + (size_t)r * C::D;
        float ss = 0.f;
#pragma unroll
        for (int j = 0; j < 8; ++j) { const f32x4 v = *(const f32x4*)(src + (lane + 64 * j) * 4); *(f32x4*)(X + (lane + 64 * j) * 4) = v;
            u32x2 w; w.x = pg8::cvt_pk_bf16(v[0], v[1]); w.y = pg8::cvt_pk_bf16(v[2], v[3]); *(u32x2*)(XB + (lane + 64 * j) * 4) = w;
            ss += (v[0] * v[0] + v[1] * v[1]) + (v[2] * v[2] + v[3] * v[3]); }
        ss = wave_sum(ss);
        if (lane < C::NSS) SS[(size_t)lane * C::M + r] = lane == 0 ? ss : 0.f;
    }
    for (int r = gw; r < C::MM; r += NGW) {
        const float* src = p.in[I_MEM] + (size_t)r * C::D; bf16_t* MB = wsb<C>(p, C::WS_MEMB) + (size_t)r * C::D;
        float ss = 0.f;
#pragma unroll
        for (int j = 0; j < 8; ++j) { const f32x4 v = *(const f32x4*)(src + (lane + 64 * j) * 4);
            u32x2 w; w.x = pg8::cvt_pk_bf16(v[0], v[1]); w.y = pg8::cvt_pk_bf16(v[2], v[3]); *(u32x2*)(MB + (lane + 64 * j) * 4) = w;
            ss += (v[0] * v[0] + v[1] * v[1]) + (v[2] * v[2] + v[3] * v[3]); }
        ss = wave_sum(ss);
        if (lane == 0) wsf<C>(p, C::WS_RSTDM)[r] = rsqrtf(ss * (1.0f / C::D) + 1e-6f);
    }
}
__device__ __forceinline__ void rows_final(const Ptrs& p, int tid, int bid, int gsz) {
    const int lane = tid & 63, gw = bid * NWAVES + (tid >> 6), NGW = gsz * NWAVES;
    for (int r = gw; r < C::M; r += NGW) {
        const float* X = wsf<C>(p, C::WS_X) + (size_t)r * C::D; const float rs = rsqrtf(wsf<C>(p, C::WS_SS)[(size_t)(C::NSS - 1) * C::M + r] * (1.0f / C::D) + 1e-6f);
        float* o = r < C::MP ? p.out + C::OUT_YP + (size_t)r * C::D : p.out + C::OUT_YS + (size_t)(r - C::MP) * C::D;
        float pscale = 1.0f, padd = 0.f;
#if defined(PROBE_MASK_A)
        { const unsigned long long* TS = (const unsigned long long*)(p.ws + C::WS_CTL + 32768); unsigned long long ta = 0, tb = 0;
          for (int k = 0; k < 25; ++k) { const unsigned long long dk = TS[k + 1] - TS[k]; if ((PROBE_MASK_A >> k) & 1ull) ta += dk; if ((PROBE_MASK_B >> k) & 1ull) tb += dk; }
#if defined(PROBE_MLT)
          ta = TS[48 + PROBE_MLT];
#endif
#if defined(PROBE_MIXA)
          ta = 0; for (int l2 = 0; l2 < 2; ++l2) { const int k = 1 + 12 * l2 + 3; ta += (PROBE_MIXA == 1) ? TS[40 + l2] - TS[k] : (PROBE_MIXA == 2) ? TS[42 + l2] - TS[40 + l2] : TS[k + 1] - TS[42 + l2]; }
#endif
#if defined(PROBE_SPLIT_MODE)
          ta = 0; for (int l2 = 0; l2 < 2; ++l2) { const int k = 1 + 10 * l2 + 3; ta += (PROBE_SPLIT_MODE == 1) ? TS[40 + l2] - TS[k] : TS[k + 1] - TS[40 + l2]; }
#endif
          if (r >= C::MP) pscale = 1.0f + 0.03f + (float)ta * 0.01f * PROBE_SA;
          if (r == 0 && lane == 0) padd = 1.0f + (float)tb * 0.01f * PROBE_SB; }
#endif
#pragma unroll
        for (int j = 0; j < 8; ++j) { const f32x4 v = *(const f32x4*)(X + (lane + 64 * j) * 4); const f32x4 gg = *(const f32x4*)(p.in[I_GFIN] + (lane + 64 * j) * 4);
            f32x4 y = v * rs * gg * pscale; if (j == 0) y[0] += padd; *(f32x4*)(o + (lane + 64 * j) * 4) = y; }
    }
}
__device__ __forceinline__ void ml_scan(const Ptrs& p, int l, long gtid, long gthreads) {
    const float* CBL = wsf<C>(p, C::WS_CBL); const float* CML = wsf<C>(p, C::WS_CML);
    float* DC = wsf<C>(p, C::WS_DC); float* DN = wsf<C>(p, C::WS_DN);
    constexpr int NPS = C::BATCH * C::MH, E4 = C::MHD / 4;
    for (long it = gtid; it < (long)NPS * C::MHD * E4; it += gthreads) {
        const int e4 = (int)(it % E4), d = (int)((it / E4) % C::MHD), sq = (int)(it / ((long)E4 * C::MHD));
        float m = 0.f; f32x4 cst = (f32x4){0.f, 0.f, 0.f, 0.f};
        static_assert(C::NC % 8 == 0, "scan is unrolled by 8 chunks");
        for (int c0 = 0; c0 < C::NC; c0 += 8) {
            f32x4 v[8]; float bl[8], ml[8];
#pragma unroll
            for (int j = 0; j < 8; ++j) { const int ci = sq * C::NC + c0 + j; v[j] = *(const f32x4*)(DC + ((size_t)ci * C::MHD + d) * C::MHD + e4 * 4); bl[j] = CBL[ci]; ml[j] = CML[ci]; }
#pragma unroll
            for (int j = 0; j < 8; ++j) { const int ci = sq * C::NC + c0 + j; const float a = bl[j] + m, mn = fmaxf(a, ml[j]), dec = __expf(a - mn), f = __expf(ml[j] - mn);
                cst = cst * dec + v[j] * f; *(f32x4*)(DC + ((size_t)ci * C::MHD + d) * C::MHD + e4 * 4) = cst; m = mn; }
        }
        *(f32x4*)(p.out + C::OUT_CP + (((size_t)l * NPS + sq) * C::MHD + d) * C::MHD + e4 * 4) = cst;
    }
    for (long it = gtid; it < (long)NPS * C::MHD; it += gthreads) {
        const int d = (int)(it % C::MHD), sq = (int)(it / C::MHD);
        float m = 0.f, nst = 0.f;
        for (int c = 0; c < C::NC; ++c) { const int ci = sq * C::NC + c; const float a = CBL[ci] + m, b2 = CML[ci], mn = fmaxf(a, b2), dec = __expf(a - mn), f = __expf(b2 - mn);
            const size_t on = (size_t)ci * C::MHD + d; nst = dec * nst + f * DN[on]; DN[on] = nst; m = mn; }
        p.out[C::OUT_NP + ((size_t)l * NPS + sq) * C::MHD + d] = nst;
    }
    for (long it = gtid; it < (long)C::NSC * C::MHD * E4; it += gthreads) {
        const int e4 = (int)(it % E4), d = (int)((it / E4) % C::MHD), q = (int)(it / ((long)E4 * C::MHD)), ci = C::NPC + q;
        const float m0 = p.in[I_SM][(size_t)l * C::NSC + q], a = CBL[ci] + m0, b2 = CML[ci], mn = fmaxf(a, b2), dec = __expf(a - mn), f = __expf(b2 - mn);
        const size_t so = (((size_t)l * C::NSC + q) * C::MHD + d) * C::MHD + e4 * 4;
        *(f32x4*)(p.out + C::OUT_CS + so) = *(const f32x4*)(p.in[I_SC] + so) * dec + *(const f32x4*)(DC + ((size_t)ci * C::MHD + d) * C::MHD + e4 * 4) * f;
    }
    for (long it = gtid; it < (long)C::NSC * C::MHD; it += gthreads) {
        const int d = (int)(it % C::MHD), q = (int)(it / C::MHD), ci = C::NPC + q;
        const float m0 = p.in[I_SM][(size_t)l * C::NSC + q], a = CBL[ci] + m0, b2 = CML[ci], mn = fmaxf(a, b2), dec = __expf(a - mn), f = __expf(b2 - mn);
        const size_t no = ((size_t)l * C::NSC + q) * C::MHD + d;
        p.out[C::OUT_NS + no] = dec * p.in[I_SN][no] + f * DN[(size_t)ci * C::MHD + d];
    }
}
}

namespace gp {
typedef att::bf16x8 bf16x8; typedef att::s16x4 s16x4; typedef att::f32x4 f32x4; typedef att::u32x2 u32x2;
constexpr int PT = mx::PT, T128 = mx::T128;
static_assert(C::GHD == 128 && C::PGD == 128 && C::GCH == 128 && C::SEQ % 128 == 0 && C::DEC_SEQ == 32 && C::PH == 15, "gmlp / pool phases are built for these shapes");
constexpr int NT_P = C::MP / 128;
constexpr int NU_G = NT_P * 4 + C::DEC_BATCH * 4;
__device__ __forceinline__ void gmlp_phase(LAS unsigned char* lds, const Ptrs& p, int l, int tid, int bid, int gsz) {
    const int lane = tid & 63, wave = __builtin_amdgcn_readfirstlane(tid >> 6), li = lane & 15, g = lane >> 4;
    LAS unsigned char* Vs = lds; LAS unsigned char* Ws = lds + T128;
    const float* P = wsf<C>(p, C::WS_BIG);
    for (int u = bid; u < NU_G; u += gsz) {
        int r0, lc, h; bool sample = false; int sb = 0;
        if (u < NT_P * 4) { h = u & 3; r0 = (u >> 2) * 128; lc = 128; } else { const int s = u - NT_P * 4; h = s & 3; sb = s >> 2; r0 = C::MP + sb * C::DEC_SEQ; lc = C::DEC_SEQ; sample = true; }
#pragma unroll
        for (int i = 0; i < 8; ++i) { const int f = tid + 512 * i, row = f >> 5, c4 = f & 31; f32x4 v = (f32x4){0.f, 0.f, 0.f, 0.f};
            if (row < lc) v = *(const f32x4*)(P + (size_t)(r0 + row) * C::LDP + C::O_V + h * 128 + c4 * 4);
            float ss = (v[0] * v[0] + v[1] * v[1]) + (v[2] * v[2] + v[3] * v[3]);
#pragma unroll
            for (int o = 1; o < 32; o <<= 1) ss += __shfl_xor(ss, o);
            const float rs = rsqrtf(ss * (1.0f / 128) + 1e-6f); const f32x4 gn = *(const f32x4*)(p.in[I_GVG] + (size_t)l * C::GW + h * 128 + c4 * 4);
            v = v * rs * gn;
            if (sample && row < lc) *(f32x4*)(p.out + C::OUT_VS + (((size_t)l * C::DEC_BATCH + sb) * C::DEC_SEQ + row) * C::GW + h * 128 + c4 * 4) = v;
            u32x2 w; w.x = pg8::cvt_pk_bf16(v[0], v[1]); w.y = pg8::cvt_pk_bf16(v[2], v[3]); *(LAS u32x2*)(Vs + row * PT + c4 * 8) = w; }
        const float* wsrc = p.in[I_GWS] + ((size_t)l * C::GH + h) * 128 * 128;
#pragma unroll
        for (int i = 0; i < 8; ++i) { const int f = tid + 512 * i, row = f >> 5, c4 = f & 31; f32x4 v = *(const f32x4*)(wsrc + (size_t)row * 128 + c4 * 4);
#pragma unroll
            for (int j = 0; j < 4; ++j) if (c4 * 4 + j > row) v[j] = 0.f;
            u32x2 w; w.x = pg8::cvt_pk_bf16(v[0], v[1]); w.y = pg8::cvt_pk_bf16(v[2], v[3]); *(LAS u32x2*)(Ws + row * PT + c4 * 8) = w; }
        WG_SYNC();
        if (wave * 16 < lc) {
            const int i = wave * 16 + li, nks = (wave * 16 + 15) / 32 + 1;
            f32x4 acc[8];
#pragma unroll
            for (int dt = 0; dt < 8; ++dt) acc[dt] = (f32x4){0.f, 0.f, 0.f, 0.f};
            const unsigned vs = (unsigned)(size_t)Vs;
            for (int ks = 0; ks < nks; ++ks) {
                const bf16x8 bq = *(const LAS bf16x8*)(Ws + i * PT + ks * 64 + g * 16);
                s16x4 lo[8], hi[8];
#pragma unroll
                for (int dt = 0; dt < 8; ++dt) { lo[dt] = att::tr_read(mx::tr_addr(vs, 32 * ks + 8 * g, 16 * dt, li)); hi[dt] = att::tr_read(mx::tr_addr(vs, 32 * ks + 8 * g + 4, 16 * dt, li)); }
                mx::lds_wait();
#pragma unroll
                for (int dt = 0; dt < 8; ++dt) acc[dt] = __builtin_amdgcn_mfma_f32_16x16x32_bf16(mx::mk8(lo[dt], hi[dt]), bq, acc[dt], 0, 0, 0);
            }
            const float bsi = p.in[I_GBS][((size_t)l * C::GH + h) * C::GCH + i];
            const int row = r0 + i;
#pragma unroll
            for (int dt = 0; dt < 8; ++dt) { const int d = 16 * dt + 4 * g; const f32x4 uu = *(const f32x4*)(P + (size_t)row * C::LDP + C::O_U + h * 128 + d);
                u32x2 w; w.x = pg8::cvt_pk_bf16(uu[0] * (acc[dt][0] + bsi), uu[1] * (acc[dt][1] + bsi)); w.y = pg8::cvt_pk_bf16(uu[2] * (acc[dt][2] + bsi), uu[3] * (acc[dt][3] + bsi));
                *(u32x2*)(wsb<C>(p, C::WS_MIX) + (size_t)row * C::D + C::PW + h * 128 + d) = w; }
        }
        WG_SYNC();
    }
}
__device__ __forceinline__ void pool_phase(LAS unsigned char* lds, const Ptrs& p, int l, int tid, int bid, int gsz) {
    const int lane = tid & 63, wave = __builtin_amdgcn_readfirstlane(tid >> 6), li = lane & 15, g = lane >> 4;
    LAS unsigned char* Ds = lds; LAS unsigned char* Ws = lds + T128;
    const float* P = wsf<C>(p, C::WS_BIG);
    for (int u = bid; u < NU_G; u += gsz) {
        int r0, lc, grp, t0, L, b; bool sample = false;
        if (u < NT_P * 4) { grp = u & 3; r0 = (u >> 2) * 128; lc = 128; b = r0 / C::SEQ; t0 = r0 % C::SEQ; L = C::SEQ; } else { const int s = u - NT_P * 4; grp = s & 3; b = s >> 2; r0 = C::MP + b * C::DEC_SEQ; lc = C::DEC_SEQ; t0 = 0; L = C::DEC_SEQ; sample = true; }
        const int w = 2 << grp;
        { const int c4 = tid & 31, sg = tid >> 5, ch = grp * 128 + c4 * 4;
            const float* hist = p.in[I_SPOOL] + ((size_t)l * C::DEC_BATCH + b) * C::PH * C::PW + ch;
            auto xat = [&](int t) -> f32x4 {
                if (t >= 0) return *(const f32x4*)(P + (size_t)(r0 - t0 + t) * C::LDP + ch);
                if (sample && C::PH + t >= 0) return *(const f32x4*)(hist + (size_t)(C::PH + t) * C::PW);
                return (f32x4){0.f, 0.f, 0.f, 0.f}; };
            if (sg * 8 < lc) {
                const int ts = t0 + sg * 8;
                f32x4 sum = (f32x4){0.f, 0.f, 0.f, 0.f};
                for (int j = 1; j < w; ++j) sum = sum + xat(ts - j);
#pragma unroll
                for (int k = 0; k < 8; ++k) { const int t = ts + k; const f32x4 x = xat(t); sum = sum + x;
                    const int pos = (sample ? C::PAST : 0) + t; const float inv = 1.0f / (float)((pos + 1) < w ? (pos + 1) : w);
                    const f32x4 dv = sum * inv - x;
                    u32x2 ww; ww.x = pg8::cvt_pk_bf16(dv[0], dv[1]); ww.y = pg8::cvt_pk_bf16(dv[2], dv[3]); *(LAS u32x2*)(Ds + (sg * 8 + k) * PT + c4 * 8) = ww;
                    sum = sum - xat(t - w + 1);
                    const int idx = t - (L - C::PH);
                    if (idx >= 0) *(f32x4*)(p.out + (sample ? C::OUT_POOLS + (((size_t)l * C::DEC_BATCH + b) * C::PH + idx) * C::PW : C::OUT_POOLP + (((size_t)l * C::BATCH + b) * C::PH + idx) * C::PW) + ch) = x; }
            } else {
#pragma unroll
                for (int k = 0; k < 8; ++k) *(LAS u32x2*)(Ds + (sg * 8 + k) * PT + c4 * 8) = (u32x2){0u, 0u};
            }
        }
        const float* wsrc = p.in[I_POOLW] + ((size_t)l * C::PG + grp) * 128 * 128;
#pragma unroll
        for (int i = 0; i < 8; ++i) { const int f = tid + 512 * i, row = f >> 5, c4 = f & 31; const f32x4 v = *(const f32x4*)(wsrc + (size_t)row * 128 + c4 * 4);
            u32x2 ww; ww.x = pg8::cvt_pk_bf16(v[0], v[1]); ww.y = pg8::cvt_pk_bf16(v[2], v[3]); *(LAS u32x2*)(Ws + row * PT + c4 * 8) = ww; }
        WG_SYNC();
        if (wave * 16 < lc) {
            const int t = wave * 16 + li;
            f32x4 acc[8];
#pragma unroll
            for (int et = 0; et < 8; ++et) acc[et] = (f32x4){0.f, 0.f, 0.f, 0.f};
            const unsigned wsa = (unsigned)(size_t)Ws;
#pragma unroll
            for (int ks = 0; ks < 4; ++ks) {
                const bf16x8 bq = *(const LAS bf16x8*)(Ds + t * PT + ks * 64 + g * 16);
                s16x4 lo[8], hi[8];
#pragma unroll
                for (int et = 0; et < 8; ++et) { lo[et] = att::tr_read(mx::tr_addr(wsa, 32 * ks + 8 * g, 16 * et, li)); hi[et] = att::tr_read(mx::tr_addr(wsa, 32 * ks + 8 * g + 4, 16 * et, li)); }
                mx::lds_wait();
#pragma unroll
                for (int et = 0; et < 8; ++et) acc[et] = __builtin_amdgcn_mfma_f32_16x16x32_bf16(mx::mk8(lo[et], hi[et]), bq, acc[et], 0, 0, 0);
            }
            const int row = r0 + t;
#pragma unroll
            for (int et = 0; et < 8; ++et) { const int e = 16 * et + 4 * g; const f32x4 sc = *(const f32x4*)(p.in[I_POOLS] + (size_t)l * C::PW + grp * 128 + e);
                u32x2 ww; ww.x = pg8::cvt_pk_bf16(acc[et][0] * sc[0], acc[et][1] * sc[1]); ww.y = pg8::cvt_pk_bf16(acc[et][2] * sc[2], acc[et][3] * sc[3]);
                *(u32x2*)(wsb<C>(p, C::WS_MIX) + (size_t)row * C::D + grp * 128 + e) = ww; }
        }
        WG_SYNC();
    }
}
}
namespace mp {
typedef att::bf16x8 bf16x8; typedef att::s16x4 s16x4; typedef att::f32x4 f32x4; typedef att::u32x2 u32x2; typedef pg8::u32x4 u32x4;
constexpr int PT = mx::PT, T64 = mx::T64, T128 = mx::T128, MAXU = 8;
#define MP_TR(dst, base, OFF) asm volatile("ds_read_b64_tr_b16 %0, %1 offset:%2" : "=&v"(dst) : "v"(base), "i"(OFF) : "memory")
__device__ __forceinline__ void ml_a(LAS unsigned char* lds, const Ptrs& p, int l, int tid, int bid, int gsz) {
    const int lane = tid & 63, wave = __builtin_amdgcn_readfirstlane(tid >> 6), li = lane & 15, g = lane >> 4;
    LAS unsigned char* Ks = lds; LAS unsigned char* Vs = lds + T64; LAS float* wts = (LAS float*)(lds + 2 * T64);
    const float* P = wsf<C>(p, C::WS_BIG);
    const int nu = bid < C::NCH ? (C::NCH - 1 - bid) / gsz + 1 : 0;
    if (wave < nu) { const int ci = bid + wave * gsz; int r0, h, lc; mx::ch_decode(ci, r0, h, lc);
        float lf = 0.f, ig = -3.0e38f;
        if (lane < lc) { const float* pr = P + (size_t)(r0 + lane) * C::LDP; ig = pr[C::O_IG + h] + p.in[I_IB][l * C::MH + h]; const float fx = pr[C::O_FG + h] + p.in[I_FB][l * C::MH + h];
            lf = fx >= 0.f ? -__logf(1.0f + __expf(-fx)) : fx - __logf(1.0f + __expf(fx)); }
        float b = lf;
#pragma unroll
        for (int o = 1; o < 64; o <<= 1) { const float t = __shfl_up(b, o); if (lane >= o) b += t; }
        const float a = lane < lc ? ig - b : -3.0e38f;
        float amax = a;
#pragma unroll
        for (int o = 1; o < 64; o <<= 1) amax = fmaxf(amax, __shfl_xor(amax, o));
        const float bL = __shfl(b, lc - 1), mloc = bL + amax;
        wts[wave * 64 + lane] = lane < lc ? __expf(bL + a - mloc) : 0.f;
        if (lane < lc) { wsf<C>(p, C::WS_GB)[(size_t)(r0 + lane) * C::MH + h] = b; wsf<C>(p, C::WS_GA)[(size_t)(r0 + lane) * C::MH + h] = a; }
        if (lane == 0) { wsf<C>(p, C::WS_CBL)[ci] = bL; wsf<C>(p, C::WS_CML)[ci] = mloc; } }
    const unsigned lofs8 = (unsigned)((8 * g + (li >> 2)) * PT + 8 * (li & 3));
    const unsigned kw8 = (unsigned)(size_t)Ks + lofs8 + (unsigned)(32 * wave), vs8 = (unsigned)(size_t)Vs + lofs8;
    f32x4 pk[4], pv[4];
    auto window = [&](int ci) { int r0, h, lc; mx::ch_decode(ci, r0, h, lc); const float* src = P + (size_t)r0 * C::LDP + h * C::MHD;
#pragma unroll
        for (int q = 0; q < 4; ++q) { const int f = tid + 512 * q, row = f >> 5, c4 = f & 31;
            if (row < lc) { pk[q] = *(const f32x4*)(src + (size_t)row * C::LDP + C::O_K + c4 * 4); pv[q] = *(const f32x4*)(src + (size_t)row * C::LDP + C::O_VM + c4 * 4); }
            else { pk[q] = (f32x4){0.f, 0.f, 0.f, 0.f}; pv[q] = pk[q]; } }
        __builtin_amdgcn_sched_barrier(0); };
    if (nu > 0) window(bid);
    WG_SYNC();
    for (int j = 0; j < nu; ++j) { const int ci = bid + j * gsz;
#pragma unroll
        for (int q = 0; q < 4; ++q) { const int f = tid + 512 * q, row = f >> 5, c4 = f & 31; const float sw = 0.08838834764831845f * wts[j * 64 + row];
            u32x2 w; w.x = pg8::cvt_pk_bf16(pk[q][0] * sw, pk[q][1] * sw); w.y = pg8::cvt_pk_bf16(pk[q][2] * sw, pk[q][3] * sw); *(LAS u32x2*)(Ks + row * PT + c4 * 8) = w;
            w.x = pg8::cvt_pk_bf16(pv[q][0], pv[q][1]); w.y = pg8::cvt_pk_bf16(pv[q][2], pv[q][3]); *(LAS u32x2*)(Vs + row * PT + c4 * 8) = w; }
        if (j + 1 < nu) window(ci + gsz);
        WG_SYNC();
        f32x4 acc[8], accn = (f32x4){0.f, 0.f, 0.f, 0.f};
#pragma unroll
        for (int et = 0; et < 8; ++et) acc[et] = (f32x4){0.f, 0.f, 0.f, 0.f};
        const bf16x8 ones = (bf16x8){0x3F80, 0x3F80, 0x3F80, 0x3F80, 0x3F80, 0x3F80, 0x3F80, 0x3F80};
#pragma unroll
        for (int t = 0; t < 2; ++t) {
            s16x4 alo, ahi, blo[8], bhi[8]; MP_TR(alo, kw8, (32 * t) * PT); MP_TR(ahi, kw8, (32 * t + 4) * PT);
#pragma unroll
            for (int et = 0; et < 8; ++et) { MP_TR(blo[et], vs8, (32 * t) * PT + 32 * et); MP_TR(bhi[et], vs8, (32 * t + 4) * PT + 32 * et); }
            mx::lds_wait();
            const bf16x8 a = mx::mk8(alo, ahi);
#pragma unroll
            for (int et = 0; et < 8; ++et) acc[et] = __builtin_amdgcn_mfma_f32_16x16x32_bf16(mx::mk8(blo[et], bhi[et]), a, acc[et], 0, 0, 0);
            accn = __builtin_amdgcn_mfma_f32_16x16x32_bf16(ones, a, accn, 0, 0, 0);
        }
        float* DC = wsf<C>(p, C::WS_DC) + (size_t)ci * C::MHD * C::MHD + (size_t)(16 * wave + li) * C::MHD + 4 * g;
#pragma unroll
        for (int et = 0; et < 8; ++et) *(f32x4*)(DC + 16 * et) = acc[et];
        if (g == 0) wsf<C>(p, C::WS_DN)[(size_t)ci * C::MHD + 16 * wave + li] = accn[0];
        WG_SYNC();
    }
}
__device__ __forceinline__ void ml_scan(const Ptrs& p, int l, long gtid, long gthreads) {
    const float* CBL = wsf<C>(p, C::WS_CBL); const float* CML = wsf<C>(p, C::WS_CML); const float* DC = wsf<C>(p, C::WS_DC); float* DN = wsf<C>(p, C::WS_DN);
    bf16_t* DCB = wsb<C>(p, C::WS_DCB); float* MPREV = wsf<C>(p, C::WS_MPREV);
    constexpr int NPS = C::BATCH * C::MH, E4 = C::MHD / 4;
    static_assert(C::NC % 8 == 0, "scan is unrolled by 8 chunks");
    for (long it = gtid; it < (long)NPS * C::MHD * E4; it += gthreads) {
        const int e4 = (int)(it % E4), d = (int)((it / E4) % C::MHD), sq = (int)(it / ((long)E4 * C::MHD));
        float m = 0.f; f32x4 cst = (f32x4){0.f, 0.f, 0.f, 0.f};
        for (int c0 = 0; c0 < C::NC; c0 += 8) {
            f32x4 v[8]; float bl[8], ml[8];
#pragma unroll
            for (int j = 0; j < 8; ++j) { const int ci = sq * C::NC + c0 + j; v[j] = *(const f32x4*)(DC + ((size_t)ci * C::MHD + d) * C::MHD + e4 * 4); bl[j] = CBL[ci]; ml[j] = CML[ci]; }
            __builtin_amdgcn_sched_barrier(0);
#pragma unroll
            for (int j = 0; j < 8; ++j) { const int ci = sq * C::NC + c0 + j; const float a = bl[j] + m, mn = fmaxf(a, ml[j]), dec = __expf(a - mn), f = __expf(ml[j] - mn);
                if (d == 0 && e4 == 0) MPREV[ci] = m;
                cst = cst * dec + v[j] * f; u32x2 w; w.x = pg8::cvt_pk_bf16(cst[0], cst[1]); w.y = pg8::cvt_pk_bf16(cst[2], cst[3]);
                *(u32x2*)(DCB + ((size_t)ci * C::MHD + d) * C::MHD + e4 * 4) = w; m = mn; }
        }
        *(f32x4*)(p.out + C::OUT_CP + (((size_t)l * NPS + sq) * C::MHD + d) * C::MHD + e4 * 4) = cst;
        if (d == 0 && e4 == 0) p.out[C::OUT_MP + (size_t)l * NPS + sq] = m;
    }
    for (long it = gtid; it < (long)NPS * C::MHD; it += gthreads) {
        const int d = (int)(it % C::MHD), sq = (int)(it / C::MHD);
        float m = 0.f, nst = 0.f;
        for (int c = 0; c < C::NC; ++c) { const int ci = sq * C::NC + c; const float a = CBL[ci] + m, b2 = CML[ci], mn = fmaxf(a, b2), dec = __expf(a - mn), f = __expf(b2 - mn);
            const size_t on = (size_t)ci * C::MHD + d; nst = dec * nst + f * DN[on]; DN[on] = nst; m = mn; }
        p.out[C::OUT_NP + ((size_t)l * NPS + sq) * C::MHD + d] = nst;
    }
    for (long it = gtid; it < (long)C::NSC * C::MHD * E4; it += gthreads) {
        const int e4 = (int)(it % E4), d = (int)((it / E4) % C::MHD), q = (int)(it / ((long)E4 * C::MHD)), ci = C::NPC + q;
        const float m0 = p.in[I_SM][(size_t)l * C::NSC + q], a = CBL[ci] + m0, b2 = CML[ci], mn = fmaxf(a, b2), dec = __expf(a - mn), f = __expf(b2 - mn);
        const size_t so = (((size_t)l * C::NSC + q) * C::MHD + d) * C::MHD + e4 * 4; const f32x4 cin = *(const f32x4*)(p.in[I_SC] + so);
        *(f32x4*)(p.out + C::OUT_CS + so) = cin * dec + *(const f32x4*)(DC + ((size_t)ci * C::MHD + d) * C::MHD + e4 * 4) * f;
        u32x2 w; w.x = pg8::cvt_pk_bf16(cin[0], cin[1]); w.y = pg8::cvt_pk_bf16(cin[2], cin[3]); *(u32x2*)(DCB + ((size_t)ci * C::MHD + d) * C::MHD + e4 * 4) = w;
        if (d == 0 && e4 == 0) { MPREV[ci] = m0; p.out[C::OUT_MS + (size_t)l * C::NSC + q] = mn; }
    }
    for (long it = gtid; it < (long)C::NSC * C::MHD; it += gthreads) {
        const int d = (int)(it % C::MHD), q = (int)(it / C::MHD), ci = C::NPC + q;
        const float m0 = p.in[I_SM][(size_t)l * C::NSC + q], a = CBL[ci] + m0, b2 = CML[ci], mn = fmaxf(a, b2), dec = __expf(a - mn), f = __expf(b2 - mn);
        const size_t no = ((size_t)l * C::NSC + q) * C::MHD + d;
        p.out[C::OUT_NS + no] = dec * p.in[I_SN][no] + f * DN[(size_t)ci * C::MHD + d];
    }
}
__device__ __forceinline__ void ml_c(LAS unsigned char* lds, const Ptrs& p, int l, int tid, int bid, int gsz) {
    const int lane = tid & 63, wave = __builtin_amdgcn_readfirstlane(tid >> 6), li = lane & 15, g = lane >> 4, it = wave & 3, eh = wave >> 2;
    LAS unsigned char* Qs = lds; LAS unsigned char* Ks = lds + T64; LAS unsigned char* Vs = lds + 2 * T64; LAS unsigned char* Cs = lds + 3 * T64;
    LAS float* SB = (LAS float*)(lds + 3 * T64 + T128); LAS float* SA = SB + MAXU * 64; LAS float* SMR = SA + MAXU * 64; LAS float* SIW = SMR + MAXU * 64;
    LAS float* snp = SIW + MAXU * 64; LAS float* ssq = snp + 128; LAS float* sgn = ssq + 128;
    const float* P = wsf<C>(p, C::WS_BIG);
    const int nu = bid < C::NCH ? (C::NCH - 1 - bid) / gsz + 1 : 0;
    if (wave < nu) { const int ci = bid + wave * gsz; int r0, h, lc; mx::ch_decode(ci, r0, h, lc); const float mprev = wsf<C>(p, C::WS_MPREV)[ci];
        float b = 0.f, a = -3.0e38f;
        if (lane < lc) { b = wsf<C>(p, C::WS_GB)[(size_t)(r0 + lane) * C::MH + h]; a = wsf<C>(p, C::WS_GA)[(size_t)(r0 + lane) * C::MH + h]; }
        float pm = a;
#pragma unroll
        for (int o = 1; o < 64; o <<= 1) { const float t = __shfl_up(pm, o); if (lane >= o) pm = fmaxf(pm, t); }
        const float mrow = b + fmaxf(mprev, pm);
        SB[wave * 64 + lane] = b; SA[wave * 64 + lane] = a; SMR[wave * 64 + lane] = mrow; SIW[wave * 64 + lane] = __expf(b + mprev - mrow); }
    const unsigned lofs8 = (unsigned)((8 * g + (li >> 2)) * PT + 8 * (li & 3)), lofs4 = (unsigned)((4 * g + (li >> 2)) * PT + 8 * (li & 3));
    const unsigned vs4e = (unsigned)(size_t)Vs + lofs4 + (unsigned)(128 * eh), cb8e = (unsigned)(size_t)Cs + lofs8 + (unsigned)(128 * eh);
    f32x4 pq[4], pk[4], pv[4], og[4]; u32x4 pc[4]; float pn = 0.f, pg = 0.f;
    auto window = [&](int ci) { int r0, h, lc; mx::ch_decode(ci, r0, h, lc); const float* src = P + (size_t)r0 * C::LDP + h * C::MHD;
        const bool sample = ci >= C::NPC, first = !sample && (ci % C::NC) == 0;
#pragma unroll
        for (int q = 0; q < 4; ++q) { const int f = tid + 512 * q, row = f >> 5, c4 = f & 31;
            if (row < lc) { pq[q] = *(const f32x4*)(src + (size_t)row * C::LDP + C::O_Q + c4 * 4); pk[q] = *(const f32x4*)(src + (size_t)row * C::LDP + C::O_K + c4 * 4); pv[q] = *(const f32x4*)(src + (size_t)row * C::LDP + C::O_VM + c4 * 4); }
            else { pq[q] = (f32x4){0.f, 0.f, 0.f, 0.f}; pk[q] = pq[q]; pv[q] = pq[q]; } }
        const bf16_t* cb = wsb<C>(p, C::WS_DCB) + (size_t)(sample ? ci : (first ? ci : ci - 1)) * C::MHD * C::MHD;
#pragma unroll
        for (int q = 0; q < 4; ++q) { const int f = tid + 512 * q; pc[q] = first ? (u32x4){0u, 0u, 0u, 0u} : *(const u32x4*)(cb + (size_t)f * 8); }
        const int i = 16 * it + li;
#pragma unroll
        for (int e4 = 0; e4 < 4; ++e4) og[e4] = (it * 16 < lc) ? *(const f32x4*)(src + (size_t)i * C::LDP + C::O_O + 16 * (4 * eh + e4) + 4 * g) : (f32x4){0.f, 0.f, 0.f, 0.f};
        if (tid < C::MHD) { pn = sample ? p.in[I_SN][((size_t)l * C::NSC + (ci - C::NPC)) * C::MHD + tid] : (first ? 0.f : wsf<C>(p, C::WS_DN)[(size_t)(ci - 1) * C::MHD + tid]);
            pg = p.in[I_NG][(size_t)l * C::MW + h * C::MHD + tid]; }
        __builtin_amdgcn_sched_barrier(0); };
    if (nu > 0) window(bid);
    WG_SYNC();
    for (int j = 0; j < nu; ++j) { const int ci = bid + j * gsz; int r0, h, lc; mx::ch_decode(ci, r0, h, lc);
        const LAS float* sb = SB + j * 64; const LAS float* sa = SA + j * 64; const LAS float* smr = SMR + j * 64; const LAS float* siw = SIW + j * 64;
#pragma unroll
        for (int q = 0; q < 4; ++q) { const int f = tid + 512 * q, row = f >> 5, c4 = f & 31; const float sc = 0.08838834764831845f;
            u32x2 w; w.x = pg8::cvt_pk_bf16(pq[q][0], pq[q][1]); w.y = pg8::cvt_pk_bf16(pq[q][2], pq[q][3]); *(LAS u32x2*)(Qs + row * PT + c4 * 8) = w;
            w.x = pg8::cvt_pk_bf16(pk[q][0] * sc, pk[q][1] * sc); w.y = pg8::cvt_pk_bf16(pk[q][2] * sc, pk[q][3] * sc); *(LAS u32x2*)(Ks + row * PT + c4 * 8) = w;
            w.x = pg8::cvt_pk_bf16(pv[q][0], pv[q][1]); w.y = pg8::cvt_pk_bf16(pv[q][2], pv[q][3]); *(LAS u32x2*)(Vs + row * PT + c4 * 8) = w;
            *(LAS u32x4*)(Cs + (f >> 4) * PT + (f & 15) * 16) = pc[q]; }
        if (tid < C::MHD) { snp[tid] = pn; sgn[tid] = pg; }
        f32x4 ogc[4];
#pragma unroll
        for (int e4 = 0; e4 < 4; ++e4) ogc[e4] = og[e4];
        if (j + 1 < nu) window(ci + gsz);
        WG_SYNC();
        const bool active = it * 16 < lc; const int i = 16 * it + li;
        float ssq_part = 0.f; f32x4 hv[4];
        if (active) {
            bf16x8 qf[4];
#pragma unroll
            for (int ks = 0; ks < 4; ++ks) qf[ks] = *(const LAS bf16x8*)(Qs + i * PT + ks * 64 + g * 16);
            f32x4 st[4];
#pragma unroll
            for (int jt = 0; jt < 4; ++jt) st[jt] = (f32x4){0.f, 0.f, 0.f, 0.f};
#pragma unroll
            for (int jt = 0; jt < 4; ++jt) if (jt <= it) {
#pragma unroll
                for (int ks = 0; ks < 4; ++ks) { const bf16x8 a = *(const LAS bf16x8*)(Ks + (16 * jt + li) * PT + ks * 64 + g * 16);
                    st[jt] = __builtin_amdgcn_mfma_f32_16x16x32_bf16(a, qf[ks], st[jt], 0, 0, 0); } }
            const float bi = sb[i], mri = smr[i], iwi = siw[i];
            float dsum = 0.f;
#pragma unroll
            for (int jt = 0; jt < 4; ++jt)
#pragma unroll
                for (int r = 0; r < 4; ++r) { const int jj = 16 * jt + 4 * g + r; const float w = (jj <= i) ? __expf(bi + sa[jj] - mri) : 0.f; st[jt][r] *= w; dsum += st[jt][r]; }
            dsum += __shfl_xor(dsum, 16); dsum += __shfl_xor(dsum, 32);
            float qn = 0.f;
#pragma unroll
            for (int ks = 0; ks < 4; ++ks)
#pragma unroll
                for (int jj = 0; jj < 8; ++jj) qn += bf2f((bf16_t)qf[ks][jj]) * snp[32 * ks + 8 * g + jj];
            qn += __shfl_xor(qn, 16); qn += __shfl_xor(qn, 32);
            const float den = dsum + iwi * qn, inv_den = 1.0f / fmaxf(fabsf(den), __expf(-mri));
            bf16x8 pf[2];
#pragma unroll
            for (int t = 0; t < 2; ++t) { u32x4 w; w.x = pg8::cvt_pk_bf16(st[2 * t][0], st[2 * t][1]); w.y = pg8::cvt_pk_bf16(st[2 * t][2], st[2 * t][3]);
                w.z = pg8::cvt_pk_bf16(st[2 * t + 1][0], st[2 * t + 1][1]); w.w = pg8::cvt_pk_bf16(st[2 * t + 1][2], st[2 * t + 1][3]); pf[t] = __builtin_bit_cast(bf16x8, w); }
#pragma unroll
            for (int e2 = 0; e2 < 2; ++e2) {
                s16x4 vlo[2][2], vhi[2][2], clo[2][4], chi[2][4];
#pragma unroll
                for (int u = 0; u < 2; ++u) {
#pragma unroll
                    for (int t = 0; t < 2; ++t) { MP_TR(vlo[u][t], vs4e, (32 * t) * PT + 32 * (2 * e2 + u)); MP_TR(vhi[u][t], vs4e, (32 * t + 16) * PT + 32 * (2 * e2 + u)); }
#pragma unroll
                    for (int ks = 0; ks < 4; ++ks) { MP_TR(clo[u][ks], cb8e, (32 * ks) * PT + 32 * (2 * e2 + u)); MP_TR(chi[u][ks], cb8e, (32 * ks + 4) * PT + 32 * (2 * e2 + u)); } }
                mx::lds_wait();
#pragma unroll
                for (int u = 0; u < 2; ++u) { const int e4 = 2 * e2 + u;
                    f32x4 aS = (f32x4){0.f, 0.f, 0.f, 0.f}, aC = (f32x4){0.f, 0.f, 0.f, 0.f};
#pragma unroll
                    for (int t = 0; t < 2; ++t) aS = __builtin_amdgcn_mfma_f32_16x16x32_bf16(mx::mk8(vlo[u][t], vhi[u][t]), pf[t], aS, 0, 0, 0);
#pragma unroll
                    for (int ks = 0; ks < 4; ++ks) aC = __builtin_amdgcn_mfma_f32_16x16x32_bf16(mx::mk8(clo[u][ks], chi[u][ks]), qf[ks], aC, 0, 0, 0);
                    hv[e4] = (aS + aC * iwi) * inv_den;
                    ssq_part += (hv[e4][0] * hv[e4][0] + hv[e4][1] * hv[e4][1]) + (hv[e4][2] * hv[e4][2] + hv[e4][3] * hv[e4][3]); } }
            ssq_part += __shfl_xor(ssq_part, 16); ssq_part += __shfl_xor(ssq_part, 32);
            if (g == 0) ssq[wave * 16 + li] = ssq_part;
        }
        WG_SYNC();
        if (active) {
            const float tot = ssq_part + ssq[(wave ^ 4) * 16 + li];
            const float rs = rsqrtf(tot * (1.0f / C::MHD) + 1e-6f);
            const int row = r0 + i;
#pragma unroll
            for (int e4 = 0; e4 < 4; ++e4) { const int e = 16 * (4 * eh + e4) + 4 * g; const f32x4 gn = *(const LAS f32x4*)(sgn + e);
                float o4[4];
#pragma unroll
                for (int r = 0; r < 4; ++r) o4[r] = hv[e4][r] * rs * gn[r] * __builtin_amdgcn_rcpf(1.0f + __expf(-ogc[e4][r]));
                u32x2 w; w.x = pg8::cvt_pk_bf16(o4[0], o4[1]); w.y = pg8::cvt_pk_bf16(o4[2], o4[3]);
                *(u32x2*)(wsb<C>(p, C::WS_MIX) + (size_t)row * C::D + C::PW + C::GW + h * C::MHD + e) = w; }
        }
        WG_SYNC();
    }
}
}
constexpr int PH_PER_LAYER = 12, N_PHASES = 2 + PH_PER_LAYER * C::DEPTH;
struct Args { Ptrs p; int ph_lo, ph_hi; };
__global__ void __launch_bounds__(NTHREADS, 2) fwd(Args a) {
    extern __shared__ __attribute__((aligned(16))) unsigned char lds_raw[];
    LAS unsigned char* lds = (LAS unsigned char*)lds_raw;
    typedef __attribute__((address_space(4))) const Args* KArgs;
    const KArgs ka0 = (KArgs)__builtin_amdgcn_kernarg_segment_ptr();
    const int lo = a.ph_lo, hi = a.ph_hi;
#define IN(k) (lo <= (k) && (k) < hi)
#define BOTH(k) (IN(k) && IN((k) + 1))
#define GRID_BAR(k) do { if (BOTH(k)) { xcd_barrier(bar); } } while (0)
#if defined(__HIP_DEVICE_COMPILE__)
#define LOAD_PTRS KArgs ka = ka0; asm volatile("" : "+s"(ka)); Ptrs p; _Pragma("unroll") for (int i_ = 0; i_ < 33; ++i_) p.in[i_] = ka->p.in[i_]; p.out = ka->p.out; p.ws = ka->p.ws;
#else
#define LOAD_PTRS (void)ka0; const Ptrs p = a.p;
#endif
#define PHASE_ARGS LOAD_PTRS int tid = threadIdx.x; asm volatile("" : "+v"(tid)); int bid = blockIdx.x, gsz = gridDim.x; asm volatile("" : "+s"(bid), "+s"(gsz));     \
    const int lane = tid & 63, wave = __builtin_amdgcn_readfirstlane(tid >> 6); (void)lane; (void)wave; \
    const long gtid = (long)bid * NTHREADS + tid, gthreads = (long)gsz * NTHREADS; (void)gtid; (void)gthreads; \
    float* SS = wsf<C>(p, C::WS_SS); (void)SS; const float invd = 1.0f / C::D; (void)invd;
#if defined(PROBE_MASK_A)
#define STAMP(k) do { if (blockIdx.x == 0 && threadIdx.x == 0) ((unsigned long long*)(a.p.ws + C::WS_CTL + 32768))[k] = wall_clock64(); } while (0)
#else
#define STAMP(k) do { } while (0)
#endif
#define ITEMS(n, call) do { for (long it = gtid; it < (long)(n); it += gthreads) { call; } } while (0)
#define SSL(j) (SS + (size_t)(4 * l + (j)) * C::M)
#define GEMM_ALL(STRIP, EPI, Aop, Bop, Mr, Nc, Kd, ...) do { pg8::Gemm g{Aop, Bop, Mr, Nc, Kd, Kd}; pg8::StaticOrder S; S.init(Mr, Nc, gsz, bid, (STRIP) ? 288 : 256); \
        pg8::EPI E{__VA_ARGS__}; pg8::gemm_phase<pg8::EPI, pg8::StaticOrder, STRIP, false>(lds, g, S, E, nullptr); } while (0)
#if ONE_LAUNCH
    if (threadIdx.x < 4) ((LAS unsigned*)(lds + LDS_CTL))[threadIdx.x] = 0u;
    __syncthreads();
    XcdBarrier bar = xcd_barrier_post((unsigned*)(a.p.ws + C::WS_CTL), (volatile LAS unsigned*)(lds + LDS_CTL));
#else
    XcdBarrier bar; bar.bar = nullptr; bar.x = 0; bar.st = nullptr;
#endif

    if (IN(0)) { PHASE_ARGS STAMP(0);
        const int gw = bid * NWAVES + wave, NGW = gsz * NWAVES;
        for (int l = 0; l < C::DEPTH; ++l)
            for (int idx = 0; idx < 10; ++idx) { const WDesc d = wdesc(p, l, idx); const int nitems = (d.K / 64) * (d.N / 64);
                for (int it = gw; it < nitems; it += NGW) prep_item(d.W, d.K, d.Ncols, d.g, d.kind, d.N, d.dst, lds + wave * 9216, it, lane); }
        rw::rows_init(p, tid, bid, gsz);
        GRID_BAR(0);
    }
    for (int l = 0; l < C::DEPTH; ++l) {
        const int pb = 1 + PH_PER_LAYER * l;
        if (IN(pb + 0)) { PHASE_ARGS STAMP(pb + 0);
            GEMM_ALL(true, EpiSwiGLU, wsb<C>(p, C::WS_XB), wlayer<C>(p, l, C::W_1IN), C::M, 2 * C::FF, C::D, wsb<C>(p, C::WS_BIG), SSL(0), C::FF, invd);
            GRID_BAR(pb + 0); }
        if (IN(pb + 1)) { PHASE_ARGS STAMP(pb + 1);
            GEMM_ALL(true, EpiResid, wsb<C>(p, C::WS_BIG), wlayer<C>(p, l, C::W_1OUT), C::M, C::D, C::FF, wsf<C>(p, C::WS_X), wsb<C>(p, C::WS_XB), SSL(1), 0.5f, C::D);
            GRID_BAR(pb + 1); }
        if (IN(pb + 2)) { PHASE_ARGS STAMP(pb + 2);
            GEMM_ALL(true, EpiScaleF32, wsb<C>(p, C::WS_XB), wlayer<C>(p, l, C::W_IN), C::M, C::LDP, C::D, wsf<C>(p, C::WS_BIG), C::LDP, SSL(1), invd);
            GRID_BAR(pb + 2); }
        if (IN(pb + 3)) { PHASE_ARGS STAMP(pb + 3); mp::ml_a(lds, p, l, tid, bid, gsz);
#if defined(PROBE_MIXA)
            xcd_barrier(bar); STAMP(40 + l);
#endif
            gp::gmlp_phase(lds, p, l, tid, bid, gsz);
#if defined(PROBE_MIXA)
            xcd_barrier(bar); STAMP(42 + l);
#endif
            gp::pool_phase(lds, p, l, tid, (bid + gsz / 2) % gsz, gsz); GRID_BAR(pb + 3); }
        if (IN(pb + 4)) { PHASE_ARGS STAMP(pb + 4);
            if (bid < 64) {
                pg8::Gemm g{wsb<C>(p, C::WS_MEMB), wlayer<C>(p, l, C::W_KV), C::MM, 2 * C::D, C::D, C::D}; pg8::StaticOrder S; S.init(C::MM, 2 * C::D, 64, bid);
                pg8::EpiMemKV E{p.out + C::OUT_MK + (size_t)l * C::MM * C::D, p.out + C::OUT_MV + (size_t)l * C::MM * C::D, wsf<C>(p, C::WS_RSTDM), C::D};
                pg8::gemm_phase<pg8::EpiMemKV, pg8::StaticOrder, false, false>(lds, g, S, E, nullptr);
            } else mp::ml_scan(p, l, (long)(bid - 64) * NTHREADS + tid, (long)(gsz - 64) * NTHREADS);
            GRID_BAR(pb + 4); }
        if (IN(pb + 5)) { PHASE_ARGS STAMP(pb + 5); mp::ml_c(lds, p, l, tid, bid, gsz); GRID_BAR(pb + 5); }
        if (IN(pb + 6)) { PHASE_ARGS STAMP(pb + 6);
            GEMM_ALL(true, EpiResid, wsb<C>(p, C::WS_MIX), wlayer<C>(p, l, C::W_OUT), C::M, C::D, C::D, wsf<C>(p, C::WS_X), wsb<C>(p, C::WS_XB), SSL(2), 1.0f, C::D);
            GRID_BAR(pb + 6); }
        if (IN(pb + 7)) { PHASE_ARGS STAMP(pb + 7);
            GEMM_ALL(true, EpiScaleBf16, wsb<C>(p, C::WS_XB), wlayer<C>(p, l, C::W_Q), C::M, C::D, C::D, wsb<C>(p, C::WS_Q), C::D, SSL(2), invd);
            GRID_BAR(pb + 7); }
        if (IN(pb + 8)) { PHASE_ARGS STAMP(pb + 8); att::attn_phase(lds, p, l, tid, bid, gsz); GRID_BAR(pb + 8); }
        if (IN(pb + 9)) { PHASE_ARGS STAMP(pb + 9);
            GEMM_ALL(true, EpiResid, wsb<C>(p, C::WS_AO), wlayer<C>(p, l, C::W_O), C::M, C::D, C::D, wsf<C>(p, C::WS_X), wsb<C>(p, C::WS_XB), SSL(3), 1.0f, C::D);
            GRID_BAR(pb + 9); }
        if (IN(pb + 10)) { PHASE_ARGS STAMP(pb + 10);
            GEMM_ALL(true, EpiSwiGLU, wsb<C>(p, C::WS_XB), wlayer<C>(p, l, C::W_2IN), C::M, 2 * C::FF, C::D, wsb<C>(p, C::WS_BIG), SSL(3), C::FF, invd);
            GRID_BAR(pb + 10); }
        if (IN(pb + 11)) { PHASE_ARGS STAMP(pb + 11);
            GEMM_ALL(true, EpiResid, wsb<C>(p, C::WS_BIG), wlayer<C>(p, l, C::W_2OUT), C::M, C::D, C::FF, wsf<C>(p, C::WS_X), wsb<C>(p, C::WS_XB), SSL(4), 0.5f, C::D);
            GRID_BAR(pb + 11); }
    }
    if (IN(N_PHASES - 1)) { PHASE_ARGS STAMP(N_PHASES - 1); __syncthreads(); rw::rows_final(p, tid, bid, gsz); }
#undef IN
#undef BOTH
#undef GRID_BAR
#undef ITEMS
#undef PHASE_ARGS
#undef SSL
}

extern "C" void kernel_launch(void* const* d_in, const int* in_sizes, int n_in, void* d_out, int out_size, void* d_ws, size_t ws_size, hipStream_t stream) {
    static int ready = 0;
    if (!ready) {
        if (n_in != 33 || (long)out_size != (long)C::OUT_END || ws_size < (size_t)C::WS_END) { fprintf(stderr, "kernel_launch: unexpected shapes: n_in %d out %d ws %zu (need %zu)\n", n_in, out_size, ws_size, (size_t)C::WS_END); ready = -1; return; }
        if (hipFuncSetAttribute((const void*)fwd, hipFuncAttributeMaxDynamicSharedMemorySize, LDS_BYTES) != hipSuccess) { fprintf(stderr, "kernel_launch: hipFuncSetAttribute failed\n"); ready = -1; return; }
        int dev = 0, cus = 0, per_cu = 0;
        if (hipGetDevice(&dev) != hipSuccess || hipDeviceGetAttribute(&cus, hipDeviceAttributeMultiprocessorCount, dev) != hipSuccess) { fprintf(stderr, "kernel_launch: device query failed\n"); ready = -1; return; }
        if (hipOccupancyMaxActiveBlocksPerMultiprocessor(&per_cu, (const void*)fwd, NTHREADS, LDS_BYTES) != hipSuccess || per_cu < 1) { fprintf(stderr, "kernel_launch: occupancy query reports %d blocks per CU\n", per_cu); (void)hipGetLastError(); per_cu = 1; }
        if (cus != 256) { fprintf(stderr, "kernel_launch: built for a 256-CU device (one resident workgroup per CU), found %d\n", cus); ready = -1; return; }
        ready = cus;
    }
    if (ready < 0) return;
    Args a{};
    for (int i = 0; i < 33; ++i) a.p.in[i] = (const float*)d_in[i];
    a.p.out = (float*)d_out; a.p.ws = (unsigned char*)d_ws;
#if ONE_LAUNCH
    (void)hipMemsetAsync((char*)d_ws + C::WS_CTL, 0, 65536, stream);
    a.ph_lo = 0; a.ph_hi = N_PHASES;
    hipLaunchKernelGGL(fwd, dim3(ready), dim3(NTHREADS), LDS_BYTES, stream, a);
#else
    for (int k = 0; k < N_PHASES; ++k) { a.ph_lo = k; a.ph_hi = k + 1; hipLaunchKernelGGL(fwd, dim3(ready), dim3(NTHREADS), LDS_BYTES, stream, a); }
#endif
}
```

```cpp
#include <hip/hip_runtime.h>
#include <cstdio>
#define ONE_LAUNCH 1

#define HD __host__ __device__
#ifndef HD
#define HD __host__ __device__
#endif
typedef unsigned short bf16_t;
HD inline unsigned f2u(float f) { return __builtin_bit_cast(unsigned, f); }
HD inline float u2f(unsigned u) { return __builtin_bit_cast(float, u); }
HD inline bf16_t f2bf(float f) { unsigned u = f2u(f); u += 0x7FFFu + ((u >> 16) & 1u); return (bf16_t)(u >> 16); }
HD inline float bf2f(bf16_t b) { return u2f(((unsigned)b) << 16); }

struct RC {
    static constexpr int D = 2048, FF = 8192, BATCH = 4, SEQ = 2048, DEPTH = 2, DEC_BATCH = 32, DEC_SEQ = 32, PAST = 2048, NMEM = 256;
};
template <class B> struct CfgT : B {
    using B::D; using B::FF; using B::BATCH; using B::SEQ; using B::DEPTH; using B::DEC_BATCH; using B::DEC_SEQ; using B::PAST; using B::NMEM;
    static constexpr int MP = BATCH * SEQ, MS = DEC_BATCH * DEC_SEQ, M = MP + MS, MM = BATCH * NMEM;
    static constexpr int PW = D / 4, PG = 4, PGD = PW / 4, PH = 15;
    static constexpr int GW = D / 4, GH = 4, GHD = GW / 4, GCH = 128;
    static constexpr int MW = D - PW - GW, MH = 8, MHD = MW / 8, CH = 64;
    static constexpr int INC = PW + 2 * GW + 4 * MW + 2 * MH;
    static constexpr int LDP = ((INC + 255) / 256) * 256;
    static constexpr int AH = 4, AHD = D / 4;
    static constexpr int O_U = PW, O_V = PW + GW, O_Q = PW + 2 * GW, O_K = O_Q + MW, O_VM = O_K + MW, O_O = O_VM + MW, O_IG = O_O + MW, O_FG = O_IG + MH;
    static constexpr int NC = SEQ / CH, NPC = BATCH * MH * NC, NSC = DEC_BATCH * MH, NCH = NPC + NSC;
    static constexpr int LCS = DEC_SEQ < CH ? DEC_SEQ : CH;
    static constexpr int GLP = SEQ < GCH ? SEQ : GCH, GLS = DEC_SEQ < GCH ? DEC_SEQ : GCH;
    static constexpr int NSS = 1 + 4 * DEPTH;
    static constexpr long OUT_YP = 0, OUT_YS = OUT_YP + (long)MP * D, OUT_POOLP = OUT_YS + (long)MS * D, OUT_POOLS = OUT_POOLP + (long)DEPTH * BATCH * PH * PW,
        OUT_CP = OUT_POOLS + (long)DEPTH * DEC_BATCH * PH * PW, OUT_NP = OUT_CP + (long)DEPTH * BATCH * MH * MHD * MHD, OUT_MP = OUT_NP + (long)DEPTH * BATCH * MH * MHD,
        OUT_CS = OUT_MP + (long)DEPTH * BATCH * MH, OUT_NS = OUT_CS + (long)DEPTH * DEC_BATCH * MH * MHD * MHD, OUT_MS = OUT_NS + (long)DEPTH * DEC_BATCH * MH * MHD,
        OUT_VS = OUT_MS + (long)DEPTH * DEC_BATCH * MH, OUT_MK = OUT_VS + (long)DEPTH * DEC_BATCH * DEC_SEQ * GW, OUT_MV = OUT_MK + (long)DEPTH * BATCH * NMEM * D,
        OUT_END = OUT_MV + (long)DEPTH * BATCH * NMEM * D;
    static constexpr size_t al(size_t x) { return (x + 255) & ~(size_t)255; }
    static constexpr size_t WS_CTL = 0, WS_SS = 65536, WS_X = al(WS_SS + (size_t)NSS * M * 4), WS_XB = al(WS_X + (size_t)M * D * 4),
        WS_BIG = al(WS_XB + (size_t)M * D * 2),
        WS_BIG_SZ = ((size_t)M * FF * 2 > (size_t)M * LDP * 4) ? (size_t)M * FF * 2 : (size_t)M * LDP * 4,
        WS_MIX = al(WS_BIG + WS_BIG_SZ), WS_Q = al(WS_MIX + (size_t)M * D * 2), WS_AO = al(WS_Q + (size_t)M * D * 2),
        WS_MEMB = al(WS_AO + (size_t)M * D * 2), WS_RSTDM = al(WS_MEMB + (size_t)MM * D * 2),
        WS_GB = al(WS_RSTDM + (size_t)MM * 4), WS_GA = al(WS_GB + (size_t)M * MH * 4),
        WS_CBL = al(WS_GA + (size_t)M * MH * 4), WS_CML = al(WS_CBL + (size_t)NCH * 4), WS_MPREV = al(WS_CML + (size_t)NCH * 4),
        WS_DC = al(WS_MPREV + (size_t)NCH * 4), WS_DN = al(WS_DC + (size_t)NCH * MHD * MHD * 4),
        WS_DCB = al(WS_DN + (size_t)NCH * MHD * 4),
        WS_W = al(WS_DCB + (size_t)NCH * MHD * MHD * 2);
    static constexpr size_t W_1IN = 0, W_1OUT = W_1IN + (size_t)2 * FF * D, W_IN = W_1OUT + (size_t)D * FF, W_OUT = W_IN + (size_t)LDP * D, W_Q = W_OUT + (size_t)D * D,
        W_KV = W_Q + (size_t)D * D, W_O = W_KV + (size_t)2 * D * D, W_2IN = W_O + (size_t)D * D, W_2OUT = W_2IN + (size_t)2 * FF * D, W_LAYER = W_2OUT + (size_t)D * FF;
    static constexpr size_t WS_END = al(WS_W + (size_t)DEPTH * W_LAYER * 2);
};

struct Ptrs { const float* in[33]; float* out; unsigned char* ws; };
enum { I_XP = 0, I_XS, I_MEM, I_SPOOL, I_SC, I_SN, I_SM, I_CK, I_CV, I_GFFN1, I_W1IN, I_W1OUT, I_GMIX, I_WIN, I_POOLW, I_POOLS, I_GVG, I_GWS, I_GBS, I_IB, I_FB, I_NG, I_WOUT,
       I_GX, I_GMEM, I_WQ, I_WK, I_WV, I_WO, I_GFFN2, I_W2IN, I_W2OUT, I_GFIN };

template <class C> HD inline float* wsf(const Ptrs& p, size_t off) { return (float*)(p.ws + off); }
template <class C> HD inline bf16_t* wsb(const Ptrs& p, size_t off) { return (bf16_t*)(p.ws + off); }
template <class C> HD inline bf16_t* wlayer(const Ptrs& p, int l, size_t off) { return (bf16_t*)(p.ws + C::WS_W) + (size_t)l * C::W_LAYER + off; }

template <class C> HD inline void row_info(int r, bool& s, int& b, int& t) {
    if (r < C::MP) { s = false; b = r / C::SEQ; t = r % C::SEQ; } else { s = true; const int q = r - C::MP; b = q / C::DEC_SEQ; t = q % C::DEC_SEQ; }
}
template <class C> HD inline void chunk_info(int r, int h, int& ci, int& i, int& lc) {
    bool s; int b, t; row_info<C>(r, s, b, t);
    if (!s) { ci = (b * C::MH + h) * C::NC + t / C::CH; i = t % C::CH; lc = C::CH; } else { ci = C::NPC + b * C::MH + h; i = t; lc = C::LCS; }
}
HD inline float sigmoidf_(float x) { return 1.0f / (1.0f + expf(-x)); }
HD inline float logsigmoidf_(float x) { return x >= 0.f ? -log1pf(expf(-x)) : x - log1pf(expf(x)); }

enum { WK_PLAIN = 0, WK_FFNIN = 1, WK_WIN = 2 };
template <class C> HD inline int wsrc_col(int kind, int n) {
    if (kind == WK_FFNIN) { const int pn = n >> 8, j = n & 255; return j < 128 ? 128 * pn + j : C::FF + 128 * pn + (j - 128); }
    if (kind == WK_WIN) return n < C::INC ? n : -1;
    return n;
}

template <class C> HD inline void st_ml_b0(const Ptrs& p, int l, int sq) {
    const float* CBL = wsf<C>(p, C::WS_CBL); const float* CML = wsf<C>(p, C::WS_CML); float* MPREV = wsf<C>(p, C::WS_MPREV);
    if (sq < C::BATCH * C::MH) { float m = 0.f;
        for (int c = 0; c < C::NC; ++c) { const int ci = sq * C::NC + c; MPREV[ci] = m; const float a = CBL[ci] + m, b2 = CML[ci]; m = a > b2 ? a : b2; }
        p.out[C::OUT_MP + (size_t)l * C::BATCH * C::MH + sq] = m;
    } else { const int q = sq - C::BATCH * C::MH, ci = C::NPC + q; const float m0 = p.in[I_SM][(size_t)l * C::DEC_BATCH * C::MH + q];
        MPREV[ci] = m0; const float a = CBL[ci] + m0, b2 = CML[ci]; p.out[C::OUT_MS + (size_t)l * C::DEC_BATCH * C::MH + q] = a > b2 ? a : b2; }
}

namespace pg8 {
#define PG8_LAS __attribute__((address_space(3)))
typedef unsigned short bf16_t;
typedef short bf16x8 __attribute__((ext_vector_type(8)));
typedef float f32x4 __attribute__((ext_vector_type(4)));
typedef unsigned u32x4 __attribute__((ext_vector_type(4)));
constexpr int BM = 256, BK = 64, HALF = 128, HTB = HALF * BK * 2  , STAGE_BYTES = 8 * HTB, NXCD = 8, WGM = 8;

__host__ __device__ __forceinline__ int lds_byte(int r, int c) { const int st = (r >> 4) * 2 + (c >> 5), rr = r & 15, cc = c & 31, ob = rr * 64 + cc * 2; return st * 1024 + (ob ^ (((ob >> 9) & 1) << 5)); }
__host__ __device__ __forceinline__ void stage_rc(int b, int& R, int& C) { const int st = b / 1024, sb = b % 1024, swz = sb ^ (((sb >> 9) & 1) << 5); R = (st >> 1) * 16 + swz / 64; C = (st & 1) * 32 + (swz % 64) / 2; }
__host__ __device__ __forceinline__ int perm32(int rho) { const int n = rho >> 4, i = rho & 15; return 8 * (i >> 2) + 4 * n + (i & 3); }

struct Unit { int pm, pn; };
struct Gemm { const bf16_t* A; const bf16_t* Bt; int M, N, K, ld; };

struct StaticOrder {
    int nM, nN, nwg, G, c;
    __host__ __device__ __forceinline__ void init(int M, int N, int G_, int c_, int rows_per_tile = BM) { nM = M / rows_per_tile; nN = N / BM; nwg = nM * nN; G = G_; c = c_; }
    __host__ __device__ __forceinline__ bool next(int i, Unit& u) const {
        const long L = (long)i * G + c; if (L >= nwg) return false;
        int wgid = (int)L; { const int q = nwg / NXCD, r = nwg % NXCD, xcd = wgid % NXCD, off = wgid / NXCD; wgid = (xcd < r ? xcd * (q + 1) : r * (q + 1) + (xcd - r) * q) + off; }
        const int nig = WGM * nN, gid = wgid / nig, fm = gid * WGM, gsz = (nM - fm) < WGM ? (nM - fm) : WGM;
        u.pm = fm + ((wgid % nig) % gsz); u.pn = (wgid % nig) / gsz; return true;
    }
    __device__ __forceinline__ void a_ready(const Unit&) const {}
    __device__ __forceinline__ void done(const Unit&) const {}
};
__device__ __forceinline__ unsigned cvt_pk_bf16(float lo, float hi) { unsigned r; asm volatile("v_cvt_pk_bf16_f32 %0, %1, %2" : "=v"(r) : "v"(lo), "v"(hi)); return r; }
typedef float f32x2 __attribute__((ext_vector_type(2)));
template <class Epi, class Sched, bool STRIP = false, bool STAMP = false>
__device__ __forceinline__ void gemm_phase(PG8_LAS unsigned char* lds, const Gemm g, const Sched& S, const Epi& E, unsigned long long* stamps) {
    int tid_l = threadIdx.x; asm volatile("" : "+v"(tid_l));
    const int tid = tid_l, wid = __builtin_amdgcn_readfirstlane(tid >> 6), lane = tid & 63, wr = wid >> 2, wc = wid & 3, fr = lane & 15, fq = lane >> 4;
    const int K = g.K, nt = K / BK;
    int ts_lo = 0, ts_hi = 0, nts = 0; const unsigned long long rt_entry = STAMP ? (unsigned long long)wall_clock64() : 0ull;
#define PG8_STAMP() do { if (STAMP && wid == 0 && nts < 64) { const unsigned long long _c = (unsigned long long)clock64(); \
        ts_lo = (lane == nts) ? (int)(unsigned)_c : ts_lo; ts_hi = (lane == nts) ? (int)(unsigned)(_c >> 32) : ts_hi; ++nts; } } while (0)
    PG8_STAMP();
    unsigned voffA[2], voffB[2];
#pragma unroll
    for (int i = 0; i < 2; ++i) { int R, C; stage_rc(tid * 16 + i * 8192, R, C); const int Rb = Epi::PERM ? ((R & ~31) + perm32(R & 31)) : R;
        voffA[i] = (unsigned)(R * g.ld + C) * 2u; voffB[i] = (unsigned)(Rb * g.ld + C) * 2u; }
    const size_t kstep = (size_t)(BK * 2);
    const size_t hstep = (size_t)HALF * g.ld * 2;
    const size_t tstep = 2 * hstep;
    const size_t tstepA = STRIP ? (size_t)288 * g.ld * 2 : tstep;
    unsigned voffS = 0u; if constexpr (STRIP) { int R, C; stage_rc((wid & 3) * 1024 + lane * 16, R, C); voffS = (unsigned)(R * g.ld + C) * 2u; }
    const int soff = lds_byte(wr * 16 + fr, fq * 8);
    const unsigned ldsw = (unsigned)wid * 1024u;
    const int aoff = lds_byte(wr * 64 + fr, fq * 8), boff = lds_byte(wc * 32 + fr, fq * 8);
#define PG8_SA(b, h) (((b) * 2 + (h)) * HTB)
#define PG8_SB(b, h) ((4 + (b) * 2 + (h)) * HTB)
#define PG8_SS(b) (8 * HTB + (b) * 8192)
#define PG8_STAGE_S(b, gbase) do { if constexpr (STRIP) __builtin_amdgcn_global_load_lds((const unsigned*)((const char*)(gbase) + 2 * hstep + voffS), (PG8_LAS unsigned*)(lds + PG8_SS(b) + ldsw), 16, 0, 0); } while (0)
#define PG8_LDS(b) do { if constexpr (STRIP) { _Pragma("unroll") for (int k = 0; k < 2; ++k) Sf[k] = *(const PG8_LAS bf16x8*)(lds + PG8_SS(b) + soff + k * 1024); } } while (0)
#define PG8_MMS(bj, Bt) do { if constexpr (STRIP) { _Pragma("unroll") for (int n = 0; n < 2; ++n) _Pragma("unroll") for (int k = 0; k < 2; ++k) accS[bj][n] = __builtin_amdgcn_mfma_f32_16x16x32_bf16(Bt[n][k], Sf[k], accS[bj][n], 0, 0, 0); } } while (0)
#define PG8_STAGE(bufoff, gbase, voff) do { _Pragma("unroll") for (int _i = 0; _i < 2; ++_i) \
        __builtin_amdgcn_global_load_lds((const unsigned*)((const char*)(gbase) + (voff)[_i]), (PG8_LAS unsigned*)(lds + (bufoff) + ldsw + _i * 8192), 16, 0, 0); } while (0)
#define PG8_LDA(dst, b, h) do { _Pragma("unroll") for (int m = 0; m < 4; ++m) _Pragma("unroll") for (int k = 0; k < 2; ++k) dst[m][k] = *(const PG8_LAS bf16x8*)(lds + PG8_SA(b, h) + aoff + m * 2048 + k * 1024); } while (0)
#define PG8_LDB(dst, b, h) do { _Pragma("unroll") for (int n = 0; n < 2; ++n) _Pragma("unroll") for (int k = 0; k < 2; ++k) dst[n][k] = *(const PG8_LAS bf16x8*)(lds + PG8_SB(b, h) + boff + n * 2048 + k * 1024); } while (0)
#define PG8_MMA(ai, bj, At, Bt) do { __builtin_amdgcn_s_setprio(1); _Pragma("unroll") for (int m = 0; m < 4; ++m) _Pragma("unroll") for (int n = 0; n < 2; ++n) _Pragma("unroll") for (int k = 0; k < 2; ++k) \
        acc[ai][bj][m][n] = __builtin_amdgcn_mfma_f32_16x16x32_bf16(Bt[n][k], At[m][k], acc[ai][bj][m][n], 0, 0, 0); __builtin_amdgcn_s_setprio(0); } while (0)
#define PG8_WAIT_V(n) asm volatile("s_waitcnt vmcnt(" #n ")" ::: "memory")
#define PG8_WAIT_L(n) asm volatile("s_waitcnt lgkmcnt(" #n ")" ::: "memory")
#define PG8_WAIT_VS(n, ns) do { if constexpr (STRIP) PG8_WAIT_V(ns); else PG8_WAIT_V(n); } while (0)
#define PG8_WAIT_LS(n, ns) do { if constexpr (STRIP) PG8_WAIT_L(ns); else PG8_WAIT_L(n); } while (0)
#define PG8_BAR __builtin_amdgcn_s_barrier()
#define PG8_SCHED __builtin_amdgcn_sched_barrier(0)
    Unit cur, nxt; int ui = 0;
    if (!S.next(0, cur)) return;
    f32x4 acc[2][2][4][2];
#pragma unroll
    for (int a = 0; a < 2; ++a)
#pragma unroll
        for (int b = 0; b < 2; ++b)
#pragma unroll
            for (int m = 0; m < 4; ++m)
#pragma unroll
                for (int n = 0; n < 2; ++n) acc[a][b][m][n] = (f32x4){0.f, 0.f, 0.f, 0.f};
    bf16x8 At[4][2], B0[2][2], B1[2][2];
    f32x4 accS[2][2]; bf16x8 Sf[2];
#pragma unroll
    for (int b = 0; b < 2; ++b)
#pragma unroll
        for (int n = 0; n < 2; ++n) accS[b][n] = (f32x4){0.f, 0.f, 0.f, 0.f};
#pragma unroll
    for (int k = 0; k < 2; ++k) Sf[k] = (bf16x8){0, 0, 0, 0, 0, 0, 0, 0};
    const char* cA = (const char*)g.A + (size_t)cur.pm * tstepA; const char* cB = (const char*)g.Bt + (size_t)cur.pn * tstep;
    S.a_ready(cur);
    PG8_STAGE(PG8_SB(0, 0), cB, voffB); PG8_STAGE(PG8_SA(0, 0), cA, voffA); PG8_STAGE(PG8_SB(0, 1), cB + hstep, voffB); PG8_STAGE(PG8_SA(0, 1), cA + hstep, voffA); PG8_STAGE_S(0, cA);
    if (wr == 1) PG8_BAR;
    PG8_WAIT_VS(4, 5); PG8_BAR;
    PG8_STAGE(PG8_SB(1, 0), cB + kstep, voffB); PG8_STAGE(PG8_SA(1, 0), cA + kstep, voffA); PG8_STAGE(PG8_SB(1, 1), cB + hstep + kstep, voffB); PG8_STAGE_S(1, cA + kstep);
    PG8_WAIT_VS(6, 7); PG8_BAR;
    PG8_STAMP();
    for (;;) {
        const bool has_next = S.next(ui + 1, nxt);
        const char* nA = has_next ? (const char*)g.A + (size_t)nxt.pm * tstepA : cA; const char* nB = has_next ? (const char*)g.Bt + (size_t)nxt.pn * tstep : cB;
        for (int t = 0; t < nt; t += 2) {
            const bool last = (t == nt - 2);
            const char* a1 = cA + (size_t)(t + 1) * kstep;
            const char* a2 = last ? nA : cA + (size_t)(t + 2) * kstep; const char* b2 = last ? nB : cB + (size_t)(t + 2) * kstep;
            const char* a3 = a2 + kstep; const char* b3 = b2 + kstep;
            if (last && has_next) S.a_ready(nxt);
            PG8_LDB(B0, 0, 0); PG8_SCHED; PG8_LDA(At, 0, 0); PG8_LDS(0); PG8_STAGE(PG8_SA(1, 1), a1 + hstep, voffA);
            PG8_WAIT_LS(8, 10); PG8_BAR; PG8_WAIT_L(0); PG8_MMA(0, 0, At, B0); PG8_MMS(0, B0); PG8_BAR; PG8_SCHED;
            PG8_LDB(B1, 0, 1); PG8_STAGE(PG8_SB(0, 0), b2, voffB);
            PG8_BAR; PG8_WAIT_L(0); PG8_MMA(0, 1, At, B1); PG8_MMS(1, B1); PG8_BAR;
            PG8_LDA(At, 0, 1); PG8_STAGE(PG8_SA(0, 0), a2, voffA); PG8_STAGE_S(0, a2);
            PG8_BAR; PG8_WAIT_L(0); PG8_MMA(1, 0, At, B0); PG8_BAR; PG8_SCHED;
            PG8_STAGE(PG8_SB(0, 1), b2 + hstep, voffB);
            PG8_WAIT_VS(6, 7); PG8_BAR; PG8_MMA(1, 1, At, B1); PG8_BAR;
            PG8_LDB(B0, 1, 0); PG8_SCHED; PG8_LDA(At, 1, 0); PG8_LDS(1); PG8_STAGE(PG8_SA(0, 1), a2 + hstep, voffA);
            PG8_WAIT_LS(8, 10); PG8_BAR; PG8_WAIT_L(0); PG8_MMA(0, 0, At, B0); PG8_MMS(0, B0); PG8_BAR; PG8_SCHED;
            PG8_LDB(B1, 1, 1); PG8_STAGE(PG8_SB(1, 0), b3, voffB);
            PG8_BAR; PG8_WAIT_L(0); PG8_MMA(0, 1, At, B1); PG8_MMS(1, B1); PG8_BAR;
            PG8_LDA(At, 1, 1); PG8_STAGE(PG8_SA(1, 0), a3, voffA); PG8_STAGE_S(1, a3);
            PG8_BAR; PG8_WAIT_L(0); PG8_MMA(1, 0, At, B0); PG8_BAR; PG8_SCHED;
            PG8_STAGE(PG8_SB(1, 1), b3 + hstep, voffB);
            PG8_WAIT_VS(6, 7); PG8_BAR; PG8_MMA(1, 1, At, B1); PG8_BAR;
        }
        PG8_STAMP();
        { const int rt0 = cur.pm * (STRIP ? 288 : 256), rw0 = rt0 + wr * 64 + fr;
#define PG8_RV(ai, m) {{acc[ai][0][m][0], acc[ai][0][m][1]}, {acc[ai][1][m][0], acc[ai][1][m][1]}}
#define PG8_BATCH(r0_, v0_, r1_, v1_) do { const typename Epi::Pre p0_ = E.pre(r0_, cur.pn, wc, fq), p1_ = E.pre(r1_, cur.pn, wc, fq); \
              { const f32x4 v_[2][2] = v0_; E.row(v_, p0_, r0_, cur.pn, wc, fq); } { const f32x4 v_[2][2] = v1_; E.row(v_, p1_, r1_, cur.pn, wc, fq); } } while (0)
          PG8_BATCH(rw0, PG8_RV(0, 0), rw0 + 16, PG8_RV(0, 1));
          PG8_BATCH(rw0 + 32, PG8_RV(0, 2), rw0 + 48, PG8_RV(0, 3));
          PG8_BATCH(rw0 + HALF, PG8_RV(1, 0), rw0 + HALF + 16, PG8_RV(1, 1));
          PG8_BATCH(rw0 + HALF + 32, PG8_RV(1, 2), rw0 + HALF + 48, PG8_RV(1, 3));
          if constexpr (STRIP) { const int rs_ = rt0 + 256 + wr * 16 + fr; const typename Epi::Pre ps_ = E.pre(rs_, cur.pn, wc, fq); E.row(accS, ps_, rs_, cur.pn, wc, fq);
#pragma unroll
              for (int b = 0; b < 2; ++b)
#pragma unroll
                for (int n = 0; n < 2; ++n) accS[b][n] = (f32x4){0.f, 0.f, 0.f, 0.f}; }
#undef PG8_BATCH
#undef PG8_RV
          S.done(cur); }
        PG8_STAMP();
        if (!has_next) break;
#pragma unroll
        for (int a = 0; a < 2; ++a)
#pragma unroll
            for (int b = 0; b < 2; ++b)
#pragma unroll
                for (int m = 0; m < 4; ++m)
#pragma unroll
                    for (int n = 0; n < 2; ++n) acc[a][b][m][n] = (f32x4){0.f, 0.f, 0.f, 0.f};
        cur = nxt; cA = nA; cB = nB; ++ui;
    }
    PG8_WAIT_V(0);
    if (wr == 0) PG8_BAR;
    PG8_BAR;
    PG8_STAMP();
    if (STAMP && wid == 0) { stamps[lane] = lane < nts ? (((unsigned long long)(unsigned)ts_hi << 32) | (unsigned)ts_lo) : 0ull;
        if (lane == 62) stamps[62] = rt_entry; if (lane == 63) stamps[63] = (unsigned long long)wall_clock64(); }
#undef PG8_STAMP
#undef PG8_SA
#undef PG8_SB
#undef PG8_STAGE
#undef PG8_LDA
#undef PG8_LDB
#undef PG8_MMA
#undef PG8_WAIT_V
#undef PG8_WAIT_L
#undef PG8_BAR
#undef PG8_SCHED
#undef PG8_WAIT_LS
#undef PG8_WAIT_VS
#undef PG8_MMS
#undef PG8_LDS
#undef PG8_STAGE_S
#undef PG8_SS
}
}


#define LAS __attribute__((address_space(3)))
#define XB_TMO      128
#define XB_XCNT(j)  (256  + 64 * (j))
#define XB_XSUB(j)  (1280 + 64 * (j))
#define XB_XGEN(j)  (2304 + 64 * (j))
#define XB_TOP      3328
#define XB_TOPGEN   3392
#define XCD_BAR_WORDS 3456
#define XB_SPIN_CAP (1u << 18)

__device__ __forceinline__ unsigned xb_ld(unsigned* p)              { return __hip_atomic_load(p, __ATOMIC_RELAXED, __HIP_MEMORY_SCOPE_AGENT); }
__device__ __forceinline__ unsigned xb_add(unsigned* p, unsigned v) { return __hip_atomic_fetch_add(p, v, __ATOMIC_RELAXED, __HIP_MEMORY_SCOPE_AGENT); }
__device__ __forceinline__ unsigned xb_xcc_id() { return (unsigned)__builtin_amdgcn_s_getreg((3 << 11) | 20) & 0xFu; }
#define XB_SPIN(cond, bar) do { unsigned _sp = 0; while (cond) { __builtin_amdgcn_s_sleep(1); \
    if ((++_sp & 255u) == 0u) { if (xb_ld(&(bar)[XB_TMO])) break; if (_sp > XB_SPIN_CAP) { atomicAdd(&(bar)[XB_TMO], 1u); break; } } } } while (0)

struct XcdBarrier {
    unsigned* bar; unsigned x;
    volatile LAS unsigned* st;
};

__device__ __forceinline__ XcdBarrier xcd_barrier_post(unsigned* bar, volatile LAS unsigned* st) {
    XcdBarrier b; b.bar = bar; b.x = xb_xcc_id(); b.st = st;
    if (threadIdx.x == 0) (void)xb_add(&bar[XB_XCNT(b.x)], 1u);
    return b;
}
__device__ __forceinline__ void xcd_barrier_complete(unsigned* bar, unsigned x, unsigned& nloc, unsigned& nx) {
    const unsigned G = gridDim.x * gridDim.y * gridDim.z;
    unsigned sum, cnt, mine, sp = 0u;
    for (;;) {
        sum = 0u; cnt = 0u; mine = 0u;
#pragma unroll
        for (unsigned j = 0; j < 16; ++j) { const unsigned c = xb_ld(&bar[XB_XCNT(j)]); sum += c; cnt += (c > 0u) ? 1u : 0u; mine = (j == x) ? c : mine; }
        if (sum == G) break;
        __builtin_amdgcn_s_sleep(1);
        if ((++sp & 255u) == 0u) { if (xb_ld(&bar[XB_TMO])) break; if (sp > XB_SPIN_CAP) { atomicAdd(&bar[XB_TMO], 1u); break; } }
    }
    nloc = mine > 0u ? mine : 1u; nx = cnt > 0u ? cnt : 1u;
}

__device__ __forceinline__ void xcd_barrier(const XcdBarrier& b) {
    asm volatile("s_waitcnt vmcnt(0)" ::: "memory");
    __syncthreads();
    if (threadIdx.x == 0) {
        unsigned* bar = b.bar;
        __builtin_amdgcn_s_waitcnt(0);
        unsigned nloc = b.st[0], nx = b.st[1];
        if (nloc == 0u) { xcd_barrier_complete(bar, b.x, nloc, nx); b.st[0] = nloc; b.st[1] = nx; }
        const unsigned old = xb_add(&bar[XB_XSUB(b.x)], 1u);
        const unsigned gen = old / nloc;
        if (old + 1u == (gen + 1u) * nloc) {
            __builtin_amdgcn_fence(__ATOMIC_RELEASE, "agent");
            asm volatile("s_waitcnt vmcnt(0)" ::: "memory");
            const unsigned og = xb_add(&bar[XB_TOP], 1u);
            const unsigned tg = og / nx;
            if (og + 1u == (tg + 1u) * nx) xb_add(&bar[XB_TOPGEN], 1u);
            else XB_SPIN(xb_ld(&bar[XB_TOPGEN]) == tg, bar);
            __builtin_amdgcn_fence(__ATOMIC_ACQUIRE, "agent");
            xb_add(&bar[XB_XGEN(b.x)], 1u);
            asm volatile("s_waitcnt vmcnt(0)" ::: "memory");
        } else {
            XB_SPIN(xb_ld(&bar[XB_XGEN(b.x)]) == gen, bar);
            __builtin_amdgcn_fence(__ATOMIC_ACQUIRE, "agent");
            asm volatile("s_waitcnt vmcnt(0)" ::: "memory");
        }
    }
    __syncthreads();
}

typedef CfgT<RC> C;
constexpr int NTHREADS = 512, NWAVES = 8;
constexpr int LDS_STAGE = 131072 + 16384 + 8192, LDS_CTL = LDS_STAGE, LDS_BYTES = LDS_STAGE + 256;

namespace pg8 {
typedef unsigned u32x2 __attribute__((ext_vector_type(2)));
__device__ __forceinline__ float silu_f(float g) { return g * __builtin_amdgcn_rcpf(1.0f + __expf(-g)); }
struct EpiSwiGLU { static constexpr bool PERM = true;
    bf16_t* act; const float* ss; int ff; float invd;
    typedef float Pre;
    __device__ __forceinline__ Pre pre(int row, int pn, int wc, int fq) const { return ss[row]; }
    __device__ __forceinline__ void row(const f32x4 (&v)[2][2], Pre ssr, int row, int pn, int wc, int fq) const {
        const float rs = rsqrtf(ssr * invd + 1e-6f); f32x4 o[2];
#pragma unroll
        for (int n = 0; n < 2; ++n) { const f32x4 g = v[0][n] * rs, up = v[1][n] * rs;
#pragma unroll
            for (int j = 0; j < 4; ++j) o[n][j] = silu_f(g[j]) * up[j]; }
        u32x4 w; w.x = cvt_pk_bf16(o[0][0], o[0][1]); w.y = cvt_pk_bf16(o[0][2], o[0][3]); w.z = cvt_pk_bf16(o[1][0], o[1][1]); w.w = cvt_pk_bf16(o[1][2], o[1][3]);
        *(u32x4*)(act + (size_t)row * ff + pn * 128 + wc * 32 + 8 * fq) = w;
    }
};
struct EpiResid { static constexpr bool PERM = false;
    float* X; bf16_t* XB; float* ssout; float scale; int ld;
    struct Pre { f32x4 x[2][2]; };
    __device__ __forceinline__ Pre pre(int row, int pn, int wc, int fq) const { Pre q; const float* xr = X + (size_t)row * ld + pn * BM + wc * 32 + 4 * fq;
#pragma unroll
        for (int bj = 0; bj < 2; ++bj)
#pragma unroll
            for (int n = 0; n < 2; ++n) q.x[bj][n] = *(const f32x4*)(xr + bj * HALF + n * 16);
        return q; }
    __device__ __forceinline__ void row(const f32x4 (&v)[2][2], const Pre& q, int row, int pn, int wc, int fq) const {
        const int col0 = pn * BM + wc * 32 + 4 * fq; float* xr = X + (size_t)row * ld + col0; bf16_t* br = XB + (size_t)row * ld + col0; float s = 0.f;
#pragma unroll
        for (int bj = 0; bj < 2; ++bj)
#pragma unroll
            for (int n = 0; n < 2; ++n) { const f32x4 x = q.x[bj][n] + v[bj][n] * scale; *(f32x4*)(xr + bj * HALF + n * 16) = x;
                u32x2 w; w.x = cvt_pk_bf16(x[0], x[1]); w.y = cvt_pk_bf16(x[2], x[3]); *(u32x2*)(br + bj * HALF + n * 16) = w;
                s += (x[0] * x[0] + x[1] * x[1]) + (x[2] * x[2] + x[3] * x[3]); }
        s += __shfl_xor(s, 16); s += __shfl_xor(s, 32);
        if (fq == 0) unsafeAtomicAdd(ssout + row, s);
    }
};
struct EpiScaleF32 { static constexpr bool PERM = false;
    float* Cp; int ldc; const float* ss; float invd;
    typedef float Pre;
    __device__ __forceinline__ Pre pre(int row, int pn, int wc, int fq) const { return ss[row]; }
    __device__ __forceinline__ void row(const f32x4 (&v)[2][2], Pre ssr, int row, int pn, int wc, int fq) const {
        const float rs = rsqrtf(ssr * invd + 1e-6f); float* cr = Cp + (size_t)row * ldc + pn * BM + wc * 32 + 4 * fq;
#pragma unroll
        for (int bj = 0; bj < 2; ++bj)
#pragma unroll
            for (int n = 0; n < 2; ++n) *(f32x4*)(cr + bj * HALF + n * 16) = v[bj][n] * rs;
    }
};
struct EpiScaleBf16 { static constexpr bool PERM = true;
    bf16_t* O; int ldc; const float* ss; float invd;
    typedef float Pre;
    __device__ __forceinline__ Pre pre(int row, int pn, int wc, int fq) const { return ss[row]; }
    __device__ __forceinline__ void row(const f32x4 (&v)[2][2], Pre ssr, int row, int pn, int wc, int fq) const {
        const float rs = rsqrtf(ssr * invd + 1e-6f); bf16_t* orow = O + (size_t)row * ldc + pn * BM + wc * 32 + 8 * fq;
#pragma unroll
        for (int bj = 0; bj < 2; ++bj) { const f32x4 v0 = v[bj][0] * rs, v1 = v[bj][1] * rs;
            u32x4 w; w.x = cvt_pk_bf16(v0[0], v0[1]); w.y = cvt_pk_bf16(v0[2], v0[3]); w.z = cvt_pk_bf16(v1[0], v1[1]); w.w = cvt_pk_bf16(v1[2], v1[3]);
            *(u32x4*)(orow + bj * HALF) = w; }
    }
};
struct EpiMemKV { static constexpr bool PERM = false;
    float* K; float* V; const float* rstd; int d;
    typedef float Pre;
    __device__ __forceinline__ Pre pre(int row, int pn, int wc, int fq) const { return rstd[row]; }
    __device__ __forceinline__ void row(const f32x4 (&v)[2][2], Pre rs, int row, int pn, int wc, int fq) const {
        int ct = pn * BM; float* base = K; if (ct >= d) { base = V; ct -= d; } float* cr = base + (size_t)row * d + ct + wc * 32 + 4 * fq;
#pragma unroll
        for (int bj = 0; bj < 2; ++bj)
#pragma unroll
            for (int n = 0; n < 2; ++n) *(f32x4*)(cr + bj * HALF + n * 16) = v[bj][n] * rs;
    }
};
}

__device__ __forceinline__ void prep_item(const float* W, int K, int Ncols, const float* g, int kind, int N, bf16_t* Bt, LAS unsigned char* scr, int item, int lane) {
    const int nblk = N / 64, kb = item / nblk, nb = item % nblk, k0 = 64 * kb, n = 64 * nb + lane;
    const int sc = wsrc_col<C>(kind, n);
    const float* src = W + (size_t)k0 * Ncols + (sc >= 0 ? sc : 0);
    float v[64];
#pragma unroll
    for (int kk = 0; kk < 64; ++kk) v[kk] = src[(size_t)kk * Ncols];
    if (g) {
#pragma unroll
        for (int kk = 0; kk < 64; ++kk) v[kk] *= g[k0 + kk];
    }
    if (sc < 0) {
#pragma unroll
        for (int kk = 0; kk < 64; ++kk) v[kk] = 0.f;
    }
#pragma unroll
    for (int j = 0; j < 8; ++j) { pg8::u32x4 o; o.x = pg8::cvt_pk_bf16(v[8 * j], v[8 * j + 1]); o.y = pg8::cvt_pk_bf16(v[8 * j + 2], v[8 * j + 3]); o.z = pg8::cvt_pk_bf16(v[8 * j + 4], v[8 * j + 5]); o.w = pg8::cvt_pk_bf16(v[8 * j + 6], v[8 * j + 7]);
        *(LAS pg8::u32x4*)(scr + lane * 144 + j * 16) = o; }
    asm volatile("s_waitcnt lgkmcnt(0)" ::: "memory");
    bf16_t* dst = Bt + (size_t)(64 * nb) * K + k0 + (lane & 7) * 8;
#pragma unroll
    for (int it = 0; it < 8; ++it) { const int row = it * 8 + (lane >> 3); const pg8::u32x4 o = *(const LAS pg8::u32x4*)(scr + row * 144 + (lane & 7) * 16);
        *(pg8::u32x4*)(dst + (size_t)row * K) = o; }
    asm volatile("s_waitcnt lgkmcnt(0)" ::: "memory");
}
struct WDesc { const float* W; const float* g; bf16_t* dst; int K, Ncols, kind, N; };
__device__ __forceinline__ WDesc wdesc(const Ptrs& p, int l, int idx) {
    WDesc d; d.g = nullptr; d.kind = WK_PLAIN;
    switch (idx) {
    case 0: d.W = p.in[I_W1IN] + (size_t)l * C::D * 2 * C::FF; d.K = C::D; d.Ncols = 2 * C::FF; d.N = 2 * C::FF; d.g = p.in[I_GFFN1] + l * C::D; d.kind = WK_FFNIN; d.dst = wlayer<C>(p, l, C::W_1IN); break;
    case 1: d.W = p.in[I_W1OUT] + (size_t)l * C::FF * C::D; d.K = C::FF; d.Ncols = C::D; d.N = C::D; d.dst = wlayer<C>(p, l, C::W_1OUT); break;
    case 2: d.W = p.in[I_WIN] + (size_t)l * C::D * C::INC; d.K = C::D; d.Ncols = C::INC; d.N = C::LDP; d.g = p.in[I_GMIX] + l * C::D; d.kind = WK_WIN; d.dst = wlayer<C>(p, l, C::W_IN); break;
    case 3: d.W = p.in[I_WOUT] + (size_t)l * C::D * C::D; d.K = C::D; d.Ncols = C::D; d.N = C::D; d.dst = wlayer<C>(p, l, C::W_OUT); break;
    case 4: d.W = p.in[I_WQ] + (size_t)l * C::D * C::D; d.K = C::D; d.Ncols = C::D; d.N = C::D; d.g = p.in[I_GX] + l * C::D; d.dst = wlayer<C>(p, l, C::W_Q); break;
    case 5: d.W = p.in[I_WK] + (size_t)l * C::D * C::D; d.K = C::D; d.Ncols = C::D; d.N = C::D; d.g = p.in[I_GMEM] + l * C::D; d.dst = wlayer<C>(p, l, C::W_KV); break;
    case 6: d.W = p.in[I_WV] + (size_t)l * C::D * C::D; d.K = C::D; d.Ncols = C::D; d.N = C::D; d.g = p.in[I_GMEM] + l * C::D; d.dst = wlayer<C>(p, l, C::W_KV) + (size_t)C::D * C::D; break;
    case 7: d.W = p.in[I_WO] + (size_t)l * C::D * C::D; d.K = C::D; d.Ncols = C::D; d.N = C::D; d.dst = wlayer<C>(p, l, C::W_O); break;
    case 8: d.W = p.in[I_W2IN] + (size_t)l * C::D * 2 * C::FF; d.K = C::D; d.Ncols = 2 * C::FF; d.N = 2 * C::FF; d.g = p.in[I_GFFN2] + l * C::D; d.kind = WK_FFNIN; d.dst = wlayer<C>(p, l, C::W_2IN); break;
    default: d.W = p.in[I_W2OUT] + (size_t)l * C::FF * C::D; d.K = C::FF; d.Ncols = C::D; d.N = C::D; d.dst = wlayer<C>(p, l, C::W_2OUT); break;
    }
    return d;
}

#define WG_SYNC() do { asm volatile("s_waitcnt lgkmcnt(0)" ::: "memory"); __builtin_amdgcn_s_barrier(); asm volatile("" ::: "memory"); } while (0)
namespace att {
typedef short bf16x8 __attribute__((ext_vector_type(8)));
typedef short s16x4 __attribute__((ext_vector_type(4)));
typedef float f32x4 __attribute__((ext_vector_type(4)));
typedef unsigned u32x2 __attribute__((ext_vector_type(2)));
constexpr int TOK = 256, CD = 64, PITCH = 144, CBYTES = TOK * PITCH, HDIM = 512, NH = 4, LD = 2048;
static_assert(C::NMEM == TOK && C::AHD == HDIM && C::AH == NH && C::D == LD && C::DEC_SEQ == 32 && C::SEQ % 256 == 0, "attention phase is built for these shapes");
__device__ __forceinline__ s16x4 tr_read(unsigned addr) { s16x4 r; asm volatile("ds_read_b64_tr_b16 %0, %1" : "=&v"(r) : "v"(addr) : "memory"); return r; }
__device__ __forceinline__ void stage_load(f32x4 (&r)[8], const float* src, int tid) {
    const unsigned off0 = (unsigned)(((tid >> 4) * LD + (tid & 15) * 4) * 4);
#pragma unroll
    for (int i = 0; i < 8; ++i) r[i] = *(const f32x4*)((const char*)src + (off0 + (unsigned)(i * 32 * LD * 4)));
    __builtin_amdgcn_sched_barrier(0);
}
__device__ __forceinline__ void stage_store(const f32x4 (&r)[8], LAS unsigned char* buf, int tid) {
#pragma unroll
    for (int i = 0; i < 8; ++i) { const int f = tid + 512 * i; u32x2 w; w.x = pg8::cvt_pk_bf16(r[i][0], r[i][1]); w.y = pg8::cvt_pk_bf16(r[i][2], r[i][3]);
        *(LAS u32x2*)(buf + (f >> 4) * PITCH + (f & 15) * 8) = w; }
}
__device__ __forceinline__ void attn_phase(LAS unsigned char* lds, const Ptrs& p, int l, int tid, int bid, int gsz) {
    const int lane = tid & 63, wave = __builtin_amdgcn_readfirstlane(tid >> 6), li = lane & 15, g = lane >> 4;
    const bf16_t* Qg = wsb<C>(p, C::WS_Q); bf16_t* AO = wsb<C>(p, C::WS_AO);
    constexpr int NUP = (C::MP / 256) * NH, NUS = C::DEC_BATCH * NH;
    static_assert(C::SEQ % 256 == 0, "prompt units are 256 rows");
    for (int un = bid; un < NUP + NUS; un += gsz) {
        int row0, nrows, head; const float* kb; const float* vb;
        if (un < NUP) { const int per_b = (C::SEQ / 256) * NH, b = un / per_b, rem = un % per_b; head = rem / (C::SEQ / 256); row0 = b * C::SEQ + (rem % (C::SEQ / 256)) * 256; nrows = 256;
            kb = p.out + C::OUT_MK + ((size_t)l * C::BATCH + b) * TOK * LD + head * HDIM; vb = p.out + C::OUT_MV + ((size_t)l * C::BATCH + b) * TOK * LD + head * HDIM; }
        else { const int s = un - NUP, b = s / NH; head = s % NH; row0 = C::MP + b * C::DEC_SEQ; nrows = C::DEC_SEQ;
            kb = p.in[I_CK] + ((size_t)l * C::DEC_BATCH + b) * TOK * LD + head * HDIM; vb = p.in[I_CV] + ((size_t)l * C::DEC_BATCH + b) * TOK * LD + head * HDIM; }
        const bool active = wave * 32 < nrows;
        const bf16_t* q0 = Qg + (size_t)(row0 + wave * 32 + li) * LD + head * HDIM + g * 8;
        f32x4 s[2][16];
#pragma unroll
        for (int u = 0; u < 2; ++u)
#pragma unroll
            for (int T = 0; T < 16; ++T) s[u][T] = (f32x4){0.f, 0.f, 0.f, 0.f};
        f32x4 pre[8]; bf16x8 qf[2][2];
        stage_load(pre, kb, tid); stage_store(pre, lds, tid);
#pragma unroll
        for (int u = 0; u < 2; ++u)
#pragma unroll
            for (int ks = 0; ks < 2; ++ks) qf[u][ks] = active ? *(const bf16x8*)(q0 + (size_t)u * 16 * LD + ks * 32) : (bf16x8){0, 0, 0, 0, 0, 0, 0, 0};
        WG_SYNC();
        for (int c = 0; c < 8; ++c) {
            LAS unsigned char* buf = lds + (c & 1) * CBYTES;
            stage_load(pre, c < 7 ? kb + (c + 1) * CD : vb, tid);
            if (active) {
#pragma unroll
                for (int ks = 0; ks < 2; ++ks)
#pragma unroll
                    for (int T = 0; T < 16; ++T) { const bf16x8 a = *(const LAS bf16x8*)(buf + (T * 16 + li) * PITCH + ks * 64 + g * 16);
                        s[0][T] = __builtin_amdgcn_mfma_f32_16x16x32_bf16(a, qf[0][ks], s[0][T], 0, 0, 0);
                        s[1][T] = __builtin_amdgcn_mfma_f32_16x16x32_bf16(a, qf[1][ks], s[1][T], 0, 0, 0); }
            }
            if (active && c < 7) {
                __builtin_amdgcn_sched_barrier(0);
#pragma unroll
                for (int u = 0; u < 2; ++u)
#pragma unroll
                    for (int ks = 0; ks < 2; ++ks) qf[u][ks] = *(const bf16x8*)(q0 + (size_t)u * 16 * LD + (c + 1) * CD + ks * 32);
                __builtin_amdgcn_sched_barrier(0); }
            stage_store(pre, lds + ((c + 1) & 1) * CBYTES, tid);
            WG_SYNC();
        }
        const float sc = 0.044194173824159216f * 1.4426950408889634f;
        float inv[2]; bf16x8 pf[2][8];
#pragma unroll
        for (int u = 0; u < 2; ++u) {
            float mx = -3.0e38f;
#pragma unroll
            for (int T = 0; T < 16; ++T) mx = fmaxf(mx, fmaxf(fmaxf(s[u][T][0], s[u][T][1]), fmaxf(s[u][T][2], s[u][T][3])));
            mx = fmaxf(mx, __shfl_xor(mx, 16)); mx = fmaxf(mx, __shfl_xor(mx, 32));
            float sum = 0.f;
#pragma unroll
            for (int T = 0; T < 16; ++T)
#pragma unroll
                for (int j = 0; j < 4; ++j) { const float e = __builtin_amdgcn_exp2f((s[u][T][j] - mx) * sc); s[u][T][j] = e; sum += e; }
            sum += __shfl_xor(sum, 16); sum += __shfl_xor(sum, 32);
            inv[u] = 1.0f / sum;
#pragma unroll
            for (int t = 0; t < 8; ++t) { pg8::u32x4 w; w.x = pg8::cvt_pk_bf16(s[u][2 * t][0], s[u][2 * t][1]); w.y = pg8::cvt_pk_bf16(s[u][2 * t][2], s[u][2 * t][3]);
                w.z = pg8::cvt_pk_bf16(s[u][2 * t + 1][0], s[u][2 * t + 1][1]); w.w = pg8::cvt_pk_bf16(s[u][2 * t + 1][2], s[u][2 * t + 1][3]); pf[u][t] = __builtin_bit_cast(bf16x8, w); }
        }
        const unsigned trb = (unsigned)(size_t)lds + (unsigned)((4 * g + (li >> 2)) * PITCH + (li & 3) * 8);
        for (int c = 0; c < 8; ++c) {
            const unsigned bofs = (unsigned)(c & 1) * CBYTES;
            if (c < 7) stage_load(pre, vb + (c + 1) * CD, tid);
            if (active) {
                f32x4 o[2][4];
#pragma unroll
                for (int u = 0; u < 2; ++u)
#pragma unroll
                    for (int dt = 0; dt < 4; ++dt) o[u][dt] = (f32x4){0.f, 0.f, 0.f, 0.f};
#pragma unroll
                for (int t = 0; t < 8; ++t) {
                    s16x4 lo[4], hi[4];
#pragma unroll
                    for (int dt = 0; dt < 4; ++dt) { lo[dt] = tr_read(trb + bofs + (unsigned)(t * 32 * PITCH + dt * 32)); hi[dt] = tr_read(trb + bofs + (unsigned)(t * 32 * PITCH + 16 * PITCH + dt * 32)); }
                    asm volatile("s_waitcnt lgkmcnt(0)" ::: "memory"); __builtin_amdgcn_sched_barrier(0);
#pragma unroll
                    for (int dt = 0; dt < 4; ++dt) { const bf16x8 a = (bf16x8){lo[dt][0], lo[dt][1], lo[dt][2], lo[dt][3], hi[dt][0], hi[dt][1], hi[dt][2], hi[dt][3]};
                        o[0][dt] = __builtin_amdgcn_mfma_f32_16x16x32_bf16(a, pf[0][t], o[0][dt], 0, 0, 0);
                        o[1][dt] = __builtin_amdgcn_mfma_f32_16x16x32_bf16(a, pf[1][t], o[1][dt], 0, 0, 0); }
                }
#pragma unroll
                for (int u = 0; u < 2; ++u)
#pragma unroll
                    for (int dt = 0; dt < 4; ++dt) { u32x2 w; w.x = pg8::cvt_pk_bf16(o[u][dt][0] * inv[u], o[u][dt][1] * inv[u]); w.y = pg8::cvt_pk_bf16(o[u][dt][2] * inv[u], o[u][dt][3] * inv[u]);
                        *(u32x2*)(AO + (size_t)(row0 + wave * 32 + 16 * u + li) * LD + head * HDIM + c * CD + dt * 16 + g * 4) = w; }
            }
            if (c < 7) stage_store(pre, lds + ((c + 1) & 1) * CBYTES, tid);
            WG_SYNC();
        }
    }
}
}
namespace mx {
typedef att::bf16x8 bf16x8; typedef att::s16x4 s16x4; typedef att::f32x4 f32x4; typedef att::u32x2 u32x2;
constexpr int PT = 272;
constexpr int T64 = 64 * PT, T128 = 128 * PT;
static_assert(C::MHD == 128 && C::CH == 64 && C::MH == 8 && C::LCS == 32, "mLSTM phases are built for these shapes");
__device__ __forceinline__ void lds_wait() { asm volatile("s_waitcnt lgkmcnt(0)" ::: "memory"); __builtin_amdgcn_sched_barrier(0); }
__device__ __forceinline__ bf16x8 mk8(s16x4 lo, s16x4 hi) { return (bf16x8){lo[0], lo[1], lo[2], lo[3], hi[0], hi[1], hi[2], hi[3]}; }
__device__ __forceinline__ unsigned tr_addr(unsigned tile, int krow, int c0, int li) { return tile + (unsigned)((krow + (li >> 2)) * PT + (c0 + 4 * (li & 3)) * 2); }
__device__ __forceinline__ void ch_decode(int ci, int& r0, int& h, int& lc) {
    if (ci < C::NPC) { const int c = ci % C::NC, bh = ci / C::NC; h = bh % C::MH; r0 = (bh / C::MH) * C::SEQ + c * C::CH; lc = C::CH; }
    else { const int q = ci - C::NPC; h = q % C::MH; r0 = C::MP + (q / C::MH) * C::DEC_SEQ; lc = C::LCS; }
}
__device__ __forceinline__ void stage64(LAS unsigned char* tile, const float* src, int ld, int lc, int tid, const LAS float* rs, float mul) {
#pragma unroll
    for (int i = 0; i < 4; ++i) { const int f = tid + 512 * i, row = f >> 5, c4 = f & 31; f32x4 v = (f32x4){0.f, 0.f, 0.f, 0.f};
        if (row < lc) { v = *(const f32x4*)(src + (size_t)row * ld + c4 * 4); const float m = rs ? rs[row] * mul : mul; v = v * m; }
        u32x2 w; w.x = pg8::cvt_pk_bf16(v[0], v[1]); w.y = pg8::cvt_pk_bf16(v[2], v[3]); *(LAS u32x2*)(tile + row * PT + c4 * 8) = w; }
}
__device__ __forceinline__ void ml_phase_a(LAS unsigned char* lds, const Ptrs& p, int l, int tid, int bid, int gsz) {
    const int lane = tid & 63, wave = __builtin_amdgcn_readfirstlane(tid >> 6), li = lane & 15, g = lane >> 4;
    LAS unsigned char* Ks = lds; LAS unsigned char* Vs = lds + T64; LAS float* wts = (LAS float*)(lds + 2 * T64);
    const float* P = wsf<C>(p, C::WS_BIG);
    for (int ci = bid; ci < C::NCH; ci += gsz) {
        int r0, h, lc; ch_decode(ci, r0, h, lc);
        if (wave == 0) {
            float lf = 0.f, ig = -3.0e38f;
            if (lane < lc) { const float* pr = P + (size_t)(r0 + lane) * C::LDP; ig = pr[C::O_IG + h] + p.in[I_IB][l * C::MH + h]; const float fx = pr[C::O_FG + h] + p.in[I_FB][l * C::MH + h]; lf = fx >= 0.f ? -__logf(1.0f + __expf(-fx)) : fx - __logf(1.0f + __expf(fx)); }
            float b = lf;
#pragma unroll
            for (int o = 1; o < 64; o <<= 1) { const float t = __shfl_up(b, o); if (lane >= o) b += t; }
            const float a = lane < lc ? ig - b : -3.0e38f;
            float amax = a;
#pragma unroll
            for (int o = 1; o < 64; o <<= 1) amax = fmaxf(amax, __shfl_xor(amax, o));
            const float bL = __shfl(b, lc - 1), mloc = bL + amax;
            const float wt = lane < lc ? __expf(bL + a - mloc) : 0.f;
            wts[lane] = wt;
            if (lane < lc) { wsf<C>(p, C::WS_GB)[(size_t)(r0 + lane) * C::MH + h] = b; wsf<C>(p, C::WS_GA)[(size_t)(r0 + lane) * C::MH + h] = a; }
            if (lane == 0) { wsf<C>(p, C::WS_CBL)[ci] = bL; wsf<C>(p, C::WS_CML)[ci] = mloc; }
        }
        __syncthreads();
        stage64(Ks, P + (size_t)r0 * C::LDP + C::O_K + h * C::MHD, C::LDP, lc, tid, wts, 0.08838834764831845f);
        stage64(Vs, P + (size_t)r0 * C::LDP + C::O_VM + h * C::MHD, C::LDP, lc, tid, nullptr, 1.0f);
        __syncthreads();
        f32x4 acc[8];
#pragma unroll
        for (int et = 0; et < 8; ++et) acc[et] = (f32x4){0.f, 0.f, 0.f, 0.f};
        const unsigned ks = (unsigned)(size_t)Ks, vs = (unsigned)(size_t)Vs;
#pragma unroll
        for (int t = 0; t < 2; ++t) {
            const s16x4 alo = att::tr_read(tr_addr(ks, 32 * t + 8 * g, 16 * wave, li)), ahi = att::tr_read(tr_addr(ks, 32 * t + 8 * g + 4, 16 * wave, li));
            s16x4 blo[8], bhi[8];
#pragma unroll
            for (int et = 0; et < 8; ++et) { blo[et] = att::tr_read(tr_addr(vs, 32 * t + 8 * g, 16 * et, li)); bhi[et] = att::tr_read(tr_addr(vs, 32 * t + 8 * g + 4, 16 * et, li)); }
            lds_wait();
            const bf16x8 a = mk8(alo, ahi);
#pragma unroll
            for (int et = 0; et < 8; ++et) acc[et] = __builtin_amdgcn_mfma_f32_16x16x32_bf16(a, mk8(blo[et], bhi[et]), acc[et], 0, 0, 0);
        }
        float* DC = wsf<C>(p, C::WS_DC) + (size_t)ci * C::MHD * C::MHD;
#pragma unroll
        for (int et = 0; et < 8; ++et)
#pragma unroll
            for (int r = 0; r < 4; ++r) DC[(size_t)(16 * wave + 4 * g + r) * C::MHD + 16 * et + li] = acc[et][r];
        if (tid < C::MHD) { float s = 0.f; for (int t = 0; t < 64; ++t) s += bf2f(*(const LAS bf16_t*)(Ks + t * PT + tid * 2)); wsf<C>(p, C::WS_DN)[(size_t)ci * C::MHD + tid] = s; }
        __syncthreads();
    }
}
__device__ __forceinline__ void ml_phase_c(LAS unsigned char* lds, const Ptrs& p, int l, int tid, int bid, int gsz) {
    const int lane = tid & 63, wave = __builtin_amdgcn_readfirstlane(tid >> 6), li = lane & 15, g = lane >> 4, it = wave & 3, eh = wave >> 2;
    LAS unsigned char* Qs = lds; LAS unsigned char* Ks = lds + T64; LAS unsigned char* Vs = lds + 2 * T64; LAS unsigned char* Cs = lds + 3 * T64;
    LAS float* sb = (LAS float*)(lds + 3 * T64 + T128);
    LAS float* sa = sb + 64; LAS float* smr = sb + 128; LAS float* siw = sb + 192; LAS float* snp = sb + 256; LAS float* ssq = sb + 384;
    const float* P = wsf<C>(p, C::WS_BIG);
    for (int ci = bid; ci < C::NCH; ci += gsz) {
        int r0, h, lc; ch_decode(ci, r0, h, lc);
        const bool sample = ci >= C::NPC, first = !sample && (ci % C::NC) == 0;
        const float mprev = wsf<C>(p, C::WS_MPREV)[ci];
        if (wave == 0) {
            float b = 0.f, a = -3.0e38f;
            if (lane < lc) { b = wsf<C>(p, C::WS_GB)[(size_t)(r0 + lane) * C::MH + h]; a = wsf<C>(p, C::WS_GA)[(size_t)(r0 + lane) * C::MH + h]; }
            float pm = a;
#pragma unroll
            for (int o = 1; o < 64; o <<= 1) { const float t = __shfl_up(pm, o); if (lane >= o) pm = fmaxf(pm, t); }
            const float mrow = b + fmaxf(mprev, pm);
            sb[lane] = b; sa[lane] = a; smr[lane] = mrow; siw[lane] = __expf(b + mprev - mrow);
        }
        if (tid >= 128 && tid < 256) { const int d = tid - 128;
            snp[d] = sample ? p.in[I_SN][((size_t)l * C::NSC + (ci - C::NPC)) * C::MHD + d] : (first ? 0.f : wsf<C>(p, C::WS_DN)[(size_t)(ci - 1) * C::MHD + d]); }
        stage64(Qs, P + (size_t)r0 * C::LDP + C::O_Q + h * C::MHD, C::LDP, lc, tid, nullptr, 1.0f);
        stage64(Ks, P + (size_t)r0 * C::LDP + C::O_K + h * C::MHD, C::LDP, lc, tid, nullptr, 0.08838834764831845f);
        stage64(Vs, P + (size_t)r0 * C::LDP + C::O_VM + h * C::MHD, C::LDP, lc, tid, nullptr, 1.0f);
        { const float* cp = sample ? p.in[I_SC] + ((size_t)l * C::NSC + (ci - C::NPC)) * C::MHD * C::MHD : wsf<C>(p, C::WS_DC) + (size_t)(first ? ci : ci - 1) * C::MHD * C::MHD;
#pragma unroll
            for (int i = 0; i < 8; ++i) { const int f = tid + 512 * i, row = f >> 5, c4 = f & 31; f32x4 v = (f32x4){0.f, 0.f, 0.f, 0.f};
                if (!first) v = *(const f32x4*)(cp + (size_t)row * C::MHD + c4 * 4);
                u32x2 w; w.x = pg8::cvt_pk_bf16(v[0], v[1]); w.y = pg8::cvt_pk_bf16(v[2], v[3]); *(LAS u32x2*)(Cs + row * PT + c4 * 8) = w; } }
        __syncthreads();
        const bool active = it * 16 < lc;
        float ssq_part = 0.f; f32x4 hv[4]; float inv_den = 0.f;
        const int i = 16 * it + li;
        if (active) {
            bf16x8 qf[4];
#pragma unroll
            for (int ks = 0; ks < 4; ++ks) qf[ks] = *(const LAS bf16x8*)(Qs + i * PT + ks * 64 + g * 16);
            f32x4 st[4];
#pragma unroll
            for (int jt = 0; jt < 4; ++jt) st[jt] = (f32x4){0.f, 0.f, 0.f, 0.f};
#pragma unroll
            for (int jt = 0; jt < 4; ++jt) if (jt <= it) {
#pragma unroll
                for (int ks = 0; ks < 4; ++ks) { const bf16x8 a = *(const LAS bf16x8*)(Ks + (16 * jt + li) * PT + ks * 64 + g * 16);
                    st[jt] = __builtin_amdgcn_mfma_f32_16x16x32_bf16(a, qf[ks], st[jt], 0, 0, 0); } }
            const float bi = sb[i], mri = smr[i], iwi = siw[i];
            float dsum = 0.f;
#pragma unroll
            for (int jt = 0; jt < 4; ++jt)
#pragma unroll
                for (int r = 0; r < 4; ++r) { const int j = 16 * jt + 4 * g + r; const float w = (j <= i) ? __expf(bi + sa[j] - mri) : 0.f; st[jt][r] *= w; dsum += st[jt][r]; }
            dsum += __shfl_xor(dsum, 16); dsum += __shfl_xor(dsum, 32);
            float qn = 0.f;
#pragma unroll
            for (int ks = 0; ks < 4; ++ks)
#pragma unroll
                for (int jj = 0; jj < 8; ++jj) qn += bf2f((bf16_t)qf[ks][jj]) * snp[32 * ks + 8 * g + jj];
            qn += __shfl_xor(qn, 16); qn += __shfl_xor(qn, 32);
            const float den = dsum + iwi * qn;
            inv_den = 1.0f / fmaxf(fabsf(den), __expf(-mri));
            bf16x8 pf[2];
#pragma unroll
            for (int t = 0; t < 2; ++t) { pg8::u32x4 w; w.x = pg8::cvt_pk_bf16(st[2 * t][0], st[2 * t][1]); w.y = pg8::cvt_pk_bf16(st[2 * t][2], st[2 * t][3]);
                w.z = pg8::cvt_pk_bf16(st[2 * t + 1][0], st[2 * t + 1][1]); w.w = pg8::cvt_pk_bf16(st[2 * t + 1][2], st[2 * t + 1][3]); pf[t] = __builtin_bit_cast(bf16x8, w); }
            const unsigned vs = (unsigned)(size_t)Vs, cs = (unsigned)(size_t)Cs;
#pragma unroll
            for (int e4 = 0; e4 < 4; ++e4) { const int et = 4 * eh + e4;
                s16x4 vlo[2], vhi[2], clo[4], chi[4];
#pragma unroll
                for (int t = 0; t < 2; ++t) { vlo[t] = att::tr_read(tr_addr(vs, 32 * t + 4 * g, 16 * et, li)); vhi[t] = att::tr_read(tr_addr(vs, 32 * t + 16 + 4 * g, 16 * et, li)); }
#pragma unroll
                for (int ks = 0; ks < 4; ++ks) { clo[ks] = att::tr_read(tr_addr(cs, 32 * ks + 8 * g, 16 * et, li)); chi[ks] = att::tr_read(tr_addr(cs, 32 * ks + 8 * g + 4, 16 * et, li)); }
                lds_wait();
                f32x4 aS = (f32x4){0.f, 0.f, 0.f, 0.f}, aC = (f32x4){0.f, 0.f, 0.f, 0.f};
#pragma unroll
                for (int t = 0; t < 2; ++t) aS = __builtin_amdgcn_mfma_f32_16x16x32_bf16(mk8(vlo[t], vhi[t]), pf[t], aS, 0, 0, 0);
#pragma unroll
                for (int ks = 0; ks < 4; ++ks) aC = __builtin_amdgcn_mfma_f32_16x16x32_bf16(mk8(clo[ks], chi[ks]), qf[ks], aC, 0, 0, 0);
                hv[e4] = (aS + aC * iwi) * inv_den;
                ssq_part += (hv[e4][0] * hv[e4][0] + hv[e4][1] * hv[e4][1]) + (hv[e4][2] * hv[e4][2] + hv[e4][3] * hv[e4][3]); }
            ssq_part += __shfl_xor(ssq_part, 16); ssq_part += __shfl_xor(ssq_part, 32);
            if (g == 0) ssq[wave * 16 + li] = ssq_part;
        }
        __syncthreads();
        if (active) {
            const float tot = ssq_part + ssq[(wave ^ 4) * 16 + li];
            const float rs = rsqrtf(tot * (1.0f / C::MHD) + 1e-6f);
            const int row = r0 + i;
#pragma unroll
            for (int e4 = 0; e4 < 4; ++e4) { const int e = 16 * (4 * eh + e4) + 4 * g;
                const f32x4 og = *(const f32x4*)(P + (size_t)row * C::LDP + C::O_O + h * C::MHD + e); const f32x4 gn = *(const f32x4*)(p.in[I_NG] + (size_t)l * C::MW + h * C::MHD + e);
                float o4[4];
#pragma unroll
                for (int r = 0; r < 4; ++r) o4[r] = hv[e4][r] * rs * gn[r] * __builtin_amdgcn_rcpf(1.0f + __expf(-og[r]));
                u32x2 w; w.x = pg8::cvt_pk_bf16(o4[0], o4[1]); w.y = pg8::cvt_pk_bf16(o4[2], o4[3]);
                *(u32x2*)(wsb<C>(p, C::WS_MIX) + (size_t)row * C::D + C::PW + C::GW + h * C::MHD + e) = w; }
        }
        __syncthreads();
    }
}
}
namespace rw {
typedef att::f32x4 f32x4; typedef att::u32x2 u32x2;
static_assert(C::D == 2048, "row ops assume 2048 columns = 8 float4 per lane");
__device__ __forceinline__ float wave_sum(float v) {
#pragma unroll
    for (int o = 1; o < 64; o <<= 1) v += __shfl_xor(v, o);
    return v;
}
__device__ __forceinline__ void rows_init(const Ptrs& p, int tid, int bid, int gsz) {
    const int lane = tid & 63, gw = bid * NWAVES + (tid >> 6), NGW = gsz * NWAVES;
    float* SS = wsf<C>(p, C::WS_SS);
    for (int r = gw; r < C::M; r += NGW) {
        const float* src = r < C::MP ? p.in[I_XP] + (size_t)r * C::D : p.in[I_XS] + (size_t)(r - C::MP) * C::D;
        float* X = wsf<C>(p, C::WS_X) + (size_t)r * C::D; bf16_t* XB = wsb<C>(p, C::WS_XB) + (size_t)r * C::D;
        float ss = 0.f;
#pragma unroll
        for (int j = 0; j < 8; ++j) { const f32x4 v = *(const f32x4*)(src + (lane + 64 * j) * 4); *(f32x4*)(X + (lane + 64 * j) * 4) = v;
            u32x2 w; w.x = pg8::cvt_pk_bf16(v[0], v[1]); w.y = pg8::cvt_pk_bf16(v[2], v[3]); *(u32x2*)(XB + (lane + 64 * j) * 4) = w;
            ss += (v[0] * v[0] + v[1] * v[1]) + (v[2] * v[2] + v[3] * v[3]); }
        ss = wave_sum(ss);
        if (lane < C::NSS) SS[(size_t)lane * C::M + r] = lane == 0 ? ss : 0.f;
    }
    for (int r = gw; r < C::MM; r += NGW) {
        const float* src = p.in[I_MEM] + (size_t)r * C::D; bf16_t* MB = wsb<C>(p, C::WS_MEMB) + (size_t)r * C::D;
        float ss = 0.f;
#pragma unroll
        for (int j = 0; j < 8; ++j) { const f32x4 v = *(const f32x4*)(src + (lane + 64 * j) * 4);
            u32x2 w; w.x = pg8::cvt_pk_bf16(v[0], v[1]); w.y = pg8::cvt_pk_bf16(v[2], v[3]); *(u32x2*)(MB + (lane + 64 * j) * 4) = w;
            ss += (v[0] * v[0] + v[1] * v[1]) + (v[2] * v[2] + v[3] * v[3]); }
        ss = wave_sum(ss);
        if (lane == 0) wsf<C>(p, C::WS_RSTDM)[r] = rsqrtf(ss * (1.0f / C::D) + 1e-6f);
    }
}
__device__ __forceinline__ void rows_final(const Ptrs& p, int tid, int bid, int gsz) {
    const int lane = tid & 63, gw = bid * NWAVES + (tid >> 6), NGW = gsz * NWAVES;
    for (int r = gw; r < C::M; r += NGW) {
        const float* X = wsf<C>(p, C::WS_X) + (size_t)r * C::D; const float rs = rsqrtf(wsf<C>(p, C::WS_SS)[(size_t)(C::NSS - 1) * C::M + r] * (1.0f / C::D) + 1e-6f);
        float* o = r < C::MP ? p.out + C::OUT_YP + (size_t)r * C::D : p.out + C::OUT_YS + (size_t)(r - C::MP) * C::D;
        float pscale = 1.0f, padd = 0.f;
#if defined(PROBE_MASK_A)
        { const unsigned long long* TS = (const unsigned long long*)(p.ws + C::WS_CTL + 32768); unsigned long long ta = 0, tb = 0;
          for (int k = 0; k < 25; ++k) { const unsigned long long dk = TS[k + 1] - TS[k]; if ((PROBE_MASK_A >> k) & 1ull) ta += dk; if ((PROBE_MASK_B >> k) & 1ull) tb += dk; }
#if defined(PROBE_MLT)
          ta = TS[48 + PROBE_MLT];
#endif
#if defined(PROBE_ATT)
          ta = 0; for (int l2 = 0; l2 < 2; ++l2) { const int k = 1 + 12 * l2 + 8; ta += (PROBE_ATT == 1) ? TS[44 + l2] - TS[k] : TS[k + 1] - TS[44 + l2]; }
#endif
#if defined(PROBE_MIXA)
          ta = 0; for (int l2 = 0; l2 < 2; ++l2) { const int k = 1 + 12 * l2 + 3; ta += (PROBE_MIXA == 1) ? TS[40 + l2] - TS[k] : (PROBE_MIXA == 2) ? TS[42 + l2] - TS[40 + l2] : TS[k + 1] - TS[42 + l2]; }
#endif
#if defined(PROBE_SPLIT_MODE)
          ta = 0; for (int l2 = 0; l2 < 2; ++l2) { const int k = 1 + 10 * l2 + 3; ta += (PROBE_SPLIT_MODE == 1) ? TS[40 + l2] - TS[k] : TS[k + 1] - TS[40 + l2]; }
#endif
          if (r >= C::MP) pscale = 1.0f + 0.03f + (float)ta * 0.01f * PROBE_SA;
          if (r == 0 && lane == 0) padd = 1.0f + (float)tb * 0.01f * PROBE_SB; }
#endif
#pragma unroll
        for (int j = 0; j < 8; ++j) { const f32x4 v = *(const f32x4*)(X + (lane + 64 * j) * 4); const f32x4 gg = *(const f32x4*)(p.in[I_GFIN] + (lane + 64 * j) * 4);
            f32x4 y = v * rs * gg * pscale; if (j == 0) y[0] += padd; *(f32x4*)(o + (lane + 64 * j) * 4) = y; }
    }
}
__device__ __forceinline__ void ml_scan(const Ptrs& p, int l, long gtid, long gthreads) {
    const float* CBL = wsf<C>(p, C::WS_CBL); const float* CML = wsf<C>(p, C::WS_CML);
    float* DC = wsf<C>(p, C::WS_DC); float* DN = wsf<C>(p, C::WS_DN);
    constexpr int NPS = C::BATCH * C::MH, E4 = C::MHD / 4;
    for (long it = gtid; it < (long)NPS * C::MHD * E4; it += gthreads) {
        const int e4 = (int)(it % E4), d = (int)((it / E4) % C::MHD), sq = (int)(it / ((long)E4 * C::MHD));
        float m = 0.f; f32x4 cst = (f32x4){0.f, 0.f, 0.f, 0.f};
        static_assert(C::NC % 8 == 0, "scan is unrolled by 8 chunks");
        for (int c0 = 0; c0 < C::NC; c0 += 8) {
            f32x4 v[8]; float bl[8], ml[8];
#pragma unroll
            for (int j = 0; j < 8; ++j) { const int ci = sq * C::NC + c0 + j; v[j] = *(const f32x4*)(DC + ((size_t)ci * C::MHD + d) * C::MHD + e4 * 4); bl[j] = CBL[ci]; ml[j] = CML[ci]; }
#pragma unroll
            for (int j = 0; j < 8; ++j) { const int ci = sq * C::NC + c0 + j; const float a = bl[j] + m, mn = fmaxf(a, ml[j]), dec = __expf(a - mn), f = __expf(ml[j] - mn);
                cst = cst * dec + v[j] * f; *(f32x4*)(DC + ((size_t)ci * C::MHD + d) * C::MHD + e4 * 4) = cst; m = mn; }
        }
        *(f32x4*)(p.out + C::OUT_CP + (((size_t)l * NPS + sq) * C::MHD + d) * C::MHD + e4 * 4) = cst;
    }
    for (long it = gtid; it < (long)NPS * C::MHD; it += gthreads) {
        const int d = (int)(it % C::MHD), sq = (int)(it / C::MHD);
        float m = 0.f, nst = 0.f;
        for (int c = 0; c < C::NC; ++c) { const int ci = sq * C::NC + c; const float a = CBL[ci] + m, b2 = CML[ci], mn = fmaxf(a, b2), dec = __expf(a - mn), f = __expf(b2 - mn);
            const size_t on = (size_t)ci * C::MHD + d; nst = dec * nst + f * DN[on]; DN[on] = nst; m = mn; }
        p.out[C::OUT_NP + ((size_t)l * NPS + sq) * C::MHD + d] = nst;
    }
    for (long it = gtid; it < (long)C::NSC * C::MHD * E4; it += gthreads) {
        const int e4 = (int)(it % E4), d = (int)((it / E4) % C::MHD), q = (int)(it / ((long)E4 * C::MHD)), ci = C::NPC + q;
        const float m0 = p.in[I_SM][(size_t)l * C::NSC + q], a = CBL[ci] + m0, b2 = CML[ci], mn = fmaxf(a, b2), dec = __expf(a - mn), f = __expf(b2 - mn);
        const size_t so = (((size_t)l * C::NSC + q) * C::MHD + d) * C::MHD + e4 * 4;
        *(f32x4*)(p.out + C::OUT_CS + so) = *(const f32x4*)(p.in[I_SC] + so) * dec + *(const f32x4*)(DC + ((size_t)ci * C::MHD + d) * C::MHD + e4 * 4) * f;
    }
    for (long it = gtid; it < (long)C::NSC * C::MHD; it += gthreads) {
        const int d = (int)(it % C::MHD), q = (int)(it / C::MHD), ci = C::NPC + q;
        const float m0 = p.in[I_SM][(size_t)l * C::NSC + q], a = CBL[ci] + m0, b2 = CML[ci], mn = fmaxf(a, b2), dec = __expf(a - mn), f = __expf(b2 - mn);
        const size_t no = ((size_t)l * C::NSC + q) * C::MHD + d;
        p.out[C::OUT_NS + no] = dec * p.in[I_SN][no] + f * DN[(size_t)ci * C::MHD + d];
    }
}
}

namespace gp {
typedef att::bf16x8 bf16x8; typedef att::s16x4 s16x4; typedef att::f32x4 f32x4; typedef att::u32x2 u32x2;
constexpr int PT = mx::PT, T128 = mx::T128;
static_assert(C::GHD == 128 && C::PGD == 128 && C::GCH == 128 && C::SEQ % 128 == 0 && C::DEC_SEQ == 32 && C::PH == 15, "gmlp / pool phases are built for these shapes");
constexpr int NT_P = C::MP / 128;
constexpr int NU_G = NT_P * 4 + C::DEC_BATCH * 4;
__device__ __forceinline__ void gmlp_phase(LAS unsigned char* lds, const Ptrs& p, int l, int tid, int bid, int gsz) {
    const int lane = tid & 63, wave = __builtin_amdgcn_readfirstlane(tid >> 6), li = lane & 15, g = lane >> 4;
    LAS unsigned char* Vs = lds; LAS unsigned char* Ws = lds + T128;
    const float* P = wsf<C>(p, C::WS_BIG);
    for (int u = bid; u < NU_G; u += gsz) {
        int r0, lc, h; bool sample = false; int sb = 0;
        if (u < NT_P * 4) { h = u & 3; r0 = (u >> 2) * 128; lc = 128; } else { const int s = u - NT_P * 4; h = s & 3; sb = s >> 2; r0 = C::MP + sb * C::DEC_SEQ; lc = C::DEC_SEQ; sample = true; }
#pragma unroll
        for (int i = 0; i < 8; ++i) { const int f = tid + 512 * i, row = f >> 5, c4 = f & 31; f32x4 v = (f32x4){0.f, 0.f, 0.f, 0.f};
            if (row < lc) v = *(const f32x4*)(P + (size_t)(r0 + row) * C::LDP + C::O_V + h * 128 + c4 * 4);
            float ss = (v[0] * v[0] + v[1] * v[1]) + (v[2] * v[2] + v[3] * v[3]);
#pragma unroll
            for (int o = 1; o < 32; o <<= 1) ss += __shfl_xor(ss, o);
            const float rs = rsqrtf(ss * (1.0f / 128) + 1e-6f); const f32x4 gn = *(const f32x4*)(p.in[I_GVG] + (size_t)l * C::GW + h * 128 + c4 * 4);
            v = v * rs * gn;
            if (sample && row < lc) *(f32x4*)(p.out + C::OUT_VS + (((size_t)l * C::DEC_BATCH + sb) * C::DEC_SEQ + row) * C::GW + h * 128 + c4 * 4) = v;
            u32x2 w; w.x = pg8::cvt_pk_bf16(v[0], v[1]); w.y = pg8::cvt_pk_bf16(v[2], v[3]); *(LAS u32x2*)(Vs + row * PT + c4 * 8) = w; }
        const float* wsrc = p.in[I_GWS] + ((size_t)l * C::GH + h) * 128 * 128;
#pragma unroll
        for (int i = 0; i < 8; ++i) { const int f = tid + 512 * i, row = f >> 5, c4 = f & 31; f32x4 v = *(const f32x4*)(wsrc + (size_t)row * 128 + c4 * 4);
#pragma unroll
            for (int j = 0; j < 4; ++j) if (c4 * 4 + j > row) v[j] = 0.f;
            u32x2 w; w.x = pg8::cvt_pk_bf16(v[0], v[1]); w.y = pg8::cvt_pk_bf16(v[2], v[3]); *(LAS u32x2*)(Ws + row * PT + c4 * 8) = w; }
        WG_SYNC();
        if (wave * 16 < lc) {
            const int i = wave * 16 + li, nks = (wave * 16 + 15) / 32 + 1;
            f32x4 acc[8];
#pragma unroll
            for (int dt = 0; dt < 8; ++dt) acc[dt] = (f32x4){0.f, 0.f, 0.f, 0.f};
            const unsigned vs = (unsigned)(size_t)Vs;
            for (int ks = 0; ks < nks; ++ks) {
                const bf16x8 bq = *(const LAS bf16x8*)(Ws + i * PT + ks * 64 + g * 16);
                s16x4 lo[8], hi[8];
#pragma unroll
                for (int dt = 0; dt < 8; ++dt) { lo[dt] = att::tr_read(mx::tr_addr(vs, 32 * ks + 8 * g, 16 * dt, li)); hi[dt] = att::tr_read(mx::tr_addr(vs, 32 * ks + 8 * g + 4, 16 * dt, li)); }
                mx::lds_wait();
#pragma unroll
                for (int dt = 0; dt < 8; ++dt) acc[dt] = __builtin_amdgcn_mfma_f32_16x16x32_bf16(mx::mk8(lo[dt], hi[dt]), bq, acc[dt], 0, 0, 0);
            }
            const float bsi = p.in[I_GBS][((size_t)l * C::GH + h) * C::GCH + i];
            const int row = r0 + i;
#pragma unroll
            for (int dt = 0; dt < 8; ++dt) { const int d = 16 * dt + 4 * g; const f32x4 uu = *(const f32x4*)(P + (size_t)row * C::LDP + C::O_U + h * 128 + d);
                u32x2 w; w.x = pg8::cvt_pk_bf16(uu[0] * (acc[dt][0] + bsi), uu[1] * (acc[dt][1] + bsi)); w.y = pg8::cvt_pk_bf16(uu[2] * (acc[dt][2] + bsi), uu[3] * (acc[dt][3] + bsi));
                *(u32x2*)(wsb<C>(p, C::WS_MIX) + (size_t)row * C::D + C::PW + h * 128 + d) = w; }
        }
        WG_SYNC();
    }
}
__device__ __forceinline__ void pool_phase(LAS unsigned char* lds, const Ptrs& p, int l, int tid, int bid, int gsz) {
    const int lane = tid & 63, wave = __builtin_amdgcn_readfirstlane(tid >> 6), li = lane & 15, g = lane >> 4;
    LAS unsigned char* Ds = lds; LAS unsigned char* Ws = lds + T128;
    const float* P = wsf<C>(p, C::WS_BIG);
    for (int u = bid; u < NU_G; u += gsz) {
        int r0, lc, grp, t0, L, b; bool sample = false;
        if (u < NT_P * 4) { grp = u & 3; r0 = (u >> 2) * 128; lc = 128; b = r0 / C::SEQ; t0 = r0 % C::SEQ; L = C::SEQ; } else { const int s = u - NT_P * 4; grp = s & 3; b = s >> 2; r0 = C::MP + b * C::DEC_SEQ; lc = C::DEC_SEQ; t0 = 0; L = C::DEC_SEQ; sample = true; }
        const int w = 2 << grp;
        { const int c4 = tid & 31, sg = tid >> 5, ch = grp * 128 + c4 * 4;
            const float* hist = p.in[I_SPOOL] + ((size_t)l * C::DEC_BATCH + b) * C::PH * C::PW + ch;
            auto xat = [&](int t) -> f32x4 {
                if (t >= 0) return *(const f32x4*)(P + (size_t)(r0 - t0 + t) * C::LDP + ch);
                if (sample && C::PH + t >= 0) return *(const f32x4*)(hist + (size_t)(C::PH + t) * C::PW);
                return (f32x4){0.f, 0.f, 0.f, 0.f}; };
            if (sg * 8 < lc) {
                const int ts = t0 + sg * 8;
                f32x4 sum = (f32x4){0.f, 0.f, 0.f, 0.f};
                for (int j = 1; j < w; ++j) sum = sum + xat(ts - j);
#pragma unroll
                for (int k = 0; k < 8; ++k) { const int t = ts + k; const f32x4 x = xat(t); sum = sum + x;
                    const int pos = (sample ? C::PAST : 0) + t; const float inv = 1.0f / (float)((pos + 1) < w ? (pos + 1) : w);
                    const f32x4 dv = sum * inv - x;
                    u32x2 ww; ww.x = pg8::cvt_pk_bf16(dv[0], dv[1]); ww.y = pg8::cvt_pk_bf16(dv[2], dv[3]); *(LAS u32x2*)(Ds + (sg * 8 + k) * PT + c4 * 8) = ww;
                    sum = sum - xat(t - w + 1);
                    const int idx = t - (L - C::PH);
                    if (idx >= 0) *(f32x4*)(p.out + (sample ? C::OUT_POOLS + (((size_t)l * C::DEC_BATCH + b) * C::PH + idx) * C::PW : C::OUT_POOLP + (((size_t)l * C::BATCH + b) * C::PH + idx) * C::PW) + ch) = x; }
            } else {
#pragma unroll
                for (int k = 0; k < 8; ++k) *(LAS u32x2*)(Ds + (sg * 8 + k) * PT + c4 * 8) = (u32x2){0u, 0u};
            }
        }
        const float* wsrc = p.in[I_POOLW] + ((size_t)l * C::PG + grp) * 128 * 128;
#pragma unroll
        for (int i = 0; i < 8; ++i) { const int f = tid + 512 * i, row = f >> 5, c4 = f & 31; const f32x4 v = *(const f32x4*)(wsrc + (size_t)row * 128 + c4 * 4);
            u32x2 ww; ww.x = pg8::cvt_pk_bf16(v[0], v[1]); ww.y = pg8::cvt_pk_bf16(v[2], v[3]); *(LAS u32x2*)(Ws + row * PT + c4 * 8) = ww; }
        WG_SYNC();
        if (wave * 16 < lc) {
            const int t = wave * 16 + li;
            f32x4 acc[8];
#pragma unroll
            for (int et = 0; et < 8; ++et) acc[et] = (f32x4){0.f, 0.f, 0.f, 0.f};
            const unsigned wsa = (unsigned)(size_t)Ws;
#pragma unroll
            for (int ks = 0; ks < 4; ++ks) {
                const bf16x8 bq = *(const LAS bf16x8*)(Ds + t * PT + ks * 64 + g * 16);
                s16x4 lo[8], hi[8];
#pragma unroll
                for (int et = 0; et < 8; ++et) { lo[et] = att::tr_read(mx::tr_addr(wsa, 32 * ks + 8 * g, 16 * et, li)); hi[et] = att::tr_read(mx::tr_addr(wsa, 32 * ks + 8 * g + 4, 16 * et, li)); }
                mx::lds_wait();
#pragma unroll
                for (int et = 0; et < 8; ++et) acc[et] = __builtin_amdgcn_mfma_f32_16x16x32_bf16(mx::mk8(lo[et], hi[et]), bq, acc[et], 0, 0, 0);
            }
            const int row = r0 + t;
#pragma unroll
            for (int et = 0; et < 8; ++et) { const int e = 16 * et + 4 * g; const f32x4 sc = *(const f32x4*)(p.in[I_POOLS] + (size_t)l * C::PW + grp * 128 + e);
                u32x2 ww; ww.x = pg8::cvt_pk_bf16(acc[et][0] * sc[0], acc[et][1] * sc[1]); ww.y = pg8::cvt_pk_bf16(acc[et][2] * sc[2], acc[et][3] * sc[3]);
                *(u32x2*)(wsb<C>(p, C::WS_MIX) + (size_t)row * C::D + grp * 128 + e) = ww; }
        }
        WG_SYNC();
    }
}
}
namespace mp {
typedef att::bf16x8 bf16x8; typedef att::s16x4 s16x4; typedef att::f32x4 f32x4; typedef att::u32x2 u32x2; typedef pg8::u32x4 u32x4;
constexpr int PT = mx::PT, T64 = mx::T64, T128 = mx::T128, MAXU = 8;
#define MP_TR(dst, base, OFF) asm volatile("ds_read_b64_tr_b16 %0, %1 offset:%2" : "=&v"(dst) : "v"(base), "i"(OFF) : "memory")
__device__ __forceinline__ void ml_a(LAS unsigned char* lds, const Ptrs& p, int l, int tid, int bid, int gsz) {
    const int lane = tid & 63, wave = __builtin_amdgcn_readfirstlane(tid >> 6), li = lane & 15, g = lane >> 4;
    LAS unsigned char* Ks = lds; LAS unsigned char* Vs = lds + T64; LAS float* wts = (LAS float*)(lds + 2 * T64);
    const float* P = wsf<C>(p, C::WS_BIG);
    const int nu = bid < C::NCH ? (C::NCH - 1 - bid) / gsz + 1 : 0;
    if (wave < nu) { const int ci = bid + wave * gsz; int r0, h, lc; mx::ch_decode(ci, r0, h, lc);
        float lf = 0.f, ig = -3.0e38f;
        if (lane < lc) { const float* pr = P + (size_t)(r0 + lane) * C::LDP; ig = pr[C::O_IG + h] + p.in[I_IB][l * C::MH + h]; const float fx = pr[C::O_FG + h] + p.in[I_FB][l * C::MH + h];
            lf = fx >= 0.f ? -__logf(1.0f + __expf(-fx)) : fx - __logf(1.0f + __expf(fx)); }
        float b = lf;
#pragma unroll
        for (int o = 1; o < 64; o <<= 1) { const float t = __shfl_up(b, o); if (lane >= o) b += t; }
        const float a = lane < lc ? ig - b : -3.0e38f;
        float amax = a;
#pragma unroll
        for (int o = 1; o < 64; o <<= 1) amax = fmaxf(amax, __shfl_xor(amax, o));
        const float bL = __shfl(b, lc - 1), mloc = bL + amax;
        wts[wave * 64 + lane] = lane < lc ? __expf(bL + a - mloc) : 0.f;
        if (lane < lc) { wsf<C>(p, C::WS_GB)[(size_t)(r0 + lane) * C::MH + h] = b; wsf<C>(p, C::WS_GA)[(size_t)(r0 + lane) * C::MH + h] = a; }
        if (lane == 0) { wsf<C>(p, C::WS_CBL)[ci] = bL; wsf<C>(p, C::WS_CML)[ci] = mloc; } }
    const unsigned lofs8 = (unsigned)((8 * g + (li >> 2)) * PT + 8 * (li & 3));
    const unsigned kw8 = (unsigned)(size_t)Ks + lofs8 + (unsigned)(32 * wave), vs8 = (unsigned)(size_t)Vs + lofs8;
    f32x4 pk[4], pv[4];
    auto window = [&](int ci) { int r0, h, lc; mx::ch_decode(ci, r0, h, lc); const float* src = P + (size_t)r0 * C::LDP + h * C::MHD;
#pragma unroll
        for (int q = 0; q < 4; ++q) { const int f = tid + 512 * q, row = f >> 5, c4 = f & 31;
            if (row < lc) { pk[q] = *(const f32x4*)(src + (size_t)row * C::LDP + C::O_K + c4 * 4); pv[q] = *(const f32x4*)(src + (size_t)row * C::LDP + C::O_VM + c4 * 4); }
            else { pk[q] = (f32x4){0.f, 0.f, 0.f, 0.f}; pv[q] = pk[q]; } }
        __builtin_amdgcn_sched_barrier(0); };
    if (nu > 0) window(bid);
    WG_SYNC();
    for (int j = 0; j < nu; ++j) { const int ci = bid + j * gsz;
#pragma unroll
        for (int q = 0; q < 4; ++q) { const int f = tid + 512 * q, row = f >> 5, c4 = f & 31; const float sw = 0.08838834764831845f * wts[j * 64 + row];
            u32x2 w; w.x = pg8::cvt_pk_bf16(pk[q][0] * sw, pk[q][1] * sw); w.y = pg8::cvt_pk_bf16(pk[q][2] * sw, pk[q][3] * sw); *(LAS u32x2*)(Ks + row * PT + c4 * 8) = w;
            w.x = pg8::cvt_pk_bf16(pv[q][0], pv[q][1]); w.y = pg8::cvt_pk_bf16(pv[q][2], pv[q][3]); *(LAS u32x2*)(Vs + row * PT + c4 * 8) = w; }
        if (j + 1 < nu) window(ci + gsz);
        WG_SYNC();
        f32x4 acc[8], accn = (f32x4){0.f, 0.f, 0.f, 0.f};
#pragma unroll
        for (int et = 0; et < 8; ++et) acc[et] = (f32x4){0.f, 0.f, 0.f, 0.f};
        const bf16x8 ones = (bf16x8){0x3F80, 0x3F80, 0x3F80, 0x3F80, 0x3F80, 0x3F80, 0x3F80, 0x3F80};
#pragma unroll
        for (int t = 0; t < 2; ++t) {
            s16x4 alo, ahi, blo[8], bhi[8]; MP_TR(alo, kw8, (32 * t) * PT); MP_TR(ahi, kw8, (32 * t + 4) * PT);
#pragma unroll
            for (int et = 0; et < 8; ++et) { MP_TR(blo[et], vs8, (32 * t) * PT + 32 * et); MP_TR(bhi[et], vs8, (32 * t + 4) * PT + 32 * et); }
            mx::lds_wait();
            const bf16x8 a = mx::mk8(alo, ahi);
#pragma unroll
            for (int et = 0; et < 8; ++et) acc[et] = __builtin_amdgcn_mfma_f32_16x16x32_bf16(mx::mk8(blo[et], bhi[et]), a, acc[et], 0, 0, 0);
            accn = __builtin_amdgcn_mfma_f32_16x16x32_bf16(ones, a, accn, 0, 0, 0);
        }
        float* DC = wsf<C>(p, C::WS_DC) + (size_t)ci * C::MHD * C::MHD + (size_t)(16 * wave + li) * C::MHD + 4 * g;
#pragma unroll
        for (int et = 0; et < 8; ++et) *(f32x4*)(DC + 16 * et) = acc[et];
        if (g == 0) wsf<C>(p, C::WS_DN)[(size_t)ci * C::MHD + 16 * wave + li] = accn[0];
        WG_SYNC();
    }
}
__device__ __forceinline__ void ml_scan(const Ptrs& p, int l, long gtid, long gthreads) {
    const float* CBL = wsf<C>(p, C::WS_CBL); const float* CML = wsf<C>(p, C::WS_CML); const float* DC = wsf<C>(p, C::WS_DC); float* DN = wsf<C>(p, C::WS_DN);
    bf16_t* DCB = wsb<C>(p, C::WS_DCB); float* MPREV = wsf<C>(p, C::WS_MPREV);
    constexpr int NPS = C::BATCH * C::MH, E4 = C::MHD / 4;
    static_assert(C::NC % 8 == 0, "scan is unrolled by 8 chunks");
    for (long it = gtid; it < (long)NPS * C::MHD * E4; it += gthreads) {
        const int e4 = (int)(it % E4), d = (int)((it / E4) % C::MHD), sq = (int)(it / ((long)E4 * C::MHD));
        float m = 0.f; f32x4 cst = (f32x4){0.f, 0.f, 0.f, 0.f};
        for (int c0 = 0; c0 < C::NC; c0 += 8) {
            f32x4 v[8]; float bl[8], ml[8];
#pragma unroll
            for (int j = 0; j < 8; ++j) { const int ci = sq * C::NC + c0 + j; v[j] = *(const f32x4*)(DC + ((size_t)ci * C::MHD + d) * C::MHD + e4 * 4); bl[j] = CBL[ci]; ml[j] = CML[ci]; }
            __builtin_amdgcn_sched_barrier(0);
#pragma unroll
            for (int j = 0; j < 8; ++j) { const int ci = sq * C::NC + c0 + j; const float a = bl[j] + m, mn = fmaxf(a, ml[j]), dec = __expf(a - mn), f = __expf(ml[j] - mn);
                if (d == 0 && e4 == 0) MPREV[ci] = m;
                cst = cst * dec + v[j] * f; u32x2 w; w.x = pg8::cvt_pk_bf16(cst[0], cst[1]); w.y = pg8::cvt_pk_bf16(cst[2], cst[3]);
                *(u32x2*)(DCB + ((size_t)ci * C::MHD + d) * C::MHD + e4 * 4) = w; m = mn; }
        }
        *(f32x4*)(p.out + C::OUT_CP + (((size_t)l * NPS + sq) * C::MHD + d) * C::MHD + e4 * 4) = cst;
        if (d == 0 && e4 == 0) p.out[C::OUT_MP + (size_t)l * NPS + sq] = m;
    }
    for (long it = gtid; it < (long)NPS * C::MHD; it += gthreads) {
        const int d = (int)(it % C::MHD), sq = (int)(it / C::MHD);
        float m = 0.f, nst = 0.f;
        for (int c = 0; c < C::NC; ++c) { const int ci = sq * C::NC + c; const float a = CBL[ci] + m, b2 = CML[ci], mn = fmaxf(a, b2), dec = __expf(a - mn), f = __expf(b2 - mn);
            const size_t on = (size_t)ci * C::MHD + d; nst = dec * nst + f * DN[on]; DN[on] = nst; m = mn; }
        p.out[C::OUT_NP + ((size_t)l * NPS + sq) * C::MHD + d] = nst;
    }
    for (long it = gtid; it < (long)C::NSC * C::MHD * E4; it += gthreads) {
        const int e4 = (int)(it % E4), d = (int)((it / E4) % C::MHD), q = (int)(it / ((long)E4 * C::MHD)), ci = C::NPC + q;
        const float m0 = p.in[I_SM][(size_t)l * C::NSC + q], a = CBL[ci] + m0, b2 = CML[ci], mn = fmaxf(a, b2), dec = __expf(a - mn), f = __expf(b2 - mn);
        const size_t so = (((size_t)l * C::NSC + q) * C::MHD + d) * C::MHD + e4 * 4; const f32x4 cin = *(const f32x4*)(p.in[I_SC] + so);
        *(f32x4*)(p.out + C::OUT_CS + so) = cin * dec + *(const f32x4*)(DC + ((size_t)ci * C::MHD + d) * C::MHD + e4 * 4) * f;
        u32x2 w; w.x = pg8::cvt_pk_bf16(cin[0], cin[1]); w.y = pg8::cvt_pk_bf16(cin[2], cin[3]); *(u32x2*)(DCB + ((size_t)ci * C::MHD + d) * C::MHD + e4 * 4) = w;
        if (d == 0 && e4 == 0) { MPREV[ci] = m0; p.out[C::OUT_MS + (size_t)l * C::NSC + q] = mn; }
    }
    for (long it = gtid; it < (long)C::NSC * C::MHD; it += gthreads) {
        const int d = (int)(it % C::MHD), q = (int)(it / C::MHD), ci = C::NPC + q;
        const float m0 = p.in[I_SM][(size_t)l * C::NSC + q], a = CBL[ci] + m0, b2 = CML[ci], mn = fmaxf(a, b2), dec = __expf(a - mn), f = __expf(b2 - mn);
        const size_t no = ((size_t)l * C::NSC + q) * C::MHD + d;
        p.out[C::OUT_NS + no] = dec * p.in[I_SN][no] + f * DN[(size_t)ci * C::MHD + d];
    }
}
__device__ __forceinline__ void ml_c(LAS unsigned char* lds, const Ptrs& p, int l, int tid, int bid, int gsz) {
    const int lane = tid & 63, wave = __builtin_amdgcn_readfirstlane(tid >> 6), li = lane & 15, g = lane >> 4, it = wave & 3, eh = wave >> 2;
    LAS unsigned char* Qs = lds; LAS unsigned char* Ks = lds + T64; LAS unsigned char* Vs = lds + 2 * T64; LAS unsigned char* Cs = lds + 3 * T64;
    LAS float* SB = (LAS float*)(lds + 3 * T64 + T128); LAS float* SA = SB + MAXU * 64; LAS float* SMR = SA + MAXU * 64; LAS float* SIW = SMR + MAXU * 64;
    LAS float* snp = SIW + MAXU * 64; LAS float* ssq = snp + 128; LAS float* sgn = ssq + 128;
    const float* P = wsf<C>(p, C::WS_BIG);
    const int nu = bid < C::NCH ? (C::NCH - 1 - bid) / gsz + 1 : 0;
    if (wave < nu) { const int ci = bid + wave * gsz; int r0, h, lc; mx::ch_decode(ci, r0, h, lc); const float mprev = wsf<C>(p, C::WS_MPREV)[ci];
        float b = 0.f, a = -3.0e38f;
        if (lane < lc) { b = wsf<C>(p, C::WS_GB)[(size_t)(r0 + lane) * C::MH + h]; a = wsf<C>(p, C::WS_GA)[(size_t)(r0 + lane) * C::MH + h]; }
        float pm = a;
#pragma unroll
        for (int o = 1; o < 64; o <<= 1) { const float t = __shfl_up(pm, o); if (lane >= o) pm = fmaxf(pm, t); }
        const float mrow = b + fmaxf(mprev, pm);
        SB[wave * 64 + lane] = b; SA[wave * 64 + lane] = a; SMR[wave * 64 + lane] = mrow; SIW[wave * 64 + lane] = __expf(b + mprev - mrow); }
    const unsigned lofs8 = (unsigned)((8 * g + (li >> 2)) * PT + 8 * (li & 3)), lofs4 = (unsigned)((4 * g + (li >> 2)) * PT + 8 * (li & 3));
    const unsigned vs4e = (unsigned)(size_t)Vs + lofs4 + (unsigned)(128 * eh), cb8e = (unsigned)(size_t)Cs + lofs8 + (unsigned)(128 * eh);
    f32x4 pq[4], pk[4], pv[4], og[4]; u32x4 pc[4]; float pn = 0.f, pg = 0.f;
    auto window = [&](int ci) { int r0, h, lc; mx::ch_decode(ci, r0, h, lc); const float* src = P + (size_t)r0 * C::LDP + h * C::MHD;
        const bool sample = ci >= C::NPC, first = !sample && (ci % C::NC) == 0;
#pragma unroll
        for (int q = 0; q < 4; ++q) { const int f = tid + 512 * q, row = f >> 5, c4 = f & 31;
            if (row < lc) { pq[q] = *(const f32x4*)(src + (size_t)row * C::LDP + C::O_Q + c4 * 4); pk[q] = *(const f32x4*)(src + (size_t)row * C::LDP + C::O_K + c4 * 4); pv[q] = *(const f32x4*)(src + (size_t)row * C::LDP + C::O_VM + c4 * 4); }
            else { pq[q] = (f32x4){0.f, 0.f, 0.f, 0.f}; pk[q] = pq[q]; pv[q] = pq[q]; } }
        const bf16_t* cb = wsb<C>(p, C::WS_DCB) + (size_t)(sample ? ci : (first ? ci : ci - 1)) * C::MHD * C::MHD;
#pragma unroll
        for (int q = 0; q < 4; ++q) { const int f = tid + 512 * q; pc[q] = first ? (u32x4){0u, 0u, 0u, 0u} : *(const u32x4*)(cb + (size_t)f * 8); }
        const int i = 16 * it + li;
#pragma unroll
        for (int e4 = 0; e4 < 4; ++e4) og[e4] = (it * 16 < lc) ? *(const f32x4*)(src + (size_t)i * C::LDP + C::O_O + 16 * (4 * eh + e4) + 4 * g) : (f32x4){0.f, 0.f, 0.f, 0.f};
        if (tid < C::MHD) { pn = sample ? p.in[I_SN][((size_t)l * C::NSC + (ci - C::NPC)) * C::MHD + tid] : (first ? 0.f : wsf<C>(p, C::WS_DN)[(size_t)(ci - 1) * C::MHD + tid]);
            pg = p.in[I_NG][(size_t)l * C::MW + h * C::MHD + tid]; }
        __builtin_amdgcn_sched_barrier(0); };
    if (nu > 0) window(bid);
    WG_SYNC();
    for (int j = 0; j < nu; ++j) { const int ci = bid + j * gsz; int r0, h, lc; mx::ch_decode(ci, r0, h, lc);
        const LAS float* sb = SB + j * 64; const LAS float* sa = SA + j * 64; const LAS float* smr = SMR + j * 64; const LAS float* siw = SIW + j * 64;
#pragma unroll
        for (int q = 0; q < 4; ++q) { const int f = tid + 512 * q, row = f >> 5, c4 = f & 31; const float sc = 0.08838834764831845f;
            u32x2 w; w.x = pg8::cvt_pk_bf16(pq[q][0], pq[q][1]); w.y = pg8::cvt_pk_bf16(pq[q][2], pq[q][3]); *(LAS u32x2*)(Qs + row * PT + c4 * 8) = w;
            w.x = pg8::cvt_pk_bf16(pk[q][0] * sc, pk[q][1] * sc); w.y = pg8::cvt_pk_bf16(pk[q][2] * sc, pk[q][3] * sc); *(LAS u32x2*)(Ks + row * PT + c4 * 8) = w;
            w.x = pg8::cvt_pk_bf16(pv[q][0], pv[q][1]); w.y = pg8::cvt_pk_bf16(pv[q][2], pv[q][3]); *(LAS u32x2*)(Vs + row * PT + c4 * 8) = w;
            *(LAS u32x4*)(Cs + (f >> 4) * PT + (f & 15) * 16) = pc[q]; }
        if (tid < C::MHD) { snp[tid] = pn; sgn[tid] = pg; }
        f32x4 ogc[4];
#pragma unroll
        for (int e4 = 0; e4 < 4; ++e4) ogc[e4] = og[e4];
        if (j + 1 < nu) window(ci + gsz);
        WG_SYNC();
        const bool active = it * 16 < lc; const int i = 16 * it + li;
        float ssq_part = 0.f; f32x4 hv[4];
        if (active) {
            bf16x8 qf[4];
#pragma unroll
            for (int ks = 0; ks < 4; ++ks) qf[ks] = *(const LAS bf16x8*)(Qs + i * PT + ks * 64 + g * 16);
            f32x4 st[4];
#pragma unroll
            for (int jt = 0; jt < 4; ++jt) st[jt] = (f32x4){0.f, 0.f, 0.f, 0.f};
#pragma unroll
            for (int jt = 0; jt < 4; ++jt) if (jt <= it) {
#pragma unroll
                for (int ks = 0; ks < 4; ++ks) { const bf16x8 a = *(const LAS bf16x8*)(Ks + (16 * jt + li) * PT + ks * 64 + g * 16);
                    st[jt] = __builtin_amdgcn_mfma_f32_16x16x32_bf16(a, qf[ks], st[jt], 0, 0, 0); } }
            const float bi = sb[i], mri = smr[i], iwi = siw[i];
            float dsum = 0.f;
#pragma unroll
            for (int jt = 0; jt < 4; ++jt)
#pragma unroll
                for (int r = 0; r < 4; ++r) { const int jj = 16 * jt + 4 * g + r; const float w = (jj <= i) ? __expf(bi + sa[jj] - mri) : 0.f; st[jt][r] *= w; dsum += st[jt][r]; }
            dsum += __shfl_xor(dsum, 16); dsum += __shfl_xor(dsum, 32);
            float qn = 0.f;
#pragma unroll
            for (int ks = 0; ks < 4; ++ks)
#pragma unroll
                for (int jj = 0; jj < 8; ++jj) qn += bf2f((bf16_t)qf[ks][jj]) * snp[32 * ks + 8 * g + jj];
            qn += __shfl_xor(qn, 16); qn += __shfl_xor(qn, 32);
            const float den = dsum + iwi * qn, inv_den = 1.0f / fmaxf(fabsf(den), __expf(-mri));
            bf16x8 pf[2];
#pragma unroll
            for (int t = 0; t < 2; ++t) { u32x4 w; w.x = pg8::cvt_pk_bf16(st[2 * t][0], st[2 * t][1]); w.y = pg8::cvt_pk_bf16(st[2 * t][2], st[2 * t][3]);
                w.z = pg8::cvt_pk_bf16(st[2 * t + 1][0], st[2 * t + 1][1]); w.w = pg8::cvt_pk_bf16(st[2 * t + 1][2], st[2 * t + 1][3]); pf[t] = __builtin_bit_cast(bf16x8, w); }
#pragma unroll
            for (int e2 = 0; e2 < 2; ++e2) {
                s16x4 vlo[2][2], vhi[2][2], clo[2][4], chi[2][4];
#pragma unroll
                for (int u = 0; u < 2; ++u) {
#pragma unroll
                    for (int t = 0; t < 2; ++t) { MP_TR(vlo[u][t], vs4e, (32 * t) * PT + 32 * (2 * e2 + u)); MP_TR(vhi[u][t], vs4e, (32 * t + 16) * PT + 32 * (2 * e2 + u)); }
#pragma unroll
                    for (int ks = 0; ks < 4; ++ks) { MP_TR(clo[u][ks], cb8e, (32 * ks) * PT + 32 * (2 * e2 + u)); MP_TR(chi[u][ks], cb8e, (32 * ks + 4) * PT + 32 * (2 * e2 + u)); } }
                mx::lds_wait();
#pragma unroll
                for (int u = 0; u < 2; ++u) { const int e4 = 2 * e2 + u;
                    f32x4 aS = (f32x4){0.f, 0.f, 0.f, 0.f}, aC = (f32x4){0.f, 0.f, 0.f, 0.f};
#pragma unroll
                    for (int t = 0; t < 2; ++t) aS = __builtin_amdgcn_mfma_f32_16x16x32_bf16(mx::mk8(vlo[u][t], vhi[u][t]), pf[t], aS, 0, 0, 0);
#pragma unroll
                    for (int ks = 0; ks < 4; ++ks) aC = __builtin_amdgcn_mfma_f32_16x16x32_bf16(mx::mk8(clo[u][ks], chi[u][ks]), qf[ks], aC, 0, 0, 0);
                    hv[e4] = (aS + aC * iwi) * inv_den;
                    ssq_part += (hv[e4][0] * hv[e4][0] + hv[e4][1] * hv[e4][1]) + (hv[e4][2] * hv[e4][2] + hv[e4][3] * hv[e4][3]); } }
            ssq_part += __shfl_xor(ssq_part, 16); ssq_part += __shfl_xor(ssq_part, 32);
            if (g == 0) ssq[wave * 16 + li] = ssq_part;
        }
        WG_SYNC();
        if (active) {
            const float tot = ssq_part + ssq[(wave ^ 4) * 16 + li];
            const float rs = rsqrtf(tot * (1.0f / C::MHD) + 1e-6f);
            const int row = r0 + i;
#pragma unroll
            for (int e4 = 0; e4 < 4; ++e4) { const int e = 16 * (4 * eh + e4) + 4 * g; const f32x4 gn = *(const LAS f32x4*)(sgn + e);
                float o4[4];
#pragma unroll
                for (int r = 0; r < 4; ++r) o4[r] = hv[e4][r] * rs * gn[r] * __builtin_amdgcn_rcpf(1.0f + __expf(-ogc[e4][r]));
                u32x2 w; w.x = pg8::cvt_pk_bf16(o4[0], o4[1]); w.y = pg8::cvt_pk_bf16(o4[2], o4[3]);
                *(u32x2*)(wsb<C>(p, C::WS_MIX) + (size_t)row * C::D + C::PW + C::GW + h * C::MHD + e) = w; }
        }
        WG_SYNC();
    }
}
}
constexpr int PH_PER_LAYER = 12, N_PHASES = 2 + PH_PER_LAYER * C::DEPTH;
struct Args { Ptrs p; int ph_lo, ph_hi; };
__global__ void __launch_bounds__(NTHREADS, 2) fwd(Args a) {
    extern __shared__ __attribute__((aligned(16))) unsigned char lds_raw[];
    LAS unsigned char* lds = (LAS unsigned char*)lds_raw;
    typedef __attribute__((address_space(4))) const Args* KArgs;
    const KArgs ka0 = (KArgs)__builtin_amdgcn_kernarg_segment_ptr();
    const int lo = a.ph_lo, hi = a.ph_hi;
#define IN(k) (lo <= (k) && (k) < hi)
#define BOTH(k) (IN(k) && IN((k) + 1))
#define GRID_BAR(k) do { if (BOTH(k)) { xcd_barrier(bar); } } while (0)
#if defined(__HIP_DEVICE_COMPILE__)
#define LOAD_PTRS KArgs ka = ka0; asm volatile("" : "+s"(ka)); Ptrs p; _Pragma("unroll") for (int i_ = 0; i_ < 33; ++i_) p.in[i_] = ka->p.in[i_]; p.out = ka->p.out; p.ws = ka->p.ws;
#else
#define LOAD_PTRS (void)ka0; const Ptrs p = a.p;
#endif
#define PHASE_ARGS LOAD_PTRS int tid = threadIdx.x; asm volatile("" : "+v"(tid)); int bid = blockIdx.x, gsz = gridDim.x; asm volatile("" : "+s"(bid), "+s"(gsz));     \
    const int lane = tid & 63, wave = __builtin_amdgcn_readfirstlane(tid >> 6); (void)lane; (void)wave; \
    const long gtid = (long)bid * NTHREADS + tid, gthreads = (long)gsz * NTHREADS; (void)gtid; (void)gthreads; \
    float* SS = wsf<C>(p, C::WS_SS); (void)SS; const float invd = 1.0f / C::D; (void)invd;
#if defined(PROBE_MASK_A)
#define STAMP(k) do { if (blockIdx.x == 0 && threadIdx.x == 0) ((unsigned long long*)(a.p.ws + C::WS_CTL + 32768))[k] = wall_clock64(); } while (0)
#else
#define STAMP(k) do { } while (0)
#endif
#define ITEMS(n, call) do { for (long it = gtid; it < (long)(n); it += gthreads) { call; } } while (0)
#define SSL(j) (SS + (size_t)(4 * l + (j)) * C::M)
#define GEMM_ALL(STRIP, EPI, Aop, Bop, Mr, Nc, Kd, ...) do { pg8::Gemm g{Aop, Bop, Mr, Nc, Kd, Kd}; pg8::StaticOrder S; S.init(Mr, Nc, gsz, bid, (STRIP) ? 288 : 256); \
        pg8::EPI E{__VA_ARGS__}; pg8::gemm_phase<pg8::EPI, pg8::StaticOrder, STRIP, false>(lds, g, S, E, nullptr); } while (0)
#if ONE_LAUNCH
    if (threadIdx.x < 4) ((LAS unsigned*)(lds + LDS_CTL))[threadIdx.x] = 0u;
    __syncthreads();
    XcdBarrier bar = xcd_barrier_post((unsigned*)(a.p.ws + C::WS_CTL), (volatile LAS unsigned*)(lds + LDS_CTL));
#else
    XcdBarrier bar; bar.bar = nullptr; bar.x = 0; bar.st = nullptr;
#endif

    if (IN(0)) { PHASE_ARGS STAMP(0);
        const int gw = bid * NWAVES + wave, NGW = gsz * NWAVES;
        for (int l = 0; l < C::DEPTH; ++l)
            for (int idx = 0; idx < 10; ++idx) { const WDesc d = wdesc(p, l, idx); const int nitems = (d.K / 64) * (d.N / 64);
                for (int it = gw; it < nitems; it += NGW) prep_item(d.W, d.K, d.Ncols, d.g, d.kind, d.N, d.dst, lds + wave * 9216, it, lane); }
        rw::rows_init(p, tid, bid, gsz);
        GRID_BAR(0);
    }
    for (int l = 0; l < C::DEPTH; ++l) {
        const int pb = 1 + PH_PER_LAYER * l;
        if (IN(pb + 0)) { PHASE_ARGS STAMP(pb + 0);
            GEMM_ALL(true, EpiSwiGLU, wsb<C>(p, C::WS_XB), wlayer<C>(p, l, C::W_1IN), C::M, 2 * C::FF, C::D, wsb<C>(p, C::WS_BIG), SSL(0), C::FF, invd);
            GRID_BAR(pb + 0); }
        if (IN(pb + 1)) { PHASE_ARGS STAMP(pb + 1);
            GEMM_ALL(true, EpiResid, wsb<C>(p, C::WS_BIG), wlayer<C>(p, l, C::W_1OUT), C::M, C::D, C::FF, wsf<C>(p, C::WS_X), wsb<C>(p, C::WS_XB), SSL(1), 0.5f, C::D);
            GRID_BAR(pb + 1); }
        if (IN(pb + 2)) { PHASE_ARGS STAMP(pb + 2);
            GEMM_ALL(true, EpiScaleF32, wsb<C>(p, C::WS_XB), wlayer<C>(p, l, C::W_IN), C::M, C::LDP, C::D, wsf<C>(p, C::WS_BIG), C::LDP, SSL(1), invd);
            GRID_BAR(pb + 2); }
        if (IN(pb + 3)) { PHASE_ARGS STAMP(pb + 3); mp::ml_a(lds, p, l, tid, bid, gsz);
#if defined(PROBE_MIXA)
            xcd_barrier(bar); STAMP(40 + l);
#endif
            gp::gmlp_phase(lds, p, l, tid, bid, gsz);
#if defined(PROBE_MIXA)
            xcd_barrier(bar); STAMP(42 + l);
#endif
            GRID_BAR(pb + 3); }
        if (IN(pb + 4)) { PHASE_ARGS STAMP(pb + 4);
            if (bid < 64) {
                pg8::Gemm g{wsb<C>(p, C::WS_MEMB), wlayer<C>(p, l, C::W_KV), C::MM, 2 * C::D, C::D, C::D}; pg8::StaticOrder S; S.init(C::MM, 2 * C::D, 64, bid);
                pg8::EpiMemKV E{p.out + C::OUT_MK + (size_t)l * C::MM * C::D, p.out + C::OUT_MV + (size_t)l * C::MM * C::D, wsf<C>(p, C::WS_RSTDM), C::D};
                pg8::gemm_phase<pg8::EpiMemKV, pg8::StaticOrder, false, false>(lds, g, S, E, nullptr);
            } else { mp::ml_scan(p, l, (long)(bid - 64) * NTHREADS + tid, (long)(gsz - 64) * NTHREADS); gp::pool_phase(lds, p, l, tid, bid - 64, gsz - 64); }
            GRID_BAR(pb + 4); }
        if (IN(pb + 5)) { PHASE_ARGS STAMP(pb + 5); mp::ml_c(lds, p, l, tid, bid, gsz); GRID_BAR(pb + 5); }
        if (IN(pb + 6)) { PHASE_ARGS STAMP(pb + 6);
            GEMM_ALL(true, EpiResid, wsb<C>(p, C::WS_MIX), wlayer<C>(p, l, C::W_OUT), C::M, C::D, C::D, wsf<C>(p, C::WS_X), wsb<C>(p, C::WS_XB), SSL(2), 1.0f, C::D);
            GRID_BAR(pb + 6); }
        if (IN(pb + 7)) { PHASE_ARGS STAMP(pb + 7);
            GEMM_ALL(true, EpiScaleBf16, wsb<C>(p, C::WS_XB), wlayer<C>(p, l, C::W_Q), C::M, C::D, C::D, wsb<C>(p, C::WS_Q), C::D, SSL(2), invd);
            GRID_BAR(pb + 7); }
        if (IN(pb + 8)) { PHASE_ARGS STAMP(pb + 8); att::attn_phase(lds, p, l, tid, bid, gsz); GRID_BAR(pb + 8); }
        if (IN(pb + 9)) { PHASE_ARGS STAMP(pb + 9);
            GEMM_ALL(true, EpiResid, wsb<C>(p, C::WS_AO), wlayer<C>(p, l, C::W_O), C::M, C::D, C::D, wsf<C>(p, C::WS_X), wsb<C>(p, C::WS_XB), SSL(3), 1.0f, C::D);
            GRID_BAR(pb + 9); }
        if (IN(pb + 10)) { PHASE_ARGS STAMP(pb + 10);
            GEMM_ALL(true, EpiSwiGLU, wsb<C>(p, C::WS_XB), wlayer<C>(p, l, C::W_2IN), C::M, 2 * C::FF, C::D, wsb<C>(p, C::WS_BIG), SSL(3), C::FF, invd);
            GRID_BAR(pb + 10); }
        if (IN(pb + 11)) { PHASE_ARGS STAMP(pb + 11);
            GEMM_ALL(true, EpiResid, wsb<C>(p, C::WS_BIG), wlayer<C>(p, l, C::W_2OUT), C::M, C::D, C::FF, wsf<C>(p, C::WS_X), wsb<C>(p, C::WS_XB), SSL(4), 0.5f, C::D);
            GRID_BAR(pb + 11); }
    }
    if (IN(N_PHASES - 1)) { PHASE_ARGS STAMP(N_PHASES - 1); __syncthreads(); rw::rows_final(p, tid, bid, gsz); }
#undef IN
#undef BOTH
#undef GRID_BAR
#undef ITEMS
#undef PHASE_ARGS
#undef SSL
}

extern "C" void kernel_launch(void* const* d_in, const int* in_sizes, int n_in, void* d_out, int out_size, void* d_ws, size_t ws_size, hipStream_t stream) {
    static int ready = 0;
    if (!ready) {
        if (n_in != 33 || (long)out_size != (long)C::OUT_END || ws_size < (size_t)C::WS_END) { fprintf(stderr, "kernel_launch: unexpected shapes: n_in %d out %d ws %zu (need %zu)\n", n_in, out_size, ws_size, (size_t)C::WS_END); ready = -1; return; }
        if (hipFuncSetAttribute((const void*)fwd, hipFuncAttributeMaxDynamicSharedMemorySize, LDS_BYTES) != hipSuccess) { fprintf(stderr, "kernel_launch: hipFuncSetAttribute failed\n"); ready = -1; return; }
        int dev = 0, cus = 0, per_cu = 0;
        if (hipGetDevice(&dev) != hipSuccess || hipDeviceGetAttribute(&cus, hipDeviceAttributeMultiprocessorCount, dev) != hipSuccess) { fprintf(stderr, "kernel_launch: device query failed\n"); ready = -1; return; }
        if (hipOccupancyMaxActiveBlocksPerMultiprocessor(&per_cu, (const void*)fwd, NTHREADS, LDS_BYTES) != hipSuccess || per_cu < 1) { fprintf(stderr, "kernel_launch: occupancy query reports %d blocks per CU\n", per_cu); (void)hipGetLastError(); per_cu = 1; }
        if (cus != 256) { fprintf(stderr, "kernel_launch: built for a 256-CU device (one resident workgroup per CU), found %d\n", cus); ready = -1; return; }
        ready = cus;
    }
    if (ready < 0) return;
    Args a{};
    for (int i = 0; i < 33; ++i) a.p.in[i] = (const float*)d_in[i];
    a.p.out = (float*)d_out; a.p.ws = (unsigned char*)d_ws;
#if ONE_LAUNCH
    (void)hipMemsetAsync((char*)d_ws + C::WS_CTL, 0, 65536, stream);
    a.ph_lo = 0; a.ph_hi = N_PHASES;
    hipLaunchKernelGGL(fwd, dim3(ready), dim3(NTHREADS), LDS_BYTES, stream, a);
#else
    for (int k = 0; k < N_PHASES; ++k) { a.ph_lo = k; a.ph_hi = k + 1; hipLaunchKernelGGL(fwd, dim3(ready), dim3(NTHREADS), LDS_BYTES, stream, a); }
#endif
}
```

```cpp
#include <hip/hip_runtime.h>
#include <cstdio>
#define ONE_LAUNCH 1

#define HD __host__ __device__
#ifndef HD
#define HD __host__ __device__
#endif
typedef unsigned short bf16_t;
HD inline unsigned f2u(float f) { return __builtin_bit_cast(unsigned, f); }
HD inline float u2f(unsigned u) { return __builtin_bit_cast(float, u); }
HD inline bf16_t f2bf(float f) { unsigned u = f2u(f); u += 0x7FFFu + ((u >> 16) & 1u); return (bf16_t)(u >> 16); }
HD inline float bf2f(bf16_t b) { return u2f(((unsigned)b) << 16); }

struct RC {
    static constexpr int D = 2048, FF = 8192, BATCH = 4, SEQ = 2048, DEPTH = 2, DEC_BATCH = 32, DEC_SEQ = 32, PAST = 2048, NMEM = 256;
};
template <class B> struct CfgT : B {
    using B::D; using B::FF; using B::BATCH; using B::SEQ; using B::DEPTH; using B::DEC_BATCH; using B::DEC_SEQ; using B::PAST; using B::NMEM;
    static constexpr int MP = BATCH * SEQ, MS = DEC_BATCH * DEC_SEQ, M = MP + MS, MM = BATCH * NMEM;
    static constexpr int PW = D / 4, PG = 4, PGD = PW / 4, PH = 15;
    static constexpr int GW = D / 4, GH = 4, GHD = GW / 4, GCH = 128;
    static constexpr int MW = D - PW - GW, MH = 8, MHD = MW / 8, CH = 64;
    static constexpr int INC = PW + 2 * GW + 4 * MW + 2 * MH;
    static constexpr int LDP = ((INC + 255) / 256) * 256;
    static constexpr int AH = 4, AHD = D / 4;
    static constexpr int O_U = PW, O_V = PW + GW, O_Q = PW + 2 * GW, O_K = O_Q + MW, O_VM = O_K + MW, O_O = O_VM + MW, O_IG = O_O + MW, O_FG = O_IG + MH;
    static constexpr int NC = SEQ / CH, NPC = BATCH * MH * NC, NSC = DEC_BATCH * MH, NCH = NPC + NSC;
    static constexpr int LCS = DEC_SEQ < CH ? DEC_SEQ : CH;
    static constexpr int GLP = SEQ < GCH ? SEQ : GCH, GLS = DEC_SEQ < GCH ? DEC_SEQ : GCH;
    static constexpr int NSS = 1 + 4 * DEPTH;
    static constexpr long OUT_YP = 0, OUT_YS = OUT_YP + (long)MP * D, OUT_POOLP = OUT_YS + (long)MS * D, OUT_POOLS = OUT_POOLP + (long)DEPTH * BATCH * PH * PW,
        OUT_CP = OUT_POOLS + (long)DEPTH * DEC_BATCH * PH * PW, OUT_NP = OUT_CP + (long)DEPTH * BATCH * MH * MHD * MHD, OUT_MP = OUT_NP + (long)DEPTH * BATCH * MH * MHD,
        OUT_CS = OUT_MP + (long)DEPTH * BATCH * MH, OUT_NS = OUT_CS + (long)DEPTH * DEC_BATCH * MH * MHD * MHD, OUT_MS = OUT_NS + (long)DEPTH * DEC_BATCH * MH * MHD,
        OUT_VS = OUT_MS + (long)DEPTH * DEC_BATCH * MH, OUT_MK = OUT_VS + (long)DEPTH * DEC_BATCH * DEC_SEQ * GW, OUT_MV = OUT_MK + (long)DEPTH * BATCH * NMEM * D,
        OUT_END = OUT_MV + (long)DEPTH * BATCH * NMEM * D;
    static constexpr size_t al(size_t x) { return (x + 255) & ~(size_t)255; }
    static constexpr size_t WS_CTL = 0, WS_SS = 65536, WS_X = al(WS_SS + (size_t)NSS * M * 4), WS_XB = al(WS_X + (size_t)M * D * 4),
        WS_BIG = al(WS_XB + (size_t)M * D * 2),
        WS_BIG_SZ = ((size_t)M * FF * 2 > (size_t)M * LDP * 4) ? (size_t)M * FF * 2 : (size_t)M * LDP * 4,
        WS_MIX = al(WS_BIG + WS_BIG_SZ), WS_Q = al(WS_MIX + (size_t)M * D * 2), WS_AO = al(WS_Q + (size_t)M * D * 2),
        WS_MEMB = al(WS_AO + (size_t)M * D * 2), WS_RSTDM = al(WS_MEMB + (size_t)MM * D * 2),
        WS_GB = al(WS_RSTDM + (size_t)MM * 4), WS_GA = al(WS_GB + (size_t)M * MH * 4),
        WS_CBL = al(WS_GA + (size_t)M * MH * 4), WS_CML = al(WS_CBL + (size_t)NCH * 4), WS_MPREV = al(WS_CML + (size_t)NCH * 4),
        WS_DC = al(WS_MPREV + (size_t)NCH * 4), WS_DN = al(WS_DC + (size_t)NCH * MHD * MHD * 4),
        WS_DCB = al(WS_DN + (size_t)NCH * MHD * 4),
        WS_W = al(WS_DCB + (size_t)NCH * MHD * MHD * 2);
    static constexpr size_t W_1IN = 0, W_1OUT = W_1IN + (size_t)2 * FF * D, W_IN = W_1OUT + (size_t)D * FF, W_OUT = W_IN + (size_t)LDP * D, W_Q = W_OUT + (size_t)D * D,
        W_KV = W_Q + (size_t)D * D, W_O = W_KV + (size_t)2 * D * D, W_2IN = W_O + (size_t)D * D, W_2OUT = W_2IN + (size_t)2 * FF * D, W_LAYER = W_2OUT + (size_t)D * FF;
    static constexpr size_t WS_END = al(WS_W + (size_t)DEPTH * W_LAYER * 2);
};

struct Ptrs { const float* in[33]; float* out; unsigned char* ws; };
enum { I_XP = 0, I_XS, I_MEM, I_SPOOL, I_SC, I_SN, I_SM, I_CK, I_CV, I_GFFN1, I_W1IN, I_W1OUT, I_GMIX, I_WIN, I_POOLW, I_POOLS, I_GVG, I_GWS, I_GBS, I_IB, I_FB, I_NG, I_WOUT,
       I_GX, I_GMEM, I_WQ, I_WK, I_WV, I_WO, I_GFFN2, I_W2IN, I_W2OUT, I_GFIN };

template <class C> HD inline float* wsf(const Ptrs& p, size_t off) { return (float*)(p.ws + off); }
template <class C> HD inline bf16_t* wsb(const Ptrs& p, size_t off) { return (bf16_t*)(p.ws + off); }
template <class C> HD inline bf16_t* wlayer(const Ptrs& p, int l, size_t off) { return (bf16_t*)(p.ws + C::WS_W) + (size_t)l * C::W_LAYER + off; }

template <class C> HD inline void row_info(int r, bool& s, int& b, int& t) {
    if (r < C::MP) { s = false; b = r / C::SEQ; t = r % C::SEQ; } else { s = true; const int q = r - C::MP; b = q / C::DEC_SEQ; t = q % C::DEC_SEQ; }
}
template <class C> HD inline void chunk_info(int r, int h, int& ci, int& i, int& lc) {
    bool s; int b, t; row_info<C>(r, s, b, t);
    if (!s) { ci = (b * C::MH + h) * C::NC + t / C::CH; i = t % C::CH; lc = C::CH; } else { ci = C::NPC + b * C::MH + h; i = t; lc = C::LCS; }
}
HD inline float sigmoidf_(float x) { return 1.0f / (1.0f + expf(-x)); }
HD inline float logsigmoidf_(float x) { return x >= 0.f ? -log1pf(expf(-x)) : x - log1pf(expf(x)); }

enum { WK_PLAIN = 0, WK_FFNIN = 1, WK_WIN = 2 };
template <class C> HD inline int wsrc_col(int kind, int n) {
    if (kind == WK_FFNIN) { const int pn = n >> 8, j = n & 255; return j < 128 ? 128 * pn + j : C::FF + 128 * pn + (j - 128); }
    if (kind == WK_WIN) return n < C::INC ? n : -1;
    return n;
}

template <class C> HD inline void st_ml_b0(const Ptrs& p, int l, int sq) {
    const float* CBL = wsf<C>(p, C::WS_CBL); const float* CML = wsf<C>(p, C::WS_CML); float* MPREV = wsf<C>(p, C::WS_MPREV);
    if (sq < C::BATCH * C::MH) { float m = 0.f;
        for (int c = 0; c < C::NC; ++c) { const int ci = sq * C::NC + c; MPREV[ci] = m; const float a = CBL[ci] + m, b2 = CML[ci]; m = a > b2 ? a : b2; }
        p.out[C::OUT_MP + (size_t)l * C::BATCH * C::MH + sq] = m;
    } else { const int q = sq - C::BATCH * C::MH, ci = C::NPC + q; const float m0 = p.in[I_SM][(size_t)l * C::DEC_BATCH * C::MH + q];
        MPREV[ci] = m0; const float a = CBL[ci] + m0, b2 = CML[ci]; p.out[C::OUT_MS + (size_t)l * C::DEC_BATCH * C::MH + q] = a > b2 ? a : b2; }
}

namespace pg8 {
#define PG8_LAS __attribute__((address_space(3)))
typedef unsigned short bf16_t;
typedef short bf16x8 __attribute__((ext_vector_type(8)));
typedef float f32x4 __attribute__((ext_vector_type(4)));
typedef unsigned u32x4 __attribute__((ext_vector_type(4)));
constexpr int BM = 256, BK = 64, HALF = 128, HTB = HALF * BK * 2  , STAGE_BYTES = 8 * HTB, NXCD = 8, WGM = 8;

__host__ __device__ __forceinline__ int lds_byte(int r, int c) { const int st = (r >> 4) * 2 + (c >> 5), rr = r & 15, cc = c & 31, ob = rr * 64 + cc * 2; return st * 1024 + (ob ^ (((ob >> 9) & 1) << 5)); }
__host__ __device__ __forceinline__ void stage_rc(int b, int& R, int& C) { const int st = b / 1024, sb = b % 1024, swz = sb ^ (((sb >> 9) & 1) << 5); R = (st >> 1) * 16 + swz / 64; C = (st & 1) * 32 + (swz % 64) / 2; }
__host__ __device__ __forceinline__ int perm32(int rho) { const int n = rho >> 4, i = rho & 15; return 8 * (i >> 2) + 4 * n + (i & 3); }

struct Unit { int pm, pn; };
struct Gemm { const bf16_t* A; const bf16_t* Bt; int M, N, K, ld; };

struct StaticOrder {
    int nM, nN, nwg, G, c;
    __host__ __device__ __forceinline__ void init(int M, int N, int G_, int c_, int rows_per_tile = BM) { nM = M / rows_per_tile; nN = N / BM; nwg = nM * nN; G = G_; c = c_; }
    __host__ __device__ __forceinline__ bool next(int i, Unit& u) const {
        const long L = (long)i * G + c; if (L >= nwg) return false;
        int wgid = (int)L; { const int q = nwg / NXCD, r = nwg % NXCD, xcd = wgid % NXCD, off = wgid / NXCD; wgid = (xcd < r ? xcd * (q + 1) : r * (q + 1) + (xcd - r) * q) + off; }
        const int nig = WGM * nN, gid = wgid / nig, fm = gid * WGM, gsz = (nM - fm) < WGM ? (nM - fm) : WGM;
        u.pm = fm + ((wgid % nig) % gsz); u.pn = (wgid % nig) / gsz; return true;
    }
    __device__ __forceinline__ void a_ready(const Unit&) const {}
    __device__ __forceinline__ void done(const Unit&) const {}
};
__device__ __forceinline__ unsigned cvt_pk_bf16(float lo, float hi) { unsigned r; asm volatile("v_cvt_pk_bf16_f32 %0, %1, %2" : "=v"(r) : "v"(lo), "v"(hi)); return r; }
typedef float f32x2 __attribute__((ext_vector_type(2)));
template <class Epi, class Sched, bool STRIP = false, bool STAMP = false>
__device__ __forceinline__ void gemm_phase(PG8_LAS unsigned char* lds, const Gemm g, const Sched& S, const Epi& E, unsigned long long* stamps) {
    int tid_l = threadIdx.x; asm volatile("" : "+v"(tid_l));
    const int tid = tid_l, wid = __builtin_amdgcn_readfirstlane(tid >> 6), lane = tid & 63, wr = wid >> 2, wc = wid & 3, fr = lane & 15, fq = lane >> 4;
    const int K = g.K, nt = K / BK;
    int ts_lo = 0, ts_hi = 0, nts = 0; const unsigned long long rt_entry = STAMP ? (unsigned long long)wall_clock64() : 0ull;
#define PG8_STAMP() do { if (STAMP && wid == 0 && nts < 64) { const unsigned long long _c = (unsigned long long)clock64(); \
        ts_lo = (lane == nts) ? (int)(unsigned)_c : ts_lo; ts_hi = (lane == nts) ? (int)(unsigned)(_c >> 32) : ts_hi; ++nts; } } while (0)
    PG8_STAMP();
    unsigned voffA[2], voffB[2];
#pragma unroll
    for (int i = 0; i < 2; ++i) { int R, C; stage_rc(tid * 16 + i * 8192, R, C); const int Rb = Epi::PERM ? ((R & ~31) + perm32(R & 31)) : R;
        voffA[i] = (unsigned)(R * g.ld + C) * 2u; voffB[i] = (unsigned)(Rb * g.ld + C) * 2u; }
    const size_t kstep = (size_t)(BK * 2);
    const size_t hstep = (size_t)HALF * g.ld * 2;
    const size_t tstep = 2 * hstep;
    const size_t tstepA = STRIP ? (size_t)288 * g.ld * 2 : tstep;
    unsigned voffS = 0u; if constexpr (STRIP) { int R, C; stage_rc((wid & 3) * 1024 + lane * 16, R, C); voffS = (unsigned)(R * g.ld + C) * 2u; }
    const int soff = lds_byte(wr * 16 + fr, fq * 8);
    const unsigned ldsw = (unsigned)wid * 1024u;
    const int aoff = lds_byte(wr * 64 + fr, fq * 8), boff = lds_byte(wc * 32 + fr, fq * 8);
#define PG8_SA(b, h) (((b) * 2 + (h)) * HTB)
#define PG8_SB(b, h) ((4 + (b) * 2 + (h)) * HTB)
#define PG8_SS(b) (8 * HTB + (b) * 8192)
#define PG8_STAGE_S(b, gbase) do { if constexpr (STRIP) __builtin_amdgcn_global_load_lds((const unsigned*)((const char*)(gbase) + 2 * hstep + voffS), (PG8_LAS unsigned*)(lds + PG8_SS(b) + ldsw), 16, 0, 0); } while (0)
#define PG8_LDS(b) do { if constexpr (STRIP) { _Pragma("unroll") for (int k = 0; k < 2; ++k) Sf[k] = *(const PG8_LAS bf16x8*)(lds + PG8_SS(b) + soff + k * 1024); } } while (0)
#define PG8_MMS(bj, Bt) do { if constexpr (STRIP) { _Pragma("unroll") for (int n = 0; n < 2; ++n) _Pragma("unroll") for (int k = 0; k < 2; ++k) accS[bj][n] = __builtin_amdgcn_mfma_f32_16x16x32_bf16(Bt[n][k], Sf[k], accS[bj][n], 0, 0, 0); } } while (0)
#define PG8_STAGE(bufoff, gbase, voff) do { _Pragma("unroll") for (int _i = 0; _i < 2; ++_i) \
        __builtin_amdgcn_global_load_lds((const unsigned*)((const char*)(gbase) + (voff)[_i]), (PG8_LAS unsigned*)(lds + (bufoff) + ldsw + _i * 8192), 16, 0, 0); } while (0)
#define PG8_LDA(dst, b, h) do { _Pragma("unroll") for (int m = 0; m < 4; ++m) _Pragma("unroll") for (int k = 0; k < 2; ++k) dst[m][k] = *(const PG8_LAS bf16x8*)(lds + PG8_SA(b, h) + aoff + m * 2048 + k * 1024); } while (0)
#define PG8_LDB(dst, b, h) do { _Pragma("unroll") for (int n = 0; n < 2; ++n) _Pragma("unroll") for (int k = 0; k < 2; ++k) dst[n][k] = *(const PG8_LAS bf16x8*)(lds + PG8_SB(b, h) + boff + n * 2048 + k * 1024); } while (0)
#define PG8_MMA(ai, bj, At, Bt) do { __builtin_amdgcn_s_setprio(1); _Pragma("unroll") for (int m = 0; m < 4; ++m) _Pragma("unroll") for (int n = 0; n < 2; ++n) _Pragma("unroll") for (int k = 0; k < 2; ++k) \
        acc[ai][bj][m][n] = __builtin_amdgcn_mfma_f32_16x16x32_bf16(Bt[n][k], At[m][k], acc[ai][bj][m][n], 0, 0, 0); __builtin_amdgcn_s_setprio(0); } while (0)
#define PG8_WAIT_V(n) asm volatile("s_waitcnt vmcnt(" #n ")" ::: "memory")
#define PG8_WAIT_L(n) asm volatile("s_waitcnt lgkmcnt(" #n ")" ::: "memory")
#define PG8_WAIT_VS(n, ns) do { if constexpr (STRIP) PG8_WAIT_V(ns); else PG8_WAIT_V(n); } while (0)
#define PG8_WAIT_LS(n, ns) do { if constexpr (STRIP) PG8_WAIT_L(ns); else PG8_WAIT_L(n); } while (0)
#define PG8_BAR __builtin_amdgcn_s_barrier()
#define PG8_SCHED __builtin_amdgcn_sched_barrier(0)
    Unit cur, nxt; int ui = 0;
    if (!S.next(0, cur)) return;
    f32x4 acc[2][2][4][2];
#pragma unroll
    for (int a = 0; a < 2; ++a)
#pragma unroll
        for (int b = 0; b < 2; ++b)
#pragma unroll
            for (int m = 0; m < 4; ++m)
#pragma unroll
                for (int n = 0; n < 2; ++n) acc[a][b][m][n] = (f32x4){0.f, 0.f, 0.f, 0.f};
    bf16x8 At[4][2], B0[2][2], B1[2][2];
    f32x4 accS[2][2]; bf16x8 Sf[2];
#pragma unroll
    for (int b = 0; b < 2; ++b)
#pragma unroll
        for (int n = 0; n < 2; ++n) accS[b][n] = (f32x4){0.f, 0.f, 0.f, 0.f};
#pragma unroll
    for (int k = 0; k < 2; ++k) Sf[k] = (bf16x8){0, 0, 0, 0, 0, 0, 0, 0};
    const char* cA = (const char*)g.A + (size_t)cur.pm * tstepA; const char* cB = (const char*)g.Bt + (size_t)cur.pn * tstep;
    S.a_ready(cur);
    PG8_STAGE(PG8_SB(0, 0), cB, voffB); PG8_STAGE(PG8_SA(0, 0), cA, voffA); PG8_STAGE(PG8_SB(0, 1), cB + hstep, voffB); PG8_STAGE(PG8_SA(0, 1), cA + hstep, voffA); PG8_STAGE_S(0, cA);
    if (wr == 1) PG8_BAR;
    PG8_WAIT_VS(4, 5); PG8_BAR;
    PG8_STAGE(PG8_SB(1, 0), cB + kstep, voffB); PG8_STAGE(PG8_SA(1, 0), cA + kstep, voffA); PG8_STAGE(PG8_SB(1, 1), cB + hstep + kstep, voffB); PG8_STAGE_S(1, cA + kstep);
    PG8_WAIT_VS(6, 7); PG8_BAR;
    PG8_STAMP();
    for (;;) {
        const bool has_next = S.next(ui + 1, nxt);
        const char* nA = has_next ? (const char*)g.A + (size_t)nxt.pm * tstepA : cA; const char* nB = has_next ? (const char*)g.Bt + (size_t)nxt.pn * tstep : cB;
        for (int t = 0; t < nt; t += 2) {
            const bool last = (t == nt - 2);
            const char* a1 = cA + (size_t)(t + 1) * kstep;
            const char* a2 = last ? nA : cA + (size_t)(t + 2) * kstep; const char* b2 = last ? nB : cB + (size_t)(t + 2) * kstep;
            const char* a3 = a2 + kstep; const char* b3 = b2 + kstep;
            if (last && has_next) S.a_ready(nxt);
            PG8_LDB(B0, 0, 0); PG8_SCHED; PG8_LDA(At, 0, 0); PG8_LDS(0); PG8_STAGE(PG8_SA(1, 1), a1 + hstep, voffA);
            PG8_WAIT_LS(8, 10); PG8_BAR; PG8_WAIT_L(0); PG8_MMA(0, 0, At, B0); PG8_MMS(0, B0); PG8_BAR; PG8_SCHED;
            PG8_LDB(B1, 0, 1); PG8_STAGE(PG8_SB(0, 0), b2, voffB);
            PG8_BAR; PG8_WAIT_L(0); PG8_MMA(0, 1, At, B1); PG8_MMS(1, B1); PG8_BAR;
            PG8_LDA(At, 0, 1); PG8_STAGE(PG8_SA(0, 0), a2, voffA); PG8_STAGE_S(0, a2);
            PG8_BAR; PG8_WAIT_L(0); PG8_MMA(1, 0, At, B0); PG8_BAR; PG8_SCHED;
            PG8_STAGE(PG8_SB(0, 1), b2 + hstep, voffB);
            PG8_WAIT_VS(6, 7); PG8_BAR; PG8_MMA(1, 1, At, B1); PG8_BAR;
            PG8_LDB(B0, 1, 0); PG8_SCHED; PG8_LDA(At, 1, 0); PG8_LDS(1); PG8_STAGE(PG8_SA(0, 1), a2 + hstep, voffA);
            PG8_WAIT_LS(8, 10); PG8_BAR; PG8_WAIT_L(0); PG8_MMA(0, 0, At, B0); PG8_MMS(0, B0); PG8_BAR; PG8_SCHED;
            PG8_LDB(B1, 1, 1); PG8_STAGE(PG8_SB(1, 0), b3, voffB);
            PG8_BAR; PG8_WAIT_L(0); PG8_MMA(0, 1, At, B1); PG8_MMS(1, B1); PG8_BAR;
            PG8_LDA(At, 1, 1); PG8_STAGE(PG8_SA(1, 0), a3, voffA); PG8_STAGE_S(1, a3);
            PG8_BAR; PG8_WAIT_L(0); PG8_MMA(1, 0, At, B0); PG8_BAR; PG8_SCHED;
            PG8_STAGE(PG8_SB(1, 1), b3 + hstep, voffB);
            PG8_WAIT_VS(6, 7); PG8_BAR; PG8_MMA(1, 1, At, B1); PG8_BAR;
        }
        PG8_STAMP();
        { const int rt0 = cur.pm * (STRIP ? 288 : 256), rw0 = rt0 + wr * 64 + fr;
#define PG8_RV(ai, m) {{acc[ai][0][m][0], acc[ai][0][m][1]}, {acc[ai][1][m][0], acc[ai][1][m][1]}}
#define PG8_BATCH(r0_, v0_, r1_, v1_) do { const typename Epi::Pre p0_ = E.pre(r0_, cur.pn, wc, fq), p1_ = E.pre(r1_, cur.pn, wc, fq); \
              { const f32x4 v_[2][2] = v0_; E.row(v_, p0_, r0_, cur.pn, wc, fq); } { const f32x4 v_[2][2] = v1_; E.row(v_, p1_, r1_, cur.pn, wc, fq); } } while (0)
          if constexpr (Epi::PRE_ALL) {
              typename Epi::Pre pa_[9];
#pragma unroll
              for (int q_ = 0; q_ < 8; ++q_) pa_[q_] = E.pre(rw0 + (q_ >> 2) * HALF + (q_ & 3) * 16, cur.pn, wc, fq);
              pa_[8] = STRIP ? E.pre(rt0 + 256 + wr * 16 + fr, cur.pn, wc, fq) : pa_[0];
#define PG8_ONE(q_, ai, m) { const f32x4 v_[2][2] = PG8_RV(ai, m); E.row(v_, pa_[q_], rw0 + ai * HALF + m * 16, cur.pn, wc, fq); }
              PG8_ONE(0, 0, 0) PG8_ONE(1, 0, 1) PG8_ONE(2, 0, 2) PG8_ONE(3, 0, 3) PG8_ONE(4, 1, 0) PG8_ONE(5, 1, 1) PG8_ONE(6, 1, 2) PG8_ONE(7, 1, 3)
#undef PG8_ONE
              if constexpr (STRIP) E.row(accS, pa_[8], rt0 + 256 + wr * 16 + fr, cur.pn, wc, fq);
#if defined(PROBE_EPI2)
              asm volatile("" ::: "memory");
#pragma unroll
              for (int q_ = 0; q_ < 8; ++q_) pa_[q_] = E.pre(rw0 + (q_ >> 2) * HALF + (q_ & 3) * 16, cur.pn, wc, fq);
              pa_[8] = STRIP ? E.pre(rt0 + 256 + wr * 16 + fr, cur.pn, wc, fq) : pa_[0];
#define PG8_ONE(q_, ai, m) { const f32x4 v_[2][2] = PG8_RV(ai, m); E.row(v_, pa_[q_], rw0 + ai * HALF + m * 16, cur.pn, wc, fq); }
              PG8_ONE(0, 0, 0) PG8_ONE(1, 0, 1) PG8_ONE(2, 0, 2) PG8_ONE(3, 0, 3) PG8_ONE(4, 1, 0) PG8_ONE(5, 1, 1) PG8_ONE(6, 1, 2) PG8_ONE(7, 1, 3)
#undef PG8_ONE
              if constexpr (STRIP) E.row(accS, pa_[8], rt0 + 256 + wr * 16 + fr, cur.pn, wc, fq);
#endif
          } else {
          PG8_BATCH(rw0, PG8_RV(0, 0), rw0 + 16, PG8_RV(0, 1));
          PG8_BATCH(rw0 + 32, PG8_RV(0, 2), rw0 + 48, PG8_RV(0, 3));
          PG8_BATCH(rw0 + HALF, PG8_RV(1, 0), rw0 + HALF + 16, PG8_RV(1, 1));
          PG8_BATCH(rw0 + HALF + 32, PG8_RV(1, 2), rw0 + HALF + 48, PG8_RV(1, 3));
          if constexpr (STRIP) { const int rs_ = rt0 + 256 + wr * 16 + fr; const typename Epi::Pre ps_ = E.pre(rs_, cur.pn, wc, fq); E.row(accS, ps_, rs_, cur.pn, wc, fq); }
          }
          if constexpr (STRIP) {
#pragma unroll
              for (int b = 0; b < 2; ++b)
#pragma unroll
                for (int n = 0; n < 2; ++n) accS[b][n] = (f32x4){0.f, 0.f, 0.f, 0.f}; }
#undef PG8_BATCH
#undef PG8_RV
          S.done(cur); }
        PG8_STAMP();
        if (!has_next) break;
#pragma unroll
        for (int a = 0; a < 2; ++a)
#pragma unroll
            for (int b = 0; b < 2; ++b)
#pragma unroll
                for (int m = 0; m < 4; ++m)
#pragma unroll
                    for (int n = 0; n < 2; ++n) acc[a][b][m][n] = (f32x4){0.f, 0.f, 0.f, 0.f};
        cur = nxt; cA = nA; cB = nB; ++ui;
    }
    PG8_WAIT_V(0);
    if (wr == 0) PG8_BAR;
    PG8_BAR;
    PG8_STAMP();
    if (STAMP && wid == 0) { stamps[lane] = lane < nts ? (((unsigned long long)(unsigned)ts_hi << 32) | (unsigned)ts_lo) : 0ull;
        if (lane == 62) stamps[62] = rt_entry; if (lane == 63) stamps[63] = (unsigned long long)wall_clock64(); }
#undef PG8_STAMP
#undef PG8_SA
#undef PG8_SB
#undef PG8_STAGE
#undef PG8_LDA
#undef PG8_LDB
#undef PG8_MMA
#undef PG8_WAIT_V
#undef PG8_WAIT_L
#undef PG8_BAR
#undef PG8_SCHED
#undef PG8_WAIT_LS
#undef PG8_WAIT_VS
#undef PG8_MMS
#undef PG8_LDS
#undef PG8_STAGE_S
#undef PG8_SS
}
}


#define LAS __attribute__((address_space(3)))
#define XB_TMO      128
#define XB_XCNT(j)  (256  + 64 * (j))
#define XB_XSUB(j)  (1280 + 64 * (j))
#define XB_XGEN(j)  (2304 + 64 * (j))
#define XB_TOP      3328
#define XB_TOPGEN   3392
#define XCD_BAR_WORDS 3456
#define XB_SPIN_CAP (1u << 18)

__device__ __forceinline__ unsigned xb_ld(unsigned* p)              { return __hip_atomic_load(p, __ATOMIC_RELAXED, __HIP_MEMORY_SCOPE_AGENT); }
__device__ __forceinline__ unsigned xb_add(unsigned* p, unsigned v) { return __hip_atomic_fetch_add(p, v, __ATOMIC_RELAXED, __HIP_MEMORY_SCOPE_AGENT); }
__device__ __forceinline__ unsigned xb_xcc_id() { return (unsigned)__builtin_amdgcn_s_getreg((3 << 11) | 20) & 0xFu; }
#define XB_SPIN(cond, bar) do { unsigned _sp = 0; while (cond) { __builtin_amdgcn_s_sleep(1); \
    if ((++_sp & 255u) == 0u) { if (xb_ld(&(bar)[XB_TMO])) break; if (_sp > XB_SPIN_CAP) { atomicAdd(&(bar)[XB_TMO], 1u); break; } } } } while (0)

struct XcdBarrier {
    unsigned* bar; unsigned x;
    volatile LAS unsigned* st;
};

__device__ __forceinline__ XcdBarrier xcd_barrier_post(unsigned* bar, volatile LAS unsigned* st) {
    XcdBarrier b; b.bar = bar; b.x = xb_xcc_id(); b.st = st;
    if (threadIdx.x == 0) (void)xb_add(&bar[XB_XCNT(b.x)], 1u);
    return b;
}
__device__ __forceinline__ void xcd_barrier_complete(unsigned* bar, unsigned x, unsigned& nloc, unsigned& nx) {
    const unsigned G = gridDim.x * gridDim.y * gridDim.z;
    unsigned sum, cnt, mine, sp = 0u;
    for (;;) {
        sum = 0u; cnt = 0u; mine = 0u;
#pragma unroll
        for (unsigned j = 0; j < 16; ++j) { const unsigned c = xb_ld(&bar[XB_XCNT(j)]); sum += c; cnt += (c > 0u) ? 1u : 0u; mine = (j == x) ? c : mine; }
        if (sum == G) break;
        __builtin_amdgcn_s_sleep(1);
        if ((++sp & 255u) == 0u) { if (xb_ld(&bar[XB_TMO])) break; if (sp > XB_SPIN_CAP) { atomicAdd(&bar[XB_TMO], 1u); break; } }
    }
    nloc = mine > 0u ? mine : 1u; nx = cnt > 0u ? cnt : 1u;
}

__device__ __forceinline__ void xcd_barrier(const XcdBarrier& b) {
    asm volatile("s_waitcnt vmcnt(0)" ::: "memory");
    __syncthreads();
    if (threadIdx.x == 0) {
        unsigned* bar = b.bar;
        __builtin_amdgcn_s_waitcnt(0);
        unsigned nloc = b.st[0], nx = b.st[1];
        if (nloc == 0u) { xcd_barrier_complete(bar, b.x, nloc, nx); b.st[0] = nloc; b.st[1] = nx; }
        const unsigned old = xb_add(&bar[XB_XSUB(b.x)], 1u);
        const unsigned gen = old / nloc;
        if (old + 1u == (gen + 1u) * nloc) {
            __builtin_amdgcn_fence(__ATOMIC_RELEASE, "agent");
            asm volatile("s_waitcnt vmcnt(0)" ::: "memory");
            const unsigned og = xb_add(&bar[XB_TOP], 1u);
            const unsigned tg = og / nx;
            if (og + 1u == (tg + 1u) * nx) xb_add(&bar[XB_TOPGEN], 1u);
            else XB_SPIN(xb_ld(&bar[XB_TOPGEN]) == tg, bar);
            __builtin_amdgcn_fence(__ATOMIC_ACQUIRE, "agent");
            xb_add(&bar[XB_XGEN(b.x)], 1u);
            asm volatile("s_waitcnt vmcnt(0)" ::: "memory");
        } else {
            XB_SPIN(xb_ld(&bar[XB_XGEN(b.x)]) == gen, bar);
            __builtin_amdgcn_fence(__ATOMIC_ACQUIRE, "agent");
            asm volatile("s_waitcnt vmcnt(0)" ::: "memory");
        }
    }
    __syncthreads();
}

typedef CfgT<RC> C;
constexpr int NTHREADS = 512, NWAVES = 8;
constexpr int LDS_STAGE = 131072 + 16384 + 8192, LDS_CTL = LDS_STAGE, LDS_BYTES = LDS_STAGE + 256;

namespace pg8 {
typedef unsigned u32x2 __attribute__((ext_vector_type(2)));
__device__ __forceinline__ float silu_f(float g) { return g * __builtin_amdgcn_rcpf(1.0f + __expf(-g)); }
struct EpiSwiGLU { static constexpr bool PERM = true, PRE_ALL = true;
    bf16_t* act; const float* ss; int ff; float invd;
    typedef float Pre;
    __device__ __forceinline__ Pre pre(int row, int pn, int wc, int fq) const { return ss[row]; }
    __device__ __forceinline__ void row(const f32x4 (&v)[2][2], Pre ssr, int row, int pn, int wc, int fq) const {
        const float rs = rsqrtf(ssr * invd + 1e-6f); f32x4 o[2];
#pragma unroll
        for (int n = 0; n < 2; ++n) { const f32x4 g = v[0][n] * rs, up = v[1][n] * rs;
#pragma unroll
            for (int j = 0; j < 4; ++j) o[n][j] = silu_f(g[j]) * up[j]; }
        u32x4 w; w.x = cvt_pk_bf16(o[0][0], o[0][1]); w.y = cvt_pk_bf16(o[0][2], o[0][3]); w.z = cvt_pk_bf16(o[1][0], o[1][1]); w.w = cvt_pk_bf16(o[1][2], o[1][3]);
        *(u32x4*)(act + (size_t)row * ff + pn * 128 + wc * 32 + 8 * fq) = w;
    }
};
struct EpiResid { static constexpr bool PERM = false, PRE_ALL = false;
    float* X; bf16_t* XB; float* ssout; float scale; int ld;
    struct Pre { f32x4 x[2][2]; };
    __device__ __forceinline__ Pre pre(int row, int pn, int wc, int fq) const { Pre q; const float* xr = X + (size_t)row * ld + pn * BM + wc * 32 + 4 * fq;
#pragma unroll
        for (int bj = 0; bj < 2; ++bj)
#pragma unroll
            for (int n = 0; n < 2; ++n) q.x[bj][n] = *(const f32x4*)(xr + bj * HALF + n * 16);
        return q; }
    __device__ __forceinline__ void row(const f32x4 (&v)[2][2], const Pre& q, int row, int pn, int wc, int fq) const {
        const int col0 = pn * BM + wc * 32 + 4 * fq; float* xr = X + (size_t)row * ld + col0; bf16_t* br = XB + (size_t)row * ld + col0; float s = 0.f;
#pragma unroll
        for (int bj = 0; bj < 2; ++bj)
#pragma unroll
            for (int n = 0; n < 2; ++n) { const f32x4 x = q.x[bj][n] + v[bj][n] * scale; *(f32x4*)(xr + bj * HALF + n * 16) = x;
                u32x2 w; w.x = cvt_pk_bf16(x[0], x[1]); w.y = cvt_pk_bf16(x[2], x[3]); *(u32x2*)(br + bj * HALF + n * 16) = w;
                s += (x[0] * x[0] + x[1] * x[1]) + (x[2] * x[2] + x[3] * x[3]); }
        s += __shfl_xor(s, 16); s += __shfl_xor(s, 32);
        if (fq == 0) unsafeAtomicAdd(ssout + row, s);
    }
};
struct EpiScaleF32 { static constexpr bool PERM = false, PRE_ALL = true;
    float* Cp; int ldc; const float* ss; float invd;
    typedef float Pre;
    __device__ __forceinline__ Pre pre(int row, int pn, int wc, int fq) const { return ss[row]; }
    __device__ __forceinline__ void row(const f32x4 (&v)[2][2], Pre ssr, int row, int pn, int wc, int fq) const {
        const float rs = rsqrtf(ssr * invd + 1e-6f); float* cr = Cp + (size_t)row * ldc + pn * BM + wc * 32 + 4 * fq;
#pragma unroll
        for (int bj = 0; bj < 2; ++bj)
#pragma unroll
            for (int n = 0; n < 2; ++n) *(f32x4*)(cr + bj * HALF + n * 16) = v[bj][n] * rs;
    }
};
struct EpiScaleBf16 { static constexpr bool PERM = true, PRE_ALL = true;
    bf16_t* O; int ldc; const float* ss; float invd;
    typedef float Pre;
    __device__ __forceinline__ Pre pre(int row, int pn, int wc, int fq) const { return ss[row]; }
    __device__ __forceinline__ void row(const f32x4 (&v)[2][2], Pre ssr, int row, int pn, int wc, int fq) const {
        const float rs = rsqrtf(ssr * invd + 1e-6f); bf16_t* orow = O + (size_t)row * ldc + pn * BM + wc * 32 + 8 * fq;
#pragma unroll
        for (int bj = 0; bj < 2; ++bj) { const f32x4 v0 = v[bj][0] * rs, v1 = v[bj][1] * rs;
            u32x4 w; w.x = cvt_pk_bf16(v0[0], v0[1]); w.y = cvt_pk_bf16(v0[2], v0[3]); w.z = cvt_pk_bf16(v1[0], v1[1]); w.w = cvt_pk_bf16(v1[2], v1[3]);
            *(u32x4*)(orow + bj * HALF) = w; }
    }
};
struct EpiMemKV { static constexpr bool PERM = false, PRE_ALL = true;
    float* K; float* V; const float* rstd; int d;
    typedef float Pre;
    __device__ __forceinline__ Pre pre(int row, int pn, int wc, int fq) const { return rstd[row]; }
    __device__ __forceinline__ void row(const f32x4 (&v)[2][2], Pre rs, int row, int pn, int wc, int fq) const {
        int ct = pn * BM; float* base = K; if (ct >= d) { base = V; ct -= d; } float* cr = base + (size_t)row * d + ct + wc * 32 + 4 * fq;
#pragma unroll
        for (int bj = 0; bj < 2; ++bj)
#pragma unroll
            for (int n = 0; n < 2; ++n) *(f32x4*)(cr + bj * HALF + n * 16) = v[bj][n] * rs;
    }
};
}

__device__ __forceinline__ void prep_item(const float* W, int K, int Ncols, const float* g, int kind, int N, bf16_t* Bt, LAS unsigned char* scr, int item, int lane) {
    const int nblk = N / 64, kb = item / nblk, nb = item % nblk, k0 = 64 * kb, n = 64 * nb + lane;
    const int sc = wsrc_col<C>(kind, n);
    const float* src = W + (size_t)k0 * Ncols + (sc >= 0 ? sc : 0);
    float v[64];
#pragma unroll
    for (int kk = 0; kk < 64; ++kk) v[kk] = src[(size_t)kk * Ncols];
    if (g) {
#pragma unroll
        for (int kk = 0; kk < 64; ++kk) v[kk] *= g[k0 + kk];
    }
    if (sc < 0) {
#pragma unroll
        for (int kk = 0; kk < 64; ++kk) v[kk] = 0.f;
    }
#pragma unroll
    for (int j = 0; j < 8; ++j) { pg8::u32x4 o; o.x = pg8::cvt_pk_bf16(v[8 * j], v[8 * j + 1]); o.y = pg8::cvt_pk_bf16(v[8 * j + 2], v[8 * j + 3]); o.z = pg8::cvt_pk_bf16(v[8 * j + 4], v[8 * j + 5]); o.w = pg8::cvt_pk_bf16(v[8 * j + 6], v[8 * j + 7]);
        *(LAS pg8::u32x4*)(scr + lane * 144 + j * 16) = o; }
    asm volatile("s_waitcnt lgkmcnt(0)" ::: "memory");
    bf16_t* dst = Bt + (size_t)(64 * nb) * K + k0 + (lane & 7) * 8;
#pragma unroll
    for (int it = 0; it < 8; ++it) { const int row = it * 8 + (lane >> 3); const pg8::u32x4 o = *(const LAS pg8::u32x4*)(scr + row * 144 + (lane & 7) * 16);
        *(pg8::u32x4*)(dst + (size_t)row * K) = o; }
    asm volatile("s_waitcnt lgkmcnt(0)" ::: "memory");
}
struct WDesc { const float* W; const float* g; bf16_t* dst; int K, Ncols, kind, N; };
__device__ __forceinline__ WDesc wdesc(const Ptrs& p, int l, int idx) {
    WDesc d; d.g = nullptr; d.kind = WK_PLAIN;
    switch (idx) {
    case 0: d.W = p.in[I_W1IN] + (size_t)l * C::D * 2 * C::FF; d.K = C::D; d.Ncols = 2 * C::FF; d.N = 2 * C::FF; d.g = p.in[I_GFFN1] + l * C::D; d.kind = WK_FFNIN; d.dst = wlayer<C>(p, l, C::W_1IN); break;
    case 1: d.W = p.in[I_W1OUT] + (size_t)l * C::FF * C::D; d.K = C::FF; d.Ncols = C::D; d.N = C::D; d.dst = wlayer<C>(p, l, C::W_1OUT); break;
    case 2: d.W = p.in[I_WIN] + (size_t)l * C::D * C::INC; d.K = C::D; d.Ncols = C::INC; d.N = C::LDP; d.g = p.in[I_GMIX] + l * C::D; d.kind = WK_WIN; d.dst = wlayer<C>(p, l, C::W_IN); break;
    case 3: d.W = p.in[I_WOUT] + (size_t)l * C::D * C::D; d.K = C::D; d.Ncols = C::D; d.N = C::D; d.dst = wlayer<C>(p, l, C::W_OUT); break;
    case 4: d.W = p.in[I_WQ] + (size_t)l * C::D * C::D; d.K = C::D; d.Ncols = C::D; d.N = C::D; d.g = p.in[I_GX] + l * C::D; d.dst = wlayer<C>(p, l, C::W_Q); break;
    case 5: d.W = p.in[I_WK] + (size_t)l * C::D * C::D; d.K = C::D; d.Ncols = C::D; d.N = C::D; d.g = p.in[I_GMEM] + l * C::D; d.dst = wlayer<C>(p, l, C::W_KV); break;
    case 6: d.W = p.in[I_WV] + (size_t)l * C::D * C::D; d.K = C::D; d.Ncols = C::D; d.N = C::D; d.g = p.in[I_GMEM] + l * C::D; d.dst = wlayer<C>(p, l, C::W_KV) + (size_t)C::D * C::D; break;
    case 7: d.W = p.in[I_WO] + (size_t)l * C::D * C::D; d.K = C::D; d.Ncols = C::D; d.N = C::D; d.dst = wlayer<C>(p, l, C::W_O); break;
    case 8: d.W = p.in[I_W2IN] + (size_t)l * C::D * 2 * C::FF; d.K = C::D; d.Ncols = 2 * C::FF; d.N = 2 * C::FF; d.g = p.in[I_GFFN2] + l * C::D; d.kind = WK_FFNIN; d.dst = wlayer<C>(p, l, C::W_2IN); break;
    default: d.W = p.in[I_W2OUT] + (size_t)l * C::FF * C::D; d.K = C::FF; d.Ncols = C::D; d.N = C::D; d.dst = wlayer<C>(p, l, C::W_2OUT); break;
    }
    return d;
}

#define WG_SYNC() do { asm volatile("s_waitcnt lgkmcnt(0)" ::: "memory"); __builtin_amdgcn_s_barrier(); asm volatile("" ::: "memory"); } while (0)
namespace att {
typedef short bf16x8 __attribute__((ext_vector_type(8)));
typedef short s16x4 __attribute__((ext_vector_type(4)));
typedef float f32x4 __attribute__((ext_vector_type(4)));
typedef unsigned u32x2 __attribute__((ext_vector_type(2)));
constexpr int TOK = 256, CD = 64, PITCH = 144, CBYTES = TOK * PITCH, HDIM = 512, NH = 4, LD = 2048;
static_assert(C::NMEM == TOK && C::AHD == HDIM && C::AH == NH && C::D == LD && C::DEC_SEQ == 32 && C::SEQ % 256 == 0, "attention phase is built for these shapes");
__device__ __forceinline__ s16x4 tr_read(unsigned addr) { s16x4 r; asm volatile("ds_read_b64_tr_b16 %0, %1" : "=&v"(r) : "v"(addr) : "memory"); return r; }
__device__ __forceinline__ void stage_load(f32x4 (&r)[8], const float* src, int tid) {
    const unsigned off0 = (unsigned)(((tid >> 4) * LD + (tid & 15) * 4) * 4);
#pragma unroll
    for (int i = 0; i < 8; ++i) r[i] = *(const f32x4*)((const char*)src + (off0 + (unsigned)(i * 32 * LD * 4)));
    __builtin_amdgcn_sched_barrier(0);
}
__device__ __forceinline__ void stage_store(const f32x4 (&r)[8], LAS unsigned char* buf, int tid) {
#pragma unroll
    for (int i = 0; i < 8; ++i) { const int f = tid + 512 * i; u32x2 w; w.x = pg8::cvt_pk_bf16(r[i][0], r[i][1]); w.y = pg8::cvt_pk_bf16(r[i][2], r[i][3]);
        *(LAS u32x2*)(buf + (f >> 4) * PITCH + (f & 15) * 8) = w; }
}
__device__ __forceinline__ void attn_phase(LAS unsigned char* lds, const Ptrs& p, int l, int tid, int bid, int gsz) {
    const int lane = tid & 63, wave = __builtin_amdgcn_readfirstlane(tid >> 6), li = lane & 15, g = lane >> 4;
    const bf16_t* Qg = wsb<C>(p, C::WS_Q); bf16_t* AO = wsb<C>(p, C::WS_AO);
    constexpr int NUP = (C::MP / 256) * NH, NUS = C::DEC_BATCH * NH;
    static_assert(C::SEQ % 256 == 0, "prompt units are 256 rows");
    for (int un = bid; un < NUP + NUS; un += gsz) {
        int row0, nrows, head; const float* kb; const float* vb;
        if (un < NUP) { const int per_b = (C::SEQ / 256) * NH, b = un / per_b, rem = un % per_b; head = rem / (C::SEQ / 256); row0 = b * C::SEQ + (rem % (C::SEQ / 256)) * 256; nrows = 256;
            kb = p.out + C::OUT_MK + ((size_t)l * C::BATCH + b) * TOK * LD + head * HDIM; vb = p.out + C::OUT_MV + ((size_t)l * C::BATCH + b) * TOK * LD + head * HDIM; }
        else { const int s = un - NUP, b = s / NH; head = s % NH; row0 = C::MP + b * C::DEC_SEQ; nrows = C::DEC_SEQ;
            kb = p.in[I_CK] + ((size_t)l * C::DEC_BATCH + b) * TOK * LD + head * HDIM; vb = p.in[I_CV] + ((size_t)l * C::DEC_BATCH + b) * TOK * LD + head * HDIM; }
        const bool active = wave * 32 < nrows;
        const bf16_t* q0 = Qg + (size_t)(row0 + wave * 32 + li) * LD + head * HDIM + g * 8;
        f32x4 s[2][16];
#pragma unroll
        for (int u = 0; u < 2; ++u)
#pragma unroll
            for (int T = 0; T < 16; ++T) s[u][T] = (f32x4){0.f, 0.f, 0.f, 0.f};
        f32x4 pre[8]; bf16x8 qf[2][2];
        stage_load(pre, kb, tid); stage_store(pre, lds, tid);
#pragma unroll
        for (int u = 0; u < 2; ++u)
#pragma unroll
            for (int ks = 0; ks < 2; ++ks) qf[u][ks] = active ? *(const bf16x8*)(q0 + (size_t)u * 16 * LD + ks * 32) : (bf16x8){0, 0, 0, 0, 0, 0, 0, 0};
        WG_SYNC();
        for (int c = 0; c < 8; ++c) {
            LAS unsigned char* buf = lds + (c & 1) * CBYTES;
            stage_load(pre, c < 7 ? kb + (c + 1) * CD : vb, tid);
            if (active) {
#pragma unroll
                for (int ks = 0; ks < 2; ++ks)
#pragma unroll
                    for (int T = 0; T < 16; ++T) { const bf16x8 a = *(const LAS bf16x8*)(buf + (T * 16 + li) * PITCH + ks * 64 + g * 16);
                        s[0][T] = __builtin_amdgcn_mfma_f32_16x16x32_bf16(a, qf[0][ks], s[0][T], 0, 0, 0);
                        s[1][T] = __builtin_amdgcn_mfma_f32_16x16x32_bf16(a, qf[1][ks], s[1][T], 0, 0, 0); }
            }
            if (active && c < 7) {
                __builtin_amdgcn_sched_barrier(0);
#pragma unroll
                for (int u = 0; u < 2; ++u)
#pragma unroll
                    for (int ks = 0; ks < 2; ++ks) qf[u][ks] = *(const bf16x8*)(q0 + (size_t)u * 16 * LD + (c + 1) * CD + ks * 32);
                __builtin_amdgcn_sched_barrier(0); }
            stage_store(pre, lds + ((c + 1) & 1) * CBYTES, tid);
            WG_SYNC();
        }
        const float sc = 0.044194173824159216f * 1.4426950408889634f;
        float inv[2]; bf16x8 pf[2][8];
#pragma unroll
        for (int u = 0; u < 2; ++u) {
            float mx = -3.0e38f;
#pragma unroll
            for (int T = 0; T < 16; ++T) mx = fmaxf(mx, fmaxf(fmaxf(s[u][T][0], s[u][T][1]), fmaxf(s[u][T][2], s[u][T][3])));
            mx = fmaxf(mx, __shfl_xor(mx, 16)); mx = fmaxf(mx, __shfl_xor(mx, 32));
            float sum = 0.f;
#pragma unroll
            for (int T = 0; T < 16; ++T)
#pragma unroll
                for (int j = 0; j < 4; ++j) { const float e = __builtin_amdgcn_exp2f((s[u][T][j] - mx) * sc); s[u][T][j] = e; sum += e; }
            sum += __shfl_xor(sum, 16); sum += __shfl_xor(sum, 32);
            inv[u] = 1.0f / sum;
#pragma unroll
            for (int t = 0; t < 8; ++t) { pg8::u32x4 w; w.x = pg8::cvt_pk_bf16(s[u][2 * t][0], s[u][2 * t][1]); w.y = pg8::cvt_pk_bf16(s[u][2 * t][2], s[u][2 * t][3]);
                w.z = pg8::cvt_pk_bf16(s[u][2 * t + 1][0], s[u][2 * t + 1][1]); w.w = pg8::cvt_pk_bf16(s[u][2 * t + 1][2], s[u][2 * t + 1][3]); pf[u][t] = __builtin_bit_cast(bf16x8, w); }
        }
        const unsigned trb = (unsigned)(size_t)lds + (unsigned)((4 * g + (li >> 2)) * PITCH + (li & 3) * 8);
        for (int c = 0; c < 8; ++c) {
            const unsigned bofs = (unsigned)(c & 1) * CBYTES;
            if (c < 7) stage_load(pre, vb + (c + 1) * CD, tid);
            if (active) {
                f32x4 o[2][4];
#pragma unroll
                for (int u = 0; u < 2; ++u)
#pragma unroll
                    for (int dt = 0; dt < 4; ++dt) o[u][dt] = (f32x4){0.f, 0.f, 0.f, 0.f};
#pragma unroll
                for (int t = 0; t < 8; ++t) {
                    s16x4 lo[4], hi[4];
#pragma unroll
                    for (int dt = 0; dt < 4; ++dt) { lo[dt] = tr_read(trb + bofs + (unsigned)(t * 32 * PITCH + dt * 32)); hi[dt] = tr_read(trb + bofs + (unsigned)(t * 32 * PITCH + 16 * PITCH + dt * 32)); }
                    asm volatile("s_waitcnt lgkmcnt(0)" ::: "memory"); __builtin_amdgcn_sched_barrier(0);
#pragma unroll
                    for (int dt = 0; dt < 4; ++dt) { const bf16x8 a = (bf16x8){lo[dt][0], lo[dt][1], lo[dt][2], lo[dt][3], hi[dt][0], hi[dt][1], hi[dt][2], hi[dt][3]};
                        o[0][dt] = __builtin_amdgcn_mfma_f32_16x16x32_bf16(a, pf[0][t], o[0][dt], 0, 0, 0);
                        o[1][dt] = __builtin_amdgcn_mfma_f32_16x16x32_bf16(a, pf[1][t], o[1][dt], 0, 0, 0); }
                }
#pragma unroll
                for (int u = 0; u < 2; ++u)
#pragma unroll
                    for (int dt = 0; dt < 4; ++dt) { u32x2 w; w.x = pg8::cvt_pk_bf16(o[u][dt][0] * inv[u], o[u][dt][1] * inv[u]); w.y = pg8::cvt_pk_bf16(o[u][dt][2] * inv[u], o[u][dt][3] * inv[u]);
                        *(u32x2*)(AO + (size_t)(row0 + wave * 32 + 16 * u + li) * LD + head * HDIM + c * CD + dt * 16 + g * 4) = w; }
            }
            if (c < 7) stage_store(pre, lds + ((c + 1) & 1) * CBYTES, tid);
            WG_SYNC();
        }
    }
}
}
namespace mx {
typedef att::bf16x8 bf16x8; typedef att::s16x4 s16x4; typedef att::f32x4 f32x4; typedef att::u32x2 u32x2;
constexpr int PT = 272;
constexpr int T64 = 64 * PT, T128 = 128 * PT;
static_assert(C::MHD == 128 && C::CH == 64 && C::MH == 8 && C::LCS == 32, "mLSTM phases are built for these shapes");
__device__ __forceinline__ void lds_wait() { asm volatile("s_waitcnt lgkmcnt(0)" ::: "memory"); __builtin_amdgcn_sched_barrier(0); }
__device__ __forceinline__ bf16x8 mk8(s16x4 lo, s16x4 hi) { return (bf16x8){lo[0], lo[1], lo[2], lo[3], hi[0], hi[1], hi[2], hi[3]}; }
__device__ __forceinline__ unsigned tr_addr(unsigned tile, int krow, int c0, int li) { return tile + (unsigned)((krow + (li >> 2)) * PT + (c0 + 4 * (li & 3)) * 2); }
__device__ __forceinline__ void ch_decode(int ci, int& r0, int& h, int& lc) {
    if (ci < C::NPC) { const int c = ci % C::NC, bh = ci / C::NC; h = bh % C::MH; r0 = (bh / C::MH) * C::SEQ + c * C::CH; lc = C::CH; }
    else { const int q = ci - C::NPC; h = q % C::MH; r0 = C::MP + (q / C::MH) * C::DEC_SEQ; lc = C::LCS; }
}
__device__ __forceinline__ void stage64(LAS unsigned char* tile, const float* src, int ld, int lc, int tid, const LAS float* rs, float mul) {
#pragma unroll
    for (int i = 0; i < 4; ++i) { const int f = tid + 512 * i, row = f >> 5, c4 = f & 31; f32x4 v = (f32x4){0.f, 0.f, 0.f, 0.f};
        if (row < lc) { v = *(const f32x4*)(src + (size_t)row * ld + c4 * 4); const float m = rs ? rs[row] * mul : mul; v = v * m; }
        u32x2 w; w.x = pg8::cvt_pk_bf16(v[0], v[1]); w.y = pg8::cvt_pk_bf16(v[2], v[3]); *(LAS u32x2*)(tile + row * PT + c4 * 8) = w; }
}
__device__ __forceinline__ void ml_phase_a(LAS unsigned char* lds, const Ptrs& p, int l, int tid, int bid, int gsz) {
    const int lane = tid & 63, wave = __builtin_amdgcn_readfirstlane(tid >> 6), li = lane & 15, g = lane >> 4;
    LAS unsigned char* Ks = lds; LAS unsigned char* Vs = lds + T64; LAS float* wts = (LAS float*)(lds + 2 * T64);
    const float* P = wsf<C>(p, C::WS_BIG);
    for (int ci = bid; ci < C::NCH; ci += gsz) {
        int r0, h, lc; ch_decode(ci, r0, h, lc);
        if (wave == 0) {
            float lf = 0.f, ig = -3.0e38f;
            if (lane < lc) { const float* pr = P + (size_t)(r0 + lane) * C::LDP; ig = pr[C::O_IG + h] + p.in[I_IB][l * C::MH + h]; const float fx = pr[C::O_FG + h] + p.in[I_FB][l * C::MH + h]; lf = fx >= 0.f ? -__logf(1.0f + __expf(-fx)) : fx - __logf(1.0f + __expf(fx)); }
            float b = lf;
#pragma unroll
            for (int o = 1; o < 64; o <<= 1) { const float t = __shfl_up(b, o); if (lane >= o) b += t; }
            const float a = lane < lc ? ig - b : -3.0e38f;
            float amax = a;
#pragma unroll
            for (int o = 1; o < 64; o <<= 1) amax = fmaxf(amax, __shfl_xor(amax, o));
            const float bL = __shfl(b, lc - 1), mloc = bL + amax;
            const float wt = lane < lc ? __expf(bL + a - mloc) : 0.f;
            wts[lane] = wt;
            if (lane < lc) { wsf<C>(p, C::WS_GB)[(size_t)(r0 + lane) * C::MH + h] = b; wsf<C>(p, C::WS_GA)[(size_t)(r0 + lane) * C::MH + h] = a; }
            if (lane == 0) { wsf<C>(p, C::WS_CBL)[ci] = bL; wsf<C>(p, C::WS_CML)[ci] = mloc; }
        }
        __syncthreads();
        stage64(Ks, P + (size_t)r0 * C::LDP + C::O_K + h * C::MHD, C::LDP, lc, tid, wts, 0.08838834764831845f);
        stage64(Vs, P + (size_t)r0 * C::LDP + C::O_VM + h * C::MHD, C::LDP, lc, tid, nullptr, 1.0f);
        __syncthreads();
        f32x4 acc[8];
#pragma unroll
        for (int et = 0; et < 8; ++et) acc[et] = (f32x4){0.f, 0.f, 0.f, 0.f};
        const unsigned ks = (unsigned)(size_t)Ks, vs = (unsigned)(size_t)Vs;
#pragma unroll
        for (int t = 0; t < 2; ++t) {
            const s16x4 alo = att::tr_read(tr_addr(ks, 32 * t + 8 * g, 16 * wave, li)), ahi = att::tr_read(tr_addr(ks, 32 * t + 8 * g + 4, 16 * wave, li));
            s16x4 blo[8], bhi[8];
#pragma unroll
            for (int et = 0; et < 8; ++et) { blo[et] = att::tr_read(tr_addr(vs, 32 * t + 8 * g, 16 * et, li)); bhi[et] = att::tr_read(tr_addr(vs, 32 * t + 8 * g + 4, 16 * et, li)); }
            lds_wait();
            const bf16x8 a = mk8(alo, ahi);
#pragma unroll
            for (int et = 0; et < 8; ++et) acc[et] = __builtin_amdgcn_mfma_f32_16x16x32_bf16(a, mk8(blo[et], bhi[et]), acc[et], 0, 0, 0);
        }
        float* DC = wsf<C>(p, C::WS_DC) + (size_t)ci * C::MHD * C::MHD;
#pragma unroll
        for (int et = 0; et < 8; ++et)
#pragma unroll
            for (int r = 0; r < 4; ++r) DC[(size_t)(16 * wave + 4 * g + r) * C::MHD + 16 * et + li] = acc[et][r];
        if (tid < C::MHD) { float s = 0.f; for (int t = 0; t < 64; ++t) s += bf2f(*(const LAS bf16_t*)(Ks + t * PT + tid * 2)); wsf<C>(p, C::WS_DN)[(size_t)ci * C::MHD + tid] = s; }
        __syncthreads();
    }
}
__device__ __forceinline__ void ml_phase_c(LAS unsigned char* lds, const Ptrs& p, int l, int tid, int bid, int gsz) {
    const int lane = tid & 63, wave = __builtin_amdgcn_readfirstlane(tid >> 6), li = lane & 15, g = lane >> 4, it = wave & 3, eh = wave >> 2;
    LAS unsigned char* Qs = lds; LAS unsigned char* Ks = lds + T64; LAS unsigned char* Vs = lds + 2 * T64; LAS unsigned char* Cs = lds + 3 * T64;
    LAS float* sb = (LAS float*)(lds + 3 * T64 + T128);
    LAS float* sa = sb + 64; LAS float* smr = sb + 128; LAS float* siw = sb + 192; LAS float* snp = sb + 256; LAS float* ssq = sb + 384;
    const float* P = wsf<C>(p, C::WS_BIG);
    for (int ci = bid; ci < C::NCH; ci += gsz) {
        int r0, h, lc; ch_decode(ci, r0, h, lc);
        const bool sample = ci >= C::NPC, first = !sample && (ci % C::NC) == 0;
        const float mprev = wsf<C>(p, C::WS_MPREV)[ci];
        if (wave == 0) {
            float b = 0.f, a = -3.0e38f;
            if (lane < lc) { b = wsf<C>(p, C::WS_GB)[(size_t)(r0 + lane) * C::MH + h]; a = wsf<C>(p, C::WS_GA)[(size_t)(r0 + lane) * C::MH + h]; }
            float pm = a;
#pragma unroll
            for (int o = 1; o < 64; o <<= 1) { const float t = __shfl_up(pm, o); if (lane >= o) pm = fmaxf(pm, t); }
            const float mrow = b + fmaxf(mprev, pm);
            sb[lane] = b; sa[lane] = a; smr[lane] = mrow; siw[lane] = __expf(b + mprev - mrow);
        }
        if (tid >= 128 && tid < 256) { const int d = tid - 128;
            snp[d] = sample ? p.in[I_SN][((size_t)l * C::NSC + (ci - C::NPC)) * C::MHD + d] : (first ? 0.f : wsf<C>(p, C::WS_DN)[(size_t)(ci - 1) * C::MHD + d]); }
        stage64(Qs, P + (size_t)r0 * C::LDP + C::O_Q + h * C::MHD, C::LDP, lc, tid, nullptr, 1.0f);
        stage64(Ks, P + (size_t)r0 * C::LDP + C::O_K + h * C::MHD, C::LDP, lc, tid, nullptr, 0.08838834764831845f);
        stage64(Vs, P + (size_t)r0 * C::LDP + C::O_VM + h * C::MHD, C::LDP, lc, tid, nullptr, 1.0f);
        { const float* cp = sample ? p.in[I_SC] + ((size_t)l * C::NSC + (ci - C::NPC)) * C::MHD * C::MHD : wsf<C>(p, C::WS_DC) + (size_t)(first ? ci : ci - 1) * C::MHD * C::MHD;
#pragma unroll
            for (int i = 0; i < 8; ++i) { const int f = tid + 512 * i, row = f >> 5, c4 = f & 31; f32x4 v = (f32x4){0.f, 0.f, 0.f, 0.f};
                if (!first) v = *(const f32x4*)(cp + (size_t)row * C::MHD + c4 * 4);
                u32x2 w; w.x = pg8::cvt_pk_bf16(v[0], v[1]); w.y = pg8::cvt_pk_bf16(v[2], v[3]); *(LAS u32x2*)(Cs + row * PT + c4 * 8) = w; } }
        __syncthreads();
        const bool active = it * 16 < lc;
        float ssq_part = 0.f; f32x4 hv[4]; float inv_den = 0.f;
        const int i = 16 * it + li;
        if (active) {
            bf16x8 qf[4];
#pragma unroll
            for (int ks = 0; ks < 4; ++ks) qf[ks] = *(const LAS bf16x8*)(Qs + i * PT + ks * 64 + g * 16);
            f32x4 st[4];
#pragma unroll
            for (int jt = 0; jt < 4; ++jt) st[jt] = (f32x4){0.f, 0.f, 0.f, 0.f};
#pragma unroll
            for (int jt = 0; jt < 4; ++jt) if (jt <= it) {
#pragma unroll
                for (int ks = 0; ks < 4; ++ks) { const bf16x8 a = *(const LAS bf16x8*)(Ks + (16 * jt + li) * PT + ks * 64 + g * 16);
                    st[jt] = __builtin_amdgcn_mfma_f32_16x16x32_bf16(a, qf[ks], st[jt], 0, 0, 0); } }
            const float bi = sb[i], mri = smr[i], iwi = siw[i];
            float dsum = 0.f;
#pragma unroll
            for (int jt = 0; jt < 4; ++jt)
#pragma unroll
                for (int r = 0; r < 4; ++r) { const int j = 16 * jt + 4 * g + r; const float w = (j <= i) ? __expf(bi + sa[j] - mri) : 0.f; st[jt][r] *= w; dsum += st[jt][r]; }
            dsum += __shfl_xor(dsum, 16); dsum += __shfl_xor(dsum, 32);
            float qn = 0.f;
#pragma unroll
            for (int ks = 0; ks < 4; ++ks)
#pragma unroll
                for (int jj = 0; jj < 8; ++jj) qn += bf2f((bf16_t)qf[ks][jj]) * snp[32 * ks + 8 * g + jj];
            qn += __shfl_xor(qn, 16); qn += __shfl_xor(qn, 32);
            const float den = dsum + iwi * qn;
            inv_den = 1.0f / fmaxf(fabsf(den), __expf(-mri));
            bf16x8 pf[2];
#pragma unroll
            for (int t = 0; t < 2; ++t) { pg8::u32x4 w; w.x = pg8::cvt_pk_bf16(st[2 * t][0], st[2 * t][1]); w.y = pg8::cvt_pk_bf16(st[2 * t][2], st[2 * t][3]);
                w.z = pg8::cvt_pk_bf16(st[2 * t + 1][0], st[2 * t + 1][1]); w.w = pg8::cvt_pk_bf16(st[2 * t + 1][2], st[2 * t + 1][3]); pf[t] = __builtin_bit_cast(bf16x8, w); }
            const unsigned vs = (unsigned)(size_t)Vs, cs = (unsigned)(size_t)Cs;
#pragma unroll
            for (int e4 = 0; e4 < 4; ++e4) { const int et = 4 * eh + e4;
                s16x4 vlo[2], vhi[2], clo[4], chi[4];
#pragma unroll
                for (int t = 0; t < 2; ++t) { vlo[t] = att::tr_read(tr_addr(vs, 32 * t + 4 * g, 16 * et, li)); vhi[t] = att::tr_read(tr_addr(vs, 32 * t + 16 + 4 * g, 16 * et, li)); }
#pragma unroll
                for (int ks = 0; ks < 4; ++ks) { clo[ks] = att::tr_read(tr_addr(cs, 32 * ks + 8 * g, 16 * et, li)); chi[ks] = att::tr_read(tr_addr(cs, 32 * ks + 8 * g + 4, 16 * et, li)); }
                lds_wait();
                f32x4 aS = (f32x4){0.f, 0.f, 0.f, 0.f}, aC = (f32x4){0.f, 0.f, 0.f, 0.f};
#pragma unroll
                for (int t = 0; t < 2; ++t) aS = __builtin_amdgcn_mfma_f32_16x16x32_bf16(mk8(vlo[t], vhi[t]), pf[t], aS, 0, 0, 0);
#pragma unroll
                for (int ks = 0; ks < 4; ++ks) aC = __builtin_amdgcn_mfma_f32_16x16x32_bf16(mk8(clo[ks], chi[ks]), qf[ks], aC, 0, 0, 0);
                hv[e4] = (aS + aC * iwi) * inv_den;
                ssq_part += (hv[e4][0] * hv[e4][0] + hv[e4][1] * hv[e4][1]) + (hv[e4][2] * hv[e4][2] + hv[e4][3] * hv[e4][3]); }
            ssq_part += __shfl_xor(ssq_part, 16); ssq_part += __shfl_xor(ssq_part, 32);
            if (g == 0) ssq[wave * 16 + li] = ssq_part;
        }
        __syncthreads();
        if (active) {
            const float tot = ssq_part + ssq[(wave ^ 4) * 16 + li];
            const float rs = rsqrtf(tot * (1.0f / C::MHD) + 1e-6f);
            const int row = r0 + i;
#pragma unroll
            for (int e4 = 0; e4 < 4; ++e4) { const int e = 16 * (4 * eh + e4) + 4 * g;
                const f32x4 og = *(const f32x4*)(P + (size_t)row * C::LDP + C::O_O + h * C::MHD + e); const f32x4 gn = *(const f32x4*)(p.in[I_NG] + (size_t)l * C::MW + h * C::MHD + e);
                float o4[4];
#pragma unroll
                for (int r = 0; r < 4; ++r) o4[r] = hv[e4][r] * rs * gn[r] * __builtin_amdgcn_rcpf(1.0f + __expf(-og[r]));
                u32x2 w; w.x = pg8::cvt_pk_bf16(o4[0], o4[1]); w.y = pg8::cvt_pk_bf16(o4[2], o4[3]);
                *(u32x2*)(wsb<C>(p, C::WS_MIX) + (size_t)row * C::D + C::PW + C::GW + h * C::MHD + e) = w; }
        }
        __syncthreads();
    }
}
}
namespace rw {
typedef att::f32x4 f32x4; typedef att::u32x2 u32x2;
static_assert(C::D == 2048, "row ops assume 2048 columns = 8 float4 per lane");
__device__ __forceinline__ float wave_sum(float v) {
#pragma unroll
    for (int o = 1; o < 64; o <<= 1) v += __shfl_xor(v, o);
    return v;
}
__device__ __forceinline__ void rows_init(const Ptrs& p, int tid, int bid, int gsz) {
    const int lane = tid & 63, gw = bid * NWAVES + (tid >> 6), NGW = gsz * NWAVES;
    float* SS = wsf<C>(p, C::WS_SS);
    for (int r = gw; r < C::M; r += NGW) {
        const float* src = r < C::MP ? p.in[I_XP] + (size_t)r * C::D : p.in[I_XS] + (size_t)(r - C::MP) * C::D;
        float* X = wsf<C>(p, C::WS_X) + (size_t)r * C::D; bf16_t* XB = wsb<C>(p, C::WS_XB) + (size_t)r * C::D;
        float ss = 0.f;
#pragma unroll
        for (int j = 0; j < 8; ++j) { const f32x4 v = *(const f32x4*)(src + (lane + 64 * j) * 4); *(f32x4*)(X + (lane + 64 * j) * 4) = v;
            u32x2 w; w.x = pg8::cvt_pk_bf16(v[0], v[1]); w.y = pg8::cvt_pk_bf16(v[2], v[3]); *(u32x2*)(XB + (lane + 64 * j) * 4) = w;
            ss += (v[0] * v[0] + v[1] * v[1]) + (v[2] * v[2] + v[3] * v[3]); }
        ss = wave_sum(ss);
        if (lane < C::NSS) SS[(size_t)lane * C::M + r] = lane == 0 ? ss : 0.f;
    }
    for (int r = gw; r < C::MM; r += NGW) {
        const float* src = p.in[I_MEM] + (size_t)r * C::D; bf16_t* MB = wsb<C>(p, C::WS_MEMB) + (size_t)r * C::D;
        float ss = 0.f;
#pragma unroll
        for (int j = 0; j < 8; ++j) { const f32x4 v = *(const f32x4*)(src + (lane + 64 * j) * 4);
            u32x2 w; w.x = pg8::cvt_pk_bf16(v[0], v[1]); w.y = pg8::cvt_pk_bf16(v[2], v[3]); *(u32x2*)(MB + (lane + 64 * j) * 4) = w;
            ss += (v[0] * v[0] + v[1] * v[1]) + (v[2] * v[2] + v[3] * v[3]); }
        ss = wave_sum(ss);
        if (lane == 0) wsf<C>(p, C::WS_RSTDM)[r] = rsqrtf(ss * (1.0f / C::D) + 1e-6f);
    }
}
__device__ __forceinline__ void rows_final(const Ptrs& p, int tid, int bid, int gsz) {
    const int lane = tid & 63, gw = bid * NWAVES + (tid >> 6), NGW = gsz * NWAVES;
    for (int r = gw; r < C::M; r += NGW) {
        const float* X = wsf<C>(p, C::WS_X) + (size_t)r * C::D; const float rs = rsqrtf(wsf<C>(p, C::WS_SS)[(size_t)(C::NSS - 1) * C::M + r] * (1.0f / C::D) + 1e-6f);
        float* o = r < C::MP ? p.out + C::OUT_YP + (size_t)r * C::D : p.out + C::OUT_YS + (size_t)(r - C::MP) * C::D;
        float pscale = 1.0f, padd = 0.f;
#if defined(PROBE_MASK_A)
        { const unsigned long long* TS = (const unsigned long long*)(p.ws + C::WS_CTL + 32768); unsigned long long ta = 0, tb = 0;
          for (int k = 0; k < 25; ++k) { const unsigned long long dk = TS[k + 1] - TS[k]; if ((PROBE_MASK_A >> k) & 1ull) ta += dk; if ((PROBE_MASK_B >> k) & 1ull) tb += dk; }
#if defined(PROBE_MLT)
          ta = TS[48 + PROBE_MLT];
#endif
#if defined(PROBE_GST)
          { const unsigned long long* st = (const unsigned long long*)(p.ws + C::WS_END); unsigned long long epi = 0; for (int u2 = 0; u2 < 8; ++u2) epi += st[3 + 2 * u2] - st[2 + 2 * u2];
            const unsigned long long tot = st[18] - st[0], fill = st[1] - st[0];
            ta = (unsigned long long)(1.0e6 * (double)(PROBE_GST == 1 ? epi : fill) / (double)tot); }
#endif
#if defined(PROBE_MLC)
          ta = TS[48 + PROBE_MLC];
#endif
#if defined(PROBE_ATT)
          ta = 0; for (int l2 = 0; l2 < 2; ++l2) { const int k = 1 + 12 * l2 + 8; ta += (PROBE_ATT == 1) ? TS[44 + l2] - TS[k] : TS[k + 1] - TS[44 + l2]; }
#endif
#if defined(PROBE_MIXA)
          ta = 0; for (int l2 = 0; l2 < 2; ++l2) { const int k = 1 + 12 * l2 + 3; ta += (PROBE_MIXA == 1) ? TS[40 + l2] - TS[k] : (PROBE_MIXA == 2) ? TS[42 + l2] - TS[40 + l2] : TS[k + 1] - TS[42 + l2]; }
#endif
#if defined(PROBE_SPLIT_MODE)
          ta = 0; for (int l2 = 0; l2 < 2; ++l2) { const int k = 1 + 10 * l2 + 3; ta += (PROBE_SPLIT_MODE == 1) ? TS[40 + l2] - TS[k] : TS[k + 1] - TS[40 + l2]; }
#endif
          if (r >= C::MP) pscale = 1.0f + 0.03f + (float)ta * 0.01f * PROBE_SA;
          if (r == 0 && lane == 0) padd = 1.0f + (float)tb * 0.01f * PROBE_SB; }
#endif
#pragma unroll
        for (int j = 0; j < 8; ++j) { const f32x4 v = *(const f32x4*)(X + (lane + 64 * j) * 4); const f32x4 gg = *(const f32x4*)(p.in[I_GFIN] + (lane + 64 * j) * 4);
            f32x4 y = v * rs * gg * pscale; if (j == 0) y[0] += padd; *(f32x4*)(o + (lane + 64 * j) * 4) = y; }
    }
}
__device__ __forceinline__ void ml_scan(const Ptrs& p, int l, long gtid, long gthreads) {
    const float* CBL = wsf<C>(p, C::WS_CBL); const float* CML = wsf<C>(p, C::WS_CML);
    float* DC = wsf<C>(p, C::WS_DC); float* DN = wsf<C>(p, C::WS_DN);
    constexpr int NPS = C::BATCH * C::MH, E4 = C::MHD / 4;
    for (long it = gtid; it < (long)NPS * C::MHD * E4; it += gthreads) {
        const int e4 = (int)(it % E4), d = (int)((it / E4) % C::MHD), sq = (int)(it / ((long)E4 * C::MHD));
        float m = 0.f; f32x4 cst = (f32x4){0.f, 0.f, 0.f, 0.f};
        static_assert(C::NC % 8 == 0, "scan is unrolled by 8 chunks");
        for (int c0 = 0; c0 < C::NC; c0 += 8) {
            f32x4 v[8]; float bl[8], ml[8];
#pragma unroll
            for (int j = 0; j < 8; ++j) { const int ci = sq * C::NC + c0 + j; v[j] = *(const f32x4*)(DC + ((size_t)ci * C::MHD + d) * C::MHD + e4 * 4); bl[j] = CBL[ci]; ml[j] = CML[ci]; }
#pragma unroll
            for (int j = 0; j < 8; ++j) { const int ci = sq * C::NC + c0 + j; const float a = bl[j] + m, mn = fmaxf(a, ml[j]), dec = __expf(a - mn), f = __expf(ml[j] - mn);
                cst = cst * dec + v[j] * f; *(f32x4*)(DC + ((size_t)ci * C::MHD + d) * C::MHD + e4 * 4) = cst; m = mn; }
        }
        *(f32x4*)(p.out + C::OUT_CP + (((size_t)l * NPS + sq) * C::MHD + d) * C::MHD + e4 * 4) = cst;
    }
    for (long it = gtid; it < (long)NPS * C::MHD; it += gthreads) {
        const int d = (int)(it % C::MHD), sq = (int)(it / C::MHD);
        float m = 0.f, nst = 0.f;
        for (int c = 0; c < C::NC; ++c) { const int ci = sq * C::NC + c; const float a = CBL[ci] + m, b2 = CML[ci], mn = fmaxf(a, b2), dec = __expf(a - mn), f = __expf(b2 - mn);
            const size_t on = (size_t)ci * C::MHD + d; nst = dec * nst + f * DN[on]; DN[on] = nst; m = mn; }
        p.out[C::OUT_NP + ((size_t)l * NPS + sq) * C::MHD + d] = nst;
    }
    for (long it = gtid; it < (long)C::NSC * C::MHD * E4; it += gthreads) {
        const int e4 = (int)(it % E4), d = (int)((it / E4) % C::MHD), q = (int)(it / ((long)E4 * C::MHD)), ci = C::NPC + q;
        const float m0 = p.in[I_SM][(size_t)l * C::NSC + q], a = CBL[ci] + m0, b2 = CML[ci], mn = fmaxf(a, b2), dec = __expf(a - mn), f = __expf(b2 - mn);
        const size_t so = (((size_t)l * C::NSC + q) * C::MHD + d) * C::MHD + e4 * 4;
        *(f32x4*)(p.out + C::OUT_CS + so) = *(const f32x4*)(p.in[I_SC] + so) * dec + *(const f32x4*)(DC + ((size_t)ci * C::MHD + d) * C::MHD + e4 * 4) * f;
    }
    for (long it = gtid; it < (long)C::NSC * C::MHD; it += gthreads) {
        const int d = (int)(it % C::MHD), q = (int)(it / C::MHD), ci = C::NPC + q;
        const float m0 = p.in[I_SM][(size_t)l * C::NSC + q], a = CBL[ci] + m0, b2 = CML[ci], mn = fmaxf(a, b2), dec = __expf(a - mn), f = __expf(b2 - mn);
        const size_t no = ((size_t)l * C::NSC + q) * C::MHD + d;
        p.out[C::OUT_NS + no] = dec * p.in[I_SN][no] + f * DN[(size_t)ci * C::MHD + d];
    }
}
}

namespace gp {
typedef att::bf16x8 bf16x8; typedef att::s16x4 s16x4; typedef att::f32x4 f32x4; typedef att::u32x2 u32x2;
constexpr int PT = mx::PT, T128 = mx::T128;
static_assert(C::GHD == 128 && C::PGD == 128 && C::GCH == 128 && C::SEQ % 128 == 0 && C::DEC_SEQ == 32 && C::PH == 15, "gmlp / pool phases are built for these shapes");
constexpr int NT_P = C::MP / 128;
constexpr int NU_G = NT_P * 4 + C::DEC_BATCH * 4;
__device__ __forceinline__ void gmlp_phase(LAS unsigned char* lds, const Ptrs& p, int l, int tid, int bid, int gsz) {
    const int lane = tid & 63, wave = __builtin_amdgcn_readfirstlane(tid >> 6), li = lane & 15, g = lane >> 4;
    LAS unsigned char* Vs = lds; LAS unsigned char* Ws = lds + T128;
    const float* P = wsf<C>(p, C::WS_BIG);
    for (int u = bid; u < NU_G; u += gsz) {
        int r0, lc, h; bool sample = false; int sb = 0;
        if (u < NT_P * 4) { h = u & 3; r0 = (u >> 2) * 128; lc = 128; } else { const int s = u - NT_P * 4; h = s & 3; sb = s >> 2; r0 = C::MP + sb * C::DEC_SEQ; lc = C::DEC_SEQ; sample = true; }
#pragma unroll
        for (int i = 0; i < 8; ++i) { const int f = tid + 512 * i, row = f >> 5, c4 = f & 31; f32x4 v = (f32x4){0.f, 0.f, 0.f, 0.f};
            if (row < lc) v = *(const f32x4*)(P + (size_t)(r0 + row) * C::LDP + C::O_V + h * 128 + c4 * 4);
            float ss = (v[0] * v[0] + v[1] * v[1]) + (v[2] * v[2] + v[3] * v[3]);
#pragma unroll
            for (int o = 1; o < 32; o <<= 1) ss += __shfl_xor(ss, o);
            const float rs = rsqrtf(ss * (1.0f / 128) + 1e-6f); const f32x4 gn = *(const f32x4*)(p.in[I_GVG] + (size_t)l * C::GW + h * 128 + c4 * 4);
            v = v * rs * gn;
            if (sample && row < lc) *(f32x4*)(p.out + C::OUT_VS + (((size_t)l * C::DEC_BATCH + sb) * C::DEC_SEQ + row) * C::GW + h * 128 + c4 * 4) = v;
            u32x2 w; w.x = pg8::cvt_pk_bf16(v[0], v[1]); w.y = pg8::cvt_pk_bf16(v[2], v[3]); *(LAS u32x2*)(Vs + row * PT + c4 * 8) = w; }
        const float* wsrc = p.in[I_GWS] + ((size_t)l * C::GH + h) * 128 * 128;
#pragma unroll
        for (int i = 0; i < 8; ++i) { const int f = tid + 512 * i, row = f >> 5, c4 = f & 31; f32x4 v = *(const f32x4*)(wsrc + (size_t)row * 128 + c4 * 4);
#pragma unroll
            for (int j = 0; j < 4; ++j) if (c4 * 4 + j > row) v[j] = 0.f;
            u32x2 w; w.x = pg8::cvt_pk_bf16(v[0], v[1]); w.y = pg8::cvt_pk_bf16(v[2], v[3]); *(LAS u32x2*)(Ws + row * PT + c4 * 8) = w; }
        WG_SYNC();
        if (wave * 16 < lc) {
            const int i = wave * 16 + li, nks = (wave * 16 + 15) / 32 + 1;
            f32x4 acc[8];
#pragma unroll
            for (int dt = 0; dt < 8; ++dt) acc[dt] = (f32x4){0.f, 0.f, 0.f, 0.f};
            const unsigned vs = (unsigned)(size_t)Vs;
            for (int ks = 0; ks < nks; ++ks) {
                const bf16x8 bq = *(const LAS bf16x8*)(Ws + i * PT + ks * 64 + g * 16);
                s16x4 lo[8], hi[8];
#pragma unroll
                for (int dt = 0; dt < 8; ++dt) { lo[dt] = att::tr_read(mx::tr_addr(vs, 32 * ks + 8 * g, 16 * dt, li)); hi[dt] = att::tr_read(mx::tr_addr(vs, 32 * ks + 8 * g + 4, 16 * dt, li)); }
                mx::lds_wait();
#pragma unroll
                for (int dt = 0; dt < 8; ++dt) acc[dt] = __builtin_amdgcn_mfma_f32_16x16x32_bf16(mx::mk8(lo[dt], hi[dt]), bq, acc[dt], 0, 0, 0);
            }
            const float bsi = p.in[I_GBS][((size_t)l * C::GH + h) * C::GCH + i];
            const int row = r0 + i;
#pragma unroll
            for (int dt = 0; dt < 8; ++dt) { const int d = 16 * dt + 4 * g; const f32x4 uu = *(const f32x4*)(P + (size_t)row * C::LDP + C::O_U + h * 128 + d);
                u32x2 w; w.x = pg8::cvt_pk_bf16(uu[0] * (acc[dt][0] + bsi), uu[1] * (acc[dt][1] + bsi)); w.y = pg8::cvt_pk_bf16(uu[2] * (acc[dt][2] + bsi), uu[3] * (acc[dt][3] + bsi));
                *(u32x2*)(wsb<C>(p, C::WS_MIX) + (size_t)row * C::D + C::PW + h * 128 + d) = w; }
        }
        WG_SYNC();
    }
}
__device__ __forceinline__ void pool_phase(LAS unsigned char* lds, const Ptrs& p, int l, int tid, int bid, int gsz) {
    const int lane = tid & 63, wave = __builtin_amdgcn_readfirstlane(tid >> 6), li = lane & 15, g = lane >> 4;
    LAS unsigned char* Ds = lds; LAS unsigned char* Ws = lds + T128;
    const float* P = wsf<C>(p, C::WS_BIG);
    for (int u = bid; u < NU_G; u += gsz) {
        int r0, lc, grp, t0, L, b; bool sample = false;
        if (u < NT_P * 4) { grp = u & 3; r0 = (u >> 2) * 128; lc = 128; b = r0 / C::SEQ; t0 = r0 % C::SEQ; L = C::SEQ; } else { const int s = u - NT_P * 4; grp = s & 3; b = s >> 2; r0 = C::MP + b * C::DEC_SEQ; lc = C::DEC_SEQ; t0 = 0; L = C::DEC_SEQ; sample = true; }
        const int w = 2 << grp;
        { const int c4 = tid & 31, sg = tid >> 5, ch = grp * 128 + c4 * 4;
            const float* hist = p.in[I_SPOOL] + ((size_t)l * C::DEC_BATCH + b) * C::PH * C::PW + ch;
            auto xat = [&](int t) -> f32x4 {
                if (t >= 0) return *(const f32x4*)(P + (size_t)(r0 - t0 + t) * C::LDP + ch);
                if (sample && C::PH + t >= 0) return *(const f32x4*)(hist + (size_t)(C::PH + t) * C::PW);
                return (f32x4){0.f, 0.f, 0.f, 0.f}; };
            if (sg * 8 < lc) {
                const int ts = t0 + sg * 8;
                f32x4 sum = (f32x4){0.f, 0.f, 0.f, 0.f};
                for (int j = 1; j < w; ++j) sum = sum + xat(ts - j);
#pragma unroll
                for (int k = 0; k < 8; ++k) { const int t = ts + k; const f32x4 x = xat(t); sum = sum + x;
                    const int pos = (sample ? C::PAST : 0) + t; const float inv = 1.0f / (float)((pos + 1) < w ? (pos + 1) : w);
                    const f32x4 dv = sum * inv - x;
                    u32x2 ww; ww.x = pg8::cvt_pk_bf16(dv[0], dv[1]); ww.y = pg8::cvt_pk_bf16(dv[2], dv[3]); *(LAS u32x2*)(Ds + (sg * 8 + k) * PT + c4 * 8) = ww;
                    sum = sum - xat(t - w + 1);
                    const int idx = t - (L - C::PH);
                    if (idx >= 0) *(f32x4*)(p.out + (sample ? C::OUT_POOLS + (((size_t)l * C::DEC_BATCH + b) * C::PH + idx) * C::PW : C::OUT_POOLP + (((size_t)l * C::BATCH + b) * C::PH + idx) * C::PW) + ch) = x; }
            } else {
#pragma unroll
                for (int k = 0; k < 8; ++k) *(LAS u32x2*)(Ds + (sg * 8 + k) * PT + c4 * 8) = (u32x2){0u, 0u};
            }
        }
        const float* wsrc = p.in[I_POOLW] + ((size_t)l * C::PG + grp) * 128 * 128;
#pragma unroll
        for (int i = 0; i < 8; ++i) { const int f = tid + 512 * i, row = f >> 5, c4 = f & 31; const f32x4 v = *(const f32x4*)(wsrc + (size_t)row * 128 + c4 * 4);
            u32x2 ww; ww.x = pg8::cvt_pk_bf16(v[0], v[1]); ww.y = pg8::cvt_pk_bf16(v[2], v[3]); *(LAS u32x2*)(Ws + row * PT + c4 * 8) = ww; }
        WG_SYNC();
        if (wave * 16 < lc) {
            const int t = wave * 16 + li;
            f32x4 acc[8];
#pragma unroll
            for (int et = 0; et < 8; ++et) acc[et] = (f32x4){0.f, 0.f, 0.f, 0.f};
            const unsigned wsa = (unsigned)(size_t)Ws;
#pragma unroll
            for (int ks = 0; ks < 4; ++ks) {
                const bf16x8 bq = *(const LAS bf16x8*)(Ds + t * PT + ks * 64 + g * 16);
                s16x4 lo[8], hi[8];
#pragma unroll
                for (int et = 0; et < 8; ++et) { lo[et] = att::tr_read(mx::tr_addr(wsa, 32 * ks + 8 * g, 16 * et, li)); hi[et] = att::tr_read(mx::tr_addr(wsa, 32 * ks + 8 * g + 4, 16 * et, li)); }
                mx::lds_wait();
#pragma unroll
                for (int et = 0; et < 8; ++et) acc[et] = __builtin_amdgcn_mfma_f32_16x16x32_bf16(mx::mk8(lo[et], hi[et]), bq, acc[et], 0, 0, 0);
            }
            const int row = r0 + t;
#pragma unroll
            for (int et = 0; et < 8; ++et) { const int e = 16 * et + 4 * g; const f32x4 sc = *(const f32x4*)(p.in[I_POOLS] + (size_t)l * C::PW + grp * 128 + e);
                u32x2 ww; ww.x = pg8::cvt_pk_bf16(acc[et][0] * sc[0], acc[et][1] * sc[1]); ww.y = pg8::cvt_pk_bf16(acc[et][2] * sc[2], acc[et][3] * sc[3]);
                *(u32x2*)(wsb<C>(p, C::WS_MIX) + (size_t)row * C::D + grp * 128 + e) = ww; }
        }
        WG_SYNC();
    }
}
}
namespace mp {
typedef att::bf16x8 bf16x8; typedef att::s16x4 s16x4; typedef att::f32x4 f32x4; typedef att::u32x2 u32x2; typedef pg8::u32x4 u32x4;
constexpr int PT = mx::PT, T64 = mx::T64, T128 = mx::T128, MAXU = 8;
#define MP_TR(dst, base, OFF) asm volatile("ds_read_b64_tr_b16 %0, %1 offset:%2" : "=&v"(dst) : "v"(base), "i"(OFF) : "memory")
__device__ __forceinline__ void ml_a(LAS unsigned char* lds, const Ptrs& p, int l, int tid, int bid, int gsz) {
    const int lane = tid & 63, wave = __builtin_amdgcn_readfirstlane(tid >> 6), li = lane & 15, g = lane >> 4;
    LAS unsigned char* Ks = lds; LAS unsigned char* Vs = lds + T64; LAS float* wts = (LAS float*)(lds + 2 * T64);
    const float* P = wsf<C>(p, C::WS_BIG);
    const int nu = bid < C::NCH ? (C::NCH - 1 - bid) / gsz + 1 : 0;
    if (wave < nu) { const int ci = bid + wave * gsz; int r0, h, lc; mx::ch_decode(ci, r0, h, lc);
        float lf = 0.f, ig = -3.0e38f;
        if (lane < lc) { const float* pr = P + (size_t)(r0 + lane) * C::LDP; ig = pr[C::O_IG + h] + p.in[I_IB][l * C::MH + h]; const float fx = pr[C::O_FG + h] + p.in[I_FB][l * C::MH + h];
            lf = fx >= 0.f ? -__logf(1.0f + __expf(-fx)) : fx - __logf(1.0f + __expf(fx)); }
        float b = lf;
#pragma unroll
        for (int o = 1; o < 64; o <<= 1) { const float t = __shfl_up(b, o); if (lane >= o) b += t; }
        const float a = lane < lc ? ig - b : -3.0e38f;
        float amax = a;
#pragma unroll
        for (int o = 1; o < 64; o <<= 1) amax = fmaxf(amax, __shfl_xor(amax, o));
        const float bL = __shfl(b, lc - 1), mloc = bL + amax;
        wts[wave * 64 + lane] = lane < lc ? __expf(bL + a - mloc) : 0.f;
        if (lane < lc) { wsf<C>(p, C::WS_GB)[(size_t)(r0 + lane) * C::MH + h] = b; wsf<C>(p, C::WS_GA)[(size_t)(r0 + lane) * C::MH + h] = a; }
        if (lane == 0) { wsf<C>(p, C::WS_CBL)[ci] = bL; wsf<C>(p, C::WS_CML)[ci] = mloc; } }
    const unsigned lofs8 = (unsigned)((8 * g + (li >> 2)) * PT + 8 * (li & 3));
    const unsigned kw8 = (unsigned)(size_t)Ks + lofs8 + (unsigned)(32 * wave), vs8 = (unsigned)(size_t)Vs + lofs8;
    f32x4 pk[4], pv[4];
    auto window = [&](int ci) { int r0, h, lc; mx::ch_decode(ci, r0, h, lc); const float* src = P + (size_t)r0 * C::LDP + h * C::MHD;
#pragma unroll
        for (int q = 0; q < 4; ++q) { const int f = tid + 512 * q, row = f >> 5, c4 = f & 31;
            if (row < lc) { pk[q] = *(const f32x4*)(src + (size_t)row * C::LDP + C::O_K + c4 * 4); pv[q] = *(const f32x4*)(src + (size_t)row * C::LDP + C::O_VM + c4 * 4); }
            else { pk[q] = (f32x4){0.f, 0.f, 0.f, 0.f}; pv[q] = pk[q]; } }
        __builtin_amdgcn_sched_barrier(0); };
    if (nu > 0) window(bid);
    WG_SYNC();
    for (int j = 0; j < nu; ++j) { const int ci = bid + j * gsz;
#pragma unroll
        for (int q = 0; q < 4; ++q) { const int f = tid + 512 * q, row = f >> 5, c4 = f & 31; const float sw = 0.08838834764831845f * wts[j * 64 + row];
            u32x2 w; w.x = pg8::cvt_pk_bf16(pk[q][0] * sw, pk[q][1] * sw); w.y = pg8::cvt_pk_bf16(pk[q][2] * sw, pk[q][3] * sw); *(LAS u32x2*)(Ks + row * PT + c4 * 8) = w;
            w.x = pg8::cvt_pk_bf16(pv[q][0], pv[q][1]); w.y = pg8::cvt_pk_bf16(pv[q][2], pv[q][3]); *(LAS u32x2*)(Vs + row * PT + c4 * 8) = w; }
        if (j + 1 < nu) window(ci + gsz);
        WG_SYNC();
        f32x4 acc[8], accn = (f32x4){0.f, 0.f, 0.f, 0.f};
#pragma unroll
        for (int et = 0; et < 8; ++et) acc[et] = (f32x4){0.f, 0.f, 0.f, 0.f};
        const bf16x8 ones = (bf16x8){0x3F80, 0x3F80, 0x3F80, 0x3F80, 0x3F80, 0x3F80, 0x3F80, 0x3F80};
#pragma unroll
        for (int t = 0; t < 2; ++t) {
            s16x4 alo, ahi, blo[8], bhi[8]; MP_TR(alo, kw8, (32 * t) * PT); MP_TR(ahi, kw8, (32 * t + 4) * PT);
#pragma unroll
            for (int et = 0; et < 8; ++et) { MP_TR(blo[et], vs8, (32 * t) * PT + 32 * et); MP_TR(bhi[et], vs8, (32 * t + 4) * PT + 32 * et); }
            mx::lds_wait();
            const bf16x8 a = mx::mk8(alo, ahi);
#pragma unroll
            for (int et = 0; et < 8; ++et) acc[et] = __builtin_amdgcn_mfma_f32_16x16x32_bf16(mx::mk8(blo[et], bhi[et]), a, acc[et], 0, 0, 0);
            accn = __builtin_amdgcn_mfma_f32_16x16x32_bf16(ones, a, accn, 0, 0, 0);
        }
        float* DC = wsf<C>(p, C::WS_DC) + (size_t)ci * C::MHD * C::MHD + (size_t)(16 * wave + li) * C::MHD + 4 * g;
#pragma unroll
        for (int et = 0; et < 8; ++et) *(f32x4*)(DC + 16 * et) = acc[et];
        if (g == 0) wsf<C>(p, C::WS_DN)[(size_t)ci * C::MHD + 16 * wave + li] = accn[0];
        WG_SYNC();
    }
}
__device__ __forceinline__ void ml_scan(const Ptrs& p, int l, long gtid, long gthreads) {
    const float* CBL = wsf<C>(p, C::WS_CBL); const float* CML = wsf<C>(p, C::WS_CML); const float* DC = wsf<C>(p, C::WS_DC); float* DN = wsf<C>(p, C::WS_DN);
    bf16_t* DCB = wsb<C>(p, C::WS_DCB); float* MPREV = wsf<C>(p, C::WS_MPREV);
    constexpr int NPS = C::BATCH * C::MH, E4 = C::MHD / 4;
    static_assert(C::NC % 8 == 0, "scan is unrolled by 8 chunks");
    for (long it = gtid; it < (long)NPS * C::MHD * E4; it += gthreads) {
        const int e4 = (int)(it % E4), d = (int)((it / E4) % C::MHD), sq = (int)(it / ((long)E4 * C::MHD));
        float m = 0.f; f32x4 cst = (f32x4){0.f, 0.f, 0.f, 0.f};
        for (int c0 = 0; c0 < C::NC; c0 += 8) {
            f32x4 v[8]; float bl[8], ml[8];
#pragma unroll
            for (int j = 0; j < 8; ++j) { const int ci = sq * C::NC + c0 + j; v[j] = *(const f32x4*)(DC + ((size_t)ci * C::MHD + d) * C::MHD + e4 * 4); bl[j] = CBL[ci]; ml[j] = CML[ci]; }
            __builtin_amdgcn_sched_barrier(0);
#pragma unroll
            for (int j = 0; j < 8; ++j) { const int ci = sq * C::NC + c0 + j; const float a = bl[j] + m, mn = fmaxf(a, ml[j]), dec = __expf(a - mn), f = __expf(ml[j] - mn);
                if (d == 0 && e4 == 0) MPREV[ci] = m;
                cst = cst * dec + v[j] * f; u32x2 w; w.x = pg8::cvt_pk_bf16(cst[0], cst[1]); w.y = pg8::cvt_pk_bf16(cst[2], cst[3]);
                *(u32x2*)(DCB + ((size_t)ci * C::MHD + d) * C::MHD + e4 * 4) = w; m = mn; }
        }
        *(f32x4*)(p.out + C::OUT_CP + (((size_t)l * NPS + sq) * C::MHD + d) * C::MHD + e4 * 4) = cst;
        if (d == 0 && e4 == 0) p.out[C::OUT_MP + (size_t)l * NPS + sq] = m;
    }
    for (long it = gtid; it < (long)NPS * C::MHD; it += gthreads) {
        const int d = (int)(it % C::MHD), sq = (int)(it / C::MHD);
        float m = 0.f, nst = 0.f;
        for (int c = 0; c < C::NC; ++c) { const int ci = sq * C::NC + c; const float a = CBL[ci] + m, b2 = CML[ci], mn = fmaxf(a, b2), dec = __expf(a - mn), f = __expf(b2 - mn);
            const size_t on = (size_t)ci * C::MHD + d; nst = dec * nst + f * DN[on]; DN[on] = nst; m = mn; }
        p.out[C::OUT_NP + ((size_t)l * NPS + sq) * C::MHD + d] = nst;
    }
    for (long it = gtid; it < (long)C::NSC * C::MHD * E4; it += gthreads) {
        const int e4 = (int)(it % E4), d = (int)((it / E4) % C::MHD), q = (int)(it / ((long)E4 * C::MHD)), ci = C::NPC + q;
        const float m0 = p.in[I_SM][(size_t)l * C::NSC + q], a = CBL[ci] + m0, b2 = CML[ci], mn = fmaxf(a, b2), dec = __expf(a - mn), f = __expf(b2 - mn);
        const size_t so = (((size_t)l * C::NSC + q) * C::MHD + d) * C::MHD + e4 * 4; const f32x4 cin = *(const f32x4*)(p.in[I_SC] + so);
        *(f32x4*)(p.out + C::OUT_CS + so) = cin * dec + *(const f32x4*)(DC + ((size_t)ci * C::MHD + d) * C::MHD + e4 * 4) * f;
        u32x2 w; w.x = pg8::cvt_pk_bf16(cin[0], cin[1]); w.y = pg8::cvt_pk_bf16(cin[2], cin[3]); *(u32x2*)(DCB + ((size_t)ci * C::MHD + d) * C::MHD + e4 * 4) = w;
        if (d == 0 && e4 == 0) { MPREV[ci] = m0; p.out[C::OUT_MS + (size_t)l * C::NSC + q] = mn; }
    }
    for (long it = gtid; it < (long)C::NSC * C::MHD; it += gthreads) {
        const int d = (int)(it % C::MHD), q = (int)(it / C::MHD), ci = C::NPC + q;
        const float m0 = p.in[I_SM][(size_t)l * C::NSC + q], a = CBL[ci] + m0, b2 = CML[ci], mn = fmaxf(a, b2), dec = __expf(a - mn), f = __expf(b2 - mn);
        const size_t no = ((size_t)l * C::NSC + q) * C::MHD + d;
        p.out[C::OUT_NS + no] = dec * p.in[I_SN][no] + f * DN[(size_t)ci * C::MHD + d];
    }
}
__device__ __forceinline__ void ml_c(LAS unsigned char* lds, const Ptrs& p, int l, int tid, int bid, int gsz) {
    const int lane = tid & 63, wave = __builtin_amdgcn_readfirstlane(tid >> 6), li = lane & 15, g = lane >> 4, it = wave & 3, eh = wave >> 2;
    LAS unsigned char* Qs = lds; LAS unsigned char* Ks = lds + T64; LAS unsigned char* Vs = lds + 2 * T64; LAS unsigned char* Cs = lds + 3 * T64;
    LAS float* SB = (LAS float*)(lds + 3 * T64 + T128); LAS float* SA = SB + MAXU * 64; LAS float* SMR = SA + MAXU * 64; LAS float* SIW = SMR + MAXU * 64;
    LAS float* snp = SIW + MAXU * 64; LAS float* ssq = snp + 128; LAS float* sgn = ssq + 128;
    const float* P = wsf<C>(p, C::WS_BIG);
    const int nu = bid < C::NCH ? (C::NCH - 1 - bid) / gsz + 1 : 0;
    if (wave < nu) { const int ci = bid + wave * gsz; int r0, h, lc; mx::ch_decode(ci, r0, h, lc); const float mprev = wsf<C>(p, C::WS_MPREV)[ci];
        float b = 0.f, a = -3.0e38f;
        if (lane < lc) { b = wsf<C>(p, C::WS_GB)[(size_t)(r0 + lane) * C::MH + h]; a = wsf<C>(p, C::WS_GA)[(size_t)(r0 + lane) * C::MH + h]; }
        float pm = a;
#pragma unroll
        for (int o = 1; o < 64; o <<= 1) { const float t = __shfl_up(pm, o); if (lane >= o) pm = fmaxf(pm, t); }
        const float mrow = b + fmaxf(mprev, pm);
        SB[wave * 64 + lane] = b; SA[wave * 64 + lane] = a; SMR[wave * 64 + lane] = mrow; SIW[wave * 64 + lane] = __expf(b + mprev - mrow); }
    const unsigned lofs8 = (unsigned)((8 * g + (li >> 2)) * PT + 8 * (li & 3)), lofs4 = (unsigned)((4 * g + (li >> 2)) * PT + 8 * (li & 3));
    const unsigned vs4e = (unsigned)(size_t)Vs + lofs4 + (unsigned)(128 * eh), cb8e = (unsigned)(size_t)Cs + lofs8 + (unsigned)(128 * eh);
    f32x4 pq[4], pk[4], pv[4], og[4]; u32x4 pc[4]; float pn = 0.f, pg = 0.f;
    auto window = [&](int ci) { int r0, h, lc; mx::ch_decode(ci, r0, h, lc); const float* src = P + (size_t)r0 * C::LDP + h * C::MHD;
        const bool sample = ci >= C::NPC, first = !sample && (ci % C::NC) == 0;
#pragma unroll
        for (int q = 0; q < 4; ++q) { const int f = tid + 512 * q, row = f >> 5, c4 = f & 31;
            if (row < lc) { pq[q] = *(const f32x4*)(src + (size_t)row * C::LDP + C::O_Q + c4 * 4); pk[q] = *(const f32x4*)(src + (size_t)row * C::LDP + C::O_K + c4 * 4); pv[q] = *(const f32x4*)(src + (size_t)row * C::LDP + C::O_VM + c4 * 4); }
            else { pq[q] = (f32x4){0.f, 0.f, 0.f, 0.f}; pk[q] = pq[q]; pv[q] = pq[q]; } }
        const bf16_t* cb = wsb<C>(p, C::WS_DCB) + (size_t)(sample ? ci : (first ? ci : ci - 1)) * C::MHD * C::MHD;
#pragma unroll
        for (int q = 0; q < 4; ++q) { const int f = tid + 512 * q; pc[q] = first ? (u32x4){0u, 0u, 0u, 0u} : *(const u32x4*)(cb + (size_t)f * 8); }
        const int i = 16 * it + li;
#pragma unroll
        for (int e4 = 0; e4 < 4; ++e4) og[e4] = (it * 16 < lc) ? *(const f32x4*)(src + (size_t)i * C::LDP + C::O_O + 16 * (4 * eh + e4) + 4 * g) : (f32x4){0.f, 0.f, 0.f, 0.f};
        if (tid < C::MHD) { pn = sample ? p.in[I_SN][((size_t)l * C::NSC + (ci - C::NPC)) * C::MHD + tid] : (first ? 0.f : wsf<C>(p, C::WS_DN)[(size_t)(ci - 1) * C::MHD + tid]);
            pg = p.in[I_NG][(size_t)l * C::MW + h * C::MHD + tid]; }
        __builtin_amdgcn_sched_barrier(0); };
    if (nu > 0) window(bid);
    WG_SYNC();
#if defined(PROBE_MLC)
    unsigned long long tacc[4] = {0, 0, 0, 0}; unsigned long long tprev = wall_clock64();
#define MLC_T(j) do { const unsigned long long tn_ = wall_clock64(); tacc[j] += tn_ - tprev; tprev = tn_; } while (0)
#else
#define MLC_T(j) do { } while (0)
#endif
    for (int j = 0; j < nu; ++j) { const int ci = bid + j * gsz; int r0, h, lc; mx::ch_decode(ci, r0, h, lc);
        const LAS float* sb = SB + j * 64; const LAS float* sa = SA + j * 64; const LAS float* smr = SMR + j * 64; const LAS float* siw = SIW + j * 64;
#pragma unroll
        for (int q = 0; q < 4; ++q) { const int f = tid + 512 * q, row = f >> 5, c4 = f & 31; const float sc = 0.08838834764831845f;
            u32x2 w; w.x = pg8::cvt_pk_bf16(pq[q][0], pq[q][1]); w.y = pg8::cvt_pk_bf16(pq[q][2], pq[q][3]); *(LAS u32x2*)(Qs + row * PT + c4 * 8) = w;
            w.x = pg8::cvt_pk_bf16(pk[q][0] * sc, pk[q][1] * sc); w.y = pg8::cvt_pk_bf16(pk[q][2] * sc, pk[q][3] * sc); *(LAS u32x2*)(Ks + row * PT + c4 * 8) = w;
            w.x = pg8::cvt_pk_bf16(pv[q][0], pv[q][1]); w.y = pg8::cvt_pk_bf16(pv[q][2], pv[q][3]); *(LAS u32x2*)(Vs + row * PT + c4 * 8) = w;
            *(LAS u32x4*)(Cs + (f >> 4) * PT + (f & 15) * 16) = pc[q]; }
        if (tid < C::MHD) { snp[tid] = pn; sgn[tid] = pg; }
        f32x4 ogc[4];
#pragma unroll
        for (int e4 = 0; e4 < 4; ++e4) ogc[e4] = og[e4];
        if (j + 1 < nu) window(ci + gsz);
        WG_SYNC(); MLC_T(0);
        const bool active = it * 16 < lc; const int i = 16 * it + li;
        float ssq_part = 0.f; f32x4 hv[4];
        if (active) {
            bf16x8 qf[4];
#pragma unroll
            for (int ks = 0; ks < 4; ++ks) qf[ks] = *(const LAS bf16x8*)(Qs + i * PT + ks * 64 + g * 16);
            f32x4 st[4];
#pragma unroll
            for (int jt = 0; jt < 4; ++jt) st[jt] = (f32x4){0.f, 0.f, 0.f, 0.f};
#pragma unroll
            for (int jt = 0; jt < 4; ++jt) if (jt <= it) {
#pragma unroll
                for (int ks = 0; ks < 4; ++ks) { const bf16x8 a = *(const LAS bf16x8*)(Ks + (16 * jt + li) * PT + ks * 64 + g * 16);
                    st[jt] = __builtin_amdgcn_mfma_f32_16x16x32_bf16(a, qf[ks], st[jt], 0, 0, 0); } }
            const float bi = sb[i], mri = smr[i], iwi = siw[i];
            float dsum = 0.f;
#pragma unroll
            for (int jt = 0; jt < 4; ++jt)
#pragma unroll
                for (int r = 0; r < 4; ++r) { const int jj = 16 * jt + 4 * g + r; const float w = (jj <= i) ? __expf(bi + sa[jj] - mri) : 0.f; st[jt][r] *= w; dsum += st[jt][r]; }
            dsum += __shfl_xor(dsum, 16); dsum += __shfl_xor(dsum, 32);
            float qn = 0.f;
#pragma unroll
            for (int ks = 0; ks < 4; ++ks)
#pragma unroll
                for (int jj = 0; jj < 8; ++jj) qn += bf2f((bf16_t)qf[ks][jj]) * snp[32 * ks + 8 * g + jj];
            qn += __shfl_xor(qn, 16); qn += __shfl_xor(qn, 32);
            const float den = dsum + iwi * qn, inv_den = 1.0f / fmaxf(fabsf(den), __expf(-mri));
            bf16x8 pf[2];
#pragma unroll
            for (int t = 0; t < 2; ++t) { u32x4 w; w.x = pg8::cvt_pk_bf16(st[2 * t][0], st[2 * t][1]); w.y = pg8::cvt_pk_bf16(st[2 * t][2], st[2 * t][3]);
                w.z = pg8::cvt_pk_bf16(st[2 * t + 1][0], st[2 * t + 1][1]); w.w = pg8::cvt_pk_bf16(st[2 * t + 1][2], st[2 * t + 1][3]); pf[t] = __builtin_bit_cast(bf16x8, w); }
#pragma unroll
            for (int e2 = 0; e2 < 2; ++e2) {
                s16x4 vlo[2][2], vhi[2][2], clo[2][4], chi[2][4];
#pragma unroll
                for (int u = 0; u < 2; ++u) {
#pragma unroll
                    for (int t = 0; t < 2; ++t) { MP_TR(vlo[u][t], vs4e, (32 * t) * PT + 32 * (2 * e2 + u)); MP_TR(vhi[u][t], vs4e, (32 * t + 16) * PT + 32 * (2 * e2 + u)); }
#pragma unroll
                    for (int ks = 0; ks < 4; ++ks) { MP_TR(clo[u][ks], cb8e, (32 * ks) * PT + 32 * (2 * e2 + u)); MP_TR(chi[u][ks], cb8e, (32 * ks + 4) * PT + 32 * (2 * e2 + u)); } }
                mx::lds_wait();
#pragma unroll
                for (int u = 0; u < 2; ++u) { const int e4 = 2 * e2 + u;
                    f32x4 aS = (f32x4){0.f, 0.f, 0.f, 0.f}, aC = (f32x4){0.f, 0.f, 0.f, 0.f};
#pragma unroll
                    for (int t = 0; t < 2; ++t) aS = __builtin_amdgcn_mfma_f32_16x16x32_bf16(mx::mk8(vlo[u][t], vhi[u][t]), pf[t], aS, 0, 0, 0);
#pragma unroll
                    for (int ks = 0; ks < 4; ++ks) aC = __builtin_amdgcn_mfma_f32_16x16x32_bf16(mx::mk8(clo[u][ks], chi[u][ks]), qf[ks], aC, 0, 0, 0);
                    hv[e4] = (aS + aC * iwi) * inv_den;
                    ssq_part += (hv[e4][0] * hv[e4][0] + hv[e4][1] * hv[e4][1]) + (hv[e4][2] * hv[e4][2] + hv[e4][3] * hv[e4][3]); } }
            ssq_part += __shfl_xor(ssq_part, 16); ssq_part += __shfl_xor(ssq_part, 32);
            if (g == 0) ssq[wave * 16 + li] = ssq_part;
        }
        MLC_T(1); WG_SYNC();
        if (active) {
            const float tot = ssq_part + ssq[(wave ^ 4) * 16 + li];
            const float rs = rsqrtf(tot * (1.0f / C::MHD) + 1e-6f);
            const int row = r0 + i;
#pragma unroll
            for (int e4 = 0; e4 < 4; ++e4) { const int e = 16 * (4 * eh + e4) + 4 * g; const f32x4 gn = *(const LAS f32x4*)(sgn + e);
                float o4[4];
#pragma unroll
                for (int r = 0; r < 4; ++r) o4[r] = hv[e4][r] * rs * gn[r] * __builtin_amdgcn_rcpf(1.0f + __expf(-ogc[e4][r]));
                u32x2 w; w.x = pg8::cvt_pk_bf16(o4[0], o4[1]); w.y = pg8::cvt_pk_bf16(o4[2], o4[3]);
                *(u32x2*)(wsb<C>(p, C::WS_MIX) + (size_t)row * C::D + C::PW + C::GW + h * C::MHD + e) = w; }
        }
        MLC_T(2); WG_SYNC(); MLC_T(3);
    }
#if defined(PROBE_MLC)
    if (bid == 0 && tid == 0) { unsigned long long* TS = (unsigned long long*)(p.ws + C::WS_CTL + 32768); for (int j = 0; j < 4; ++j) TS[48 + j] += tacc[j]; }
#endif
}
}
constexpr int PH_PER_LAYER = 12, N_PHASES = 2 + PH_PER_LAYER * C::DEPTH;
struct Args { Ptrs p; int ph_lo, ph_hi; };
__global__ void __launch_bounds__(NTHREADS, 2) fwd(Args a) {
    extern __shared__ __attribute__((aligned(16))) unsigned char lds_raw[];
    LAS unsigned char* lds = (LAS unsigned char*)lds_raw;
    typedef __attribute__((address_space(4))) const Args* KArgs;
    const KArgs ka0 = (KArgs)__builtin_amdgcn_kernarg_segment_ptr();
    const int lo = a.ph_lo, hi = a.ph_hi;
#define IN(k) (lo <= (k) && (k) < hi)
#define BOTH(k) (IN(k) && IN((k) + 1))
#define GRID_BAR(k) do { if (BOTH(k)) { xcd_barrier(bar); } } while (0)
#if defined(__HIP_DEVICE_COMPILE__)
#define LOAD_PTRS KArgs ka = ka0; asm volatile("" : "+s"(ka)); Ptrs p; _Pragma("unroll") for (int i_ = 0; i_ < 33; ++i_) p.in[i_] = ka->p.in[i_]; p.out = ka->p.out; p.ws = ka->p.ws;
#else
#define LOAD_PTRS (void)ka0; const Ptrs p = a.p;
#endif
#define PHASE_ARGS LOAD_PTRS int tid = threadIdx.x; asm volatile("" : "+v"(tid)); int bid = blockIdx.x, gsz = gridDim.x; asm volatile("" : "+s"(bid), "+s"(gsz));     \
    const int lane = tid & 63, wave = __builtin_amdgcn_readfirstlane(tid >> 6); (void)lane; (void)wave; \
    const long gtid = (long)bid * NTHREADS + tid, gthreads = (long)gsz * NTHREADS; (void)gtid; (void)gthreads; \
    float* SS = wsf<C>(p, C::WS_SS); (void)SS; const float invd = 1.0f / C::D; (void)invd;
#if defined(PROBE_MASK_A)
#define STAMP(k) do { if (blockIdx.x == 0 && threadIdx.x == 0) ((unsigned long long*)(a.p.ws + C::WS_CTL + 32768))[k] = wall_clock64(); } while (0)
#else
#define STAMP(k) do { } while (0)
#endif
#define ITEMS(n, call) do { for (long it = gtid; it < (long)(n); it += gthreads) { call; } } while (0)
#define SSL(j) (SS + (size_t)(4 * l + (j)) * C::M)
#define GEMM_ALL(STRIP, EPI, Aop, Bop, Mr, Nc, Kd, ...) do { pg8::Gemm g{Aop, Bop, Mr, Nc, Kd, Kd}; pg8::StaticOrder S; S.init(Mr, Nc, gsz, bid, (STRIP) ? 288 : 256); \
        pg8::EPI E{__VA_ARGS__}; pg8::gemm_phase<pg8::EPI, pg8::StaticOrder, STRIP, false>(lds, g, S, E, nullptr); } while (0)
#if ONE_LAUNCH
    if (threadIdx.x < 4) ((LAS unsigned*)(lds + LDS_CTL))[threadIdx.x] = 0u;
    __syncthreads();
    XcdBarrier bar = xcd_barrier_post((unsigned*)(a.p.ws + C::WS_CTL), (volatile LAS unsigned*)(lds + LDS_CTL));
#else
    XcdBarrier bar; bar.bar = nullptr; bar.x = 0; bar.st = nullptr;
#endif

    if (IN(0)) { PHASE_ARGS STAMP(0);
        const int gw = bid * NWAVES + wave, NGW = gsz * NWAVES;
        for (int l = 0; l < C::DEPTH; ++l)
            for (int idx = 0; idx < 10; ++idx) { const WDesc d = wdesc(p, l, idx); const int nitems = (d.K / 64) * (d.N / 64);
                for (int it = gw; it < nitems; it += NGW) prep_item(d.W, d.K, d.Ncols, d.g, d.kind, d.N, d.dst, lds + wave * 9216, it, lane); }
        rw::rows_init(p, tid, bid, gsz);
        GRID_BAR(0);
    }
    for (int l = 0; l < C::DEPTH; ++l) {
        const int pb = 1 + PH_PER_LAYER * l;
        if (IN(pb + 0)) { PHASE_ARGS STAMP(pb + 0);
#if defined(PROBE_GST)
            if (l == 0) { pg8::Gemm g{wsb<C>(p, C::WS_XB), wlayer<C>(p, l, C::W_1IN), C::M, 2 * C::FF, C::D, C::D}; pg8::StaticOrder S; S.init(C::M, 2 * C::FF, gsz, bid, 288);
                pg8::EpiSwiGLU E{wsb<C>(p, C::WS_BIG), SSL(0), C::FF, invd}; pg8::gemm_phase<pg8::EpiSwiGLU, pg8::StaticOrder, true, true>(lds, g, S, E, (unsigned long long*)(p.ws + C::WS_END) + (size_t)bid * 64); } else
#endif
            GEMM_ALL(true, EpiSwiGLU, wsb<C>(p, C::WS_XB), wlayer<C>(p, l, C::W_1IN), C::M, 2 * C::FF, C::D, wsb<C>(p, C::WS_BIG), SSL(0), C::FF, invd);
            GRID_BAR(pb + 0); }
        if (IN(pb + 1)) { PHASE_ARGS STAMP(pb + 1);
            GEMM_ALL(true, EpiResid, wsb<C>(p, C::WS_BIG), wlayer<C>(p, l, C::W_1OUT), C::M, C::D, C::FF, wsf<C>(p, C::WS_X), wsb<C>(p, C::WS_XB), SSL(1), 0.5f, C::D);
            GRID_BAR(pb + 1); }
        if (IN(pb + 2)) { PHASE_ARGS STAMP(pb + 2);
            GEMM_ALL(true, EpiScaleF32, wsb<C>(p, C::WS_XB), wlayer<C>(p, l, C::W_IN), C::M, C::LDP, C::D, wsf<C>(p, C::WS_BIG), C::LDP, SSL(1), invd);
            GRID_BAR(pb + 2); }
        if (IN(pb + 3)) { PHASE_ARGS STAMP(pb + 3); mp::ml_a(lds, p, l, tid, bid, gsz);
#if defined(PROBE_MIXA)
            xcd_barrier(bar); STAMP(40 + l);
#endif
            gp::gmlp_phase(lds, p, l, tid, bid, gsz);
#if defined(PROBE_MIXA)
            xcd_barrier(bar); STAMP(42 + l);
#endif
            GRID_BAR(pb + 3); }
        if (IN(pb + 4)) { PHASE_ARGS STAMP(pb + 4);
            if (bid < 64) {
                pg8::Gemm g{wsb<C>(p, C::WS_MEMB), wlayer<C>(p, l, C::W_KV), C::MM, 2 * C::D, C::D, C::D}; pg8::StaticOrder S; S.init(C::MM, 2 * C::D, 64, bid);
                pg8::EpiMemKV E{p.out + C::OUT_MK + (size_t)l * C::MM * C::D, p.out + C::OUT_MV + (size_t)l * C::MM * C::D, wsf<C>(p, C::WS_RSTDM), C::D};
                pg8::gemm_phase<pg8::EpiMemKV, pg8::StaticOrder, false, false>(lds, g, S, E, nullptr);
            } else { mp::ml_scan(p, l, (long)(bid - 64) * NTHREADS + tid, (long)(gsz - 64) * NTHREADS); gp::pool_phase(lds, p, l, tid, bid - 64, gsz - 64); }
            GRID_BAR(pb + 4); }
        if (IN(pb + 5)) { PHASE_ARGS STAMP(pb + 5); mp::ml_c(lds, p, l, tid, bid, gsz); GRID_BAR(pb + 5); }
        if (IN(pb + 6)) { PHASE_ARGS STAMP(pb + 6);
            GEMM_ALL(true, EpiResid, wsb<C>(p, C::WS_MIX), wlayer<C>(p, l, C::W_OUT), C::M, C::D, C::D, wsf<C>(p, C::WS_X), wsb<C>(p, C::WS_XB), SSL(2), 1.0f, C::D);
            GRID_BAR(pb + 6); }
        if (IN(pb + 7)) { PHASE_ARGS STAMP(pb + 7);
            GEMM_ALL(true, EpiScaleBf16, wsb<C>(p, C::WS_XB), wlayer<C>(p, l, C::W_Q), C::M, C::D, C::D, wsb<C>(p, C::WS_Q), C::D, SSL(2), invd);
            GRID_BAR(pb + 7); }
        if (IN(pb + 8)) { PHASE_ARGS STAMP(pb + 8); att::attn_phase(lds, p, l, tid, bid, gsz); GRID_BAR(pb + 8); }
        if (IN(pb + 9)) { PHASE_ARGS STAMP(pb + 9);
            GEMM_ALL(true, EpiResid, wsb<C>(p, C::WS_AO), wlayer<C>(p, l, C::W_O), C::M, C::D, C::D, wsf<C>(p, C::WS_X), wsb<C>(p, C::WS_XB), SSL(3), 1.0f, C::D);
            GRID_BAR(pb + 9); }
        if (IN(pb + 10)) { PHASE_ARGS STAMP(pb + 10);
            GEMM_ALL(true, EpiSwiGLU, wsb<C>(p, C::WS_XB), wlayer<C>(p, l, C::W_2IN), C::M, 2 * C::FF, C::D, wsb<C>(p, C::WS_BIG), SSL(3), C::FF, invd);
            GRID_BAR(pb + 10); }
        if (IN(pb + 11)) { PHASE_ARGS STAMP(pb + 11);
            GEMM_ALL(true, EpiResid, wsb<C>(p, C::WS_BIG), wlayer<C>(p, l, C::W_2OUT), C::M, C::D, C::FF, wsf<C>(p, C::WS_X), wsb<C>(p, C::WS_XB), SSL(4), 0.5f, C::D);
            GRID_BAR(pb + 11); }
    }
    if (IN(N_PHASES - 1)) { PHASE_ARGS STAMP(N_PHASES - 1); __syncthreads(); rw::rows_final(p, tid, bid, gsz); }
#undef IN
#undef BOTH
#undef GRID_BAR
#undef ITEMS
#undef PHASE_ARGS
#undef SSL
}

extern "C" void kernel_launch(void* const* d_in, const int* in_sizes, int n_in, void* d_out, int out_size, void* d_ws, size_t ws_size, hipStream_t stream) {
    static int ready = 0;
    if (!ready) {
        if (n_in != 33 || (long)out_size != (long)C::OUT_END || ws_size < (size_t)C::WS_END) { fprintf(stderr, "kernel_launch: unexpected shapes: n_in %d out %d ws %zu (need %zu)\n", n_in, out_size, ws_size, (size_t)C::WS_END); ready = -1; return; }
        if (hipFuncSetAttribute((const void*)fwd, hipFuncAttributeMaxDynamicSharedMemorySize, LDS_BYTES) != hipSuccess) { fprintf(stderr, "kernel_launch: hipFuncSetAttribute failed\n"); ready = -1; return; }
        int dev = 0, cus = 0, per_cu = 0;
        if (hipGetDevice(&dev) != hipSuccess || hipDeviceGetAttribute(&cus, hipDeviceAttributeMultiprocessorCount, dev) != hipSuccess) { fprintf(stderr, "kernel_launch: device query failed\n"); ready = -1; return; }
        if (hipOccupancyMaxActiveBlocksPerMultiprocessor(&per_cu, (const void*)fwd, NTHREADS, LDS_BYTES) != hipSuccess || per_cu < 1) { fprintf(stderr, "kernel_launch: occupancy query reports %d blocks per CU\n", per_cu); (void)hipGetLastError(); per_cu = 1; }
        if (cus != 256) { fprintf(stderr, "kernel_launch: built for a 256-CU device (one resident workgroup per CU), found %d\n", cus); ready = -1; return; }
        ready = cus;
    }
    if (ready < 0) return;
    Args a{};
    for (int i = 0; i < 33; ++i) a.p.in[i] = (const float*)d_in[i];
    a.p.out = (float*)d_out; a.p.ws = (unsigned char*)d_ws;
#if ONE_LAUNCH
    (void)hipMemsetAsync((char*)d_ws + C::WS_CTL, 0, 65536, stream);
    a.ph_lo = 0; a.ph_hi = N_PHASES;
    hipLaunchKernelGGL(fwd, dim3(ready), dim3(NTHREADS), LDS_BYTES, stream, a);
#else
    for (int k = 0; k < N_PHASES; ++k) { a.ph_lo = k; a.ph_hi = k + 1; hipLaunchKernelGGL(fwd, dim3(ready), dim3(NTHREADS), LDS_BYTES, stream, a); }
#endif
}
```

```cpp
#include <hip/hip_runtime.h>
#include <cstdio>
#define ONE_LAUNCH 1

#define HD __host__ __device__
#ifndef HD
#define HD __host__ __device__
#endif
typedef unsigned short bf16_t;
HD inline unsigned f2u(float f) { return __builtin_bit_cast(unsigned, f); }
HD inline float u2f(unsigned u) { return __builtin_bit_cast(float, u); }
HD inline bf16_t f2bf(float f) { unsigned u = f2u(f); u += 0x7FFFu + ((u >> 16) & 1u); return (bf16_t)(u >> 16); }
HD inline float bf2f(bf16_t b) { return u2f(((unsigned)b) << 16); }

struct RC {
    static constexpr int D = 2048, FF = 8192, BATCH = 4, SEQ = 2048, DEPTH = 2, DEC_BATCH = 32, DEC_SEQ = 32, PAST = 2048, NMEM = 256;
};
template <class B> struct CfgT : B {
    using B::D; using B::FF; using B::BATCH; using B::SEQ; using B::DEPTH; using B::DEC_BATCH; using B::DEC_SEQ; using B::PAST; using B::NMEM;
    static constexpr int MP = BATCH * SEQ, MS = DEC_BATCH * DEC_SEQ, M = MP + MS, MM = BATCH * NMEM;
    static constexpr int PW = D / 4, PG = 4, PGD = PW / 4, PH = 15;
    static constexpr int GW = D / 4, GH = 4, GHD = GW / 4, GCH = 128;
    static constexpr int MW = D - PW - GW, MH = 8, MHD = MW / 8, CH = 64;
    static constexpr int INC = PW + 2 * GW + 4 * MW + 2 * MH;
    static constexpr int LDP = ((INC + 255) / 256) * 256;
    static constexpr int AH = 4, AHD = D / 4;
    static constexpr int O_U = PW, O_V = PW + GW, O_Q = PW + 2 * GW, O_K = O_Q + MW, O_VM = O_K + MW, O_O = O_VM + MW, O_IG = O_O + MW, O_FG = O_IG + MH;
    static constexpr int NC = SEQ / CH, NPC = BATCH * MH * NC, NSC = DEC_BATCH * MH, NCH = NPC + NSC;
    static constexpr int LCS = DEC_SEQ < CH ? DEC_SEQ : CH;
    static constexpr int GLP = SEQ < GCH ? SEQ : GCH, GLS = DEC_SEQ < GCH ? DEC_SEQ : GCH;
    static constexpr int NSS = 1 + 4 * DEPTH;
    static constexpr long OUT_YP = 0, OUT_YS = OUT_YP + (long)MP * D, OUT_POOLP = OUT_YS + (long)MS * D, OUT_POOLS = OUT_POOLP + (long)DEPTH * BATCH * PH * PW,
        OUT_CP = OUT_POOLS + (long)DEPTH * DEC_BATCH * PH * PW, OUT_NP = OUT_CP + (long)DEPTH * BATCH * MH * MHD * MHD, OUT_MP = OUT_NP + (long)DEPTH * BATCH * MH * MHD,
        OUT_CS = OUT_MP + (long)DEPTH * BATCH * MH, OUT_NS = OUT_CS + (long)DEPTH * DEC_BATCH * MH * MHD * MHD, OUT_MS = OUT_NS + (long)DEPTH * DEC_BATCH * MH * MHD,
        OUT_VS = OUT_MS + (long)DEPTH * DEC_BATCH * MH, OUT_MK = OUT_VS + (long)DEPTH * DEC_BATCH * DEC_SEQ * GW, OUT_MV = OUT_MK + (long)DEPTH * BATCH * NMEM * D,
        OUT_END = OUT_MV + (long)DEPTH * BATCH * NMEM * D;
    static constexpr size_t al(size_t x) { return (x + 255) & ~(size_t)255; }
    static constexpr size_t WS_CTL = 0, WS_SS = 65536, WS_X = al(WS_SS + (size_t)NSS * M * 4), WS_XB = al(WS_X + (size_t)M * D * 4),
        WS_BIG = al(WS_XB + (size_t)M * D * 2),
        WS_BIG_SZ = ((size_t)M * FF * 2 > (size_t)M * LDP * 4) ? (size_t)M * FF * 2 : (size_t)M * LDP * 4,
        WS_MIX = al(WS_BIG + WS_BIG_SZ), WS_Q = al(WS_MIX + (size_t)M * D * 2), WS_AO = al(WS_Q + (size_t)M * D * 2),
        WS_MEMB = al(WS_AO + (size_t)M * D * 2), WS_RSTDM = al(WS_MEMB + (size_t)MM * D * 2),
        WS_GB = al(WS_RSTDM + (size_t)MM * 4), WS_GA = al(WS_GB + (size_t)M * MH * 4),
        WS_CBL = al(WS_GA + (size_t)M * MH * 4), WS_CML = al(WS_CBL + (size_t)NCH * 4), WS_MPREV = al(WS_CML + (size_t)NCH * 4),
        WS_DC = al(WS_MPREV + (size_t)NCH * 4), WS_DN = al(WS_DC + (size_t)NCH * MHD * MHD * 4),
        WS_DCB = al(WS_DN + (size_t)NCH * MHD * 4),
        WS_W = al(WS_DCB + (size_t)NCH * MHD * MHD * 2);
    static constexpr size_t W_1IN = 0, W_1OUT = W_1IN + (size_t)2 * FF * D, W_IN = W_1OUT + (size_t)D * FF, W_OUT = W_IN + (size_t)LDP * D, W_Q = W_OUT + (size_t)D * D,
        W_KV = W_Q + (size_t)D * D, W_O = W_KV + (size_t)2 * D * D, W_2IN = W_O + (size_t)D * D, W_2OUT = W_2IN + (size_t)2 * FF * D, W_LAYER = W_2OUT + (size_t)D * FF;
    static constexpr size_t WS_END = al(WS_W + (size_t)DEPTH * W_LAYER * 2);
};

struct Ptrs { const float* in[33]; float* out; unsigned char* ws; };
enum { I_XP = 0, I_XS, I_MEM, I_SPOOL, I_SC, I_SN, I_SM, I_CK, I_CV, I_GFFN1, I_W1IN, I_W1OUT, I_GMIX, I_WIN, I_POOLW, I_POOLS, I_GVG, I_GWS, I_GBS, I_IB, I_FB, I_NG, I_WOUT,
       I_GX, I_GMEM, I_WQ, I_WK, I_WV, I_WO, I_GFFN2, I_W2IN, I_W2OUT, I_GFIN };

template <class C> HD inline float* wsf(const Ptrs& p, size_t off) { return (float*)(p.ws + off); }
template <class C> HD inline bf16_t* wsb(const Ptrs& p, size_t off) { return (bf16_t*)(p.ws + off); }
template <class C> HD inline bf16_t* wlayer(const Ptrs& p, int l, size_t off) { return (bf16_t*)(p.ws + C::WS_W) + (size_t)l * C::W_LAYER + off; }

template <class C> HD inline void row_info(int r, bool& s, int& b, int& t) {
    if (r < C::MP) { s = false; b = r / C::SEQ; t = r % C::SEQ; } else { s = true; const int q = r - C::MP; b = q / C::DEC_SEQ; t = q % C::DEC_SEQ; }
}
template <class C> HD inline void chunk_info(int r, int h, int& ci, int& i, int& lc) {
    bool s; int b, t; row_info<C>(r, s, b, t);
    if (!s) { ci = (b * C::MH + h) * C::NC + t / C::CH; i = t % C::CH; lc = C::CH; } else { ci = C::NPC + b * C::MH + h; i = t; lc = C::LCS; }
}
HD inline float sigmoidf_(float x) { return 1.0f / (1.0f + expf(-x)); }
HD inline float logsigmoidf_(float x) { return x >= 0.f ? -log1pf(expf(-x)) : x - log1pf(expf(x)); }

enum { WK_PLAIN = 0, WK_FFNIN = 1, WK_WIN = 2 };
template <class C> HD inline int wsrc_col(int kind, int n) {
    if (kind == WK_FFNIN) { const int pn = n >> 8, j = n & 255; return j < 128 ? 128 * pn + j : C::FF + 128 * pn + (j - 128); }
    if (kind == WK_WIN) return n < C::INC ? n : -1;
    return n;
}

template <class C> HD inline void st_ml_b0(const Ptrs& p, int l, int sq) {
    const float* CBL = wsf<C>(p, C::WS_CBL); const float* CML = wsf<C>(p, C::WS_CML); float* MPREV = wsf<C>(p, C::WS_MPREV);
    if (sq < C::BATCH * C::MH) { float m = 0.f;
        for (int c = 0; c < C::NC; ++c) { const int ci = sq * C::NC + c; MPREV[ci] = m; const float a = CBL[ci] + m, b2 = CML[ci]; m = a > b2 ? a : b2; }
        p.out[C::OUT_MP + (size_t)l * C::BATCH * C::MH + sq] = m;
    } else { const int q = sq - C::BATCH * C::MH, ci = C::NPC + q; const float m0 = p.in[I_SM][(size_t)l * C::DEC_BATCH * C::MH + q];
        MPREV[ci] = m0; const float a = CBL[ci] + m0, b2 = CML[ci]; p.out[C::OUT_MS + (size_t)l * C::DEC_BATCH * C::MH + q] = a > b2 ? a : b2; }
}

namespace pg8 {
#define PG8_LAS __attribute__((address_space(3)))
typedef unsigned short bf16_t;
typedef short bf16x8 __attribute__((ext_vector_type(8)));
typedef float f32x4 __attribute__((ext_vector_type(4)));
typedef unsigned u32x4 __attribute__((ext_vector_type(4)));
constexpr int BM = 256, BK = 64, HALF = 128, HTB = HALF * BK * 2  , STAGE_BYTES = 8 * HTB, NXCD = 8, WGM = 8;

__host__ __device__ __forceinline__ int lds_byte(int r, int c) { const int st = (r >> 4) * 2 + (c >> 5), rr = r & 15, cc = c & 31, ob = rr * 64 + cc * 2; return st * 1024 + (ob ^ (((ob >> 9) & 1) << 5)); }
__host__ __device__ __forceinline__ void stage_rc(int b, int& R, int& C) { const int st = b / 1024, sb = b % 1024, swz = sb ^ (((sb >> 9) & 1) << 5); R = (st >> 1) * 16 + swz / 64; C = (st & 1) * 32 + (swz % 64) / 2; }
__host__ __device__ __forceinline__ int perm32(int rho) { const int n = rho >> 4, i = rho & 15; return 8 * (i >> 2) + 4 * n + (i & 3); }

struct Unit { int pm, pn; };
struct Gemm { const bf16_t* A; const bf16_t* Bt; int M, N, K, ld; };

struct StaticOrder {
    int nM, nN, nwg, G, c;
    __host__ __device__ __forceinline__ void init(int M, int N, int G_, int c_, int rows_per_tile = BM) { nM = M / rows_per_tile; nN = N / BM; nwg = nM * nN; G = G_; c = c_; }
    __host__ __device__ __forceinline__ bool next(int i, Unit& u) const {
        const long L = (long)i * G + c; if (L >= nwg) return false;
        int wgid = (int)L; { const int q = nwg / NXCD, r = nwg % NXCD, xcd = wgid % NXCD, off = wgid / NXCD; wgid = (xcd < r ? xcd * (q + 1) : r * (q + 1) + (xcd - r) * q) + off; }
        const int nig = WGM * nN, gid = wgid / nig, fm = gid * WGM, gsz = (nM - fm) < WGM ? (nM - fm) : WGM;
        u.pm = fm + ((wgid % nig) % gsz); u.pn = (wgid % nig) / gsz; return true;
    }
    __device__ __forceinline__ void a_ready(const Unit&) const {}
    __device__ __forceinline__ void done(const Unit&) const {}
};
__device__ __forceinline__ unsigned cvt_pk_bf16(float lo, float hi) { unsigned r; asm volatile("v_cvt_pk_bf16_f32 %0, %1, %2" : "=v"(r) : "v"(lo), "v"(hi)); return r; }
typedef float f32x2 __attribute__((ext_vector_type(2)));
template <class Epi, class Sched, bool STRIP = false, bool STAMP = false>
__device__ __forceinline__ void gemm_phase(PG8_LAS unsigned char* lds, const Gemm g, const Sched& S, const Epi& E, unsigned long long* stamps) {
    int tid_l = threadIdx.x; asm volatile("" : "+v"(tid_l));
    const int tid = tid_l, wid = __builtin_amdgcn_readfirstlane(tid >> 6), lane = tid & 63, wr = wid >> 2, wc = wid & 3, fr = lane & 15, fq = lane >> 4;
    const int K = g.K, nt = K / BK;
    int ts_lo = 0, ts_hi = 0, nts = 0; const unsigned long long rt_entry = STAMP ? (unsigned long long)wall_clock64() : 0ull;
#define PG8_STAMP() do { if (STAMP && wid == 0 && nts < 64) { const unsigned long long _c = (unsigned long long)clock64(); \
        ts_lo = (lane == nts) ? (int)(unsigned)_c : ts_lo; ts_hi = (lane == nts) ? (int)(unsigned)(_c >> 32) : ts_hi; ++nts; } } while (0)
    PG8_STAMP();
    unsigned voffA[2], voffB[2];
#pragma unroll
    for (int i = 0; i < 2; ++i) { int R, C; stage_rc(tid * 16 + i * 8192, R, C); const int Rb = Epi::PERM ? ((R & ~31) + perm32(R & 31)) : R;
        voffA[i] = (unsigned)(R * g.ld + C) * 2u; voffB[i] = (unsigned)(Rb * g.ld + C) * 2u; }
    const size_t kstep = (size_t)(BK * 2);
    const size_t hstep = (size_t)HALF * g.ld * 2;
    const size_t tstep = 2 * hstep;
    const size_t tstepA = STRIP ? (size_t)288 * g.ld * 2 : tstep;
    unsigned voffS = 0u; if constexpr (STRIP) { int R, C; stage_rc((wid & 3) * 1024 + lane * 16, R, C); voffS = (unsigned)(R * g.ld + C) * 2u; }
    const int soff = lds_byte(wr * 16 + fr, fq * 8);
    const unsigned ldsw = (unsigned)wid * 1024u;
    const int aoff = lds_byte(wr * 64 + fr, fq * 8), boff = lds_byte(wc * 32 + fr, fq * 8);
#define PG8_SA(b, h) (((b) * 2 + (h)) * HTB)
#define PG8_SB(b, h) ((4 + (b) * 2 + (h)) * HTB)
#define PG8_SS(b) (8 * HTB + (b) * 8192)
#define PG8_STAGE_S(b, gbase) do { if constexpr (STRIP) __builtin_amdgcn_global_load_lds((const unsigned*)((const char*)(gbase) + 2 * hstep + voffS), (PG8_LAS unsigned*)(lds + PG8_SS(b) + ldsw), 16, 0, 0); } while (0)
#define PG8_LDS(b) do { if constexpr (STRIP) { _Pragma("unroll") for (int k = 0; k < 2; ++k) Sf[k] = *(const PG8_LAS bf16x8*)(lds + PG8_SS(b) + soff + k * 1024); } } while (0)
#define PG8_MMS(bj, Bt) do { if constexpr (STRIP) { __builtin_amdgcn_s_setprio(1); _Pragma("unroll") for (int n = 0; n < 2; ++n) _Pragma("unroll") for (int k = 0; k < 2; ++k) accS[bj][n] = __builtin_amdgcn_mfma_f32_16x16x32_bf16(Bt[n][k], Sf[k], accS[bj][n], 0, 0, 0); __builtin_amdgcn_s_setprio(0); } } while (0)
#define PG8_STAGE(bufoff, gbase, voff) do { _Pragma("unroll") for (int _i = 0; _i < 2; ++_i) \
        __builtin_amdgcn_global_load_lds((const unsigned*)((const char*)(gbase) + (voff)[_i]), (PG8_LAS unsigned*)(lds + (bufoff) + ldsw + _i * 8192), 16, 0, 0); } while (0)
#define PG8_LDA(dst, b, h) do { _Pragma("unroll") for (int m = 0; m < 4; ++m) _Pragma("unroll") for (int k = 0; k < 2; ++k) dst[m][k] = *(const PG8_LAS bf16x8*)(lds + PG8_SA(b, h) + aoff + m * 2048 + k * 1024); } while (0)
#define PG8_LDB(dst, b, h) do { _Pragma("unroll") for (int n = 0; n < 2; ++n) _Pragma("unroll") for (int k = 0; k < 2; ++k) dst[n][k] = *(const PG8_LAS bf16x8*)(lds + PG8_SB(b, h) + boff + n * 2048 + k * 1024); } while (0)
#define PG8_MMA(ai, bj, At, Bt) do { __builtin_amdgcn_s_setprio(1); _Pragma("unroll") for (int m = 0; m < 4; ++m) _Pragma("unroll") for (int n = 0; n < 2; ++n) _Pragma("unroll") for (int k = 0; k < 2; ++k) \
        acc[ai][bj][m][n] = __builtin_amdgcn_mfma_f32_16x16x32_bf16(Bt[n][k], At[m][k], acc[ai][bj][m][n], 0, 0, 0); __builtin_amdgcn_s_setprio(0); } while (0)
#define PG8_WAIT_V(n) asm volatile("s_waitcnt vmcnt(" #n ")" ::: "memory")
#define PG8_WAIT_L(n) asm volatile("s_waitcnt lgkmcnt(" #n ")" ::: "memory")
#define PG8_WAIT_VS(n, ns) do { if constexpr (STRIP) PG8_WAIT_V(ns); else PG8_WAIT_V(n); } while (0)
#define PG8_WAIT_LS(n, ns) do { if constexpr (STRIP) PG8_WAIT_L(ns); else PG8_WAIT_L(n); } while (0)
#define PG8_BAR __builtin_amdgcn_s_barrier()
#define PG8_SCHED __builtin_amdgcn_sched_barrier(0)
    Unit cur, nxt; int ui = 0;
    if (!S.next(0, cur)) return;
    f32x4 acc[2][2][4][2];
#pragma unroll
    for (int a = 0; a < 2; ++a)
#pragma unroll
        for (int b = 0; b < 2; ++b)
#pragma unroll
            for (int m = 0; m < 4; ++m)
#pragma unroll
                for (int n = 0; n < 2; ++n) acc[a][b][m][n] = (f32x4){0.f, 0.f, 0.f, 0.f};
    bf16x8 At[4][2], B0[2][2], B1[2][2];
    f32x4 accS[2][2]; bf16x8 Sf[2];
#pragma unroll
    for (int b = 0; b < 2; ++b)
#pragma unroll
        for (int n = 0; n < 2; ++n) accS[b][n] = (f32x4){0.f, 0.f, 0.f, 0.f};
#pragma unroll
    for (int k = 0; k < 2; ++k) Sf[k] = (bf16x8){0, 0, 0, 0, 0, 0, 0, 0};
    const char* cA = (const char*)g.A + (size_t)cur.pm * tstepA; const char* cB = (const char*)g.Bt + (size_t)cur.pn * tstep;
    S.a_ready(cur);
    PG8_STAGE(PG8_SB(0, 0), cB, voffB); PG8_STAGE(PG8_SA(0, 0), cA, voffA); PG8_STAGE(PG8_SB(0, 1), cB + hstep, voffB); PG8_STAGE(PG8_SA(0, 1), cA + hstep, voffA); PG8_STAGE_S(0, cA);
    if (wr == 1) PG8_BAR;
    PG8_WAIT_VS(4, 5); PG8_BAR;
    PG8_STAGE(PG8_SB(1, 0), cB + kstep, voffB); PG8_STAGE(PG8_SA(1, 0), cA + kstep, voffA); PG8_STAGE(PG8_SB(1, 1), cB + hstep + kstep, voffB); PG8_STAGE_S(1, cA + kstep);
    PG8_WAIT_VS(6, 7); PG8_BAR;
    PG8_STAMP();
    for (;;) {
        const bool has_next = S.next(ui + 1, nxt);
        const char* nA = has_next ? (const char*)g.A + (size_t)nxt.pm * tstepA : cA; const char* nB = has_next ? (const char*)g.Bt + (size_t)nxt.pn * tstep : cB;
        for (int t = 0; t < nt; t += 2) {
            const bool last = (t == nt - 2);
            const char* a1 = cA + (size_t)(t + 1) * kstep;
            const char* a2 = last ? nA : cA + (size_t)(t + 2) * kstep; const char* b2 = last ? nB : cB + (size_t)(t + 2) * kstep;
            const char* a3 = a2 + kstep; const char* b3 = b2 + kstep;
            if (last && has_next) S.a_ready(nxt);
            PG8_LDB(B0, 0, 0); PG8_SCHED; PG8_LDA(At, 0, 0); PG8_LDS(0); PG8_STAGE(PG8_SA(1, 1), a1 + hstep, voffA);
            PG8_WAIT_LS(8, 10); PG8_BAR; PG8_WAIT_L(0); PG8_MMA(0, 0, At, B0); PG8_MMS(0, B0); PG8_BAR; PG8_SCHED;
            PG8_LDB(B1, 0, 1); PG8_STAGE(PG8_SB(0, 0), b2, voffB);
            PG8_BAR; PG8_WAIT_L(0); PG8_MMA(0, 1, At, B1); PG8_MMS(1, B1); PG8_BAR;
            PG8_LDA(At, 0, 1); PG8_STAGE(PG8_SA(0, 0), a2, voffA); PG8_STAGE_S(0, a2);
            PG8_BAR; PG8_WAIT_L(0); PG8_MMA(1, 0, At, B0); PG8_BAR; PG8_SCHED;
            PG8_STAGE(PG8_SB(0, 1), b2 + hstep, voffB);
            PG8_WAIT_VS(6, 7); PG8_BAR; PG8_MMA(1, 1, At, B1); PG8_BAR;
            PG8_LDB(B0, 1, 0); PG8_SCHED; PG8_LDA(At, 1, 0); PG8_LDS(1); PG8_STAGE(PG8_SA(0, 1), a2 + hstep, voffA);
            PG8_WAIT_LS(8, 10); PG8_BAR; PG8_WAIT_L(0); PG8_MMA(0, 0, At, B0); PG8_MMS(0, B0); PG8_BAR; PG8_SCHED;
            PG8_LDB(B1, 1, 1); PG8_STAGE(PG8_SB(1, 0), b3, voffB);
            PG8_BAR; PG8_WAIT_L(0); PG8_MMA(0, 1, At, B1); PG8_MMS(1, B1); PG8_BAR;
            PG8_LDA(At, 1, 1); PG8_STAGE(PG8_SA(1, 0), a3, voffA); PG8_STAGE_S(1, a3);
            PG8_BAR; PG8_WAIT_L(0); PG8_MMA(1, 0, At, B0); PG8_BAR; PG8_SCHED;
            PG8_STAGE(PG8_SB(1, 1), b3 + hstep, voffB);
            PG8_WAIT_VS(6, 7); PG8_BAR; PG8_MMA(1, 1, At, B1); PG8_BAR;
        }
        PG8_STAMP();
        { const int rt0 = cur.pm * (STRIP ? 288 : 256), rw0 = rt0 + wr * 64 + fr;
#define PG8_RV(ai, m) {{acc[ai][0][m][0], acc[ai][0][m][1]}, {acc[ai][1][m][0], acc[ai][1][m][1]}}
#define PG8_BATCH(r0_, v0_, r1_, v1_) do { const typename Epi::Pre p0_ = E.pre(r0_, cur.pn, wc, fq), p1_ = E.pre(r1_, cur.pn, wc, fq); \
              { const f32x4 v_[2][2] = v0_; E.row(v_, p0_, r0_, cur.pn, wc, fq); } { const f32x4 v_[2][2] = v1_; E.row(v_, p1_, r1_, cur.pn, wc, fq); } } while (0)
          if constexpr (Epi::PRE_ALL) {
              typename Epi::Pre pa_[9];
#pragma unroll
              for (int q_ = 0; q_ < 8; ++q_) pa_[q_] = E.pre(rw0 + (q_ >> 2) * HALF + (q_ & 3) * 16, cur.pn, wc, fq);
              pa_[8] = STRIP ? E.pre(rt0 + 256 + wr * 16 + fr, cur.pn, wc, fq) : pa_[0];
#define PG8_ONE(q_, ai, m) { const f32x4 v_[2][2] = PG8_RV(ai, m); E.row(v_, pa_[q_], rw0 + ai * HALF + m * 16, cur.pn, wc, fq); }
              PG8_ONE(0, 0, 0) PG8_ONE(1, 0, 1) PG8_ONE(2, 0, 2) PG8_ONE(3, 0, 3) PG8_ONE(4, 1, 0) PG8_ONE(5, 1, 1) PG8_ONE(6, 1, 2) PG8_ONE(7, 1, 3)
#undef PG8_ONE
              if constexpr (STRIP) E.row(accS, pa_[8], rt0 + 256 + wr * 16 + fr, cur.pn, wc, fq);
#if defined(PROBE_EPI2)
              asm volatile("" ::: "memory");
#pragma unroll
              for (int q_ = 0; q_ < 8; ++q_) pa_[q_] = E.pre(rw0 + (q_ >> 2) * HALF + (q_ & 3) * 16, cur.pn, wc, fq);
              pa_[8] = STRIP ? E.pre(rt0 + 256 + wr * 16 + fr, cur.pn, wc, fq) : pa_[0];
#define PG8_ONE(q_, ai, m) { const f32x4 v_[2][2] = PG8_RV(ai, m); E.row(v_, pa_[q_], rw0 + ai * HALF + m * 16, cur.pn, wc, fq); }
              PG8_ONE(0, 0, 0) PG8_ONE(1, 0, 1) PG8_ONE(2, 0, 2) PG8_ONE(3, 0, 3) PG8_ONE(4, 1, 0) PG8_ONE(5, 1, 1) PG8_ONE(6, 1, 2) PG8_ONE(7, 1, 3)
#undef PG8_ONE
              if constexpr (STRIP) E.row(accS, pa_[8], rt0 + 256 + wr * 16 + fr, cur.pn, wc, fq);
#endif
          } else {
          PG8_BATCH(rw0, PG8_RV(0, 0), rw0 + 16, PG8_RV(0, 1));
          PG8_BATCH(rw0 + 32, PG8_RV(0, 2), rw0 + 48, PG8_RV(0, 3));
          PG8_BATCH(rw0 + HALF, PG8_RV(1, 0), rw0 + HALF + 16, PG8_RV(1, 1));
          PG8_BATCH(rw0 + HALF + 32, PG8_RV(1, 2), rw0 + HALF + 48, PG8_RV(1, 3));
          if constexpr (STRIP) { const int rs_ = rt0 + 256 + wr * 16 + fr; const typename Epi::Pre ps_ = E.pre(rs_, cur.pn, wc, fq); E.row(accS, ps_, rs_, cur.pn, wc, fq); }
          }
          if constexpr (STRIP) {
#pragma unroll
              for (int b = 0; b < 2; ++b)
#pragma unroll
                for (int n = 0; n < 2; ++n) accS[b][n] = (f32x4){0.f, 0.f, 0.f, 0.f}; }
#undef PG8_BATCH
#undef PG8_RV
          S.done(cur); }
        PG8_STAMP();
        if (!has_next) break;
#pragma unroll
        for (int a = 0; a < 2; ++a)
#pragma unroll
            for (int b = 0; b < 2; ++b)
#pragma unroll
                for (int m = 0; m < 4; ++m)
#pragma unroll
                    for (int n = 0; n < 2; ++n) acc[a][b][m][n] = (f32x4){0.f, 0.f, 0.f, 0.f};
        cur = nxt; cA = nA; cB = nB; ++ui;
    }
    PG8_WAIT_V(0);
    if (wr == 0) PG8_BAR;
    PG8_BAR;
    PG8_STAMP();
    if (STAMP && wid == 0) { stamps[lane] = lane < nts ? (((unsigned long long)(unsigned)ts_hi << 32) | (unsigned)ts_lo) : 0ull;
        if (lane == 62) stamps[62] = rt_entry; if (lane == 63) stamps[63] = (unsigned long long)wall_clock64(); }
#undef PG8_STAMP
#undef PG8_SA
#undef PG8_SB
#undef PG8_STAGE
#undef PG8_LDA
#undef PG8_LDB
#undef PG8_MMA
#undef PG8_WAIT_V
#undef PG8_WAIT_L
#undef PG8_BAR
#undef PG8_SCHED
#undef PG8_WAIT_LS
#undef PG8_WAIT_VS
#undef PG8_MMS
#undef PG8_LDS
#undef PG8_STAGE_S
#undef PG8_SS
}
}


#define LAS __attribute__((address_space(3)))
#define XB_TMO      128
#define XB_XCNT(j)  (256  + 64 * (j))
#define XB_XSUB(j)  (1280 + 64 * (j))
#define XB_XGEN(j)  (2304 + 64 * (j))
#define XB_TOP      3328
#define XB_TOPGEN   3392
#define XCD_BAR_WORDS 3456
#define XB_SPIN_CAP (1u << 18)

__device__ __forceinline__ unsigned xb_ld(unsigned* p)              { return __hip_atomic_load(p, __ATOMIC_RELAXED, __HIP_MEMORY_SCOPE_AGENT); }
__device__ __forceinline__ unsigned xb_add(unsigned* p, unsigned v) { return __hip_atomic_fetch_add(p, v, __ATOMIC_RELAXED, __HIP_MEMORY_SCOPE_AGENT); }
__device__ __forceinline__ unsigned xb_xcc_id() { return (unsigned)__builtin_amdgcn_s_getreg((3 << 11) | 20) & 0xFu; }
#define XB_SPIN(cond, bar) do { unsigned _sp = 0; while (cond) { __builtin_amdgcn_s_sleep(1); \
    if ((++_sp & 255u) == 0u) { if (xb_ld(&(bar)[XB_TMO])) break; if (_sp > XB_SPIN_CAP) { atomicAdd(&(bar)[XB_TMO], 1u); break; } } } } while (0)

struct XcdBarrier {
    unsigned* bar; unsigned x;
    volatile LAS unsigned* st;
};

__device__ __forceinline__ XcdBarrier xcd_barrier_post(unsigned* bar, volatile LAS unsigned* st) {
    XcdBarrier b; b.bar = bar; b.x = xb_xcc_id(); b.st = st;
    if (threadIdx.x == 0) (void)xb_add(&bar[XB_XCNT(b.x)], 1u);
    return b;
}
__device__ __forceinline__ void xcd_barrier_complete(unsigned* bar, unsigned x, unsigned& nloc, unsigned& nx) {
    const unsigned G = gridDim.x * gridDim.y * gridDim.z;
    unsigned sum, cnt, mine, sp = 0u;
    for (;;) {
        sum = 0u; cnt = 0u; mine = 0u;
#pragma unroll
        for (unsigned j = 0; j < 16; ++j) { const unsigned c = xb_ld(&bar[XB_XCNT(j)]); sum += c; cnt += (c > 0u) ? 1u : 0u; mine = (j == x) ? c : mine; }
        if (sum == G) break;
        __builtin_amdgcn_s_sleep(1);
        if ((++sp & 255u) == 0u) { if (xb_ld(&bar[XB_TMO])) break; if (sp > XB_SPIN_CAP) { atomicAdd(&bar[XB_TMO], 1u); break; } }
    }
    nloc = mine > 0u ? mine : 1u; nx = cnt > 0u ? cnt : 1u;
}

__device__ __forceinline__ void xcd_barrier(const XcdBarrier& b) {
    asm volatile("s_waitcnt vmcnt(0)" ::: "memory");
    __syncthreads();
    if (threadIdx.x == 0) {
        unsigned* bar = b.bar;
        __builtin_amdgcn_s_waitcnt(0);
        unsigned nloc = b.st[0], nx = b.st[1];
        if (nloc == 0u) { xcd_barrier_complete(bar, b.x, nloc, nx); b.st[0] = nloc; b.st[1] = nx; }
        const unsigned old = xb_add(&bar[XB_XSUB(b.x)], 1u);
        const unsigned gen = old / nloc;
        if (old + 1u == (gen + 1u) * nloc) {
            __builtin_amdgcn_fence(__ATOMIC_RELEASE, "agent");
            asm volatile("s_waitcnt vmcnt(0)" ::: "memory");
            const unsigned og = xb_add(&bar[XB_TOP], 1u);
            const unsigned tg = og / nx;
            if (og + 1u == (tg + 1u) * nx) xb_add(&bar[XB_TOPGEN], 1u);
            else XB_SPIN(xb_ld(&bar[XB_TOPGEN]) == tg, bar);
            __builtin_amdgcn_fence(__ATOMIC_ACQUIRE, "agent");
            xb_add(&bar[XB_XGEN(b.x)], 1u);
            asm volatile("s_waitcnt vmcnt(0)" ::: "memory");
        } else {
            XB_SPIN(xb_ld(&bar[XB_XGEN(b.x)]) == gen, bar);
            __builtin_amdgcn_fence(__ATOMIC_ACQUIRE, "agent");
            asm volatile("s_waitcnt vmcnt(0)" ::: "memory");
        }
    }
    __syncthreads();
}

typedef CfgT<RC> C;
constexpr int NTHREADS = 512, NWAVES = 8;
constexpr int LDS_STAGE = 131072 + 16384 + 8192, LDS_CTL = LDS_STAGE, LDS_BYTES = LDS_STAGE + 256;

namespace pg8 {
typedef unsigned u32x2 __attribute__((ext_vector_type(2)));
__device__ __forceinline__ float silu_f(float g) { return g * __builtin_amdgcn_rcpf(1.0f + __expf(-g)); }
struct EpiSwiGLU { static constexpr bool PERM = true, PRE_ALL = true;
    bf16_t* act; const float* ss; int ff; float invd;
    typedef float Pre;
    __device__ __forceinline__ Pre pre(int row, int pn, int wc, int fq) const { return ss[row]; }
    __device__ __forceinline__ void row(const f32x4 (&v)[2][2], Pre ssr, int row, int pn, int wc, int fq) const {
        const float rs = rsqrtf(ssr * invd + 1e-6f); f32x4 o[2];
#pragma unroll
        for (int n = 0; n < 2; ++n) { const f32x4 g = v[0][n] * rs, up = v[1][n] * rs;
#pragma unroll
            for (int j = 0; j < 4; ++j) o[n][j] = silu_f(g[j]) * up[j]; }
        u32x4 w; w.x = cvt_pk_bf16(o[0][0], o[0][1]); w.y = cvt_pk_bf16(o[0][2], o[0][3]); w.z = cvt_pk_bf16(o[1][0], o[1][1]); w.w = cvt_pk_bf16(o[1][2], o[1][3]);
        *(u32x4*)(act + (size_t)row * ff + pn * 128 + wc * 32 + 8 * fq) = w;
    }
};
struct EpiResid { static constexpr bool PERM = false, PRE_ALL = false;
    float* X; bf16_t* XB; float* ssout; float scale; int ld;
    struct Pre { f32x4 x[2][2]; };
    __device__ __forceinline__ Pre pre(int row, int pn, int wc, int fq) const { Pre q; const float* xr = X + (size_t)row * ld + pn * BM + wc * 32 + 4 * fq;
#pragma unroll
        for (int bj = 0; bj < 2; ++bj)
#pragma unroll
            for (int n = 0; n < 2; ++n) q.x[bj][n] = *(const f32x4*)(xr + bj * HALF + n * 16);
        return q; }
    __device__ __forceinline__ void row(const f32x4 (&v)[2][2], const Pre& q, int row, int pn, int wc, int fq) const {
        const int col0 = pn * BM + wc * 32 + 4 * fq; float* xr = X + (size_t)row * ld + col0; bf16_t* br = XB + (size_t)row * ld + col0; float s = 0.f;
#pragma unroll
        for (int bj = 0; bj < 2; ++bj)
#pragma unroll
            for (int n = 0; n < 2; ++n) { const f32x4 x = q.x[bj][n] + v[bj][n] * scale; *(f32x4*)(xr + bj * HALF + n * 16) = x;
                u32x2 w; w.x = cvt_pk_bf16(x[0], x[1]); w.y = cvt_pk_bf16(x[2], x[3]); *(u32x2*)(br + bj * HALF + n * 16) = w;
                s += (x[0] * x[0] + x[1] * x[1]) + (x[2] * x[2] + x[3] * x[3]); }
        s += __shfl_xor(s, 16); s += __shfl_xor(s, 32);
        if (fq == 0) unsafeAtomicAdd(ssout + row, s);
    }
};
struct EpiScaleF32 { static constexpr bool PERM = false, PRE_ALL = true;
    float* Cp; int ldc; const float* ss; float invd;
    typedef float Pre;
    __device__ __forceinline__ Pre pre(int row, int pn, int wc, int fq) const { return ss[row]; }
    __device__ __forceinline__ void row(const f32x4 (&v)[2][2], Pre ssr, int row, int pn, int wc, int fq) const {
        const float rs = rsqrtf(ssr * invd + 1e-6f); float* cr = Cp + (size_t)row * ldc + pn * BM + wc * 32 + 4 * fq;
#pragma unroll
        for (int bj = 0; bj < 2; ++bj)
#pragma unroll
            for (int n = 0; n < 2; ++n) *(f32x4*)(cr + bj * HALF + n * 16) = v[bj][n] * rs;
    }
};
struct EpiScaleBf16 { static constexpr bool PERM = true, PRE_ALL = true;
    bf16_t* O; int ldc; const float* ss; float invd;
    typedef float Pre;
    __device__ __forceinline__ Pre pre(int row, int pn, int wc, int fq) const { return ss[row]; }
    __device__ __forceinline__ void row(const f32x4 (&v)[2][2], Pre ssr, int row, int pn, int wc, int fq) const {
        const float rs = rsqrtf(ssr * invd + 1e-6f); bf16_t* orow = O + (size_t)row * ldc + pn * BM + wc * 32 + 8 * fq;
#pragma unroll
        for (int bj = 0; bj < 2; ++bj) { const f32x4 v0 = v[bj][0] * rs, v1 = v[bj][1] * rs;
            u32x4 w; w.x = cvt_pk_bf16(v0[0], v0[1]); w.y = cvt_pk_bf16(v0[2], v0[3]); w.z = cvt_pk_bf16(v1[0], v1[1]); w.w = cvt_pk_bf16(v1[2], v1[3]);
            *(u32x4*)(orow + bj * HALF) = w; }
    }
};
struct EpiMemKV { static constexpr bool PERM = false, PRE_ALL = true;
    float* K; float* V; const float* rstd; int d;
    typedef float Pre;
    __device__ __forceinline__ Pre pre(int row, int pn, int wc, int fq) const { return rstd[row]; }
    __device__ __forceinline__ void row(const f32x4 (&v)[2][2], Pre rs, int row, int pn, int wc, int fq) const {
        int ct = pn * BM; float* base = K; if (ct >= d) { base = V; ct -= d; } float* cr = base + (size_t)row * d + ct + wc * 32 + 4 * fq;
#pragma unroll
        for (int bj = 0; bj < 2; ++bj)
#pragma unroll
            for (int n = 0; n < 2; ++n) *(f32x4*)(cr + bj * HALF + n * 16) = v[bj][n] * rs;
    }
};
}

__device__ __forceinline__ void prep_item(const float* W, int K, int Ncols, const float* g, int kind, int N, bf16_t* Bt, LAS unsigned char* scr, int item, int lane) {
    const int nblk = N / 64, kb = item / nblk, nb = item % nblk, k0 = 64 * kb, n = 64 * nb + lane;
    const int sc = wsrc_col<C>(kind, n);
    const float* src = W + (size_t)k0 * Ncols + (sc >= 0 ? sc : 0);
    float v[64];
#pragma unroll
    for (int kk = 0; kk < 64; ++kk) v[kk] = src[(size_t)kk * Ncols];
    if (g) {
#pragma unroll
        for (int kk = 0; kk < 64; ++kk) v[kk] *= g[k0 + kk];
    }
    if (sc < 0) {
#pragma unroll
        for (int kk = 0; kk < 64; ++kk) v[kk] = 0.f;
    }
#pragma unroll
    for (int j = 0; j < 8; ++j) { pg8::u32x4 o; o.x = pg8::cvt_pk_bf16(v[8 * j], v[8 * j + 1]); o.y = pg8::cvt_pk_bf16(v[8 * j + 2], v[8 * j + 3]); o.z = pg8::cvt_pk_bf16(v[8 * j + 4], v[8 * j + 5]); o.w = pg8::cvt_pk_bf16(v[8 * j + 6], v[8 * j + 7]);
        *(LAS pg8::u32x4*)(scr + lane * 144 + j * 16) = o; }
    asm volatile("s_waitcnt lgkmcnt(0)" ::: "memory");
    bf16_t* dst = Bt + (size_t)(64 * nb) * K + k0 + (lane & 7) * 8;
#pragma unroll
    for (int it = 0; it < 8; ++it) { const int row = it * 8 + (lane >> 3); const pg8::u32x4 o = *(const LAS pg8::u32x4*)(scr + row * 144 + (lane & 7) * 16);
        *(pg8::u32x4*)(dst + (size_t)row * K) = o; }
    asm volatile("s_waitcnt lgkmcnt(0)" ::: "memory");
}
struct WDesc { const float* W; const float* g; bf16_t* dst; int K, Ncols, kind, N; };
__device__ __forceinline__ WDesc wdesc(const Ptrs& p, int l, int idx) {
    WDesc d; d.g = nullptr; d.kind = WK_PLAIN;
    switch (idx) {
    case 0: d.W = p.in[I_W1IN] + (size_t)l * C::D * 2 * C::FF; d.K = C::D; d.Ncols = 2 * C::FF; d.N = 2 * C::FF; d.g = p.in[I_GFFN1] + l * C::D; d.kind = WK_FFNIN; d.dst = wlayer<C>(p, l, C::W_1IN); break;
    case 1: d.W = p.in[I_W1OUT] + (size_t)l * C::FF * C::D; d.K = C::FF; d.Ncols = C::D; d.N = C::D; d.dst = wlayer<C>(p, l, C::W_1OUT); break;
    case 2: d.W = p.in[I_WIN] + (size_t)l * C::D * C::INC; d.K = C::D; d.Ncols = C::INC; d.N = C::LDP; d.g = p.in[I_GMIX] + l * C::D; d.kind = WK_WIN; d.dst = wlayer<C>(p, l, C::W_IN); break;
    case 3: d.W = p.in[I_WOUT] + (size_t)l * C::D * C::D; d.K = C::D; d.Ncols = C::D; d.N = C::D; d.dst = wlayer<C>(p, l, C::W_OUT); break;
    case 4: d.W = p.in[I_WQ] + (size_t)l * C::D * C::D; d.K = C::D; d.Ncols = C::D; d.N = C::D; d.g = p.in[I_GX] + l * C::D; d.dst = wlayer<C>(p, l, C::W_Q); break;
    case 5: d.W = p.in[I_WK] + (size_t)l * C::D * C::D; d.K = C::D; d.Ncols = C::D; d.N = C::D; d.g = p.in[I_GMEM] + l * C::D; d.dst = wlayer<C>(p, l, C::W_KV); break;
    case 6: d.W = p.in[I_WV] + (size_t)l * C::D * C::D; d.K = C::D; d.Ncols = C::D; d.N = C::D; d.g = p.in[I_GMEM] + l * C::D; d.dst = wlayer<C>(p, l, C::W_KV) + (size_t)C::D * C::D; break;
    case 7: d.W = p.in[I_WO] + (size_t)l * C::D * C::D; d.K = C::D; d.Ncols = C::D; d.N = C::D; d.dst = wlayer<C>(p, l, C::W_O); break;
    case 8: d.W = p.in[I_W2IN] + (size_t)l * C::D * 2 * C::FF; d.K = C::D; d.Ncols = 2 * C::FF; d.N = 2 * C::FF; d.g = p.in[I_GFFN2] + l * C::D; d.kind = WK_FFNIN; d.dst = wlayer<C>(p, l, C::W_2IN); break;
    default: d.W = p.in[I_W2OUT] + (size_t)l * C::FF * C::D; d.K = C::FF; d.Ncols = C::D; d.N = C::D; d.dst = wlayer<C>(p, l, C::W_2OUT); break;
    }
    return d;
}

#define WG_SYNC() do { asm volatile("s_waitcnt lgkmcnt(0)" ::: "memory"); __builtin_amdgcn_s_barrier(); asm volatile("" ::: "memory"); } while (0)
namespace att {
typedef short bf16x8 __attribute__((ext_vector_type(8)));
typedef short s16x4 __attribute__((ext_vector_type(4)));
typedef float f32x4 __attribute__((ext_vector_type(4)));
typedef unsigned u32x2 __attribute__((ext_vector_type(2)));
constexpr int TOK = 256, CD = 64, PITCH = 144, CBYTES = TOK * PITCH, HDIM = 512, NH = 4, LD = 2048;
static_assert(C::NMEM == TOK && C::AHD == HDIM && C::AH == NH && C::D == LD && C::DEC_SEQ == 32 && C::SEQ % 256 == 0, "attention phase is built for these shapes");
__device__ __forceinline__ s16x4 tr_read(unsigned addr) { s16x4 r; asm volatile("ds_read_b64_tr_b16 %0, %1" : "=&v"(r) : "v"(addr) : "memory"); return r; }
__device__ __forceinline__ void stage_load(f32x4 (&r)[8], const float* src, int tid) {
    const unsigned off0 = (unsigned)(((tid >> 4) * LD + (tid & 15) * 4) * 4);
#pragma unroll
    for (int i = 0; i < 8; ++i) r[i] = *(const f32x4*)((const char*)src + (off0 + (unsigned)(i * 32 * LD * 4)));
    __builtin_amdgcn_sched_barrier(0);
}
__device__ __forceinline__ void stage_store(const f32x4 (&r)[8], LAS unsigned char* buf, int tid) {
#pragma unroll
    for (int i = 0; i < 8; ++i) { const int f = tid + 512 * i; u32x2 w; w.x = pg8::cvt_pk_bf16(r[i][0], r[i][1]); w.y = pg8::cvt_pk_bf16(r[i][2], r[i][3]);
        *(LAS u32x2*)(buf + (f >> 4) * PITCH + (f & 15) * 8) = w; }
}
__device__ __forceinline__ void attn_phase(LAS unsigned char* lds, const Ptrs& p, int l, int tid, int bid, int gsz) {
    const int lane = tid & 63, wave = __builtin_amdgcn_readfirstlane(tid >> 6), li = lane & 15, g = lane >> 4;
    const bf16_t* Qg = wsb<C>(p, C::WS_Q); bf16_t* AO = wsb<C>(p, C::WS_AO);
    constexpr int NUP = (C::MP / 256) * NH, NUS = C::DEC_BATCH * NH;
    static_assert(C::SEQ % 256 == 0, "prompt units are 256 rows");
    for (int un = bid; un < NUP + NUS; un += gsz) {
        int row0, nrows, head; const float* kb; const float* vb;
        if (un < NUP) { const int per_b = (C::SEQ / 256) * NH, b = un / per_b, rem = un % per_b; head = rem / (C::SEQ / 256); row0 = b * C::SEQ + (rem % (C::SEQ / 256)) * 256; nrows = 256;
            kb = p.out + C::OUT_MK + ((size_t)l * C::BATCH + b) * TOK * LD + head * HDIM; vb = p.out + C::OUT_MV + ((size_t)l * C::BATCH + b) * TOK * LD + head * HDIM; }
        else { const int s = un - NUP, b = s / NH; head = s % NH; row0 = C::MP + b * C::DEC_SEQ; nrows = C::DEC_SEQ;
            kb = p.in[I_CK] + ((size_t)l * C::DEC_BATCH + b) * TOK * LD + head * HDIM; vb = p.in[I_CV] + ((size_t)l * C::DEC_BATCH + b) * TOK * LD + head * HDIM; }
        const bool active = wave * 32 < nrows;
        const bf16_t* q0 = Qg + (size_t)(row0 + wave * 32 + li) * LD + head * HDIM + g * 8;
        f32x4 s[2][16];
#pragma unroll
        for (int u = 0; u < 2; ++u)
#pragma unroll
            for (int T = 0; T < 16; ++T) s[u][T] = (f32x4){0.f, 0.f, 0.f, 0.f};
        f32x4 pre[8]; bf16x8 qf[2][2];
        stage_load(pre, kb, tid); stage_store(pre, lds, tid);
#pragma unroll
        for (int u = 0; u < 2; ++u)
#pragma unroll
            for (int ks = 0; ks < 2; ++ks) qf[u][ks] = active ? *(const bf16x8*)(q0 + (size_t)u * 16 * LD + ks * 32) : (bf16x8){0, 0, 0, 0, 0, 0, 0, 0};
        WG_SYNC();
        for (int c = 0; c < 8; ++c) {
            LAS unsigned char* buf = lds + (c & 1) * CBYTES;
            stage_load(pre, c < 7 ? kb + (c + 1) * CD : vb, tid);
            if (active) {
#pragma unroll
                for (int ks = 0; ks < 2; ++ks)
#pragma unroll
                    for (int T = 0; T < 16; ++T) { const bf16x8 a = *(const LAS bf16x8*)(buf + (T * 16 + li) * PITCH + ks * 64 + g * 16);
                        s[0][T] = __builtin_amdgcn_mfma_f32_16x16x32_bf16(a, qf[0][ks], s[0][T], 0, 0, 0);
                        s[1][T] = __builtin_amdgcn_mfma_f32_16x16x32_bf16(a, qf[1][ks], s[1][T], 0, 0, 0); }
            }
            if (active && c < 7) {
                __builtin_amdgcn_sched_barrier(0);
#pragma unroll
                for (int u = 0; u < 2; ++u)
#pragma unroll
                    for (int ks = 0; ks < 2; ++ks) qf[u][ks] = *(const bf16x8*)(q0 + (size_t)u * 16 * LD + (c + 1) * CD + ks * 32);
                __builtin_amdgcn_sched_barrier(0); }
            stage_store(pre, lds + ((c + 1) & 1) * CBYTES, tid);
            WG_SYNC();
        }
        const float sc = 0.044194173824159216f * 1.4426950408889634f;
        float inv[2]; bf16x8 pf[2][8];
#pragma unroll
        for (int u = 0; u < 2; ++u) {
            float mx = -3.0e38f;
#pragma unroll
            for (int T = 0; T < 16; ++T) mx = fmaxf(mx, fmaxf(fmaxf(s[u][T][0], s[u][T][1]), fmaxf(s[u][T][2], s[u][T][3])));
            mx = fmaxf(mx, __shfl_xor(mx, 16)); mx = fmaxf(mx, __shfl_xor(mx, 32));
            float sum = 0.f;
#pragma unroll
            for (int T = 0; T < 16; ++T)
#pragma unroll
                for (int j = 0; j < 4; ++j) { const float e = __builtin_amdgcn_exp2f((s[u][T][j] - mx) * sc); s[u][T][j] = e; sum += e; }
            sum += __shfl_xor(sum, 16); sum += __shfl_xor(sum, 32);
            inv[u] = 1.0f / sum;
#pragma unroll
            for (int t = 0; t < 8; ++t) { pg8::u32x4 w; w.x = pg8::cvt_pk_bf16(s[u][2 * t][0], s[u][2 * t][1]); w.y = pg8::cvt_pk_bf16(s[u][2 * t][2], s[u][2 * t][3]);
                w.z = pg8::cvt_pk_bf16(s[u][2 * t + 1][0], s[u][2 * t + 1][1]); w.w = pg8::cvt_pk_bf16(s[u][2 * t + 1][2], s[u][2 * t + 1][3]); pf[u][t] = __builtin_bit_cast(bf16x8, w); }
        }
        const unsigned trb = (unsigned)(size_t)lds + (unsigned)((4 * g + (li >> 2)) * PITCH + (li & 3) * 8);
        for (int c = 0; c < 8; ++c) {
            const unsigned bofs = (unsigned)(c & 1) * CBYTES;
            if (c < 7) stage_load(pre, vb + (c + 1) * CD, tid);
            if (active) {
                f32x4 o[2][4];
#pragma unroll
                for (int u = 0; u < 2; ++u)
#pragma unroll
                    for (int dt = 0; dt < 4; ++dt) o[u][dt] = (f32x4){0.f, 0.f, 0.f, 0.f};
#pragma unroll
                for (int t = 0; t < 8; ++t) {
                    s16x4 lo[4], hi[4];
#pragma unroll
                    for (int dt = 0; dt < 4; ++dt) { lo[dt] = tr_read(trb + bofs + (unsigned)(t * 32 * PITCH + dt * 32)); hi[dt] = tr_read(trb + bofs + (unsigned)(t * 32 * PITCH + 16 * PITCH + dt * 32)); }
                    asm volatile("s_waitcnt lgkmcnt(0)" ::: "memory"); __builtin_amdgcn_sched_barrier(0);
#pragma unroll
                    for (int dt = 0; dt < 4; ++dt) { const bf16x8 a = (bf16x8){lo[dt][0], lo[dt][1], lo[dt][2], lo[dt][3], hi[dt][0], hi[dt][1], hi[dt][2], hi[dt][3]};
                        o[0][dt] = __builtin_amdgcn_mfma_f32_16x16x32_bf16(a, pf[0][t], o[0][dt], 0, 0, 0);
                        o[1][dt] = __builtin_amdgcn_mfma_f32_16x16x32_bf16(a, pf[1][t], o[1][dt], 0, 0, 0); }
                }
#pragma unroll
                for (int u = 0; u < 2; ++u)
#pragma unroll
                    for (int dt = 0; dt < 4; ++dt) { u32x2 w; w.x = pg8::cvt_pk_bf16(o[u][dt][0] * inv[u], o[u][dt][1] * inv[u]); w.y = pg8::cvt_pk_bf16(o[u][dt][2] * inv[u], o[u][dt][3] * inv[u]);
                        *(u32x2*)(AO + (size_t)(row0 + wave * 32 + 16 * u + li) * LD + head * HDIM + c * CD + dt * 16 + g * 4) = w; }
            }
            if (c < 7) stage_store(pre, lds + ((c + 1) & 1) * CBYTES, tid);
            WG_SYNC();
        }
    }
}
}
namespace mx {
typedef att::bf16x8 bf16x8; typedef att::s16x4 s16x4; typedef att::f32x4 f32x4; typedef att::u32x2 u32x2;
constexpr int PT = 272;
constexpr int T64 = 64 * PT, T128 = 128 * PT;
static_assert(C::MHD == 128 && C::CH == 64 && C::MH == 8 && C::LCS == 32, "mLSTM phases are built for these shapes");
__device__ __forceinline__ void lds_wait() { asm volatile("s_waitcnt lgkmcnt(0)" ::: "memory"); __builtin_amdgcn_sched_barrier(0); }
__device__ __forceinline__ bf16x8 mk8(s16x4 lo, s16x4 hi) { return (bf16x8){lo[0], lo[1], lo[2], lo[3], hi[0], hi[1], hi[2], hi[3]}; }
__device__ __forceinline__ unsigned tr_addr(unsigned tile, int krow, int c0, int li) { return tile + (unsigned)((krow + (li >> 2)) * PT + (c0 + 4 * (li & 3)) * 2); }
__device__ __forceinline__ void ch_decode(int ci, int& r0, int& h, int& lc) {
    if (ci < C::NPC) { const int c = ci % C::NC, bh = ci / C::NC; h = bh % C::MH; r0 = (bh / C::MH) * C::SEQ + c * C::CH; lc = C::CH; }
    else { const int q = ci - C::NPC; h = q % C::MH; r0 = C::MP + (q / C::MH) * C::DEC_SEQ; lc = C::LCS; }
}
__device__ __forceinline__ void stage64(LAS unsigned char* tile, const float* src, int ld, int lc, int tid, const LAS float* rs, float mul) {
#pragma unroll
    for (int i = 0; i < 4; ++i) { const int f = tid + 512 * i, row = f >> 5, c4 = f & 31; f32x4 v = (f32x4){0.f, 0.f, 0.f, 0.f};
        if (row < lc) { v = *(const f32x4*)(src + (size_t)row * ld + c4 * 4); const float m = rs ? rs[row] * mul : mul; v = v * m; }
        u32x2 w; w.x = pg8::cvt_pk_bf16(v[0], v[1]); w.y = pg8::cvt_pk_bf16(v[2], v[3]); *(LAS u32x2*)(tile + row * PT + c4 * 8) = w; }
}
__device__ __forceinline__ void ml_phase_a(LAS unsigned char* lds, const Ptrs& p, int l, int tid, int bid, int gsz) {
    const int lane = tid & 63, wave = __builtin_amdgcn_readfirstlane(tid >> 6), li = lane & 15, g = lane >> 4;
    LAS unsigned char* Ks = lds; LAS unsigned char* Vs = lds + T64; LAS float* wts = (LAS float*)(lds + 2 * T64);
    const float* P = wsf<C>(p, C::WS_BIG);
    for (int ci = bid; ci < C::NCH; ci += gsz) {
        int r0, h, lc; ch_decode(ci, r0, h, lc);
        if (wave == 0) {
            float lf = 0.f, ig = -3.0e38f;
            if (lane < lc) { const float* pr = P + (size_t)(r0 + lane) * C::LDP; ig = pr[C::O_IG + h] + p.in[I_IB][l * C::MH + h]; const float fx = pr[C::O_FG + h] + p.in[I_FB][l * C::MH + h]; lf = fx >= 0.f ? -__logf(1.0f + __expf(-fx)) : fx - __logf(1.0f + __expf(fx)); }
            float b = lf;
#pragma unroll
            for (int o = 1; o < 64; o <<= 1) { const float t = __shfl_up(b, o); if (lane >= o) b += t; }
            const float a = lane < lc ? ig - b : -3.0e38f;
            float amax = a;
#pragma unroll
            for (int o = 1; o < 64; o <<= 1) amax = fmaxf(amax, __shfl_xor(amax, o));
            const float bL = __shfl(b, lc - 1), mloc = bL + amax;
            const float wt = lane < lc ? __expf(bL + a - mloc) : 0.f;
            wts[lane] = wt;
            if (lane < lc) { wsf<C>(p, C::WS_GB)[(size_t)(r0 + lane) * C::MH + h] = b; wsf<C>(p, C::WS_GA)[(size_t)(r0 + lane) * C::MH + h] = a; }
            if (lane == 0) { wsf<C>(p, C::WS_CBL)[ci] = bL; wsf<C>(p, C::WS_CML)[ci] = mloc; }
        }
        __syncthreads();
        stage64(Ks, P + (size_t)r0 * C::LDP + C::O_K + h * C::MHD, C::LDP, lc, tid, wts, 0.08838834764831845f);
        stage64(Vs, P + (size_t)r0 * C::LDP + C::O_VM + h * C::MHD, C::LDP, lc, tid, nullptr, 1.0f);
        __syncthreads();
        f32x4 acc[8];
#pragma unroll
        for (int et = 0; et < 8; ++et) acc[et] = (f32x4){0.f, 0.f, 0.f, 0.f};
        const unsigned ks = (unsigned)(size_t)Ks, vs = (unsigned)(size_t)Vs;
#pragma unroll
        for (int t = 0; t < 2; ++t) {
            const s16x4 alo = att::tr_read(tr_addr(ks, 32 * t + 8 * g, 16 * wave, li)), ahi = att::tr_read(tr_addr(ks, 32 * t + 8 * g + 4, 16 * wave, li));
            s16x4 blo[8], bhi[8];
#pragma unroll
            for (int et = 0; et < 8; ++et) { blo[et] = att::tr_read(tr_addr(vs, 32 * t + 8 * g, 16 * et, li)); bhi[et] = att::tr_read(tr_addr(vs, 32 * t + 8 * g + 4, 16 * et, li)); }
            lds_wait();
            const bf16x8 a = mk8(alo, ahi);
#pragma unroll
            for (int et = 0; et < 8; ++et) acc[et] = __builtin_amdgcn_mfma_f32_16x16x32_bf16(a, mk8(blo[et], bhi[et]), acc[et], 0, 0, 0);
        }
        float* DC = wsf<C>(p, C::WS_DC) + (size_t)ci * C::MHD * C::MHD;
#pragma unroll
        for (int et = 0; et < 8; ++et)
#pragma unroll
            for (int r = 0; r < 4; ++r) DC[(size_t)(16 * wave + 4 * g + r) * C::MHD + 16 * et + li] = acc[et][r];
        if (tid < C::MHD) { float s = 0.f; for (int t = 0; t < 64; ++t) s += bf2f(*(const LAS bf16_t*)(Ks + t * PT + tid * 2)); wsf<C>(p, C::WS_DN)[(size_t)ci * C::MHD + tid] = s; }
        __syncthreads();
    }
}
__device__ __forceinline__ void ml_phase_c(LAS unsigned char* lds, const Ptrs& p, int l, int tid, int bid, int gsz) {
    const int lane = tid & 63, wave = __builtin_amdgcn_readfirstlane(tid >> 6), li = lane & 15, g = lane >> 4, it = wave & 3, eh = wave >> 2;
    LAS unsigned char* Qs = lds; LAS unsigned char* Ks = lds + T64; LAS unsigned char* Vs = lds + 2 * T64; LAS unsigned char* Cs = lds + 3 * T64;
    LAS float* sb = (LAS float*)(lds + 3 * T64 + T128);
    LAS float* sa = sb + 64; LAS float* smr = sb + 128; LAS float* siw = sb + 192; LAS float* snp = sb + 256; LAS float* ssq = sb + 384;
    const float* P = wsf<C>(p, C::WS_BIG);
    for (int ci = bid; ci < C::NCH; ci += gsz) {
        int r0, h, lc; ch_decode(ci, r0, h, lc);
        const bool sample = ci >= C::NPC, first = !sample && (ci % C::NC) == 0;
        const float mprev = wsf<C>(p, C::WS_MPREV)[ci];
        if (wave == 0) {
            float b = 0.f, a = -3.0e38f;
            if (lane < lc) { b = wsf<C>(p, C::WS_GB)[(size_t)(r0 + lane) * C::MH + h]; a = wsf<C>(p, C::WS_GA)[(size_t)(r0 + lane) * C::MH + h]; }
            float pm = a;
#pragma unroll
            for (int o = 1; o < 64; o <<= 1) { const float t = __shfl_up(pm, o); if (lane >= o) pm = fmaxf(pm, t); }
            const float mrow = b + fmaxf(mprev, pm);
            sb[lane] = b; sa[lane] = a; smr[lane] = mrow; siw[lane] = __expf(b + mprev - mrow);
        }
        if (tid >= 128 && tid < 256) { const int d = tid - 128;
            snp[d] = sample ? p.in[I_SN][((size_t)l * C::NSC + (ci - C::NPC)) * C::MHD + d] : (first ? 0.f : wsf<C>(p, C::WS_DN)[(size_t)(ci - 1) * C::MHD + d]); }
        stage64(Qs, P + (size_t)r0 * C::LDP + C::O_Q + h * C::MHD, C::LDP, lc, tid, nullptr, 1.0f);
        stage64(Ks, P + (size_t)r0 * C::LDP + C::O_K + h * C::MHD, C::LDP, lc, tid, nullptr, 0.08838834764831845f);
        stage64(Vs, P + (size_t)r0 * C::LDP + C::O_VM + h * C::MHD, C::LDP, lc, tid, nullptr, 1.0f);
        { const float* cp = sample ? p.in[I_SC] + ((size_t)l * C::NSC + (ci - C::NPC)) * C::MHD * C::MHD : wsf<C>(p, C::WS_DC) + (size_t)(first ? ci : ci - 1) * C::MHD * C::MHD;
#pragma unroll
            for (int i = 0; i < 8; ++i) { const int f = tid + 512 * i, row = f >> 5, c4 = f & 31; f32x4 v = (f32x4){0.f, 0.f, 0.f, 0.f};
                if (!first) v = *(const f32x4*)(cp + (size_t)row * C::MHD + c4 * 4);
                u32x2 w; w.x = pg8::cvt_pk_bf16(v[0], v[1]); w.y = pg8::cvt_pk_bf16(v[2], v[3]); *(LAS u32x2*)(Cs + row * PT + c4 * 8) = w; } }
        __syncthreads();
        const bool active = it * 16 < lc;
        float ssq_part = 0.f; f32x4 hv[4]; float inv_den = 0.f;
        const int i = 16 * it + li;
        if (active) {
            bf16x8 qf[4];
#pragma unroll
            for (int ks = 0; ks < 4; ++ks) qf[ks] = *(const LAS bf16x8*)(Qs + i * PT + ks * 64 + g * 16);
            f32x4 st[4];
#pragma unroll
            for (int jt = 0; jt < 4; ++jt) st[jt] = (f32x4){0.f, 0.f, 0.f, 0.f};
#pragma unroll
            for (int jt = 0; jt < 4; ++jt) if (jt <= it) {
#pragma unroll
                for (int ks = 0; ks < 4; ++ks) { const bf16x8 a = *(const LAS bf16x8*)(Ks + (16 * jt + li) * PT + ks * 64 + g * 16);
                    st[jt] = __builtin_amdgcn_mfma_f32_16x16x32_bf16(a, qf[ks], st[jt], 0, 0, 0); } }
            const float bi = sb[i], mri = smr[i], iwi = siw[i];
            float dsum = 0.f;
#pragma unroll
            for (int jt = 0; jt < 4; ++jt)
#pragma unroll
                for (int r = 0; r < 4; ++r) { const int j = 16 * jt + 4 * g + r; const float w = (j <= i) ? __expf(bi + sa[j] - mri) : 0.f; st[jt][r] *= w; dsum += st[jt][r]; }
            dsum += __shfl_xor(dsum, 16); dsum += __shfl_xor(dsum, 32);
            float qn = 0.f;
#pragma unroll
            for (int ks = 0; ks < 4; ++ks)
#pragma unroll
                for (int jj = 0; jj < 8; ++jj) qn += bf2f((bf16_t)qf[ks][jj]) * snp[32 * ks + 8 * g + jj];
            qn += __shfl_xor(qn, 16); qn += __shfl_xor(qn, 32);
            const float den = dsum + iwi * qn;
            inv_den = 1.0f / fmaxf(fabsf(den), __expf(-mri));
            bf16x8 pf[2];
#pragma unroll
            for (int t = 0; t < 2; ++t) { pg8::u32x4 w; w.x = pg8::cvt_pk_bf16(st[2 * t][0], st[2 * t][1]); w.y = pg8::cvt_pk_bf16(st[2 * t][2], st[2 * t][3]);
                w.z = pg8::cvt_pk_bf16(st[2 * t + 1][0], st[2 * t + 1][1]); w.w = pg8::cvt_pk_bf16(st[2 * t + 1][2], st[2 * t + 1][3]); pf[t] = __builtin_bit_cast(bf16x8, w); }
            const unsigned vs = (unsigned)(size_t)Vs, cs = (unsigned)(size_t)Cs;
#pragma unroll
            for (int e4 = 0; e4 < 4; ++e4) { const int et = 4 * eh + e4;
                s16x4 vlo[2], vhi[2], clo[4], chi[4];
#pragma unroll
                for (int t = 0; t < 2; ++t) { vlo[t] = att::tr_read(tr_addr(vs, 32 * t + 4 * g, 16 * et, li)); vhi[t] = att::tr_read(tr_addr(vs, 32 * t + 16 + 4 * g, 16 * et, li)); }
#pragma unroll
                for (int ks = 0; ks < 4; ++ks) { clo[ks] = att::tr_read(tr_addr(cs, 32 * ks + 8 * g, 16 * et, li)); chi[ks] = att::tr_read(tr_addr(cs, 32 * ks + 8 * g + 4, 16 * et, li)); }
                lds_wait();
                f32x4 aS = (f32x4){0.f, 0.f, 0.f, 0.f}, aC = (f32x4){0.f, 0.f, 0.f, 0.f};
#pragma unroll
                for (int t = 0; t < 2; ++t) aS = __builtin_amdgcn_mfma_f32_16x16x32_bf16(mk8(vlo[t], vhi[t]), pf[t], aS, 0, 0, 0);
#pragma unroll
                for (int ks = 0; ks < 4; ++ks) aC = __builtin_amdgcn_mfma_f32_16x16x32_bf16(mk8(clo[ks], chi[ks]), qf[ks], aC, 0, 0, 0);
                hv[e4] = (aS + aC * iwi) * inv_den;
                ssq_part += (hv[e4][0] * hv[e4][0] + hv[e4][1] * hv[e4][1]) + (hv[e4][2] * hv[e4][2] + hv[e4][3] * hv[e4][3]); }
            ssq_part += __shfl_xor(ssq_part, 16); ssq_part += __shfl_xor(ssq_part, 32);
            if (g == 0) ssq[wave * 16 + li] = ssq_part;
        }
        __syncthreads();
        if (active) {
            const float tot = ssq_part + ssq[(wave ^ 4) * 16 + li];
            const float rs = rsqrtf(tot * (1.0f / C::MHD) + 1e-6f);
            const int row = r0 + i;
#pragma unroll
            for (int e4 = 0; e4 < 4; ++e4) { const int e = 16 * (4 * eh + e4) + 4 * g;
                const f32x4 og = *(const f32x4*)(P + (size_t)row * C::LDP + C::O_O + h * C::MHD + e); const f32x4 gn = *(const f32x4*)(p.in[I_NG] + (size_t)l * C::MW + h * C::MHD + e);
                float o4[4];
#pragma unroll
                for (int r = 0; r < 4; ++r) o4[r] = hv[e4][r] * rs * gn[r] * __builtin_amdgcn_rcpf(1.0f + __expf(-og[r]));
                u32x2 w; w.x = pg8::cvt_pk_bf16(o4[0], o4[1]); w.y = pg8::cvt_pk_bf16(o4[2], o4[3]);
                *(u32x2*)(wsb<C>(p, C::WS_MIX) + (size_t)row * C::D + C::PW + C::GW + h * C::MHD + e) = w; }
        }
        __syncthreads();
    }
}
}
namespace rw {
typedef att::f32x4 f32x4; typedef att::u32x2 u32x2;
static_assert(C::D == 2048, "row ops assume 2048 columns = 8 float4 per lane");
__device__ __forceinline__ float wave_sum(float v) {
#pragma unroll
    for (int o = 1; o < 64; o <<= 1) v += __shfl_xor(v, o);
    return v;
}
__device__ __forceinline__ void rows_init(const Ptrs& p, int tid, int bid, int gsz) {
    const int lane = tid & 63, gw = bid * NWAVES + (tid >> 6), NGW = gsz * NWAVES;
    float* SS = wsf<C>(p, C::WS_SS);
    for (int r = gw; r < C::M; r += NGW) {
        const float* src = r < C::MP ? p.in[I_XP] + (size_t)r * C::D : p.in[I_XS] + (size_t)(r - C::MP) * C::D;
        float* X = wsf<C>(p, C::WS_X) + (size_t)r * C::D; bf16_t* XB = wsb<C>(p, C::WS_XB) + (size_t)r * C::D;
        float ss = 0.f;
#pragma unroll
        for (int j = 0; j < 8; ++j) { const f32x4 v = *(const f32x4*)(src + (lane + 64 * j) * 4); *(f32x4*)(X + (lane + 64 * j) * 4) = v;
            u32x2 w; w.x = pg8::cvt_pk_bf16(v[0], v[1]); w.y = pg8::cvt_pk_bf16(v[2], v[3]); *(u32x2*)(XB + (lane + 64 * j) * 4) = w;
            ss += (v[0] * v[0] + v[1] * v[1]) + (v[2] * v[2] + v[3] * v[3]); }
        ss = wave_sum(ss);
        if (lane < C::NSS) SS[(size_t)lane * C::M + r] = lane == 0 ? ss : 0.f;
    }
    for (int r = gw; r < C::MM; r += NGW) {
        const float* src = p.in[I_MEM] + (size_t)r * C::D; bf16_t* MB = wsb<C>(p, C::WS_MEMB) + (size_t)r * C::D;
        float ss = 0.f;
#pragma unroll
        for (int j = 0; j < 8; ++j) { const f32x4 v = *(const f32x4*)(src + (lane + 64 * j) * 4);
            u32x2 w; w.x = pg8::cvt_pk_bf16(v[0], v[1]); w.y = pg8::cvt_pk_bf16(v[2], v[3]); *(u32x2*)(MB + (lane + 64 * j) * 4) = w;
            ss += (v[0] * v[0] + v[1] * v[1]) + (v[2] * v[2] + v[3] * v[3]); }
        ss = wave_sum(ss);
        if (lane == 0) wsf<C>(p, C::WS_RSTDM)[r] = rsqrtf(ss * (1.0f / C::D) + 1e-6f);
    }
}
__device__ __forceinline__ void rows_final(const Ptrs& p, int tid, int bid, int gsz) {
    const int lane = tid & 63, gw = bid * NWAVES + (tid >> 6), NGW = gsz * NWAVES;
    for (int r = gw; r < C::M; r += NGW) {
        const float* X = wsf<C>(p, C::WS_X) + (size_t)r * C::D; const float rs = rsqrtf(wsf<C>(p, C::WS_SS)[(size_t)(C::NSS - 1) * C::M + r] * (1.0f / C::D) + 1e-6f);
        float* o = r < C::MP ? p.out + C::OUT_YP + (size_t)r * C::D : p.out + C::OUT_YS + (size_t)(r - C::MP) * C::D;
        float pscale = 1.0f, padd = 0.f;
#if defined(PROBE_MASK_A)
        { const unsigned long long* TS = (const unsigned long long*)(p.ws + C::WS_CTL + 32768); unsigned long long ta = 0, tb = 0;
          for (int k = 0; k < 25; ++k) { const unsigned long long dk = TS[k + 1] - TS[k]; if ((PROBE_MASK_A >> k) & 1ull) ta += dk; if ((PROBE_MASK_B >> k) & 1ull) tb += dk; }
#if defined(PROBE_MLT)
          ta = TS[48 + PROBE_MLT];
#endif
#if defined(PROBE_GST)
          { const unsigned long long* st = (const unsigned long long*)(p.ws + C::WS_END); unsigned long long epi = 0; for (int u2 = 0; u2 < 8; ++u2) epi += st[3 + 2 * u2] - st[2 + 2 * u2];
            const unsigned long long tot = st[18] - st[0], fill = st[1] - st[0];
            ta = (unsigned long long)(1.0e6 * (double)(PROBE_GST == 1 ? epi : fill) / (double)tot); }
#endif
#if defined(PROBE_MLC)
          ta = TS[48 + PROBE_MLC];
#endif
#if defined(PROBE_ATT)
          ta = 0; for (int l2 = 0; l2 < 2; ++l2) { const int k = 1 + 12 * l2 + 8; ta += (PROBE_ATT == 1) ? TS[44 + l2] - TS[k] : TS[k + 1] - TS[44 + l2]; }
#endif
#if defined(PROBE_MIXA)
          ta = 0; for (int l2 = 0; l2 < 2; ++l2) { const int k = 1 + 12 * l2 + 3; ta += (PROBE_MIXA == 1) ? TS[40 + l2] - TS[k] : (PROBE_MIXA == 2) ? TS[42 + l2] - TS[40 + l2] : TS[k + 1] - TS[42 + l2]; }
#endif
#if defined(PROBE_SPLIT_MODE)
          ta = 0; for (int l2 = 0; l2 < 2; ++l2) { const int k = 1 + 10 * l2 + 3; ta += (PROBE_SPLIT_MODE == 1) ? TS[40 + l2] - TS[k] : TS[k + 1] - TS[40 + l2]; }
#endif
          if (r >= C::MP) pscale = 1.0f + 0.03f + (float)ta * 0.01f * PROBE_SA;
          if (r == 0 && lane == 0) padd = 1.0f + (float)tb * 0.01f * PROBE_SB; }
#endif
#pragma unroll
        for (int j = 0; j < 8; ++j) { const f32x4 v = *(const f32x4*)(X + (lane + 64 * j) * 4); const f32x4 gg = *(const f32x4*)(p.in[I_GFIN] + (lane + 64 * j) * 4);
            f32x4 y = v * rs * gg * pscale; if (j == 0) y[0] += padd; *(f32x4*)(o + (lane + 64 * j) * 4) = y; }
    }
}
__device__ __forceinline__ void ml_scan(const Ptrs& p, int l, long gtid, long gthreads) {
    const float* CBL = wsf<C>(p, C::WS_CBL); const float* CML = wsf<C>(p, C::WS_CML);
    float* DC = wsf<C>(p, C::WS_DC); float* DN = wsf<C>(p, C::WS_DN);
    constexpr int NPS = C::BATCH * C::MH, E4 = C::MHD / 4;
    for (long it = gtid; it < (long)NPS * C::MHD * E4; it += gthreads) {
        const int e4 = (int)(it % E4), d = (int)((it / E4) % C::MHD), sq = (int)(it / ((long)E4 * C::MHD));
        float m = 0.f; f32x4 cst = (f32x4){0.f, 0.f, 0.f, 0.f};
        static_assert(C::NC % 8 == 0, "scan is unrolled by 8 chunks");
        for (int c0 = 0; c0 < C::NC; c0 += 8) {
            f32x4 v[8]; float bl[8], ml[8];
#pragma unroll
            for (int j = 0; j < 8; ++j) { const int ci = sq * C::NC + c0 + j; v[j] = *(const f32x4*)(DC + ((size_t)ci * C::MHD + d) * C::MHD + e4 * 4); bl[j] = CBL[ci]; ml[j] = CML[ci]; }
#pragma unroll
            for (int j = 0; j < 8; ++j) { const int ci = sq * C::NC + c0 + j; const float a = bl[j] + m, mn = fmaxf(a, ml[j]), dec = __expf(a - mn), f = __expf(ml[j] - mn);
                cst = cst * dec + v[j] * f; *(f32x4*)(DC + ((size_t)ci * C::MHD + d) * C::MHD + e4 * 4) = cst; m = mn; }
        }
        *(f32x4*)(p.out + C::OUT_CP + (((size_t)l * NPS + sq) * C::MHD + d) * C::MHD + e4 * 4) = cst;
    }
    for (long it = gtid; it < (long)NPS * C::MHD; it += gthreads) {
        const int d = (int)(it % C::MHD), sq = (int)(it / C::MHD);
        float m = 0.f, nst = 0.f;
        for (int c = 0; c < C::NC; ++c) { const int ci = sq * C::NC + c; const float a = CBL[ci] + m, b2 = CML[ci], mn = fmaxf(a, b2), dec = __expf(a - mn), f = __expf(b2 - mn);
            const size_t on = (size_t)ci * C::MHD + d; nst = dec * nst + f * DN[on]; DN[on] = nst; m = mn; }
        p.out[C::OUT_NP + ((size_t)l * NPS + sq) * C::MHD + d] = nst;
    }
    for (long it = gtid; it < (long)C::NSC * C::MHD * E4; it += gthreads) {
        const int e4 = (int)(it % E4), d = (int)((it / E4) % C::MHD), q = (int)(it / ((long)E4 * C::MHD)), ci = C::NPC + q;
        const float m0 = p.in[I_SM][(size_t)l * C::NSC + q], a = CBL[ci] + m0, b2 = CML[ci], mn = fmaxf(a, b2), dec = __expf(a - mn), f = __expf(b2 - mn);
        const size_t so = (((size_t)l * C::NSC + q) * C::MHD + d) * C::MHD + e4 * 4;
        *(f32x4*)(p.out + C::OUT_CS + so) = *(const f32x4*)(p.in[I_SC] + so) * dec + *(const f32x4*)(DC + ((size_t)ci * C::MHD + d) * C::MHD + e4 * 4) * f;
    }
    for (long it = gtid; it < (long)C::NSC * C::MHD; it += gthreads) {
        const int d = (int)(it % C::MHD), q = (int)(it / C::MHD), ci = C::NPC + q;
        const float m0 = p.in[I_SM][(size_t)l * C::NSC + q], a = CBL[ci] + m0, b2 = CML[ci], mn = fmaxf(a, b2), dec = __expf(a - mn), f = __expf(b2 - mn);
        const size_t no = ((size_t)l * C::NSC + q) * C::MHD + d;
        p.out[C::OUT_NS + no] = dec * p.in[I_SN][no] + f * DN[(size_t)ci * C::MHD + d];
    }
}
}

namespace gp {
typedef att::bf16x8 bf16x8; typedef att::s16x4 s16x4; typedef att::f32x4 f32x4; typedef att::u32x2 u32x2;
constexpr int PT = mx::PT, T128 = mx::T128;
static_assert(C::GHD == 128 && C::PGD == 128 && C::GCH == 128 && C::SEQ % 128 == 0 && C::DEC_SEQ == 32 && C::PH == 15, "gmlp / pool phases are built for these shapes");
constexpr int NT_P = C::MP / 128;
constexpr int NU_G = NT_P * 4 + C::DEC_BATCH * 4;
__device__ __forceinline__ void gmlp_phase(LAS unsigned char* lds, const Ptrs& p, int l, int tid, int bid, int gsz) {
    const int lane = tid & 63, wave = __builtin_amdgcn_readfirstlane(tid >> 6), li = lane & 15, g = lane >> 4;
    LAS unsigned char* Vs = lds; LAS unsigned char* Ws = lds + T128;
    const float* P = wsf<C>(p, C::WS_BIG);
    for (int u = bid; u < NU_G; u += gsz) {
        int r0, lc, h; bool sample = false; int sb = 0;
        if (u < NT_P * 4) { h = u & 3; r0 = (u >> 2) * 128; lc = 128; } else { const int s = u - NT_P * 4; h = s & 3; sb = s >> 2; r0 = C::MP + sb * C::DEC_SEQ; lc = C::DEC_SEQ; sample = true; }
#pragma unroll
        for (int i = 0; i < 8; ++i) { const int f = tid + 512 * i, row = f >> 5, c4 = f & 31; f32x4 v = (f32x4){0.f, 0.f, 0.f, 0.f};
            if (row < lc) v = *(const f32x4*)(P + (size_t)(r0 + row) * C::LDP + C::O_V + h * 128 + c4 * 4);
            float ss = (v[0] * v[0] + v[1] * v[1]) + (v[2] * v[2] + v[3] * v[3]);
#pragma unroll
            for (int o = 1; o < 32; o <<= 1) ss += __shfl_xor(ss, o);
            const float rs = rsqrtf(ss * (1.0f / 128) + 1e-6f); const f32x4 gn = *(const f32x4*)(p.in[I_GVG] + (size_t)l * C::GW + h * 128 + c4 * 4);
            v = v * rs * gn;
            if (sample && row < lc) *(f32x4*)(p.out + C::OUT_VS + (((size_t)l * C::DEC_BATCH + sb) * C::DEC_SEQ + row) * C::GW + h * 128 + c4 * 4) = v;
            u32x2 w; w.x = pg8::cvt_pk_bf16(v[0], v[1]); w.y = pg8::cvt_pk_bf16(v[2], v[3]); *(LAS u32x2*)(Vs + row * PT + c4 * 8) = w; }
        const float* wsrc = p.in[I_GWS] + ((size_t)l * C::GH + h) * 128 * 128;
#pragma unroll
        for (int i = 0; i < 8; ++i) { const int f = tid + 512 * i, row = f >> 5, c4 = f & 31; f32x4 v = *(const f32x4*)(wsrc + (size_t)row * 128 + c4 * 4);
#pragma unroll
            for (int j = 0; j < 4; ++j) if (c4 * 4 + j > row) v[j] = 0.f;
            u32x2 w; w.x = pg8::cvt_pk_bf16(v[0], v[1]); w.y = pg8::cvt_pk_bf16(v[2], v[3]); *(LAS u32x2*)(Ws + row * PT + c4 * 8) = w; }
        WG_SYNC();
        if (wave * 16 < lc) {
            const int i = wave * 16 + li, nks = (wave * 16 + 15) / 32 + 1;
            f32x4 acc[8];
#pragma unroll
            for (int dt = 0; dt < 8; ++dt) acc[dt] = (f32x4){0.f, 0.f, 0.f, 0.f};
            const unsigned vs = (unsigned)(size_t)Vs;
            for (int ks = 0; ks < nks; ++ks) {
                const bf16x8 bq = *(const LAS bf16x8*)(Ws + i * PT + ks * 64 + g * 16);
                s16x4 lo[8], hi[8];
#pragma unroll
                for (int dt = 0; dt < 8; ++dt) { lo[dt] = att::tr_read(mx::tr_addr(vs, 32 * ks + 8 * g, 16 * dt, li)); hi[dt] = att::tr_read(mx::tr_addr(vs, 32 * ks + 8 * g + 4, 16 * dt, li)); }
                mx::lds_wait();
#pragma unroll
                for (int dt = 0; dt < 8; ++dt) acc[dt] = __builtin_amdgcn_mfma_f32_16x16x32_bf16(mx::mk8(lo[dt], hi[dt]), bq, acc[dt], 0, 0, 0);
            }
            const float bsi = p.in[I_GBS][((size_t)l * C::GH + h) * C::GCH + i];
            const int row = r0 + i;
#pragma unroll
            for (int dt = 0; dt < 8; ++dt) { const int d = 16 * dt + 4 * g; const f32x4 uu = *(const f32x4*)(P + (size_t)row * C::LDP + C::O_U + h * 128 + d);
                u32x2 w; w.x = pg8::cvt_pk_bf16(uu[0] * (acc[dt][0] + bsi), uu[1] * (acc[dt][1] + bsi)); w.y = pg8::cvt_pk_bf16(uu[2] * (acc[dt][2] + bsi), uu[3] * (acc[dt][3] + bsi));
                *(u32x2*)(wsb<C>(p, C::WS_MIX) + (size_t)row * C::D + C::PW + h * 128 + d) = w; }
        }
        WG_SYNC();
    }
}
__device__ __forceinline__ void pool_phase(LAS unsigned char* lds, const Ptrs& p, int l, int tid, int bid, int gsz) {
    const int lane = tid & 63, wave = __builtin_amdgcn_readfirstlane(tid >> 6), li = lane & 15, g = lane >> 4;
    LAS unsigned char* Ds = lds; LAS unsigned char* Ws = lds + T128;
    const float* P = wsf<C>(p, C::WS_BIG);
    for (int u = bid; u < NU_G; u += gsz) {
        int r0, lc, grp, t0, L, b; bool sample = false;
        if (u < NT_P * 4) { grp = u & 3; r0 = (u >> 2) * 128; lc = 128; b = r0 / C::SEQ; t0 = r0 % C::SEQ; L = C::SEQ; } else { const int s = u - NT_P * 4; grp = s & 3; b = s >> 2; r0 = C::MP + b * C::DEC_SEQ; lc = C::DEC_SEQ; t0 = 0; L = C::DEC_SEQ; sample = true; }
        const int w = 2 << grp;
        { const int c4 = tid & 31, sg = tid >> 5, ch = grp * 128 + c4 * 4;
            const float* hist = p.in[I_SPOOL] + ((size_t)l * C::DEC_BATCH + b) * C::PH * C::PW + ch;
            auto xat = [&](int t) -> f32x4 {
                if (t >= 0) return *(const f32x4*)(P + (size_t)(r0 - t0 + t) * C::LDP + ch);
                if (sample && C::PH + t >= 0) return *(const f32x4*)(hist + (size_t)(C::PH + t) * C::PW);
                return (f32x4){0.f, 0.f, 0.f, 0.f}; };
            if (sg * 8 < lc) {
                const int ts = t0 + sg * 8;
                f32x4 sum = (f32x4){0.f, 0.f, 0.f, 0.f};
                for (int j = 1; j < w; ++j) sum = sum + xat(ts - j);
#pragma unroll
                for (int k = 0; k < 8; ++k) { const int t = ts + k; const f32x4 x = xat(t); sum = sum + x;
                    const int pos = (sample ? C::PAST : 0) + t; const float inv = 1.0f / (float)((pos + 1) < w ? (pos + 1) : w);
                    const f32x4 dv = sum * inv - x;
                    u32x2 ww; ww.x = pg8::cvt_pk_bf16(dv[0], dv[1]); ww.y = pg8::cvt_pk_bf16(dv[2], dv[3]); *(LAS u32x2*)(Ds + (sg * 8 + k) * PT + c4 * 8) = ww;
                    sum = sum - xat(t - w + 1);
                    const int idx = t - (L - C::PH);
                    if (idx >= 0) *(f32x4*)(p.out + (sample ? C::OUT_POOLS + (((size_t)l * C::DEC_BATCH + b) * C::PH + idx) * C::PW : C::OUT_POOLP + (((size_t)l * C::BATCH + b) * C::PH + idx) * C::PW) + ch) = x; }
            } else {
#pragma unroll
                for (int k = 0; k < 8; ++k) *(LAS u32x2*)(Ds + (sg * 8 + k) * PT + c4 * 8) = (u32x2){0u, 0u};
            }
        }
        const float* wsrc = p.in[I_POOLW] + ((size_t)l * C::PG + grp) * 128 * 128;
#pragma unroll
        for (int i = 0; i < 8; ++i) { const int f = tid + 512 * i, row = f >> 5, c4 = f & 31; const f32x4 v = *(const f32x4*)(wsrc + (size_t)row * 128 + c4 * 4);
            u32x2 ww; ww.x = pg8::cvt_pk_bf16(v[0], v[1]); ww.y = pg8::cvt_pk_bf16(v[2], v[3]); *(LAS u32x2*)(Ws + row * PT + c4 * 8) = ww; }
        WG_SYNC();
        if (wave * 16 < lc) {
            const int t = wave * 16 + li;
            f32x4 acc[8];
#pragma unroll
            for (int et = 0; et < 8; ++et) acc[et] = (f32x4){0.f, 0.f, 0.f, 0.f};
            const unsigned wsa = (unsigned)(size_t)Ws;
#pragma unroll
            for (int ks = 0; ks < 4; ++ks) {
                const bf16x8 bq = *(const LAS bf16x8*)(Ds + t * PT + ks * 64 + g * 16);
                s16x4 lo[8], hi[8];
#pragma unroll
                for (int et = 0; et < 8; ++et) { lo[et] = att::tr_read(mx::tr_addr(wsa, 32 * ks + 8 * g, 16 * et, li)); hi[et] = att::tr_read(mx::tr_addr(wsa, 32 * ks + 8 * g + 4, 16 * et, li)); }
                mx::lds_wait();
#pragma unroll
                for (int et = 0; et < 8; ++et) acc[et] = __builtin_amdgcn_mfma_f32_16x16x32_bf16(mx::mk8(lo[et], hi[et]), bq, acc[et], 0, 0, 0);
            }
            const int row = r0 + t;
#pragma unroll
            for (int et = 0; et < 8; ++et) { const int e = 16 * et + 4 * g; const f32x4 sc = *(const f32x4*)(p.in[I_POOLS] + (size_t)l * C::PW + grp * 128 + e);
                u32x2 ww; ww.x = pg8::cvt_pk_bf16(acc[et][0] * sc[0], acc[et][1] * sc[1]); ww.y = pg8::cvt_pk_bf16(acc[et][2] * sc[2], acc[et][3] * sc[3]);
                *(u32x2*)(wsb<C>(p, C::WS_MIX) + (size_t)row * C::D + grp * 128 + e) = ww; }
        }
        WG_SYNC();
    }
}
}
namespace mp {
typedef att::bf16x8 bf16x8; typedef att::s16x4 s16x4; typedef att::f32x4 f32x4; typedef att::u32x2 u32x2; typedef pg8::u32x4 u32x4;
constexpr int PT = mx::PT, T64 = mx::T64, T128 = mx::T128, MAXU = 8;
#define MP_TR(dst, base, OFF) asm volatile("ds_read_b64_tr_b16 %0, %1 offset:%2" : "=&v"(dst) : "v"(base), "i"(OFF) : "memory")
__device__ __forceinline__ void ml_a(LAS unsigned char* lds, const Ptrs& p, int l, int tid, int bid, int gsz) {
    const int lane = tid & 63, wave = __builtin_amdgcn_readfirstlane(tid >> 6), li = lane & 15, g = lane >> 4;
    LAS unsigned char* Ks = lds; LAS unsigned char* Vs = lds + T64; LAS float* wts = (LAS float*)(lds + 2 * T64);
    const float* P = wsf<C>(p, C::WS_BIG);
    const int nu = bid < C::NCH ? (C::NCH - 1 - bid) / gsz + 1 : 0;
    if (wave < nu) { const int ci = bid + wave * gsz; int r0, h, lc; mx::ch_decode(ci, r0, h, lc);
        float lf = 0.f, ig = -3.0e38f;
        if (lane < lc) { const float* pr = P + (size_t)(r0 + lane) * C::LDP; ig = pr[C::O_IG + h] + p.in[I_IB][l * C::MH + h]; const float fx = pr[C::O_FG + h] + p.in[I_FB][l * C::MH + h];
            lf = fx >= 0.f ? -__logf(1.0f + __expf(-fx)) : fx - __logf(1.0f + __expf(fx)); }
        float b = lf;
#pragma unroll
        for (int o = 1; o < 64; o <<= 1) { const float t = __shfl_up(b, o); if (lane >= o) b += t; }
        const float a = lane < lc ? ig - b : -3.0e38f;
        float amax = a;
#pragma unroll
        for (int o = 1; o < 64; o <<= 1) amax = fmaxf(amax, __shfl_xor(amax, o));
        const float bL = __shfl(b, lc - 1), mloc = bL + amax;
        wts[wave * 64 + lane] = lane < lc ? __expf(bL + a - mloc) : 0.f;
        if (lane < lc) { wsf<C>(p, C::WS_GB)[(size_t)(r0 + lane) * C::MH + h] = b; wsf<C>(p, C::WS_GA)[(size_t)(r0 + lane) * C::MH + h] = a; }
        if (lane == 0) { wsf<C>(p, C::WS_CBL)[ci] = bL; wsf<C>(p, C::WS_CML)[ci] = mloc; } }
    const unsigned lofs8 = (unsigned)((8 * g + (li >> 2)) * PT + 8 * (li & 3));
    const unsigned kw8 = (unsigned)(size_t)Ks + lofs8 + (unsigned)(32 * wave), vs8 = (unsigned)(size_t)Vs + lofs8;
    f32x4 pk[4], pv[4];
    auto window = [&](int ci) { int r0, h, lc; mx::ch_decode(ci, r0, h, lc); const float* src = P + (size_t)r0 * C::LDP + h * C::MHD;
#pragma unroll
        for (int q = 0; q < 4; ++q) { const int f = tid + 512 * q, row = f >> 5, c4 = f & 31;
            if (row < lc) { pk[q] = *(const f32x4*)(src + (size_t)row * C::LDP + C::O_K + c4 * 4); pv[q] = *(const f32x4*)(src + (size_t)row * C::LDP + C::O_VM + c4 * 4); }
            else { pk[q] = (f32x4){0.f, 0.f, 0.f, 0.f}; pv[q] = pk[q]; } }
        __builtin_amdgcn_sched_barrier(0); };
    if (nu > 0) window(bid);
    WG_SYNC();
    for (int j = 0; j < nu; ++j) { const int ci = bid + j * gsz;
#pragma unroll
        for (int q = 0; q < 4; ++q) { const int f = tid + 512 * q, row = f >> 5, c4 = f & 31; const float sw = 0.08838834764831845f * wts[j * 64 + row];
            u32x2 w; w.x = pg8::cvt_pk_bf16(pk[q][0] * sw, pk[q][1] * sw); w.y = pg8::cvt_pk_bf16(pk[q][2] * sw, pk[q][3] * sw); *(LAS u32x2*)(Ks + row * PT + c4 * 8) = w;
            w.x = pg8::cvt_pk_bf16(pv[q][0], pv[q][1]); w.y = pg8::cvt_pk_bf16(pv[q][2], pv[q][3]); *(LAS u32x2*)(Vs + row * PT + c4 * 8) = w; }
        if (j + 1 < nu) window(ci + gsz);
        WG_SYNC();
        f32x4 acc[8], accn = (f32x4){0.f, 0.f, 0.f, 0.f};
#pragma unroll
        for (int et = 0; et < 8; ++et) acc[et] = (f32x4){0.f, 0.f, 0.f, 0.f};
        const bf16x8 ones = (bf16x8){0x3F80, 0x3F80, 0x3F80, 0x3F80, 0x3F80, 0x3F80, 0x3F80, 0x3F80};
#pragma unroll
        for (int t = 0; t < 2; ++t) {
            s16x4 alo, ahi, blo[8], bhi[8]; MP_TR(alo, kw8, (32 * t) * PT); MP_TR(ahi, kw8, (32 * t + 4) * PT);
#pragma unroll
            for (int et = 0; et < 8; ++et) { MP_TR(blo[et], vs8, (32 * t) * PT + 32 * et); MP_TR(bhi[et], vs8, (32 * t + 4) * PT + 32 * et); }
            mx::lds_wait();
            const bf16x8 a = mx::mk8(alo, ahi);
#pragma unroll
            for (int et = 0; et < 8; ++et) acc[et] = __builtin_amdgcn_mfma_f32_16x16x32_bf16(mx::mk8(blo[et], bhi[et]), a, acc[et], 0, 0, 0);
            accn = __builtin_amdgcn_mfma_f32_16x16x32_bf16(ones, a, accn, 0, 0, 0);
        }
        float* DC = wsf<C>(p, C::WS_DC) + (size_t)ci * C::MHD * C::MHD + (size_t)(16 * wave + li) * C::MHD + 4 * g;
#pragma unroll
        for (int et = 0; et < 8; ++et) *(f32x4*)(DC + 16 * et) = acc[et];
        if (g == 0) wsf<C>(p, C::WS_DN)[(size_t)ci * C::MHD + 16 * wave + li] = accn[0];
        WG_SYNC();
    }
}
__device__ __forceinline__ void ml_scan(const Ptrs& p, int l, long gtid, long gthreads) {
    const float* CBL = wsf<C>(p, C::WS_CBL); const float* CML = wsf<C>(p, C::WS_CML); const float* DC = wsf<C>(p, C::WS_DC); float* DN = wsf<C>(p, C::WS_DN);
    bf16_t* DCB = wsb<C>(p, C::WS_DCB); float* MPREV = wsf<C>(p, C::WS_MPREV);
    constexpr int NPS = C::BATCH * C::MH, E4 = C::MHD / 4;
    static_assert(C::NC % 8 == 0, "scan is unrolled by 8 chunks");
    for (long it = gtid; it < (long)NPS * C::MHD * E4; it += gthreads) {
        const int e4 = (int)(it % E4), d = (int)((it / E4) % C::MHD), sq = (int)(it / ((long)E4 * C::MHD));
        float m = 0.f; f32x4 cst = (f32x4){0.f, 0.f, 0.f, 0.f};
        for (int c0 = 0; c0 < C::NC; c0 += 8) {
            f32x4 v[8]; float bl[8], ml[8];
#pragma unroll
            for (int j = 0; j < 8; ++j) { const int ci = sq * C::NC + c0 + j; v[j] = *(const f32x4*)(DC + ((size_t)ci * C::MHD + d) * C::MHD + e4 * 4); bl[j] = CBL[ci]; ml[j] = CML[ci]; }
            __builtin_amdgcn_sched_barrier(0);
#pragma unroll
            for (int j = 0; j < 8; ++j) { const int ci = sq * C::NC + c0 + j; const float a = bl[j] + m, mn = fmaxf(a, ml[j]), dec = __expf(a - mn), f = __expf(ml[j] - mn);
                if (d == 0 && e4 == 0) MPREV[ci] = m;
                cst = cst * dec + v[j] * f; u32x2 w; w.x = pg8::cvt_pk_bf16(cst[0], cst[1]); w.y = pg8::cvt_pk_bf16(cst[2], cst[3]);
                *(u32x2*)(DCB + ((size_t)ci * C::MHD + d) * C::MHD + e4 * 4) = w; m = mn; }
        }
        *(f32x4*)(p.out + C::OUT_CP + (((size_t)l * NPS + sq) * C::MHD + d) * C::MHD + e4 * 4) = cst;
        if (d == 0 && e4 == 0) p.out[C::OUT_MP + (size_t)l * NPS + sq] = m;
    }
    for (long it = gtid; it < (long)NPS * C::MHD; it += gthreads) {
        const int d = (int)(it % C::MHD), sq = (int)(it / C::MHD);
        float m = 0.f, nst = 0.f;
        for (int c = 0; c < C::NC; ++c) { const int ci = sq * C::NC + c; const float a = CBL[ci] + m, b2 = CML[ci], mn = fmaxf(a, b2), dec = __expf(a - mn), f = __expf(b2 - mn);
            const size_t on = (size_t)ci * C::MHD + d; nst = dec * nst + f * DN[on]; DN[on] = nst; m = mn; }
        p.out[C::OUT_NP + ((size_t)l * NPS + sq) * C::MHD + d] = nst;
    }
    for (long it = gtid; it < (long)C::NSC * C::MHD * E4; it += gthreads) {
        const int e4 = (int)(it % E4), d = (int)((it / E4) % C::MHD), q = (int)(it / ((long)E4 * C::MHD)), ci = C::NPC + q;
        const float m0 = p.in[I_SM][(size_t)l * C::NSC + q], a = CBL[ci] + m0, b2 = CML[ci], mn = fmaxf(a, b2), dec = __expf(a - mn), f = __expf(b2 - mn);
        const size_t so = (((size_t)l * C::NSC + q) * C::MHD + d) * C::MHD + e4 * 4; const f32x4 cin = *(const f32x4*)(p.in[I_SC] + so);
        *(f32x4*)(p.out + C::OUT_CS + so) = cin * dec + *(const f32x4*)(DC + ((size_t)ci * C::MHD + d) * C::MHD + e4 * 4) * f;
        u32x2 w; w.x = pg8::cvt_pk_bf16(cin[0], cin[1]); w.y = pg8::cvt_pk_bf16(cin[2], cin[3]); *(u32x2*)(DCB + ((size_t)ci * C::MHD + d) * C::MHD + e4 * 4) = w;
        if (d == 0 && e4 == 0) { MPREV[ci] = m0; p.out[C::OUT_MS + (size_t)l * C::NSC + q] = mn; }
    }
    for (long it = gtid; it < (long)C::NSC * C::MHD; it += gthreads) {
        const int d = (int)(it % C::MHD), q = (int)(it / C::MHD), ci = C::NPC + q;
        const float m0 = p.in[I_SM][(size_t)l * C::NSC + q], a = CBL[ci] + m0, b2 = CML[ci], mn = fmaxf(a, b2), dec = __expf(a - mn), f = __expf(b2 - mn);
        const size_t no = ((size_t)l * C::NSC + q) * C::MHD + d;
        p.out[C::OUT_NS + no] = dec * p.in[I_SN][no] + f * DN[(size_t)ci * C::MHD + d];
    }
}
__device__ __forceinline__ void ml_c(LAS unsigned char* lds, const Ptrs& p, int l, int tid, int bid, int gsz) {
    const int lane = tid & 63, wave = __builtin_amdgcn_readfirstlane(tid >> 6), li = lane & 15, g = lane >> 4, it = wave & 3, eh = wave >> 2;
    LAS unsigned char* Qs = lds; LAS unsigned char* Ks = lds + T64; LAS unsigned char* Vs = lds + 2 * T64; LAS unsigned char* Cs = lds + 3 * T64;
    LAS float* SB = (LAS float*)(lds + 3 * T64 + T128); LAS float* SA = SB + MAXU * 64; LAS float* SMR = SA + MAXU * 64; LAS float* SIW = SMR + MAXU * 64;
    LAS float* snp = SIW + MAXU * 64; LAS float* ssq = snp + 128; LAS float* sgn = ssq + 128;
    const float* P = wsf<C>(p, C::WS_BIG);
    const int nu = bid < C::NCH ? (C::NCH - 1 - bid) / gsz + 1 : 0;
    if (wave < nu) { const int ci = bid + wave * gsz; int r0, h, lc; mx::ch_decode(ci, r0, h, lc); const float mprev = wsf<C>(p, C::WS_MPREV)[ci];
        float b = 0.f, a = -3.0e38f;
        if (lane < lc) { b = wsf<C>(p, C::WS_GB)[(size_t)(r0 + lane) * C::MH + h]; a = wsf<C>(p, C::WS_GA)[(size_t)(r0 + lane) * C::MH + h]; }
        float pm = a;
#pragma unroll
        for (int o = 1; o < 64; o <<= 1) { const float t = __shfl_up(pm, o); if (lane >= o) pm = fmaxf(pm, t); }
        const float mrow = b + fmaxf(mprev, pm);
        SB[wave * 64 + lane] = b; SA[wave * 64 + lane] = a; SMR[wave * 64 + lane] = mrow; SIW[wave * 64 + lane] = __expf(b + mprev - mrow); }
    const unsigned lofs8 = (unsigned)((8 * g + (li >> 2)) * PT + 8 * (li & 3)), lofs4 = (unsigned)((4 * g + (li >> 2)) * PT + 8 * (li & 3));
    const unsigned vs4e = (unsigned)(size_t)Vs + lofs4 + (unsigned)(128 * eh), cb8e = (unsigned)(size_t)Cs + lofs8 + (unsigned)(128 * eh);
    f32x4 pq[4], pk[4], pv[4], og[4]; u32x4 pc[4]; float pn = 0.f, pg = 0.f;
    auto window = [&](int ci) { int r0, h, lc; mx::ch_decode(ci, r0, h, lc); const float* src = P + (size_t)r0 * C::LDP + h * C::MHD;
        const bool sample = ci >= C::NPC, first = !sample && (ci % C::NC) == 0;
#pragma unroll
        for (int q = 0; q < 4; ++q) { const int f = tid + 512 * q, row = f >> 5, c4 = f & 31;
            if (row < lc) { pq[q] = *(const f32x4*)(src + (size_t)row * C::LDP + C::O_Q + c4 * 4); pk[q] = *(const f32x4*)(src + (size_t)row * C::LDP + C::O_K + c4 * 4); pv[q] = *(const f32x4*)(src + (size_t)row * C::LDP + C::O_VM + c4 * 4); }
            else { pq[q] = (f32x4){0.f, 0.f, 0.f, 0.f}; pk[q] = pq[q]; pv[q] = pq[q]; } }
        const bf16_t* cb = wsb<C>(p, C::WS_DCB) + (size_t)(sample ? ci : (first ? ci : ci - 1)) * C::MHD * C::MHD;
#pragma unroll
        for (int q = 0; q < 4; ++q) { const int f = tid + 512 * q; pc[q] = first ? (u32x4){0u, 0u, 0u, 0u} : *(const u32x4*)(cb + (size_t)f * 8); }
        const int i = 16 * it + li;
#pragma unroll
        for (int e4 = 0; e4 < 4; ++e4) og[e4] = (it * 16 < lc) ? *(const f32x4*)(src + (size_t)i * C::LDP + C::O_O + 16 * (4 * eh + e4) + 4 * g) : (f32x4){0.f, 0.f, 0.f, 0.f};
        if (tid < C::MHD) { pn = sample ? p.in[I_SN][((size_t)l * C::NSC + (ci - C::NPC)) * C::MHD + tid] : (first ? 0.f : wsf<C>(p, C::WS_DN)[(size_t)(ci - 1) * C::MHD + tid]);
            pg = p.in[I_NG][(size_t)l * C::MW + h * C::MHD + tid]; }
        __builtin_amdgcn_sched_barrier(0); };
    if (nu > 0) window(bid);
    WG_SYNC();
#if defined(PROBE_MLC)
    unsigned long long tacc[4] = {0, 0, 0, 0}; unsigned long long tprev = wall_clock64();
#define MLC_T(j) do { const unsigned long long tn_ = wall_clock64(); tacc[j] += tn_ - tprev; tprev = tn_; } while (0)
#else
#define MLC_T(j) do { } while (0)
#endif
    for (int j = 0; j < nu; ++j) { const int ci = bid + j * gsz; int r0, h, lc; mx::ch_decode(ci, r0, h, lc);
        const LAS float* sb = SB + j * 64; const LAS float* sa = SA + j * 64; const LAS float* smr = SMR + j * 64; const LAS float* siw = SIW + j * 64;
#pragma unroll
        for (int q = 0; q < 4; ++q) { const int f = tid + 512 * q, row = f >> 5, c4 = f & 31; const float sc = 0.08838834764831845f;
            u32x2 w; w.x = pg8::cvt_pk_bf16(pq[q][0], pq[q][1]); w.y = pg8::cvt_pk_bf16(pq[q][2], pq[q][3]); *(LAS u32x2*)(Qs + row * PT + c4 * 8) = w;
            w.x = pg8::cvt_pk_bf16(pk[q][0] * sc, pk[q][1] * sc); w.y = pg8::cvt_pk_bf16(pk[q][2] * sc, pk[q][3] * sc); *(LAS u32x2*)(Ks + row * PT + c4 * 8) = w;
            w.x = pg8::cvt_pk_bf16(pv[q][0], pv[q][1]); w.y = pg8::cvt_pk_bf16(pv[q][2], pv[q][3]); *(LAS u32x2*)(Vs + row * PT + c4 * 8) = w;
            *(LAS u32x4*)(Cs + (f >> 4) * PT + (f & 15) * 16) = pc[q]; }
        if (tid < C::MHD) { snp[tid] = pn; sgn[tid] = pg; }
        f32x4 ogc[4];
#pragma unroll
        for (int e4 = 0; e4 < 4; ++e4) ogc[e4] = og[e4];
        if (j + 1 < nu) window(ci + gsz);
        WG_SYNC(); MLC_T(0);
        const bool active = it * 16 < lc; const int i = 16 * it + li;
        float ssq_part = 0.f; f32x4 hv[4];
        if (active) {
            bf16x8 qf[4];
#pragma unroll
            for (int ks = 0; ks < 4; ++ks) qf[ks] = *(const LAS bf16x8*)(Qs + i * PT + ks * 64 + g * 16);
            f32x4 st[4];
#pragma unroll
            for (int jt = 0; jt < 4; ++jt) st[jt] = (f32x4){0.f, 0.f, 0.f, 0.f};
#pragma unroll
            for (int jt = 0; jt < 4; ++jt) if (jt <= it) {
#pragma unroll
                for (int ks = 0; ks < 4; ++ks) { const bf16x8 a = *(const LAS bf16x8*)(Ks + (16 * jt + li) * PT + ks * 64 + g * 16);
                    st[jt] = __builtin_amdgcn_mfma_f32_16x16x32_bf16(a, qf[ks], st[jt], 0, 0, 0); } }
            const float bi = sb[i], mri = smr[i], iwi = siw[i];
            float dsum = 0.f;
#pragma unroll
            for (int jt = 0; jt < 4; ++jt)
#pragma unroll
                for (int r = 0; r < 4; ++r) { const int jj = 16 * jt + 4 * g + r; const float w = (jj <= i) ? __expf(bi + sa[jj] - mri) : 0.f; st[jt][r] *= w; dsum += st[jt][r]; }
            dsum += __shfl_xor(dsum, 16); dsum += __shfl_xor(dsum, 32);
            float qn = 0.f;
#pragma unroll
            for (int ks = 0; ks < 4; ++ks)
#pragma unroll
                for (int jj = 0; jj < 8; ++jj) qn += bf2f((bf16_t)qf[ks][jj]) * snp[32 * ks + 8 * g + jj];
            qn += __shfl_xor(qn, 16); qn += __shfl_xor(qn, 32);
            const float den = dsum + iwi * qn, inv_den = 1.0f / fmaxf(fabsf(den), __expf(-mri));
            bf16x8 pf[2];
#pragma unroll
            for (int t = 0; t < 2; ++t) { u32x4 w; w.x = pg8::cvt_pk_bf16(st[2 * t][0], st[2 * t][1]); w.y = pg8::cvt_pk_bf16(st[2 * t][2], st[2 * t][3]);
                w.z = pg8::cvt_pk_bf16(st[2 * t + 1][0], st[2 * t + 1][1]); w.w = pg8::cvt_pk_bf16(st[2 * t + 1][2], st[2 * t + 1][3]); pf[t] = __builtin_bit_cast(bf16x8, w); }
#pragma unroll
            for (int e2 = 0; e2 < 2; ++e2) {
                s16x4 vlo[2][2], vhi[2][2], clo[2][4], chi[2][4];
#pragma unroll
                for (int u = 0; u < 2; ++u) {
#pragma unroll
                    for (int t = 0; t < 2; ++t) { MP_TR(vlo[u][t], vs4e, (32 * t) * PT + 32 * (2 * e2 + u)); MP_TR(vhi[u][t], vs4e, (32 * t + 16) * PT + 32 * (2 * e2 + u)); }
#pragma unroll
                    for (int ks = 0; ks < 4; ++ks) { MP_TR(clo[u][ks], cb8e, (32 * ks) * PT + 32 * (2 * e2 + u)); MP_TR(chi[u][ks], cb8e, (32 * ks + 4) * PT + 32 * (2 * e2 + u)); } }
                mx::lds_wait();
#pragma unroll
                for (int u = 0; u < 2; ++u) { const int e4 = 2 * e2 + u;
                    f32x4 aS = (f32x4){0.f, 0.f, 0.f, 0.f}, aC = (f32x4){0.f, 0.f, 0.f, 0.f};
#pragma unroll
                    for (int t = 0; t < 2; ++t) aS = __builtin_amdgcn_mfma_f32_16x16x32_bf16(mx::mk8(vlo[u][t], vhi[u][t]), pf[t], aS, 0, 0, 0);
#pragma unroll
                    for (int ks = 0; ks < 4; ++ks) aC = __builtin_amdgcn_mfma_f32_16x16x32_bf16(mx::mk8(clo[u][ks], chi[u][ks]), qf[ks], aC, 0, 0, 0);
                    hv[e4] = (aS + aC * iwi) * inv_den;
                    ssq_part += (hv[e4][0] * hv[e4][0] + hv[e4][1] * hv[e4][1]) + (hv[e4][2] * hv[e4][2] + hv[e4][3] * hv[e4][3]); } }
            ssq_part += __shfl_xor(ssq_part, 16); ssq_part += __shfl_xor(ssq_part, 32);
            if (g == 0) ssq[wave * 16 + li] = ssq_part;
        }
        MLC_T(1); WG_SYNC();
        if (active) {
            const float tot = ssq_part + ssq[(wave ^ 4) * 16 + li];
            const float rs = rsqrtf(tot * (1.0f / C::MHD) + 1e-6f);
            const int row = r0 + i;
#pragma unroll
            for (int e4 = 0; e4 < 4; ++e4) { const int e = 16 * (4 * eh + e4) + 4 * g; const f32x4 gn = *(const LAS f32x4*)(sgn + e);
                float o4[4];
#pragma unroll
                for (int r = 0; r < 4; ++r) o4[r] = hv[e4][r] * rs * gn[r] * __builtin_amdgcn_rcpf(1.0f + __expf(-ogc[e4][r]));
                u32x2 w; w.x = pg8::cvt_pk_bf16(o4[0], o4[1]); w.y = pg8::cvt_pk_bf16(o4[2], o4[3]);
                *(u32x2*)(wsb<C>(p, C::WS_MIX) + (size_t)row * C::D + C::PW + C::GW + h * C::MHD + e) = w; }
        }
        MLC_T(2); WG_SYNC(); MLC_T(3);
    }
#if defined(PROBE_MLC)
    if (bid == 0 && tid == 0) { unsigned long long* TS = (unsigned long long*)(p.ws + C::WS_CTL + 32768); for (int j = 0; j < 4; ++j) TS[48 + j] += tacc[j]; }
#endif
}
}
constexpr int PH_PER_LAYER = 12, N_PHASES = 2 + PH_PER_LAYER * C::DEPTH;
struct Args { Ptrs p; int ph_lo, ph_hi; };
__global__ void __launch_bounds__(NTHREADS, 2) fwd(Args a) {
    extern __shared__ __attribute__((aligned(16))) unsigned char lds_raw[];
    LAS unsigned char* lds = (LAS unsigned char*)lds_raw;
    typedef __attribute__((address_space(4))) const Args* KArgs;
    const KArgs ka0 = (KArgs)__builtin_amdgcn_kernarg_segment_ptr();
    const int lo = a.ph_lo, hi = a.ph_hi;
#define IN(k) (lo <= (k) && (k) < hi)
#define BOTH(k) (IN(k) && IN((k) + 1))
#define GRID_BAR(k) do { if (BOTH(k)) { xcd_barrier(bar); } } while (0)
#if defined(__HIP_DEVICE_COMPILE__)
#define LOAD_PTRS KArgs ka = ka0; asm volatile("" : "+s"(ka)); Ptrs p; _Pragma("unroll") for (int i_ = 0; i_ < 33; ++i_) p.in[i_] = ka->p.in[i_]; p.out = ka->p.out; p.ws = ka->p.ws;
#else
#define LOAD_PTRS (void)ka0; const Ptrs p = a.p;
#endif
#define PHASE_ARGS LOAD_PTRS int tid = threadIdx.x; asm volatile("" : "+v"(tid)); int bid = blockIdx.x, gsz = gridDim.x; asm volatile("" : "+s"(bid), "+s"(gsz));     \
    const int lane = tid & 63, wave = __builtin_amdgcn_readfirstlane(tid >> 6); (void)lane; (void)wave; \
    const long gtid = (long)bid * NTHREADS + tid, gthreads = (long)gsz * NTHREADS; (void)gtid; (void)gthreads; \
    float* SS = wsf<C>(p, C::WS_SS); (void)SS; const float invd = 1.0f / C::D; (void)invd;
#if defined(PROBE_MASK_A)
#define STAMP(k) do { if (blockIdx.x == 0 && threadIdx.x == 0) ((unsigned long long*)(a.p.ws + C::WS_CTL + 32768))[k] = wall_clock64(); } while (0)
#else
#define STAMP(k) do { } while (0)
#endif
#define ITEMS(n, call) do { for (long it = gtid; it < (long)(n); it += gthreads) { call; } } while (0)
#define SSL(j) (SS + (size_t)(4 * l + (j)) * C::M)
#define GEMM_ALL(STRIP, EPI, Aop, Bop, Mr, Nc, Kd, ...) do { pg8::Gemm g{Aop, Bop, Mr, Nc, Kd, Kd}; pg8::StaticOrder S; S.init(Mr, Nc, gsz, bid, (STRIP) ? 288 : 256); \
        pg8::EPI E{__VA_ARGS__}; pg8::gemm_phase<pg8::EPI, pg8::StaticOrder, STRIP, false>(lds, g, S, E, nullptr); } while (0)
#if ONE_LAUNCH
    if (threadIdx.x < 4) ((LAS unsigned*)(lds + LDS_CTL))[threadIdx.x] = 0u;
    __syncthreads();
    XcdBarrier bar = xcd_barrier_post((unsigned*)(a.p.ws + C::WS_CTL), (volatile LAS unsigned*)(lds + LDS_CTL));
#else
    XcdBarrier bar; bar.bar = nullptr; bar.x = 0; bar.st = nullptr;
#endif

    if (IN(0)) { PHASE_ARGS STAMP(0);
        const int gw = bid * NWAVES + wave, NGW = gsz * NWAVES;
        for (int l = 0; l < C::DEPTH; ++l)
            for (int idx = 0; idx < 10; ++idx) { const WDesc d = wdesc(p, l, idx); const int nitems = (d.K / 64) * (d.N / 64);
                for (int it = gw; it < nitems; it += NGW) prep_item(d.W, d.K, d.Ncols, d.g, d.kind, d.N, d.dst, lds + wave * 9216, it, lane); }
        rw::rows_init(p, tid, bid, gsz);
        GRID_BAR(0);
    }
    for (int l = 0; l < C::DEPTH; ++l) {
        const int pb = 1 + PH_PER_LAYER * l;
        if (IN(pb + 0)) { PHASE_ARGS STAMP(pb + 0);
#if defined(PROBE_GST)
            if (l == 0) { pg8::Gemm g{wsb<C>(p, C::WS_XB), wlayer<C>(p, l, C::W_1IN), C::M, 2 * C::FF, C::D, C::D}; pg8::StaticOrder S; S.init(C::M, 2 * C::FF, gsz, bid, 288);
                pg8::EpiSwiGLU E{wsb<C>(p, C::WS_BIG), SSL(0), C::FF, invd}; pg8::gemm_phase<pg8::EpiSwiGLU, pg8::StaticOrder, true, true>(lds, g, S, E, (unsigned long long*)(p.ws + C::WS_END) + (size_t)bid * 64); } else
#endif
            GEMM_ALL(true, EpiSwiGLU, wsb<C>(p, C::WS_XB), wlayer<C>(p, l, C::W_1IN), C::M, 2 * C::FF, C::D, wsb<C>(p, C::WS_BIG), SSL(0), C::FF, invd);
            GRID_BAR(pb + 0); }
        if (IN(pb + 1)) { PHASE_ARGS STAMP(pb + 1);
            GEMM_ALL(true, EpiResid, wsb<C>(p, C::WS_BIG), wlayer<C>(p, l, C::W_1OUT), C::M, C::D, C::FF, wsf<C>(p, C::WS_X), wsb<C>(p, C::WS_XB), SSL(1), 0.5f, C::D);
            GRID_BAR(pb + 1); }
        if (IN(pb + 2)) { PHASE_ARGS STAMP(pb + 2);
            GEMM_ALL(true, EpiScaleF32, wsb<C>(p, C::WS_XB), wlayer<C>(p, l, C::W_IN), C::M, C::LDP, C::D, wsf<C>(p, C::WS_BIG), C::LDP, SSL(1), invd);
            GRID_BAR(pb + 2); }
        if (IN(pb + 3)) { PHASE_ARGS STAMP(pb + 3); mp::ml_a(lds, p, l, tid, bid, gsz);
#if defined(PROBE_MIXA)
            xcd_barrier(bar); STAMP(40 + l);
#endif
            gp::gmlp_phase(lds, p, l, tid, bid, gsz);
#if defined(PROBE_MIXA)
            xcd_barrier(bar); STAMP(42 + l);
#endif
            GRID_BAR(pb + 3); }
        if (IN(pb + 4)) { PHASE_ARGS STAMP(pb + 4);
            if (bid < 64) {
                pg8::Gemm g{wsb<C>(p, C::WS_MEMB), wlayer<C>(p, l, C::W_KV), C::MM, 2 * C::D, C::D, C::D}; pg8::StaticOrder S; S.init(C::MM, 2 * C::D, 64, bid);
                pg8::EpiMemKV E{p.out + C::OUT_MK + (size_t)l * C::MM * C::D, p.out + C::OUT_MV + (size_t)l * C::MM * C::D, wsf<C>(p, C::WS_RSTDM), C::D};
                pg8::gemm_phase<pg8::EpiMemKV, pg8::StaticOrder, false, false>(lds, g, S, E, nullptr);
            } else { mp::ml_scan(p, l, (long)(bid - 64) * NTHREADS + tid, (long)(gsz - 64) * NTHREADS); gp::pool_phase(lds, p, l, tid, bid - 64, gsz - 64); }
            GRID_BAR(pb + 4); }
        if (IN(pb + 5)) { PHASE_ARGS STAMP(pb + 5); mp::ml_c(lds, p, l, tid, bid, gsz); GRID_BAR(pb + 5); }
        if (IN(pb + 6)) { PHASE_ARGS STAMP(pb + 6);
            GEMM_ALL(true, EpiResid, wsb<C>(p, C::WS_MIX), wlayer<C>(p, l, C::W_OUT), C::M, C::D, C::D, wsf<C>(p, C::WS_X), wsb<C>(p, C::WS_XB), SSL(2), 1.0f, C::D);
            GRID_BAR(pb + 6); }
        if (IN(pb + 7)) { PHASE_ARGS STAMP(pb + 7);
            GEMM_ALL(true, EpiScaleBf16, wsb<C>(p, C::WS_XB), wlayer<C>(p, l, C::W_Q), C::M, C::D, C::D, wsb<C>(p, C::WS_Q), C::D, SSL(2), invd);
            GRID_BAR(pb + 7); }
        if (IN(pb + 8)) { PHASE_ARGS STAMP(pb + 8); att::attn_phase(lds, p, l, tid, bid, gsz); GRID_BAR(pb + 8); }
        if (IN(pb + 9)) { PHASE_ARGS STAMP(pb + 9);
            GEMM_ALL(true, EpiResid, wsb<C>(p, C::WS_AO), wlayer<C>(p, l, C::W_O), C::M, C::D, C::D, wsf<C>(p, C::WS_X), wsb<C>(p, C::WS_XB), SSL(3), 1.0f, C::D);
            GRID_BAR(pb + 9); }
        if (IN(pb + 10)) { PHASE_ARGS STAMP(pb + 10);
            GEMM_ALL(true, EpiSwiGLU, wsb<C>(p, C::WS_XB), wlayer<C>(p, l, C::W_2IN), C::M, 2 * C::FF, C::D, wsb<C>(p, C::WS_BIG), SSL(3), C::FF, invd);
            GRID_BAR(pb + 10); }
        if (IN(pb + 11)) { PHASE_ARGS STAMP(pb + 11);
            GEMM_ALL(true, EpiResid, wsb<C>(p, C::WS_BIG), wlayer<C>(p, l, C::W_2OUT), C::M, C::D, C::FF, wsf<C>(p, C::WS_X), wsb<C>(p, C::WS_XB), SSL(4), 0.5f, C::D);
            GRID_BAR(pb + 11); }
    }
    if (IN(N_PHASES - 1)) { PHASE_ARGS STAMP(N_PHASES - 1); __syncthreads(); rw::rows_final(p, tid, bid, gsz); }
#undef IN
#undef BOTH
#undef GRID_BAR
#undef ITEMS
#undef PHASE_ARGS
#undef SSL
}

extern "C" void kernel_launch(void* const* d_in, const int* in_sizes, int n_in, void* d_out, int out_size, void* d_ws, size_t ws_size, hipStream_t stream) {
    static int ready = 0;
    if (!ready) {
        if (n_in != 33 || (long)out_size != (long)C::OUT_END || ws_size < (size_t)C::WS_END) { fprintf(stderr, "kernel_launch: unexpected shapes: n_in %d out %d ws %zu (need %zu)\n", n_in, out_size, ws_size, (size_t)C::WS_END); ready = -1; return; }
        if (hipFuncSetAttribute((const void*)fwd, hipFuncAttributeMaxDynamicSharedMemorySize, LDS_BYTES) != hipSuccess) { fprintf(stderr, "kernel_launch: hipFuncSetAttribute failed\n"); ready = -1; return; }
        int dev = 0, cus = 0, per_cu = 0;
        if (hipGetDevice(&dev) != hipSuccess || hipDeviceGetAttribute(&cus, hipDeviceAttributeMultiprocessorCount, dev) != hipSuccess) { fprintf(stderr, "kernel_launch: device query failed\n"); ready = -1; return; }
        if (hipOccupancyMaxActiveBlocksPerMultiprocessor(&per_cu, (const void*)fwd, NTHREADS, LDS_BYTES) != hipSuccess || per_cu < 1) { fprintf(stderr, "kernel_launch: occupancy query reports %d blocks per CU\n", per_cu); (void)hipGetLastError(); per_cu = 1; }
        if (cus != 256) { fprintf(stderr, "kernel_launch: built for a 256-CU device (one resident workgroup per CU), found %d\n", cus); ready = -1; return; }
        ready = cus;
    }
    if (ready < 0) return;
    Args a{};
    for (int i = 0; i < 33; ++i) a.p.in[i] = (const float*)d_in[i];
    a.p.out = (float*)d_out; a.p.ws = (unsigned char*)d_ws;
#if ONE_LAUNCH
    (void)hipMemsetAsync((char*)d_ws + C::WS_CTL, 0, 65536, stream);
    a.ph_lo = 0; a.ph_hi = N_PHASES;
    hipLaunchKernelGGL(fwd, dim3(ready), dim3(NTHREADS), LDS_BYTES, stream, a);
#else
    for (int k = 0; k < N_PHASES; ++k) { a.ph_lo = k; a.ph_hi = k + 1; hipLaunchKernelGGL(fwd, dim3(ready), dim3(NTHREADS), LDS_BYTES, stream, a); }
#endif
}
```

```cpp
#include <hip/hip_runtime.h>
#include <cstdio>
#define ONE_LAUNCH 1

#define HD __host__ __device__
#ifndef HD
#define HD __host__ __device__
#endif
typedef unsigned short bf16_t;
HD inline unsigned f2u(float f) { return __builtin_bit_cast(unsigned, f); }
HD inline float u2f(unsigned u) { return __builtin_bit_cast(float, u); }
HD inline bf16_t f2bf(float f) { unsigned u = f2u(f); u += 0x7FFFu + ((u >> 16) & 1u); return (bf16_t)(u >> 16); }
HD inline float bf2f(bf16_t b) { return u2f(((unsigned)b) << 16); }

struct RC {
    static constexpr int D = 2048, FF = 8192, BATCH = 4, SEQ = 2048, DEPTH = 2, DEC_BATCH = 32, DEC_SEQ = 32, PAST = 2048, NMEM = 256;
};
template <class B> struct CfgT : B {
    using B::D; using B::FF; using B::BATCH; using B::SEQ; using B::DEPTH; using B::DEC_BATCH; using B::DEC_SEQ; using B::PAST; using B::NMEM;
    static constexpr int MP = BATCH * SEQ, MS = DEC_BATCH * DEC_SEQ, M = MP + MS, MM = BATCH * NMEM;
    static constexpr int PW = D / 4, PG = 4, PGD = PW / 4, PH = 15;
    static constexpr int GW = D / 4, GH = 4, GHD = GW / 4, GCH = 128;
    static constexpr int MW = D - PW - GW, MH = 8, MHD = MW / 8, CH = 64;
    static constexpr int INC = PW + 2 * GW + 4 * MW + 2 * MH;
    static constexpr int LDP = ((INC + 255) / 256) * 256;
    static constexpr int AH = 4, AHD = D / 4;
    static constexpr int O_U = PW, O_V = PW + GW, O_Q = PW + 2 * GW, O_K = O_Q + MW, O_VM = O_K + MW, O_O = O_VM + MW, O_IG = O_O + MW, O_FG = O_IG + MH;
    static constexpr int NC = SEQ / CH, NPC = BATCH * MH * NC, NSC = DEC_BATCH * MH, NCH = NPC + NSC;
    static constexpr int LCS = DEC_SEQ < CH ? DEC_SEQ : CH;
    static constexpr int GLP = SEQ < GCH ? SEQ : GCH, GLS = DEC_SEQ < GCH ? DEC_SEQ : GCH;
    static constexpr int NSS = 1 + 4 * DEPTH;
    static constexpr long OUT_YP = 0, OUT_YS = OUT_YP + (long)MP * D, OUT_POOLP = OUT_YS + (long)MS * D, OUT_POOLS = OUT_POOLP + (long)DEPTH * BATCH * PH * PW,
        OUT_CP = OUT_POOLS + (long)DEPTH * DEC_BATCH * PH * PW, OUT_NP = OUT_CP + (long)DEPTH * BATCH * MH * MHD * MHD, OUT_MP = OUT_NP + (long)DEPTH * BATCH * MH * MHD,
        OUT_CS = OUT_MP + (long)DEPTH * BATCH * MH, OUT_NS = OUT_CS + (long)DEPTH * DEC_BATCH * MH * MHD * MHD, OUT_MS = OUT_NS + (long)DEPTH * DEC_BATCH * MH * MHD,
        OUT_VS = OUT_MS + (long)DEPTH * DEC_BATCH * MH, OUT_MK = OUT_VS + (long)DEPTH * DEC_BATCH * DEC_SEQ * GW, OUT_MV = OUT_MK + (long)DEPTH * BATCH * NMEM * D,
        OUT_END = OUT_MV + (long)DEPTH * BATCH * NMEM * D;
    static constexpr size_t al(size_t x) { return (x + 255) & ~(size_t)255; }
    static constexpr size_t WS_CTL = 0, WS_SS = 65536, WS_X = al(WS_SS + (size_t)NSS * M * 4), WS_XB = al(WS_X + (size_t)M * D * 4),
        WS_BIG = al(WS_XB + (size_t)M * D * 2),
        WS_BIG_SZ = ((size_t)M * FF * 2 > (size_t)M * LDP * 4) ? (size_t)M * FF * 2 : (size_t)M * LDP * 4,
        WS_MIX = al(WS_BIG + WS_BIG_SZ), WS_Q = al(WS_MIX + (size_t)M * D * 2), WS_AO = al(WS_Q + (size_t)M * D * 2),
        WS_MEMB = al(WS_AO + (size_t)M * D * 2), WS_RSTDM = al(WS_MEMB + (size_t)MM * D * 2),
        WS_GB = al(WS_RSTDM + (size_t)MM * 4), WS_GA = al(WS_GB + (size_t)M * MH * 4),
        WS_CBL = al(WS_GA + (size_t)M * MH * 4), WS_CML = al(WS_CBL + (size_t)NCH * 4), WS_MPREV = al(WS_CML + (size_t)NCH * 4),
        WS_DC = al(WS_MPREV + (size_t)NCH * 4), WS_DN = al(WS_DC + (size_t)NCH * MHD * MHD * 4),
        WS_DCB = al(WS_DN + (size_t)NCH * MHD * 4),
        WS_W = al(WS_DCB + (size_t)NCH * MHD * MHD * 2);
    static constexpr size_t W_1IN = 0, W_1OUT = W_1IN + (size_t)2 * FF * D, W_IN = W_1OUT + (size_t)D * FF, W_OUT = W_IN + (size_t)LDP * D, W_Q = W_OUT + (size_t)D * D,
        W_KV = W_Q + (size_t)D * D, W_O = W_KV + (size_t)2 * D * D, W_2IN = W_O + (size_t)D * D, W_2OUT = W_2IN + (size_t)2 * FF * D, W_LAYER = W_2OUT + (size_t)D * FF;
    static constexpr size_t WS_KVB = al(WS_W + (size_t)DEPTH * W_LAYER * 2);
    static constexpr size_t WS_END = al(WS_KVB + (size_t)2 * MM * D * 2);
};

struct Ptrs { const float* in[33]; float* out; unsigned char* ws; };
enum { I_XP = 0, I_XS, I_MEM, I_SPOOL, I_SC, I_SN, I_SM, I_CK, I_CV, I_GFFN1, I_W1IN, I_W1OUT, I_GMIX, I_WIN, I_POOLW, I_POOLS, I_GVG, I_GWS, I_GBS, I_IB, I_FB, I_NG, I_WOUT,
       I_GX, I_GMEM, I_WQ, I_WK, I_WV, I_WO, I_GFFN2, I_W2IN, I_W2OUT, I_GFIN };

template <class C> HD inline float* wsf(const Ptrs& p, size_t off) { return (float*)(p.ws + off); }
template <class C> HD inline bf16_t* wsb(const Ptrs& p, size_t off) { return (bf16_t*)(p.ws + off); }
template <class C> HD inline bf16_t* wlayer(const Ptrs& p, int l, size_t off) { return (bf16_t*)(p.ws + C::WS_W) + (size_t)l * C::W_LAYER + off; }

template <class C> HD inline void row_info(int r, bool& s, int& b, int& t) {
    if (r < C::MP) { s = false; b = r / C::SEQ; t = r % C::SEQ; } else { s = true; const int q = r - C::MP; b = q / C::DEC_SEQ; t = q % C::DEC_SEQ; }
}
template <class C> HD inline void chunk_info(int r, int h, int& ci, int& i, int& lc) {
    bool s; int b, t; row_info<C>(r, s, b, t);
    if (!s) { ci = (b * C::MH + h) * C::NC + t / C::CH; i = t % C::CH; lc = C::CH; } else { ci = C::NPC + b * C::MH + h; i = t; lc = C::LCS; }
}
HD inline float sigmoidf_(float x) { return 1.0f / (1.0f + expf(-x)); }
HD inline float logsigmoidf_(float x) { return x >= 0.f ? -log1pf(expf(-x)) : x - log1pf(expf(x)); }

enum { WK_PLAIN = 0, WK_FFNIN = 1, WK_WIN = 2 };
template <class C> HD inline int wsrc_col(int kind, int n) {
    if (kind == WK_FFNIN) { const int pn = n >> 8, j = n & 255; return j < 128 ? 128 * pn + j : C::FF + 128 * pn + (j - 128); }
    if (kind == WK_WIN) return n < C::INC ? n : -1;
    return n;
}

template <class C> HD inline void st_ml_b0(const Ptrs& p, int l, int sq) {
    const float* CBL = wsf<C>(p, C::WS_CBL); const float* CML = wsf<C>(p, C::WS_CML); float* MPREV = wsf<C>(p, C::WS_MPREV);
    if (sq < C::BATCH * C::MH) { float m = 0.f;
        for (int c = 0; c < C::NC; ++c) { const int ci = sq * C::NC + c; MPREV[ci] = m; const float a = CBL[ci] + m, b2 = CML[ci]; m = a > b2 ? a : b2; }
        p.out[C::OUT_MP + (size_t)l * C::BATCH * C::MH + sq] = m;
    } else { const int q = sq - C::BATCH * C::MH, ci = C::NPC + q; const float m0 = p.in[I_SM][(size_t)l * C::DEC_BATCH * C::MH + q];
        MPREV[ci] = m0; const float a = CBL[ci] + m0, b2 = CML[ci]; p.out[C::OUT_MS + (size_t)l * C::DEC_BATCH * C::MH + q] = a > b2 ? a : b2; }
}

namespace pg8 {
#define PG8_LAS __attribute__((address_space(3)))
typedef unsigned short bf16_t;
typedef short bf16x8 __attribute__((ext_vector_type(8)));
typedef float f32x4 __attribute__((ext_vector_type(4)));
typedef unsigned u32x4 __attribute__((ext_vector_type(4)));
constexpr int BM = 256, BK = 64, HALF = 128, HTB = HALF * BK * 2  , STAGE_BYTES = 8 * HTB, NXCD = 8, WGM = 8;

__host__ __device__ __forceinline__ int lds_byte(int r, int c) { const int st = (r >> 4) * 2 + (c >> 5), rr = r & 15, cc = c & 31, ob = rr * 64 + cc * 2; return st * 1024 + (ob ^ (((ob >> 9) & 1) << 5)); }
__host__ __device__ __forceinline__ void stage_rc(int b, int& R, int& C) { const int st = b / 1024, sb = b % 1024, swz = sb ^ (((sb >> 9) & 1) << 5); R = (st >> 1) * 16 + swz / 64; C = (st & 1) * 32 + (swz % 64) / 2; }
__host__ __device__ __forceinline__ int perm32(int rho) { const int n = rho >> 4, i = rho & 15; return 8 * (i >> 2) + 4 * n + (i & 3); }

struct Unit { int pm, pn; };
struct Gemm { const bf16_t* A; const bf16_t* Bt; int M, N, K, ld; };

struct StaticOrder {
    int nM, nN, nwg, G, c;
    __host__ __device__ __forceinline__ void init(int M, int N, int G_, int c_, int rows_per_tile = BM) { nM = M / rows_per_tile; nN = N / BM; nwg = nM * nN; G = G_; c = c_; }
    __host__ __device__ __forceinline__ bool next(int i, Unit& u) const {
        const long L = (long)i * G + c; if (L >= nwg) return false;
        int wgid = (int)L; { const int q = nwg / NXCD, r = nwg % NXCD, xcd = wgid % NXCD, off = wgid / NXCD; wgid = (xcd < r ? xcd * (q + 1) : r * (q + 1) + (xcd - r) * q) + off; }
        const int nig = WGM * nN, gid = wgid / nig, fm = gid * WGM, gsz = (nM - fm) < WGM ? (nM - fm) : WGM;
        u.pm = fm + ((wgid % nig) % gsz); u.pn = (wgid % nig) / gsz; return true;
    }
    __device__ __forceinline__ void a_ready(const Unit&) const {}
    __device__ __forceinline__ void done(const Unit&) const {}
};
__device__ __forceinline__ unsigned cvt_pk_bf16(float lo, float hi) { unsigned r; asm volatile("v_cvt_pk_bf16_f32 %0, %1, %2" : "=v"(r) : "v"(lo), "v"(hi)); return r; }
typedef float f32x2 __attribute__((ext_vector_type(2)));
template <class Epi, class Sched, bool STRIP = false, bool STAMP = false>
__device__ __forceinline__ void gemm_phase(PG8_LAS unsigned char* lds, const Gemm g, const Sched& S, const Epi& E, unsigned long long* stamps) {
    int tid_l = threadIdx.x; asm volatile("" : "+v"(tid_l));
    const int tid = tid_l, wid = __builtin_amdgcn_readfirstlane(tid >> 6), lane = tid & 63, wr = wid >> 2, wc = wid & 3, fr = lane & 15, fq = lane >> 4;
    const int K = g.K, nt = K / BK;
    int ts_lo = 0, ts_hi = 0, nts = 0; const unsigned long long rt_entry = STAMP ? (unsigned long long)wall_clock64() : 0ull;
#define PG8_STAMP() do { if (STAMP && wid == 0 && nts < 64) { const unsigned long long _c = (unsigned long long)clock64(); \
        ts_lo = (lane == nts) ? (int)(unsigned)_c : ts_lo; ts_hi = (lane == nts) ? (int)(unsigned)(_c >> 32) : ts_hi; ++nts; } } while (0)
    PG8_STAMP();
    unsigned voffA[2], voffB[2];
#pragma unroll
    for (int i = 0; i < 2; ++i) { int R, C; stage_rc(tid * 16 + i * 8192, R, C); const int Rb = Epi::PERM ? ((R & ~31) + perm32(R & 31)) : R;
        voffA[i] = (unsigned)(R * g.ld + C) * 2u; voffB[i] = (unsigned)(Rb * g.ld + C) * 2u; }
    const size_t kstep = (size_t)(BK * 2);
    const size_t hstep = (size_t)HALF * g.ld * 2;
    const size_t tstep = 2 * hstep;
    const size_t tstepA = STRIP ? (size_t)288 * g.ld * 2 : tstep;
    unsigned voffS = 0u; if constexpr (STRIP) { int R, C; stage_rc((wid & 3) * 1024 + lane * 16, R, C); voffS = (unsigned)(R * g.ld + C) * 2u; }
    const int soff = lds_byte(wr * 16 + fr, fq * 8);
    const unsigned ldsw = (unsigned)wid * 1024u;
    const int aoff = lds_byte(wr * 64 + fr, fq * 8), boff = lds_byte(wc * 32 + fr, fq * 8);
#define PG8_SA(b, h) (((b) * 2 + (h)) * HTB)
#define PG8_SB(b, h) ((4 + (b) * 2 + (h)) * HTB)
#define PG8_SS(b) (8 * HTB + (b) * 8192)
#define PG8_STAGE_S(b, gbase) do { if constexpr (STRIP) __builtin_amdgcn_global_load_lds((const unsigned*)((const char*)(gbase) + 2 * hstep + voffS), (PG8_LAS unsigned*)(lds + PG8_SS(b) + ldsw), 16, 0, 0); } while (0)
#define PG8_LDS(b) do { if constexpr (STRIP) { _Pragma("unroll") for (int k = 0; k < 2; ++k) Sf[k] = *(const PG8_LAS bf16x8*)(lds + PG8_SS(b) + soff + k * 1024); } } while (0)
#define PG8_MMS(bj, Bt) do { if constexpr (STRIP) { __builtin_amdgcn_s_setprio(1); _Pragma("unroll") for (int n = 0; n < 2; ++n) _Pragma("unroll") for (int k = 0; k < 2; ++k) accS[bj][n] = __builtin_amdgcn_mfma_f32_16x16x32_bf16(Bt[n][k], Sf[k], accS[bj][n], 0, 0, 0); __builtin_amdgcn_s_setprio(0); } } while (0)
#define PG8_STAGE(bufoff, gbase, voff) do { _Pragma("unroll") for (int _i = 0; _i < 2; ++_i) \
        __builtin_amdgcn_global_load_lds((const unsigned*)((const char*)(gbase) + (voff)[_i]), (PG8_LAS unsigned*)(lds + (bufoff) + ldsw + _i * 8192), 16, 0, 0); } while (0)
#define PG8_LDA(dst, b, h) do { _Pragma("unroll") for (int m = 0; m < 4; ++m) _Pragma("unroll") for (int k = 0; k < 2; ++k) dst[m][k] = *(const PG8_LAS bf16x8*)(lds + PG8_SA(b, h) + aoff + m * 2048 + k * 1024); } while (0)
#define PG8_LDB(dst, b, h) do { _Pragma("unroll") for (int n = 0; n < 2; ++n) _Pragma("unroll") for (int k = 0; k < 2; ++k) dst[n][k] = *(const PG8_LAS bf16x8*)(lds + PG8_SB(b, h) + boff + n * 2048 + k * 1024); } while (0)
#define PG8_MMA(ai, bj, At, Bt) do { __builtin_amdgcn_s_setprio(1); _Pragma("unroll") for (int m = 0; m < 4; ++m) _Pragma("unroll") for (int n = 0; n < 2; ++n) _Pragma("unroll") for (int k = 0; k < 2; ++k) \
        acc[ai][bj][m][n] = __builtin_amdgcn_mfma_f32_16x16x32_bf16(Bt[n][k], At[m][k], acc[ai][bj][m][n], 0, 0, 0); __builtin_amdgcn_s_setprio(0); } while (0)
#define PG8_WAIT_V(n) asm volatile("s_waitcnt vmcnt(" #n ")" ::: "memory")
#define PG8_WAIT_L(n) asm volatile("s_waitcnt lgkmcnt(" #n ")" ::: "memory")
#define PG8_WAIT_VS(n, ns) do { if constexpr (STRIP) PG8_WAIT_V(ns); else PG8_WAIT_V(n); } while (0)
#define PG8_WAIT_LS(n, ns) do { if constexpr (STRIP) PG8_WAIT_L(ns); else PG8_WAIT_L(n); } while (0)
#define PG8_BAR __builtin_amdgcn_s_barrier()
#define PG8_SCHED __builtin_amdgcn_sched_barrier(0)
    Unit cur, nxt; int ui = 0;
    if (!S.next(0, cur)) return;
    f32x4 acc[2][2][4][2];
#pragma unroll
    for (int a = 0; a < 2; ++a)
#pragma unroll
        for (int b = 0; b < 2; ++b)
#pragma unroll
            for (int m = 0; m < 4; ++m)
#pragma unroll
                for (int n = 0; n < 2; ++n) acc[a][b][m][n] = (f32x4){0.f, 0.f, 0.f, 0.f};
    bf16x8 At[4][2], B0[2][2], B1[2][2];
    f32x4 accS[2][2]; bf16x8 Sf[2];
#pragma unroll
    for (int b = 0; b < 2; ++b)
#pragma unroll
        for (int n = 0; n < 2; ++n) accS[b][n] = (f32x4){0.f, 0.f, 0.f, 0.f};
#pragma unroll
    for (int k = 0; k < 2; ++k) Sf[k] = (bf16x8){0, 0, 0, 0, 0, 0, 0, 0};
    const char* cA = (const char*)g.A + (size_t)cur.pm * tstepA; const char* cB = (const char*)g.Bt + (size_t)cur.pn * tstep;
    S.a_ready(cur);
    PG8_STAGE(PG8_SB(0, 0), cB, voffB); PG8_STAGE(PG8_SA(0, 0), cA, voffA); PG8_STAGE(PG8_SB(0, 1), cB + hstep, voffB); PG8_STAGE(PG8_SA(0, 1), cA + hstep, voffA); PG8_STAGE_S(0, cA);
    if (wr == 1) PG8_BAR;
    PG8_WAIT_VS(4, 5); PG8_BAR;
    PG8_STAGE(PG8_SB(1, 0), cB + kstep, voffB); PG8_STAGE(PG8_SA(1, 0), cA + kstep, voffA); PG8_STAGE(PG8_SB(1, 1), cB + hstep + kstep, voffB); PG8_STAGE_S(1, cA + kstep);
    PG8_WAIT_VS(6, 7); PG8_BAR;
    PG8_STAMP();
    for (;;) {
        const bool has_next = S.next(ui + 1, nxt);
        const char* nA = has_next ? (const char*)g.A + (size_t)nxt.pm * tstepA : cA; const char* nB = has_next ? (const char*)g.Bt + (size_t)nxt.pn * tstep : cB;
        for (int t = 0; t < nt; t += 2) {
            const bool last = (t == nt - 2);
            const char* a1 = cA + (size_t)(t + 1) * kstep;
            const char* a2 = last ? nA : cA + (size_t)(t + 2) * kstep; const char* b2 = last ? nB : cB + (size_t)(t + 2) * kstep;
            const char* a3 = a2 + kstep; const char* b3 = b2 + kstep;
            if (last && has_next) S.a_ready(nxt);
            PG8_LDB(B0, 0, 0); PG8_SCHED; PG8_LDA(At, 0, 0); PG8_LDS(0); PG8_STAGE(PG8_SA(1, 1), a1 + hstep, voffA);
            PG8_WAIT_LS(8, 10); PG8_BAR; PG8_WAIT_L(0); PG8_MMA(0, 0, At, B0); PG8_MMS(0, B0); PG8_BAR; PG8_SCHED;
            PG8_LDB(B1, 0, 1); PG8_STAGE(PG8_SB(0, 0), b2, voffB);
            PG8_BAR; PG8_WAIT_L(0); PG8_MMA(0, 1, At, B1); PG8_MMS(1, B1); PG8_BAR;
            PG8_LDA(At, 0, 1); PG8_STAGE(PG8_SA(0, 0), a2, voffA); PG8_STAGE_S(0, a2);
            PG8_BAR; PG8_WAIT_L(0); PG8_MMA(1, 0, At, B0); PG8_BAR; PG8_SCHED;
            PG8_STAGE(PG8_SB(0, 1), b2 + hstep, voffB);
            PG8_WAIT_VS(6, 7); PG8_BAR; PG8_MMA(1, 1, At, B1); PG8_BAR;
            PG8_LDB(B0, 1, 0); PG8_SCHED; PG8_LDA(At, 1, 0); PG8_LDS(1); PG8_STAGE(PG8_SA(0, 1), a2 + hstep, voffA);
            PG8_WAIT_LS(8, 10); PG8_BAR; PG8_WAIT_L(0); PG8_MMA(0, 0, At, B0); PG8_MMS(0, B0); PG8_BAR; PG8_SCHED;
            PG8_LDB(B1, 1, 1); PG8_STAGE(PG8_SB(1, 0), b3, voffB);
            PG8_BAR; PG8_WAIT_L(0); PG8_MMA(0, 1, At, B1); PG8_MMS(1, B1); PG8_BAR;
            PG8_LDA(At, 1, 1); PG8_STAGE(PG8_SA(1, 0), a3, voffA); PG8_STAGE_S(1, a3);
            PG8_BAR; PG8_WAIT_L(0); PG8_MMA(1, 0, At, B0); PG8_BAR; PG8_SCHED;
            PG8_STAGE(PG8_SB(1, 1), b3 + hstep, voffB);
            PG8_WAIT_VS(6, 7); PG8_BAR; PG8_MMA(1, 1, At, B1); PG8_BAR;
        }
        PG8_STAMP();
        { const int rt0 = cur.pm * (STRIP ? 288 : 256), rw0 = rt0 + wr * 64 + fr;
#define PG8_RV(ai, m) {{acc[ai][0][m][0], acc[ai][0][m][1]}, {acc[ai][1][m][0], acc[ai][1][m][1]}}
#define PG8_BATCH(r0_, v0_, r1_, v1_) do { const typename Epi::Pre p0_ = E.pre(r0_, cur.pn, wc, fq), p1_ = E.pre(r1_, cur.pn, wc, fq); \
              { const f32x4 v_[2][2] = v0_; E.row(v_, p0_, r0_, cur.pn, wc, fq); } { const f32x4 v_[2][2] = v1_; E.row(v_, p1_, r1_, cur.pn, wc, fq); } } while (0)
          if constexpr (Epi::PRE_ALL) {
              typename Epi::Pre pa_[9];
#pragma unroll
              for (int q_ = 0; q_ < 8; ++q_) pa_[q_] = E.pre(rw0 + (q_ >> 2) * HALF + (q_ & 3) * 16, cur.pn, wc, fq);
              pa_[8] = STRIP ? E.pre(rt0 + 256 + wr * 16 + fr, cur.pn, wc, fq) : pa_[0];
#define PG8_ONE(q_, ai, m) { const f32x4 v_[2][2] = PG8_RV(ai, m); E.row(v_, pa_[q_], rw0 + ai * HALF + m * 16, cur.pn, wc, fq); }
              PG8_ONE(0, 0, 0) PG8_ONE(1, 0, 1) PG8_ONE(2, 0, 2) PG8_ONE(3, 0, 3) PG8_ONE(4, 1, 0) PG8_ONE(5, 1, 1) PG8_ONE(6, 1, 2) PG8_ONE(7, 1, 3)
#undef PG8_ONE
              if constexpr (STRIP) E.row(accS, pa_[8], rt0 + 256 + wr * 16 + fr, cur.pn, wc, fq);
#if defined(PROBE_EPI2)
              asm volatile("" ::: "memory");
#pragma unroll
              for (int q_ = 0; q_ < 8; ++q_) pa_[q_] = E.pre(rw0 + (q_ >> 2) * HALF + (q_ & 3) * 16, cur.pn, wc, fq);
              pa_[8] = STRIP ? E.pre(rt0 + 256 + wr * 16 + fr, cur.pn, wc, fq) : pa_[0];
#define PG8_ONE(q_, ai, m) { const f32x4 v_[2][2] = PG8_RV(ai, m); E.row(v_, pa_[q_], rw0 + ai * HALF + m * 16, cur.pn, wc, fq); }
              PG8_ONE(0, 0, 0) PG8_ONE(1, 0, 1) PG8_ONE(2, 0, 2) PG8_ONE(3, 0, 3) PG8_ONE(4, 1, 0) PG8_ONE(5, 1, 1) PG8_ONE(6, 1, 2) PG8_ONE(7, 1, 3)
#undef PG8_ONE
              if constexpr (STRIP) E.row(accS, pa_[8], rt0 + 256 + wr * 16 + fr, cur.pn, wc, fq);
#endif
          } else {
          PG8_BATCH(rw0, PG8_RV(0, 0), rw0 + 16, PG8_RV(0, 1));
          PG8_BATCH(rw0 + 32, PG8_RV(0, 2), rw0 + 48, PG8_RV(0, 3));
          PG8_BATCH(rw0 + HALF, PG8_RV(1, 0), rw0 + HALF + 16, PG8_RV(1, 1));
          PG8_BATCH(rw0 + HALF + 32, PG8_RV(1, 2), rw0 + HALF + 48, PG8_RV(1, 3));
          if constexpr (STRIP) { const int rs_ = rt0 + 256 + wr * 16 + fr; const typename Epi::Pre ps_ = E.pre(rs_, cur.pn, wc, fq); E.row(accS, ps_, rs_, cur.pn, wc, fq); }
          }
          if constexpr (STRIP) {
#pragma unroll
              for (int b = 0; b < 2; ++b)
#pragma unroll
                for (int n = 0; n < 2; ++n) accS[b][n] = (f32x4){0.f, 0.f, 0.f, 0.f}; }
#undef PG8_BATCH
#undef PG8_RV
          S.done(cur); }
        PG8_STAMP();
        if (!has_next) break;
#pragma unroll
        for (int a = 0; a < 2; ++a)
#pragma unroll
            for (int b = 0; b < 2; ++b)
#pragma unroll
                for (int m = 0; m < 4; ++m)
#pragma unroll
                    for (int n = 0; n < 2; ++n) acc[a][b][m][n] = (f32x4){0.f, 0.f, 0.f, 0.f};
        cur = nxt; cA = nA; cB = nB; ++ui;
    }
    PG8_WAIT_V(0);
    if (wr == 0) PG8_BAR;
    PG8_BAR;
    PG8_STAMP();
    if (STAMP && wid == 0) { stamps[lane] = lane < nts ? (((unsigned long long)(unsigned)ts_hi << 32) | (unsigned)ts_lo) : 0ull;
        if (lane == 62) stamps[62] = rt_entry; if (lane == 63) stamps[63] = (unsigned long long)wall_clock64(); }
#undef PG8_STAMP
#undef PG8_SA
#undef PG8_SB
#undef PG8_STAGE
#undef PG8_LDA
#undef PG8_LDB
#undef PG8_MMA
#undef PG8_WAIT_V
#undef PG8_WAIT_L
#undef PG8_BAR
#undef PG8_SCHED
#undef PG8_WAIT_LS
#undef PG8_WAIT_VS
#undef PG8_MMS
#undef PG8_LDS
#undef PG8_STAGE_S
#undef PG8_SS
}
}


#define LAS __attribute__((address_space(3)))
#define XB_TMO      128
#define XB_XCNT(j)  (256  + 64 * (j))
#define XB_XSUB(j)  (1280 + 64 * (j))
#define XB_XGEN(j)  (2304 + 64 * (j))
#define XB_TOP      3328
#define XB_TOPGEN   3392
#define XCD_BAR_WORDS 3456
#define XB_SPIN_CAP (1u << 18)

__device__ __forceinline__ unsigned xb_ld(unsigned* p)              { return __hip_atomic_load(p, __ATOMIC_RELAXED, __HIP_MEMORY_SCOPE_AGENT); }
__device__ __forceinline__ unsigned xb_add(unsigned* p, unsigned v) { return __hip_atomic_fetch_add(p, v, __ATOMIC_RELAXED, __HIP_MEMORY_SCOPE_AGENT); }
__device__ __forceinline__ unsigned xb_xcc_id() { return (unsigned)__builtin_amdgcn_s_getreg((3 << 11) | 20) & 0xFu; }
#define XB_SPIN(cond, bar) do { unsigned _sp = 0; while (cond) { __builtin_amdgcn_s_sleep(1); \
    if ((++_sp & 255u) == 0u) { if (xb_ld(&(bar)[XB_TMO])) break; if (_sp > XB_SPIN_CAP) { atomicAdd(&(bar)[XB_TMO], 1u); break; } } } } while (0)

struct XcdBarrier {
    unsigned* bar; unsigned x;
    volatile LAS unsigned* st;
};

__device__ __forceinline__ XcdBarrier xcd_barrier_post(unsigned* bar, volatile LAS unsigned* st) {
    XcdBarrier b; b.bar = bar; b.x = xb_xcc_id(); b.st = st;
    if (threadIdx.x == 0) (void)xb_add(&bar[XB_XCNT(b.x)], 1u);
    return b;
}
__device__ __forceinline__ void xcd_barrier_complete(unsigned* bar, unsigned x, unsigned& nloc, unsigned& nx) {
    const unsigned G = gridDim.x * gridDim.y * gridDim.z;
    unsigned sum, cnt, mine, sp = 0u;
    for (;;) {
        sum = 0u; cnt = 0u; mine = 0u;
#pragma unroll
        for (unsigned j = 0; j < 16; ++j) { const unsigned c = xb_ld(&bar[XB_XCNT(j)]); sum += c; cnt += (c > 0u) ? 1u : 0u; mine = (j == x) ? c : mine; }
        if (sum == G) break;
        __builtin_amdgcn_s_sleep(1);
        if ((++sp & 255u) == 0u) { if (xb_ld(&bar[XB_TMO])) break; if (sp > XB_SPIN_CAP) { atomicAdd(&bar[XB_TMO], 1u); break; } }
    }
    nloc = mine > 0u ? mine : 1u; nx = cnt > 0u ? cnt : 1u;
}

__device__ __forceinline__ void xcd_barrier(const XcdBarrier& b) {
    asm volatile("s_waitcnt vmcnt(0)" ::: "memory");
    __syncthreads();
    if (threadIdx.x == 0) {
        unsigned* bar = b.bar;
        __builtin_amdgcn_s_waitcnt(0);
        unsigned nloc = b.st[0], nx = b.st[1];
        if (nloc == 0u) { xcd_barrier_complete(bar, b.x, nloc, nx); b.st[0] = nloc; b.st[1] = nx; }
        const unsigned old = xb_add(&bar[XB_XSUB(b.x)], 1u);
        const unsigned gen = old / nloc;
        if (old + 1u == (gen + 1u) * nloc) {
            __builtin_amdgcn_fence(__ATOMIC_RELEASE, "agent");
            asm volatile("s_waitcnt vmcnt(0)" ::: "memory");
            const unsigned og = xb_add(&bar[XB_TOP], 1u);
            const unsigned tg = og / nx;
            if (og + 1u == (tg + 1u) * nx) xb_add(&bar[XB_TOPGEN], 1u);
            else XB_SPIN(xb_ld(&bar[XB_TOPGEN]) == tg, bar);
            __builtin_amdgcn_fence(__ATOMIC_ACQUIRE, "agent");
            xb_add(&bar[XB_XGEN(b.x)], 1u);
            asm volatile("s_waitcnt vmcnt(0)" ::: "memory");
        } else {
            XB_SPIN(xb_ld(&bar[XB_XGEN(b.x)]) == gen, bar);
            __builtin_amdgcn_fence(__ATOMIC_ACQUIRE, "agent");
            asm volatile("s_waitcnt vmcnt(0)" ::: "memory");
        }
    }
    __syncthreads();
}

typedef CfgT<RC> C;
constexpr int NTHREADS = 512, NWAVES = 8;
constexpr int LDS_STAGE = 131072 + 16384 + 8192, LDS_CTL = LDS_STAGE, LDS_BYTES = LDS_STAGE + 256;

namespace pg8 {
typedef unsigned u32x2 __attribute__((ext_vector_type(2)));
__device__ __forceinline__ float silu_f(float g) { return g * __builtin_amdgcn_rcpf(1.0f + __expf(-g)); }
struct EpiSwiGLU { static constexpr bool PERM = true, PRE_ALL = true;
    bf16_t* act; const float* ss; int ff; float invd;
    typedef float Pre;
    __device__ __forceinline__ Pre pre(int row, int pn, int wc, int fq) const { return ss[row]; }
    __device__ __forceinline__ void row(const f32x4 (&v)[2][2], Pre ssr, int row, int pn, int wc, int fq) const {
        const float rs = rsqrtf(ssr * invd + 1e-6f); f32x4 o[2];
#pragma unroll
        for (int n = 0; n < 2; ++n) { const f32x4 g = v[0][n] * rs, up = v[1][n] * rs;
#pragma unroll
            for (int j = 0; j < 4; ++j) o[n][j] = silu_f(g[j]) * up[j]; }
        u32x4 w; w.x = cvt_pk_bf16(o[0][0], o[0][1]); w.y = cvt_pk_bf16(o[0][2], o[0][3]); w.z = cvt_pk_bf16(o[1][0], o[1][1]); w.w = cvt_pk_bf16(o[1][2], o[1][3]);
        *(u32x4*)(act + (size_t)row * ff + pn * 128 + wc * 32 + 8 * fq) = w;
    }
};
struct EpiResid { static constexpr bool PERM = false, PRE_ALL = false;
    float* X; bf16_t* XB; float* ssout; float scale; int ld;
    struct Pre { f32x4 x[2][2]; };
    __device__ __forceinline__ Pre pre(int row, int pn, int wc, int fq) const { Pre q; const float* xr = X + (size_t)row * ld + pn * BM + wc * 32 + 4 * fq;
#pragma unroll
        for (int bj = 0; bj < 2; ++bj)
#pragma unroll
            for (int n = 0; n < 2; ++n) q.x[bj][n] = *(const f32x4*)(xr + bj * HALF + n * 16);
        return q; }
    __device__ __forceinline__ void row(const f32x4 (&v)[2][2], const Pre& q, int row, int pn, int wc, int fq) const {
        const int col0 = pn * BM + wc * 32 + 4 * fq; float* xr = X + (size_t)row * ld + col0; bf16_t* br = XB + (size_t)row * ld + col0; float s = 0.f;
#pragma unroll
        for (int bj = 0; bj < 2; ++bj)
#pragma unroll
            for (int n = 0; n < 2; ++n) { const f32x4 x = q.x[bj][n] + v[bj][n] * scale; *(f32x4*)(xr + bj * HALF + n * 16) = x;
                u32x2 w; w.x = cvt_pk_bf16(x[0], x[1]); w.y = cvt_pk_bf16(x[2], x[3]); *(u32x2*)(br + bj * HALF + n * 16) = w;
                s += (x[0] * x[0] + x[1] * x[1]) + (x[2] * x[2] + x[3] * x[3]); }
        s += __shfl_xor(s, 16); s += __shfl_xor(s, 32);
        if (fq == 0) unsafeAtomicAdd(ssout + row, s);
    }
};
struct EpiScaleF32 { static constexpr bool PERM = false, PRE_ALL = true;
    float* Cp; int ldc; const float* ss; float invd;
    typedef float Pre;
    __device__ __forceinline__ Pre pre(int row, int pn, int wc, int fq) const { return ss[row]; }
    __device__ __forceinline__ void row(const f32x4 (&v)[2][2], Pre ssr, int row, int pn, int wc, int fq) const {
        const float rs = rsqrtf(ssr * invd + 1e-6f); float* cr = Cp + (size_t)row * ldc + pn * BM + wc * 32 + 4 * fq;
#pragma unroll
        for (int bj = 0; bj < 2; ++bj)
#pragma unroll
            for (int n = 0; n < 2; ++n) *(f32x4*)(cr + bj * HALF + n * 16) = v[bj][n] * rs;
    }
};
struct EpiScaleBf16 { static constexpr bool PERM = true, PRE_ALL = true;
    bf16_t* O; int ldc; const float* ss; float invd;
    typedef float Pre;
    __device__ __forceinline__ Pre pre(int row, int pn, int wc, int fq) const { return ss[row]; }
    __device__ __forceinline__ void row(const f32x4 (&v)[2][2], Pre ssr, int row, int pn, int wc, int fq) const {
        const float rs = rsqrtf(ssr * invd + 1e-6f); bf16_t* orow = O + (size_t)row * ldc + pn * BM + wc * 32 + 8 * fq;
#pragma unroll
        for (int bj = 0; bj < 2; ++bj) { const f32x4 v0 = v[bj][0] * rs, v1 = v[bj][1] * rs;
            u32x4 w; w.x = cvt_pk_bf16(v0[0], v0[1]); w.y = cvt_pk_bf16(v0[2], v0[3]); w.z = cvt_pk_bf16(v1[0], v1[1]); w.w = cvt_pk_bf16(v1[2], v1[3]);
            *(u32x4*)(orow + bj * HALF) = w; }
    }
};
struct EpiMemKV { static constexpr bool PERM = false, PRE_ALL = true;
    float* K; float* V; const float* rstd; int d; bf16_t* KVB; int mm;
    typedef float Pre;
    __device__ __forceinline__ Pre pre(int row, int pn, int wc, int fq) const { return rstd[row]; }
    __device__ __forceinline__ void row(const f32x4 (&v)[2][2], Pre rs, int row, int pn, int wc, int fq) const {
        int ct = pn * BM; float* base = K; bf16_t* bb = KVB; if (ct >= d) { base = V; ct -= d; bb += (size_t)mm * d; }
        float* cr = base + (size_t)row * d + ct + wc * 32 + 4 * fq; bb += (size_t)row * d + ct + wc * 32 + 4 * fq;
#pragma unroll
        for (int bj = 0; bj < 2; ++bj)
#pragma unroll
            for (int n = 0; n < 2; ++n) { const f32x4 o = v[bj][n] * rs; *(f32x4*)(cr + bj * HALF + n * 16) = o;
                u32x2 w; w.x = cvt_pk_bf16(o[0], o[1]); w.y = cvt_pk_bf16(o[2], o[3]); *(u32x2*)(bb + bj * HALF + n * 16) = w; }
    }
};
}

__device__ __forceinline__ void prep_item(const float* W, int K, int Ncols, const float* g, int kind, int N, bf16_t* Bt, LAS unsigned char* scr, int item, int lane) {
    const int nblk = N / 64, kb = item / nblk, nb = item % nblk, k0 = 64 * kb, n = 64 * nb + lane;
    const int sc = wsrc_col<C>(kind, n);
    const float* src = W + (size_t)k0 * Ncols + (sc >= 0 ? sc : 0);
    float v[64];
#pragma unroll
    for (int kk = 0; kk < 64; ++kk) v[kk] = src[(size_t)kk * Ncols];
    if (g) {
#pragma unroll
        for (int kk = 0; kk < 64; ++kk) v[kk] *= g[k0 + kk];
    }
    if (sc < 0) {
#pragma unroll
        for (int kk = 0; kk < 64; ++kk) v[kk] = 0.f;
    }
#pragma unroll
    for (int j = 0; j < 8; ++j) { pg8::u32x4 o; o.x = pg8::cvt_pk_bf16(v[8 * j], v[8 * j + 1]); o.y = pg8::cvt_pk_bf16(v[8 * j + 2], v[8 * j + 3]); o.z = pg8::cvt_pk_bf16(v[8 * j + 4], v[8 * j + 5]); o.w = pg8::cvt_pk_bf16(v[8 * j + 6], v[8 * j + 7]);
        *(LAS pg8::u32x4*)(scr + lane * 144 + j * 16) = o; }
    asm volatile("s_waitcnt lgkmcnt(0)" ::: "memory");
    bf16_t* dst = Bt + (size_t)(64 * nb) * K + k0 + (lane & 7) * 8;
#pragma unroll
    for (int it = 0; it < 8; ++it) { const int row = it * 8 + (lane >> 3); const pg8::u32x4 o = *(const LAS pg8::u32x4*)(scr + row * 144 + (lane & 7) * 16);
        *(pg8::u32x4*)(dst + (size_t)row * K) = o; }
    asm volatile("s_waitcnt lgkmcnt(0)" ::: "memory");
}
struct WDesc { const float* W; const float* g; bf16_t* dst; int K, Ncols, kind, N; };
__device__ __forceinline__ WDesc wdesc(const Ptrs& p, int l, int idx) {
    WDesc d; d.g = nullptr; d.kind = WK_PLAIN;
    switch (idx) {
    case 0: d.W = p.in[I_W1IN] + (size_t)l * C::D * 2 * C::FF; d.K = C::D; d.Ncols = 2 * C::FF; d.N = 2 * C::FF; d.g = p.in[I_GFFN1] + l * C::D; d.kind = WK_FFNIN; d.dst = wlayer<C>(p, l, C::W_1IN); break;
    case 1: d.W = p.in[I_W1OUT] + (size_t)l * C::FF * C::D; d.K = C::FF; d.Ncols = C::D; d.N = C::D; d.dst = wlayer<C>(p, l, C::W_1OUT); break;
    case 2: d.W = p.in[I_WIN] + (size_t)l * C::D * C::INC; d.K = C::D; d.Ncols = C::INC; d.N = C::LDP; d.g = p.in[I_GMIX] + l * C::D; d.kind = WK_WIN; d.dst = wlayer<C>(p, l, C::W_IN); break;
    case 3: d.W = p.in[I_WOUT] + (size_t)l * C::D * C::D; d.K = C::D; d.Ncols = C::D; d.N = C::D; d.dst = wlayer<C>(p, l, C::W_OUT); break;
    case 4: d.W = p.in[I_WQ] + (size_t)l * C::D * C::D; d.K = C::D; d.Ncols = C::D; d.N = C::D; d.g = p.in[I_GX] + l * C::D; d.dst = wlayer<C>(p, l, C::W_Q); break;
    case 5: d.W = p.in[I_WK] + (size_t)l * C::D * C::D; d.K = C::D; d.Ncols = C::D; d.N = C::D; d.g = p.in[I_GMEM] + l * C::D; d.dst = wlayer<C>(p, l, C::W_KV); break;
    case 6: d.W = p.in[I_WV] + (size_t)l * C::D * C::D; d.K = C::D; d.Ncols = C::D; d.N = C::D; d.g = p.in[I_GMEM] + l * C::D; d.dst = wlayer<C>(p, l, C::W_KV) + (size_t)C::D * C::D; break;
    case 7: d.W = p.in[I_WO] + (size_t)l * C::D * C::D; d.K = C::D; d.Ncols = C::D; d.N = C::D; d.dst = wlayer<C>(p, l, C::W_O); break;
    case 8: d.W = p.in[I_W2IN] + (size_t)l * C::D * 2 * C::FF; d.K = C::D; d.Ncols = 2 * C::FF; d.N = 2 * C::FF; d.g = p.in[I_GFFN2] + l * C::D; d.kind = WK_FFNIN; d.dst = wlayer<C>(p, l, C::W_2IN); break;
    default: d.W = p.in[I_W2OUT] + (size_t)l * C::FF * C::D; d.K = C::FF; d.Ncols = C::D; d.N = C::D; d.dst = wlayer<C>(p, l, C::W_2OUT); break;
    }
    return d;
}

#define WG_SYNC() do { asm volatile("s_waitcnt lgkmcnt(0)" ::: "memory"); __builtin_amdgcn_s_barrier(); asm volatile("" ::: "memory"); } while (0)
namespace att {
typedef short bf16x8 __attribute__((ext_vector_type(8)));
typedef short s16x4 __attribute__((ext_vector_type(4)));
typedef float f32x4 __attribute__((ext_vector_type(4)));
typedef unsigned u32x2 __attribute__((ext_vector_type(2)));
constexpr int TOK = 256, CD = 64, PITCH = 144, CBYTES = TOK * PITCH, HDIM = 512, NH = 4, LD = 2048;
static_assert(C::NMEM == TOK && C::AHD == HDIM && C::AH == NH && C::D == LD && C::DEC_SEQ == 32 && C::SEQ % 256 == 0, "attention phase is built for these shapes");
__device__ __forceinline__ s16x4 tr_read(unsigned addr) { s16x4 r; asm volatile("ds_read_b64_tr_b16 %0, %1" : "=&v"(r) : "v"(addr) : "memory"); return r; }
__device__ __forceinline__ void stage_load(f32x4 (&r)[8], const float* src, int tid) {
    const unsigned off0 = (unsigned)(((tid >> 4) * LD + (tid & 15) * 4) * 4);
#pragma unroll
    for (int i = 0; i < 8; ++i) { const float* si = src + (size_t)i * 32 * LD; asm volatile("" : "+s"(si));
        r[i] = *(const f32x4*)((const char*)si + off0); }
    __builtin_amdgcn_sched_barrier(0);
}
__device__ __forceinline__ void stage_load_b(pg8::u32x4 (&r)[4], const bf16_t* src, int tid) {
    const unsigned off0 = (unsigned)(((tid >> 3) * LD + (tid & 7) * 8) * 2);
#pragma unroll
    for (int i = 0; i < 4; ++i) { const bf16_t* si = src + (size_t)i * 64 * LD; asm volatile("" : "+s"(si)); r[i] = *(const pg8::u32x4*)((const char*)si + off0); }
    __builtin_amdgcn_sched_barrier(0);
}
__device__ __forceinline__ int klds(int r, int c) { const int ob = (r & 15) * 64 + (c & 31) * 2; return ((r >> 4) * 2 + (c >> 5)) * 1024 + (ob ^ (((ob >> 9) & 1) << 5)); }
__device__ __forceinline__ void stage_store_k(const f32x4 (&r)[8], LAS unsigned char* buf, int tid) {
#pragma unroll
    for (int i = 0; i < 8; ++i) { const int f = tid + 512 * i; u32x2 w; w.x = pg8::cvt_pk_bf16(r[i][0], r[i][1]); w.y = pg8::cvt_pk_bf16(r[i][2], r[i][3]);
        *(LAS u32x2*)(buf + klds(f >> 4, (f & 15) * 4)) = w; }
}
__device__ __forceinline__ void stage_store_kb(const pg8::u32x4 (&r)[4], LAS unsigned char* buf, int tid) {
    asm volatile("" : "+v"(tid));
#pragma unroll
    for (int i = 0; i < 4; ++i) *(LAS pg8::u32x4*)(buf + klds((tid >> 3) + 64 * i, (tid & 7) * 8)) = r[i];
}
__device__ __forceinline__ void stage_store_vb(const pg8::u32x4 (&r)[4], LAS unsigned char* buf, int tid) {
    asm volatile("" : "+v"(tid));
#pragma unroll
    for (int i = 0; i < 4; ++i) *(LAS pg8::u32x4*)(buf + ((tid >> 3) + 64 * i) * PITCH + (tid & 7) * 16) = r[i];
}
__device__ __forceinline__ void stage_store(const f32x4 (&r)[8], LAS unsigned char* buf, int tid) {
#pragma unroll
    for (int i = 0; i < 8; ++i) { const int f = tid + 512 * i; u32x2 w; w.x = pg8::cvt_pk_bf16(r[i][0], r[i][1]); w.y = pg8::cvt_pk_bf16(r[i][2], r[i][3]);
        *(LAS u32x2*)(buf + (f >> 4) * PITCH + (f & 15) * 8) = w; }
}
__device__ __forceinline__ void attn_sample_unit(LAS unsigned char* lds, const bf16_t* Qg, bf16_t* AO, const float* kb, const float* vb, int row0, int head, int tid) {
    const int lane = tid & 63, wave = __builtin_amdgcn_readfirstlane(tid >> 6), li = lane & 15, g = lane >> 4;
    constexpr int PP = 528;
    LAS unsigned char* Ps = lds + 2 * CBYTES;
    LAS float* smax = (LAS float*)(Ps + 32 * PP); LAS float* ssum = smax + 8 * 32;
    const bf16_t* q0 = Qg + (size_t)(row0 + li) * LD + head * HDIM + g * 8;
    f32x4 s[2][2];
#pragma unroll
    for (int u = 0; u < 2; ++u)
#pragma unroll
        for (int tt = 0; tt < 2; ++tt) s[u][tt] = (f32x4){0.f, 0.f, 0.f, 0.f};
    f32x4 r0[8], r1[8]; bf16x8 qf[2][2];
    stage_load(r0, kb, tid); stage_load(r1, kb + CD, tid);
#pragma unroll
    for (int u = 0; u < 2; ++u)
#pragma unroll
        for (int ks = 0; ks < 2; ++ks) qf[u][ks] = *(const bf16x8*)(q0 + (size_t)u * 16 * LD + ks * 32);
    stage_store(r0, lds, tid);
    WG_SYNC();
    stage_load(r0, kb + 2 * CD, tid);
#define ATS_SRC(cc) ((cc) < 8 ? kb + (cc) * CD : vb + ((cc) - 8) * CD)
#define ATS_SCORE(cc, REGN, REGF) do { LAS unsigned char* buf = lds + ((cc) & 1) * CBYTES; \
        _Pragma("unroll") for (int ks = 0; ks < 2; ++ks) _Pragma("unroll") for (int tt = 0; tt < 2; ++tt) { const bf16x8 a = *(const LAS bf16x8*)(buf + ((2 * wave + tt) * 16 + li) * PITCH + ks * 64 + g * 16); \
            s[0][tt] = __builtin_amdgcn_mfma_f32_16x16x32_bf16(a, qf[0][ks], s[0][tt], 0, 0, 0); s[1][tt] = __builtin_amdgcn_mfma_f32_16x16x32_bf16(a, qf[1][ks], s[1][tt], 0, 0, 0); } \
        if ((cc) < 7) { __builtin_amdgcn_sched_barrier(0); _Pragma("unroll") for (int u = 0; u < 2; ++u) _Pragma("unroll") for (int ks = 0; ks < 2; ++ks) qf[u][ks] = *(const bf16x8*)(q0 + (size_t)u * 16 * LD + ((cc) + 1) * CD + ks * 32); __builtin_amdgcn_sched_barrier(0); } \
        stage_store(REGN, lds + (((cc) + 1) & 1) * CBYTES, tid); WG_SYNC(); stage_load(REGF, ATS_SRC((cc) + 3), tid); } while (0)
    ATS_SCORE(0, r1, r1); ATS_SCORE(1, r0, r0); ATS_SCORE(2, r1, r1); ATS_SCORE(3, r0, r0); ATS_SCORE(4, r1, r1); ATS_SCORE(5, r0, r0); ATS_SCORE(6, r1, r1); ATS_SCORE(7, r0, r0);
    const float sc = 0.044194173824159216f * 1.4426950408889634f;
#pragma unroll
    for (int u = 0; u < 2; ++u) { float mx = fmaxf(fmaxf(fmaxf(s[u][0][0], s[u][0][1]), fmaxf(s[u][0][2], s[u][0][3])), fmaxf(fmaxf(s[u][1][0], s[u][1][1]), fmaxf(s[u][1][2], s[u][1][3])));
        mx = fmaxf(mx, __shfl_xor(mx, 16)); mx = fmaxf(mx, __shfl_xor(mx, 32));
        if (g == 0) smax[wave * 32 + u * 16 + li] = mx; }
    WG_SYNC();
#pragma unroll
    for (int u = 0; u < 2; ++u) { float mx = smax[u * 16 + li];
#pragma unroll
        for (int w = 1; w < 8; ++w) mx = fmaxf(mx, smax[w * 32 + u * 16 + li]);
        float sum = 0.f;
#pragma unroll
        for (int tt = 0; tt < 2; ++tt) {
#pragma unroll
            for (int j = 0; j < 4; ++j) { const float e = __builtin_amdgcn_exp2f((s[u][tt][j] - mx) * sc); s[u][tt][j] = e; sum += e; }
            u32x2 w2; w2.x = pg8::cvt_pk_bf16(s[u][tt][0], s[u][tt][1]); w2.y = pg8::cvt_pk_bf16(s[u][tt][2], s[u][tt][3]);
            *(LAS u32x2*)(Ps + (u * 16 + li) * PP + (32 * wave + 16 * tt + 4 * g) * 2) = w2; }
        sum += __shfl_xor(sum, 16); sum += __shfl_xor(sum, 32);
        if (g == 0) ssum[wave * 32 + u * 16 + li] = sum; }
    WG_SYNC();
    const int dt = wave & 3, uq = wave >> 2;
    float inv;
    { float sum = 0.f;
#pragma unroll
      for (int w = 0; w < 8; ++w) sum += ssum[w * 32 + uq * 16 + li];
      inv = 1.0f / sum; }
    bf16x8 pfr[8];
#pragma unroll
    for (int t = 0; t < 8; ++t) pfr[t] = *(const LAS bf16x8*)(Ps + (uq * 16 + li) * PP + (32 * t + 8 * g) * 2);
    const unsigned trb8 = (unsigned)(size_t)lds + (unsigned)((8 * g + (li >> 2)) * PITCH + (li & 3) * 8 + dt * 32);
#define ATS_PV(cc, REGN, REGF) do { const unsigned bofs = (unsigned)((cc) & 1) * CBYTES; f32x4 o = (f32x4){0.f, 0.f, 0.f, 0.f}; s16x4 lo[8], hi[8]; \
        _Pragma("unroll") for (int t = 0; t < 8; ++t) { lo[t] = tr_read(trb8 + bofs + (unsigned)(t * 32 * PITCH)); hi[t] = tr_read(trb8 + bofs + (unsigned)(t * 32 * PITCH + 4 * PITCH)); } \
        asm volatile("s_waitcnt lgkmcnt(0)" ::: "memory"); __builtin_amdgcn_sched_barrier(0); \
        _Pragma("unroll") for (int t = 0; t < 8; ++t) { const bf16x8 a = (bf16x8){lo[t][0], lo[t][1], lo[t][2], lo[t][3], hi[t][0], hi[t][1], hi[t][2], hi[t][3]}; o = __builtin_amdgcn_mfma_f32_16x16x32_bf16(a, pfr[t], o, 0, 0, 0); } \
        { u32x2 w2; w2.x = pg8::cvt_pk_bf16(o[0] * inv, o[1] * inv); w2.y = pg8::cvt_pk_bf16(o[2] * inv, o[3] * inv); \
          *(u32x2*)(AO + (size_t)(row0 + 16 * uq + li) * LD + head * HDIM + ((cc) - 8) * CD + dt * 16 + g * 4) = w2; } \
        if ((cc) < 15) stage_store(REGN, lds + (((cc) + 1) & 1) * CBYTES, tid); WG_SYNC(); if ((cc) + 3 < 16) stage_load(REGF, ATS_SRC((cc) + 3), tid); } while (0)
    ATS_PV(8, r1, r1); ATS_PV(9, r0, r0); ATS_PV(10, r1, r1); ATS_PV(11, r0, r0); ATS_PV(12, r1, r1); ATS_PV(13, r0, r0); ATS_PV(14, r1, r1); ATS_PV(15, r0, r0);
#undef ATS_SRC
#undef ATS_SCORE
#undef ATS_PV
}
__device__ __forceinline__ void attn_sample_phase(LAS unsigned char* lds, const Ptrs& p, int l, int tid, int first, int stride) {
    const bf16_t* Qg = wsb<C>(p, C::WS_Q); bf16_t* AO = wsb<C>(p, C::WS_AO);
    for (int s = first; s < C::DEC_BATCH * NH; s += stride) { const int b = s / NH, head = s % NH;
        attn_sample_unit(lds, Qg, AO, p.in[I_CK] + ((size_t)l * C::DEC_BATCH + b) * TOK * LD + head * HDIM, p.in[I_CV] + ((size_t)l * C::DEC_BATCH + b) * TOK * LD + head * HDIM, C::MP + b * C::DEC_SEQ, head, tid); }
}
__device__ __forceinline__ void attn_phase(LAS unsigned char* lds, const Ptrs& p, int l, int tid, int bid, int gsz, int nunits) {
    const int lane = tid & 63, wave = __builtin_amdgcn_readfirstlane(tid >> 6), li = lane & 15, g = lane >> 4;
    const bf16_t* Qg = wsb<C>(p, C::WS_Q); bf16_t* AO = wsb<C>(p, C::WS_AO);
    constexpr int NUP = (C::MP / 256) * NH;
    static_assert(C::SEQ % 256 == 0, "prompt units are 256 rows");
    for (int un0 = bid; un0 < nunits; un0 += gsz) {
        const int un = (NUP % 64 == 0) ? (un0 & ~63) + (un0 & 7) * 8 + ((un0 >> 3) & 7) : un0;
        const int per_b = (C::SEQ / 256) * NH, b = un / per_b, rem = un % per_b, head = rem / (C::SEQ / 256), row0 = b * C::SEQ + (rem % (C::SEQ / 256)) * 256;
        const bf16_t* kbb = wsb<C>(p, C::WS_KVB) + (size_t)b * TOK * LD + head * HDIM; const bf16_t* vbb = kbb + (size_t)C::MM * LD;
#define ATP_SRC(cc) ((cc) < 8 ? kbb + (cc) * CD : vbb + ((cc) - 8) * CD)
        const bf16_t* q0 = Qg + (size_t)(row0 + wave * 32 + li) * LD + head * HDIM + g * 8;
        f32x4 s[2][16];
#pragma unroll
        for (int u = 0; u < 2; ++u)
#pragma unroll
            for (int T = 0; T < 16; ++T) s[u][T] = (f32x4){0.f, 0.f, 0.f, 0.f};
        pg8::u32x4 w0[4], w1[4]; bf16x8 qf[2][2];
        stage_load_b(w0, ATP_SRC(0), tid); stage_load_b(w1, ATP_SRC(1), tid);
#pragma unroll
        for (int u = 0; u < 2; ++u)
#pragma unroll
            for (int ks = 0; ks < 2; ++ks) qf[u][ks] = *(const bf16x8*)(q0 + (size_t)u * 16 * LD + ks * 32);
        stage_store_kb(w0, lds, tid);
        WG_SYNC();
        stage_load_b(w0, ATP_SRC(2), tid);
        const int aoff = (li * 64 + g * 16) ^ ((li >> 3) << 5);
#define ATP_KS(ks) do { _Pragma("unroll") for (int T0 = 0; T0 < 16; T0 += 2) { bf16x8 af[2]; \
            _Pragma("unroll") for (int j = 0; j < 2; ++j) af[j] = *(const LAS bf16x8*)(buf + ((T0 + j) * 2 + (ks)) * 1024 + aoff); \
            asm volatile("s_waitcnt lgkmcnt(0)" ::: "memory"); __builtin_amdgcn_sched_barrier(0); \
            _Pragma("unroll") for (int j = 0; j < 2; ++j) { s[0][T0 + j] = __builtin_amdgcn_mfma_f32_16x16x32_bf16(af[j], qf[0][ks], s[0][T0 + j], 0, 0, 0); \
                s[1][T0 + j] = __builtin_amdgcn_mfma_f32_16x16x32_bf16(af[j], qf[1][ks], s[1][T0 + j], 0, 0, 0); } \
            __builtin_amdgcn_sched_barrier(0); } } while (0)
#define ATP_SITER(cc, WN) do { LAS unsigned char* buf = lds + ((cc) & 1) * CBYTES; \
            ATP_KS(0); ATP_KS(1); \
            if ((cc) < 7) { __builtin_amdgcn_sched_barrier(0); _Pragma("unroll") for (int u = 0; u < 2; ++u) _Pragma("unroll") for (int ks = 0; ks < 2; ++ks) qf[u][ks] = *(const bf16x8*)(q0 + (size_t)u * 16 * LD + ((cc) + 1) * CD + ks * 32); \
                __builtin_amdgcn_sched_barrier(0); stage_store_kb(WN, lds + (((cc) + 1) & 1) * CBYTES, tid); } \
            else stage_store_vb(WN, lds + (((cc) + 1) & 1) * CBYTES, tid); \
            WG_SYNC(); stage_load_b(WN, ATP_SRC((cc) + 3), tid); } while (0)
#pragma unroll 1
        for (int c2 = 0; c2 < 8; c2 += 2) { ATP_SITER(c2, w1); ATP_SITER(c2 + 1, w0); }
#undef ATP_SITER
#undef ATP_KS
        const float sc = 0.044194173824159216f * 1.4426950408889634f;
        float inv[2]; bf16x8 pf[2][8];
#pragma unroll
        for (int u = 0; u < 2; ++u) {
            float mx = -3.0e38f;
#pragma unroll
            for (int T = 0; T < 16; ++T) mx = fmaxf(mx, fmaxf(fmaxf(s[u][T][0], s[u][T][1]), fmaxf(s[u][T][2], s[u][T][3])));
            mx = fmaxf(mx, __shfl_xor(mx, 16)); mx = fmaxf(mx, __shfl_xor(mx, 32));
            float sum = 0.f;
#pragma unroll
            for (int T = 0; T < 16; ++T)
#pragma unroll
                for (int j = 0; j < 4; ++j) { const float e = __builtin_amdgcn_exp2f((s[u][T][j] - mx) * sc); s[u][T][j] = e; sum += e; }
            sum += __shfl_xor(sum, 16); sum += __shfl_xor(sum, 32);
            inv[u] = 1.0f / sum;
#pragma unroll
            for (int t = 0; t < 8; ++t) { pg8::u32x4 w; w.x = pg8::cvt_pk_bf16(s[u][2 * t][0], s[u][2 * t][1]); w.y = pg8::cvt_pk_bf16(s[u][2 * t][2], s[u][2 * t][3]);
                w.z = pg8::cvt_pk_bf16(s[u][2 * t + 1][0], s[u][2 * t + 1][1]); w.w = pg8::cvt_pk_bf16(s[u][2 * t + 1][2], s[u][2 * t + 1][3]); pf[u][t] = __builtin_bit_cast(bf16x8, w); }
        }
        const unsigned trb = (unsigned)(size_t)lds + (unsigned)((4 * g + (li >> 2)) * PITCH + (li & 3) * 8);
#define ATP_VITER(c, WN) do { unsigned bofs = (unsigned)((c) & 1) * CBYTES; asm volatile("" : "+v"(bofs));        \
            { f32x4 o[2][4]; \
              _Pragma("unroll") for (int u = 0; u < 2; ++u) _Pragma("unroll") for (int dt = 0; dt < 4; ++dt) o[u][dt] = (f32x4){0.f, 0.f, 0.f, 0.f}; \
              _Pragma("unroll") for (int t = 0; t < 8; ++t) { s16x4 lo[4], hi[4]; \
                _Pragma("unroll") for (int dt = 0; dt < 4; ++dt) { lo[dt] = tr_read(trb + bofs + (unsigned)(t * 32 * PITCH + dt * 32)); hi[dt] = tr_read(trb + bofs + (unsigned)(t * 32 * PITCH + 16 * PITCH + dt * 32)); } \
                asm volatile("s_waitcnt lgkmcnt(0)" ::: "memory"); __builtin_amdgcn_sched_barrier(0); \
                _Pragma("unroll") for (int dt = 0; dt < 4; ++dt) { const bf16x8 a = (bf16x8){lo[dt][0], lo[dt][1], lo[dt][2], lo[dt][3], hi[dt][0], hi[dt][1], hi[dt][2], hi[dt][3]}; \
                    o[0][dt] = __builtin_amdgcn_mfma_f32_16x16x32_bf16(a, pf[0][t], o[0][dt], 0, 0, 0); \
                    o[1][dt] = __builtin_amdgcn_mfma_f32_16x16x32_bf16(a, pf[1][t], o[1][dt], 0, 0, 0); } } \
              _Pragma("unroll") for (int u = 0; u < 2; ++u) _Pragma("unroll") for (int dt = 0; dt < 4; ++dt) { u32x2 w; w.x = pg8::cvt_pk_bf16(o[u][dt][0] * inv[u], o[u][dt][1] * inv[u]); w.y = pg8::cvt_pk_bf16(o[u][dt][2] * inv[u], o[u][dt][3] * inv[u]); \
                    *(u32x2*)(AO + (size_t)(row0 + wave * 32 + 16 * u + li) * LD + head * HDIM + (c) * CD + dt * 16 + g * 4) = w; } } \
            if ((c) < 7) stage_store_vb(WN, lds + (((c) + 1) & 1) * CBYTES, tid); \
            WG_SYNC(); if ((c) < 5) stage_load_b(WN, ATP_SRC((c) + 11), tid); } while (0)
#pragma unroll 1
        for (int c2 = 0; c2 < 8; c2 += 2) { ATP_VITER(c2, w1); ATP_VITER(c2 + 1, w0); }
#undef ATP_VITER
#undef ATP_SRC
    }
}
}
namespace mx {
typedef att::bf16x8 bf16x8; typedef att::s16x4 s16x4; typedef att::f32x4 f32x4; typedef att::u32x2 u32x2;
constexpr int PT = 272;
constexpr int T64 = 64 * PT, T128 = 128 * PT;
static_assert(C::MHD == 128 && C::CH == 64 && C::MH == 8 && C::LCS == 32, "mLSTM phases are built for these shapes");
__device__ __forceinline__ void lds_wait() { asm volatile("s_waitcnt lgkmcnt(0)" ::: "memory"); __builtin_amdgcn_sched_barrier(0); }
__device__ __forceinline__ bf16x8 mk8(s16x4 lo, s16x4 hi) { return (bf16x8){lo[0], lo[1], lo[2], lo[3], hi[0], hi[1], hi[2], hi[3]}; }
__device__ __forceinline__ unsigned tr_addr(unsigned tile, int krow, int c0, int li) { return tile + (unsigned)((krow + (li >> 2)) * PT + (c0 + 4 * (li & 3)) * 2); }
__device__ __forceinline__ void ch_decode(int ci, int& r0, int& h, int& lc) {
    if (ci < C::NPC) { const int c = ci % C::NC, bh = ci / C::NC; h = bh % C::MH; r0 = (bh / C::MH) * C::SEQ + c * C::CH; lc = C::CH; }
    else { const int q = ci - C::NPC; h = q % C::MH; r0 = C::MP + (q / C::MH) * C::DEC_SEQ; lc = C::LCS; }
}
__device__ __forceinline__ void stage64(LAS unsigned char* tile, const float* src, int ld, int lc, int tid, const LAS float* rs, float mul) {
#pragma unroll
    for (int i = 0; i < 4; ++i) { const int f = tid + 512 * i, row = f >> 5, c4 = f & 31; f32x4 v = (f32x4){0.f, 0.f, 0.f, 0.f};
        if (row < lc) { v = *(const f32x4*)(src + (size_t)row * ld + c4 * 4); const float m = rs ? rs[row] * mul : mul; v = v * m; }
        u32x2 w; w.x = pg8::cvt_pk_bf16(v[0], v[1]); w.y = pg8::cvt_pk_bf16(v[2], v[3]); *(LAS u32x2*)(tile + row * PT + c4 * 8) = w; }
}
__device__ __forceinline__ void ml_phase_a(LAS unsigned char* lds, const Ptrs& p, int l, int tid, int bid, int gsz) {
    const int lane = tid & 63, wave = __builtin_amdgcn_readfirstlane(tid >> 6), li = lane & 15, g = lane >> 4;
    LAS unsigned char* Ks = lds; LAS unsigned char* Vs = lds + T64; LAS float* wts = (LAS float*)(lds + 2 * T64);
    const float* P = wsf<C>(p, C::WS_BIG);
    for (int ci = bid; ci < C::NCH; ci += gsz) {
        int r0, h, lc; ch_decode(ci, r0, h, lc);
        if (wave == 0) {
            float lf = 0.f, ig = -3.0e38f;
            if (lane < lc) { const float* pr = P + (size_t)(r0 + lane) * C::LDP; ig = pr[C::O_IG + h] + p.in[I_IB][l * C::MH + h]; const float fx = pr[C::O_FG + h] + p.in[I_FB][l * C::MH + h]; lf = fx >= 0.f ? -__logf(1.0f + __expf(-fx)) : fx - __logf(1.0f + __expf(fx)); }
            float b = lf;
#pragma unroll
            for (int o = 1; o < 64; o <<= 1) { const float t = __shfl_up(b, o); if (lane >= o) b += t; }
            const float a = lane < lc ? ig - b : -3.0e38f;
            float amax = a;
#pragma unroll
            for (int o = 1; o < 64; o <<= 1) amax = fmaxf(amax, __shfl_xor(amax, o));
            const float bL = __shfl(b, lc - 1), mloc = bL + amax;
            const float wt = lane < lc ? __expf(bL + a - mloc) : 0.f;
            wts[lane] = wt;
            if (lane < lc) { wsf<C>(p, C::WS_GB)[(size_t)(r0 + lane) * C::MH + h] = b; wsf<C>(p, C::WS_GA)[(size_t)(r0 + lane) * C::MH + h] = a; }
            if (lane == 0) { wsf<C>(p, C::WS_CBL)[ci] = bL; wsf<C>(p, C::WS_CML)[ci] = mloc; }
        }
        __syncthreads();
        stage64(Ks, P + (size_t)r0 * C::LDP + C::O_K + h * C::MHD, C::LDP, lc, tid, wts, 0.08838834764831845f);
        stage64(Vs, P + (size_t)r0 * C::LDP + C::O_VM + h * C::MHD, C::LDP, lc, tid, nullptr, 1.0f);
        __syncthreads();
        f32x4 acc[8];
#pragma unroll
        for (int et = 0; et < 8; ++et) acc[et] = (f32x4){0.f, 0.f, 0.f, 0.f};
        const unsigned ks = (unsigned)(size_t)Ks, vs = (unsigned)(size_t)Vs;
#pragma unroll
        for (int t = 0; t < 2; ++t) {
            const s16x4 alo = att::tr_read(tr_addr(ks, 32 * t + 8 * g, 16 * wave, li)), ahi = att::tr_read(tr_addr(ks, 32 * t + 8 * g + 4, 16 * wave, li));
            s16x4 blo[8], bhi[8];
#pragma unroll
            for (int et = 0; et < 8; ++et) { blo[et] = att::tr_read(tr_addr(vs, 32 * t + 8 * g, 16 * et, li)); bhi[et] = att::tr_read(tr_addr(vs, 32 * t + 8 * g + 4, 16 * et, li)); }
            lds_wait();
            const bf16x8 a = mk8(alo, ahi);
#pragma unroll
            for (int et = 0; et < 8; ++et) acc[et] = __builtin_amdgcn_mfma_f32_16x16x32_bf16(a, mk8(blo[et], bhi[et]), acc[et], 0, 0, 0);
        }
        float* DC = wsf<C>(p, C::WS_DC) + (size_t)ci * C::MHD * C::MHD;
#pragma unroll
        for (int et = 0; et < 8; ++et)
#pragma unroll
            for (int r = 0; r < 4; ++r) DC[(size_t)(16 * wave + 4 * g + r) * C::MHD + 16 * et + li] = acc[et][r];
        if (tid < C::MHD) { float s = 0.f; for (int t = 0; t < 64; ++t) s += bf2f(*(const LAS bf16_t*)(Ks + t * PT + tid * 2)); wsf<C>(p, C::WS_DN)[(size_t)ci * C::MHD + tid] = s; }
        __syncthreads();
    }
}
__device__ __forceinline__ void ml_phase_c(LAS unsigned char* lds, const Ptrs& p, int l, int tid, int bid, int gsz) {
    const int lane = tid & 63, wave = __builtin_amdgcn_readfirstlane(tid >> 6), li = lane & 15, g = lane >> 4, it = wave & 3, eh = wave >> 2;
    LAS unsigned char* Qs = lds; LAS unsigned char* Ks = lds + T64; LAS unsigned char* Vs = lds + 2 * T64; LAS unsigned char* Cs = lds + 3 * T64;
    LAS float* sb = (LAS float*)(lds + 3 * T64 + T128);
    LAS float* sa = sb + 64; LAS float* smr = sb + 128; LAS float* siw = sb + 192; LAS float* snp = sb + 256; LAS float* ssq = sb + 384;
    const float* P = wsf<C>(p, C::WS_BIG);
    for (int ci = bid; ci < C::NCH; ci += gsz) {
        int r0, h, lc; ch_decode(ci, r0, h, lc);
        const bool sample = ci >= C::NPC, first = !sample && (ci % C::NC) == 0;
        const float mprev = wsf<C>(p, C::WS_MPREV)[ci];
        if (wave == 0) {
            float b = 0.f, a = -3.0e38f;
            if (lane < lc) { b = wsf<C>(p, C::WS_GB)[(size_t)(r0 + lane) * C::MH + h]; a = wsf<C>(p, C::WS_GA)[(size_t)(r0 + lane) * C::MH + h]; }
            float pm = a;
#pragma unroll
            for (int o = 1; o < 64; o <<= 1) { const float t = __shfl_up(pm, o); if (lane >= o) pm = fmaxf(pm, t); }
            const float mrow = b + fmaxf(mprev, pm);
            sb[lane] = b; sa[lane] = a; smr[lane] = mrow; siw[lane] = __expf(b + mprev - mrow);
        }
        if (tid >= 128 && tid < 256) { const int d = tid - 128;
            snp[d] = sample ? p.in[I_SN][((size_t)l * C::NSC + (ci - C::NPC)) * C::MHD + d] : (first ? 0.f : wsf<C>(p, C::WS_DN)[(size_t)(ci - 1) * C::MHD + d]); }
        stage64(Qs, P + (size_t)r0 * C::LDP + C::O_Q + h * C::MHD, C::LDP, lc, tid, nullptr, 1.0f);
        stage64(Ks, P + (size_t)r0 * C::LDP + C::O_K + h * C::MHD, C::LDP, lc, tid, nullptr, 0.08838834764831845f);
        stage64(Vs, P + (size_t)r0 * C::LDP + C::O_VM + h * C::MHD, C::LDP, lc, tid, nullptr, 1.0f);
        { const float* cp = sample ? p.in[I_SC] + ((size_t)l * C::NSC + (ci - C::NPC)) * C::MHD * C::MHD : wsf<C>(p, C::WS_DC) + (size_t)(first ? ci : ci - 1) * C::MHD * C::MHD;
#pragma unroll
            for (int i = 0; i < 8; ++i) { const int f = tid + 512 * i, row = f >> 5, c4 = f & 31; f32x4 v = (f32x4){0.f, 0.f, 0.f, 0.f};
                if (!first) v = *(const f32x4*)(cp + (size_t)row * C::MHD + c4 * 4);
                u32x2 w; w.x = pg8::cvt_pk_bf16(v[0], v[1]); w.y = pg8::cvt_pk_bf16(v[2], v[3]); *(LAS u32x2*)(Cs + row * PT + c4 * 8) = w; } }
        __syncthreads();
        const bool active = it * 16 < lc;
        float ssq_part = 0.f; f32x4 hv[4]; float inv_den = 0.f;
        const int i = 16 * it + li;
        if (active) {
            bf16x8 qf[4];
#pragma unroll
            for (int ks = 0; ks < 4; ++ks) qf[ks] = *(const LAS bf16x8*)(Qs + i * PT + ks * 64 + g * 16);
            f32x4 st[4];
#pragma unroll
            for (int jt = 0; jt < 4; ++jt) st[jt] = (f32x4){0.f, 0.f, 0.f, 0.f};
#pragma unroll
            for (int jt = 0; jt < 4; ++jt) if (jt <= it) {
#pragma unroll
                for (int ks = 0; ks < 4; ++ks) { const bf16x8 a = *(const LAS bf16x8*)(Ks + (16 * jt + li) * PT + ks * 64 + g * 16);
                    st[jt] = __builtin_amdgcn_mfma_f32_16x16x32_bf16(a, qf[ks], st[jt], 0, 0, 0); } }
            const float bi = sb[i], mri = smr[i], iwi = siw[i];
            float dsum = 0.f;
#pragma unroll
            for (int jt = 0; jt < 4; ++jt)
#pragma unroll
                for (int r = 0; r < 4; ++r) { const int j = 16 * jt + 4 * g + r; const float w = (j <= i) ? __expf(bi + sa[j] - mri) : 0.f; st[jt][r] *= w; dsum += st[jt][r]; }
            dsum += __shfl_xor(dsum, 16); dsum += __shfl_xor(dsum, 32);
            float qn = 0.f;
#pragma unroll
            for (int ks = 0; ks < 4; ++ks)
#pragma unroll
                for (int jj = 0; jj < 8; ++jj) qn += bf2f((bf16_t)qf[ks][jj]) * snp[32 * ks + 8 * g + jj];
            qn += __shfl_xor(qn, 16); qn += __shfl_xor(qn, 32);
            const float den = dsum + iwi * qn;
            inv_den = 1.0f / fmaxf(fabsf(den), __expf(-mri));
            bf16x8 pf[2];
#pragma unroll
            for (int t = 0; t < 2; ++t) { pg8::u32x4 w; w.x = pg8::cvt_pk_bf16(st[2 * t][0], st[2 * t][1]); w.y = pg8::cvt_pk_bf16(st[2 * t][2], st[2 * t][3]);
                w.z = pg8::cvt_pk_bf16(st[2 * t + 1][0], st[2 * t + 1][1]); w.w = pg8::cvt_pk_bf16(st[2 * t + 1][2], st[2 * t + 1][3]); pf[t] = __builtin_bit_cast(bf16x8, w); }
            const unsigned vs = (unsigned)(size_t)Vs, cs = (unsigned)(size_t)Cs;
#pragma unroll
            for (int e4 = 0; e4 < 4; ++e4) { const int et = 4 * eh + e4;
                s16x4 vlo[2], vhi[2], clo[4], chi[4];
#pragma unroll
                for (int t = 0; t < 2; ++t) { vlo[t] = att::tr_read(tr_addr(vs, 32 * t + 4 * g, 16 * et, li)); vhi[t] = att::tr_read(tr_addr(vs, 32 * t + 16 + 4 * g, 16 * et, li)); }
#pragma unroll
                for (int ks = 0; ks < 4; ++ks) { clo[ks] = att::tr_read(tr_addr(cs, 32 * ks + 8 * g, 16 * et, li)); chi[ks] = att::tr_read(tr_addr(cs, 32 * ks + 8 * g + 4, 16 * et, li)); }
                lds_wait();
                f32x4 aS = (f32x4){0.f, 0.f, 0.f, 0.f}, aC = (f32x4){0.f, 0.f, 0.f, 0.f};
#pragma unroll
                for (int t = 0; t < 2; ++t) aS = __builtin_amdgcn_mfma_f32_16x16x32_bf16(mk8(vlo[t], vhi[t]), pf[t], aS, 0, 0, 0);
#pragma unroll
                for (int ks = 0; ks < 4; ++ks) aC = __builtin_amdgcn_mfma_f32_16x16x32_bf16(mk8(clo[ks], chi[ks]), qf[ks], aC, 0, 0, 0);
                hv[e4] = (aS + aC * iwi) * inv_den;
                ssq_part += (hv[e4][0] * hv[e4][0] + hv[e4][1] * hv[e4][1]) + (hv[e4][2] * hv[e4][2] + hv[e4][3] * hv[e4][3]); }
            ssq_part += __shfl_xor(ssq_part, 16); ssq_part += __shfl_xor(ssq_part, 32);
            if (g == 0) ssq[wave * 16 + li] = ssq_part;
        }
        __syncthreads();
        if (active) {
            const float tot = ssq_part + ssq[(wave ^ 4) * 16 + li];
            const float rs = rsqrtf(tot * (1.0f / C::MHD) + 1e-6f);
            const int row = r0 + i;
#pragma unroll
            for (int e4 = 0; e4 < 4; ++e4) { const int e = 16 * (4 * eh + e4) + 4 * g;
                const f32x4 og = *(const f32x4*)(P + (size_t)row * C::LDP + C::O_O + h * C::MHD + e); const f32x4 gn = *(const f32x4*)(p.in[I_NG] + (size_t)l * C::MW + h * C::MHD + e);
                float o4[4];
#pragma unroll
                for (int r = 0; r < 4; ++r) o4[r] = hv[e4][r] * rs * gn[r] * __builtin_amdgcn_rcpf(1.0f + __expf(-og[r]));
                u32x2 w; w.x = pg8::cvt_pk_bf16(o4[0], o4[1]); w.y = pg8::cvt_pk_bf16(o4[2], o4[3]);
                *(u32x2*)(wsb<C>(p, C::WS_MIX) + (size_t)row * C::D + C::PW + C::GW + h * C::MHD + e) = w; }
        }
        __syncthreads();
    }
}
}
namespace rw {
typedef att::f32x4 f32x4; typedef att::u32x2 u32x2;
static_assert(C::D == 2048, "row ops assume 2048 columns = 8 float4 per lane");
__device__ __forceinline__ float wave_sum(float v) {
#pragma unroll
    for (int o = 1; o < 64; o <<= 1) v += __shfl_xor(v, o);
    return v;
}
__device__ __forceinline__ void rows_init(const Ptrs& p, int tid, int bid, int gsz) {
    const int lane = tid & 63, gw = bid * NWAVES + (tid >> 6), NGW = gsz * NWAVES;
    float* SS = wsf<C>(p, C::WS_SS);
    for (int r = gw; r < C::M; r += NGW) {
        const float* src = r < C::MP ? p.in[I_XP] + (size_t)r * C::D : p.in[I_XS] + (size_t)(r - C::MP) * C::D;
        float* X = wsf<C>(p, C::WS_X) + (size_t)r * C::D; bf16_t* XB = wsb<C>(p, C::WS_XB) + (size_t)r * C::D;
        float ss = 0.f;
#pragma unroll
        for (int j = 0; j < 8; ++j) { const f32x4 v = *(const f32x4*)(src + (lane + 64 * j) * 4); *(f32x4*)(X + (lane + 64 * j) * 4) = v;
            u32x2 w; w.x = pg8::cvt_pk_bf16(v[0], v[1]); w.y = pg8::cvt_pk_bf16(v[2], v[3]); *(u32x2*)(XB + (lane + 64 * j) * 4) = w;
            ss += (v[0] * v[0] + v[1] * v[1]) + (v[2] * v[2] + v[3] * v[3]); }
        ss = wave_sum(ss);
        if (lane < C::NSS) SS[(size_t)lane * C::M + r] = lane == 0 ? ss : 0.f;
    }
    for (int r = gw; r < C::MM; r += NGW) {
        const float* src = p.in[I_MEM] + (size_t)r * C::D; bf16_t* MB = wsb<C>(p, C::WS_MEMB) + (size_t)r * C::D;
        float ss = 0.f;
#pragma unroll
        for (int j = 0; j < 8; ++j) { const f32x4 v = *(const f32x4*)(src + (lane + 64 * j) * 4);
            u32x2 w; w.x = pg8::cvt_pk_bf16(v[0], v[1]); w.y = pg8::cvt_pk_bf16(v[2], v[3]); *(u32x2*)(MB + (lane + 64 * j) * 4) = w;
            ss += (v[0] * v[0] + v[1] * v[1]) + (v[2] * v[2] + v[3] * v[3]); }
        ss = wave_sum(ss);
        if (lane == 0) wsf<C>(p, C::WS_RSTDM)[r] = rsqrtf(ss * (1.0f / C::D) + 1e-6f);
    }
}
__device__ __forceinline__ void rows_final(const Ptrs& p, int tid, int bid, int gsz) {
    const int lane = tid & 63, gw = bid * NWAVES + (tid >> 6), NGW = gsz * NWAVES;
    for (int r = gw; r < C::M; r += NGW) {
        const float* X = wsf<C>(p, C::WS_X) + (size_t)r * C::D; const float rs = rsqrtf(wsf<C>(p, C::WS_SS)[(size_t)(C::NSS - 1) * C::M + r] * (1.0f / C::D) + 1e-6f);
        float* o = r < C::MP ? p.out + C::OUT_YP + (size_t)r * C::D : p.out + C::OUT_YS + (size_t)(r - C::MP) * C::D;
        float pscale = 1.0f, padd = 0.f;
#if defined(PROBE_MASK_A)
        { const unsigned long long* TS = (const unsigned long long*)(p.ws + C::WS_CTL + 32768); unsigned long long ta = 0, tb = 0;
          for (int k = 0; k < 25; ++k) { const unsigned long long dk = TS[k + 1] - TS[k]; if ((PROBE_MASK_A >> k) & 1ull) ta += dk; if ((PROBE_MASK_B >> k) & 1ull) tb += dk; }
#if defined(PROBE_MLT)
          ta = TS[48 + PROBE_MLT];
#endif
#if defined(PROBE_GST)
          { const unsigned long long* st = (const unsigned long long*)(p.ws + C::WS_END); unsigned long long epi = 0; for (int u2 = 0; u2 < 8; ++u2) epi += st[3 + 2 * u2] - st[2 + 2 * u2];
            const unsigned long long tot = st[18] - st[0], fill = st[1] - st[0];
            ta = (unsigned long long)(1.0e6 * (double)(PROBE_GST == 1 ? epi : fill) / (double)tot); }
#endif
#if defined(PROBE_MLC)
          ta = TS[48 + PROBE_MLC];
#endif
#if defined(PROBE_ATT)
          ta = 0; for (int l2 = 0; l2 < 2; ++l2) { const int k = 1 + 12 * l2 + 8; ta += (PROBE_ATT == 1) ? TS[44 + l2] - TS[k] : TS[k + 1] - TS[44 + l2]; }
#endif
#if defined(PROBE_SCN)
          ta = 0; for (int l2 = 0; l2 < 2; ++l2) { const int k = 1 + 12 * l2 + 4; ta += (PROBE_SCN == 1) ? TS[44 + l2] - TS[k] : TS[k + 1] - TS[44 + l2]; }
#endif
#if defined(PROBE_MIXA)
          ta = 0; for (int l2 = 0; l2 < 2; ++l2) { const int k = 1 + 12 * l2 + 3; ta += (PROBE_MIXA == 1) ? TS[40 + l2] - TS[k] : (PROBE_MIXA == 2) ? TS[42 + l2] - TS[40 + l2] : TS[k + 1] - TS[42 + l2]; }
#endif
#if defined(PROBE_SPLIT_MODE)
          ta = 0; for (int l2 = 0; l2 < 2; ++l2) { const int k = 1 + 10 * l2 + 3; ta += (PROBE_SPLIT_MODE == 1) ? TS[40 + l2] - TS[k] : TS[k + 1] - TS[40 + l2]; }
#endif
          if (r >= C::MP) pscale = 1.0f + 0.03f + (float)ta * 0.01f * PROBE_SA;
          if (r == 0 && lane == 0) padd = 1.0f + (float)tb * 0.01f * PROBE_SB; }
#endif
#pragma unroll
        for (int j = 0; j < 8; ++j) { const f32x4 v = *(const f32x4*)(X + (lane + 64 * j) * 4); const f32x4 gg = *(const f32x4*)(p.in[I_GFIN] + (lane + 64 * j) * 4);
            f32x4 y = v * rs * gg * pscale; if (j == 0) y[0] += padd; *(f32x4*)(o + (lane + 64 * j) * 4) = y; }
    }
}
__device__ __forceinline__ void ml_scan(const Ptrs& p, int l, long gtid, long gthreads) {
    const float* CBL = wsf<C>(p, C::WS_CBL); const float* CML = wsf<C>(p, C::WS_CML);
    float* DC = wsf<C>(p, C::WS_DC); float* DN = wsf<C>(p, C::WS_DN);
    constexpr int NPS = C::BATCH * C::MH, E4 = C::MHD / 4;
    for (long it = gtid; it < (long)NPS * C::MHD * E4; it += gthreads) {
        const int e4 = (int)(it % E4), d = (int)((it / E4) % C::MHD), sq = (int)(it / ((long)E4 * C::MHD));
        float m = 0.f; f32x4 cst = (f32x4){0.f, 0.f, 0.f, 0.f};
        static_assert(C::NC % 8 == 0, "scan is unrolled by 8 chunks");
        for (int c0 = 0; c0 < C::NC; c0 += 8) {
            f32x4 v[8]; float bl[8], ml[8];
#pragma unroll
            for (int j = 0; j < 8; ++j) { const int ci = sq * C::NC + c0 + j; v[j] = *(const f32x4*)(DC + ((size_t)ci * C::MHD + d) * C::MHD + e4 * 4); bl[j] = CBL[ci]; ml[j] = CML[ci]; }
#pragma unroll
            for (int j = 0; j < 8; ++j) { const int ci = sq * C::NC + c0 + j; const float a = bl[j] + m, mn = fmaxf(a, ml[j]), dec = __expf(a - mn), f = __expf(ml[j] - mn);
                cst = cst * dec + v[j] * f; *(f32x4*)(DC + ((size_t)ci * C::MHD + d) * C::MHD + e4 * 4) = cst; m = mn; }
        }
        *(f32x4*)(p.out + C::OUT_CP + (((size_t)l * NPS + sq) * C::MHD + d) * C::MHD + e4 * 4) = cst;
    }
    for (long it = gtid; it < (long)NPS * C::MHD; it += gthreads) {
        const int d = (int)(it % C::MHD), sq = (int)(it / C::MHD);
        float m = 0.f, nst = 0.f;
        for (int c = 0; c < C::NC; ++c) { const int ci = sq * C::NC + c; const float a = CBL[ci] + m, b2 = CML[ci], mn = fmaxf(a, b2), dec = __expf(a - mn), f = __expf(b2 - mn);
            const size_t on = (size_t)ci * C::MHD + d; nst = dec * nst + f * DN[on]; DN[on] = nst; m = mn; }
        p.out[C::OUT_NP + ((size_t)l * NPS + sq) * C::MHD + d] = nst;
    }
    for (long it = gtid; it < (long)C::NSC * C::MHD * E4; it += gthreads) {
        const int e4 = (int)(it % E4), d = (int)((it / E4) % C::MHD), q = (int)(it / ((long)E4 * C::MHD)), ci = C::NPC + q;
        const float m0 = p.in[I_SM][(size_t)l * C::NSC + q], a = CBL[ci] + m0, b2 = CML[ci], mn = fmaxf(a, b2), dec = __expf(a - mn), f = __expf(b2 - mn);
        const size_t so = (((size_t)l * C::NSC + q) * C::MHD + d) * C::MHD + e4 * 4;
        *(f32x4*)(p.out + C::OUT_CS + so) = *(const f32x4*)(p.in[I_SC] + so) * dec + *(const f32x4*)(DC + ((size_t)ci * C::MHD + d) * C::MHD + e4 * 4) * f;
    }
    for (long it = gtid; it < (long)C::NSC * C::MHD; it += gthreads) {
        const int d = (int)(it % C::MHD), q = (int)(it / C::MHD), ci = C::NPC + q;
        const float m0 = p.in[I_SM][(size_t)l * C::NSC + q], a = CBL[ci] + m0, b2 = CML[ci], mn = fmaxf(a, b2), dec = __expf(a - mn), f = __expf(b2 - mn);
        const size_t no = ((size_t)l * C::NSC + q) * C::MHD + d;
        p.out[C::OUT_NS + no] = dec * p.in[I_SN][no] + f * DN[(size_t)ci * C::MHD + d];
    }
}
}

namespace gp {
typedef att::bf16x8 bf16x8; typedef att::s16x4 s16x4; typedef att::f32x4 f32x4; typedef att::u32x2 u32x2;
constexpr int PT = mx::PT, T128 = mx::T128;
static_assert(C::GHD == 128 && C::PGD == 128 && C::GCH == 128 && C::SEQ % 128 == 0 && C::DEC_SEQ == 32 && C::PH == 15, "gmlp / pool phases are built for these shapes");
constexpr int NT_P = C::MP / 128;
constexpr int NU_G = NT_P * 4 + C::DEC_BATCH * 4;
__device__ __forceinline__ void gmlp_phase(LAS unsigned char* lds, const Ptrs& p, int l, int tid, int bid, int gsz) {
    const int lane = tid & 63, wave = __builtin_amdgcn_readfirstlane(tid >> 6), li = lane & 15, g = lane >> 4;
    LAS unsigned char* Vs = lds; LAS unsigned char* Ws = lds + T128;
    const float* P = wsf<C>(p, C::WS_BIG);
    for (int u = bid; u < NU_G; u += gsz) {
        int r0, lc, h; bool sample = false; int sb = 0;
        if (u < NT_P * 4) { h = u & 3; r0 = (u >> 2) * 128; lc = 128; } else { const int s = u - NT_P * 4; h = s & 3; sb = s >> 2; r0 = C::MP + sb * C::DEC_SEQ; lc = C::DEC_SEQ; sample = true; }
#pragma unroll
        for (int i = 0; i < 8; ++i) { const int f = tid + 512 * i, row = f >> 5, c4 = f & 31; f32x4 v = (f32x4){0.f, 0.f, 0.f, 0.f};
            if (row < lc) v = *(const f32x4*)(P + (size_t)(r0 + row) * C::LDP + C::O_V + h * 128 + c4 * 4);
            float ss = (v[0] * v[0] + v[1] * v[1]) + (v[2] * v[2] + v[3] * v[3]);
#pragma unroll
            for (int o = 1; o < 32; o <<= 1) ss += __shfl_xor(ss, o);
            const float rs = rsqrtf(ss * (1.0f / 128) + 1e-6f); const f32x4 gn = *(const f32x4*)(p.in[I_GVG] + (size_t)l * C::GW + h * 128 + c4 * 4);
            v = v * rs * gn;
            if (sample && row < lc) *(f32x4*)(p.out + C::OUT_VS + (((size_t)l * C::DEC_BATCH + sb) * C::DEC_SEQ + row) * C::GW + h * 128 + c4 * 4) = v;
            u32x2 w; w.x = pg8::cvt_pk_bf16(v[0], v[1]); w.y = pg8::cvt_pk_bf16(v[2], v[3]); *(LAS u32x2*)(Vs + row * PT + c4 * 8) = w; }
        const float* wsrc = p.in[I_GWS] + ((size_t)l * C::GH + h) * 128 * 128;
#pragma unroll
        for (int i = 0; i < 8; ++i) { const int f = tid + 512 * i, row = f >> 5, c4 = f & 31; f32x4 v = *(const f32x4*)(wsrc + (size_t)row * 128 + c4 * 4);
#pragma unroll
            for (int j = 0; j < 4; ++j) if (c4 * 4 + j > row) v[j] = 0.f;
            u32x2 w; w.x = pg8::cvt_pk_bf16(v[0], v[1]); w.y = pg8::cvt_pk_bf16(v[2], v[3]); *(LAS u32x2*)(Ws + row * PT + c4 * 8) = w; }
        WG_SYNC();
        if (wave * 16 < lc) {
            const int i = wave * 16 + li, nks = (wave * 16 + 15) / 32 + 1;
            f32x4 acc[8];
#pragma unroll
            for (int dt = 0; dt < 8; ++dt) acc[dt] = (f32x4){0.f, 0.f, 0.f, 0.f};
            const unsigned vs = (unsigned)(size_t)Vs;
            for (int ks = 0; ks < nks; ++ks) {
                const bf16x8 bq = *(const LAS bf16x8*)(Ws + i * PT + ks * 64 + g * 16);
                s16x4 lo[8], hi[8];
#pragma unroll
                for (int dt = 0; dt < 8; ++dt) { lo[dt] = att::tr_read(mx::tr_addr(vs, 32 * ks + 8 * g, 16 * dt, li)); hi[dt] = att::tr_read(mx::tr_addr(vs, 32 * ks + 8 * g + 4, 16 * dt, li)); }
                mx::lds_wait();
#pragma unroll
                for (int dt = 0; dt < 8; ++dt) acc[dt] = __builtin_amdgcn_mfma_f32_16x16x32_bf16(mx::mk8(lo[dt], hi[dt]), bq, acc[dt], 0, 0, 0);
            }
            const float bsi = p.in[I_GBS][((size_t)l * C::GH + h) * C::GCH + i];
            const int row = r0 + i;
#pragma unroll
            for (int dt = 0; dt < 8; ++dt) { const int d = 16 * dt + 4 * g; const f32x4 uu = *(const f32x4*)(P + (size_t)row * C::LDP + C::O_U + h * 128 + d);
                u32x2 w; w.x = pg8::cvt_pk_bf16(uu[0] * (acc[dt][0] + bsi), uu[1] * (acc[dt][1] + bsi)); w.y = pg8::cvt_pk_bf16(uu[2] * (acc[dt][2] + bsi), uu[3] * (acc[dt][3] + bsi));
                *(u32x2*)(wsb<C>(p, C::WS_MIX) + (size_t)row * C::D + C::PW + h * 128 + d) = w; }
        }
        WG_SYNC();
    }
}
__device__ __forceinline__ void pool_phase(LAS unsigned char* lds, const Ptrs& p, int l, int tid, int bid, int gsz) {
    const int lane = tid & 63, wave = __builtin_amdgcn_readfirstlane(tid >> 6), li = lane & 15, g = lane >> 4;
    LAS unsigned char* Ds = lds; LAS unsigned char* Ws = lds + T128;
    const float* P = wsf<C>(p, C::WS_BIG);
    for (int u = bid; u < NU_G; u += gsz) {
        int r0, lc, grp, t0, L, b; bool sample = false;
        if (u < NT_P * 4) { grp = u & 3; r0 = (u >> 2) * 128; lc = 128; b = r0 / C::SEQ; t0 = r0 % C::SEQ; L = C::SEQ; } else { const int s = u - NT_P * 4; grp = s & 3; b = s >> 2; r0 = C::MP + b * C::DEC_SEQ; lc = C::DEC_SEQ; t0 = 0; L = C::DEC_SEQ; sample = true; }
        const int w = 2 << grp;
        { const int c4 = tid & 31, sg = tid >> 5, ch = grp * 128 + c4 * 4;
            const float* hist = p.in[I_SPOOL] + ((size_t)l * C::DEC_BATCH + b) * C::PH * C::PW + ch;
            auto xat = [&](int t) -> f32x4 {
                if (t >= 0) return *(const f32x4*)(P + (size_t)(r0 - t0 + t) * C::LDP + ch);
                if (sample && C::PH + t >= 0) return *(const f32x4*)(hist + (size_t)(C::PH + t) * C::PW);
                return (f32x4){0.f, 0.f, 0.f, 0.f}; };
            if (sg * 8 < lc) {
                const int ts = t0 + sg * 8;
                f32x4 sum = (f32x4){0.f, 0.f, 0.f, 0.f};
                for (int j = 1; j < w; ++j) sum = sum + xat(ts - j);
#pragma unroll
                for (int k = 0; k < 8; ++k) { const int t = ts + k; const f32x4 x = xat(t); sum = sum + x;
                    const int pos = (sample ? C::PAST : 0) + t; const float inv = 1.0f / (float)((pos + 1) < w ? (pos + 1) : w);
                    const f32x4 dv = sum * inv - x;
                    u32x2 ww; ww.x = pg8::cvt_pk_bf16(dv[0], dv[1]); ww.y = pg8::cvt_pk_bf16(dv[2], dv[3]); *(LAS u32x2*)(Ds + (sg * 8 + k) * PT + c4 * 8) = ww;
                    sum = sum - xat(t - w + 1);
                    const int idx = t - (L - C::PH);
                    if (idx >= 0) *(f32x4*)(p.out + (sample ? C::OUT_POOLS + (((size_t)l * C::DEC_BATCH + b) * C::PH + idx) * C::PW : C::OUT_POOLP + (((size_t)l * C::BATCH + b) * C::PH + idx) * C::PW) + ch) = x; }
            } else {
#pragma unroll
                for (int k = 0; k < 8; ++k) *(LAS u32x2*)(Ds + (sg * 8 + k) * PT + c4 * 8) = (u32x2){0u, 0u};
            }
        }
        const float* wsrc = p.in[I_POOLW] + ((size_t)l * C::PG + grp) * 128 * 128;
#pragma unroll
        for (int i = 0; i < 8; ++i) { const int f = tid + 512 * i, row = f >> 5, c4 = f & 31; const f32x4 v = *(const f32x4*)(wsrc + (size_t)row * 128 + c4 * 4);
            u32x2 ww; ww.x = pg8::cvt_pk_bf16(v[0], v[1]); ww.y = pg8::cvt_pk_bf16(v[2], v[3]); *(LAS u32x2*)(Ws + row * PT + c4 * 8) = ww; }
        WG_SYNC();
        if (wave * 16 < lc) {
            const int t = wave * 16 + li;
            f32x4 acc[8];
#pragma unroll
            for (int et = 0; et < 8; ++et) acc[et] = (f32x4){0.f, 0.f, 0.f, 0.f};
            const unsigned wsa = (unsigned)(size_t)Ws;
#pragma unroll
            for (int ks = 0; ks < 4; ++ks) {
                const bf16x8 bq = *(const LAS bf16x8*)(Ds + t * PT + ks * 64 + g * 16);
                s16x4 lo[8], hi[8];
#pragma unroll
                for (int et = 0; et < 8; ++et) { lo[et] = att::tr_read(mx::tr_addr(wsa, 32 * ks + 8 * g, 16 * et, li)); hi[et] = att::tr_read(mx::tr_addr(wsa, 32 * ks + 8 * g + 4, 16 * et, li)); }
                mx::lds_wait();
#pragma unroll
                for (int et = 0; et < 8; ++et) acc[et] = __builtin_amdgcn_mfma_f32_16x16x32_bf16(mx::mk8(lo[et], hi[et]), bq, acc[et], 0, 0, 0);
            }
            const int row = r0 + t;
#pragma unroll
            for (int et = 0; et < 8; ++et) { const int e = 16 * et + 4 * g; const f32x4 sc = *(const f32x4*)(p.in[I_POOLS] + (size_t)l * C::PW + grp * 128 + e);
                u32x2 ww; ww.x = pg8::cvt_pk_bf16(acc[et][0] * sc[0], acc[et][1] * sc[1]); ww.y = pg8::cvt_pk_bf16(acc[et][2] * sc[2], acc[et][3] * sc[3]);
                *(u32x2*)(wsb<C>(p, C::WS_MIX) + (size_t)row * C::D + grp * 128 + e) = ww; }
        }
        WG_SYNC();
    }
}
}
namespace mp {
typedef att::bf16x8 bf16x8; typedef att::s16x4 s16x4; typedef att::f32x4 f32x4; typedef att::u32x2 u32x2; typedef pg8::u32x4 u32x4;
constexpr int PT = mx::PT, T64 = mx::T64, T128 = mx::T128, MAXU = 8;
#define MP_TR(dst, base, OFF) asm volatile("ds_read_b64_tr_b16 %0, %1 offset:%2" : "=&v"(dst) : "v"(base), "i"(OFF) : "memory")
__device__ __forceinline__ void ml_a(LAS unsigned char* lds, const Ptrs& p, int l, int tid, int bid, int gsz) {
    const int lane = tid & 63, wave = __builtin_amdgcn_readfirstlane(tid >> 6), li = lane & 15, g = lane >> 4;
    LAS unsigned char* Ks = lds; LAS unsigned char* Vs = lds + T64; LAS float* wts = (LAS float*)(lds + 2 * T64);
    const float* P = wsf<C>(p, C::WS_BIG);
    const int nu = bid < C::NCH ? (C::NCH - 1 - bid) / gsz + 1 : 0;
    if (wave < nu) { const int ci = bid + wave * gsz; int r0, h, lc; mx::ch_decode(ci, r0, h, lc);
        float lf = 0.f, ig = -3.0e38f;
        if (lane < lc) { const float* pr = P + (size_t)(r0 + lane) * C::LDP; ig = pr[C::O_IG + h] + p.in[I_IB][l * C::MH + h]; const float fx = pr[C::O_FG + h] + p.in[I_FB][l * C::MH + h];
            lf = fx >= 0.f ? -__logf(1.0f + __expf(-fx)) : fx - __logf(1.0f + __expf(fx)); }
        float b = lf;
#pragma unroll
        for (int o = 1; o < 64; o <<= 1) { const float t = __shfl_up(b, o); if (lane >= o) b += t; }
        const float a = lane < lc ? ig - b : -3.0e38f;
        float amax = a;
#pragma unroll
        for (int o = 1; o < 64; o <<= 1) amax = fmaxf(amax, __shfl_xor(amax, o));
        const float bL = __shfl(b, lc - 1), mloc = bL + amax;
        wts[wave * 64 + lane] = lane < lc ? __expf(bL + a - mloc) : 0.f;
        if (lane < lc) { wsf<C>(p, C::WS_GB)[(size_t)(r0 + lane) * C::MH + h] = b; wsf<C>(p, C::WS_GA)[(size_t)(r0 + lane) * C::MH + h] = a; }
        if (lane == 0) { wsf<C>(p, C::WS_CBL)[ci] = bL; wsf<C>(p, C::WS_CML)[ci] = mloc; } }
    const unsigned lofs8 = (unsigned)((8 * g + (li >> 2)) * PT + 8 * (li & 3));
    const unsigned kw8 = (unsigned)(size_t)Ks + lofs8 + (unsigned)(32 * wave), vs8 = (unsigned)(size_t)Vs + lofs8;
    f32x4 pk[4], pv[4];
    auto window = [&](int ci) { int r0, h, lc; mx::ch_decode(ci, r0, h, lc); const float* src = P + (size_t)r0 * C::LDP + h * C::MHD;
#pragma unroll
        for (int q = 0; q < 4; ++q) { const int f = tid + 512 * q, row = f >> 5, c4 = f & 31;
            if (row < lc) { pk[q] = *(const f32x4*)(src + (size_t)row * C::LDP + C::O_K + c4 * 4); pv[q] = *(const f32x4*)(src + (size_t)row * C::LDP + C::O_VM + c4 * 4); }
            else { pk[q] = (f32x4){0.f, 0.f, 0.f, 0.f}; pv[q] = pk[q]; } }
        __builtin_amdgcn_sched_barrier(0); };
    if (nu > 0) window(bid);
    WG_SYNC();
    for (int j = 0; j < nu; ++j) { const int ci = bid + j * gsz;
#pragma unroll
        for (int q = 0; q < 4; ++q) { const int f = tid + 512 * q, row = f >> 5, c4 = f & 31; const float sw = 0.08838834764831845f * wts[j * 64 + row];
            u32x2 w; w.x = pg8::cvt_pk_bf16(pk[q][0] * sw, pk[q][1] * sw); w.y = pg8::cvt_pk_bf16(pk[q][2] * sw, pk[q][3] * sw); *(LAS u32x2*)(Ks + row * PT + c4 * 8) = w;
            w.x = pg8::cvt_pk_bf16(pv[q][0], pv[q][1]); w.y = pg8::cvt_pk_bf16(pv[q][2], pv[q][3]); *(LAS u32x2*)(Vs + row * PT + c4 * 8) = w; }
        if (j + 1 < nu) window(ci + gsz);
        WG_SYNC();
        f32x4 acc[8], accn = (f32x4){0.f, 0.f, 0.f, 0.f};
#pragma unroll
        for (int et = 0; et < 8; ++et) acc[et] = (f32x4){0.f, 0.f, 0.f, 0.f};
        const bf16x8 ones = (bf16x8){0x3F80, 0x3F80, 0x3F80, 0x3F80, 0x3F80, 0x3F80, 0x3F80, 0x3F80};
#pragma unroll
        for (int t = 0; t < 2; ++t) {
            s16x4 alo, ahi, blo[8], bhi[8]; MP_TR(alo, kw8, (32 * t) * PT); MP_TR(ahi, kw8, (32 * t + 4) * PT);
#pragma unroll
            for (int et = 0; et < 8; ++et) { MP_TR(blo[et], vs8, (32 * t) * PT + 32 * et); MP_TR(bhi[et], vs8, (32 * t + 4) * PT + 32 * et); }
            mx::lds_wait();
            const bf16x8 a = mx::mk8(alo, ahi);
#pragma unroll
            for (int et = 0; et < 8; ++et) acc[et] = __builtin_amdgcn_mfma_f32_16x16x32_bf16(mx::mk8(blo[et], bhi[et]), a, acc[et], 0, 0, 0);
            accn = __builtin_amdgcn_mfma_f32_16x16x32_bf16(ones, a, accn, 0, 0, 0);
        }
        float* DC = wsf<C>(p, C::WS_DC) + (size_t)ci * C::MHD * C::MHD + (size_t)(16 * wave + li) * C::MHD + 4 * g;
#pragma unroll
        for (int et = 0; et < 8; ++et) *(f32x4*)(DC + 16 * et) = acc[et];
        if (g == 0) wsf<C>(p, C::WS_DN)[(size_t)ci * C::MHD + 16 * wave + li] = accn[0];
        WG_SYNC();
    }
}
__device__ __forceinline__ void ml_scan(const Ptrs& p, int l, long gtid, long gthreads) {
    const float* CBL = wsf<C>(p, C::WS_CBL); const float* CML = wsf<C>(p, C::WS_CML); const float* DC = wsf<C>(p, C::WS_DC); float* DN = wsf<C>(p, C::WS_DN);
    bf16_t* DCB = wsb<C>(p, C::WS_DCB); float* MPREV = wsf<C>(p, C::WS_MPREV);
    constexpr int NPS = C::BATCH * C::MH, E4 = C::MHD / 4;
    static_assert(C::NC % 8 == 0, "scan is unrolled by 8 chunks");
    for (long it = gtid; it < (long)NPS * C::MHD * E4; it += gthreads) {
        const int e4 = (int)(it % E4), d = (int)((it / E4) % C::MHD), sq = (int)(it / ((long)E4 * C::MHD));
        float m = 0.f, nst = 0.f; f32x4 cst = (f32x4){0.f, 0.f, 0.f, 0.f};
        for (int c0 = 0; c0 < C::NC; c0 += 8) {
            f32x4 v[8]; float bl[8], ml[8], dn[8];
#pragma unroll
            for (int j = 0; j < 8; ++j) { const int ci = sq * C::NC + c0 + j; v[j] = *(const f32x4*)(DC + ((size_t)ci * C::MHD + d) * C::MHD + e4 * 4); bl[j] = CBL[ci]; ml[j] = CML[ci];
                dn[j] = (e4 == 0) ? DN[(size_t)ci * C::MHD + d] : 0.f; }
            __builtin_amdgcn_sched_barrier(0);
#pragma unroll
            for (int j = 0; j < 8; ++j) { const int ci = sq * C::NC + c0 + j; const float a = bl[j] + m, mn = fmaxf(a, ml[j]), dec = __expf(a - mn), f = __expf(ml[j] - mn);
                if (d == 0 && e4 == 0) MPREV[ci] = m;
                cst = cst * dec + v[j] * f; u32x2 w; w.x = pg8::cvt_pk_bf16(cst[0], cst[1]); w.y = pg8::cvt_pk_bf16(cst[2], cst[3]);
                *(u32x2*)(DCB + ((size_t)ci * C::MHD + d) * C::MHD + e4 * 4) = w;
                nst = dec * nst + f * dn[j]; if (e4 == 0) DN[(size_t)ci * C::MHD + d] = nst;
                m = mn; }
        }
        *(f32x4*)(p.out + C::OUT_CP + (((size_t)l * NPS + sq) * C::MHD + d) * C::MHD + e4 * 4) = cst;
        if (e4 == 0) p.out[C::OUT_NP + ((size_t)l * NPS + sq) * C::MHD + d] = nst;
        if (d == 0 && e4 == 0) p.out[C::OUT_MP + (size_t)l * NPS + sq] = m;
    }
    for (long it = gtid; it < (long)C::NSC * C::MHD * E4; it += gthreads) {
        const int e4 = (int)(it % E4), d = (int)((it / E4) % C::MHD), q = (int)(it / ((long)E4 * C::MHD)), ci = C::NPC + q;
        const float m0 = p.in[I_SM][(size_t)l * C::NSC + q], a = CBL[ci] + m0, b2 = CML[ci], mn = fmaxf(a, b2), dec = __expf(a - mn), f = __expf(b2 - mn);
        const size_t so = (((size_t)l * C::NSC + q) * C::MHD + d) * C::MHD + e4 * 4; const f32x4 cin = *(const f32x4*)(p.in[I_SC] + so);
        *(f32x4*)(p.out + C::OUT_CS + so) = cin * dec + *(const f32x4*)(DC + ((size_t)ci * C::MHD + d) * C::MHD + e4 * 4) * f;
        u32x2 w; w.x = pg8::cvt_pk_bf16(cin[0], cin[1]); w.y = pg8::cvt_pk_bf16(cin[2], cin[3]); *(u32x2*)(DCB + ((size_t)ci * C::MHD + d) * C::MHD + e4 * 4) = w;
        if (d == 0 && e4 == 0) { MPREV[ci] = m0; p.out[C::OUT_MS + (size_t)l * C::NSC + q] = mn; }
    }
    for (long it = gtid; it < (long)C::NSC * C::MHD; it += gthreads) {
        const int d = (int)(it % C::MHD), q = (int)(it / C::MHD), ci = C::NPC + q;
        const float m0 = p.in[I_SM][(size_t)l * C::NSC + q], a = CBL[ci] + m0, b2 = CML[ci], mn = fmaxf(a, b2), dec = __expf(a - mn), f = __expf(b2 - mn);
        const size_t no = ((size_t)l * C::NSC + q) * C::MHD + d;
        p.out[C::OUT_NS + no] = dec * p.in[I_SN][no] + f * DN[(size_t)ci * C::MHD + d];
    }
}
__device__ __forceinline__ void ml_c(LAS unsigned char* lds, const Ptrs& p, int l, int tid, int bid, int gsz) {
    const int lane = tid & 63, wave = __builtin_amdgcn_readfirstlane(tid >> 6), li = lane & 15, g = lane >> 4, it = wave & 3, eh = wave >> 2;
    LAS unsigned char* Qs = lds; LAS unsigned char* Ks = lds + T64; LAS unsigned char* Vs = lds + 2 * T64; LAS unsigned char* Cs = lds + 3 * T64;
    LAS float* SB = (LAS float*)(lds + 3 * T64 + T128); LAS float* SA = SB + MAXU * 64; LAS float* SMR = SA + MAXU * 64; LAS float* SIW = SMR + MAXU * 64;
    LAS float* snp = SIW + MAXU * 64; LAS float* ssq = snp + 128; LAS float* sgn = ssq + 128;
    const float* P = wsf<C>(p, C::WS_BIG);
    const int nu = bid < C::NCH ? (C::NCH - 1 - bid) / gsz + 1 : 0;
    if (wave < nu) { const int ci = bid + wave * gsz; int r0, h, lc; mx::ch_decode(ci, r0, h, lc); const float mprev = wsf<C>(p, C::WS_MPREV)[ci];
        float b = 0.f, a = -3.0e38f;
        if (lane < lc) { b = wsf<C>(p, C::WS_GB)[(size_t)(r0 + lane) * C::MH + h]; a = wsf<C>(p, C::WS_GA)[(size_t)(r0 + lane) * C::MH + h]; }
        float pm = a;
#pragma unroll
        for (int o = 1; o < 64; o <<= 1) { const float t = __shfl_up(pm, o); if (lane >= o) pm = fmaxf(pm, t); }
        const float mrow = b + fmaxf(mprev, pm);
        SB[wave * 64 + lane] = b; SA[wave * 64 + lane] = a; SMR[wave * 64 + lane] = mrow; SIW[wave * 64 + lane] = __expf(b + mprev - mrow); }
    const unsigned lofs8 = (unsigned)((8 * g + (li >> 2)) * PT + 8 * (li & 3)), lofs4 = (unsigned)((4 * g + (li >> 2)) * PT + 8 * (li & 3));
    const unsigned vs4e = (unsigned)(size_t)Vs + lofs4 + (unsigned)(128 * eh), cb8e = (unsigned)(size_t)Cs + lofs8 + (unsigned)(128 * eh);
    f32x4 pq[4], pk[4], pv[4], og[4]; u32x4 pc[4]; float pn = 0.f, pg = 0.f;
    auto window = [&](int ci) { int r0, h, lc; mx::ch_decode(ci, r0, h, lc); const float* src = P + (size_t)r0 * C::LDP + h * C::MHD;
        const bool sample = ci >= C::NPC, first = !sample && (ci % C::NC) == 0;
#pragma unroll
        for (int q = 0; q < 4; ++q) { const int f = tid + 512 * q, row = f >> 5, c4 = f & 31;
            if (row < lc) { pq[q] = *(const f32x4*)(src + (size_t)row * C::LDP + C::O_Q + c4 * 4); pk[q] = *(const f32x4*)(src + (size_t)row * C::LDP + C::O_K + c4 * 4); pv[q] = *(const f32x4*)(src + (size_t)row * C::LDP + C::O_VM + c4 * 4); }
            else { pq[q] = (f32x4){0.f, 0.f, 0.f, 0.f}; pk[q] = pq[q]; pv[q] = pq[q]; } }
        const bf16_t* cb = wsb<C>(p, C::WS_DCB) + (size_t)(sample ? ci : (first ? ci : ci - 1)) * C::MHD * C::MHD;
#pragma unroll
        for (int q = 0; q < 4; ++q) { const int f = tid + 512 * q; pc[q] = first ? (u32x4){0u, 0u, 0u, 0u} : *(const u32x4*)(cb + (size_t)f * 8); }
        const int i = 16 * it + li;
#pragma unroll
        for (int e4 = 0; e4 < 4; ++e4) og[e4] = (it * 16 < lc) ? *(const f32x4*)(src + (size_t)i * C::LDP + C::O_O + 16 * (4 * eh + e4) + 4 * g) : (f32x4){0.f, 0.f, 0.f, 0.f};
        if (tid < C::MHD) { pn = sample ? p.in[I_SN][((size_t)l * C::NSC + (ci - C::NPC)) * C::MHD + tid] : (first ? 0.f : wsf<C>(p, C::WS_DN)[(size_t)(ci - 1) * C::MHD + tid]);
            pg = p.in[I_NG][(size_t)l * C::MW + h * C::MHD + tid]; }
        __builtin_amdgcn_sched_barrier(0); };
    if (nu > 0) window(bid);
    WG_SYNC();
#if defined(PROBE_MLC)
    unsigned long long tacc[4] = {0, 0, 0, 0}; unsigned long long tprev = wall_clock64();
#define MLC_T(j) do { const unsigned long long tn_ = wall_clock64(); tacc[j] += tn_ - tprev; tprev = tn_; } while (0)
#else
#define MLC_T(j) do { } while (0)
#endif
    for (int j = 0; j < nu; ++j) { const int ci = bid + j * gsz; int r0, h, lc; mx::ch_decode(ci, r0, h, lc);
        const LAS float* sb = SB + j * 64; const LAS float* sa = SA + j * 64; const LAS float* smr = SMR + j * 64; const LAS float* siw = SIW + j * 64;
#pragma unroll
        for (int q = 0; q < 4; ++q) { const int f = tid + 512 * q, row = f >> 5, c4 = f & 31; const float sc = 0.08838834764831845f;
            u32x2 w; w.x = pg8::cvt_pk_bf16(pq[q][0], pq[q][1]); w.y = pg8::cvt_pk_bf16(pq[q][2], pq[q][3]); *(LAS u32x2*)(Qs + row * PT + c4 * 8) = w;
            w.x = pg8::cvt_pk_bf16(pk[q][0] * sc, pk[q][1] * sc); w.y = pg8::cvt_pk_bf16(pk[q][2] * sc, pk[q][3] * sc); *(LAS u32x2*)(Ks + row * PT + c4 * 8) = w;
            w.x = pg8::cvt_pk_bf16(pv[q][0], pv[q][1]); w.y = pg8::cvt_pk_bf16(pv[q][2], pv[q][3]); *(LAS u32x2*)(Vs + row * PT + c4 * 8) = w;
            *(LAS u32x4*)(Cs + (f >> 4) * PT + (f & 15) * 16) = pc[q]; }
        if (tid < C::MHD) { snp[tid] = pn; sgn[tid] = pg; }
        f32x4 ogc[4];
#pragma unroll
        for (int e4 = 0; e4 < 4; ++e4) ogc[e4] = og[e4];
        if (j + 1 < nu) window(ci + gsz);
        WG_SYNC(); MLC_T(0);
        const bool active = it * 16 < lc; const int i = 16 * it + li;
        float ssq_part = 0.f; f32x4 hv[4];
        if (active) {
            bf16x8 qf[4];
#pragma unroll
            for (int ks = 0; ks < 4; ++ks) qf[ks] = *(const LAS bf16x8*)(Qs + i * PT + ks * 64 + g * 16);
            f32x4 st[4];
#pragma unroll
            for (int jt = 0; jt < 4; ++jt) st[jt] = (f32x4){0.f, 0.f, 0.f, 0.f};
#pragma unroll
            for (int jt = 0; jt < 4; ++jt) if (jt <= it) {
#pragma unroll
                for (int ks = 0; ks < 4; ++ks) { const bf16x8 a = *(const LAS bf16x8*)(Ks + (16 * jt + li) * PT + ks * 64 + g * 16);
                    st[jt] = __builtin_amdgcn_mfma_f32_16x16x32_bf16(a, qf[ks], st[jt], 0, 0, 0); } }
            const float bi = sb[i], mri = smr[i], iwi = siw[i];
            float dsum = 0.f;
#pragma unroll
            for (int jt = 0; jt < 4; ++jt)
#pragma unroll
                for (int r = 0; r < 4; ++r) { const int jj = 16 * jt + 4 * g + r; const float w = (jj <= i) ? __expf(bi + sa[jj] - mri) : 0.f; st[jt][r] *= w; dsum += st[jt][r]; }
            dsum += __shfl_xor(dsum, 16); dsum += __shfl_xor(dsum, 32);
            float qn = 0.f;
#pragma unroll
            for (int ks = 0; ks < 4; ++ks)
#pragma unroll
                for (int jj = 0; jj < 8; ++jj) qn += bf2f((bf16_t)qf[ks][jj]) * snp[32 * ks + 8 * g + jj];
            qn += __shfl_xor(qn, 16); qn += __shfl_xor(qn, 32);
            const float den = dsum + iwi * qn, inv_den = 1.0f / fmaxf(fabsf(den), __expf(-mri));
            bf16x8 pf[2];
#pragma unroll
            for (int t = 0; t < 2; ++t) { u32x4 w; w.x = pg8::cvt_pk_bf16(st[2 * t][0], st[2 * t][1]); w.y = pg8::cvt_pk_bf16(st[2 * t][2], st[2 * t][3]);
                w.z = pg8::cvt_pk_bf16(st[2 * t + 1][0], st[2 * t + 1][1]); w.w = pg8::cvt_pk_bf16(st[2 * t + 1][2], st[2 * t + 1][3]); pf[t] = __builtin_bit_cast(bf16x8, w); }
#pragma unroll
            for (int e2 = 0; e2 < 2; ++e2) {
                s16x4 vlo[2][2], vhi[2][2], clo[2][4], chi[2][4];
#pragma unroll
                for (int u = 0; u < 2; ++u) {
#pragma unroll
                    for (int t = 0; t < 2; ++t) { MP_TR(vlo[u][t], vs4e, (32 * t) * PT + 32 * (2 * e2 + u)); MP_TR(vhi[u][t], vs4e, (32 * t + 16) * PT + 32 * (2 * e2 + u)); }
#pragma unroll
                    for (int ks = 0; ks < 4; ++ks) { MP_TR(clo[u][ks], cb8e, (32 * ks) * PT + 32 * (2 * e2 + u)); MP_TR(chi[u][ks], cb8e, (32 * ks + 4) * PT + 32 * (2 * e2 + u)); } }
                mx::lds_wait();
#pragma unroll
                for (int u = 0; u < 2; ++u) { const int e4 = 2 * e2 + u;
                    f32x4 aS = (f32x4){0.f, 0.f, 0.f, 0.f}, aC = (f32x4){0.f, 0.f, 0.f, 0.f};
#pragma unroll
                    for (int t = 0; t < 2; ++t) aS = __builtin_amdgcn_mfma_f32_16x16x32_bf16(mx::mk8(vlo[u][t], vhi[u][t]), pf[t], aS, 0, 0, 0);
#pragma unroll
                    for (int ks = 0; ks < 4; ++ks) aC = __builtin_amdgcn_mfma_f32_16x16x32_bf16(mx::mk8(clo[u][ks], chi[u][ks]), qf[ks], aC, 0, 0, 0);
                    hv[e4] = (aS + aC * iwi) * inv_den;
                    ssq_part += (hv[e4][0] * hv[e4][0] + hv[e4][1] * hv[e4][1]) + (hv[e4][2] * hv[e4][2] + hv[e4][3] * hv[e4][3]); } }
            ssq_part += __shfl_xor(ssq_part, 16); ssq_part += __shfl_xor(ssq_part, 32);
            if (g == 0) ssq[wave * 16 + li] = ssq_part;
        }
        MLC_T(1); WG_SYNC();
        if (active) {
            const float tot = ssq_part + ssq[(wave ^ 4) * 16 + li];
            const float rs = rsqrtf(tot * (1.0f / C::MHD) + 1e-6f);
            const int row = r0 + i;
#pragma unroll
            for (int e4 = 0; e4 < 4; ++e4) { const int e = 16 * (4 * eh + e4) + 4 * g; const f32x4 gn = *(const LAS f32x4*)(sgn + e);
                float o4[4];
#pragma unroll
                for (int r = 0; r < 4; ++r) o4[r] = hv[e4][r] * rs * gn[r] * __builtin_amdgcn_rcpf(1.0f + __expf(-ogc[e4][r]));
                u32x2 w; w.x = pg8::cvt_pk_bf16(o4[0], o4[1]); w.y = pg8::cvt_pk_bf16(o4[2], o4[3]);
                *(u32x2*)(wsb<C>(p, C::WS_MIX) + (size_t)row * C::D + C::PW + C::GW + h * C::MHD + e) = w; }
        }
        MLC_T(2); WG_SYNC(); MLC_T(3);
    }
#if defined(PROBE_MLC)
    if (bid == 0 && tid == 0) { unsigned long long* TS = (unsigned long long*)(p.ws + C::WS_CTL + 32768); for (int j = 0; j < 4; ++j) TS[48 + j] += tacc[j]; }
#endif
}
}
constexpr int PH_PER_LAYER = 12, N_PHASES = 2 + PH_PER_LAYER * C::DEPTH;
struct Args { Ptrs p; int ph_lo, ph_hi; };
__global__ void __launch_bounds__(NTHREADS, 2) fwd(Args a) {
    extern __shared__ __attribute__((aligned(16))) unsigned char lds_raw[];
    LAS unsigned char* lds = (LAS unsigned char*)lds_raw;
    typedef __attribute__((address_space(4))) const Args* KArgs;
    const KArgs ka0 = (KArgs)__builtin_amdgcn_kernarg_segment_ptr();
    const int lo = a.ph_lo, hi = a.ph_hi;
#define IN(k) (lo <= (k) && (k) < hi)
#define BOTH(k) (IN(k) && IN((k) + 1))
#define GRID_BAR(k) do { if (BOTH(k)) { xcd_barrier(bar); } } while (0)
#if defined(__HIP_DEVICE_COMPILE__)
#define LOAD_PTRS KArgs ka = ka0; asm volatile("" : "+s"(ka)); Ptrs p; _Pragma("unroll") for (int i_ = 0; i_ < 33; ++i_) p.in[i_] = ka->p.in[i_]; p.out = ka->p.out; p.ws = ka->p.ws;
#else
#define LOAD_PTRS (void)ka0; const Ptrs p = a.p;
#endif
#define PHASE_ARGS LOAD_PTRS int tid = threadIdx.x; asm volatile("" : "+v"(tid)); int bid = blockIdx.x, gsz = gridDim.x; asm volatile("" : "+s"(bid), "+s"(gsz));     \
    const int lane = tid & 63, wave = __builtin_amdgcn_readfirstlane(tid >> 6); (void)lane; (void)wave; \
    const long gtid = (long)bid * NTHREADS + tid, gthreads = (long)gsz * NTHREADS; (void)gtid; (void)gthreads; \
    float* SS = wsf<C>(p, C::WS_SS); (void)SS; const float invd = 1.0f / C::D; (void)invd;
#if defined(PROBE_MASK_A)
#define STAMP(k) do { if (blockIdx.x == 0 && threadIdx.x == 0) ((unsigned long long*)(a.p.ws + C::WS_CTL + 32768))[k] = wall_clock64(); } while (0)
#else
#define STAMP(k) do { } while (0)
#endif
#define ITEMS(n, call) do { for (long it = gtid; it < (long)(n); it += gthreads) { call; } } while (0)
#define SSL(j) (SS + (size_t)(4 * l + (j)) * C::M)
#define GEMM_ALL(STRIP, EPI, Aop, Bop, Mr, Nc, Kd, ...) do { pg8::Gemm g{Aop, Bop, Mr, Nc, Kd, Kd}; pg8::StaticOrder S; S.init(Mr, Nc, gsz, bid, (STRIP) ? 288 : 256); \
        pg8::EPI E{__VA_ARGS__}; pg8::gemm_phase<pg8::EPI, pg8::StaticOrder, STRIP, false>(lds, g, S, E, nullptr); } while (0)
#if ONE_LAUNCH
    if (threadIdx.x < 4) ((LAS unsigned*)(lds + LDS_CTL))[threadIdx.x] = 0u;
    __syncthreads();
    XcdBarrier bar = xcd_barrier_post((unsigned*)(a.p.ws + C::WS_CTL), (volatile LAS unsigned*)(lds + LDS_CTL));
#else
    XcdBarrier bar; bar.bar = nullptr; bar.x = 0; bar.st = nullptr;
#endif

    if (IN(0)) { PHASE_ARGS STAMP(0);
        const int gw = bid * NWAVES + wave, NGW = gsz * NWAVES;
        for (int l = 0; l < C::DEPTH; ++l)
            for (int idx = 0; idx < 10; ++idx) { const WDesc d = wdesc(p, l, idx); const int nitems = (d.K / 64) * (d.N / 64);
                for (int it = gw; it < nitems; it += NGW) prep_item(d.W, d.K, d.Ncols, d.g, d.kind, d.N, d.dst, lds + wave * 9216, it, lane); }
        rw::rows_init(p, tid, bid, gsz);
        GRID_BAR(0);
    }
    for (int l = 0; l < C::DEPTH; ++l) {
        const int pb = 1 + PH_PER_LAYER * l;
        if (IN(pb + 0)) { PHASE_ARGS STAMP(pb + 0);
#if defined(PROBE_GST)
            if (l == 0) { pg8::Gemm g{wsb<C>(p, C::WS_XB), wlayer<C>(p, l, C::W_1IN), C::M, 2 * C::FF, C::D, C::D}; pg8::StaticOrder S; S.init(C::M, 2 * C::FF, gsz, bid, 288);
                pg8::EpiSwiGLU E{wsb<C>(p, C::WS_BIG), SSL(0), C::FF, invd}; pg8::gemm_phase<pg8::EpiSwiGLU, pg8::StaticOrder, true, true>(lds, g, S, E, (unsigned long long*)(p.ws + C::WS_END) + (size_t)bid * 64); } else
#endif
            GEMM_ALL(true, EpiSwiGLU, wsb<C>(p, C::WS_XB), wlayer<C>(p, l, C::W_1IN), C::M, 2 * C::FF, C::D, wsb<C>(p, C::WS_BIG), SSL(0), C::FF, invd);
            GRID_BAR(pb + 0); }
        if (IN(pb + 1)) { PHASE_ARGS STAMP(pb + 1);
            GEMM_ALL(true, EpiResid, wsb<C>(p, C::WS_BIG), wlayer<C>(p, l, C::W_1OUT), C::M, C::D, C::FF, wsf<C>(p, C::WS_X), wsb<C>(p, C::WS_XB), SSL(1), 0.5f, C::D);
            GRID_BAR(pb + 1); }
        if (IN(pb + 2)) { PHASE_ARGS STAMP(pb + 2);
            GEMM_ALL(true, EpiScaleF32, wsb<C>(p, C::WS_XB), wlayer<C>(p, l, C::W_IN), C::M, C::LDP, C::D, wsf<C>(p, C::WS_BIG), C::LDP, SSL(1), invd);
            GRID_BAR(pb + 2); }
        if (IN(pb + 3)) { PHASE_ARGS STAMP(pb + 3); mp::ml_a(lds, p, l, tid, bid, gsz);
#if defined(PROBE_MIXA)
            xcd_barrier(bar); STAMP(40 + l);
#endif
            gp::gmlp_phase(lds, p, l, tid, gsz - 1 - bid, gsz);
#if defined(PROBE_MIXA)
            xcd_barrier(bar); STAMP(42 + l);
#endif
            GRID_BAR(pb + 3); }
        if (IN(pb + 4)) { PHASE_ARGS STAMP(pb + 4);
            if (bid < 64) {
                pg8::Gemm g{wsb<C>(p, C::WS_MEMB), wlayer<C>(p, l, C::W_KV), C::MM, 2 * C::D, C::D, C::D}; pg8::StaticOrder S; S.init(C::MM, 2 * C::D, 64, bid);
                pg8::EpiMemKV E{p.out + C::OUT_MK + (size_t)l * C::MM * C::D, p.out + C::OUT_MV + (size_t)l * C::MM * C::D, wsf<C>(p, C::WS_RSTDM), C::D, wsb<C>(p, C::WS_KVB), C::MM};
                pg8::gemm_phase<pg8::EpiMemKV, pg8::StaticOrder, false, false>(lds, g, S, E, nullptr);
            } else { mp::ml_scan(p, l, (long)(bid - 64) * NTHREADS + tid, (long)(gsz - 64) * NTHREADS); gp::pool_phase(lds, p, l, tid, gsz - 1 - bid, gsz - 64); }
            GRID_BAR(pb + 4); }
        if (IN(pb + 5)) { PHASE_ARGS STAMP(pb + 5); mp::ml_c(lds, p, l, tid, bid, gsz); GRID_BAR(pb + 5); }
        if (IN(pb + 6)) { PHASE_ARGS STAMP(pb + 6);
            GEMM_ALL(true, EpiResid, wsb<C>(p, C::WS_MIX), wlayer<C>(p, l, C::W_OUT), C::M, C::D, C::D, wsf<C>(p, C::WS_X), wsb<C>(p, C::WS_XB), SSL(2), 1.0f, C::D);
            GRID_BAR(pb + 6); }
        if (IN(pb + 7)) { PHASE_ARGS STAMP(pb + 7);
            GEMM_ALL(true, EpiScaleBf16, wsb<C>(p, C::WS_XB), wlayer<C>(p, l, C::W_Q), C::M, C::D, C::D, wsb<C>(p, C::WS_Q), C::D, SSL(2), invd);
            GRID_BAR(pb + 7); }
        if (IN(pb + 8)) { PHASE_ARGS STAMP(pb + 8);
            if (bid < 128) att::attn_phase(lds, p, l, tid, bid, 128, 128);
            else att::attn_sample_phase(lds, p, l, tid, bid - 128, gsz - 128);
            GRID_BAR(pb + 8); }
        if (IN(pb + 9)) { PHASE_ARGS STAMP(pb + 9);
            GEMM_ALL(true, EpiResid, wsb<C>(p, C::WS_AO), wlayer<C>(p, l, C::W_O), C::M, C::D, C::D, wsf<C>(p, C::WS_X), wsb<C>(p, C::WS_XB), SSL(3), 1.0f, C::D);
            GRID_BAR(pb + 9); }
        if (IN(pb + 10)) { PHASE_ARGS STAMP(pb + 10);
            GEMM_ALL(true, EpiSwiGLU, wsb<C>(p, C::WS_XB), wlayer<C>(p, l, C::W_2IN), C::M, 2 * C::FF, C::D, wsb<C>(p, C::WS_BIG), SSL(3), C::FF, invd);
            GRID_BAR(pb + 10); }
        if (IN(pb + 11)) { PHASE_ARGS STAMP(pb + 11);
            GEMM_ALL(true, EpiResid, wsb<C>(p, C::WS_BIG), wlayer<C>(p, l, C::W_2OUT), C::M, C::D, C::FF, wsf<C>(p, C::WS_X), wsb<C>(p, C::WS_XB), SSL(4), 0.5f, C::D);
            GRID_BAR(pb + 11); }
    }
    if (IN(N_PHASES - 1)) { PHASE_ARGS STAMP(N_PHASES - 1); __syncthreads(); rw::rows_final(p, tid, bid, gsz); }
#undef IN
#undef BOTH
#undef GRID_BAR
#undef ITEMS
#undef PHASE_ARGS
#undef SSL
}

extern "C" void kernel_launch(void* const* d_in, const int* in_sizes, int n_in, void* d_out, int out_size, void* d_ws, size_t ws_size, hipStream_t stream) {
    static int ready = 0;
    if (!ready) {
        if (n_in != 33 || (long)out_size != (long)C::OUT_END || ws_size < (size_t)C::WS_END) { fprintf(stderr, "kernel_launch: unexpected shapes: n_in %d out %d ws %zu (need %zu)\n", n_in, out_size, ws_size, (size_t)C::WS_END); ready = -1; return; }
        if (hipFuncSetAttribute((const void*)fwd, hipFuncAttributeMaxDynamicSharedMemorySize, LDS_BYTES) != hipSuccess) { fprintf(stderr, "kernel_launch: hipFuncSetAttribute failed\n"); ready = -1; return; }
        int dev = 0, cus = 0, per_cu = 0;
        if (hipGetDevice(&dev) != hipSuccess || hipDeviceGetAttribute(&cus, hipDeviceAttributeMultiprocessorCount, dev) != hipSuccess) { fprintf(stderr, "kernel_launch: device query failed\n"); ready = -1; return; }
        if (hipOccupancyMaxActiveBlocksPerMultiprocessor(&per_cu, (const void*)fwd, NTHREADS, LDS_BYTES) != hipSuccess || per_cu < 1) { fprintf(stderr, "kernel_launch: occupancy query reports %d blocks per CU\n", per_cu); (void)hipGetLastError(); per_cu = 1; }
        if (cus != 256) { fprintf(stderr, "kernel_launch: built for a 256-CU device (one resident workgroup per CU), found %d\n", cus); ready = -1; return; }
        ready = cus;
    }
    if (ready < 0) return;
    Args a{};
    for (int i = 0; i < 33; ++i) a.p.in[i] = (const float*)d_in[i];
    a.p.out = (float*)d_out; a.p.ws = (unsigned char*)d_ws;
#if ONE_LAUNCH
    (void)hipMemsetAsync((char*)d_ws + C::WS_CTL, 0, 65536, stream);
    a.ph_lo = 0; a.ph_hi = N_PHASES;
    hipLaunchKernelGGL(fwd, dim3(ready), dim3(NTHREADS), LDS_BYTES, stream, a);
#else
    for (int k = 0; k < N_PHASES; ++k) { a.ph_lo = k; a.ph_hi = k + 1; hipLaunchKernelGGL(fwd, dim3(ready), dim3(NTHREADS), LDS_BYTES, stream, a); }
#endif
}
```

```cpp
#include <hip/hip_runtime.h>
#include <cstdio>
#define ONE_LAUNCH 1

#define HD __host__ __device__
#ifndef HD
#define HD __host__ __device__
#endif
typedef unsigned short bf16_t;
HD inline unsigned f2u(float f) { return __builtin_bit_cast(unsigned, f); }
HD inline float u2f(unsigned u) { return __builtin_bit_cast(float, u); }
HD inline bf16_t f2bf(float f) { unsigned u = f2u(f); u += 0x7FFFu + ((u >> 16) & 1u); return (bf16_t)(u >> 16); }
HD inline float bf2f(bf16_t b) { return u2f(((unsigned)b) << 16); }

struct RC {
    static constexpr int D = 2048, FF = 8192, BATCH = 4, SEQ = 2048, DEPTH = 2, DEC_BATCH = 32, DEC_SEQ = 32, PAST = 2048, NMEM = 256;
};
template <class B> struct CfgT : B {
    using B::D; using B::FF; using B::BATCH; using B::SEQ; using B::DEPTH; using B::DEC_BATCH; using B::DEC_SEQ; using B::PAST; using B::NMEM;
    static constexpr int MP = BATCH * SEQ, MS = DEC_BATCH * DEC_SEQ, M = MP + MS, MM = BATCH * NMEM;
    static constexpr int PW = D / 4, PG = 4, PGD = PW / 4, PH = 15;
    static constexpr int GW = D / 4, GH = 4, GHD = GW / 4, GCH = 128;
    static constexpr int MW = D - PW - GW, MH = 8, MHD = MW / 8, CH = 64;
    static constexpr int INC = PW + 2 * GW + 4 * MW + 2 * MH;
    static constexpr int LDP = ((INC + 255) / 256) * 256;
    static constexpr int AH = 4, AHD = D / 4;
    static constexpr int O_U = PW, O_V = PW + GW, O_Q = PW + 2 * GW, O_K = O_Q + MW, O_VM = O_K + MW, O_O = O_VM + MW, O_IG = O_O + MW, O_FG = O_IG + MH;
    static constexpr int NC = SEQ / CH, NPC = BATCH * MH * NC, NSC = DEC_BATCH * MH, NCH = NPC + NSC;
    static constexpr int LCS = DEC_SEQ < CH ? DEC_SEQ : CH;
    static constexpr int GLP = SEQ < GCH ? SEQ : GCH, GLS = DEC_SEQ < GCH ? DEC_SEQ : GCH;
    static constexpr int NSS = 1 + 4 * DEPTH;
    static constexpr long OUT_YP = 0, OUT_YS = OUT_YP + (long)MP * D, OUT_POOLP = OUT_YS + (long)MS * D, OUT_POOLS = OUT_POOLP + (long)DEPTH * BATCH * PH * PW,
        OUT_CP = OUT_POOLS + (long)DEPTH * DEC_BATCH * PH * PW, OUT_NP = OUT_CP + (long)DEPTH * BATCH * MH * MHD * MHD, OUT_MP = OUT_NP + (long)DEPTH * BATCH * MH * MHD,
        OUT_CS = OUT_MP + (long)DEPTH * BATCH * MH, OUT_NS = OUT_CS + (long)DEPTH * DEC_BATCH * MH * MHD * MHD, OUT_MS = OUT_NS + (long)DEPTH * DEC_BATCH * MH * MHD,
        OUT_VS = OUT_MS + (long)DEPTH * DEC_BATCH * MH, OUT_MK = OUT_VS + (long)DEPTH * DEC_BATCH * DEC_SEQ * GW, OUT_MV = OUT_MK + (long)DEPTH * BATCH * NMEM * D,
        OUT_END = OUT_MV + (long)DEPTH * BATCH * NMEM * D;
    static constexpr size_t al(size_t x) { return (x + 255) & ~(size_t)255; }
    static constexpr size_t WS_CTL = 0, WS_SS = 65536, WS_X = al(WS_SS + (size_t)NSS * M * 4), WS_XB = al(WS_X + (size_t)M * D * 4),
        WS_BIG = al(WS_XB + (size_t)M * D * 2),
        WS_BIG_SZ = ((size_t)M * FF * 2 > (size_t)M * LDP * 4) ? (size_t)M * FF * 2 : (size_t)M * LDP * 4,
        WS_MIX = al(WS_BIG + WS_BIG_SZ), WS_Q = al(WS_MIX + (size_t)M * D * 2), WS_AO = al(WS_Q + (size_t)M * D * 2),
        WS_MEMB = al(WS_AO + (size_t)M * D * 2), WS_RSTDM = al(WS_MEMB + (size_t)MM * D * 2),
        WS_GB = al(WS_RSTDM + (size_t)MM * 4), WS_GA = al(WS_GB + (size_t)M * MH * 4),
        WS_CBL = al(WS_GA + (size_t)M * MH * 4), WS_CML = al(WS_CBL + (size_t)NCH * 4), WS_MPREV = al(WS_CML + (size_t)NCH * 4),
        WS_DC = al(WS_MPREV + (size_t)NCH * 4), WS_DN = al(WS_DC + (size_t)NCH * MHD * MHD * 4),
        WS_DCB = al(WS_DN + (size_t)NCH * MHD * 4),
        WS_W = al(WS_DCB + (size_t)NCH * MHD * MHD * 2);
    static constexpr size_t W_1IN = 0, W_1OUT = W_1IN + (size_t)2 * FF * D, W_IN = W_1OUT + (size_t)D * FF, W_OUT = W_IN + (size_t)LDP * D, W_Q = W_OUT + (size_t)D * D,
        W_KV = W_Q + (size_t)D * D, W_O = W_KV + (size_t)2 * D * D, W_2IN = W_O + (size_t)D * D, W_2OUT = W_2IN + (size_t)2 * FF * D, W_LAYER = W_2OUT + (size_t)D * FF;
    static constexpr size_t WS_KVB = al(WS_W + (size_t)DEPTH * W_LAYER * 2);
    static constexpr size_t WS_END = al(WS_KVB + (size_t)2 * MM * D * 2);
};

struct Ptrs { const float* in[33]; float* out; unsigned char* ws; };
enum { I_XP = 0, I_XS, I_MEM, I_SPOOL, I_SC, I_SN, I_SM, I_CK, I_CV, I_GFFN1, I_W1IN, I_W1OUT, I_GMIX, I_WIN, I_POOLW, I_POOLS, I_GVG, I_GWS, I_GBS, I_IB, I_FB, I_NG, I_WOUT,
       I_GX, I_GMEM, I_WQ, I_WK, I_WV, I_WO, I_GFFN2, I_W2IN, I_W2OUT, I_GFIN };

template <class C> HD inline float* wsf(const Ptrs& p, size_t off) { return (float*)(p.ws + off); }
template <class C> HD inline bf16_t* wsb(const Ptrs& p, size_t off) { return (bf16_t*)(p.ws + off); }
template <class C> HD inline bf16_t* wlayer(const Ptrs& p, int l, size_t off) { return (bf16_t*)(p.ws + C::WS_W) + (size_t)l * C::W_LAYER + off; }

template <class C> HD inline void row_info(int r, bool& s, int& b, int& t) {
    if (r < C::MP) { s = false; b = r / C::SEQ; t = r % C::SEQ; } else { s = true; const int q = r - C::MP; b = q / C::DEC_SEQ; t = q % C::DEC_SEQ; }
}
template <class C> HD inline void chunk_info(int r, int h, int& ci, int& i, int& lc) {
    bool s; int b, t; row_info<C>(r, s, b, t);
    if (!s) { ci = (b * C::MH + h) * C::NC + t / C::CH; i = t % C::CH; lc = C::CH; } else { ci = C::NPC + b * C::MH + h; i = t; lc = C::LCS; }
}
HD inline float sigmoidf_(float x) { return 1.0f / (1.0f + expf(-x)); }
HD inline float logsigmoidf_(float x) { return x >= 0.f ? -log1pf(expf(-x)) : x - log1pf(expf(x)); }

enum { WK_PLAIN = 0, WK_FFNIN = 1, WK_WIN = 2 };
template <class C> HD inline int wsrc_col(int kind, int n) {
    if (kind == WK_FFNIN) { const int pn = n >> 8, j = n & 255; return j < 128 ? 128 * pn + j : C::FF + 128 * pn + (j - 128); }
    if (kind == WK_WIN) return n < C::INC ? n : -1;
    return n;
}

template <class C> HD inline void st_ml_b0(const Ptrs& p, int l, int sq) {
    const float* CBL = wsf<C>(p, C::WS_CBL); const float* CML = wsf<C>(p, C::WS_CML); float* MPREV = wsf<C>(p, C::WS_MPREV);
    if (sq < C::BATCH * C::MH) { float m = 0.f;
        for (int c = 0; c < C::NC; ++c) { const int ci = sq * C::NC + c; MPREV[ci] = m; const float a = CBL[ci] + m, b2 = CML[ci]; m = a > b2 ? a : b2; }
        p.out[C::OUT_MP + (size_t)l * C::BATCH * C::MH + sq] = m;
    } else { const int q = sq - C::BATCH * C::MH, ci = C::NPC + q; const float m0 = p.in[I_SM][(size_t)l * C::DEC_BATCH * C::MH + q];
        MPREV[ci] = m0; const float a = CBL[ci] + m0, b2 = CML[ci]; p.out[C::OUT_MS + (size_t)l * C::DEC_BATCH * C::MH + q] = a > b2 ? a : b2; }
}

namespace pg8 {
#define PG8_LAS __attribute__((address_space(3)))
typedef unsigned short bf16_t;
typedef short bf16x8 __attribute__((ext_vector_type(8)));
typedef float f32x4 __attribute__((ext_vector_type(4)));
typedef unsigned u32x4 __attribute__((ext_vector_type(4)));
constexpr int BM = 256, BK = 64, HALF = 128, HTB = HALF * BK * 2  , STAGE_BYTES = 8 * HTB, NXCD = 8, WGM = 8;

__host__ __device__ __forceinline__ int lds_byte(int r, int c) { const int st = (r >> 4) * 2 + (c >> 5), rr = r & 15, cc = c & 31, ob = rr * 64 + cc * 2; return st * 1024 + (ob ^ (((ob >> 9) & 1) << 5)); }
__host__ __device__ __forceinline__ void stage_rc(int b, int& R, int& C) { const int st = b / 1024, sb = b % 1024, swz = sb ^ (((sb >> 9) & 1) << 5); R = (st >> 1) * 16 + swz / 64; C = (st & 1) * 32 + (swz % 64) / 2; }
__host__ __device__ __forceinline__ int perm32(int rho) { const int n = rho >> 4, i = rho & 15; return 8 * (i >> 2) + 4 * n + (i & 3); }

struct Unit { int pm, pn; };
struct Gemm { const bf16_t* A; const bf16_t* Bt; int M, N, K, ld; };

struct StaticOrder {
    int nM, nN, nwg, G, c;
    __host__ __device__ __forceinline__ void init(int M, int N, int G_, int c_, int rows_per_tile = BM) { nM = M / rows_per_tile; nN = N / BM; nwg = nM * nN; G = G_; c = c_; }
    __host__ __device__ __forceinline__ bool next(int i, Unit& u) const {
        const long L = (long)i * G + c; if (L >= nwg) return false;
        int wgid = (int)L; { const int q = nwg / NXCD, r = nwg % NXCD, xcd = wgid % NXCD, off = wgid / NXCD; wgid = (xcd < r ? xcd * (q + 1) : r * (q + 1) + (xcd - r) * q) + off; }
        const int nig = WGM * nN, gid = wgid / nig, fm = gid * WGM, gsz = (nM - fm) < WGM ? (nM - fm) : WGM;
        u.pm = fm + ((wgid % nig) % gsz); u.pn = (wgid % nig) / gsz; return true;
    }
    __device__ __forceinline__ void a_ready(const Unit&) const {}
    __device__ __forceinline__ void done(const Unit&) const {}
};
__device__ __forceinline__ unsigned cvt_pk_bf16(float lo, float hi) { unsigned r; asm volatile("v_cvt_pk_bf16_f32 %0, %1, %2" : "=v"(r) : "v"(lo), "v"(hi)); return r; }
typedef float f32x2 __attribute__((ext_vector_type(2)));
template <class Epi, class Sched, bool STRIP = false, bool STAMP = false>
__device__ __forceinline__ void gemm_phase(PG8_LAS unsigned char* lds, const Gemm g, const Sched& S, const Epi& E, unsigned long long* stamps) {
    int tid_l = threadIdx.x; asm volatile("" : "+v"(tid_l));
    const int tid = tid_l, wid = __builtin_amdgcn_readfirstlane(tid >> 6), lane = tid & 63, wr = wid >> 2, wc = wid & 3, fr = lane & 15, fq = lane >> 4;
    const int K = g.K, nt = K / BK;
    int ts_lo = 0, ts_hi = 0, nts = 0; const unsigned long long rt_entry = STAMP ? (unsigned long long)wall_clock64() : 0ull;
#define PG8_STAMP() do { if (STAMP && wid == 0 && nts < 64) { const unsigned long long _c = (unsigned long long)clock64(); \
        ts_lo = (lane == nts) ? (int)(unsigned)_c : ts_lo; ts_hi = (lane == nts) ? (int)(unsigned)(_c >> 32) : ts_hi; ++nts; } } while (0)
    PG8_STAMP();
    unsigned voffA[2], voffB[2];
#pragma unroll
    for (int i = 0; i < 2; ++i) { int R, C; stage_rc(tid * 16 + i * 8192, R, C); const int Rb = Epi::PERM ? ((R & ~31) + perm32(R & 31)) : R;
        voffA[i] = (unsigned)(R * g.ld + C) * 2u; voffB[i] = (unsigned)(Rb * g.ld + C) * 2u; }
    const size_t kstep = (size_t)(BK * 2);
    const size_t hstep = (size_t)HALF * g.ld * 2;
    const size_t tstep = 2 * hstep;
    const size_t tstepA = STRIP ? (size_t)288 * g.ld * 2 : tstep;
    unsigned voffS = 0u; if constexpr (STRIP) { int R, C; stage_rc((wid & 3) * 1024 + lane * 16, R, C); voffS = (unsigned)(R * g.ld + C) * 2u; }
    const int soff = lds_byte(wr * 16 + fr, fq * 8);
    const unsigned ldsw = (unsigned)wid * 1024u;
    const int aoff = lds_byte(wr * 64 + fr, fq * 8), boff = lds_byte(wc * 32 + fr, fq * 8);
#define PG8_SA(b, h) (((b) * 2 + (h)) * HTB)
#define PG8_SB(b, h) ((4 + (b) * 2 + (h)) * HTB)
#define PG8_SS(b) (8 * HTB + (b) * 8192)
#define PG8_STAGE_S(b, gbase) do { if constexpr (STRIP) __builtin_amdgcn_global_load_lds((const unsigned*)((const char*)(gbase) + 2 * hstep + voffS), (PG8_LAS unsigned*)(lds + PG8_SS(b) + ldsw), 16, 0, 0); } while (0)
#define PG8_LDS(b) do { if constexpr (STRIP) { _Pragma("unroll") for (int k = 0; k < 2; ++k) Sf[k] = *(const PG8_LAS bf16x8*)(lds + PG8_SS(b) + soff + k * 1024); } } while (0)
#define PG8_MMS(bj, Bt) do { if constexpr (STRIP) { __builtin_amdgcn_s_setprio(1); _Pragma("unroll") for (int n = 0; n < 2; ++n) _Pragma("unroll") for (int k = 0; k < 2; ++k) accS[bj][n] = __builtin_amdgcn_mfma_f32_16x16x32_bf16(Bt[n][k], Sf[k], accS[bj][n], 0, 0, 0); __builtin_amdgcn_s_setprio(0); } } while (0)
#define PG8_STAGE(bufoff, gbase, voff) do { _Pragma("unroll") for (int _i = 0; _i < 2; ++_i) \
        __builtin_amdgcn_global_load_lds((const unsigned*)((const char*)(gbase) + (voff)[_i]), (PG8_LAS unsigned*)(lds + (bufoff) + ldsw + _i * 8192), 16, 0, 0); } while (0)
#define PG8_LDA(dst, b, h) do { _Pragma("unroll") for (int m = 0; m < 4; ++m) _Pragma("unroll") for (int k = 0; k < 2; ++k) dst[m][k] = *(const PG8_LAS bf16x8*)(lds + PG8_SA(b, h) + aoff + m * 2048 + k * 1024); } while (0)
#define PG8_LDB(dst, b, h) do { _Pragma("unroll") for (int n = 0; n < 2; ++n) _Pragma("unroll") for (int k = 0; k < 2; ++k) dst[n][k] = *(const PG8_LAS bf16x8*)(lds + PG8_SB(b, h) + boff + n * 2048 + k * 1024); } while (0)
#define PG8_MMA(ai, bj, At, Bt) do { __builtin_amdgcn_s_setprio(1); _Pragma("unroll") for (int m = 0; m < 4; ++m) _Pragma("unroll") for (int n = 0; n < 2; ++n) _Pragma("unroll") for (int k = 0; k < 2; ++k) \
        acc[ai][bj][m][n] = __builtin_amdgcn_mfma_f32_16x16x32_bf16(Bt[n][k], At[m][k], acc[ai][bj][m][n], 0, 0, 0); __builtin_amdgcn_s_setprio(0); } while (0)
#define PG8_WAIT_V(n) asm volatile("s_waitcnt vmcnt(" #n ")" ::: "memory")
#define PG8_WAIT_L(n) asm volatile("s_waitcnt lgkmcnt(" #n ")" ::: "memory")
#define PG8_WAIT_VS(n, ns) do { if constexpr (STRIP) PG8_WAIT_V(ns); else PG8_WAIT_V(n); } while (0)
#define PG8_WAIT_LS(n, ns) do { if constexpr (STRIP) PG8_WAIT_L(ns); else PG8_WAIT_L(n); } while (0)
#define PG8_BAR __builtin_amdgcn_s_barrier()
#define PG8_SCHED __builtin_amdgcn_sched_barrier(0)
    Unit cur, nxt; int ui = 0;
    if (!S.next(0, cur)) return;
    f32x4 acc[2][2][4][2];
#pragma unroll
    for (int a = 0; a < 2; ++a)
#pragma unroll
        for (int b = 0; b < 2; ++b)
#pragma unroll
            for (int m = 0; m < 4; ++m)
#pragma unroll
                for (int n = 0; n < 2; ++n) acc[a][b][m][n] = (f32x4){0.f, 0.f, 0.f, 0.f};
    bf16x8 At[4][2], B0[2][2], B1[2][2];
    f32x4 accS[2][2]; bf16x8 Sf[2];
#pragma unroll
    for (int b = 0; b < 2; ++b)
#pragma unroll
        for (int n = 0; n < 2; ++n) accS[b][n] = (f32x4){0.f, 0.f, 0.f, 0.f};
#pragma unroll
    for (int k = 0; k < 2; ++k) Sf[k] = (bf16x8){0, 0, 0, 0, 0, 0, 0, 0};
    const char* cA = (const char*)g.A + (size_t)cur.pm * tstepA; const char* cB = (const char*)g.Bt + (size_t)cur.pn * tstep;
    S.a_ready(cur);
    PG8_STAGE(PG8_SB(0, 0), cB, voffB); PG8_STAGE(PG8_SA(0, 0), cA, voffA); PG8_STAGE(PG8_SB(0, 1), cB + hstep, voffB); PG8_STAGE(PG8_SA(0, 1), cA + hstep, voffA); PG8_STAGE_S(0, cA);
    if (wr == 1) PG8_BAR;
    PG8_WAIT_VS(4, 5); PG8_BAR;
    PG8_STAGE(PG8_SB(1, 0), cB + kstep, voffB); PG8_STAGE(PG8_SA(1, 0), cA + kstep, voffA); PG8_STAGE(PG8_SB(1, 1), cB + hstep + kstep, voffB); PG8_STAGE_S(1, cA + kstep);
    PG8_WAIT_VS(6, 7); PG8_BAR;
    PG8_STAMP();
    for (;;) {
        const bool has_next = S.next(ui + 1, nxt);
        const char* nA = has_next ? (const char*)g.A + (size_t)nxt.pm * tstepA : cA; const char* nB = has_next ? (const char*)g.Bt + (size_t)nxt.pn * tstep : cB;
        for (int t = 0; t < nt; t += 2) {
            const bool last = (t == nt - 2);
            const char* a1 = cA + (size_t)(t + 1) * kstep;
            const char* a2 = last ? nA : cA + (size_t)(t + 2) * kstep; const char* b2 = last ? nB : cB + (size_t)(t + 2) * kstep;
            const char* a3 = a2 + kstep; const char* b3 = b2 + kstep;
            if (last && has_next) S.a_ready(nxt);
            PG8_LDB(B0, 0, 0); PG8_SCHED; PG8_LDA(At, 0, 0); PG8_LDS(0); PG8_STAGE(PG8_SA(1, 1), a1 + hstep, voffA);
            PG8_WAIT_LS(8, 10); PG8_BAR; PG8_WAIT_L(0); PG8_MMA(0, 0, At, B0); PG8_MMS(0, B0); PG8_BAR; PG8_SCHED;
            PG8_LDB(B1, 0, 1); PG8_STAGE(PG8_SB(0, 0), b2, voffB);
            PG8_BAR; PG8_WAIT_L(0); PG8_MMA(0, 1, At, B1); PG8_MMS(1, B1); PG8_BAR;
            PG8_LDA(At, 0, 1); PG8_STAGE(PG8_SA(0, 0), a2, voffA); PG8_STAGE_S(0, a2);
            PG8_BAR; PG8_WAIT_L(0); PG8_MMA(1, 0, At, B0); PG8_BAR; PG8_SCHED;
            PG8_STAGE(PG8_SB(0, 1), b2 + hstep, voffB);
            PG8_WAIT_VS(6, 7); PG8_BAR; PG8_MMA(1, 1, At, B1); PG8_BAR;
            PG8_LDB(B0, 1, 0); PG8_SCHED; PG8_LDA(At, 1, 0); PG8_LDS(1); PG8_STAGE(PG8_SA(0, 1), a2 + hstep, voffA);
            PG8_WAIT_LS(8, 10); PG8_BAR; PG8_WAIT_L(0); PG8_MMA(0, 0, At, B0); PG8_MMS(0, B0); PG8_BAR; PG8_SCHED;
            PG8_LDB(B1, 1, 1); PG8_STAGE(PG8_SB(1, 0), b3, voffB);
            PG8_BAR; PG8_WAIT_L(0); PG8_MMA(0, 1, At, B1); PG8_MMS(1, B1); PG8_BAR;
            PG8_LDA(At, 1, 1); PG8_STAGE(PG8_SA(1, 0), a3, voffA); PG8_STAGE_S(1, a3);
            PG8_BAR; PG8_WAIT_L(0); PG8_MMA(1, 0, At, B0); PG8_BAR; PG8_SCHED;
            PG8_STAGE(PG8_SB(1, 1), b3 + hstep, voffB);
            PG8_WAIT_VS(6, 7); PG8_BAR; PG8_MMA(1, 1, At, B1); PG8_BAR;
        }
        PG8_STAMP();
        { const int rt0 = cur.pm * (STRIP ? 288 : 256), rw0 = rt0 + wr * 64 + fr;
#define PG8_RV(ai, m) {{acc[ai][0][m][0], acc[ai][0][m][1]}, {acc[ai][1][m][0], acc[ai][1][m][1]}}
#define PG8_BATCH(r0_, v0_, r1_, v1_) do { const typename Epi::Pre p0_ = E.pre(r0_, cur.pn, wc, fq), p1_ = E.pre(r1_, cur.pn, wc, fq); \
              { const f32x4 v_[2][2] = v0_; E.row(v_, p0_, r0_, cur.pn, wc, fq); } { const f32x4 v_[2][2] = v1_; E.row(v_, p1_, r1_, cur.pn, wc, fq); } } while (0)
          if constexpr (Epi::PRE_ALL) {
              typename Epi::Pre pa_[9];
#pragma unroll
              for (int q_ = 0; q_ < 8; ++q_) pa_[q_] = E.pre(rw0 + (q_ >> 2) * HALF + (q_ & 3) * 16, cur.pn, wc, fq);
              pa_[8] = STRIP ? E.pre(rt0 + 256 + wr * 16 + fr, cur.pn, wc, fq) : pa_[0];
#define PG8_ONE(q_, ai, m) { const f32x4 v_[2][2] = PG8_RV(ai, m); E.row(v_, pa_[q_], rw0 + ai * HALF + m * 16, cur.pn, wc, fq); }
              PG8_ONE(0, 0, 0) PG8_ONE(1, 0, 1) PG8_ONE(2, 0, 2) PG8_ONE(3, 0, 3) PG8_ONE(4, 1, 0) PG8_ONE(5, 1, 1) PG8_ONE(6, 1, 2) PG8_ONE(7, 1, 3)
#undef PG8_ONE
              if constexpr (STRIP) E.row(accS, pa_[8], rt0 + 256 + wr * 16 + fr, cur.pn, wc, fq);
#if defined(PROBE_EPI2)
              asm volatile("" ::: "memory");
#pragma unroll
              for (int q_ = 0; q_ < 8; ++q_) pa_[q_] = E.pre(rw0 + (q_ >> 2) * HALF + (q_ & 3) * 16, cur.pn, wc, fq);
              pa_[8] = STRIP ? E.pre(rt0 + 256 + wr * 16 + fr, cur.pn, wc, fq) : pa_[0];
#define PG8_ONE(q_, ai, m) { const f32x4 v_[2][2] = PG8_RV(ai, m); E.row(v_, pa_[q_], rw0 + ai * HALF + m * 16, cur.pn, wc, fq); }
              PG8_ONE(0, 0, 0) PG8_ONE(1, 0, 1) PG8_ONE(2, 0, 2) PG8_ONE(3, 0, 3) PG8_ONE(4, 1, 0) PG8_ONE(5, 1, 1) PG8_ONE(6, 1, 2) PG8_ONE(7, 1, 3)
#undef PG8_ONE
              if constexpr (STRIP) E.row(accS, pa_[8], rt0 + 256 + wr * 16 + fr, cur.pn, wc, fq);
#endif
          } else {
          PG8_BATCH(rw0, PG8_RV(0, 0), rw0 + 16, PG8_RV(0, 1));
          PG8_BATCH(rw0 + 32, PG8_RV(0, 2), rw0 + 48, PG8_RV(0, 3));
          PG8_BATCH(rw0 + HALF, PG8_RV(1, 0), rw0 + HALF + 16, PG8_RV(1, 1));
          PG8_BATCH(rw0 + HALF + 32, PG8_RV(1, 2), rw0 + HALF + 48, PG8_RV(1, 3));
          if constexpr (STRIP) { const int rs_ = rt0 + 256 + wr * 16 + fr; const typename Epi::Pre ps_ = E.pre(rs_, cur.pn, wc, fq); E.row(accS, ps_, rs_, cur.pn, wc, fq); }
          }
          if constexpr (STRIP) {
#pragma unroll
              for (int b = 0; b < 2; ++b)
#pragma unroll
                for (int n = 0; n < 2; ++n) accS[b][n] = (f32x4){0.f, 0.f, 0.f, 0.f}; }
#undef PG8_BATCH
#undef PG8_RV
          S.done(cur); }
        PG8_STAMP();
        if (!has_next) break;
#pragma unroll
        for (int a = 0; a < 2; ++a)
#pragma unroll
            for (int b = 0; b < 2; ++b)
#pragma unroll
                for (int m = 0; m < 4; ++m)
#pragma unroll
                    for (int n = 0; n < 2; ++n) acc[a][b][m][n] = (f32x4){0.f, 0.f, 0.f, 0.f};
        cur = nxt; cA = nA; cB = nB; ++ui;
    }
    PG8_WAIT_V(0);
    if (wr == 0) PG8_BAR;
    PG8_BAR;
    PG8_STAMP();
    if (STAMP && wid == 0) { stamps[lane] = lane < nts ? (((unsigned long long)(unsigned)ts_hi << 32) | (unsigned)ts_lo) : 0ull;
        if (lane == 62) stamps[62] = rt_entry; if (lane == 63) stamps[63] = (unsigned long long)wall_clock64(); }
#undef PG8_STAMP
#undef PG8_SA
#undef PG8_SB
#undef PG8_STAGE
#undef PG8_LDA
#undef PG8_LDB
#undef PG8_MMA
#undef PG8_WAIT_V
#undef PG8_WAIT_L
#undef PG8_BAR
#undef PG8_SCHED
#undef PG8_WAIT_LS
#undef PG8_WAIT_VS
#undef PG8_MMS
#undef PG8_LDS
#undef PG8_STAGE_S
#undef PG8_SS
}
}


#define LAS __attribute__((address_space(3)))
#define XB_TMO      128
#define XB_XCNT(j)  (256  + 64 * (j))
#define XB_XSUB(j)  (1280 + 64 * (j))
#define XB_XGEN(j)  (2304 + 64 * (j))
#define XB_TOP      3328
#define XB_TOPGEN   3392
#define XCD_BAR_WORDS 3456
#define XB_SPIN_CAP (1u << 18)

__device__ __forceinline__ unsigned xb_ld(unsigned* p)              { return __hip_atomic_load(p, __ATOMIC_RELAXED, __HIP_MEMORY_SCOPE_AGENT); }
__device__ __forceinline__ unsigned xb_add(unsigned* p, unsigned v) { return __hip_atomic_fetch_add(p, v, __ATOMIC_RELAXED, __HIP_MEMORY_SCOPE_AGENT); }
__device__ __forceinline__ unsigned xb_xcc_id() { return (unsigned)__builtin_amdgcn_s_getreg((3 << 11) | 20) & 0xFu; }
#define XB_SPIN(cond, bar) do { unsigned _sp = 0; while (cond) { __builtin_amdgcn_s_sleep(1); \
    if ((++_sp & 255u) == 0u) { if (xb_ld(&(bar)[XB_TMO])) break; if (_sp > XB_SPIN_CAP) { atomicAdd(&(bar)[XB_TMO], 1u); break; } } } } while (0)

struct XcdBarrier {
    unsigned* bar; unsigned x;
    volatile LAS unsigned* st;
};

__device__ __forceinline__ XcdBarrier xcd_barrier_post(unsigned* bar, volatile LAS unsigned* st) {
    XcdBarrier b; b.bar = bar; b.x = xb_xcc_id(); b.st = st;
    if (threadIdx.x == 0) (void)xb_add(&bar[XB_XCNT(b.x)], 1u);
    return b;
}
__device__ __forceinline__ void xcd_barrier_complete(unsigned* bar, unsigned x, unsigned& nloc, unsigned& nx) {
    const unsigned G = gridDim.x * gridDim.y * gridDim.z;
    unsigned sum, cnt, mine, sp = 0u;
    for (;;) {
        sum = 0u; cnt = 0u; mine = 0u;
#pragma unroll
        for (unsigned j = 0; j < 16; ++j) { const unsigned c = xb_ld(&bar[XB_XCNT(j)]); sum += c; cnt += (c > 0u) ? 1u : 0u; mine = (j == x) ? c : mine; }
        if (sum == G) break;
        __builtin_amdgcn_s_sleep(1);
        if ((++sp & 255u) == 0u) { if (xb_ld(&bar[XB_TMO])) break; if (sp > XB_SPIN_CAP) { atomicAdd(&bar[XB_TMO], 1u); break; } }
    }
    nloc = mine > 0u ? mine : 1u; nx = cnt > 0u ? cnt : 1u;
}

__device__ __forceinline__ void xcd_barrier(const XcdBarrier& b) {
    asm volatile("s_waitcnt vmcnt(0)" ::: "memory");
    __syncthreads();
    if (threadIdx.x == 0) {
        unsigned* bar = b.bar;
        __builtin_amdgcn_s_waitcnt(0);
        unsigned nloc = b.st[0], nx = b.st[1];
        if (nloc == 0u) { xcd_barrier_complete(bar, b.x, nloc, nx); b.st[0] = nloc; b.st[1] = nx; }
        const unsigned old = xb_add(&bar[XB_XSUB(b.x)], 1u);
        const unsigned gen = old / nloc;
        if (old + 1u == (gen + 1u) * nloc) {
            __builtin_amdgcn_fence(__ATOMIC_RELEASE, "agent");
            asm volatile("s_waitcnt vmcnt(0)" ::: "memory");
            const unsigned og = xb_add(&bar[XB_TOP], 1u);
            const unsigned tg = og / nx;
            if (og + 1u == (tg + 1u) * nx) xb_add(&bar[XB_TOPGEN], 1u);
            else XB_SPIN(xb_ld(&bar[XB_TOPGEN]) == tg, bar);
            __builtin_amdgcn_fence(__ATOMIC_ACQUIRE, "agent");
            xb_add(&bar[XB_XGEN(b.x)], 1u);
            asm volatile("s_waitcnt vmcnt(0)" ::: "memory");
        } else {
            XB_SPIN(xb_ld(&bar[XB_XGEN(b.x)]) == gen, bar);
            __builtin_amdgcn_fence(__ATOMIC_ACQUIRE, "agent");
            asm volatile("s_waitcnt vmcnt(0)" ::: "memory");
        }
    }
    __syncthreads();
}

typedef CfgT<RC> C;
constexpr int NTHREADS = 512, NWAVES = 8;
constexpr int LDS_STAGE = 131072 + 16384 + 8192, LDS_CTL = LDS_STAGE, LDS_BYTES = LDS_STAGE + 256;

namespace pg8 {
typedef unsigned u32x2 __attribute__((ext_vector_type(2)));
__device__ __forceinline__ float silu_f(float g) { return g * __builtin_amdgcn_rcpf(1.0f + __expf(-g)); }
struct EpiSwiGLU { static constexpr bool PERM = true, PRE_ALL = true;
    bf16_t* act; const float* ss; int ff; float invd;
    typedef float Pre;
    __device__ __forceinline__ Pre pre(int row, int pn, int wc, int fq) const { return ss[row]; }
    __device__ __forceinline__ void row(const f32x4 (&v)[2][2], Pre ssr, int row, int pn, int wc, int fq) const {
        const float rs = rsqrtf(ssr * invd + 1e-6f); f32x4 o[2];
#pragma unroll
        for (int n = 0; n < 2; ++n) { const f32x4 g = v[0][n] * rs, up = v[1][n] * rs, t = g * -1.4426950408889634f; f32x4 e, r;
#pragma unroll
            for (int j = 0; j < 4; ++j) e[j] = __builtin_amdgcn_exp2f(t[j]);
            const f32x4 dd = e + 1.0f;
#pragma unroll
            for (int j = 0; j < 4; ++j) r[j] = __builtin_amdgcn_rcpf(dd[j]);
            o[n] = g * r * up; }
        u32x4 w; w.x = cvt_pk_bf16(o[0][0], o[0][1]); w.y = cvt_pk_bf16(o[0][2], o[0][3]); w.z = cvt_pk_bf16(o[1][0], o[1][1]); w.w = cvt_pk_bf16(o[1][2], o[1][3]);
        *(u32x4*)(act + (size_t)row * ff + pn * 128 + wc * 32 + 8 * fq) = w;
    }
};
struct EpiResid { static constexpr bool PERM = false, PRE_ALL = false;
    float* X; bf16_t* XB; float* ssout; float scale; int ld;
    struct Pre { f32x4 x[2][2]; };
    __device__ __forceinline__ Pre pre(int row, int pn, int wc, int fq) const { Pre q; const float* xr = X + (size_t)row * ld + pn * BM + wc * 32 + 4 * fq;
#pragma unroll
        for (int bj = 0; bj < 2; ++bj)
#pragma unroll
            for (int n = 0; n < 2; ++n) q.x[bj][n] = *(const f32x4*)(xr + bj * HALF + n * 16);
        return q; }
    __device__ __forceinline__ void row(const f32x4 (&v)[2][2], const Pre& q, int row, int pn, int wc, int fq) const {
        const int col0 = pn * BM + wc * 32 + 4 * fq; float* xr = X + (size_t)row * ld + col0; bf16_t* br = XB + (size_t)row * ld + col0; float s = 0.f;
#pragma unroll
        for (int bj = 0; bj < 2; ++bj)
#pragma unroll
            for (int n = 0; n < 2; ++n) { const f32x4 x = q.x[bj][n] + v[bj][n] * scale; *(f32x4*)(xr + bj * HALF + n * 16) = x;
                u32x2 w; w.x = cvt_pk_bf16(x[0], x[1]); w.y = cvt_pk_bf16(x[2], x[3]); *(u32x2*)(br + bj * HALF + n * 16) = w;
                s += (x[0] * x[0] + x[1] * x[1]) + (x[2] * x[2] + x[3] * x[3]); }
        s += __shfl_xor(s, 16); s += __shfl_xor(s, 32);
        if (fq == 0) unsafeAtomicAdd(ssout + row, s);
    }
};
struct EpiScaleF32 { static constexpr bool PERM = false, PRE_ALL = true;
    float* Cp; int ldc; const float* ss; float invd;
    typedef float Pre;
    __device__ __forceinline__ Pre pre(int row, int pn, int wc, int fq) const { return ss[row]; }
    __device__ __forceinline__ void row(const f32x4 (&v)[2][2], Pre ssr, int row, int pn, int wc, int fq) const {
        const float rs = rsqrtf(ssr * invd + 1e-6f); float* cr = Cp + (size_t)row * ldc + pn * BM + wc * 32 + 4 * fq;
#pragma unroll
        for (int bj = 0; bj < 2; ++bj)
#pragma unroll
            for (int n = 0; n < 2; ++n) *(f32x4*)(cr + bj * HALF + n * 16) = v[bj][n] * rs;
    }
};
struct EpiScaleBf16 { static constexpr bool PERM = true, PRE_ALL = true;
    bf16_t* O; int ldc; const float* ss; float invd;
    typedef float Pre;
    __device__ __forceinline__ Pre pre(int row, int pn, int wc, int fq) const { return ss[row]; }
    __device__ __forceinline__ void row(const f32x4 (&v)[2][2], Pre ssr, int row, int pn, int wc, int fq) const {
        const float rs = rsqrtf(ssr * invd + 1e-6f); bf16_t* orow = O + (size_t)row * ldc + pn * BM + wc * 32 + 8 * fq;
#pragma unroll
        for (int bj = 0; bj < 2; ++bj) { const f32x4 v0 = v[bj][0] * rs, v1 = v[bj][1] * rs;
            u32x4 w; w.x = cvt_pk_bf16(v0[0], v0[1]); w.y = cvt_pk_bf16(v0[2], v0[3]); w.z = cvt_pk_bf16(v1[0], v1[1]); w.w = cvt_pk_bf16(v1[2], v1[3]);
            *(u32x4*)(orow + bj * HALF) = w; }
    }
};
struct EpiMemKV { static constexpr bool PERM = false, PRE_ALL = true;
    float* K; float* V; const float* rstd; int d; bf16_t* KVB; int mm;
    typedef float Pre;
    __device__ __forceinline__ Pre pre(int row, int pn, int wc, int fq) const { return rstd[row]; }
    __device__ __forceinline__ void row(const f32x4 (&v)[2][2], Pre rs, int row, int pn, int wc, int fq) const {
        int ct = pn * BM; float* base = K; bf16_t* bb = KVB; if (ct >= d) { base = V; ct -= d; bb += (size_t)mm * d; }
        float* cr = base + (size_t)row * d + ct + wc * 32 + 4 * fq; bb += (size_t)row * d + ct + wc * 32 + 4 * fq;
#pragma unroll
        for (int bj = 0; bj < 2; ++bj)
#pragma unroll
            for (int n = 0; n < 2; ++n) { const f32x4 o = v[bj][n] * rs; *(f32x4*)(cr + bj * HALF + n * 16) = o;
                u32x2 w; w.x = cvt_pk_bf16(o[0], o[1]); w.y = cvt_pk_bf16(o[2], o[3]); *(u32x2*)(bb + bj * HALF + n * 16) = w; }
    }
};
}

__device__ __forceinline__ void prep_item(const float* W, int K, int Ncols, const float* g, int kind, int N, bf16_t* Bt, LAS unsigned char* scr, int item, int lane) {
    const int nblk = N / 64, kb = item / nblk, nb = item % nblk, k0 = 64 * kb, n = 64 * nb + lane;
    const int sc = wsrc_col<C>(kind, n);
    const float* src = W + (size_t)k0 * Ncols + (sc >= 0 ? sc : 0);
    float v[64];
#pragma unroll
    for (int kk = 0; kk < 64; ++kk) v[kk] = src[(size_t)kk * Ncols];
    if (g) {
#pragma unroll
        for (int kk = 0; kk < 64; ++kk) v[kk] *= g[k0 + kk];
    }
    if (sc < 0) {
#pragma unroll
        for (int kk = 0; kk < 64; ++kk) v[kk] = 0.f;
    }
#pragma unroll
    for (int j = 0; j < 8; ++j) { pg8::u32x4 o; o.x = pg8::cvt_pk_bf16(v[8 * j], v[8 * j + 1]); o.y = pg8::cvt_pk_bf16(v[8 * j + 2], v[8 * j + 3]); o.z = pg8::cvt_pk_bf16(v[8 * j + 4], v[8 * j + 5]); o.w = pg8::cvt_pk_bf16(v[8 * j + 6], v[8 * j + 7]);
        *(LAS pg8::u32x4*)(scr + lane * 144 + j * 16) = o; }
    asm volatile("s_waitcnt lgkmcnt(0)" ::: "memory");
    bf16_t* dst = Bt + (size_t)(64 * nb) * K + k0 + (lane & 7) * 8;
#pragma unroll
    for (int it = 0; it < 8; ++it) { const int row = it * 8 + (lane >> 3); const pg8::u32x4 o = *(const LAS pg8::u32x4*)(scr + row * 144 + (lane & 7) * 16);
        *(pg8::u32x4*)(dst + (size_t)row * K) = o; }
    asm volatile("s_waitcnt lgkmcnt(0)" ::: "memory");
}
struct WDesc { const float* W; const float* g; bf16_t* dst; int K, Ncols, kind, N; };
__device__ __forceinline__ WDesc wdesc(const Ptrs& p, int l, int idx) {
    WDesc d; d.g = nullptr; d.kind = WK_PLAIN;
    switch (idx) {
    case 0: d.W = p.in[I_W1IN] + (size_t)l * C::D * 2 * C::FF; d.K = C::D; d.Ncols = 2 * C::FF; d.N = 2 * C::FF; d.g = p.in[I_GFFN1] + l * C::D; d.kind = WK_FFNIN; d.dst = wlayer<C>(p, l, C::W_1IN); break;
    case 1: d.W = p.in[I_W1OUT] + (size_t)l * C::FF * C::D; d.K = C::FF; d.Ncols = C::D; d.N = C::D; d.dst = wlayer<C>(p, l, C::W_1OUT); break;
    case 2: d.W = p.in[I_WIN] + (size_t)l * C::D * C::INC; d.K = C::D; d.Ncols = C::INC; d.N = C::LDP; d.g = p.in[I_GMIX] + l * C::D; d.kind = WK_WIN; d.dst = wlayer<C>(p, l, C::W_IN); break;
    case 3: d.W = p.in[I_WOUT] + (size_t)l * C::D * C::D; d.K = C::D; d.Ncols = C::D; d.N = C::D; d.dst = wlayer<C>(p, l, C::W_OUT); break;
    case 4: d.W = p.in[I_WQ] + (size_t)l * C::D * C::D; d.K = C::D; d.Ncols = C::D; d.N = C::D; d.g = p.in[I_GX] + l * C::D; d.dst = wlayer<C>(p, l, C::W_Q); break;
    case 5: d.W = p.in[I_WK] + (size_t)l * C::D * C::D; d.K = C::D; d.Ncols = C::D; d.N = C::D; d.g = p.in[I_GMEM] + l * C::D; d.dst = wlayer<C>(p, l, C::W_KV); break;
    case 6: d.W = p.in[I_WV] + (size_t)l * C::D * C::D; d.K = C::D; d.Ncols = C::D; d.N = C::D; d.g = p.in[I_GMEM] + l * C::D; d.dst = wlayer<C>(p, l, C::W_KV) + (size_t)C::D * C::D; break;
    case 7: d.W = p.in[I_WO] + (size_t)l * C::D * C::D; d.K = C::D; d.Ncols = C::D; d.N = C::D; d.dst = wlayer<C>(p, l, C::W_O); break;
    case 8: d.W = p.in[I_W2IN] + (size_t)l * C::D * 2 * C::FF; d.K = C::D; d.Ncols = 2 * C::FF; d.N = 2 * C::FF; d.g = p.in[I_GFFN2] + l * C::D; d.kind = WK_FFNIN; d.dst = wlayer<C>(p, l, C::W_2IN); break;
    default: d.W = p.in[I_W2OUT] + (size_t)l * C::FF * C::D; d.K = C::FF; d.Ncols = C::D; d.N = C::D; d.dst = wlayer<C>(p, l, C::W_2OUT); break;
    }
    return d;
}

#define WG_SYNC() do { asm volatile("s_waitcnt lgkmcnt(0)" ::: "memory"); __builtin_amdgcn_s_barrier(); asm volatile("" ::: "memory"); } while (0)
namespace att {
typedef short bf16x8 __attribute__((ext_vector_type(8)));
typedef short s16x4 __attribute__((ext_vector_type(4)));
typedef float f32x4 __attribute__((ext_vector_type(4)));
typedef unsigned u32x2 __attribute__((ext_vector_type(2)));
constexpr int TOK = 256, CD = 64, PITCH = 144, CBYTES = TOK * PITCH, HDIM = 512, NH = 4, LD = 2048;
static_assert(C::NMEM == TOK && C::AHD == HDIM && C::AH == NH && C::D == LD && C::DEC_SEQ == 32 && C::SEQ % 256 == 0, "attention phase is built for these shapes");
__device__ __forceinline__ s16x4 tr_read(unsigned addr) { s16x4 r; asm volatile("ds_read_b64_tr_b16 %0, %1" : "=&v"(r) : "v"(addr) : "memory"); return r; }
__device__ __forceinline__ void stage_load(f32x4 (&r)[8], const float* src, int tid) {
    const unsigned off0 = (unsigned)(((tid >> 4) * LD + (tid & 15) * 4) * 4);
#pragma unroll
    for (int i = 0; i < 8; ++i) { const float* si = src + (size_t)i * 32 * LD; asm volatile("" : "+s"(si));
        r[i] = *(const f32x4*)((const char*)si + off0); }
    __builtin_amdgcn_sched_barrier(0);
}
__device__ __forceinline__ void stage_load_b(pg8::u32x4 (&r)[4], const bf16_t* src, int tid) {
    const unsigned off0 = (unsigned)(((tid >> 3) * LD + (tid & 7) * 8) * 2);
#pragma unroll
    for (int i = 0; i < 4; ++i) { const bf16_t* si = src + (size_t)i * 64 * LD; asm volatile("" : "+s"(si)); r[i] = *(const pg8::u32x4*)((const char*)si + off0); }
    __builtin_amdgcn_sched_barrier(0);
}
__device__ __forceinline__ int klds(int r, int c) { const int ob = (r & 15) * 64 + (c & 31) * 2; return ((r >> 4) * 2 + (c >> 5)) * 1024 + (ob ^ (((ob >> 9) & 1) << 5)); }
__device__ __forceinline__ void stage_store_k(const f32x4 (&r)[8], LAS unsigned char* buf, int tid) {
#pragma unroll
    for (int i = 0; i < 8; ++i) { const int f = tid + 512 * i; u32x2 w; w.x = pg8::cvt_pk_bf16(r[i][0], r[i][1]); w.y = pg8::cvt_pk_bf16(r[i][2], r[i][3]);
        *(LAS u32x2*)(buf + klds(f >> 4, (f & 15) * 4)) = w; }
}
__device__ __forceinline__ void stage_store_kb(const pg8::u32x4 (&r)[4], LAS unsigned char* buf, int tid) {
    asm volatile("" : "+v"(tid));
#pragma unroll
    for (int i = 0; i < 4; ++i) *(LAS pg8::u32x4*)(buf + klds((tid >> 3) + 64 * i, (tid & 7) * 8)) = r[i];
}
__device__ __forceinline__ void stage_store_vb(const pg8::u32x4 (&r)[4], LAS unsigned char* buf, int tid) {
    asm volatile("" : "+v"(tid));
#pragma unroll
    for (int i = 0; i < 4; ++i) *(LAS pg8::u32x4*)(buf + ((tid >> 3) + 64 * i) * PITCH + (tid & 7) * 16) = r[i];
}
__device__ __forceinline__ void stage_store(const f32x4 (&r)[8], LAS unsigned char* buf, int tid) {
#pragma unroll
    for (int i = 0; i < 8; ++i) { const int f = tid + 512 * i; u32x2 w; w.x = pg8::cvt_pk_bf16(r[i][0], r[i][1]); w.y = pg8::cvt_pk_bf16(r[i][2], r[i][3]);
        *(LAS u32x2*)(buf + (f >> 4) * PITCH + (f & 15) * 8) = w; }
}
__device__ __forceinline__ void attn_sample_unit(LAS unsigned char* lds, const bf16_t* Qg, bf16_t* AO, const float* kb, const float* vb, int row0, int head, int tid) {
    const int lane = tid & 63, wave = __builtin_amdgcn_readfirstlane(tid >> 6), li = lane & 15, g = lane >> 4;
    constexpr int PP = 528;
    LAS unsigned char* Ps = lds + 2 * CBYTES;
    LAS float* smax = (LAS float*)(Ps + 32 * PP); LAS float* ssum = smax + 8 * 32;
    const bf16_t* q0 = Qg + (size_t)(row0 + li) * LD + head * HDIM + g * 8;
    f32x4 s[2][2];
#pragma unroll
    for (int u = 0; u < 2; ++u)
#pragma unroll
        for (int tt = 0; tt < 2; ++tt) s[u][tt] = (f32x4){0.f, 0.f, 0.f, 0.f};
    f32x4 r0[8], r1[8]; bf16x8 qf[2][2];
    stage_load(r0, kb, tid); stage_load(r1, kb + CD, tid);
#pragma unroll
    for (int u = 0; u < 2; ++u)
#pragma unroll
        for (int ks = 0; ks < 2; ++ks) qf[u][ks] = *(const bf16x8*)(q0 + (size_t)u * 16 * LD + ks * 32);
    stage_store(r0, lds, tid);
    WG_SYNC();
    stage_load(r0, kb + 2 * CD, tid);
#define ATS_SRC(cc) ((cc) < 8 ? kb + (cc) * CD : vb + ((cc) - 8) * CD)
#define ATS_SCORE(cc, REGN, REGF) do { LAS unsigned char* buf = lds + ((cc) & 1) * CBYTES; \
        _Pragma("unroll") for (int ks = 0; ks < 2; ++ks) _Pragma("unroll") for (int tt = 0; tt < 2; ++tt) { const bf16x8 a = *(const LAS bf16x8*)(buf + ((2 * wave + tt) * 16 + li) * PITCH + ks * 64 + g * 16); \
            s[0][tt] = __builtin_amdgcn_mfma_f32_16x16x32_bf16(a, qf[0][ks], s[0][tt], 0, 0, 0); s[1][tt] = __builtin_amdgcn_mfma_f32_16x16x32_bf16(a, qf[1][ks], s[1][tt], 0, 0, 0); } \
        if ((cc) < 7) { __builtin_amdgcn_sched_barrier(0); _Pragma("unroll") for (int u = 0; u < 2; ++u) _Pragma("unroll") for (int ks = 0; ks < 2; ++ks) qf[u][ks] = *(const bf16x8*)(q0 + (size_t)u * 16 * LD + ((cc) + 1) * CD + ks * 32); __builtin_amdgcn_sched_barrier(0); } \
        stage_store(REGN, lds + (((cc) + 1) & 1) * CBYTES, tid); WG_SYNC(); stage_load(REGF, ATS_SRC((cc) + 3), tid); } while (0)
    ATS_SCORE(0, r1, r1); ATS_SCORE(1, r0, r0); ATS_SCORE(2, r1, r1); ATS_SCORE(3, r0, r0); ATS_SCORE(4, r1, r1); ATS_SCORE(5, r0, r0); ATS_SCORE(6, r1, r1); ATS_SCORE(7, r0, r0);
    const float sc = 0.044194173824159216f * 1.4426950408889634f;
#pragma unroll
    for (int u = 0; u < 2; ++u) { float mx = fmaxf(fmaxf(fmaxf(s[u][0][0], s[u][0][1]), fmaxf(s[u][0][2], s[u][0][3])), fmaxf(fmaxf(s[u][1][0], s[u][1][1]), fmaxf(s[u][1][2], s[u][1][3])));
        mx = fmaxf(mx, __shfl_xor(mx, 16)); mx = fmaxf(mx, __shfl_xor(mx, 32));
        if (g == 0) smax[wave * 32 + u * 16 + li] = mx; }
    WG_SYNC();
#pragma unroll
    for (int u = 0; u < 2; ++u) { float mx = smax[u * 16 + li];
#pragma unroll
        for (int w = 1; w < 8; ++w) mx = fmaxf(mx, smax[w * 32 + u * 16 + li]);
        float sum = 0.f;
#pragma unroll
        for (int tt = 0; tt < 2; ++tt) {
#pragma unroll
            for (int j = 0; j < 4; ++j) { const float e = __builtin_amdgcn_exp2f((s[u][tt][j] - mx) * sc); s[u][tt][j] = e; sum += e; }
            u32x2 w2; w2.x = pg8::cvt_pk_bf16(s[u][tt][0], s[u][tt][1]); w2.y = pg8::cvt_pk_bf16(s[u][tt][2], s[u][tt][3]);
            *(LAS u32x2*)(Ps + (u * 16 + li) * PP + (32 * wave + 16 * tt + 4 * g) * 2) = w2; }
        sum += __shfl_xor(sum, 16); sum += __shfl_xor(sum, 32);
        if (g == 0) ssum[wave * 32 + u * 16 + li] = sum; }
    WG_SYNC();
    const int dt = wave & 3, uq = wave >> 2;
    float inv;
    { float sum = 0.f;
#pragma unroll
      for (int w = 0; w < 8; ++w) sum += ssum[w * 32 + uq * 16 + li];
      inv = 1.0f / sum; }
    bf16x8 pfr[8];
#pragma unroll
    for (int t = 0; t < 8; ++t) pfr[t] = *(const LAS bf16x8*)(Ps + (uq * 16 + li) * PP + (32 * t + 8 * g) * 2);
    const unsigned trb8 = (unsigned)(size_t)lds + (unsigned)((8 * g + (li >> 2)) * PITCH + (li & 3) * 8 + dt * 32);
#define ATS_PV(cc, REGN, REGF) do { const unsigned bofs = (unsigned)((cc) & 1) * CBYTES; f32x4 o = (f32x4){0.f, 0.f, 0.f, 0.f}; s16x4 lo[8], hi[8]; \
        _Pragma("unroll") for (int t = 0; t < 8; ++t) { lo[t] = tr_read(trb8 + bofs + (unsigned)(t * 32 * PITCH)); hi[t] = tr_read(trb8 + bofs + (unsigned)(t * 32 * PITCH + 4 * PITCH)); } \
        asm volatile("s_waitcnt lgkmcnt(0)" ::: "memory"); __builtin_amdgcn_sched_barrier(0); \
        _Pragma("unroll") for (int t = 0; t < 8; ++t) { const bf16x8 a = (bf16x8){lo[t][0], lo[t][1], lo[t][2], lo[t][3], hi[t][0], hi[t][1], hi[t][2], hi[t][3]}; o = __builtin_amdgcn_mfma_f32_16x16x32_bf16(a, pfr[t], o, 0, 0, 0); } \
        { u32x2 w2; w2.x = pg8::cvt_pk_bf16(o[0] * inv, o[1] * inv); w2.y = pg8::cvt_pk_bf16(o[2] * inv, o[3] * inv); \
          *(u32x2*)(AO + (size_t)(row0 + 16 * uq + li) * LD + head * HDIM + ((cc) - 8) * CD + dt * 16 + g * 4) = w2; } \
        if ((cc) < 15) stage_store(REGN, lds + (((cc) + 1) & 1) * CBYTES, tid); WG_SYNC(); if ((cc) + 3 < 16) stage_load(REGF, ATS_SRC((cc) + 3), tid); } while (0)
    ATS_PV(8, r1, r1); ATS_PV(9, r0, r0); ATS_PV(10, r1, r1); ATS_PV(11, r0, r0); ATS_PV(12, r1, r1); ATS_PV(13, r0, r0); ATS_PV(14, r1, r1); ATS_PV(15, r0, r0);
#undef ATS_SRC
#undef ATS_SCORE
#undef ATS_PV
}
__device__ __forceinline__ void attn_sample_phase(LAS unsigned char* lds, const Ptrs& p, int l, int tid, int first, int stride) {
    const bf16_t* Qg = wsb<C>(p, C::WS_Q); bf16_t* AO = wsb<C>(p, C::WS_AO);
    for (int s = first; s < C::DEC_BATCH * NH; s += stride) { const int b = s / NH, head = s % NH;
        attn_sample_unit(lds, Qg, AO, p.in[I_CK] + ((size_t)l * C::DEC_BATCH + b) * TOK * LD + head * HDIM, p.in[I_CV] + ((size_t)l * C::DEC_BATCH + b) * TOK * LD + head * HDIM, C::MP + b * C::DEC_SEQ, head, tid); }
}
__device__ __forceinline__ void attn_phase(LAS unsigned char* lds, const Ptrs& p, int l, int tid, int bid, int gsz, int nunits) {
    const int lane = tid & 63, wave = __builtin_amdgcn_readfirstlane(tid >> 6), li = lane & 15, g = lane >> 4;
    const bf16_t* Qg = wsb<C>(p, C::WS_Q); bf16_t* AO = wsb<C>(p, C::WS_AO);
    constexpr int NUP = (C::MP / 256) * NH;
    static_assert(C::SEQ % 256 == 0, "prompt units are 256 rows");
    for (int un0 = bid; un0 < nunits; un0 += gsz) {
        const int un = (NUP % 64 == 0) ? (un0 & ~63) + (un0 & 7) * 8 + ((un0 >> 3) & 7) : un0;
        const int per_b = (C::SEQ / 256) * NH, b = un / per_b, rem = un % per_b, head = rem / (C::SEQ / 256), row0 = b * C::SEQ + (rem % (C::SEQ / 256)) * 256;
        const bf16_t* kbb = wsb<C>(p, C::WS_KVB) + (size_t)b * TOK * LD + head * HDIM; const bf16_t* vbb = kbb + (size_t)C::MM * LD;
#define ATP_SRC(cc) ((cc) < 8 ? kbb + (cc) * CD : vbb + ((cc) - 8) * CD)
        const bf16_t* q0 = Qg + (size_t)(row0 + wave * 32 + li) * LD + head * HDIM + g * 8;
        f32x4 s[2][16];
#pragma unroll
        for (int u = 0; u < 2; ++u)
#pragma unroll
            for (int T = 0; T < 16; ++T) s[u][T] = (f32x4){0.f, 0.f, 0.f, 0.f};
        pg8::u32x4 w0[4], w1[4]; bf16x8 qf[2][2];
        stage_load_b(w0, ATP_SRC(0), tid); stage_load_b(w1, ATP_SRC(1), tid);
#pragma unroll
        for (int u = 0; u < 2; ++u)
#pragma unroll
            for (int ks = 0; ks < 2; ++ks) qf[u][ks] = *(const bf16x8*)(q0 + (size_t)u * 16 * LD + ks * 32);
        stage_store_kb(w0, lds, tid);
        WG_SYNC();
        stage_load_b(w0, ATP_SRC(2), tid);
        const int aoff = (li * 64 + g * 16) ^ ((li >> 3) << 5);
#define ATP_KS(ks) do { _Pragma("unroll") for (int T0 = 0; T0 < 16; T0 += 2) { bf16x8 af[2]; \
            _Pragma("unroll") for (int j = 0; j < 2; ++j) af[j] = *(const LAS bf16x8*)(buf + ((T0 + j) * 2 + (ks)) * 1024 + aoff); \
            asm volatile("s_waitcnt lgkmcnt(0)" ::: "memory"); __builtin_amdgcn_sched_barrier(0); \
            _Pragma("unroll") for (int j = 0; j < 2; ++j) { s[0][T0 + j] = __builtin_amdgcn_mfma_f32_16x16x32_bf16(af[j], qf[0][ks], s[0][T0 + j], 0, 0, 0); \
                s[1][T0 + j] = __builtin_amdgcn_mfma_f32_16x16x32_bf16(af[j], qf[1][ks], s[1][T0 + j], 0, 0, 0); } \
            __builtin_amdgcn_sched_barrier(0); } } while (0)
#define ATP_SITER(cc, WN) do { LAS unsigned char* buf = lds + ((cc) & 1) * CBYTES; \
            ATP_KS(0); ATP_KS(1); \
            if ((cc) < 7) { __builtin_amdgcn_sched_barrier(0); _Pragma("unroll") for (int u = 0; u < 2; ++u) _Pragma("unroll") for (int ks = 0; ks < 2; ++ks) qf[u][ks] = *(const bf16x8*)(q0 + (size_t)u * 16 * LD + ((cc) + 1) * CD + ks * 32); \
                __builtin_amdgcn_sched_barrier(0); stage_store_kb(WN, lds + (((cc) + 1) & 1) * CBYTES, tid); } \
            else stage_store_vb(WN, lds + (((cc) + 1) & 1) * CBYTES, tid); \
            WG_SYNC(); stage_load_b(WN, ATP_SRC((cc) + 3), tid); } while (0)
#pragma unroll 1
        for (int c2 = 0; c2 < 8; c2 += 2) { ATP_SITER(c2, w1); ATP_SITER(c2 + 1, w0); }
#undef ATP_SITER
#undef ATP_KS
        const float sc = 0.044194173824159216f * 1.4426950408889634f;
        float inv[2]; bf16x8 pf[2][8];
#pragma unroll
        for (int u = 0; u < 2; ++u) {
            float mx = -3.0e38f;
#pragma unroll
            for (int T = 0; T < 16; ++T) mx = fmaxf(mx, fmaxf(fmaxf(s[u][T][0], s[u][T][1]), fmaxf(s[u][T][2], s[u][T][3])));
            mx = fmaxf(mx, __shfl_xor(mx, 16)); mx = fmaxf(mx, __shfl_xor(mx, 32));
            float sum = 0.f;
#pragma unroll
            for (int T = 0; T < 16; ++T)
#pragma unroll
                for (int j = 0; j < 4; ++j) { const float e = __builtin_amdgcn_exp2f((s[u][T][j] - mx) * sc); s[u][T][j] = e; sum += e; }
            sum += __shfl_xor(sum, 16); sum += __shfl_xor(sum, 32);
            inv[u] = 1.0f / sum;
#pragma unroll
            for (int t = 0; t < 8; ++t) { pg8::u32x4 w; w.x = pg8::cvt_pk_bf16(s[u][2 * t][0], s[u][2 * t][1]); w.y = pg8::cvt_pk_bf16(s[u][2 * t][2], s[u][2 * t][3]);
                w.z = pg8::cvt_pk_bf16(s[u][2 * t + 1][0], s[u][2 * t + 1][1]); w.w = pg8::cvt_pk_bf16(s[u][2 * t + 1][2], s[u][2 * t + 1][3]); pf[u][t] = __builtin_bit_cast(bf16x8, w); }
        }
        const unsigned trb = (unsigned)(size_t)lds + (unsigned)((4 * g + (li >> 2)) * PITCH + (li & 3) * 8);
#define ATP_VITER(c, WN) do { unsigned bofs = (unsigned)((c) & 1) * CBYTES; asm volatile("" : "+v"(bofs));        \
            { f32x4 o[2][4]; \
              _Pragma("unroll") for (int u = 0; u < 2; ++u) _Pragma("unroll") for (int dt = 0; dt < 4; ++dt) o[u][dt] = (f32x4){0.f, 0.f, 0.f, 0.f}; \
              _Pragma("unroll") for (int t = 0; t < 8; ++t) { s16x4 lo[4], hi[4]; \
                _Pragma("unroll") for (int dt = 0; dt < 4; ++dt) { lo[dt] = tr_read(trb + bofs + (unsigned)(t * 32 * PITCH + dt * 32)); hi[dt] = tr_read(trb + bofs + (unsigned)(t * 32 * PITCH + 16 * PITCH + dt * 32)); } \
                asm volatile("s_waitcnt lgkmcnt(0)" ::: "memory"); __builtin_amdgcn_sched_barrier(0); \
                _Pragma("unroll") for (int dt = 0; dt < 4; ++dt) { const bf16x8 a = (bf16x8){lo[dt][0], lo[dt][1], lo[dt][2], lo[dt][3], hi[dt][0], hi[dt][1], hi[dt][2], hi[dt][3]}; \
                    o[0][dt] = __builtin_amdgcn_mfma_f32_16x16x32_bf16(a, pf[0][t], o[0][dt], 0, 0, 0); \
                    o[1][dt] = __builtin_amdgcn_mfma_f32_16x16x32_bf16(a, pf[1][t], o[1][dt], 0, 0, 0); } } \
              _Pragma("unroll") for (int u = 0; u < 2; ++u) _Pragma("unroll") for (int dt = 0; dt < 4; ++dt) { u32x2 w; w.x = pg8::cvt_pk_bf16(o[u][dt][0] * inv[u], o[u][dt][1] * inv[u]); w.y = pg8::cvt_pk_bf16(o[u][dt][2] * inv[u], o[u][dt][3] * inv[u]); \
                    *(u32x2*)(AO + (size_t)(row0 + wave * 32 + 16 * u + li) * LD + head * HDIM + (c) * CD + dt * 16 + g * 4) = w; } } \
            if ((c) < 7) stage_store_vb(WN, lds + (((c) + 1) & 1) * CBYTES, tid); \
            WG_SYNC(); if ((c) < 5) stage_load_b(WN, ATP_SRC((c) + 11), tid); } while (0)
#pragma unroll 1
        for (int c2 = 0; c2 < 8; c2 += 2) { ATP_VITER(c2, w1); ATP_VITER(c2 + 1, w0); }
#undef ATP_VITER
#undef ATP_SRC
    }
}
}
namespace mx {
typedef att::bf16x8 bf16x8; typedef att::s16x4 s16x4; typedef att::f32x4 f32x4; typedef att::u32x2 u32x2;
constexpr int PT = 272;
constexpr int T64 = 64 * PT, T128 = 128 * PT;
static_assert(C::MHD == 128 && C::CH == 64 && C::MH == 8 && C::LCS == 32, "mLSTM phases are built for these shapes");
__device__ __forceinline__ void lds_wait() { asm volatile("s_waitcnt lgkmcnt(0)" ::: "memory"); __builtin_amdgcn_sched_barrier(0); }
__device__ __forceinline__ bf16x8 mk8(s16x4 lo, s16x4 hi) { return (bf16x8){lo[0], lo[1], lo[2], lo[3], hi[0], hi[1], hi[2], hi[3]}; }
__device__ __forceinline__ unsigned tr_addr(unsigned tile, int krow, int c0, int li) { return tile + (unsigned)((krow + (li >> 2)) * PT + (c0 + 4 * (li & 3)) * 2); }
__device__ __forceinline__ void ch_decode(int ci, int& r0, int& h, int& lc) {
    if (ci < C::NPC) { const int c = ci % C::NC, bh = ci / C::NC; h = bh % C::MH; r0 = (bh / C::MH) * C::SEQ + c * C::CH; lc = C::CH; }
    else { const int q = ci - C::NPC; h = q % C::MH; r0 = C::MP + (q / C::MH) * C::DEC_SEQ; lc = C::LCS; }
}
__device__ __forceinline__ void stage64(LAS unsigned char* tile, const float* src, int ld, int lc, int tid, const LAS float* rs, float mul) {
#pragma unroll
    for (int i = 0; i < 4; ++i) { const int f = tid + 512 * i, row = f >> 5, c4 = f & 31; f32x4 v = (f32x4){0.f, 0.f, 0.f, 0.f};
        if (row < lc) { v = *(const f32x4*)(src + (size_t)row * ld + c4 * 4); const float m = rs ? rs[row] * mul : mul; v = v * m; }
        u32x2 w; w.x = pg8::cvt_pk_bf16(v[0], v[1]); w.y = pg8::cvt_pk_bf16(v[2], v[3]); *(LAS u32x2*)(tile + row * PT + c4 * 8) = w; }
}
__device__ __forceinline__ void ml_phase_a(LAS unsigned char* lds, const Ptrs& p, int l, int tid, int bid, int gsz) {
    const int lane = tid & 63, wave = __builtin_amdgcn_readfirstlane(tid >> 6), li = lane & 15, g = lane >> 4;
    LAS unsigned char* Ks = lds; LAS unsigned char* Vs = lds + T64; LAS float* wts = (LAS float*)(lds + 2 * T64);
    const float* P = wsf<C>(p, C::WS_BIG);
    for (int ci = bid; ci < C::NCH; ci += gsz) {
        int r0, h, lc; ch_decode(ci, r0, h, lc);
        if (wave == 0) {
            float lf = 0.f, ig = -3.0e38f;
            if (lane < lc) { const float* pr = P + (size_t)(r0 + lane) * C::LDP; ig = pr[C::O_IG + h] + p.in[I_IB][l * C::MH + h]; const float fx = pr[C::O_FG + h] + p.in[I_FB][l * C::MH + h]; lf = fx >= 0.f ? -__logf(1.0f + __expf(-fx)) : fx - __logf(1.0f + __expf(fx)); }
            float b = lf;
#pragma unroll
            for (int o = 1; o < 64; o <<= 1) { const float t = __shfl_up(b, o); if (lane >= o) b += t; }
            const float a = lane < lc ? ig - b : -3.0e38f;
            float amax = a;
#pragma unroll
            for (int o = 1; o < 64; o <<= 1) amax = fmaxf(amax, __shfl_xor(amax, o));
            const float bL = __shfl(b, lc - 1), mloc = bL + amax;
            const float wt = lane < lc ? __expf(bL + a - mloc) : 0.f;
            wts[lane] = wt;
            if (lane < lc) { wsf<C>(p, C::WS_GB)[(size_t)(r0 + lane) * C::MH + h] = b; wsf<C>(p, C::WS_GA)[(size_t)(r0 + lane) * C::MH + h] = a; }
            if (lane == 0) { wsf<C>(p, C::WS_CBL)[ci] = bL; wsf<C>(p, C::WS_CML)[ci] = mloc; }
        }
        __syncthreads();
        stage64(Ks, P + (size_t)r0 * C::LDP + C::O_K + h * C::MHD, C::LDP, lc, tid, wts, 0.08838834764831845f);
        stage64(Vs, P + (size_t)r0 * C::LDP + C::O_VM + h * C::MHD, C::LDP, lc, tid, nullptr, 1.0f);
        __syncthreads();
        f32x4 acc[8];
#pragma unroll
        for (int et = 0; et < 8; ++et) acc[et] = (f32x4){0.f, 0.f, 0.f, 0.f};
        const unsigned ks = (unsigned)(size_t)Ks, vs = (unsigned)(size_t)Vs;
#pragma unroll
        for (int t = 0; t < 2; ++t) {
            const s16x4 alo = att::tr_read(tr_addr(ks, 32 * t + 8 * g, 16 * wave, li)), ahi = att::tr_read(tr_addr(ks, 32 * t + 8 * g + 4, 16 * wave, li));
            s16x4 blo[8], bhi[8];
#pragma unroll
            for (int et = 0; et < 8; ++et) { blo[et] = att::tr_read(tr_addr(vs, 32 * t + 8 * g, 16 * et, li)); bhi[et] = att::tr_read(tr_addr(vs, 32 * t + 8 * g + 4, 16 * et, li)); }
            lds_wait();
            const bf16x8 a = mk8(alo, ahi);
#pragma unroll
            for (int et = 0; et < 8; ++et) acc[et] = __builtin_amdgcn_mfma_f32_16x16x32_bf16(a, mk8(blo[et], bhi[et]), acc[et], 0, 0, 0);
        }
        float* DC = wsf<C>(p, C::WS_DC) + (size_t)ci * C::MHD * C::MHD;
#pragma unroll
        for (int et = 0; et < 8; ++et)
#pragma unroll
            for (int r = 0; r < 4; ++r) DC[(size_t)(16 * wave + 4 * g + r) * C::MHD + 16 * et + li] = acc[et][r];
        if (tid < C::MHD) { float s = 0.f; for (int t = 0; t < 64; ++t) s += bf2f(*(const LAS bf16_t*)(Ks + t * PT + tid * 2)); wsf<C>(p, C::WS_DN)[(size_t)ci * C::MHD + tid] = s; }
        __syncthreads();
    }
}
__device__ __forceinline__ void ml_phase_c(LAS unsigned char* lds, const Ptrs& p, int l, int tid, int bid, int gsz) {
    const int lane = tid & 63, wave = __builtin_amdgcn_readfirstlane(tid >> 6), li = lane & 15, g = lane >> 4, it = wave & 3, eh = wave >> 2;
    LAS unsigned char* Qs = lds; LAS unsigned char* Ks = lds + T64; LAS unsigned char* Vs = lds + 2 * T64; LAS unsigned char* Cs = lds + 3 * T64;
    LAS float* sb = (LAS float*)(lds + 3 * T64 + T128);
    LAS float* sa = sb + 64; LAS float* smr = sb + 128; LAS float* siw = sb + 192; LAS float* snp = sb + 256; LAS float* ssq = sb + 384;
    const float* P = wsf<C>(p, C::WS_BIG);
    for (int ci = bid; ci < C::NCH; ci += gsz) {
        int r0, h, lc; ch_decode(ci, r0, h, lc);
        const bool sample = ci >= C::NPC, first = !sample && (ci % C::NC) == 0;
        const float mprev = wsf<C>(p, C::WS_MPREV)[ci];
        if (wave == 0) {
            float b = 0.f, a = -3.0e38f;
            if (lane < lc) { b = wsf<C>(p, C::WS_GB)[(size_t)(r0 + lane) * C::MH + h]; a = wsf<C>(p, C::WS_GA)[(size_t)(r0 + lane) * C::MH + h]; }
            float pm = a;
#pragma unroll
            for (int o = 1; o < 64; o <<= 1) { const float t = __shfl_up(pm, o); if (lane >= o) pm = fmaxf(pm, t); }
            const float mrow = b + fmaxf(mprev, pm);
            sb[lane] = b; sa[lane] = a; smr[lane] = mrow; siw[lane] = __expf(b + mprev - mrow);
        }
        if (tid >= 128 && tid < 256) { const int d = tid - 128;
            snp[d] = sample ? p.in[I_SN][((size_t)l * C::NSC + (ci - C::NPC)) * C::MHD + d] : (first ? 0.f : wsf<C>(p, C::WS_DN)[(size_t)(ci - 1) * C::MHD + d]); }
        stage64(Qs, P + (size_t)r0 * C::LDP + C::O_Q + h * C::MHD, C::LDP, lc, tid, nullptr, 1.0f);
        stage64(Ks, P + (size_t)r0 * C::LDP + C::O_K + h * C::MHD, C::LDP, lc, tid, nullptr, 0.08838834764831845f);
        stage64(Vs, P + (size_t)r0 * C::LDP + C::O_VM + h * C::MHD, C::LDP, lc, tid, nullptr, 1.0f);
        { const float* cp = sample ? p.in[I_SC] + ((size_t)l * C::NSC + (ci - C::NPC)) * C::MHD * C::MHD : wsf<C>(p, C::WS_DC) + (size_t)(first ? ci : ci - 1) * C::MHD * C::MHD;
#pragma unroll
            for (int i = 0; i < 8; ++i) { const int f = tid + 512 * i, row = f >> 5, c4 = f & 31; f32x4 v = (f32x4){0.f, 0.f, 0.f, 0.f};
                if (!first) v = *(const f32x4*)(cp + (size_t)row * C::MHD + c4 * 4);
                u32x2 w; w.x = pg8::cvt_pk_bf16(v[0], v[1]); w.y = pg8::cvt_pk_bf16(v[2], v[3]); *(LAS u32x2*)(Cs + row * PT + c4 * 8) = w; } }
        __syncthreads();
        const bool active = it * 16 < lc;
        float ssq_part = 0.f; f32x4 hv[4]; float inv_den = 0.f;
        const int i = 16 * it + li;
        if (active) {
            bf16x8 qf[4];
#pragma unroll
            for (int ks = 0; ks < 4; ++ks) qf[ks] = *(const LAS bf16x8*)(Qs + i * PT + ks * 64 + g * 16);
            f32x4 st[4];
#pragma unroll
            for (int jt = 0; jt < 4; ++jt) st[jt] = (f32x4){0.f, 0.f, 0.f, 0.f};
#pragma unroll
            for (int jt = 0; jt < 4; ++jt) if (jt <= it) {
#pragma unroll
                for (int ks = 0; ks < 4; ++ks) { const bf16x8 a = *(const LAS bf16x8*)(Ks + (16 * jt + li) * PT + ks * 64 + g * 16);
                    st[jt] = __builtin_amdgcn_mfma_f32_16x16x32_bf16(a, qf[ks], st[jt], 0, 0, 0); } }
            const float bi = sb[i], mri = smr[i], iwi = siw[i];
            float dsum = 0.f;
#pragma unroll
            for (int jt = 0; jt < 4; ++jt)
#pragma unroll
                for (int r = 0; r < 4; ++r) { const int j = 16 * jt + 4 * g + r; const float w = (j <= i) ? __expf(bi + sa[j] - mri) : 0.f; st[jt][r] *= w; dsum += st[jt][r]; }
            dsum += __shfl_xor(dsum, 16); dsum += __shfl_xor(dsum, 32);
            float qn = 0.f;
#pragma unroll
            for (int ks = 0; ks < 4; ++ks)
#pragma unroll
                for (int jj = 0; jj < 8; ++jj) qn += bf2f((bf16_t)qf[ks][jj]) * snp[32 * ks + 8 * g + jj];
            qn += __shfl_xor(qn, 16); qn += __shfl_xor(qn, 32);
            const float den = dsum + iwi * qn;
            inv_den = 1.0f / fmaxf(fabsf(den), __expf(-mri));
            bf16x8 pf[2];
#pragma unroll
            for (int t = 0; t < 2; ++t) { pg8::u32x4 w; w.x = pg8::cvt_pk_bf16(st[2 * t][0], st[2 * t][1]); w.y = pg8::cvt_pk_bf16(st[2 * t][2], st[2 * t][3]);
                w.z = pg8::cvt_pk_bf16(st[2 * t + 1][0], st[2 * t + 1][1]); w.w = pg8::cvt_pk_bf16(st[2 * t + 1][2], st[2 * t + 1][3]); pf[t] = __builtin_bit_cast(bf16x8, w); }
            const unsigned vs = (unsigned)(size_t)Vs, cs = (unsigned)(size_t)Cs;
#pragma unroll
            for (int e4 = 0; e4 < 4; ++e4) { const int et = 4 * eh + e4;
                s16x4 vlo[2], vhi[2], clo[4], chi[4];
#pragma unroll
                for (int t = 0; t < 2; ++t) { vlo[t] = att::tr_read(tr_addr(vs, 32 * t + 4 * g, 16 * et, li)); vhi[t] = att::tr_read(tr_addr(vs, 32 * t + 16 + 4 * g, 16 * et, li)); }
#pragma unroll
                for (int ks = 0; ks < 4; ++ks) { clo[ks] = att::tr_read(tr_addr(cs, 32 * ks + 8 * g, 16 * et, li)); chi[ks] = att::tr_read(tr_addr(cs, 32 * ks + 8 * g + 4, 16 * et, li)); }
                lds_wait();
                f32x4 aS = (f32x4){0.f, 0.f, 0.f, 0.f}, aC = (f32x4){0.f, 0.f, 0.f, 0.f};
#pragma unroll
                for (int t = 0; t < 2; ++t) aS = __builtin_amdgcn_mfma_f32_16x16x32_bf16(mk8(vlo[t], vhi[t]), pf[t], aS, 0, 0, 0);
#pragma unroll
                for (int ks = 0; ks < 4; ++ks) aC = __builtin_amdgcn_mfma_f32_16x16x32_bf16(mk8(clo[ks], chi[ks]), qf[ks], aC, 0, 0, 0);
                hv[e4] = (aS + aC * iwi) * inv_den;
                ssq_part += (hv[e4][0] * hv[e4][0] + hv[e4][1] * hv[e4][1]) + (hv[e4][2] * hv[e4][2] + hv[e4][3] * hv[e4][3]); }
            ssq_part += __shfl_xor(ssq_part, 16); ssq_part += __shfl_xor(ssq_part, 32);
            if (g == 0) ssq[wave * 16 + li] = ssq_part;
        }
        __syncthreads();
        if (active) {
            const float tot = ssq_part + ssq[(wave ^ 4) * 16 + li];
            const float rs = rsqrtf(tot * (1.0f / C::MHD) + 1e-6f);
            const int row = r0 + i;
#pragma unroll
            for (int e4 = 0; e4 < 4; ++e4) { const int e = 16 * (4 * eh + e4) + 4 * g;
                const f32x4 og = *(const f32x4*)(P + (size_t)row * C::LDP + C::O_O + h * C::MHD + e); const f32x4 gn = *(const f32x4*)(p.in[I_NG] + (size_t)l * C::MW + h * C::MHD + e);
                float o4[4];
#pragma unroll
                for (int r = 0; r < 4; ++r) o4[r] = hv[e4][r] * rs * gn[r] * __builtin_amdgcn_rcpf(1.0f + __expf(-og[r]));
                u32x2 w; w.x = pg8::cvt_pk_bf16(o4[0], o4[1]); w.y = pg8::cvt_pk_bf16(o4[2], o4[3]);
                *(u32x2*)(wsb<C>(p, C::WS_MIX) + (size_t)row * C::D + C::PW + C::GW + h * C::MHD + e) = w; }
        }
        __syncthreads();
    }
}
}
namespace rw {
typedef att::f32x4 f32x4; typedef att::u32x2 u32x2;
static_assert(C::D == 2048, "row ops assume 2048 columns = 8 float4 per lane");
__device__ __forceinline__ float wave_sum(float v) {
#pragma unroll
    for (int o = 1; o < 64; o <<= 1) v += __shfl_xor(v, o);
    return v;
}
__device__ __forceinline__ void rows_init(const Ptrs& p, int tid, int bid, int gsz) {
    const int lane = tid & 63, gw = bid * NWAVES + (tid >> 6), NGW = gsz * NWAVES;
    float* SS = wsf<C>(p, C::WS_SS);
    for (int r = gw; r < C::M; r += NGW) {
        const float* src = r < C::MP ? p.in[I_XP] + (size_t)r * C::D : p.in[I_XS] + (size_t)(r - C::MP) * C::D;
        float* X = wsf<C>(p, C::WS_X) + (size_t)r * C::D; bf16_t* XB = wsb<C>(p, C::WS_XB) + (size_t)r * C::D;
        float ss = 0.f;
#pragma unroll
        for (int j = 0; j < 8; ++j) { const f32x4 v = *(const f32x4*)(src + (lane + 64 * j) * 4); *(f32x4*)(X + (lane + 64 * j) * 4) = v;
            u32x2 w; w.x = pg8::cvt_pk_bf16(v[0], v[1]); w.y = pg8::cvt_pk_bf16(v[2], v[3]); *(u32x2*)(XB + (lane + 64 * j) * 4) = w;
            ss += (v[0] * v[0] + v[1] * v[1]) + (v[2] * v[2] + v[3] * v[3]); }
        ss = wave_sum(ss);
        if (lane < C::NSS) SS[(size_t)lane * C::M + r] = lane == 0 ? ss : 0.f;
    }
    for (int r = gw; r < C::MM; r += NGW) {
        const float* src = p.in[I_MEM] + (size_t)r * C::D; bf16_t* MB = wsb<C>(p, C::WS_MEMB) + (size_t)r * C::D;
        float ss = 0.f;
#pragma unroll
        for (int j = 0; j < 8; ++j) { const f32x4 v = *(const f32x4*)(src + (lane + 64 * j) * 4);
            u32x2 w; w.x = pg8::cvt_pk_bf16(v[0], v[1]); w.y = pg8::cvt_pk_bf16(v[2], v[3]); *(u32x2*)(MB + (lane + 64 * j) * 4) = w;
            ss += (v[0] * v[0] + v[1] * v[1]) + (v[2] * v[2] + v[3] * v[3]); }
        ss = wave_sum(ss);
        if (lane == 0) wsf<C>(p, C::WS_RSTDM)[r] = rsqrtf(ss * (1.0f / C::D) + 1e-6f);
    }
}
__device__ __forceinline__ void rows_final(const Ptrs& p, int tid, int bid, int gsz) {
    const int lane = tid & 63, gw = bid * NWAVES + (tid >> 6), NGW = gsz * NWAVES;
    for (int r = gw; r < C::M; r += NGW) {
        const float* X = wsf<C>(p, C::WS_X) + (size_t)r * C::D; const float rs = rsqrtf(wsf<C>(p, C::WS_SS)[(size_t)(C::NSS - 1) * C::M + r] * (1.0f / C::D) + 1e-6f);
        float* o = r < C::MP ? p.out + C::OUT_YP + (size_t)r * C::D : p.out + C::OUT_YS + (size_t)(r - C::MP) * C::D;
        float pscale = 1.0f, padd = 0.f;
#if defined(PROBE_MASK_A)
        { const unsigned long long* TS = (const unsigned long long*)(p.ws + C::WS_CTL + 32768); unsigned long long ta = 0, tb = 0;
          for (int k = 0; k < 25; ++k) { const unsigned long long dk = TS[k + 1] - TS[k]; if ((PROBE_MASK_A >> k) & 1ull) ta += dk; if ((PROBE_MASK_B >> k) & 1ull) tb += dk; }
#if defined(PROBE_MLT)
          ta = TS[48 + PROBE_MLT];
#endif
#if defined(PROBE_GST)
          { const unsigned long long* st = (const unsigned long long*)(p.ws + C::WS_END); unsigned long long epi = 0; for (int u2 = 0; u2 < 8; ++u2) epi += st[3 + 2 * u2] - st[2 + 2 * u2];
            const unsigned long long tot = st[18] - st[0], fill = st[1] - st[0];
            ta = (unsigned long long)(1.0e6 * (double)(PROBE_GST == 1 ? epi : fill) / (double)tot); }
#endif
#if defined(PROBE_MLC)
          ta = TS[48 + PROBE_MLC];
#endif
#if defined(PROBE_ATT)
          ta = 0; for (int l2 = 0; l2 < 2; ++l2) { const int k = 1 + 12 * l2 + 8; ta += (PROBE_ATT == 1) ? TS[44 + l2] - TS[k] : TS[k + 1] - TS[44 + l2]; }
#endif
#if defined(PROBE_SCN)
          ta = 0; for (int l2 = 0; l2 < 2; ++l2) { const int k = 1 + 12 * l2 + 4; ta += (PROBE_SCN == 1) ? TS[44 + l2] - TS[k] : TS[k + 1] - TS[44 + l2]; }
#endif
#if defined(PROBE_MIXA)
          ta = 0; for (int l2 = 0; l2 < 2; ++l2) { const int k = 1 + 12 * l2 + 3; ta += (PROBE_MIXA == 1) ? TS[40 + l2] - TS[k] : (PROBE_MIXA == 2) ? TS[42 + l2] - TS[40 + l2] : TS[k + 1] - TS[42 + l2]; }
#endif
#if defined(PROBE_SPLIT_MODE)
          ta = 0; for (int l2 = 0; l2 < 2; ++l2) { const int k = 1 + 10 * l2 + 3; ta += (PROBE_SPLIT_MODE == 1) ? TS[40 + l2] - TS[k] : TS[k + 1] - TS[40 + l2]; }
#endif
          if (r >= C::MP) pscale = 1.0f + 0.03f + (float)ta * 0.01f * PROBE_SA;
          if (r == 0 && lane == 0) padd = 1.0f + (float)tb * 0.01f * PROBE_SB; }
#endif
#pragma unroll
        for (int j = 0; j < 8; ++j) { const f32x4 v = *(const f32x4*)(X + (lane + 64 * j) * 4); const f32x4 gg = *(const f32x4*)(p.in[I_GFIN] + (lane + 64 * j) * 4);
            f32x4 y = v * rs * gg * pscale; if (j == 0) y[0] += padd; *(f32x4*)(o + (lane + 64 * j) * 4) = y; }
    }
}
__device__ __forceinline__ void ml_scan(const Ptrs& p, int l, long gtid, long gthreads) {
    const float* CBL = wsf<C>(p, C::WS_CBL); const float* CML = wsf<C>(p, C::WS_CML);
    float* DC = wsf<C>(p, C::WS_DC); float* DN = wsf<C>(p, C::WS_DN);
    constexpr int NPS = C::BATCH * C::MH, E4 = C::MHD / 4;
    for (long it = gtid; it < (long)NPS * C::MHD * E4; it += gthreads) {
        const int e4 = (int)(it % E4), d = (int)((it / E4) % C::MHD), sq = (int)(it / ((long)E4 * C::MHD));
        float m = 0.f; f32x4 cst = (f32x4){0.f, 0.f, 0.f, 0.f};
        static_assert(C::NC % 8 == 0, "scan is unrolled by 8 chunks");
        for (int c0 = 0; c0 < C::NC; c0 += 8) {
            f32x4 v[8]; float bl[8], ml[8];
#pragma unroll
            for (int j = 0; j < 8; ++j) { const int ci = sq * C::NC + c0 + j; v[j] = *(const f32x4*)(DC + ((size_t)ci * C::MHD + d) * C::MHD + e4 * 4); bl[j] = CBL[ci]; ml[j] = CML[ci]; }
#pragma unroll
            for (int j = 0; j < 8; ++j) { const int ci = sq * C::NC + c0 + j; const float a = bl[j] + m, mn = fmaxf(a, ml[j]), dec = __expf(a - mn), f = __expf(ml[j] - mn);
                cst = cst * dec + v[j] * f; *(f32x4*)(DC + ((size_t)ci * C::MHD + d) * C::MHD + e4 * 4) = cst; m = mn; }
        }
        *(f32x4*)(p.out + C::OUT_CP + (((size_t)l * NPS + sq) * C::MHD + d) * C::MHD + e4 * 4) = cst;
    }
    for (long it = gtid; it < (long)NPS * C::MHD; it += gthreads) {
        const int d = (int)(it % C::MHD), sq = (int)(it / C::MHD);
        float m = 0.f, nst = 0.f;
        for (int c = 0; c < C::NC; ++c) { const int ci = sq * C::NC + c; const float a = CBL[ci] + m, b2 = CML[ci], mn = fmaxf(a, b2), dec = __expf(a - mn), f = __expf(b2 - mn);
            const size_t on = (size_t)ci * C::MHD + d; nst = dec * nst + f * DN[on]; DN[on] = nst; m = mn; }
        p.out[C::OUT_NP + ((size_t)l * NPS + sq) * C::MHD + d] = nst;
    }
    for (long it = gtid; it < (long)C::NSC * C::MHD * E4; it += gthreads) {
        const int e4 = (int)(it % E4), d = (int)((it / E4) % C::MHD), q = (int)(it / ((long)E4 * C::MHD)), ci = C::NPC + q;
        const float m0 = p.in[I_SM][(size_t)l * C::NSC + q], a = CBL[ci] + m0, b2 = CML[ci], mn = fmaxf(a, b2), dec = __expf(a - mn), f = __expf(b2 - mn);
        const size_t so = (((size_t)l * C::NSC + q) * C::MHD + d) * C::MHD + e4 * 4;
        *(f32x4*)(p.out + C::OUT_CS + so) = *(const f32x4*)(p.in[I_SC] + so) * dec + *(const f32x4*)(DC + ((size_t)ci * C::MHD + d) * C::MHD + e4 * 4) * f;
    }
    for (long it = gtid; it < (long)C::NSC * C::MHD; it += gthreads) {
        const int d = (int)(it % C::MHD), q = (int)(it / C::MHD), ci = C::NPC + q;
        const float m0 = p.in[I_SM][(size_t)l * C::NSC + q], a = CBL[ci] + m0, b2 = CML[ci], mn = fmaxf(a, b2), dec = __expf(a - mn), f = __expf(b2 - mn);
        const size_t no = ((size_t)l * C::NSC + q) * C::MHD + d;
        p.out[C::OUT_NS + no] = dec * p.in[I_SN][no] + f * DN[(size_t)ci * C::MHD + d];
    }
}
}

namespace gp {
typedef att::bf16x8 bf16x8; typedef att::s16x4 s16x4; typedef att::f32x4 f32x4; typedef att::u32x2 u32x2;
constexpr int PT = mx::PT, T128 = mx::T128;
static_assert(C::GHD == 128 && C::PGD == 128 && C::GCH == 128 && C::SEQ % 128 == 0 && C::DEC_SEQ == 32 && C::PH == 15, "gmlp / pool phases are built for these shapes");
constexpr int NT_P = C::MP / 128;
constexpr int NU_G = NT_P * 4 + C::DEC_BATCH * 4;
__device__ __forceinline__ void gmlp_phase(LAS unsigned char* lds, const Ptrs& p, int l, int tid, int bid, int gsz) {
    const int lane = tid & 63, wave = __builtin_amdgcn_readfirstlane(tid >> 6), li = lane & 15, g = lane >> 4;
    LAS unsigned char* Vs = lds; LAS unsigned char* Ws = lds + T128;
    const float* P = wsf<C>(p, C::WS_BIG);
    for (int u = bid; u < NU_G; u += gsz) {
        int r0, lc, h; bool sample = false; int sb = 0;
        if (u < NT_P * 4) { h = u & 3; r0 = (u >> 2) * 128; lc = 128; } else { const int s = u - NT_P * 4; h = s & 3; sb = s >> 2; r0 = C::MP + sb * C::DEC_SEQ; lc = C::DEC_SEQ; sample = true; }
#pragma unroll
        for (int i = 0; i < 8; ++i) { const int f = tid + 512 * i, row = f >> 5, c4 = f & 31; f32x4 v = (f32x4){0.f, 0.f, 0.f, 0.f};
            if (row < lc) v = *(const f32x4*)(P + (size_t)(r0 + row) * C::LDP + C::O_V + h * 128 + c4 * 4);
            float ss = (v[0] * v[0] + v[1] * v[1]) + (v[2] * v[2] + v[3] * v[3]);
#pragma unroll
            for (int o = 1; o < 32; o <<= 1) ss += __shfl_xor(ss, o);
            const float rs = rsqrtf(ss * (1.0f / 128) + 1e-6f); const f32x4 gn = *(const f32x4*)(p.in[I_GVG] + (size_t)l * C::GW + h * 128 + c4 * 4);
            v = v * rs * gn;
            if (sample && row < lc) *(f32x4*)(p.out + C::OUT_VS + (((size_t)l * C::DEC_BATCH + sb) * C::DEC_SEQ + row) * C::GW + h * 128 + c4 * 4) = v;
            u32x2 w; w.x = pg8::cvt_pk_bf16(v[0], v[1]); w.y = pg8::cvt_pk_bf16(v[2], v[3]); *(LAS u32x2*)(Vs + row * PT + c4 * 8) = w; }
        const float* wsrc = p.in[I_GWS] + ((size_t)l * C::GH + h) * 128 * 128;
#pragma unroll
        for (int i = 0; i < 8; ++i) { const int f = tid + 512 * i, row = f >> 5, c4 = f & 31; f32x4 v = *(const f32x4*)(wsrc + (size_t)row * 128 + c4 * 4);
#pragma unroll
            for (int j = 0; j < 4; ++j) if (c4 * 4 + j > row) v[j] = 0.f;
            u32x2 w; w.x = pg8::cvt_pk_bf16(v[0], v[1]); w.y = pg8::cvt_pk_bf16(v[2], v[3]); *(LAS u32x2*)(Ws + row * PT + c4 * 8) = w; }
        WG_SYNC();
        if (wave * 16 < lc) {
            const int i = wave * 16 + li, nks = (wave * 16 + 15) / 32 + 1;
            f32x4 acc[8];
#pragma unroll
            for (int dt = 0; dt < 8; ++dt) acc[dt] = (f32x4){0.f, 0.f, 0.f, 0.f};
            const unsigned vs = (unsigned)(size_t)Vs;
            for (int ks = 0; ks < nks; ++ks) {
                const bf16x8 bq = *(const LAS bf16x8*)(Ws + i * PT + ks * 64 + g * 16);
                s16x4 lo[8], hi[8];
#pragma unroll
                for (int dt = 0; dt < 8; ++dt) { lo[dt] = att::tr_read(mx::tr_addr(vs, 32 * ks + 8 * g, 16 * dt, li)); hi[dt] = att::tr_read(mx::tr_addr(vs, 32 * ks + 8 * g + 4, 16 * dt, li)); }
                mx::lds_wait();
#pragma unroll
                for (int dt = 0; dt < 8; ++dt) acc[dt] = __builtin_amdgcn_mfma_f32_16x16x32_bf16(mx::mk8(lo[dt], hi[dt]), bq, acc[dt], 0, 0, 0);
            }
            const float bsi = p.in[I_GBS][((size_t)l * C::GH + h) * C::GCH + i];
            const int row = r0 + i;
#pragma unroll
            for (int dt = 0; dt < 8; ++dt) { const int d = 16 * dt + 4 * g; const f32x4 uu = *(const f32x4*)(P + (size_t)row * C::LDP + C::O_U + h * 128 + d);
                u32x2 w; w.x = pg8::cvt_pk_bf16(uu[0] * (acc[dt][0] + bsi), uu[1] * (acc[dt][1] + bsi)); w.y = pg8::cvt_pk_bf16(uu[2] * (acc[dt][2] + bsi), uu[3] * (acc[dt][3] + bsi));
                *(u32x2*)(wsb<C>(p, C::WS_MIX) + (size_t)row * C::D + C::PW + h * 128 + d) = w; }
        }
        WG_SYNC();
    }
}
__device__ __forceinline__ void pool_phase(LAS unsigned char* lds, const Ptrs& p, int l, int tid, int bid, int gsz) {
    const int lane = tid & 63, wave = __builtin_amdgcn_readfirstlane(tid >> 6), li = lane & 15, g = lane >> 4;
    LAS unsigned char* Ds = lds; LAS unsigned char* Ws = lds + T128;
    const float* P = wsf<C>(p, C::WS_BIG);
    for (int u = bid; u < NU_G; u += gsz) {
        int r0, lc, grp, t0, L, b; bool sample = false;
        if (u < NT_P * 4) { grp = u & 3; r0 = (u >> 2) * 128; lc = 128; b = r0 / C::SEQ; t0 = r0 % C::SEQ; L = C::SEQ; } else { const int s = u - NT_P * 4; grp = s & 3; b = s >> 2; r0 = C::MP + b * C::DEC_SEQ; lc = C::DEC_SEQ; t0 = 0; L = C::DEC_SEQ; sample = true; }
        const int w = 2 << grp;
        { const int c4 = tid & 31, sg = tid >> 5, ch = grp * 128 + c4 * 4;
            const float* hist = p.in[I_SPOOL] + ((size_t)l * C::DEC_BATCH + b) * C::PH * C::PW + ch;
            auto xat = [&](int t) -> f32x4 {
                if (t >= 0) return *(const f32x4*)(P + (size_t)(r0 - t0 + t) * C::LDP + ch);
                if (sample && C::PH + t >= 0) return *(const f32x4*)(hist + (size_t)(C::PH + t) * C::PW);
                return (f32x4){0.f, 0.f, 0.f, 0.f}; };
            if (sg * 8 < lc) {
                const int ts = t0 + sg * 8;
                f32x4 sum = (f32x4){0.f, 0.f, 0.f, 0.f};
                for (int j = 1; j < w; ++j) sum = sum + xat(ts - j);
#pragma unroll
                for (int k = 0; k < 8; ++k) { const int t = ts + k; const f32x4 x = xat(t); sum = sum + x;
                    const int pos = (sample ? C::PAST : 0) + t; const float inv = 1.0f / (float)((pos + 1) < w ? (pos + 1) : w);
                    const f32x4 dv = sum * inv - x;
                    u32x2 ww; ww.x = pg8::cvt_pk_bf16(dv[0], dv[1]); ww.y = pg8::cvt_pk_bf16(dv[2], dv[3]); *(LAS u32x2*)(Ds + (sg * 8 + k) * PT + c4 * 8) = ww;
                    sum = sum - xat(t - w + 1);
                    const int idx = t - (L - C::PH);
                    if (idx >= 0) *(f32x4*)(p.out + (sample ? C::OUT_POOLS + (((size_t)l * C::DEC_BATCH + b) * C::PH + idx) * C::PW : C::OUT_POOLP + (((size_t)l * C::BATCH + b) * C::PH + idx) * C::PW) + ch) = x; }
            } else {
#pragma unroll
                for (int k = 0; k < 8; ++k) *(LAS u32x2*)(Ds + (sg * 8 + k) * PT + c4 * 8) = (u32x2){0u, 0u};
            }
        }
        const float* wsrc = p.in[I_POOLW] + ((size_t)l * C::PG + grp) * 128 * 128;
#pragma unroll
        for (int i = 0; i < 8; ++i) { const int f = tid + 512 * i, row = f >> 5, c4 = f & 31; const f32x4 v = *(const f32x4*)(wsrc + (size_t)row * 128 + c4 * 4);
            u32x2 ww; ww.x = pg8::cvt_pk_bf16(v[0], v[1]); ww.y = pg8::cvt_pk_bf16(v[2], v[3]); *(LAS u32x2*)(Ws + row * PT + c4 * 8) = ww; }
        WG_SYNC();
        if (wave * 16 < lc) {
            const int t = wave * 16 + li;
            f32x4 acc[8];
#pragma unroll
            for (int et = 0; et < 8; ++et) acc[et] = (f32x4){0.f, 0.f, 0.f, 0.f};
            const unsigned wsa = (unsigned)(size_t)Ws;
#pragma unroll
            for (int ks = 0; ks < 4; ++ks) {
                const bf16x8 bq = *(const LAS bf16x8*)(Ds + t * PT + ks * 64 + g * 16);
                s16x4 lo[8], hi[8];
#pragma unroll
                for (int et = 0; et < 8; ++et) { lo[et] = att::tr_read(mx::tr_addr(wsa, 32 * ks + 8 * g, 16 * et, li)); hi[et] = att::tr_read(mx::tr_addr(wsa, 32 * ks + 8 * g + 4, 16 * et, li)); }
                mx::lds_wait();
#pragma unroll
                for (int et = 0; et < 8; ++et) acc[et] = __builtin_amdgcn_mfma_f32_16x16x32_bf16(mx::mk8(lo[et], hi[et]), bq, acc[et], 0, 0, 0);
            }
            const int row = r0 + t;
#pragma unroll
            for (int et = 0; et < 8; ++et) { const int e = 16 * et + 4 * g; const f32x4 sc = *(const f32x4*)(p.in[I_POOLS] + (size_t)l * C::PW + grp * 128 + e);
                u32x2 ww; ww.x = pg8::cvt_pk_bf16(acc[et][0] * sc[0], acc[et][1] * sc[1]); ww.y = pg8::cvt_pk_bf16(acc[et][2] * sc[2], acc[et][3] * sc[3]);
                *(u32x2*)(wsb<C>(p, C::WS_MIX) + (size_t)row * C::D + grp * 128 + e) = ww; }
        }
        WG_SYNC();
    }
}
}
namespace mp {
typedef att::bf16x8 bf16x8; typedef att::s16x4 s16x4; typedef att::f32x4 f32x4; typedef att::u32x2 u32x2; typedef pg8::u32x4 u32x4;
constexpr int PT = mx::PT, T64 = mx::T64, T128 = mx::T128, MAXU = 8;
#define MP_TR(dst, base, OFF) asm volatile("ds_read_b64_tr_b16 %0, %1 offset:%2" : "=&v"(dst) : "v"(base), "i"(OFF) : "memory")
__device__ __forceinline__ void ml_a(LAS unsigned char* lds, const Ptrs& p, int l, int tid, int bid, int gsz) {
    const int lane = tid & 63, wave = __builtin_amdgcn_readfirstlane(tid >> 6), li = lane & 15, g = lane >> 4;
    LAS unsigned char* Ks = lds; LAS unsigned char* Vs = lds + T64; LAS float* wts = (LAS float*)(lds + 2 * T64);
    const float* P = wsf<C>(p, C::WS_BIG);
    const int nu = bid < C::NCH ? (C::NCH - 1 - bid) / gsz + 1 : 0;
    if (wave < nu) { const int ci = bid + wave * gsz; int r0, h, lc; mx::ch_decode(ci, r0, h, lc);
        float lf = 0.f, ig = -3.0e38f;
        if (lane < lc) { const float* pr = P + (size_t)(r0 + lane) * C::LDP; ig = pr[C::O_IG + h] + p.in[I_IB][l * C::MH + h]; const float fx = pr[C::O_FG + h] + p.in[I_FB][l * C::MH + h];
            lf = fx >= 0.f ? -__logf(1.0f + __expf(-fx)) : fx - __logf(1.0f + __expf(fx)); }
        float b = lf;
#pragma unroll
        for (int o = 1; o < 64; o <<= 1) { const float t = __shfl_up(b, o); if (lane >= o) b += t; }
        const float a = lane < lc ? ig - b : -3.0e38f;
        float amax = a;
#pragma unroll
        for (int o = 1; o < 64; o <<= 1) amax = fmaxf(amax, __shfl_xor(amax, o));
        const float bL = __shfl(b, lc - 1), mloc = bL + amax;
        wts[wave * 64 + lane] = lane < lc ? __expf(bL + a - mloc) : 0.f;
        if (lane < lc) { wsf<C>(p, C::WS_GB)[(size_t)(r0 + lane) * C::MH + h] = b; wsf<C>(p, C::WS_GA)[(size_t)(r0 + lane) * C::MH + h] = a; }
        if (lane == 0) { wsf<C>(p, C::WS_CBL)[ci] = bL; wsf<C>(p, C::WS_CML)[ci] = mloc; } }
    const unsigned lofs8 = (unsigned)((8 * g + (li >> 2)) * PT + 8 * (li & 3));
    const unsigned kw8 = (unsigned)(size_t)Ks + lofs8 + (unsigned)(32 * wave), vs8 = (unsigned)(size_t)Vs + lofs8;
    f32x4 pk[4], pv[4];
    auto window = [&](int ci) { int r0, h, lc; mx::ch_decode(ci, r0, h, lc); const float* src = P + (size_t)r0 * C::LDP + h * C::MHD;
#pragma unroll
        for (int q = 0; q < 4; ++q) { const int f = tid + 512 * q, row = f >> 5, c4 = f & 31;
            if (row < lc) { pk[q] = *(const f32x4*)(src + (size_t)row * C::LDP + C::O_K + c4 * 4); pv[q] = *(const f32x4*)(src + (size_t)row * C::LDP + C::O_VM + c4 * 4); }
            else { pk[q] = (f32x4){0.f, 0.f, 0.f, 0.f}; pv[q] = pk[q]; } }
        __builtin_amdgcn_sched_barrier(0); };
    if (nu > 0) window(bid);
    WG_SYNC();
    for (int j = 0; j < nu; ++j) { const int ci = bid + j * gsz;
#pragma unroll
        for (int q = 0; q < 4; ++q) { const int f = tid + 512 * q, row = f >> 5, c4 = f & 31; const float sw = 0.08838834764831845f * wts[j * 64 + row];
            u32x2 w; w.x = pg8::cvt_pk_bf16(pk[q][0] * sw, pk[q][1] * sw); w.y = pg8::cvt_pk_bf16(pk[q][2] * sw, pk[q][3] * sw); *(LAS u32x2*)(Ks + row * PT + c4 * 8) = w;
            w.x = pg8::cvt_pk_bf16(pv[q][0], pv[q][1]); w.y = pg8::cvt_pk_bf16(pv[q][2], pv[q][3]); *(LAS u32x2*)(Vs + row * PT + c4 * 8) = w; }
        if (j + 1 < nu) window(ci + gsz);
        WG_SYNC();
        f32x4 acc[8], accn = (f32x4){0.f, 0.f, 0.f, 0.f};
#pragma unroll
        for (int et = 0; et < 8; ++et) acc[et] = (f32x4){0.f, 0.f, 0.f, 0.f};
        const bf16x8 ones = (bf16x8){0x3F80, 0x3F80, 0x3F80, 0x3F80, 0x3F80, 0x3F80, 0x3F80, 0x3F80};
#pragma unroll
        for (int t = 0; t < 2; ++t) {
            s16x4 alo, ahi, blo[8], bhi[8]; MP_TR(alo, kw8, (32 * t) * PT); MP_TR(ahi, kw8, (32 * t + 4) * PT);
#pragma unroll
            for (int et = 0; et < 8; ++et) { MP_TR(blo[et], vs8, (32 * t) * PT + 32 * et); MP_TR(bhi[et], vs8, (32 * t + 4) * PT + 32 * et); }
            mx::lds_wait();
            const bf16x8 a = mx::mk8(alo, ahi);
#pragma unroll
            for (int et = 0; et < 8; ++et) acc[et] = __builtin_amdgcn_mfma_f32_16x16x32_bf16(mx::mk8(blo[et], bhi[et]), a, acc[et], 0, 0, 0);
            accn = __builtin_amdgcn_mfma_f32_16x16x32_bf16(ones, a, accn, 0, 0, 0);
        }
        float* DC = wsf<C>(p, C::WS_DC) + (size_t)ci * C::MHD * C::MHD + (size_t)(16 * wave + li) * C::MHD + 4 * g;
#pragma unroll
        for (int et = 0; et < 8; ++et) *(f32x4*)(DC + 16 * et) = acc[et];
        if (g == 0) wsf<C>(p, C::WS_DN)[(size_t)ci * C::MHD + 16 * wave + li] = accn[0];
        WG_SYNC();
    }
}
__device__ __forceinline__ void ml_scan(const Ptrs& p, int l, long gtid, long gthreads) {
    const float* CBL = wsf<C>(p, C::WS_CBL); const float* CML = wsf<C>(p, C::WS_CML); const float* DC = wsf<C>(p, C::WS_DC); float* DN = wsf<C>(p, C::WS_DN);
    bf16_t* DCB = wsb<C>(p, C::WS_DCB); float* MPREV = wsf<C>(p, C::WS_MPREV);
    constexpr int NPS = C::BATCH * C::MH, E4 = C::MHD / 4;
    static_assert(C::NC % 8 == 0, "scan is unrolled by 8 chunks");
    for (long it = gtid; it < (long)NPS * C::MHD * E4; it += gthreads) {
        const int e4 = (int)(it % E4), d = (int)((it / E4) % C::MHD), sq = (int)(it / ((long)E4 * C::MHD));
        float m = 0.f, nst = 0.f; f32x4 cst = (f32x4){0.f, 0.f, 0.f, 0.f};
        for (int c0 = 0; c0 < C::NC; c0 += 8) {
            f32x4 v[8]; float bl[8], ml[8], dn[8];
#pragma unroll
            for (int j = 0; j < 8; ++j) { const int ci = sq * C::NC + c0 + j; v[j] = *(const f32x4*)(DC + ((size_t)ci * C::MHD + d) * C::MHD + e4 * 4); bl[j] = CBL[ci]; ml[j] = CML[ci];
                dn[j] = (e4 == 0) ? DN[(size_t)ci * C::MHD + d] : 0.f; }
            __builtin_amdgcn_sched_barrier(0);
#pragma unroll
            for (int j = 0; j < 8; ++j) { const int ci = sq * C::NC + c0 + j; const float a = bl[j] + m, mn = fmaxf(a, ml[j]), dec = __expf(a - mn), f = __expf(ml[j] - mn);
                if (d == 0 && e4 == 0) MPREV[ci] = m;
                cst = cst * dec + v[j] * f; u32x2 w; w.x = pg8::cvt_pk_bf16(cst[0], cst[1]); w.y = pg8::cvt_pk_bf16(cst[2], cst[3]);
                *(u32x2*)(DCB + ((size_t)ci * C::MHD + d) * C::MHD + e4 * 4) = w;
                nst = dec * nst + f * dn[j]; if (e4 == 0) DN[(size_t)ci * C::MHD + d] = nst;
                m = mn; }
        }
        *(f32x4*)(p.out + C::OUT_CP + (((size_t)l * NPS + sq) * C::MHD + d) * C::MHD + e4 * 4) = cst;
        if (e4 == 0) p.out[C::OUT_NP + ((size_t)l * NPS + sq) * C::MHD + d] = nst;
        if (d == 0 && e4 == 0) p.out[C::OUT_MP + (size_t)l * NPS + sq] = m;
    }
    for (long it = gtid; it < (long)C::NSC * C::MHD * E4; it += gthreads) {
        const int e4 = (int)(it % E4), d = (int)((it / E4) % C::MHD), q = (int)(it / ((long)E4 * C::MHD)), ci = C::NPC + q;
        const float m0 = p.in[I_SM][(size_t)l * C::NSC + q], a = CBL[ci] + m0, b2 = CML[ci], mn = fmaxf(a, b2), dec = __expf(a - mn), f = __expf(b2 - mn);
        const size_t so = (((size_t)l * C::NSC + q) * C::MHD + d) * C::MHD + e4 * 4; const f32x4 cin = *(const f32x4*)(p.in[I_SC] + so);
        *(f32x4*)(p.out + C::OUT_CS + so) = cin * dec + *(const f32x4*)(DC + ((size_t)ci * C::MHD + d) * C::MHD + e4 * 4) * f;
        u32x2 w; w.x = pg8::cvt_pk_bf16(cin[0], cin[1]); w.y = pg8::cvt_pk_bf16(cin[2], cin[3]); *(u32x2*)(DCB + ((size_t)ci * C::MHD + d) * C::MHD + e4 * 4) = w;
        if (d == 0 && e4 == 0) { MPREV[ci] = m0; p.out[C::OUT_MS + (size_t)l * C::NSC + q] = mn; }
    }
    for (long it = gtid; it < (long)C::NSC * C::MHD; it += gthreads) {
        const int d = (int)(it % C::MHD), q = (int)(it / C::MHD), ci = C::NPC + q;
        const float m0 = p.in[I_SM][(size_t)l * C::NSC + q], a = CBL[ci] + m0, b2 = CML[ci], mn = fmaxf(a, b2), dec = __expf(a - mn), f = __expf(b2 - mn);
        const size_t no = ((size_t)l * C::NSC + q) * C::MHD + d;
        p.out[C::OUT_NS + no] = dec * p.in[I_SN][no] + f * DN[(size_t)ci * C::MHD + d];
    }
}
__device__ __forceinline__ void ml_c(LAS unsigned char* lds, const Ptrs& p, int l, int tid, int bid, int gsz) {
    const int lane = tid & 63, wave = __builtin_amdgcn_readfirstlane(tid >> 6), li = lane & 15, g = lane >> 4, it = wave & 3, eh = wave >> 2;
    LAS unsigned char* Qs = lds; LAS unsigned char* Ks = lds + T64; LAS unsigned char* Vs = lds + 2 * T64; LAS unsigned char* Cs = lds + 3 * T64;
    LAS float* SB = (LAS float*)(lds + 3 * T64 + T128); LAS float* SA = SB + MAXU * 64; LAS float* SMR = SA + MAXU * 64; LAS float* SIW = SMR + MAXU * 64;
    LAS float* snp = SIW + MAXU * 64; LAS float* ssq = snp + 128; LAS float* sgn = ssq + 128;
    const float* P = wsf<C>(p, C::WS_BIG);
    const int nu = bid < C::NCH ? (C::NCH - 1 - bid) / gsz + 1 : 0;
    if (wave < nu) { const int ci = bid + wave * gsz; int r0, h, lc; mx::ch_decode(ci, r0, h, lc); const float mprev = wsf<C>(p, C::WS_MPREV)[ci];
        float b = 0.f, a = -3.0e38f;
        if (lane < lc) { b = wsf<C>(p, C::WS_GB)[(size_t)(r0 + lane) * C::MH + h]; a = wsf<C>(p, C::WS_GA)[(size_t)(r0 + lane) * C::MH + h]; }
        float pm = a;
#pragma unroll
        for (int o = 1; o < 64; o <<= 1) { const float t = __shfl_up(pm, o); if (lane >= o) pm = fmaxf(pm, t); }
        const float mrow = b + fmaxf(mprev, pm);
        SB[wave * 64 + lane] = b; SA[wave * 64 + lane] = a; SMR[wave * 64 + lane] = mrow; SIW[wave * 64 + lane] = __expf(b + mprev - mrow); }
    const unsigned lofs8 = (unsigned)((8 * g + (li >> 2)) * PT + 8 * (li & 3)), lofs4 = (unsigned)((4 * g + (li >> 2)) * PT + 8 * (li & 3));
    const unsigned vs4e = (unsigned)(size_t)Vs + lofs4 + (unsigned)(128 * eh), cb8e = (unsigned)(size_t)Cs + lofs8 + (unsigned)(128 * eh);
    f32x4 pq[4], pk[4], pv[4], og[4]; u32x4 pc[4]; float pn = 0.f, pg = 0.f;
    auto window = [&](int ci) { int r0, h, lc; mx::ch_decode(ci, r0, h, lc); const float* src = P + (size_t)r0 * C::LDP + h * C::MHD;
        const bool sample = ci >= C::NPC, first = !sample && (ci % C::NC) == 0;
#pragma unroll
        for (int q = 0; q < 4; ++q) { const int f = tid + 512 * q, row = f >> 5, c4 = f & 31;
            if (row < lc) { pq[q] = *(const f32x4*)(src + (size_t)row * C::LDP + C::O_Q + c4 * 4); pk[q] = *(const f32x4*)(src + (size_t)row * C::LDP + C::O_K + c4 * 4); pv[q] = *(const f32x4*)(src + (size_t)row * C::LDP + C::O_VM + c4 * 4); }
            else { pq[q] = (f32x4){0.f, 0.f, 0.f, 0.f}; pk[q] = pq[q]; pv[q] = pq[q]; } }
        const bf16_t* cb = wsb<C>(p, C::WS_DCB) + (size_t)(sample ? ci : (first ? ci : ci - 1)) * C::MHD * C::MHD;
#pragma unroll
        for (int q = 0; q < 4; ++q) { const int f = tid + 512 * q; pc[q] = first ? (u32x4){0u, 0u, 0u, 0u} : *(const u32x4*)(cb + (size_t)f * 8); }
        const int i = 16 * it + li;
#pragma unroll
        for (int e4 = 0; e4 < 4; ++e4) og[e4] = (it * 16 < lc) ? *(const f32x4*)(src + (size_t)i * C::LDP + C::O_O + 16 * (4 * eh + e4) + 4 * g) : (f32x4){0.f, 0.f, 0.f, 0.f};
        if (tid < C::MHD) { pn = sample ? p.in[I_SN][((size_t)l * C::NSC + (ci - C::NPC)) * C::MHD + tid] : (first ? 0.f : wsf<C>(p, C::WS_DN)[(size_t)(ci - 1) * C::MHD + tid]);
            pg = p.in[I_NG][(size_t)l * C::MW + h * C::MHD + tid]; }
        __builtin_amdgcn_sched_barrier(0); };
    if (nu > 0) window(bid);
    WG_SYNC();
#if defined(PROBE_MLC)
    unsigned long long tacc[4] = {0, 0, 0, 0}; unsigned long long tprev = wall_clock64();
#define MLC_T(j) do { const unsigned long long tn_ = wall_clock64(); tacc[j] += tn_ - tprev; tprev = tn_; } while (0)
#else
#define MLC_T(j) do { } while (0)
#endif
    for (int j = 0; j < nu; ++j) { const int ci = bid + j * gsz; int r0, h, lc; mx::ch_decode(ci, r0, h, lc);
        const LAS float* sb = SB + j * 64; const LAS float* sa = SA + j * 64; const LAS float* smr = SMR + j * 64; const LAS float* siw = SIW + j * 64;
#pragma unroll
        for (int q = 0; q < 4; ++q) { const int f = tid + 512 * q, row = f >> 5, c4 = f & 31; const float sc = 0.08838834764831845f;
            u32x2 w; w.x = pg8::cvt_pk_bf16(pq[q][0], pq[q][1]); w.y = pg8::cvt_pk_bf16(pq[q][2], pq[q][3]); *(LAS u32x2*)(Qs + row * PT + c4 * 8) = w;
            w.x = pg8::cvt_pk_bf16(pk[q][0] * sc, pk[q][1] * sc); w.y = pg8::cvt_pk_bf16(pk[q][2] * sc, pk[q][3] * sc); *(LAS u32x2*)(Ks + row * PT + c4 * 8) = w;
            w.x = pg8::cvt_pk_bf16(pv[q][0], pv[q][1]); w.y = pg8::cvt_pk_bf16(pv[q][2], pv[q][3]); *(LAS u32x2*)(Vs + row * PT + c4 * 8) = w;
            *(LAS u32x4*)(Cs + (f >> 4) * PT + (f & 15) * 16) = pc[q]; }
        if (tid < C::MHD) { snp[tid] = pn; sgn[tid] = pg; }
        f32x4 ogc[4];
#pragma unroll
        for (int e4 = 0; e4 < 4; ++e4) ogc[e4] = og[e4];
        if (j + 1 < nu) window(ci + gsz);
        WG_SYNC(); MLC_T(0);
        const bool active = it * 16 < lc; const int i = 16 * it + li;
        float ssq_part = 0.f; f32x4 hv[4];
        if (active) {
            bf16x8 qf[4];
#pragma unroll
            for (int ks = 0; ks < 4; ++ks) qf[ks] = *(const LAS bf16x8*)(Qs + i * PT + ks * 64 + g * 16);
            f32x4 st[4];
#pragma unroll
            for (int jt = 0; jt < 4; ++jt) st[jt] = (f32x4){0.f, 0.f, 0.f, 0.f};
#pragma unroll
            for (int jt = 0; jt < 4; ++jt) if (jt <= it) {
#pragma unroll
                for (int ks = 0; ks < 4; ++ks) { const bf16x8 a = *(const LAS bf16x8*)(Ks + (16 * jt + li) * PT + ks * 64 + g * 16);
                    st[jt] = __builtin_amdgcn_mfma_f32_16x16x32_bf16(a, qf[ks], st[jt], 0, 0, 0); } }
            const float bi = sb[i], mri = smr[i], iwi = siw[i];
            float dsum = 0.f;
#pragma unroll
            for (int jt = 0; jt < 4; ++jt)
#pragma unroll
                for (int r = 0; r < 4; ++r) { const int jj = 16 * jt + 4 * g + r; const float w = (jj <= i) ? __expf(bi + sa[jj] - mri) : 0.f; st[jt][r] *= w; dsum += st[jt][r]; }
            dsum += __shfl_xor(dsum, 16); dsum += __shfl_xor(dsum, 32);
            float qn = 0.f;
#pragma unroll
            for (int ks = 0; ks < 4; ++ks)
#pragma unroll
                for (int jj = 0; jj < 8; ++jj) qn += bf2f((bf16_t)qf[ks][jj]) * snp[32 * ks + 8 * g + jj];
            qn += __shfl_xor(qn, 16); qn += __shfl_xor(qn, 32);
            const float den = dsum + iwi * qn, inv_den = 1.0f / fmaxf(fabsf(den), __expf(-mri));
            bf16x8 pf[2];
#pragma unroll
            for (int t = 0; t < 2; ++t) { u32x4 w; w.x = pg8::cvt_pk_bf16(st[2 * t][0], st[2 * t][1]); w.y = pg8::cvt_pk_bf16(st[2 * t][2], st[2 * t][3]);
                w.z = pg8::cvt_pk_bf16(st[2 * t + 1][0], st[2 * t + 1][1]); w.w = pg8::cvt_pk_bf16(st[2 * t + 1][2], st[2 * t + 1][3]); pf[t] = __builtin_bit_cast(bf16x8, w); }
#pragma unroll
            for (int e2 = 0; e2 < 2; ++e2) {
                s16x4 vlo[2][2], vhi[2][2], clo[2][4], chi[2][4];
#pragma unroll
                for (int u = 0; u < 2; ++u) {
#pragma unroll
                    for (int t = 0; t < 2; ++t) { MP_TR(vlo[u][t], vs4e, (32 * t) * PT + 32 * (2 * e2 + u)); MP_TR(vhi[u][t], vs4e, (32 * t + 16) * PT + 32 * (2 * e2 + u)); }
#pragma unroll
                    for (int ks = 0; ks < 4; ++ks) { MP_TR(clo[u][ks], cb8e, (32 * ks) * PT + 32 * (2 * e2 + u)); MP_TR(chi[u][ks], cb8e, (32 * ks + 4) * PT + 32 * (2 * e2 + u)); } }
                mx::lds_wait();
#pragma unroll
                for (int u = 0; u < 2; ++u) { const int e4 = 2 * e2 + u;
                    f32x4 aS = (f32x4){0.f, 0.f, 0.f, 0.f}, aC = (f32x4){0.f, 0.f, 0.f, 0.f};
#pragma unroll
                    for (int t = 0; t < 2; ++t) aS = __builtin_amdgcn_mfma_f32_16x16x32_bf16(mx::mk8(vlo[u][t], vhi[u][t]), pf[t], aS, 0, 0, 0);
#pragma unroll
                    for (int ks = 0; ks < 4; ++ks) aC = __builtin_amdgcn_mfma_f32_16x16x32_bf16(mx::mk8(clo[u][ks], chi[u][ks]), qf[ks], aC, 0, 0, 0);
                    hv[e4] = (aS + aC * iwi) * inv_den;
                    ssq_part += (hv[e4][0] * hv[e4][0] + hv[e4][1] * hv[e4][1]) + (hv[e4][2] * hv[e4][2] + hv[e4][3] * hv[e4][3]); } }
            ssq_part += __shfl_xor(ssq_part, 16); ssq_part += __shfl_xor(ssq_part, 32);
            if (g == 0) ssq[wave * 16 + li] = ssq_part;
        }
        MLC_T(1); WG_SYNC();
        if (active) {
            const float tot = ssq_part + ssq[(wave ^ 4) * 16 + li];
            const float rs = rsqrtf(tot * (1.0f / C::MHD) + 1e-6f);
            const int row = r0 + i;
#pragma unroll
            for (int e4 = 0; e4 < 4; ++e4) { const int e = 16 * (4 * eh + e4) + 4 * g; const f32x4 gn = *(const LAS f32x4*)(sgn + e);
                float o4[4];
#pragma unroll
                for (int r = 0; r < 4; ++r) o4[r] = hv[e4][r] * rs * gn[r] * __builtin_amdgcn_rcpf(1.0f + __expf(-ogc[e4][r]));
                u32x2 w; w.x = pg8::cvt_pk_bf16(o4[0], o4[1]); w.y = pg8::cvt_pk_bf16(o4[2], o4[3]);
                *(u32x2*)(wsb<C>(p, C::WS_MIX) + (size_t)row * C::D + C::PW + C::GW + h * C::MHD + e) = w; }
        }
        MLC_T(2); WG_SYNC(); MLC_T(3);
    }
#if defined(PROBE_MLC)
    if (bid == 0 && tid == 0) { unsigned long long* TS = (unsigned long long*)(p.ws + C::WS_CTL + 32768); for (int j = 0; j < 4; ++j) TS[48 + j] += tacc[j]; }
#endif
}
}
constexpr int PH_PER_LAYER = 12, N_PHASES = 2 + PH_PER_LAYER * C::DEPTH;
struct Args { Ptrs p; int ph_lo, ph_hi; };
__global__ void __launch_bounds__(NTHREADS, 2) fwd(Args a) {
    extern __shared__ __attribute__((aligned(16))) unsigned char lds_raw[];
    LAS unsigned char* lds = (LAS unsigned char*)lds_raw;
    typedef __attribute__((address_space(4))) const Args* KArgs;
    const KArgs ka0 = (KArgs)__builtin_amdgcn_kernarg_segment_ptr();
    const int lo = a.ph_lo, hi = a.ph_hi;
#define IN(k) (lo <= (k) && (k) < hi)
#define BOTH(k) (IN(k) && IN((k) + 1))
#define GRID_BAR(k) do { if (BOTH(k)) { xcd_barrier(bar); } } while (0)
#if defined(__HIP_DEVICE_COMPILE__)
#define LOAD_PTRS KArgs ka = ka0; asm volatile("" : "+s"(ka)); Ptrs p; _Pragma("unroll") for (int i_ = 0; i_ < 33; ++i_) p.in[i_] = ka->p.in[i_]; p.out = ka->p.out; p.ws = ka->p.ws;
#else
#define LOAD_PTRS (void)ka0; const Ptrs p = a.p;
#endif
#define PHASE_ARGS LOAD_PTRS int tid = threadIdx.x; asm volatile("" : "+v"(tid)); int bid = blockIdx.x, gsz = gridDim.x; asm volatile("" : "+s"(bid), "+s"(gsz));     \
    const int lane = tid & 63, wave = __builtin_amdgcn_readfirstlane(tid >> 6); (void)lane; (void)wave; \
    const long gtid = (long)bid * NTHREADS + tid, gthreads = (long)gsz * NTHREADS; (void)gtid; (void)gthreads; \
    float* SS = wsf<C>(p, C::WS_SS); (void)SS; const float invd = 1.0f / C::D; (void)invd;
#if defined(PROBE_MASK_A)
#define STAMP(k) do { if (blockIdx.x == 0 && threadIdx.x == 0) ((unsigned long long*)(a.p.ws + C::WS_CTL + 32768))[k] = wall_clock64(); } while (0)
#else
#define STAMP(k) do { } while (0)
#endif
#define ITEMS(n, call) do { for (long it = gtid; it < (long)(n); it += gthreads) { call; } } while (0)
#define SSL(j) (SS + (size_t)(4 * l + (j)) * C::M)
#define GEMM_ALL(STRIP, EPI, Aop, Bop, Mr, Nc, Kd, ...) do { pg8::Gemm g{Aop, Bop, Mr, Nc, Kd, Kd}; pg8::StaticOrder S; S.init(Mr, Nc, gsz, bid, (STRIP) ? 288 : 256); \
        pg8::EPI E{__VA_ARGS__}; pg8::gemm_phase<pg8::EPI, pg8::StaticOrder, STRIP, false>(lds, g, S, E, nullptr); } while (0)
#if ONE_LAUNCH
    if (threadIdx.x < 4) ((LAS unsigned*)(lds + LDS_CTL))[threadIdx.x] = 0u;
    __syncthreads();
    XcdBarrier bar = xcd_barrier_post((unsigned*)(a.p.ws + C::WS_CTL), (volatile LAS unsigned*)(lds + LDS_CTL));
#else
    XcdBarrier bar; bar.bar = nullptr; bar.x = 0; bar.st = nullptr;
#endif

    if (IN(0)) { PHASE_ARGS STAMP(0);
        const int gw = bid * NWAVES + wave, NGW = gsz * NWAVES;
        for (int l = 0; l < C::DEPTH; ++l)
            for (int idx = 0; idx < 10; ++idx) { const WDesc d = wdesc(p, l, idx); const int nitems = (d.K / 64) * (d.N / 64);
                for (int it = gw; it < nitems; it += NGW) prep_item(d.W, d.K, d.Ncols, d.g, d.kind, d.N, d.dst, lds + wave * 9216, it, lane); }
        rw::rows_init(p, tid, bid, gsz);
        GRID_BAR(0);
    }
    for (int l = 0; l < C::DEPTH; ++l) {
        const int pb = 1 + PH_PER_LAYER * l;
        if (IN(pb + 0)) { PHASE_ARGS STAMP(pb + 0);
#if defined(PROBE_GST)
            if (l == 0) { pg8::Gemm g{wsb<C>(p, C::WS_XB), wlayer<C>(p, l, C::W_1IN), C::M, 2 * C::FF, C::D, C::D}; pg8::StaticOrder S; S.init(C::M, 2 * C::FF, gsz, bid, 288);
                pg8::EpiSwiGLU E{wsb<C>(p, C::WS_BIG), SSL(0), C::FF, invd}; pg8::gemm_phase<pg8::EpiSwiGLU, pg8::StaticOrder, true, true>(lds, g, S, E, (unsigned long long*)(p.ws + C::WS_END) + (size_t)bid * 64); } else
#endif
            GEMM_ALL(true, EpiSwiGLU, wsb<C>(p, C::WS_XB), wlayer<C>(p, l, C::W_1IN), C::M, 2 * C::FF, C::D, wsb<C>(p, C::WS_BIG), SSL(0), C::FF, invd);
            GRID_BAR(pb + 0); }
        if (IN(pb + 1)) { PHASE_ARGS STAMP(pb + 1);
            GEMM_ALL(true, EpiResid, wsb<C>(p, C::WS_BIG), wlayer<C>(p, l, C::W_1OUT), C::M, C::D, C::FF, wsf<C>(p, C::WS_X), wsb<C>(p, C::WS_XB), SSL(1), 0.5f, C::D);
            GRID_BAR(pb + 1); }
        if (IN(pb + 2)) { PHASE_ARGS STAMP(pb + 2);
            GEMM_ALL(true, EpiScaleF32, wsb<C>(p, C::WS_XB), wlayer<C>(p, l, C::W_IN), C::M, C::LDP, C::D, wsf<C>(p, C::WS_BIG), C::LDP, SSL(1), invd);
            GRID_BAR(pb + 2); }
        if (IN(pb + 3)) { PHASE_ARGS STAMP(pb + 3); mp::ml_a(lds, p, l, tid, bid, gsz);
#if defined(PROBE_MIXA)
            xcd_barrier(bar); STAMP(40 + l);
#endif
            gp::gmlp_phase(lds, p, l, tid, gsz - 1 - bid, gsz);
#if defined(PROBE_MIXA)
            xcd_barrier(bar); STAMP(42 + l);
#endif
            GRID_BAR(pb + 3); }
        if (IN(pb + 4)) { PHASE_ARGS STAMP(pb + 4);
            if (bid < 64) {
                pg8::Gemm g{wsb<C>(p, C::WS_MEMB), wlayer<C>(p, l, C::W_KV), C::MM, 2 * C::D, C::D, C::D}; pg8::StaticOrder S; S.init(C::MM, 2 * C::D, 64, bid);
                pg8::EpiMemKV E{p.out + C::OUT_MK + (size_t)l * C::MM * C::D, p.out + C::OUT_MV + (size_t)l * C::MM * C::D, wsf<C>(p, C::WS_RSTDM), C::D, wsb<C>(p, C::WS_KVB), C::MM};
                pg8::gemm_phase<pg8::EpiMemKV, pg8::StaticOrder, false, false>(lds, g, S, E, nullptr);
            } else { mp::ml_scan(p, l, (long)(bid - 64) * NTHREADS + tid, (long)(gsz - 64) * NTHREADS); gp::pool_phase(lds, p, l, tid, gsz - 1 - bid, gsz - 64); }
            GRID_BAR(pb + 4); }
        if (IN(pb + 5)) { PHASE_ARGS STAMP(pb + 5); mp::ml_c(lds, p, l, tid, bid, gsz); GRID_BAR(pb + 5); }
        if (IN(pb + 6)) { PHASE_ARGS STAMP(pb + 6);
            GEMM_ALL(true, EpiResid, wsb<C>(p, C::WS_MIX), wlayer<C>(p, l, C::W_OUT), C::M, C::D, C::D, wsf<C>(p, C::WS_X), wsb<C>(p, C::WS_XB), SSL(2), 1.0f, C::D);
            GRID_BAR(pb + 6); }
        if (IN(pb + 7)) { PHASE_ARGS STAMP(pb + 7);
            GEMM_ALL(true, EpiScaleBf16, wsb<C>(p, C::WS_XB), wlayer<C>(p, l, C::W_Q), C::M, C::D, C::D, wsb<C>(p, C::WS_Q), C::D, SSL(2), invd);
            GRID_BAR(pb + 7); }
        if (IN(pb + 8)) { PHASE_ARGS STAMP(pb + 8);
            if (bid < 128) att::attn_phase(lds, p, l, tid, bid, 128, 128);
            else att::attn_sample_phase(lds, p, l, tid, bid - 128, gsz - 128);
            GRID_BAR(pb + 8); }
        if (IN(pb + 9)) { PHASE_ARGS STAMP(pb + 9);
            GEMM_ALL(true, EpiResid, wsb<C>(p, C::WS_AO), wlayer<C>(p, l, C::W_O), C::M, C::D, C::D, wsf<C>(p, C::WS_X), wsb<C>(p, C::WS_XB), SSL(3), 1.0f, C::D);
            GRID_BAR(pb + 9); }
        if (IN(pb + 10)) { PHASE_ARGS STAMP(pb + 10);
            GEMM_ALL(true, EpiSwiGLU, wsb<C>(p, C::WS_XB), wlayer<C>(p, l, C::W_2IN), C::M, 2 * C::FF, C::D, wsb<C>(p, C::WS_BIG), SSL(3), C::FF, invd);
            GRID_BAR(pb + 10); }
        if (IN(pb + 11)) { PHASE_ARGS STAMP(pb + 11);
            GEMM_ALL(true, EpiResid, wsb<C>(p, C::WS_BIG), wlayer<C>(p, l, C::W_2OUT), C::M, C::D, C::FF, wsf<C>(p, C::WS_X), wsb<C>(p, C::WS_XB), SSL(4), 0.5f, C::D);
            GRID_BAR(pb + 11); }
    }
    if (IN(N_PHASES - 1)) { PHASE_ARGS STAMP(N_PHASES - 1); __syncthreads(); rw::rows_final(p, tid, bid, gsz); }
#undef IN
#undef BOTH
#undef GRID_BAR
#undef ITEMS
#undef PHASE_ARGS
#undef SSL
}

extern "C" void kernel_launch(void* const* d_in, const int* in_sizes, int n_in, void* d_out, int out_size, void* d_ws, size_t ws_size, hipStream_t stream) {
    static int ready = 0;
    if (!ready) {
        if (n_in != 33 || (long)out_size != (long)C::OUT_END || ws_size < (size_t)C::WS_END) { fprintf(stderr, "kernel_launch: unexpected shapes: n_in %d out %d ws %zu (need %zu)\n", n_in, out_size, ws_size, (size_t)C::WS_END); ready = -1; return; }
        if (hipFuncSetAttribute((const void*)fwd, hipFuncAttributeMaxDynamicSharedMemorySize, LDS_BYTES) != hipSuccess) { fprintf(stderr, "kernel_launch: hipFuncSetAttribute failed\n"); ready = -1; return; }
        int dev = 0, cus = 0, per_cu = 0;
        if (hipGetDevice(&dev) != hipSuccess || hipDeviceGetAttribute(&cus, hipDeviceAttributeMultiprocessorCount, dev) != hipSuccess) { fprintf(stderr, "kernel_launch: device query failed\n"); ready = -1; return; }
        if (hipOccupancyMaxActiveBlocksPerMultiprocessor(&per_cu, (const void*)fwd, NTHREADS, LDS_BYTES) != hipSuccess || per_cu < 1) { fprintf(stderr, "kernel_launch: occupancy query reports %d blocks per CU\n", per_cu); (void)hipGetLastError(); per_cu = 1; }
        if (cus != 256) { fprintf(stderr, "kernel_launch: built for a 256-CU device (one resident workgroup per CU), found %d\n", cus); ready = -1; return; }
        ready = cus;
    }
    if (ready < 0) return;
    Args a{};
    for (int i = 0; i < 33; ++i) a.p.in[i] = (const float*)d_in[i];
    a.p.out = (float*)d_out; a.p.ws = (unsigned char*)d_ws;
#if ONE_LAUNCH
    (void)hipMemsetAsync((char*)d_ws + C::WS_CTL, 0, 65536, stream);
    a.ph_lo = 0; a.ph_hi = N_PHASES;
    hipLaunchKernelGGL(fwd, dim3(ready), dim3(NTHREADS), LDS_BYTES, stream, a);
#else
    for (int k = 0; k < N_PHASES; ++k) { a.ph_lo = k; a.ph_hi = k + 1; hipLaunchKernelGGL(fwd, dim3(ready), dim3(NTHREADS), LDS_BYTES, stream, a); }
#endif
}
```

```cpp
#include <hip/hip_runtime.h>
#include <cstdio>
#define ONE_LAUNCH 1

#define HD __host__ __device__
#ifndef HD
#define HD __host__ __device__
#endif
typedef unsigned short bf16_t;
HD inline unsigned f2u(float f) { return __builtin_bit_cast(unsigned, f); }
HD inline float u2f(unsigned u) { return __builtin_bit_cast(float, u); }
HD inline bf16_t f2bf(float f) { unsigned u = f2u(f); u += 0x7FFFu + ((u >> 16) & 1u); return (bf16_t)(u >> 16); }
HD inline float bf2f(bf16_t b) { return u2f(((unsigned)b) << 16); }

struct RC {
    static constexpr int D = 2048, FF = 8192, BATCH = 4, SEQ = 2048, DEPTH = 2, DEC_BATCH = 32, DEC_SEQ = 32, PAST = 2048, NMEM = 256;
};
template <class B> struct CfgT : B {
    using B::D; using B::FF; using B::BATCH; using B::SEQ; using B::DEPTH; using B::DEC_BATCH; using B::DEC_SEQ; using B::PAST; using B::NMEM;
    static constexpr int MP = BATCH * SEQ, MS = DEC_BATCH * DEC_SEQ, M = MP + MS, MM = BATCH * NMEM;
    static constexpr int PW = D / 4, PG = 4, PGD = PW / 4, PH = 15;
    static constexpr int GW = D / 4, GH = 4, GHD = GW / 4, GCH = 128;
    static constexpr int MW = D - PW - GW, MH = 8, MHD = MW / 8, CH = 64;
    static constexpr int INC = PW + 2 * GW + 4 * MW + 2 * MH;
    static constexpr int LDP = ((INC + 255) / 256) * 256;
    static constexpr int AH = 4, AHD = D / 4;
    static constexpr int O_U = PW, O_V = PW + GW, O_Q = PW + 2 * GW, O_K = O_Q + MW, O_VM = O_K + MW, O_O = O_VM + MW, O_IG = O_O + MW, O_FG = O_IG + MH;
    static constexpr int NC = SEQ / CH, NPC = BATCH * MH * NC, NSC = DEC_BATCH * MH, NCH = NPC + NSC;
    static constexpr int LCS = DEC_SEQ < CH ? DEC_SEQ : CH;
    static constexpr int GLP = SEQ < GCH ? SEQ : GCH, GLS = DEC_SEQ < GCH ? DEC_SEQ : GCH;
    static constexpr int NSS = 1 + 4 * DEPTH;
    static constexpr long OUT_YP = 0, OUT_YS = OUT_YP + (long)MP * D, OUT_POOLP = OUT_YS + (long)MS * D, OUT_POOLS = OUT_POOLP + (long)DEPTH * BATCH * PH * PW,
        OUT_CP = OUT_POOLS + (long)DEPTH * DEC_BATCH * PH * PW, OUT_NP = OUT_CP + (long)DEPTH * BATCH * MH * MHD * MHD, OUT_MP = OUT_NP + (long)DEPTH * BATCH * MH * MHD,
        OUT_CS = OUT_MP + (long)DEPTH * BATCH * MH, OUT_NS = OUT_CS + (long)DEPTH * DEC_BATCH * MH * MHD * MHD, OUT_MS = OUT_NS + (long)DEPTH * DEC_BATCH * MH * MHD,
        OUT_VS = OUT_MS + (long)DEPTH * DEC_BATCH * MH, OUT_MK = OUT_VS + (long)DEPTH * DEC_BATCH * DEC_SEQ * GW, OUT_MV = OUT_MK + (long)DEPTH * BATCH * NMEM * D,
        OUT_END = OUT_MV + (long)DEPTH * BATCH * NMEM * D;
    static constexpr size_t al(size_t x) { return (x + 255) & ~(size_t)255; }
    static constexpr size_t WS_CTL = 0, WS_SS = 65536, WS_X = al(WS_SS + (size_t)NSS * M * 4), WS_XB = al(WS_X + (size_t)M * D * 4),
        WS_BIG = al(WS_XB + (size_t)M * D * 2),
        WS_BIG_SZ = ((size_t)M * FF * 2 > (size_t)M * LDP * 4) ? (size_t)M * FF * 2 : (size_t)M * LDP * 4,
        WS_MIX = al(WS_BIG + WS_BIG_SZ), WS_Q = al(WS_MIX + (size_t)M * D * 2), WS_AO = al(WS_Q + (size_t)M * D * 2),
        WS_MEMB = al(WS_AO + (size_t)M * D * 2), WS_RSTDM = al(WS_MEMB + (size_t)MM * D * 2),
        WS_GB = al(WS_RSTDM + (size_t)MM * 4), WS_GA = al(WS_GB + (size_t)M * MH * 4),
        WS_CBL = al(WS_GA + (size_t)M * MH * 4), WS_CML = al(WS_CBL + (size_t)NCH * 4), WS_MPREV = al(WS_CML + (size_t)NCH * 4),
        WS_DC = al(WS_MPREV + (size_t)NCH * 4), WS_DN = al(WS_DC + (size_t)NCH * MHD * MHD * 4),
        WS_DCB = al(WS_DN + (size_t)NCH * MHD * 4),
        WS_W = al(WS_DCB + (size_t)NCH * MHD * MHD * 2);
    static constexpr size_t W_1IN = 0, W_1OUT = W_1IN + (size_t)2 * FF * D, W_IN = W_1OUT + (size_t)D * FF, W_OUT = W_IN + (size_t)LDP * D, W_Q = W_OUT + (size_t)D * D,
        W_KV = W_Q + (size_t)D * D, W_O = W_KV + (size_t)2 * D * D, W_2IN = W_O + (size_t)D * D, W_2OUT = W_2IN + (size_t)2 * FF * D, W_LAYER = W_2OUT + (size_t)D * FF;
    static constexpr size_t WS_KVB = al(WS_W + (size_t)DEPTH * W_LAYER * 2);
    static constexpr size_t WS_END = al(WS_KVB + (size_t)2 * MM * D * 2);
};

struct Ptrs { const float* in[33]; float* out; unsigned char* ws; };
enum { I_XP = 0, I_XS, I_MEM, I_SPOOL, I_SC, I_SN, I_SM, I_CK, I_CV, I_GFFN1, I_W1IN, I_W1OUT, I_GMIX, I_WIN, I_POOLW, I_POOLS, I_GVG, I_GWS, I_GBS, I_IB, I_FB, I_NG, I_WOUT,
       I_GX, I_GMEM, I_WQ, I_WK, I_WV, I_WO, I_GFFN2, I_W2IN, I_W2OUT, I_GFIN };

template <class C> HD inline float* wsf(const Ptrs& p, size_t off) { return (float*)(p.ws + off); }
template <class C> HD inline bf16_t* wsb(const Ptrs& p, size_t off) { return (bf16_t*)(p.ws + off); }
template <class C> HD inline bf16_t* wlayer(const Ptrs& p, int l, size_t off) { return (bf16_t*)(p.ws + C::WS_W) + (size_t)l * C::W_LAYER + off; }

template <class C> HD inline void row_info(int r, bool& s, int& b, int& t) {
    if (r < C::MP) { s = false; b = r / C::SEQ; t = r % C::SEQ; } else { s = true; const int q = r - C::MP; b = q / C::DEC_SEQ; t = q % C::DEC_SEQ; }
}
template <class C> HD inline void chunk_info(int r, int h, int& ci, int& i, int& lc) {
    bool s; int b, t; row_info<C>(r, s, b, t);
    if (!s) { ci = (b * C::MH + h) * C::NC + t / C::CH; i = t % C::CH; lc = C::CH; } else { ci = C::NPC + b * C::MH + h; i = t; lc = C::LCS; }
}
HD inline float sigmoidf_(float x) { return 1.0f / (1.0f + expf(-x)); }
HD inline float logsigmoidf_(float x) { return x >= 0.f ? -log1pf(expf(-x)) : x - log1pf(expf(x)); }

enum { WK_PLAIN = 0, WK_FFNIN = 1, WK_WIN = 2 };
template <class C> HD inline int wsrc_col(int kind, int n) {
    if (kind == WK_FFNIN) { const int pn = n >> 8, j = n & 255; return j < 128 ? 128 * pn + j : C::FF + 128 * pn + (j - 128); }
    if (kind == WK_WIN) return n < C::INC ? n : -1;
    return n;
}

template <class C> HD inline void st_ml_b0(const Ptrs& p, int l, int sq) {
    const float* CBL = wsf<C>(p, C::WS_CBL); const float* CML = wsf<C>(p, C::WS_CML); float* MPREV = wsf<C>(p, C::WS_MPREV);
    if (sq < C::BATCH * C::MH) { float m = 0.f;
        for (int c = 0; c < C::NC; ++c) { const int ci = sq * C::NC + c; MPREV[ci] = m; const float a = CBL[ci] + m, b2 = CML[ci]; m = a > b2 ? a : b2; }
        p.out[C::OUT_MP + (size_t)l * C::BATCH * C::MH + sq] = m;
    } else { const int q = sq - C::BATCH * C::MH, ci = C::NPC + q; const float m0 = p.in[I_SM][(size_t)l * C::DEC_BATCH * C::MH + q];
        MPREV[ci] = m0; const float a = CBL[ci] + m0, b2 = CML[ci]; p.out[C::OUT_MS + (size_t)l * C::DEC_BATCH * C::MH + q] = a > b2 ? a : b2; }
}

namespace pg8 {
#define PG8_LAS __attribute__((address_space(3)))
typedef unsigned short bf16_t;
typedef short bf16x8 __attribute__((ext_vector_type(8)));
typedef float f32x4 __attribute__((ext_vector_type(4)));
typedef unsigned u32x4 __attribute__((ext_vector_type(4)));
constexpr int BM = 256, BK = 64, HALF = 128, HTB = HALF * BK * 2  , STAGE_BYTES = 8 * HTB, NXCD = 8, WGM = 8;

__host__ __device__ __forceinline__ int lds_byte(int r, int c) { const int st = (r >> 4) * 2 + (c >> 5), rr = r & 15, cc = c & 31, ob = rr * 64 + cc * 2; return st * 1024 + (ob ^ (((ob >> 9) & 1) << 5)); }
__host__ __device__ __forceinline__ void stage_rc(int b, int& R, int& C) { const int st = b / 1024, sb = b % 1024, swz = sb ^ (((sb >> 9) & 1) << 5); R = (st >> 1) * 16 + swz / 64; C = (st & 1) * 32 + (swz % 64) / 2; }
__host__ __device__ __forceinline__ int perm32(int rho) { const int n = rho >> 4, i = rho & 15; return 8 * (i >> 2) + 4 * n + (i & 3); }

struct Unit { int pm, pn; };
struct Gemm { const bf16_t* A; const bf16_t* Bt; int M, N, K, ld; };

struct StaticOrder {
    int nM, nN, nwg, G, c;
    __host__ __device__ __forceinline__ void init(int M, int N, int G_, int c_, int rows_per_tile = BM) { nM = M / rows_per_tile; nN = N / BM; nwg = nM * nN; G = G_; c = c_; }
    __host__ __device__ __forceinline__ bool next(int i, Unit& u) const {
        const long L = (long)i * G + c; if (L >= nwg) return false;
        int wgid = (int)L; { const int q = nwg / NXCD, r = nwg % NXCD, xcd = wgid % NXCD, off = wgid / NXCD; wgid = (xcd < r ? xcd * (q + 1) : r * (q + 1) + (xcd - r) * q) + off; }
        const int nig = WGM * nN, gid = wgid / nig, fm = gid * WGM, gsz = (nM - fm) < WGM ? (nM - fm) : WGM;
        u.pm = fm + ((wgid % nig) % gsz); u.pn = (wgid % nig) / gsz; return true;
    }
    __device__ __forceinline__ void a_ready(const Unit&) const {}
    __device__ __forceinline__ void done(const Unit&) const {}
};
__device__ __forceinline__ unsigned cvt_pk_bf16(float lo, float hi) { unsigned r; asm volatile("v_cvt_pk_bf16_f32 %0, %1, %2" : "=v"(r) : "v"(lo), "v"(hi)); return r; }
typedef float f32x2 __attribute__((ext_vector_type(2)));
template <class Epi, class Sched, bool STRIP = false, bool STAMP = false>
__device__ __forceinline__ void gemm_phase(PG8_LAS unsigned char* lds, const Gemm g, const Sched& S, const Epi& E, unsigned long long* stamps) {
    int tid_l = threadIdx.x; asm volatile("" : "+v"(tid_l));
    const int tid = tid_l, wid = __builtin_amdgcn_readfirstlane(tid >> 6), lane = tid & 63, wr = wid >> 2, wc = wid & 3, fr = lane & 15, fq = lane >> 4;
    const int K = g.K, nt = K / BK;
    int ts_lo = 0, ts_hi = 0, nts = 0; const unsigned long long rt_entry = STAMP ? (unsigned long long)wall_clock64() : 0ull;
#define PG8_STAMP() do { if (STAMP && wid == 0 && nts < 64) { const unsigned long long _c = (unsigned long long)clock64(); \
        ts_lo = (lane == nts) ? (int)(unsigned)_c : ts_lo; ts_hi = (lane == nts) ? (int)(unsigned)(_c >> 32) : ts_hi; ++nts; } } while (0)
    PG8_STAMP();
    unsigned voffA[2], voffB[2];
#pragma unroll
    for (int i = 0; i < 2; ++i) { int R, C; stage_rc(tid * 16 + i * 8192, R, C); const int Rb = Epi::PERM ? ((R & ~31) + perm32(R & 31)) : R;
        voffA[i] = (unsigned)(R * g.ld + C) * 2u; voffB[i] = (unsigned)(Rb * g.ld + C) * 2u; }
    const size_t kstep = (size_t)(BK * 2);
    const size_t hstep = (size_t)HALF * g.ld * 2;
    const size_t tstep = 2 * hstep;
    const size_t tstepA = STRIP ? (size_t)288 * g.ld * 2 : tstep;
    unsigned voffS = 0u; if constexpr (STRIP) { int R, C; stage_rc((wid & 3) * 1024 + lane * 16, R, C); voffS = (unsigned)(R * g.ld + C) * 2u; }
    const int soff = lds_byte(wr * 16 + fr, fq * 8);
    const unsigned ldsw = (unsigned)wid * 1024u;
    const int aoff = lds_byte(wr * 64 + fr, fq * 8), boff = lds_byte(wc * 32 + fr, fq * 8);
#define PG8_SA(b, h) (((b) * 2 + (h)) * HTB)
#define PG8_SB(b, h) ((4 + (b) * 2 + (h)) * HTB)
#define PG8_SS(b) (8 * HTB + (b) * 8192)
#define PG8_STAGE_S(b, gbase) do { if constexpr (STRIP) __builtin_amdgcn_global_load_lds((const unsigned*)((const char*)(gbase) + 2 * hstep + voffS), (PG8_LAS unsigned*)(lds + PG8_SS(b) + ldsw), 16, 0, 0); } while (0)
#define PG8_LDS(b) do { if constexpr (STRIP) { _Pragma("unroll") for (int k = 0; k < 2; ++k) Sf[k] = *(const PG8_LAS bf16x8*)(lds + PG8_SS(b) + soff + k * 1024); } } while (0)
#define PG8_MMS(bj, Bt) do { if constexpr (STRIP) { __builtin_amdgcn_s_setprio(1); _Pragma("unroll") for (int n = 0; n < 2; ++n) _Pragma("unroll") for (int k = 0; k < 2; ++k) accS[bj][n] = __builtin_amdgcn_mfma_f32_16x16x32_bf16(Bt[n][k], Sf[k], accS[bj][n], 0, 0, 0); __builtin_amdgcn_s_setprio(0); } } while (0)
#define PG8_STAGE(bufoff, gbase, voff) do { _Pragma("unroll") for (int _i = 0; _i < 2; ++_i) \
        __builtin_amdgcn_global_load_lds((const unsigned*)((const char*)(gbase) + (voff)[_i]), (PG8_LAS unsigned*)(lds + (bufoff) + ldsw + _i * 8192), 16, 0, 0); } while (0)
#define PG8_LDA(dst, b, h) do { _Pragma("unroll") for (int m = 0; m < 4; ++m) _Pragma("unroll") for (int k = 0; k < 2; ++k) dst[m][k] = *(const PG8_LAS bf16x8*)(lds + PG8_SA(b, h) + aoff + m * 2048 + k * 1024); } while (0)
#define PG8_LDB(dst, b, h) do { _Pragma("unroll") for (int n = 0; n < 2; ++n) _Pragma("unroll") for (int k = 0; k < 2; ++k) dst[n][k] = *(const PG8_LAS bf16x8*)(lds + PG8_SB(b, h) + boff + n * 2048 + k * 1024); } while (0)
#define PG8_MMA(ai, bj, At, Bt) do { __builtin_amdgcn_s_setprio(1); _Pragma("unroll") for (int m = 0; m < 4; ++m) _Pragma("unroll") for (int n = 0; n < 2; ++n) _Pragma("unroll") for (int k = 0; k < 2; ++k) \
        acc[ai][bj][m][n] = __builtin_amdgcn_mfma_f32_16x16x32_bf16(Bt[n][k], At[m][k], acc[ai][bj][m][n], 0, 0, 0); __builtin_amdgcn_s_setprio(0); } while (0)
#define PG8_WAIT_V(n) asm volatile("s_waitcnt vmcnt(" #n ")" ::: "memory")
#define PG8_WAIT_L(n) asm volatile("s_waitcnt lgkmcnt(" #n ")" ::: "memory")
#define PG8_WAIT_VS(n, ns) do { if constexpr (STRIP) PG8_WAIT_V(ns); else PG8_WAIT_V(n); } while (0)
#define PG8_WAIT_LS(n, ns) do { if constexpr (STRIP) PG8_WAIT_L(ns); else PG8_WAIT_L(n); } while (0)
#define PG8_BAR __builtin_amdgcn_s_barrier()
#define PG8_SCHED __builtin_amdgcn_sched_barrier(0)
    Unit cur, nxt; int ui = 0;
    if (!S.next(0, cur)) return;
    f32x4 acc[2][2][4][2];
#pragma unroll
    for (int a = 0; a < 2; ++a)
#pragma unroll
        for (int b = 0; b < 2; ++b)
#pragma unroll
            for (int m = 0; m < 4; ++m)
#pragma unroll
                for (int n = 0; n < 2; ++n) acc[a][b][m][n] = (f32x4){0.f, 0.f, 0.f, 0.f};
    bf16x8 At[4][2], B0[2][2], B1[2][2];
    f32x4 accS[2][2]; bf16x8 Sf[2];
#pragma unroll
    for (int b = 0; b < 2; ++b)
#pragma unroll
        for (int n = 0; n < 2; ++n) accS[b][n] = (f32x4){0.f, 0.f, 0.f, 0.f};
#pragma unroll
    for (int k = 0; k < 2; ++k) Sf[k] = (bf16x8){0, 0, 0, 0, 0, 0, 0, 0};
    const char* cA = (const char*)g.A + (size_t)cur.pm * tstepA; const char* cB = (const char*)g.Bt + (size_t)cur.pn * tstep;
    S.a_ready(cur);
    PG8_STAGE(PG8_SB(0, 0), cB, voffB); PG8_STAGE(PG8_SA(0, 0), cA, voffA); PG8_STAGE(PG8_SB(0, 1), cB + hstep, voffB); PG8_STAGE(PG8_SA(0, 1), cA + hstep, voffA); PG8_STAGE_S(0, cA);
    if (wr == 1) PG8_BAR;
    PG8_WAIT_VS(4, 5); PG8_BAR;
    PG8_STAGE(PG8_SB(1, 0), cB + kstep, voffB); PG8_STAGE(PG8_SA(1, 0), cA + kstep, voffA); PG8_STAGE(PG8_SB(1, 1), cB + hstep + kstep, voffB); PG8_STAGE_S(1, cA + kstep);
    PG8_WAIT_VS(6, 7); PG8_BAR;
    PG8_STAMP();
    for (;;) {
        const bool has_next = S.next(ui + 1, nxt);
        const char* nA = has_next ? (const char*)g.A + (size_t)nxt.pm * tstepA : cA; const char* nB = has_next ? (const char*)g.Bt + (size_t)nxt.pn * tstep : cB;
        for (int t = 0; t < nt; t += 2) {
            const bool last = (t == nt - 2);
            const char* a1 = cA + (size_t)(t + 1) * kstep;
            const char* a2 = last ? nA : cA + (size_t)(t + 2) * kstep; const char* b2 = last ? nB : cB + (size_t)(t + 2) * kstep;
            const char* a3 = a2 + kstep; const char* b3 = b2 + kstep;
            if (last && has_next) S.a_ready(nxt);
            PG8_LDB(B0, 0, 0); PG8_SCHED; PG8_LDA(At, 0, 0); PG8_LDS(0); PG8_STAGE(PG8_SA(1, 1), a1 + hstep, voffA);
            PG8_WAIT_LS(8, 10); PG8_BAR; PG8_WAIT_L(0); PG8_MMA(0, 0, At, B0); PG8_MMS(0, B0); PG8_BAR; PG8_SCHED;
            PG8_LDB(B1, 0, 1); PG8_STAGE(PG8_SB(0, 0), b2, voffB);
            PG8_BAR; PG8_WAIT_L(0); PG8_MMA(0, 1, At, B1); PG8_MMS(1, B1); PG8_BAR;
            PG8_LDA(At, 0, 1); PG8_STAGE(PG8_SA(0, 0), a2, voffA); PG8_STAGE_S(0, a2);
            PG8_BAR; PG8_WAIT_L(0); PG8_MMA(1, 0, At, B0); PG8_BAR; PG8_SCHED;
            PG8_STAGE(PG8_SB(0, 1), b2 + hstep, voffB);
            PG8_WAIT_VS(6, 7); PG8_BAR; PG8_MMA(1, 1, At, B1); PG8_BAR;
            PG8_LDB(B0, 1, 0); PG8_SCHED; PG8_LDA(At, 1, 0); PG8_LDS(1); PG8_STAGE(PG8_SA(0, 1), a2 + hstep, voffA);
            PG8_WAIT_LS(8, 10); PG8_BAR; PG8_WAIT_L(0); PG8_MMA(0, 0, At, B0); PG8_MMS(0, B0); PG8_BAR; PG8_SCHED;
            PG8_LDB(B1, 1, 1); PG8_STAGE(PG8_SB(1, 0), b3, voffB);
            PG8_BAR; PG8_WAIT_L(0); PG8_MMA(0, 1, At, B1); PG8_MMS(1, B1); PG8_BAR;
            PG8_LDA(At, 1, 1); PG8_STAGE(PG8_SA(1, 0), a3, voffA); PG8_STAGE_S(1, a3);
            PG8_BAR; PG8_WAIT_L(0); PG8_MMA(1, 0, At, B0); PG8_BAR; PG8_SCHED;
            PG8_STAGE(PG8_SB(1, 1), b3 + hstep, voffB);
            PG8_WAIT_VS(6, 7); PG8_BAR; PG8_MMA(1, 1, At, B1); PG8_BAR;
        }
        PG8_STAMP();
        { const int rt0 = cur.pm * (STRIP ? 288 : 256), rw0 = rt0 + wr * 64 + fr;
#define PG8_RV(ai, m) {{acc[ai][0][m][0], acc[ai][0][m][1]}, {acc[ai][1][m][0], acc[ai][1][m][1]}}
#define PG8_BATCH(r0_, v0_, r1_, v1_) do { const typename Epi::Pre p0_ = E.pre(r0_, cur.pn, wc, fq), p1_ = E.pre(r1_, cur.pn, wc, fq); \
              { const f32x4 v_[2][2] = v0_; E.row(v_, p0_, r0_, cur.pn, wc, fq); } { const f32x4 v_[2][2] = v1_; E.row(v_, p1_, r1_, cur.pn, wc, fq); } } while (0)
          if constexpr (Epi::PRE_ALL) {
              typename Epi::Pre pa_[9];
#pragma unroll
              for (int q_ = 0; q_ < 8; ++q_) pa_[q_] = E.pre(rw0 + (q_ >> 2) * HALF + (q_ & 3) * 16, cur.pn, wc, fq);
              pa_[8] = STRIP ? E.pre(rt0 + 256 + wr * 16 + fr, cur.pn, wc, fq) : pa_[0];
#define PG8_ONE(q_, ai, m) { const f32x4 v_[2][2] = PG8_RV(ai, m); E.row(v_, pa_[q_], rw0 + ai * HALF + m * 16, cur.pn, wc, fq); }
              PG8_ONE(0, 0, 0) PG8_ONE(1, 0, 1) PG8_ONE(2, 0, 2) PG8_ONE(3, 0, 3) PG8_ONE(4, 1, 0) PG8_ONE(5, 1, 1) PG8_ONE(6, 1, 2) PG8_ONE(7, 1, 3)
#undef PG8_ONE
              if constexpr (STRIP) E.row(accS, pa_[8], rt0 + 256 + wr * 16 + fr, cur.pn, wc, fq);
#if defined(PROBE_EPI2)
              asm volatile("" ::: "memory");
#pragma unroll
              for (int q_ = 0; q_ < 8; ++q_) pa_[q_] = E.pre(rw0 + (q_ >> 2) * HALF + (q_ & 3) * 16, cur.pn, wc, fq);
              pa_[8] = STRIP ? E.pre(rt0 + 256 + wr * 16 + fr, cur.pn, wc, fq) : pa_[0];
#define PG8_ONE(q_, ai, m) { const f32x4 v_[2][2] = PG8_RV(ai, m); E.row(v_, pa_[q_], rw0 + ai * HALF + m * 16, cur.pn, wc, fq); }
              PG8_ONE(0, 0, 0) PG8_ONE(1, 0, 1) PG8_ONE(2, 0, 2) PG8_ONE(3, 0, 3) PG8_ONE(4, 1, 0) PG8_ONE(5, 1, 1) PG8_ONE(6, 1, 2) PG8_ONE(7, 1, 3)
#undef PG8_ONE
              if constexpr (STRIP) E.row(accS, pa_[8], rt0 + 256 + wr * 16 + fr, cur.pn, wc, fq);
#endif
          } else {
          PG8_BATCH(rw0, PG8_RV(0, 0), rw0 + 16, PG8_RV(0, 1));
          PG8_BATCH(rw0 + 32, PG8_RV(0, 2), rw0 + 48, PG8_RV(0, 3));
          PG8_BATCH(rw0 + HALF, PG8_RV(1, 0), rw0 + HALF + 16, PG8_RV(1, 1));
          PG8_BATCH(rw0 + HALF + 32, PG8_RV(1, 2), rw0 + HALF + 48, PG8_RV(1, 3));
          if constexpr (STRIP) { const int rs_ = rt0 + 256 + wr * 16 + fr; const typename Epi::Pre ps_ = E.pre(rs_, cur.pn, wc, fq); E.row(accS, ps_, rs_, cur.pn, wc, fq); }
          }
          if constexpr (STRIP) {
#pragma unroll
              for (int b = 0; b < 2; ++b)
#pragma unroll
                for (int n = 0; n < 2; ++n) accS[b][n] = (f32x4){0.f, 0.f, 0.f, 0.f}; }
#undef PG8_BATCH
#undef PG8_RV
          S.done(cur); }
        PG8_STAMP();
        if (!has_next) break;
#pragma unroll
        for (int a = 0; a < 2; ++a)
#pragma unroll
            for (int b = 0; b < 2; ++b)
#pragma unroll
                for (int m = 0; m < 4; ++m)
#pragma unroll
                    for (int n = 0; n < 2; ++n) acc[a][b][m][n] = (f32x4){0.f, 0.f, 0.f, 0.f};
        cur = nxt; cA = nA; cB = nB; ++ui;
    }
    PG8_WAIT_V(0);
    if (wr == 0) PG8_BAR;
    PG8_BAR;
    PG8_STAMP();
    if (STAMP && wid == 0) { stamps[lane] = lane < nts ? (((unsigned long long)(unsigned)ts_hi << 32) | (unsigned)ts_lo) : 0ull;
        if (lane == 62) stamps[62] = rt_entry; if (lane == 63) stamps[63] = (unsigned long long)wall_clock64(); }
#undef PG8_STAMP
#undef PG8_SA
#undef PG8_SB
#undef PG8_STAGE
#undef PG8_LDA
#undef PG8_LDB
#undef PG8_MMA
#undef PG8_WAIT_V
#undef PG8_WAIT_L
#undef PG8_BAR
#undef PG8_SCHED
#undef PG8_WAIT_LS
#undef PG8_WAIT_VS
#undef PG8_MMS
#undef PG8_LDS
#undef PG8_STAGE_S
#undef PG8_SS
}
}


#define LAS __attribute__((address_space(3)))
#define XB_TMO      128
#define XB_XCNT(j)  (256  + 64 * (j))
#define XB_XSUB(j)  (1280 + 64 * (j))
#define XB_XGEN(j)  (2304 + 64 * (j))
#define XB_TOP      3328
#define XB_TOPGEN   3392
#define XCD_BAR_WORDS 3456
#define XB_SPIN_CAP (1u << 18)

__device__ __forceinline__ unsigned xb_ld(unsigned* p)              { return __hip_atomic_load(p, __ATOMIC_RELAXED, __HIP_MEMORY_SCOPE_AGENT); }
__device__ __forceinline__ unsigned xb_add(unsigned* p, unsigned v) { return __hip_atomic_fetch_add(p, v, __ATOMIC_RELAXED, __HIP_MEMORY_SCOPE_AGENT); }
__device__ __forceinline__ unsigned xb_xcc_id() { return (unsigned)__builtin_amdgcn_s_getreg((3 << 11) | 20) & 0xFu; }
#define XB_SPIN(cond, bar) do { unsigned _sp = 0; while (cond) { __builtin_amdgcn_s_sleep(1); \
    if ((++_sp & 255u) == 0u) { if (xb_ld(&(bar)[XB_TMO])) break; if (_sp > XB_SPIN_CAP) { atomicAdd(&(bar)[XB_TMO], 1u); break; } } } } while (0)

struct XcdBarrier {
    unsigned* bar; unsigned x;
    volatile LAS unsigned* st;
};

__device__ __forceinline__ XcdBarrier xcd_barrier_post(unsigned* bar, volatile LAS unsigned* st) {
    XcdBarrier b; b.bar = bar; b.x = xb_xcc_id(); b.st = st;
    if (threadIdx.x == 0) (void)xb_add(&bar[XB_XCNT(b.x)], 1u);
    return b;
}
__device__ __forceinline__ void xcd_barrier_complete(unsigned* bar, unsigned x, unsigned& nloc, unsigned& nx) {
    const unsigned G = gridDim.x * gridDim.y * gridDim.z;
    unsigned sum, cnt, mine, sp = 0u;
    for (;;) {
        sum = 0u; cnt = 0u; mine = 0u;
#pragma unroll
        for (unsigned j = 0; j < 16; ++j) { const unsigned c = xb_ld(&bar[XB_XCNT(j)]); sum += c; cnt += (c > 0u) ? 1u : 0u; mine = (j == x) ? c : mine; }
        if (sum == G) break;
        __builtin_amdgcn_s_sleep(1);
        if ((++sp & 255u) == 0u) { if (xb_ld(&bar[XB_TMO])) break; if (sp > XB_SPIN_CAP) { atomicAdd(&bar[XB_TMO], 1u); break; } }
    }
    nloc = mine > 0u ? mine : 1u; nx = cnt > 0u ? cnt : 1u;
}

__device__ __forceinline__ void xcd_barrier(const XcdBarrier& b) {
    asm volatile("s_waitcnt vmcnt(0)" ::: "memory");
    __syncthreads();
    if (threadIdx.x == 0) {
        unsigned* bar = b.bar;
        __builtin_amdgcn_s_waitcnt(0);
        unsigned nloc = b.st[0], nx = b.st[1];
        if (nloc == 0u) { xcd_barrier_complete(bar, b.x, nloc, nx); b.st[0] = nloc; b.st[1] = nx; }
        const unsigned old = xb_add(&bar[XB_XSUB(b.x)], 1u);
        const unsigned gen = old / nloc;
        if (old + 1u == (gen + 1u) * nloc) {
            __builtin_amdgcn_fence(__ATOMIC_RELEASE, "agent");
            asm volatile("s_waitcnt vmcnt(0)" ::: "memory");
            const unsigned og = xb_add(&bar[XB_TOP], 1u);
            const unsigned tg = og / nx;
            if (og + 1u == (tg + 1u) * nx) xb_add(&bar[XB_TOPGEN], 1u);
            else XB_SPIN(xb_ld(&bar[XB_TOPGEN]) == tg, bar);
            __builtin_amdgcn_fence(__ATOMIC_ACQUIRE, "agent");
            xb_add(&bar[XB_XGEN(b.x)], 1u);
            asm volatile("s_waitcnt vmcnt(0)" ::: "memory");
        } else {
            XB_SPIN(xb_ld(&bar[XB_XGEN(b.x)]) == gen, bar);
            __builtin_amdgcn_fence(__ATOMIC_ACQUIRE, "agent");
            asm volatile("s_waitcnt vmcnt(0)" ::: "memory");
        }
    }
    __syncthreads();
}

typedef CfgT<RC> C;
constexpr int NTHREADS = 512, NWAVES = 8;
constexpr int LDS_STAGE = 131072 + 16384 + 8192, LDS_CTL = LDS_STAGE, LDS_BYTES = LDS_STAGE + 256;

namespace pg8 {
typedef unsigned u32x2 __attribute__((ext_vector_type(2)));
__device__ __forceinline__ float silu_f(float g) { return g * __builtin_amdgcn_rcpf(1.0f + __expf(-g)); }
struct EpiSwiGLU { static constexpr bool PERM = true, PRE_ALL = true;
    bf16_t* act; const float* ss; int ff; float invd;
    typedef float Pre;
    __device__ __forceinline__ Pre pre(int row, int pn, int wc, int fq) const { return ss[row]; }
    __device__ __forceinline__ void row(const f32x4 (&v)[2][2], Pre ssr, int row, int pn, int wc, int fq) const {
        const float rs = rsqrtf(ssr * invd + 1e-6f), nc = rs * -1.4426950408889634f, rs2 = rs * rs; f32x4 o[2];
#pragma unroll
        for (int n = 0; n < 2; ++n) { const f32x4 t = v[0][n] * nc, w = v[0][n] * v[1][n]; f32x4 e, r;
#pragma unroll
            for (int j = 0; j < 4; ++j) e[j] = __builtin_amdgcn_exp2f(t[j]);
            const f32x4 dd = e + 1.0f;
#pragma unroll
            for (int j = 0; j < 4; ++j) r[j] = __builtin_amdgcn_rcpf(dd[j]);
            o[n] = w * (r * rs2); }
        u32x4 w; w.x = cvt_pk_bf16(o[0][0], o[0][1]); w.y = cvt_pk_bf16(o[0][2], o[0][3]); w.z = cvt_pk_bf16(o[1][0], o[1][1]); w.w = cvt_pk_bf16(o[1][2], o[1][3]);
        *(u32x4*)(act + (size_t)row * ff + pn * 128 + wc * 32 + 8 * fq) = w;
    }
};
struct EpiResid { static constexpr bool PERM = false, PRE_ALL = false;
    float* X; bf16_t* XB; float* ssout; float scale; int ld;
    struct Pre { f32x4 x[2][2]; };
    __device__ __forceinline__ Pre pre(int row, int pn, int wc, int fq) const { Pre q; const float* xr = X + (size_t)row * ld + pn * BM + wc * 32 + 4 * fq;
#pragma unroll
        for (int bj = 0; bj < 2; ++bj)
#pragma unroll
            for (int n = 0; n < 2; ++n) q.x[bj][n] = *(const f32x4*)(xr + bj * HALF + n * 16);
        return q; }
    __device__ __forceinline__ void row(const f32x4 (&v)[2][2], const Pre& q, int row, int pn, int wc, int fq) const {
        const int col0 = pn * BM + wc * 32 + 4 * fq; float* xr = X + (size_t)row * ld + col0; bf16_t* br = XB + (size_t)row * ld + col0; float s = 0.f;
#pragma unroll
        for (int bj = 0; bj < 2; ++bj)
#pragma unroll
            for (int n = 0; n < 2; ++n) { const f32x4 x = q.x[bj][n] + v[bj][n] * scale; *(f32x4*)(xr + bj * HALF + n * 16) = x;
                u32x2 w; w.x = cvt_pk_bf16(x[0], x[1]); w.y = cvt_pk_bf16(x[2], x[3]); *(u32x2*)(br + bj * HALF + n * 16) = w;
                s += (x[0] * x[0] + x[1] * x[1]) + (x[2] * x[2] + x[3] * x[3]); }
        s += __shfl_xor(s, 16); s += __shfl_xor(s, 32);
        if (fq == 0) unsafeAtomicAdd(ssout + row, s);
    }
};
struct EpiScaleF32 { static constexpr bool PERM = false, PRE_ALL = true;
    float* Cp; int ldc; const float* ss; float invd;
    typedef float Pre;
    __device__ __forceinline__ Pre pre(int row, int pn, int wc, int fq) const { return ss[row]; }
    __device__ __forceinline__ void row(const f32x4 (&v)[2][2], Pre ssr, int row, int pn, int wc, int fq) const {
        const float rs = rsqrtf(ssr * invd + 1e-6f); float* cr = Cp + (size_t)row * ldc + pn * BM + wc * 32 + 4 * fq;
#pragma unroll
        for (int bj = 0; bj < 2; ++bj)
#pragma unroll
            for (int n = 0; n < 2; ++n) *(f32x4*)(cr + bj * HALF + n * 16) = v[bj][n] * rs;
    }
};
struct EpiScaleBf16 { static constexpr bool PERM = true, PRE_ALL = true;
    bf16_t* O; int ldc; const float* ss; float invd;
    typedef float Pre;
    __device__ __forceinline__ Pre pre(int row, int pn, int wc, int fq) const { return ss[row]; }
    __device__ __forceinline__ void row(const f32x4 (&v)[2][2], Pre ssr, int row, int pn, int wc, int fq) const {
        const float rs = rsqrtf(ssr * invd + 1e-6f); bf16_t* orow = O + (size_t)row * ldc + pn * BM + wc * 32 + 8 * fq;
#pragma unroll
        for (int bj = 0; bj < 2; ++bj) { const f32x4 v0 = v[bj][0] * rs, v1 = v[bj][1] * rs;
            u32x4 w; w.x = cvt_pk_bf16(v0[0], v0[1]); w.y = cvt_pk_bf16(v0[2], v0[3]); w.z = cvt_pk_bf16(v1[0], v1[1]); w.w = cvt_pk_bf16(v1[2], v1[3]);
            *(u32x4*)(orow + bj * HALF) = w; }
    }
};
struct EpiMemKV { static constexpr bool PERM = false, PRE_ALL = true;
    float* K; float* V; const float* rstd; int d; bf16_t* KVB; int mm;
    typedef float Pre;
    __device__ __forceinline__ Pre pre(int row, int pn, int wc, int fq) const { return rstd[row]; }
    __device__ __forceinline__ void row(const f32x4 (&v)[2][2], Pre rs, int row, int pn, int wc, int fq) const {
        int ct = pn * BM; float* base = K; bf16_t* bb = KVB; if (ct >= d) { base = V; ct -= d; bb += (size_t)mm * d; }
        float* cr = base + (size_t)row * d + ct + wc * 32 + 4 * fq; bb += (size_t)row * d + ct + wc * 32 + 4 * fq;
#pragma unroll
        for (int bj = 0; bj < 2; ++bj)
#pragma unroll
            for (int n = 0; n < 2; ++n) { const f32x4 o = v[bj][n] * rs; *(f32x4*)(cr + bj * HALF + n * 16) = o;
                u32x2 w; w.x = cvt_pk_bf16(o[0], o[1]); w.y = cvt_pk_bf16(o[2], o[3]); *(u32x2*)(bb + bj * HALF + n * 16) = w; }
    }
};
}

__device__ __forceinline__ void prep_item(const float* W, int K, int Ncols, const float* g, int kind, int N, bf16_t* Bt, LAS unsigned char* scr, int item, int lane) {
    const int nblk = N / 64, kb = item / nblk, nb = item % nblk, k0 = 64 * kb, n = 64 * nb + lane;
    const int sc = wsrc_col<C>(kind, n);
    const float* src = W + (size_t)k0 * Ncols + (sc >= 0 ? sc : 0);
    float v[64];
#pragma unroll
    for (int kk = 0; kk < 64; ++kk) v[kk] = src[(size_t)kk * Ncols];
    if (g) {
#pragma unroll
        for (int kk = 0; kk < 64; ++kk) v[kk] *= g[k0 + kk];
    }
    if (sc < 0) {
#pragma unroll
        for (int kk = 0; kk < 64; ++kk) v[kk] = 0.f;
    }
#pragma unroll
    for (int j = 0; j < 8; ++j) { pg8::u32x4 o; o.x = pg8::cvt_pk_bf16(v[8 * j], v[8 * j + 1]); o.y = pg8::cvt_pk_bf16(v[8 * j + 2], v[8 * j + 3]); o.z = pg8::cvt_pk_bf16(v[8 * j + 4], v[8 * j + 5]); o.w = pg8::cvt_pk_bf16(v[8 * j + 6], v[8 * j + 7]);
        *(LAS pg8::u32x4*)(scr + lane * 144 + j * 16) = o; }
    asm volatile("s_waitcnt lgkmcnt(0)" ::: "memory");
    bf16_t* dst = Bt + (size_t)(64 * nb) * K + k0 + (lane & 7) * 8;
#pragma unroll
    for (int it = 0; it < 8; ++it) { const int row = it * 8 + (lane >> 3); const pg8::u32x4 o = *(const LAS pg8::u32x4*)(scr + row * 144 + (lane & 7) * 16);
        *(pg8::u32x4*)(dst + (size_t)row * K) = o; }
    asm volatile("s_waitcnt lgkmcnt(0)" ::: "memory");
}
struct WDesc { const float* W; const float* g; bf16_t* dst; int K, Ncols, kind, N; };
__device__ __forceinline__ WDesc wdesc(const Ptrs& p, int l, int idx) {
    WDesc d; d.g = nullptr; d.kind = WK_PLAIN;
    switch (idx) {
    case 0: d.W = p.in[I_W1IN] + (size_t)l * C::D * 2 * C::FF; d.K = C::D; d.Ncols = 2 * C::FF; d.N = 2 * C::FF; d.g = p.in[I_GFFN1] + l * C::D; d.kind = WK_FFNIN; d.dst = wlayer<C>(p, l, C::W_1IN); break;
    case 1: d.W = p.in[I_W1OUT] + (size_t)l * C::FF * C::D; d.K = C::FF; d.Ncols = C::D; d.N = C::D; d.dst = wlayer<C>(p, l, C::W_1OUT); break;
    case 2: d.W = p.in[I_WIN] + (size_t)l * C::D * C::INC; d.K = C::D; d.Ncols = C::INC; d.N = C::LDP; d.g = p.in[I_GMIX] + l * C::D; d.kind = WK_WIN; d.dst = wlayer<C>(p, l, C::W_IN); break;
    case 3: d.W = p.in[I_WOUT] + (size_t)l * C::D * C::D; d.K = C::D; d.Ncols = C::D; d.N = C::D; d.dst = wlayer<C>(p, l, C::W_OUT); break;
    case 4: d.W = p.in[I_WQ] + (size_t)l * C::D * C::D; d.K = C::D; d.Ncols = C::D; d.N = C::D; d.g = p.in[I_GX] + l * C::D; d.dst = wlayer<C>(p, l, C::W_Q); break;
    case 5: d.W = p.in[I_WK] + (size_t)l * C::D * C::D; d.K = C::D; d.Ncols = C::D; d.N = C::D; d.g = p.in[I_GMEM] + l * C::D; d.dst = wlayer<C>(p, l, C::W_KV); break;
    case 6: d.W = p.in[I_WV] + (size_t)l * C::D * C::D; d.K = C::D; d.Ncols = C::D; d.N = C::D; d.g = p.in[I_GMEM] + l * C::D; d.dst = wlayer<C>(p, l, C::W_KV) + (size_t)C::D * C::D; break;
    case 7: d.W = p.in[I_WO] + (size_t)l * C::D * C::D; d.K = C::D; d.Ncols = C::D; d.N = C::D; d.dst = wlayer<C>(p, l, C::W_O); break;
    case 8: d.W = p.in[I_W2IN] + (size_t)l * C::D * 2 * C::FF; d.K = C::D; d.Ncols = 2 * C::FF; d.N = 2 * C::FF; d.g = p.in[I_GFFN2] + l * C::D; d.kind = WK_FFNIN; d.dst = wlayer<C>(p, l, C::W_2IN); break;
    default: d.W = p.in[I_W2OUT] + (size_t)l * C::FF * C::D; d.K = C::FF; d.Ncols = C::D; d.N = C::D; d.dst = wlayer<C>(p, l, C::W_2OUT); break;
    }
    return d;
}

#define WG_SYNC() do { asm volatile("s_waitcnt lgkmcnt(0)" ::: "memory"); __builtin_amdgcn_s_barrier(); asm volatile("" ::: "memory"); } while (0)
namespace att {
typedef short bf16x8 __attribute__((ext_vector_type(8)));
typedef short s16x4 __attribute__((ext_vector_type(4)));
typedef float f32x4 __attribute__((ext_vector_type(4)));
typedef unsigned u32x2 __attribute__((ext_vector_type(2)));
constexpr int TOK = 256, CD = 64, PITCH = 144, CBYTES = TOK * PITCH, HDIM = 512, NH = 4, LD = 2048;
static_assert(C::NMEM == TOK && C::AHD == HDIM && C::AH == NH && C::D == LD && C::DEC_SEQ == 32 && C::SEQ % 256 == 0, "attention phase is built for these shapes");
__device__ __forceinline__ s16x4 tr_read(unsigned addr) { s16x4 r; asm volatile("ds_read_b64_tr_b16 %0, %1" : "=&v"(r) : "v"(addr) : "memory"); return r; }
__device__ __forceinline__ void stage_load(f32x4 (&r)[8], const float* src, int tid) {
    const unsigned off0 = (unsigned)(((tid >> 4) * LD + (tid & 15) * 4) * 4);
#pragma unroll
    for (int i = 0; i < 8; ++i) { const float* si = src + (size_t)i * 32 * LD; asm volatile("" : "+s"(si));
        r[i] = *(const f32x4*)((const char*)si + off0); }
    __builtin_amdgcn_sched_barrier(0);
}
__device__ __forceinline__ void stage_load_b(pg8::u32x4 (&r)[4], const bf16_t* src, int tid) {
    const unsigned off0 = (unsigned)(((tid >> 3) * LD + (tid & 7) * 8) * 2);
#pragma unroll
    for (int i = 0; i < 4; ++i) { const bf16_t* si = src + (size_t)i * 64 * LD; asm volatile("" : "+s"(si)); r[i] = *(const pg8::u32x4*)((const char*)si + off0); }
    __builtin_amdgcn_sched_barrier(0);
}
__device__ __forceinline__ int klds(int r, int c) { const int ob = (r & 15) * 64 + (c & 31) * 2; return ((r >> 4) * 2 + (c >> 5)) * 1024 + (ob ^ (((ob >> 9) & 1) << 5)); }
__device__ __forceinline__ void stage_store_k(const f32x4 (&r)[8], LAS unsigned char* buf, int tid) {
#pragma unroll
    for (int i = 0; i < 8; ++i) { const int f = tid + 512 * i; u32x2 w; w.x = pg8::cvt_pk_bf16(r[i][0], r[i][1]); w.y = pg8::cvt_pk_bf16(r[i][2], r[i][3]);
        *(LAS u32x2*)(buf + klds(f >> 4, (f & 15) * 4)) = w; }
}
__device__ __forceinline__ void stage_store_kb(const pg8::u32x4 (&r)[4], LAS unsigned char* buf, int tid) {
    asm volatile("" : "+v"(tid));
#pragma unroll
    for (int i = 0; i < 4; ++i) *(LAS pg8::u32x4*)(buf + klds((tid >> 3) + 64 * i, (tid & 7) * 8)) = r[i];
}
__device__ __forceinline__ void stage_store_vb(const pg8::u32x4 (&r)[4], LAS unsigned char* buf, int tid) {
    asm volatile("" : "+v"(tid));
#pragma unroll
    for (int i = 0; i < 4; ++i) *(LAS pg8::u32x4*)(buf + ((tid >> 3) + 64 * i) * PITCH + (tid & 7) * 16) = r[i];
}
__device__ __forceinline__ void stage_store(const f32x4 (&r)[8], LAS unsigned char* buf, int tid) {
#pragma unroll
    for (int i = 0; i < 8; ++i) { const int f = tid + 512 * i; u32x2 w; w.x = pg8::cvt_pk_bf16(r[i][0], r[i][1]); w.y = pg8::cvt_pk_bf16(r[i][2], r[i][3]);
        *(LAS u32x2*)(buf + (f >> 4) * PITCH + (f & 15) * 8) = w; }
}
__device__ __forceinline__ void attn_sample_unit(LAS unsigned char* lds, const bf16_t* Qg, bf16_t* AO, const float* kb, const float* vb, int row0, int head, int tid) {
    const int lane = tid & 63, wave = __builtin_amdgcn_readfirstlane(tid >> 6), li = lane & 15, g = lane >> 4;
    constexpr int PP = 528;
    LAS unsigned char* Ps = lds + 2 * CBYTES;
    LAS float* smax = (LAS float*)(Ps + 32 * PP); LAS float* ssum = smax + 8 * 32;
    const bf16_t* q0 = Qg + (size_t)(row0 + li) * LD + head * HDIM + g * 8;
    f32x4 s[2][2];
#pragma unroll
    for (int u = 0; u < 2; ++u)
#pragma unroll
        for (int tt = 0; tt < 2; ++tt) s[u][tt] = (f32x4){0.f, 0.f, 0.f, 0.f};
    f32x4 r0[8], r1[8]; bf16x8 qf[2][2];
    stage_load(r0, kb, tid); stage_load(r1, kb + CD, tid);
#pragma unroll
    for (int u = 0; u < 2; ++u)
#pragma unroll
        for (int ks = 0; ks < 2; ++ks) qf[u][ks] = *(const bf16x8*)(q0 + (size_t)u * 16 * LD + ks * 32);
    stage_store(r0, lds, tid);
    WG_SYNC();
    stage_load(r0, kb + 2 * CD, tid);
#define ATS_SRC(cc) ((cc) < 8 ? kb + (cc) * CD : vb + ((cc) - 8) * CD)
#define ATS_SCORE(cc, REGN, REGF) do { LAS unsigned char* buf = lds + ((cc) & 1) * CBYTES; \
        _Pragma("unroll") for (int ks = 0; ks < 2; ++ks) _Pragma("unroll") for (int tt = 0; tt < 2; ++tt) { const bf16x8 a = *(const LAS bf16x8*)(buf + ((2 * wave + tt) * 16 + li) * PITCH + ks * 64 + g * 16); \
            s[0][tt] = __builtin_amdgcn_mfma_f32_16x16x32_bf16(a, qf[0][ks], s[0][tt], 0, 0, 0); s[1][tt] = __builtin_amdgcn_mfma_f32_16x16x32_bf16(a, qf[1][ks], s[1][tt], 0, 0, 0); } \
        if ((cc) < 7) { __builtin_amdgcn_sched_barrier(0); _Pragma("unroll") for (int u = 0; u < 2; ++u) _Pragma("unroll") for (int ks = 0; ks < 2; ++ks) qf[u][ks] = *(const bf16x8*)(q0 + (size_t)u * 16 * LD + ((cc) + 1) * CD + ks * 32); __builtin_amdgcn_sched_barrier(0); } \
        stage_store(REGN, lds + (((cc) + 1) & 1) * CBYTES, tid); WG_SYNC(); stage_load(REGF, ATS_SRC((cc) + 3), tid); } while (0)
    ATS_SCORE(0, r1, r1); ATS_SCORE(1, r0, r0); ATS_SCORE(2, r1, r1); ATS_SCORE(3, r0, r0); ATS_SCORE(4, r1, r1); ATS_SCORE(5, r0, r0); ATS_SCORE(6, r1, r1); ATS_SCORE(7, r0, r0);
    const float sc = 0.044194173824159216f * 1.4426950408889634f;
#pragma unroll
    for (int u = 0; u < 2; ++u) { float mx = fmaxf(fmaxf(fmaxf(s[u][0][0], s[u][0][1]), fmaxf(s[u][0][2], s[u][0][3])), fmaxf(fmaxf(s[u][1][0], s[u][1][1]), fmaxf(s[u][1][2], s[u][1][3])));
        mx = fmaxf(mx, __shfl_xor(mx, 16)); mx = fmaxf(mx, __shfl_xor(mx, 32));
        if (g == 0) smax[wave * 32 + u * 16 + li] = mx; }
    WG_SYNC();
#pragma unroll
    for (int u = 0; u < 2; ++u) { float mx = smax[u * 16 + li];
#pragma unroll
        for (int w = 1; w < 8; ++w) mx = fmaxf(mx, smax[w * 32 + u * 16 + li]);
        float sum = 0.f;
#pragma unroll
        for (int tt = 0; tt < 2; ++tt) {
#pragma unroll
            for (int j = 0; j < 4; ++j) { const float e = __builtin_amdgcn_exp2f((s[u][tt][j] - mx) * sc); s[u][tt][j] = e; sum += e; }
            u32x2 w2; w2.x = pg8::cvt_pk_bf16(s[u][tt][0], s[u][tt][1]); w2.y = pg8::cvt_pk_bf16(s[u][tt][2], s[u][tt][3]);
            *(LAS u32x2*)(Ps + (u * 16 + li) * PP + (32 * wave + 16 * tt + 4 * g) * 2) = w2; }
        sum += __shfl_xor(sum, 16); sum += __shfl_xor(sum, 32);
        if (g == 0) ssum[wave * 32 + u * 16 + li] = sum; }
    WG_SYNC();
    const int dt = wave & 3, uq = wave >> 2;
    float inv;
    { float sum = 0.f;
#pragma unroll
      for (int w = 0; w < 8; ++w) sum += ssum[w * 32 + uq * 16 + li];
      inv = 1.0f / sum; }
    bf16x8 pfr[8];
#pragma unroll
    for (int t = 0; t < 8; ++t) pfr[t] = *(const LAS bf16x8*)(Ps + (uq * 16 + li) * PP + (32 * t + 8 * g) * 2);
    const unsigned trb8 = (unsigned)(size_t)lds + (unsigned)((8 * g + (li >> 2)) * PITCH + (li & 3) * 8 + dt * 32);
#define ATS_PV(cc, REGN, REGF) do { const unsigned bofs = (unsigned)((cc) & 1) * CBYTES; f32x4 o = (f32x4){0.f, 0.f, 0.f, 0.f}; s16x4 lo[8], hi[8]; \
        _Pragma("unroll") for (int t = 0; t < 8; ++t) { lo[t] = tr_read(trb8 + bofs + (unsigned)(t * 32 * PITCH)); hi[t] = tr_read(trb8 + bofs + (unsigned)(t * 32 * PITCH + 4 * PITCH)); } \
        asm volatile("s_waitcnt lgkmcnt(0)" ::: "memory"); __builtin_amdgcn_sched_barrier(0); \
        _Pragma("unroll") for (int t = 0; t < 8; ++t) { const bf16x8 a = (bf16x8){lo[t][0], lo[t][1], lo[t][2], lo[t][3], hi[t][0], hi[t][1], hi[t][2], hi[t][3]}; o = __builtin_amdgcn_mfma_f32_16x16x32_bf16(a, pfr[t], o, 0, 0, 0); } \
        { u32x2 w2; w2.x = pg8::cvt_pk_bf16(o[0] * inv, o[1] * inv); w2.y = pg8::cvt_pk_bf16(o[2] * inv, o[3] * inv); \
          *(u32x2*)(AO + (size_t)(row0 + 16 * uq + li) * LD + head * HDIM + ((cc) - 8) * CD + dt * 16 + g * 4) = w2; } \
        if ((cc) < 15) stage_store(REGN, lds + (((cc) + 1) & 1) * CBYTES, tid); WG_SYNC(); if ((cc) + 3 < 16) stage_load(REGF, ATS_SRC((cc) + 3), tid); } while (0)
    ATS_PV(8, r1, r1); ATS_PV(9, r0, r0); ATS_PV(10, r1, r1); ATS_PV(11, r0, r0); ATS_PV(12, r1, r1); ATS_PV(13, r0, r0); ATS_PV(14, r1, r1); ATS_PV(15, r0, r0);
#undef ATS_SRC
#undef ATS_SCORE
#undef ATS_PV
}
__device__ __forceinline__ void attn_sample_phase(LAS unsigned char* lds, const Ptrs& p, int l, int tid, int first, int stride) {
    const bf16_t* Qg = wsb<C>(p, C::WS_Q); bf16_t* AO = wsb<C>(p, C::WS_AO);
    for (int s = first; s < C::DEC_BATCH * NH; s += stride) { const int b = s / NH, head = s % NH;
        attn_sample_unit(lds, Qg, AO, p.in[I_CK] + ((size_t)l * C::DEC_BATCH + b) * TOK * LD + head * HDIM, p.in[I_CV] + ((size_t)l * C::DEC_BATCH + b) * TOK * LD + head * HDIM, C::MP + b * C::DEC_SEQ, head, tid); }
}
__device__ __forceinline__ void attn_phase(LAS unsigned char* lds, const Ptrs& p, int l, int tid, int bid, int gsz, int nunits) {
    const int lane = tid & 63, wave = __builtin_amdgcn_readfirstlane(tid >> 6), li = lane & 15, g = lane >> 4;
    const bf16_t* Qg = wsb<C>(p, C::WS_Q); bf16_t* AO = wsb<C>(p, C::WS_AO);
    constexpr int NUP = (C::MP / 256) * NH;
    static_assert(C::SEQ % 256 == 0, "prompt units are 256 rows");
    for (int un0 = bid; un0 < nunits; un0 += gsz) {
        const int un = (NUP % 64 == 0) ? (un0 & ~63) + (un0 & 7) * 8 + ((un0 >> 3) & 7) : un0;
        const int per_b = (C::SEQ / 256) * NH, b = un / per_b, rem = un % per_b, head = rem / (C::SEQ / 256), row0 = b * C::SEQ + (rem % (C::SEQ / 256)) * 256;
        const bf16_t* kbb = wsb<C>(p, C::WS_KVB) + (size_t)b * TOK * LD + head * HDIM; const bf16_t* vbb = kbb + (size_t)C::MM * LD;
#define ATP_SRC(cc) ((cc) < 8 ? kbb + (cc) * CD : vbb + ((cc) - 8) * CD)
        const bf16_t* q0 = Qg + (size_t)(row0 + wave * 32 + li) * LD + head * HDIM + g * 8;
        f32x4 s[2][16];
#pragma unroll
        for (int u = 0; u < 2; ++u)
#pragma unroll
            for (int T = 0; T < 16; ++T) s[u][T] = (f32x4){0.f, 0.f, 0.f, 0.f};
        pg8::u32x4 w0[4], w1[4]; bf16x8 qf[2][2];
        stage_load_b(w0, ATP_SRC(0), tid); stage_load_b(w1, ATP_SRC(1), tid);
#pragma unroll
        for (int u = 0; u < 2; ++u)
#pragma unroll
            for (int ks = 0; ks < 2; ++ks) qf[u][ks] = *(const bf16x8*)(q0 + (size_t)u * 16 * LD + ks * 32);
        stage_store_kb(w0, lds, tid);
        WG_SYNC();
        stage_load_b(w0, ATP_SRC(2), tid);
        const int aoff = (li * 64 + g * 16) ^ ((li >> 3) << 5);
#define ATP_KS(ks) do { _Pragma("unroll") for (int T0 = 0; T0 < 16; T0 += 2) { bf16x8 af[2]; \
            _Pragma("unroll") for (int j = 0; j < 2; ++j) af[j] = *(const LAS bf16x8*)(buf + ((T0 + j) * 2 + (ks)) * 1024 + aoff); \
            asm volatile("s_waitcnt lgkmcnt(0)" ::: "memory"); __builtin_amdgcn_sched_barrier(0); \
            _Pragma("unroll") for (int j = 0; j < 2; ++j) { s[0][T0 + j] = __builtin_amdgcn_mfma_f32_16x16x32_bf16(af[j], qf[0][ks], s[0][T0 + j], 0, 0, 0); \
                s[1][T0 + j] = __builtin_amdgcn_mfma_f32_16x16x32_bf16(af[j], qf[1][ks], s[1][T0 + j], 0, 0, 0); } \
            __builtin_amdgcn_sched_barrier(0); } } while (0)
#define ATP_SITER(cc, WN) do { LAS unsigned char* buf = lds + ((cc) & 1) * CBYTES; \
            ATP_KS(0); ATP_KS(1); \
            if ((cc) < 7) { __builtin_amdgcn_sched_barrier(0); _Pragma("unroll") for (int u = 0; u < 2; ++u) _Pragma("unroll") for (int ks = 0; ks < 2; ++ks) qf[u][ks] = *(const bf16x8*)(q0 + (size_t)u * 16 * LD + ((cc) + 1) * CD + ks * 32); \
                __builtin_amdgcn_sched_barrier(0); stage_store_kb(WN, lds + (((cc) + 1) & 1) * CBYTES, tid); } \
            else stage_store_vb(WN, lds + (((cc) + 1) & 1) * CBYTES, tid); \
            WG_SYNC(); stage_load_b(WN, ATP_SRC((cc) + 3), tid); } while (0)
#pragma unroll 1
        for (int c2 = 0; c2 < 8; c2 += 2) { ATP_SITER(c2, w1); ATP_SITER(c2 + 1, w0); }
#undef ATP_SITER
#undef ATP_KS
        const float sc = 0.044194173824159216f * 1.4426950408889634f;
        float inv[2]; bf16x8 pf[2][8];
#pragma unroll
        for (int u = 0; u < 2; ++u) {
            float mx = -3.0e38f;
#pragma unroll
            for (int T = 0; T < 16; ++T) mx = fmaxf(mx, fmaxf(fmaxf(s[u][T][0], s[u][T][1]), fmaxf(s[u][T][2], s[u][T][3])));
            mx = fmaxf(mx, __shfl_xor(mx, 16)); mx = fmaxf(mx, __shfl_xor(mx, 32));
            float sum = 0.f;
#pragma unroll
            for (int T = 0; T < 16; ++T)
#pragma unroll
                for (int j = 0; j < 4; ++j) { const float e = __builtin_amdgcn_exp2f((s[u][T][j] - mx) * sc); s[u][T][j] = e; sum += e; }
            sum += __shfl_xor(sum, 16); sum += __shfl_xor(sum, 32);
            inv[u] = 1.0f / sum;
#pragma unroll
            for (int t = 0; t < 8; ++t) { pg8::u32x4 w; w.x = pg8::cvt_pk_bf16(s[u][2 * t][0], s[u][2 * t][1]); w.y = pg8::cvt_pk_bf16(s[u][2 * t][2], s[u][2 * t][3]);
                w.z = pg8::cvt_pk_bf16(s[u][2 * t + 1][0], s[u][2 * t + 1][1]); w.w = pg8::cvt_pk_bf16(s[u][2 * t + 1][2], s[u][2 * t + 1][3]); pf[u][t] = __builtin_bit_cast(bf16x8, w); }
        }
        const unsigned trb = (unsigned)(size_t)lds + (unsigned)((4 * g + (li >> 2)) * PITCH + (li & 3) * 8);
#define ATP_VITER(c, WN) do { unsigned bofs = (unsigned)((c) & 1) * CBYTES; asm volatile("" : "+v"(bofs));        \
            { f32x4 o[2][4]; \
              _Pragma("unroll") for (int u = 0; u < 2; ++u) _Pragma("unroll") for (int dt = 0; dt < 4; ++dt) o[u][dt] = (f32x4){0.f, 0.f, 0.f, 0.f}; \
              _Pragma("unroll") for (int t = 0; t < 8; ++t) { s16x4 lo[4], hi[4]; \
                _Pragma("unroll") for (int dt = 0; dt < 4; ++dt) { lo[dt] = tr_read(trb + bofs + (unsigned)(t * 32 * PITCH + dt * 32)); hi[dt] = tr_read(trb + bofs + (unsigned)(t * 32 * PITCH + 16 * PITCH + dt * 32)); } \
                asm volatile("s_waitcnt lgkmcnt(0)" ::: "memory"); __builtin_amdgcn_sched_barrier(0); \
                _Pragma("unroll") for (int dt = 0; dt < 4; ++dt) { const bf16x8 a = (bf16x8){lo[dt][0], lo[dt][1], lo[dt][2], lo[dt][3], hi[dt][0], hi[dt][1], hi[dt][2], hi[dt][3]}; \
                    o[0][dt] = __builtin_amdgcn_mfma_f32_16x16x32_bf16(a, pf[0][t], o[0][dt], 0, 0, 0); \
                    o[1][dt] = __builtin_amdgcn_mfma_f32_16x16x32_bf16(a, pf[1][t], o[1][dt], 0, 0, 0); } } \
              _Pragma("unroll") for (int u = 0; u < 2; ++u) _Pragma("unroll") for (int dt = 0; dt < 4; ++dt) { u32x2 w; w.x = pg8::cvt_pk_bf16(o[u][dt][0] * inv[u], o[u][dt][1] * inv[u]); w.y = pg8::cvt_pk_bf16(o[u][dt][2] * inv[u], o[u][dt][3] * inv[u]); \
                    *(u32x2*)(AO + (size_t)(row0 + wave * 32 + 16 * u + li) * LD + head * HDIM + (c) * CD + dt * 16 + g * 4) = w; } } \
            if ((c) < 7) stage_store_vb(WN, lds + (((c) + 1) & 1) * CBYTES, tid); \
            WG_SYNC(); if ((c) < 5) stage_load_b(WN, ATP_SRC((c) + 11), tid); } while (0)
#pragma unroll 1
        for (int c2 = 0; c2 < 8; c2 += 2) { ATP_VITER(c2, w1); ATP_VITER(c2 + 1, w0); }
#undef ATP_VITER
#undef ATP_SRC
    }
}
}
namespace mx {
typedef att::bf16x8 bf16x8; typedef att::s16x4 s16x4; typedef att::f32x4 f32x4; typedef att::u32x2 u32x2;
constexpr int PT = 272;
constexpr int T64 = 64 * PT, T128 = 128 * PT;
static_assert(C::MHD == 128 && C::CH == 64 && C::MH == 8 && C::LCS == 32, "mLSTM phases are built for these shapes");
__device__ __forceinline__ void lds_wait() { asm volatile("s_waitcnt lgkmcnt(0)" ::: "memory"); __builtin_amdgcn_sched_barrier(0); }
__device__ __forceinline__ bf16x8 mk8(s16x4 lo, s16x4 hi) { return (bf16x8){lo[0], lo[1], lo[2], lo[3], hi[0], hi[1], hi[2], hi[3]}; }
__device__ __forceinline__ unsigned tr_addr(unsigned tile, int krow, int c0, int li) { return tile + (unsigned)((krow + (li >> 2)) * PT + (c0 + 4 * (li & 3)) * 2); }
__device__ __forceinline__ void ch_decode(int ci, int& r0, int& h, int& lc) {
    if (ci < C::NPC) { const int c = ci % C::NC, bh = ci / C::NC; h = bh % C::MH; r0 = (bh / C::MH) * C::SEQ + c * C::CH; lc = C::CH; }
    else { const int q = ci - C::NPC; h = q % C::MH; r0 = C::MP + (q / C::MH) * C::DEC_SEQ; lc = C::LCS; }
}
__device__ __forceinline__ void stage64(LAS unsigned char* tile, const float* src, int ld, int lc, int tid, const LAS float* rs, float mul) {
#pragma unroll
    for (int i = 0; i < 4; ++i) { const int f = tid + 512 * i, row = f >> 5, c4 = f & 31; f32x4 v = (f32x4){0.f, 0.f, 0.f, 0.f};
        if (row < lc) { v = *(const f32x4*)(src + (size_t)row * ld + c4 * 4); const float m = rs ? rs[row] * mul : mul; v = v * m; }
        u32x2 w; w.x = pg8::cvt_pk_bf16(v[0], v[1]); w.y = pg8::cvt_pk_bf16(v[2], v[3]); *(LAS u32x2*)(tile + row * PT + c4 * 8) = w; }
}
__device__ __forceinline__ void ml_phase_a(LAS unsigned char* lds, const Ptrs& p, int l, int tid, int bid, int gsz) {
    const int lane = tid & 63, wave = __builtin_amdgcn_readfirstlane(tid >> 6), li = lane & 15, g = lane >> 4;
    LAS unsigned char* Ks = lds; LAS unsigned char* Vs = lds + T64; LAS float* wts = (LAS float*)(lds + 2 * T64);
    const float* P = wsf<C>(p, C::WS_BIG);
    for (int ci = bid; ci < C::NCH; ci += gsz) {
        int r0, h, lc; ch_decode(ci, r0, h, lc);
        if (wave == 0) {
            float lf = 0.f, ig = -3.0e38f;
            if (lane < lc) { const float* pr = P + (size_t)(r0 + lane) * C::LDP; ig = pr[C::O_IG + h] + p.in[I_IB][l * C::MH + h]; const float fx = pr[C::O_FG + h] + p.in[I_FB][l * C::MH + h]; lf = fx >= 0.f ? -__logf(1.0f + __expf(-fx)) : fx - __logf(1.0f + __expf(fx)); }
            float b = lf;
#pragma unroll
            for (int o = 1; o < 64; o <<= 1) { const float t = __shfl_up(b, o); if (lane >= o) b += t; }
            const float a = lane < lc ? ig - b : -3.0e38f;
            float amax = a;
#pragma unroll
            for (int o = 1; o < 64; o <<= 1) amax = fmaxf(amax, __shfl_xor(amax, o));
            const float bL = __shfl(b, lc - 1), mloc = bL + amax;
            const float wt = lane < lc ? __expf(bL + a - mloc) : 0.f;
            wts[lane] = wt;
            if (lane < lc) { wsf<C>(p, C::WS_GB)[(size_t)(r0 + lane) * C::MH + h] = b; wsf<C>(p, C::WS_GA)[(size_t)(r0 + lane) * C::MH + h] = a; }
            if (lane == 0) { wsf<C>(p, C::WS_CBL)[ci] = bL; wsf<C>(p, C::WS_CML)[ci] = mloc; }
        }
        __syncthreads();
        stage64(Ks, P + (size_t)r0 * C::LDP + C::O_K + h * C::MHD, C::LDP, lc, tid, wts, 0.08838834764831845f);
        stage64(Vs, P + (size_t)r0 * C::LDP + C::O_VM + h * C::MHD, C::LDP, lc, tid, nullptr, 1.0f);
        __syncthreads();
        f32x4 acc[8];
#pragma unroll
        for (int et = 0; et < 8; ++et) acc[et] = (f32x4){0.f, 0.f, 0.f, 0.f};
        const unsigned ks = (unsigned)(size_t)Ks, vs = (unsigned)(size_t)Vs;
#pragma unroll
        for (int t = 0; t < 2; ++t) {
            const s16x4 alo = att::tr_read(tr_addr(ks, 32 * t + 8 * g, 16 * wave, li)), ahi = att::tr_read(tr_addr(ks, 32 * t + 8 * g + 4, 16 * wave, li));
            s16x4 blo[8], bhi[8];
#pragma unroll
            for (int et = 0; et < 8; ++et) { blo[et] = att::tr_read(tr_addr(vs, 32 * t + 8 * g, 16 * et, li)); bhi[et] = att::tr_read(tr_addr(vs, 32 * t + 8 * g + 4, 16 * et, li)); }
            lds_wait();
            const bf16x8 a = mk8(alo, ahi);
#pragma unroll
            for (int et = 0; et < 8; ++et) acc[et] = __builtin_amdgcn_mfma_f32_16x16x32_bf16(a, mk8(blo[et], bhi[et]), acc[et], 0, 0, 0);
        }
        float* DC = wsf<C>(p, C::WS_DC) + (size_t)ci * C::MHD * C::MHD;
#pragma unroll
        for (int et = 0; et < 8; ++et)
#pragma unroll
            for (int r = 0; r < 4; ++r) DC[(size_t)(16 * wave + 4 * g + r) * C::MHD + 16 * et + li] = acc[et][r];
        if (tid < C::MHD) { float s = 0.f; for (int t = 0; t < 64; ++t) s += bf2f(*(const LAS bf16_t*)(Ks + t * PT + tid * 2)); wsf<C>(p, C::WS_DN)[(size_t)ci * C::MHD + tid] = s; }
        __syncthreads();
    }
}
__device__ __forceinline__ void ml_phase_c(LAS unsigned char* lds, const Ptrs& p, int l, int tid, int bid, int gsz) {
    const int lane = tid & 63, wave = __builtin_amdgcn_readfirstlane(tid >> 6), li = lane & 15, g = lane >> 4, it = wave & 3, eh = wave >> 2;
    LAS unsigned char* Qs = lds; LAS unsigned char* Ks = lds + T64; LAS unsigned char* Vs = lds + 2 * T64; LAS unsigned char* Cs = lds + 3 * T64;
    LAS float* sb = (LAS float*)(lds + 3 * T64 + T128);
    LAS float* sa = sb + 64; LAS float* smr = sb + 128; LAS float* siw = sb + 192; LAS float* snp = sb + 256; LAS float* ssq = sb + 384;
    const float* P = wsf<C>(p, C::WS_BIG);
    for (int ci = bid; ci < C::NCH; ci += gsz) {
        int r0, h, lc; ch_decode(ci, r0, h, lc);
        const bool sample = ci >= C::NPC, first = !sample && (ci % C::NC) == 0;
        const float mprev = wsf<C>(p, C::WS_MPREV)[ci];
        if (wave == 0) {
            float b = 0.f, a = -3.0e38f;
            if (lane < lc) { b = wsf<C>(p, C::WS_GB)[(size_t)(r0 + lane) * C::MH + h]; a = wsf<C>(p, C::WS_GA)[(size_t)(r0 + lane) * C::MH + h]; }
            float pm = a;
#pragma unroll
            for (int o = 1; o < 64; o <<= 1) { const float t = __shfl_up(pm, o); if (lane >= o) pm = fmaxf(pm, t); }
            const float mrow = b + fmaxf(mprev, pm);
            sb[lane] = b; sa[lane] = a; smr[lane] = mrow; siw[lane] = __expf(b + mprev - mrow);
        }
        if (tid >= 128 && tid < 256) { const int d = tid - 128;
            snp[d] = sample ? p.in[I_SN][((size_t)l * C::NSC + (ci - C::NPC)) * C::MHD + d] : (first ? 0.f : wsf<C>(p, C::WS_DN)[(size_t)(ci - 1) * C::MHD + d]); }
        stage64(Qs, P + (size_t)r0 * C::LDP + C::O_Q + h * C::MHD, C::LDP, lc, tid, nullptr, 1.0f);
        stage64(Ks, P + (size_t)r0 * C::LDP + C::O_K + h * C::MHD, C::LDP, lc, tid, nullptr, 0.08838834764831845f);
        stage64(Vs, P + (size_t)r0 * C::LDP + C::O_VM + h * C::MHD, C::LDP, lc, tid, nullptr, 1.0f);
        { const float* cp = sample ? p.in[I_SC] + ((size_t)l * C::NSC + (ci - C::NPC)) * C::MHD * C::MHD : wsf<C>(p, C::WS_DC) + (size_t)(first ? ci : ci - 1) * C::MHD * C::MHD;
#pragma unroll
            for (int i = 0; i < 8; ++i) { const int f = tid + 512 * i, row = f >> 5, c4 = f & 31; f32x4 v = (f32x4){0.f, 0.f, 0.f, 0.f};
                if (!first) v = *(const f32x4*)(cp + (size_t)row * C::MHD + c4 * 4);
                u32x2 w; w.x = pg8::cvt_pk_bf16(v[0], v[1]); w.y = pg8::cvt_pk_bf16(v[2], v[3]); *(LAS u32x2*)(Cs + row * PT + c4 * 8) = w; } }
        __syncthreads();
        const bool active = it * 16 < lc;
        float ssq_part = 0.f; f32x4 hv[4]; float inv_den = 0.f;
        const int i = 16 * it + li;
        if (active) {
            bf16x8 qf[4];
#pragma unroll
            for (int ks = 0; ks < 4; ++ks) qf[ks] = *(const LAS bf16x8*)(Qs + i * PT + ks * 64 + g * 16);
            f32x4 st[4];
#pragma unroll
            for (int jt = 0; jt < 4; ++jt) st[jt] = (f32x4){0.f, 0.f, 0.f, 0.f};
#pragma unroll
            for (int jt = 0; jt < 4; ++jt) if (jt <= it) {
#pragma unroll
                for (int ks = 0; ks < 4; ++ks) { const bf16x8 a = *(const LAS bf16x8*)(Ks + (16 * jt + li) * PT + ks * 64 + g * 16);
                    st[jt] = __builtin_amdgcn_mfma_f32_16x16x32_bf16(a, qf[ks], st[jt], 0, 0, 0); } }
            const float bi = sb[i], mri = smr[i], iwi = siw[i];
            float dsum = 0.f;
#pragma unroll
            for (int jt = 0; jt < 4; ++jt)
#pragma unroll
                for (int r = 0; r < 4; ++r) { const int j = 16 * jt + 4 * g + r; const float w = (j <= i) ? __expf(bi + sa[j] - mri) : 0.f; st[jt][r] *= w; dsum += st[jt][r]; }
            dsum += __shfl_xor(dsum, 16); dsum += __shfl_xor(dsum, 32);
            float qn = 0.f;
#pragma unroll
            for (int ks = 0; ks < 4; ++ks)
#pragma unroll
                for (int jj = 0; jj < 8; ++jj) qn += bf2f((bf16_t)qf[ks][jj]) * snp[32 * ks + 8 * g + jj];
            qn += __shfl_xor(qn, 16); qn += __shfl_xor(qn, 32);
            const float den = dsum + iwi * qn;
            inv_den = 1.0f / fmaxf(fabsf(den), __expf(-mri));
            bf16x8 pf[2];
#pragma unroll
            for (int t = 0; t < 2; ++t) { pg8::u32x4 w; w.x = pg8::cvt_pk_bf16(st[2 * t][0], st[2 * t][1]); w.y = pg8::cvt_pk_bf16(st[2 * t][2], st[2 * t][3]);
                w.z = pg8::cvt_pk_bf16(st[2 * t + 1][0], st[2 * t + 1][1]); w.w = pg8::cvt_pk_bf16(st[2 * t + 1][2], st[2 * t + 1][3]); pf[t] = __builtin_bit_cast(bf16x8, w); }
            const unsigned vs = (unsigned)(size_t)Vs, cs = (unsigned)(size_t)Cs;
#pragma unroll
            for (int e4 = 0; e4 < 4; ++e4) { const int et = 4 * eh + e4;
                s16x4 vlo[2], vhi[2], clo[4], chi[4];
#pragma unroll
                for (int t = 0; t < 2; ++t) { vlo[t] = att::tr_read(tr_addr(vs, 32 * t + 4 * g, 16 * et, li)); vhi[t] = att::tr_read(tr_addr(vs, 32 * t + 16 + 4 * g, 16 * et, li)); }
#pragma unroll
                for (int ks = 0; ks < 4; ++ks) { clo[ks] = att::tr_read(tr_addr(cs, 32 * ks + 8 * g, 16 * et, li)); chi[ks] = att::tr_read(tr_addr(cs, 32 * ks + 8 * g + 4, 16 * et, li)); }
                lds_wait();
                f32x4 aS = (f32x4){0.f, 0.f, 0.f, 0.f}, aC = (f32x4){0.f, 0.f, 0.f, 0.f};
#pragma unroll
                for (int t = 0; t < 2; ++t) aS = __builtin_amdgcn_mfma_f32_16x16x32_bf16(mk8(vlo[t], vhi[t]), pf[t], aS, 0, 0, 0);
#pragma unroll
                for (int ks = 0; ks < 4; ++ks) aC = __builtin_amdgcn_mfma_f32_16x16x32_bf16(mk8(clo[ks], chi[ks]), qf[ks], aC, 0, 0, 0);
                hv[e4] = (aS + aC * iwi) * inv_den;
                ssq_part += (hv[e4][0] * hv[e4][0] + hv[e4][1] * hv[e4][1]) + (hv[e4][2] * hv[e4][2] + hv[e4][3] * hv[e4][3]); }
            ssq_part += __shfl_xor(ssq_part, 16); ssq_part += __shfl_xor(ssq_part, 32);
            if (g == 0) ssq[wave * 16 + li] = ssq_part;
        }
        __syncthreads();
        if (active) {
            const float tot = ssq_part + ssq[(wave ^ 4) * 16 + li];
            const float rs = rsqrtf(tot * (1.0f / C::MHD) + 1e-6f);
            const int row = r0 + i;
#pragma unroll
            for (int e4 = 0; e4 < 4; ++e4) { const int e = 16 * (4 * eh + e4) + 4 * g;
                const f32x4 og = *(const f32x4*)(P + (size_t)row * C::LDP + C::O_O + h * C::MHD + e); const f32x4 gn = *(const f32x4*)(p.in[I_NG] + (size_t)l * C::MW + h * C::MHD + e);
                float o4[4];
#pragma unroll
                for (int r = 0; r < 4; ++r) o4[r] = hv[e4][r] * rs * gn[r] * __builtin_amdgcn_rcpf(1.0f + __expf(-og[r]));
                u32x2 w; w.x = pg8::cvt_pk_bf16(o4[0], o4[1]); w.y = pg8::cvt_pk_bf16(o4[2], o4[3]);
                *(u32x2*)(wsb<C>(p, C::WS_MIX) + (size_t)row * C::D + C::PW + C::GW + h * C::MHD + e) = w; }
        }
        __syncthreads();
    }
}
}
namespace rw {
typedef att::f32x4 f32x4; typedef att::u32x2 u32x2;
static_assert(C::D == 2048, "row ops assume 2048 columns = 8 float4 per lane");
__device__ __forceinline__ float wave_sum(float v) {
#pragma unroll
    for (int o = 1; o < 64; o <<= 1) v += __shfl_xor(v, o);
    return v;
}
__device__ __forceinline__ void rows_init(const Ptrs& p, int tid, int bid, int gsz) {
    const int lane = tid & 63, gw = bid * NWAVES + (tid >> 6), NGW = gsz * NWAVES;
    float* SS = wsf<C>(p, C::WS_SS);
    for (int r = gw; r < C::M; r += NGW) {
        const float* src = r < C::MP ? p.in[I_XP] + (size_t)r * C::D : p.in[I_XS] + (size_t)(r - C::MP) * C::D;
        float* X = wsf<C>(p, C::WS_X) + (size_t)r * C::D; bf16_t* XB = wsb<C>(p, C::WS_XB) + (size_t)r * C::D;
        float ss = 0.f;
#pragma unroll
        for (int j = 0; j < 8; ++j) { const f32x4 v = *(const f32x4*)(src + (lane + 64 * j) * 4); *(f32x4*)(X + (lane + 64 * j) * 4) = v;
            u32x2 w; w.x = pg8::cvt_pk_bf16(v[0], v[1]); w.y = pg8::cvt_pk_bf16(v[2], v[3]); *(u32x2*)(XB + (lane + 64 * j) * 4) = w;
            ss += (v[0] * v[0] + v[1] * v[1]) + (v[2] * v[2] + v[3] * v[3]); }
        ss = wave_sum(ss);
        if (lane < C::NSS) SS[(size_t)lane * C::M + r] = lane == 0 ? ss : 0.f;
    }
    for (int r = gw; r < C::MM; r += NGW) {
        const float* src = p.in[I_MEM] + (size_t)r * C::D; bf16_t* MB = wsb<C>(p, C::WS_MEMB) + (size_t)r * C::D;
        float ss = 0.f;
#pragma unroll
        for (int j = 0; j < 8; ++j) { const f32x4 v = *(const f32x4*)(src + (lane + 64 * j) * 4);
            u32x2 w; w.x = pg8::cvt_pk_bf16(v[0], v[1]); w.y = pg8::cvt_pk_bf16(v[2], v[3]); *(u32x2*)(MB + (lane + 64 * j) * 4) = w;
            ss += (v[0] * v[0] + v[1] * v[1]) + (v[2] * v[2] + v[3] * v[3]); }
        ss = wave_sum(ss);
        if (lane == 0) wsf<C>(p, C::WS_RSTDM)[r] = rsqrtf(ss * (1.0f / C::D) + 1e-6f);
    }
}
__device__ __forceinline__ void rows_final(const Ptrs& p, int tid, int bid, int gsz) {
    const int lane = tid & 63, gw = bid * NWAVES + (tid >> 6), NGW = gsz * NWAVES;
    for (int r = gw; r < C::M; r += NGW) {
        const float* X = wsf<C>(p, C::WS_X) + (size_t)r * C::D; const float rs = rsqrtf(wsf<C>(p, C::WS_SS)[(size_t)(C::NSS - 1) * C::M + r] * (1.0f / C::D) + 1e-6f);
        float* o = r < C::MP ? p.out + C::OUT_YP + (size_t)r * C::D : p.out + C::OUT_YS + (size_t)(r - C::MP) * C::D;
        float pscale = 1.0f, padd = 0.f;
#if defined(PROBE_MASK_A)
        { const unsigned long long* TS = (const unsigned long long*)(p.ws + C::WS_CTL + 32768); unsigned long long ta = 0, tb = 0;
          for (int k = 0; k < 25; ++k) { const unsigned long long dk = TS[k + 1] - TS[k]; if ((PROBE_MASK_A >> k) & 1ull) ta += dk; if ((PROBE_MASK_B >> k) & 1ull) tb += dk; }
#if defined(PROBE_MLT)
          ta = TS[48 + PROBE_MLT];
#endif
#if defined(PROBE_GST)
          { const unsigned long long* st = (const unsigned long long*)(p.ws + C::WS_END); unsigned long long epi = 0; for (int u2 = 0; u2 < 8; ++u2) epi += st[3 + 2 * u2] - st[2 + 2 * u2];
            const unsigned long long tot = st[18] - st[0], fill = st[1] - st[0];
            ta = (unsigned long long)(1.0e6 * (double)(PROBE_GST == 1 ? epi : fill) / (double)tot); }
#endif
#if defined(PROBE_MLC)
          ta = TS[48 + PROBE_MLC];
#endif
#if defined(PROBE_ATT)
          ta = 0; for (int l2 = 0; l2 < 2; ++l2) { const int k = 1 + 12 * l2 + 8; ta += (PROBE_ATT == 1) ? TS[44 + l2] - TS[k] : TS[k + 1] - TS[44 + l2]; }
#endif
#if defined(PROBE_SCN)
          ta = 0; for (int l2 = 0; l2 < 2; ++l2) { const int k = 1 + 12 * l2 + 4; ta += (PROBE_SCN == 1) ? TS[44 + l2] - TS[k] : TS[k + 1] - TS[44 + l2]; }
#endif
#if defined(PROBE_MIXA)
          ta = 0; for (int l2 = 0; l2 < 2; ++l2) { const int k = 1 + 12 * l2 + 3; ta += (PROBE_MIXA == 1) ? TS[40 + l2] - TS[k] : (PROBE_MIXA == 2) ? TS[42 + l2] - TS[40 + l2] : TS[k + 1] - TS[42 + l2]; }
#endif
#if defined(PROBE_SPLIT_MODE)
          ta = 0; for (int l2 = 0; l2 < 2; ++l2) { const int k = 1 + 10 * l2 + 3; ta += (PROBE_SPLIT_MODE == 1) ? TS[40 + l2] - TS[k] : TS[k + 1] - TS[40 + l2]; }
#endif
          if (r >= C::MP) pscale = 1.0f + 0.03f + (float)ta * 0.01f * PROBE_SA;
          if (r == 0 && lane == 0) padd = 1.0f + (float)tb * 0.01f * PROBE_SB; }
#endif
#pragma unroll
        for (int j = 0; j < 8; ++j) { const f32x4 v = *(const f32x4*)(X + (lane + 64 * j) * 4); const f32x4 gg = *(const f32x4*)(p.in[I_GFIN] + (lane + 64 * j) * 4);
            f32x4 y = v * rs * gg * pscale; if (j == 0) y[0] += padd; *(f32x4*)(o + (lane + 64 * j) * 4) = y; }
    }
}
__device__ __forceinline__ void ml_scan(const Ptrs& p, int l, long gtid, long gthreads) {
    const float* CBL = wsf<C>(p, C::WS_CBL); const float* CML = wsf<C>(p, C::WS_CML);
    float* DC = wsf<C>(p, C::WS_DC); float* DN = wsf<C>(p, C::WS_DN);
    constexpr int NPS = C::BATCH * C::MH, E4 = C::MHD / 4;
    for (long it = gtid; it < (long)NPS * C::MHD * E4; it += gthreads) {
        const int e4 = (int)(it % E4), d = (int)((it / E4) % C::MHD), sq = (int)(it / ((long)E4 * C::MHD));
        float m = 0.f; f32x4 cst = (f32x4){0.f, 0.f, 0.f, 0.f};
        static_assert(C::NC % 8 == 0, "scan is unrolled by 8 chunks");
        for (int c0 = 0; c0 < C::NC; c0 += 8) {
            f32x4 v[8]; float bl[8], ml[8];
#pragma unroll
            for (int j = 0; j < 8; ++j) { const int ci = sq * C::NC + c0 + j; v[j] = *(const f32x4*)(DC + ((size_t)ci * C::MHD + d) * C::MHD + e4 * 4); bl[j] = CBL[ci]; ml[j] = CML[ci]; }
#pragma unroll
            for (int j = 0; j < 8; ++j) { const int ci = sq * C::NC + c0 + j; const float a = bl[j] + m, mn = fmaxf(a, ml[j]), dec = __expf(a - mn), f = __expf(ml[j] - mn);
                cst = cst * dec + v[j] * f; *(f32x4*)(DC + ((size_t)ci * C::MHD + d) * C::MHD + e4 * 4) = cst; m = mn; }
        }
        *(f32x4*)(p.out + C::OUT_CP + (((size_t)l * NPS + sq) * C::MHD + d) * C::MHD + e4 * 4) = cst;
    }
    for (long it = gtid; it < (long)NPS * C::MHD; it += gthreads) {
        const int d = (int)(it % C::MHD), sq = (int)(it / C::MHD);
        float m = 0.f, nst = 0.f;
        for (int c = 0; c < C::NC; ++c) { const int ci = sq * C::NC + c; const float a = CBL[ci] + m, b2 = CML[ci], mn = fmaxf(a, b2), dec = __expf(a - mn), f = __expf(b2 - mn);
            const size_t on = (size_t)ci * C::MHD + d; nst = dec * nst + f * DN[on]; DN[on] = nst; m = mn; }
        p.out[C::OUT_NP + ((size_t)l * NPS + sq) * C::MHD + d] = nst;
    }
    for (long it = gtid; it < (long)C::NSC * C::MHD * E4; it += gthreads) {
        const int e4 = (int)(it % E4), d = (int)((it / E4) % C::MHD), q = (int)(it / ((long)E4 * C::MHD)), ci = C::NPC + q;
        const float m0 = p.in[I_SM][(size_t)l * C::NSC + q], a = CBL[ci] + m0, b2 = CML[ci], mn = fmaxf(a, b2), dec = __expf(a - mn), f = __expf(b2 - mn);
        const size_t so = (((size_t)l * C::NSC + q) * C::MHD + d) * C::MHD + e4 * 4;
        *(f32x4*)(p.out + C::OUT_CS + so) = *(const f32x4*)(p.in[I_SC] + so) * dec + *(const f32x4*)(DC + ((size_t)ci * C::MHD + d) * C::MHD + e4 * 4) * f;
    }
    for (long it = gtid; it < (long)C::NSC * C::MHD; it += gthreads) {
        const int d = (int)(it % C::MHD), q = (int)(it / C::MHD), ci = C::NPC + q;
        const float m0 = p.in[I_SM][(size_t)l * C::NSC + q], a = CBL[ci] + m0, b2 = CML[ci], mn = fmaxf(a, b2), dec = __expf(a - mn), f = __expf(b2 - mn);
        const size_t no = ((size_t)l * C::NSC + q) * C::MHD + d;
        p.out[C::OUT_NS + no] = dec * p.in[I_SN][no] + f * DN[(size_t)ci * C::MHD + d];
    }
}
}

namespace gp {
typedef att::bf16x8 bf16x8; typedef att::s16x4 s16x4; typedef att::f32x4 f32x4; typedef att::u32x2 u32x2;
constexpr int PT = mx::PT, T128 = mx::T128;
static_assert(C::GHD == 128 && C::PGD == 128 && C::GCH == 128 && C::SEQ % 128 == 0 && C::DEC_SEQ == 32 && C::PH == 15, "gmlp / pool phases are built for these shapes");
constexpr int NT_P = C::MP / 128;
constexpr int NU_G = NT_P * 4 + C::DEC_BATCH * 4;
__device__ __forceinline__ void gmlp_phase(LAS unsigned char* lds, const Ptrs& p, int l, int tid, int bid, int gsz) {
    const int lane = tid & 63, wave = __builtin_amdgcn_readfirstlane(tid >> 6), li = lane & 15, g = lane >> 4;
    LAS unsigned char* Vs = lds; LAS unsigned char* Ws = lds + T128;
    const float* P = wsf<C>(p, C::WS_BIG);
    for (int u = bid; u < NU_G; u += gsz) {
        int r0, lc, h; bool sample = false; int sb = 0;
        if (u < NT_P * 4) { h = u & 3; r0 = (u >> 2) * 128; lc = 128; } else { const int s = u - NT_P * 4; h = s & 3; sb = s >> 2; r0 = C::MP + sb * C::DEC_SEQ; lc = C::DEC_SEQ; sample = true; }
#pragma unroll
        for (int i = 0; i < 8; ++i) { const int f = tid + 512 * i, row = f >> 5, c4 = f & 31; f32x4 v = (f32x4){0.f, 0.f, 0.f, 0.f};
            if (row < lc) v = *(const f32x4*)(P + (size_t)(r0 + row) * C::LDP + C::O_V + h * 128 + c4 * 4);
            float ss = (v[0] * v[0] + v[1] * v[1]) + (v[2] * v[2] + v[3] * v[3]);
#pragma unroll
            for (int o = 1; o < 32; o <<= 1) ss += __shfl_xor(ss, o);
            const float rs = rsqrtf(ss * (1.0f / 128) + 1e-6f); const f32x4 gn = *(const f32x4*)(p.in[I_GVG] + (size_t)l * C::GW + h * 128 + c4 * 4);
            v = v * rs * gn;
            if (sample && row < lc) *(f32x4*)(p.out + C::OUT_VS + (((size_t)l * C::DEC_BATCH + sb) * C::DEC_SEQ + row) * C::GW + h * 128 + c4 * 4) = v;
            u32x2 w; w.x = pg8::cvt_pk_bf16(v[0], v[1]); w.y = pg8::cvt_pk_bf16(v[2], v[3]); *(LAS u32x2*)(Vs + row * PT + c4 * 8) = w; }
        const float* wsrc = p.in[I_GWS] + ((size_t)l * C::GH + h) * 128 * 128;
#pragma unroll
        for (int i = 0; i < 8; ++i) { const int f = tid + 512 * i, row = f >> 5, c4 = f & 31; f32x4 v = *(const f32x4*)(wsrc + (size_t)row * 128 + c4 * 4);
#pragma unroll
            for (int j = 0; j < 4; ++j) if (c4 * 4 + j > row) v[j] = 0.f;
            u32x2 w; w.x = pg8::cvt_pk_bf16(v[0], v[1]); w.y = pg8::cvt_pk_bf16(v[2], v[3]); *(LAS u32x2*)(Ws + row * PT + c4 * 8) = w; }
        WG_SYNC();
        if (wave * 16 < lc) {
            const int i = wave * 16 + li, nks = (wave * 16 + 15) / 32 + 1;
            f32x4 acc[8];
#pragma unroll
            for (int dt = 0; dt < 8; ++dt) acc[dt] = (f32x4){0.f, 0.f, 0.f, 0.f};
            const unsigned vs = (unsigned)(size_t)Vs;
            for (int ks = 0; ks < nks; ++ks) {
                const bf16x8 bq = *(const LAS bf16x8*)(Ws + i * PT + ks * 64 + g * 16);
                s16x4 lo[8], hi[8];
#pragma unroll
                for (int dt = 0; dt < 8; ++dt) { lo[dt] = att::tr_read(mx::tr_addr(vs, 32 * ks + 8 * g, 16 * dt, li)); hi[dt] = att::tr_read(mx::tr_addr(vs, 32 * ks + 8 * g + 4, 16 * dt, li)); }
                mx::lds_wait();
#pragma unroll
                for (int dt = 0; dt < 8; ++dt) acc[dt] = __builtin_amdgcn_mfma_f32_16x16x32_bf16(mx::mk8(lo[dt], hi[dt]), bq, acc[dt], 0, 0, 0);
            }
            const float bsi = p.in[I_GBS][((size_t)l * C::GH + h) * C::GCH + i];
            const int row = r0 + i;
#pragma unroll
            for (int dt = 0; dt < 8; ++dt) { const int d = 16 * dt + 4 * g; const f32x4 uu = *(const f32x4*)(P + (size_t)row * C::LDP + C::O_U + h * 128 + d);
                u32x2 w; w.x = pg8::cvt_pk_bf16(uu[0] * (acc[dt][0] + bsi), uu[1] * (acc[dt][1] + bsi)); w.y = pg8::cvt_pk_bf16(uu[2] * (acc[dt][2] + bsi), uu[3] * (acc[dt][3] + bsi));
                *(u32x2*)(wsb<C>(p, C::WS_MIX) + (size_t)row * C::D + C::PW + h * 128 + d) = w; }
        }
        WG_SYNC();
    }
}
__device__ __forceinline__ void pool_phase(LAS unsigned char* lds, const Ptrs& p, int l, int tid, int bid, int gsz) {
    const int lane = tid & 63, wave = __builtin_amdgcn_readfirstlane(tid >> 6), li = lane & 15, g = lane >> 4;
    LAS unsigned char* Ds = lds; LAS unsigned char* Ws = lds + T128;
    const float* P = wsf<C>(p, C::WS_BIG);
    for (int u = bid; u < NU_G; u += gsz) {
        int r0, lc, grp, t0, L, b; bool sample = false;
        if (u < NT_P * 4) { grp = u & 3; r0 = (u >> 2) * 128; lc = 128; b = r0 / C::SEQ; t0 = r0 % C::SEQ; L = C::SEQ; } else { const int s = u - NT_P * 4; grp = s & 3; b = s >> 2; r0 = C::MP + b * C::DEC_SEQ; lc = C::DEC_SEQ; t0 = 0; L = C::DEC_SEQ; sample = true; }
        const int w = 2 << grp;
        { const int c4 = tid & 31, sg = tid >> 5, ch = grp * 128 + c4 * 4;
            const float* hist = p.in[I_SPOOL] + ((size_t)l * C::DEC_BATCH + b) * C::PH * C::PW + ch;
            auto xat = [&](int t) -> f32x4 {
                if (t >= 0) return *(const f32x4*)(P + (size_t)(r0 - t0 + t) * C::LDP + ch);
                if (sample && C::PH + t >= 0) return *(const f32x4*)(hist + (size_t)(C::PH + t) * C::PW);
                return (f32x4){0.f, 0.f, 0.f, 0.f}; };
            if (sg * 8 < lc) {
                const int ts = t0 + sg * 8;
                f32x4 sum = (f32x4){0.f, 0.f, 0.f, 0.f};
                for (int j = 1; j < w; ++j) sum = sum + xat(ts - j);
#pragma unroll
                for (int k = 0; k < 8; ++k) { const int t = ts + k; const f32x4 x = xat(t); sum = sum + x;
                    const int pos = (sample ? C::PAST : 0) + t; const float inv = 1.0f / (float)((pos + 1) < w ? (pos + 1) : w);
                    const f32x4 dv = sum * inv - x;
                    u32x2 ww; ww.x = pg8::cvt_pk_bf16(dv[0], dv[1]); ww.y = pg8::cvt_pk_bf16(dv[2], dv[3]); *(LAS u32x2*)(Ds + (sg * 8 + k) * PT + c4 * 8) = ww;
                    sum = sum - xat(t - w + 1);
                    const int idx = t - (L - C::PH);
                    if (idx >= 0) *(f32x4*)(p.out + (sample ? C::OUT_POOLS + (((size_t)l * C::DEC_BATCH + b) * C::PH + idx) * C::PW : C::OUT_POOLP + (((size_t)l * C::BATCH + b) * C::PH + idx) * C::PW) + ch) = x; }
            } else {
#pragma unroll
                for (int k = 0; k < 8; ++k) *(LAS u32x2*)(Ds + (sg * 8 + k) * PT + c4 * 8) = (u32x2){0u, 0u};
            }
        }
        const float* wsrc = p.in[I_POOLW] + ((size_t)l * C::PG + grp) * 128 * 128;
#pragma unroll
        for (int i = 0; i < 8; ++i) { const int f = tid + 512 * i, row = f >> 5, c4 = f & 31; const f32x4 v = *(const f32x4*)(wsrc + (size_t)row * 128 + c4 * 4);
            u32x2 ww; ww.x = pg8::cvt_pk_bf16(v[0], v[1]); ww.y = pg8::cvt_pk_bf16(v[2], v[3]); *(LAS u32x2*)(Ws + row * PT + c4 * 8) = ww; }
        WG_SYNC();
        if (wave * 16 < lc) {
            const int t = wave * 16 + li;
            f32x4 acc[8];
#pragma unroll
            for (int et = 0; et < 8; ++et) acc[et] = (f32x4){0.f, 0.f, 0.f, 0.f};
            const unsigned wsa = (unsigned)(size_t)Ws;
#pragma unroll
            for (int ks = 0; ks < 4; ++ks) {
                const bf16x8 bq = *(const LAS bf16x8*)(Ds + t * PT + ks * 64 + g * 16);
                s16x4 lo[8], hi[8];
#pragma unroll
                for (int et = 0; et < 8; ++et) { lo[et] = att::tr_read(mx::tr_addr(wsa, 32 * ks + 8 * g, 16 * et, li)); hi[et] = att::tr_read(mx::tr_addr(wsa, 32 * ks + 8 * g + 4, 16 * et, li)); }
                mx::lds_wait();
#pragma unroll
                for (int et = 0; et < 8; ++et) acc[et] = __builtin_amdgcn_mfma_f32_16x16x32_bf16(mx::mk8(lo[et], hi[et]), bq, acc[et], 0, 0, 0);
            }
            const int row = r0 + t;
#pragma unroll
            for (int et = 0; et < 8; ++et) { const int e = 16 * et + 4 * g; const f32x4 sc = *(const f32x4*)(p.in[I_POOLS] + (size_t)l * C::PW + grp * 128 + e);
                u32x2 ww; ww.x = pg8::cvt_pk_bf16(acc[et][0] * sc[0], acc[et][1] * sc[1]); ww.y = pg8::cvt_pk_bf16(acc[et][2] * sc[2], acc[et][3] * sc[3]);
                *(u32x2*)(wsb<C>(p, C::WS_MIX) + (size_t)row * C::D + grp * 128 + e) = ww; }
        }
        WG_SYNC();
    }
}
}
namespace mp {
typedef att::bf16x8 bf16x8; typedef att::s16x4 s16x4; typedef att::f32x4 f32x4; typedef att::u32x2 u32x2; typedef pg8::u32x4 u32x4;
constexpr int PT = mx::PT, T64 = mx::T64, T128 = mx::T128, MAXU = 8;
#define MP_TR(dst, base, OFF) asm volatile("ds_read_b64_tr_b16 %0, %1 offset:%2" : "=&v"(dst) : "v"(base), "i"(OFF) : "memory")
__device__ __forceinline__ void ml_a(LAS unsigned char* lds, const Ptrs& p, int l, int tid, int bid, int gsz) {
    const int lane = tid & 63, wave = __builtin_amdgcn_readfirstlane(tid >> 6), li = lane & 15, g = lane >> 4;
    LAS unsigned char* Ks = lds; LAS unsigned char* Vs = lds + T64; LAS float* wts = (LAS float*)(lds + 2 * T64);
    const float* P = wsf<C>(p, C::WS_BIG);
    const int nu = bid < C::NCH ? (C::NCH - 1 - bid) / gsz + 1 : 0;
    if (wave < nu) { const int ci = bid + wave * gsz; int r0, h, lc; mx::ch_decode(ci, r0, h, lc);
        float lf = 0.f, ig = -3.0e38f;
        if (lane < lc) { const float* pr = P + (size_t)(r0 + lane) * C::LDP; ig = pr[C::O_IG + h] + p.in[I_IB][l * C::MH + h]; const float fx = pr[C::O_FG + h] + p.in[I_FB][l * C::MH + h];
            lf = fx >= 0.f ? -__logf(1.0f + __expf(-fx)) : fx - __logf(1.0f + __expf(fx)); }
        float b = lf;
#pragma unroll
        for (int o = 1; o < 64; o <<= 1) { const float t = __shfl_up(b, o); if (lane >= o) b += t; }
        const float a = lane < lc ? ig - b : -3.0e38f;
        float amax = a;
#pragma unroll
        for (int o = 1; o < 64; o <<= 1) amax = fmaxf(amax, __shfl_xor(amax, o));
        const float bL = __shfl(b, lc - 1), mloc = bL + amax;
        wts[wave * 64 + lane] = lane < lc ? __expf(bL + a - mloc) : 0.f;
        if (lane < lc) { wsf<C>(p, C::WS_GB)[(size_t)(r0 + lane) * C::MH + h] = b; wsf<C>(p, C::WS_GA)[(size_t)(r0 + lane) * C::MH + h] = a; }
        if (lane == 0) { wsf<C>(p, C::WS_CBL)[ci] = bL; wsf<C>(p, C::WS_CML)[ci] = mloc; } }
    const unsigned lofs8 = (unsigned)((8 * g + (li >> 2)) * PT + 8 * (li & 3));
    const unsigned kw8 = (unsigned)(size_t)Ks + lofs8 + (unsigned)(32 * wave), vs8 = (unsigned)(size_t)Vs + lofs8;
    f32x4 pk[4], pv[4];
    auto window = [&](int ci) { int r0, h, lc; mx::ch_decode(ci, r0, h, lc); const float* src = P + (size_t)r0 * C::LDP + h * C::MHD;
#pragma unroll
        for (int q = 0; q < 4; ++q) { const int f = tid + 512 * q, row = f >> 5, c4 = f & 31;
            if (row < lc) { pk[q] = *(const f32x4*)(src + (size_t)row * C::LDP + C::O_K + c4 * 4); pv[q] = *(const f32x4*)(src + (size_t)row * C::LDP + C::O_VM + c4 * 4); }
            else { pk[q] = (f32x4){0.f, 0.f, 0.f, 0.f}; pv[q] = pk[q]; } }
        __builtin_amdgcn_sched_barrier(0); };
    if (nu > 0) window(bid);
    WG_SYNC();
    for (int j = 0; j < nu; ++j) { const int ci = bid + j * gsz;
#pragma unroll
        for (int q = 0; q < 4; ++q) { const int f = tid + 512 * q, row = f >> 5, c4 = f & 31; const float sw = 0.08838834764831845f * wts[j * 64 + row];
            u32x2 w; w.x = pg8::cvt_pk_bf16(pk[q][0] * sw, pk[q][1] * sw); w.y = pg8::cvt_pk_bf16(pk[q][2] * sw, pk[q][3] * sw); *(LAS u32x2*)(Ks + row * PT + c4 * 8) = w;
            w.x = pg8::cvt_pk_bf16(pv[q][0], pv[q][1]); w.y = pg8::cvt_pk_bf16(pv[q][2], pv[q][3]); *(LAS u32x2*)(Vs + row * PT + c4 * 8) = w; }
        if (j + 1 < nu) window(ci + gsz);
        WG_SYNC();
        f32x4 acc[8], accn = (f32x4){0.f, 0.f, 0.f, 0.f};
#pragma unroll
        for (int et = 0; et < 8; ++et) acc[et] = (f32x4){0.f, 0.f, 0.f, 0.f};
        const bf16x8 ones = (bf16x8){0x3F80, 0x3F80, 0x3F80, 0x3F80, 0x3F80, 0x3F80, 0x3F80, 0x3F80};
#pragma unroll
        for (int t = 0; t < 2; ++t) {
            s16x4 alo, ahi, blo[8], bhi[8]; MP_TR(alo, kw8, (32 * t) * PT); MP_TR(ahi, kw8, (32 * t + 4) * PT);
#pragma unroll
            for (int et = 0; et < 8; ++et) { MP_TR(blo[et], vs8, (32 * t) * PT + 32 * et); MP_TR(bhi[et], vs8, (32 * t + 4) * PT + 32 * et); }
            mx::lds_wait();
            const bf16x8 a = mx::mk8(alo, ahi);
#pragma unroll
            for (int et = 0; et < 8; ++et) acc[et] = __builtin_amdgcn_mfma_f32_16x16x32_bf16(mx::mk8(blo[et], bhi[et]), a, acc[et], 0, 0, 0);
            accn = __builtin_amdgcn_mfma_f32_16x16x32_bf16(ones, a, accn, 0, 0, 0);
        }
        float* DC = wsf<C>(p, C::WS_DC) + (size_t)ci * C::MHD * C::MHD + (size_t)(16 * wave + li) * C::MHD + 4 * g;
#pragma unroll
        for (int et = 0; et < 8; ++et) *(f32x4*)(DC + 16 * et) = acc[et];
        if (g == 0) wsf<C>(p, C::WS_DN)[(size_t)ci * C::MHD + 16 * wave + li] = accn[0];
        WG_SYNC();
    }
}
__device__ __forceinline__ void ml_scan(const Ptrs& p, int l, long gtid, long gthreads) {
    const float* CBL = wsf<C>(p, C::WS_CBL); const float* CML = wsf<C>(p, C::WS_CML); const float* DC = wsf<C>(p, C::WS_DC); float* DN = wsf<C>(p, C::WS_DN);
    bf16_t* DCB = wsb<C>(p, C::WS_DCB); float* MPREV = wsf<C>(p, C::WS_MPREV);
    constexpr int NPS = C::BATCH * C::MH, E4 = C::MHD / 4;
    static_assert(C::NC % 8 == 0, "scan is unrolled by 8 chunks");
    for (long it = gtid; it < (long)NPS * C::MHD * E4; it += gthreads) {
        const int e4 = (int)(it % E4), d = (int)((it / E4) % C::MHD), sq = (int)(it / ((long)E4 * C::MHD));
        float m = 0.f, nst = 0.f; f32x4 cst = (f32x4){0.f, 0.f, 0.f, 0.f};
        for (int c0 = 0; c0 < C::NC; c0 += 8) {
            f32x4 v[8]; float bl[8], ml[8], dn[8];
#pragma unroll
            for (int j = 0; j < 8; ++j) { const int ci = sq * C::NC + c0 + j; v[j] = *(const f32x4*)(DC + ((size_t)ci * C::MHD + d) * C::MHD + e4 * 4); bl[j] = CBL[ci]; ml[j] = CML[ci];
                dn[j] = (e4 == 0) ? DN[(size_t)ci * C::MHD + d] : 0.f; }
            __builtin_amdgcn_sched_barrier(0);
#pragma unroll
            for (int j = 0; j < 8; ++j) { const int ci = sq * C::NC + c0 + j; const float a = bl[j] + m, mn = fmaxf(a, ml[j]), dec = __expf(a - mn), f = __expf(ml[j] - mn);
                if (d == 0 && e4 == 0) MPREV[ci] = m;
                cst = cst * dec + v[j] * f; u32x2 w; w.x = pg8::cvt_pk_bf16(cst[0], cst[1]); w.y = pg8::cvt_pk_bf16(cst[2], cst[3]);
                *(u32x2*)(DCB + ((size_t)ci * C::MHD + d) * C::MHD + e4 * 4) = w;
                nst = dec * nst + f * dn[j]; if (e4 == 0) DN[(size_t)ci * C::MHD + d] = nst;
                m = mn; }
        }
        *(f32x4*)(p.out + C::OUT_CP + (((size_t)l * NPS + sq) * C::MHD + d) * C::MHD + e4 * 4) = cst;
        if (e4 == 0) p.out[C::OUT_NP + ((size_t)l * NPS + sq) * C::MHD + d] = nst;
        if (d == 0 && e4 == 0) p.out[C::OUT_MP + (size_t)l * NPS + sq] = m;
    }
    for (long it = gtid; it < (long)C::NSC * C::MHD * E4; it += gthreads) {
        const int e4 = (int)(it % E4), d = (int)((it / E4) % C::MHD), q = (int)(it / ((long)E4 * C::MHD)), ci = C::NPC + q;
        const float m0 = p.in[I_SM][(size_t)l * C::NSC + q], a = CBL[ci] + m0, b2 = CML[ci], mn = fmaxf(a, b2), dec = __expf(a - mn), f = __expf(b2 - mn);
        const size_t so = (((size_t)l * C::NSC + q) * C::MHD + d) * C::MHD + e4 * 4; const f32x4 cin = *(const f32x4*)(p.in[I_SC] + so);
        *(f32x4*)(p.out + C::OUT_CS + so) = cin * dec + *(const f32x4*)(DC + ((size_t)ci * C::MHD + d) * C::MHD + e4 * 4) * f;
        u32x2 w; w.x = pg8::cvt_pk_bf16(cin[0], cin[1]); w.y = pg8::cvt_pk_bf16(cin[2], cin[3]); *(u32x2*)(DCB + ((size_t)ci * C::MHD + d) * C::MHD + e4 * 4) = w;
        if (d == 0 && e4 == 0) { MPREV[ci] = m0; p.out[C::OUT_MS + (size_t)l * C::NSC + q] = mn; }
    }
    for (long it = gtid; it < (long)C::NSC * C::MHD; it += gthreads) {
        const int d = (int)(it % C::MHD), q = (int)(it / C::MHD), ci = C::NPC + q;
        const float m0 = p.in[I_SM][(size_t)l * C::NSC + q], a = CBL[ci] + m0, b2 = CML[ci], mn = fmaxf(a, b2), dec = __expf(a - mn), f = __expf(b2 - mn);
        const size_t no = ((size_t)l * C::NSC + q) * C::MHD + d;
        p.out[C::OUT_NS + no] = dec * p.in[I_SN][no] + f * DN[(size_t)ci * C::MHD + d];
    }
}
__device__ __forceinline__ void ml_c(LAS unsigned char* lds, const Ptrs& p, int l, int tid, int bid, int gsz) {
    const int lane = tid & 63, wave = __builtin_amdgcn_readfirstlane(tid >> 6), li = lane & 15, g = lane >> 4, it = wave & 3, eh = wave >> 2;
    LAS unsigned char* Qs = lds; LAS unsigned char* Ks = lds + T64; LAS unsigned char* Vs = lds + 2 * T64; LAS unsigned char* Cs = lds + 3 * T64;
    LAS float* SB = (LAS float*)(lds + 3 * T64 + T128); LAS float* SA = SB + MAXU * 64; LAS float* SMR = SA + MAXU * 64; LAS float* SIW = SMR + MAXU * 64;
    LAS float* snp = SIW + MAXU * 64; LAS float* ssq = snp + 128; LAS float* sgn = ssq + 128;
    const float* P = wsf<C>(p, C::WS_BIG);
    const int nu = bid < C::NCH ? (C::NCH - 1 - bid) / gsz + 1 : 0;
    if (wave < nu) { const int ci = bid + wave * gsz; int r0, h, lc; mx::ch_decode(ci, r0, h, lc); const float mprev = wsf<C>(p, C::WS_MPREV)[ci];
        float b = 0.f, a = -3.0e38f;
        if (lane < lc) { b = wsf<C>(p, C::WS_GB)[(size_t)(r0 + lane) * C::MH + h]; a = wsf<C>(p, C::WS_GA)[(size_t)(r0 + lane) * C::MH + h]; }
        float pm = a;
#pragma unroll
        for (int o = 1; o < 64; o <<= 1) { const float t = __shfl_up(pm, o); if (lane >= o) pm = fmaxf(pm, t); }
        const float mrow = b + fmaxf(mprev, pm);
        SB[wave * 64 + lane] = b; SA[wave * 64 + lane] = a; SMR[wave * 64 + lane] = mrow; SIW[wave * 64 + lane] = __expf(b + mprev - mrow); }
    const unsigned lofs8 = (unsigned)((8 * g + (li >> 2)) * PT + 8 * (li & 3)), lofs4 = (unsigned)((4 * g + (li >> 2)) * PT + 8 * (li & 3));
    const unsigned vs4e = (unsigned)(size_t)Vs + lofs4 + (unsigned)(128 * eh), cb8e = (unsigned)(size_t)Cs + lofs8 + (unsigned)(128 * eh);
    f32x4 pq[4], pk[4], pv[4], og[4]; u32x4 pc[4]; float pn = 0.f, pg = 0.f;
    auto window = [&](int ci) { int r0, h, lc; mx::ch_decode(ci, r0, h, lc); const float* src = P + (size_t)r0 * C::LDP + h * C::MHD;
        const bool sample = ci >= C::NPC, first = !sample && (ci % C::NC) == 0;
#pragma unroll
        for (int q = 0; q < 4; ++q) { const int f = tid + 512 * q, row = f >> 5, c4 = f & 31;
            if (row < lc) { pq[q] = *(const f32x4*)(src + (size_t)row * C::LDP + C::O_Q + c4 * 4); pk[q] = *(const f32x4*)(src + (size_t)row * C::LDP + C::O_K + c4 * 4); pv[q] = *(const f32x4*)(src + (size_t)row * C::LDP + C::O_VM + c4 * 4); }
            else { pq[q] = (f32x4){0.f, 0.f, 0.f, 0.f}; pk[q] = pq[q]; pv[q] = pq[q]; } }
        const bf16_t* cb = wsb<C>(p, C::WS_DCB) + (size_t)(sample ? ci : (first ? ci : ci - 1)) * C::MHD * C::MHD;
#pragma unroll
        for (int q = 0; q < 4; ++q) { const int f = tid + 512 * q; pc[q] = first ? (u32x4){0u, 0u, 0u, 0u} : *(const u32x4*)(cb + (size_t)f * 8); }
        const int i = 16 * it + li;
#pragma unroll
        for (int e4 = 0; e4 < 4; ++e4) og[e4] = (it * 16 < lc) ? *(const f32x4*)(src + (size_t)i * C::LDP + C::O_O + 16 * (4 * eh + e4) + 4 * g) : (f32x4){0.f, 0.f, 0.f, 0.f};
        if (tid < C::MHD) { pn = sample ? p.in[I_SN][((size_t)l * C::NSC + (ci - C::NPC)) * C::MHD + tid] : (first ? 0.f : wsf<C>(p, C::WS_DN)[(size_t)(ci - 1) * C::MHD + tid]);
            pg = p.in[I_NG][(size_t)l * C::MW + h * C::MHD + tid]; }
        __builtin_amdgcn_sched_barrier(0); };
    if (nu > 0) window(bid);
    WG_SYNC();
#if defined(PROBE_MLC)
    unsigned long long tacc[4] = {0, 0, 0, 0}; unsigned long long tprev = wall_clock64();
#define MLC_T(j) do { const unsigned long long tn_ = wall_clock64(); tacc[j] += tn_ - tprev; tprev = tn_; } while (0)
#else
#define MLC_T(j) do { } while (0)
#endif
    for (int j = 0; j < nu; ++j) { const int ci = bid + j * gsz; int r0, h, lc; mx::ch_decode(ci, r0, h, lc);
        const LAS float* sb = SB + j * 64; const LAS float* sa = SA + j * 64; const LAS float* smr = SMR + j * 64; const LAS float* siw = SIW + j * 64;
#pragma unroll
        for (int q = 0; q < 4; ++q) { const int f = tid + 512 * q, row = f >> 5, c4 = f & 31; const float sc = 0.08838834764831845f;
            u32x2 w; w.x = pg8::cvt_pk_bf16(pq[q][0], pq[q][1]); w.y = pg8::cvt_pk_bf16(pq[q][2], pq[q][3]); *(LAS u32x2*)(Qs + row * PT + c4 * 8) = w;
            w.x = pg8::cvt_pk_bf16(pk[q][0] * sc, pk[q][1] * sc); w.y = pg8::cvt_pk_bf16(pk[q][2] * sc, pk[q][3] * sc); *(LAS u32x2*)(Ks + row * PT + c4 * 8) = w;
            w.x = pg8::cvt_pk_bf16(pv[q][0], pv[q][1]); w.y = pg8::cvt_pk_bf16(pv[q][2], pv[q][3]); *(LAS u32x2*)(Vs + row * PT + c4 * 8) = w;
            *(LAS u32x4*)(Cs + (f >> 4) * PT + (f & 15) * 16) = pc[q]; }
        if (tid < C::MHD) { snp[tid] = pn; sgn[tid] = pg; }
        f32x4 ogc[4];
#pragma unroll
        for (int e4 = 0; e4 < 4; ++e4) ogc[e4] = og[e4];
        if (j + 1 < nu) window(ci + gsz);
        WG_SYNC(); MLC_T(0);
        const bool active = it * 16 < lc; const int i = 16 * it + li;
        float ssq_part = 0.f; f32x4 hv[4];
        if (active) {
            bf16x8 qf[4];
#pragma unroll
            for (int ks = 0; ks < 4; ++ks) qf[ks] = *(const LAS bf16x8*)(Qs + i * PT + ks * 64 + g * 16);
            f32x4 st[4];
#pragma unroll
            for (int jt = 0; jt < 4; ++jt) st[jt] = (f32x4){0.f, 0.f, 0.f, 0.f};
#pragma unroll
            for (int jt = 0; jt < 4; ++jt) if (jt <= it) {
#pragma unroll
                for (int ks = 0; ks < 4; ++ks) { const bf16x8 a = *(const LAS bf16x8*)(Ks + (16 * jt + li) * PT + ks * 64 + g * 16);
                    st[jt] = __builtin_amdgcn_mfma_f32_16x16x32_bf16(a, qf[ks], st[jt], 0, 0, 0); } }
            const float bi = sb[i], mri = smr[i], iwi = siw[i];
            float dsum = 0.f;
#pragma unroll
            for (int jt = 0; jt < 4; ++jt)
#pragma unroll
                for (int r = 0; r < 4; ++r) { const int jj = 16 * jt + 4 * g + r; const float w = (jj <= i) ? __expf(bi + sa[jj] - mri) : 0.f; st[jt][r] *= w; dsum += st[jt][r]; }
            dsum += __shfl_xor(dsum, 16); dsum += __shfl_xor(dsum, 32);
            float qn = 0.f;
#pragma unroll
            for (int ks = 0; ks < 4; ++ks)
#pragma unroll
                for (int jj = 0; jj < 8; ++jj) qn += bf2f((bf16_t)qf[ks][jj]) * snp[32 * ks + 8 * g + jj];
            qn += __shfl_xor(qn, 16); qn += __shfl_xor(qn, 32);
            const float den = dsum + iwi * qn, inv_den = 1.0f / fmaxf(fabsf(den), __expf(-mri));
            bf16x8 pf[2];
#pragma unroll
            for (int t = 0; t < 2; ++t) { u32x4 w; w.x = pg8::cvt_pk_bf16(st[2 * t][0], st[2 * t][1]); w.y = pg8::cvt_pk_bf16(st[2 * t][2], st[2 * t][3]);
                w.z = pg8::cvt_pk_bf16(st[2 * t + 1][0], st[2 * t + 1][1]); w.w = pg8::cvt_pk_bf16(st[2 * t + 1][2], st[2 * t + 1][3]); pf[t] = __builtin_bit_cast(bf16x8, w); }
#pragma unroll
            for (int e2 = 0; e2 < 2; ++e2) {
                s16x4 vlo[2][2], vhi[2][2], clo[2][4], chi[2][4];
#pragma unroll
                for (int u = 0; u < 2; ++u) {
#pragma unroll
                    for (int t = 0; t < 2; ++t) { MP_TR(vlo[u][t], vs4e, (32 * t) * PT + 32 * (2 * e2 + u)); MP_TR(vhi[u][t], vs4e, (32 * t + 16) * PT + 32 * (2 * e2 + u)); }
#pragma unroll
                    for (int ks = 0; ks < 4; ++ks) { MP_TR(clo[u][ks], cb8e, (32 * ks) * PT + 32 * (2 * e2 + u)); MP_TR(chi[u][ks], cb8e, (32 * ks + 4) * PT + 32 * (2 * e2 + u)); } }
                mx::lds_wait();
#pragma unroll
                for (int u = 0; u < 2; ++u) { const int e4 = 2 * e2 + u;
                    f32x4 aS = (f32x4){0.f, 0.f, 0.f, 0.f}, aC = (f32x4){0.f, 0.f, 0.f, 0.f};
#pragma unroll
                    for (int t = 0; t < 2; ++t) aS = __builtin_amdgcn_mfma_f32_16x16x32_bf16(mx::mk8(vlo[u][t], vhi[u][t]), pf[t], aS, 0, 0, 0);
#pragma unroll
                    for (int ks = 0; ks < 4; ++ks) aC = __builtin_amdgcn_mfma_f32_16x16x32_bf16(mx::mk8(clo[u][ks], chi[u][ks]), qf[ks], aC, 0, 0, 0);
                    hv[e4] = (aS + aC * iwi) * inv_den;
                    ssq_part += (hv[e4][0] * hv[e4][0] + hv[e4][1] * hv[e4][1]) + (hv[e4][2] * hv[e4][2] + hv[e4][3] * hv[e4][3]); } }
            ssq_part += __shfl_xor(ssq_part, 16); ssq_part += __shfl_xor(ssq_part, 32);
            if (g == 0) ssq[wave * 16 + li] = ssq_part;
        }
        MLC_T(1); WG_SYNC();
        if (active) {
            const float tot = ssq_part + ssq[(wave ^ 4) * 16 + li];
            const float rs = rsqrtf(tot * (1.0f / C::MHD) + 1e-6f);
            const int row = r0 + i;
#pragma unroll
            for (int e4 = 0; e4 < 4; ++e4) { const int e = 16 * (4 * eh + e4) + 4 * g; const f32x4 gn = *(const LAS f32x4*)(sgn + e);
                float o4[4];
#pragma unroll
                for (int r = 0; r < 4; ++r) o4[r] = hv[e4][r] * rs * gn[r] * __builtin_amdgcn_rcpf(1.0f + __expf(-ogc[e4][r]));
                u32x2 w; w.x = pg8::cvt_pk_bf16(o4[0], o4[1]); w.y = pg8::cvt_pk_bf16(o4[2], o4[3]);
                *(u32x2*)(wsb<C>(p, C::WS_MIX) + (size_t)row * C::D + C::PW + C::GW + h * C::MHD + e) = w; }
        }
        MLC_T(2); WG_SYNC(); MLC_T(3);
    }
#if defined(PROBE_MLC)
    if (bid == 0 && tid == 0) { unsigned long long* TS = (unsigned long long*)(p.ws + C::WS_CTL + 32768); for (int j = 0; j < 4; ++j) TS[48 + j] += tacc[j]; }
#endif
}
}
constexpr int PH_PER_LAYER = 12, N_PHASES = 2 + PH_PER_LAYER * C::DEPTH;
struct Args { Ptrs p; int ph_lo, ph_hi; };
__global__ void __launch_bounds__(NTHREADS, 2) fwd(Args a) {
    extern __shared__ __attribute__((aligned(16))) unsigned char lds_raw[];
    LAS unsigned char* lds = (LAS unsigned char*)lds_raw;
    typedef __attribute__((address_space(4))) const Args* KArgs;
    const KArgs ka0 = (KArgs)__builtin_amdgcn_kernarg_segment_ptr();
    const int lo = a.ph_lo, hi = a.ph_hi;
#define IN(k) (lo <= (k) && (k) < hi)
#define BOTH(k) (IN(k) && IN((k) + 1))
#define GRID_BAR(k) do { if (BOTH(k)) { xcd_barrier(bar); } } while (0)
#if defined(__HIP_DEVICE_COMPILE__)
#define LOAD_PTRS KArgs ka = ka0; asm volatile("" : "+s"(ka)); Ptrs p; _Pragma("unroll") for (int i_ = 0; i_ < 33; ++i_) p.in[i_] = ka->p.in[i_]; p.out = ka->p.out; p.ws = ka->p.ws;
#else
#define LOAD_PTRS (void)ka0; const Ptrs p = a.p;
#endif
#define PHASE_ARGS LOAD_PTRS int tid = threadIdx.x; asm volatile("" : "+v"(tid)); int bid = blockIdx.x, gsz = gridDim.x; asm volatile("" : "+s"(bid), "+s"(gsz));     \
    const int lane = tid & 63, wave = __builtin_amdgcn_readfirstlane(tid >> 6); (void)lane; (void)wave; \
    const long gtid = (long)bid * NTHREADS + tid, gthreads = (long)gsz * NTHREADS; (void)gtid; (void)gthreads; \
    float* SS = wsf<C>(p, C::WS_SS); (void)SS; const float invd = 1.0f / C::D; (void)invd;
#if defined(PROBE_MASK_A)
#define STAMP(k) do { if (blockIdx.x == 0 && threadIdx.x == 0) ((unsigned long long*)(a.p.ws + C::WS_CTL + 32768))[k] = wall_clock64(); } while (0)
#else
#define STAMP(k) do { } while (0)
#endif
#define ITEMS(n, call) do { for (long it = gtid; it < (long)(n); it += gthreads) { call; } } while (0)
#define SSL(j) (SS + (size_t)(4 * l + (j)) * C::M)
#define GEMM_ALL(STRIP, EPI, Aop, Bop, Mr, Nc, Kd, ...) do { pg8::Gemm g{Aop, Bop, Mr, Nc, Kd, Kd}; pg8::StaticOrder S; S.init(Mr, Nc, gsz, bid, (STRIP) ? 288 : 256); \
        pg8::EPI E{__VA_ARGS__}; pg8::gemm_phase<pg8::EPI, pg8::StaticOrder, STRIP, false>(lds, g, S, E, nullptr); } while (0)
#if ONE_LAUNCH
    if (threadIdx.x < 4) ((LAS unsigned*)(lds + LDS_CTL))[threadIdx.x] = 0u;
    __syncthreads();
    XcdBarrier bar = xcd_barrier_post((unsigned*)(a.p.ws + C::WS_CTL), (volatile LAS unsigned*)(lds + LDS_CTL));
#else
    XcdBarrier bar; bar.bar = nullptr; bar.x = 0; bar.st = nullptr;
#endif

    if (IN(0)) { PHASE_ARGS STAMP(0);
        const int gw = bid * NWAVES + wave, NGW = gsz * NWAVES;
        for (int l = 0; l < C::DEPTH; ++l)
            for (int idx = 0; idx < 10; ++idx) { const WDesc d = wdesc(p, l, idx); const int nitems = (d.K / 64) * (d.N / 64);
                for (int it = gw; it < nitems; it += NGW) prep_item(d.W, d.K, d.Ncols, d.g, d.kind, d.N, d.dst, lds + wave * 9216, it, lane); }
        rw::rows_init(p, tid, bid, gsz);
        GRID_BAR(0);
    }
    for (int l = 0; l < C::DEPTH; ++l) {
        const int pb = 1 + PH_PER_LAYER * l;
        if (IN(pb + 0)) { PHASE_ARGS STAMP(pb + 0);
#if defined(PROBE_GST)
            if (l == 0) { pg8::Gemm g{wsb<C>(p, C::WS_XB), wlayer<C>(p, l, C::W_1IN), C::M, 2 * C::FF, C::D, C::D}; pg8::StaticOrder S; S.init(C::M, 2 * C::FF, gsz, bid, 288);
                pg8::EpiSwiGLU E{wsb<C>(p, C::WS_BIG), SSL(0), C::FF, invd}; pg8::gemm_phase<pg8::EpiSwiGLU, pg8::StaticOrder, true, true>(lds, g, S, E, (unsigned long long*)(p.ws + C::WS_END) + (size_t)bid * 64); } else
#endif
            GEMM_ALL(true, EpiSwiGLU, wsb<C>(p, C::WS_XB), wlayer<C>(p, l, C::W_1IN), C::M, 2 * C::FF, C::D, wsb<C>(p, C::WS_BIG), SSL(0), C::FF, invd);
            GRID_BAR(pb + 0); }
        if (IN(pb + 1)) { PHASE_ARGS STAMP(pb + 1);
            GEMM_ALL(true, EpiResid, wsb<C>(p, C::WS_BIG), wlayer<C>(p, l, C::W_1OUT), C::M, C::D, C::FF, wsf<C>(p, C::WS_X), wsb<C>(p, C::WS_XB), SSL(1), 0.5f, C::D);
            GRID_BAR(pb + 1); }
        if (IN(pb + 2)) { PHASE_ARGS STAMP(pb + 2);
            GEMM_ALL(true, EpiScaleF32, wsb<C>(p, C::WS_XB), wlayer<C>(p, l, C::W_IN), C::M, C::LDP, C::D, wsf<C>(p, C::WS_BIG), C::LDP, SSL(1), invd);
            GRID_BAR(pb + 2); }
        if (IN(pb + 3)) { PHASE_ARGS STAMP(pb + 3); mp::ml_a(lds, p, l, tid, bid, gsz);
#if defined(PROBE_MIXA)
            xcd_barrier(bar); STAMP(40 + l);
#endif
            gp::gmlp_phase(lds, p, l, tid, gsz - 1 - bid, gsz);
#if defined(PROBE_MIXA)
            xcd_barrier(bar); STAMP(42 + l);
#endif
            GRID_BAR(pb + 3); }
        if (IN(pb + 4)) { PHASE_ARGS STAMP(pb + 4);
            if (bid < 64) {
                pg8::Gemm g{wsb<C>(p, C::WS_MEMB), wlayer<C>(p, l, C::W_KV), C::MM, 2 * C::D, C::D, C::D}; pg8::StaticOrder S; S.init(C::MM, 2 * C::D, 64, bid);
                pg8::EpiMemKV E{p.out + C::OUT_MK + (size_t)l * C::MM * C::D, p.out + C::OUT_MV + (size_t)l * C::MM * C::D, wsf<C>(p, C::WS_RSTDM), C::D, wsb<C>(p, C::WS_KVB), C::MM};
                pg8::gemm_phase<pg8::EpiMemKV, pg8::StaticOrder, false, false>(lds, g, S, E, nullptr);
            } else { mp::ml_scan(p, l, (long)(bid - 64) * NTHREADS + tid, (long)(gsz - 64) * NTHREADS); gp::pool_phase(lds, p, l, tid, gsz - 1 - bid, gsz - 64); }
            GRID_BAR(pb + 4); }
        if (IN(pb + 5)) { PHASE_ARGS STAMP(pb + 5); mp::ml_c(lds, p, l, tid, bid, gsz); GRID_BAR(pb + 5); }
        if (IN(pb + 6)) { PHASE_ARGS STAMP(pb + 6);
            GEMM_ALL(true, EpiResid, wsb<C>(p, C::WS_MIX), wlayer<C>(p, l, C::W_OUT), C::M, C::D, C::D, wsf<C>(p, C::WS_X), wsb<C>(p, C::WS_XB), SSL(2), 1.0f, C::D);
            GRID_BAR(pb + 6); }
        if (IN(pb + 7)) { PHASE_ARGS STAMP(pb + 7);
            GEMM_ALL(true, EpiScaleBf16, wsb<C>(p, C::WS_XB), wlayer<C>(p, l, C::W_Q), C::M, C::D, C::D, wsb<C>(p, C::WS_Q), C::D, SSL(2), invd);
            GRID_BAR(pb + 7); }
        if (IN(pb + 8)) { PHASE_ARGS STAMP(pb + 8);
            if (bid < 128) att::attn_phase(lds, p, l, tid, bid, 128, 128);
            else att::attn_sample_phase(lds, p, l, tid, bid - 128, gsz - 128);
            GRID_BAR(pb + 8); }
        if (IN(pb + 9)) { PHASE_ARGS STAMP(pb + 9);
            GEMM_ALL(true, EpiResid, wsb<C>(p, C::WS_AO), wlayer<C>(p, l, C::W_O), C::M, C::D, C::D, wsf<C>(p, C::WS_X), wsb<C>(p, C::WS_XB), SSL(3), 1.0f, C::D);
            GRID_BAR(pb + 9); }
        if (IN(pb + 10)) { PHASE_ARGS STAMP(pb + 10);
            GEMM_ALL(true, EpiSwiGLU, wsb<C>(p, C::WS_XB), wlayer<C>(p, l, C::W_2IN), C::M, 2 * C::FF, C::D, wsb<C>(p, C::WS_BIG), SSL(3), C::FF, invd);
            GRID_BAR(pb + 10); }
        if (IN(pb + 11)) { PHASE_ARGS STAMP(pb + 11);
            GEMM_ALL(true, EpiResid, wsb<C>(p, C::WS_BIG), wlayer<C>(p, l, C::W_2OUT), C::M, C::D, C::FF, wsf<C>(p, C::WS_X), wsb<C>(p, C::WS_XB), SSL(4), 0.5f, C::D);
            GRID_BAR(pb + 11); }
    }
    if (IN(N_PHASES - 1)) { PHASE_ARGS STAMP(N_PHASES - 1); __syncthreads(); rw::rows_final(p, tid, bid, gsz); }
#undef IN
#undef BOTH
#undef GRID_BAR
#undef ITEMS
#undef PHASE_ARGS
#undef SSL
}

extern "C" void kernel_launch(void* const* d_in, const int* in_sizes, int n_in, void* d_out, int out_size, void* d_ws, size_t ws_size, hipStream_t stream) {
    static int ready = 0;
    if (!ready) {
        if (n_in != 33 || (long)out_size != (long)C::OUT_END || ws_size < (size_t)C::WS_END) { fprintf(stderr, "kernel_launch: unexpected shapes: n_in %d out %d ws %zu (need %zu)\n", n_in, out_size, ws_size, (size_t)C::WS_END); ready = -1; return; }
        if (hipFuncSetAttribute((const void*)fwd, hipFuncAttributeMaxDynamicSharedMemorySize, LDS_BYTES) != hipSuccess) { fprintf(stderr, "kernel_launch: hipFuncSetAttribute failed\n"); ready = -1; return; }
        int dev = 0, cus = 0, per_cu = 0;
        if (hipGetDevice(&dev) != hipSuccess || hipDeviceGetAttribute(&cus, hipDeviceAttributeMultiprocessorCount, dev) != hipSuccess) { fprintf(stderr, "kernel_launch: device query failed\n"); ready = -1; return; }
        if (hipOccupancyMaxActiveBlocksPerMultiprocessor(&per_cu, (const void*)fwd, NTHREADS, LDS_BYTES) != hipSuccess || per_cu < 1) { fprintf(stderr, "kernel_launch: occupancy query reports %d blocks per CU\n", per_cu); (void)hipGetLastError(); per_cu = 1; }
        if (cus != 256) { fprintf(stderr, "kernel_launch: built for a 256-CU device (one resident workgroup per CU), found %d\n", cus); ready = -1; return; }
        ready = cus;
    }
    if (ready < 0) return;
    Args a{};
    for (int i = 0; i < 33; ++i) a.p.in[i] = (const float*)d_in[i];
    a.p.out = (float*)d_out; a.p.ws = (unsigned char*)d_ws;
#if ONE_LAUNCH
    (void)hipMemsetAsync((char*)d_ws + C::WS_CTL, 0, 65536, stream);
    a.ph_lo = 0; a.ph_hi = N_PHASES;
    hipLaunchKernelGGL(fwd, dim3(ready), dim3(NTHREADS), LDS_BYTES, stream, a);
#else
    for (int k = 0; k < N_PHASES; ++k) { a.ph_lo = k; a.ph_hi = k + 1; hipLaunchKernelGGL(fwd, dim3(ready), dim3(NTHREADS), LDS_BYTES, stream, a); }
#endif
}
```

```cpp
#include <hip/hip_runtime.h>
#include <cstdio>
#define ONE_LAUNCH 1

#define HD __host__ __device__
#ifndef HD
#define HD __host__ __device__
#endif
typedef unsigned short bf16_t;
HD inline unsigned f2u(float f) { return __builtin_bit_cast(unsigned, f); }
HD inline float u2f(unsigned u) { return __builtin_bit_cast(float, u); }
HD inline bf16_t f2bf(float f) { unsigned u = f2u(f); u += 0x7FFFu + ((u >> 16) & 1u); return (bf16_t)(u >> 16); }
HD inline float bf2f(bf16_t b) { return u2f(((unsigned)b) << 16); }

struct RC {
    static constexpr int D = 2048, FF = 8192, BATCH = 4, SEQ = 2048, DEPTH = 2, DEC_BATCH = 32, DEC_SEQ = 32, PAST = 2048, NMEM = 256;
};
template <class B> struct CfgT : B {
    using B::D; using B::FF; using B::BATCH; using B::SEQ; using B::DEPTH; using B::DEC_BATCH; using B::DEC_SEQ; using B::PAST; using B::NMEM;
    static constexpr int MP = BATCH * SEQ, MS = DEC_BATCH * DEC_SEQ, M = MP + MS, MM = BATCH * NMEM;
    static constexpr int PW = D / 4, PG = 4, PGD = PW / 4, PH = 15;
    static constexpr int GW = D / 4, GH = 4, GHD = GW / 4, GCH = 128;
    static constexpr int MW = D - PW - GW, MH = 8, MHD = MW / 8, CH = 64;
    static constexpr int INC = PW + 2 * GW + 4 * MW + 2 * MH;
    static constexpr int LDP = ((INC + 255) / 256) * 256;
    static constexpr int AH = 4, AHD = D / 4;
    static constexpr int O_U = PW, O_V = PW + GW, O_Q = PW + 2 * GW, O_K = O_Q + MW, O_VM = O_K + MW, O_O = O_VM + MW, O_IG = O_O + MW, O_FG = O_IG + MH;
    static constexpr int NC = SEQ / CH, NPC = BATCH * MH * NC, NSC = DEC_BATCH * MH, NCH = NPC + NSC;
    static constexpr int LCS = DEC_SEQ < CH ? DEC_SEQ : CH;
    static constexpr int GLP = SEQ < GCH ? SEQ : GCH, GLS = DEC_SEQ < GCH ? DEC_SEQ : GCH;
    static constexpr int NSS = 1 + 4 * DEPTH;
    static constexpr long OUT_YP = 0, OUT_YS = OUT_YP + (long)MP * D, OUT_POOLP = OUT_YS + (long)MS * D, OUT_POOLS = OUT_POOLP + (long)DEPTH * BATCH * PH * PW,
        OUT_CP = OUT_POOLS + (long)DEPTH * DEC_BATCH * PH * PW, OUT_NP = OUT_CP + (long)DEPTH * BATCH * MH * MHD * MHD, OUT_MP = OUT_NP + (long)DEPTH * BATCH * MH * MHD,
        OUT_CS = OUT_MP + (long)DEPTH * BATCH * MH, OUT_NS = OUT_CS + (long)DEPTH * DEC_BATCH * MH * MHD * MHD, OUT_MS = OUT_NS + (long)DEPTH * DEC_BATCH * MH * MHD,
        OUT_VS = OUT_MS + (long)DEPTH * DEC_BATCH * MH, OUT_MK = OUT_VS + (long)DEPTH * DEC_BATCH * DEC_SEQ * GW, OUT_MV = OUT_MK + (long)DEPTH * BATCH * NMEM * D,
        OUT_END = OUT_MV + (long)DEPTH * BATCH * NMEM * D;
    static constexpr size_t al(size_t x) { return (x + 255) & ~(size_t)255; }
    static constexpr size_t WS_CTL = 0, WS_SS = 65536, WS_X = al(WS_SS + (size_t)NSS * M * 4), WS_XB = al(WS_X + (size_t)M * D * 4),
        WS_BIG = al(WS_XB + (size_t)M * D * 2),
        WS_BIG_SZ = ((size_t)M * FF * 2 > (size_t)M * LDP * 4) ? (size_t)M * FF * 2 : (size_t)M * LDP * 4,
        WS_MIX = al(WS_BIG + WS_BIG_SZ), WS_Q = al(WS_MIX + (size_t)M * D * 2), WS_AO = al(WS_Q + (size_t)M * D * 2),
        WS_MEMB = al(WS_AO + (size_t)M * D * 2), WS_RSTDM = al(WS_MEMB + (size_t)MM * D * 2),
        WS_GB = al(WS_RSTDM + (size_t)MM * 4), WS_GA = al(WS_GB + (size_t)M * MH * 4),
        WS_CBL = al(WS_GA + (size_t)M * MH * 4), WS_CML = al(WS_CBL + (size_t)NCH * 4), WS_MPREV = al(WS_CML + (size_t)NCH * 4),
        WS_DC = al(WS_MPREV + (size_t)NCH * 4), WS_DN = al(WS_DC + (size_t)NCH * MHD * MHD * 4),
        WS_DCB = al(WS_DN + (size_t)NCH * MHD * 4),
        WS_W = al(WS_DCB + (size_t)NCH * MHD * MHD * 2);
    static constexpr size_t W_1IN = 0, W_1OUT = W_1IN + (size_t)2 * FF * D, W_IN = W_1OUT + (size_t)D * FF, W_OUT = W_IN + (size_t)LDP * D, W_Q = W_OUT + (size_t)D * D,
        W_KV = W_Q + (size_t)D * D, W_O = W_KV + (size_t)2 * D * D, W_2IN = W_O + (size_t)D * D, W_2OUT = W_2IN + (size_t)2 * FF * D, W_LAYER = W_2OUT + (size_t)D * FF;
    static constexpr size_t WS_KVB = al(WS_W + (size_t)DEPTH * W_LAYER * 2);
    static constexpr size_t WS_END = al(WS_KVB + (size_t)2 * MM * D * 2);
};

struct Ptrs { const float* in[33]; float* out; unsigned char* ws; };
enum { I_XP = 0, I_XS, I_MEM, I_SPOOL, I_SC, I_SN, I_SM, I_CK, I_CV, I_GFFN1, I_W1IN, I_W1OUT, I_GMIX, I_WIN, I_POOLW, I_POOLS, I_GVG, I_GWS, I_GBS, I_IB, I_FB, I_NG, I_WOUT,
       I_GX, I_GMEM, I_WQ, I_WK, I_WV, I_WO, I_GFFN2, I_W2IN, I_W2OUT, I_GFIN };

template <class C> HD inline float* wsf(const Ptrs& p, size_t off) { return (float*)(p.ws + off); }
template <class C> HD inline bf16_t* wsb(const Ptrs& p, size_t off) { return (bf16_t*)(p.ws + off); }
template <class C> HD inline bf16_t* wlayer(const Ptrs& p, int l, size_t off) { return (bf16_t*)(p.ws + C::WS_W) + (size_t)l * C::W_LAYER + off; }

template <class C> HD inline void row_info(int r, bool& s, int& b, int& t) {
    if (r < C::MP) { s = false; b = r / C::SEQ; t = r % C::SEQ; } else { s = true; const int q = r - C::MP; b = q / C::DEC_SEQ; t = q % C::DEC_SEQ; }
}
template <class C> HD inline void chunk_info(int r, int h, int& ci, int& i, int& lc) {
    bool s; int b, t; row_info<C>(r, s, b, t);
    if (!s) { ci = (b * C::MH + h) * C::NC + t / C::CH; i = t % C::CH; lc = C::CH; } else { ci = C::NPC + b * C::MH + h; i = t; lc = C::LCS; }
}
HD inline float sigmoidf_(float x) { return 1.0f / (1.0f + expf(-x)); }
HD inline float logsigmoidf_(float x) { return x >= 0.f ? -log1pf(expf(-x)) : x - log1pf(expf(x)); }

enum { WK_PLAIN = 0, WK_FFNIN = 1, WK_WIN = 2 };
template <class C> HD inline int wsrc_col(int kind, int n) {
    if (kind == WK_FFNIN) { const int pn = n >> 8, j = n & 255; return j < 128 ? 128 * pn + j : C::FF + 128 * pn + (j - 128); }
    if (kind == WK_WIN) return n < C::INC ? n : -1;
    return n;
}

template <class C> HD inline void st_ml_b0(const Ptrs& p, int l, int sq) {
    const float* CBL = wsf<C>(p, C::WS_CBL); const float* CML = wsf<C>(p, C::WS_CML); float* MPREV = wsf<C>(p, C::WS_MPREV);
    if (sq < C::BATCH * C::MH) { float m = 0.f;
        for (int c = 0; c < C::NC; ++c) { const int ci = sq * C::NC + c; MPREV[ci] = m; const float a = CBL[ci] + m, b2 = CML[ci]; m = a > b2 ? a : b2; }
        p.out[C::OUT_MP + (size_t)l * C::BATCH * C::MH + sq] = m;
    } else { const int q = sq - C::BATCH * C::MH, ci = C::NPC + q; const float m0 = p.in[I_SM][(size_t)l * C::DEC_BATCH * C::MH + q];
        MPREV[ci] = m0; const float a = CBL[ci] + m0, b2 = CML[ci]; p.out[C::OUT_MS + (size_t)l * C::DEC_BATCH * C::MH + q] = a > b2 ? a : b2; }
}

namespace pg8 {
#define PG8_LAS __attribute__((address_space(3)))
typedef unsigned short bf16_t;
typedef short bf16x8 __attribute__((ext_vector_type(8)));
typedef float f32x4 __attribute__((ext_vector_type(4)));
typedef unsigned u32x4 __attribute__((ext_vector_type(4)));
constexpr int BM = 256, BK = 64, HALF = 128, HTB = HALF * BK * 2  , STAGE_BYTES = 8 * HTB, NXCD = 8, WGM = 8;

__host__ __device__ __forceinline__ int lds_byte(int r, int c) { const int st = (r >> 4) * 2 + (c >> 5), rr = r & 15, cc = c & 31, ob = rr * 64 + cc * 2; return st * 1024 + (ob ^ (((ob >> 9) & 1) << 5)); }
__host__ __device__ __forceinline__ void stage_rc(int b, int& R, int& C) { const int st = b / 1024, sb = b % 1024, swz = sb ^ (((sb >> 9) & 1) << 5); R = (st >> 1) * 16 + swz / 64; C = (st & 1) * 32 + (swz % 64) / 2; }
__host__ __device__ __forceinline__ int perm32(int rho) { const int n = rho >> 4, i = rho & 15; return 8 * (i >> 2) + 4 * n + (i & 3); }

struct Unit { int pm, pn; };
struct Gemm { const bf16_t* A; const bf16_t* Bt; int M, N, K, ld; };

struct StaticOrder {
    int nM, nN, nwg, G, c;
    __host__ __device__ __forceinline__ void init(int M, int N, int G_, int c_, int rows_per_tile = BM) { nM = M / rows_per_tile; nN = N / BM; nwg = nM * nN; G = G_; c = c_; }
    __host__ __device__ __forceinline__ bool next(int i, Unit& u) const {
        const long L = (long)i * G + c; if (L >= nwg) return false;
        int wgid = (int)L; { const int q = nwg / NXCD, r = nwg % NXCD, xcd = wgid % NXCD, off = wgid / NXCD; wgid = (xcd < r ? xcd * (q + 1) : r * (q + 1) + (xcd - r) * q) + off; }
        const int nig = WGM * nN, gid = wgid / nig, fm = gid * WGM, gsz = (nM - fm) < WGM ? (nM - fm) : WGM;
        u.pm = fm + ((wgid % nig) % gsz); u.pn = (wgid % nig) / gsz; return true;
    }
    __device__ __forceinline__ void a_ready(const Unit&) const {}
    __device__ __forceinline__ void done(const Unit&) const {}
};
__device__ __forceinline__ unsigned cvt_pk_bf16(float lo, float hi) { unsigned r; asm volatile("v_cvt_pk_bf16_f32 %0, %1, %2" : "=v"(r) : "v"(lo), "v"(hi)); return r; }
typedef float f32x2 __attribute__((ext_vector_type(2)));
template <class Epi, class Sched, bool STRIP = false, bool STAMP = false>
__device__ __forceinline__ void gemm_phase(PG8_LAS unsigned char* lds, const Gemm g, const Sched& S, const Epi& E, unsigned long long* stamps) {
    int tid_l = threadIdx.x; asm volatile("" : "+v"(tid_l));
    const int tid = tid_l, wid = __builtin_amdgcn_readfirstlane(tid >> 6), lane = tid & 63, wr = wid >> 2, wc = wid & 3, fr = lane & 15, fq = lane >> 4;
    const int K = g.K, nt = K / BK;
    int ts_lo = 0, ts_hi = 0, nts = 0; const unsigned long long rt_entry = STAMP ? (unsigned long long)wall_clock64() : 0ull;
#define PG8_STAMP() do { if (STAMP && wid == 0 && nts < 64) { const unsigned long long _c = (unsigned long long)clock64(); \
        ts_lo = (lane == nts) ? (int)(unsigned)_c : ts_lo; ts_hi = (lane == nts) ? (int)(unsigned)(_c >> 32) : ts_hi; ++nts; } } while (0)
    PG8_STAMP();
    unsigned voffA[2], voffB[2];
#pragma unroll
    for (int i = 0; i < 2; ++i) { int R, C; stage_rc(tid * 16 + i * 8192, R, C); const int Rb = Epi::PERM ? ((R & ~31) + perm32(R & 31)) : R;
        voffA[i] = (unsigned)(R * g.ld + C) * 2u; voffB[i] = (unsigned)(Rb * g.ld + C) * 2u; }
    const size_t kstep = (size_t)(BK * 2);
    const size_t hstep = (size_t)HALF * g.ld * 2;
    const size_t tstep = 2 * hstep;
    const size_t tstepA = STRIP ? (size_t)288 * g.ld * 2 : tstep;
    unsigned voffS = 0u; if constexpr (STRIP) { int R, C; stage_rc((wid & 3) * 1024 + lane * 16, R, C); voffS = (unsigned)(R * g.ld + C) * 2u; }
    const int soff = lds_byte(wr * 16 + fr, fq * 8);
    const unsigned ldsw = (unsigned)wid * 1024u;
    const int aoff = lds_byte(wr * 64 + fr, fq * 8), boff = lds_byte(wc * 32 + fr, fq * 8);
#define PG8_SA(b, h) (((b) * 2 + (h)) * HTB)
#define PG8_SB(b, h) ((4 + (b) * 2 + (h)) * HTB)
#define PG8_SS(b) (8 * HTB + (b) * 8192)
#define PG8_STAGE_S(b, gbase) do { if constexpr (STRIP) __builtin_amdgcn_global_load_lds((const unsigned*)((const char*)(gbase) + 2 * hstep + voffS), (PG8_LAS unsigned*)(lds + PG8_SS(b) + ldsw), 16, 0, 0); } while (0)
#define PG8_LDS(b) do { if constexpr (STRIP) { _Pragma("unroll") for (int k = 0; k < 2; ++k) Sf[k] = *(const PG8_LAS bf16x8*)(lds + PG8_SS(b) + soff + k * 1024); } } while (0)
#define PG8_MMS(bj, Bt) do { if constexpr (STRIP) { __builtin_amdgcn_s_setprio(1); _Pragma("unroll") for (int n = 0; n < 2; ++n) _Pragma("unroll") for (int k = 0; k < 2; ++k) accS[bj][n] = __builtin_amdgcn_mfma_f32_16x16x32_bf16(Bt[n][k], Sf[k], accS[bj][n], 0, 0, 0); __builtin_amdgcn_s_setprio(0); } } while (0)
#define PG8_STAGE(bufoff, gbase, voff) do { _Pragma("unroll") for (int _i = 0; _i < 2; ++_i) \
        __builtin_amdgcn_global_load_lds((const unsigned*)((const char*)(gbase) + (voff)[_i]), (PG8_LAS unsigned*)(lds + (bufoff) + ldsw + _i * 8192), 16, 0, 0); } while (0)
#define PG8_LDA(dst, b, h) do { _Pragma("unroll") for (int m = 0; m < 4; ++m) _Pragma("unroll") for (int k = 0; k < 2; ++k) dst[m][k] = *(const PG8_LAS bf16x8*)(lds + PG8_SA(b, h) + aoff + m * 2048 + k * 1024); } while (0)
#define PG8_LDB(dst, b, h) do { _Pragma("unroll") for (int n = 0; n < 2; ++n) _Pragma("unroll") for (int k = 0; k < 2; ++k) dst[n][k] = *(const PG8_LAS bf16x8*)(lds + PG8_SB(b, h) + boff + n * 2048 + k * 1024); } while (0)
#define PG8_MMA(ai, bj, At, Bt) do { __builtin_amdgcn_s_setprio(1); _Pragma("unroll") for (int m = 0; m < 4; ++m) _Pragma("unroll") for (int n = 0; n < 2; ++n) _Pragma("unroll") for (int k = 0; k < 2; ++k) \
        acc[ai][bj][m][n] = __builtin_amdgcn_mfma_f32_16x16x32_bf16(Bt[n][k], At[m][k], acc[ai][bj][m][n], 0, 0, 0); __builtin_amdgcn_s_setprio(0); } while (0)
#define PG8_WAIT_V(n) asm volatile("s_waitcnt vmcnt(" #n ")" ::: "memory")
#define PG8_WAIT_L(n) asm volatile("s_waitcnt lgkmcnt(" #n ")" ::: "memory")
#define PG8_WAIT_VS(n, ns) do { if constexpr (STRIP) PG8_WAIT_V(ns); else PG8_WAIT_V(n); } while (0)
#define PG8_WAIT_LS(n, ns) do { if constexpr (STRIP) PG8_WAIT_L(ns); else PG8_WAIT_L(n); } while (0)
#define PG8_BAR __builtin_amdgcn_s_barrier()
#define PG8_SCHED __builtin_amdgcn_sched_barrier(0)
    Unit cur, nxt; int ui = 0;
    if (!S.next(0, cur)) return;
    f32x4 acc[2][2][4][2];
#pragma unroll
    for (int a = 0; a < 2; ++a)
#pragma unroll
        for (int b = 0; b < 2; ++b)
#pragma unroll
            for (int m = 0; m < 4; ++m)
#pragma unroll
                for (int n = 0; n < 2; ++n) acc[a][b][m][n] = (f32x4){0.f, 0.f, 0.f, 0.f};
    bf16x8 At[4][2], B0[2][2], B1[2][2];
    f32x4 accS[2][2]; bf16x8 Sf[2];
#pragma unroll
    for (int b = 0; b < 2; ++b)
#pragma unroll
        for (int n = 0; n < 2; ++n) accS[b][n] = (f32x4){0.f, 0.f, 0.f, 0.f};
#pragma unroll
    for (int k = 0; k < 2; ++k) Sf[k] = (bf16x8){0, 0, 0, 0, 0, 0, 0, 0};
    const char* cA = (const char*)g.A + (size_t)cur.pm * tstepA; const char* cB = (const char*)g.Bt + (size_t)cur.pn * tstep;
    S.a_ready(cur);
    PG8_STAGE(PG8_SB(0, 0), cB, voffB); PG8_STAGE(PG8_SA(0, 0), cA, voffA); PG8_STAGE(PG8_SB(0, 1), cB + hstep, voffB); PG8_STAGE(PG8_SA(0, 1), cA + hstep, voffA); PG8_STAGE_S(0, cA);
    if (wr == 1) PG8_BAR;
    PG8_WAIT_VS(4, 5); PG8_BAR;
    PG8_STAGE(PG8_SB(1, 0), cB + kstep, voffB); PG8_STAGE(PG8_SA(1, 0), cA + kstep, voffA); PG8_STAGE(PG8_SB(1, 1), cB + hstep + kstep, voffB); PG8_STAGE_S(1, cA + kstep);
    PG8_WAIT_VS(6, 7); PG8_BAR;
    PG8_STAMP();
    for (;;) {
        const bool has_next = S.next(ui + 1, nxt);
        const char* nA = has_next ? (const char*)g.A + (size_t)nxt.pm * tstepA : cA; const char* nB = has_next ? (const char*)g.Bt + (size_t)nxt.pn * tstep : cB;
        for (int t = 0; t < nt; t += 2) {
            const bool last = (t == nt - 2);
            const char* a1 = cA + (size_t)(t + 1) * kstep;
            const char* a2 = last ? nA : cA + (size_t)(t + 2) * kstep; const char* b2 = last ? nB : cB + (size_t)(t + 2) * kstep;
            const char* a3 = a2 + kstep; const char* b3 = b2 + kstep;
            if (last && has_next) S.a_ready(nxt);
            PG8_LDB(B0, 0, 0); PG8_SCHED; PG8_LDA(At, 0, 0); PG8_LDS(0); PG8_STAGE(PG8_SA(1, 1), a1 + hstep, voffA);
            PG8_WAIT_LS(8, 10); PG8_BAR; PG8_WAIT_L(0); PG8_MMA(0, 0, At, B0); PG8_MMS(0, B0); PG8_BAR; PG8_SCHED;
            PG8_LDB(B1, 0, 1); PG8_STAGE(PG8_SB(0, 0), b2, voffB);
            PG8_BAR; PG8_WAIT_L(0); PG8_MMA(0, 1, At, B1); PG8_MMS(1, B1); PG8_BAR;
            PG8_LDA(At, 0, 1); PG8_STAGE(PG8_SA(0, 0), a2, voffA); PG8_STAGE_S(0, a2);
            PG8_BAR; PG8_WAIT_L(0); PG8_MMA(1, 0, At, B0); PG8_BAR; PG8_SCHED;
            PG8_STAGE(PG8_SB(0, 1), b2 + hstep, voffB);
            PG8_WAIT_VS(6, 7); PG8_BAR; PG8_MMA(1, 1, At, B1); PG8_BAR;
            PG8_LDB(B0, 1, 0); PG8_SCHED; PG8_LDA(At, 1, 0); PG8_LDS(1); PG8_STAGE(PG8_SA(0, 1), a2 + hstep, voffA);
            PG8_WAIT_LS(8, 10); PG8_BAR; PG8_WAIT_L(0); PG8_MMA(0, 0, At, B0); PG8_MMS(0, B0); PG8_BAR; PG8_SCHED;
            PG8_LDB(B1, 1, 1); PG8_STAGE(PG8_SB(1, 0), b3, voffB);
            PG8_BAR; PG8_WAIT_L(0); PG8_MMA(0, 1, At, B1); PG8_MMS(1, B1); PG8_BAR;
            PG8_LDA(At, 1, 1); PG8_STAGE(PG8_SA(1, 0), a3, voffA); PG8_STAGE_S(1, a3);
            PG8_BAR; PG8_WAIT_L(0); PG8_MMA(1, 0, At, B0); PG8_BAR; PG8_SCHED;
            PG8_STAGE(PG8_SB(1, 1), b3 + hstep, voffB);
            PG8_WAIT_VS(6, 7); PG8_BAR; PG8_MMA(1, 1, At, B1); PG8_BAR;
        }
        PG8_STAMP();
        { const int rt0 = cur.pm * (STRIP ? 288 : 256), rw0 = rt0 + wr * 64 + fr;
#define PG8_RV(ai, m) {{acc[ai][0][m][0], acc[ai][0][m][1]}, {acc[ai][1][m][0], acc[ai][1][m][1]}}
#define PG8_BATCH(r0_, v0_, r1_, v1_) do { const typename Epi::Pre p0_ = E.pre(r0_, cur.pn, wc, fq), p1_ = E.pre(r1_, cur.pn, wc, fq); \
              { const f32x4 v_[2][2] = v0_; E.row(v_, p0_, r0_, cur.pn, wc, fq); } { const f32x4 v_[2][2] = v1_; E.row(v_, p1_, r1_, cur.pn, wc, fq); } } while (0)
          if constexpr (Epi::PRE_ALL) {
              typename Epi::Pre pa_[9];
#pragma unroll
              for (int q_ = 0; q_ < 8; ++q_) pa_[q_] = E.pre(rw0 + (q_ >> 2) * HALF + (q_ & 3) * 16, cur.pn, wc, fq);
              pa_[8] = STRIP ? E.pre(rt0 + 256 + wr * 16 + fr, cur.pn, wc, fq) : pa_[0];
#define PG8_ONE(q_, ai, m) { const f32x4 v_[2][2] = PG8_RV(ai, m); E.row(v_, pa_[q_], rw0 + ai * HALF + m * 16, cur.pn, wc, fq); }
              PG8_ONE(0, 0, 0) PG8_ONE(1, 0, 1) PG8_ONE(2, 0, 2) PG8_ONE(3, 0, 3) PG8_ONE(4, 1, 0) PG8_ONE(5, 1, 1) PG8_ONE(6, 1, 2) PG8_ONE(7, 1, 3)
#undef PG8_ONE
              if constexpr (STRIP) E.row(accS, pa_[8], rt0 + 256 + wr * 16 + fr, cur.pn, wc, fq);
#if defined(PROBE_EPI2)
              asm volatile("" ::: "memory");
#pragma unroll
              for (int q_ = 0; q_ < 8; ++q_) pa_[q_] = E.pre(rw0 + (q_ >> 2) * HALF + (q_ & 3) * 16, cur.pn, wc, fq);
              pa_[8] = STRIP ? E.pre(rt0 + 256 + wr * 16 + fr, cur.pn, wc, fq) : pa_[0];
#define PG8_ONE(q_, ai, m) { const f32x4 v_[2][2] = PG8_RV(ai, m); E.row(v_, pa_[q_], rw0 + ai * HALF + m * 16, cur.pn, wc, fq); }
              PG8_ONE(0, 0, 0) PG8_ONE(1, 0, 1) PG8_ONE(2, 0, 2) PG8_ONE(3, 0, 3) PG8_ONE(4, 1, 0) PG8_ONE(5, 1, 1) PG8_ONE(6, 1, 2) PG8_ONE(7, 1, 3)
#undef PG8_ONE
              if constexpr (STRIP) E.row(accS, pa_[8], rt0 + 256 + wr * 16 + fr, cur.pn, wc, fq);
#endif
          } else {
          PG8_BATCH(rw0, PG8_RV(0, 0), rw0 + 16, PG8_RV(0, 1));
          PG8_BATCH(rw0 + 32, PG8_RV(0, 2), rw0 + 48, PG8_RV(0, 3));
          PG8_BATCH(rw0 + HALF, PG8_RV(1, 0), rw0 + HALF + 16, PG8_RV(1, 1));
          PG8_BATCH(rw0 + HALF + 32, PG8_RV(1, 2), rw0 + HALF + 48, PG8_RV(1, 3));
          if constexpr (STRIP) { const int rs_ = rt0 + 256 + wr * 16 + fr; const typename Epi::Pre ps_ = E.pre(rs_, cur.pn, wc, fq); E.row(accS, ps_, rs_, cur.pn, wc, fq); }
          }
          if constexpr (STRIP) {
#pragma unroll
              for (int b = 0; b < 2; ++b)
#pragma unroll
                for (int n = 0; n < 2; ++n) accS[b][n] = (f32x4){0.f, 0.f, 0.f, 0.f}; }
#undef PG8_BATCH
#undef PG8_RV
          S.done(cur); }
        PG8_STAMP();
        if (!has_next) break;
#pragma unroll
        for (int a = 0; a < 2; ++a)
#pragma unroll
            for (int b = 0; b < 2; ++b)
#pragma unroll
                for (int m = 0; m < 4; ++m)
#pragma unroll
                    for (int n = 0; n < 2; ++n) acc[a][b][m][n] = (f32x4){0.f, 0.f, 0.f, 0.f};
        cur = nxt; cA = nA; cB = nB; ++ui;
    }
    PG8_WAIT_V(0);
    if (wr == 0) PG8_BAR;
    PG8_BAR;
    PG8_STAMP();
    if (STAMP && wid == 0) { stamps[lane] = lane < nts ? (((unsigned long long)(unsigned)ts_hi << 32) | (unsigned)ts_lo) : 0ull;
        if (lane == 62) stamps[62] = rt_entry; if (lane == 63) stamps[63] = (unsigned long long)wall_clock64(); }
#undef PG8_STAMP
#undef PG8_SA
#undef PG8_SB
#undef PG8_STAGE
#undef PG8_LDA
#undef PG8_LDB
#undef PG8_MMA
#undef PG8_WAIT_V
#undef PG8_WAIT_L
#undef PG8_BAR
#undef PG8_SCHED
#undef PG8_WAIT_LS
#undef PG8_WAIT_VS
#undef PG8_MMS
#undef PG8_LDS
#undef PG8_STAGE_S
#undef PG8_SS
}
}


#define LAS __attribute__((address_space(3)))
#define XB_TMO      128
#define XB_XCNT(j)  (256  + 64 * (j))
#define XB_XSUB(j)  (1280 + 64 * (j))
#define XB_XGEN(j)  (2304 + 64 * (j))
#define XB_TOP      3328
#define XB_TOPGEN   3392
#define XCD_BAR_WORDS 3456
#define XB_SPIN_CAP (1u << 18)

__device__ __forceinline__ unsigned xb_ld(unsigned* p)              { return __hip_atomic_load(p, __ATOMIC_RELAXED, __HIP_MEMORY_SCOPE_AGENT); }
__device__ __forceinline__ unsigned xb_add(unsigned* p, unsigned v) { return __hip_atomic_fetch_add(p, v, __ATOMIC_RELAXED, __HIP_MEMORY_SCOPE_AGENT); }
__device__ __forceinline__ unsigned xb_xcc_id() { return (unsigned)__builtin_amdgcn_s_getreg((3 << 11) | 20) & 0xFu; }
#define XB_SPIN(cond, bar) do { unsigned _sp = 0; while (cond) { __builtin_amdgcn_s_sleep(1); \
    if ((++_sp & 255u) == 0u) { if (xb_ld(&(bar)[XB_TMO])) break; if (_sp > XB_SPIN_CAP) { atomicAdd(&(bar)[XB_TMO], 1u); break; } } } } while (0)

struct XcdBarrier {
    unsigned* bar; unsigned x;
    volatile LAS unsigned* st;
};

__device__ __forceinline__ XcdBarrier xcd_barrier_post(unsigned* bar, volatile LAS unsigned* st) {
    XcdBarrier b; b.bar = bar; b.x = xb_xcc_id(); b.st = st;
    if (threadIdx.x == 0) (void)xb_add(&bar[XB_XCNT(b.x)], 1u);
    return b;
}
__device__ __forceinline__ void xcd_barrier_complete(unsigned* bar, unsigned x, unsigned& nloc, unsigned& nx) {
    const unsigned G = gridDim.x * gridDim.y * gridDim.z;
    unsigned sum, cnt, mine, sp = 0u;
    for (;;) {
        sum = 0u; cnt = 0u; mine = 0u;
#pragma unroll
        for (unsigned j = 0; j < 16; ++j) { const unsigned c = xb_ld(&bar[XB_XCNT(j)]); sum += c; cnt += (c > 0u) ? 1u : 0u; mine = (j == x) ? c : mine; }
        if (sum == G) break;
        __builtin_amdgcn_s_sleep(1);
        if ((++sp & 255u) == 0u) { if (xb_ld(&bar[XB_TMO])) break; if (sp > XB_SPIN_CAP) { atomicAdd(&bar[XB_TMO], 1u); break; } }
    }
    nloc = mine > 0u ? mine : 1u; nx = cnt > 0u ? cnt : 1u;
}

__device__ __forceinline__ void xcd_barrier(const XcdBarrier& b) {
    asm volatile("s_waitcnt vmcnt(0)" ::: "memory");
    __syncthreads();
    if (threadIdx.x == 0) {
        unsigned* bar = b.bar;
        __builtin_amdgcn_s_waitcnt(0);
        unsigned nloc = b.st[0], nx = b.st[1];
        if (nloc == 0u) { xcd_barrier_complete(bar, b.x, nloc, nx); b.st[0] = nloc; b.st[1] = nx; }
        const unsigned old = xb_add(&bar[XB_XSUB(b.x)], 1u);
        const unsigned gen = old / nloc;
        if (old + 1u == (gen + 1u) * nloc) {
            __builtin_amdgcn_fence(__ATOMIC_RELEASE, "agent");
            asm volatile("s_waitcnt vmcnt(0)" ::: "memory");
            const unsigned og = xb_add(&bar[XB_TOP], 1u);
            const unsigned tg = og / nx;
            if (og + 1u == (tg + 1u) * nx) xb_add(&bar[XB_TOPGEN], 1u);
            else XB_SPIN(xb_ld(&bar[XB_TOPGEN]) == tg, bar);
            __builtin_amdgcn_fence(__ATOMIC_ACQUIRE, "agent");
            xb_add(&bar[XB_XGEN(b.x)], 1u);
            asm volatile("s_waitcnt vmcnt(0)" ::: "memory");
        } else {
            XB_SPIN(xb_ld(&bar[XB_XGEN(b.x)]) == gen, bar);
            __builtin_amdgcn_fence(__ATOMIC_ACQUIRE, "agent");
            asm volatile("s_waitcnt vmcnt(0)" ::: "memory");
        }
    }
    __syncthreads();
}

typedef CfgT<RC> C;
constexpr int NTHREADS = 512, NWAVES = 8;
constexpr int LDS_STAGE = 131072 + 16384 + 8192, LDS_CTL = LDS_STAGE, LDS_BYTES = LDS_STAGE + 256;

namespace pg8 {
typedef unsigned u32x2 __attribute__((ext_vector_type(2)));
__device__ __forceinline__ float silu_f(float g) { return g * __builtin_amdgcn_rcpf(1.0f + __expf(-g)); }
struct EpiSwiGLU { static constexpr bool PERM = true, PRE_ALL = true;
    bf16_t* act; const float* ss; int ff; float invd;
    typedef float Pre;
    __device__ __forceinline__ Pre pre(int row, int pn, int wc, int fq) const { return ss[row]; }
    __device__ __forceinline__ void row(const f32x4 (&v)[2][2], Pre ssr, int row, int pn, int wc, int fq) const {
        const float rs = rsqrtf(ssr * invd + 1e-6f), nc = rs * -1.4426950408889634f, rs2 = rs * rs; f32x4 o[2];
#pragma unroll
        for (int n = 0; n < 2; ++n) { const f32x4 t = v[0][n] * nc, w = v[0][n] * v[1][n]; f32x4 e, r;
#pragma unroll
            for (int j = 0; j < 4; ++j) e[j] = __builtin_amdgcn_exp2f(t[j]);
            const f32x4 dd = e + 1.0f;
#pragma unroll
            for (int j = 0; j < 4; ++j) r[j] = __builtin_amdgcn_rcpf(dd[j]);
            o[n] = w * (r * rs2); }
        u32x4 w; w.x = cvt_pk_bf16(o[0][0], o[0][1]); w.y = cvt_pk_bf16(o[0][2], o[0][3]); w.z = cvt_pk_bf16(o[1][0], o[1][1]); w.w = cvt_pk_bf16(o[1][2], o[1][3]);
        *(u32x4*)(act + (size_t)row * ff + pn * 128 + wc * 32 + 8 * fq) = w;
    }
};
struct EpiResid { static constexpr bool PERM = false, PRE_ALL = false;
    float* X; bf16_t* XB; float* ssout; float scale; int ld;
    struct Pre { f32x4 x[2][2]; };
    __device__ __forceinline__ Pre pre(int row, int pn, int wc, int fq) const { Pre q; const float* xr = X + (size_t)row * ld + pn * BM + wc * 32 + 4 * fq;
#pragma unroll
        for (int bj = 0; bj < 2; ++bj)
#pragma unroll
            for (int n = 0; n < 2; ++n) q.x[bj][n] = *(const f32x4*)(xr + bj * HALF + n * 16);
        return q; }
    __device__ __forceinline__ void row(const f32x4 (&v)[2][2], const Pre& q, int row, int pn, int wc, int fq) const {
        const int col0 = pn * BM + wc * 32 + 4 * fq; float* xr = X + (size_t)row * ld + col0; bf16_t* br = XB + (size_t)row * ld + col0; float s = 0.f;
#pragma unroll
        for (int bj = 0; bj < 2; ++bj)
#pragma unroll
            for (int n = 0; n < 2; ++n) { const f32x4 x = q.x[bj][n] + v[bj][n] * scale; *(f32x4*)(xr + bj * HALF + n * 16) = x;
                u32x2 w; w.x = cvt_pk_bf16(x[0], x[1]); w.y = cvt_pk_bf16(x[2], x[3]); *(u32x2*)(br + bj * HALF + n * 16) = w;
                s += (x[0] * x[0] + x[1] * x[1]) + (x[2] * x[2] + x[3] * x[3]); }
        s += __shfl_xor(s, 16); s += __shfl_xor(s, 32);
        if (fq == 0) unsafeAtomicAdd(ssout + row, s);
    }
};
struct EpiScaleF32 { static constexpr bool PERM = false, PRE_ALL = true;
    float* Cp; int ldc; const float* ss; float invd;
    typedef float Pre;
    __device__ __forceinline__ Pre pre(int row, int pn, int wc, int fq) const { return ss[row]; }
    __device__ __forceinline__ void row(const f32x4 (&v)[2][2], Pre ssr, int row, int pn, int wc, int fq) const {
        const float rs = rsqrtf(ssr * invd + 1e-6f); float* cr = Cp + (size_t)row * ldc + pn * BM + wc * 32 + 4 * fq;
#pragma unroll
        for (int bj = 0; bj < 2; ++bj)
#pragma unroll
            for (int n = 0; n < 2; ++n) *(f32x4*)(cr + bj * HALF + n * 16) = v[bj][n] * rs;
    }
};
struct EpiScaleBf16 { static constexpr bool PERM = true, PRE_ALL = true;
    bf16_t* O; int ldc; const float* ss; float invd;
    typedef float Pre;
    __device__ __forceinline__ Pre pre(int row, int pn, int wc, int fq) const { return ss[row]; }
    __device__ __forceinline__ void row(const f32x4 (&v)[2][2], Pre ssr, int row, int pn, int wc, int fq) const {
        const float rs = rsqrtf(ssr * invd + 1e-6f); bf16_t* orow = O + (size_t)row * ldc + pn * BM + wc * 32 + 8 * fq;
#pragma unroll
        for (int bj = 0; bj < 2; ++bj) { const f32x4 v0 = v[bj][0] * rs, v1 = v[bj][1] * rs;
            u32x4 w; w.x = cvt_pk_bf16(v0[0], v0[1]); w.y = cvt_pk_bf16(v0[2], v0[3]); w.z = cvt_pk_bf16(v1[0], v1[1]); w.w = cvt_pk_bf16(v1[2], v1[3]);
            *(u32x4*)(orow + bj * HALF) = w; }
    }
};
struct EpiMemKV { static constexpr bool PERM = false, PRE_ALL = true;
    float* K; float* V; const float* rstd; int d; bf16_t* KVB; int mm;
    typedef float Pre;
    __device__ __forceinline__ Pre pre(int row, int pn, int wc, int fq) const { return rstd[row]; }
    __device__ __forceinline__ void row(const f32x4 (&v)[2][2], Pre rs, int row, int pn, int wc, int fq) const {
        int ct = pn * BM; float* base = K; bf16_t* bb = KVB; if (ct >= d) { base = V; ct -= d; bb += (size_t)mm * d; }
        float* cr = base + (size_t)row * d + ct + wc * 32 + 4 * fq; bb += (size_t)row * d + ct + wc * 32 + 4 * fq;
#pragma unroll
        for (int bj = 0; bj < 2; ++bj)
#pragma unroll
            for (int n = 0; n < 2; ++n) { const f32x4 o = v[bj][n] * rs; *(f32x4*)(cr + bj * HALF + n * 16) = o;
                u32x2 w; w.x = cvt_pk_bf16(o[0], o[1]); w.y = cvt_pk_bf16(o[2], o[3]); *(u32x2*)(bb + bj * HALF + n * 16) = w; }
    }
};
}

__device__ __forceinline__ void prep_item(const float* W, int K, int Ncols, const float* g, int kind, int N, bf16_t* Bt, LAS unsigned char* scr, int item, int lane) {
    const int nblk = N / 64, kb = item / nblk, nb = item % nblk, k0 = 64 * kb, n = 64 * nb + lane;
    const int sc = wsrc_col<C>(kind, n);
    const float* src = W + (size_t)k0 * Ncols + (sc >= 0 ? sc : 0);
    float v[64];
#pragma unroll
    for (int kk = 0; kk < 64; ++kk) v[kk] = src[(size_t)kk * Ncols];
    if (g) {
#pragma unroll
        for (int kk = 0; kk < 64; ++kk) v[kk] *= g[k0 + kk];
    }
    if (sc < 0) {
#pragma unroll
        for (int kk = 0; kk < 64; ++kk) v[kk] = 0.f;
    }
#pragma unroll
    for (int j = 0; j < 8; ++j) { pg8::u32x4 o; o.x = pg8::cvt_pk_bf16(v[8 * j], v[8 * j + 1]); o.y = pg8::cvt_pk_bf16(v[8 * j + 2], v[8 * j + 3]); o.z = pg8::cvt_pk_bf16(v[8 * j + 4], v[8 * j + 5]); o.w = pg8::cvt_pk_bf16(v[8 * j + 6], v[8 * j + 7]);
        *(LAS pg8::u32x4*)(scr + lane * 144 + j * 16) = o; }
    asm volatile("s_waitcnt lgkmcnt(0)" ::: "memory");
    bf16_t* dst = Bt + (size_t)(64 * nb) * K + k0 + (lane & 7) * 8;
#pragma unroll
    for (int it = 0; it < 8; ++it) { const int row = it * 8 + (lane >> 3); const pg8::u32x4 o = *(const LAS pg8::u32x4*)(scr + row * 144 + (lane & 7) * 16);
        *(pg8::u32x4*)(dst + (size_t)row * K) = o; }
    asm volatile("s_waitcnt lgkmcnt(0)" ::: "memory");
}
struct WDesc { const float* W; const float* g; bf16_t* dst; int K, Ncols, kind, N; };
__device__ __forceinline__ WDesc wdesc(const Ptrs& p, int l, int idx) {
    WDesc d; d.g = nullptr; d.kind = WK_PLAIN;
    switch (idx) {
    case 0: d.W = p.in[I_W1IN] + (size_t)l * C::D * 2 * C::FF; d.K = C::D; d.Ncols = 2 * C::FF; d.N = 2 * C::FF; d.g = p.in[I_GFFN1] + l * C::D; d.kind = WK_FFNIN; d.dst = wlayer<C>(p, l, C::W_1IN); break;
    case 1: d.W = p.in[I_W1OUT] + (size_t)l * C::FF * C::D; d.K = C::FF; d.Ncols = C::D; d.N = C::D; d.dst = wlayer<C>(p, l, C::W_1OUT); break;
    case 2: d.W = p.in[I_WIN] + (size_t)l * C::D * C::INC; d.K = C::D; d.Ncols = C::INC; d.N = C::LDP; d.g = p.in[I_GMIX] + l * C::D; d.kind = WK_WIN; d.dst = wlayer<C>(p, l, C::W_IN); break;
    case 3: d.W = p.in[I_WOUT] + (size_t)l * C::D * C::D; d.K = C::D; d.Ncols = C::D; d.N = C::D; d.dst = wlayer<C>(p, l, C::W_OUT); break;
    case 4: d.W = p.in[I_WQ] + (size_t)l * C::D * C::D; d.K = C::D; d.Ncols = C::D; d.N = C::D; d.g = p.in[I_GX] + l * C::D; d.dst = wlayer<C>(p, l, C::W_Q); break;
    case 5: d.W = p.in[I_WK] + (size_t)l * C::D * C::D; d.K = C::D; d.Ncols = C::D; d.N = C::D; d.g = p.in[I_GMEM] + l * C::D; d.dst = wlayer<C>(p, l, C::W_KV); break;
    case 6: d.W = p.in[I_WV] + (size_t)l * C::D * C::D; d.K = C::D; d.Ncols = C::D; d.N = C::D; d.g = p.in[I_GMEM] + l * C::D; d.dst = wlayer<C>(p, l, C::W_KV) + (size_t)C::D * C::D; break;
    case 7: d.W = p.in[I_WO] + (size_t)l * C::D * C::D; d.K = C::D; d.Ncols = C::D; d.N = C::D; d.dst = wlayer<C>(p, l, C::W_O); break;
    case 8: d.W = p.in[I_W2IN] + (size_t)l * C::D * 2 * C::FF; d.K = C::D; d.Ncols = 2 * C::FF; d.N = 2 * C::FF; d.g = p.in[I_GFFN2] + l * C::D; d.kind = WK_FFNIN; d.dst = wlayer<C>(p, l, C::W_2IN); break;
    default: d.W = p.in[I_W2OUT] + (size_t)l * C::FF * C::D; d.K = C::FF; d.Ncols = C::D; d.N = C::D; d.dst = wlayer<C>(p, l, C::W_2OUT); break;
    }
    return d;
}

#define WG_SYNC() do { asm volatile("s_waitcnt lgkmcnt(0)" ::: "memory"); __builtin_amdgcn_s_barrier(); asm volatile("" ::: "memory"); } while (0)
namespace att {
typedef short bf16x8 __attribute__((ext_vector_type(8)));
typedef short s16x4 __attribute__((ext_vector_type(4)));
typedef float f32x4 __attribute__((ext_vector_type(4)));
typedef unsigned u32x2 __attribute__((ext_vector_type(2)));
constexpr int TOK = 256, CD = 64, PITCH = 144, CBYTES = TOK * PITCH, HDIM = 512, NH = 4, LD = 2048;
static_assert(C::NMEM == TOK && C::AHD == HDIM && C::AH == NH && C::D == LD && C::DEC_SEQ == 32 && C::SEQ % 256 == 0, "attention phase is built for these shapes");
__device__ __forceinline__ s16x4 tr_read(unsigned addr) { s16x4 r; asm volatile("ds_read_b64_tr_b16 %0, %1" : "=&v"(r) : "v"(addr) : "memory"); return r; }
__device__ __forceinline__ void stage_load(f32x4 (&r)[8], const float* src, int tid) {
    const unsigned off0 = (unsigned)(((tid >> 4) * LD + (tid & 15) * 4) * 4);
#pragma unroll
    for (int i = 0; i < 8; ++i) { const float* si = src + (size_t)i * 32 * LD; asm volatile("" : "+s"(si));
        r[i] = *(const f32x4*)((const char*)si + off0); }
    __builtin_amdgcn_sched_barrier(0);
}
__device__ __forceinline__ void stage_load_b(pg8::u32x4 (&r)[4], const bf16_t* src, int tid) {
    const unsigned off0 = (unsigned)(((tid >> 3) * LD + (tid & 7) * 8) * 2);
#pragma unroll
    for (int i = 0; i < 4; ++i) { const bf16_t* si = src + (size_t)i * 64 * LD; asm volatile("" : "+s"(si)); r[i] = *(const pg8::u32x4*)((const char*)si + off0); }
    __builtin_amdgcn_sched_barrier(0);
}
__device__ __forceinline__ int klds(int r, int c) { const int ob = (r & 15) * 64 + (c & 31) * 2; return ((r >> 4) * 2 + (c >> 5)) * 1024 + (ob ^ (((ob >> 9) & 1) << 5)); }
__device__ __forceinline__ void stage_store_k(const f32x4 (&r)[8], LAS unsigned char* buf, int tid) {
#pragma unroll
    for (int i = 0; i < 8; ++i) { const int f = tid + 512 * i; u32x2 w; w.x = pg8::cvt_pk_bf16(r[i][0], r[i][1]); w.y = pg8::cvt_pk_bf16(r[i][2], r[i][3]);
        *(LAS u32x2*)(buf + klds(f >> 4, (f & 15) * 4)) = w; }
}
__device__ __forceinline__ void stage_store_kb(const pg8::u32x4 (&r)[4], LAS unsigned char* buf, int tid) {
    asm volatile("" : "+v"(tid));
#pragma unroll
    for (int i = 0; i < 4; ++i) *(LAS pg8::u32x4*)(buf + klds((tid >> 3) + 64 * i, (tid & 7) * 8)) = r[i];
}
__device__ __forceinline__ void stage_store_vb(const pg8::u32x4 (&r)[4], LAS unsigned char* buf, int tid) {
    asm volatile("" : "+v"(tid));
#pragma unroll
    for (int i = 0; i < 4; ++i) *(LAS pg8::u32x4*)(buf + ((tid >> 3) + 64 * i) * PITCH + (tid & 7) * 16) = r[i];
}
__device__ __forceinline__ void stage_store(const f32x4 (&r)[8], LAS unsigned char* buf, int tid) {
#pragma unroll
    for (int i = 0; i < 8; ++i) { const int f = tid + 512 * i; u32x2 w; w.x = pg8::cvt_pk_bf16(r[i][0], r[i][1]); w.y = pg8::cvt_pk_bf16(r[i][2], r[i][3]);
        *(LAS u32x2*)(buf + (f >> 4) * PITCH + (f & 15) * 8) = w; }
}
__device__ __forceinline__ void attn_sample_unit(LAS unsigned char* lds, const bf16_t* Qg, bf16_t* AO, const float* kb, const float* vb, int row0, int head, int tid) {
    const int lane = tid & 63, wave = __builtin_amdgcn_readfirstlane(tid >> 6), li = lane & 15, g = lane >> 4;
    constexpr int PP = 528;
    LAS unsigned char* Ps = lds + 2 * CBYTES;
    LAS float* smax = (LAS float*)(Ps + 32 * PP); LAS float* ssum = smax + 8 * 32;
    const bf16_t* q0 = Qg + (size_t)(row0 + li) * LD + head * HDIM + g * 8;
    f32x4 s[2][2];
#pragma unroll
    for (int u = 0; u < 2; ++u)
#pragma unroll
        for (int tt = 0; tt < 2; ++tt) s[u][tt] = (f32x4){0.f, 0.f, 0.f, 0.f};
    f32x4 r0[8], r1[8]; bf16x8 qf[2][2];
    stage_load(r0, kb, tid); stage_load(r1, kb + CD, tid);
#pragma unroll
    for (int u = 0; u < 2; ++u)
#pragma unroll
        for (int ks = 0; ks < 2; ++ks) qf[u][ks] = *(const bf16x8*)(q0 + (size_t)u * 16 * LD + ks * 32);
    stage_store(r0, lds, tid);
    WG_SYNC();
    stage_load(r0, kb + 2 * CD, tid);
#define ATS_SRC(cc) ((cc) < 8 ? kb + (cc) * CD : vb + ((cc) - 8) * CD)
#define ATS_SCORE(cc, REGN, REGF) do { LAS unsigned char* buf = lds + ((cc) & 1) * CBYTES; \
        _Pragma("unroll") for (int ks = 0; ks < 2; ++ks) _Pragma("unroll") for (int tt = 0; tt < 2; ++tt) { const bf16x8 a = *(const LAS bf16x8*)(buf + ((2 * wave + tt) * 16 + li) * PITCH + ks * 64 + g * 16); \
            s[0][tt] = __builtin_amdgcn_mfma_f32_16x16x32_bf16(a, qf[0][ks], s[0][tt], 0, 0, 0); s[1][tt] = __builtin_amdgcn_mfma_f32_16x16x32_bf16(a, qf[1][ks], s[1][tt], 0, 0, 0); } \
        if ((cc) < 7) { __builtin_amdgcn_sched_barrier(0); _Pragma("unroll") for (int u = 0; u < 2; ++u) _Pragma("unroll") for (int ks = 0; ks < 2; ++ks) qf[u][ks] = *(const bf16x8*)(q0 + (size_t)u * 16 * LD + ((cc) + 1) * CD + ks * 32); __builtin_amdgcn_sched_barrier(0); } \
        stage_store(REGN, lds + (((cc) + 1) & 1) * CBYTES, tid); WG_SYNC(); stage_load(REGF, ATS_SRC((cc) + 3), tid); } while (0)
    ATS_SCORE(0, r1, r1); ATS_SCORE(1, r0, r0); ATS_SCORE(2, r1, r1); ATS_SCORE(3, r0, r0); ATS_SCORE(4, r1, r1); ATS_SCORE(5, r0, r0); ATS_SCORE(6, r1, r1); ATS_SCORE(7, r0, r0);
    const float sc = 0.044194173824159216f * 1.4426950408889634f;
#pragma unroll
    for (int u = 0; u < 2; ++u) { float mx = fmaxf(fmaxf(fmaxf(s[u][0][0], s[u][0][1]), fmaxf(s[u][0][2], s[u][0][3])), fmaxf(fmaxf(s[u][1][0], s[u][1][1]), fmaxf(s[u][1][2], s[u][1][3])));
        mx = fmaxf(mx, __shfl_xor(mx, 16)); mx = fmaxf(mx, __shfl_xor(mx, 32));
        if (g == 0) smax[wave * 32 + u * 16 + li] = mx; }
    WG_SYNC();
#pragma unroll
    for (int u = 0; u < 2; ++u) { float mx = smax[u * 16 + li];
#pragma unroll
        for (int w = 1; w < 8; ++w) mx = fmaxf(mx, smax[w * 32 + u * 16 + li]);
        float sum = 0.f;
#pragma unroll
        for (int tt = 0; tt < 2; ++tt) {
#pragma unroll
            for (int j = 0; j < 4; ++j) { const float e = __builtin_amdgcn_exp2f((s[u][tt][j] - mx) * sc); s[u][tt][j] = e; sum += e; }
            u32x2 w2; w2.x = pg8::cvt_pk_bf16(s[u][tt][0], s[u][tt][1]); w2.y = pg8::cvt_pk_bf16(s[u][tt][2], s[u][tt][3]);
            *(LAS u32x2*)(Ps + (u * 16 + li) * PP + (32 * wave + 16 * tt + 4 * g) * 2) = w2; }
        sum += __shfl_xor(sum, 16); sum += __shfl_xor(sum, 32);
        if (g == 0) ssum[wave * 32 + u * 16 + li] = sum; }
    WG_SYNC();
    const int dt = wave & 3, uq = wave >> 2;
    float inv;
    { float sum = 0.f;
#pragma unroll
      for (int w = 0; w < 8; ++w) sum += ssum[w * 32 + uq * 16 + li];
      inv = 1.0f / sum; }
    bf16x8 pfr[8];
#pragma unroll
    for (int t = 0; t < 8; ++t) pfr[t] = *(const LAS bf16x8*)(Ps + (uq * 16 + li) * PP + (32 * t + 8 * g) * 2);
    const unsigned trb8 = (unsigned)(size_t)lds + (unsigned)((8 * g + (li >> 2)) * PITCH + (li & 3) * 8 + dt * 32);
#define ATS_PV(cc, REGN, REGF) do { const unsigned bofs = (unsigned)((cc) & 1) * CBYTES; f32x4 o = (f32x4){0.f, 0.f, 0.f, 0.f}; s16x4 lo[8], hi[8]; \
        _Pragma("unroll") for (int t = 0; t < 8; ++t) { lo[t] = tr_read(trb8 + bofs + (unsigned)(t * 32 * PITCH)); hi[t] = tr_read(trb8 + bofs + (unsigned)(t * 32 * PITCH + 4 * PITCH)); } \
        asm volatile("s_waitcnt lgkmcnt(0)" ::: "memory"); __builtin_amdgcn_sched_barrier(0); \
        _Pragma("unroll") for (int t = 0; t < 8; ++t) { const bf16x8 a = (bf16x8){lo[t][0], lo[t][1], lo[t][2], lo[t][3], hi[t][0], hi[t][1], hi[t][2], hi[t][3]}; o = __builtin_amdgcn_mfma_f32_16x16x32_bf16(a, pfr[t], o, 0, 0, 0); } \
        { u32x2 w2; w2.x = pg8::cvt_pk_bf16(o[0] * inv, o[1] * inv); w2.y = pg8::cvt_pk_bf16(o[2] * inv, o[3] * inv); \
          *(u32x2*)(AO + (size_t)(row0 + 16 * uq + li) * LD + head * HDIM + ((cc) - 8) * CD + dt * 16 + g * 4) = w2; } \
        if ((cc) < 15) stage_store(REGN, lds + (((cc) + 1) & 1) * CBYTES, tid); WG_SYNC(); if ((cc) + 3 < 16) stage_load(REGF, ATS_SRC((cc) + 3), tid); } while (0)
    ATS_PV(8, r1, r1); ATS_PV(9, r0, r0); ATS_PV(10, r1, r1); ATS_PV(11, r0, r0); ATS_PV(12, r1, r1); ATS_PV(13, r0, r0); ATS_PV(14, r1, r1); ATS_PV(15, r0, r0);
#undef ATS_SRC
#undef ATS_SCORE
#undef ATS_PV
}
__device__ __forceinline__ void attn_sample_phase(LAS unsigned char* lds, const Ptrs& p, int l, int tid, int first, int stride) {
    const bf16_t* Qg = wsb<C>(p, C::WS_Q); bf16_t* AO = wsb<C>(p, C::WS_AO);
    for (int s = first; s < C::DEC_BATCH * NH; s += stride) { const int b = s / NH, head = s % NH;
        attn_sample_unit(lds, Qg, AO, p.in[I_CK] + ((size_t)l * C::DEC_BATCH + b) * TOK * LD + head * HDIM, p.in[I_CV] + ((size_t)l * C::DEC_BATCH + b) * TOK * LD + head * HDIM, C::MP + b * C::DEC_SEQ, head, tid); }
}
__device__ __forceinline__ void attn_phase(LAS unsigned char* lds, const Ptrs& p, int l, int tid, int bid, int gsz, int nunits) {
    const int lane = tid & 63, wave = __builtin_amdgcn_readfirstlane(tid >> 6), li = lane & 15, g = lane >> 4;
    const bf16_t* Qg = wsb<C>(p, C::WS_Q); bf16_t* AO = wsb<C>(p, C::WS_AO);
    constexpr int NUP = (C::MP / 256) * NH;
    static_assert(C::SEQ % 256 == 0, "prompt units are 256 rows");
    for (int un0 = bid; un0 < nunits; un0 += gsz) {
        const int un = (NUP % 64 == 0) ? (un0 & ~63) + (un0 & 7) * 8 + ((un0 >> 3) & 7) : un0;
        const int per_b = (C::SEQ / 256) * NH, b = un / per_b, rem = un % per_b, head = rem / (C::SEQ / 256), row0 = b * C::SEQ + (rem % (C::SEQ / 256)) * 256;
        const bf16_t* kbb = wsb<C>(p, C::WS_KVB) + (size_t)b * TOK * LD + head * HDIM; const bf16_t* vbb = kbb + (size_t)C::MM * LD;
#define ATP_SRC(cc) ((cc) < 8 ? kbb + (cc) * CD : vbb + ((cc) - 8) * CD)
        const bf16_t* q0 = Qg + (size_t)(row0 + wave * 32 + li) * LD + head * HDIM + g * 8;
        f32x4 s[2][16];
#pragma unroll
        for (int u = 0; u < 2; ++u)
#pragma unroll
            for (int T = 0; T < 16; ++T) s[u][T] = (f32x4){0.f, 0.f, 0.f, 0.f};
        pg8::u32x4 w0[4], w1[4]; bf16x8 qf[2][2];
        stage_load_b(w0, ATP_SRC(0), tid); stage_load_b(w1, ATP_SRC(1), tid);
#pragma unroll
        for (int u = 0; u < 2; ++u)
#pragma unroll
            for (int ks = 0; ks < 2; ++ks) qf[u][ks] = *(const bf16x8*)(q0 + (size_t)u * 16 * LD + ks * 32);
        stage_store_kb(w0, lds, tid);
        WG_SYNC();
        stage_load_b(w0, ATP_SRC(2), tid);
        const int aoff = (li * 64 + g * 16) ^ ((li >> 3) << 5);
#define ATP_KS(ks) do { _Pragma("unroll") for (int T0 = 0; T0 < 16; T0 += 2) { bf16x8 af[2]; \
            _Pragma("unroll") for (int j = 0; j < 2; ++j) af[j] = *(const LAS bf16x8*)(buf + ((T0 + j) * 2 + (ks)) * 1024 + aoff); \
            asm volatile("s_waitcnt lgkmcnt(0)" ::: "memory"); __builtin_amdgcn_sched_barrier(0); \
            _Pragma("unroll") for (int j = 0; j < 2; ++j) { s[0][T0 + j] = __builtin_amdgcn_mfma_f32_16x16x32_bf16(af[j], qf[0][ks], s[0][T0 + j], 0, 0, 0); \
                s[1][T0 + j] = __builtin_amdgcn_mfma_f32_16x16x32_bf16(af[j], qf[1][ks], s[1][T0 + j], 0, 0, 0); } \
            __builtin_amdgcn_sched_barrier(0); } } while (0)
#define ATP_SITER(cc, WN) do { LAS unsigned char* buf = lds + ((cc) & 1) * CBYTES; \
            ATP_KS(0); ATP_KS(1); \
            if ((cc) < 7) { __builtin_amdgcn_sched_barrier(0); _Pragma("unroll") for (int u = 0; u < 2; ++u) _Pragma("unroll") for (int ks = 0; ks < 2; ++ks) qf[u][ks] = *(const bf16x8*)(q0 + (size_t)u * 16 * LD + ((cc) + 1) * CD + ks * 32); \
                __builtin_amdgcn_sched_barrier(0); stage_store_kb(WN, lds + (((cc) + 1) & 1) * CBYTES, tid); } \
            else stage_store_vb(WN, lds + (((cc) + 1) & 1) * CBYTES, tid); \
            WG_SYNC(); stage_load_b(WN, ATP_SRC((cc) + 3), tid); } while (0)
#pragma unroll 1
        for (int c2 = 0; c2 < 8; c2 += 2) { ATP_SITER(c2, w1); ATP_SITER(c2 + 1, w0); }
#undef ATP_SITER
#undef ATP_KS
        const float sc = 0.044194173824159216f * 1.4426950408889634f;
        float inv[2]; bf16x8 pf[2][8];
#pragma unroll
        for (int u = 0; u < 2; ++u) {
            float mx = -3.0e38f;
#pragma unroll
            for (int T = 0; T < 16; ++T) mx = fmaxf(mx, fmaxf(fmaxf(s[u][T][0], s[u][T][1]), fmaxf(s[u][T][2], s[u][T][3])));
            mx = fmaxf(mx, __shfl_xor(mx, 16)); mx = fmaxf(mx, __shfl_xor(mx, 32));
            float sum = 0.f;
#pragma unroll
            for (int T = 0; T < 16; ++T)
#pragma unroll
                for (int j = 0; j < 4; ++j) { const float e = __builtin_amdgcn_exp2f((s[u][T][j] - mx) * sc); s[u][T][j] = e; sum += e; }
            sum += __shfl_xor(sum, 16); sum += __shfl_xor(sum, 32);
            inv[u] = 1.0f / sum;
#pragma unroll
            for (int t = 0; t < 8; ++t) { pg8::u32x4 w; w.x = pg8::cvt_pk_bf16(s[u][2 * t][0], s[u][2 * t][1]); w.y = pg8::cvt_pk_bf16(s[u][2 * t][2], s[u][2 * t][3]);
                w.z = pg8::cvt_pk_bf16(s[u][2 * t + 1][0], s[u][2 * t + 1][1]); w.w = pg8::cvt_pk_bf16(s[u][2 * t + 1][2], s[u][2 * t + 1][3]); pf[u][t] = __builtin_bit_cast(bf16x8, w); }
        }
        const unsigned trb = (unsigned)(size_t)lds + (unsigned)((4 * g + (li >> 2)) * PITCH + (li & 3) * 8);
#define ATP_VITER(c, WN) do { unsigned bofs = (unsigned)((c) & 1) * CBYTES; asm volatile("" : "+v"(bofs));        \
            { f32x4 o[2][4]; \
              _Pragma("unroll") for (int u = 0; u < 2; ++u) _Pragma("unroll") for (int dt = 0; dt < 4; ++dt) o[u][dt] = (f32x4){0.f, 0.f, 0.f, 0.f}; \
              _Pragma("unroll") for (int t = 0; t < 8; ++t) { s16x4 lo[4], hi[4]; \
                _Pragma("unroll") for (int dt = 0; dt < 4; ++dt) { lo[dt] = tr_read(trb + bofs + (unsigned)(t * 32 * PITCH + dt * 32)); hi[dt] = tr_read(trb + bofs + (unsigned)(t * 32 * PITCH + 16 * PITCH + dt * 32)); } \
                asm volatile("s_waitcnt lgkmcnt(0)" ::: "memory"); __builtin_amdgcn_sched_barrier(0); \
                _Pragma("unroll") for (int dt = 0; dt < 4; ++dt) { const bf16x8 a = (bf16x8){lo[dt][0], lo[dt][1], lo[dt][2], lo[dt][3], hi[dt][0], hi[dt][1], hi[dt][2], hi[dt][3]}; \
                    o[0][dt] = __builtin_amdgcn_mfma_f32_16x16x32_bf16(a, pf[0][t], o[0][dt], 0, 0, 0); \
                    o[1][dt] = __builtin_amdgcn_mfma_f32_16x16x32_bf16(a, pf[1][t], o[1][dt], 0, 0, 0); } } \
              _Pragma("unroll") for (int u = 0; u < 2; ++u) _Pragma("unroll") for (int dt = 0; dt < 4; ++dt) { u32x2 w; w.x = pg8::cvt_pk_bf16(o[u][dt][0] * inv[u], o[u][dt][1] * inv[u]); w.y = pg8::cvt_pk_bf16(o[u][dt][2] * inv[u], o[u][dt][3] * inv[u]); \
                    *(u32x2*)(AO + (size_t)(row0 + wave * 32 + 16 * u + li) * LD + head * HDIM + (c) * CD + dt * 16 + g * 4) = w; } } \
            if ((c) < 7) stage_store_vb(WN, lds + (((c) + 1) & 1) * CBYTES, tid); \
            WG_SYNC(); if ((c) < 5) stage_load_b(WN, ATP_SRC((c) + 11), tid); } while (0)
#pragma unroll 1
        for (int c2 = 0; c2 < 8; c2 += 2) { ATP_VITER(c2, w1); ATP_VITER(c2 + 1, w0); }
#undef ATP_VITER
#undef ATP_SRC
    }
}
}
namespace mx {
typedef att::bf16x8 bf16x8; typedef att::s16x4 s16x4; typedef att::f32x4 f32x4; typedef att::u32x2 u32x2;
constexpr int PT = 272;
constexpr int T64 = 64 * PT, T128 = 128 * PT;
static_assert(C::MHD == 128 && C::CH == 64 && C::MH == 8 && C::LCS == 32, "mLSTM phases are built for these shapes");
__device__ __forceinline__ void lds_wait() { asm volatile("s_waitcnt lgkmcnt(0)" ::: "memory"); __builtin_amdgcn_sched_barrier(0); }
__device__ __forceinline__ bf16x8 mk8(s16x4 lo, s16x4 hi) { return (bf16x8){lo[0], lo[1], lo[2], lo[3], hi[0], hi[1], hi[2], hi[3]}; }
__device__ __forceinline__ unsigned tr_addr(unsigned tile, int krow, int c0, int li) { return tile + (unsigned)((krow + (li >> 2)) * PT + (c0 + 4 * (li & 3)) * 2); }
__device__ __forceinline__ void ch_decode(int ci, int& r0, int& h, int& lc) {
    if (ci < C::NPC) { const int c = ci % C::NC, bh = ci / C::NC; h = bh % C::MH; r0 = (bh / C::MH) * C::SEQ + c * C::CH; lc = C::CH; }
    else { const int q = ci - C::NPC; h = q % C::MH; r0 = C::MP + (q / C::MH) * C::DEC_SEQ; lc = C::LCS; }
}
__device__ __forceinline__ void stage64(LAS unsigned char* tile, const float* src, int ld, int lc, int tid, const LAS float* rs, float mul) {
#pragma unroll
    for (int i = 0; i < 4; ++i) { const int f = tid + 512 * i, row = f >> 5, c4 = f & 31; f32x4 v = (f32x4){0.f, 0.f, 0.f, 0.f};
        if (row < lc) { v = *(const f32x4*)(src + (size_t)row * ld + c4 * 4); const float m = rs ? rs[row] * mul : mul; v = v * m; }
        u32x2 w; w.x = pg8::cvt_pk_bf16(v[0], v[1]); w.y = pg8::cvt_pk_bf16(v[2], v[3]); *(LAS u32x2*)(tile + row * PT + c4 * 8) = w; }
}
__device__ __forceinline__ void ml_phase_a(LAS unsigned char* lds, const Ptrs& p, int l, int tid, int bid, int gsz) {
    const int lane = tid & 63, wave = __builtin_amdgcn_readfirstlane(tid >> 6), li = lane & 15, g = lane >> 4;
    LAS unsigned char* Ks = lds; LAS unsigned char* Vs = lds + T64; LAS float* wts = (LAS float*)(lds + 2 * T64);
    const float* P = wsf<C>(p, C::WS_BIG);
    for (int ci = bid; ci < C::NCH; ci += gsz) {
        int r0, h, lc; ch_decode(ci, r0, h, lc);
        if (wave == 0) {
            float lf = 0.f, ig = -3.0e38f;
            if (lane < lc) { const float* pr = P + (size_t)(r0 + lane) * C::LDP; ig = pr[C::O_IG + h] + p.in[I_IB][l * C::MH + h]; const float fx = pr[C::O_FG + h] + p.in[I_FB][l * C::MH + h]; lf = fx >= 0.f ? -__logf(1.0f + __expf(-fx)) : fx - __logf(1.0f + __expf(fx)); }
            float b = lf;
#pragma unroll
            for (int o = 1; o < 64; o <<= 1) { const float t = __shfl_up(b, o); if (lane >= o) b += t; }
            const float a = lane < lc ? ig - b : -3.0e38f;
            float amax = a;
#pragma unroll
            for (int o = 1; o < 64; o <<= 1) amax = fmaxf(amax, __shfl_xor(amax, o));
            const float bL = __shfl(b, lc - 1), mloc = bL + amax;
            const float wt = lane < lc ? __expf(bL + a - mloc) : 0.f;
            wts[lane] = wt;
            if (lane < lc) { wsf<C>(p, C::WS_GB)[(size_t)(r0 + lane) * C::MH + h] = b; wsf<C>(p, C::WS_GA)[(size_t)(r0 + lane) * C::MH + h] = a; }
            if (lane == 0) { wsf<C>(p, C::WS_CBL)[ci] = bL; wsf<C>(p, C::WS_CML)[ci] = mloc; }
        }
        __syncthreads();
        stage64(Ks, P + (size_t)r0 * C::LDP + C::O_K + h * C::MHD, C::LDP, lc, tid, wts, 0.08838834764831845f);
        stage64(Vs, P + (size_t)r0 * C::LDP + C::O_VM + h * C::MHD, C::LDP, lc, tid, nullptr, 1.0f);
        __syncthreads();
        f32x4 acc[8];
#pragma unroll
        for (int et = 0; et < 8; ++et) acc[et] = (f32x4){0.f, 0.f, 0.f, 0.f};
        const unsigned ks = (unsigned)(size_t)Ks, vs = (unsigned)(size_t)Vs;
#pragma unroll
        for (int t = 0; t < 2; ++t) {
            const s16x4 alo = att::tr_read(tr_addr(ks, 32 * t + 8 * g, 16 * wave, li)), ahi = att::tr_read(tr_addr(ks, 32 * t + 8 * g + 4, 16 * wave, li));
            s16x4 blo[8], bhi[8];
#pragma unroll
            for (int et = 0; et < 8; ++et) { blo[et] = att::tr_read(tr_addr(vs, 32 * t + 8 * g, 16 * et, li)); bhi[et] = att::tr_read(tr_addr(vs, 32 * t + 8 * g + 4, 16 * et, li)); }
            lds_wait();
            const bf16x8 a = mk8(alo, ahi);
#pragma unroll
            for (int et = 0; et < 8; ++et) acc[et] = __builtin_amdgcn_mfma_f32_16x16x32_bf16(a, mk8(blo[et], bhi[et]), acc[et], 0, 0, 0);
        }
        float* DC = wsf<C>(p, C::WS_DC) + (size_t)ci * C::MHD * C::MHD;
#pragma unroll
        for (int et = 0; et < 8; ++et)
#pragma unroll
            for (int r = 0; r < 4; ++r) DC[(size_t)(16 * wave + 4 * g + r) * C::MHD + 16 * et + li] = acc[et][r];
        if (tid < C::MHD) { float s = 0.f; for (int t = 0; t < 64; ++t) s += bf2f(*(const LAS bf16_t*)(Ks + t * PT + tid * 2)); wsf<C>(p, C::WS_DN)[(size_t)ci * C::MHD + tid] = s; }
        __syncthreads();
    }
}
__device__ __forceinline__ void ml_phase_c(LAS unsigned char* lds, const Ptrs& p, int l, int tid, int bid, int gsz) {
    const int lane = tid & 63, wave = __builtin_amdgcn_readfirstlane(tid >> 6), li = lane & 15, g = lane >> 4, it = wave & 3, eh = wave >> 2;
    LAS unsigned char* Qs = lds; LAS unsigned char* Ks = lds + T64; LAS unsigned char* Vs = lds + 2 * T64; LAS unsigned char* Cs = lds + 3 * T64;
    LAS float* sb = (LAS float*)(lds + 3 * T64 + T128);
    LAS float* sa = sb + 64; LAS float* smr = sb + 128; LAS float* siw = sb + 192; LAS float* snp = sb + 256; LAS float* ssq = sb + 384;
    const float* P = wsf<C>(p, C::WS_BIG);
    for (int ci = bid; ci < C::NCH; ci += gsz) {
        int r0, h, lc; ch_decode(ci, r0, h, lc);
        const bool sample = ci >= C::NPC, first = !sample && (ci % C::NC) == 0;
        const float mprev = wsf<C>(p, C::WS_MPREV)[ci];
        if (wave == 0) {
            float b = 0.f, a = -3.0e38f;
            if (lane < lc) { b = wsf<C>(p, C::WS_GB)[(size_t)(r0 + lane) * C::MH + h]; a = wsf<C>(p, C::WS_GA)[(size_t)(r0 + lane) * C::MH + h]; }
            float pm = a;
#pragma unroll
            for (int o = 1; o < 64; o <<= 1) { const float t = __shfl_up(pm, o); if (lane >= o) pm = fmaxf(pm, t); }
            const float mrow = b + fmaxf(mprev, pm);
            sb[lane] = b; sa[lane] = a; smr[lane] = mrow; siw[lane] = __expf(b + mprev - mrow);
        }
        if (tid >= 128 && tid < 256) { const int d = tid - 128;
            snp[d] = sample ? p.in[I_SN][((size_t)l * C::NSC + (ci - C::NPC)) * C::MHD + d] : (first ? 0.f : wsf<C>(p, C::WS_DN)[(size_t)(ci - 1) * C::MHD + d]); }
        stage64(Qs, P + (size_t)r0 * C::LDP + C::O_Q + h * C::MHD, C::LDP, lc, tid, nullptr, 1.0f);
        stage64(Ks, P + (size_t)r0 * C::LDP + C::O_K + h * C::MHD, C::LDP, lc, tid, nullptr, 0.08838834764831845f);
        stage64(Vs, P + (size_t)r0 * C::LDP + C::O_VM + h * C::MHD, C::LDP, lc, tid, nullptr, 1.0f);
        { const float* cp = sample ? p.in[I_SC] + ((size_t)l * C::NSC + (ci - C::NPC)) * C::MHD * C::MHD : wsf<C>(p, C::WS_DC) + (size_t)(first ? ci : ci - 1) * C::MHD * C::MHD;
#pragma unroll
            for (int i = 0; i < 8; ++i) { const int f = tid + 512 * i, row = f >> 5, c4 = f & 31; f32x4 v = (f32x4){0.f, 0.f, 0.f, 0.f};
                if (!first) v = *(const f32x4*)(cp + (size_t)row * C::MHD + c4 * 4);
                u32x2 w; w.x = pg8::cvt_pk_bf16(v[0], v[1]); w.y = pg8::cvt_pk_bf16(v[2], v[3]); *(LAS u32x2*)(Cs + row * PT + c4 * 8) = w; } }
        __syncthreads();
        const bool active = it * 16 < lc;
        float ssq_part = 0.f; f32x4 hv[4]; float inv_den = 0.f;
        const int i = 16 * it + li;
        if (active) {
            bf16x8 qf[4];
#pragma unroll
            for (int ks = 0; ks < 4; ++ks) qf[ks] = *(const LAS bf16x8*)(Qs + i * PT + ks * 64 + g * 16);
            f32x4 st[4];
#pragma unroll
            for (int jt = 0; jt < 4; ++jt) st[jt] = (f32x4){0.f, 0.f, 0.f, 0.f};
#pragma unroll
            for (int jt = 0; jt < 4; ++jt) if (jt <= it) {
#pragma unroll
                for (int ks = 0; ks < 4; ++ks) { const bf16x8 a = *(const LAS bf16x8*)(Ks + (16 * jt + li) * PT + ks * 64 + g * 16);
                    st[jt] = __builtin_amdgcn_mfma_f32_16x16x32_bf16(a, qf[ks], st[jt], 0, 0, 0); } }
            const float bi = sb[i], mri = smr[i], iwi = siw[i];
            float dsum = 0.f;
#pragma unroll
            for (int jt = 0; jt < 4; ++jt)
#pragma unroll
                for (int r = 0; r < 4; ++r) { const int j = 16 * jt + 4 * g + r; const float w = (j <= i) ? __expf(bi + sa[j] - mri) : 0.f; st[jt][r] *= w; dsum += st[jt][r]; }
            dsum += __shfl_xor(dsum, 16); dsum += __shfl_xor(dsum, 32);
            float qn = 0.f;
#pragma unroll
            for (int ks = 0; ks < 4; ++ks)
#pragma unroll
                for (int jj = 0; jj < 8; ++jj) qn += bf2f((bf16_t)qf[ks][jj]) * snp[32 * ks + 8 * g + jj];
            qn += __shfl_xor(qn, 16); qn += __shfl_xor(qn, 32);
            const float den = dsum + iwi * qn;
            inv_den = 1.0f / fmaxf(fabsf(den), __expf(-mri));
            bf16x8 pf[2];
#pragma unroll
            for (int t = 0; t < 2; ++t) { pg8::u32x4 w; w.x = pg8::cvt_pk_bf16(st[2 * t][0], st[2 * t][1]); w.y = pg8::cvt_pk_bf16(st[2 * t][2], st[2 * t][3]);
                w.z = pg8::cvt_pk_bf16(st[2 * t + 1][0], st[2 * t + 1][1]); w.w = pg8::cvt_pk_bf16(st[2 * t + 1][2], st[2 * t + 1][3]); pf[t] = __builtin_bit_cast(bf16x8, w); }
            const unsigned vs = (unsigned)(size_t)Vs, cs = (unsigned)(size_t)Cs;
#pragma unroll
            for (int e4 = 0; e4 < 4; ++e4) { const int et = 4 * eh + e4;
                s16x4 vlo[2], vhi[2], clo[4], chi[4];
#pragma unroll
                for (int t = 0; t < 2; ++t) { vlo[t] = att::tr_read(tr_addr(vs, 32 * t + 4 * g, 16 * et, li)); vhi[t] = att::tr_read(tr_addr(vs, 32 * t + 16 + 4 * g, 16 * et, li)); }
#pragma unroll
                for (int ks = 0; ks < 4; ++ks) { clo[ks] = att::tr_read(tr_addr(cs, 32 * ks + 8 * g, 16 * et, li)); chi[ks] = att::tr_read(tr_addr(cs, 32 * ks + 8 * g + 4, 16 * et, li)); }
                lds_wait();
                f32x4 aS = (f32x4){0.f, 0.f, 0.f, 0.f}, aC = (f32x4){0.f, 0.f, 0.f, 0.f};
#pragma unroll
                for (int t = 0; t < 2; ++t) aS = __builtin_amdgcn_mfma_f32_16x16x32_bf16(mk8(vlo[t], vhi[t]), pf[t], aS, 0, 0, 0);
#pragma unroll
                for (int ks = 0; ks < 4; ++ks) aC = __builtin_amdgcn_mfma_f32_16x16x32_bf16(mk8(clo[ks], chi[ks]), qf[ks], aC, 0, 0, 0);
                hv[e4] = (aS + aC * iwi) * inv_den;
                ssq_part += (hv[e4][0] * hv[e4][0] + hv[e4][1] * hv[e4][1]) + (hv[e4][2] * hv[e4][2] + hv[e4][3] * hv[e4][3]); }
            ssq_part += __shfl_xor(ssq_part, 16); ssq_part += __shfl_xor(ssq_part, 32);
            if (g == 0) ssq[wave * 16 + li] = ssq_part;
        }
        __syncthreads();
        if (active) {
            const float tot = ssq_part + ssq[(wave ^ 4) * 16 + li];
            const float rs = rsqrtf(tot * (1.0f / C::MHD) + 1e-6f);
            const int row = r0 + i;
#pragma unroll
            for (int e4 = 0; e4 < 4; ++e4) { const int e = 16 * (4 * eh + e4) + 4 * g;
                const f32x4 og = *(const f32x4*)(P + (size_t)row * C::LDP + C::O_O + h * C::MHD + e); const f32x4 gn = *(const f32x4*)(p.in[I_NG] + (size_t)l * C::MW + h * C::MHD + e);
                float o4[4];
#pragma unroll
                for (int r = 0; r < 4; ++r) o4[r] = hv[e4][r] * rs * gn[r] * __builtin_amdgcn_rcpf(1.0f + __expf(-og[r]));
                u32x2 w; w.x = pg8::cvt_pk_bf16(o4[0], o4[1]); w.y = pg8::cvt_pk_bf16(o4[2], o4[3]);
                *(u32x2*)(wsb<C>(p, C::WS_MIX) + (size_t)row * C::D + C::PW + C::GW + h * C::MHD + e) = w; }
        }
        __syncthreads();
    }
}
}
namespace rw {
typedef att::f32x4 f32x4; typedef att::u32x2 u32x2;
static_assert(C::D == 2048, "row ops assume 2048 columns = 8 float4 per lane");
__device__ __forceinline__ float wave_sum(float v) {
#pragma unroll
    for (int o = 1; o < 64; o <<= 1) v += __shfl_xor(v, o);
    return v;
}
__device__ __forceinline__ void rows_init(const Ptrs& p, int tid, int bid, int gsz) {
    const int lane = tid & 63, gw = bid * NWAVES + (tid >> 6), NGW = gsz * NWAVES;
    float* SS = wsf<C>(p, C::WS_SS);
    for (int r = gw; r < C::M; r += NGW) {
        const float* src = r < C::MP ? p.in[I_XP] + (size_t)r * C::D : p.in[I_XS] + (size_t)(r - C::MP) * C::D;
        float* X = wsf<C>(p, C::WS_X) + (size_t)r * C::D; bf16_t* XB = wsb<C>(p, C::WS_XB) + (size_t)r * C::D;
        float ss = 0.f;
#pragma unroll
        for (int j = 0; j < 8; ++j) { const f32x4 v = *(const f32x4*)(src + (lane + 64 * j) * 4); *(f32x4*)(X + (lane + 64 * j) * 4) = v;
            u32x2 w; w.x = pg8::cvt_pk_bf16(v[0], v[1]); w.y = pg8::cvt_pk_bf16(v[2], v[3]); *(u32x2*)(XB + (lane + 64 * j) * 4) = w;
            ss += (v[0] * v[0] + v[1] * v[1]) + (v[2] * v[2] + v[3] * v[3]); }
        ss = wave_sum(ss);
        if (lane < C::NSS) SS[(size_t)lane * C::M + r] = lane == 0 ? ss : 0.f;
    }
    for (int r = gw; r < C::MM; r += NGW) {
        const float* src = p.in[I_MEM] + (size_t)r * C::D; bf16_t* MB = wsb<C>(p, C::WS_MEMB) + (size_t)r * C::D;
        float ss = 0.f;
#pragma unroll
        for (int j = 0; j < 8; ++j) { const f32x4 v = *(const f32x4*)(src + (lane + 64 * j) * 4);
            u32x2 w; w.x = pg8::cvt_pk_bf16(v[0], v[1]); w.y = pg8::cvt_pk_bf16(v[2], v[3]); *(u32x2*)(MB + (lane + 64 * j) * 4) = w;
            ss += (v[0] * v[0] + v[1] * v[1]) + (v[2] * v[2] + v[3] * v[3]); }
        ss = wave_sum(ss);
        if (lane == 0) wsf<C>(p, C::WS_RSTDM)[r] = rsqrtf(ss * (1.0f / C::D) + 1e-6f);
    }
}
__device__ __forceinline__ void rows_final(const Ptrs& p, int tid, int bid, int gsz) {
    const int lane = tid & 63, gw = bid * NWAVES + (tid >> 6), NGW = gsz * NWAVES;
    for (int r = gw; r < C::M; r += NGW) {
        const float* X = wsf<C>(p, C::WS_X) + (size_t)r * C::D; const float rs = rsqrtf(wsf<C>(p, C::WS_SS)[(size_t)(C::NSS - 1) * C::M + r] * (1.0f / C::D) + 1e-6f);
        float* o = r < C::MP ? p.out + C::OUT_YP + (size_t)r * C::D : p.out + C::OUT_YS + (size_t)(r - C::MP) * C::D;
        float pscale = 1.0f, padd = 0.f;
#if defined(PROBE_MASK_A)
        { const unsigned long long* TS = (const unsigned long long*)(p.ws + C::WS_CTL + 32768); unsigned long long ta = 0, tb = 0;
          for (int k = 0; k < 25; ++k) { const unsigned long long dk = TS[k + 1] - TS[k]; if ((PROBE_MASK_A >> k) & 1ull) ta += dk; if ((PROBE_MASK_B >> k) & 1ull) tb += dk; }
#if defined(PROBE_MLT)
          ta = TS[48 + PROBE_MLT];
#endif
#if defined(PROBE_GST)
          { const unsigned long long* st = (const unsigned long long*)(p.ws + C::WS_END); unsigned long long epi = 0; for (int u2 = 0; u2 < 8; ++u2) epi += st[3 + 2 * u2] - st[2 + 2 * u2];
            const unsigned long long tot = st[18] - st[0], fill = st[1] - st[0];
            ta = (unsigned long long)(1.0e6 * (double)(PROBE_GST == 1 ? epi : fill) / (double)tot); }
#endif
#if defined(PROBE_MLC)
          ta = TS[48 + PROBE_MLC];
#endif
#if defined(PROBE_ATT)
          ta = 0; for (int l2 = 0; l2 < 2; ++l2) { const int k = 1 + 12 * l2 + 8; ta += (PROBE_ATT == 1) ? TS[44 + l2] - TS[k] : TS[k + 1] - TS[44 + l2]; }
#endif
#if defined(PROBE_SCN)
          ta = 0; for (int l2 = 0; l2 < 2; ++l2) { const int k = 1 + 12 * l2 + 4; ta += (PROBE_SCN == 1) ? TS[44 + l2] - TS[k] : TS[k + 1] - TS[44 + l2]; }
#endif
#if defined(PROBE_MIXA)
          ta = 0; for (int l2 = 0; l2 < 2; ++l2) { const int k = 1 + 12 * l2 + 3; ta += (PROBE_MIXA == 1) ? TS[40 + l2] - TS[k] : (PROBE_MIXA == 2) ? TS[42 + l2] - TS[40 + l2] : TS[k + 1] - TS[42 + l2]; }
#endif
#if defined(PROBE_SPLIT_MODE)
          ta = 0; for (int l2 = 0; l2 < 2; ++l2) { const int k = 1 + 10 * l2 + 3; ta += (PROBE_SPLIT_MODE == 1) ? TS[40 + l2] - TS[k] : TS[k + 1] - TS[40 + l2]; }
#endif
          if (r >= C::MP) pscale = 1.0f + 0.03f + (float)ta * 0.01f * PROBE_SA;
          if (r == 0 && lane == 0) padd = 1.0f + (float)tb * 0.01f * PROBE_SB; }
#endif
#pragma unroll
        for (int j = 0; j < 8; ++j) { const f32x4 v = *(const f32x4*)(X + (lane + 64 * j) * 4); const f32x4 gg = *(const f32x4*)(p.in[I_GFIN] + (lane + 64 * j) * 4);
            f32x4 y = v * rs * gg * pscale; if (j == 0) y[0] += padd; *(f32x4*)(o + (lane + 64 * j) * 4) = y; }
    }
}
__device__ __forceinline__ void ml_scan(const Ptrs& p, int l, long gtid, long gthreads) {
    const float* CBL = wsf<C>(p, C::WS_CBL); const float* CML = wsf<C>(p, C::WS_CML);
    float* DC = wsf<C>(p, C::WS_DC); float* DN = wsf<C>(p, C::WS_DN);
    constexpr int NPS = C::BATCH * C::MH, E4 = C::MHD / 4;
    for (long it = gtid; it < (long)NPS * C::MHD * E4; it += gthreads) {
        const int e4 = (int)(it % E4), d = (int)((it / E4) % C::MHD), sq = (int)(it / ((long)E4 * C::MHD));
        float m = 0.f; f32x4 cst = (f32x4){0.f, 0.f, 0.f, 0.f};
        static_assert(C::NC % 8 == 0, "scan is unrolled by 8 chunks");
        for (int c0 = 0; c0 < C::NC; c0 += 8) {
            f32x4 v[8]; float bl[8], ml[8];
#pragma unroll
            for (int j = 0; j < 8; ++j) { const int ci = sq * C::NC + c0 + j; v[j] = *(const f32x4*)(DC + ((size_t)ci * C::MHD + d) * C::MHD + e4 * 4); bl[j] = CBL[ci]; ml[j] = CML[ci]; }
#pragma unroll
            for (int j = 0; j < 8; ++j) { const int ci = sq * C::NC + c0 + j; const float a = bl[j] + m, mn = fmaxf(a, ml[j]), dec = __expf(a - mn), f = __expf(ml[j] - mn);
                cst = cst * dec + v[j] * f; *(f32x4*)(DC + ((size_t)ci * C::MHD + d) * C::MHD + e4 * 4) = cst; m = mn; }
        }
        *(f32x4*)(p.out + C::OUT_CP + (((size_t)l * NPS + sq) * C::MHD + d) * C::MHD + e4 * 4) = cst;
    }
    for (long it = gtid; it < (long)NPS * C::MHD; it += gthreads) {
        const int d = (int)(it % C::MHD), sq = (int)(it / C::MHD);
        float m = 0.f, nst = 0.f;
        for (int c = 0; c < C::NC; ++c) { const int ci = sq * C::NC + c; const float a = CBL[ci] + m, b2 = CML[ci], mn = fmaxf(a, b2), dec = __expf(a - mn), f = __expf(b2 - mn);
            const size_t on = (size_t)ci * C::MHD + d; nst = dec * nst + f * DN[on]; DN[on] = nst; m = mn; }
        p.out[C::OUT_NP + ((size_t)l * NPS + sq) * C::MHD + d] = nst;
    }
    for (long it = gtid; it < (long)C::NSC * C::MHD * E4; it += gthreads) {
        const int e4 = (int)(it % E4), d = (int)((it / E4) % C::MHD), q = (int)(it / ((long)E4 * C::MHD)), ci = C::NPC + q;
        const float m0 = p.in[I_SM][(size_t)l * C::NSC + q], a = CBL[ci] + m0, b2 = CML[ci], mn = fmaxf(a, b2), dec = __expf(a - mn), f = __expf(b2 - mn);
        const size_t so = (((size_t)l * C::NSC + q) * C::MHD + d) * C::MHD + e4 * 4;
        *(f32x4*)(p.out + C::OUT_CS + so) = *(const f32x4*)(p.in[I_SC] + so) * dec + *(const f32x4*)(DC + ((size_t)ci * C::MHD + d) * C::MHD + e4 * 4) * f;
    }
    for (long it = gtid; it < (long)C::NSC * C::MHD; it += gthreads) {
        const int d = (int)(it % C::MHD), q = (int)(it / C::MHD), ci = C::NPC + q;
        const float m0 = p.in[I_SM][(size_t)l * C::NSC + q], a = CBL[ci] + m0, b2 = CML[ci], mn = fmaxf(a, b2), dec = __expf(a - mn), f = __expf(b2 - mn);
        const size_t no = ((size_t)l * C::NSC + q) * C::MHD + d;
        p.out[C::OUT_NS + no] = dec * p.in[I_SN][no] + f * DN[(size_t)ci * C::MHD + d];
    }
}
}

namespace gp {
typedef att::bf16x8 bf16x8; typedef att::s16x4 s16x4; typedef att::f32x4 f32x4; typedef att::u32x2 u32x2;
constexpr int PT = mx::PT, T128 = mx::T128;
static_assert(C::GHD == 128 && C::PGD == 128 && C::GCH == 128 && C::SEQ % 128 == 0 && C::DEC_SEQ == 32 && C::PH == 15, "gmlp / pool phases are built for these shapes");
constexpr int NT_P = C::MP / 128;
constexpr int NU_G = NT_P * 4 + C::DEC_BATCH * 4;
__device__ __forceinline__ void gmlp_phase(LAS unsigned char* lds, const Ptrs& p, int l, int tid, int bid, int gsz) {
    const int lane = tid & 63, wave = __builtin_amdgcn_readfirstlane(tid >> 6), li = lane & 15, g = lane >> 4;
    LAS unsigned char* Vs = lds; LAS unsigned char* Ws = lds + T128;
    const float* P = wsf<C>(p, C::WS_BIG);
    for (int u = bid; u < NU_G; u += gsz) {
        int r0, lc, h; bool sample = false; int sb = 0;
        if (u < NT_P * 4) { h = u & 3; r0 = (u >> 2) * 128; lc = 128; } else { const int s = u - NT_P * 4; h = s & 3; sb = s >> 2; r0 = C::MP + sb * C::DEC_SEQ; lc = C::DEC_SEQ; sample = true; }
#pragma unroll
        for (int i = 0; i < 8; ++i) { const int f = tid + 512 * i, row = f >> 5, c4 = f & 31; f32x4 v = (f32x4){0.f, 0.f, 0.f, 0.f};
            if (row < lc) v = *(const f32x4*)(P + (size_t)(r0 + row) * C::LDP + C::O_V + h * 128 + c4 * 4);
            float ss = (v[0] * v[0] + v[1] * v[1]) + (v[2] * v[2] + v[3] * v[3]);
#pragma unroll
            for (int o = 1; o < 32; o <<= 1) ss += __shfl_xor(ss, o);
            const float rs = rsqrtf(ss * (1.0f / 128) + 1e-6f); const f32x4 gn = *(const f32x4*)(p.in[I_GVG] + (size_t)l * C::GW + h * 128 + c4 * 4);
            v = v * rs * gn;
            if (sample && row < lc) *(f32x4*)(p.out + C::OUT_VS + (((size_t)l * C::DEC_BATCH + sb) * C::DEC_SEQ + row) * C::GW + h * 128 + c4 * 4) = v;
            u32x2 w; w.x = pg8::cvt_pk_bf16(v[0], v[1]); w.y = pg8::cvt_pk_bf16(v[2], v[3]); *(LAS u32x2*)(Vs + row * PT + c4 * 8) = w; }
        const float* wsrc = p.in[I_GWS] + ((size_t)l * C::GH + h) * 128 * 128;
#pragma unroll
        for (int i = 0; i < 8; ++i) { const int f = tid + 512 * i, row = f >> 5, c4 = f & 31; f32x4 v = *(const f32x4*)(wsrc + (size_t)row * 128 + c4 * 4);
#pragma unroll
            for (int j = 0; j < 4; ++j) if (c4 * 4 + j > row) v[j] = 0.f;
            u32x2 w; w.x = pg8::cvt_pk_bf16(v[0], v[1]); w.y = pg8::cvt_pk_bf16(v[2], v[3]); *(LAS u32x2*)(Ws + row * PT + c4 * 8) = w; }
        WG_SYNC();
        if (wave * 16 < lc) {
            const int i = wave * 16 + li, nks = (wave * 16 + 15) / 32 + 1;
            f32x4 acc[8];
#pragma unroll
            for (int dt = 0; dt < 8; ++dt) acc[dt] = (f32x4){0.f, 0.f, 0.f, 0.f};
            const unsigned vs = (unsigned)(size_t)Vs;
            for (int ks = 0; ks < nks; ++ks) {
                const bf16x8 bq = *(const LAS bf16x8*)(Ws + i * PT + ks * 64 + g * 16);
                s16x4 lo[8], hi[8];
#pragma unroll
                for (int dt = 0; dt < 8; ++dt) { lo[dt] = att::tr_read(mx::tr_addr(vs, 32 * ks + 8 * g, 16 * dt, li)); hi[dt] = att::tr_read(mx::tr_addr(vs, 32 * ks + 8 * g + 4, 16 * dt, li)); }
                mx::lds_wait();
#pragma unroll
                for (int dt = 0; dt < 8; ++dt) acc[dt] = __builtin_amdgcn_mfma_f32_16x16x32_bf16(mx::mk8(lo[dt], hi[dt]), bq, acc[dt], 0, 0, 0);
            }
            const float bsi = p.in[I_GBS][((size_t)l * C::GH + h) * C::GCH + i];
            const int row = r0 + i;
#pragma unroll
            for (int dt = 0; dt < 8; ++dt) { const int d = 16 * dt + 4 * g; const f32x4 uu = *(const f32x4*)(P + (size_t)row * C::LDP + C::O_U + h * 128 + d);
                u32x2 w; w.x = pg8::cvt_pk_bf16(uu[0] * (acc[dt][0] + bsi), uu[1] * (acc[dt][1] + bsi)); w.y = pg8::cvt_pk_bf16(uu[2] * (acc[dt][2] + bsi), uu[3] * (acc[dt][3] + bsi));
                *(u32x2*)(wsb<C>(p, C::WS_MIX) + (size_t)row * C::D + C::PW + h * 128 + d) = w; }
        }
        WG_SYNC();
    }
}
__device__ __forceinline__ void pool_phase(LAS unsigned char* lds, const Ptrs& p, int l, int tid, int bid, int gsz) {
    const int lane = tid & 63, wave = __builtin_amdgcn_readfirstlane(tid >> 6), li = lane & 15, g = lane >> 4;
    LAS unsigned char* Ds = lds; LAS unsigned char* Ws = lds + T128;
    const float* P = wsf<C>(p, C::WS_BIG);
    for (int u = bid; u < NU_G; u += gsz) {
        int r0, lc, grp, t0, L, b; bool sample = false;
        if (u < NT_P * 4) { grp = u & 3; r0 = (u >> 2) * 128; lc = 128; b = r0 / C::SEQ; t0 = r0 % C::SEQ; L = C::SEQ; } else { const int s = u - NT_P * 4; grp = s & 3; b = s >> 2; r0 = C::MP + b * C::DEC_SEQ; lc = C::DEC_SEQ; t0 = 0; L = C::DEC_SEQ; sample = true; }
        const int w = 2 << grp;
        { const int c4 = tid & 31, sg = tid >> 5, ch = grp * 128 + c4 * 4;
            const float* hist = p.in[I_SPOOL] + ((size_t)l * C::DEC_BATCH + b) * C::PH * C::PW + ch;
            auto xat = [&](int t) -> f32x4 {
                if (t >= 0) return *(const f32x4*)(P + (size_t)(r0 - t0 + t) * C::LDP + ch);
                if (sample && C::PH + t >= 0) return *(const f32x4*)(hist + (size_t)(C::PH + t) * C::PW);
                return (f32x4){0.f, 0.f, 0.f, 0.f}; };
            if (sg * 8 < lc) {
                const int ts = t0 + sg * 8;
                f32x4 sum = (f32x4){0.f, 0.f, 0.f, 0.f};
                for (int j = 1; j < w; ++j) sum = sum + xat(ts - j);
#pragma unroll
                for (int k = 0; k < 8; ++k) { const int t = ts + k; const f32x4 x = xat(t); sum = sum + x;
                    const int pos = (sample ? C::PAST : 0) + t; const float inv = 1.0f / (float)((pos + 1) < w ? (pos + 1) : w);
                    const f32x4 dv = sum * inv - x;
                    u32x2 ww; ww.x = pg8::cvt_pk_bf16(dv[0], dv[1]); ww.y = pg8::cvt_pk_bf16(dv[2], dv[3]); *(LAS u32x2*)(Ds + (sg * 8 + k) * PT + c4 * 8) = ww;
                    sum = sum - xat(t - w + 1);
                    const int idx = t - (L - C::PH);
                    if (idx >= 0) *(f32x4*)(p.out + (sample ? C::OUT_POOLS + (((size_t)l * C::DEC_BATCH + b) * C::PH + idx) * C::PW : C::OUT_POOLP + (((size_t)l * C::BATCH + b) * C::PH + idx) * C::PW) + ch) = x; }
            } else {
#pragma unroll
                for (int k = 0; k < 8; ++k) *(LAS u32x2*)(Ds + (sg * 8 + k) * PT + c4 * 8) = (u32x2){0u, 0u};
            }
        }
        const float* wsrc = p.in[I_POOLW] + ((size_t)l * C::PG + grp) * 128 * 128;
#pragma unroll
        for (int i = 0; i < 8; ++i) { const int f = tid + 512 * i, row = f >> 5, c4 = f & 31; const f32x4 v = *(const f32x4*)(wsrc + (size_t)row * 128 + c4 * 4);
            u32x2 ww; ww.x = pg8::cvt_pk_bf16(v[0], v[1]); ww.y = pg8::cvt_pk_bf16(v[2], v[3]); *(LAS u32x2*)(Ws + row * PT + c4 * 8) = ww; }
        WG_SYNC();
        if (wave * 16 < lc) {
            const int t = wave * 16 + li;
            f32x4 acc[8];
#pragma unroll
            for (int et = 0; et < 8; ++et) acc[et] = (f32x4){0.f, 0.f, 0.f, 0.f};
            const unsigned wsa = (unsigned)(size_t)Ws;
#pragma unroll
            for (int ks = 0; ks < 4; ++ks) {
                const bf16x8 bq = *(const LAS bf16x8*)(Ds + t * PT + ks * 64 + g * 16);
                s16x4 lo[8], hi[8];
#pragma unroll
                for (int et = 0; et < 8; ++et) { lo[et] = att::tr_read(mx::tr_addr(wsa, 32 * ks + 8 * g, 16 * et, li)); hi[et] = att::tr_read(mx::tr_addr(wsa, 32 * ks + 8 * g + 4, 16 * et, li)); }
                mx::lds_wait();
#pragma unroll
                for (int et = 0; et < 8; ++et) acc[et] = __builtin_amdgcn_mfma_f32_16x16x32_bf16(mx::mk8(lo[et], hi[et]), bq, acc[et], 0, 0, 0);
            }
            const int row = r0 + t;
#pragma unroll
            for (int et = 0; et < 8; ++et) { const int e = 16 * et + 4 * g; const f32x4 sc = *(const f32x4*)(p.in[I_POOLS] + (size_t)l * C::PW + grp * 128 + e);
                u32x2 ww; ww.x = pg8::cvt_pk_bf16(acc[et][0] * sc[0], acc[et][1] * sc[1]); ww.y = pg8::cvt_pk_bf16(acc[et][2] * sc[2], acc[et][3] * sc[3]);
                *(u32x2*)(wsb<C>(p, C::WS_MIX) + (size_t)row * C::D + grp * 128 + e) = ww; }
        }
        WG_SYNC();
    }
}
}
namespace mp {
typedef att::bf16x8 bf16x8; typedef att::s16x4 s16x4; typedef att::f32x4 f32x4; typedef att::u32x2 u32x2; typedef pg8::u32x4 u32x4;
constexpr int PT = mx::PT, T64 = mx::T64, T128 = mx::T128, MAXU = 8;
#define MP_TR(dst, base, OFF) asm volatile("ds_read_b64_tr_b16 %0, %1 offset:%2" : "=&v"(dst) : "v"(base), "i"(OFF) : "memory")
__device__ __forceinline__ void ml_a(LAS unsigned char* lds, const Ptrs& p, int l, int tid, int bid, int gsz) {
    const int lane = tid & 63, wave = __builtin_amdgcn_readfirstlane(tid >> 6), li = lane & 15, g = lane >> 4;
    LAS unsigned char* Ks = lds; LAS unsigned char* Vs = lds + T64; LAS float* wts = (LAS float*)(lds + 2 * T64);
    const float* P = wsf<C>(p, C::WS_BIG);
    const int nu = bid < C::NCH ? (C::NCH - 1 - bid) / gsz + 1 : 0;
    if (wave < nu) { const int ci = bid + wave * gsz; int r0, h, lc; mx::ch_decode(ci, r0, h, lc);
        float lf = 0.f, ig = -3.0e38f;
        if (lane < lc) { const float* pr = P + (size_t)(r0 + lane) * C::LDP; ig = pr[C::O_IG + h] + p.in[I_IB][l * C::MH + h]; const float fx = pr[C::O_FG + h] + p.in[I_FB][l * C::MH + h];
            lf = fx >= 0.f ? -__logf(1.0f + __expf(-fx)) : fx - __logf(1.0f + __expf(fx)); }
        float b = lf;
#pragma unroll
        for (int o = 1; o < 64; o <<= 1) { const float t = __shfl_up(b, o); if (lane >= o) b += t; }
        const float a = lane < lc ? ig - b : -3.0e38f;
        float amax = a;
#pragma unroll
        for (int o = 1; o < 64; o <<= 1) amax = fmaxf(amax, __shfl_xor(amax, o));
        const float bL = __shfl(b, lc - 1), mloc = bL + amax;
        wts[wave * 64 + lane] = lane < lc ? __expf(bL + a - mloc) : 0.f;
        if (lane < lc) { wsf<C>(p, C::WS_GB)[(size_t)(r0 + lane) * C::MH + h] = b; wsf<C>(p, C::WS_GA)[(size_t)(r0 + lane) * C::MH + h] = a; }
        if (lane == 0) { wsf<C>(p, C::WS_CBL)[ci] = bL; wsf<C>(p, C::WS_CML)[ci] = mloc; } }
    const unsigned lofs8 = (unsigned)((8 * g + (li >> 2)) * PT + 8 * (li & 3));
    const unsigned kw8 = (unsigned)(size_t)Ks + lofs8 + (unsigned)(32 * wave), vs8 = (unsigned)(size_t)Vs + lofs8;
    f32x4 pk[4], pv[4];
    auto window = [&](int ci) { int r0, h, lc; mx::ch_decode(ci, r0, h, lc); const float* src = P + (size_t)r0 * C::LDP + h * C::MHD;
#pragma unroll
        for (int q = 0; q < 4; ++q) { const int f = tid + 512 * q, row = f >> 5, c4 = f & 31;
            if (row < lc) { pk[q] = *(const f32x4*)(src + (size_t)row * C::LDP + C::O_K + c4 * 4); pv[q] = *(const f32x4*)(src + (size_t)row * C::LDP + C::O_VM + c4 * 4); }
            else { pk[q] = (f32x4){0.f, 0.f, 0.f, 0.f}; pv[q] = pk[q]; } }
        __builtin_amdgcn_sched_barrier(0); };
    if (nu > 0) window(bid);
    WG_SYNC();
    for (int j = 0; j < nu; ++j) { const int ci = bid + j * gsz;
#pragma unroll
        for (int q = 0; q < 4; ++q) { const int f = tid + 512 * q, row = f >> 5, c4 = f & 31; const float sw = 0.08838834764831845f * wts[j * 64 + row];
            u32x2 w; w.x = pg8::cvt_pk_bf16(pk[q][0] * sw, pk[q][1] * sw); w.y = pg8::cvt_pk_bf16(pk[q][2] * sw, pk[q][3] * sw); *(LAS u32x2*)(Ks + row * PT + c4 * 8) = w;
            w.x = pg8::cvt_pk_bf16(pv[q][0], pv[q][1]); w.y = pg8::cvt_pk_bf16(pv[q][2], pv[q][3]); *(LAS u32x2*)(Vs + row * PT + c4 * 8) = w; }
        if (j + 1 < nu) window(ci + gsz);
        WG_SYNC();
        f32x4 acc[8], accn = (f32x4){0.f, 0.f, 0.f, 0.f};
#pragma unroll
        for (int et = 0; et < 8; ++et) acc[et] = (f32x4){0.f, 0.f, 0.f, 0.f};
        const bf16x8 ones = (bf16x8){0x3F80, 0x3F80, 0x3F80, 0x3F80, 0x3F80, 0x3F80, 0x3F80, 0x3F80};
#pragma unroll
        for (int t = 0; t < 2; ++t) {
            s16x4 alo, ahi, blo[8], bhi[8]; MP_TR(alo, kw8, (32 * t) * PT); MP_TR(ahi, kw8, (32 * t + 4) * PT);
#pragma unroll
            for (int et = 0; et < 8; ++et) { MP_TR(blo[et], vs8, (32 * t) * PT + 32 * et); MP_TR(bhi[et], vs8, (32 * t + 4) * PT + 32 * et); }
            mx::lds_wait();
            const bf16x8 a = mx::mk8(alo, ahi);
#pragma unroll
            for (int et = 0; et < 8; ++et) acc[et] = __builtin_amdgcn_mfma_f32_16x16x32_bf16(mx::mk8(blo[et], bhi[et]), a, acc[et], 0, 0, 0);
            accn = __builtin_amdgcn_mfma_f32_16x16x32_bf16(ones, a, accn, 0, 0, 0);
        }
        float* DC = wsf<C>(p, C::WS_DC) + (size_t)ci * C::MHD * C::MHD + (size_t)(16 * wave + li) * C::MHD + 4 * g;
#pragma unroll
        for (int et = 0; et < 8; ++et) *(f32x4*)(DC + 16 * et) = acc[et];
        if (g == 0) wsf<C>(p, C::WS_DN)[(size_t)ci * C::MHD + 16 * wave + li] = accn[0];
        WG_SYNC();
    }
}
__device__ __forceinline__ void ml_scan(const Ptrs& p, int l, long gtid, long gthreads) {
    const float* CBL = wsf<C>(p, C::WS_CBL); const float* CML = wsf<C>(p, C::WS_CML); const float* DC = wsf<C>(p, C::WS_DC); float* DN = wsf<C>(p, C::WS_DN);
    bf16_t* DCB = wsb<C>(p, C::WS_DCB); float* MPREV = wsf<C>(p, C::WS_MPREV);
    constexpr int NPS = C::BATCH * C::MH, E4 = C::MHD / 4;
    static_assert(C::NC % 8 == 0, "scan is unrolled by 8 chunks");
    for (long it = gtid; it < (long)NPS * C::MHD * E4; it += gthreads) {
        const int e4 = (int)(it % E4), d = (int)((it / E4) % C::MHD), sq = (int)(it / ((long)E4 * C::MHD));
        float m = 0.f, nst = 0.f; f32x4 cst = (f32x4){0.f, 0.f, 0.f, 0.f};
        for (int c0 = 0; c0 < C::NC; c0 += 8) {
            f32x4 v[8]; float bl[8], ml[8], dn[8];
#pragma unroll
            for (int j = 0; j < 8; ++j) { const int ci = sq * C::NC + c0 + j; v[j] = *(const f32x4*)(DC + ((size_t)ci * C::MHD + d) * C::MHD + e4 * 4); bl[j] = CBL[ci]; ml[j] = CML[ci];
                dn[j] = (e4 == 0) ? DN[(size_t)ci * C::MHD + d] : 0.f; }
            __builtin_amdgcn_sched_barrier(0);
#pragma unroll
            for (int j = 0; j < 8; ++j) { const int ci = sq * C::NC + c0 + j; const float a = bl[j] + m, mn = fmaxf(a, ml[j]), dec = __expf(a - mn), f = __expf(ml[j] - mn);
                if (d == 0 && e4 == 0) MPREV[ci] = m;
                cst = cst * dec + v[j] * f; u32x2 w; w.x = pg8::cvt_pk_bf16(cst[0], cst[1]); w.y = pg8::cvt_pk_bf16(cst[2], cst[3]);
                *(u32x2*)(DCB + ((size_t)ci * C::MHD + d) * C::MHD + e4 * 4) = w;
                nst = dec * nst + f * dn[j]; if (e4 == 0) DN[(size_t)ci * C::MHD + d] = nst;
                m = mn; }
        }
        *(f32x4*)(p.out + C::OUT_CP + (((size_t)l * NPS + sq) * C::MHD + d) * C::MHD + e4 * 4) = cst;
        if (e4 == 0) p.out[C::OUT_NP + ((size_t)l * NPS + sq) * C::MHD + d] = nst;
        if (d == 0 && e4 == 0) p.out[C::OUT_MP + (size_t)l * NPS + sq] = m;
    }
    for (long it = gtid; it < (long)C::NSC * C::MHD * E4; it += gthreads) {
        const int e4 = (int)(it % E4), d = (int)((it / E4) % C::MHD), q = (int)(it / ((long)E4 * C::MHD)), ci = C::NPC + q;
        const float m0 = p.in[I_SM][(size_t)l * C::NSC + q], a = CBL[ci] + m0, b2 = CML[ci], mn = fmaxf(a, b2), dec = __expf(a - mn), f = __expf(b2 - mn);
        const size_t so = (((size_t)l * C::NSC + q) * C::MHD + d) * C::MHD + e4 * 4; const f32x4 cin = *(const f32x4*)(p.in[I_SC] + so);
        *(f32x4*)(p.out + C::OUT_CS + so) = cin * dec + *(const f32x4*)(DC + ((size_t)ci * C::MHD + d) * C::MHD + e4 * 4) * f;
        u32x2 w; w.x = pg8::cvt_pk_bf16(cin[0], cin[1]); w.y = pg8::cvt_pk_bf16(cin[2], cin[3]); *(u32x2*)(DCB + ((size_t)ci * C::MHD + d) * C::MHD + e4 * 4) = w;
        if (d == 0 && e4 == 0) { MPREV[ci] = m0; p.out[C::OUT_MS + (size_t)l * C::NSC + q] = mn; }
    }
    for (long it = gtid; it < (long)C::NSC * C::MHD; it += gthreads) {
        const int d = (int)(it % C::MHD), q = (int)(it / C::MHD), ci = C::NPC + q;
        const float m0 = p.in[I_SM][(size_t)l * C::NSC + q], a = CBL[ci] + m0, b2 = CML[ci], mn = fmaxf(a, b2), dec = __expf(a - mn), f = __expf(b2 - mn);
        const size_t no = ((size_t)l * C::NSC + q) * C::MHD + d;
        p.out[C::OUT_NS + no] = dec * p.in[I_SN][no] + f * DN[(size_t)ci * C::MHD + d];
    }
}
__device__ __forceinline__ void ml_c(LAS unsigned char* lds, const Ptrs& p, int l, int tid, int bid, int gsz) {
    const int lane = tid & 63, wave = __builtin_amdgcn_readfirstlane(tid >> 6), li = lane & 15, g = lane >> 4, it = wave & 3, eh = wave >> 2;
    LAS unsigned char* Qs = lds; LAS unsigned char* Ks = lds + T64; LAS unsigned char* Vs = lds + 2 * T64; LAS unsigned char* Cs = lds + 3 * T64;
    LAS float* SB = (LAS float*)(lds + 3 * T64 + T128); LAS float* SA = SB + MAXU * 64; LAS float* SMR = SA + MAXU * 64; LAS float* SIW = SMR + MAXU * 64;
    LAS float* snp = SIW + MAXU * 64; LAS float* ssq = snp + 128; LAS float* sgn = ssq + 128;
    const float* P = wsf<C>(p, C::WS_BIG);
    const int nu = bid < C::NCH ? (C::NCH - 1 - bid) / gsz + 1 : 0;
    if (wave < nu) { const int ci = bid + wave * gsz; int r0, h, lc; mx::ch_decode(ci, r0, h, lc); const float mprev = wsf<C>(p, C::WS_MPREV)[ci];
        float b = 0.f, a = -3.0e38f;
        if (lane < lc) { b = wsf<C>(p, C::WS_GB)[(size_t)(r0 + lane) * C::MH + h]; a = wsf<C>(p, C::WS_GA)[(size_t)(r0 + lane) * C::MH + h]; }
        float pm = a;
#pragma unroll
        for (int o = 1; o < 64; o <<= 1) { const float t = __shfl_up(pm, o); if (lane >= o) pm = fmaxf(pm, t); }
        const float mrow = b + fmaxf(mprev, pm);
        SB[wave * 64 + lane] = b; SA[wave * 64 + lane] = a; SMR[wave * 64 + lane] = mrow; SIW[wave * 64 + lane] = __expf(b + mprev - mrow); }
    const unsigned lofs8 = (unsigned)((8 * g + (li >> 2)) * PT + 8 * (li & 3)), lofs4 = (unsigned)((4 * g + (li >> 2)) * PT + 8 * (li & 3));
    const unsigned vs4e = (unsigned)(size_t)Vs + lofs4 + (unsigned)(128 * eh), cb8e = (unsigned)(size_t)Cs + lofs8 + (unsigned)(128 * eh);
    f32x4 pq[4], pk[4], pv[4], og[4]; u32x4 pc[4]; float pn = 0.f, pg = 0.f;
    auto window = [&](int ci) { int r0, h, lc; mx::ch_decode(ci, r0, h, lc); const float* src = P + (size_t)r0 * C::LDP + h * C::MHD;
        const bool sample = ci >= C::NPC, first = !sample && (ci % C::NC) == 0;
#pragma unroll
        for (int q = 0; q < 4; ++q) { const int f = tid + 512 * q, row = f >> 5, c4 = f & 31;
            if (row < lc) { pq[q] = *(const f32x4*)(src + (size_t)row * C::LDP + C::O_Q + c4 * 4); pk[q] = *(const f32x4*)(src + (size_t)row * C::LDP + C::O_K + c4 * 4); pv[q] = *(const f32x4*)(src + (size_t)row * C::LDP + C::O_VM + c4 * 4); }
            else { pq[q] = (f32x4){0.f, 0.f, 0.f, 0.f}; pk[q] = pq[q]; pv[q] = pq[q]; } }
        const bf16_t* cb = wsb<C>(p, C::WS_DCB) + (size_t)(sample ? ci : (first ? ci : ci - 1)) * C::MHD * C::MHD;
#pragma unroll
        for (int q = 0; q < 4; ++q) { const int f = tid + 512 * q; pc[q] = first ? (u32x4){0u, 0u, 0u, 0u} : *(const u32x4*)(cb + (size_t)f * 8); }
        const int i = 16 * it + li;
#pragma unroll
        for (int e4 = 0; e4 < 4; ++e4) og[e4] = (it * 16 < lc) ? *(const f32x4*)(src + (size_t)i * C::LDP + C::O_O + 16 * (4 * eh + e4) + 4 * g) : (f32x4){0.f, 0.f, 0.f, 0.f};
        if (tid < C::MHD) { pn = sample ? p.in[I_SN][((size_t)l * C::NSC + (ci - C::NPC)) * C::MHD + tid] : (first ? 0.f : wsf<C>(p, C::WS_DN)[(size_t)(ci - 1) * C::MHD + tid]);
            pg = p.in[I_NG][(size_t)l * C::MW + h * C::MHD + tid]; }
        __builtin_amdgcn_sched_barrier(0); };
    if (nu > 0) window(bid);
    WG_SYNC();
#if defined(PROBE_MLC)
    unsigned long long tacc[4] = {0, 0, 0, 0}; unsigned long long tprev = wall_clock64();
#define MLC_T(j) do { const unsigned long long tn_ = wall_clock64(); tacc[j] += tn_ - tprev; tprev = tn_; } while (0)
#else
#define MLC_T(j) do { } while (0)
#endif
    for (int j = 0; j < nu; ++j) { const int ci = bid + j * gsz; int r0, h, lc; mx::ch_decode(ci, r0, h, lc);
        const LAS float* sb = SB + j * 64; const LAS float* sa = SA + j * 64; const LAS float* smr = SMR + j * 64; const LAS float* siw = SIW + j * 64;
#pragma unroll
        for (int q = 0; q < 4; ++q) { const int f = tid + 512 * q, row = f >> 5, c4 = f & 31; const float sc = 0.08838834764831845f;
            u32x2 w; w.x = pg8::cvt_pk_bf16(pq[q][0], pq[q][1]); w.y = pg8::cvt_pk_bf16(pq[q][2], pq[q][3]); *(LAS u32x2*)(Qs + row * PT + c4 * 8) = w;
            w.x = pg8::cvt_pk_bf16(pk[q][0] * sc, pk[q][1] * sc); w.y = pg8::cvt_pk_bf16(pk[q][2] * sc, pk[q][3] * sc); *(LAS u32x2*)(Ks + row * PT + c4 * 8) = w;
            w.x = pg8::cvt_pk_bf16(pv[q][0], pv[q][1]); w.y = pg8::cvt_pk_bf16(pv[q][2], pv[q][3]); *(LAS u32x2*)(Vs + row * PT + c4 * 8) = w;
            *(LAS u32x4*)(Cs + (f >> 4) * PT + (f & 15) * 16) = pc[q]; }
        if (tid < C::MHD) { snp[tid] = pn; sgn[tid] = pg; }
        f32x4 ogc[4];
#pragma unroll
        for (int e4 = 0; e4 < 4; ++e4) ogc[e4] = og[e4];
        if (j + 1 < nu) window(ci + gsz);
        WG_SYNC(); MLC_T(0);
        const bool active = it * 16 < lc; const int i = 16 * it + li;
        float ssq_part = 0.f; f32x4 hv[4];
        if (active) {
            bf16x8 qf[4];
#pragma unroll
            for (int ks = 0; ks < 4; ++ks) qf[ks] = *(const LAS bf16x8*)(Qs + i * PT + ks * 64 + g * 16);
            f32x4 st[4];
#pragma unroll
            for (int jt = 0; jt < 4; ++jt) st[jt] = (f32x4){0.f, 0.f, 0.f, 0.f};
#pragma unroll
            for (int jt = 0; jt < 4; ++jt) if (jt <= it) {
#pragma unroll
                for (int ks = 0; ks < 4; ++ks) { const bf16x8 a = *(const LAS bf16x8*)(Ks + (16 * jt + li) * PT + ks * 64 + g * 16);
                    st[jt] = __builtin_amdgcn_mfma_f32_16x16x32_bf16(a, qf[ks], st[jt], 0, 0, 0); } }
            const float bi = sb[i], mri = smr[i], iwi = siw[i];
            float dsum = 0.f;
#pragma unroll
            for (int jt = 0; jt < 4; ++jt)
#pragma unroll
                for (int r = 0; r < 4; ++r) { const int jj = 16 * jt + 4 * g + r; const float w = (jj <= i) ? __expf(bi + sa[jj] - mri) : 0.f; st[jt][r] *= w; dsum += st[jt][r]; }
            dsum += __shfl_xor(dsum, 16); dsum += __shfl_xor(dsum, 32);
            float qn = 0.f;
#pragma unroll
            for (int ks = 0; ks < 4; ++ks)
#pragma unroll
                for (int jj = 0; jj < 8; ++jj) qn += bf2f((bf16_t)qf[ks][jj]) * snp[32 * ks + 8 * g + jj];
            qn += __shfl_xor(qn, 16); qn += __shfl_xor(qn, 32);
            const float den = dsum + iwi * qn, inv_den = 1.0f / fmaxf(fabsf(den), __expf(-mri));
            bf16x8 pf[2];
#pragma unroll
            for (int t = 0; t < 2; ++t) { u32x4 w; w.x = pg8::cvt_pk_bf16(st[2 * t][0], st[2 * t][1]); w.y = pg8::cvt_pk_bf16(st[2 * t][2], st[2 * t][3]);
                w.z = pg8::cvt_pk_bf16(st[2 * t + 1][0], st[2 * t + 1][1]); w.w = pg8::cvt_pk_bf16(st[2 * t + 1][2], st[2 * t + 1][3]); pf[t] = __builtin_bit_cast(bf16x8, w); }
#pragma unroll
            for (int e2 = 0; e2 < 2; ++e2) {
                s16x4 vlo[2][2], vhi[2][2], clo[2][4], chi[2][4];
#pragma unroll
                for (int u = 0; u < 2; ++u) {
#pragma unroll
                    for (int t = 0; t < 2; ++t) { MP_TR(vlo[u][t], vs4e, (32 * t) * PT + 32 * (2 * e2 + u)); MP_TR(vhi[u][t], vs4e, (32 * t + 16) * PT + 32 * (2 * e2 + u)); }
#pragma unroll
                    for (int ks = 0; ks < 4; ++ks) { MP_TR(clo[u][ks], cb8e, (32 * ks) * PT + 32 * (2 * e2 + u)); MP_TR(chi[u][ks], cb8e, (32 * ks + 4) * PT + 32 * (2 * e2 + u)); } }
                mx::lds_wait();
#pragma unroll
                for (int u = 0; u < 2; ++u) { const int e4 = 2 * e2 + u;
                    f32x4 aS = (f32x4){0.f, 0.f, 0.f, 0.f}, aC = (f32x4){0.f, 0.f, 0.f, 0.f};
#pragma unroll
                    for (int t = 0; t < 2; ++t) aS = __builtin_amdgcn_mfma_f32_16x16x32_bf16(mx::mk8(vlo[u][t], vhi[u][t]), pf[t], aS, 0, 0, 0);
#pragma unroll
                    for (int ks = 0; ks < 4; ++ks) aC = __builtin_amdgcn_mfma_f32_16x16x32_bf16(mx::mk8(clo[u][ks], chi[u][ks]), qf[ks], aC, 0, 0, 0);
                    hv[e4] = (aS + aC * iwi) * inv_den;
                    ssq_part += (hv[e4][0] * hv[e4][0] + hv[e4][1] * hv[e4][1]) + (hv[e4][2] * hv[e4][2] + hv[e4][3] * hv[e4][3]); } }
            ssq_part += __shfl_xor(ssq_part, 16); ssq_part += __shfl_xor(ssq_part, 32);
            if (g == 0) ssq[wave * 16 + li] = ssq_part;
        }
        MLC_T(1); WG_SYNC();
        if (active) {
            const float tot = ssq_part + ssq[(wave ^ 4) * 16 + li];
            const float rs = rsqrtf(tot * (1.0f / C::MHD) + 1e-6f);
            const int row = r0 + i;
#pragma unroll
            for (int e4 = 0; e4 < 4; ++e4) { const int e = 16 * (4 * eh + e4) + 4 * g; const f32x4 gn = *(const LAS f32x4*)(sgn + e);
                float o4[4];
#pragma unroll
                for (int r = 0; r < 4; ++r) o4[r] = hv[e4][r] * rs * gn[r] * __builtin_amdgcn_rcpf(1.0f + __expf(-ogc[e4][r]));
                u32x2 w; w.x = pg8::cvt_pk_bf16(o4[0], o4[1]); w.y = pg8::cvt_pk_bf16(o4[2], o4[3]);
                *(u32x2*)(wsb<C>(p, C::WS_MIX) + (size_t)row * C::D + C::PW + C::GW + h * C::MHD + e) = w; }
        }
        MLC_T(2); WG_SYNC(); MLC_T(3);
    }
#if defined(PROBE_MLC)
    if (bid == 0 && tid == 0) { unsigned long long* TS = (unsigned long long*)(p.ws + C::WS_CTL + 32768); for (int j = 0; j < 4; ++j) TS[48 + j] += tacc[j]; }
#endif
}
}
constexpr int PH_PER_LAYER = 12, N_PHASES = 2 + PH_PER_LAYER * C::DEPTH;
struct Args { Ptrs p; int ph_lo, ph_hi; };
__global__ void __launch_bounds__(NTHREADS, 2) fwd(Args a) {
    extern __shared__ __attribute__((aligned(16))) unsigned char lds_raw[];
    LAS unsigned char* lds = (LAS unsigned char*)lds_raw;
    typedef __attribute__((address_space(4))) const Args* KArgs;
    const KArgs ka0 = (KArgs)__builtin_amdgcn_kernarg_segment_ptr();
    const int lo = a.ph_lo, hi = a.ph_hi;
#define IN(k) (lo <= (k) && (k) < hi)
#define BOTH(k) (IN(k) && IN((k) + 1))
#define GRID_BAR(k) do { if (BOTH(k)) { xcd_barrier(bar); } } while (0)
#if defined(__HIP_DEVICE_COMPILE__)
#define LOAD_PTRS KArgs ka = ka0; asm volatile("" : "+s"(ka)); Ptrs p; _Pragma("unroll") for (int i_ = 0; i_ < 33; ++i_) p.in[i_] = ka->p.in[i_]; p.out = ka->p.out; p.ws = ka->p.ws;
#else
#define LOAD_PTRS (void)ka0; const Ptrs p = a.p;
#endif
#define PHASE_ARGS LOAD_PTRS int tid = threadIdx.x; asm volatile("" : "+v"(tid)); int bid = blockIdx.x, gsz = gridDim.x; asm volatile("" : "+s"(bid), "+s"(gsz));     \
    const int lane = tid & 63, wave = __builtin_amdgcn_readfirstlane(tid >> 6); (void)lane; (void)wave; \
    const long gtid = (long)bid * NTHREADS + tid, gthreads = (long)gsz * NTHREADS; (void)gtid; (void)gthreads; \
    float* SS = wsf<C>(p, C::WS_SS); (void)SS; const float invd = 1.0f / C::D; (void)invd;
#if defined(PROBE_MASK_A)
#define STAMP(k) do { if (blockIdx.x == 0 && threadIdx.x == 0) ((unsigned long long*)(a.p.ws + C::WS_CTL + 32768))[k] = wall_clock64(); } while (0)
#else
#define STAMP(k) do { } while (0)
#endif
#define ITEMS(n, call) do { for (long it = gtid; it < (long)(n); it += gthreads) { call; } } while (0)
#define SSL(j) (SS + (size_t)(4 * l + (j)) * C::M)
#define GEMM_ALL(STRIP, EPI, Aop, Bop, Mr, Nc, Kd, ...) do { pg8::Gemm g{Aop, Bop, Mr, Nc, Kd, Kd}; pg8::StaticOrder S; S.init(Mr, Nc, gsz, bid, (STRIP) ? 288 : 256); \
        pg8::EPI E{__VA_ARGS__}; pg8::gemm_phase<pg8::EPI, pg8::StaticOrder, STRIP, false>(lds, g, S, E, nullptr); } while (0)
#if ONE_LAUNCH
    if (threadIdx.x < 4) ((LAS unsigned*)(lds + LDS_CTL))[threadIdx.x] = 0u;
    __syncthreads();
    XcdBarrier bar = xcd_barrier_post((unsigned*)(a.p.ws + C::WS_CTL), (volatile LAS unsigned*)(lds + LDS_CTL));
#else
    XcdBarrier bar; bar.bar = nullptr; bar.x = 0; bar.st = nullptr;
#endif

    if (IN(0)) { PHASE_ARGS STAMP(0);
        const int gw = bid * NWAVES + wave, NGW = gsz * NWAVES;
        { int wl = 0, widx = 0, base = 0; WDesc d = wdesc(p, 0, 0); int nitems = (d.K / 64) * (d.N / 64);
          for (int git = gw; wl < C::DEPTH; git += NGW) {
              while (wl < C::DEPTH && git >= base + nitems) { base += nitems; if (++widx == 10) { widx = 0; ++wl; } if (wl < C::DEPTH) { d = wdesc(p, wl, widx); nitems = (d.K / 64) * (d.N / 64); } }
              if (wl < C::DEPTH) prep_item(d.W, d.K, d.Ncols, d.g, d.kind, d.N, d.dst, lds + wave * 9216, git - base, lane); } }
        rw::rows_init(p, tid, bid, gsz);
        GRID_BAR(0);
    }
    for (int l = 0; l < C::DEPTH; ++l) {
        const int pb = 1 + PH_PER_LAYER * l;
        if (IN(pb + 0)) { PHASE_ARGS STAMP(pb + 0);
#if defined(PROBE_GST)
            if (l == 0) { pg8::Gemm g{wsb<C>(p, C::WS_XB), wlayer<C>(p, l, C::W_1IN), C::M, 2 * C::FF, C::D, C::D}; pg8::StaticOrder S; S.init(C::M, 2 * C::FF, gsz, bid, 288);
                pg8::EpiSwiGLU E{wsb<C>(p, C::WS_BIG), SSL(0), C::FF, invd}; pg8::gemm_phase<pg8::EpiSwiGLU, pg8::StaticOrder, true, true>(lds, g, S, E, (unsigned long long*)(p.ws + C::WS_END) + (size_t)bid * 64); } else
#endif
            GEMM_ALL(true, EpiSwiGLU, wsb<C>(p, C::WS_XB), wlayer<C>(p, l, C::W_1IN), C::M, 2 * C::FF, C::D, wsb<C>(p, C::WS_BIG), SSL(0), C::FF, invd);
            GRID_BAR(pb + 0); }
        if (IN(pb + 1)) { PHASE_ARGS STAMP(pb + 1);
            GEMM_ALL(true, EpiResid, wsb<C>(p, C::WS_BIG), wlayer<C>(p, l, C::W_1OUT), C::M, C::D, C::FF, wsf<C>(p, C::WS_X), wsb<C>(p, C::WS_XB), SSL(1), 0.5f, C::D);
            GRID_BAR(pb + 1); }
        if (IN(pb + 2)) { PHASE_ARGS STAMP(pb + 2);
            GEMM_ALL(true, EpiScaleF32, wsb<C>(p, C::WS_XB), wlayer<C>(p, l, C::W_IN), C::M, C::LDP, C::D, wsf<C>(p, C::WS_BIG), C::LDP, SSL(1), invd);
            GRID_BAR(pb + 2); }
        if (IN(pb + 3)) { PHASE_ARGS STAMP(pb + 3); mp::ml_a(lds, p, l, tid, bid, gsz);
#if defined(PROBE_MIXA)
            xcd_barrier(bar); STAMP(40 + l);
#endif
            gp::gmlp_phase(lds, p, l, tid, gsz - 1 - bid, gsz);
#if defined(PROBE_MIXA)
            xcd_barrier(bar); STAMP(42 + l);
#endif
            GRID_BAR(pb + 3); }
        if (IN(pb + 4)) { PHASE_ARGS STAMP(pb + 4);
            if (bid < 64) {
                pg8::Gemm g{wsb<C>(p, C::WS_MEMB), wlayer<C>(p, l, C::W_KV), C::MM, 2 * C::D, C::D, C::D}; pg8::StaticOrder S; S.init(C::MM, 2 * C::D, 64, bid);
                pg8::EpiMemKV E{p.out + C::OUT_MK + (size_t)l * C::MM * C::D, p.out + C::OUT_MV + (size_t)l * C::MM * C::D, wsf<C>(p, C::WS_RSTDM), C::D, wsb<C>(p, C::WS_KVB), C::MM};
                pg8::gemm_phase<pg8::EpiMemKV, pg8::StaticOrder, false, false>(lds, g, S, E, nullptr);
            } else { mp::ml_scan(p, l, (long)(bid - 64) * NTHREADS + tid, (long)(gsz - 64) * NTHREADS); gp::pool_phase(lds, p, l, tid, gsz - 1 - bid, gsz - 64); }
            GRID_BAR(pb + 4); }
        if (IN(pb + 5)) { PHASE_ARGS STAMP(pb + 5); mp::ml_c(lds, p, l, tid, bid, gsz); GRID_BAR(pb + 5); }
        if (IN(pb + 6)) { PHASE_ARGS STAMP(pb + 6);
            GEMM_ALL(true, EpiResid, wsb<C>(p, C::WS_MIX), wlayer<C>(p, l, C::W_OUT), C::M, C::D, C::D, wsf<C>(p, C::WS_X), wsb<C>(p, C::WS_XB), SSL(2), 1.0f, C::D);
            GRID_BAR(pb + 6); }
        if (IN(pb + 7)) { PHASE_ARGS STAMP(pb + 7);
            GEMM_ALL(true, EpiScaleBf16, wsb<C>(p, C::WS_XB), wlayer<C>(p, l, C::W_Q), C::M, C::D, C::D, wsb<C>(p, C::WS_Q), C::D, SSL(2), invd);
            GRID_BAR(pb + 7); }
        if (IN(pb + 8)) { PHASE_ARGS STAMP(pb + 8);
            if (bid < 128) att::attn_phase(lds, p, l, tid, bid, 128, 128);
            else att::attn_sample_phase(lds, p, l, tid, bid - 128, gsz - 128);
            GRID_BAR(pb + 8); }
        if (IN(pb + 9)) { PHASE_ARGS STAMP(pb + 9);
            GEMM_ALL(true, EpiResid, wsb<C>(p, C::WS_AO), wlayer<C>(p, l, C::W_O), C::M, C::D, C::D, wsf<C>(p, C::WS_X), wsb<C>(p, C::WS_XB), SSL(3), 1.0f, C::D);
            GRID_BAR(pb + 9); }
        if (IN(pb + 10)) { PHASE_ARGS STAMP(pb + 10);
            GEMM_ALL(true, EpiSwiGLU, wsb<C>(p, C::WS_XB), wlayer<C>(p, l, C::W_2IN), C::M, 2 * C::FF, C::D, wsb<C>(p, C::WS_BIG), SSL(3), C::FF, invd);
            GRID_BAR(pb + 10); }
        if (IN(pb + 11)) { PHASE_ARGS STAMP(pb + 11);
            GEMM_ALL(true, EpiResid, wsb<C>(p, C::WS_BIG), wlayer<C>(p, l, C::W_2OUT), C::M, C::D, C::FF, wsf<C>(p, C::WS_X), wsb<C>(p, C::WS_XB), SSL(4), 0.5f, C::D);
            GRID_BAR(pb + 11); }
    }
    if (IN(N_PHASES - 1)) { PHASE_ARGS STAMP(N_PHASES - 1); __syncthreads(); rw::rows_final(p, tid, bid, gsz); }
#undef IN
#undef BOTH
#undef GRID_BAR
#undef ITEMS
#undef PHASE_ARGS
#undef SSL
}

extern "C" void kernel_launch(void* const* d_in, const int* in_sizes, int n_in, void* d_out, int out_size, void* d_ws, size_t ws_size, hipStream_t stream) {
    static int ready = 0;
    if (!ready) {
        if (n_in != 33 || (long)out_size != (long)C::OUT_END || ws_size < (size_t)C::WS_END) { fprintf(stderr, "kernel_launch: unexpected shapes: n_in %d out %d ws %zu (need %zu)\n", n_in, out_size, ws_size, (size_t)C::WS_END); ready = -1; return; }
        if (hipFuncSetAttribute((const void*)fwd, hipFuncAttributeMaxDynamicSharedMemorySize, LDS_BYTES) != hipSuccess) { fprintf(stderr, "kernel_launch: hipFuncSetAttribute failed\n"); ready = -1; return; }
        int dev = 0, cus = 0, per_cu = 0;
        if (hipGetDevice(&dev) != hipSuccess || hipDeviceGetAttribute(&cus, hipDeviceAttributeMultiprocessorCount, dev) != hipSuccess) { fprintf(stderr, "kernel_launch: device query failed\n"); ready = -1; return; }
        if (hipOccupancyMaxActiveBlocksPerMultiprocessor(&per_cu, (const void*)fwd, NTHREADS, LDS_BYTES) != hipSuccess || per_cu < 1) { fprintf(stderr, "kernel_launch: occupancy query reports %d blocks per CU\n", per_cu); (void)hipGetLastError(); per_cu = 1; }
        if (cus != 256) { fprintf(stderr, "kernel_launch: built for a 256-CU device (one resident workgroup per CU), found %d\n", cus); ready = -1; return; }
        ready = cus;
    }
    if (ready < 0) return;
    Args a{};
    for (int i = 0; i < 33; ++i) a.p.in[i] = (const float*)d_in[i];
    a.p.out = (float*)d_out; a.p.ws = (unsigned char*)d_ws;
#if ONE_LAUNCH
    (void)hipMemsetAsync((char*)d_ws + C::WS_CTL, 0, 65536, stream);
    a.ph_lo = 0; a.ph_hi = N_PHASES;
    hipLaunchKernelGGL(fwd, dim3(ready), dim3(NTHREADS), LDS_BYTES, stream, a);
#else
    for (int k = 0; k < N_PHASES; ++k) { a.ph_lo = k; a.ph_hi = k + 1; hipLaunchKernelGGL(fwd, dim3(ready), dim3(NTHREADS), LDS_BYTES, stream, a); }
#endif
}
```

```cpp
#include <hip/hip_runtime.h>
#include <cstdio>
#define ONE_LAUNCH 1

#define HD __host__ __device__
#ifndef HD
#define HD __host__ __device__
#endif
typedef unsigned short bf16_t;
HD inline unsigned f2u(float f) { return __builtin_bit_cast(unsigned, f); }
HD inline float u2f(unsigned u) { return __builtin_bit_cast(float, u); }
HD inline bf16_t f2bf(float f) { unsigned u = f2u(f); u += 0x7FFFu + ((u >> 16) & 1u); return (bf16_t)(u >> 16); }
HD inline float bf2f(bf16_t b) { return u2f(((unsigned)b) << 16); }

struct RC {
    static constexpr int D = 2048, FF = 8192, BATCH = 4, SEQ = 2048, DEPTH = 2, DEC_BATCH = 32, DEC_SEQ = 32, PAST = 2048, NMEM = 256;
};
template <class B> struct CfgT : B {
    using B::D; using B::FF; using B::BATCH; using B::SEQ; using B::DEPTH; using B::DEC_BATCH; using B::DEC_SEQ; using B::PAST; using B::NMEM;
    static constexpr int MP = BATCH * SEQ, MS = DEC_BATCH * DEC_SEQ, M = MP + MS, MM = BATCH * NMEM;
    static constexpr int PW = D / 4, PG = 4, PGD = PW / 4, PH = 15;
    static constexpr int GW = D / 4, GH = 4, GHD = GW / 4, GCH = 128;
    static constexpr int MW = D - PW - GW, MH = 8, MHD = MW / 8, CH = 64;
    static constexpr int INC = PW + 2 * GW + 4 * MW + 2 * MH;
    static constexpr int LDP = ((INC + 255) / 256) * 256;
    static constexpr int AH = 4, AHD = D / 4;
    static constexpr int O_U = PW, O_V = PW + GW, O_Q = PW + 2 * GW, O_K = O_Q + MW, O_VM = O_K + MW, O_O = O_VM + MW, O_IG = O_O + MW, O_FG = O_IG + MH;
    static constexpr int NC = SEQ / CH, NPC = BATCH * MH * NC, NSC = DEC_BATCH * MH, NCH = NPC + NSC;
    static constexpr int LCS = DEC_SEQ < CH ? DEC_SEQ : CH;
    static constexpr int GLP = SEQ < GCH ? SEQ : GCH, GLS = DEC_SEQ < GCH ? DEC_SEQ : GCH;
    static constexpr int NSS = 1 + 4 * DEPTH;
    static constexpr long OUT_YP = 0, OUT_YS = OUT_YP + (long)MP * D, OUT_POOLP = OUT_YS + (long)MS * D, OUT_POOLS = OUT_POOLP + (long)DEPTH * BATCH * PH * PW,
        OUT_CP = OUT_POOLS + (long)DEPTH * DEC_BATCH * PH * PW, OUT_NP = OUT_CP + (long)DEPTH * BATCH * MH * MHD * MHD, OUT_MP = OUT_NP + (long)DEPTH * BATCH * MH * MHD,
        OUT_CS = OUT_MP + (long)DEPTH * BATCH * MH, OUT_NS = OUT_CS + (long)DEPTH * DEC_BATCH * MH * MHD * MHD, OUT_MS = OUT_NS + (long)DEPTH * DEC_BATCH * MH * MHD,
        OUT_VS = OUT_MS + (long)DEPTH * DEC_BATCH * MH, OUT_MK = OUT_VS + (long)DEPTH * DEC_BATCH * DEC_SEQ * GW, OUT_MV = OUT_MK + (long)DEPTH * BATCH * NMEM * D,
        OUT_END = OUT_MV + (long)DEPTH * BATCH * NMEM * D;
    static constexpr size_t al(size_t x) { return (x + 255) & ~(size_t)255; }
    static constexpr size_t WS_CTL = 0, WS_SS = 65536, WS_X = al(WS_SS + (size_t)NSS * M * 4), WS_XB = al(WS_X + (size_t)M * D * 4),
        WS_BIG = al(WS_XB + (size_t)M * D * 2),
        WS_BIG_SZ = ((size_t)M * FF * 2 > (size_t)M * LDP * 4) ? (size_t)M * FF * 2 : (size_t)M * LDP * 4,
        WS_MIX = al(WS_BIG + WS_BIG_SZ), WS_Q = al(WS_MIX + (size_t)M * D * 2), WS_AO = al(WS_Q + (size_t)M * D * 2),
        WS_MEMB = al(WS_AO + (size_t)M * D * 2), WS_RSTDM = al(WS_MEMB + (size_t)MM * D * 2),
        WS_GB = al(WS_RSTDM + (size_t)MM * 4), WS_GA = al(WS_GB + (size_t)M * MH * 4),
        WS_CBL = al(WS_GA + (size_t)M * MH * 4), WS_CML = al(WS_CBL + (size_t)NCH * 4), WS_MPREV = al(WS_CML + (size_t)NCH * 4),
        WS_DC = al(WS_MPREV + (size_t)NCH * 4), WS_DN = al(WS_DC + (size_t)NCH * MHD * MHD * 4),
        WS_DCB = al(WS_DN + (size_t)NCH * MHD * 4),
        WS_W = al(WS_DCB + (size_t)NCH * MHD * MHD * 2);
    static constexpr size_t W_1IN = 0, W_1OUT = W_1IN + (size_t)2 * FF * D, W_IN = W_1OUT + (size_t)D * FF, W_OUT = W_IN + (size_t)LDP * D, W_Q = W_OUT + (size_t)D * D,
        W_KV = W_Q + (size_t)D * D, W_O = W_KV + (size_t)2 * D * D, W_2IN = W_O + (size_t)D * D, W_2OUT = W_2IN + (size_t)2 * FF * D, W_LAYER = W_2OUT + (size_t)D * FF;
    static constexpr size_t WS_KVB = al(WS_W + (size_t)DEPTH * W_LAYER * 2);
    static constexpr size_t WS_END = al(WS_KVB + (size_t)2 * MM * D * 2);
};

struct Ptrs { const float* in[33]; float* out; unsigned char* ws; };
enum { I_XP = 0, I_XS, I_MEM, I_SPOOL, I_SC, I_SN, I_SM, I_CK, I_CV, I_GFFN1, I_W1IN, I_W1OUT, I_GMIX, I_WIN, I_POOLW, I_POOLS, I_GVG, I_GWS, I_GBS, I_IB, I_FB, I_NG, I_WOUT,
       I_GX, I_GMEM, I_WQ, I_WK, I_WV, I_WO, I_GFFN2, I_W2IN, I_W2OUT, I_GFIN };

template <class C> HD inline float* wsf(const Ptrs& p, size_t off) { return (float*)(p.ws + off); }
template <class C> HD inline bf16_t* wsb(const Ptrs& p, size_t off) { return (bf16_t*)(p.ws + off); }
template <class C> HD inline bf16_t* wlayer(const Ptrs& p, int l, size_t off) { return (bf16_t*)(p.ws + C::WS_W) + (size_t)l * C::W_LAYER + off; }

template <class C> HD inline void row_info(int r, bool& s, int& b, int& t) {
    if (r < C::MP) { s = false; b = r / C::SEQ; t = r % C::SEQ; } else { s = true; const int q = r - C::MP; b = q / C::DEC_SEQ; t = q % C::DEC_SEQ; }
}
template <class C> HD inline void chunk_info(int r, int h, int& ci, int& i, int& lc) {
    bool s; int b, t; row_info<C>(r, s, b, t);
    if (!s) { ci = (b * C::MH + h) * C::NC + t / C::CH; i = t % C::CH; lc = C::CH; } else { ci = C::NPC + b * C::MH + h; i = t; lc = C::LCS; }
}
HD inline float sigmoidf_(float x) { return 1.0f / (1.0f + expf(-x)); }
HD inline float logsigmoidf_(float x) { return x >= 0.f ? -log1pf(expf(-x)) : x - log1pf(expf(x)); }

enum { WK_PLAIN = 0, WK_FFNIN = 1, WK_WIN = 2 };
template <class C> HD inline int wsrc_col(int kind, int n) {
    if (kind == WK_FFNIN) { const int pn = n >> 8, j = n & 255; return j < 128 ? 128 * pn + j : C::FF + 128 * pn + (j - 128); }
    if (kind == WK_WIN) return n < C::INC ? n : -1;
    return n;
}

template <class C> HD inline void st_ml_b0(const Ptrs& p, int l, int sq) {
    const float* CBL = wsf<C>(p, C::WS_CBL); const float* CML = wsf<C>(p, C::WS_CML); float* MPREV = wsf<C>(p, C::WS_MPREV);
    if (sq < C::BATCH * C::MH) { float m = 0.f;
        for (int c = 0; c < C::NC; ++c) { const int ci = sq * C::NC + c; MPREV[ci] = m; const float a = CBL[ci] + m, b2 = CML[ci]; m = a > b2 ? a : b2; }
        p.out[C::OUT_MP + (size_t)l * C::BATCH * C::MH + sq] = m;
    } else { const int q = sq - C::BATCH * C::MH, ci = C::NPC + q; const float m0 = p.in[I_SM][(size_t)l * C::DEC_BATCH * C::MH + q];
        MPREV[ci] = m0; const float a = CBL[ci] + m0, b2 = CML[ci]; p.out[C::OUT_MS + (size_t)l * C::DEC_BATCH * C::MH + q] = a > b2 ? a : b2; }
}

namespace pg8 {
#define PG8_LAS __attribute__((address_space(3)))
typedef unsigned short bf16_t;
typedef short bf16x8 __attribute__((ext_vector_type(8)));
typedef float f32x4 __attribute__((ext_vector_type(4)));
typedef unsigned u32x4 __attribute__((ext_vector_type(4)));
constexpr int BM = 256, BK = 64, HALF = 128, HTB = HALF * BK * 2  , STAGE_BYTES = 8 * HTB, NXCD = 8, WGM = 8;

__host__ __device__ __forceinline__ int lds_byte(int r, int c) { const int st = (r >> 4) * 2 + (c >> 5), rr = r & 15, cc = c & 31, ob = rr * 64 + cc * 2; return st * 1024 + (ob ^ (((ob >> 9) & 1) << 5)); }
__host__ __device__ __forceinline__ void stage_rc(int b, int& R, int& C) { const int st = b / 1024, sb = b % 1024, swz = sb ^ (((sb >> 9) & 1) << 5); R = (st >> 1) * 16 + swz / 64; C = (st & 1) * 32 + (swz % 64) / 2; }
__host__ __device__ __forceinline__ int perm32(int rho) { const int n = rho >> 4, i = rho & 15; return 8 * (i >> 2) + 4 * n + (i & 3); }

struct Unit { int pm, pn; };
struct Gemm { const bf16_t* A; const bf16_t* Bt; int M, N, K, ld; };

struct StaticOrder {
    int nM, nN, nwg, G, c;
    __host__ __device__ __forceinline__ void init(int M, int N, int G_, int c_, int rows_per_tile = BM) { nM = M / rows_per_tile; nN = N / BM; nwg = nM * nN; G = G_; c = c_; }
    __host__ __device__ __forceinline__ bool next(int i, Unit& u) const {
        const long L = (long)i * G + c; if (L >= nwg) return false;
        int wgid = (int)L; { const int q = nwg / NXCD, r = nwg % NXCD, xcd = wgid % NXCD, off = wgid / NXCD; wgid = (xcd < r ? xcd * (q + 1) : r * (q + 1) + (xcd - r) * q) + off; }
        const int nig = WGM * nN, gid = wgid / nig, fm = gid * WGM, gsz = (nM - fm) < WGM ? (nM - fm) : WGM;
        u.pm = fm + ((wgid % nig) % gsz); u.pn = (wgid % nig) / gsz; return true;
    }
    __device__ __forceinline__ void a_ready(const Unit&) const {}
    __device__ __forceinline__ void done(const Unit&) const {}
};
__device__ __forceinline__ unsigned cvt_pk_bf16(float lo, float hi) { unsigned r; asm volatile("v_cvt_pk_bf16_f32 %0, %1, %2" : "=v"(r) : "v"(lo), "v"(hi)); return r; }
typedef float f32x2 __attribute__((ext_vector_type(2)));
template <class Epi, class Sched, bool STRIP = false, bool STAMP = false>
__device__ __forceinline__ void gemm_phase(PG8_LAS unsigned char* lds, const Gemm g, const Sched& S, const Epi& E, unsigned long long* stamps) {
    int tid_l = threadIdx.x; asm volatile("" : "+v"(tid_l));
    const int tid = tid_l, wid = __builtin_amdgcn_readfirstlane(tid >> 6), lane = tid & 63, wr = wid >> 2, wc = wid & 3, fr = lane & 15, fq = lane >> 4;
    const int K = g.K, nt = K / BK;
    int ts_lo = 0, ts_hi = 0, nts = 0; const unsigned long long rt_entry = STAMP ? (unsigned long long)wall_clock64() : 0ull;
#define PG8_STAMP() do { if (STAMP && wid == 0 && nts < 64) { const unsigned long long _c = (unsigned long long)clock64(); \
        ts_lo = (lane == nts) ? (int)(unsigned)_c : ts_lo; ts_hi = (lane == nts) ? (int)(unsigned)(_c >> 32) : ts_hi; ++nts; } } while (0)
    PG8_STAMP();
    unsigned voffA[2], voffB[2];
#pragma unroll
    for (int i = 0; i < 2; ++i) { int R, C; stage_rc(tid * 16 + i * 8192, R, C); const int Rb = Epi::PERM ? ((R & ~31) + perm32(R & 31)) : R;
        voffA[i] = (unsigned)(R * g.ld + C) * 2u; voffB[i] = (unsigned)(Rb * g.ld + C) * 2u; }
    const size_t kstep = (size_t)(BK * 2);
    const size_t hstep = (size_t)HALF * g.ld * 2;
    const size_t tstep = 2 * hstep;
    const size_t tstepA = STRIP ? (size_t)288 * g.ld * 2 : tstep;
    unsigned voffS = 0u; if constexpr (STRIP) { int R, C; stage_rc((wid & 3) * 1024 + lane * 16, R, C); voffS = (unsigned)(R * g.ld + C) * 2u; }
    const int soff = lds_byte(wr * 16 + fr, fq * 8);
    const unsigned ldsw = (unsigned)wid * 1024u;
    const int aoff = lds_byte(wr * 64 + fr, fq * 8), boff = lds_byte(wc * 32 + fr, fq * 8);
#define PG8_SA(b, h) (((b) * 2 + (h)) * HTB)
#define PG8_SB(b, h) ((4 + (b) * 2 + (h)) * HTB)
#define PG8_SS(b) (8 * HTB + (b) * 8192)
#define PG8_STAGE_S(b, gbase) do { if constexpr (STRIP) __builtin_amdgcn_global_load_lds((const unsigned*)((const char*)(gbase) + 2 * hstep + voffS), (PG8_LAS unsigned*)(lds + PG8_SS(b) + ldsw), 16, 0, 0); } while (0)
#define PG8_LDS(b) do { if constexpr (STRIP) { _Pragma("unroll") for (int k = 0; k < 2; ++k) Sf[k] = *(const PG8_LAS bf16x8*)(lds + PG8_SS(b) + soff + k * 1024); } } while (0)
#define PG8_MMS(bj, Bt) do { if constexpr (STRIP) { __builtin_amdgcn_s_setprio(1); _Pragma("unroll") for (int n = 0; n < 2; ++n) _Pragma("unroll") for (int k = 0; k < 2; ++k) accS[bj][n] = __builtin_amdgcn_mfma_f32_16x16x32_bf16(Bt[n][k], Sf[k], accS[bj][n], 0, 0, 0); __builtin_amdgcn_s_setprio(0); } } while (0)
#define PG8_STAGE(bufoff, gbase, voff) do { _Pragma("unroll") for (int _i = 0; _i < 2; ++_i) \
        __builtin_amdgcn_global_load_lds((const unsigned*)((const char*)(gbase) + (voff)[_i]), (PG8_LAS unsigned*)(lds + (bufoff) + ldsw + _i * 8192), 16, 0, 0); } while (0)
#define PG8_LDA(dst, b, h) do { _Pragma("unroll") for (int m = 0; m < 4; ++m) _Pragma("unroll") for (int k = 0; k < 2; ++k) dst[m][k] = *(const PG8_LAS bf16x8*)(lds + PG8_SA(b, h) + aoff + m * 2048 + k * 1024); } while (0)
#define PG8_LDB(dst, b, h) do { _Pragma("unroll") for (int n = 0; n < 2; ++n) _Pragma("unroll") for (int k = 0; k < 2; ++k) dst[n][k] = *(const PG8_LAS bf16x8*)(lds + PG8_SB(b, h) + boff + n * 2048 + k * 1024); } while (0)
#define PG8_MMA(ai, bj, At, Bt) do { __builtin_amdgcn_s_setprio(1); _Pragma("unroll") for (int m = 0; m < 4; ++m) _Pragma("unroll") for (int n = 0; n < 2; ++n) _Pragma("unroll") for (int k = 0; k < 2; ++k) \
        acc[ai][bj][m][n] = __builtin_amdgcn_mfma_f32_16x16x32_bf16(Bt[n][k], At[m][k], acc[ai][bj][m][n], 0, 0, 0); __builtin_amdgcn_s_setprio(0); } while (0)
#define PG8_WAIT_V(n) asm volatile("s_waitcnt vmcnt(" #n ")" ::: "memory")
#define PG8_WAIT_L(n) asm volatile("s_waitcnt lgkmcnt(" #n ")" ::: "memory")
#define PG8_WAIT_VS(n, ns) do { if constexpr (STRIP) PG8_WAIT_V(ns); else PG8_WAIT_V(n); } while (0)
#define PG8_WAIT_LS(n, ns) do { if constexpr (STRIP) PG8_WAIT_L(ns); else PG8_WAIT_L(n); } while (0)
#define PG8_BAR __builtin_amdgcn_s_barrier()
#define PG8_SCHED __builtin_amdgcn_sched_barrier(0)
    Unit cur, nxt; int ui = 0;
    if (!S.next(0, cur)) return;
    f32x4 acc[2][2][4][2];
#pragma unroll
    for (int a = 0; a < 2; ++a)
#pragma unroll
        for (int b = 0; b < 2; ++b)
#pragma unroll
            for (int m = 0; m < 4; ++m)
#pragma unroll
                for (int n = 0; n < 2; ++n) acc[a][b][m][n] = (f32x4){0.f, 0.f, 0.f, 0.f};
    bf16x8 At[4][2], B0[2][2], B1[2][2];
    f32x4 accS[2][2]; bf16x8 Sf[2];
#pragma unroll
    for (int b = 0; b < 2; ++b)
#pragma unroll
        for (int n = 0; n < 2; ++n) accS[b][n] = (f32x4){0.f, 0.f, 0.f, 0.f};
#pragma unroll
    for (int k = 0; k < 2; ++k) Sf[k] = (bf16x8){0, 0, 0, 0, 0, 0, 0, 0};
    const char* cA = (const char*)g.A + (size_t)cur.pm * tstepA; const char* cB = (const char*)g.Bt + (size_t)cur.pn * tstep;
    S.a_ready(cur);
    PG8_STAGE(PG8_SB(0, 0), cB, voffB); PG8_STAGE(PG8_SA(0, 0), cA, voffA); PG8_STAGE(PG8_SB(0, 1), cB + hstep, voffB); PG8_STAGE(PG8_SA(0, 1), cA + hstep, voffA); PG8_STAGE_S(0, cA);
    if (wr == 1) PG8_BAR;
    PG8_WAIT_VS(4, 5); PG8_BAR;
    PG8_STAGE(PG8_SB(1, 0), cB + kstep, voffB); PG8_STAGE(PG8_SA(1, 0), cA + kstep, voffA); PG8_STAGE(PG8_SB(1, 1), cB + hstep + kstep, voffB); PG8_STAGE_S(1, cA + kstep);
    PG8_WAIT_VS(6, 7); PG8_BAR;
    PG8_STAMP();
    for (;;) {
        const bool has_next = S.next(ui + 1, nxt);
        const char* nA = has_next ? (const char*)g.A + (size_t)nxt.pm * tstepA : cA; const char* nB = has_next ? (const char*)g.Bt + (size_t)nxt.pn * tstep : cB;
        for (int t = 0; t < nt; t += 2) {
            const bool last = (t == nt - 2);
            const char* a1 = cA + (size_t)(t + 1) * kstep;
            const char* a2 = last ? nA : cA + (size_t)(t + 2) * kstep; const char* b2 = last ? nB : cB + (size_t)(t + 2) * kstep;
            const char* a3 = a2 + kstep; const char* b3 = b2 + kstep;
            if (last && has_next) S.a_ready(nxt);
            PG8_LDB(B0, 0, 0); PG8_SCHED; PG8_LDA(At, 0, 0); PG8_LDS(0); PG8_STAGE(PG8_SA(1, 1), a1 + hstep, voffA);
            PG8_WAIT_LS(8, 10); PG8_BAR; PG8_WAIT_L(0); PG8_MMA(0, 0, At, B0); PG8_MMS(0, B0); PG8_BAR; PG8_SCHED;
            PG8_LDB(B1, 0, 1); PG8_STAGE(PG8_SB(0, 0), b2, voffB);
            PG8_BAR; PG8_WAIT_L(0); PG8_MMA(0, 1, At, B1); PG8_MMS(1, B1); PG8_BAR;
            PG8_LDA(At, 0, 1); PG8_STAGE(PG8_SA(0, 0), a2, voffA); PG8_STAGE_S(0, a2);
            PG8_BAR; PG8_WAIT_L(0); PG8_MMA(1, 0, At, B0); PG8_BAR; PG8_SCHED;
            PG8_STAGE(PG8_SB(0, 1), b2 + hstep, voffB);
            PG8_WAIT_VS(6, 7); PG8_BAR; PG8_MMA(1, 1, At, B1); PG8_BAR;
            PG8_LDB(B0, 1, 0); PG8_SCHED; PG8_LDA(At, 1, 0); PG8_LDS(1); PG8_STAGE(PG8_SA(0, 1), a2 + hstep, voffA);
            PG8_WAIT_LS(8, 10); PG8_BAR; PG8_WAIT_L(0); PG8_MMA(0, 0, At, B0); PG8_MMS(0, B0); PG8_BAR; PG8_SCHED;
            PG8_LDB(B1, 1, 1); PG8_STAGE(PG8_SB(1, 0), b3, voffB);
            PG8_BAR; PG8_WAIT_L(0); PG8_MMA(0, 1, At, B1); PG8_MMS(1, B1); PG8_BAR;
            PG8_LDA(At, 1, 1); PG8_STAGE(PG8_SA(1, 0), a3, voffA); PG8_STAGE_S(1, a3);
            PG8_BAR; PG8_WAIT_L(0); PG8_MMA(1, 0, At, B0); PG8_BAR; PG8_SCHED;
            PG8_STAGE(PG8_SB(1, 1), b3 + hstep, voffB);
            PG8_WAIT_VS(6, 7); PG8_BAR; PG8_MMA(1, 1, At, B1); PG8_BAR;
        }
        PG8_STAMP();
        { const int rt0 = cur.pm * (STRIP ? 288 : 256), rw0 = rt0 + wr * 64 + fr;
#define PG8_RV(ai, m) {{acc[ai][0][m][0], acc[ai][0][m][1]}, {acc[ai][1][m][0], acc[ai][1][m][1]}}
#define PG8_BATCH(r0_, v0_, r1_, v1_) do { const typename Epi::Pre p0_ = E.pre(r0_, cur.pn, wc, fq), p1_ = E.pre(r1_, cur.pn, wc, fq); \
              { const f32x4 v_[2][2] = v0_; E.row(v_, p0_, r0_, cur.pn, wc, fq); } { const f32x4 v_[2][2] = v1_; E.row(v_, p1_, r1_, cur.pn, wc, fq); } } while (0)
          if constexpr (Epi::PRE_ALL) {
              typename Epi::Pre pa_[9];
#pragma unroll
              for (int q_ = 0; q_ < 8; ++q_) pa_[q_] = E.pre(rw0 + (q_ >> 2) * HALF + (q_ & 3) * 16, cur.pn, wc, fq);
              pa_[8] = STRIP ? E.pre(rt0 + 256 + wr * 16 + fr, cur.pn, wc, fq) : pa_[0];
#define PG8_ONE(q_, ai, m) { const f32x4 v_[2][2] = PG8_RV(ai, m); E.row(v_, pa_[q_], rw0 + ai * HALF + m * 16, cur.pn, wc, fq); }
              PG8_ONE(0, 0, 0) PG8_ONE(1, 0, 1) PG8_ONE(2, 0, 2) PG8_ONE(3, 0, 3) PG8_ONE(4, 1, 0) PG8_ONE(5, 1, 1) PG8_ONE(6, 1, 2) PG8_ONE(7, 1, 3)
#undef PG8_ONE
              if constexpr (STRIP) E.row(accS, pa_[8], rt0 + 256 + wr * 16 + fr, cur.pn, wc, fq);
#if defined(PROBE_EPI2)
              asm volatile("" ::: "memory");
#pragma unroll
              for (int q_ = 0; q_ < 8; ++q_) pa_[q_] = E.pre(rw0 + (q_ >> 2) * HALF + (q_ & 3) * 16, cur.pn, wc, fq);
              pa_[8] = STRIP ? E.pre(rt0 + 256 + wr * 16 + fr, cur.pn, wc, fq) : pa_[0];
#define PG8_ONE(q_, ai, m) { const f32x4 v_[2][2] = PG8_RV(ai, m); E.row(v_, pa_[q_], rw0 + ai * HALF + m * 16, cur.pn, wc, fq); }
              PG8_ONE(0, 0, 0) PG8_ONE(1, 0, 1) PG8_ONE(2, 0, 2) PG8_ONE(3, 0, 3) PG8_ONE(4, 1, 0) PG8_ONE(5, 1, 1) PG8_ONE(6, 1, 2) PG8_ONE(7, 1, 3)
#undef PG8_ONE
              if constexpr (STRIP) E.row(accS, pa_[8], rt0 + 256 + wr * 16 + fr, cur.pn, wc, fq);
#endif
          } else {
          PG8_BATCH(rw0, PG8_RV(0, 0), rw0 + 16, PG8_RV(0, 1));
          PG8_BATCH(rw0 + 32, PG8_RV(0, 2), rw0 + 48, PG8_RV(0, 3));
          PG8_BATCH(rw0 + HALF, PG8_RV(1, 0), rw0 + HALF + 16, PG8_RV(1, 1));
          PG8_BATCH(rw0 + HALF + 32, PG8_RV(1, 2), rw0 + HALF + 48, PG8_RV(1, 3));
          if constexpr (STRIP) { const int rs_ = rt0 + 256 + wr * 16 + fr; const typename Epi::Pre ps_ = E.pre(rs_, cur.pn, wc, fq); E.row(accS, ps_, rs_, cur.pn, wc, fq); }
          }
          if constexpr (STRIP) {
#pragma unroll
              for (int b = 0; b < 2; ++b)
#pragma unroll
                for (int n = 0; n < 2; ++n) accS[b][n] = (f32x4){0.f, 0.f, 0.f, 0.f}; }
#undef PG8_BATCH
#undef PG8_RV
          S.done(cur); }
        PG8_STAMP();
        if (!has_next) break;
#pragma unroll
        for (int a = 0; a < 2; ++a)
#pragma unroll
            for (int b = 0; b < 2; ++b)
#pragma unroll
                for (int m = 0; m < 4; ++m)
#pragma unroll
                    for (int n = 0; n < 2; ++n) acc[a][b][m][n] = (f32x4){0.f, 0.f, 0.f, 0.f};
        cur = nxt; cA = nA; cB = nB; ++ui;
    }
    PG8_WAIT_V(0);
    if (wr == 0) PG8_BAR;
    PG8_BAR;
    PG8_STAMP();
    if (STAMP && wid == 0) { stamps[lane] = lane < nts ? (((unsigned long long)(unsigned)ts_hi << 32) | (unsigned)ts_lo) : 0ull;
        if (lane == 62) stamps[62] = rt_entry; if (lane == 63) stamps[63] = (unsigned long long)wall_clock64(); }
#undef PG8_STAMP
#undef PG8_SA
#undef PG8_SB
#undef PG8_STAGE
#undef PG8_LDA
#undef PG8_LDB
#undef PG8_MMA
#undef PG8_WAIT_V
#undef PG8_WAIT_L
#undef PG8_BAR
#undef PG8_SCHED
#undef PG8_WAIT_LS
#undef PG8_WAIT_VS
#undef PG8_MMS
#undef PG8_LDS
#undef PG8_STAGE_S
#undef PG8_SS
}
}


#define LAS __attribute__((address_space(3)))
#define XB_TMO      128
#define XB_XCNT(j)  (256  + 64 * (j))
#define XB_XSUB(j)  (1280 + 64 * (j))
#define XB_XGEN(j)  (2304 + 64 * (j))
#define XB_TOP      3328
#define XB_TOPGEN   3392
#define XCD_BAR_WORDS 3456
#define XB_SPIN_CAP (1u << 18)

__device__ __forceinline__ unsigned xb_ld(unsigned* p)              { return __hip_atomic_load(p, __ATOMIC_RELAXED, __HIP_MEMORY_SCOPE_AGENT); }
__device__ __forceinline__ unsigned xb_add(unsigned* p, unsigned v) { return __hip_atomic_fetch_add(p, v, __ATOMIC_RELAXED, __HIP_MEMORY_SCOPE_AGENT); }
__device__ __forceinline__ unsigned xb_xcc_id() { return (unsigned)__builtin_amdgcn_s_getreg((3 << 11) | 20) & 0xFu; }
#define XB_SPIN(cond, bar) do { unsigned _sp = 0; while (cond) { __builtin_amdgcn_s_sleep(1); \
    if ((++_sp & 255u) == 0u) { if (xb_ld(&(bar)[XB_TMO])) break; if (_sp > XB_SPIN_CAP) { atomicAdd(&(bar)[XB_TMO], 1u); break; } } } } while (0)

struct XcdBarrier {
    unsigned* bar; unsigned x;
    volatile LAS unsigned* st;
};

__device__ __forceinline__ XcdBarrier xcd_barrier_post(unsigned* bar, volatile LAS unsigned* st) {
    XcdBarrier b; b.bar = bar; b.x = xb_xcc_id(); b.st = st;
    if (threadIdx.x == 0) (void)xb_add(&bar[XB_XCNT(b.x)], 1u);
    return b;
}
__device__ __forceinline__ void xcd_barrier_complete(unsigned* bar, unsigned x, unsigned& nloc, unsigned& nx) {
    const unsigned G = gridDim.x * gridDim.y * gridDim.z;
    unsigned sum, cnt, mine, sp = 0u;
    for (;;) {
        sum = 0u; cnt = 0u; mine = 0u;
#pragma unroll
        for (unsigned j = 0; j < 16; ++j) { const unsigned c = xb_ld(&bar[XB_XCNT(j)]); sum += c; cnt += (c > 0u) ? 1u : 0u; mine = (j == x) ? c : mine; }
        if (sum == G) break;
        __builtin_amdgcn_s_sleep(1);
        if ((++sp & 255u) == 0u) { if (xb_ld(&bar[XB_TMO])) break; if (sp > XB_SPIN_CAP) { atomicAdd(&bar[XB_TMO], 1u); break; } }
    }
    nloc = mine > 0u ? mine : 1u; nx = cnt > 0u ? cnt : 1u;
}

__device__ __forceinline__ void xcd_barrier(const XcdBarrier& b) {
    asm volatile("s_waitcnt vmcnt(0)" ::: "memory");
    __syncthreads();
    if (threadIdx.x == 0) {
        unsigned* bar = b.bar;
        __builtin_amdgcn_s_waitcnt(0);
        unsigned nloc = b.st[0], nx = b.st[1];
        if (nloc == 0u) { xcd_barrier_complete(bar, b.x, nloc, nx); b.st[0] = nloc; b.st[1] = nx; }
        const unsigned old = xb_add(&bar[XB_XSUB(b.x)], 1u);
        const unsigned gen = old / nloc;
        if (old + 1u == (gen + 1u) * nloc) {
            __builtin_amdgcn_fence(__ATOMIC_RELEASE, "agent");
            asm volatile("s_waitcnt vmcnt(0)" ::: "memory");
            const unsigned og = xb_add(&bar[XB_TOP], 1u);
            const unsigned tg = og / nx;
            if (og + 1u == (tg + 1u) * nx) xb_add(&bar[XB_TOPGEN], 1u);
            else XB_SPIN(xb_ld(&bar[XB_TOPGEN]) == tg, bar);
            __builtin_amdgcn_fence(__ATOMIC_ACQUIRE, "agent");
            xb_add(&bar[XB_XGEN(b.x)], 1u);
            asm volatile("s_waitcnt vmcnt(0)" ::: "memory");
        } else {
            XB_SPIN(xb_ld(&bar[XB_XGEN(b.x)]) == gen, bar);
            __builtin_amdgcn_fence(__ATOMIC_ACQUIRE, "agent");
            asm volatile("s_waitcnt vmcnt(0)" ::: "memory");
        }
    }
    __syncthreads();
}

typedef CfgT<RC> C;
constexpr int NTHREADS = 512, NWAVES = 8;
constexpr int LDS_STAGE = 131072 + 16384 + 8192, LDS_CTL = LDS_STAGE, LDS_BYTES = LDS_STAGE + 256;

namespace pg8 {
typedef unsigned u32x2 __attribute__((ext_vector_type(2)));
__device__ __forceinline__ float silu_f(float g) { return g * __builtin_amdgcn_rcpf(1.0f + __expf(-g)); }
struct EpiSwiGLU { static constexpr bool PERM = true, PRE_ALL = true;
    bf16_t* act; const float* ss; int ff; float invd;
    typedef float Pre;
    __device__ __forceinline__ Pre pre(int row, int pn, int wc, int fq) const { return ss[row]; }
    __device__ __forceinline__ void row(const f32x4 (&v)[2][2], Pre ssr, int row, int pn, int wc, int fq) const {
        const float rs = rsqrtf(ssr * invd + 1e-6f), nc = rs * -1.4426950408889634f, rs2 = rs * rs; f32x4 o[2];
#pragma unroll
        for (int n = 0; n < 2; ++n) { const f32x4 t = v[0][n] * nc, w = v[0][n] * v[1][n]; f32x4 e, r;
#pragma unroll
            for (int j = 0; j < 4; ++j) e[j] = __builtin_amdgcn_exp2f(t[j]);
            const f32x4 dd = e + 1.0f;
#pragma unroll
            for (int j = 0; j < 4; ++j) r[j] = __builtin_amdgcn_rcpf(dd[j]);
            o[n] = w * (r * rs2); }
        u32x4 w; w.x = cvt_pk_bf16(o[0][0], o[0][1]); w.y = cvt_pk_bf16(o[0][2], o[0][3]); w.z = cvt_pk_bf16(o[1][0], o[1][1]); w.w = cvt_pk_bf16(o[1][2], o[1][3]);
        *(u32x4*)(act + (size_t)row * ff + pn * 128 + wc * 32 + 8 * fq) = w;
    }
};
struct EpiResid { static constexpr bool PERM = false, PRE_ALL = false;
    float* X; bf16_t* XB; float* ssout; float scale; int ld;
    struct Pre { f32x4 x[2][2]; };
    __device__ __forceinline__ Pre pre(int row, int pn, int wc, int fq) const { Pre q; const float* xr = X + (size_t)row * ld + pn * BM + wc * 32 + 4 * fq;
#pragma unroll
        for (int bj = 0; bj < 2; ++bj)
#pragma unroll
            for (int n = 0; n < 2; ++n) q.x[bj][n] = *(const f32x4*)(xr + bj * HALF + n * 16);
        return q; }
    __device__ __forceinline__ void row(const f32x4 (&v)[2][2], const Pre& q, int row, int pn, int wc, int fq) const {
        const int col0 = pn * BM + wc * 32 + 4 * fq; float* xr = X + (size_t)row * ld + col0; bf16_t* br = XB + (size_t)row * ld + col0; float s = 0.f;
#pragma unroll
        for (int bj = 0; bj < 2; ++bj)
#pragma unroll
            for (int n = 0; n < 2; ++n) { const f32x4 x = q.x[bj][n] + v[bj][n] * scale; *(f32x4*)(xr + bj * HALF + n * 16) = x;
                u32x2 w; w.x = cvt_pk_bf16(x[0], x[1]); w.y = cvt_pk_bf16(x[2], x[3]); *(u32x2*)(br + bj * HALF + n * 16) = w;
                s += (x[0] * x[0] + x[1] * x[1]) + (x[2] * x[2] + x[3] * x[3]); }
        s += __shfl_xor(s, 16); s += __shfl_xor(s, 32);
        if (fq == 0) unsafeAtomicAdd(ssout + row, s);
    }
};
struct EpiScaleF32 { static constexpr bool PERM = false, PRE_ALL = true;
    float* Cp; int ldc; const float* ss; float invd;
    typedef float Pre;
    __device__ __forceinline__ Pre pre(int row, int pn, int wc, int fq) const { return ss[row]; }
    __device__ __forceinline__ void row(const f32x4 (&v)[2][2], Pre ssr, int row, int pn, int wc, int fq) const {
        const float rs = rsqrtf(ssr * invd + 1e-6f); float* cr = Cp + (size_t)row * ldc + pn * BM + wc * 32 + 4 * fq;
#pragma unroll
        for (int bj = 0; bj < 2; ++bj)
#pragma unroll
            for (int n = 0; n < 2; ++n) *(f32x4*)(cr + bj * HALF + n * 16) = v[bj][n] * rs;
    }
};
struct EpiScaleBf16 { static constexpr bool PERM = true, PRE_ALL = true;
    bf16_t* O; int ldc; const float* ss; float invd;
    typedef float Pre;
    __device__ __forceinline__ Pre pre(int row, int pn, int wc, int fq) const { return ss[row]; }
    __device__ __forceinline__ void row(const f32x4 (&v)[2][2], Pre ssr, int row, int pn, int wc, int fq) const {
        const float rs = rsqrtf(ssr * invd + 1e-6f); bf16_t* orow = O + (size_t)row * ldc + pn * BM + wc * 32 + 8 * fq;
#pragma unroll
        for (int bj = 0; bj < 2; ++bj) { const f32x4 v0 = v[bj][0] * rs, v1 = v[bj][1] * rs;
            u32x4 w; w.x = cvt_pk_bf16(v0[0], v0[1]); w.y = cvt_pk_bf16(v0[2], v0[3]); w.z = cvt_pk_bf16(v1[0], v1[1]); w.w = cvt_pk_bf16(v1[2], v1[3]);
            *(u32x4*)(orow + bj * HALF) = w; }
    }
};
struct EpiMemKV { static constexpr bool PERM = false, PRE_ALL = true;
    float* K; float* V; const float* rstd; int d; bf16_t* KVB; int mm;
    typedef float Pre;
    __device__ __forceinline__ Pre pre(int row, int pn, int wc, int fq) const { return rstd[row]; }
    __device__ __forceinline__ void row(const f32x4 (&v)[2][2], Pre rs, int row, int pn, int wc, int fq) const {
        int ct = pn * BM; float* base = K; bf16_t* bb = KVB; if (ct >= d) { base = V; ct -= d; bb += (size_t)mm * d; }
        float* cr = base + (size_t)row * d + ct + wc * 32 + 4 * fq; bb += (size_t)row * d + ct + wc * 32 + 4 * fq;
#pragma unroll
        for (int bj = 0; bj < 2; ++bj)
#pragma unroll
            for (int n = 0; n < 2; ++n) { const f32x4 o = v[bj][n] * rs; *(f32x4*)(cr + bj * HALF + n * 16) = o;
                u32x2 w; w.x = cvt_pk_bf16(o[0], o[1]); w.y = cvt_pk_bf16(o[2], o[3]); *(u32x2*)(bb + bj * HALF + n * 16) = w; }
    }
};
}

__device__ __forceinline__ void prep_item(const float* W, int K, int Ncols, const float* g, int kind, int N, bf16_t* Bt, LAS unsigned char* scr, int item, int lane) {
    const int nblk = N / 64, kb = item / nblk, nb = item % nblk, k0 = 64 * kb, n = 64 * nb + lane;
    const int sc = wsrc_col<C>(kind, n);
    const float* src = W + (size_t)k0 * Ncols + (sc >= 0 ? sc : 0);
    float v[64];
#pragma unroll
    for (int kk = 0; kk < 64; ++kk) v[kk] = src[(size_t)kk * Ncols];
    if (g) {
        typedef float f32x16 __attribute__((ext_vector_type(16)));
        const float* gp = g + k0;
#pragma unroll
        for (int q = 0; q < 4; ++q) { f32x16 gs; asm volatile("s_load_dwordx16 %0, %1, %2\n\ts_waitcnt lgkmcnt(0)" : "=s"(gs) : "s"(gp), "n"(q * 64));
#pragma unroll
            for (int j = 0; j < 16; ++j) v[16 * q + j] *= gs[j]; }
    }
    if (sc < 0) {
#pragma unroll
        for (int kk = 0; kk < 64; ++kk) v[kk] = 0.f;
    }
#pragma unroll
    for (int j = 0; j < 8; ++j) { pg8::u32x4 o; o.x = pg8::cvt_pk_bf16(v[8 * j], v[8 * j + 1]); o.y = pg8::cvt_pk_bf16(v[8 * j + 2], v[8 * j + 3]); o.z = pg8::cvt_pk_bf16(v[8 * j + 4], v[8 * j + 5]); o.w = pg8::cvt_pk_bf16(v[8 * j + 6], v[8 * j + 7]);
        *(LAS pg8::u32x4*)(scr + lane * 144 + j * 16) = o; }
    asm volatile("s_waitcnt lgkmcnt(0)" ::: "memory");
    bf16_t* dst = Bt + (size_t)(64 * nb) * K + k0 + (lane & 7) * 8;
#pragma unroll
    for (int it = 0; it < 8; ++it) { const int row = it * 8 + (lane >> 3); const pg8::u32x4 o = *(const LAS pg8::u32x4*)(scr + row * 144 + (lane & 7) * 16);
        *(pg8::u32x4*)(dst + (size_t)row * K) = o; }
    asm volatile("s_waitcnt lgkmcnt(0)" ::: "memory");
}
struct WDesc { const float* W; const float* g; bf16_t* dst; int K, Ncols, kind, N; };
__device__ __forceinline__ WDesc wdesc(const Ptrs& p, int l, int idx) {
    WDesc d; d.g = nullptr; d.kind = WK_PLAIN;
    switch (idx) {
    case 0: d.W = p.in[I_W1IN] + (size_t)l * C::D * 2 * C::FF; d.K = C::D; d.Ncols = 2 * C::FF; d.N = 2 * C::FF; d.g = p.in[I_GFFN1] + l * C::D; d.kind = WK_FFNIN; d.dst = wlayer<C>(p, l, C::W_1IN); break;
    case 1: d.W = p.in[I_W1OUT] + (size_t)l * C::FF * C::D; d.K = C::FF; d.Ncols = C::D; d.N = C::D; d.dst = wlayer<C>(p, l, C::W_1OUT); break;
    case 2: d.W = p.in[I_WIN] + (size_t)l * C::D * C::INC; d.K = C::D; d.Ncols = C::INC; d.N = C::LDP; d.g = p.in[I_GMIX] + l * C::D; d.kind = WK_WIN; d.dst = wlayer<C>(p, l, C::W_IN); break;
    case 3: d.W = p.in[I_WOUT] + (size_t)l * C::D * C::D; d.K = C::D; d.Ncols = C::D; d.N = C::D; d.dst = wlayer<C>(p, l, C::W_OUT); break;
    case 4: d.W = p.in[I_WQ] + (size_t)l * C::D * C::D; d.K = C::D; d.Ncols = C::D; d.N = C::D; d.g = p.in[I_GX] + l * C::D; d.dst = wlayer<C>(p, l, C::W_Q); break;
    case 5: d.W = p.in[I_WK] + (size_t)l * C::D * C::D; d.K = C::D; d.Ncols = C::D; d.N = C::D; d.g = p.in[I_GMEM] + l * C::D; d.dst = wlayer<C>(p, l, C::W_KV); break;
    case 6: d.W = p.in[I_WV] + (size_t)l * C::D * C::D; d.K = C::D; d.Ncols = C::D; d.N = C::D; d.g = p.in[I_GMEM] + l * C::D; d.dst = wlayer<C>(p, l, C::W_KV) + (size_t)C::D * C::D; break;
    case 7: d.W = p.in[I_WO] + (size_t)l * C::D * C::D; d.K = C::D; d.Ncols = C::D; d.N = C::D; d.dst = wlayer<C>(p, l, C::W_O); break;
    case 8: d.W = p.in[I_W2IN] + (size_t)l * C::D * 2 * C::FF; d.K = C::D; d.Ncols = 2 * C::FF; d.N = 2 * C::FF; d.g = p.in[I_GFFN2] + l * C::D; d.kind = WK_FFNIN; d.dst = wlayer<C>(p, l, C::W_2IN); break;
    default: d.W = p.in[I_W2OUT] + (size_t)l * C::FF * C::D; d.K = C::FF; d.Ncols = C::D; d.N = C::D; d.dst = wlayer<C>(p, l, C::W_2OUT); break;
    }
    return d;
}

#define WG_SYNC() do { asm volatile("s_waitcnt lgkmcnt(0)" ::: "memory"); __builtin_amdgcn_s_barrier(); asm volatile("" ::: "memory"); } while (0)
namespace att {
typedef short bf16x8 __attribute__((ext_vector_type(8)));
typedef short s16x4 __attribute__((ext_vector_type(4)));
typedef float f32x4 __attribute__((ext_vector_type(4)));
typedef unsigned u32x2 __attribute__((ext_vector_type(2)));
constexpr int TOK = 256, CD = 64, PITCH = 144, CBYTES = TOK * PITCH, HDIM = 512, NH = 4, LD = 2048;
static_assert(C::NMEM == TOK && C::AHD == HDIM && C::AH == NH && C::D == LD && C::DEC_SEQ == 32 && C::SEQ % 256 == 0, "attention phase is built for these shapes");
__device__ __forceinline__ s16x4 tr_read(unsigned addr) { s16x4 r; asm volatile("ds_read_b64_tr_b16 %0, %1" : "=&v"(r) : "v"(addr) : "memory"); return r; }
__device__ __forceinline__ void stage_load(f32x4 (&r)[8], const float* src, int tid) {
    const unsigned off0 = (unsigned)(((tid >> 4) * LD + (tid & 15) * 4) * 4);
#pragma unroll
    for (int i = 0; i < 8; ++i) { const float* si = src + (size_t)i * 32 * LD; asm volatile("" : "+s"(si));
        r[i] = *(const f32x4*)((const char*)si + off0); }
    __builtin_amdgcn_sched_barrier(0);
}
__device__ __forceinline__ void stage_load_b(pg8::u32x4 (&r)[4], const bf16_t* src, int tid) {
    const unsigned off0 = (unsigned)(((tid >> 3) * LD + (tid & 7) * 8) * 2);
#pragma unroll
    for (int i = 0; i < 4; ++i) { const bf16_t* si = src + (size_t)i * 64 * LD; asm volatile("" : "+s"(si)); r[i] = *(const pg8::u32x4*)((const char*)si + off0); }
    __builtin_amdgcn_sched_barrier(0);
}
__device__ __forceinline__ int klds(int r, int c) { const int ob = (r & 15) * 64 + (c & 31) * 2; return ((r >> 4) * 2 + (c >> 5)) * 1024 + (ob ^ (((ob >> 9) & 1) << 5)); }
__device__ __forceinline__ void stage_store_k(const f32x4 (&r)[8], LAS unsigned char* buf, int tid) {
#pragma unroll
    for (int i = 0; i < 8; ++i) { const int f = tid + 512 * i; u32x2 w; w.x = pg8::cvt_pk_bf16(r[i][0], r[i][1]); w.y = pg8::cvt_pk_bf16(r[i][2], r[i][3]);
        *(LAS u32x2*)(buf + klds(f >> 4, (f & 15) * 4)) = w; }
}
__device__ __forceinline__ void stage_store_kb(const pg8::u32x4 (&r)[4], LAS unsigned char* buf, int tid) {
    asm volatile("" : "+v"(tid));
#pragma unroll
    for (int i = 0; i < 4; ++i) *(LAS pg8::u32x4*)(buf + klds((tid >> 3) + 64 * i, (tid & 7) * 8)) = r[i];
}
__device__ __forceinline__ void stage_store_vb(const pg8::u32x4 (&r)[4], LAS unsigned char* buf, int tid) {
    asm volatile("" : "+v"(tid));
#pragma unroll
    for (int i = 0; i < 4; ++i) *(LAS pg8::u32x4*)(buf + ((tid >> 3) + 64 * i) * PITCH + (tid & 7) * 16) = r[i];
}
__device__ __forceinline__ void stage_store(const f32x4 (&r)[8], LAS unsigned char* buf, int tid) {
#pragma unroll
    for (int i = 0; i < 8; ++i) { const int f = tid + 512 * i; u32x2 w; w.x = pg8::cvt_pk_bf16(r[i][0], r[i][1]); w.y = pg8::cvt_pk_bf16(r[i][2], r[i][3]);
        *(LAS u32x2*)(buf + (f >> 4) * PITCH + (f & 15) * 8) = w; }
}
__device__ __forceinline__ void attn_sample_unit(LAS unsigned char* lds, const bf16_t* Qg, bf16_t* AO, const float* kb, const float* vb, int row0, int head, int tid) {
    const int lane = tid & 63, wave = __builtin_amdgcn_readfirstlane(tid >> 6), li = lane & 15, g = lane >> 4;
    constexpr int PP = 528;
    LAS unsigned char* Ps = lds + 2 * CBYTES;
    LAS float* smax = (LAS float*)(Ps + 32 * PP); LAS float* ssum = smax + 8 * 32;
    const bf16_t* q0 = Qg + (size_t)(row0 + li) * LD + head * HDIM + g * 8;
    f32x4 s[2][2];
#pragma unroll
    for (int u = 0; u < 2; ++u)
#pragma unroll
        for (int tt = 0; tt < 2; ++tt) s[u][tt] = (f32x4){0.f, 0.f, 0.f, 0.f};
    f32x4 r0[8], r1[8]; bf16x8 qf[2][2];
    stage_load(r0, kb, tid); stage_load(r1, kb + CD, tid);
#pragma unroll
    for (int u = 0; u < 2; ++u)
#pragma unroll
        for (int ks = 0; ks < 2; ++ks) qf[u][ks] = *(const bf16x8*)(q0 + (size_t)u * 16 * LD + ks * 32);
    stage_store(r0, lds, tid);
    WG_SYNC();
    stage_load(r0, kb + 2 * CD, tid);
#define ATS_SRC(cc) ((cc) < 8 ? kb + (cc) * CD : vb + ((cc) - 8) * CD)
#define ATS_SCORE(cc, REGN, REGF) do { LAS unsigned char* buf = lds + ((cc) & 1) * CBYTES; \
        _Pragma("unroll") for (int ks = 0; ks < 2; ++ks) _Pragma("unroll") for (int tt = 0; tt < 2; ++tt) { const bf16x8 a = *(const LAS bf16x8*)(buf + ((2 * wave + tt) * 16 + li) * PITCH + ks * 64 + g * 16); \
            s[0][tt] = __builtin_amdgcn_mfma_f32_16x16x32_bf16(a, qf[0][ks], s[0][tt], 0, 0, 0); s[1][tt] = __builtin_amdgcn_mfma_f32_16x16x32_bf16(a, qf[1][ks], s[1][tt], 0, 0, 0); } \
        if ((cc) < 7) { __builtin_amdgcn_sched_barrier(0); _Pragma("unroll") for (int u = 0; u < 2; ++u) _Pragma("unroll") for (int ks = 0; ks < 2; ++ks) qf[u][ks] = *(const bf16x8*)(q0 + (size_t)u * 16 * LD + ((cc) + 1) * CD + ks * 32); __builtin_amdgcn_sched_barrier(0); } \
        stage_store(REGN, lds + (((cc) + 1) & 1) * CBYTES, tid); WG_SYNC(); stage_load(REGF, ATS_SRC((cc) + 3), tid); } while (0)
    ATS_SCORE(0, r1, r1); ATS_SCORE(1, r0, r0); ATS_SCORE(2, r1, r1); ATS_SCORE(3, r0, r0); ATS_SCORE(4, r1, r1); ATS_SCORE(5, r0, r0); ATS_SCORE(6, r1, r1); ATS_SCORE(7, r0, r0);
    const float sc = 0.044194173824159216f * 1.4426950408889634f;
#pragma unroll
    for (int u = 0; u < 2; ++u) { float mx = fmaxf(fmaxf(fmaxf(s[u][0][0], s[u][0][1]), fmaxf(s[u][0][2], s[u][0][3])), fmaxf(fmaxf(s[u][1][0], s[u][1][1]), fmaxf(s[u][1][2], s[u][1][3])));
        mx = fmaxf(mx, __shfl_xor(mx, 16)); mx = fmaxf(mx, __shfl_xor(mx, 32));
        if (g == 0) smax[wave * 32 + u * 16 + li] = mx; }
    WG_SYNC();
#pragma unroll
    for (int u = 0; u < 2; ++u) { float mx = smax[u * 16 + li];
#pragma unroll
        for (int w = 1; w < 8; ++w) mx = fmaxf(mx, smax[w * 32 + u * 16 + li]);
        float sum = 0.f;
#pragma unroll
        for (int tt = 0; tt < 2; ++tt) {
#pragma unroll
            for (int j = 0; j < 4; ++j) { const float e = __builtin_amdgcn_exp2f((s[u][tt][j] - mx) * sc); s[u][tt][j] = e; sum += e; }
            u32x2 w2; w2.x = pg8::cvt_pk_bf16(s[u][tt][0], s[u][tt][1]); w2.y = pg8::cvt_pk_bf16(s[u][tt][2], s[u][tt][3]);
            *(LAS u32x2*)(Ps + (u * 16 + li) * PP + (32 * wave + 16 * tt + 4 * g) * 2) = w2; }
        sum += __shfl_xor(sum, 16); sum += __shfl_xor(sum, 32);
        if (g == 0) ssum[wave * 32 + u * 16 + li] = sum; }
    WG_SYNC();
    const int dt = wave & 3, uq = wave >> 2;
    float inv;
    { float sum = 0.f;
#pragma unroll
      for (int w = 0; w < 8; ++w) sum += ssum[w * 32 + uq * 16 + li];
      inv = 1.0f / sum; }
    bf16x8 pfr[8];
#pragma unroll
    for (int t = 0; t < 8; ++t) pfr[t] = *(const LAS bf16x8*)(Ps + (uq * 16 + li) * PP + (32 * t + 8 * g) * 2);
    const unsigned trb8 = (unsigned)(size_t)lds + (unsigned)((8 * g + (li >> 2)) * PITCH + (li & 3) * 8 + dt * 32);
#define ATS_PV(cc, REGN, REGF) do { const unsigned bofs = (unsigned)((cc) & 1) * CBYTES; f32x4 o = (f32x4){0.f, 0.f, 0.f, 0.f}; s16x4 lo[8], hi[8]; \
        _Pragma("unroll") for (int t = 0; t < 8; ++t) { lo[t] = tr_read(trb8 + bofs + (unsigned)(t * 32 * PITCH)); hi[t] = tr_read(trb8 + bofs + (unsigned)(t * 32 * PITCH + 4 * PITCH)); } \
        asm volatile("s_waitcnt lgkmcnt(0)" ::: "memory"); __builtin_amdgcn_sched_barrier(0); \
        _Pragma("unroll") for (int t = 0; t < 8; ++t) { const bf16x8 a = (bf16x8){lo[t][0], lo[t][1], lo[t][2], lo[t][3], hi[t][0], hi[t][1], hi[t][2], hi[t][3]}; o = __builtin_amdgcn_mfma_f32_16x16x32_bf16(a, pfr[t], o, 0, 0, 0); } \
        { u32x2 w2; w2.x = pg8::cvt_pk_bf16(o[0] * inv, o[1] * inv); w2.y = pg8::cvt_pk_bf16(o[2] * inv, o[3] * inv); \
          *(u32x2*)(AO + (size_t)(row0 + 16 * uq + li) * LD + head * HDIM + ((cc) - 8) * CD + dt * 16 + g * 4) = w2; } \
        if ((cc) < 15) stage_store(REGN, lds + (((cc) + 1) & 1) * CBYTES, tid); WG_SYNC(); if ((cc) + 3 < 16) stage_load(REGF, ATS_SRC((cc) + 3), tid); } while (0)
    ATS_PV(8, r1, r1); ATS_PV(9, r0, r0); ATS_PV(10, r1, r1); ATS_PV(11, r0, r0); ATS_PV(12, r1, r1); ATS_PV(13, r0, r0); ATS_PV(14, r1, r1); ATS_PV(15, r0, r0);
#undef ATS_SRC
#undef ATS_SCORE
#undef ATS_PV
}
__device__ __forceinline__ void attn_sample_phase(LAS unsigned char* lds, const Ptrs& p, int l, int tid, int first, int stride) {
    const bf16_t* Qg = wsb<C>(p, C::WS_Q); bf16_t* AO = wsb<C>(p, C::WS_AO);
    for (int s = first; s < C::DEC_BATCH * NH; s += stride) { const int b = s / NH, head = s % NH;
        attn_sample_unit(lds, Qg, AO, p.in[I_CK] + ((size_t)l * C::DEC_BATCH + b) * TOK * LD + head * HDIM, p.in[I_CV] + ((size_t)l * C::DEC_BATCH + b) * TOK * LD + head * HDIM, C::MP + b * C::DEC_SEQ, head, tid); }
}
__device__ __forceinline__ void attn_phase(LAS unsigned char* lds, const Ptrs& p, int l, int tid, int bid, int gsz, int nunits) {
    const int lane = tid & 63, wave = __builtin_amdgcn_readfirstlane(tid >> 6), li = lane & 15, g = lane >> 4;
    const bf16_t* Qg = wsb<C>(p, C::WS_Q); bf16_t* AO = wsb<C>(p, C::WS_AO);
    constexpr int NUP = (C::MP / 256) * NH;
    static_assert(C::SEQ % 256 == 0, "prompt units are 256 rows");
    for (int un0 = bid; un0 < nunits; un0 += gsz) {
        const int un = (NUP % 64 == 0) ? (un0 & ~63) + (un0 & 7) * 8 + ((un0 >> 3) & 7) : un0;
        const int per_b = (C::SEQ / 256) * NH, b = un / per_b, rem = un % per_b, head = rem / (C::SEQ / 256), row0 = b * C::SEQ + (rem % (C::SEQ / 256)) * 256;
        const bf16_t* kbb = wsb<C>(p, C::WS_KVB) + (size_t)b * TOK * LD + head * HDIM; const bf16_t* vbb = kbb + (size_t)C::MM * LD;
#define ATP_SRC(cc) ((cc) < 8 ? kbb + (cc) * CD : vbb + ((cc) - 8) * CD)
        const bf16_t* q0 = Qg + (size_t)(row0 + wave * 32 + li) * LD + head * HDIM + g * 8;
        f32x4 s[2][16];
#pragma unroll
        for (int u = 0; u < 2; ++u)
#pragma unroll
            for (int T = 0; T < 16; ++T) s[u][T] = (f32x4){0.f, 0.f, 0.f, 0.f};
        pg8::u32x4 w0[4], w1[4]; bf16x8 qf[2][2];
        stage_load_b(w0, ATP_SRC(0), tid); stage_load_b(w1, ATP_SRC(1), tid);
#pragma unroll
        for (int u = 0; u < 2; ++u)
#pragma unroll
            for (int ks = 0; ks < 2; ++ks) qf[u][ks] = *(const bf16x8*)(q0 + (size_t)u * 16 * LD + ks * 32);
        stage_store_kb(w0, lds, tid);
        WG_SYNC();
        stage_load_b(w0, ATP_SRC(2), tid);
        const int aoff = (li * 64 + g * 16) ^ ((li >> 3) << 5);
#define ATP_KS(ks) do { _Pragma("unroll") for (int T0 = 0; T0 < 16; T0 += 2) { bf16x8 af[2]; \
            _Pragma("unroll") for (int j = 0; j < 2; ++j) af[j] = *(const LAS bf16x8*)(buf + ((T0 + j) * 2 + (ks)) * 1024 + aoff); \
            asm volatile("s_waitcnt lgkmcnt(0)" ::: "memory"); __builtin_amdgcn_sched_barrier(0); \
            _Pragma("unroll") for (int j = 0; j < 2; ++j) { s[0][T0 + j] = __builtin_amdgcn_mfma_f32_16x16x32_bf16(af[j], qf[0][ks], s[0][T0 + j], 0, 0, 0); \
                s[1][T0 + j] = __builtin_amdgcn_mfma_f32_16x16x32_bf16(af[j], qf[1][ks], s[1][T0 + j], 0, 0, 0); } \
            __builtin_amdgcn_sched_barrier(0); } } while (0)
#define ATP_SITER(cc, WN) do { LAS unsigned char* buf = lds + ((cc) & 1) * CBYTES; \
            ATP_KS(0); ATP_KS(1); \
            if ((cc) < 7) { __builtin_amdgcn_sched_barrier(0); _Pragma("unroll") for (int u = 0; u < 2; ++u) _Pragma("unroll") for (int ks = 0; ks < 2; ++ks) qf[u][ks] = *(const bf16x8*)(q0 + (size_t)u * 16 * LD + ((cc) + 1) * CD + ks * 32); \
                __builtin_amdgcn_sched_barrier(0); stage_store_kb(WN, lds + (((cc) + 1) & 1) * CBYTES, tid); } \
            else stage_store_vb(WN, lds + (((cc) + 1) & 1) * CBYTES, tid); \
            WG_SYNC(); stage_load_b(WN, ATP_SRC((cc) + 3), tid); } while (0)
#pragma unroll 1
        for (int c2 = 0; c2 < 8; c2 += 2) { ATP_SITER(c2, w1); ATP_SITER(c2 + 1, w0); }
#undef ATP_SITER
#undef ATP_KS
        const float sc = 0.044194173824159216f * 1.4426950408889634f;
        float inv[2]; bf16x8 pf[2][8];
#pragma unroll
        for (int u = 0; u < 2; ++u) {
            float mx = -3.0e38f;
#pragma unroll
            for (int T = 0; T < 16; ++T) mx = fmaxf(mx, fmaxf(fmaxf(s[u][T][0], s[u][T][1]), fmaxf(s[u][T][2], s[u][T][3])));
            mx = fmaxf(mx, __shfl_xor(mx, 16)); mx = fmaxf(mx, __shfl_xor(mx, 32));
            float sum = 0.f;
#pragma unroll
            for (int T = 0; T < 16; ++T)
#pragma unroll
                for (int j = 0; j < 4; ++j) { const float e = __builtin_amdgcn_exp2f((s[u][T][j] - mx) * sc); s[u][T][j] = e; sum += e; }
            sum += __shfl_xor(sum, 16); sum += __shfl_xor(sum, 32);
            inv[u] = 1.0f / sum;
#pragma unroll
            for (int t = 0; t < 8; ++t) { pg8::u32x4 w; w.x = pg8::cvt_pk_bf16(s[u][2 * t][0], s[u][2 * t][1]); w.y = pg8::cvt_pk_bf16(s[u][2 * t][2], s[u][2 * t][3]);
                w.z = pg8::cvt_pk_bf16(s[u][2 * t + 1][0], s[u][2 * t + 1][1]); w.w = pg8::cvt_pk_bf16(s[u][2 * t + 1][2], s[u][2 * t + 1][3]); pf[u][t] = __builtin_bit_cast(bf16x8, w); }
        }
        const unsigned trb = (unsigned)(size_t)lds + (unsigned)((4 * g + (li >> 2)) * PITCH + (li & 3) * 8);
#define ATP_VITER(c, WN) do { unsigned bofs = (unsigned)((c) & 1) * CBYTES; asm volatile("" : "+v"(bofs));        \
            { f32x4 o[2][4]; \
              _Pragma("unroll") for (int u = 0; u < 2; ++u) _Pragma("unroll") for (int dt = 0; dt < 4; ++dt) o[u][dt] = (f32x4){0.f, 0.f, 0.f, 0.f}; \
              _Pragma("unroll") for (int t = 0; t < 8; ++t) { s16x4 lo[4], hi[4]; \
                _Pragma("unroll") for (int dt = 0; dt < 4; ++dt) { lo[dt] = tr_read(trb + bofs + (unsigned)(t * 32 * PITCH + dt * 32)); hi[dt] = tr_read(trb + bofs + (unsigned)(t * 32 * PITCH + 16 * PITCH + dt * 32)); } \
                asm volatile("s_waitcnt lgkmcnt(0)" ::: "memory"); __builtin_amdgcn_sched_barrier(0); \
                _Pragma("unroll") for (int dt = 0; dt < 4; ++dt) { const bf16x8 a = (bf16x8){lo[dt][0], lo[dt][1], lo[dt][2], lo[dt][3], hi[dt][0], hi[dt][1], hi[dt][2], hi[dt][3]}; \
                    o[0][dt] = __builtin_amdgcn_mfma_f32_16x16x32_bf16(a, pf[0][t], o[0][dt], 0, 0, 0); \
                    o[1][dt] = __builtin_amdgcn_mfma_f32_16x16x32_bf16(a, pf[1][t], o[1][dt], 0, 0, 0); } } \
              _Pragma("unroll") for (int u = 0; u < 2; ++u) _Pragma("unroll") for (int dt = 0; dt < 4; ++dt) { u32x2 w; w.x = pg8::cvt_pk_bf16(o[u][dt][0] * inv[u], o[u][dt][1] * inv[u]); w.y = pg8::cvt_pk_bf16(o[u][dt][2] * inv[u], o[u][dt][3] * inv[u]); \
                    *(u32x2*)(AO + (size_t)(row0 + wave * 32 + 16 * u + li) * LD + head * HDIM + (c) * CD + dt * 16 + g * 4) = w; } } \
            if ((c) < 7) stage_store_vb(WN, lds + (((c) + 1) & 1) * CBYTES, tid); \
            WG_SYNC(); if ((c) < 5) stage_load_b(WN, ATP_SRC((c) + 11), tid); } while (0)
#pragma unroll 1
        for (int c2 = 0; c2 < 8; c2 += 2) { ATP_VITER(c2, w1); ATP_VITER(c2 + 1, w0); }
#undef ATP_VITER
#undef ATP_SRC
    }
}
}
namespace mx {
typedef att::bf16x8 bf16x8; typedef att::s16x4 s16x4; typedef att::f32x4 f32x4; typedef att::u32x2 u32x2;
constexpr int PT = 272;
constexpr int T64 = 64 * PT, T128 = 128 * PT;
static_assert(C::MHD == 128 && C::CH == 64 && C::MH == 8 && C::LCS == 32, "mLSTM phases are built for these shapes");
__device__ __forceinline__ void lds_wait() { asm volatile("s_waitcnt lgkmcnt(0)" ::: "memory"); __builtin_amdgcn_sched_barrier(0); }
__device__ __forceinline__ bf16x8 mk8(s16x4 lo, s16x4 hi) { return (bf16x8){lo[0], lo[1], lo[2], lo[3], hi[0], hi[1], hi[2], hi[3]}; }
__device__ __forceinline__ unsigned tr_addr(unsigned tile, int krow, int c0, int li) { return tile + (unsigned)((krow + (li >> 2)) * PT + (c0 + 4 * (li & 3)) * 2); }
__device__ __forceinline__ void ch_decode(int ci, int& r0, int& h, int& lc) {
    if (ci < C::NPC) { const int c = ci % C::NC, bh = ci / C::NC; h = bh % C::MH; r0 = (bh / C::MH) * C::SEQ + c * C::CH; lc = C::CH; }
    else { const int q = ci - C::NPC; h = q % C::MH; r0 = C::MP + (q / C::MH) * C::DEC_SEQ; lc = C::LCS; }
}
__device__ __forceinline__ void stage64(LAS unsigned char* tile, const float* src, int ld, int lc, int tid, const LAS float* rs, float mul) {
#pragma unroll
    for (int i = 0; i < 4; ++i) { const int f = tid + 512 * i, row = f >> 5, c4 = f & 31; f32x4 v = (f32x4){0.f, 0.f, 0.f, 0.f};
        if (row < lc) { v = *(const f32x4*)(src + (size_t)row * ld + c4 * 4); const float m = rs ? rs[row] * mul : mul; v = v * m; }
        u32x2 w; w.x = pg8::cvt_pk_bf16(v[0], v[1]); w.y = pg8::cvt_pk_bf16(v[2], v[3]); *(LAS u32x2*)(tile + row * PT + c4 * 8) = w; }
}
__device__ __forceinline__ void ml_phase_a(LAS unsigned char* lds, const Ptrs& p, int l, int tid, int bid, int gsz) {
    const int lane = tid & 63, wave = __builtin_amdgcn_readfirstlane(tid >> 6), li = lane & 15, g = lane >> 4;
    LAS unsigned char* Ks = lds; LAS unsigned char* Vs = lds + T64; LAS float* wts = (LAS float*)(lds + 2 * T64);
    const float* P = wsf<C>(p, C::WS_BIG);
    for (int ci = bid; ci < C::NCH; ci += gsz) {
        int r0, h, lc; ch_decode(ci, r0, h, lc);
        if (wave == 0) {
            float lf = 0.f, ig = -3.0e38f;
            if (lane < lc) { const float* pr = P + (size_t)(r0 + lane) * C::LDP; ig = pr[C::O_IG + h] + p.in[I_IB][l * C::MH + h]; const float fx = pr[C::O_FG + h] + p.in[I_FB][l * C::MH + h]; lf = fx >= 0.f ? -__logf(1.0f + __expf(-fx)) : fx - __logf(1.0f + __expf(fx)); }
            float b = lf;
#pragma unroll
            for (int o = 1; o < 64; o <<= 1) { const float t = __shfl_up(b, o); if (lane >= o) b += t; }
            const float a = lane < lc ? ig - b : -3.0e38f;
            float amax = a;
#pragma unroll
            for (int o = 1; o < 64; o <<= 1) amax = fmaxf(amax, __shfl_xor(amax, o));
            const float bL = __shfl(b, lc - 1), mloc = bL + amax;
            const float wt = lane < lc ? __expf(bL + a - mloc) : 0.f;
            wts[lane] = wt;
            if (lane < lc) { wsf<C>(p, C::WS_GB)[(size_t)(r0 + lane) * C::MH + h] = b; wsf<C>(p, C::WS_GA)[(size_t)(r0 + lane) * C::MH + h] = a; }
            if (lane == 0) { wsf<C>(p, C::WS_CBL)[ci] = bL; wsf<C>(p, C::WS_CML)[ci] = mloc; }
        }
        __syncthreads();
        stage64(Ks, P + (size_t)r0 * C::LDP + C::O_K + h * C::MHD, C::LDP, lc, tid, wts, 0.08838834764831845f);
        stage64(Vs, P + (size_t)r0 * C::LDP + C::O_VM + h * C::MHD, C::LDP, lc, tid, nullptr, 1.0f);
        __syncthreads();
        f32x4 acc[8];
#pragma unroll
        for (int et = 0; et < 8; ++et) acc[et] = (f32x4){0.f, 0.f, 0.f, 0.f};
        const unsigned ks = (unsigned)(size_t)Ks, vs = (unsigned)(size_t)Vs;
#pragma unroll
        for (int t = 0; t < 2; ++t) {
            const s16x4 alo = att::tr_read(tr_addr(ks, 32 * t + 8 * g, 16 * wave, li)), ahi = att::tr_read(tr_addr(ks, 32 * t + 8 * g + 4, 16 * wave, li));
            s16x4 blo[8], bhi[8];
#pragma unroll
            for (int et = 0; et < 8; ++et) { blo[et] = att::tr_read(tr_addr(vs, 32 * t + 8 * g, 16 * et, li)); bhi[et] = att::tr_read(tr_addr(vs, 32 * t + 8 * g + 4, 16 * et, li)); }
            lds_wait();
            const bf16x8 a = mk8(alo, ahi);
#pragma unroll
            for (int et = 0; et < 8; ++et) acc[et] = __builtin_amdgcn_mfma_f32_16x16x32_bf16(a, mk8(blo[et], bhi[et]), acc[et], 0, 0, 0);
        }
        float* DC = wsf<C>(p, C::WS_DC) + (size_t)ci * C::MHD * C::MHD;
#pragma unroll
        for (int et = 0; et < 8; ++et)
#pragma unroll
            for (int r = 0; r < 4; ++r) DC[(size_t)(16 * wave + 4 * g + r) * C::MHD + 16 * et + li] = acc[et][r];
        if (tid < C::MHD) { float s = 0.f; for (int t = 0; t < 64; ++t) s += bf2f(*(const LAS bf16_t*)(Ks + t * PT + tid * 2)); wsf<C>(p, C::WS_DN)[(size_t)ci * C::MHD + tid] = s; }
        __syncthreads();
    }
}
__device__ __forceinline__ void ml_phase_c(LAS unsigned char* lds, const Ptrs& p, int l, int tid, int bid, int gsz) {
    const int lane = tid & 63, wave = __builtin_amdgcn_readfirstlane(tid >> 6), li = lane & 15, g = lane >> 4, it = wave & 3, eh = wave >> 2;
    LAS unsigned char* Qs = lds; LAS unsigned char* Ks = lds + T64; LAS unsigned char* Vs = lds + 2 * T64; LAS unsigned char* Cs = lds + 3 * T64;
    LAS float* sb = (LAS float*)(lds + 3 * T64 + T128);
    LAS float* sa = sb + 64; LAS float* smr = sb + 128; LAS float* siw = sb + 192; LAS float* snp = sb + 256; LAS float* ssq = sb + 384;
    const float* P = wsf<C>(p, C::WS_BIG);
    for (int ci = bid; ci < C::NCH; ci += gsz) {
        int r0, h, lc; ch_decode(ci, r0, h, lc);
        const bool sample = ci >= C::NPC, first = !sample && (ci % C::NC) == 0;
        const float mprev = wsf<C>(p, C::WS_MPREV)[ci];
        if (wave == 0) {
            float b = 0.f, a = -3.0e38f;
            if (lane < lc) { b = wsf<C>(p, C::WS_GB)[(size_t)(r0 + lane) * C::MH + h]; a = wsf<C>(p, C::WS_GA)[(size_t)(r0 + lane) * C::MH + h]; }
            float pm = a;
#pragma unroll
            for (int o = 1; o < 64; o <<= 1) { const float t = __shfl_up(pm, o); if (lane >= o) pm = fmaxf(pm, t); }
            const float mrow = b + fmaxf(mprev, pm);
            sb[lane] = b; sa[lane] = a; smr[lane] = mrow; siw[lane] = __expf(b + mprev - mrow);
        }
        if (tid >= 128 && tid < 256) { const int d = tid - 128;
            snp[d] = sample ? p.in[I_SN][((size_t)l * C::NSC + (ci - C::NPC)) * C::MHD + d] : (first ? 0.f : wsf<C>(p, C::WS_DN)[(size_t)(ci - 1) * C::MHD + d]); }
        stage64(Qs, P + (size_t)r0 * C::LDP + C::O_Q + h * C::MHD, C::LDP, lc, tid, nullptr, 1.0f);
        stage64(Ks, P + (size_t)r0 * C::LDP + C::O_K + h * C::MHD, C::LDP, lc, tid, nullptr, 0.08838834764831845f);
        stage64(Vs, P + (size_t)r0 * C::LDP + C::O_VM + h * C::MHD, C::LDP, lc, tid, nullptr, 1.0f);
        { const float* cp = sample ? p.in[I_SC] + ((size_t)l * C::NSC + (ci - C::NPC)) * C::MHD * C::MHD : wsf<C>(p, C::WS_DC) + (size_t)(first ? ci : ci - 1) * C::MHD * C::MHD;
#pragma unroll
            for (int i = 0; i < 8; ++i) { const int f = tid + 512 * i, row = f >> 5, c4 = f & 31; f32x4 v = (f32x4){0.f, 0.f, 0.f, 0.f};
                if (!first) v = *(const f32x4*)(cp + (size_t)row * C::MHD + c4 * 4);
                u32x2 w; w.x = pg8::cvt_pk_bf16(v[0], v[1]); w.y = pg8::cvt_pk_bf16(v[2], v[3]); *(LAS u32x2*)(Cs + row * PT + c4 * 8) = w; } }
        __syncthreads();
        const bool active = it * 16 < lc;
        float ssq_part = 0.f; f32x4 hv[4]; float inv_den = 0.f;
        const int i = 16 * it + li;
        if (active) {
            bf16x8 qf[4];
#pragma unroll
            for (int ks = 0; ks < 4; ++ks) qf[ks] = *(const LAS bf16x8*)(Qs + i * PT + ks * 64 + g * 16);
            f32x4 st[4];
#pragma unroll
            for (int jt = 0; jt < 4; ++jt) st[jt] = (f32x4){0.f, 0.f, 0.f, 0.f};
#pragma unroll
            for (int jt = 0; jt < 4; ++jt) if (jt <= it) {
#pragma unroll
                for (int ks = 0; ks < 4; ++ks) { const bf16x8 a = *(const LAS bf16x8*)(Ks + (16 * jt + li) * PT + ks * 64 + g * 16);
                    st[jt] = __builtin_amdgcn_mfma_f32_16x16x32_bf16(a, qf[ks], st[jt], 0, 0, 0); } }
            const float bi = sb[i], mri = smr[i], iwi = siw[i];
            float dsum = 0.f;
#pragma unroll
            for (int jt = 0; jt < 4; ++jt)
#pragma unroll
                for (int r = 0; r < 4; ++r) { const int j = 16 * jt + 4 * g + r; const float w = (j <= i) ? __expf(bi + sa[j] - mri) : 0.f; st[jt][r] *= w; dsum += st[jt][r]; }
            dsum += __shfl_xor(dsum, 16); dsum += __shfl_xor(dsum, 32);
            float qn = 0.f;
#pragma unroll
            for (int ks = 0; ks < 4; ++ks)
#pragma unroll
                for (int jj = 0; jj < 8; ++jj) qn += bf2f((bf16_t)qf[ks][jj]) * snp[32 * ks + 8 * g + jj];
            qn += __shfl_xor(qn, 16); qn += __shfl_xor(qn, 32);
            const float den = dsum + iwi * qn;
            inv_den = 1.0f / fmaxf(fabsf(den), __expf(-mri));
            bf16x8 pf[2];
#pragma unroll
            for (int t = 0; t < 2; ++t) { pg8::u32x4 w; w.x = pg8::cvt_pk_bf16(st[2 * t][0], st[2 * t][1]); w.y = pg8::cvt_pk_bf16(st[2 * t][2], st[2 * t][3]);
                w.z = pg8::cvt_pk_bf16(st[2 * t + 1][0], st[2 * t + 1][1]); w.w = pg8::cvt_pk_bf16(st[2 * t + 1][2], st[2 * t + 1][3]); pf[t] = __builtin_bit_cast(bf16x8, w); }
            const unsigned vs = (unsigned)(size_t)Vs, cs = (unsigned)(size_t)Cs;
#pragma unroll
            for (int e4 = 0; e4 < 4; ++e4) { const int et = 4 * eh + e4;
                s16x4 vlo[2], vhi[2], clo[4], chi[4];
#pragma unroll
                for (int t = 0; t < 2; ++t) { vlo[t] = att::tr_read(tr_addr(vs, 32 * t + 4 * g, 16 * et, li)); vhi[t] = att::tr_read(tr_addr(vs, 32 * t + 16 + 4 * g, 16 * et, li)); }
#pragma unroll
                for (int ks = 0; ks < 4; ++ks) { clo[ks] = att::tr_read(tr_addr(cs, 32 * ks + 8 * g, 16 * et, li)); chi[ks] = att::tr_read(tr_addr(cs, 32 * ks + 8 * g + 4, 16 * et, li)); }
                lds_wait();
                f32x4 aS = (f32x4){0.f, 0.f, 0.f, 0.f}, aC = (f32x4){0.f, 0.f, 0.f, 0.f};
#pragma unroll
                for (int t = 0; t < 2; ++t) aS = __builtin_amdgcn_mfma_f32_16x16x32_bf16(mk8(vlo[t], vhi[t]), pf[t], aS, 0, 0, 0);
#pragma unroll
                for (int ks = 0; ks < 4; ++ks) aC = __builtin_amdgcn_mfma_f32_16x16x32_bf16(mk8(clo[ks], chi[ks]), qf[ks], aC, 0, 0, 0);
                hv[e4] = (aS + aC * iwi) * inv_den;
                ssq_part += (hv[e4][0] * hv[e4][0] + hv[e4][1] * hv[e4][1]) + (hv[e4][2] * hv[e4][2] + hv[e4][3] * hv[e4][3]); }
            ssq_part += __shfl_xor(ssq_part, 16); ssq_part += __shfl_xor(ssq_part, 32);
            if (g == 0) ssq[wave * 16 + li] = ssq_part;
        }
        __syncthreads();
        if (active) {
            const float tot = ssq_part + ssq[(wave ^ 4) * 16 + li];
            const float rs = rsqrtf(tot * (1.0f / C::MHD) + 1e-6f);
            const int row = r0 + i;
#pragma unroll
            for (int e4 = 0; e4 < 4; ++e4) { const int e = 16 * (4 * eh + e4) + 4 * g;
                const f32x4 og = *(const f32x4*)(P + (size_t)row * C::LDP + C::O_O + h * C::MHD + e); const f32x4 gn = *(const f32x4*)(p.in[I_NG] + (size_t)l * C::MW + h * C::MHD + e);
                float o4[4];
#pragma unroll
                for (int r = 0; r < 4; ++r) o4[r] = hv[e4][r] * rs * gn[r] * __builtin_amdgcn_rcpf(1.0f + __expf(-og[r]));
                u32x2 w; w.x = pg8::cvt_pk_bf16(o4[0], o4[1]); w.y = pg8::cvt_pk_bf16(o4[2], o4[3]);
                *(u32x2*)(wsb<C>(p, C::WS_MIX) + (size_t)row * C::D + C::PW + C::GW + h * C::MHD + e) = w; }
        }
        __syncthreads();
    }
}
}
namespace rw {
typedef att::f32x4 f32x4; typedef att::u32x2 u32x2;
static_assert(C::D == 2048, "row ops assume 2048 columns = 8 float4 per lane");
__device__ __forceinline__ float wave_sum(float v) {
#pragma unroll
    for (int o = 1; o < 64; o <<= 1) v += __shfl_xor(v, o);
    return v;
}
__device__ __forceinline__ void rows_init(const Ptrs& p, int tid, int bid, int gsz) {
    const int lane = tid & 63, gw = bid * NWAVES + (tid >> 6), NGW = gsz * NWAVES;
    float* SS = wsf<C>(p, C::WS_SS);
    for (int r = gw; r < C::M; r += NGW) {
        const float* src = r < C::MP ? p.in[I_XP] + (size_t)r * C::D : p.in[I_XS] + (size_t)(r - C::MP) * C::D;
        float* X = wsf<C>(p, C::WS_X) + (size_t)r * C::D; bf16_t* XB = wsb<C>(p, C::WS_XB) + (size_t)r * C::D;
        float ss = 0.f;
#pragma unroll
        for (int j = 0; j < 8; ++j) { const f32x4 v = *(const f32x4*)(src + (lane + 64 * j) * 4); *(f32x4*)(X + (lane + 64 * j) * 4) = v;
            u32x2 w; w.x = pg8::cvt_pk_bf16(v[0], v[1]); w.y = pg8::cvt_pk_bf16(v[2], v[3]); *(u32x2*)(XB + (lane + 64 * j) * 4) = w;
            ss += (v[0] * v[0] + v[1] * v[1]) + (v[2] * v[2] + v[3] * v[3]); }
        ss = wave_sum(ss);
        if (lane < C::NSS) SS[(size_t)lane * C::M + r] = lane == 0 ? ss : 0.f;
    }
    for (int r = gw; r < C::MM; r += NGW) {
        const float* src = p.in[I_MEM] + (size_t)r * C::D; bf16_t* MB = wsb<C>(p, C::WS_MEMB) + (size_t)r * C::D;
        float ss = 0.f;
#pragma unroll
        for (int j = 0; j < 8; ++j) { const f32x4 v = *(const f32x4*)(src + (lane + 64 * j) * 4);
            u32x2 w; w.x = pg8::cvt_pk_bf16(v[0], v[1]); w.y = pg8::cvt_pk_bf16(v[2], v[3]); *(u32x2*)(MB + (lane + 64 * j) * 4) = w;
            ss += (v[0] * v[0] + v[1] * v[1]) + (v[2] * v[2] + v[3] * v[3]); }
        ss = wave_sum(ss);
        if (lane == 0) wsf<C>(p, C::WS_RSTDM)[r] = rsqrtf(ss * (1.0f / C::D) + 1e-6f);
    }
}
__device__ __forceinline__ void rows_final(const Ptrs& p, int tid, int bid, int gsz) {
    const int lane = tid & 63, gw = bid * NWAVES + (tid >> 6), NGW = gsz * NWAVES;
    for (int r = gw; r < C::M; r += NGW) {
        const float* X = wsf<C>(p, C::WS_X) + (size_t)r * C::D; const float rs = rsqrtf(wsf<C>(p, C::WS_SS)[(size_t)(C::NSS - 1) * C::M + r] * (1.0f / C::D) + 1e-6f);
        float* o = r < C::MP ? p.out + C::OUT_YP + (size_t)r * C::D : p.out + C::OUT_YS + (size_t)(r - C::MP) * C::D;
        float pscale = 1.0f, padd = 0.f;
#if defined(PROBE_MASK_A)
        { const unsigned long long* TS = (const unsigned long long*)(p.ws + C::WS_CTL + 32768); unsigned long long ta = 0, tb = 0;
          for (int k = 0; k < 25; ++k) { const unsigned long long dk = TS[k + 1] - TS[k]; if ((PROBE_MASK_A >> k) & 1ull) ta += dk; if ((PROBE_MASK_B >> k) & 1ull) tb += dk; }
#if defined(PROBE_MLT)
          ta = TS[48 + PROBE_MLT];
#endif
#if defined(PROBE_GST)
          { const unsigned long long* st = (const unsigned long long*)(p.ws + C::WS_END); unsigned long long epi = 0; for (int u2 = 0; u2 < 8; ++u2) epi += st[3 + 2 * u2] - st[2 + 2 * u2];
            const unsigned long long tot = st[18] - st[0], fill = st[1] - st[0];
            ta = (unsigned long long)(1.0e6 * (double)(PROBE_GST == 1 ? epi : fill) / (double)tot); }
#endif
#if defined(PROBE_MLC)
          ta = TS[48 + PROBE_MLC];
#endif
#if defined(PROBE_ATT)
          ta = 0; for (int l2 = 0; l2 < 2; ++l2) { const int k = 1 + 12 * l2 + 8; ta += (PROBE_ATT == 1) ? TS[44 + l2] - TS[k] : TS[k + 1] - TS[44 + l2]; }
#endif
#if defined(PROBE_SCN)
          ta = 0; for (int l2 = 0; l2 < 2; ++l2) { const int k = 1 + 12 * l2 + 4; ta += (PROBE_SCN == 1) ? TS[44 + l2] - TS[k] : TS[k + 1] - TS[44 + l2]; }
#endif
#if defined(PROBE_MIXA)
          ta = 0; for (int l2 = 0; l2 < 2; ++l2) { const int k = 1 + 12 * l2 + 3; ta += (PROBE_MIXA == 1) ? TS[40 + l2] - TS[k] : (PROBE_MIXA == 2) ? TS[42 + l2] - TS[40 + l2] : TS[k + 1] - TS[42 + l2]; }
#endif
#if defined(PROBE_SPLIT_MODE)
          ta = 0; for (int l2 = 0; l2 < 2; ++l2) { const int k = 1 + 10 * l2 + 3; ta += (PROBE_SPLIT_MODE == 1) ? TS[40 + l2] - TS[k] : TS[k + 1] - TS[40 + l2]; }
#endif
          if (r >= C::MP) pscale = 1.0f + 0.03f + (float)ta * 0.01f * PROBE_SA;
          if (r == 0 && lane == 0) padd = 1.0f + (float)tb * 0.01f * PROBE_SB; }
#endif
#pragma unroll
        for (int j = 0; j < 8; ++j) { const f32x4 v = *(const f32x4*)(X + (lane + 64 * j) * 4); const f32x4 gg = *(const f32x4*)(p.in[I_GFIN] + (lane + 64 * j) * 4);
            f32x4 y = v * rs * gg * pscale; if (j == 0) y[0] += padd; *(f32x4*)(o + (lane + 64 * j) * 4) = y; }
    }
}
__device__ __forceinline__ void ml_scan(const Ptrs& p, int l, long gtid, long gthreads) {
    const float* CBL = wsf<C>(p, C::WS_CBL); const float* CML = wsf<C>(p, C::WS_CML);
    float* DC = wsf<C>(p, C::WS_DC); float* DN = wsf<C>(p, C::WS_DN);
    constexpr int NPS = C::BATCH * C::MH, E4 = C::MHD / 4;
    for (long it = gtid; it < (long)NPS * C::MHD * E4; it += gthreads) {
        const int e4 = (int)(it % E4), d = (int)((it / E4) % C::MHD), sq = (int)(it / ((long)E4 * C::MHD));
        float m = 0.f; f32x4 cst = (f32x4){0.f, 0.f, 0.f, 0.f};
        static_assert(C::NC % 8 == 0, "scan is unrolled by 8 chunks");
        for (int c0 = 0; c0 < C::NC; c0 += 8) {
            f32x4 v[8]; float bl[8], ml[8];
#pragma unroll
            for (int j = 0; j < 8; ++j) { const int ci = sq * C::NC + c0 + j; v[j] = *(const f32x4*)(DC + ((size_t)ci * C::MHD + d) * C::MHD + e4 * 4); bl[j] = CBL[ci]; ml[j] = CML[ci]; }
#pragma unroll
            for (int j = 0; j < 8; ++j) { const int ci = sq * C::NC + c0 + j; const float a = bl[j] + m, mn = fmaxf(a, ml[j]), dec = __expf(a - mn), f = __expf(ml[j] - mn);
                cst = cst * dec + v[j] * f; *(f32x4*)(DC + ((size_t)ci * C::MHD + d) * C::MHD + e4 * 4) = cst; m = mn; }
        }
        *(f32x4*)(p.out + C::OUT_CP + (((size_t)l * NPS + sq) * C::MHD + d) * C::MHD + e4 * 4) = cst;
    }
    for (long it = gtid; it < (long)NPS * C::MHD; it += gthreads) {
        const int d = (int)(it % C::MHD), sq = (int)(it / C::MHD);
        float m = 0.f, nst = 0.f;
        for (int c = 0; c < C::NC; ++c) { const int ci = sq * C::NC + c; const float a = CBL[ci] + m, b2 = CML[ci], mn = fmaxf(a, b2), dec = __expf(a - mn), f = __expf(b2 - mn);
            const size_t on = (size_t)ci * C::MHD + d; nst = dec * nst + f * DN[on]; DN[on] = nst; m = mn; }
        p.out[C::OUT_NP + ((size_t)l * NPS + sq) * C::MHD + d] = nst;
    }
    for (long it = gtid; it < (long)C::NSC * C::MHD * E4; it += gthreads) {
        const int e4 = (int)(it % E4), d = (int)((it / E4) % C::MHD), q = (int)(it / ((long)E4 * C::MHD)), ci = C::NPC + q;
        const float m0 = p.in[I_SM][(size_t)l * C::NSC + q], a = CBL[ci] + m0, b2 = CML[ci], mn = fmaxf(a, b2), dec = __expf(a - mn), f = __expf(b2 - mn);
        const size_t so = (((size_t)l * C::NSC + q) * C::MHD + d) * C::MHD + e4 * 4;
        *(f32x4*)(p.out + C::OUT_CS + so) = *(const f32x4*)(p.in[I_SC] + so) * dec + *(const f32x4*)(DC + ((size_t)ci * C::MHD + d) * C::MHD + e4 * 4) * f;
    }
    for (long it = gtid; it < (long)C::NSC * C::MHD; it += gthreads) {
        const int d = (int)(it % C::MHD), q = (int)(it / C::MHD), ci = C::NPC + q;
        const float m0 = p.in[I_SM][(size_t)l * C::NSC + q], a = CBL[ci] + m0, b2 = CML[ci], mn = fmaxf(a, b2), dec = __expf(a - mn), f = __expf(b2 - mn);
        const size_t no = ((size_t)l * C::NSC + q) * C::MHD + d;
        p.out[C::OUT_NS + no] = dec * p.in[I_SN][no] + f * DN[(size_t)ci * C::MHD + d];
    }
}
}

namespace gp {
typedef att::bf16x8 bf16x8; typedef att::s16x4 s16x4; typedef att::f32x4 f32x4; typedef att::u32x2 u32x2;
constexpr int PT = mx::PT, T128 = mx::T128;
static_assert(C::GHD == 128 && C::PGD == 128 && C::GCH == 128 && C::SEQ % 128 == 0 && C::DEC_SEQ == 32 && C::PH == 15, "gmlp / pool phases are built for these shapes");
constexpr int NT_P = C::MP / 128;
constexpr int NU_G = NT_P * 4 + C::DEC_BATCH * 4;
__device__ __forceinline__ void gmlp_phase(LAS unsigned char* lds, const Ptrs& p, int l, int tid, int bid, int gsz) {
    const int lane = tid & 63, wave = __builtin_amdgcn_readfirstlane(tid >> 6), li = lane & 15, g = lane >> 4;
    LAS unsigned char* Vs = lds; LAS unsigned char* Ws = lds + T128;
    const float* P = wsf<C>(p, C::WS_BIG);
    for (int u = bid; u < NU_G; u += gsz) {
        int r0, lc, h; bool sample = false; int sb = 0;
        if (u < NT_P * 4) { h = u & 3; r0 = (u >> 2) * 128; lc = 128; } else { const int s = u - NT_P * 4; h = s & 3; sb = s >> 2; r0 = C::MP + sb * C::DEC_SEQ; lc = C::DEC_SEQ; sample = true; }
#pragma unroll
        for (int i = 0; i < 8; ++i) { const int f = tid + 512 * i, row = f >> 5, c4 = f & 31; f32x4 v = (f32x4){0.f, 0.f, 0.f, 0.f};
            if (row < lc) v = *(const f32x4*)(P + (size_t)(r0 + row) * C::LDP + C::O_V + h * 128 + c4 * 4);
            float ss = (v[0] * v[0] + v[1] * v[1]) + (v[2] * v[2] + v[3] * v[3]);
#pragma unroll
            for (int o = 1; o < 32; o <<= 1) ss += __shfl_xor(ss, o);
            const float rs = rsqrtf(ss * (1.0f / 128) + 1e-6f); const f32x4 gn = *(const f32x4*)(p.in[I_GVG] + (size_t)l * C::GW + h * 128 + c4 * 4);
            v = v * rs * gn;
            if (sample && row < lc) *(f32x4*)(p.out + C::OUT_VS + (((size_t)l * C::DEC_BATCH + sb) * C::DEC_SEQ + row) * C::GW + h * 128 + c4 * 4) = v;
            u32x2 w; w.x = pg8::cvt_pk_bf16(v[0], v[1]); w.y = pg8::cvt_pk_bf16(v[2], v[3]); *(LAS u32x2*)(Vs + row * PT + c4 * 8) = w; }
        const float* wsrc = p.in[I_GWS] + ((size_t)l * C::GH + h) * 128 * 128;
#pragma unroll
        for (int i = 0; i < 8; ++i) { const int f = tid + 512 * i, row = f >> 5, c4 = f & 31; f32x4 v = *(const f32x4*)(wsrc + (size_t)row * 128 + c4 * 4);
#pragma unroll
            for (int j = 0; j < 4; ++j) if (c4 * 4 + j > row) v[j] = 0.f;
            u32x2 w; w.x = pg8::cvt_pk_bf16(v[0], v[1]); w.y = pg8::cvt_pk_bf16(v[2], v[3]); *(LAS u32x2*)(Ws + row * PT + c4 * 8) = w; }
        WG_SYNC();
        if (wave * 16 < lc) {
            const int i = wave * 16 + li, nks = (wave * 16 + 15) / 32 + 1;
            f32x4 acc[8];
#pragma unroll
            for (int dt = 0; dt < 8; ++dt) acc[dt] = (f32x4){0.f, 0.f, 0.f, 0.f};
            const unsigned vs = (unsigned)(size_t)Vs;
            for (int ks = 0; ks < nks; ++ks) {
                const bf16x8 bq = *(const LAS bf16x8*)(Ws + i * PT + ks * 64 + g * 16);
                s16x4 lo[8], hi[8];
#pragma unroll
                for (int dt = 0; dt < 8; ++dt) { lo[dt] = att::tr_read(mx::tr_addr(vs, 32 * ks + 8 * g, 16 * dt, li)); hi[dt] = att::tr_read(mx::tr_addr(vs, 32 * ks + 8 * g + 4, 16 * dt, li)); }
                mx::lds_wait();
#pragma unroll
                for (int dt = 0; dt < 8; ++dt) acc[dt] = __builtin_amdgcn_mfma_f32_16x16x32_bf16(mx::mk8(lo[dt], hi[dt]), bq, acc[dt], 0, 0, 0);
            }
            const float bsi = p.in[I_GBS][((size_t)l * C::GH + h) * C::GCH + i];
            const int row = r0 + i;
#pragma unroll
            for (int dt = 0; dt < 8; ++dt) { const int d = 16 * dt + 4 * g; const f32x4 uu = *(const f32x4*)(P + (size_t)row * C::LDP + C::O_U + h * 128 + d);
                u32x2 w; w.x = pg8::cvt_pk_bf16(uu[0] * (acc[dt][0] + bsi), uu[1] * (acc[dt][1] + bsi)); w.y = pg8::cvt_pk_bf16(uu[2] * (acc[dt][2] + bsi), uu[3] * (acc[dt][3] + bsi));
                *(u32x2*)(wsb<C>(p, C::WS_MIX) + (size_t)row * C::D + C::PW + h * 128 + d) = w; }
        }
        WG_SYNC();
    }
}
__device__ __forceinline__ void pool_phase(LAS unsigned char* lds, const Ptrs& p, int l, int tid, int bid, int gsz) {
    const int lane = tid & 63, wave = __builtin_amdgcn_readfirstlane(tid >> 6), li = lane & 15, g = lane >> 4;
    LAS unsigned char* Ds = lds; LAS unsigned char* Ws = lds + T128;
    const float* P = wsf<C>(p, C::WS_BIG);
    for (int u = bid; u < NU_G; u += gsz) {
        int r0, lc, grp, t0, L, b; bool sample = false;
        if (u < NT_P * 4) { grp = u & 3; r0 = (u >> 2) * 128; lc = 128; b = r0 / C::SEQ; t0 = r0 % C::SEQ; L = C::SEQ; } else { const int s = u - NT_P * 4; grp = s & 3; b = s >> 2; r0 = C::MP + b * C::DEC_SEQ; lc = C::DEC_SEQ; t0 = 0; L = C::DEC_SEQ; sample = true; }
        const int w = 2 << grp;
        { const int c4 = tid & 31, sg = tid >> 5, ch = grp * 128 + c4 * 4;
            const float* hist = p.in[I_SPOOL] + ((size_t)l * C::DEC_BATCH + b) * C::PH * C::PW + ch;
            auto xat = [&](int t) -> f32x4 {
                if (t >= 0) return *(const f32x4*)(P + (size_t)(r0 - t0 + t) * C::LDP + ch);
                if (sample && C::PH + t >= 0) return *(const f32x4*)(hist + (size_t)(C::PH + t) * C::PW);
                return (f32x4){0.f, 0.f, 0.f, 0.f}; };
            if (sg * 8 < lc) {
                const int ts = t0 + sg * 8;
                f32x4 sum = (f32x4){0.f, 0.f, 0.f, 0.f};
                for (int j = 1; j < w; ++j) sum = sum + xat(ts - j);
#pragma unroll
                for (int k = 0; k < 8; ++k) { const int t = ts + k; const f32x4 x = xat(t); sum = sum + x;
                    const int pos = (sample ? C::PAST : 0) + t; const float inv = 1.0f / (float)((pos + 1) < w ? (pos + 1) : w);
                    const f32x4 dv = sum * inv - x;
                    u32x2 ww; ww.x = pg8::cvt_pk_bf16(dv[0], dv[1]); ww.y = pg8::cvt_pk_bf16(dv[2], dv[3]); *(LAS u32x2*)(Ds + (sg * 8 + k) * PT + c4 * 8) = ww;
                    sum = sum - xat(t - w + 1);
                    const int idx = t - (L - C::PH);
                    if (idx >= 0) *(f32x4*)(p.out + (sample ? C::OUT_POOLS + (((size_t)l * C::DEC_BATCH + b) * C::PH + idx) * C::PW : C::OUT_POOLP + (((size_t)l * C::BATCH + b) * C::PH + idx) * C::PW) + ch) = x; }
            } else {
#pragma unroll
                for (int k = 0; k < 8; ++k) *(LAS u32x2*)(Ds + (sg * 8 + k) * PT + c4 * 8) = (u32x2){0u, 0u};
            }
        }
        const float* wsrc = p.in[I_POOLW] + ((size_t)l * C::PG + grp) * 128 * 128;
#pragma unroll
        for (int i = 0; i < 8; ++i) { const int f = tid + 512 * i, row = f >> 5, c4 = f & 31; const f32x4 v = *(const f32x4*)(wsrc + (size_t)row * 128 + c4 * 4);
            u32x2 ww; ww.x = pg8::cvt_pk_bf16(v[0], v[1]); ww.y = pg8::cvt_pk_bf16(v[2], v[3]); *(LAS u32x2*)(Ws + row * PT + c4 * 8) = ww; }
        WG_SYNC();
        if (wave * 16 < lc) {
            const int t = wave * 16 + li;
            f32x4 acc[8];
#pragma unroll
            for (int et = 0; et < 8; ++et) acc[et] = (f32x4){0.f, 0.f, 0.f, 0.f};
            const unsigned wsa = (unsigned)(size_t)Ws;
#pragma unroll
            for (int ks = 0; ks < 4; ++ks) {
                const bf16x8 bq = *(const LAS bf16x8*)(Ds + t * PT + ks * 64 + g * 16);
                s16x4 lo[8], hi[8];
#pragma unroll
                for (int et = 0; et < 8; ++et) { lo[et] = att::tr_read(mx::tr_addr(wsa, 32 * ks + 8 * g, 16 * et, li)); hi[et] = att::tr_read(mx::tr_addr(wsa, 32 * ks + 8 * g + 4, 16 * et, li)); }
                mx::lds_wait();
#pragma unroll
                for (int et = 0; et < 8; ++et) acc[et] = __builtin_amdgcn_mfma_f32_16x16x32_bf16(mx::mk8(lo[et], hi[et]), bq, acc[et], 0, 0, 0);
            }
            const int row = r0 + t;
#pragma unroll
            for (int et = 0; et < 8; ++et) { const int e = 16 * et + 4 * g; const f32x4 sc = *(const f32x4*)(p.in[I_POOLS] + (size_t)l * C::PW + grp * 128 + e);
                u32x2 ww; ww.x = pg8::cvt_pk_bf16(acc[et][0] * sc[0], acc[et][1] * sc[1]); ww.y = pg8::cvt_pk_bf16(acc[et][2] * sc[2], acc[et][3] * sc[3]);
                *(u32x2*)(wsb<C>(p, C::WS_MIX) + (size_t)row * C::D + grp * 128 + e) = ww; }
        }
        WG_SYNC();
    }
}
}
namespace mp {
typedef att::bf16x8 bf16x8; typedef att::s16x4 s16x4; typedef att::f32x4 f32x4; typedef att::u32x2 u32x2; typedef pg8::u32x4 u32x4;
constexpr int PT = mx::PT, T64 = mx::T64, T128 = mx::T128, MAXU = 8;
#define MP_TR(dst, base, OFF) asm volatile("ds_read_b64_tr_b16 %0, %1 offset:%2" : "=&v"(dst) : "v"(base), "i"(OFF) : "memory")
__device__ __forceinline__ void ml_a(LAS unsigned char* lds, const Ptrs& p, int l, int tid, int bid, int gsz) {
    const int lane = tid & 63, wave = __builtin_amdgcn_readfirstlane(tid >> 6), li = lane & 15, g = lane >> 4;
    LAS unsigned char* Ks = lds; LAS unsigned char* Vs = lds + T64; LAS float* wts = (LAS float*)(lds + 2 * T64);
    const float* P = wsf<C>(p, C::WS_BIG);
    const int nu = bid < C::NCH ? (C::NCH - 1 - bid) / gsz + 1 : 0;
    if (wave < nu) { const int ci = bid + wave * gsz; int r0, h, lc; mx::ch_decode(ci, r0, h, lc);
        float lf = 0.f, ig = -3.0e38f;
        if (lane < lc) { const float* pr = P + (size_t)(r0 + lane) * C::LDP; ig = pr[C::O_IG + h] + p.in[I_IB][l * C::MH + h]; const float fx = pr[C::O_FG + h] + p.in[I_FB][l * C::MH + h];
            lf = fx >= 0.f ? -__logf(1.0f + __expf(-fx)) : fx - __logf(1.0f + __expf(fx)); }
        float b = lf;
#pragma unroll
        for (int o = 1; o < 64; o <<= 1) { const float t = __shfl_up(b, o); if (lane >= o) b += t; }
        const float a = lane < lc ? ig - b : -3.0e38f;
        float amax = a;
#pragma unroll
        for (int o = 1; o < 64; o <<= 1) amax = fmaxf(amax, __shfl_xor(amax, o));
        const float bL = __shfl(b, lc - 1), mloc = bL + amax;
        wts[wave * 64 + lane] = lane < lc ? __expf(bL + a - mloc) : 0.f;
        if (lane < lc) { wsf<C>(p, C::WS_GB)[(size_t)(r0 + lane) * C::MH + h] = b; wsf<C>(p, C::WS_GA)[(size_t)(r0 + lane) * C::MH + h] = a; }
        if (lane == 0) { wsf<C>(p, C::WS_CBL)[ci] = bL; wsf<C>(p, C::WS_CML)[ci] = mloc; } }
    const unsigned lofs8 = (unsigned)((8 * g + (li >> 2)) * PT + 8 * (li & 3));
    const unsigned kw8 = (unsigned)(size_t)Ks + lofs8 + (unsigned)(32 * wave), vs8 = (unsigned)(size_t)Vs + lofs8;
    f32x4 pk[4], pv[4];
    auto window = [&](int ci) { int r0, h, lc; mx::ch_decode(ci, r0, h, lc); const float* src = P + (size_t)r0 * C::LDP + h * C::MHD;
#pragma unroll
        for (int q = 0; q < 4; ++q) { const int f = tid + 512 * q, row = f >> 5, c4 = f & 31;
            if (row < lc) { pk[q] = *(const f32x4*)(src + (size_t)row * C::LDP + C::O_K + c4 * 4); pv[q] = *(const f32x4*)(src + (size_t)row * C::LDP + C::O_VM + c4 * 4); }
            else { pk[q] = (f32x4){0.f, 0.f, 0.f, 0.f}; pv[q] = pk[q]; } }
        __builtin_amdgcn_sched_barrier(0); };
    if (nu > 0) window(bid);
    WG_SYNC();
    for (int j = 0; j < nu; ++j) { const int ci = bid + j * gsz;
#pragma unroll
        for (int q = 0; q < 4; ++q) { const int f = tid + 512 * q, row = f >> 5, c4 = f & 31; const float sw = 0.08838834764831845f * wts[j * 64 + row];
            u32x2 w; w.x = pg8::cvt_pk_bf16(pk[q][0] * sw, pk[q][1] * sw); w.y = pg8::cvt_pk_bf16(pk[q][2] * sw, pk[q][3] * sw); *(LAS u32x2*)(Ks + row * PT + c4 * 8) = w;
            w.x = pg8::cvt_pk_bf16(pv[q][0], pv[q][1]); w.y = pg8::cvt_pk_bf16(pv[q][2], pv[q][3]); *(LAS u32x2*)(Vs + row * PT + c4 * 8) = w; }
        if (j + 1 < nu) window(ci + gsz);
        WG_SYNC();
        f32x4 acc[8], accn = (f32x4){0.f, 0.f, 0.f, 0.f};
#pragma unroll
        for (int et = 0; et < 8; ++et) acc[et] = (f32x4){0.f, 0.f, 0.f, 0.f};
        const bf16x8 ones = (bf16x8){0x3F80, 0x3F80, 0x3F80, 0x3F80, 0x3F80, 0x3F80, 0x3F80, 0x3F80};
#pragma unroll
        for (int t = 0; t < 2; ++t) {
            s16x4 alo, ahi, blo[8], bhi[8]; MP_TR(alo, kw8, (32 * t) * PT); MP_TR(ahi, kw8, (32 * t + 4) * PT);
#pragma unroll
            for (int et = 0; et < 8; ++et) { MP_TR(blo[et], vs8, (32 * t) * PT + 32 * et); MP_TR(bhi[et], vs8, (32 * t + 4) * PT + 32 * et); }
            mx::lds_wait();
            const bf16x8 a = mx::mk8(alo, ahi);
#pragma unroll
            for (int et = 0; et < 8; ++et) acc[et] = __builtin_amdgcn_mfma_f32_16x16x32_bf16(mx::mk8(blo[et], bhi[et]), a, acc[et], 0, 0, 0);
            accn = __builtin_amdgcn_mfma_f32_16x16x32_bf16(ones, a, accn, 0, 0, 0);
        }
        float* DC = wsf<C>(p, C::WS_DC) + (size_t)ci * C::MHD * C::MHD + (size_t)(16 * wave + li) * C::MHD + 4 * g;
#pragma unroll
        for (int et = 0; et < 8; ++et) *(f32x4*)(DC + 16 * et) = acc[et];
        if (g == 0) wsf<C>(p, C::WS_DN)[(size_t)ci * C::MHD + 16 * wave + li] = accn[0];
        WG_SYNC();
    }
}
__device__ __forceinline__ void ml_scan(const Ptrs& p, int l, long gtid, long gthreads) {
    const float* CBL = wsf<C>(p, C::WS_CBL); const float* CML = wsf<C>(p, C::WS_CML); const float* DC = wsf<C>(p, C::WS_DC); float* DN = wsf<C>(p, C::WS_DN);
    bf16_t* DCB = wsb<C>(p, C::WS_DCB); float* MPREV = wsf<C>(p, C::WS_MPREV);
    constexpr int NPS = C::BATCH * C::MH, E4 = C::MHD / 4;
    static_assert(C::NC % 8 == 0, "scan is unrolled by 8 chunks");
    for (long it = gtid; it < (long)NPS * C::MHD * E4; it += gthreads) {
        const int e4 = (int)(it % E4), d = (int)((it / E4) % C::MHD), sq = (int)(it / ((long)E4 * C::MHD));
        float m = 0.f, nst = 0.f; f32x4 cst = (f32x4){0.f, 0.f, 0.f, 0.f};
        for (int c0 = 0; c0 < C::NC; c0 += 8) {
            f32x4 v[8]; float bl[8], ml[8], dn[8];
#pragma unroll
            for (int j = 0; j < 8; ++j) { const int ci = sq * C::NC + c0 + j; v[j] = *(const f32x4*)(DC + ((size_t)ci * C::MHD + d) * C::MHD + e4 * 4); bl[j] = CBL[ci]; ml[j] = CML[ci];
                dn[j] = (e4 == 0) ? DN[(size_t)ci * C::MHD + d] : 0.f; }
            __builtin_amdgcn_sched_barrier(0);
#pragma unroll
            for (int j = 0; j < 8; ++j) { const int ci = sq * C::NC + c0 + j; const float a = bl[j] + m, mn = fmaxf(a, ml[j]), dec = __expf(a - mn), f = __expf(ml[j] - mn);
                if (d == 0 && e4 == 0) MPREV[ci] = m;
                cst = cst * dec + v[j] * f; u32x2 w; w.x = pg8::cvt_pk_bf16(cst[0], cst[1]); w.y = pg8::cvt_pk_bf16(cst[2], cst[3]);
                *(u32x2*)(DCB + ((size_t)ci * C::MHD + d) * C::MHD + e4 * 4) = w;
                nst = dec * nst + f * dn[j]; if (e4 == 0) DN[(size_t)ci * C::MHD + d] = nst;
                m = mn; }
        }
        *(f32x4*)(p.out + C::OUT_CP + (((size_t)l * NPS + sq) * C::MHD + d) * C::MHD + e4 * 4) = cst;
        if (e4 == 0) p.out[C::OUT_NP + ((size_t)l * NPS + sq) * C::MHD + d] = nst;
        if (d == 0 && e4 == 0) p.out[C::OUT_MP + (size_t)l * NPS + sq] = m;
    }
    for (long it = gtid; it < (long)C::NSC * C::MHD * E4; it += gthreads) {
        const int e4 = (int)(it % E4), d = (int)((it / E4) % C::MHD), q = (int)(it / ((long)E4 * C::MHD)), ci = C::NPC + q;
        const float m0 = p.in[I_SM][(size_t)l * C::NSC + q], a = CBL[ci] + m0, b2 = CML[ci], mn = fmaxf(a, b2), dec = __expf(a - mn), f = __expf(b2 - mn);
        const size_t so = (((size_t)l * C::NSC + q) * C::MHD + d) * C::MHD + e4 * 4; const f32x4 cin = *(const f32x4*)(p.in[I_SC] + so);
        *(f32x4*)(p.out + C::OUT_CS + so) = cin * dec + *(const f32x4*)(DC + ((size_t)ci * C::MHD + d) * C::MHD + e4 * 4) * f;
        u32x2 w; w.x = pg8::cvt_pk_bf16(cin[0], cin[1]); w.y = pg8::cvt_pk_bf16(cin[2], cin[3]); *(u32x2*)(DCB + ((size_t)ci * C::MHD + d) * C::MHD + e4 * 4) = w;
        if (d == 0 && e4 == 0) { MPREV[ci] = m0; p.out[C::OUT_MS + (size_t)l * C::NSC + q] = mn; }
    }
    for (long it = gtid; it < (long)C::NSC * C::MHD; it += gthreads) {
        const int d = (int)(it % C::MHD), q = (int)(it / C::MHD), ci = C::NPC + q;
        const float m0 = p.in[I_SM][(size_t)l * C::NSC + q], a = CBL[ci] + m0, b2 = CML[ci], mn = fmaxf(a, b2), dec = __expf(a - mn), f = __expf(b2 - mn);
        const size_t no = ((size_t)l * C::NSC + q) * C::MHD + d;
        p.out[C::OUT_NS + no] = dec * p.in[I_SN][no] + f * DN[(size_t)ci * C::MHD + d];
    }
}
__device__ __forceinline__ void ml_c(LAS unsigned char* lds, const Ptrs& p, int l, int tid, int bid, int gsz) {
    const int lane = tid & 63, wave = __builtin_amdgcn_readfirstlane(tid >> 6), li = lane & 15, g = lane >> 4, it = wave & 3, eh = wave >> 2;
    LAS unsigned char* Qs = lds; LAS unsigned char* Ks = lds + T64; LAS unsigned char* Vs = lds + 2 * T64; LAS unsigned char* Cs = lds + 3 * T64;
    LAS float* SB = (LAS float*)(lds + 3 * T64 + T128); LAS float* SA = SB + MAXU * 64; LAS float* SMR = SA + MAXU * 64; LAS float* SIW = SMR + MAXU * 64;
    LAS float* snp = SIW + MAXU * 64; LAS float* ssq = snp + 128; LAS float* sgn = ssq + 128;
    const float* P = wsf<C>(p, C::WS_BIG);
    const int nu = bid < C::NCH ? (C::NCH - 1 - bid) / gsz + 1 : 0;
    if (wave < nu) { const int ci = bid + wave * gsz; int r0, h, lc; mx::ch_decode(ci, r0, h, lc); const float mprev = wsf<C>(p, C::WS_MPREV)[ci];
        float b = 0.f, a = -3.0e38f;
        if (lane < lc) { b = wsf<C>(p, C::WS_GB)[(size_t)(r0 + lane) * C::MH + h]; a = wsf<C>(p, C::WS_GA)[(size_t)(r0 + lane) * C::MH + h]; }
        float pm = a;
#pragma unroll
        for (int o = 1; o < 64; o <<= 1) { const float t = __shfl_up(pm, o); if (lane >= o) pm = fmaxf(pm, t); }
        const float mrow = b + fmaxf(mprev, pm);
        SB[wave * 64 + lane] = b; SA[wave * 64 + lane] = a; SMR[wave * 64 + lane] = mrow; SIW[wave * 64 + lane] = __expf(b + mprev - mrow); }
    const unsigned lofs8 = (unsigned)((8 * g + (li >> 2)) * PT + 8 * (li & 3)), lofs4 = (unsigned)((4 * g + (li >> 2)) * PT + 8 * (li & 3));
    const unsigned vs4e = (unsigned)(size_t)Vs + lofs4 + (unsigned)(128 * eh), cb8e = (unsigned)(size_t)Cs + lofs8 + (unsigned)(128 * eh);
    f32x4 pq[4], pk[4], pv[4], og[4]; u32x4 pc[4]; float pn = 0.f, pg = 0.f;
    auto window = [&](int ci) { int r0, h, lc; mx::ch_decode(ci, r0, h, lc); const float* src = P + (size_t)r0 * C::LDP + h * C::MHD;
        const bool sample = ci >= C::NPC, first = !sample && (ci % C::NC) == 0;
#pragma unroll
        for (int q = 0; q < 4; ++q) { const int f = tid + 512 * q, row = f >> 5, c4 = f & 31;
            if (row < lc) { pq[q] = *(const f32x4*)(src + (size_t)row * C::LDP + C::O_Q + c4 * 4); pk[q] = *(const f32x4*)(src + (size_t)row * C::LDP + C::O_K + c4 * 4); pv[q] = *(const f32x4*)(src + (size_t)row * C::LDP + C::O_VM + c4 * 4); }
            else { pq[q] = (f32x4){0.f, 0.f, 0.f, 0.f}; pk[q] = pq[q]; pv[q] = pq[q]; } }
        const bf16_t* cb = wsb<C>(p, C::WS_DCB) + (size_t)(sample ? ci : (first ? ci : ci - 1)) * C::MHD * C::MHD;
#pragma unroll
        for (int q = 0; q < 4; ++q) { const int f = tid + 512 * q; pc[q] = first ? (u32x4){0u, 0u, 0u, 0u} : *(const u32x4*)(cb + (size_t)f * 8); }
        const int i = 16 * it + li;
#pragma unroll
        for (int e4 = 0; e4 < 4; ++e4) og[e4] = (it * 16 < lc) ? *(const f32x4*)(src + (size_t)i * C::LDP + C::O_O + 16 * (4 * eh + e4) + 4 * g) : (f32x4){0.f, 0.f, 0.f, 0.f};
        if (tid < C::MHD) { pn = sample ? p.in[I_SN][((size_t)l * C::NSC + (ci - C::NPC)) * C::MHD + tid] : (first ? 0.f : wsf<C>(p, C::WS_DN)[(size_t)(ci - 1) * C::MHD + tid]);
            pg = p.in[I_NG][(size_t)l * C::MW + h * C::MHD + tid]; }
        __builtin_amdgcn_sched_barrier(0); };
    if (nu > 0) window(bid);
    WG_SYNC();
#if defined(PROBE_MLC)
    unsigned long long tacc[4] = {0, 0, 0, 0}; unsigned long long tprev = wall_clock64();
#define MLC_T(j) do { const unsigned long long tn_ = wall_clock64(); tacc[j] += tn_ - tprev; tprev = tn_; } while (0)
#else
#define MLC_T(j) do { } while (0)
#endif
    for (int j = 0; j < nu; ++j) { const int ci = bid + j * gsz; int r0, h, lc; mx::ch_decode(ci, r0, h, lc);
        const LAS float* sb = SB + j * 64; const LAS float* sa = SA + j * 64; const LAS float* smr = SMR + j * 64; const LAS float* siw = SIW + j * 64;
#pragma unroll
        for (int q = 0; q < 4; ++q) { const int f = tid + 512 * q, row = f >> 5, c4 = f & 31; const float sc = 0.08838834764831845f;
            u32x2 w; w.x = pg8::cvt_pk_bf16(pq[q][0], pq[q][1]); w.y = pg8::cvt_pk_bf16(pq[q][2], pq[q][3]); *(LAS u32x2*)(Qs + row * PT + c4 * 8) = w;
            w.x = pg8::cvt_pk_bf16(pk[q][0] * sc, pk[q][1] * sc); w.y = pg8::cvt_pk_bf16(pk[q][2] * sc, pk[q][3] * sc); *(LAS u32x2*)(Ks + row * PT + c4 * 8) = w;
            w.x = pg8::cvt_pk_bf16(pv[q][0], pv[q][1]); w.y = pg8::cvt_pk_bf16(pv[q][2], pv[q][3]); *(LAS u32x2*)(Vs + row * PT + c4 * 8) = w;
            *(LAS u32x4*)(Cs + (f >> 4) * PT + (f & 15) * 16) = pc[q]; }
        if (tid < C::MHD) { snp[tid] = pn; sgn[tid] = pg; }
        f32x4 ogc[4];
#pragma unroll
        for (int e4 = 0; e4 < 4; ++e4) ogc[e4] = og[e4];
        if (j + 1 < nu) window(ci + gsz);
        WG_SYNC(); MLC_T(0);
        const bool active = it * 16 < lc; const int i = 16 * it + li;
        float ssq_part = 0.f; f32x4 hv[4];
        if (active) {
            bf16x8 qf[4];
#pragma unroll
            for (int ks = 0; ks < 4; ++ks) qf[ks] = *(const LAS bf16x8*)(Qs + i * PT + ks * 64 + g * 16);
            f32x4 st[4];
#pragma unroll
            for (int jt = 0; jt < 4; ++jt) st[jt] = (f32x4){0.f, 0.f, 0.f, 0.f};
#pragma unroll
            for (int jt = 0; jt < 4; ++jt) if (jt <= it) {
#pragma unroll
                for (int ks = 0; ks < 4; ++ks) { const bf16x8 a = *(const LAS bf16x8*)(Ks + (16 * jt + li) * PT + ks * 64 + g * 16);
                    st[jt] = __builtin_amdgcn_mfma_f32_16x16x32_bf16(a, qf[ks], st[jt], 0, 0, 0); } }
            const float bi = sb[i], mri = smr[i], iwi = siw[i];
            float dsum = 0.f;
#pragma unroll
            for (int jt = 0; jt < 4; ++jt)
#pragma unroll
                for (int r = 0; r < 4; ++r) { const int jj = 16 * jt + 4 * g + r; const float w = (jj <= i) ? __expf(bi + sa[jj] - mri) : 0.f; st[jt][r] *= w; dsum += st[jt][r]; }
            dsum += __shfl_xor(dsum, 16); dsum += __shfl_xor(dsum, 32);
            float qn = 0.f;
#pragma unroll
            for (int ks = 0; ks < 4; ++ks)
#pragma unroll
                for (int jj = 0; jj < 8; ++jj) qn += bf2f((bf16_t)qf[ks][jj]) * snp[32 * ks + 8 * g + jj];
            qn += __shfl_xor(qn, 16); qn += __shfl_xor(qn, 32);
            const float den = dsum + iwi * qn, inv_den = 1.0f / fmaxf(fabsf(den), __expf(-mri));
            bf16x8 pf[2];
#pragma unroll
            for (int t = 0; t < 2; ++t) { u32x4 w; w.x = pg8::cvt_pk_bf16(st[2 * t][0], st[2 * t][1]); w.y = pg8::cvt_pk_bf16(st[2 * t][2], st[2 * t][3]);
                w.z = pg8::cvt_pk_bf16(st[2 * t + 1][0], st[2 * t + 1][1]); w.w = pg8::cvt_pk_bf16(st[2 * t + 1][2], st[2 * t + 1][3]); pf[t] = __builtin_bit_cast(bf16x8, w); }
#pragma unroll
            for (int e2 = 0; e2 < 2; ++e2) {
                s16x4 vlo[2][2], vhi[2][2], clo[2][4], chi[2][4];
#pragma unroll
                for (int u = 0; u < 2; ++u) {
#pragma unroll
                    for (int t = 0; t < 2; ++t) { MP_TR(vlo[u][t], vs4e, (32 * t) * PT + 32 * (2 * e2 + u)); MP_TR(vhi[u][t], vs4e, (32 * t + 16) * PT + 32 * (2 * e2 + u)); }
#pragma unroll
                    for (int ks = 0; ks < 4; ++ks) { MP_TR(clo[u][ks], cb8e, (32 * ks) * PT + 32 * (2 * e2 + u)); MP_TR(chi[u][ks], cb8e, (32 * ks + 4) * PT + 32 * (2 * e2 + u)); } }
                mx::lds_wait();
#pragma unroll
                for (int u = 0; u < 2; ++u) { const int e4 = 2 * e2 + u;
                    f32x4 aS = (f32x4){0.f, 0.f, 0.f, 0.f}, aC = (f32x4){0.f, 0.f, 0.f, 0.f};
#pragma unroll
                    for (int t = 0; t < 2; ++t) aS = __builtin_amdgcn_mfma_f32_16x16x32_bf16(mx::mk8(vlo[u][t], vhi[u][t]), pf[t], aS, 0, 0, 0);
#pragma unroll
                    for (int ks = 0; ks < 4; ++ks) aC = __builtin_amdgcn_mfma_f32_16x16x32_bf16(mx::mk8(clo[u][ks], chi[u][ks]), qf[ks], aC, 0, 0, 0);
                    hv[e4] = (aS + aC * iwi) * inv_den;
                    ssq_part += (hv[e4][0] * hv[e4][0] + hv[e4][1] * hv[e4][1]) + (hv[e4][2] * hv[e4][2] + hv[e4][3] * hv[e4][3]); } }
            ssq_part += __shfl_xor(ssq_part, 16); ssq_part += __shfl_xor(ssq_part, 32);
            if (g == 0) ssq[wave * 16 + li] = ssq_part;
        }
        MLC_T(1); WG_SYNC();
        if (active) {
            const float tot = ssq_part + ssq[(wave ^ 4) * 16 + li];
            const float rs = rsqrtf(tot * (1.0f / C::MHD) + 1e-6f);
            const int row = r0 + i;
#pragma unroll
            for (int e4 = 0; e4 < 4; ++e4) { const int e = 16 * (4 * eh + e4) + 4 * g; const f32x4 gn = *(const LAS f32x4*)(sgn + e);
                float o4[4];
#pragma unroll
                for (int r = 0; r < 4; ++r) o4[r] = hv[e4][r] * rs * gn[r] * __builtin_amdgcn_rcpf(1.0f + __expf(-ogc[e4][r]));
                u32x2 w; w.x = pg8::cvt_pk_bf16(o4[0], o4[1]); w.y = pg8::cvt_pk_bf16(o4[2], o4[3]);
                *(u32x2*)(wsb<C>(p, C::WS_MIX) + (size_t)row * C::D + C::PW + C::GW + h * C::MHD + e) = w; }
        }
        MLC_T(2); WG_SYNC(); MLC_T(3);
    }
#if defined(PROBE_MLC)
    if (bid == 0 && tid == 0) { unsigned long long* TS = (unsigned long long*)(p.ws + C::WS_CTL + 32768); for (int j = 0; j < 4; ++j) TS[48 + j] += tacc[j]; }
#endif
}
}
constexpr int PH_PER_LAYER = 12, N_PHASES = 2 + PH_PER_LAYER * C::DEPTH;
struct Args { Ptrs p; int ph_lo, ph_hi; };
__global__ void __launch_bounds__(NTHREADS, 2) fwd(Args a) {
    extern __shared__ __attribute__((aligned(16))) unsigned char lds_raw[];
    LAS unsigned char* lds = (LAS unsigned char*)lds_raw;
    typedef __attribute__((address_space(4))) const Args* KArgs;
    const KArgs ka0 = (KArgs)__builtin_amdgcn_kernarg_segment_ptr();
    const int lo = a.ph_lo, hi = a.ph_hi;
#define IN(k) (lo <= (k) && (k) < hi)
#define BOTH(k) (IN(k) && IN((k) + 1))
#define GRID_BAR(k) do { if (BOTH(k)) { xcd_barrier(bar); } } while (0)
#if defined(__HIP_DEVICE_COMPILE__)
#define LOAD_PTRS KArgs ka = ka0; asm volatile("" : "+s"(ka)); Ptrs p; _Pragma("unroll") for (int i_ = 0; i_ < 33; ++i_) p.in[i_] = ka->p.in[i_]; p.out = ka->p.out; p.ws = ka->p.ws;
#else
#define LOAD_PTRS (void)ka0; const Ptrs p = a.p;
#endif
#define PHASE_ARGS LOAD_PTRS int tid = threadIdx.x; asm volatile("" : "+v"(tid)); int bid = blockIdx.x, gsz = gridDim.x; asm volatile("" : "+s"(bid), "+s"(gsz));     \
    const int lane = tid & 63, wave = __builtin_amdgcn_readfirstlane(tid >> 6); (void)lane; (void)wave; \
    const long gtid = (long)bid * NTHREADS + tid, gthreads = (long)gsz * NTHREADS; (void)gtid; (void)gthreads; \
    float* SS = wsf<C>(p, C::WS_SS); (void)SS; const float invd = 1.0f / C::D; (void)invd;
#if defined(PROBE_MASK_A)
#define STAMP(k) do { if (blockIdx.x == 0 && threadIdx.x == 0) ((unsigned long long*)(a.p.ws + C::WS_CTL + 32768))[k] = wall_clock64(); } while (0)
#else
#define STAMP(k) do { } while (0)
#endif
#define ITEMS(n, call) do { for (long it = gtid; it < (long)(n); it += gthreads) { call; } } while (0)
#define SSL(j) (SS + (size_t)(4 * l + (j)) * C::M)
#define GEMM_ALL(STRIP, EPI, Aop, Bop, Mr, Nc, Kd, ...) do { pg8::Gemm g{Aop, Bop, Mr, Nc, Kd, Kd}; pg8::StaticOrder S; S.init(Mr, Nc, gsz, bid, (STRIP) ? 288 : 256); \
        pg8::EPI E{__VA_ARGS__}; pg8::gemm_phase<pg8::EPI, pg8::StaticOrder, STRIP, false>(lds, g, S, E, nullptr); } while (0)
#if ONE_LAUNCH
    if (threadIdx.x < 4) ((LAS unsigned*)(lds + LDS_CTL))[threadIdx.x] = 0u;
    __syncthreads();
    XcdBarrier bar = xcd_barrier_post((unsigned*)(a.p.ws + C::WS_CTL), (volatile LAS unsigned*)(lds + LDS_CTL));
#else
    XcdBarrier bar; bar.bar = nullptr; bar.x = 0; bar.st = nullptr;
#endif

    if (IN(0)) { PHASE_ARGS STAMP(0);
        const int gw = bid * NWAVES + wave, NGW = gsz * NWAVES;
        { int wl = 0, widx = 0, base = 0; WDesc d = wdesc(p, 0, 0); int nitems = (d.K / 64) * (d.N / 64);
          for (int git = gw; wl < C::DEPTH; git += NGW) {
              while (wl < C::DEPTH && git >= base + nitems) { base += nitems; if (++widx == 10) { widx = 0; ++wl; } if (wl < C::DEPTH) { d = wdesc(p, wl, widx); nitems = (d.K / 64) * (d.N / 64); } }
              if (wl < C::DEPTH) prep_item(d.W, d.K, d.Ncols, d.g, d.kind, d.N, d.dst, lds + wave * 9216, git - base, lane); } }
        rw::rows_init(p, tid, bid, gsz);
        GRID_BAR(0);
    }
    for (int l = 0; l < C::DEPTH; ++l) {
        const int pb = 1 + PH_PER_LAYER * l;
        if (IN(pb + 0)) { PHASE_ARGS STAMP(pb + 0);
#if defined(PROBE_GST)
            if (l == 0) { pg8::Gemm g{wsb<C>(p, C::WS_XB), wlayer<C>(p, l, C::W_1IN), C::M, 2 * C::FF, C::D, C::D}; pg8::StaticOrder S; S.init(C::M, 2 * C::FF, gsz, bid, 288);
                pg8::EpiSwiGLU E{wsb<C>(p, C::WS_BIG), SSL(0), C::FF, invd}; pg8::gemm_phase<pg8::EpiSwiGLU, pg8::StaticOrder, true, true>(lds, g, S, E, (unsigned long long*)(p.ws + C::WS_END) + (size_t)bid * 64); } else
#endif
            GEMM_ALL(true, EpiSwiGLU, wsb<C>(p, C::WS_XB), wlayer<C>(p, l, C::W_1IN), C::M, 2 * C::FF, C::D, wsb<C>(p, C::WS_BIG), SSL(0), C::FF, invd);
            GRID_BAR(pb + 0); }
        if (IN(pb + 1)) { PHASE_ARGS STAMP(pb + 1);
            GEMM_ALL(true, EpiResid, wsb<C>(p, C::WS_BIG), wlayer<C>(p, l, C::W_1OUT), C::M, C::D, C::FF, wsf<C>(p, C::WS_X), wsb<C>(p, C::WS_XB), SSL(1), 0.5f, C::D);
            GRID_BAR(pb + 1); }
        if (IN(pb + 2)) { PHASE_ARGS STAMP(pb + 2);
            GEMM_ALL(true, EpiScaleF32, wsb<C>(p, C::WS_XB), wlayer<C>(p, l, C::W_IN), C::M, C::LDP, C::D, wsf<C>(p, C::WS_BIG), C::LDP, SSL(1), invd);
            GRID_BAR(pb + 2); }
        if (IN(pb + 3)) { PHASE_ARGS STAMP(pb + 3); mp::ml_a(lds, p, l, tid, bid, gsz);
#if defined(PROBE_MIXA)
            xcd_barrier(bar); STAMP(40 + l);
#endif
            gp::gmlp_phase(lds, p, l, tid, gsz - 1 - bid, gsz);
#if defined(PROBE_MIXA)
            xcd_barrier(bar); STAMP(42 + l);
#endif
            GRID_BAR(pb + 3); }
        if (IN(pb + 4)) { PHASE_ARGS STAMP(pb + 4);
            if (bid < 64) {
                pg8::Gemm g{wsb<C>(p, C::WS_MEMB), wlayer<C>(p, l, C::W_KV), C::MM, 2 * C::D, C::D, C::D}; pg8::StaticOrder S; S.init(C::MM, 2 * C::D, 64, bid);
                pg8::EpiMemKV E{p.out + C::OUT_MK + (size_t)l * C::MM * C::D, p.out + C::OUT_MV + (size_t)l * C::MM * C::D, wsf<C>(p, C::WS_RSTDM), C::D, wsb<C>(p, C::WS_KVB), C::MM};
                pg8::gemm_phase<pg8::EpiMemKV, pg8::StaticOrder, false, false>(lds, g, S, E, nullptr);
            } else { mp::ml_scan(p, l, (long)(bid - 64) * NTHREADS + tid, (long)(gsz - 64) * NTHREADS); gp::pool_phase(lds, p, l, tid, gsz - 1 - bid, gsz - 64); }
            GRID_BAR(pb + 4); }
        if (IN(pb + 5)) { PHASE_ARGS STAMP(pb + 5); mp::ml_c(lds, p, l, tid, bid, gsz); GRID_BAR(pb + 5); }
        if (IN(pb + 6)) { PHASE_ARGS STAMP(pb + 6);
            GEMM_ALL(true, EpiResid, wsb<C>(p, C::WS_MIX), wlayer<C>(p, l, C::W_OUT), C::M, C::D, C::D, wsf<C>(p, C::WS_X), wsb<C>(p, C::WS_XB), SSL(2), 1.0f, C::D);
            GRID_BAR(pb + 6); }
        if (IN(pb + 7)) { PHASE_ARGS STAMP(pb + 7);
            GEMM_ALL(true, EpiScaleBf16, wsb<C>(p, C::WS_XB), wlayer<C>(p, l, C::W_Q), C::M, C::D, C::D, wsb<C>(p, C::WS_Q), C::D, SSL(2), invd);
            GRID_BAR(pb + 7); }
        if (IN(pb + 8)) { PHASE_ARGS STAMP(pb + 8);
            if (bid < 128) att::attn_phase(lds, p, l, tid, bid, 128, 128);
            else att::attn_sample_phase(lds, p, l, tid, bid - 128, gsz - 128);
            GRID_BAR(pb + 8); }
        if (IN(pb + 9)) { PHASE_ARGS STAMP(pb + 9);
            GEMM_ALL(true, EpiResid, wsb<C>(p, C::WS_AO), wlayer<C>(p, l, C::W_O), C::M, C::D, C::D, wsf<C>(p, C::WS_X), wsb<C>(p, C::WS_XB), SSL(3), 1.0f, C::D);
            GRID_BAR(pb + 9); }
        if (IN(pb + 10)) { PHASE_ARGS STAMP(pb + 10);
            GEMM_ALL(true, EpiSwiGLU, wsb<C>(p, C::WS_XB), wlayer<C>(p, l, C::W_2IN), C::M, 2 * C::FF, C::D, wsb<C>(p, C::WS_BIG), SSL(3), C::FF, invd);
            GRID_BAR(pb + 10); }
        if (IN(pb + 11)) { PHASE_ARGS STAMP(pb + 11);
            GEMM_ALL(true, EpiResid, wsb<C>(p, C::WS_BIG), wlayer<C>(p, l, C::W_2OUT), C::M, C::D, C::FF, wsf<C>(p, C::WS_X), wsb<C>(p, C::WS_XB), SSL(4), 0.5f, C::D);
            GRID_BAR(pb + 11); }
    }
    if (IN(N_PHASES - 1)) { PHASE_ARGS STAMP(N_PHASES - 1); __syncthreads(); rw::rows_final(p, tid, bid, gsz); }
#undef IN
#undef BOTH
#undef GRID_BAR
#undef ITEMS
#undef PHASE_ARGS
#undef SSL
}

extern "C" void kernel_launch(void* const* d_in, const int* in_sizes, int n_in, void* d_out, int out_size, void* d_ws, size_t ws_size, hipStream_t stream) {
    static int ready = 0;
    if (!ready) {
        if (n_in != 33 || (long)out_size != (long)C::OUT_END || ws_size < (size_t)C::WS_END) { fprintf(stderr, "kernel_launch: unexpected shapes: n_in %d out %d ws %zu (need %zu)\n", n_in, out_size, ws_size, (size_t)C::WS_END); ready = -1; return; }
        if (hipFuncSetAttribute((const void*)fwd, hipFuncAttributeMaxDynamicSharedMemorySize, LDS_BYTES) != hipSuccess) { fprintf(stderr, "kernel_launch: hipFuncSetAttribute failed\n"); ready = -1; return; }
        int dev = 0, cus = 0, per_cu = 0;
        if (hipGetDevice(&dev) != hipSuccess || hipDeviceGetAttribute(&cus, hipDeviceAttributeMultiprocessorCount, dev) != hipSuccess) { fprintf(stderr, "kernel_launch: device query failed\n"); ready = -1; return; }
        if (hipOccupancyMaxActiveBlocksPerMultiprocessor(&per_cu, (const void*)fwd, NTHREADS, LDS_BYTES) != hipSuccess || per_cu < 1) { fprintf(stderr, "kernel_launch: occupancy query reports %d blocks per CU\n", per_cu); (void)hipGetLastError(); per_cu = 1; }
        if (cus != 256) { fprintf(stderr, "kernel_launch: built for a 256-CU device (one resident workgroup per CU), found %d\n", cus); ready = -1; return; }
        ready = cus;
    }
    if (ready < 0) return;
    Args a{};
    for (int i = 0; i < 33; ++i) a.p.in[i] = (const float*)d_in[i];
    a.p.out = (float*)d_out; a.p.ws = (unsigned char*)d_ws;
#if ONE_LAUNCH
    (void)hipMemsetAsync((char*)d_ws + C::WS_CTL, 0, 65536, stream);
    a.ph_lo = 0; a.ph_hi = N_PHASES;
    hipLaunchKernelGGL(fwd, dim3(ready), dim3(NTHREADS), LDS_BYTES, stream, a);
#else
    for (int k = 0; k < N_PHASES; ++k) { a.ph_lo = k; a.ph_hi = k + 1; hipLaunchKernelGGL(fwd, dim3(ready), dim3(NTHREADS), LDS_BYTES, stream, a); }
#endif
}
```
